# Optimizing an MI355X kernel written in HIP

```python
import jax, jax.numpy as jnp
from jax import lax
import numpy as np

D_MODEL = 1024
BATCH = 4
SEQ = 8192
DEPTH = 2

CTX_LEN = 256
GRID_W = 64
N_DIR = 2
N_EVEN = (DEPTH + 1) // 2
N_ODD = DEPTH // 2
D_FF = 2816
MIX_W = 1024
EPS = 1e-6

RWKV_HEADS = 8
RWKV_HD = 64
RWKV_W = RWKV_HEADS * RWKV_HD
DECAY_LORA = 64
AAA_LORA = 64
GATE_LORA = 128
RWKV_GN_EPS = 64e-5
RWKV_SHIFT_W = 3 * RWKV_W + DECAY_LORA + AAA_LORA

MLSTM_HEADS = 4
MLSTM_HD = 128
MLSTM_W = MLSTM_HEADS * MLSTM_HD
MLSTM_CHUNK = 128

HGRN_HEADS = 4
HGRN_FD = 128
HGRN_ID = 128
HGRN_W = HGRN_HEADS * HGRN_FD
HGRN_CHUNK = 64

LRU_W = 512
LRU_BLOCKS = 8
LRU_BD = LRU_W // LRU_BLOCKS
CONV_W = 4
CONV_PAD_L = 2
LRU_C = 8.0

EVEN_SPLITS = (RWKV_W, RWKV_W, RWKV_W, N_DIR * DECAY_LORA, N_DIR * AAA_LORA, GATE_LORA,
               MLSTM_W, MLSTM_W, MLSTM_W, MLSTM_W, N_DIR * MLSTM_HEADS, N_DIR * MLSTM_HEADS)
ODD_SPLITS = (HGRN_W, N_DIR * HGRN_W, HGRN_W, HGRN_W, LRU_W, LRU_W)
EVEN_IN = sum(EVEN_SPLITS)
ODD_IN = sum(ODD_SPLITS)

kernel_name = 'hybrid_bidir_rwkv7_mlstm_hgrn2_rglru_dit'


def split_cols(t, sizes):
    idx = np.cumsum(sizes)[:-1].tolist()
    return jnp.split(t, idx, axis=-1)


def rmsnorm(x, g):
    xf = x.astype(jnp.float32)
    y = xf * lax.rsqrt(jnp.mean(xf * xf, axis=-1, keepdims=True) + EPS)
    return (y * g.astype(jnp.float32)).astype(x.dtype)


def frames_shared(t):
    return jnp.stack([t, jnp.flip(t, axis=1)])


def frames_dir(t):
    return jnp.stack([t[0], jnp.flip(t[1], axis=1)])


def merge_frames(o):
    return o[0] + jnp.flip(o[1], axis=1)


def shift_prev(t):
    return jnp.pad(t, ((0, 0), (0, 0), (1, 0), (0, 0)))[:, :, :-1]


def chunk_major(t, T):
    d, b, l, h = t.shape[:4]
    t = t.reshape((d, b, l // T, T, h) + t.shape[4:])
    return jnp.moveaxis(t, (2, 4), (0, 3))


def unchunk(t):
    t = jnp.moveaxis(t, (0, 3), (2, 4))
    d, b, nc, T, h = t.shape[:5]
    return t.reshape((d, b, nc * T, h) + t.shape[5:])


def to_col_major(t, rows):
    b, l, f = t.shape
    return t.reshape(b, rows, GRID_W, f).transpose(0, 2, 1, 3).reshape(b, l, f)


def to_row_major(t, rows):
    b, l, f = t.shape
    return t.reshape(b, GRID_W, rows, f).transpose(0, 2, 1, 3).reshape(b, l, f)


def swiglu(t, w1, w3, w2):
    return (jax.nn.silu(t @ w1) * (t @ w3)) @ w2


def bidir(seq, p, cols_ctx, cols_lat, state0):
    y_ctx, state = seq(cols_ctx, state0, p)
    y_lat, _ = seq(cols_lat, state, p)
    return y_ctx, y_lat


def rwkv7_seq(cols, S0, p):
    r, k, v, wd, ad, gd = (t.astype(jnp.float32) for t in cols)
    B_, L_ = r.shape[:2]
    heads = lambda t: t.reshape(t.shape[:3] + (RWKV_HEADS, RWKV_HD))
    per_dir = lambda t, n: frames_dir(jnp.moveaxis(t.reshape(B_, L_, N_DIR, n), 2, 0))
    s = jnp.concatenate([frames_shared(r), frames_shared(k), frames_shared(v),
                         per_dir(wd, DECAY_LORA), per_dir(ad, AAA_LORA)], axis=-1)
    s = s + p['mu'][:, None, None, :] * (shift_prev(s) - s)
    r, k, v, wd, ad = split_cols(s, (RWKV_W, RWKV_W, RWKV_W, DECAY_LORA, AAA_LORA))
    w = -jax.nn.softplus(-(p['w0'][:, None, None, :]
                           + jnp.einsum('dblr,drc->dblc', jnp.tanh(wd), p['w2']))) - 0.5
    a = jax.nn.sigmoid(p['a0'][:, None, None, :] + jnp.einsum('dblr,drc->dblc', ad, p['a2']))
    kk = heads(k * p['k_k'][:, None, None, :])
    kk = kk / jnp.maximum(jnp.sqrt(jnp.sum(kk * kk, axis=-1, keepdims=True)), 1e-12)
    k = heads(k * (1.0 + (a - 1.0) * p['k_a'][:, None, None, :]))
    r, v, a = heads(r), heads(v), heads(a)
    decay = heads(jnp.exp(-jnp.exp(w)))
    xs = tuple(jnp.moveaxis(t, 2, 0) for t in (r, decay, k, v, kk, kk * a))

    def step(S, inp):
        r_t, w_t, k_t, v_t, kk_t, b_t = inp
        S = (S * w_t[..., None, :]
             - jnp.einsum('...ij,...j->...i', S, kk_t)[..., :, None] * b_t[..., None, :]
             + v_t[..., :, None] * k_t[..., None, :])
        return S, jnp.einsum('...ij,...j->...i', S, r_t)

    S, o = lax.scan(step, S0, xs)
    o = jnp.moveaxis(o, 0, 2)
    mean = jnp.mean(o, axis=-1, keepdims=True)
    var = jnp.mean(jnp.square(o - mean), axis=-1, keepdims=True)
    gn = ((o - mean) * lax.rsqrt(var + RWKV_GN_EPS)).reshape(N_DIR, B_, L_, RWKV_W)
    gn = gn * p['ln_w'][:, None, None, :] + p['ln_b'][:, None, None, :]
    bonus = (jnp.sum(r * k * p['r_k'][:, None, None], axis=-1, keepdims=True) * v).reshape(N_DIR, B_, L_, RWKV_W)
    g = jnp.einsum('blr,rc->blc', jax.nn.sigmoid(gd), p['g2'])
    return merge_frames(gn + bonus) * g, S


def mlstm_seq(cols, state0, p):
    q, k, v, o_pre, i_pre, f_pre = (t.astype(jnp.float32) for t in cols)
    B_, L_ = q.shape[:2]
    T = MLSTM_CHUNK
    heads = lambda t: t.reshape(B_, L_, MLSTM_HEADS, MLSTM_HD)
    gates = lambda t, bias: frames_dir(jnp.moveaxis(t.reshape(B_, L_, N_DIR, MLSTM_HEADS), 2, 0)
                                       + bias[:, None, None, :])
    qc = chunk_major(frames_shared(heads(q)) * MLSTM_HD ** -0.5, T)
    kc = chunk_major(frames_shared(heads(k)), T)
    vc = chunk_major(frames_shared(heads(v)), T)
    li = chunk_major(gates(i_pre, p['b_i'])[..., None], T)[..., 0]
    lf = chunk_major(jax.nn.log_sigmoid(gates(f_pre, p['b_f']))[..., None], T)[..., 0]
    mask = jnp.tril(jnp.ones((T, T), bool))

    def step(carry, inp):
        C0, n0, m0 = carry
        q_c, k_c, v_c, li_c, lf_c = inp
        b = jnp.cumsum(lf_c, axis=-1)
        logD = jnp.where(mask, b[..., :, None] - b[..., None, :] + li_c[..., None, :], -jnp.inf)
        m_prev = b + m0[..., None]
        m = jnp.maximum(m_prev, jnp.max(logD, axis=-1))
        s = jnp.einsum('...tk,...sk->...ts', q_c, k_c) * jnp.exp(logD - m[..., None])
        inter = jnp.exp(m_prev - m)
        num = jnp.einsum('...ts,...sv->...tv', s, v_c) + inter[..., None] * jnp.einsum('...vk,...tk->...tv', C0, q_c)
        den = jnp.sum(s, axis=-1) + inter * jnp.einsum('...k,...tk->...t', n0, q_c)
        h = num / jnp.maximum(jnp.abs(den), jnp.exp(-m))[..., None]
        bT = b[..., -1]
        gsum = bT[..., None] - b + li_c
        m_new = jnp.maximum(bT + m0, jnp.max(gsum, axis=-1))
        wts = jnp.exp(gsum - m_new[..., None])
        carry_decay = jnp.exp(bT + m0 - m_new)
        C = carry_decay[..., None, None] * C0 + jnp.einsum('...t,...tv,...tk->...vk', wts, v_c, k_c)
        n = carry_decay[..., None] * n0 + jnp.einsum('...t,...tk->...k', wts, k_c)
        return (C, n, m_new), h

    state, h = lax.scan(step, state0, (qc, kc, vc, li, lf))
    h = merge_frames(unchunk(h))
    y = rmsnorm(h, p['ng'].reshape(MLSTM_HEADS, MLSTM_HD)).reshape(B_, L_, MLSTM_W)
    return y * jax.nn.sigmoid(o_pre), state


def hgrn2_seq(cols, S0, p):
    q, f_pre, i, g = (t.astype(jnp.float32) for t in cols)
    B_, L_ = q.shape[:2]
    T = HGRN_CHUNK
    lb = p['lb']
    qc = chunk_major(frames_shared(jax.nn.silu(q).reshape(B_, L_, HGRN_HEADS, HGRN_FD)), T)
    vc = chunk_major(frames_shared(i.reshape(B_, L_, HGRN_HEADS, HGRN_ID)), T)
    f = lb + (1.0 - lb) * jax.nn.sigmoid(f_pre.reshape(B_, L_, N_DIR, HGRN_W))
    f = frames_dir(jnp.moveaxis(f, 2, 0)).reshape(N_DIR, B_, L_, HGRN_HEADS, HGRN_FD)
    kc = chunk_major(1.0 - f, T)
    lfc = chunk_major(jnp.log(f), T)
    mask = jnp.tril(jnp.ones((T, T), bool))[..., None]

    def step(S, inp):
        q_c, k_c, v_c, lf_c = inp
        Bc = jnp.cumsum(lf_c, axis=-2)
        rel = jnp.exp(jnp.where(mask, Bc[..., :, None, :] - Bc[..., None, :, :], -jnp.inf))
        A = jnp.einsum('...tf,...tsf,...sf->...ts', q_c, rel, k_c)
        o = A @ v_c + jnp.einsum('...tf,...fi->...ti', q_c * jnp.exp(Bc), S)
        BT = Bc[..., -1:, :]
        S = jnp.exp(BT)[..., 0, :, None] * S + jnp.einsum('...sf,...si->...fi', k_c * jnp.exp(BT - Bc), v_c)
        return S, o

    S, o = lax.scan(step, S0, (qc, kc, vc, lfc))
    o = merge_frames(unchunk(o))
    y = rmsnorm(o, p['ng'].reshape(HGRN_HEADS, HGRN_ID)).reshape(B_, L_, HGRN_W)
    return y * jax.nn.silu(g), S


def rglru_seq(cols, h0, p):
    xb, gb = (t.astype(jnp.float32) for t in cols)
    B_, L_ = xb.shape[:2]
    xp = jnp.pad(xb, ((0, 0), (CONV_PAD_L, CONV_W - 1 - CONV_PAD_L), (0, 0)))
    xconv = sum(xp[:, j:j + L_] * p['conv_w'][j] for j in range(CONV_W)) + p['conv_b']
    xc = frames_shared(xconv)
    xh = xc.reshape(N_DIR, B_, L_, LRU_BLOCKS, LRU_BD)
    blockdiag = lambda w, b: (jnp.einsum('dblhi,dhij->dblhj', xh, w).reshape(N_DIR, B_, L_, LRU_W)
                              + b[:, None, None, :])
    r = jax.nn.sigmoid(blockdiag(p['wa'], p['ba']))
    ig = jax.nn.sigmoid(blockdiag(p['wi'], p['bi']))
    log_a = -LRU_C * r * jax.nn.softplus(-p['lam'])[:, None, None, :]
    a = jnp.exp(log_a)
    u = jnp.sqrt(-jnp.expm1(2.0 * log_a)) * (ig * xc)
    u = u.at[:, :, 0].add(a[:, :, 0] * h0)

    def combine(e1, e2):
        a1, b1 = e1
        a2, b2 = e2
        return a1 * a2, a2 * b1 + b2

    _, h = lax.associative_scan(combine, (a, u), axis=2)
    return merge_frames(h) * jax.nn.gelu(gb), h[:, :, -1]


def setup_inputs(seed: int = 0) -> dict:
    key = jax.random.key(seed)
    ks = list(jax.random.split(key, 48))
    f32 = jnp.float32

    def nrm(shape, scale):
        return jax.random.normal(ks.pop(), shape, f32) * scale

    def uni(shape, lo, hi):
        return jax.random.uniform(ks.pop(), shape, f32, lo, hi)

    D = D_MODEL
    ramp = (jnp.arange(RWKV_W, dtype=f32) / (RWKV_W - 1)) ** 0.9
    a_base = uni((N_ODD, N_DIR, LRU_W), 0.9, 0.999) ** (1.0 / LRU_C)
    return {
        'x': nrm((BATCH, SEQ, D), 1.0),
        'c': nrm((BATCH, D), 1.0),
        'ctx': nrm((BATCH, CTX_LEN, D), 1.0),
        'c_ctx': nrm((D,), 1.0),
        'norm1_g': 1.0 + nrm((DEPTH, D), 0.05),
        'norm2_g': 1.0 + nrm((DEPTH, D), 0.05),
        'mod_w': nrm((DEPTH, D, 6 * D), D ** -0.5),
        'mod_b': nrm((DEPTH, 6 * D), 0.02),
        'ffn_w1': nrm((DEPTH, D, D_FF), D ** -0.5),
        'ffn_w3': nrm((DEPTH, D, D_FF), D ** -0.5),
        'ffn_w2': nrm((DEPTH, D_FF, D), D_FF ** -0.5),
        'final_g': 1.0 + nrm((D,), 0.05),
        'ev_in_w': nrm((N_EVEN, D, EVEN_IN), D ** -0.5),
        'ev_out_w': nrm((N_EVEN, MIX_W, D), MIX_W ** -0.5),
        'rwkv_mu': uni((N_EVEN, N_DIR, RWKV_SHIFT_W), 0.0, 1.0),
        'rwkv_w0': -6.0 + 5.0 * ramp + nrm((N_EVEN, N_DIR, RWKV_W), 0.1),
        'rwkv_w2': nrm((N_EVEN, N_DIR, DECAY_LORA, RWKV_W), 0.5 * DECAY_LORA ** -0.5),
        'rwkv_a0': nrm((N_EVEN, N_DIR, RWKV_W), 0.1),
        'rwkv_a2': nrm((N_EVEN, N_DIR, AAA_LORA, RWKV_W), AAA_LORA ** -0.5),
        'rwkv_kk': 0.85 + nrm((N_EVEN, N_DIR, RWKV_W), 0.05),
        'rwkv_ka': 1.0 + nrm((N_EVEN, N_DIR, RWKV_W), 0.05),
        'rwkv_rk': nrm((N_EVEN, N_DIR, RWKV_HEADS, RWKV_HD), 0.1),
        'rwkv_lnw': 1.0 + nrm((N_EVEN, N_DIR, RWKV_W), 0.05),
        'rwkv_lnb': nrm((N_EVEN, N_DIR, RWKV_W), 0.02),
        'rwkv_g2': nrm((N_EVEN, GATE_LORA, RWKV_W), GATE_LORA ** -0.5),
        'mlstm_bi': nrm((N_EVEN, N_DIR, MLSTM_HEADS), 0.1),
        'mlstm_bf': jnp.linspace(3.0, 6.0, MLSTM_HEADS, dtype=f32) + nrm((N_EVEN, N_DIR, MLSTM_HEADS), 0.1),
        'mlstm_ng': 1.0 + nrm((N_EVEN, MLSTM_W), 0.05),
        'od_in_w': nrm((N_ODD, D, ODD_IN), D ** -0.5),
        'od_out_w': nrm((N_ODD, MIX_W, D), MIX_W ** -0.5),
        'hgrn_lb': 1.0 + nrm((DEPTH, HGRN_W), 0.1),
        'hgrn_ng': 1.0 + nrm((N_ODD, HGRN_W), 0.05),
        'lru_conv_w': nrm((N_ODD, CONV_W, LRU_W), CONV_W ** -0.5),
        'lru_conv_b': nrm((N_ODD, LRU_W), 0.02),
        'lru_wa': nrm((N_ODD, N_DIR, LRU_BLOCKS, LRU_BD, LRU_BD), LRU_BD ** -0.5),
        'lru_ba': nrm((N_ODD, N_DIR, LRU_W), 0.1),
        'lru_wi': nrm((N_ODD, N_DIR, LRU_BLOCKS, LRU_BD, LRU_BD), LRU_BD ** -0.5),
        'lru_bi': nrm((N_ODD, N_DIR, LRU_W), 0.1),
        'lru_lam': jnp.log(a_base) - jnp.log1p(-a_base),
    }


def reference(x, c, ctx, c_ctx, norm1_g, norm2_g, mod_w, mod_b, ffn_w1, ffn_w3, ffn_w2, final_g,
              ev_in_w, ev_out_w, rwkv_mu, rwkv_w0, rwkv_w2, rwkv_a0, rwkv_a2, rwkv_kk, rwkv_ka,
              rwkv_rk, rwkv_lnw, rwkv_lnb, rwkv_g2, mlstm_bi, mlstm_bf, mlstm_ng,
              od_in_w, od_out_w, hgrn_lb, hgrn_ng, lru_conv_w, lru_conv_b, lru_wa, lru_ba,
              lru_wi, lru_bi, lru_lam):
    B_, L_, _ = x.shape
    rows = L_ // GRID_W
    f32 = jnp.float32
    sm = jax.nn.softmax(hgrn_lb.astype(f32), axis=0)
    lower_bounds = jnp.cumsum(sm, axis=0) - sm[0]
    h, hc = x, ctx
    for l in range(DEPTH):
        j = l // 2
        last = l == DEPTH - 1
        mod = jnp.split((jax.nn.silu(c) @ mod_w[l] + mod_b[l])[:, None, :], 6, axis=-1)
        mod_c = jnp.split(jax.nn.silu(c_ctx) @ mod_w[l] + mod_b[l], 6, axis=-1)
        u = rmsnorm(h, norm1_g[l]) * (1.0 + mod[1]) + mod[0]
        uc = rmsnorm(hc, norm1_g[l]) * (1.0 + mod_c[1]) + mod_c[0]
        if l % 2 == 0:
            cols = split_cols(u @ ev_in_w[j], EVEN_SPLITS)
            cols_c = split_cols(uc @ ev_in_w[j], EVEN_SPLITS)
            pa = {'mu': rwkv_mu[j], 'w0': rwkv_w0[j], 'w2': rwkv_w2[j], 'a0': rwkv_a0[j],
                  'a2': rwkv_a2[j], 'k_k': rwkv_kk[j], 'k_a': rwkv_ka[j], 'r_k': rwkv_rk[j],
                  'ln_w': rwkv_lnw[j], 'ln_b': rwkv_lnb[j], 'g2': rwkv_g2[j]}
            pb = {'b_i': mlstm_bi[j], 'b_f': mlstm_bf[j], 'ng': mlstm_ng[j]}
            s_a = jnp.zeros((N_DIR, B_, RWKV_HEADS, RWKV_HD, RWKV_HD), f32)
            s_b = (jnp.zeros((N_DIR, B_, MLSTM_HEADS, MLSTM_HD, MLSTM_HD), f32),
                   jnp.zeros((N_DIR, B_, MLSTM_HEADS, MLSTM_HD), f32),
                   jnp.zeros((N_DIR, B_, MLSTM_HEADS), f32))
            y1_c, y1_l = bidir(rwkv7_seq, pa, cols_c[:6], cols[:6], s_a)
            y2_c, y2_l = bidir(mlstm_seq, pb, cols_c[6:], cols[6:], s_b)
            mix = jnp.concatenate([y1_l, y2_l], axis=-1).astype(h.dtype) @ ev_out_w[j]
            out_w = ev_out_w[j]
        else:
            cols = split_cols(to_col_major(u, rows) @ od_in_w[j], ODD_SPLITS)
            cols_c = split_cols(uc @ od_in_w[j], ODD_SPLITS)
            pc = {'lb': lower_bounds[l], 'ng': hgrn_ng[j]}
            pd = {'conv_w': lru_conv_w[j], 'conv_b': lru_conv_b[j], 'wa': lru_wa[j], 'ba': lru_ba[j],
                  'wi': lru_wi[j], 'bi': lru_bi[j], 'lam': lru_lam[j]}
            s_c = jnp.zeros((N_DIR, B_, HGRN_HEADS, HGRN_FD, HGRN_ID), f32)
            s_d = jnp.zeros((N_DIR, B_, LRU_W), f32)
            y1_c, y1_l = bidir(hgrn2_seq, pc, cols_c[:4], cols[:4], s_c)
            y2_c, y2_l = bidir(rglru_seq, pd, cols_c[4:], cols[4:], s_d)
            mix = to_row_major(jnp.concatenate([y1_l, y2_l], axis=-1).astype(h.dtype), rows) @ od_out_w[j]
            out_w = od_out_w[j]
        h = h + mod[2] * mix
        v = rmsnorm(h, norm2_g[l]) * (1.0 + mod[4]) + mod[3]
        h = h + mod[5] * swiglu(v, ffn_w1[l], ffn_w3[l], ffn_w2[l])
        if not last:
            mix_c = jnp.concatenate([y1_c, y2_c], axis=-1).astype(hc.dtype) @ out_w
            hc = hc + mod_c[2] * mix_c
            vc = rmsnorm(hc, norm2_g[l]) * (1.0 + mod_c[4]) + mod_c[3]
            hc = hc + mod_c[5] * swiglu(vc, ffn_w1[l], ffn_w3[l], ffn_w2[l])
    return rmsnorm(h, final_g)
```

```cpp
#include <hip/hip_runtime.h>
#include <hip/hip_cooperative_groups.h>
#include <cstdio>
#include <cstdint>
namespace pg8 {
#define PG8_LAS __attribute__((address_space(3)))
typedef unsigned short bf16_t;
typedef short bf16x8 __attribute__((ext_vector_type(8)));
typedef float f32x4 __attribute__((ext_vector_type(4)));
typedef unsigned u32x4 __attribute__((ext_vector_type(4)));
constexpr int BM = 256, BK = 64, HALF = 128, HTB = HALF * BK * 2  , STAGE_BYTES = 8 * HTB, NXCD = 8, WGM = 8;

__host__ __device__ __forceinline__ int lds_byte(int r, int c) { const int st = (r >> 4) * 2 + (c >> 5), rr = r & 15, cc = c & 31, ob = rr * 64 + cc * 2; return st * 1024 + (ob ^ (((ob >> 9) & 1) << 5)); }
__host__ __device__ __forceinline__ void stage_rc(int b, int& R, int& C) { const int st = b / 1024, sb = b % 1024, swz = sb ^ (((sb >> 9) & 1) << 5); R = (st >> 1) * 16 + swz / 64; C = (st & 1) * 32 + (swz % 64) / 2; }
__host__ __device__ __forceinline__ int perm32(int rho) { const int n = rho >> 4, i = rho & 15; return 8 * (i >> 2) + 4 * n + (i & 3); }

struct Unit { int pm, pn; };
struct Gemm { const bf16_t* A; const bf16_t* Bt; int M, N, K; };

struct StaticOrder {
    int nM, nN, nwg, G, c;
    __host__ __device__ void init(int M, int N, int G_, int c_) { nM = M / BM; nN = N / BM; nwg = nM * nN; G = G_; c = c_; }
    __host__ __device__ bool next(int i, Unit& u) const {
        const long L = (long)i * G + c; if (L >= nwg) return false;
        int wgid = (int)L; { const int q = nwg / NXCD, r = nwg % NXCD, xcd = wgid % NXCD, off = wgid / NXCD; wgid = (xcd < r ? xcd * (q + 1) : r * (q + 1) + (xcd - r) * q) + off; }
        const int nig = WGM * nN, gid = wgid / nig, fm = gid * WGM, gsz = (nM - fm) < WGM ? (nM - fm) : WGM;
        u.pm = fm + ((wgid % nig) % gsz); u.pn = (wgid % nig) / gsz; return true;
    }
    __device__ __forceinline__ void a_ready(const Unit&) const {}
    __device__ __forceinline__ void done(const Unit&) const {}
};
__device__ __forceinline__ unsigned cvt_pk_bf16(float lo, float hi) { unsigned r; asm volatile("v_cvt_pk_bf16_f32 %0, %1, %2" : "=v"(r) : "v"(lo), "v"(hi)); return r; }
typedef float f32x2 __attribute__((ext_vector_type(2)));
template <class Epi, class Sched, bool STAMP = false>
__device__ __forceinline__ void gemm_phase(PG8_LAS unsigned char* lds, const Gemm g, const Sched& S, const Epi& E, unsigned long long* stamps) {
    const int tid = threadIdx.x, wid = __builtin_amdgcn_readfirstlane(tid >> 6), lane = tid & 63, wr = wid >> 2, wc = wid & 3, fr = lane & 15, fq = lane >> 4;
    const int K = g.K, nt = K / BK;
    int ts_lo = 0, ts_hi = 0, nts = 0; const unsigned long long rt_entry = STAMP ? (unsigned long long)wall_clock64() : 0ull;
#define PG8_STAMP() do { if (STAMP && wid == 0 && nts < 64) { const unsigned long long _c = (unsigned long long)clock64(); \
        ts_lo = (lane == nts) ? (int)(unsigned)_c : ts_lo; ts_hi = (lane == nts) ? (int)(unsigned)(_c >> 32) : ts_hi; ++nts; } } while (0)
    PG8_STAMP();
    unsigned voffA[2], voffB[2];
#pragma unroll
    for (int i = 0; i < 2; ++i) { int R, C; stage_rc(tid * 16 + i * 8192, R, C); const int Rb = Epi::PERM ? ((R & ~31) + perm32(R & 31)) : R;
        voffA[i] = (unsigned)(R * K + C) * 2u; voffB[i] = (unsigned)(Rb * K + C) * 2u; }
    const size_t kstep = (size_t)(BK * 2);
    const size_t hstep = (size_t)HALF * K * 2;
    const size_t tstep = 2 * hstep;
    const unsigned ldsw = (unsigned)wid * 1024u;
    const int aoff = lds_byte(wr * 64 + fr, fq * 8), boff = lds_byte(wc * 32 + fr, fq * 8);
#define PG8_SA(b, h) (((b) * 2 + (h)) * HTB)
#define PG8_SB(b, h) ((4 + (b) * 2 + (h)) * HTB)
#define PG8_STAGE(bufoff, gbase, voff) do { _Pragma("unroll") for (int _i = 0; _i < 2; ++_i) \
        __builtin_amdgcn_global_load_lds((const unsigned*)((const char*)(gbase) + (voff)[_i]), (PG8_LAS unsigned*)(lds + (bufoff) + ldsw + _i * 8192), 16, 0, 0); } while (0)
#define PG8_LDA(dst, b, h) do { _Pragma("unroll") for (int m = 0; m < 4; ++m) _Pragma("unroll") for (int k = 0; k < 2; ++k) dst[m][k] = *(const PG8_LAS bf16x8*)(lds + PG8_SA(b, h) + aoff + m * 2048 + k * 1024); } while (0)
#define PG8_LDB(dst, b, h) do { _Pragma("unroll") for (int n = 0; n < 2; ++n) _Pragma("unroll") for (int k = 0; k < 2; ++k) dst[n][k] = *(const PG8_LAS bf16x8*)(lds + PG8_SB(b, h) + boff + n * 2048 + k * 1024); } while (0)
#define PG8_MMA(ai, bj, At, Bt) do { __builtin_amdgcn_s_setprio(1); _Pragma("unroll") for (int m = 0; m < 4; ++m) _Pragma("unroll") for (int n = 0; n < 2; ++n) _Pragma("unroll") for (int k = 0; k < 2; ++k) \
        acc[ai][bj][m][n] = __builtin_amdgcn_mfma_f32_16x16x32_bf16(Bt[n][k], At[m][k], acc[ai][bj][m][n], 0, 0, 0); __builtin_amdgcn_s_setprio(0); } while (0)
#define PG8_WAIT_V(n) asm volatile("s_waitcnt vmcnt(" #n ")" ::: "memory")
#define PG8_WAIT_L(n) asm volatile("s_waitcnt lgkmcnt(" #n ")" ::: "memory")
#define PG8_BAR __builtin_amdgcn_s_barrier()
#define PG8_SCHED __builtin_amdgcn_sched_barrier(0)
    Unit cur, nxt; int ui = 0;
    if (!S.next(0, cur)) return;
    f32x4 acc[2][2][4][2];
#pragma unroll
    for (int a = 0; a < 2; ++a)
#pragma unroll
        for (int b = 0; b < 2; ++b)
#pragma unroll
            for (int m = 0; m < 4; ++m)
#pragma unroll
                for (int n = 0; n < 2; ++n) acc[a][b][m][n] = (f32x4){0.f, 0.f, 0.f, 0.f};
    bf16x8 At[4][2], B0[2][2], B1[2][2];
    const char* cA = (const char*)g.A + (size_t)cur.pm * tstep; const char* cB = (const char*)g.Bt + (size_t)cur.pn * tstep;
    S.a_ready(cur);
    PG8_STAGE(PG8_SB(0, 0), cB, voffB); PG8_STAGE(PG8_SA(0, 0), cA, voffA); PG8_STAGE(PG8_SB(0, 1), cB + hstep, voffB); PG8_STAGE(PG8_SA(0, 1), cA + hstep, voffA);
    if (wr == 1) PG8_BAR;
    PG8_WAIT_V(4); PG8_BAR;
    PG8_STAGE(PG8_SB(1, 0), cB + kstep, voffB); PG8_STAGE(PG8_SA(1, 0), cA + kstep, voffA); PG8_STAGE(PG8_SB(1, 1), cB + hstep + kstep, voffB);
    PG8_WAIT_V(6); PG8_BAR;
    PG8_STAMP();
    for (;;) {
        const bool has_next = S.next(ui + 1, nxt);
        const char* nA = has_next ? (const char*)g.A + (size_t)nxt.pm * tstep : cA; const char* nB = has_next ? (const char*)g.Bt + (size_t)nxt.pn * tstep : cB;
        for (int t = 0; t < nt; t += 2) {
            const bool last = (t == nt - 2);
            const char* a1 = cA + (size_t)(t + 1) * kstep;
            const char* a2 = last ? nA : cA + (size_t)(t + 2) * kstep; const char* b2 = last ? nB : cB + (size_t)(t + 2) * kstep;
            const char* a3 = a2 + kstep; const char* b3 = b2 + kstep;
            if (last && has_next) S.a_ready(nxt);
            PG8_LDB(B0, 0, 0); PG8_SCHED; PG8_LDA(At, 0, 0); PG8_STAGE(PG8_SA(1, 1), a1 + hstep, voffA);
            PG8_WAIT_L(8); PG8_BAR; PG8_WAIT_L(0); PG8_MMA(0, 0, At, B0); PG8_BAR; PG8_SCHED;
            PG8_LDB(B1, 0, 1); PG8_STAGE(PG8_SB(0, 0), b2, voffB);
            PG8_BAR; PG8_WAIT_L(0); PG8_MMA(0, 1, At, B1); PG8_BAR;
            PG8_LDA(At, 0, 1); PG8_STAGE(PG8_SA(0, 0), a2, voffA);
            PG8_BAR; PG8_WAIT_L(0); PG8_MMA(1, 0, At, B0); PG8_BAR; PG8_SCHED;
            PG8_STAGE(PG8_SB(0, 1), b2 + hstep, voffB);
            PG8_WAIT_V(6); PG8_BAR; PG8_MMA(1, 1, At, B1); PG8_BAR;
            PG8_LDB(B0, 1, 0); PG8_SCHED; PG8_LDA(At, 1, 0); PG8_STAGE(PG8_SA(0, 1), a2 + hstep, voffA);
            PG8_WAIT_L(8); PG8_BAR; PG8_WAIT_L(0); PG8_MMA(0, 0, At, B0); PG8_BAR; PG8_SCHED;
            PG8_LDB(B1, 1, 1); PG8_STAGE(PG8_SB(1, 0), b3, voffB);
            PG8_BAR; PG8_WAIT_L(0); PG8_MMA(0, 1, At, B1); PG8_BAR;
            PG8_LDA(At, 1, 1); PG8_STAGE(PG8_SA(1, 0), a3, voffA);
            PG8_BAR; PG8_WAIT_L(0); PG8_MMA(1, 0, At, B0); PG8_BAR; PG8_SCHED;
            PG8_STAGE(PG8_SB(1, 1), b3 + hstep, voffB);
            PG8_WAIT_V(6); PG8_BAR; PG8_MMA(1, 1, At, B1); PG8_BAR;
        }
        PG8_STAMP();
        if constexpr (!Epi::AFTER_DRAIN) { E(acc, cur, wr, wc, fr, fq); S.done(cur); }
        PG8_STAMP();
        if (!has_next) break;
#pragma unroll
        for (int a = 0; a < 2; ++a)
#pragma unroll
            for (int b = 0; b < 2; ++b)
#pragma unroll
                for (int m = 0; m < 4; ++m)
#pragma unroll
                    for (int n = 0; n < 2; ++n) acc[a][b][m][n] = (f32x4){0.f, 0.f, 0.f, 0.f};
        cur = nxt; cA = nA; cB = nB; ++ui;
    }
    PG8_WAIT_V(0);
    if (wr == 0) PG8_BAR;
    PG8_BAR;
    if constexpr (Epi::AFTER_DRAIN) { E.fused(acc, cur, wr, wc, fr, fq, lds, wid, lane); S.done(cur); }
    PG8_STAMP();
    if (STAMP && wid == 0) { stamps[lane] = lane < nts ? (((unsigned long long)(unsigned)ts_hi << 32) | (unsigned)ts_lo) : 0ull;
        if (lane == 62) stamps[62] = rt_entry; if (lane == 63) stamps[63] = (unsigned long long)wall_clock64(); }
#undef PG8_STAMP
#undef PG8_SA
#undef PG8_SB
#undef PG8_STAGE
#undef PG8_LDA
#undef PG8_LDB
#undef PG8_MMA
#undef PG8_WAIT_V
#undef PG8_WAIT_L
#undef PG8_BAR
#undef PG8_SCHED
}
}

namespace mk {
#define DI __device__ __forceinline__
#define LAS __attribute__((address_space(3)))
typedef unsigned short bf16_t;
typedef float f32x4 __attribute__((ext_vector_type(4)));
typedef unsigned u32x2 __attribute__((ext_vector_type(2)));
typedef unsigned u32x4 __attribute__((ext_vector_type(4)));

constexpr int D = 1024, NB = 4, L = 8192, LC = 256, NLAT = NB * L, NCTX = NB * LC, NALL = NLAT + NCTX, LT = L + LC, DFF = 2816;
constexpr int NT = 512;
constexpr size_t MiB = (size_t)1 << 20;
constexpr size_t WS_CTL = 0, WS_MODV = 1 * MiB, WS_HC = 2 * MiB, WS_W_EVIN = 6 * MiB, WS_W_EVOUT = 14 * MiB, WS_W_ODIN = 16 * MiB, WS_W_ODOUT = 23 * MiB,
                 WS_W_UP = 25 * MiB, WS_W_DN = 47 * MiB, WS_ACT = 58 * MiB, WS_COLS = 124 * MiB, WS_Z = 388 * MiB, WS_END = 454 * MiB;
constexpr size_t W_UP_STRIDE = (size_t)5632 * 1024, W_DN_STRIDE = (size_t)1024 * 2816;
constexpr size_t OFF_RW = 0, OFF_LO = (size_t)NALL * 1536, OFF_ML = OFF_LO + (size_t)NALL * 512;
constexpr int LDS_BYTES = 147456;

enum { I_X = 0, I_C, I_CTX, I_CCTX, I_N1G, I_N2G, I_MODW, I_MODB, I_W1, I_W3, I_W2, I_FING, I_EVIN, I_EVOUT, I_MU, I_W0, I_W2L, I_A0, I_A2L, I_KK, I_KA, I_RK,
       I_LNW, I_LNB, I_G2, I_MBI, I_MBF, I_MNG, I_ODIN, I_ODOUT, I_HLB, I_HNG, I_CONVW, I_CONVB, I_WA, I_BA, I_WI, I_BI, I_LAM, N_IN };

struct P { const float* in[N_IN]; float* out; unsigned char* ws; int ph_lo, ph_hi; };

DI float bf2f(bf16_t v) { return __uint_as_float(((unsigned)v) << 16); }
DI bf16_t f2bf(float f) { unsigned u = __float_as_uint(f); u += 0x7fffu + ((u >> 16) & 1u); return (bf16_t)(u >> 16); }
DI float sigm(float x) { return 1.f / (1.f + expf(-x)); }
DI float siluf(float x) { return x * sigm(x); }
DI float geluf(float x) { return 0.5f * x * (1.f + tanhf(0.7978845608028654f * (x + 0.044715f * x * x * x))); }
DI float wave_sum(float v) {
#pragma unroll
    for (int o = 32; o >= 1; o >>= 1) v += __shfl_xor(v, o);
    return v;
}
DI int step_row(int d, int b, int n) {
    if (n < LC) return NLAT + b * LC + (d ? LC - 1 - n : n);
    const int m = n - LC; return b * L + (d ? L - 1 - m : m);
}

DI int matN(int m) { return m == 0 ? 4096 : m == 1 ? 1024 : m == 2 ? 3584 : m == 3 ? 1024 : m < 6 ? 5632 : 1024; }
DI int matK(int m) { return m < 6 ? 1024 : 2816; }
DI int matTile0(int m) { return m == 0 ? 0 : m == 1 ? 1024 : m == 2 ? 1280 : m == 3 ? 2176 : m == 4 ? 2432 : m == 5 ? 3840 : m == 6 ? 5248 : m == 7 ? 5952 : 6656; }
DI size_t matOff(int m) { return m == 0 ? WS_W_EVIN : m == 1 ? WS_W_EVOUT : m == 2 ? WS_W_ODIN : m == 3 ? WS_W_ODOUT : m == 4 ? WS_W_UP : m == 5 ? WS_W_UP + W_UP_STRIDE * 2 : m == 6 ? WS_W_DN : WS_W_DN + W_DN_STRIDE * 2; }
DI const float* matSrc(const P& p, int m, int n, int& ld) {
    if (m == 0) { ld = 3984; int col; if (n < 1920) col = n; else if (n < 1936) col = 3968 + (n - 1920); else if (n < 2048) return nullptr; else col = 1920 + (n - 2048); return p.in[I_EVIN] + col; }
    if (m == 1) { ld = 1024; return p.in[I_EVOUT] + n; }
    if (m == 2) { ld = 3584; return p.in[I_ODIN] + n; }
    if (m == 3) { ld = 1024; return p.in[I_ODOUT] + n; }
    if (m < 6) { ld = 2816; const int l = m - 4, pn = n >> 8, w = n & 255; const size_t lo = (size_t)l * 1024 * 2816; return (w < 128) ? p.in[I_W1] + lo + 128 * pn + w : p.in[I_W3] + lo + 128 * pn + (w - 128); }
    ld = 1024; return p.in[I_W2] + (size_t)(m - 6) * 2816 * 1024 + n;
}
DI void phase_wprep(const P& p, LAS unsigned char* ldsb) {
    LAS float* tile = (LAS float*)ldsb;
    const int tid = threadIdx.x, tx = tid & 63, ty = tid >> 6;
    for (int item = blockIdx.x; item < 6656; item += gridDim.x) {
        int m = 0;
#pragma unroll
        for (int q = 1; q < 8; ++q) if (item >= matTile0(q)) m = q;
        const int local = item - matTile0(m), K = matK(m), nK = K >> 6, nb = local / nK, kb = local - nb * nK, n0 = nb * 64, k0 = kb * 64;
        bf16_t* Bt = (bf16_t*)(p.ws + matOff(m));
        int ld; const float* src = matSrc(p, m, n0 + tx, ld);
        __syncthreads();
#pragma unroll
        for (int i = 0; i < 8; ++i) { const int k = k0 + ty + 8 * i; tile[(ty + 8 * i) * 65 + tx] = src ? src[(size_t)k * ld] : 0.f; }
        __syncthreads();
#pragma unroll
        for (int i = 0; i < 8; ++i) { const int nn = ty + 8 * i; Bt[(size_t)(n0 + nn) * K + k0 + tx] = f2bf(tile[tx * 65 + nn]); }
    }
    __syncthreads();
}
DI void phase_modv(const P& p, LAS unsigned char* ldsb) {
    LAS float* sc = (LAS float*)ldsb;
    const int tid = threadIdx.x;
    float* MODV = (float*)(p.ws + WS_MODV);
    __syncthreads();
    for (int e = tid; e < 5 * 1024; e += NT) { const int s = e >> 10, k = e & 1023; const float v = (s < 4) ? p.in[I_C][s * 1024 + k] : p.in[I_CCTX][k]; sc[e] = siluf(v); }
    __syncthreads();
    for (int vb = blockIdx.x; vb < 24; vb += gridDim.x) {
        const int l = vb / 12, n = (vb % 12) * 512 + tid;
        const float* W = p.in[I_MODW] + (size_t)l * 1024 * 6144 + n;
        float a0 = 0.f, a1 = 0.f, a2 = 0.f, a3 = 0.f, a4 = 0.f;
#pragma unroll 8
        for (int k = 0; k < 1024; ++k) { const float w = W[(size_t)k * 6144]; a0 += sc[k] * w; a1 += sc[1024 + k] * w; a2 += sc[2048 + k] * w; a3 += sc[3072 + k] * w; a4 += sc[4096 + k] * w; }
        const float bb = p.in[I_MODB][l * 6144 + n];
        float* o = MODV + (size_t)l * 5 * 6144 + n;
        o[0] = a0 + bb; o[6144] = a1 + bb; o[2 * 6144] = a2 + bb; o[3 * 6144] = a3 + bb; o[4 * 6144] = a4 + bb;
    }
    __syncthreads();
}

DI void phase_modnorm(const P& p, int layer, int which, const float* hlat, const float* hctx, int nrows, bool permute) {
    const int lane = threadIdx.x & 63, wv = threadIdx.x >> 6;
    const float* MODV = (const float*)(p.ws + WS_MODV) + (size_t)layer * 5 * 6144;
    const float* g = p.in[which ? I_N2G : I_N1G] + layer * 1024;
    bf16_t* ACT = (bf16_t*)(p.ws + WS_ACT);
    for (int r = blockIdx.x * 8 + wv; r < nrows; r += gridDim.x * 8) {
        const bool isctx = r >= NLAT;
        const float* src = isctx ? hctx + (size_t)(r - NLAT) * D : hlat + (size_t)r * D;
        const int sv = isctx ? 4 : r / L;
        const float* shift = MODV + sv * 6144 + (which ? 3 : 0) * 1024; const float* scale = shift + 1024;
        int dr = r;
        if (permute && !isctx) { const int b = r / L, t = r % L; dr = b * L + (t % 64) * 128 + t / 64; }
        f32x4 v[4]; float ss = 0.f;
#pragma unroll
        for (int j = 0; j < 4; ++j) { v[j] = *(const f32x4*)(src + 4 * lane + 256 * j); ss += v[j].x * v[j].x + v[j].y * v[j].y + v[j].z * v[j].z + v[j].w * v[j].w; }
        const float rinv = rsqrtf(wave_sum(ss) * (1.f / D) + 1e-6f);
#pragma unroll
        for (int j = 0; j < 4; ++j) { const int c = 4 * lane + 256 * j;
            const f32x4 gg = *(const f32x4*)(g + c), sc = *(const f32x4*)(scale + c), sh = *(const f32x4*)(shift + c);
            const float o0 = v[j].x * rinv * gg.x * (1.f + sc.x) + sh.x, o1 = v[j].y * rinv * gg.y * (1.f + sc.y) + sh.y, o2 = v[j].z * rinv * gg.z * (1.f + sc.z) + sh.z, o3 = v[j].w * rinv * gg.w * (1.f + sc.w) + sh.w;
            u32x2 w; w.x = (unsigned)f2bf(o0) | ((unsigned)f2bf(o1) << 16); w.y = (unsigned)f2bf(o2) | ((unsigned)f2bf(o3) << 16);
            *(u32x2*)(ACT + (size_t)dr * D + c) = w; }
    }
}
DI void phase_finalnorm(const P& p) {
    const int lane = threadIdx.x & 63, wv = threadIdx.x >> 6;
    const float* g = p.in[I_FING];
    for (int r = blockIdx.x * 8 + wv; r < NLAT; r += gridDim.x * 8) {
        float* src = p.out + (size_t)r * D;
        f32x4 v[4]; float ss = 0.f;
#pragma unroll
        for (int j = 0; j < 4; ++j) { v[j] = *(const f32x4*)(src + 4 * lane + 256 * j); ss += v[j].x * v[j].x + v[j].y * v[j].y + v[j].z * v[j].z + v[j].w * v[j].w; }
        const float rinv = rsqrtf(wave_sum(ss) * (1.f / D) + 1e-6f);
#pragma unroll
        for (int j = 0; j < 4; ++j) { const int c = 4 * lane + 256 * j; const f32x4 gg = *(const f32x4*)(g + c);
            f32x4 o; o.x = v[j].x * rinv * gg.x; o.y = v[j].y * rinv * gg.y; o.z = v[j].z * rinv * gg.z; o.w = v[j].w * rinv * gg.w; *(f32x4*)(src + c) = o; }
    }
}

struct EpiStore3 {
    static constexpr bool PERM = false, AFTER_DRAIN = false;
    bf16_t* p0; int ld0; int pn1; bf16_t* p1; int ld1; int pn2; bf16_t* p2; int ld2;
    DI void operator()(const f32x4 (&acc)[2][2][4][2], const pg8::Unit& u, int wr, int wc, int fr, int fq) const {
        bf16_t* base; int ld, ct;
        if (u.pn >= pn2) { base = p2; ld = ld2; ct = u.pn - pn2; } else if (u.pn >= pn1) { base = p1; ld = ld1; ct = u.pn - pn1; } else { base = p0; ld = ld0; ct = u.pn; }
        const int row0 = u.pm * 256 + wr * 64 + fr, col0 = ct * 256 + wc * 32 + 4 * fq;
#pragma unroll
        for (int ai = 0; ai < 2; ++ai)
#pragma unroll
            for (int m = 0; m < 4; ++m) { bf16_t* rowp = base + (size_t)(row0 + ai * 128 + m * 16) * ld + col0;
#pragma unroll
                for (int bj = 0; bj < 2; ++bj)
#pragma unroll
                    for (int n = 0; n < 2; ++n) { const f32x4 v = acc[ai][bj][m][n]; u32x2 w; w.x = pg8::cvt_pk_bf16(v[0], v[1]); w.y = pg8::cvt_pk_bf16(v[2], v[3]); *(u32x2*)(rowp + bj * 128 + n * 16) = w; } }
    }
};
struct EpiResid {
    static constexpr bool PERM = false, AFTER_DRAIN = false;
    const float* hin; float* hout; const float* cin; float* cout; const float* modv_l; int gidx;
    DI void operator()(const f32x4 (&acc)[2][2][4][2], const pg8::Unit& u, int wr, int wc, int fr, int fq) const {
        const bool isctx = u.pm >= 128; const int sv = isctx ? 4 : (u.pm >> 5);
        const float* gate = modv_l + sv * 6144 + gidx * 1024;
        const float* bi = isctx ? cin : hin; float* bo = isctx ? cout : hout;
        const int row0 = (isctx ? (u.pm - 128) : u.pm) * 256 + wr * 64 + fr, col0 = u.pn * 256 + wc * 32 + 4 * fq;
        f32x4 gv[2][2];
#pragma unroll
        for (int bj = 0; bj < 2; ++bj)
#pragma unroll
            for (int n = 0; n < 2; ++n) gv[bj][n] = *(const f32x4*)(gate + col0 + bj * 128 + n * 16);
#pragma unroll
        for (int ai = 0; ai < 2; ++ai)
#pragma unroll
            for (int m = 0; m < 4; ++m) { const size_t off = (size_t)(row0 + ai * 128 + m * 16) * D + col0;
#pragma unroll
                for (int bj = 0; bj < 2; ++bj)
#pragma unroll
                    for (int n = 0; n < 2; ++n) { const f32x4 bs = *(const f32x4*)(bi + off + bj * 128 + n * 16); *(f32x4*)(bo + off + bj * 128 + n * 16) = bs + gv[bj][n] * acc[ai][bj][m][n]; } }
    }
};
struct EpiSwiglu {
    static constexpr bool PERM = false, AFTER_DRAIN = false;
    bf16_t* G;
    DI void operator()(const f32x4 (&acc)[2][2][4][2], const pg8::Unit& u, int wr, int wc, int fr, int fq) const {
        const int row0 = u.pm * 256 + wr * 64 + fr, col0 = u.pn * 128 + wc * 32 + 4 * fq;
#pragma unroll
        for (int ai = 0; ai < 2; ++ai)
#pragma unroll
            for (int m = 0; m < 4; ++m) { bf16_t* rowp = G + (size_t)(row0 + ai * 128 + m * 16) * DFF + col0;
#pragma unroll
                for (int n = 0; n < 2; ++n) { const f32x4 a = acc[ai][0][m][n], b = acc[ai][1][m][n];
                    const float g0 = a[0] / (1.f + __expf(-a[0])) * b[0], g1 = a[1] / (1.f + __expf(-a[1])) * b[1], g2 = a[2] / (1.f + __expf(-a[2])) * b[2], g3 = a[3] / (1.f + __expf(-a[3])) * b[3];
                    u32x2 w; w.x = pg8::cvt_pk_bf16(g0, g1); w.y = pg8::cvt_pk_bf16(g2, g3); *(u32x2*)(rowp + n * 16) = w; } }
    }
};
template <class Epi> DI void run_gemm(LAS unsigned char* lds, const bf16_t* A, const bf16_t* Bt, int M, int N, int K, const Epi& E) {
    pg8::Gemm g{A, Bt, M, N, K}; pg8::StaticOrder S; S.init(M, N, (int)gridDim.x, (int)blockIdx.x);
    pg8::gemm_phase<Epi, pg8::StaticOrder, false>((PG8_LAS unsigned char*)lds, g, S, E, nullptr);
    __syncthreads();
}

DI void phase_rwkv_scan(const P& p, LAS unsigned char* ldsb) {
    LAS float* lds = (LAS float*)ldsb;
    LAS float *w2s = lds, *a2s = lds + 4096, *prm = lds + 8192, *TH = prm + 768, *AD = TH + 2048, *R = AD + 2048, *W = R + 2048, *K = W + 2048, *KK = K + 2048, *BV = KK + 2048,
              *V = BV + 2048, *BS = V + 2048, *OUT = BS + 32;
    const int tid = threadIdx.x, lane = tid & 63, wv = tid >> 6;
    const bf16_t* RW = (const bf16_t*)(p.ws + WS_COLS) + OFF_RW; const bf16_t* LO = (const bf16_t*)(p.ws + WS_COLS) + OFF_LO; bf16_t* Z = (bf16_t*)(p.ws + WS_Z);
    const int srow = tid >> 3, sg = tid & 7;
    for (int vb = blockIdx.x; vb < 64; vb += gridDim.x) {
        const int d = vb >> 5, b = (vb >> 3) & 3, h = vb & 7;
        __syncthreads();
        for (int e = tid; e < 4096; e += NT) { const int i = e >> 6, c = e & 63; w2s[e] = p.in[I_W2L][(size_t)(d * 64 + i) * 512 + 64 * h + c]; a2s[e] = p.in[I_A2L][(size_t)(d * 64 + i) * 512 + 64 * h + c]; }
        if (tid < 64) { const int j = tid, c = 64 * h + j; const float* mu = p.in[I_MU] + d * 1664;
            prm[j] = mu[c]; prm[64 + j] = mu[512 + c]; prm[128 + j] = mu[1024 + c]; prm[192 + j] = mu[1536 + j]; prm[256 + j] = mu[1600 + j];
            prm[320 + j] = p.in[I_W0][d * 512 + c]; prm[384 + j] = p.in[I_A0][d * 512 + c]; prm[448 + j] = p.in[I_KK][d * 512 + c]; prm[512 + j] = p.in[I_KA][d * 512 + c];
            prm[576 + j] = p.in[I_RK][(d * 8 + h) * 64 + j]; prm[640 + j] = p.in[I_LNW][d * 512 + c]; prm[704 + j] = p.in[I_LNB][d * 512 + c]; }
        __syncthreads();
        float S0 = 0.f, S1 = 0.f, S2 = 0.f, S3 = 0.f, S4 = 0.f, S5 = 0.f, S6 = 0.f, S7 = 0.f;
        for (int n0 = 0; n0 < LT; n0 += 32) {
            float rs[4], ks[4], vs[4];
#pragma unroll
            for (int m = 0; m < 4; ++m) { const int s = wv + 8 * m, n = n0 + s; const bool hp = (n != 0) && (n != LC);
                const size_t row = (size_t)step_row(d, b, n), prow = hp ? (size_t)step_row(d, b, n - 1) : row; const int c = 64 * h + lane;
                const float r0 = bf2f(RW[row * 1536 + c]), k0 = bf2f(RW[row * 1536 + 512 + c]), v0 = bf2f(RW[row * 1536 + 1024 + c]);
                const float r1 = hp ? bf2f(RW[prow * 1536 + c]) : 0.f, k1 = hp ? bf2f(RW[prow * 1536 + 512 + c]) : 0.f, v1 = hp ? bf2f(RW[prow * 1536 + 1024 + c]) : 0.f;
                rs[m] = r0 + prm[lane] * (r1 - r0); ks[m] = k0 + prm[64 + lane] * (k1 - k0); vs[m] = v0 + prm[128 + lane] * (v1 - v0);
                const float wd0 = bf2f(LO[row * 512 + 64 * d + lane]), wd1 = hp ? bf2f(LO[prow * 512 + 64 * d + lane]) : 0.f;
                const float ad0 = bf2f(LO[row * 512 + 128 + 64 * d + lane]), ad1 = hp ? bf2f(LO[prow * 512 + 128 + 64 * d + lane]) : 0.f;
                TH[s * 64 + lane] = tanhf(wd0 + prm[192 + lane] * (wd1 - wd0)); AD[s * 64 + lane] = ad0 + prm[256 + lane] * (ad1 - ad0); }
            __syncthreads();
#pragma unroll
            for (int m = 0; m < 4; ++m) { const int s = wv + 8 * m;
                float xw = prm[320 + lane], xa = prm[384 + lane];
#pragma unroll 8
                for (int i = 0; i < 64; ++i) { xw += TH[s * 64 + i] * w2s[i * 64 + lane]; xa += AD[s * 64 + i] * a2s[i * 64 + lane]; }
                const float elog = 0.6065306597126334f * sigm(xw), dec = expf(-elog), a = sigm(xa);
                const float kkr = ks[m] * prm[448 + lane]; const float ss = wave_sum(kkr * kkr); const float kkn = kkr / fmaxf(sqrtf(ss), 1e-12f);
                const float km = ks[m] * (1.f + (a - 1.f) * prm[512 + lane]);
                const float bs = wave_sum(rs[m] * km * prm[576 + lane]);
                R[s * 64 + lane] = rs[m]; W[s * 64 + lane] = dec; K[s * 64 + lane] = km; KK[s * 64 + lane] = kkn; BV[s * 64 + lane] = kkn * a; V[s * 64 + lane] = vs[m];
                if (lane == 0) BS[s] = bs; }
            __syncthreads();
            for (int s = 0; s < 32; ++s) {
                const LAS f32x4* pq = (const LAS f32x4*)(KK + s * 64 + 8 * sg); const f32x4 q0 = pq[0], q1 = pq[1];
                const LAS f32x4* pw = (const LAS f32x4*)(W + s * 64 + 8 * sg); const f32x4 w0 = pw[0], w1 = pw[1];
                const LAS f32x4* pb = (const LAS f32x4*)(BV + s * 64 + 8 * sg); const f32x4 b0 = pb[0], b1 = pb[1];
                const LAS f32x4* pk = (const LAS f32x4*)(K + s * 64 + 8 * sg); const f32x4 k0 = pk[0], k1 = pk[1];
                const LAS f32x4* pr = (const LAS f32x4*)(R + s * 64 + 8 * sg); const f32x4 r0 = pr[0], r1 = pr[1];
                const float vi = V[s * 64 + srow];
                float sa = S0 * q0.x + S1 * q0.y + S2 * q0.z + S3 * q0.w + S4 * q1.x + S5 * q1.y + S6 * q1.z + S7 * q1.w;
                sa += __shfl_xor(sa, 1); sa += __shfl_xor(sa, 2); sa += __shfl_xor(sa, 4);
                S0 = S0 * w0.x - sa * b0.x + vi * k0.x; S1 = S1 * w0.y - sa * b0.y + vi * k0.y; S2 = S2 * w0.z - sa * b0.z + vi * k0.z; S3 = S3 * w0.w - sa * b0.w + vi * k0.w;
                S4 = S4 * w1.x - sa * b1.x + vi * k1.x; S5 = S5 * w1.y - sa * b1.y + vi * k1.y; S6 = S6 * w1.z - sa * b1.z + vi * k1.z; S7 = S7 * w1.w - sa * b1.w + vi * k1.w;
                float o = S0 * r0.x + S1 * r0.y + S2 * r0.z + S3 * r0.w + S4 * r1.x + S5 * r1.y + S6 * r1.z + S7 * r1.w;
                o += __shfl_xor(o, 1); o += __shfl_xor(o, 2); o += __shfl_xor(o, 4);
                if (sg == 0) OUT[s * 64 + srow] = o;
            }
            __syncthreads();
#pragma unroll
            for (int m = 0; m < 4; ++m) { const int s = wv + 8 * m, n = n0 + s; const size_t row = (size_t)step_row(d, b, n);
                const float o = OUT[s * 64 + lane]; const float mean = wave_sum(o) * (1.f / 64.f); const float dv = o - mean; const float var = wave_sum(dv * dv) * (1.f / 64.f);
                const float z = dv * rsqrtf(var + 64e-5f) * prm[640 + lane] + prm[704 + lane] + BS[s] * V[s * 64 + lane];
                Z[((size_t)d * NALL + row) * 512 + 64 * h + lane] = f2bf(z); }
        }
    }
    __syncthreads();
}
DI void phase_rwkv_post(const P& p, LAS unsigned char* ldsb) {
    LAS float* sg = (LAS float*)ldsb;
    const int tid = threadIdx.x;
    const bf16_t* LO = (const bf16_t*)(p.ws + WS_COLS) + OFF_LO; const bf16_t* Z = (const bf16_t*)(p.ws + WS_Z); bf16_t* Y = (bf16_t*)(p.ws + WS_ACT);
    const float* g2 = p.in[I_G2];
    for (int vb = blockIdx.x; vb < NALL / 8; vb += gridDim.x) {
        const size_t row0 = (size_t)vb * 8;
        __syncthreads();
        for (int e = tid; e < 1024; e += NT) { const int q = e >> 7, r = e & 127; sg[e] = sigm(bf2f(LO[(row0 + q) * 512 + 256 + r])); }
        __syncthreads();
        float a0 = 0.f, a1 = 0.f, a2 = 0.f, a3 = 0.f, a4 = 0.f, a5 = 0.f, a6 = 0.f, a7 = 0.f;
#pragma unroll 4
        for (int r = 0; r < 128; ++r) { const float g = g2[r * 512 + tid];
            a0 += sg[r] * g; a1 += sg[128 + r] * g; a2 += sg[256 + r] * g; a3 += sg[384 + r] * g; a4 += sg[512 + r] * g; a5 += sg[640 + r] * g; a6 += sg[768 + r] * g; a7 += sg[896 + r] * g; }
#define MK_RP(q, aq) { const size_t rr = row0 + q; const float z = bf2f(Z[rr * 512 + tid]) + bf2f(Z[((size_t)NALL + rr) * 512 + tid]); Y[rr * D + tid] = f2bf(z * aq); }
        MK_RP(0, a0) MK_RP(1, a1) MK_RP(2, a2) MK_RP(3, a3) MK_RP(4, a4) MK_RP(5, a5) MK_RP(6, a6) MK_RP(7, a7)
#undef MK_RP
    }
    __syncthreads();
}
DI void phase_mlstm_scan(const P& p, LAS unsigned char* ldsb) {
    LAS float* lds = (LAS float*)ldsb;
    LAS float *Q = lds, *K = lds + 4096, *V = lds + 8192, *IG = lds + 12288, *FG = IG + 32;
    const int tid = threadIdx.x, vi = tid >> 2, kg = tid & 3;
    const bf16_t* ML = (const bf16_t*)(p.ws + WS_COLS) + OFF_ML; const bf16_t* LO = (const bf16_t*)(p.ws + WS_COLS) + OFF_LO; bf16_t* HB = (bf16_t*)(p.ws + WS_Z);
    for (int vb = blockIdx.x; vb < 32; vb += gridDim.x) {
        const int d = vb >> 4, b = (vb >> 2) & 3, hd = vb & 3;
        const float bi = p.in[I_MBI][d * 4 + hd], bfv = p.in[I_MBF][d * 4 + hd];
        float C[32], Nn[32];
#pragma unroll
        for (int c = 0; c < 32; ++c) { C[c] = 0.f; Nn[c] = 0.f; }
        for (int n0 = 0; n0 < LT; n0 += 32) {
            __syncthreads();
            for (int e = tid; e < 4096; e += NT) { const int s = e >> 7, c = e & 127; const size_t row = (size_t)step_row(d, b, n0 + s);
                Q[e] = bf2f(ML[row * 2048 + 128 * hd + c]) * 0.08838834764831845f; K[e] = bf2f(ML[row * 2048 + 512 + 128 * hd + c]); V[e] = bf2f(ML[row * 2048 + 1024 + 128 * hd + c]); }
            if (tid < 32) { const size_t row = (size_t)step_row(d, b, n0 + tid);
                IG[tid] = expf(bf2f(LO[row * 512 + 384 + 4 * d + hd]) + bi); FG[tid] = sigm(bf2f(LO[row * 512 + 392 + 4 * d + hd]) + bfv); }
            __syncthreads();
            for (int s = 0; s < 32; ++s) {
                const float f = FG[s], ig = IG[s], vv = V[s * 128 + vi] * ig;
                float num = 0.f, den = 0.f;
#pragma unroll
                for (int c4 = 0; c4 < 8; ++c4) { const f32x4 kk = *(const LAS f32x4*)(K + s * 128 + 32 * kg + 4 * c4), qq = *(const LAS f32x4*)(Q + s * 128 + 32 * kg + 4 * c4);
#pragma unroll
                    for (int j = 0; j < 4; ++j) { const int c = 4 * c4 + j; C[c] = f * C[c] + vv * kk[j]; Nn[c] = f * Nn[c] + ig * kk[j]; num += C[c] * qq[j]; den += Nn[c] * qq[j]; } }
                num += __shfl_xor(num, 1); num += __shfl_xor(num, 2); den += __shfl_xor(den, 1); den += __shfl_xor(den, 2);
                if (kg == 0) { const size_t row = (size_t)step_row(d, b, n0 + s); HB[((size_t)d * NALL + row) * 512 + 128 * hd + vi] = f2bf(num / fmaxf(fabsf(den), 1.f)); }
            }
        }
    }
    __syncthreads();
}
DI void post_headnorm_row(const bf16_t* HB, size_t row, const float* ng, const bf16_t* gsrc, int gate_kind, bf16_t* ydst, int lane) {
    const int c0 = 8 * lane;
    const u32x4 h0 = *(const u32x4*)(HB + row * 512 + c0), h1 = *(const u32x4*)(HB + ((size_t)NALL + row) * 512 + c0), gg = *(const u32x4*)(gsrc + c0);
    float h[8], g[8];
#pragma unroll
    for (int j = 0; j < 4; ++j) { h[2 * j] = __uint_as_float(h0[j] << 16) + __uint_as_float(h1[j] << 16); h[2 * j + 1] = __uint_as_float(h0[j] & 0xffff0000u) + __uint_as_float(h1[j] & 0xffff0000u);
        g[2 * j] = __uint_as_float(gg[j] << 16); g[2 * j + 1] = __uint_as_float(gg[j] & 0xffff0000u); }
    float ss = 0.f;
#pragma unroll
    for (int j = 0; j < 8; ++j) ss += h[j] * h[j];
    ss += __shfl_xor(ss, 1); ss += __shfl_xor(ss, 2); ss += __shfl_xor(ss, 4); ss += __shfl_xor(ss, 8);
    const float rinv = rsqrtf(ss * (1.f / 128.f) + 1e-6f);
    unsigned o[4];
#pragma unroll
    for (int j = 0; j < 4; ++j) { const float y0 = h[2 * j] * rinv * ng[c0 + 2 * j] * (gate_kind ? siluf(g[2 * j]) : sigm(g[2 * j])), y1 = h[2 * j + 1] * rinv * ng[c0 + 2 * j + 1] * (gate_kind ? siluf(g[2 * j + 1]) : sigm(g[2 * j + 1]));
        o[j] = (unsigned)f2bf(y0) | ((unsigned)f2bf(y1) << 16); }
    u32x4 w; w.x = o[0]; w.y = o[1]; w.z = o[2]; w.w = o[3];
    *(u32x4*)(ydst + c0) = w;
}
DI void phase_mlstm_post(const P& p) {
    const int lane = threadIdx.x & 63, wv = threadIdx.x >> 6;
    const bf16_t* ML = (const bf16_t*)(p.ws + WS_COLS) + OFF_ML; const bf16_t* HB = (const bf16_t*)(p.ws + WS_Z); bf16_t* Y = (bf16_t*)(p.ws + WS_ACT);
    for (int r = blockIdx.x * 8 + wv; r < NALL; r += gridDim.x * 8)
        post_headnorm_row(HB, (size_t)r, p.in[I_MNG], ML + (size_t)r * 2048 + 1536, 0, Y + (size_t)r * D + 512, lane);
}

constexpr int C1LD = 3584;
DI int nat_row(int r) { const int b = r / L, pp = r % L; return b * L + (pp % 128) * 64 + pp / 128; }
DI void phase_hgrn_scan(const P& p, LAS unsigned char* ldsb) {
    LAS float* lds = (LAS float*)ldsb;
    LAS float *Q = lds, *F = lds + 4096, *V = lds + 8192;
    const int tid = threadIdx.x, vi = tid >> 2, fq = tid & 3;
    const bf16_t* C1 = (const bf16_t*)(p.ws + WS_COLS); bf16_t* HB = (bf16_t*)(p.ws + WS_Z);
    for (int vb = blockIdx.x; vb < 32; vb += gridDim.x) {
        const int d = vb >> 4, b = (vb >> 2) & 3, hd = vb & 3;
        float S[32];
#pragma unroll
        for (int c = 0; c < 32; ++c) S[c] = 0.f;
        for (int n0 = 0; n0 < LT; n0 += 32) {
            __syncthreads();
            for (int e = tid; e < 4096; e += NT) { const int s = e >> 7, c = e & 127, ch = 128 * hd + c; const size_t row = (size_t)step_row(d, b, n0 + s);
                const float lb = sigm(p.in[I_HLB][512 + ch] - p.in[I_HLB][ch]);
                Q[e] = siluf(bf2f(C1[row * C1LD + ch])); F[e] = lb + (1.f - lb) * sigm(bf2f(C1[row * C1LD + 512 + 512 * d + ch])); V[e] = bf2f(C1[row * C1LD + 1536 + ch]); }
            __syncthreads();
            for (int s = 0; s < 32; ++s) {
                const float v = V[s * 128 + vi]; float o = 0.f;
#pragma unroll
                for (int c4 = 0; c4 < 8; ++c4) { const f32x4 ff = *(const LAS f32x4*)(F + s * 128 + 32 * fq + 4 * c4), qq = *(const LAS f32x4*)(Q + s * 128 + 32 * fq + 4 * c4);
#pragma unroll
                    for (int j = 0; j < 4; ++j) { const int c = 4 * c4 + j; S[c] = ff[j] * (S[c] - v) + v; o += S[c] * qq[j]; } }
                o += __shfl_xor(o, 1); o += __shfl_xor(o, 2);
                if (fq == 0) { const size_t row = (size_t)step_row(d, b, n0 + s); HB[((size_t)d * NALL + row) * 512 + 128 * hd + vi] = f2bf(o); }
            }
        }
    }
    __syncthreads();
}
DI void phase_hgrn_post(const P& p) {
    const int lane = threadIdx.x & 63, wv = threadIdx.x >> 6;
    const bf16_t* C1 = (const bf16_t*)(p.ws + WS_COLS); const bf16_t* HB = (const bf16_t*)(p.ws + WS_Z); bf16_t* Y = (bf16_t*)(p.ws + WS_ACT);
    for (int r = blockIdx.x * 8 + wv; r < NLAT; r += gridDim.x * 8)
        post_headnorm_row(HB, (size_t)r, p.in[I_HNG], C1 + (size_t)r * C1LD + 2048, 1, Y + (size_t)nat_row(r) * D, lane);
}
DI void phase_lru_scan(const P& p, LAS unsigned char* ldsb) {
    LAS float* lds = (LAS float*)ldsb;
    LAS float *XC = lds, *A = lds + 512, *U = lds + 1024;
    const int tid = threadIdx.x, j = tid & 63, tl = tid >> 6;
    const bf16_t* C1 = (const bf16_t*)(p.ws + WS_COLS); bf16_t* Z = (bf16_t*)(p.ws + WS_Z);
    for (int vb = blockIdx.x; vb < 64; vb += gridDim.x) {
        const int d = vb >> 5, b = (vb >> 3) & 3, hb = vb & 7, ch = 64 * hb + j;
        float wa[64], wi[64];
#pragma unroll
        for (int i = 0; i < 64; ++i) { wa[i] = p.in[I_WA][((size_t)(d * 8 + hb) * 64 + i) * 64 + j]; wi[i] = p.in[I_WI][((size_t)(d * 8 + hb) * 64 + i) * 64 + j]; }
        const float ba = p.in[I_BA][d * 512 + ch], bi = p.in[I_BI][d * 512 + ch], lam = p.in[I_LAM][d * 512 + ch];
        const float spl = log1pf(expf(-lam));
        const float cw0 = p.in[I_CONVW][ch], cw1 = p.in[I_CONVW][512 + ch], cw2 = p.in[I_CONVW][1024 + ch], cw3 = p.in[I_CONVW][1536 + ch], cb = p.in[I_CONVB][ch];
        float h = 0.f;
        for (int n0 = 0; n0 < LT; n0 += 8) {
            const int n = n0 + tl;
            int pos, seglen, base;
            if (n < LC) { pos = d ? LC - 1 - n : n; seglen = LC; base = NLAT + b * LC; } else { const int m = n - LC; pos = d ? L - 1 - m : m; seglen = L; base = b * L; }
            float xc = cb;
            { const int p0 = pos - 2, p1 = pos - 1, p3 = pos + 1;
              if (p0 >= 0) xc += cw0 * bf2f(C1[(size_t)(base + p0) * C1LD + 2560 + ch]);
              if (p1 >= 0) xc += cw1 * bf2f(C1[(size_t)(base + p1) * C1LD + 2560 + ch]);
              xc += cw2 * bf2f(C1[(size_t)(base + pos) * C1LD + 2560 + ch]);
              if (p3 < seglen) xc += cw3 * bf2f(C1[(size_t)(base + p3) * C1LD + 2560 + ch]); }
            __syncthreads();
            XC[tl * 64 + j] = xc;
            __syncthreads();
            float rp = ba, ip = bi;
#pragma unroll
            for (int i4 = 0; i4 < 16; ++i4) { const f32x4 x = *(const LAS f32x4*)(XC + tl * 64 + 4 * i4);
                rp += x[0] * wa[4 * i4] + x[1] * wa[4 * i4 + 1] + x[2] * wa[4 * i4 + 2] + x[3] * wa[4 * i4 + 3];
                ip += x[0] * wi[4 * i4] + x[1] * wi[4 * i4 + 1] + x[2] * wi[4 * i4 + 2] + x[3] * wi[4 * i4 + 3]; }
            const float r = sigm(rp), ig = sigm(ip), la = -8.f * r * spl;
            A[tl * 64 + j] = expf(la); U[tl * 64 + j] = sqrtf(-expm1f(2.f * la)) * (ig * xc);
            __syncthreads();
            if (tid < 64) {
#pragma unroll
                for (int s = 0; s < 8; ++s) { h = A[s * 64 + j] * h + U[s * 64 + j]; const size_t row = (size_t)step_row(d, b, n0 + s); Z[((size_t)d * NALL + row) * 512 + ch] = f2bf(h); }
            }
        }
    }
    __syncthreads();
}
DI void phase_lru_post(const P& p) {
    const int lane = threadIdx.x & 63, wv = threadIdx.x >> 6;
    const bf16_t* C1 = (const bf16_t*)(p.ws + WS_COLS); const bf16_t* Z = (const bf16_t*)(p.ws + WS_Z); bf16_t* Y = (bf16_t*)(p.ws + WS_ACT);
    for (int r = blockIdx.x * 8 + wv; r < NLAT; r += gridDim.x * 8) {
        const int c0 = 8 * lane; const size_t row = (size_t)r;
        const u32x4 h0 = *(const u32x4*)(Z + row * 512 + c0), h1 = *(const u32x4*)(Z + ((size_t)NALL + row) * 512 + c0), gg = *(const u32x4*)(C1 + row * C1LD + 3072 + c0);
        unsigned o[4];
#pragma unroll
        for (int q = 0; q < 4; ++q) { const float ha = __uint_as_float(h0[q] << 16) + __uint_as_float(h1[q] << 16), hb2 = __uint_as_float(h0[q] & 0xffff0000u) + __uint_as_float(h1[q] & 0xffff0000u);
            const float ga = __uint_as_float(gg[q] << 16), gb2 = __uint_as_float(gg[q] & 0xffff0000u);
            o[q] = (unsigned)f2bf(ha * geluf(ga)) | ((unsigned)f2bf(hb2 * geluf(gb2)) << 16); }
        u32x4 w; w.x = o[0]; w.y = o[1]; w.z = o[2]; w.w = o[3];
        *(u32x4*)(Y + (size_t)nat_row(r) * D + 512 + c0) = w;
    }
}

constexpr int N_PHASES = 22;
__global__ void __launch_bounds__(NT, 2) mk_fwd(P p) {
    extern __shared__ __attribute__((aligned(16))) unsigned char lds_raw[];
    LAS unsigned char* lds = (LAS unsigned char*)lds_raw;
    cooperative_groups::grid_group grid = cooperative_groups::this_grid();
    const int lo = p.ph_lo, hi = p.ph_hi;
#define IN(k) (lo <= (k) && (k) < hi)
#define SEAM(k) do { if (IN(k) && IN((k) + 1)) grid.sync(); } while (0)
    unsigned char* ws = p.ws;
    const float* MODV = (const float*)(ws + WS_MODV);
    float* HC = (float*)(ws + WS_HC);
    bf16_t* ACT = (bf16_t*)(ws + WS_ACT); bf16_t* COLS = (bf16_t*)(ws + WS_COLS);
    if (IN(0)) { phase_wprep(p, lds); phase_modv(p, lds); } SEAM(0);
    if (IN(1)) { phase_modnorm(p, 0, 0, p.in[I_X], p.in[I_CTX], NALL, false); } SEAM(1);
    if (IN(2)) { EpiStore3 E{COLS + OFF_RW, 1536, 6, COLS + OFF_LO, 512, 8, COLS + OFF_ML, 2048}; run_gemm(lds, ACT, (const bf16_t*)(ws + WS_W_EVIN), NALL, 4096, 1024, E); } SEAM(2);
    if (IN(3)) { phase_mlstm_scan(p, lds); } SEAM(3);
    if (IN(4)) { phase_mlstm_post(p); } SEAM(4);
    if (IN(5)) { phase_rwkv_scan(p, lds); } SEAM(5);
    if (IN(6)) { phase_rwkv_post(p, lds); } SEAM(6);
    if (IN(7)) { EpiResid E{p.in[I_X], p.out, p.in[I_CTX], HC, MODV, 2}; run_gemm(lds, ACT, (const bf16_t*)(ws + WS_W_EVOUT), NALL, 1024, 1024, E); } SEAM(7);
    if (IN(8)) { phase_modnorm(p, 0, 1, p.out, HC, NALL, false); } SEAM(8);
    if (IN(9)) { EpiSwiglu E{COLS}; run_gemm(lds, ACT, (const bf16_t*)(ws + WS_W_UP), NALL, 5632, 1024, E); } SEAM(9);
    if (IN(10)) { EpiResid E{p.out, p.out, HC, HC, MODV, 5}; run_gemm(lds, COLS, (const bf16_t*)(ws + WS_W_DN), NALL, 1024, 2816, E); } SEAM(10);
    if (IN(11)) { phase_modnorm(p, 1, 0, p.out, HC, NALL, true); } SEAM(11);
    if (IN(12)) { EpiStore3 E{COLS, C1LD, 1 << 30, COLS, C1LD, 1 << 30, COLS, C1LD}; run_gemm(lds, ACT, (const bf16_t*)(ws + WS_W_ODIN), NALL, 3584, 1024, E); } SEAM(12);
    if (IN(13)) { phase_hgrn_scan(p, lds); } SEAM(13);
    if (IN(14)) { phase_hgrn_post(p); } SEAM(14);
    if (IN(15)) { phase_lru_scan(p, lds); } SEAM(15);
    if (IN(16)) { phase_lru_post(p); } SEAM(16);
    if (IN(17)) { EpiResid E{p.out, p.out, HC, HC, MODV + 5 * 6144, 2}; run_gemm(lds, ACT, (const bf16_t*)(ws + WS_W_ODOUT), NLAT, 1024, 1024, E); } SEAM(17);
    if (IN(18)) { phase_modnorm(p, 1, 1, p.out, HC, NLAT, false); } SEAM(18);
    if (IN(19)) { EpiSwiglu E{COLS}; run_gemm(lds, ACT, (const bf16_t*)(ws + WS_W_UP) + W_UP_STRIDE, NLAT, 5632, 1024, E); } SEAM(19);
    if (IN(20)) { EpiResid E{p.out, p.out, HC, HC, MODV + 5 * 6144, 5}; run_gemm(lds, COLS, (const bf16_t*)(ws + WS_W_DN) + W_DN_STRIDE, NLAT, 1024, 2816, E); } SEAM(20);
    if (IN(21)) { phase_finalnorm(p); }
#undef IN
#undef SEAM
}
}

#ifndef MK_ONE_LAUNCH
#define MK_ONE_LAUNCH 0
#endif
extern "C" void kernel_launch(void* const* d_in, const int* in_sizes, int n_in, void* d_out, int out_size, void* d_ws, size_t ws_size, hipStream_t stream) {
    using namespace mk;
    static int grid = 0;
    if (grid == 0) {
        int dev = 0, cus = 0, per_cu = 0;
        if (n_in != N_IN || ws_size < WS_END) { fprintf(stderr, "kernel_launch: unexpected n_in %d / ws_size %zu\n", n_in, ws_size); grid = -1; return; }
        hipGetDevice(&dev); hipDeviceGetAttribute(&cus, hipDeviceAttributeMultiprocessorCount, dev);
        hipFuncSetAttribute((const void*)mk_fwd, hipFuncAttributeMaxDynamicSharedMemorySize, LDS_BYTES);
        hipOccupancyMaxActiveBlocksPerMultiprocessor(&per_cu, (const void*)mk_fwd, NT, LDS_BYTES);
        if (per_cu < 1) { fprintf(stderr, "kernel_launch: occupancy query says %d blocks per CU\n", per_cu); per_cu = 1; }
        (void)hipGetLastError();
        grid = cus;
    }
    if (grid < 0) return;
    P p{};
    for (int i = 0; i < N_IN; ++i) p.in[i] = (const float*)d_in[i];
    p.out = (float*)d_out; p.ws = (unsigned char*)d_ws;
#if MK_ONE_LAUNCH
    p.ph_lo = 0; p.ph_hi = N_PHASES;
    void* args[] = {&p};
    hipError_t e = hipLaunchCooperativeKernel((const void*)mk_fwd, dim3(grid), dim3(NT), args, LDS_BYTES, stream);
    if (e != hipSuccess) fprintf(stderr, "cooperative launch failed: %s (grid %d)\n", hipGetErrorString(e), grid);
#else
    for (int k = 0; k < N_PHASES; ++k) { p.ph_lo = k; p.ph_hi = k + 1; hipLaunchKernelGGL(mk_fwd, dim3(grid), dim3(NT), LDS_BYTES, stream, p); }
#endif
}
```

```cpp
#include <hip/hip_runtime.h>
#include <hip/hip_cooperative_groups.h>
#include <cstdio>
#include <cstdint>
namespace pg8 {
#define PG8_LAS __attribute__((address_space(3)))
typedef unsigned short bf16_t;
typedef short bf16x8 __attribute__((ext_vector_type(8)));
typedef float f32x4 __attribute__((ext_vector_type(4)));
typedef unsigned u32x4 __attribute__((ext_vector_type(4)));
constexpr int BM = 256, BK = 64, HALF = 128, HTB = HALF * BK * 2  , STAGE_BYTES = 8 * HTB, NXCD = 8, WGM = 8;

__host__ __device__ __forceinline__ int lds_byte(int r, int c) { const int st = (r >> 4) * 2 + (c >> 5), rr = r & 15, cc = c & 31, ob = rr * 64 + cc * 2; return st * 1024 + (ob ^ (((ob >> 9) & 1) << 5)); }
__host__ __device__ __forceinline__ void stage_rc(int b, int& R, int& C) { const int st = b / 1024, sb = b % 1024, swz = sb ^ (((sb >> 9) & 1) << 5); R = (st >> 1) * 16 + swz / 64; C = (st & 1) * 32 + (swz % 64) / 2; }
__host__ __device__ __forceinline__ int perm32(int rho) { const int n = rho >> 4, i = rho & 15; return 8 * (i >> 2) + 4 * n + (i & 3); }

struct Unit { int pm, pn; };
struct Gemm { const bf16_t* A; const bf16_t* Bt; int M, N, K; };

struct StaticOrder {
    int nM, nN, nwg, G, c;
    __host__ __device__ void init(int M, int N, int G_, int c_) { nM = M / BM; nN = N / BM; nwg = nM * nN; G = G_; c = c_; }
    __host__ __device__ bool next(int i, Unit& u) const {
        const long L = (long)i * G + c; if (L >= nwg) return false;
        int wgid = (int)L; { const int q = nwg / NXCD, r = nwg % NXCD, xcd = wgid % NXCD, off = wgid / NXCD; wgid = (xcd < r ? xcd * (q + 1) : r * (q + 1) + (xcd - r) * q) + off; }
        const int nig = WGM * nN, gid = wgid / nig, fm = gid * WGM, gsz = (nM - fm) < WGM ? (nM - fm) : WGM;
        u.pm = fm + ((wgid % nig) % gsz); u.pn = (wgid % nig) / gsz; return true;
    }
    __device__ __forceinline__ void a_ready(const Unit&) const {}
    __device__ __forceinline__ void done(const Unit&) const {}
};
__device__ __forceinline__ unsigned cvt_pk_bf16(float lo, float hi) { unsigned r; asm volatile("v_cvt_pk_bf16_f32 %0, %1, %2" : "=v"(r) : "v"(lo), "v"(hi)); return r; }
typedef float f32x2 __attribute__((ext_vector_type(2)));
template <class Epi, class Sched, bool STAMP = false>
__device__ __forceinline__ void gemm_phase(PG8_LAS unsigned char* lds, const Gemm g, const Sched& S, const Epi& E, unsigned long long* stamps) {
    const int tid = threadIdx.x, wid = __builtin_amdgcn_readfirstlane(tid >> 6), lane = tid & 63, wr = wid >> 2, wc = wid & 3, fr = lane & 15, fq = lane >> 4;
    const int K = g.K, nt = K / BK;
    int ts_lo = 0, ts_hi = 0, nts = 0; const unsigned long long rt_entry = STAMP ? (unsigned long long)wall_clock64() : 0ull;
#define PG8_STAMP() do { if (STAMP && wid == 0 && nts < 64) { const unsigned long long _c = (unsigned long long)clock64(); \
        ts_lo = (lane == nts) ? (int)(unsigned)_c : ts_lo; ts_hi = (lane == nts) ? (int)(unsigned)(_c >> 32) : ts_hi; ++nts; } } while (0)
    PG8_STAMP();
    unsigned voffA[2], voffB[2];
#pragma unroll
    for (int i = 0; i < 2; ++i) { int R, C; stage_rc(tid * 16 + i * 8192, R, C); const int Rb = Epi::PERM ? ((R & ~31) + perm32(R & 31)) : R;
        voffA[i] = (unsigned)(R * K + C) * 2u; voffB[i] = (unsigned)(Rb * K + C) * 2u; }
    const size_t kstep = (size_t)(BK * 2);
    const size_t hstep = (size_t)HALF * K * 2;
    const size_t tstep = 2 * hstep;
    const unsigned ldsw = (unsigned)wid * 1024u;
    const int aoff = lds_byte(wr * 64 + fr, fq * 8), boff = lds_byte(wc * 32 + fr, fq * 8);
#define PG8_SA(b, h) (((b) * 2 + (h)) * HTB)
#define PG8_SB(b, h) ((4 + (b) * 2 + (h)) * HTB)
#define PG8_STAGE(bufoff, gbase, voff) do { _Pragma("unroll") for (int _i = 0; _i < 2; ++_i) \
        __builtin_amdgcn_global_load_lds((const unsigned*)((const char*)(gbase) + (voff)[_i]), (PG8_LAS unsigned*)(lds + (bufoff) + ldsw + _i * 8192), 16, 0, 0); } while (0)
#define PG8_LDA(dst, b, h) do { _Pragma("unroll") for (int m = 0; m < 4; ++m) _Pragma("unroll") for (int k = 0; k < 2; ++k) dst[m][k] = *(const PG8_LAS bf16x8*)(lds + PG8_SA(b, h) + aoff + m * 2048 + k * 1024); } while (0)
#define PG8_LDB(dst, b, h) do { _Pragma("unroll") for (int n = 0; n < 2; ++n) _Pragma("unroll") for (int k = 0; k < 2; ++k) dst[n][k] = *(const PG8_LAS bf16x8*)(lds + PG8_SB(b, h) + boff + n * 2048 + k * 1024); } while (0)
#define PG8_MMA(ai, bj, At, Bt) do { __builtin_amdgcn_s_setprio(1); _Pragma("unroll") for (int m = 0; m < 4; ++m) _Pragma("unroll") for (int n = 0; n < 2; ++n) _Pragma("unroll") for (int k = 0; k < 2; ++k) \
        acc[ai][bj][m][n] = __builtin_amdgcn_mfma_f32_16x16x32_bf16(Bt[n][k], At[m][k], acc[ai][bj][m][n], 0, 0, 0); __builtin_amdgcn_s_setprio(0); } while (0)
#define PG8_WAIT_V(n) asm volatile("s_waitcnt vmcnt(" #n ")" ::: "memory")
#define PG8_WAIT_L(n) asm volatile("s_waitcnt lgkmcnt(" #n ")" ::: "memory")
#define PG8_BAR __builtin_amdgcn_s_barrier()
#define PG8_SCHED __builtin_amdgcn_sched_barrier(0)
    Unit cur, nxt; int ui = 0;
    if (!S.next(0, cur)) return;
    f32x4 acc[2][2][4][2];
#pragma unroll
    for (int a = 0; a < 2; ++a)
#pragma unroll
        for (int b = 0; b < 2; ++b)
#pragma unroll
            for (int m = 0; m < 4; ++m)
#pragma unroll
                for (int n = 0; n < 2; ++n) acc[a][b][m][n] = (f32x4){0.f, 0.f, 0.f, 0.f};
    bf16x8 At[4][2], B0[2][2], B1[2][2];
    const char* cA = (const char*)g.A + (size_t)cur.pm * tstep; const char* cB = (const char*)g.Bt + (size_t)cur.pn * tstep;
    S.a_ready(cur);
    PG8_STAGE(PG8_SB(0, 0), cB, voffB); PG8_STAGE(PG8_SA(0, 0), cA, voffA); PG8_STAGE(PG8_SB(0, 1), cB + hstep, voffB); PG8_STAGE(PG8_SA(0, 1), cA + hstep, voffA);
    if (wr == 1) PG8_BAR;
    PG8_WAIT_V(4); PG8_BAR;
    PG8_STAGE(PG8_SB(1, 0), cB + kstep, voffB); PG8_STAGE(PG8_SA(1, 0), cA + kstep, voffA); PG8_STAGE(PG8_SB(1, 1), cB + hstep + kstep, voffB);
    PG8_WAIT_V(6); PG8_BAR;
    PG8_STAMP();
    for (;;) {
        const bool has_next = S.next(ui + 1, nxt);
        const char* nA = has_next ? (const char*)g.A + (size_t)nxt.pm * tstep : cA; const char* nB = has_next ? (const char*)g.Bt + (size_t)nxt.pn * tstep : cB;
        for (int t = 0; t < nt; t += 2) {
            const bool last = (t == nt - 2);
            const char* a1 = cA + (size_t)(t + 1) * kstep;
            const char* a2 = last ? nA : cA + (size_t)(t + 2) * kstep; const char* b2 = last ? nB : cB + (size_t)(t + 2) * kstep;
            const char* a3 = a2 + kstep; const char* b3 = b2 + kstep;
            if (last && has_next) S.a_ready(nxt);
            PG8_LDB(B0, 0, 0); PG8_SCHED; PG8_LDA(At, 0, 0); PG8_STAGE(PG8_SA(1, 1), a1 + hstep, voffA);
            PG8_WAIT_L(8); PG8_BAR; PG8_WAIT_L(0); PG8_MMA(0, 0, At, B0); PG8_BAR; PG8_SCHED;
            PG8_LDB(B1, 0, 1); PG8_STAGE(PG8_SB(0, 0), b2, voffB);
            PG8_BAR; PG8_WAIT_L(0); PG8_MMA(0, 1, At, B1); PG8_BAR;
            PG8_LDA(At, 0, 1); PG8_STAGE(PG8_SA(0, 0), a2, voffA);
            PG8_BAR; PG8_WAIT_L(0); PG8_MMA(1, 0, At, B0); PG8_BAR; PG8_SCHED;
            PG8_STAGE(PG8_SB(0, 1), b2 + hstep, voffB);
            PG8_WAIT_V(6); PG8_BAR; PG8_MMA(1, 1, At, B1); PG8_BAR;
            PG8_LDB(B0, 1, 0); PG8_SCHED; PG8_LDA(At, 1, 0); PG8_STAGE(PG8_SA(0, 1), a2 + hstep, voffA);
            PG8_WAIT_L(8); PG8_BAR; PG8_WAIT_L(0); PG8_MMA(0, 0, At, B0); PG8_BAR; PG8_SCHED;
            PG8_LDB(B1, 1, 1); PG8_STAGE(PG8_SB(1, 0), b3, voffB);
            PG8_BAR; PG8_WAIT_L(0); PG8_MMA(0, 1, At, B1); PG8_BAR;
            PG8_LDA(At, 1, 1); PG8_STAGE(PG8_SA(1, 0), a3, voffA);
            PG8_BAR; PG8_WAIT_L(0); PG8_MMA(1, 0, At, B0); PG8_BAR; PG8_SCHED;
            PG8_STAGE(PG8_SB(1, 1), b3 + hstep, voffB);
            PG8_WAIT_V(6); PG8_BAR; PG8_MMA(1, 1, At, B1); PG8_BAR;
        }
        PG8_STAMP();
        if constexpr (!Epi::AFTER_DRAIN) { E(acc, cur, wr, wc, fr, fq); S.done(cur); }
        PG8_STAMP();
        if (!has_next) break;
#pragma unroll
        for (int a = 0; a < 2; ++a)
#pragma unroll
            for (int b = 0; b < 2; ++b)
#pragma unroll
                for (int m = 0; m < 4; ++m)
#pragma unroll
                    for (int n = 0; n < 2; ++n) acc[a][b][m][n] = (f32x4){0.f, 0.f, 0.f, 0.f};
        cur = nxt; cA = nA; cB = nB; ++ui;
    }
    PG8_WAIT_V(0);
    if (wr == 0) PG8_BAR;
    PG8_BAR;
    if constexpr (Epi::AFTER_DRAIN) { E.fused(acc, cur, wr, wc, fr, fq, lds, wid, lane); S.done(cur); }
    PG8_STAMP();
    if (STAMP && wid == 0) { stamps[lane] = lane < nts ? (((unsigned long long)(unsigned)ts_hi << 32) | (unsigned)ts_lo) : 0ull;
        if (lane == 62) stamps[62] = rt_entry; if (lane == 63) stamps[63] = (unsigned long long)wall_clock64(); }
#undef PG8_STAMP
#undef PG8_SA
#undef PG8_SB
#undef PG8_STAGE
#undef PG8_LDA
#undef PG8_LDB
#undef PG8_MMA
#undef PG8_WAIT_V
#undef PG8_WAIT_L
#undef PG8_BAR
#undef PG8_SCHED
}
}

namespace mk {
#define DI __device__ __forceinline__
#define LAS __attribute__((address_space(3)))
typedef unsigned short bf16_t;
typedef float f32x4 __attribute__((ext_vector_type(4)));
typedef unsigned u32x2 __attribute__((ext_vector_type(2)));
typedef unsigned u32x4 __attribute__((ext_vector_type(4)));

constexpr int D = 1024, NB = 4, L = 8192, LC = 256, NLAT = NB * L, NCTX = NB * LC, NALL = NLAT + NCTX, LT = L + LC, DFF = 2816;
constexpr int NT = 512;
constexpr size_t MiB = (size_t)1 << 20;
constexpr size_t WS_CTL = 0, WS_MODV = 1 * MiB, WS_HC = 2 * MiB, WS_W_EVIN = 6 * MiB, WS_W_EVOUT = 14 * MiB, WS_W_ODIN = 16 * MiB, WS_W_ODOUT = 23 * MiB,
                 WS_W_UP = 25 * MiB, WS_W_DN = 47 * MiB, WS_ACT = 58 * MiB, WS_COLS = 124 * MiB, WS_Z = 388 * MiB, WS_END = 454 * MiB;
constexpr size_t W_UP_STRIDE = (size_t)5632 * 1024, W_DN_STRIDE = (size_t)1024 * 2816;
constexpr size_t OFF_RW = 0, OFF_LO = (size_t)NALL * 1536, OFF_ML = OFF_LO + (size_t)NALL * 512;
constexpr int LDS_BYTES = 147456;

enum { I_X = 0, I_C, I_CTX, I_CCTX, I_N1G, I_N2G, I_MODW, I_MODB, I_W1, I_W3, I_W2, I_FING, I_EVIN, I_EVOUT, I_MU, I_W0, I_W2L, I_A0, I_A2L, I_KK, I_KA, I_RK,
       I_LNW, I_LNB, I_G2, I_MBI, I_MBF, I_MNG, I_ODIN, I_ODOUT, I_HLB, I_HNG, I_CONVW, I_CONVB, I_WA, I_BA, I_WI, I_BI, I_LAM, N_IN };

struct P { const float* in[N_IN]; float* out; unsigned char* ws; int ph_lo, ph_hi; };

DI float bf2f(bf16_t v) { return __uint_as_float(((unsigned)v) << 16); }
DI bf16_t f2bf(float f) { unsigned u = __float_as_uint(f); u += 0x7fffu + ((u >> 16) & 1u); return (bf16_t)(u >> 16); }
DI float sigm(float x) { return 1.f / (1.f + expf(-x)); }
DI float siluf(float x) { return x * sigm(x); }
DI float geluf(float x) { return 0.5f * x * (1.f + tanhf(0.7978845608028654f * (x + 0.044715f * x * x * x))); }
DI float wave_sum(float v) {
#pragma unroll
    for (int o = 32; o >= 1; o >>= 1) v += __shfl_xor(v, o);
    return v;
}
DI int step_row(int d, int b, int n) {
    if (n < LC) return NLAT + b * LC + (d ? LC - 1 - n : n);
    const int m = n - LC; return b * L + (d ? L - 1 - m : m);
}

DI int matN(int m) { return m == 0 ? 4096 : m == 1 ? 1024 : m == 2 ? 3584 : m == 3 ? 1024 : m < 6 ? 5632 : 1024; }
DI int matK(int m) { return m < 6 ? 1024 : 2816; }
DI int matTile0(int m) { return m == 0 ? 0 : m == 1 ? 1024 : m == 2 ? 1280 : m == 3 ? 2176 : m == 4 ? 2432 : m == 5 ? 3840 : m == 6 ? 5248 : m == 7 ? 5952 : 6656; }
DI size_t matOff(int m) { return m == 0 ? WS_W_EVIN : m == 1 ? WS_W_EVOUT : m == 2 ? WS_W_ODIN : m == 3 ? WS_W_ODOUT : m == 4 ? WS_W_UP : m == 5 ? WS_W_UP + W_UP_STRIDE * 2 : m == 6 ? WS_W_DN : WS_W_DN + W_DN_STRIDE * 2; }
DI const float* matSrc(const P& p, int m, int n, int& ld) {
    if (m == 0) { ld = 3984; int col; if (n < 1920) col = n; else if (n < 1936) col = 3968 + (n - 1920); else if (n < 2048) return nullptr; else col = 1920 + (n - 2048); return p.in[I_EVIN] + col; }
    if (m == 1) { ld = 1024; return p.in[I_EVOUT] + n; }
    if (m == 2) { ld = 3584; return p.in[I_ODIN] + n; }
    if (m == 3) { ld = 1024; return p.in[I_ODOUT] + n; }
    if (m < 6) { ld = 2816; const int l = m - 4, pn = n >> 8, w = n & 255; const size_t lo = (size_t)l * 1024 * 2816; return (w < 128) ? p.in[I_W1] + lo + 128 * pn + w : p.in[I_W3] + lo + 128 * pn + (w - 128); }
    ld = 1024; return p.in[I_W2] + (size_t)(m - 6) * 2816 * 1024 + n;
}
DI void phase_wprep(const P& p, LAS unsigned char* ldsb) {
    LAS float* tile = (LAS float*)ldsb;
    const int tid = threadIdx.x, tx = tid & 63, ty = tid >> 6;
    for (int item = blockIdx.x; item < 6656; item += gridDim.x) {
        int m = 0;
#pragma unroll
        for (int q = 1; q < 8; ++q) if (item >= matTile0(q)) m = q;
        const int local = item - matTile0(m), K = matK(m), nK = K >> 6, nb = local / nK, kb = local - nb * nK, n0 = nb * 64, k0 = kb * 64;
        bf16_t* Bt = (bf16_t*)(p.ws + matOff(m));
        int ld; const float* src = matSrc(p, m, n0 + tx, ld);
        __syncthreads();
#pragma unroll
        for (int i = 0; i < 8; ++i) { const int k = k0 + ty + 8 * i; tile[(ty + 8 * i) * 65 + tx] = src ? src[(size_t)k * ld] : 0.f; }
        __syncthreads();
#pragma unroll
        for (int i = 0; i < 8; ++i) { const int nn = ty + 8 * i; Bt[(size_t)(n0 + nn) * K + k0 + tx] = f2bf(tile[tx * 65 + nn]); }
    }
    __syncthreads();
}
DI void phase_modv(const P& p, LAS unsigned char* ldsb) {
    LAS float* sc = (LAS float*)ldsb;
    const int tid = threadIdx.x;
    float* MODV = (float*)(p.ws + WS_MODV);
    __syncthreads();
    for (int e = tid; e < 5 * 1024; e += NT) { const int s = e >> 10, k = e & 1023; const float v = (s < 4) ? p.in[I_C][s * 1024 + k] : p.in[I_CCTX][k]; sc[e] = siluf(v); }
    __syncthreads();
    for (int vb = blockIdx.x; vb < 24; vb += gridDim.x) {
        const int l = vb / 12, n = (vb % 12) * 512 + tid;
        const float* W = p.in[I_MODW] + (size_t)l * 1024 * 6144 + n;
        float a0 = 0.f, a1 = 0.f, a2 = 0.f, a3 = 0.f, a4 = 0.f;
#pragma unroll 8
        for (int k = 0; k < 1024; ++k) { const float w = W[(size_t)k * 6144]; a0 += sc[k] * w; a1 += sc[1024 + k] * w; a2 += sc[2048 + k] * w; a3 += sc[3072 + k] * w; a4 += sc[4096 + k] * w; }
        const float bb = p.in[I_MODB][l * 6144 + n];
        float* o = MODV + (size_t)l * 5 * 6144 + n;
        o[0] = a0 + bb; o[6144] = a1 + bb; o[2 * 6144] = a2 + bb; o[3 * 6144] = a3 + bb; o[4 * 6144] = a4 + bb;
    }
    __syncthreads();
}

DI void phase_modnorm(const P& p, int layer, int which, const float* hlat, const float* hctx, int nrows, bool permute) {
    const int lane = threadIdx.x & 63, wv = threadIdx.x >> 6;
    const float* MODV = (const float*)(p.ws + WS_MODV) + (size_t)layer * 5 * 6144;
    const float* g = p.in[which ? I_N2G : I_N1G] + layer * 1024;
    bf16_t* ACT = (bf16_t*)(p.ws + WS_ACT);
    for (int r = blockIdx.x * 8 + wv; r < nrows; r += gridDim.x * 8) {
        const bool isctx = r >= NLAT;
        const float* src = isctx ? hctx + (size_t)(r - NLAT) * D : hlat + (size_t)r * D;
        const int sv = isctx ? 4 : r / L;
        const float* shift = MODV + sv * 6144 + (which ? 3 : 0) * 1024; const float* scale = shift + 1024;
        int dr = r;
        if (permute && !isctx) { const int b = r / L, t = r % L; dr = b * L + (t % 64) * 128 + t / 64; }
        f32x4 v[4]; float ss = 0.f;
#pragma unroll
        for (int j = 0; j < 4; ++j) { v[j] = *(const f32x4*)(src + 4 * lane + 256 * j); ss += v[j].x * v[j].x + v[j].y * v[j].y + v[j].z * v[j].z + v[j].w * v[j].w; }
        const float rinv = rsqrtf(wave_sum(ss) * (1.f / D) + 1e-6f);
#pragma unroll
        for (int j = 0; j < 4; ++j) { const int c = 4 * lane + 256 * j;
            const f32x4 gg = *(const f32x4*)(g + c), sc = *(const f32x4*)(scale + c), sh = *(const f32x4*)(shift + c);
            const float o0 = v[j].x * rinv * gg.x * (1.f + sc.x) + sh.x, o1 = v[j].y * rinv * gg.y * (1.f + sc.y) + sh.y, o2 = v[j].z * rinv * gg.z * (1.f + sc.z) + sh.z, o3 = v[j].w * rinv * gg.w * (1.f + sc.w) + sh.w;
            u32x2 w; w.x = (unsigned)f2bf(o0) | ((unsigned)f2bf(o1) << 16); w.y = (unsigned)f2bf(o2) | ((unsigned)f2bf(o3) << 16);
            *(u32x2*)(ACT + (size_t)dr * D + c) = w; }
    }
}
DI void phase_finalnorm(const P& p) {
    const int lane = threadIdx.x & 63, wv = threadIdx.x >> 6;
    const float* g = p.in[I_FING];
    for (int r = blockIdx.x * 8 + wv; r < NLAT; r += gridDim.x * 8) {
        float* src = p.out + (size_t)r * D;
        f32x4 v[4]; float ss = 0.f;
#pragma unroll
        for (int j = 0; j < 4; ++j) { v[j] = *(const f32x4*)(src + 4 * lane + 256 * j); ss += v[j].x * v[j].x + v[j].y * v[j].y + v[j].z * v[j].z + v[j].w * v[j].w; }
        const float rinv = rsqrtf(wave_sum(ss) * (1.f / D) + 1e-6f);
#pragma unroll
        for (int j = 0; j < 4; ++j) { const int c = 4 * lane + 256 * j; const f32x4 gg = *(const f32x4*)(g + c);
            f32x4 o; o.x = v[j].x * rinv * gg.x; o.y = v[j].y * rinv * gg.y; o.z = v[j].z * rinv * gg.z; o.w = v[j].w * rinv * gg.w; *(f32x4*)(src + c) = o; }
    }
}

struct EpiStore3 {
    static constexpr bool PERM = false, AFTER_DRAIN = false;
    bf16_t* p0; int ld0; int pn1; bf16_t* p1; int ld1; int pn2; bf16_t* p2; int ld2;
    DI void operator()(const f32x4 (&acc)[2][2][4][2], const pg8::Unit& u, int wr, int wc, int fr, int fq) const {
        bf16_t* base; int ld, ct;
        if (u.pn >= pn2) { base = p2; ld = ld2; ct = u.pn - pn2; } else if (u.pn >= pn1) { base = p1; ld = ld1; ct = u.pn - pn1; } else { base = p0; ld = ld0; ct = u.pn; }
        const int row0 = u.pm * 256 + wr * 64 + fr, col0 = ct * 256 + wc * 32 + 4 * fq;
#pragma unroll
        for (int ai = 0; ai < 2; ++ai)
#pragma unroll
            for (int m = 0; m < 4; ++m) { bf16_t* rowp = base + (size_t)(row0 + ai * 128 + m * 16) * ld + col0;
#pragma unroll
                for (int bj = 0; bj < 2; ++bj)
#pragma unroll
                    for (int n = 0; n < 2; ++n) { const f32x4 v = acc[ai][bj][m][n]; u32x2 w; w.x = pg8::cvt_pk_bf16(v[0], v[1]); w.y = pg8::cvt_pk_bf16(v[2], v[3]); *(u32x2*)(rowp + bj * 128 + n * 16) = w; } }
    }
};
struct EpiResid {
    static constexpr bool PERM = false, AFTER_DRAIN = false;
    const float* hin; float* hout; const float* cin; float* cout; const float* modv_l; int gidx;
    DI void operator()(const f32x4 (&acc)[2][2][4][2], const pg8::Unit& u, int wr, int wc, int fr, int fq) const {
        const bool isctx = u.pm >= 128; const int sv = isctx ? 4 : (u.pm >> 5);
        const float* gate = modv_l + sv * 6144 + gidx * 1024;
        const float* bi = isctx ? cin : hin; float* bo = isctx ? cout : hout;
        const int row0 = (isctx ? (u.pm - 128) : u.pm) * 256 + wr * 64 + fr, col0 = u.pn * 256 + wc * 32 + 4 * fq;
        f32x4 gv[2][2];
#pragma unroll
        for (int bj = 0; bj < 2; ++bj)
#pragma unroll
            for (int n = 0; n < 2; ++n) gv[bj][n] = *(const f32x4*)(gate + col0 + bj * 128 + n * 16);
#pragma unroll
        for (int ai = 0; ai < 2; ++ai)
#pragma unroll
            for (int m = 0; m < 4; ++m) { const size_t off = (size_t)(row0 + ai * 128 + m * 16) * D + col0;
#pragma unroll
                for (int bj = 0; bj < 2; ++bj)
#pragma unroll
                    for (int n = 0; n < 2; ++n) { const f32x4 bs = *(const f32x4*)(bi + off + bj * 128 + n * 16); *(f32x4*)(bo + off + bj * 128 + n * 16) = bs + gv[bj][n] * acc[ai][bj][m][n]; } }
    }
};
struct EpiSwiglu {
    static constexpr bool PERM = false, AFTER_DRAIN = false;
    bf16_t* G;
    DI void operator()(const f32x4 (&acc)[2][2][4][2], const pg8::Unit& u, int wr, int wc, int fr, int fq) const {
        const int row0 = u.pm * 256 + wr * 64 + fr, col0 = u.pn * 128 + wc * 32 + 4 * fq;
#pragma unroll
        for (int ai = 0; ai < 2; ++ai)
#pragma unroll
            for (int m = 0; m < 4; ++m) { bf16_t* rowp = G + (size_t)(row0 + ai * 128 + m * 16) * DFF + col0;
#pragma unroll
                for (int n = 0; n < 2; ++n) { const f32x4 a = acc[ai][0][m][n], b = acc[ai][1][m][n];
                    const float g0 = a[0] / (1.f + __expf(-a[0])) * b[0], g1 = a[1] / (1.f + __expf(-a[1])) * b[1], g2 = a[2] / (1.f + __expf(-a[2])) * b[2], g3 = a[3] / (1.f + __expf(-a[3])) * b[3];
                    u32x2 w; w.x = pg8::cvt_pk_bf16(g0, g1); w.y = pg8::cvt_pk_bf16(g2, g3); *(u32x2*)(rowp + n * 16) = w; } }
    }
};
template <class Epi> DI void run_gemm(LAS unsigned char* lds, const bf16_t* A, const bf16_t* Bt, int M, int N, int K, const Epi& E) {
    pg8::Gemm g{A, Bt, M, N, K}; pg8::StaticOrder S; S.init(M, N, (int)gridDim.x, (int)blockIdx.x);
    pg8::gemm_phase<Epi, pg8::StaticOrder, false>((PG8_LAS unsigned char*)lds, g, S, E, nullptr);
    __syncthreads();
}

DI void phase_rwkv_scan(const P& p, LAS unsigned char* ldsb) {
    LAS float* lds = (LAS float*)ldsb;
    LAS float *w2s = lds, *a2s = lds + 4096, *prm = lds + 8192, *TH = prm + 768, *AD = TH + 2048, *R = AD + 2048, *W = R + 2048, *K = W + 2048, *KK = K + 2048, *BV = KK + 2048,
              *V = BV + 2048, *BS = V + 2048, *OUT = BS + 32;
    const int tid = threadIdx.x, lane = tid & 63, wv = tid >> 6;
    const bf16_t* RW = (const bf16_t*)(p.ws + WS_COLS) + OFF_RW; const bf16_t* LO = (const bf16_t*)(p.ws + WS_COLS) + OFF_LO; bf16_t* Z = (bf16_t*)(p.ws + WS_Z);
    const int srow = tid >> 3, sg = tid & 7;
    for (int vb = blockIdx.x; vb < 64; vb += gridDim.x) {
        const int d = vb >> 5, b = (vb >> 3) & 3, h = vb & 7;
        __syncthreads();
        for (int e = tid; e < 4096; e += NT) { const int i = e >> 6, c = e & 63; w2s[e] = p.in[I_W2L][(size_t)(d * 64 + i) * 512 + 64 * h + c]; a2s[e] = p.in[I_A2L][(size_t)(d * 64 + i) * 512 + 64 * h + c]; }
        if (tid < 64) { const int j = tid, c = 64 * h + j; const float* mu = p.in[I_MU] + d * 1664;
            prm[j] = mu[c]; prm[64 + j] = mu[512 + c]; prm[128 + j] = mu[1024 + c]; prm[192 + j] = mu[1536 + j]; prm[256 + j] = mu[1600 + j];
            prm[320 + j] = p.in[I_W0][d * 512 + c]; prm[384 + j] = p.in[I_A0][d * 512 + c]; prm[448 + j] = p.in[I_KK][d * 512 + c]; prm[512 + j] = p.in[I_KA][d * 512 + c];
            prm[576 + j] = p.in[I_RK][(d * 8 + h) * 64 + j]; prm[640 + j] = p.in[I_LNW][d * 512 + c]; prm[704 + j] = p.in[I_LNB][d * 512 + c]; }
        __syncthreads();
        float S0 = 0.f, S1 = 0.f, S2 = 0.f, S3 = 0.f, S4 = 0.f, S5 = 0.f, S6 = 0.f, S7 = 0.f;
        for (int n0 = 0; n0 < LT; n0 += 32) {
            float rs[4], ks[4], vs[4];
#pragma unroll
            for (int m = 0; m < 4; ++m) { const int s = wv + 8 * m, n = n0 + s; const bool hp = (n != 0) && (n != LC);
                const size_t row = (size_t)step_row(d, b, n), prow = hp ? (size_t)step_row(d, b, n - 1) : row; const int c = 64 * h + lane;
                const float r0 = bf2f(RW[row * 1536 + c]), k0 = bf2f(RW[row * 1536 + 512 + c]), v0 = bf2f(RW[row * 1536 + 1024 + c]);
                const float r1 = hp ? bf2f(RW[prow * 1536 + c]) : 0.f, k1 = hp ? bf2f(RW[prow * 1536 + 512 + c]) : 0.f, v1 = hp ? bf2f(RW[prow * 1536 + 1024 + c]) : 0.f;
                rs[m] = r0 + prm[lane] * (r1 - r0); ks[m] = k0 + prm[64 + lane] * (k1 - k0); vs[m] = v0 + prm[128 + lane] * (v1 - v0);
                const float wd0 = bf2f(LO[row * 512 + 64 * d + lane]), wd1 = hp ? bf2f(LO[prow * 512 + 64 * d + lane]) : 0.f;
                const float ad0 = bf2f(LO[row * 512 + 128 + 64 * d + lane]), ad1 = hp ? bf2f(LO[prow * 512 + 128 + 64 * d + lane]) : 0.f;
                TH[s * 64 + lane] = tanhf(wd0 + prm[192 + lane] * (wd1 - wd0)); AD[s * 64 + lane] = ad0 + prm[256 + lane] * (ad1 - ad0); }
            __syncthreads();
#pragma unroll
            for (int m = 0; m < 4; ++m) { const int s = wv + 8 * m;
                float xw = prm[320 + lane], xa = prm[384 + lane];
#pragma unroll 8
                for (int i = 0; i < 64; ++i) { xw += TH[s * 64 + i] * w2s[i * 64 + lane]; xa += AD[s * 64 + i] * a2s[i * 64 + lane]; }
                const float elog = 0.6065306597126334f * sigm(xw), dec = expf(-elog), a = sigm(xa);
                const float kkr = ks[m] * prm[448 + lane]; const float ss = wave_sum(kkr * kkr); const float kkn = kkr / fmaxf(sqrtf(ss), 1e-12f);
                const float km = ks[m] * (1.f + (a - 1.f) * prm[512 + lane]);
                const float bs = wave_sum(rs[m] * km * prm[576 + lane]);
                R[s * 64 + lane] = rs[m]; W[s * 64 + lane] = dec; K[s * 64 + lane] = km; KK[s * 64 + lane] = kkn; BV[s * 64 + lane] = kkn * a; V[s * 64 + lane] = vs[m];
                if (lane == 0) BS[s] = bs; }
            __syncthreads();
            for (int s = 0; s < 32; ++s) {
                const LAS f32x4* pq = (const LAS f32x4*)(KK + s * 64 + 8 * sg); const f32x4 q0 = pq[0], q1 = pq[1];
                const LAS f32x4* pw = (const LAS f32x4*)(W + s * 64 + 8 * sg); const f32x4 w0 = pw[0], w1 = pw[1];
                const LAS f32x4* pb = (const LAS f32x4*)(BV + s * 64 + 8 * sg); const f32x4 b0 = pb[0], b1 = pb[1];
                const LAS f32x4* pk = (const LAS f32x4*)(K + s * 64 + 8 * sg); const f32x4 k0 = pk[0], k1 = pk[1];
                const LAS f32x4* pr = (const LAS f32x4*)(R + s * 64 + 8 * sg); const f32x4 r0 = pr[0], r1 = pr[1];
                const float vi = V[s * 64 + srow];
                float sa = S0 * q0.x + S1 * q0.y + S2 * q0.z + S3 * q0.w + S4 * q1.x + S5 * q1.y + S6 * q1.z + S7 * q1.w;
                sa += __shfl_xor(sa, 1); sa += __shfl_xor(sa, 2); sa += __shfl_xor(sa, 4);
                S0 = S0 * w0.x - sa * b0.x + vi * k0.x; S1 = S1 * w0.y - sa * b0.y + vi * k0.y; S2 = S2 * w0.z - sa * b0.z + vi * k0.z; S3 = S3 * w0.w - sa * b0.w + vi * k0.w;
                S4 = S4 * w1.x - sa * b1.x + vi * k1.x; S5 = S5 * w1.y - sa * b1.y + vi * k1.y; S6 = S6 * w1.z - sa * b1.z + vi * k1.z; S7 = S7 * w1.w - sa * b1.w + vi * k1.w;
                float o = S0 * r0.x + S1 * r0.y + S2 * r0.z + S3 * r0.w + S4 * r1.x + S5 * r1.y + S6 * r1.z + S7 * r1.w;
                o += __shfl_xor(o, 1); o += __shfl_xor(o, 2); o += __shfl_xor(o, 4);
                if (sg == 0) OUT[s * 64 + srow] = o;
            }
            __syncthreads();
#pragma unroll
            for (int m = 0; m < 4; ++m) { const int s = wv + 8 * m, n = n0 + s; const size_t row = (size_t)step_row(d, b, n);
                const float o = OUT[s * 64 + lane]; const float mean = wave_sum(o) * (1.f / 64.f); const float dv = o - mean; const float var = wave_sum(dv * dv) * (1.f / 64.f);
                const float z = dv * rsqrtf(var + 64e-5f) * prm[640 + lane] + prm[704 + lane] + BS[s] * V[s * 64 + lane];
                Z[((size_t)d * NALL + row) * 512 + 64 * h + lane] = f2bf(z); }
        }
    }
    __syncthreads();
}
DI void phase_rwkv_post(const P& p, LAS unsigned char* ldsb) {
    LAS float* sg = (LAS float*)ldsb;
    const int tid = threadIdx.x;
    const bf16_t* LO = (const bf16_t*)(p.ws + WS_COLS) + OFF_LO; const bf16_t* Z = (const bf16_t*)(p.ws + WS_Z); bf16_t* Y = (bf16_t*)(p.ws + WS_ACT);
    const float* g2 = p.in[I_G2];
    for (int vb = blockIdx.x; vb < NALL / 8; vb += gridDim.x) {
        const size_t row0 = (size_t)vb * 8;
        __syncthreads();
        for (int e = tid; e < 1024; e += NT) { const int q = e >> 7, r = e & 127; sg[e] = sigm(bf2f(LO[(row0 + q) * 512 + 256 + r])); }
        __syncthreads();
        float a0 = 0.f, a1 = 0.f, a2 = 0.f, a3 = 0.f, a4 = 0.f, a5 = 0.f, a6 = 0.f, a7 = 0.f;
#pragma unroll 4
        for (int r = 0; r < 128; ++r) { const float g = g2[r * 512 + tid];
            a0 += sg[r] * g; a1 += sg[128 + r] * g; a2 += sg[256 + r] * g; a3 += sg[384 + r] * g; a4 += sg[512 + r] * g; a5 += sg[640 + r] * g; a6 += sg[768 + r] * g; a7 += sg[896 + r] * g; }
#define MK_RP(q, aq) { const size_t rr = row0 + q; const float z = bf2f(Z[rr * 512 + tid]) + bf2f(Z[((size_t)NALL + rr) * 512 + tid]); Y[rr * D + tid] = f2bf(z * aq); }
        MK_RP(0, a0) MK_RP(1, a1) MK_RP(2, a2) MK_RP(3, a3) MK_RP(4, a4) MK_RP(5, a5) MK_RP(6, a6) MK_RP(7, a7)
#undef MK_RP
    }
    __syncthreads();
}
DI void phase_mlstm_scan(const P& p, LAS unsigned char* ldsb) {
    LAS float* lds = (LAS float*)ldsb;
    LAS float *Q = lds, *K = lds + 4096, *V = lds + 8192, *IG = lds + 12288, *FG = IG + 32;
    const int tid = threadIdx.x, vi = tid >> 2, kg = tid & 3;
    const bf16_t* ML = (const bf16_t*)(p.ws + WS_COLS) + OFF_ML; const bf16_t* LO = (const bf16_t*)(p.ws + WS_COLS) + OFF_LO; bf16_t* HB = (bf16_t*)(p.ws + WS_Z);
    for (int vb = blockIdx.x; vb < 32; vb += gridDim.x) {
        const int d = vb >> 4, b = (vb >> 2) & 3, hd = vb & 3;
        const float bi = p.in[I_MBI][d * 4 + hd], bfv = p.in[I_MBF][d * 4 + hd];
        float C[32], Nn[32];
#pragma unroll
        for (int c = 0; c < 32; ++c) { C[c] = 0.f; Nn[c] = 0.f; }
        for (int n0 = 0; n0 < LT; n0 += 32) {
            __syncthreads();
            for (int e = tid; e < 4096; e += NT) { const int s = e >> 7, c = e & 127; const size_t row = (size_t)step_row(d, b, n0 + s);
                Q[e] = bf2f(ML[row * 2048 + 128 * hd + c]) * 0.08838834764831845f; K[e] = bf2f(ML[row * 2048 + 512 + 128 * hd + c]); V[e] = bf2f(ML[row * 2048 + 1024 + 128 * hd + c]); }
            if (tid < 32) { const size_t row = (size_t)step_row(d, b, n0 + tid);
                IG[tid] = expf(bf2f(LO[row * 512 + 384 + 4 * d + hd]) + bi); FG[tid] = sigm(bf2f(LO[row * 512 + 392 + 4 * d + hd]) + bfv); }
            __syncthreads();
            for (int s = 0; s < 32; ++s) {
                const float f = FG[s], ig = IG[s], vv = V[s * 128 + vi] * ig;
                float num = 0.f, den = 0.f;
#pragma unroll
                for (int c4 = 0; c4 < 8; ++c4) { const f32x4 kk = *(const LAS f32x4*)(K + s * 128 + 32 * kg + 4 * c4), qq = *(const LAS f32x4*)(Q + s * 128 + 32 * kg + 4 * c4);
#pragma unroll
                    for (int j = 0; j < 4; ++j) { const int c = 4 * c4 + j; C[c] = f * C[c] + vv * kk[j]; Nn[c] = f * Nn[c] + ig * kk[j]; num += C[c] * qq[j]; den += Nn[c] * qq[j]; } }
                num += __shfl_xor(num, 1); num += __shfl_xor(num, 2); den += __shfl_xor(den, 1); den += __shfl_xor(den, 2);
                if (kg == 0) { const size_t row = (size_t)step_row(d, b, n0 + s); HB[((size_t)d * NALL + row) * 512 + 128 * hd + vi] = f2bf(num / fmaxf(fabsf(den), 1.f)); }
            }
        }
    }
    __syncthreads();
}
DI void post_headnorm_row(const bf16_t* HB, size_t row, const float* ng, const bf16_t* gsrc, int gate_kind, bf16_t* ydst, int lane) {
    const int c0 = 8 * lane;
    const u32x4 h0 = *(const u32x4*)(HB + row * 512 + c0), h1 = *(const u32x4*)(HB + ((size_t)NALL + row) * 512 + c0), gg = *(const u32x4*)(gsrc + c0);
    float h[8], g[8];
#pragma unroll
    for (int j = 0; j < 4; ++j) { h[2 * j] = __uint_as_float(h0[j] << 16) + __uint_as_float(h1[j] << 16); h[2 * j + 1] = __uint_as_float(h0[j] & 0xffff0000u) + __uint_as_float(h1[j] & 0xffff0000u);
        g[2 * j] = __uint_as_float(gg[j] << 16); g[2 * j + 1] = __uint_as_float(gg[j] & 0xffff0000u); }
    float ss = 0.f;
#pragma unroll
    for (int j = 0; j < 8; ++j) ss += h[j] * h[j];
    ss += __shfl_xor(ss, 1); ss += __shfl_xor(ss, 2); ss += __shfl_xor(ss, 4); ss += __shfl_xor(ss, 8);
    const float rinv = rsqrtf(ss * (1.f / 128.f) + 1e-6f);
    unsigned o[4];
#pragma unroll
    for (int j = 0; j < 4; ++j) { const float y0 = h[2 * j] * rinv * ng[c0 + 2 * j] * (gate_kind ? siluf(g[2 * j]) : sigm(g[2 * j])), y1 = h[2 * j + 1] * rinv * ng[c0 + 2 * j + 1] * (gate_kind ? siluf(g[2 * j + 1]) : sigm(g[2 * j + 1]));
        o[j] = (unsigned)f2bf(y0) | ((unsigned)f2bf(y1) << 16); }
    u32x4 w; w.x = o[0]; w.y = o[1]; w.z = o[2]; w.w = o[3];
    *(u32x4*)(ydst + c0) = w;
}
DI void phase_mlstm_post(const P& p) {
    const int lane = threadIdx.x & 63, wv = threadIdx.x >> 6;
    const bf16_t* ML = (const bf16_t*)(p.ws + WS_COLS) + OFF_ML; const bf16_t* HB = (const bf16_t*)(p.ws + WS_Z); bf16_t* Y = (bf16_t*)(p.ws + WS_ACT);
    for (int r = blockIdx.x * 8 + wv; r < NALL; r += gridDim.x * 8)
        post_headnorm_row(HB, (size_t)r, p.in[I_MNG], ML + (size_t)r * 2048 + 1536, 0, Y + (size_t)r * D + 512, lane);
}

constexpr int C1LD = 3584;
DI int nat_row(int r) { const int b = r / L, pp = r % L; return b * L + (pp % 128) * 64 + pp / 128; }
DI void phase_hgrn_scan(const P& p, LAS unsigned char* ldsb) {
    LAS float* lds = (LAS float*)ldsb;
    LAS float *Q = lds, *F = lds + 4096, *V = lds + 8192;
    const int tid = threadIdx.x, vi = tid >> 2, fq = tid & 3;
    const bf16_t* C1 = (const bf16_t*)(p.ws + WS_COLS); bf16_t* HB = (bf16_t*)(p.ws + WS_Z);
    for (int vb = blockIdx.x; vb < 32; vb += gridDim.x) {
        const int d = vb >> 4, b = (vb >> 2) & 3, hd = vb & 3;
        float S[32];
#pragma unroll
        for (int c = 0; c < 32; ++c) S[c] = 0.f;
        for (int n0 = 0; n0 < LT; n0 += 32) {
            __syncthreads();
            for (int e = tid; e < 4096; e += NT) { const int s = e >> 7, c = e & 127, ch = 128 * hd + c; const size_t row = (size_t)step_row(d, b, n0 + s);
                const float lb = sigm(p.in[I_HLB][512 + ch] - p.in[I_HLB][ch]);
                Q[e] = siluf(bf2f(C1[row * C1LD + ch])); F[e] = lb + (1.f - lb) * sigm(bf2f(C1[row * C1LD + 512 + 512 * d + ch])); V[e] = bf2f(C1[row * C1LD + 1536 + ch]); }
            __syncthreads();
            for (int s = 0; s < 32; ++s) {
                const float v = V[s * 128 + vi]; float o = 0.f;
#pragma unroll
                for (int c4 = 0; c4 < 8; ++c4) { const f32x4 ff = *(const LAS f32x4*)(F + s * 128 + 32 * fq + 4 * c4), qq = *(const LAS f32x4*)(Q + s * 128 + 32 * fq + 4 * c4);
#pragma unroll
                    for (int j = 0; j < 4; ++j) { const int c = 4 * c4 + j; S[c] = ff[j] * (S[c] - v) + v; o += S[c] * qq[j]; } }
                o += __shfl_xor(o, 1); o += __shfl_xor(o, 2);
                if (fq == 0) { const size_t row = (size_t)step_row(d, b, n0 + s); HB[((size_t)d * NALL + row) * 512 + 128 * hd + vi] = f2bf(o); }
            }
        }
    }
    __syncthreads();
}
DI void phase_hgrn_post(const P& p) {
    const int lane = threadIdx.x & 63, wv = threadIdx.x >> 6;
    const bf16_t* C1 = (const bf16_t*)(p.ws + WS_COLS); const bf16_t* HB = (const bf16_t*)(p.ws + WS_Z); bf16_t* Y = (bf16_t*)(p.ws + WS_ACT);
    for (int r = blockIdx.x * 8 + wv; r < NLAT; r += gridDim.x * 8)
        post_headnorm_row(HB, (size_t)r, p.in[I_HNG], C1 + (size_t)r * C1LD + 2048, 1, Y + (size_t)nat_row(r) * D, lane);
}
DI void phase_lru_scan(const P& p, LAS unsigned char* ldsb) {
    LAS float* lds = (LAS float*)ldsb;
    LAS float *XC = lds, *A = lds + 512, *U = lds + 1024;
    const int tid = threadIdx.x, j = tid & 63, tl = tid >> 6;
    const bf16_t* C1 = (const bf16_t*)(p.ws + WS_COLS); bf16_t* Z = (bf16_t*)(p.ws + WS_Z);
    for (int vb = blockIdx.x; vb < 64; vb += gridDim.x) {
        const int d = vb >> 5, b = (vb >> 3) & 3, hb = vb & 7, ch = 64 * hb + j;
        float wa[64], wi[64];
#pragma unroll
        for (int i = 0; i < 64; ++i) { wa[i] = p.in[I_WA][((size_t)(d * 8 + hb) * 64 + i) * 64 + j]; wi[i] = p.in[I_WI][((size_t)(d * 8 + hb) * 64 + i) * 64 + j]; }
        const float ba = p.in[I_BA][d * 512 + ch], bi = p.in[I_BI][d * 512 + ch], lam = p.in[I_LAM][d * 512 + ch];
        const float spl = log1pf(expf(-lam));
        const float cw0 = p.in[I_CONVW][ch], cw1 = p.in[I_CONVW][512 + ch], cw2 = p.in[I_CONVW][1024 + ch], cw3 = p.in[I_CONVW][1536 + ch], cb = p.in[I_CONVB][ch];
        float h = 0.f;
        for (int n0 = 0; n0 < LT; n0 += 8) {
            const int n = n0 + tl;
            int pos, seglen, base;
            if (n < LC) { pos = d ? LC - 1 - n : n; seglen = LC; base = NLAT + b * LC; } else { const int m = n - LC; pos = d ? L - 1 - m : m; seglen = L; base = b * L; }
            float xc = cb;
            { const int p0 = pos - 2, p1 = pos - 1, p3 = pos + 1;
              if (p0 >= 0) xc += cw0 * bf2f(C1[(size_t)(base + p0) * C1LD + 2560 + ch]);
              if (p1 >= 0) xc += cw1 * bf2f(C1[(size_t)(base + p1) * C1LD + 2560 + ch]);
              xc += cw2 * bf2f(C1[(size_t)(base + pos) * C1LD + 2560 + ch]);
              if (p3 < seglen) xc += cw3 * bf2f(C1[(size_t)(base + p3) * C1LD + 2560 + ch]); }
            __syncthreads();
            XC[tl * 64 + j] = xc;
            __syncthreads();
            float rp = ba, ip = bi;
#pragma unroll
            for (int i4 = 0; i4 < 16; ++i4) { const f32x4 x = *(const LAS f32x4*)(XC + tl * 64 + 4 * i4);
                rp += x[0] * wa[4 * i4] + x[1] * wa[4 * i4 + 1] + x[2] * wa[4 * i4 + 2] + x[3] * wa[4 * i4 + 3];
                ip += x[0] * wi[4 * i4] + x[1] * wi[4 * i4 + 1] + x[2] * wi[4 * i4 + 2] + x[3] * wi[4 * i4 + 3]; }
            const float r = sigm(rp), ig = sigm(ip), la = -8.f * r * spl;
            A[tl * 64 + j] = expf(la); U[tl * 64 + j] = sqrtf(-expm1f(2.f * la)) * (ig * xc);
            __syncthreads();
            if (tid < 64) {
#pragma unroll
                for (int s = 0; s < 8; ++s) { h = A[s * 64 + j] * h + U[s * 64 + j]; const size_t row = (size_t)step_row(d, b, n0 + s); Z[((size_t)d * NALL + row) * 512 + ch] = f2bf(h); }
            }
        }
    }
    __syncthreads();
}
DI void phase_lru_post(const P& p) {
    const int lane = threadIdx.x & 63, wv = threadIdx.x >> 6;
    const bf16_t* C1 = (const bf16_t*)(p.ws + WS_COLS); const bf16_t* Z = (const bf16_t*)(p.ws + WS_Z); bf16_t* Y = (bf16_t*)(p.ws + WS_ACT);
    for (int r = blockIdx.x * 8 + wv; r < NLAT; r += gridDim.x * 8) {
        const int c0 = 8 * lane; const size_t row = (size_t)r;
        const u32x4 h0 = *(const u32x4*)(Z + row * 512 + c0), h1 = *(const u32x4*)(Z + ((size_t)NALL + row) * 512 + c0), gg = *(const u32x4*)(C1 + row * C1LD + 3072 + c0);
        unsigned o[4];
#pragma unroll
        for (int q = 0; q < 4; ++q) { const float ha = __uint_as_float(h0[q] << 16) + __uint_as_float(h1[q] << 16), hb2 = __uint_as_float(h0[q] & 0xffff0000u) + __uint_as_float(h1[q] & 0xffff0000u);
            const float ga = __uint_as_float(gg[q] << 16), gb2 = __uint_as_float(gg[q] & 0xffff0000u);
            o[q] = (unsigned)f2bf(ha * geluf(ga)) | ((unsigned)f2bf(hb2 * geluf(gb2)) << 16); }
        u32x4 w; w.x = o[0]; w.y = o[1]; w.z = o[2]; w.w = o[3];
        *(u32x4*)(Y + (size_t)nat_row(r) * D + 512 + c0) = w;
    }
}

constexpr int N_PHASES = 22;
__global__ void __launch_bounds__(NT, 2) mk_fwd(P p) {
    extern __shared__ __attribute__((aligned(16))) unsigned char lds_raw[];
    LAS unsigned char* lds = (LAS unsigned char*)lds_raw;
    cooperative_groups::grid_group grid = cooperative_groups::this_grid();
    const int lo = p.ph_lo, hi = p.ph_hi;
#define IN(k) (lo <= (k) && (k) < hi)
#define SEAM(k) do { if (IN(k) && IN((k) + 1)) grid.sync(); } while (0)
    unsigned char* ws = p.ws;
    const float* MODV = (const float*)(ws + WS_MODV);
    float* HC = (float*)(ws + WS_HC);
    bf16_t* ACT = (bf16_t*)(ws + WS_ACT); bf16_t* COLS = (bf16_t*)(ws + WS_COLS);
    if (IN(0)) { phase_wprep(p, lds); phase_modv(p, lds); } SEAM(0);
    if (IN(1)) { phase_modnorm(p, 0, 0, p.in[I_X], p.in[I_CTX], NALL, false); } SEAM(1);
    if (IN(2)) { EpiStore3 E{COLS + OFF_RW, 1536, 6, COLS + OFF_LO, 512, 8, COLS + OFF_ML, 2048}; run_gemm(lds, ACT, (const bf16_t*)(ws + WS_W_EVIN), NALL, 4096, 1024, E); } SEAM(2);
    if (IN(3)) { phase_mlstm_scan(p, lds); } SEAM(3);
    if (IN(4)) { phase_mlstm_post(p); } SEAM(4);
    if (IN(5)) { phase_rwkv_scan(p, lds); } SEAM(5);
    if (IN(6)) { phase_rwkv_post(p, lds); } SEAM(6);
    if (IN(7)) { EpiResid E{p.in[I_X], p.out, p.in[I_CTX], HC, MODV, 2}; run_gemm(lds, ACT, (const bf16_t*)(ws + WS_W_EVOUT), NALL, 1024, 1024, E); } SEAM(7);
    if (IN(8)) { phase_modnorm(p, 0, 1, p.out, HC, NALL, false); } SEAM(8);
    if (IN(9)) { EpiSwiglu E{COLS}; run_gemm(lds, ACT, (const bf16_t*)(ws + WS_W_UP), NALL, 5632, 1024, E); } SEAM(9);
    if (IN(10)) { EpiResid E{p.out, p.out, HC, HC, MODV, 5}; run_gemm(lds, COLS, (const bf16_t*)(ws + WS_W_DN), NALL, 1024, 2816, E); } SEAM(10);
    if (IN(11)) { phase_modnorm(p, 1, 0, p.out, HC, NALL, true); } SEAM(11);
    if (IN(12)) { EpiStore3 E{COLS, C1LD, 1 << 30, COLS, C1LD, 1 << 30, COLS, C1LD}; run_gemm(lds, ACT, (const bf16_t*)(ws + WS_W_ODIN), NALL, 3584, 1024, E); } SEAM(12);
    if (IN(13)) { phase_hgrn_scan(p, lds); } SEAM(13);
    if (IN(14)) { phase_hgrn_post(p); } SEAM(14);
    if (IN(15)) { phase_lru_scan(p, lds); } SEAM(15);
    if (IN(16)) { phase_lru_post(p); } SEAM(16);
    if (IN(17)) { EpiResid E{p.out, p.out, HC, HC, MODV + 5 * 6144, 2}; run_gemm(lds, ACT, (const bf16_t*)(ws + WS_W_ODOUT), NLAT, 1024, 1024, E); } SEAM(17);
    if (IN(18)) { phase_modnorm(p, 1, 1, p.out, HC, NLAT, false); } SEAM(18);
    if (IN(19)) { EpiSwiglu E{COLS}; run_gemm(lds, ACT, (const bf16_t*)(ws + WS_W_UP) + W_UP_STRIDE, NLAT, 5632, 1024, E); } SEAM(19);
    if (IN(20)) { EpiResid E{p.out, p.out, HC, HC, MODV + 5 * 6144, 5}; run_gemm(lds, COLS, (const bf16_t*)(ws + WS_W_DN) + W_DN_STRIDE, NLAT, 1024, 2816, E); } SEAM(20);
    if (IN(21)) { phase_finalnorm(p); }
#undef IN
#undef SEAM
}
}

#ifndef MK_ONE_LAUNCH
#define MK_ONE_LAUNCH 1
#endif
extern "C" void kernel_launch(void* const* d_in, const int* in_sizes, int n_in, void* d_out, int out_size, void* d_ws, size_t ws_size, hipStream_t stream) {
    using namespace mk;
    static int grid = 0;
    if (grid == 0) {
        int dev = 0, cus = 0, per_cu = 0;
        if (n_in != N_IN || ws_size < WS_END) { fprintf(stderr, "kernel_launch: unexpected n_in %d / ws_size %zu\n", n_in, ws_size); grid = -1; return; }
        hipGetDevice(&dev); hipDeviceGetAttribute(&cus, hipDeviceAttributeMultiprocessorCount, dev);
        hipFuncSetAttribute((const void*)mk_fwd, hipFuncAttributeMaxDynamicSharedMemorySize, LDS_BYTES);
        hipOccupancyMaxActiveBlocksPerMultiprocessor(&per_cu, (const void*)mk_fwd, NT, LDS_BYTES);
        if (per_cu < 1) { fprintf(stderr, "kernel_launch: occupancy query says %d blocks per CU\n", per_cu); per_cu = 1; }
        (void)hipGetLastError();
        grid = cus;
    }
    if (grid < 0) return;
    P p{};
    for (int i = 0; i < N_IN; ++i) p.in[i] = (const float*)d_in[i];
    p.out = (float*)d_out; p.ws = (unsigned char*)d_ws;
#if MK_ONE_LAUNCH
    p.ph_lo = 0; p.ph_hi = N_PHASES;
    void* args[] = {&p};
    hipError_t e = hipLaunchCooperativeKernel((const void*)mk_fwd, dim3(grid), dim3(NT), args, LDS_BYTES, stream);
    if (e != hipSuccess) fprintf(stderr, "cooperative launch failed: %s (grid %d)\n", hipGetErrorString(e), grid);
#else
    for (int k = 0; k < N_PHASES; ++k) { p.ph_lo = k; p.ph_hi = k + 1; hipLaunchKernelGGL(mk_fwd, dim3(grid), dim3(NT), LDS_BYTES, stream, p); }
#endif
}
```

```cpp
#include <hip/hip_runtime.h>
#include <hip/hip_cooperative_groups.h>
#include <cstdio>
#include <cstdint>
namespace pg8 {
#define PG8_LAS __attribute__((address_space(3)))
typedef unsigned short bf16_t;
typedef short bf16x8 __attribute__((ext_vector_type(8)));
typedef float f32x4 __attribute__((ext_vector_type(4)));
typedef unsigned u32x4 __attribute__((ext_vector_type(4)));
constexpr int BM = 256, BK = 64, HALF = 128, HTB = HALF * BK * 2  , STAGE_BYTES = 8 * HTB, NXCD = 8, WGM = 8;

__host__ __device__ __forceinline__ int lds_byte(int r, int c) { const int st = (r >> 4) * 2 + (c >> 5), rr = r & 15, cc = c & 31, ob = rr * 64 + cc * 2; return st * 1024 + (ob ^ (((ob >> 9) & 1) << 5)); }
__host__ __device__ __forceinline__ void stage_rc(int b, int& R, int& C) { const int st = b / 1024, sb = b % 1024, swz = sb ^ (((sb >> 9) & 1) << 5); R = (st >> 1) * 16 + swz / 64; C = (st & 1) * 32 + (swz % 64) / 2; }
__host__ __device__ __forceinline__ int perm32(int rho) { const int n = rho >> 4, i = rho & 15; return 8 * (i >> 2) + 4 * n + (i & 3); }

struct Unit { int pm, pn; };
struct Gemm { const bf16_t* A; const bf16_t* Bt; int M, N, K; };

struct StaticOrder {
    int nM, nN, nwg, G, c;
    __host__ __device__ void init(int M, int N, int G_, int c_) { nM = M / BM; nN = N / BM; nwg = nM * nN; G = G_; c = c_; }
    __host__ __device__ bool next(int i, Unit& u) const {
        const long L = (long)i * G + c; if (L >= nwg) return false;
        int wgid = (int)L; { const int q = nwg / NXCD, r = nwg % NXCD, xcd = wgid % NXCD, off = wgid / NXCD; wgid = (xcd < r ? xcd * (q + 1) : r * (q + 1) + (xcd - r) * q) + off; }
        const int nig = WGM * nN, gid = wgid / nig, fm = gid * WGM, gsz = (nM - fm) < WGM ? (nM - fm) : WGM;
        u.pm = fm + ((wgid % nig) % gsz); u.pn = (wgid % nig) / gsz; return true;
    }
    __device__ __forceinline__ void a_ready(const Unit&) const {}
    __device__ __forceinline__ void done(const Unit&) const {}
};
__device__ __forceinline__ unsigned cvt_pk_bf16(float lo, float hi) { unsigned r; asm volatile("v_cvt_pk_bf16_f32 %0, %1, %2" : "=v"(r) : "v"(lo), "v"(hi)); return r; }
typedef float f32x2 __attribute__((ext_vector_type(2)));
template <class Epi, class Sched, bool STAMP = false>
__device__ __forceinline__ void gemm_phase(PG8_LAS unsigned char* lds, const Gemm g, const Sched& S, const Epi& E, unsigned long long* stamps) {
    const int tid = threadIdx.x, wid = __builtin_amdgcn_readfirstlane(tid >> 6), lane = tid & 63, wr = wid >> 2, wc = wid & 3, fr = lane & 15, fq = lane >> 4;
    const int K = g.K, nt = K / BK;
    int ts_lo = 0, ts_hi = 0, nts = 0; const unsigned long long rt_entry = STAMP ? (unsigned long long)wall_clock64() : 0ull;
#define PG8_STAMP() do { if (STAMP && wid == 0 && nts < 64) { const unsigned long long _c = (unsigned long long)clock64(); \
        ts_lo = (lane == nts) ? (int)(unsigned)_c : ts_lo; ts_hi = (lane == nts) ? (int)(unsigned)(_c >> 32) : ts_hi; ++nts; } } while (0)
    PG8_STAMP();
    unsigned voffA[2], voffB[2];
#pragma unroll
    for (int i = 0; i < 2; ++i) { int R, C; stage_rc(tid * 16 + i * 8192, R, C); const int Rb = Epi::PERM ? ((R & ~31) + perm32(R & 31)) : R;
        voffA[i] = (unsigned)(R * K + C) * 2u; voffB[i] = (unsigned)(Rb * K + C) * 2u; }
    const size_t kstep = (size_t)(BK * 2);
    const size_t hstep = (size_t)HALF * K * 2;
    const size_t tstep = 2 * hstep;
    const unsigned ldsw = (unsigned)wid * 1024u;
    const int aoff = lds_byte(wr * 64 + fr, fq * 8), boff = lds_byte(wc * 32 + fr, fq * 8);
#define PG8_SA(b, h) (((b) * 2 + (h)) * HTB)
#define PG8_SB(b, h) ((4 + (b) * 2 + (h)) * HTB)
#define PG8_STAGE(bufoff, gbase, voff) do { _Pragma("unroll") for (int _i = 0; _i < 2; ++_i) \
        __builtin_amdgcn_global_load_lds((const unsigned*)((const char*)(gbase) + (voff)[_i]), (PG8_LAS unsigned*)(lds + (bufoff) + ldsw + _i * 8192), 16, 0, 0); } while (0)
#define PG8_LDA(dst, b, h) do { _Pragma("unroll") for (int m = 0; m < 4; ++m) _Pragma("unroll") for (int k = 0; k < 2; ++k) dst[m][k] = *(const PG8_LAS bf16x8*)(lds + PG8_SA(b, h) + aoff + m * 2048 + k * 1024); } while (0)
#define PG8_LDB(dst, b, h) do { _Pragma("unroll") for (int n = 0; n < 2; ++n) _Pragma("unroll") for (int k = 0; k < 2; ++k) dst[n][k] = *(const PG8_LAS bf16x8*)(lds + PG8_SB(b, h) + boff + n * 2048 + k * 1024); } while (0)
#define PG8_MMA(ai, bj, At, Bt) do { __builtin_amdgcn_s_setprio(1); _Pragma("unroll") for (int m = 0; m < 4; ++m) _Pragma("unroll") for (int n = 0; n < 2; ++n) _Pragma("unroll") for (int k = 0; k < 2; ++k) \
        acc[ai][bj][m][n] = __builtin_amdgcn_mfma_f32_16x16x32_bf16(Bt[n][k], At[m][k], acc[ai][bj][m][n], 0, 0, 0); __builtin_amdgcn_s_setprio(0); } while (0)
#define PG8_WAIT_V(n) asm volatile("s_waitcnt vmcnt(" #n ")" ::: "memory")
#define PG8_WAIT_L(n) asm volatile("s_waitcnt lgkmcnt(" #n ")" ::: "memory")
#define PG8_BAR __builtin_amdgcn_s_barrier()
#define PG8_SCHED __builtin_amdgcn_sched_barrier(0)
    Unit cur, nxt; int ui = 0;
    if (!S.next(0, cur)) return;
    f32x4 acc[2][2][4][2];
#pragma unroll
    for (int a = 0; a < 2; ++a)
#pragma unroll
        for (int b = 0; b < 2; ++b)
#pragma unroll
            for (int m = 0; m < 4; ++m)
#pragma unroll
                for (int n = 0; n < 2; ++n) acc[a][b][m][n] = (f32x4){0.f, 0.f, 0.f, 0.f};
    bf16x8 At[4][2], B0[2][2], B1[2][2];
    const char* cA = (const char*)g.A + (size_t)cur.pm * tstep; const char* cB = (const char*)g.Bt + (size_t)cur.pn * tstep;
    S.a_ready(cur);
    PG8_STAGE(PG8_SB(0, 0), cB, voffB); PG8_STAGE(PG8_SA(0, 0), cA, voffA); PG8_STAGE(PG8_SB(0, 1), cB + hstep, voffB); PG8_STAGE(PG8_SA(0, 1), cA + hstep, voffA);
    if (wr == 1) PG8_BAR;
    PG8_WAIT_V(4); PG8_BAR;
    PG8_STAGE(PG8_SB(1, 0), cB + kstep, voffB); PG8_STAGE(PG8_SA(1, 0), cA + kstep, voffA); PG8_STAGE(PG8_SB(1, 1), cB + hstep + kstep, voffB);
    PG8_WAIT_V(6); PG8_BAR;
    PG8_STAMP();
    for (;;) {
        const bool has_next = S.next(ui + 1, nxt);
        const char* nA = has_next ? (const char*)g.A + (size_t)nxt.pm * tstep : cA; const char* nB = has_next ? (const char*)g.Bt + (size_t)nxt.pn * tstep : cB;
        for (int t = 0; t < nt; t += 2) {
            const bool last = (t == nt - 2);
            const char* a1 = cA + (size_t)(t + 1) * kstep;
            const char* a2 = last ? nA : cA + (size_t)(t + 2) * kstep; const char* b2 = last ? nB : cB + (size_t)(t + 2) * kstep;
            const char* a3 = a2 + kstep; const char* b3 = b2 + kstep;
            if (last && has_next) S.a_ready(nxt);
            PG8_LDB(B0, 0, 0); PG8_SCHED; PG8_LDA(At, 0, 0); PG8_STAGE(PG8_SA(1, 1), a1 + hstep, voffA);
            PG8_WAIT_L(8); PG8_BAR; PG8_WAIT_L(0); PG8_MMA(0, 0, At, B0); PG8_BAR; PG8_SCHED;
            PG8_LDB(B1, 0, 1); PG8_STAGE(PG8_SB(0, 0), b2, voffB);
            PG8_BAR; PG8_WAIT_L(0); PG8_MMA(0, 1, At, B1); PG8_BAR;
            PG8_LDA(At, 0, 1); PG8_STAGE(PG8_SA(0, 0), a2, voffA);
            PG8_BAR; PG8_WAIT_L(0); PG8_MMA(1, 0, At, B0); PG8_BAR; PG8_SCHED;
            PG8_STAGE(PG8_SB(0, 1), b2 + hstep, voffB);
            PG8_WAIT_V(6); PG8_BAR; PG8_MMA(1, 1, At, B1); PG8_BAR;
            PG8_LDB(B0, 1, 0); PG8_SCHED; PG8_LDA(At, 1, 0); PG8_STAGE(PG8_SA(0, 1), a2 + hstep, voffA);
            PG8_WAIT_L(8); PG8_BAR; PG8_WAIT_L(0); PG8_MMA(0, 0, At, B0); PG8_BAR; PG8_SCHED;
            PG8_LDB(B1, 1, 1); PG8_STAGE(PG8_SB(1, 0), b3, voffB);
            PG8_BAR; PG8_WAIT_L(0); PG8_MMA(0, 1, At, B1); PG8_BAR;
            PG8_LDA(At, 1, 1); PG8_STAGE(PG8_SA(1, 0), a3, voffA);
            PG8_BAR; PG8_WAIT_L(0); PG8_MMA(1, 0, At, B0); PG8_BAR; PG8_SCHED;
            PG8_STAGE(PG8_SB(1, 1), b3 + hstep, voffB);
            PG8_WAIT_V(6); PG8_BAR; PG8_MMA(1, 1, At, B1); PG8_BAR;
        }
        PG8_STAMP();
        if constexpr (!Epi::AFTER_DRAIN) { E(acc, cur, wr, wc, fr, fq); S.done(cur); }
        PG8_STAMP();
        if (!has_next) break;
#pragma unroll
        for (int a = 0; a < 2; ++a)
#pragma unroll
            for (int b = 0; b < 2; ++b)
#pragma unroll
                for (int m = 0; m < 4; ++m)
#pragma unroll
                    for (int n = 0; n < 2; ++n) acc[a][b][m][n] = (f32x4){0.f, 0.f, 0.f, 0.f};
        cur = nxt; cA = nA; cB = nB; ++ui;
    }
    PG8_WAIT_V(0);
    if (wr == 0) PG8_BAR;
    PG8_BAR;
    if constexpr (Epi::AFTER_DRAIN) { E.fused(acc, cur, wr, wc, fr, fq, lds, wid, lane); S.done(cur); }
    PG8_STAMP();
    if (STAMP && wid == 0) { stamps[lane] = lane < nts ? (((unsigned long long)(unsigned)ts_hi << 32) | (unsigned)ts_lo) : 0ull;
        if (lane == 62) stamps[62] = rt_entry; if (lane == 63) stamps[63] = (unsigned long long)wall_clock64(); }
#undef PG8_STAMP
#undef PG8_SA
#undef PG8_SB
#undef PG8_STAGE
#undef PG8_LDA
#undef PG8_LDB
#undef PG8_MMA
#undef PG8_WAIT_V
#undef PG8_WAIT_L
#undef PG8_BAR
#undef PG8_SCHED
}
}

namespace mk {
#define DI __device__ __forceinline__
#define LAS __attribute__((address_space(3)))
typedef unsigned short bf16_t;
typedef float f32x4 __attribute__((ext_vector_type(4)));
typedef unsigned u32x2 __attribute__((ext_vector_type(2)));
typedef unsigned u32x4 __attribute__((ext_vector_type(4)));

constexpr int D = 1024, NB = 4, L = 8192, LC = 256, NLAT = NB * L, NCTX = NB * LC, NALL = NLAT + NCTX, LT = L + LC, DFF = 2816;
constexpr int NT = 512;
constexpr size_t MiB = (size_t)1 << 20;
constexpr size_t WS_CTL = 0, WS_MODV = 1 * MiB, WS_HC = 2 * MiB, WS_W_EVIN = 6 * MiB, WS_W_EVOUT = 14 * MiB, WS_W_ODIN = 16 * MiB, WS_W_ODOUT = 23 * MiB,
                 WS_W_UP = 25 * MiB, WS_W_DN = 47 * MiB, WS_ACT = 58 * MiB, WS_COLS = 124 * MiB, WS_Z = 388 * MiB, WS_Z1 = 454 * MiB, WS_LAM = 486 * MiB, WS_END = 489 * MiB;
constexpr size_t W_UP_STRIDE = (size_t)5632 * 1024, W_DN_STRIDE = (size_t)1024 * 2816;
constexpr size_t OFF_RW = 0, OFF_LO = (size_t)NALL * 1536, OFF_ML = OFF_LO + (size_t)NALL * 512;
constexpr int LDS_BYTES = 147456;
constexpr int C1LD = 3584;
DI int nat_row(int r) { const int b = r / L, pp = r % L; return b * L + (pp % 128) * 64 + pp / 128; }

enum { I_X = 0, I_C, I_CTX, I_CCTX, I_N1G, I_N2G, I_MODW, I_MODB, I_W1, I_W3, I_W2, I_FING, I_EVIN, I_EVOUT, I_MU, I_W0, I_W2L, I_A0, I_A2L, I_KK, I_KA, I_RK,
       I_LNW, I_LNB, I_G2, I_MBI, I_MBF, I_MNG, I_ODIN, I_ODOUT, I_HLB, I_HNG, I_CONVW, I_CONVB, I_WA, I_BA, I_WI, I_BI, I_LAM, N_IN };

struct P { const float* in[N_IN]; float* out; unsigned char* ws; int ph_lo, ph_hi; };

DI float bf2f(bf16_t v) { return __uint_as_float(((unsigned)v) << 16); }
DI bf16_t f2bf(float f) { unsigned u = __float_as_uint(f); u += 0x7fffu + ((u >> 16) & 1u); return (bf16_t)(u >> 16); }
DI float sigm(float x) { return 1.f / (1.f + expf(-x)); }
DI float siluf(float x) { return x * sigm(x); }
DI float geluf(float x) { return 0.5f * x * (1.f + tanhf(0.7978845608028654f * (x + 0.044715f * x * x * x))); }
DI float wave_sum(float v) {
#pragma unroll
    for (int o = 32; o >= 1; o >>= 1) v += __shfl_xor(v, o);
    return v;
}
DI int step_row(int d, int b, int n) {
    if (n < LC) return NLAT + b * LC + (d ? LC - 1 - n : n);
    const int m = n - LC; return b * L + (d ? L - 1 - m : m);
}

DI int matN(int m) { return m == 0 ? 4096 : m == 1 ? 1024 : m == 2 ? 3584 : m == 3 ? 1024 : m < 6 ? 5632 : 1024; }
DI int matK(int m) { return m < 6 ? 1024 : 2816; }
DI int matTile0(int m) { return m == 0 ? 0 : m == 1 ? 1024 : m == 2 ? 1280 : m == 3 ? 2176 : m == 4 ? 2432 : m == 5 ? 3840 : m == 6 ? 5248 : m == 7 ? 5952 : 6656; }
DI size_t matOff(int m) { return m == 0 ? WS_W_EVIN : m == 1 ? WS_W_EVOUT : m == 2 ? WS_W_ODIN : m == 3 ? WS_W_ODOUT : m == 4 ? WS_W_UP : m == 5 ? WS_W_UP + W_UP_STRIDE * 2 : m == 6 ? WS_W_DN : WS_W_DN + W_DN_STRIDE * 2; }
DI const float* matSrc(const P& p, int m, int n, int& ld) {
    if (m == 0) { ld = 3984; int col; if (n < 1920) col = n; else if (n < 1936) col = 3968 + (n - 1920); else if (n < 2048) return nullptr; else col = 1920 + (n - 2048); return p.in[I_EVIN] + col; }
    if (m == 1) { ld = 1024; return p.in[I_EVOUT] + n; }
    if (m == 2) { ld = 3584; return p.in[I_ODIN] + n; }
    if (m == 3) { ld = 1024; return p.in[I_ODOUT] + n; }
    if (m < 6) { ld = 2816; const int l = m - 4, pn = n >> 8, w = n & 255; const size_t lo = (size_t)l * 1024 * 2816; return (w < 128) ? p.in[I_W1] + lo + 128 * pn + w : p.in[I_W3] + lo + 128 * pn + (w - 128); }
    ld = 1024; return p.in[I_W2] + (size_t)(m - 6) * 2816 * 1024 + n;
}
DI void phase_wprep(const P& p, LAS unsigned char* ldsb) {
    LAS float* tile = (LAS float*)ldsb;
    const int tid = threadIdx.x, tx = tid & 63, ty = tid >> 6;
    for (int item = blockIdx.x; item < 6656; item += gridDim.x) {
        int m = 0;
#pragma unroll
        for (int q = 1; q < 8; ++q) if (item >= matTile0(q)) m = q;
        const int local = item - matTile0(m), K = matK(m), nK = K >> 6, nb = local / nK, kb = local - nb * nK, n0 = nb * 64, k0 = kb * 64;
        bf16_t* Bt = (bf16_t*)(p.ws + matOff(m));
        int ld; const float* src = matSrc(p, m, n0 + tx, ld);
        __syncthreads();
#pragma unroll
        for (int i = 0; i < 8; ++i) { const int k = k0 + ty + 8 * i; tile[(ty + 8 * i) * 65 + tx] = src ? src[(size_t)k * ld] : 0.f; }
        __syncthreads();
#pragma unroll
        for (int i = 0; i < 8; ++i) { const int nn = ty + 8 * i; Bt[(size_t)(n0 + nn) * K + k0 + tx] = f2bf(tile[tx * 65 + nn]); }
    }
    __syncthreads();
}
DI void phase_modv(const P& p, LAS unsigned char* ldsb) {
    LAS float* sc = (LAS float*)ldsb;
    const int tid = threadIdx.x;
    float* MODV = (float*)(p.ws + WS_MODV);
    __syncthreads();
    for (int e = tid; e < 5 * 1024; e += NT) { const int s = e >> 10, k = e & 1023; const float v = (s < 4) ? p.in[I_C][s * 1024 + k] : p.in[I_CCTX][k]; sc[e] = siluf(v); }
    __syncthreads();
    for (int vb = blockIdx.x; vb < 24; vb += gridDim.x) {
        const int l = vb / 12, n = (vb % 12) * 512 + tid;
        const float* W = p.in[I_MODW] + (size_t)l * 1024 * 6144 + n;
        float a0 = 0.f, a1 = 0.f, a2 = 0.f, a3 = 0.f, a4 = 0.f;
#pragma unroll 8
        for (int k = 0; k < 1024; ++k) { const float w = W[(size_t)k * 6144]; a0 += sc[k] * w; a1 += sc[1024 + k] * w; a2 += sc[2048 + k] * w; a3 += sc[3072 + k] * w; a4 += sc[4096 + k] * w; }
        const float bb = p.in[I_MODB][l * 6144 + n];
        float* o = MODV + (size_t)l * 5 * 6144 + n;
        o[0] = a0 + bb; o[6144] = a1 + bb; o[2 * 6144] = a2 + bb; o[3 * 6144] = a3 + bb; o[4 * 6144] = a4 + bb;
    }
    __syncthreads();
}

DI void phase_modnorm(const P& p, int layer, int which, const float* hlat, const float* hctx, int nrows, bool permute) {
    const int lane = threadIdx.x & 63, wv = threadIdx.x >> 6;
    const float* MODV = (const float*)(p.ws + WS_MODV) + (size_t)layer * 5 * 6144;
    const float* g = p.in[which ? I_N2G : I_N1G] + layer * 1024;
    bf16_t* ACT = (bf16_t*)(p.ws + WS_ACT);
    for (int r = blockIdx.x * 8 + wv; r < nrows; r += gridDim.x * 8) {
        const bool isctx = r >= NLAT;
        const float* src = isctx ? hctx + (size_t)(r - NLAT) * D : hlat + (size_t)r * D;
        const int sv = isctx ? 4 : r / L;
        const float* shift = MODV + sv * 6144 + (which ? 3 : 0) * 1024; const float* scale = shift + 1024;
        int dr = r;
        if (permute && !isctx) { const int b = r / L, t = r % L; dr = b * L + (t % 64) * 128 + t / 64; }
        f32x4 v[4]; float ss = 0.f;
#pragma unroll
        for (int j = 0; j < 4; ++j) { v[j] = *(const f32x4*)(src + 4 * lane + 256 * j); ss += v[j].x * v[j].x + v[j].y * v[j].y + v[j].z * v[j].z + v[j].w * v[j].w; }
        const float rinv = rsqrtf(wave_sum(ss) * (1.f / D) + 1e-6f);
#pragma unroll
        for (int j = 0; j < 4; ++j) { const int c = 4 * lane + 256 * j;
            const f32x4 gg = *(const f32x4*)(g + c), sc = *(const f32x4*)(scale + c), sh = *(const f32x4*)(shift + c);
            const float o0 = v[j].x * rinv * gg.x * (1.f + sc.x) + sh.x, o1 = v[j].y * rinv * gg.y * (1.f + sc.y) + sh.y, o2 = v[j].z * rinv * gg.z * (1.f + sc.z) + sh.z, o3 = v[j].w * rinv * gg.w * (1.f + sc.w) + sh.w;
            u32x2 w; w.x = (unsigned)f2bf(o0) | ((unsigned)f2bf(o1) << 16); w.y = (unsigned)f2bf(o2) | ((unsigned)f2bf(o3) << 16);
            *(u32x2*)(ACT + (size_t)dr * D + c) = w; }
    }
}
DI void phase_finalnorm(const P& p) {
    const int lane = threadIdx.x & 63, wv = threadIdx.x >> 6;
    const float* g = p.in[I_FING];
    for (int r = blockIdx.x * 8 + wv; r < NLAT; r += gridDim.x * 8) {
        float* src = p.out + (size_t)r * D;
        f32x4 v[4]; float ss = 0.f;
#pragma unroll
        for (int j = 0; j < 4; ++j) { v[j] = *(const f32x4*)(src + 4 * lane + 256 * j); ss += v[j].x * v[j].x + v[j].y * v[j].y + v[j].z * v[j].z + v[j].w * v[j].w; }
        const float rinv = rsqrtf(wave_sum(ss) * (1.f / D) + 1e-6f);
#pragma unroll
        for (int j = 0; j < 4; ++j) { const int c = 4 * lane + 256 * j; const f32x4 gg = *(const f32x4*)(g + c);
            f32x4 o; o.x = v[j].x * rinv * gg.x; o.y = v[j].y * rinv * gg.y; o.z = v[j].z * rinv * gg.z; o.w = v[j].w * rinv * gg.w; *(f32x4*)(src + c) = o; }
    }
}

struct EpiStore3 {
    static constexpr bool PERM = false, AFTER_DRAIN = false;
    bf16_t* p0; int ld0; int pn1; bf16_t* p1; int ld1; int pn2; bf16_t* p2; int ld2;
    DI void operator()(const f32x4 (&acc)[2][2][4][2], const pg8::Unit& u, int wr, int wc, int fr, int fq) const {
        bf16_t* base; int ld, ct;
        if (u.pn >= pn2) { base = p2; ld = ld2; ct = u.pn - pn2; } else if (u.pn >= pn1) { base = p1; ld = ld1; ct = u.pn - pn1; } else { base = p0; ld = ld0; ct = u.pn; }
        const int row0 = u.pm * 256 + wr * 64 + fr, col0 = ct * 256 + wc * 32 + 4 * fq;
#pragma unroll
        for (int ai = 0; ai < 2; ++ai)
#pragma unroll
            for (int m = 0; m < 4; ++m) { bf16_t* rowp = base + (size_t)(row0 + ai * 128 + m * 16) * ld + col0;
#pragma unroll
                for (int bj = 0; bj < 2; ++bj)
#pragma unroll
                    for (int n = 0; n < 2; ++n) { const f32x4 v = acc[ai][bj][m][n]; u32x2 w; w.x = pg8::cvt_pk_bf16(v[0], v[1]); w.y = pg8::cvt_pk_bf16(v[2], v[3]); *(u32x2*)(rowp + bj * 128 + n * 16) = w; } }
    }
};
struct EpiResid {
    static constexpr bool PERM = false, AFTER_DRAIN = false;
    const float* hin; float* hout; const float* cin; float* cout; const float* modv_l; int gidx;
    DI void operator()(const f32x4 (&acc)[2][2][4][2], const pg8::Unit& u, int wr, int wc, int fr, int fq) const {
        const bool isctx = u.pm >= 128; const int sv = isctx ? 4 : (u.pm >> 5);
        const float* gate = modv_l + sv * 6144 + gidx * 1024;
        const float* bi = isctx ? cin : hin; float* bo = isctx ? cout : hout;
        const int row0 = (isctx ? (u.pm - 128) : u.pm) * 256 + wr * 64 + fr, col0 = u.pn * 256 + wc * 32 + 4 * fq;
        f32x4 gv[2][2];
#pragma unroll
        for (int bj = 0; bj < 2; ++bj)
#pragma unroll
            for (int n = 0; n < 2; ++n) gv[bj][n] = *(const f32x4*)(gate + col0 + bj * 128 + n * 16);
#pragma unroll
        for (int ai = 0; ai < 2; ++ai)
#pragma unroll
            for (int m = 0; m < 4; ++m) { const size_t off = (size_t)(row0 + ai * 128 + m * 16) * D + col0;
#pragma unroll
                for (int bj = 0; bj < 2; ++bj)
#pragma unroll
                    for (int n = 0; n < 2; ++n) { const f32x4 bs = *(const f32x4*)(bi + off + bj * 128 + n * 16); *(f32x4*)(bo + off + bj * 128 + n * 16) = bs + gv[bj][n] * acc[ai][bj][m][n]; } }
    }
};
struct EpiSwiglu {
    static constexpr bool PERM = false, AFTER_DRAIN = false;
    bf16_t* G;
    DI void operator()(const f32x4 (&acc)[2][2][4][2], const pg8::Unit& u, int wr, int wc, int fr, int fq) const {
        const int row0 = u.pm * 256 + wr * 64 + fr, col0 = u.pn * 128 + wc * 32 + 4 * fq;
#pragma unroll
        for (int ai = 0; ai < 2; ++ai)
#pragma unroll
            for (int m = 0; m < 4; ++m) { bf16_t* rowp = G + (size_t)(row0 + ai * 128 + m * 16) * DFF + col0;
#pragma unroll
                for (int n = 0; n < 2; ++n) { const f32x4 a = acc[ai][0][m][n], b = acc[ai][1][m][n];
                    const float g0 = a[0] / (1.f + __expf(-a[0])) * b[0], g1 = a[1] / (1.f + __expf(-a[1])) * b[1], g2 = a[2] / (1.f + __expf(-a[2])) * b[2], g3 = a[3] / (1.f + __expf(-a[3])) * b[3];
                    u32x2 w; w.x = pg8::cvt_pk_bf16(g0, g1); w.y = pg8::cvt_pk_bf16(g2, g3); *(u32x2*)(rowp + n * 16) = w; } }
    }
};
template <class Epi> DI void run_gemm(LAS unsigned char* lds, const bf16_t* A, const bf16_t* Bt, int M, int N, int K, const Epi& E) {
    pg8::Gemm g{A, Bt, M, N, K}; pg8::StaticOrder S; S.init(M, N, (int)gridDim.x, (int)blockIdx.x);
    pg8::gemm_phase<Epi, pg8::StaticOrder, false>((PG8_LAS unsigned char*)lds, g, S, E, nullptr);
    __syncthreads();
}

DI void phase_rwkv_scan_unit(const P& p, LAS unsigned char* ldsb, const int vb) {
    LAS float* lds = (LAS float*)ldsb;
    LAS float *w2s = lds, *a2s = lds + 4096, *prm = lds + 8192, *TH = prm + 768, *AD = TH + 2048, *R = AD + 2048, *W = R + 2048, *K = W + 2048, *KK = K + 2048, *BV = KK + 2048,
              *V = BV + 2048, *BS = V + 2048, *OUT = BS + 32;
    const int tid = threadIdx.x, lane = tid & 63, wv = tid >> 6;
    const bf16_t* RW = (const bf16_t*)(p.ws + WS_COLS) + OFF_RW; const bf16_t* LO = (const bf16_t*)(p.ws + WS_COLS) + OFF_LO; bf16_t* Z = (bf16_t*)(p.ws + WS_Z);
    const int srow = tid >> 3, sg = tid & 7;
    {
        const int d = vb >> 5, b = (vb >> 3) & 3, h = vb & 7;
        __syncthreads();
        for (int e = tid; e < 4096; e += NT) { const int i = e >> 6, c = e & 63; w2s[e] = p.in[I_W2L][(size_t)(d * 64 + i) * 512 + 64 * h + c]; a2s[e] = p.in[I_A2L][(size_t)(d * 64 + i) * 512 + 64 * h + c]; }
        if (tid < 64) { const int j = tid, c = 64 * h + j; const float* mu = p.in[I_MU] + d * 1664;
            prm[j] = mu[c]; prm[64 + j] = mu[512 + c]; prm[128 + j] = mu[1024 + c]; prm[192 + j] = mu[1536 + j]; prm[256 + j] = mu[1600 + j];
            prm[320 + j] = p.in[I_W0][d * 512 + c]; prm[384 + j] = p.in[I_A0][d * 512 + c]; prm[448 + j] = p.in[I_KK][d * 512 + c]; prm[512 + j] = p.in[I_KA][d * 512 + c];
            prm[576 + j] = p.in[I_RK][(d * 8 + h) * 64 + j]; prm[640 + j] = p.in[I_LNW][d * 512 + c]; prm[704 + j] = p.in[I_LNB][d * 512 + c]; }
        __syncthreads();
        float S0 = 0.f, S1 = 0.f, S2 = 0.f, S3 = 0.f, S4 = 0.f, S5 = 0.f, S6 = 0.f, S7 = 0.f;
        for (int n0 = 0; n0 < LT; n0 += 32) {
            float rs[4], ks[4], vs[4];
#pragma unroll
            for (int m = 0; m < 4; ++m) { const int s = wv + 8 * m, n = n0 + s; const bool hp = (n != 0) && (n != LC);
                const size_t row = (size_t)step_row(d, b, n), prow = hp ? (size_t)step_row(d, b, n - 1) : row; const int c = 64 * h + lane;
                const float r0 = bf2f(RW[row * 1536 + c]), k0 = bf2f(RW[row * 1536 + 512 + c]), v0 = bf2f(RW[row * 1536 + 1024 + c]);
                const float r1 = hp ? bf2f(RW[prow * 1536 + c]) : 0.f, k1 = hp ? bf2f(RW[prow * 1536 + 512 + c]) : 0.f, v1 = hp ? bf2f(RW[prow * 1536 + 1024 + c]) : 0.f;
                rs[m] = r0 + prm[lane] * (r1 - r0); ks[m] = k0 + prm[64 + lane] * (k1 - k0); vs[m] = v0 + prm[128 + lane] * (v1 - v0);
                const float wd0 = bf2f(LO[row * 512 + 64 * d + lane]), wd1 = hp ? bf2f(LO[prow * 512 + 64 * d + lane]) : 0.f;
                const float ad0 = bf2f(LO[row * 512 + 128 + 64 * d + lane]), ad1 = hp ? bf2f(LO[prow * 512 + 128 + 64 * d + lane]) : 0.f;
                TH[s * 64 + lane] = tanhf(wd0 + prm[192 + lane] * (wd1 - wd0)); AD[s * 64 + lane] = ad0 + prm[256 + lane] * (ad1 - ad0); }
            __syncthreads();
#pragma unroll
            for (int m = 0; m < 4; ++m) { const int s = wv + 8 * m;
                float xw = prm[320 + lane], xa = prm[384 + lane];
#pragma unroll 8
                for (int i = 0; i < 64; ++i) { xw += TH[s * 64 + i] * w2s[i * 64 + lane]; xa += AD[s * 64 + i] * a2s[i * 64 + lane]; }
                const float elog = 0.6065306597126334f * sigm(xw), dec = expf(-elog), a = sigm(xa);
                const float kkr = ks[m] * prm[448 + lane]; const float ss = wave_sum(kkr * kkr); const float kkn = kkr / fmaxf(sqrtf(ss), 1e-12f);
                const float km = ks[m] * (1.f + (a - 1.f) * prm[512 + lane]);
                const float bs = wave_sum(rs[m] * km * prm[576 + lane]);
                R[s * 64 + lane] = rs[m]; W[s * 64 + lane] = dec; K[s * 64 + lane] = km; KK[s * 64 + lane] = kkn; BV[s * 64 + lane] = kkn * a; V[s * 64 + lane] = vs[m];
                if (lane == 0) BS[s] = bs; }
            __syncthreads();
            for (int s = 0; s < 32; ++s) {
                const LAS f32x4* pq = (const LAS f32x4*)(KK + s * 64 + 8 * sg); const f32x4 q0 = pq[0], q1 = pq[1];
                const LAS f32x4* pw = (const LAS f32x4*)(W + s * 64 + 8 * sg); const f32x4 w0 = pw[0], w1 = pw[1];
                const LAS f32x4* pb = (const LAS f32x4*)(BV + s * 64 + 8 * sg); const f32x4 b0 = pb[0], b1 = pb[1];
                const LAS f32x4* pk = (const LAS f32x4*)(K + s * 64 + 8 * sg); const f32x4 k0 = pk[0], k1 = pk[1];
                const LAS f32x4* pr = (const LAS f32x4*)(R + s * 64 + 8 * sg); const f32x4 r0 = pr[0], r1 = pr[1];
                const float vi = V[s * 64 + srow];
                float sa = S0 * q0.x + S1 * q0.y + S2 * q0.z + S3 * q0.w + S4 * q1.x + S5 * q1.y + S6 * q1.z + S7 * q1.w;
                sa += __shfl_xor(sa, 1); sa += __shfl_xor(sa, 2); sa += __shfl_xor(sa, 4);
                S0 = S0 * w0.x - sa * b0.x + vi * k0.x; S1 = S1 * w0.y - sa * b0.y + vi * k0.y; S2 = S2 * w0.z - sa * b0.z + vi * k0.z; S3 = S3 * w0.w - sa * b0.w + vi * k0.w;
                S4 = S4 * w1.x - sa * b1.x + vi * k1.x; S5 = S5 * w1.y - sa * b1.y + vi * k1.y; S6 = S6 * w1.z - sa * b1.z + vi * k1.z; S7 = S7 * w1.w - sa * b1.w + vi * k1.w;
                float o = S0 * r0.x + S1 * r0.y + S2 * r0.z + S3 * r0.w + S4 * r1.x + S5 * r1.y + S6 * r1.z + S7 * r1.w;
                o += __shfl_xor(o, 1); o += __shfl_xor(o, 2); o += __shfl_xor(o, 4);
                if (sg == 0) OUT[s * 64 + srow] = o;
            }
            __syncthreads();
#pragma unroll
            for (int m = 0; m < 4; ++m) { const int s = wv + 8 * m, n = n0 + s; const size_t row = (size_t)step_row(d, b, n);
                const float o = OUT[s * 64 + lane]; const float mean = wave_sum(o) * (1.f / 64.f); const float dv = o - mean; const float var = wave_sum(dv * dv) * (1.f / 64.f);
                const float z = dv * rsqrtf(var + 64e-5f) * prm[640 + lane] + prm[704 + lane] + BS[s] * V[s * 64 + lane];
                Z[((size_t)d * NALL + row) * 512 + 64 * h + lane] = f2bf(z); }
        }
    }
    __syncthreads();
}
DI void phase_rwkv_post(const P& p, LAS unsigned char* ldsb) {
    LAS float* sg = (LAS float*)ldsb;
    const int tid = threadIdx.x;
    const bf16_t* LO = (const bf16_t*)(p.ws + WS_COLS) + OFF_LO; const bf16_t* Z = (const bf16_t*)(p.ws + WS_Z); bf16_t* Y = (bf16_t*)(p.ws + WS_COLS);
    const float* g2 = p.in[I_G2];
    for (int vb = blockIdx.x; vb < NALL / 8; vb += gridDim.x) {
        const size_t row0 = (size_t)vb * 8;
        __syncthreads();
        for (int e = tid; e < 1024; e += NT) { const int q = e >> 7, r = e & 127; sg[e] = sigm(bf2f(LO[(row0 + q) * 512 + 256 + r])); }
        __syncthreads();
        float a0 = 0.f, a1 = 0.f, a2 = 0.f, a3 = 0.f, a4 = 0.f, a5 = 0.f, a6 = 0.f, a7 = 0.f;
#pragma unroll 4
        for (int r = 0; r < 128; ++r) { const float g = g2[r * 512 + tid];
            a0 += sg[r] * g; a1 += sg[128 + r] * g; a2 += sg[256 + r] * g; a3 += sg[384 + r] * g; a4 += sg[512 + r] * g; a5 += sg[640 + r] * g; a6 += sg[768 + r] * g; a7 += sg[896 + r] * g; }
#define MK_RP(q, aq) { const size_t rr = row0 + q; const float z = bf2f(Z[rr * 512 + tid]) + bf2f(Z[((size_t)NALL + rr) * 512 + tid]); Y[rr * D + tid] = f2bf(z * aq); }
        MK_RP(0, a0) MK_RP(1, a1) MK_RP(2, a2) MK_RP(3, a3) MK_RP(4, a4) MK_RP(5, a5) MK_RP(6, a6) MK_RP(7, a7)
#undef MK_RP
    }
    __syncthreads();
}
DI void post_headnorm_row(const bf16_t* HB, size_t row, const float* ng, const bf16_t* gsrc, int gate_kind, bf16_t* ydst, int lane) {
    const int c0 = 8 * lane;
    const u32x4 h0 = *(const u32x4*)(HB + row * 512 + c0), h1 = *(const u32x4*)(HB + ((size_t)NALL + row) * 512 + c0), gg = *(const u32x4*)(gsrc + c0);
    float h[8], g[8];
#pragma unroll
    for (int j = 0; j < 4; ++j) { h[2 * j] = __uint_as_float(h0[j] << 16) + __uint_as_float(h1[j] << 16); h[2 * j + 1] = __uint_as_float(h0[j] & 0xffff0000u) + __uint_as_float(h1[j] & 0xffff0000u);
        g[2 * j] = __uint_as_float(gg[j] << 16); g[2 * j + 1] = __uint_as_float(gg[j] & 0xffff0000u); }
    float ss = 0.f;
#pragma unroll
    for (int j = 0; j < 8; ++j) ss += h[j] * h[j];
    ss += __shfl_xor(ss, 1); ss += __shfl_xor(ss, 2); ss += __shfl_xor(ss, 4); ss += __shfl_xor(ss, 8);
    const float rinv = rsqrtf(ss * (1.f / 128.f) + 1e-6f);
    unsigned o[4];
#pragma unroll
    for (int j = 0; j < 4; ++j) { const float y0 = h[2 * j] * rinv * ng[c0 + 2 * j] * (gate_kind ? siluf(g[2 * j]) : sigm(g[2 * j])), y1 = h[2 * j + 1] * rinv * ng[c0 + 2 * j + 1] * (gate_kind ? siluf(g[2 * j + 1]) : sigm(g[2 * j + 1]));
        o[j] = (unsigned)f2bf(y0) | ((unsigned)f2bf(y1) << 16); }
    u32x4 w; w.x = o[0]; w.y = o[1]; w.z = o[2]; w.w = o[3];
    *(u32x4*)(ydst + c0) = w;
}
typedef short bf16x8 __attribute__((ext_vector_type(8)));
typedef short s16x4 __attribute__((ext_vector_type(4)));
constexpr int PQ = 136, PS = 72, PV = 56;
constexpr int E_QS = 0, E_KS = E_QS + 64 * PQ * 2, E_VS = E_KS + 64 * PQ * 2, E_PS = E_VS + 64 * PV * 2, E_ST = E_PS + 64 * PS * 2, E_F = E_ST + 48 * PQ * 2, E_END = E_F + 1024;
constexpr size_t WS_Q1 = WS_COLS + (size_t)231 * MiB;
constexpr int NRC = NALL / 64;

DI int chunk_row0(int d, int b, int ci) {
    if (ci < 4) { const int cc = d ? 3 - ci : ci; return NLAT + b * LC + 64 * cc; }
    const int lc = ci - 4, cl = d ? 127 - lc : lc; return b * L + 64 * cl;
}
DI unsigned pack2(float lo, float hi) { return (unsigned)f2bf(lo) | ((unsigned)f2bf(hi) << 16); }
DI bf16x8 tr_frag(unsigned tile_base, int pitch, int k0, int c0, int r, int q) {
    const unsigned a0 = tile_base + (unsigned)(((k0 + 8 * q + (r >> 2)) * pitch + c0 + 4 * (r & 3)) * 2), a1 = a0 + (unsigned)(4 * pitch * 2);
    s16x4 x, y;
    asm volatile("ds_read_b64_tr_b16 %0, %2\n\tds_read_b64_tr_b16 %1, %3\n\ts_waitcnt lgkmcnt(0)" : "=&v"(x), "=&v"(y) : "v"(a0), "v"(a1) : "memory");
    bf16x8 o; o[0] = x[0]; o[1] = x[1]; o[2] = x[2]; o[3] = x[3]; o[4] = y[0]; o[5] = y[1]; o[6] = y[2]; o[7] = y[3];
    return o;
}

#define GLA_PREFETCH(ci_) do { const int row0_ = chunk_row0(d, b, (ci_)); \
    _Pragma("unroll") for (int i = 0; i < 2; ++i) { const size_t row_ = (size_t)(row0_ + prow0 + 32 * i); \
        rq[i] = *(const u32x4*)(Qg + row_ * ldq + 8 * ppc); rk[i] = *(const u32x4*)(Kg + row_ * ldk + 8 * ppc); } \
    if (tid < 256) rv = *(const u32x4*)(Vg + (size_t)(row0_ + vrow) * ldv + 8 * vpc); \
    if (MODE == 0) { if (tid < 64) { const size_t row_ = (size_t)(row0_ + (d ? 63 - lane : lane)); gi = bf2f(LO[row_ * 512 + 384 + 4 * d + hd]); gf = bf2f(LO[row_ * 512 + 392 + 4 * d + hd]); } } \
    else rlam = *(const f32x4*)(LAM + ((size_t)d * NRC + (row0_ >> 6)) * 512 + 128 * hd + 16 * wv + 4 * q); } while (0)

template <int MODE> DI void gla_unit(const P& p, LAS unsigned char* lds, int unit) {
    constexpr int NDV = MODE == 0 ? 3 : 2;
    const int tid = threadIdx.x, lane = tid & 63, wv = __builtin_amdgcn_readfirstlane(tid >> 6), r = lane & 15, q = lane >> 4;
    const int d = unit >> 6, b = (unit >> 4) & 3, hd = (unit >> 2) & 3, sl = unit & 3;
    const bf16_t* COLS = (const bf16_t*)(p.ws + WS_COLS);
    const bf16_t *Qg, *Kg, *Vg; int ldq, ldk, ldv;
    if (MODE == 0) { const bf16_t* ML = COLS + OFF_ML; Qg = ML + 128 * hd; Kg = ML + 512 + 128 * hd; Vg = ML + 1024 + 128 * hd + 32 * sl; ldq = ldk = ldv = 2048; }
    else { Qg = d ? (const bf16_t*)(p.ws + WS_Q1) + 128 * hd : COLS + 128 * hd; ldq = d ? 512 : 3584; Kg = COLS + 512 + 512 * d + 128 * hd; ldk = 3584; Vg = COLS + 1536 + 128 * hd + 32 * sl; ldv = 3584; }
    const bf16_t* LO = COLS + OFF_LO;
    const float* LAM = (const float*)(p.ws + WS_LAM);
    bf16_t* HB = (bf16_t*)(p.ws + WS_ACT);
    LAS bf16_t* Qs = (LAS bf16_t*)(lds + E_QS); LAS bf16_t* Ks = (LAS bf16_t*)(lds + E_KS); LAS bf16_t* Vs = (LAS bf16_t*)(lds + E_VS);
    LAS bf16_t* Ps = (LAS bf16_t*)(lds + E_PS); LAS bf16_t* STs = (LAS bf16_t*)(lds + E_ST); LAS float* Fs = (LAS float*)(lds + E_F);
    const unsigned ks_base = (unsigned)(size_t)Ks, vs_base = (unsigned)(size_t)Vs;
    float bi = 0.f, bfv = 0.f;
    if (MODE == 0) { bi = p.in[I_MBI][d * 4 + hd]; bfv = p.in[I_MBF][d * 4 + hd]; }
    __syncthreads();
    for (int e = tid; e < 48 * PQ / 2; e += NT) ((LAS unsigned*)STs)[e] = 0u;
    for (int e = tid; e < 64 * PV / 2; e += NT) ((LAS unsigned*)Vs)[e] = 0u;
    __syncthreads();
    f32x4 Sacc[NDV];
#pragma unroll
    for (int n = 0; n < NDV; ++n) Sacc[n] = (f32x4){0.f, 0.f, 0.f, 0.f};
    u32x4 rq[2], rk[2], rv = (u32x4){0u, 0u, 0u, 0u}; float gi = 0.f, gf = 0.f; f32x4 rlam = (f32x4){1.f, 1.f, 1.f, 1.f};
    const int prow0 = tid >> 4, ppc = tid & 15;
    const int vrow = tid >> 2, vpc = tid & 3;
    GLA_PREFETCH(0);
    for (int ci = 0; ci < 132; ++ci) {
        const int row0 = chunk_row0(d, b, ci);
        f32x4 lamv = rlam;
        if (MODE == 0) {
            if (tid < 64) {
                const float li = gi + bi, x = gf + bfv;
                float v = -log1pf(expf(-x));
#pragma unroll
                for (int o = 1; o < 64; o <<= 1) { const float t = __shfl_up(v, o); if (lane >= o) v += t; }
                const int rc = d ? 63 - lane : lane;
                Fs[rc] = expf(v) * 0.08838834764831845f; Fs[64 + rc] = expf(li - v);
                if (lane == 63) Fs[128] = expf(v);
            }
        }
#pragma unroll
        for (int i = 0; i < 2; ++i) { const int row = prow0 + 32 * i; *(LAS u32x4*)(Qs + row * PQ + 8 * ppc) = rq[i]; *(LAS u32x4*)(Ks + row * PQ + 8 * ppc) = rk[i]; }
        if (MODE == 0) __syncthreads();
        if (tid < 256) {
            if (MODE == 0) { const float w = Fs[64 + vrow]; u32x4 o;
#pragma unroll
                for (int e = 0; e < 4; ++e) o[e] = pack2(__uint_as_float(rv[e] << 16) * w, __uint_as_float(rv[e] & 0xffff0000u) * w);
                *(LAS u32x4*)(Vs + vrow * PV + 8 * vpc) = o;
                if (vpc == 0) Vs[vrow * PV + 32] = f2bf(w); }
            else *(LAS u32x4*)(Vs + vrow * PV + 8 * vpc) = rv;
        }
        __syncthreads();
        if (ci + 1 < 132) GLA_PREFETCH(ci + 1);
        if (MODE == 0) { const float l = Fs[128]; lamv = (f32x4){l, l, l, l}; }
        {
            const int tt = wv & 3, sh = wv >> 2;
            f32x4 pacc[2] = {(f32x4){0.f, 0.f, 0.f, 0.f}, (f32x4){0.f, 0.f, 0.f, 0.f}};
#pragma unroll
            for (int kk = 0; kk < 4; ++kk) { const bf16x8 bq = *(const LAS bf16x8*)(Qs + (16 * tt + r) * PQ + 32 * kk + 8 * q);
#pragma unroll
                for (int i = 0; i < 2; ++i) { const bf16x8 a = *(const LAS bf16x8*)(Ks + (16 * (2 * sh + i) + r) * PQ + 32 * kk + 8 * q); pacc[i] = __builtin_amdgcn_mfma_f32_16x16x32_bf16(a, bq, pacc[i], 0, 0, 0); } }
            const int t = 16 * tt + r;
#pragma unroll
            for (int i = 0; i < 2; ++i) { const int s0 = 16 * (2 * sh + i) + 4 * q; float v[4];
#pragma unroll
                for (int j = 0; j < 4; ++j) { const int s = s0 + j; const bool ok = d ? (s >= t) : (s <= t); v[j] = ok ? pacc[i][j] : 0.f; }
                u32x2 w; w.x = pack2(v[0], v[1]); w.y = pack2(v[2], v[3]); *(LAS u32x2*)(Ps + t * PS + s0) = w; }
        }
#pragma unroll
        for (int kk = 0; kk < 2; ++kk) { const bf16x8 a = tr_frag(ks_base, PQ, 32 * kk, 16 * wv, r, q);
#pragma unroll
            for (int n = 0; n < NDV; ++n) { const bf16x8 bv = tr_frag(vs_base, PV, 32 * kk, 16 * n, r, q); Sacc[n] = __builtin_amdgcn_mfma_f32_16x16x32_bf16(a, bv, Sacc[n], 0, 0, 0); } }
        __syncthreads();
        {
            const int tt = wv & 3, nA = wv >> 2;
            f32x4 oacc = (f32x4){0.f, 0.f, 0.f, 0.f}, dacc = (f32x4){0.f, 0.f, 0.f, 0.f};
#pragma unroll
            for (int kk = 0; kk < 2; ++kk) { const bf16x8 bp = *(const LAS bf16x8*)(Ps + (16 * tt + r) * PS + 32 * kk + 8 * q);
                const bf16x8 a = tr_frag(vs_base, PV, 32 * kk, 16 * nA, r, q); oacc = __builtin_amdgcn_mfma_f32_16x16x32_bf16(a, bp, oacc, 0, 0, 0);
                if (MODE == 0) { const bf16x8 a2 = tr_frag(vs_base, PV, 32 * kk, 32, r, q); dacc = __builtin_amdgcn_mfma_f32_16x16x32_bf16(a2, bp, dacc, 0, 0, 0); } }
#pragma unroll
            for (int kk = 0; kk < 4; ++kk) { const bf16x8 bq = *(const LAS bf16x8*)(Qs + (16 * tt + r) * PQ + 32 * kk + 8 * q);
                const bf16x8 a = *(const LAS bf16x8*)(STs + (16 * nA + r) * PQ + 32 * kk + 8 * q); oacc = __builtin_amdgcn_mfma_f32_16x16x32_bf16(a, bq, oacc, 0, 0, 0);
                if (MODE == 0) { const bf16x8 a2 = *(const LAS bf16x8*)(STs + (32 + r) * PQ + 32 * kk + 8 * q); dacc = __builtin_amdgcn_mfma_f32_16x16x32_bf16(a2, bq, dacc, 0, 0, 0); } }
            const int t = 16 * tt + r;
            float o0 = oacc[0], o1 = oacc[1], o2 = oacc[2], o3 = oacc[3];
            if (MODE == 0) { const float rs = Fs[t]; const float den = __shfl(dacc[0], r) * rs; const float inv = rs / fmaxf(fabsf(den), 1.f); o0 *= inv; o1 *= inv; o2 *= inv; o3 *= inv; }
            u32x2 w; w.x = pack2(o0, o1); w.y = pack2(o2, o3);
            *(u32x2*)(HB + ((size_t)d * NALL + row0 + t) * 512 + 128 * hd + 32 * sl + 16 * nA + 4 * q) = w;
        }
        __syncthreads();
#pragma unroll
        for (int n = 0; n < NDV; ++n) { Sacc[n] = Sacc[n] * lamv; u32x2 w; w.x = pack2(Sacc[n][0], Sacc[n][1]); w.y = pack2(Sacc[n][2], Sacc[n][3]); *(LAS u32x2*)(STs + (16 * n + r) * PQ + 16 * wv + 4 * q) = w; }
    }
    __syncthreads();
}

DI void phase_hgrn_prep(const P& p, LAS unsigned char* ldsb) {
    LAS float* tot = (LAS float*)ldsb;
    const int tid = threadIdx.x, ch = tid & 127, qt = tid >> 7;
    bf16_t* C1 = (bf16_t*)(p.ws + WS_COLS); bf16_t* Q1 = (bf16_t*)(p.ws + WS_Q1); float* LAM = (float*)(p.ws + WS_LAM);
    for (int vb = blockIdx.x; vb < NRC * 4; vb += gridDim.x) {
        const int rc = vb >> 2, hd = vb & 3, c = 128 * hd + ch; const size_t rbase = (size_t)rc * 64 + 16 * qt;
        const float lb = sigm(p.in[I_HLB][512 + c] - p.in[I_HLB][c]);
        float qv[16], l0[16], l1[16], k0[16], k1[16];
#pragma unroll
        for (int i = 0; i < 16; ++i) { const bf16_t* base = C1 + (rbase + i) * 3584;
            qv[i] = siluf(bf2f(base[c])); const float s0 = sigm(bf2f(base[512 + c])), s1 = sigm(bf2f(base[1024 + c]));
            l0[i] = logf(lb + (1.f - lb) * s0); l1[i] = logf(lb + (1.f - lb) * s1); k0[i] = (1.f - lb) * (1.f - s0); k1[i] = (1.f - lb) * (1.f - s1); }
#pragma unroll
        for (int i = 1; i < 16; ++i) l0[i] += l0[i - 1];
#pragma unroll
        for (int i = 14; i >= 0; --i) l1[i] += l1[i + 1];
        __syncthreads();
        tot[qt * 128 + ch] = l0[15]; tot[512 + qt * 128 + ch] = l1[0];
        __syncthreads();
        float off0 = 0.f, off1 = 0.f, t0 = 0.f, t1 = 0.f;
#pragma unroll
        for (int j = 0; j < 4; ++j) { const float a = tot[j * 128 + ch], bb = tot[512 + j * 128 + ch]; t0 += a; t1 += bb; if (j < qt) off0 += a; if (j > qt) off1 += bb; }
#pragma unroll
        for (int i = 0; i < 16; ++i) { bf16_t* base = C1 + (rbase + i) * 3584; const float c0 = l0[i] + off0, c1 = l1[i] + off1;
            base[c] = f2bf(qv[i] * expf(c0)); base[512 + c] = f2bf(k0[i] * expf(-c0)); base[1024 + c] = f2bf(k1[i] * expf(-c1)); Q1[(rbase + i) * 512 + c] = f2bf(qv[i] * expf(c1)); }
        if (qt == 0) { LAM[((size_t)rc) * 512 + c] = expf(t0); LAM[((size_t)NRC + rc) * 512 + c] = expf(t1); }
    }
    __syncthreads();
}
constexpr int L_XB = 0, L_XCS = L_XB + 67 * 64 * 4, L_WA = L_XCS + 64 * 72 * 2, L_WI = L_WA + 64 * 72 * 2, L_XCF = L_WI + 64 * 72 * 2, L_AA = L_XCF + 64 * 64 * 4, L_UU = L_AA + 64 * 65 * 4,
              L_SEG = L_UU + 64 * 65 * 4, L_PRM = L_SEG + 2 * 8 * 64 * 4, L_END = L_PRM + 10 * 64 * 4;
DI void lru_unit(const P& p, LAS unsigned char* lds, int unit) {
    const int tid = threadIdx.x, lane = tid & 63, wv = __builtin_amdgcn_readfirstlane(tid >> 6), r = lane & 15, q = lane >> 4;
    const int b = unit >> 3, hb = unit & 7;
    const bf16_t* C1 = (const bf16_t*)(p.ws + WS_COLS); bf16_t* Z1 = (bf16_t*)(p.ws + WS_Z1); bf16_t* Y = (bf16_t*)(p.ws + WS_Z);
    LAS float* XB = (LAS float*)(lds + L_XB); LAS bf16_t* XCs = (LAS bf16_t*)(lds + L_XCS); LAS bf16_t* WAt = (LAS bf16_t*)(lds + L_WA); LAS bf16_t* WIt = (LAS bf16_t*)(lds + L_WI);
    LAS float* XCf = (LAS float*)(lds + L_XCF); LAS float* Aa = (LAS float*)(lds + L_AA); LAS float* Uu = (LAS float*)(lds + L_UU); LAS float* segP = (LAS float*)(lds + L_SEG); LAS float* segH = segP + 512;
    LAS float* prm = (LAS float*)(lds + L_PRM);
    for (int d = 0; d < 2; ++d) {
        __syncthreads();
        for (int e = tid; e < 4096; e += NT) { const int i = e >> 6, j = e & 63; const size_t o = ((size_t)(d * 8 + hb) * 64 + i) * 64 + j; WAt[j * 72 + i] = f2bf(p.in[I_WA][o]); WIt[j * 72 + i] = f2bf(p.in[I_WI][o]); }
        if (tid < 64) { const int ch = 64 * hb + tid;
            prm[tid] = p.in[I_CONVW][ch]; prm[64 + tid] = p.in[I_CONVW][512 + ch]; prm[128 + tid] = p.in[I_CONVW][1024 + ch]; prm[192 + tid] = p.in[I_CONVW][1536 + ch]; prm[256 + tid] = p.in[I_CONVB][ch];
            prm[320 + tid] = p.in[I_BA][d * 512 + ch]; prm[384 + tid] = p.in[I_BI][d * 512 + ch]; prm[448 + tid] = log1pf(expf(-p.in[I_LAM][d * 512 + ch])); prm[512 + tid] = 0.f; }
        __syncthreads();
        for (int ci = 0; ci < 132; ++ci) {
            const int row0 = chunk_row0(d, b, ci);
            const int seg_lo = (ci < 4) ? NLAT + b * LC : b * L, seg_hi = seg_lo + ((ci < 4) ? LC : L);
            for (int e = tid; e < 67 * 8; e += NT) { const int rr = e >> 3, pc = e & 7, grow = row0 - 2 + rr;
                u32x4 v = (u32x4){0u, 0u, 0u, 0u};
                if (grow >= seg_lo && grow < seg_hi) v = *(const u32x4*)(C1 + (size_t)grow * C1LD + 2560 + 64 * hb + 8 * pc);
                f32x4 lo, hi; lo[0] = __uint_as_float(v[0] << 16); lo[1] = __uint_as_float(v[0] & 0xffff0000u); lo[2] = __uint_as_float(v[1] << 16); lo[3] = __uint_as_float(v[1] & 0xffff0000u);
                hi[0] = __uint_as_float(v[2] << 16); hi[1] = __uint_as_float(v[2] & 0xffff0000u); hi[2] = __uint_as_float(v[3] << 16); hi[3] = __uint_as_float(v[3] & 0xffff0000u);
                *(LAS f32x4*)(XB + rr * 64 + 8 * pc) = lo; *(LAS f32x4*)(XB + rr * 64 + 8 * pc + 4) = hi; }
            __syncthreads();
            {
                const int t = tid >> 3, i0 = 8 * (tid & 7); float xc[8];
#pragma unroll
                for (int c = 0; c < 8; ++c) { const int i = i0 + c; xc[c] = prm[256 + i] + prm[i] * XB[t * 64 + i] + prm[64 + i] * XB[(t + 1) * 64 + i] + prm[128 + i] * XB[(t + 2) * 64 + i] + prm[192 + i] * XB[(t + 3) * 64 + i]; XCf[t * 64 + i] = xc[c]; }
                u32x4 w; w.x = pack2(xc[0], xc[1]); w.y = pack2(xc[2], xc[3]); w.z = pack2(xc[4], xc[5]); w.w = pack2(xc[6], xc[7]);
                *(LAS u32x4*)(XCs + t * 72 + i0) = w;
            }
            __syncthreads();
            {
                const int jt = wv & 3, th = wv >> 2, j = 16 * jt + r;
                const float ba = prm[320 + j], bi = prm[384 + j], spl = prm[448 + j];
#pragma unroll
                for (int i2 = 0; i2 < 2; ++i2) { const int tt = 2 * th + i2;
                    f32x4 aa = (f32x4){0.f, 0.f, 0.f, 0.f}, ai = (f32x4){0.f, 0.f, 0.f, 0.f};
#pragma unroll
                    for (int kk = 0; kk < 2; ++kk) { const bf16x8 xf = *(const LAS bf16x8*)(XCs + (16 * tt + r) * 72 + 32 * kk + 8 * q);
                        const bf16x8 wa = *(const LAS bf16x8*)(WAt + (16 * jt + r) * 72 + 32 * kk + 8 * q), wi = *(const LAS bf16x8*)(WIt + (16 * jt + r) * 72 + 32 * kk + 8 * q);
                        aa = __builtin_amdgcn_mfma_f32_16x16x32_bf16(xf, wa, aa, 0, 0, 0); ai = __builtin_amdgcn_mfma_f32_16x16x32_bf16(xf, wi, ai, 0, 0, 0); }
#pragma unroll
                    for (int jj = 0; jj < 4; ++jj) { const int t = 16 * tt + 4 * q + jj;
                        const float rg = sigm(aa[jj] + ba), ig = sigm(ai[jj] + bi), la = -8.f * rg * spl;
                        Aa[t * 65 + j] = expf(la); Uu[t * 65 + j] = sqrtf(-expm1f(2.f * la)) * (ig * XCf[t * 64 + j]); } }
            }
            __syncthreads();
            {
                const int sg = tid >> 6, j = lane;
                float pp = 1.f, hh = 0.f;
#pragma unroll
                for (int k = 0; k < 8; ++k) { const int u = 8 * sg + k, t = d ? 63 - u : u; const float a = Aa[t * 65 + j]; hh = a * hh + Uu[t * 65 + j]; pp *= a; }
                segP[sg * 64 + j] = pp; segH[sg * 64 + j] = hh;
                __syncthreads();
                float h = prm[512 + j];
                for (int s2 = 0; s2 < sg; ++s2) h = segP[s2 * 64 + j] * h + segH[s2 * 64 + j];
                const int ch = 64 * hb + j;
#pragma unroll
                for (int k = 0; k < 8; ++k) { const int u = 8 * sg + k, t = d ? 63 - u : u; h = Aa[t * 65 + j] * h + Uu[t * 65 + j];
                    const int row = row0 + t;
                    if (row < NLAT) {
                        if (d == 0) Z1[(size_t)row * 512 + ch] = f2bf(h);
                        else { const float tot = bf2f(Z1[(size_t)row * 512 + ch]) + h; const float gb = bf2f(C1[(size_t)row * C1LD + 3072 + ch]); Y[(size_t)nat_row(row) * D + 512 + ch] = f2bf(tot * geluf(gb)); } } }
                __syncthreads();
                if (sg == 7) prm[512 + j] = h;
            }
        }
    }
    __syncthreads();
}
DI void phase_mlstm_post(const P& p) {
    const int lane = threadIdx.x & 63, wv = threadIdx.x >> 6;
    const bf16_t* ML = (const bf16_t*)(p.ws + WS_COLS) + OFF_ML; const bf16_t* HB = (const bf16_t*)(p.ws + WS_ACT); bf16_t* Y = (bf16_t*)(p.ws + WS_COLS);
    for (int r = blockIdx.x * 8 + wv; r < NALL; r += gridDim.x * 8)
        post_headnorm_row(HB, (size_t)r, p.in[I_MNG], ML + (size_t)r * 2048 + 1536, 0, Y + (size_t)r * D + 512, lane);
}
DI void phase_hgrn_post(const P& p) {
    const int lane = threadIdx.x & 63, wv = threadIdx.x >> 6;
    const bf16_t* C1 = (const bf16_t*)(p.ws + WS_COLS); const bf16_t* HB = (const bf16_t*)(p.ws + WS_ACT); bf16_t* Y = (bf16_t*)(p.ws + WS_Z);
    for (int r = blockIdx.x * 8 + wv; r < NLAT; r += gridDim.x * 8)
        post_headnorm_row(HB, (size_t)r, p.in[I_HNG], C1 + (size_t)r * C1LD + 2048, 1, Y + (size_t)nat_row(r) * D, lane);
}

constexpr int N_PHASES = 19;
__global__ void __launch_bounds__(NT, 2) mk_fwd(P p) {
    extern __shared__ __attribute__((aligned(16))) unsigned char lds_raw[];
    LAS unsigned char* lds = (LAS unsigned char*)lds_raw;
    cooperative_groups::grid_group grid = cooperative_groups::this_grid();
    const int lo = p.ph_lo, hi = p.ph_hi;
#define IN(k) (lo <= (k) && (k) < hi)
#define SEAM(k) do { if (IN(k) && IN((k) + 1)) grid.sync(); } while (0)
    unsigned char* ws = p.ws;
    const float* MODV = (const float*)(ws + WS_MODV);
    float* HC = (float*)(ws + WS_HC);
    bf16_t* ACT = (bf16_t*)(ws + WS_ACT); bf16_t* COLS = (bf16_t*)(ws + WS_COLS); bf16_t* Y1 = (bf16_t*)(ws + WS_Z);
    if (IN(0)) { phase_wprep(p, lds); phase_modv(p, lds); } SEAM(0);
    if (IN(1)) { phase_modnorm(p, 0, 0, p.in[I_X], p.in[I_CTX], NALL, false); } SEAM(1);
    if (IN(2)) { EpiStore3 E{COLS + OFF_RW, 1536, 6, COLS + OFF_LO, 512, 8, COLS + OFF_ML, 2048}; run_gemm(lds, ACT, (const bf16_t*)(ws + WS_W_EVIN), NALL, 4096, 1024, E); } SEAM(2);
    if (IN(3)) {
        for (int vb = blockIdx.x; vb < 192; vb += gridDim.x) { if (vb < 64) phase_rwkv_scan_unit(p, lds, vb); else gla_unit<0>(p, lds, vb - 64); }
    } SEAM(3);
    if (IN(4)) { phase_mlstm_post(p); phase_rwkv_post(p, lds); } SEAM(4);
    if (IN(5)) { EpiResid E{p.in[I_X], p.out, p.in[I_CTX], HC, MODV, 2}; run_gemm(lds, COLS, (const bf16_t*)(ws + WS_W_EVOUT), NALL, 1024, 1024, E); } SEAM(5);
    if (IN(6)) { phase_modnorm(p, 0, 1, p.out, HC, NALL, false); } SEAM(6);
    if (IN(7)) { EpiSwiglu E{COLS}; run_gemm(lds, ACT, (const bf16_t*)(ws + WS_W_UP), NALL, 5632, 1024, E); } SEAM(7);
    if (IN(8)) { EpiResid E{p.out, p.out, HC, HC, MODV, 5}; run_gemm(lds, COLS, (const bf16_t*)(ws + WS_W_DN), NALL, 1024, 2816, E); } SEAM(8);
    if (IN(9)) { phase_modnorm(p, 1, 0, p.out, HC, NALL, true); } SEAM(9);
    if (IN(10)) { EpiStore3 E{COLS, C1LD, 1 << 30, COLS, C1LD, 1 << 30, COLS, C1LD}; run_gemm(lds, ACT, (const bf16_t*)(ws + WS_W_ODIN), NALL, 3584, 1024, E); } SEAM(10);
    if (IN(11)) { phase_hgrn_prep(p, lds); } SEAM(11);
    if (IN(12)) {
        for (int vb = blockIdx.x; vb < 160; vb += gridDim.x) { if (vb < 32) lru_unit(p, lds, vb); else gla_unit<1>(p, lds, vb - 32); }
    } SEAM(12);
    if (IN(13)) { phase_hgrn_post(p); } SEAM(13);
    if (IN(14)) { EpiResid E{p.out, p.out, HC, HC, MODV + 5 * 6144, 2}; run_gemm(lds, Y1, (const bf16_t*)(ws + WS_W_ODOUT), NLAT, 1024, 1024, E); } SEAM(14);
    if (IN(15)) { phase_modnorm(p, 1, 1, p.out, HC, NLAT, false); } SEAM(15);
    if (IN(16)) { EpiSwiglu E{COLS}; run_gemm(lds, ACT, (const bf16_t*)(ws + WS_W_UP) + W_UP_STRIDE, NLAT, 5632, 1024, E); } SEAM(16);
    if (IN(17)) { EpiResid E{p.out, p.out, HC, HC, MODV + 5 * 6144, 5}; run_gemm(lds, COLS, (const bf16_t*)(ws + WS_W_DN) + W_DN_STRIDE, NLAT, 1024, 2816, E); } SEAM(17);
    if (IN(18)) { phase_finalnorm(p); }
#undef IN
#undef SEAM
}
}

#ifndef MK_ONE_LAUNCH
#define MK_ONE_LAUNCH 1
#endif
extern "C" void kernel_launch(void* const* d_in, const int* in_sizes, int n_in, void* d_out, int out_size, void* d_ws, size_t ws_size, hipStream_t stream) {
    using namespace mk;
    static int grid = 0;
    if (grid == 0) {
        int dev = 0, cus = 0, per_cu = 0;
        if (n_in != N_IN || ws_size < WS_END) { fprintf(stderr, "kernel_launch: unexpected n_in %d / ws_size %zu\n", n_in, ws_size); grid = -1; return; }
        (void)hipGetDevice(&dev); (void)hipDeviceGetAttribute(&cus, hipDeviceAttributeMultiprocessorCount, dev);
        (void)hipFuncSetAttribute((const void*)mk_fwd, hipFuncAttributeMaxDynamicSharedMemorySize, LDS_BYTES);
        (void)hipOccupancyMaxActiveBlocksPerMultiprocessor(&per_cu, (const void*)mk_fwd, NT, LDS_BYTES);
        if (per_cu < 1) { fprintf(stderr, "kernel_launch: occupancy query says %d blocks per CU\n", per_cu); per_cu = 1; }
        (void)hipGetLastError();
        grid = cus;
    }
    if (grid < 0) return;
    P p{};
    for (int i = 0; i < N_IN; ++i) p.in[i] = (const float*)d_in[i];
    p.out = (float*)d_out; p.ws = (unsigned char*)d_ws;
#if MK_ONE_LAUNCH
    p.ph_lo = 0; p.ph_hi = N_PHASES;
    void* args[] = {&p};
    hipError_t e = hipLaunchCooperativeKernel((const void*)mk_fwd, dim3(grid), dim3(NT), args, LDS_BYTES, stream);
    if (e != hipSuccess) fprintf(stderr, "cooperative launch failed: %s (grid %d)\n", hipGetErrorString(e), grid);
#else
    for (int k = 0; k < N_PHASES; ++k) { p.ph_lo = k; p.ph_hi = k + 1; hipLaunchKernelGGL(mk_fwd, dim3(grid), dim3(NT), LDS_BYTES, stream, p); }
#endif
}
```

```cpp
#include <hip/hip_runtime.h>
#include <hip/hip_cooperative_groups.h>
#include <cstdio>
#include <cstdint>
__device__ __forceinline__ int mk_tid() { int t = threadIdx.x; asm volatile("" : "+v"(t)); return t; }
namespace pg8 {
#define PG8_LAS __attribute__((address_space(3)))
typedef unsigned short bf16_t;
typedef short bf16x8 __attribute__((ext_vector_type(8)));
typedef float f32x4 __attribute__((ext_vector_type(4)));
typedef unsigned u32x4 __attribute__((ext_vector_type(4)));
constexpr int BM = 256, BK = 64, HALF = 128, HTB = HALF * BK * 2  , STAGE_BYTES = 8 * HTB, NXCD = 8, WGM = 8;

__host__ __device__ __forceinline__ int lds_byte(int r, int c) { const int st = (r >> 4) * 2 + (c >> 5), rr = r & 15, cc = c & 31, ob = rr * 64 + cc * 2; return st * 1024 + (ob ^ (((ob >> 9) & 1) << 5)); }
__host__ __device__ __forceinline__ void stage_rc(int b, int& R, int& C) { const int st = b / 1024, sb = b % 1024, swz = sb ^ (((sb >> 9) & 1) << 5); R = (st >> 1) * 16 + swz / 64; C = (st & 1) * 32 + (swz % 64) / 2; }
__host__ __device__ __forceinline__ int perm32(int rho) { const int n = rho >> 4, i = rho & 15; return 8 * (i >> 2) + 4 * n + (i & 3); }

struct Unit { int pm, pn; };
struct Gemm { const bf16_t* A; const bf16_t* Bt; int M, N, K; };

struct StaticOrder {
    int nM, nN, nwg, G, c;
    __host__ __device__ void init(int M, int N, int G_, int c_) { nM = M / BM; nN = N / BM; nwg = nM * nN; G = G_; c = c_; }
    __host__ __device__ bool next(int i, Unit& u) const {
        const long L = (long)i * G + c; if (L >= nwg) return false;
        int wgid = (int)L; { const int q = nwg / NXCD, r = nwg % NXCD, xcd = wgid % NXCD, off = wgid / NXCD; wgid = (xcd < r ? xcd * (q + 1) : r * (q + 1) + (xcd - r) * q) + off; }
        const int nig = WGM * nN, gid = wgid / nig, fm = gid * WGM, gsz = (nM - fm) < WGM ? (nM - fm) : WGM;
        u.pm = fm + ((wgid % nig) % gsz); u.pn = (wgid % nig) / gsz; return true;
    }
    __device__ __forceinline__ void a_ready(const Unit&) const {}
    __device__ __forceinline__ void done(const Unit&) const {}
};
__device__ __forceinline__ unsigned cvt_pk_bf16(float lo, float hi) { unsigned r; asm volatile("v_cvt_pk_bf16_f32 %0, %1, %2" : "=v"(r) : "v"(lo), "v"(hi)); return r; }
typedef float f32x2 __attribute__((ext_vector_type(2)));
template <class Epi, class Sched, bool STAMP = false>
__device__ __forceinline__ void gemm_phase(PG8_LAS unsigned char* lds, const Gemm g, const Sched& S, const Epi& E, unsigned long long* stamps) {
    const int tid = mk_tid(), wid = __builtin_amdgcn_readfirstlane(tid >> 6), lane = tid & 63, wr = wid >> 2, wc = wid & 3, fr = lane & 15, fq = lane >> 4;
    const int K = g.K, nt = K / BK;
    int ts_lo = 0, ts_hi = 0, nts = 0; const unsigned long long rt_entry = STAMP ? (unsigned long long)wall_clock64() : 0ull;
#define PG8_STAMP() do { if (STAMP && wid == 0 && nts < 64) { const unsigned long long _c = (unsigned long long)clock64(); \
        ts_lo = (lane == nts) ? (int)(unsigned)_c : ts_lo; ts_hi = (lane == nts) ? (int)(unsigned)(_c >> 32) : ts_hi; ++nts; } } while (0)
    PG8_STAMP();
    unsigned voffA[2], voffB[2];
#pragma unroll
    for (int i = 0; i < 2; ++i) { int R, C; stage_rc(tid * 16 + i * 8192, R, C); const int Rb = Epi::PERM ? ((R & ~31) + perm32(R & 31)) : R;
        voffA[i] = (unsigned)(R * K + C) * 2u; voffB[i] = (unsigned)(Rb * K + C) * 2u; }
    const size_t kstep = (size_t)(BK * 2);
    const size_t hstep = (size_t)HALF * K * 2;
    const size_t tstep = 2 * hstep;
    const unsigned ldsw = (unsigned)wid * 1024u;
    const int aoff = lds_byte(wr * 64 + fr, fq * 8), boff = lds_byte(wc * 32 + fr, fq * 8);
#define PG8_SA(b, h) (((b) * 2 + (h)) * HTB)
#define PG8_SB(b, h) ((4 + (b) * 2 + (h)) * HTB)
#define PG8_STAGE(bufoff, gbase, voff) do { _Pragma("unroll") for (int _i = 0; _i < 2; ++_i) \
        __builtin_amdgcn_global_load_lds((const unsigned*)((const char*)(gbase) + (voff)[_i]), (PG8_LAS unsigned*)(lds + (bufoff) + ldsw + _i * 8192), 16, 0, 0); } while (0)
#define PG8_LDA(dst, b, h) do { _Pragma("unroll") for (int m = 0; m < 4; ++m) _Pragma("unroll") for (int k = 0; k < 2; ++k) dst[m][k] = *(const PG8_LAS bf16x8*)(lds + PG8_SA(b, h) + aoff + m * 2048 + k * 1024); } while (0)
#define PG8_LDB(dst, b, h) do { _Pragma("unroll") for (int n = 0; n < 2; ++n) _Pragma("unroll") for (int k = 0; k < 2; ++k) dst[n][k] = *(const PG8_LAS bf16x8*)(lds + PG8_SB(b, h) + boff + n * 2048 + k * 1024); } while (0)
#define PG8_MMA(ai, bj, At, Bt) do { __builtin_amdgcn_s_setprio(1); _Pragma("unroll") for (int m = 0; m < 4; ++m) _Pragma("unroll") for (int n = 0; n < 2; ++n) _Pragma("unroll") for (int k = 0; k < 2; ++k) \
        acc[ai][bj][m][n] = __builtin_amdgcn_mfma_f32_16x16x32_bf16(Bt[n][k], At[m][k], acc[ai][bj][m][n], 0, 0, 0); __builtin_amdgcn_s_setprio(0); } while (0)
#define PG8_WAIT_V(n) asm volatile("s_waitcnt vmcnt(" #n ")" ::: "memory")
#define PG8_WAIT_L(n) asm volatile("s_waitcnt lgkmcnt(" #n ")" ::: "memory")
#define PG8_BAR __builtin_amdgcn_s_barrier()
#define PG8_SCHED __builtin_amdgcn_sched_barrier(0)
    Unit cur, nxt; int ui = 0;
    if (!S.next(0, cur)) return;
    f32x4 acc[2][2][4][2];
#pragma unroll
    for (int a = 0; a < 2; ++a)
#pragma unroll
        for (int b = 0; b < 2; ++b)
#pragma unroll
            for (int m = 0; m < 4; ++m)
#pragma unroll
                for (int n = 0; n < 2; ++n) acc[a][b][m][n] = (f32x4){0.f, 0.f, 0.f, 0.f};
    bf16x8 At[4][2], B0[2][2], B1[2][2];
    const char* cA = (const char*)g.A + (size_t)cur.pm * tstep; const char* cB = (const char*)g.Bt + (size_t)cur.pn * tstep;
    S.a_ready(cur);
    PG8_STAGE(PG8_SB(0, 0), cB, voffB); PG8_STAGE(PG8_SA(0, 0), cA, voffA); PG8_STAGE(PG8_SB(0, 1), cB + hstep, voffB); PG8_STAGE(PG8_SA(0, 1), cA + hstep, voffA);
    if (wr == 1) PG8_BAR;
    PG8_WAIT_V(4); PG8_BAR;
    PG8_STAGE(PG8_SB(1, 0), cB + kstep, voffB); PG8_STAGE(PG8_SA(1, 0), cA + kstep, voffA); PG8_STAGE(PG8_SB(1, 1), cB + hstep + kstep, voffB);
    PG8_WAIT_V(6); PG8_BAR;
    PG8_STAMP();
    for (;;) {
        const bool has_next = S.next(ui + 1, nxt);
        const char* nA = has_next ? (const char*)g.A + (size_t)nxt.pm * tstep : cA; const char* nB = has_next ? (const char*)g.Bt + (size_t)nxt.pn * tstep : cB;
        for (int t = 0; t < nt; t += 2) {
            const bool last = (t == nt - 2);
            const char* a1 = cA + (size_t)(t + 1) * kstep;
            const char* a2 = last ? nA : cA + (size_t)(t + 2) * kstep; const char* b2 = last ? nB : cB + (size_t)(t + 2) * kstep;
            const char* a3 = a2 + kstep; const char* b3 = b2 + kstep;
            if (last && has_next) S.a_ready(nxt);
            PG8_LDB(B0, 0, 0); PG8_SCHED; PG8_LDA(At, 0, 0); PG8_STAGE(PG8_SA(1, 1), a1 + hstep, voffA);
            PG8_WAIT_L(8); PG8_BAR; PG8_WAIT_L(0); PG8_MMA(0, 0, At, B0); PG8_BAR; PG8_SCHED;
            PG8_LDB(B1, 0, 1); PG8_STAGE(PG8_SB(0, 0), b2, voffB);
            PG8_BAR; PG8_WAIT_L(0); PG8_MMA(0, 1, At, B1); PG8_BAR;
            PG8_LDA(At, 0, 1); PG8_STAGE(PG8_SA(0, 0), a2, voffA);
            PG8_BAR; PG8_WAIT_L(0); PG8_MMA(1, 0, At, B0); PG8_BAR; PG8_SCHED;
            PG8_STAGE(PG8_SB(0, 1), b2 + hstep, voffB);
            PG8_WAIT_V(6); PG8_BAR; PG8_MMA(1, 1, At, B1); PG8_BAR;
            PG8_LDB(B0, 1, 0); PG8_SCHED; PG8_LDA(At, 1, 0); PG8_STAGE(PG8_SA(0, 1), a2 + hstep, voffA);
            PG8_WAIT_L(8); PG8_BAR; PG8_WAIT_L(0); PG8_MMA(0, 0, At, B0); PG8_BAR; PG8_SCHED;
            PG8_LDB(B1, 1, 1); PG8_STAGE(PG8_SB(1, 0), b3, voffB);
            PG8_BAR; PG8_WAIT_L(0); PG8_MMA(0, 1, At, B1); PG8_BAR;
            PG8_LDA(At, 1, 1); PG8_STAGE(PG8_SA(1, 0), a3, voffA);
            PG8_BAR; PG8_WAIT_L(0); PG8_MMA(1, 0, At, B0); PG8_BAR; PG8_SCHED;
            PG8_STAGE(PG8_SB(1, 1), b3 + hstep, voffB);
            PG8_WAIT_V(6); PG8_BAR; PG8_MMA(1, 1, At, B1); PG8_BAR;
        }
        PG8_STAMP();
        if constexpr (!Epi::AFTER_DRAIN) { E(acc, cur, wr, wc, fr, fq); S.done(cur); }
        PG8_STAMP();
        if (!has_next) break;
#pragma unroll
        for (int a = 0; a < 2; ++a)
#pragma unroll
            for (int b = 0; b < 2; ++b)
#pragma unroll
                for (int m = 0; m < 4; ++m)
#pragma unroll
                    for (int n = 0; n < 2; ++n) acc[a][b][m][n] = (f32x4){0.f, 0.f, 0.f, 0.f};
        cur = nxt; cA = nA; cB = nB; ++ui;
    }
    PG8_WAIT_V(0);
    if (wr == 0) PG8_BAR;
    PG8_BAR;
    if constexpr (Epi::AFTER_DRAIN) { E.fused(acc, cur, wr, wc, fr, fq, lds, wid, lane); S.done(cur); }
    PG8_STAMP();
    if (STAMP && wid == 0) { stamps[lane] = lane < nts ? (((unsigned long long)(unsigned)ts_hi << 32) | (unsigned)ts_lo) : 0ull;
        if (lane == 62) stamps[62] = rt_entry; if (lane == 63) stamps[63] = (unsigned long long)wall_clock64(); }
#undef PG8_STAMP
#undef PG8_SA
#undef PG8_SB
#undef PG8_STAGE
#undef PG8_LDA
#undef PG8_LDB
#undef PG8_MMA
#undef PG8_WAIT_V
#undef PG8_WAIT_L
#undef PG8_BAR
#undef PG8_SCHED
}
}

namespace mk {
#define DI __device__ __forceinline__
#define LAS __attribute__((address_space(3)))
typedef unsigned short bf16_t;
typedef float f32x4 __attribute__((ext_vector_type(4)));
typedef unsigned u32x2 __attribute__((ext_vector_type(2)));
typedef unsigned u32x4 __attribute__((ext_vector_type(4)));

constexpr int D = 1024, NB = 4, L = 8192, LC = 256, NLAT = NB * L, NCTX = NB * LC, NALL = NLAT + NCTX, LT = L + LC, DFF = 2816;
constexpr int NT = 512;
constexpr size_t MiB = (size_t)1 << 20;
constexpr size_t WS_CTL = 0, WS_MODV = 1 * MiB, WS_HC = 2 * MiB, WS_W_EVIN = 6 * MiB, WS_W_EVOUT = 14 * MiB, WS_W_ODIN = 16 * MiB, WS_W_ODOUT = 23 * MiB,
                 WS_W_UP = 25 * MiB, WS_W_DN = 47 * MiB, WS_ACT = 58 * MiB, WS_COLS = 124 * MiB, WS_Z = 388 * MiB, WS_Z1 = 454 * MiB, WS_LAM = 486 * MiB, WS_END = 489 * MiB;
constexpr size_t W_UP_STRIDE = (size_t)5632 * 1024, W_DN_STRIDE = (size_t)1024 * 2816;
constexpr size_t OFF_RW = 0, OFF_LO = (size_t)NALL * 1536, OFF_ML = OFF_LO + (size_t)NALL * 512;
constexpr int LDS_BYTES = 163840;
constexpr int C1LD = 3584;
DI int nat_row(int r) { const int b = r / L, pp = r % L; return b * L + (pp % 128) * 64 + pp / 128; }

enum { I_X = 0, I_C, I_CTX, I_CCTX, I_N1G, I_N2G, I_MODW, I_MODB, I_W1, I_W3, I_W2, I_FING, I_EVIN, I_EVOUT, I_MU, I_W0, I_W2L, I_A0, I_A2L, I_KK, I_KA, I_RK,
       I_LNW, I_LNB, I_G2, I_MBI, I_MBF, I_MNG, I_ODIN, I_ODOUT, I_HLB, I_HNG, I_CONVW, I_CONVB, I_WA, I_BA, I_WI, I_BI, I_LAM, N_IN };

struct P { const float* in[N_IN]; float* out; unsigned char* ws; int ph_lo, ph_hi; };

DI float bf2f(bf16_t v) { return __uint_as_float(((unsigned)v) << 16); }
DI bf16_t f2bf(float f) { unsigned u = __float_as_uint(f); u += 0x7fffu + ((u >> 16) & 1u); return (bf16_t)(u >> 16); }
DI float sigm(float x) { return 1.f / (1.f + expf(-x)); }
DI float siluf(float x) { return x * sigm(x); }
DI float geluf(float x) { return 0.5f * x * (1.f + tanhf(0.7978845608028654f * (x + 0.044715f * x * x * x))); }
DI float wave_sum(float v) {
#pragma unroll
    for (int o = 32; o >= 1; o >>= 1) v += __shfl_xor(v, o);
    return v;
}
DI int step_row(int d, int b, int n) {
    if (n < LC) return NLAT + b * LC + (d ? LC - 1 - n : n);
    const int m = n - LC; return b * L + (d ? L - 1 - m : m);
}

DI int matN(int m) { return m == 0 ? 4096 : m == 1 ? 1024 : m == 2 ? 3584 : m == 3 ? 1024 : m < 6 ? 5632 : 1024; }
DI int matK(int m) { return m < 6 ? 1024 : 2816; }
DI int matTile0(int m) { return m == 0 ? 0 : m == 1 ? 1024 : m == 2 ? 1280 : m == 3 ? 2176 : m == 4 ? 2432 : m == 5 ? 3840 : m == 6 ? 5248 : m == 7 ? 5952 : 6656; }
DI size_t matOff(int m) { return m == 0 ? WS_W_EVIN : m == 1 ? WS_W_EVOUT : m == 2 ? WS_W_ODIN : m == 3 ? WS_W_ODOUT : m == 4 ? WS_W_UP : m == 5 ? WS_W_UP + W_UP_STRIDE * 2 : m == 6 ? WS_W_DN : WS_W_DN + W_DN_STRIDE * 2; }
DI const float* matSrc(const P& p, int m, int n, int& ld) {
    if (m == 0) { ld = 3984; int col; if (n < 1920) col = n; else if (n < 1936) col = 3968 + (n - 1920); else if (n < 2048) return nullptr; else col = 1920 + (n - 2048); return p.in[I_EVIN] + col; }
    if (m == 1) { ld = 1024; return p.in[I_EVOUT] + n; }
    if (m == 2) { ld = 3584; return p.in[I_ODIN] + n; }
    if (m == 3) { ld = 1024; return p.in[I_ODOUT] + n; }
    if (m < 6) { ld = 2816; const int l = m - 4, pn = n >> 8, w = n & 255; const size_t lo = (size_t)l * 1024 * 2816; return (w < 128) ? p.in[I_W1] + lo + 128 * pn + w : p.in[I_W3] + lo + 128 * pn + (w - 128); }
    ld = 1024; return p.in[I_W2] + (size_t)(m - 6) * 2816 * 1024 + n;
}
DI void phase_wprep(const P& p, LAS unsigned char* ldsb) {
    LAS float* tile = (LAS float*)ldsb;
    const int tid = mk_tid(), tx = tid & 63, ty = tid >> 6;
    for (int item = blockIdx.x; item < 6656; item += gridDim.x) {
        int m = 0;
#pragma unroll
        for (int q = 1; q < 8; ++q) if (item >= matTile0(q)) m = q;
        const int local = item - matTile0(m), K = matK(m), nK = K >> 6, nb = local / nK, kb = local - nb * nK, n0 = nb * 64, k0 = kb * 64;
        bf16_t* Bt = (bf16_t*)(p.ws + matOff(m));
        int ld; const float* src = matSrc(p, m, n0 + tx, ld);
        __syncthreads();
#pragma unroll
        for (int i = 0; i < 8; ++i) { const int k = k0 + ty + 8 * i; tile[(ty + 8 * i) * 65 + tx] = src ? src[(size_t)k * ld] : 0.f; }
        __syncthreads();
#pragma unroll
        for (int i = 0; i < 8; ++i) { const int nn = ty + 8 * i; Bt[(size_t)(n0 + nn) * K + k0 + tx] = f2bf(tile[tx * 65 + nn]); }
    }
    __syncthreads();
}
DI void phase_modv(const P& p, LAS unsigned char* ldsb) {
    LAS float* sc = (LAS float*)ldsb;
    const int tid = mk_tid();
    float* MODV = (float*)(p.ws + WS_MODV);
    __syncthreads();
    for (int e = tid; e < 5 * 1024; e += NT) { const int s = e >> 10, k = e & 1023; const float v = (s < 4) ? p.in[I_C][s * 1024 + k] : p.in[I_CCTX][k]; sc[e] = siluf(v); }
    __syncthreads();
    for (int vb = blockIdx.x; vb < 24; vb += gridDim.x) {
        const int l = vb / 12, n = (vb % 12) * 512 + tid;
        const float* W = p.in[I_MODW] + (size_t)l * 1024 * 6144 + n;
        float a0 = 0.f, a1 = 0.f, a2 = 0.f, a3 = 0.f, a4 = 0.f;
#pragma unroll 8
        for (int k = 0; k < 1024; ++k) { const float w = W[(size_t)k * 6144]; a0 += sc[k] * w; a1 += sc[1024 + k] * w; a2 += sc[2048 + k] * w; a3 += sc[3072 + k] * w; a4 += sc[4096 + k] * w; }
        const float bb = p.in[I_MODB][l * 6144 + n];
        float* o = MODV + (size_t)l * 5 * 6144 + n;
        o[0] = a0 + bb; o[6144] = a1 + bb; o[2 * 6144] = a2 + bb; o[3 * 6144] = a3 + bb; o[4 * 6144] = a4 + bb;
    }
    __syncthreads();
}

DI void phase_modnorm(const P& p, int layer, int which, const float* hlat, const float* hctx, int nrows, bool permute) {
    const int lane = mk_tid() & 63, wv = mk_tid() >> 6;
    const float* MODV = (const float*)(p.ws + WS_MODV) + (size_t)layer * 5 * 6144;
    const float* g = p.in[which ? I_N2G : I_N1G] + layer * 1024;
    bf16_t* ACT = (bf16_t*)(p.ws + WS_ACT);
    for (int r = blockIdx.x * 8 + wv; r < nrows; r += gridDim.x * 8) {
        const bool isctx = r >= NLAT;
        const float* src = isctx ? hctx + (size_t)(r - NLAT) * D : hlat + (size_t)r * D;
        const int sv = isctx ? 4 : r / L;
        const float* shift = MODV + sv * 6144 + (which ? 3 : 0) * 1024; const float* scale = shift + 1024;
        int dr = r;
        if (permute && !isctx) { const int b = r / L, t = r % L; dr = b * L + (t % 64) * 128 + t / 64; }
        f32x4 v[4]; float ss = 0.f;
#pragma unroll
        for (int j = 0; j < 4; ++j) { v[j] = *(const f32x4*)(src + 4 * lane + 256 * j); ss += v[j].x * v[j].x + v[j].y * v[j].y + v[j].z * v[j].z + v[j].w * v[j].w; }
        const float rinv = rsqrtf(wave_sum(ss) * (1.f / D) + 1e-6f);
#pragma unroll
        for (int j = 0; j < 4; ++j) { const int c = 4 * lane + 256 * j;
            const f32x4 gg = *(const f32x4*)(g + c), sc = *(const f32x4*)(scale + c), sh = *(const f32x4*)(shift + c);
            const float o0 = v[j].x * rinv * gg.x * (1.f + sc.x) + sh.x, o1 = v[j].y * rinv * gg.y * (1.f + sc.y) + sh.y, o2 = v[j].z * rinv * gg.z * (1.f + sc.z) + sh.z, o3 = v[j].w * rinv * gg.w * (1.f + sc.w) + sh.w;
            u32x2 w; w.x = (unsigned)f2bf(o0) | ((unsigned)f2bf(o1) << 16); w.y = (unsigned)f2bf(o2) | ((unsigned)f2bf(o3) << 16);
            *(u32x2*)(ACT + (size_t)dr * D + c) = w; }
    }
}
DI void phase_finalnorm(const P& p) {
    const int lane = mk_tid() & 63, wv = mk_tid() >> 6;
    const float* g = p.in[I_FING];
    for (int r = blockIdx.x * 8 + wv; r < NLAT; r += gridDim.x * 8) {
        float* src = p.out + (size_t)r * D;
        f32x4 v[4]; float ss = 0.f;
#pragma unroll
        for (int j = 0; j < 4; ++j) { v[j] = *(const f32x4*)(src + 4 * lane + 256 * j); ss += v[j].x * v[j].x + v[j].y * v[j].y + v[j].z * v[j].z + v[j].w * v[j].w; }
        const float rinv = rsqrtf(wave_sum(ss) * (1.f / D) + 1e-6f);
#pragma unroll
        for (int j = 0; j < 4; ++j) { const int c = 4 * lane + 256 * j; const f32x4 gg = *(const f32x4*)(g + c);
            f32x4 o; o.x = v[j].x * rinv * gg.x; o.y = v[j].y * rinv * gg.y; o.z = v[j].z * rinv * gg.z; o.w = v[j].w * rinv * gg.w; *(f32x4*)(src + c) = o; }
    }
}

struct EpiStore3 {
    static constexpr bool PERM = false, AFTER_DRAIN = false;
    bf16_t* p0; int ld0; int pn1; bf16_t* p1; int ld1; int pn2; bf16_t* p2; int ld2;
    DI void operator()(const f32x4 (&acc)[2][2][4][2], const pg8::Unit& u, int wr, int wc, int fr, int fq) const {
        bf16_t* base; int ld, ct;
        if (u.pn >= pn2) { base = p2; ld = ld2; ct = u.pn - pn2; } else if (u.pn >= pn1) { base = p1; ld = ld1; ct = u.pn - pn1; } else { base = p0; ld = ld0; ct = u.pn; }
        const int row0 = u.pm * 256 + wr * 64 + fr, col0 = ct * 256 + wc * 32 + 4 * fq;
#pragma unroll
        for (int ai = 0; ai < 2; ++ai)
#pragma unroll
            for (int m = 0; m < 4; ++m) { bf16_t* rowp = base + (size_t)(row0 + ai * 128 + m * 16) * ld + col0;
#pragma unroll
                for (int bj = 0; bj < 2; ++bj)
#pragma unroll
                    for (int n = 0; n < 2; ++n) { const f32x4 v = acc[ai][bj][m][n]; u32x2 w; w.x = pg8::cvt_pk_bf16(v[0], v[1]); w.y = pg8::cvt_pk_bf16(v[2], v[3]); *(u32x2*)(rowp + bj * 128 + n * 16) = w; } }
    }
};
struct EpiResid {
    static constexpr bool PERM = false, AFTER_DRAIN = false;
    const float* hin; float* hout; const float* cin; float* cout; const float* modv_l; int gidx;
    DI void operator()(const f32x4 (&acc)[2][2][4][2], const pg8::Unit& u, int wr, int wc, int fr, int fq) const {
        const bool isctx = u.pm >= 128; const int sv = isctx ? 4 : (u.pm >> 5);
        const float* gate = modv_l + sv * 6144 + gidx * 1024;
        const float* bi = isctx ? cin : hin; float* bo = isctx ? cout : hout;
        const int row0 = (isctx ? (u.pm - 128) : u.pm) * 256 + wr * 64 + fr, col0 = u.pn * 256 + wc * 32 + 4 * fq;
        f32x4 gv[2][2];
#pragma unroll
        for (int bj = 0; bj < 2; ++bj)
#pragma unroll
            for (int n = 0; n < 2; ++n) gv[bj][n] = *(const f32x4*)(gate + col0 + bj * 128 + n * 16);
#pragma unroll
        for (int ai = 0; ai < 2; ++ai)
#pragma unroll
            for (int m = 0; m < 4; ++m) { const size_t off = (size_t)(row0 + ai * 128 + m * 16) * D + col0;
#pragma unroll
                for (int bj = 0; bj < 2; ++bj)
#pragma unroll
                    for (int n = 0; n < 2; ++n) { const f32x4 bs = *(const f32x4*)(bi + off + bj * 128 + n * 16); *(f32x4*)(bo + off + bj * 128 + n * 16) = bs + gv[bj][n] * acc[ai][bj][m][n]; } }
    }
};
struct EpiSwiglu {
    static constexpr bool PERM = false, AFTER_DRAIN = false;
    bf16_t* G;
    DI void operator()(const f32x4 (&acc)[2][2][4][2], const pg8::Unit& u, int wr, int wc, int fr, int fq) const {
        const int row0 = u.pm * 256 + wr * 64 + fr, col0 = u.pn * 128 + wc * 32 + 4 * fq;
#pragma unroll
        for (int ai = 0; ai < 2; ++ai)
#pragma unroll
            for (int m = 0; m < 4; ++m) { bf16_t* rowp = G + (size_t)(row0 + ai * 128 + m * 16) * DFF + col0;
#pragma unroll
                for (int n = 0; n < 2; ++n) { const f32x4 a = acc[ai][0][m][n], b = acc[ai][1][m][n];
                    const float g0 = a[0] / (1.f + __expf(-a[0])) * b[0], g1 = a[1] / (1.f + __expf(-a[1])) * b[1], g2 = a[2] / (1.f + __expf(-a[2])) * b[2], g3 = a[3] / (1.f + __expf(-a[3])) * b[3];
                    u32x2 w; w.x = pg8::cvt_pk_bf16(g0, g1); w.y = pg8::cvt_pk_bf16(g2, g3); *(u32x2*)(rowp + n * 16) = w; } }
    }
};
template <class Epi> DI void run_gemm(LAS unsigned char* lds, const bf16_t* A, const bf16_t* Bt, int M, int N, int K, const Epi& E) {
    pg8::Gemm g{A, Bt, M, N, K}; pg8::StaticOrder S; S.init(M, N, (int)gridDim.x, (int)blockIdx.x);
    pg8::gemm_phase<Epi, pg8::StaticOrder, false>((PG8_LAS unsigned char*)lds, g, S, E, nullptr);
    __syncthreads();
}

DI void phase_rwkv_scan_unit(const P& p, LAS unsigned char* ldsb, const int vb) {
    LAS float* lds = (LAS float*)ldsb;
    LAS float *w2s = lds, *a2s = lds + 4096, *prm = lds + 8192, *TH = prm + 768, *AD = TH + 2048, *R = AD + 2048, *W = R + 2048, *K = W + 2048, *KK = K + 2048, *BV = KK + 2048,
              *V = BV + 2048, *BS = V + 2048, *OUT = BS + 32;
    const int tid = mk_tid(), lane = tid & 63, wv = tid >> 6;
    const bf16_t* RW = (const bf16_t*)(p.ws + WS_COLS) + OFF_RW; const bf16_t* LO = (const bf16_t*)(p.ws + WS_COLS) + OFF_LO; bf16_t* Z = (bf16_t*)(p.ws + WS_Z);
    const int srow = tid >> 3, sg = tid & 7;
    {
        const int d = vb >> 5, b = (vb >> 3) & 3, h = vb & 7;
        __syncthreads();
        for (int e = tid; e < 4096; e += NT) { const int i = e >> 6, c = e & 63; w2s[e] = p.in[I_W2L][(size_t)(d * 64 + i) * 512 + 64 * h + c]; a2s[e] = p.in[I_A2L][(size_t)(d * 64 + i) * 512 + 64 * h + c]; }
        if (tid < 64) { const int j = tid, c = 64 * h + j; const float* mu = p.in[I_MU] + d * 1664;
            prm[j] = mu[c]; prm[64 + j] = mu[512 + c]; prm[128 + j] = mu[1024 + c]; prm[192 + j] = mu[1536 + j]; prm[256 + j] = mu[1600 + j];
            prm[320 + j] = p.in[I_W0][d * 512 + c]; prm[384 + j] = p.in[I_A0][d * 512 + c]; prm[448 + j] = p.in[I_KK][d * 512 + c]; prm[512 + j] = p.in[I_KA][d * 512 + c];
            prm[576 + j] = p.in[I_RK][(d * 8 + h) * 64 + j]; prm[640 + j] = p.in[I_LNW][d * 512 + c]; prm[704 + j] = p.in[I_LNB][d * 512 + c]; }
        __syncthreads();
        float S0 = 0.f, S1 = 0.f, S2 = 0.f, S3 = 0.f, S4 = 0.f, S5 = 0.f, S6 = 0.f, S7 = 0.f;
        for (int n0 = 0; n0 < LT; n0 += 32) {
            float rs[4], ks[4], vs[4];
#pragma unroll
            for (int m = 0; m < 4; ++m) { const int s = wv + 8 * m, n = n0 + s; const bool hp = (n != 0) && (n != LC);
                const size_t row = (size_t)step_row(d, b, n), prow = hp ? (size_t)step_row(d, b, n - 1) : row; const int c = 64 * h + lane;
                const float r0 = bf2f(RW[row * 1536 + c]), k0 = bf2f(RW[row * 1536 + 512 + c]), v0 = bf2f(RW[row * 1536 + 1024 + c]);
                const float r1 = hp ? bf2f(RW[prow * 1536 + c]) : 0.f, k1 = hp ? bf2f(RW[prow * 1536 + 512 + c]) : 0.f, v1 = hp ? bf2f(RW[prow * 1536 + 1024 + c]) : 0.f;
                rs[m] = r0 + prm[lane] * (r1 - r0); ks[m] = k0 + prm[64 + lane] * (k1 - k0); vs[m] = v0 + prm[128 + lane] * (v1 - v0);
                const float wd0 = bf2f(LO[row * 512 + 64 * d + lane]), wd1 = hp ? bf2f(LO[prow * 512 + 64 * d + lane]) : 0.f;
                const float ad0 = bf2f(LO[row * 512 + 128 + 64 * d + lane]), ad1 = hp ? bf2f(LO[prow * 512 + 128 + 64 * d + lane]) : 0.f;
                TH[s * 64 + lane] = tanhf(wd0 + prm[192 + lane] * (wd1 - wd0)); AD[s * 64 + lane] = ad0 + prm[256 + lane] * (ad1 - ad0); }
            __syncthreads();
#pragma unroll
            for (int m = 0; m < 4; ++m) { const int s = wv + 8 * m;
                float xw = prm[320 + lane], xa = prm[384 + lane];
#pragma unroll 8
                for (int i = 0; i < 64; ++i) { xw += TH[s * 64 + i] * w2s[i * 64 + lane]; xa += AD[s * 64 + i] * a2s[i * 64 + lane]; }
                const float elog = 0.6065306597126334f * sigm(xw), dec = expf(-elog), a = sigm(xa);
                const float kkr = ks[m] * prm[448 + lane]; const float ss = wave_sum(kkr * kkr); const float kkn = kkr / fmaxf(sqrtf(ss), 1e-12f);
                const float km = ks[m] * (1.f + (a - 1.f) * prm[512 + lane]);
                const float bs = wave_sum(rs[m] * km * prm[576 + lane]);
                R[s * 64 + lane] = rs[m]; W[s * 64 + lane] = dec; K[s * 64 + lane] = km; KK[s * 64 + lane] = kkn; BV[s * 64 + lane] = kkn * a; V[s * 64 + lane] = vs[m];
                if (lane == 0) BS[s] = bs; }
            __syncthreads();
            for (int s = 0; s < 32; ++s) {
                const LAS f32x4* pq = (const LAS f32x4*)(KK + s * 64 + 8 * sg); const f32x4 q0 = pq[0], q1 = pq[1];
                const LAS f32x4* pw = (const LAS f32x4*)(W + s * 64 + 8 * sg); const f32x4 w0 = pw[0], w1 = pw[1];
                const LAS f32x4* pb = (const LAS f32x4*)(BV + s * 64 + 8 * sg); const f32x4 b0 = pb[0], b1 = pb[1];
                const LAS f32x4* pk = (const LAS f32x4*)(K + s * 64 + 8 * sg); const f32x4 k0 = pk[0], k1 = pk[1];
                const LAS f32x4* pr = (const LAS f32x4*)(R + s * 64 + 8 * sg); const f32x4 r0 = pr[0], r1 = pr[1];
                const float vi = V[s * 64 + srow];
                float sa = S0 * q0.x + S1 * q0.y + S2 * q0.z + S3 * q0.w + S4 * q1.x + S5 * q1.y + S6 * q1.z + S7 * q1.w;
                sa += __shfl_xor(sa, 1); sa += __shfl_xor(sa, 2); sa += __shfl_xor(sa, 4);
                S0 = S0 * w0.x - sa * b0.x + vi * k0.x; S1 = S1 * w0.y - sa * b0.y + vi * k0.y; S2 = S2 * w0.z - sa * b0.z + vi * k0.z; S3 = S3 * w0.w - sa * b0.w + vi * k0.w;
                S4 = S4 * w1.x - sa * b1.x + vi * k1.x; S5 = S5 * w1.y - sa * b1.y + vi * k1.y; S6 = S6 * w1.z - sa * b1.z + vi * k1.z; S7 = S7 * w1.w - sa * b1.w + vi * k1.w;
                float o = S0 * r0.x + S1 * r0.y + S2 * r0.z + S3 * r0.w + S4 * r1.x + S5 * r1.y + S6 * r1.z + S7 * r1.w;
                o += __shfl_xor(o, 1); o += __shfl_xor(o, 2); o += __shfl_xor(o, 4);
                if (sg == 0) OUT[s * 64 + srow] = o;
            }
            __syncthreads();
#pragma unroll
            for (int m = 0; m < 4; ++m) { const int s = wv + 8 * m, n = n0 + s; const size_t row = (size_t)step_row(d, b, n);
                const float o = OUT[s * 64 + lane]; const float mean = wave_sum(o) * (1.f / 64.f); const float dv = o - mean; const float var = wave_sum(dv * dv) * (1.f / 64.f);
                const float z = dv * rsqrtf(var + 64e-5f) * prm[640 + lane] + prm[704 + lane] + BS[s] * V[s * 64 + lane];
                Z[((size_t)d * NALL + row) * 512 + 64 * h + lane] = f2bf(z); }
        }
    }
    __syncthreads();
}
DI void phase_rwkv_post(const P& p, LAS unsigned char* ldsb) {
    LAS float* sg = (LAS float*)ldsb;
    const int tid = mk_tid();
    const bf16_t* LO = (const bf16_t*)(p.ws + WS_COLS) + OFF_LO; const bf16_t* Z = (const bf16_t*)(p.ws + WS_Z); bf16_t* Y = (bf16_t*)(p.ws + WS_COLS);
    const float* g2 = p.in[I_G2];
    for (int vb = blockIdx.x; vb < NALL / 8; vb += gridDim.x) {
        const size_t row0 = (size_t)vb * 8;
        __syncthreads();
        for (int e = tid; e < 1024; e += NT) { const int q = e >> 7, r = e & 127; sg[e] = sigm(bf2f(LO[(row0 + q) * 512 + 256 + r])); }
        __syncthreads();
        float a0 = 0.f, a1 = 0.f, a2 = 0.f, a3 = 0.f, a4 = 0.f, a5 = 0.f, a6 = 0.f, a7 = 0.f;
#pragma unroll 4
        for (int r = 0; r < 128; ++r) { const float g = g2[r * 512 + tid];
            a0 += sg[r] * g; a1 += sg[128 + r] * g; a2 += sg[256 + r] * g; a3 += sg[384 + r] * g; a4 += sg[512 + r] * g; a5 += sg[640 + r] * g; a6 += sg[768 + r] * g; a7 += sg[896 + r] * g; }
#define MK_RP(q, aq) { const size_t rr = row0 + q; const float z = bf2f(Z[rr * 512 + tid]) + bf2f(Z[((size_t)NALL + rr) * 512 + tid]); Y[rr * D + tid] = f2bf(z * aq); }
        MK_RP(0, a0) MK_RP(1, a1) MK_RP(2, a2) MK_RP(3, a3) MK_RP(4, a4) MK_RP(5, a5) MK_RP(6, a6) MK_RP(7, a7)
#undef MK_RP
    }
    __syncthreads();
}
DI void post_headnorm_row(const bf16_t* HB, size_t row, const float* ng, const bf16_t* gsrc, int gate_kind, bf16_t* ydst, int lane) {
    const int c0 = 8 * lane;
    const u32x4 h0 = *(const u32x4*)(HB + row * 512 + c0), h1 = *(const u32x4*)(HB + ((size_t)NALL + row) * 512 + c0), gg = *(const u32x4*)(gsrc + c0);
    float h[8], g[8];
#pragma unroll
    for (int j = 0; j < 4; ++j) { h[2 * j] = __uint_as_float(h0[j] << 16) + __uint_as_float(h1[j] << 16); h[2 * j + 1] = __uint_as_float(h0[j] & 0xffff0000u) + __uint_as_float(h1[j] & 0xffff0000u);
        g[2 * j] = __uint_as_float(gg[j] << 16); g[2 * j + 1] = __uint_as_float(gg[j] & 0xffff0000u); }
    float ss = 0.f;
#pragma unroll
    for (int j = 0; j < 8; ++j) ss += h[j] * h[j];
    ss += __shfl_xor(ss, 1); ss += __shfl_xor(ss, 2); ss += __shfl_xor(ss, 4); ss += __shfl_xor(ss, 8);
    const float rinv = rsqrtf(ss * (1.f / 128.f) + 1e-6f);
    unsigned o[4];
#pragma unroll
    for (int j = 0; j < 4; ++j) { const float y0 = h[2 * j] * rinv * ng[c0 + 2 * j] * (gate_kind ? siluf(g[2 * j]) : sigm(g[2 * j])), y1 = h[2 * j + 1] * rinv * ng[c0 + 2 * j + 1] * (gate_kind ? siluf(g[2 * j + 1]) : sigm(g[2 * j + 1]));
        o[j] = (unsigned)f2bf(y0) | ((unsigned)f2bf(y1) << 16); }
    u32x4 w; w.x = o[0]; w.y = o[1]; w.z = o[2]; w.w = o[3];
    *(u32x4*)(ydst + c0) = w;
}
typedef short bf16x8 __attribute__((ext_vector_type(8)));
typedef short s16x4 __attribute__((ext_vector_type(4)));
constexpr int PQ = 136, PS = 72, PV = 56;
constexpr int E_QS = 0, E_KS = E_QS + 64 * PQ * 2, E_VS = E_KS + 64 * PQ * 2, E_PS = E_VS + 64 * PV * 2, E_ST = E_PS + 64 * PS * 2, E_F = E_ST + 48 * PQ * 2, E_END = E_F + 1024;
constexpr size_t WS_Q1 = WS_COLS + (size_t)231 * MiB;
constexpr int NRC = NALL / 64;

DI int chunk_row0(int d, int b, int ci) {
    if (ci < 4) { const int cc = d ? 3 - ci : ci; return NLAT + b * LC + 64 * cc; }
    const int lc = ci - 4, cl = d ? 127 - lc : lc; return b * L + 64 * cl;
}
DI unsigned pack2(float lo, float hi) { return (unsigned)f2bf(lo) | ((unsigned)f2bf(hi) << 16); }
DI bf16x8 tr_frag(unsigned tile_base, int pitch, int k0, int c0, int r, int q) {
    const unsigned a0 = tile_base + (unsigned)(((k0 + 8 * q + (r >> 2)) * pitch + c0 + 4 * (r & 3)) * 2), a1 = a0 + (unsigned)(4 * pitch * 2);
    s16x4 x, y;
    asm volatile("ds_read_b64_tr_b16 %0, %2\n\tds_read_b64_tr_b16 %1, %3\n\ts_waitcnt lgkmcnt(0)" : "=&v"(x), "=&v"(y) : "v"(a0), "v"(a1) : "memory");
    bf16x8 o; o[0] = x[0]; o[1] = x[1]; o[2] = x[2]; o[3] = x[3]; o[4] = y[0]; o[5] = y[1]; o[6] = y[2]; o[7] = y[3];
    return o;
}

#define GLA_PREFETCH(ci_) do { const int row0_ = chunk_row0(d, b, (ci_)); \
    _Pragma("unroll") for (int i = 0; i < 2; ++i) { const size_t row_ = (size_t)(row0_ + prow0 + 32 * i); \
        rq[i] = *(const u32x4*)(Qg + row_ * ldq + 8 * ppc); rk[i] = *(const u32x4*)(Kg + row_ * ldk + 8 * ppc); } \
    if (tid < 256) rv = *(const u32x4*)(Vg + (size_t)(row0_ + vrow) * ldv + 8 * vpc); \
    if (MODE == 0) { if (tid < 64) { const size_t row_ = (size_t)(row0_ + (d ? 63 - lane : lane)); gi = bf2f(LO[row_ * 512 + 384 + 4 * d + hd]); gf = bf2f(LO[row_ * 512 + 392 + 4 * d + hd]); } } \
    else rlam = *(const f32x4*)(LAM + ((size_t)d * NRC + (row0_ >> 6)) * 512 + 128 * hd + 16 * wv + 4 * q); } while (0)

template <int MODE> DI void gla_unit(const P& p, LAS unsigned char* lds, int unit) {
    constexpr int NDV = MODE == 0 ? 3 : 2;
    const int tid = mk_tid(), lane = tid & 63, wv = __builtin_amdgcn_readfirstlane(tid >> 6), r = lane & 15, q = lane >> 4;
    const int d = unit >> 6, b = (unit >> 4) & 3, hd = (unit >> 2) & 3, sl = unit & 3;
    const bf16_t* COLS = (const bf16_t*)(p.ws + WS_COLS);
    const bf16_t *Qg, *Kg, *Vg; int ldq, ldk, ldv;
    if (MODE == 0) { const bf16_t* ML = COLS + OFF_ML; Qg = ML + 128 * hd; Kg = ML + 512 + 128 * hd; Vg = ML + 1024 + 128 * hd + 32 * sl; ldq = ldk = ldv = 2048; }
    else { Qg = d ? (const bf16_t*)(p.ws + WS_Q1) + 128 * hd : COLS + 128 * hd; ldq = d ? 512 : 3584; Kg = COLS + 512 + 512 * d + 128 * hd; ldk = 3584; Vg = COLS + 1536 + 128 * hd + 32 * sl; ldv = 3584; }
    const bf16_t* LO = COLS + OFF_LO;
    const float* LAM = (const float*)(p.ws + WS_LAM);
    bf16_t* HB = (bf16_t*)(p.ws + WS_ACT);
    LAS bf16_t* Qs = (LAS bf16_t*)(lds + E_QS); LAS bf16_t* Ks = (LAS bf16_t*)(lds + E_KS); LAS bf16_t* Vs = (LAS bf16_t*)(lds + E_VS);
    LAS bf16_t* Ps = (LAS bf16_t*)(lds + E_PS); LAS bf16_t* STs = (LAS bf16_t*)(lds + E_ST); LAS float* Fs = (LAS float*)(lds + E_F);
    const unsigned ks_base = (unsigned)(size_t)Ks, vs_base = (unsigned)(size_t)Vs;
    float bi = 0.f, bfv = 0.f;
    if (MODE == 0) { bi = p.in[I_MBI][d * 4 + hd]; bfv = p.in[I_MBF][d * 4 + hd]; }
    __syncthreads();
    for (int e = tid; e < 48 * PQ / 2; e += NT) ((LAS unsigned*)STs)[e] = 0u;
    for (int e = tid; e < 64 * PV / 2; e += NT) ((LAS unsigned*)Vs)[e] = 0u;
    __syncthreads();
    f32x4 Sacc[NDV];
#pragma unroll
    for (int n = 0; n < NDV; ++n) Sacc[n] = (f32x4){0.f, 0.f, 0.f, 0.f};
    u32x4 rq[2], rk[2], rv = (u32x4){0u, 0u, 0u, 0u}; float gi = 0.f, gf = 0.f; f32x4 rlam = (f32x4){1.f, 1.f, 1.f, 1.f};
    const int prow0 = tid >> 4, ppc = tid & 15;
    const int vrow = tid >> 2, vpc = tid & 3;
    GLA_PREFETCH(0);
    for (int ci = 0; ci < 132; ++ci) {
        const int row0 = chunk_row0(d, b, ci);
        unsigned oz = 0u; asm volatile("" : "+v"(oz));
        const unsigned ks_b = ks_base + oz, vs_b = vs_base + oz;
        f32x4 lamv = rlam;
        if (MODE == 0) {
            if (tid < 64) {
                const float li = gi + bi, x = gf + bfv;
                float v = -log1pf(expf(-x));
#pragma unroll
                for (int o = 1; o < 64; o <<= 1) { const float t = __shfl_up(v, o); if (lane >= o) v += t; }
                const int rc = d ? 63 - lane : lane;
                Fs[rc] = expf(v) * 0.08838834764831845f; Fs[64 + rc] = expf(li - v);
                if (lane == 63) Fs[128] = expf(v);
            }
        }
#pragma unroll
        for (int i = 0; i < 2; ++i) { const int row = prow0 + 32 * i; *(LAS u32x4*)(Qs + row * PQ + 8 * ppc) = rq[i]; *(LAS u32x4*)(Ks + row * PQ + 8 * ppc) = rk[i]; }
        if (MODE == 0) __syncthreads();
        if (tid < 256) {
            if (MODE == 0) { const float w = Fs[64 + vrow]; u32x4 o;
#pragma unroll
                for (int e = 0; e < 4; ++e) o[e] = pack2(__uint_as_float(rv[e] << 16) * w, __uint_as_float(rv[e] & 0xffff0000u) * w);
                *(LAS u32x4*)(Vs + vrow * PV + 8 * vpc) = o;
                if (vpc == 0) Vs[vrow * PV + 32] = f2bf(w); }
            else *(LAS u32x4*)(Vs + vrow * PV + 8 * vpc) = rv;
        }
        __syncthreads();
        if (ci + 1 < 132) GLA_PREFETCH(ci + 1);
        if (MODE == 0) { const float l = Fs[128]; lamv = (f32x4){l, l, l, l}; }
        {
            const int tt = wv & 3, sh = wv >> 2;
            f32x4 pacc[2] = {(f32x4){0.f, 0.f, 0.f, 0.f}, (f32x4){0.f, 0.f, 0.f, 0.f}};
#pragma unroll
            for (int kk = 0; kk < 4; ++kk) { const bf16x8 bq = *(const LAS bf16x8*)(Qs + (16 * tt + r) * PQ + 32 * kk + 8 * q);
#pragma unroll
                for (int i = 0; i < 2; ++i) { const bf16x8 a = *(const LAS bf16x8*)(Ks + (16 * (2 * sh + i) + r) * PQ + 32 * kk + 8 * q); pacc[i] = __builtin_amdgcn_mfma_f32_16x16x32_bf16(a, bq, pacc[i], 0, 0, 0); } }
            const int t = 16 * tt + r;
#pragma unroll
            for (int i = 0; i < 2; ++i) { const int s0 = 16 * (2 * sh + i) + 4 * q; float v[4];
#pragma unroll
                for (int j = 0; j < 4; ++j) { const int s = s0 + j; const bool ok = d ? (s >= t) : (s <= t); v[j] = ok ? pacc[i][j] : 0.f; }
                u32x2 w; w.x = pack2(v[0], v[1]); w.y = pack2(v[2], v[3]); *(LAS u32x2*)(Ps + t * PS + s0) = w; }
        }
#pragma unroll
        for (int kk = 0; kk < 2; ++kk) { const bf16x8 a = tr_frag(ks_b, PQ, 32 * kk, 16 * wv, r, q);
#pragma unroll
            for (int n = 0; n < NDV; ++n) { const bf16x8 bv = tr_frag(vs_b, PV, 32 * kk, 16 * n, r, q); Sacc[n] = __builtin_amdgcn_mfma_f32_16x16x32_bf16(a, bv, Sacc[n], 0, 0, 0); } }
        __syncthreads();
        {
            const int tt = wv & 3, nA = wv >> 2;
            f32x4 oacc = (f32x4){0.f, 0.f, 0.f, 0.f}, dacc = (f32x4){0.f, 0.f, 0.f, 0.f};
#pragma unroll
            for (int kk = 0; kk < 2; ++kk) { const bf16x8 bp = *(const LAS bf16x8*)(Ps + (16 * tt + r) * PS + 32 * kk + 8 * q);
                const bf16x8 a = tr_frag(vs_b, PV, 32 * kk, 16 * nA, r, q); oacc = __builtin_amdgcn_mfma_f32_16x16x32_bf16(a, bp, oacc, 0, 0, 0);
                if (MODE == 0) { const bf16x8 a2 = tr_frag(vs_b, PV, 32 * kk, 32, r, q); dacc = __builtin_amdgcn_mfma_f32_16x16x32_bf16(a2, bp, dacc, 0, 0, 0); } }
#pragma unroll
            for (int kk = 0; kk < 4; ++kk) { const bf16x8 bq = *(const LAS bf16x8*)(Qs + (16 * tt + r) * PQ + 32 * kk + 8 * q);
                const bf16x8 a = *(const LAS bf16x8*)(STs + (16 * nA + r) * PQ + 32 * kk + 8 * q); oacc = __builtin_amdgcn_mfma_f32_16x16x32_bf16(a, bq, oacc, 0, 0, 0);
                if (MODE == 0) { const bf16x8 a2 = *(const LAS bf16x8*)(STs + (32 + r) * PQ + 32 * kk + 8 * q); dacc = __builtin_amdgcn_mfma_f32_16x16x32_bf16(a2, bq, dacc, 0, 0, 0); } }
            const int t = 16 * tt + r;
            float o0 = oacc[0], o1 = oacc[1], o2 = oacc[2], o3 = oacc[3];
            if (MODE == 0) { const float rs = Fs[t]; const float den = __shfl(dacc[0], r) * rs; const float inv = rs / fmaxf(fabsf(den), 1.f); o0 *= inv; o1 *= inv; o2 *= inv; o3 *= inv; }
            u32x2 w; w.x = pack2(o0, o1); w.y = pack2(o2, o3);
            *(u32x2*)(HB + ((size_t)d * NALL + row0 + t) * 512 + 128 * hd + 32 * sl + 16 * nA + 4 * q) = w;
        }
        __syncthreads();
#pragma unroll
        for (int n = 0; n < NDV; ++n) { Sacc[n] = Sacc[n] * lamv; u32x2 w; w.x = pack2(Sacc[n][0], Sacc[n][1]); w.y = pack2(Sacc[n][2], Sacc[n][3]); *(LAS u32x2*)(STs + (16 * n + r) * PQ + 16 * wv + 4 * q) = w; }
    }
    __syncthreads();
}

DI void phase_hgrn_prep(const P& p, LAS unsigned char* ldsb) {
    LAS float* tot = (LAS float*)ldsb;
    const int tid = mk_tid(), ch = tid & 127, qt = tid >> 7;
    bf16_t* C1 = (bf16_t*)(p.ws + WS_COLS); bf16_t* Q1 = (bf16_t*)(p.ws + WS_Q1); float* LAM = (float*)(p.ws + WS_LAM);
    for (int vb = blockIdx.x; vb < NRC * 4; vb += gridDim.x) {
        const int rc = vb >> 2, hd = vb & 3, c = 128 * hd + ch; const size_t rbase = (size_t)rc * 64 + 16 * qt;
        const float lb = sigm(p.in[I_HLB][512 + c] - p.in[I_HLB][c]);
        float qv[16], l0[16], l1[16], k0[16], k1[16];
#pragma unroll
        for (int i = 0; i < 16; ++i) { const bf16_t* base = C1 + (rbase + i) * 3584;
            qv[i] = siluf(bf2f(base[c])); const float s0 = sigm(bf2f(base[512 + c])), s1 = sigm(bf2f(base[1024 + c]));
            l0[i] = logf(lb + (1.f - lb) * s0); l1[i] = logf(lb + (1.f - lb) * s1); k0[i] = (1.f - lb) * (1.f - s0); k1[i] = (1.f - lb) * (1.f - s1); }
#pragma unroll
        for (int i = 1; i < 16; ++i) l0[i] += l0[i - 1];
#pragma unroll
        for (int i = 14; i >= 0; --i) l1[i] += l1[i + 1];
        __syncthreads();
        tot[qt * 128 + ch] = l0[15]; tot[512 + qt * 128 + ch] = l1[0];
        __syncthreads();
        float off0 = 0.f, off1 = 0.f, t0 = 0.f, t1 = 0.f;
#pragma unroll
        for (int j = 0; j < 4; ++j) { const float a = tot[j * 128 + ch], bb = tot[512 + j * 128 + ch]; t0 += a; t1 += bb; if (j < qt) off0 += a; if (j > qt) off1 += bb; }
#pragma unroll
        for (int i = 0; i < 16; ++i) { bf16_t* base = C1 + (rbase + i) * 3584; const float c0 = l0[i] + off0, c1 = l1[i] + off1;
            base[c] = f2bf(qv[i] * expf(c0)); base[512 + c] = f2bf(k0[i] * expf(-c0)); base[1024 + c] = f2bf(k1[i] * expf(-c1)); Q1[(rbase + i) * 512 + c] = f2bf(qv[i] * expf(c1)); }
        if (qt == 0) { LAM[((size_t)rc) * 512 + c] = expf(t0); LAM[((size_t)NRC + rc) * 512 + c] = expf(t1); }
    }
    __syncthreads();
}
constexpr int L_XB = 0, L_XCS = L_XB + 67 * 64 * 4, L_WA = L_XCS + 64 * 72 * 2, L_WI = L_WA + 64 * 72 * 2, L_XCF = L_WI + 64 * 72 * 2, L_AA = L_XCF + 64 * 64 * 4, L_UU = L_AA + 64 * 65 * 4,
              L_SEG = L_UU + 64 * 65 * 4, L_PRM = L_SEG + 2 * 8 * 64 * 4, L_END = L_PRM + 10 * 64 * 4;
DI void lru_unit(const P& p, LAS unsigned char* lds, int unit) {
    const int tid = mk_tid(), lane = tid & 63, wv = __builtin_amdgcn_readfirstlane(tid >> 6), r = lane & 15, q = lane >> 4;
    const int b = unit >> 3, hb = unit & 7;
    const bf16_t* C1 = (const bf16_t*)(p.ws + WS_COLS); bf16_t* Z1 = (bf16_t*)(p.ws + WS_Z1); bf16_t* Y = (bf16_t*)(p.ws + WS_Z);
    LAS float* XB = (LAS float*)(lds + L_XB); LAS bf16_t* XCs = (LAS bf16_t*)(lds + L_XCS); LAS bf16_t* WAt = (LAS bf16_t*)(lds + L_WA); LAS bf16_t* WIt = (LAS bf16_t*)(lds + L_WI);
    LAS float* XCf = (LAS float*)(lds + L_XCF); LAS float* Aa = (LAS float*)(lds + L_AA); LAS float* Uu = (LAS float*)(lds + L_UU); LAS float* segP = (LAS float*)(lds + L_SEG); LAS float* segH = segP + 512;
    LAS float* prm = (LAS float*)(lds + L_PRM);
    for (int d = 0; d < 2; ++d) {
        __syncthreads();
        for (int e = tid; e < 4096; e += NT) { const int i = e >> 6, j = e & 63; const size_t o = ((size_t)(d * 8 + hb) * 64 + i) * 64 + j; WAt[j * 72 + i] = f2bf(p.in[I_WA][o]); WIt[j * 72 + i] = f2bf(p.in[I_WI][o]); }
        if (tid < 64) { const int ch = 64 * hb + tid;
            prm[tid] = p.in[I_CONVW][ch]; prm[64 + tid] = p.in[I_CONVW][512 + ch]; prm[128 + tid] = p.in[I_CONVW][1024 + ch]; prm[192 + tid] = p.in[I_CONVW][1536 + ch]; prm[256 + tid] = p.in[I_CONVB][ch];
            prm[320 + tid] = p.in[I_BA][d * 512 + ch]; prm[384 + tid] = p.in[I_BI][d * 512 + ch]; prm[448 + tid] = log1pf(expf(-p.in[I_LAM][d * 512 + ch])); prm[512 + tid] = 0.f; }
        __syncthreads();
        for (int ci = 0; ci < 132; ++ci) {
            const int row0 = chunk_row0(d, b, ci);
            const int seg_lo = (ci < 4) ? NLAT + b * LC : b * L, seg_hi = seg_lo + ((ci < 4) ? LC : L);
            for (int e = tid; e < 67 * 8; e += NT) { const int rr = e >> 3, pc = e & 7, grow = row0 - 2 + rr;
                u32x4 v = (u32x4){0u, 0u, 0u, 0u};
                if (grow >= seg_lo && grow < seg_hi) v = *(const u32x4*)(C1 + (size_t)grow * C1LD + 2560 + 64 * hb + 8 * pc);
                f32x4 lo, hi; lo[0] = __uint_as_float(v[0] << 16); lo[1] = __uint_as_float(v[0] & 0xffff0000u); lo[2] = __uint_as_float(v[1] << 16); lo[3] = __uint_as_float(v[1] & 0xffff0000u);
                hi[0] = __uint_as_float(v[2] << 16); hi[1] = __uint_as_float(v[2] & 0xffff0000u); hi[2] = __uint_as_float(v[3] << 16); hi[3] = __uint_as_float(v[3] & 0xffff0000u);
                *(LAS f32x4*)(XB + rr * 64 + 8 * pc) = lo; *(LAS f32x4*)(XB + rr * 64 + 8 * pc + 4) = hi; }
            __syncthreads();
            {
                const int t = tid >> 3, i0 = 8 * (tid & 7); float xc[8];
#pragma unroll
                for (int c = 0; c < 8; ++c) { const int i = i0 + c; xc[c] = prm[256 + i] + prm[i] * XB[t * 64 + i] + prm[64 + i] * XB[(t + 1) * 64 + i] + prm[128 + i] * XB[(t + 2) * 64 + i] + prm[192 + i] * XB[(t + 3) * 64 + i]; XCf[t * 64 + i] = xc[c]; }
                u32x4 w; w.x = pack2(xc[0], xc[1]); w.y = pack2(xc[2], xc[3]); w.z = pack2(xc[4], xc[5]); w.w = pack2(xc[6], xc[7]);
                *(LAS u32x4*)(XCs + t * 72 + i0) = w;
            }
            __syncthreads();
            {
                const int jt = wv & 3, th = wv >> 2, j = 16 * jt + r;
                const float ba = prm[320 + j], bi = prm[384 + j], spl = prm[448 + j];
#pragma unroll
                for (int i2 = 0; i2 < 2; ++i2) { const int tt = 2 * th + i2;
                    f32x4 aa = (f32x4){0.f, 0.f, 0.f, 0.f}, ai = (f32x4){0.f, 0.f, 0.f, 0.f};
#pragma unroll
                    for (int kk = 0; kk < 2; ++kk) { const bf16x8 xf = *(const LAS bf16x8*)(XCs + (16 * tt + r) * 72 + 32 * kk + 8 * q);
                        const bf16x8 wa = *(const LAS bf16x8*)(WAt + (16 * jt + r) * 72 + 32 * kk + 8 * q), wi = *(const LAS bf16x8*)(WIt + (16 * jt + r) * 72 + 32 * kk + 8 * q);
                        aa = __builtin_amdgcn_mfma_f32_16x16x32_bf16(xf, wa, aa, 0, 0, 0); ai = __builtin_amdgcn_mfma_f32_16x16x32_bf16(xf, wi, ai, 0, 0, 0); }
#pragma unroll
                    for (int jj = 0; jj < 4; ++jj) { const int t = 16 * tt + 4 * q + jj;
                        const float rg = sigm(aa[jj] + ba), ig = sigm(ai[jj] + bi), la = -8.f * rg * spl;
                        Aa[t * 65 + j] = expf(la); Uu[t * 65 + j] = sqrtf(-expm1f(2.f * la)) * (ig * XCf[t * 64 + j]); } }
            }
            __syncthreads();
            {
                const int sg = tid >> 6, j = lane;
                float pp = 1.f, hh = 0.f;
#pragma unroll
                for (int k = 0; k < 8; ++k) { const int u = 8 * sg + k, t = d ? 63 - u : u; const float a = Aa[t * 65 + j]; hh = a * hh + Uu[t * 65 + j]; pp *= a; }
                segP[sg * 64 + j] = pp; segH[sg * 64 + j] = hh;
                __syncthreads();
                float h = prm[512 + j];
                for (int s2 = 0; s2 < sg; ++s2) h = segP[s2 * 64 + j] * h + segH[s2 * 64 + j];
                const int ch = 64 * hb + j;
#pragma unroll
                for (int k = 0; k < 8; ++k) { const int u = 8 * sg + k, t = d ? 63 - u : u; h = Aa[t * 65 + j] * h + Uu[t * 65 + j];
                    const int row = row0 + t;
                    if (row < NLAT) {
                        if (d == 0) Z1[(size_t)row * 512 + ch] = f2bf(h);
                        else { const float tot = bf2f(Z1[(size_t)row * 512 + ch]) + h; const float gb = bf2f(C1[(size_t)row * C1LD + 3072 + ch]); Y[(size_t)nat_row(row) * D + 512 + ch] = f2bf(tot * geluf(gb)); } } }
                __syncthreads();
                if (sg == 7) prm[512 + j] = h;
            }
        }
    }
    __syncthreads();
}
constexpr int PT = 72, PM = 40;
constexpr int C_PRM = 0, C_GAM = C_PRM + 3072, C_MISC = C_GAM + 1024, C_SBF = C_MISC + 1280, C_TILES = C_SBF + 2 * 64 * PT * 2, C_TH = C_TILES + 5 * 80 * PT * 2, C_MBF = C_TH + 2 * 64 * PT * 2,
              C_SM = C_MBF + 4 * 16 * 20 * 4, C_W1T = C_SM + 4 * 4 * 16 * PM * 2, C_AH = C_W1T + 4 * 64 * PM * 2, C_YV = C_AH + 4 * 16 * PT * 2, C_END = C_YV + 64 * PM * 2;
static_assert(C_END <= LDS_BYTES, "rwkv chunk LDS map");
DI void unpack4(u32x2 v, float* o) { o[0] = __uint_as_float(v.x << 16); o[1] = __uint_as_float(v.x & 0xffff0000u); o[2] = __uint_as_float(v.y << 16); o[3] = __uint_as_float(v.y & 0xffff0000u); }
DI u32x2 pack4(float a, float b, float c, float d) { u32x2 w; w.x = pack2(a, b); w.y = pack2(c, d); return w; }
DI float fexp(float x) { return __builtin_amdgcn_exp2f(x * 1.4426950408889634f); }
DI float frcp(float x) { return __builtin_amdgcn_rcpf(x); }
DI float fsigm(float x) { return frcp(1.f + fexp(-x)); }
DI float ftanh(float x) { return 1.f - 2.f * frcp(1.f + fexp(2.f * x)); }
DI bf16x8 zero_if(bf16x8 v, bool z) { const bf16x8 zz = {0, 0, 0, 0, 0, 0, 0, 0}; return z ? zz : v; }

DI void rwkv_chunk_unit(const P& p, LAS unsigned char* lds, const int vb) {
    const int tid = mk_tid(), lane = tid & 63, wv = __builtin_amdgcn_readfirstlane(tid >> 6), r = lane & 15, q = lane >> 4;
    const int d = vb >> 5, b = (vb >> 3) & 3, h = vb & 7;
    const bf16_t* RW = (const bf16_t*)(p.ws + WS_COLS) + OFF_RW; const bf16_t* LO = (const bf16_t*)(p.ws + WS_COLS) + OFF_LO; bf16_t* Z = (bf16_t*)(p.ws + WS_Z);
    LAS float* prm = (LAS float*)(lds + C_PRM); LAS float* GAM = (LAS float*)(lds + C_GAM); LAS float* SSQ = (LAS float*)(lds + C_MISC); LAS float* BSP = SSQ + 128; LAS float* BS = SSQ + 256;
    LAS bf16_t* Sbf = (LAS bf16_t*)(lds + C_SBF);
    LAS bf16_t* At = (LAS bf16_t*)(lds + C_TILES); LAS bf16_t* Rt = At + 80 * PT; LAS bf16_t* Bt = Rt + 80 * PT; LAS bf16_t* Kt = Bt + 80 * PT; LAS bf16_t* Vt = Kt + 80 * PT;
    LAS bf16_t* TH = (LAS bf16_t*)(lds + C_TH); LAS bf16_t* AD = TH + 64 * PT; LAS float* OUT = (LAS float*)(lds + C_TH);
    LAS float* MBf = (LAS float*)(lds + C_MBF);
    LAS bf16_t* MK = (LAS bf16_t*)(lds + C_SM); LAS bf16_t* NK = MK + 4 * 16 * PM; LAS bf16_t* NB = NK + 4 * 16 * PM; LAS bf16_t* DNV = NB + 4 * 16 * PM;
    LAS bf16_t* W1T = (LAS bf16_t*)(lds + C_W1T); LAS bf16_t* AH = (LAS bf16_t*)(lds + C_AH); LAS bf16_t* YV = (LAS bf16_t*)(lds + C_YV);
    const unsigned at_b = (unsigned)(size_t)At, bt_b = (unsigned)(size_t)Bt, kt_b = (unsigned)(size_t)Kt, vt_b = (unsigned)(size_t)Vt;
    __syncthreads();
    for (int e = tid; e < (C_END - C_SBF) / 4; e += NT) ((LAS unsigned*)(lds + C_SBF))[e] = 0u;
    if (tid < 64) { const int j = tid, c = 64 * h + j; const float* mu = p.in[I_MU] + d * 1664;
        prm[j] = mu[c]; prm[64 + j] = mu[512 + c]; prm[128 + j] = mu[1024 + c]; prm[192 + j] = mu[1536 + j]; prm[256 + j] = mu[1600 + j];
        prm[320 + j] = p.in[I_W0][d * 512 + c]; prm[384 + j] = p.in[I_A0][d * 512 + c]; prm[448 + j] = p.in[I_KK][d * 512 + c]; prm[512 + j] = p.in[I_KA][d * 512 + c];
        prm[576 + j] = p.in[I_RK][(d * 8 + h) * 64 + j]; prm[640 + j] = p.in[I_LNW][d * 512 + c]; prm[704 + j] = p.in[I_LNB][d * 512 + c]; }
    const int m1 = wv & 3, h2 = wv >> 2;
    bf16x8 fw2[2][2], fa2[2][2];
#pragma unroll
    for (int t = 0; t < 2; ++t)
#pragma unroll
        for (int kk = 0; kk < 2; ++kk) { const int c = 64 * h + 16 * (2 * h2 + t) + r;
            const float* w2p = p.in[I_W2L] + (size_t)(d * 64 + 32 * kk + 8 * q) * 512 + c; const float* a2p = p.in[I_A2L] + (size_t)(d * 64 + 32 * kk + 8 * q) * 512 + c;
#pragma unroll
            for (int e = 0; e < 8; ++e) { fw2[t][kk][e] = (short)f2bf(w2p[e * 512]); fa2[t][kk][e] = (short)f2bf(a2p[e * 512]); }
            asm volatile("" ::: "memory"); }
    f32x4 Sacc[2] = {(f32x4){0.f, 0.f, 0.f, 0.f}, (f32x4){0.f, 0.f, 0.f, 0.f}};
    int cur = 0;
    __syncthreads();
    for (int n0 = 0; n0 < LT; n0 += 64) {
        const int u1 = 16 * m1 + r, n1 = n0 + u1; const bool hp = (n1 != 0) && (n1 != LC);
        const size_t row1 = (size_t)step_row(d, b, n1), prow1 = hp ? (size_t)step_row(d, b, n1 - 1) : row1;
        float rs[8], ks[8], vs[8];
#pragma unroll
        for (int t = 0; t < 2; ++t) { const int cb = 32 * h2 + 16 * t + 4 * q;
            float a0[4], a1[4];
#define RW_SHIFT(dst, off, muo) { unpack4(*(const u32x2*)(RW + row1 * 1536 + (off) + 64 * h + cb), a0); if (hp) unpack4(*(const u32x2*)(RW + prow1 * 1536 + (off) + 64 * h + cb), a1); else { a1[0] = a1[1] = a1[2] = a1[3] = 0.f; } \
            const f32x4 mu4 = *(const LAS f32x4*)(prm + (muo) + cb); _Pragma("unroll") for (int jj = 0; jj < 4; ++jj) dst[4 * t + jj] = a0[jj] + mu4[jj] * (a1[jj] - a0[jj]); }
            RW_SHIFT(rs, 0, 0) RW_SHIFT(ks, 512, 64) RW_SHIFT(vs, 1024, 128)
#undef RW_SHIFT
            float th[4], ad[4];
            { unpack4(*(const u32x2*)(LO + row1 * 512 + 64 * d + cb), a0); if (hp) unpack4(*(const u32x2*)(LO + prow1 * 512 + 64 * d + cb), a1); else { a1[0] = a1[1] = a1[2] = a1[3] = 0.f; }
              const f32x4 mu4 = *(const LAS f32x4*)(prm + 192 + cb);
#pragma unroll
              for (int jj = 0; jj < 4; ++jj) th[jj] = ftanh(a0[jj] + mu4[jj] * (a1[jj] - a0[jj])); }
            { unpack4(*(const u32x2*)(LO + row1 * 512 + 128 + 64 * d + cb), a0); if (hp) unpack4(*(const u32x2*)(LO + prow1 * 512 + 128 + 64 * d + cb), a1); else { a1[0] = a1[1] = a1[2] = a1[3] = 0.f; }
              const f32x4 mu4 = *(const LAS f32x4*)(prm + 256 + cb);
#pragma unroll
              for (int jj = 0; jj < 4; ++jj) ad[jj] = a0[jj] + mu4[jj] * (a1[jj] - a0[jj]); }
            *(LAS u32x2*)(TH + u1 * PT + cb) = pack4(th[0], th[1], th[2], th[3]); *(LAS u32x2*)(AD + u1 * PT + cb) = pack4(ad[0], ad[1], ad[2], ad[3]);
            asm volatile("" ::: "memory");
        }
        __syncthreads();
        float elog[8], av[8], kkr[8], km[8]; float ssq = 0.f, bsp = 0.f;
#pragma unroll
        for (int t = 0; t < 2; ++t) { const int cb = 32 * h2 + 16 * t + 4 * q;
            f32x4 xw = (f32x4){0.f, 0.f, 0.f, 0.f}, xa = (f32x4){0.f, 0.f, 0.f, 0.f};
#pragma unroll
            for (int kk = 0; kk < 2; ++kk) { const bf16x8 bt = *(const LAS bf16x8*)(TH + u1 * PT + 32 * kk + 8 * q), ba = *(const LAS bf16x8*)(AD + u1 * PT + 32 * kk + 8 * q);
                xw = __builtin_amdgcn_mfma_f32_16x16x32_bf16(fw2[t][kk], bt, xw, 0, 0, 0); xa = __builtin_amdgcn_mfma_f32_16x16x32_bf16(fa2[t][kk], ba, xa, 0, 0, 0); }
            const f32x4 w04 = *(const LAS f32x4*)(prm + 320 + cb), a04 = *(const LAS f32x4*)(prm + 384 + cb), kk4 = *(const LAS f32x4*)(prm + 448 + cb), ka4 = *(const LAS f32x4*)(prm + 512 + cb), rk4 = *(const LAS f32x4*)(prm + 576 + cb);
#pragma unroll
            for (int jj = 0; jj < 4; ++jj) { const int e = 4 * t + jj;
                elog[e] = 0.6065306597126334f * fsigm(xw[jj] + w04[jj]); av[e] = fsigm(xa[jj] + a04[jj]);
                kkr[e] = ks[e] * kk4[jj]; ssq += kkr[e] * kkr[e]; km[e] = ks[e] * (1.f + (av[e] - 1.f) * ka4[jj]); bsp += rs[e] * km[e] * rk4[jj]; }
            asm volatile("" ::: "memory");
        }
        ssq += __shfl_xor(ssq, 16); ssq += __shfl_xor(ssq, 32); bsp += __shfl_xor(bsp, 16); bsp += __shfl_xor(bsp, 32);
        if (q == 0) { SSQ[h2 * 64 + u1] = ssq; BSP[h2 * 64 + u1] = bsp; }
        __syncthreads();
        {
            const float tot = SSQ[u1] + SSQ[64 + u1]; const float inv = 1.f / fmaxf(sqrtf(tot), 1e-12f);
            if (h2 == 0 && q == 0) BS[u1] = BSP[u1] + BSP[64 + u1];
#pragma unroll
            for (int t = 0; t < 2; ++t) { const int cb = 32 * h2 + 16 * t + 4 * q; float al[4], be[4], ka[4], rh[4];
#pragma unroll
                for (int jj = 0; jj < 4; ++jj) { const int e = 4 * t + jj;
                    float g = -elog[e];
#pragma unroll
                    for (int o = 1; o < 16; o <<= 1) { const float tmp = __shfl_up(g, o, 16); if (r >= o) g += tmp; }
                    const float ep = fexp(g), em = frcp(ep), epp = fexp(g + elog[e]);
                    const float kk = kkr[e] * inv;
                    al[jj] = kk * epp; be[jj] = kk * av[e] * em; ka[jj] = km[e] * em; rh[jj] = rs[e] * ep;
                    if (r == 15) GAM[m1 * 64 + cb + jj] = ep; }
                *(LAS u32x2*)(At + u1 * PT + cb) = pack4(al[0], al[1], al[2], al[3]); *(LAS u32x2*)(Bt + u1 * PT + cb) = pack4(be[0], be[1], be[2], be[3]);
                *(LAS u32x2*)(Kt + u1 * PT + cb) = pack4(ka[0], ka[1], ka[2], ka[3]); *(LAS u32x2*)(Rt + u1 * PT + cb) = pack4(rh[0], rh[1], rh[2], rh[3]);
                *(LAS u32x2*)(Vt + u1 * PT + cb) = pack4(vs[4 * t], vs[4 * t + 1], vs[4 * t + 2], vs[4 * t + 3]);
                asm volatile("" ::: "memory"); }
        }
        __syncthreads();
        {
            const int m = wv >> 1, pp = wv & 1; LAS bf16_t* XB = pp ? Rt : At;
            f32x4 c1 = (f32x4){0.f, 0.f, 0.f, 0.f}, c2 = (f32x4){0.f, 0.f, 0.f, 0.f};
#pragma unroll
            for (int kk = 0; kk < 2; ++kk) { const bf16x8 bx = *(const LAS bf16x8*)(XB + (16 * m + r) * PT + 32 * kk + 8 * q);
                const bf16x8 a1 = *(const LAS bf16x8*)(Bt + (16 * m + r) * PT + 32 * kk + 8 * q), a2 = *(const LAS bf16x8*)(Kt + (16 * m + r) * PT + 32 * kk + 8 * q);
                c1 = __builtin_amdgcn_mfma_f32_16x16x32_bf16(a1, bx, c1, 0, 0, 0); c2 = __builtin_amdgcn_mfma_f32_16x16x32_bf16(a2, bx, c2, 0, 0, 0); }
#pragma unroll
            for (int jj = 0; jj < 4; ++jj) { const int s = 4 * q + jj; const bool ok = pp ? (s <= r) : (s < r); if (!ok) { c1[jj] = 0.f; c2[jj] = 0.f; } }
            if (pp == 0) { *(LAS f32x4*)(MBf + (m * 16 + r) * 20 + 4 * q) = c1; *(LAS u32x2*)(MK + (m * 16 + r) * PM + 4 * q) = pack4(c2[0], c2[1], c2[2], c2[3]); }
            else { *(LAS u32x2*)(NB + (m * 16 + r) * PM + 4 * q) = pack4(c1[0], c1[1], c1[2], c1[3]); *(LAS u32x2*)(NK + (m * 16 + r) * PM + 4 * q) = pack4(c2[0], c2[1], c2[2], c2[3]); }
        }
        __syncthreads();
        if (wv < 4) {
            const int m = wv, c = r; float X[16];
#pragma unroll
            for (int u = 0; u < 16; ++u) { float x = (c == u) ? 1.f : 0.f;
                if (u > 0) { const LAS f32x4* rowp = (const LAS f32x4*)(MBf + (m * 16 + u) * 20);
#pragma unroll
                    for (int s4 = 0; s4 < 4; ++s4) { if (4 * s4 < u) { const f32x4 l = rowp[s4];
#pragma unroll
                        for (int e = 0; e < 4; ++e) if (4 * s4 + e < u) x -= l[e] * X[4 * s4 + e]; } } }
                X[u] = x; }
            if (q == 0) {
#pragma unroll
                for (int u = 0; u < 16; ++u) DNV[(m * 16 + u) * PM + c] = f2bf(X[u]); }
        } else {
            const int m = wv - 4; const bf16x8 a = *(const LAS bf16x8*)(MK + (m * 16 + r) * PM + 8 * q);
#pragma unroll
            for (int it = 0; it < 4; ++it) { const bf16x8 bv = tr_frag(vt_b, PT, 16 * m, 16 * it, r, q);
                const f32x4 acc = __builtin_amdgcn_mfma_f32_16x16x32_bf16(a, bv, (f32x4){0.f, 0.f, 0.f, 0.f}, 0, 0, 0);
                *(LAS u32x2*)(W1T + (m * 64 + 16 * it + r) * PM + 4 * q) = pack4(acc[0], acc[1], acc[2], acc[3]); }
        }
        __syncthreads();
        f32x4 yhat[4] = {(f32x4){0.f, 0.f, 0.f, 0.f}, (f32x4){0.f, 0.f, 0.f, 0.f}, (f32x4){0.f, 0.f, 0.f, 0.f}, (f32x4){0.f, 0.f, 0.f, 0.f}};
        if (wv < 4) {
            const int it = wv;
#pragma unroll
            for (int m = 0; m < 4; ++m) { const bf16x8 a = *(const LAS bf16x8*)(DNV + (m * 16 + r) * PM + 8 * q), bw = *(const LAS bf16x8*)(W1T + (m * 64 + 16 * it + r) * PM + 8 * q);
                yhat[m] = __builtin_amdgcn_mfma_f32_16x16x32_bf16(a, bw, yhat[m], 0, 0, 0); }
        } else {
            const int jt = wv - 4;
#pragma unroll
            for (int m = 0; m < 4; ++m) { const bf16x8 a = tr_frag(at_b, PT, 16 * m, 16 * jt, r, q), bd = *(const LAS bf16x8*)(DNV + (m * 16 + r) * PM + 8 * q);
                const f32x4 acc = __builtin_amdgcn_mfma_f32_16x16x32_bf16(a, bd, (f32x4){0.f, 0.f, 0.f, 0.f}, 0, 0, 0);
                *(LAS u32x2*)(AH + (m * 16 + r) * PT + 16 * jt + 4 * q) = pack4(acc[0], acc[1], acc[2], acc[3]); }
        }
        __syncthreads();
#pragma unroll 1
        for (int m = 0; m < 4; ++m) {
            LAS bf16_t* Sc = Sbf + cur * 64 * PT; LAS bf16_t* Sn = Sbf + (cur ^ 1) * 64 * PT;
            const int it = wv & 3;
            f32x4 oacc = (f32x4){0.f, 0.f, 0.f, 0.f};
            if (wv < 4) {
                f32x4 acc = (m == 0) ? yhat[0] : (m == 1) ? yhat[1] : (m == 2) ? yhat[2] : yhat[3];
#pragma unroll
                for (int kk = 0; kk < 2; ++kk) { const bf16x8 a = *(const LAS bf16x8*)(AH + (m * 16 + r) * PT + 32 * kk + 8 * q), bs = *(const LAS bf16x8*)(Sc + (16 * it + r) * PT + 32 * kk + 8 * q);
                    acc = __builtin_amdgcn_mfma_f32_16x16x32_bf16(a, bs, acc, 0, 0, 0); }
                *(LAS u32x2*)(YV + (16 * it + r) * PM + 4 * q) = pack4(-acc[0], -acc[1], -acc[2], -acc[3]);
            } else {
#pragma unroll
                for (int kk = 0; kk < 2; ++kk) { const bf16x8 a = *(const LAS bf16x8*)(Rt + (16 * m + r) * PT + 32 * kk + 8 * q), bs = *(const LAS bf16x8*)(Sc + (16 * it + r) * PT + 32 * kk + 8 * q);
                    oacc = __builtin_amdgcn_mfma_f32_16x16x32_bf16(a, bs, oacc, 0, 0, 0); }
                const bf16x8 a = *(const LAS bf16x8*)(NK + (m * 16 + r) * PM + 8 * q), bv = tr_frag(vt_b, PT, 16 * m, 16 * it, r, q);
                oacc = __builtin_amdgcn_mfma_f32_16x16x32_bf16(a, bv, oacc, 0, 0, 0);
            }
            __syncthreads();
            {
                const int jh = wv >> 2; const bf16x8 bv = tr_frag(vt_b, PT, 16 * m, 16 * it, r, q), by = *(const LAS bf16x8*)(YV + (16 * it + r) * PM + 8 * q);
#pragma unroll
                for (int x = 0; x < 2; ++x) { const int jt = 2 * jh + x;
                    const bf16x8 a1 = zero_if(tr_frag(kt_b, PT, 16 * m, 16 * jt, r, q), q >= 2), a2 = tr_frag(bt_b, PT, 16 * m, 16 * jt, r, q);
                    Sacc[x] = __builtin_amdgcn_mfma_f32_16x16x32_bf16(a1, bv, Sacc[x], 0, 0, 0); Sacc[x] = __builtin_amdgcn_mfma_f32_16x16x32_bf16(a2, by, Sacc[x], 0, 0, 0);
                    const f32x4 gm = *(const LAS f32x4*)(GAM + m * 64 + 16 * jt + 4 * q); Sacc[x] = Sacc[x] * gm;
                    *(LAS u32x2*)(Sn + (16 * it + r) * PT + 16 * jt + 4 * q) = pack4(Sacc[x][0], Sacc[x][1], Sacc[x][2], Sacc[x][3]); }
                if (wv >= 4) { const bf16x8 a = *(const LAS bf16x8*)(NB + (m * 16 + r) * PM + 8 * q);
                    oacc = __builtin_amdgcn_mfma_f32_16x16x32_bf16(a, by, oacc, 0, 0, 0);
#pragma unroll
                    for (int jj = 0; jj < 4; ++jj) OUT[(16 * m + 4 * q + jj) * 65 + 16 * it + r] = oacc[jj]; }
            }
            __syncthreads();
            cur ^= 1;
        }
#pragma unroll 2
        for (int mm = 0; mm < 8; ++mm) { const int u = wv + 8 * mm; const size_t row = (size_t)step_row(d, b, n0 + u);
            const float o = OUT[u * 65 + lane]; const float mean = wave_sum(o) * (1.f / 64.f); const float dv = o - mean; const float var = wave_sum(dv * dv) * (1.f / 64.f);
            const float z = dv * rsqrtf(var + 64e-5f) * prm[640 + lane] + prm[704 + lane] + BS[u] * bf2f(Vt[u * PT + lane]);
            Z[((size_t)d * NALL + row) * 512 + 64 * h + lane] = f2bf(z); }
        __syncthreads();
    }
}
DI void phase_mlstm_post(const P& p) {
    const int lane = mk_tid() & 63, wv = mk_tid() >> 6;
    const bf16_t* ML = (const bf16_t*)(p.ws + WS_COLS) + OFF_ML; const bf16_t* HB = (const bf16_t*)(p.ws + WS_ACT); bf16_t* Y = (bf16_t*)(p.ws + WS_COLS);
    for (int r = blockIdx.x * 8 + wv; r < NALL; r += gridDim.x * 8)
        post_headnorm_row(HB, (size_t)r, p.in[I_MNG], ML + (size_t)r * 2048 + 1536, 0, Y + (size_t)r * D + 512, lane);
}
DI void phase_hgrn_post(const P& p) {
    const int lane = mk_tid() & 63, wv = mk_tid() >> 6;
    const bf16_t* C1 = (const bf16_t*)(p.ws + WS_COLS); const bf16_t* HB = (const bf16_t*)(p.ws + WS_ACT); bf16_t* Y = (bf16_t*)(p.ws + WS_Z);
    for (int r = blockIdx.x * 8 + wv; r < NLAT; r += gridDim.x * 8)
        post_headnorm_row(HB, (size_t)r, p.in[I_HNG], C1 + (size_t)r * C1LD + 2048, 1, Y + (size_t)nat_row(r) * D, lane);
}

constexpr int N_PHASES = 19;
__global__ void __launch_bounds__(NT, 2) mk_fwd(P p) {
    extern __shared__ __attribute__((aligned(16))) unsigned char lds_raw[];
    LAS unsigned char* lds = (LAS unsigned char*)lds_raw;
    cooperative_groups::grid_group grid = cooperative_groups::this_grid();
    const int lo = p.ph_lo, hi = p.ph_hi;
#define IN(k) (lo <= (k) && (k) < hi)
#define SEAM(k) do { if (IN(k) && IN((k) + 1)) grid.sync(); } while (0)
    unsigned char* ws = p.ws;
    const float* MODV = (const float*)(ws + WS_MODV);
    float* HC = (float*)(ws + WS_HC);
    bf16_t* ACT = (bf16_t*)(ws + WS_ACT); bf16_t* COLS = (bf16_t*)(ws + WS_COLS); bf16_t* Y1 = (bf16_t*)(ws + WS_Z);
    if (IN(0)) { phase_wprep(p, lds); phase_modv(p, lds); } SEAM(0);
    if (IN(1)) { phase_modnorm(p, 0, 0, p.in[I_X], p.in[I_CTX], NALL, false); } SEAM(1);
    if (IN(2)) { EpiStore3 E{COLS + OFF_RW, 1536, 6, COLS + OFF_LO, 512, 8, COLS + OFF_ML, 2048}; run_gemm(lds, ACT, (const bf16_t*)(ws + WS_W_EVIN), NALL, 4096, 1024, E); } SEAM(2);
    if (IN(3)) {
        for (int vb = blockIdx.x; vb < 192; vb += gridDim.x) { if (vb < 64) rwkv_chunk_unit(p, lds, vb); else gla_unit<0>(p, lds, vb - 64); }
    } SEAM(3);
    if (IN(4)) { phase_mlstm_post(p); phase_rwkv_post(p, lds); } SEAM(4);
    if (IN(5)) { EpiResid E{p.in[I_X], p.out, p.in[I_CTX], HC, MODV, 2}; run_gemm(lds, COLS, (const bf16_t*)(ws + WS_W_EVOUT), NALL, 1024, 1024, E); } SEAM(5);
    if (IN(6)) { phase_modnorm(p, 0, 1, p.out, HC, NALL, false); } SEAM(6);
    if (IN(7)) { EpiSwiglu E{COLS}; run_gemm(lds, ACT, (const bf16_t*)(ws + WS_W_UP), NALL, 5632, 1024, E); } SEAM(7);
    if (IN(8)) { EpiResid E{p.out, p.out, HC, HC, MODV, 5}; run_gemm(lds, COLS, (const bf16_t*)(ws + WS_W_DN), NALL, 1024, 2816, E); } SEAM(8);
    if (IN(9)) { phase_modnorm(p, 1, 0, p.out, HC, NALL, true); } SEAM(9);
    if (IN(10)) { EpiStore3 E{COLS, C1LD, 1 << 30, COLS, C1LD, 1 << 30, COLS, C1LD}; run_gemm(lds, ACT, (const bf16_t*)(ws + WS_W_ODIN), NALL, 3584, 1024, E); } SEAM(10);
    if (IN(11)) { phase_hgrn_prep(p, lds); } SEAM(11);
    if (IN(12)) {
        for (int vb = blockIdx.x; vb < 160; vb += gridDim.x) { if (vb < 32) lru_unit(p, lds, vb); else gla_unit<1>(p, lds, vb - 32); }
    } SEAM(12);
    if (IN(13)) { phase_hgrn_post(p); } SEAM(13);
    if (IN(14)) { EpiResid E{p.out, p.out, HC, HC, MODV + 5 * 6144, 2}; run_gemm(lds, Y1, (const bf16_t*)(ws + WS_W_ODOUT), NLAT, 1024, 1024, E); } SEAM(14);
    if (IN(15)) { phase_modnorm(p, 1, 1, p.out, HC, NLAT, false); } SEAM(15);
    if (IN(16)) { EpiSwiglu E{COLS}; run_gemm(lds, ACT, (const bf16_t*)(ws + WS_W_UP) + W_UP_STRIDE, NLAT, 5632, 1024, E); } SEAM(16);
    if (IN(17)) { EpiResid E{p.out, p.out, HC, HC, MODV + 5 * 6144, 5}; run_gemm(lds, COLS, (const bf16_t*)(ws + WS_W_DN) + W_DN_STRIDE, NLAT, 1024, 2816, E); } SEAM(17);
    if (IN(18)) { phase_finalnorm(p); }
#undef IN
#undef SEAM
}
}

#ifndef MK_ONE_LAUNCH
#define MK_ONE_LAUNCH 1
#endif
extern "C" void kernel_launch(void* const* d_in, const int* in_sizes, int n_in, void* d_out, int out_size, void* d_ws, size_t ws_size, hipStream_t stream) {
    using namespace mk;
    static int grid = 0;
    if (grid == 0) {
        int dev = 0, cus = 0, per_cu = 0;
        if (n_in != N_IN || ws_size < WS_END) { fprintf(stderr, "kernel_launch: unexpected n_in %d / ws_size %zu\n", n_in, ws_size); grid = -1; return; }
        (void)hipGetDevice(&dev); (void)hipDeviceGetAttribute(&cus, hipDeviceAttributeMultiprocessorCount, dev);
        (void)hipFuncSetAttribute((const void*)mk_fwd, hipFuncAttributeMaxDynamicSharedMemorySize, LDS_BYTES);
        (void)hipOccupancyMaxActiveBlocksPerMultiprocessor(&per_cu, (const void*)mk_fwd, NT, LDS_BYTES);
        if (per_cu < 1) { fprintf(stderr, "kernel_launch: occupancy query says %d blocks per CU\n", per_cu); per_cu = 1; }
        (void)hipGetLastError();
        grid = cus;
    }
    if (grid < 0) return;
    P p{};
    for (int i = 0; i < N_IN; ++i) p.in[i] = (const float*)d_in[i];
    p.out = (float*)d_out; p.ws = (unsigned char*)d_ws;
#if MK_ONE_LAUNCH
    p.ph_lo = 0; p.ph_hi = N_PHASES;
    void* args[] = {&p};
    hipError_t e = hipLaunchCooperativeKernel((const void*)mk_fwd, dim3(grid), dim3(NT), args, LDS_BYTES, stream);
    if (e != hipSuccess) fprintf(stderr, "cooperative launch failed: %s (grid %d)\n", hipGetErrorString(e), grid);
#else
    for (int k = 0; k < N_PHASES; ++k) { p.ph_lo = k; p.ph_hi = k + 1; hipLaunchKernelGGL(mk_fwd, dim3(grid), dim3(NT), LDS_BYTES, stream, p); }
#endif
}
```

```cpp
#include <hip/hip_runtime.h>
#include <hip/hip_cooperative_groups.h>
#include <cstdio>
#include <cstdint>
__device__ __forceinline__ int mk_tid() { int t = threadIdx.x; asm volatile("" : "+v"(t)); return t; }
#define MK_DUP -1
namespace pg8 {
#define PG8_LAS __attribute__((address_space(3)))
typedef unsigned short bf16_t;
typedef short bf16x8 __attribute__((ext_vector_type(8)));
typedef float f32x4 __attribute__((ext_vector_type(4)));
typedef unsigned u32x4 __attribute__((ext_vector_type(4)));
constexpr int BM = 256, BK = 64, HALF = 128, HTB = HALF * BK * 2  , STAGE_BYTES = 8 * HTB, NXCD = 8, WGM = 8;

__host__ __device__ __forceinline__ int lds_byte(int r, int c) { const int st = (r >> 4) * 2 + (c >> 5), rr = r & 15, cc = c & 31, ob = rr * 64 + cc * 2; return st * 1024 + (ob ^ (((ob >> 9) & 1) << 5)); }
__host__ __device__ __forceinline__ void stage_rc(int b, int& R, int& C) { const int st = b / 1024, sb = b % 1024, swz = sb ^ (((sb >> 9) & 1) << 5); R = (st >> 1) * 16 + swz / 64; C = (st & 1) * 32 + (swz % 64) / 2; }
__host__ __device__ __forceinline__ int perm32(int rho) { const int n = rho >> 4, i = rho & 15; return 8 * (i >> 2) + 4 * n + (i & 3); }

struct Unit { int pm, pn; };
struct Gemm { const bf16_t* A; const bf16_t* Bt; int M, N, K; };

struct StaticOrder {
    int nM, nN, nwg, G, c;
    __host__ __device__ void init(int M, int N, int G_, int c_) { nM = M / BM; nN = N / BM; nwg = nM * nN; G = G_; c = c_; }
    __host__ __device__ bool next(int i, Unit& u) const {
        const long L = (long)i * G + c; if (L >= nwg) return false;
        int wgid = (int)L; { const int q = nwg / NXCD, r = nwg % NXCD, xcd = wgid % NXCD, off = wgid / NXCD; wgid = (xcd < r ? xcd * (q + 1) : r * (q + 1) + (xcd - r) * q) + off; }
        const int nig = WGM * nN, gid = wgid / nig, fm = gid * WGM, gsz = (nM - fm) < WGM ? (nM - fm) : WGM;
        u.pm = fm + ((wgid % nig) % gsz); u.pn = (wgid % nig) / gsz; return true;
    }
    __device__ __forceinline__ void a_ready(const Unit&) const {}
    __device__ __forceinline__ void done(const Unit&) const {}
};
__device__ __forceinline__ unsigned cvt_pk_bf16(float lo, float hi) { unsigned r; asm volatile("v_cvt_pk_bf16_f32 %0, %1, %2" : "=v"(r) : "v"(lo), "v"(hi)); return r; }
typedef float f32x2 __attribute__((ext_vector_type(2)));
template <class Epi, class Sched, bool STAMP = false>
__device__ __forceinline__ void gemm_phase(PG8_LAS unsigned char* lds, const Gemm g, const Sched& S, const Epi& E, unsigned long long* stamps) {
    const int tid = mk_tid(), wid = __builtin_amdgcn_readfirstlane(tid >> 6), lane = tid & 63, wr = wid >> 2, wc = wid & 3, fr = lane & 15, fq = lane >> 4;
    const int K = g.K, nt = K / BK;
    int ts_lo = 0, ts_hi = 0, nts = 0; const unsigned long long rt_entry = STAMP ? (unsigned long long)wall_clock64() : 0ull;
#define PG8_STAMP() do { if (STAMP && wid == 0 && nts < 64) { const unsigned long long _c = (unsigned long long)clock64(); \
        ts_lo = (lane == nts) ? (int)(unsigned)_c : ts_lo; ts_hi = (lane == nts) ? (int)(unsigned)(_c >> 32) : ts_hi; ++nts; } } while (0)
    PG8_STAMP();
    unsigned voffA[2], voffB[2];
#pragma unroll
    for (int i = 0; i < 2; ++i) { int R, C; stage_rc(tid * 16 + i * 8192, R, C); const int Rb = Epi::PERM ? ((R & ~31) + perm32(R & 31)) : R;
        voffA[i] = (unsigned)(R * K + C) * 2u; voffB[i] = (unsigned)(Rb * K + C) * 2u; }
    const size_t kstep = (size_t)(BK * 2);
    const size_t hstep = (size_t)HALF * K * 2;
    const size_t tstep = 2 * hstep;
    const unsigned ldsw = (unsigned)wid * 1024u;
    const int aoff = lds_byte(wr * 64 + fr, fq * 8), boff = lds_byte(wc * 32 + fr, fq * 8);
#define PG8_SA(b, h) (((b) * 2 + (h)) * HTB)
#define PG8_SB(b, h) ((4 + (b) * 2 + (h)) * HTB)
#define PG8_STAGE(bufoff, gbase, voff) do { _Pragma("unroll") for (int _i = 0; _i < 2; ++_i) \
        __builtin_amdgcn_global_load_lds((const unsigned*)((const char*)(gbase) + (voff)[_i]), (PG8_LAS unsigned*)(lds + (bufoff) + ldsw + _i * 8192), 16, 0, 0); } while (0)
#define PG8_LDA(dst, b, h) do { _Pragma("unroll") for (int m = 0; m < 4; ++m) _Pragma("unroll") for (int k = 0; k < 2; ++k) dst[m][k] = *(const PG8_LAS bf16x8*)(lds + PG8_SA(b, h) + aoff + m * 2048 + k * 1024); } while (0)
#define PG8_LDB(dst, b, h) do { _Pragma("unroll") for (int n = 0; n < 2; ++n) _Pragma("unroll") for (int k = 0; k < 2; ++k) dst[n][k] = *(const PG8_LAS bf16x8*)(lds + PG8_SB(b, h) + boff + n * 2048 + k * 1024); } while (0)
#define PG8_MMA(ai, bj, At, Bt) do { __builtin_amdgcn_s_setprio(1); _Pragma("unroll") for (int m = 0; m < 4; ++m) _Pragma("unroll") for (int n = 0; n < 2; ++n) _Pragma("unroll") for (int k = 0; k < 2; ++k) \
        acc[ai][bj][m][n] = __builtin_amdgcn_mfma_f32_16x16x32_bf16(Bt[n][k], At[m][k], acc[ai][bj][m][n], 0, 0, 0); __builtin_amdgcn_s_setprio(0); } while (0)
#define PG8_WAIT_V(n) asm volatile("s_waitcnt vmcnt(" #n ")" ::: "memory")
#define PG8_WAIT_L(n) asm volatile("s_waitcnt lgkmcnt(" #n ")" ::: "memory")
#define PG8_BAR __builtin_amdgcn_s_barrier()
#define PG8_SCHED __builtin_amdgcn_sched_barrier(0)
    Unit cur, nxt; int ui = 0;
    if (!S.next(0, cur)) return;
    f32x4 acc[2][2][4][2];
#pragma unroll
    for (int a = 0; a < 2; ++a)
#pragma unroll
        for (int b = 0; b < 2; ++b)
#pragma unroll
            for (int m = 0; m < 4; ++m)
#pragma unroll
                for (int n = 0; n < 2; ++n) acc[a][b][m][n] = (f32x4){0.f, 0.f, 0.f, 0.f};
    bf16x8 At[4][2], B0[2][2], B1[2][2];
    const char* cA = (const char*)g.A + (size_t)cur.pm * tstep; const char* cB = (const char*)g.Bt + (size_t)cur.pn * tstep;
    S.a_ready(cur);
    PG8_STAGE(PG8_SB(0, 0), cB, voffB); PG8_STAGE(PG8_SA(0, 0), cA, voffA); PG8_STAGE(PG8_SB(0, 1), cB + hstep, voffB); PG8_STAGE(PG8_SA(0, 1), cA + hstep, voffA);
    if (wr == 1) PG8_BAR;
    PG8_WAIT_V(4); PG8_BAR;
    PG8_STAGE(PG8_SB(1, 0), cB + kstep, voffB); PG8_STAGE(PG8_SA(1, 0), cA + kstep, voffA); PG8_STAGE(PG8_SB(1, 1), cB + hstep + kstep, voffB);
    PG8_WAIT_V(6); PG8_BAR;
    PG8_STAMP();
    for (;;) {
        const bool has_next = S.next(ui + 1, nxt);
        const char* nA = has_next ? (const char*)g.A + (size_t)nxt.pm * tstep : cA; const char* nB = has_next ? (const char*)g.Bt + (size_t)nxt.pn * tstep : cB;
        for (int t = 0; t < nt; t += 2) {
            const bool last = (t == nt - 2);
            const char* a1 = cA + (size_t)(t + 1) * kstep;
            const char* a2 = last ? nA : cA + (size_t)(t + 2) * kstep; const char* b2 = last ? nB : cB + (size_t)(t + 2) * kstep;
            const char* a3 = a2 + kstep; const char* b3 = b2 + kstep;
            if (last && has_next) S.a_ready(nxt);
            PG8_LDB(B0, 0, 0); PG8_SCHED; PG8_LDA(At, 0, 0); PG8_STAGE(PG8_SA(1, 1), a1 + hstep, voffA);
            PG8_WAIT_L(8); PG8_BAR; PG8_WAIT_L(0); PG8_MMA(0, 0, At, B0); PG8_BAR; PG8_SCHED;
            PG8_LDB(B1, 0, 1); PG8_STAGE(PG8_SB(0, 0), b2, voffB);
            PG8_BAR; PG8_WAIT_L(0); PG8_MMA(0, 1, At, B1); PG8_BAR;
            PG8_LDA(At, 0, 1); PG8_STAGE(PG8_SA(0, 0), a2, voffA);
            PG8_BAR; PG8_WAIT_L(0); PG8_MMA(1, 0, At, B0); PG8_BAR; PG8_SCHED;
            PG8_STAGE(PG8_SB(0, 1), b2 + hstep, voffB);
            PG8_WAIT_V(6); PG8_BAR; PG8_MMA(1, 1, At, B1); PG8_BAR;
            PG8_LDB(B0, 1, 0); PG8_SCHED; PG8_LDA(At, 1, 0); PG8_STAGE(PG8_SA(0, 1), a2 + hstep, voffA);
            PG8_WAIT_L(8); PG8_BAR; PG8_WAIT_L(0); PG8_MMA(0, 0, At, B0); PG8_BAR; PG8_SCHED;
            PG8_LDB(B1, 1, 1); PG8_STAGE(PG8_SB(1, 0), b3, voffB);
            PG8_BAR; PG8_WAIT_L(0); PG8_MMA(0, 1, At, B1); PG8_BAR;
            PG8_LDA(At, 1, 1); PG8_STAGE(PG8_SA(1, 0), a3, voffA);
            PG8_BAR; PG8_WAIT_L(0); PG8_MMA(1, 0, At, B0); PG8_BAR; PG8_SCHED;
            PG8_STAGE(PG8_SB(1, 1), b3 + hstep, voffB);
            PG8_WAIT_V(6); PG8_BAR; PG8_MMA(1, 1, At, B1); PG8_BAR;
        }
        PG8_STAMP();
        if constexpr (!Epi::AFTER_DRAIN) { E(acc, cur, wr, wc, fr, fq); S.done(cur); }
        PG8_STAMP();
        if (!has_next) break;
#pragma unroll
        for (int a = 0; a < 2; ++a)
#pragma unroll
            for (int b = 0; b < 2; ++b)
#pragma unroll
                for (int m = 0; m < 4; ++m)
#pragma unroll
                    for (int n = 0; n < 2; ++n) acc[a][b][m][n] = (f32x4){0.f, 0.f, 0.f, 0.f};
        cur = nxt; cA = nA; cB = nB; ++ui;
    }
    PG8_WAIT_V(0);
    if (wr == 0) PG8_BAR;
    PG8_BAR;
    if constexpr (Epi::AFTER_DRAIN) { E.fused(acc, cur, wr, wc, fr, fq, lds, wid, lane); S.done(cur); }
    PG8_STAMP();
    if (STAMP && wid == 0) { stamps[lane] = lane < nts ? (((unsigned long long)(unsigned)ts_hi << 32) | (unsigned)ts_lo) : 0ull;
        if (lane == 62) stamps[62] = rt_entry; if (lane == 63) stamps[63] = (unsigned long long)wall_clock64(); }
#undef PG8_STAMP
#undef PG8_SA
#undef PG8_SB
#undef PG8_STAGE
#undef PG8_LDA
#undef PG8_LDB
#undef PG8_MMA
#undef PG8_WAIT_V
#undef PG8_WAIT_L
#undef PG8_BAR
#undef PG8_SCHED
}
}

namespace mk {
#define DI __device__ __forceinline__
#define LAS __attribute__((address_space(3)))
typedef unsigned short bf16_t;
typedef float f32x4 __attribute__((ext_vector_type(4)));
typedef unsigned u32x2 __attribute__((ext_vector_type(2)));
typedef unsigned u32x4 __attribute__((ext_vector_type(4)));

constexpr int D = 1024, NB = 4, L = 8192, LC = 256, NLAT = NB * L, NCTX = NB * LC, NALL = NLAT + NCTX, LT = L + LC, DFF = 2816;
constexpr int NT = 512;
constexpr size_t MiB = (size_t)1 << 20;
constexpr size_t WS_CTL = 0, WS_MODV = 1 * MiB, WS_HC = 2 * MiB, WS_W_EVIN = 6 * MiB, WS_W_EVOUT = 14 * MiB, WS_W_ODIN = 16 * MiB, WS_W_ODOUT = 23 * MiB,
                 WS_W_UP = 25 * MiB, WS_W_DN = 47 * MiB, WS_ACT = 58 * MiB, WS_COLS = 124 * MiB, WS_Z = 388 * MiB, WS_Z1 = 454 * MiB, WS_LAM = 486 * MiB, WS_LSUM = 489 * MiB, WS_END = 494 * MiB;
constexpr size_t W_UP_STRIDE = (size_t)5632 * 1024, W_DN_STRIDE = (size_t)1024 * 2816;
constexpr size_t OFF_RW = 0, OFF_LO = (size_t)NALL * 1536, OFF_ML = OFF_LO + (size_t)NALL * 512;
constexpr int LDS_BYTES = 163840;
constexpr int C1LD = 3584;
DI int nat_row(int r) { const int b = r / L, pp = r % L; return b * L + (pp % 128) * 64 + pp / 128; }

enum { I_X = 0, I_C, I_CTX, I_CCTX, I_N1G, I_N2G, I_MODW, I_MODB, I_W1, I_W3, I_W2, I_FING, I_EVIN, I_EVOUT, I_MU, I_W0, I_W2L, I_A0, I_A2L, I_KK, I_KA, I_RK,
       I_LNW, I_LNB, I_G2, I_MBI, I_MBF, I_MNG, I_ODIN, I_ODOUT, I_HLB, I_HNG, I_CONVW, I_CONVB, I_WA, I_BA, I_WI, I_BI, I_LAM, N_IN };

struct P { const float* in[N_IN]; float* out; unsigned char* ws; int ph_lo, ph_hi; };

DI float bf2f(bf16_t v) { return __uint_as_float(((unsigned)v) << 16); }
DI bf16_t f2bf(float f) { unsigned u = __float_as_uint(f); u += 0x7fffu + ((u >> 16) & 1u); return (bf16_t)(u >> 16); }
DI float sigm(float x) { return 1.f / (1.f + expf(-x)); }
DI float siluf(float x) { return x * sigm(x); }
DI float geluf(float x) { return 0.5f * x * (1.f + tanhf(0.7978845608028654f * (x + 0.044715f * x * x * x))); }
DI float fexp(float x) { return __builtin_amdgcn_exp2f(x * 1.4426950408889634f); }
DI float frcp(float x) { return __builtin_amdgcn_rcpf(x); }
DI float fsigm(float x) { return frcp(1.f + fexp(-x)); }
DI float ftanh(float x) { return 1.f - 2.f * frcp(1.f + fexp(2.f * x)); }
DI float fgelu(float x) { return 0.5f * x * (1.f + ftanh(0.7978845608028654f * (x + 0.044715f * x * x * x))); }
DI float wave_sum(float v) {
#pragma unroll
    for (int o = 32; o >= 1; o >>= 1) v += __shfl_xor(v, o);
    return v;
}
DI int step_row(int d, int b, int n) {
    if (n < LC) return NLAT + b * LC + (d ? LC - 1 - n : n);
    const int m = n - LC; return b * L + (d ? L - 1 - m : m);
}

DI int matN(int m) { return m == 0 ? 4096 : m == 1 ? 1024 : m == 2 ? 3584 : m == 3 ? 1024 : m < 6 ? 5632 : 1024; }
DI int matK(int m) { return m < 6 ? 1024 : 2816; }
DI int matTile0(int m) { return m == 0 ? 0 : m == 1 ? 1024 : m == 2 ? 1280 : m == 3 ? 2176 : m == 4 ? 2432 : m == 5 ? 3840 : m == 6 ? 5248 : m == 7 ? 5952 : 6656; }
DI size_t matOff(int m) { return m == 0 ? WS_W_EVIN : m == 1 ? WS_W_EVOUT : m == 2 ? WS_W_ODIN : m == 3 ? WS_W_ODOUT : m == 4 ? WS_W_UP : m == 5 ? WS_W_UP + W_UP_STRIDE * 2 : m == 6 ? WS_W_DN : WS_W_DN + W_DN_STRIDE * 2; }
DI const float* matSrc(const P& p, int m, int n, int& ld) {
    if (m == 0) { ld = 3984; int col; if (n < 1920) col = n; else if (n < 1936) col = 3968 + (n - 1920); else if (n < 2048) return nullptr; else col = 1920 + (n - 2048); return p.in[I_EVIN] + col; }
    if (m == 1) { ld = 1024; return p.in[I_EVOUT] + n; }
    if (m == 2) { ld = 3584; return p.in[I_ODIN] + n; }
    if (m == 3) { ld = 1024; return p.in[I_ODOUT] + n; }
    if (m < 6) { ld = 2816; const int l = m - 4, pn = n >> 8, w = n & 255; const size_t lo = (size_t)l * 1024 * 2816; return (w < 128) ? p.in[I_W1] + lo + 128 * pn + w : p.in[I_W3] + lo + 128 * pn + (w - 128); }
    ld = 1024; return p.in[I_W2] + (size_t)(m - 6) * 2816 * 1024 + n;
}
DI void phase_wprep(const P& p, LAS unsigned char* ldsb) {
    LAS float* tile = (LAS float*)ldsb;
    const int tid = mk_tid(), tx = tid & 63, ty = tid >> 6;
    for (int item = blockIdx.x; item < 6656; item += gridDim.x) {
        int m = 0;
#pragma unroll
        for (int q = 1; q < 8; ++q) if (item >= matTile0(q)) m = q;
        const int local = item - matTile0(m), K = matK(m), nK = K >> 6, nb = local / nK, kb = local - nb * nK, n0 = nb * 64, k0 = kb * 64;
        bf16_t* Bt = (bf16_t*)(p.ws + matOff(m));
        int ld; const float* src = matSrc(p, m, n0 + tx, ld);
        __syncthreads();
#pragma unroll
        for (int i = 0; i < 8; ++i) { const int k = k0 + ty + 8 * i; tile[(ty + 8 * i) * 65 + tx] = src ? src[(size_t)k * ld] : 0.f; }
        __syncthreads();
#pragma unroll
        for (int i = 0; i < 8; ++i) { const int nn = ty + 8 * i; Bt[(size_t)(n0 + nn) * K + k0 + tx] = f2bf(tile[tx * 65 + nn]); }
    }
    __syncthreads();
}
DI void phase_modv(const P& p, LAS unsigned char* ldsb) {
    LAS float* sc = (LAS float*)ldsb;
    const int tid = mk_tid();
    float* MODV = (float*)(p.ws + WS_MODV);
    __syncthreads();
    for (int e = tid; e < 5 * 1024; e += NT) { const int s = e >> 10, k = e & 1023; const float v = (s < 4) ? p.in[I_C][s * 1024 + k] : p.in[I_CCTX][k]; sc[e] = siluf(v); }
    __syncthreads();
    for (int vb = blockIdx.x; vb < 24; vb += gridDim.x) {
        const int l = vb / 12, n = (vb % 12) * 512 + tid;
        const float* W = p.in[I_MODW] + (size_t)l * 1024 * 6144 + n;
        float a0 = 0.f, a1 = 0.f, a2 = 0.f, a3 = 0.f, a4 = 0.f;
#pragma unroll 8
        for (int k = 0; k < 1024; ++k) { const float w = W[(size_t)k * 6144]; a0 += sc[k] * w; a1 += sc[1024 + k] * w; a2 += sc[2048 + k] * w; a3 += sc[3072 + k] * w; a4 += sc[4096 + k] * w; }
        const float bb = p.in[I_MODB][l * 6144 + n];
        float* o = MODV + (size_t)l * 5 * 6144 + n;
        o[0] = a0 + bb; o[6144] = a1 + bb; o[2 * 6144] = a2 + bb; o[3 * 6144] = a3 + bb; o[4 * 6144] = a4 + bb;
    }
    __syncthreads();
}

DI void phase_modnorm(const P& p, int layer, int which, const float* hlat, const float* hctx, int nrows, bool permute) {
    const int lane = mk_tid() & 63, wv = mk_tid() >> 6;
    const float* MODV = (const float*)(p.ws + WS_MODV) + (size_t)layer * 5 * 6144;
    const float* g = p.in[which ? I_N2G : I_N1G] + layer * 1024;
    bf16_t* ACT = (bf16_t*)(p.ws + WS_ACT);
    for (int r = blockIdx.x * 8 + wv; r < nrows; r += gridDim.x * 8) {
        const bool isctx = r >= NLAT;
        const float* src = isctx ? hctx + (size_t)(r - NLAT) * D : hlat + (size_t)r * D;
        const int sv = isctx ? 4 : r / L;
        const float* shift = MODV + sv * 6144 + (which ? 3 : 0) * 1024; const float* scale = shift + 1024;
        int dr = r;
        if (permute && !isctx) { const int b = r / L, t = r % L; dr = b * L + (t % 64) * 128 + t / 64; }
        f32x4 v[4]; float ss = 0.f;
#pragma unroll
        for (int j = 0; j < 4; ++j) { v[j] = *(const f32x4*)(src + 4 * lane + 256 * j); ss += v[j].x * v[j].x + v[j].y * v[j].y + v[j].z * v[j].z + v[j].w * v[j].w; }
        const float rinv = rsqrtf(wave_sum(ss) * (1.f / D) + 1e-6f);
#pragma unroll
        for (int j = 0; j < 4; ++j) { const int c = 4 * lane + 256 * j;
            const f32x4 gg = *(const f32x4*)(g + c), sc = *(const f32x4*)(scale + c), sh = *(const f32x4*)(shift + c);
            const float o0 = v[j].x * rinv * gg.x * (1.f + sc.x) + sh.x, o1 = v[j].y * rinv * gg.y * (1.f + sc.y) + sh.y, o2 = v[j].z * rinv * gg.z * (1.f + sc.z) + sh.z, o3 = v[j].w * rinv * gg.w * (1.f + sc.w) + sh.w;
            u32x2 w; w.x = (unsigned)f2bf(o0) | ((unsigned)f2bf(o1) << 16); w.y = (unsigned)f2bf(o2) | ((unsigned)f2bf(o3) << 16);
            *(u32x2*)(ACT + (size_t)dr * D + c) = w; }
    }
}
DI void phase_finalnorm(const P& p) {
    const int lane = mk_tid() & 63, wv = mk_tid() >> 6;
    const float* g = p.in[I_FING];
    for (int r = blockIdx.x * 8 + wv; r < NLAT; r += gridDim.x * 8) {
        float* src = p.out + (size_t)r * D;
        f32x4 v[4]; float ss = 0.f;
#pragma unroll
        for (int j = 0; j < 4; ++j) { v[j] = *(const f32x4*)(src + 4 * lane + 256 * j); ss += v[j].x * v[j].x + v[j].y * v[j].y + v[j].z * v[j].z + v[j].w * v[j].w; }
        const float rinv = rsqrtf(wave_sum(ss) * (1.f / D) + 1e-6f);
#pragma unroll
        for (int j = 0; j < 4; ++j) { const int c = 4 * lane + 256 * j; const f32x4 gg = *(const f32x4*)(g + c);
            f32x4 o; o.x = v[j].x * rinv * gg.x; o.y = v[j].y * rinv * gg.y; o.z = v[j].z * rinv * gg.z; o.w = v[j].w * rinv * gg.w; *(f32x4*)(src + c) = o; }
    }
}

struct EpiStore3 {
    static constexpr bool PERM = false, AFTER_DRAIN = false;
    bf16_t* p0; int ld0; int pn1; bf16_t* p1; int ld1; int pn2; bf16_t* p2; int ld2;
    DI void operator()(const f32x4 (&acc)[2][2][4][2], const pg8::Unit& u, int wr, int wc, int fr, int fq) const {
        bf16_t* base; int ld, ct;
        if (u.pn >= pn2) { base = p2; ld = ld2; ct = u.pn - pn2; } else if (u.pn >= pn1) { base = p1; ld = ld1; ct = u.pn - pn1; } else { base = p0; ld = ld0; ct = u.pn; }
        const int row0 = u.pm * 256 + wr * 64 + fr, col0 = ct * 256 + wc * 32 + 4 * fq;
#pragma unroll
        for (int ai = 0; ai < 2; ++ai)
#pragma unroll
            for (int m = 0; m < 4; ++m) { bf16_t* rowp = base + (size_t)(row0 + ai * 128 + m * 16) * ld + col0;
#pragma unroll
                for (int bj = 0; bj < 2; ++bj)
#pragma unroll
                    for (int n = 0; n < 2; ++n) { const f32x4 v = acc[ai][bj][m][n]; u32x2 w; w.x = pg8::cvt_pk_bf16(v[0], v[1]); w.y = pg8::cvt_pk_bf16(v[2], v[3]); *(u32x2*)(rowp + bj * 128 + n * 16) = w; } }
    }
};
struct EpiResid {
    static constexpr bool PERM = false, AFTER_DRAIN = false;
    const float* hin; float* hout; const float* cin; float* cout; const float* modv_l; int gidx;
    DI void operator()(const f32x4 (&acc)[2][2][4][2], const pg8::Unit& u, int wr, int wc, int fr, int fq) const {
        const bool isctx = u.pm >= 128; const int sv = isctx ? 4 : (u.pm >> 5);
        const float* gate = modv_l + sv * 6144 + gidx * 1024;
        const float* bi = isctx ? cin : hin; float* bo = isctx ? cout : hout;
        const int row0 = (isctx ? (u.pm - 128) : u.pm) * 256 + wr * 64 + fr, col0 = u.pn * 256 + wc * 32 + 4 * fq;
        f32x4 gv[2][2];
#pragma unroll
        for (int bj = 0; bj < 2; ++bj)
#pragma unroll
            for (int n = 0; n < 2; ++n) gv[bj][n] = *(const f32x4*)(gate + col0 + bj * 128 + n * 16);
#pragma unroll
        for (int ai = 0; ai < 2; ++ai)
#pragma unroll
            for (int m = 0; m < 4; ++m) { const size_t off = (size_t)(row0 + ai * 128 + m * 16) * D + col0;
#pragma unroll
                for (int bj = 0; bj < 2; ++bj)
#pragma unroll
                    for (int n = 0; n < 2; ++n) { const f32x4 bs = *(const f32x4*)(bi + off + bj * 128 + n * 16); *(f32x4*)(bo + off + bj * 128 + n * 16) = bs + gv[bj][n] * acc[ai][bj][m][n]; } }
    }
};
struct EpiSwiglu {
    static constexpr bool PERM = false, AFTER_DRAIN = false;
    bf16_t* G;
    DI void operator()(const f32x4 (&acc)[2][2][4][2], const pg8::Unit& u, int wr, int wc, int fr, int fq) const {
        const int row0 = u.pm * 256 + wr * 64 + fr, col0 = u.pn * 128 + wc * 32 + 4 * fq;
#pragma unroll
        for (int ai = 0; ai < 2; ++ai)
#pragma unroll
            for (int m = 0; m < 4; ++m) { bf16_t* rowp = G + (size_t)(row0 + ai * 128 + m * 16) * DFF + col0;
#pragma unroll
                for (int n = 0; n < 2; ++n) { const f32x4 a = acc[ai][0][m][n], b = acc[ai][1][m][n];
                    const float g0 = a[0] / (1.f + __expf(-a[0])) * b[0], g1 = a[1] / (1.f + __expf(-a[1])) * b[1], g2 = a[2] / (1.f + __expf(-a[2])) * b[2], g3 = a[3] / (1.f + __expf(-a[3])) * b[3];
                    u32x2 w; w.x = pg8::cvt_pk_bf16(g0, g1); w.y = pg8::cvt_pk_bf16(g2, g3); *(u32x2*)(rowp + n * 16) = w; } }
    }
};
template <class Epi> DI void run_gemm(LAS unsigned char* lds, const bf16_t* A, const bf16_t* Bt, int M, int N, int K, const Epi& E) {
    pg8::Gemm g{A, Bt, M, N, K}; pg8::StaticOrder S; S.init(M, N, (int)gridDim.x, (int)blockIdx.x);
    pg8::gemm_phase<Epi, pg8::StaticOrder, false>((PG8_LAS unsigned char*)lds, g, S, E, nullptr);
    __syncthreads();
}

DI void phase_rwkv_scan_unit(const P& p, LAS unsigned char* ldsb, const int vb) {
    LAS float* lds = (LAS float*)ldsb;
    LAS float *w2s = lds, *a2s = lds + 4096, *prm = lds + 8192, *TH = prm + 768, *AD = TH + 2048, *R = AD + 2048, *W = R + 2048, *K = W + 2048, *KK = K + 2048, *BV = KK + 2048,
              *V = BV + 2048, *BS = V + 2048, *OUT = BS + 32;
    const int tid = mk_tid(), lane = tid & 63, wv = tid >> 6;
    const bf16_t* RW = (const bf16_t*)(p.ws + WS_COLS) + OFF_RW; const bf16_t* LO = (const bf16_t*)(p.ws + WS_COLS) + OFF_LO; bf16_t* Z = (bf16_t*)(p.ws + WS_Z);
    const int srow = tid >> 3, sg = tid & 7;
    {
        const int d = vb >> 5, b = (vb >> 3) & 3, h = vb & 7;
        __syncthreads();
        for (int e = tid; e < 4096; e += NT) { const int i = e >> 6, c = e & 63; w2s[e] = p.in[I_W2L][(size_t)(d * 64 + i) * 512 + 64 * h + c]; a2s[e] = p.in[I_A2L][(size_t)(d * 64 + i) * 512 + 64 * h + c]; }
        if (tid < 64) { const int j = tid, c = 64 * h + j; const float* mu = p.in[I_MU] + d * 1664;
            prm[j] = mu[c]; prm[64 + j] = mu[512 + c]; prm[128 + j] = mu[1024 + c]; prm[192 + j] = mu[1536 + j]; prm[256 + j] = mu[1600 + j];
            prm[320 + j] = p.in[I_W0][d * 512 + c]; prm[384 + j] = p.in[I_A0][d * 512 + c]; prm[448 + j] = p.in[I_KK][d * 512 + c]; prm[512 + j] = p.in[I_KA][d * 512 + c];
            prm[576 + j] = p.in[I_RK][(d * 8 + h) * 64 + j]; prm[640 + j] = p.in[I_LNW][d * 512 + c]; prm[704 + j] = p.in[I_LNB][d * 512 + c]; }
        __syncthreads();
        float S0 = 0.f, S1 = 0.f, S2 = 0.f, S3 = 0.f, S4 = 0.f, S5 = 0.f, S6 = 0.f, S7 = 0.f;
        for (int n0 = 0; n0 < LT; n0 += 32) {
            float rs[4], ks[4], vs[4];
#pragma unroll
            for (int m = 0; m < 4; ++m) { const int s = wv + 8 * m, n = n0 + s; const bool hp = (n != 0) && (n != LC);
                const size_t row = (size_t)step_row(d, b, n), prow = hp ? (size_t)step_row(d, b, n - 1) : row; const int c = 64 * h + lane;
                const float r0 = bf2f(RW[row * 1536 + c]), k0 = bf2f(RW[row * 1536 + 512 + c]), v0 = bf2f(RW[row * 1536 + 1024 + c]);
                const float r1 = hp ? bf2f(RW[prow * 1536 + c]) : 0.f, k1 = hp ? bf2f(RW[prow * 1536 + 512 + c]) : 0.f, v1 = hp ? bf2f(RW[prow * 1536 + 1024 + c]) : 0.f;
                rs[m] = r0 + prm[lane] * (r1 - r0); ks[m] = k0 + prm[64 + lane] * (k1 - k0); vs[m] = v0 + prm[128 + lane] * (v1 - v0);
                const float wd0 = bf2f(LO[row * 512 + 64 * d + lane]), wd1 = hp ? bf2f(LO[prow * 512 + 64 * d + lane]) : 0.f;
                const float ad0 = bf2f(LO[row * 512 + 128 + 64 * d + lane]), ad1 = hp ? bf2f(LO[prow * 512 + 128 + 64 * d + lane]) : 0.f;
                TH[s * 64 + lane] = tanhf(wd0 + prm[192 + lane] * (wd1 - wd0)); AD[s * 64 + lane] = ad0 + prm[256 + lane] * (ad1 - ad0); }
            __syncthreads();
#pragma unroll
            for (int m = 0; m < 4; ++m) { const int s = wv + 8 * m;
                float xw = prm[320 + lane], xa = prm[384 + lane];
#pragma unroll 8
                for (int i = 0; i < 64; ++i) { xw += TH[s * 64 + i] * w2s[i * 64 + lane]; xa += AD[s * 64 + i] * a2s[i * 64 + lane]; }
                const float elog = 0.6065306597126334f * sigm(xw), dec = expf(-elog), a = sigm(xa);
                const float kkr = ks[m] * prm[448 + lane]; const float ss = wave_sum(kkr * kkr); const float kkn = kkr / fmaxf(sqrtf(ss), 1e-12f);
                const float km = ks[m] * (1.f + (a - 1.f) * prm[512 + lane]);
                const float bs = wave_sum(rs[m] * km * prm[576 + lane]);
                R[s * 64 + lane] = rs[m]; W[s * 64 + lane] = dec; K[s * 64 + lane] = km; KK[s * 64 + lane] = kkn; BV[s * 64 + lane] = kkn * a; V[s * 64 + lane] = vs[m];
                if (lane == 0) BS[s] = bs; }
            __syncthreads();
            for (int s = 0; s < 32; ++s) {
                const LAS f32x4* pq = (const LAS f32x4*)(KK + s * 64 + 8 * sg); const f32x4 q0 = pq[0], q1 = pq[1];
                const LAS f32x4* pw = (const LAS f32x4*)(W + s * 64 + 8 * sg); const f32x4 w0 = pw[0], w1 = pw[1];
                const LAS f32x4* pb = (const LAS f32x4*)(BV + s * 64 + 8 * sg); const f32x4 b0 = pb[0], b1 = pb[1];
                const LAS f32x4* pk = (const LAS f32x4*)(K + s * 64 + 8 * sg); const f32x4 k0 = pk[0], k1 = pk[1];
                const LAS f32x4* pr = (const LAS f32x4*)(R + s * 64 + 8 * sg); const f32x4 r0 = pr[0], r1 = pr[1];
                const float vi = V[s * 64 + srow];
                float sa = S0 * q0.x + S1 * q0.y + S2 * q0.z + S3 * q0.w + S4 * q1.x + S5 * q1.y + S6 * q1.z + S7 * q1.w;
                sa += __shfl_xor(sa, 1); sa += __shfl_xor(sa, 2); sa += __shfl_xor(sa, 4);
                S0 = S0 * w0.x - sa * b0.x + vi * k0.x; S1 = S1 * w0.y - sa * b0.y + vi * k0.y; S2 = S2 * w0.z - sa * b0.z + vi * k0.z; S3 = S3 * w0.w - sa * b0.w + vi * k0.w;
                S4 = S4 * w1.x - sa * b1.x + vi * k1.x; S5 = S5 * w1.y - sa * b1.y + vi * k1.y; S6 = S6 * w1.z - sa * b1.z + vi * k1.z; S7 = S7 * w1.w - sa * b1.w + vi * k1.w;
                float o = S0 * r0.x + S1 * r0.y + S2 * r0.z + S3 * r0.w + S4 * r1.x + S5 * r1.y + S6 * r1.z + S7 * r1.w;
                o += __shfl_xor(o, 1); o += __shfl_xor(o, 2); o += __shfl_xor(o, 4);
                if (sg == 0) OUT[s * 64 + srow] = o;
            }
            __syncthreads();
#pragma unroll
            for (int m = 0; m < 4; ++m) { const int s = wv + 8 * m, n = n0 + s; const size_t row = (size_t)step_row(d, b, n);
                const float o = OUT[s * 64 + lane]; const float mean = wave_sum(o) * (1.f / 64.f); const float dv = o - mean; const float var = wave_sum(dv * dv) * (1.f / 64.f);
                const float z = dv * rsqrtf(var + 64e-5f) * prm[640 + lane] + prm[704 + lane] + BS[s] * V[s * 64 + lane];
                Z[((size_t)d * NALL + row) * 512 + 64 * h + lane] = f2bf(z); }
        }
    }
    __syncthreads();
}
DI void phase_rwkv_post(const P& p, LAS unsigned char* ldsb) {
    LAS float* sg = (LAS float*)ldsb;
    const int tid = mk_tid();
    const bf16_t* LO = (const bf16_t*)(p.ws + WS_COLS) + OFF_LO; const bf16_t* Z = (const bf16_t*)(p.ws + WS_Z); bf16_t* Y = (bf16_t*)(p.ws + WS_COLS);
    const float* g2 = p.in[I_G2];
    for (int vb = blockIdx.x; vb < NALL / 8; vb += gridDim.x) {
        const size_t row0 = (size_t)vb * 8;
        __syncthreads();
        for (int e = tid; e < 1024; e += NT) { const int q = e >> 7, r = e & 127; sg[e] = sigm(bf2f(LO[(row0 + q) * 512 + 256 + r])); }
        __syncthreads();
        float a0 = 0.f, a1 = 0.f, a2 = 0.f, a3 = 0.f, a4 = 0.f, a5 = 0.f, a6 = 0.f, a7 = 0.f;
#pragma unroll 4
        for (int r = 0; r < 128; ++r) { const float g = g2[r * 512 + tid];
            a0 += sg[r] * g; a1 += sg[128 + r] * g; a2 += sg[256 + r] * g; a3 += sg[384 + r] * g; a4 += sg[512 + r] * g; a5 += sg[640 + r] * g; a6 += sg[768 + r] * g; a7 += sg[896 + r] * g; }
#define MK_RP(q, aq) { const size_t rr = row0 + q; const float z = bf2f(Z[rr * 512 + tid]) + bf2f(Z[((size_t)NALL + rr) * 512 + tid]); Y[rr * D + tid] = f2bf(z * aq); }
        MK_RP(0, a0) MK_RP(1, a1) MK_RP(2, a2) MK_RP(3, a3) MK_RP(4, a4) MK_RP(5, a5) MK_RP(6, a6) MK_RP(7, a7)
#undef MK_RP
    }
    __syncthreads();
}
DI void post_headnorm_row(const bf16_t* HB, size_t row, const float* ng, const bf16_t* gsrc, int gate_kind, bf16_t* ydst, int lane) {
    const int c0 = 8 * lane;
    const u32x4 h0 = *(const u32x4*)(HB + row * 512 + c0), h1 = *(const u32x4*)(HB + ((size_t)NALL + row) * 512 + c0), gg = *(const u32x4*)(gsrc + c0);
    float h[8], g[8];
#pragma unroll
    for (int j = 0; j < 4; ++j) { h[2 * j] = __uint_as_float(h0[j] << 16) + __uint_as_float(h1[j] << 16); h[2 * j + 1] = __uint_as_float(h0[j] & 0xffff0000u) + __uint_as_float(h1[j] & 0xffff0000u);
        g[2 * j] = __uint_as_float(gg[j] << 16); g[2 * j + 1] = __uint_as_float(gg[j] & 0xffff0000u); }
    float ss = 0.f;
#pragma unroll
    for (int j = 0; j < 8; ++j) ss += h[j] * h[j];
    ss += __shfl_xor(ss, 1); ss += __shfl_xor(ss, 2); ss += __shfl_xor(ss, 4); ss += __shfl_xor(ss, 8);
    const float rinv = rsqrtf(ss * (1.f / 128.f) + 1e-6f);
    unsigned o[4];
#pragma unroll
    for (int j = 0; j < 4; ++j) { const float y0 = h[2 * j] * rinv * ng[c0 + 2 * j] * (gate_kind ? siluf(g[2 * j]) : sigm(g[2 * j])), y1 = h[2 * j + 1] * rinv * ng[c0 + 2 * j + 1] * (gate_kind ? siluf(g[2 * j + 1]) : sigm(g[2 * j + 1]));
        o[j] = (unsigned)f2bf(y0) | ((unsigned)f2bf(y1) << 16); }
    u32x4 w; w.x = o[0]; w.y = o[1]; w.z = o[2]; w.w = o[3];
    *(u32x4*)(ydst + c0) = w;
}
typedef short bf16x8 __attribute__((ext_vector_type(8)));
typedef short s16x4 __attribute__((ext_vector_type(4)));
constexpr int PQ = 136, PS = 72, PV = 56;
constexpr int E_QS = 0, E_KS = E_QS + 64 * PQ * 2, E_VS = E_KS + 64 * PQ * 2, E_PS = E_VS + 64 * PV * 2, E_ST = E_PS + 64 * PS * 2, E_F = E_ST + 48 * PQ * 2, E_END = E_F + 1024;
constexpr size_t WS_Q1 = WS_COLS + (size_t)231 * MiB;
constexpr int NRC = NALL / 64;

DI int chunk_row0(int d, int b, int ci) {
    if (ci < 4) { const int cc = d ? 3 - ci : ci; return NLAT + b * LC + 64 * cc; }
    const int lc = ci - 4, cl = d ? 127 - lc : lc; return b * L + 64 * cl;
}
DI unsigned pack2(float lo, float hi) { return (unsigned)f2bf(lo) | ((unsigned)f2bf(hi) << 16); }
DI bf16x8 tr_frag(unsigned tile_base, int pitch, int k0, int c0, int r, int q) {
    const unsigned a0 = tile_base + (unsigned)(((k0 + 8 * q + (r >> 2)) * pitch + c0 + 4 * (r & 3)) * 2), a1 = a0 + (unsigned)(4 * pitch * 2);
    s16x4 x, y;
    asm volatile("ds_read_b64_tr_b16 %0, %2\n\tds_read_b64_tr_b16 %1, %3\n\ts_waitcnt lgkmcnt(0)" : "=&v"(x), "=&v"(y) : "v"(a0), "v"(a1) : "memory");
    bf16x8 o; o[0] = x[0]; o[1] = x[1]; o[2] = x[2]; o[3] = x[3]; o[4] = y[0]; o[5] = y[1]; o[6] = y[2]; o[7] = y[3];
    return o;
}

#define GLA_PREFETCH(ci_) do { const int row0_ = chunk_row0(d, b, (ci_)); \
    _Pragma("unroll") for (int i = 0; i < 2; ++i) { const size_t row_ = (size_t)(row0_ + prow0 + 32 * i); \
        rq[i] = *(const u32x4*)(Qg + row_ * ldq + 8 * ppc); rk[i] = *(const u32x4*)(Kg + row_ * ldk + 8 * ppc); } \
    if (tid < 256) rv = *(const u32x4*)(Vg + (size_t)(row0_ + vrow) * ldv + 8 * vpc); \
    if (MODE == 0) { if (tid < 64) { const size_t row_ = (size_t)(row0_ + (d ? 63 - lane : lane)); gi = bf2f(LO[row_ * 512 + 384 + 4 * d + hd]); gf = bf2f(LO[row_ * 512 + 392 + 4 * d + hd]); } } \
    else rlam = *(const f32x4*)(LAM + ((size_t)d * NRC + (row0_ >> 6)) * 512 + 128 * hd + 16 * wv + 4 * q); } while (0)

template <int MODE> DI void gla_unit(const P& p, LAS unsigned char* lds, int unit) {
    constexpr int NDV = MODE == 0 ? 3 : 2;
    const int tid = mk_tid(), lane = tid & 63, wv = __builtin_amdgcn_readfirstlane(tid >> 6), r = lane & 15, q = lane >> 4;
    const int d = unit >> 6, b = (unit >> 4) & 3, hd = (unit >> 2) & 3, sl = unit & 3;
    const bf16_t* COLS = (const bf16_t*)(p.ws + WS_COLS);
    const bf16_t *Qg, *Kg, *Vg; int ldq, ldk, ldv;
    if (MODE == 0) { const bf16_t* ML = COLS + OFF_ML; Qg = ML + 128 * hd; Kg = ML + 512 + 128 * hd; Vg = ML + 1024 + 128 * hd + 32 * sl; ldq = ldk = ldv = 2048; }
    else { Qg = d ? (const bf16_t*)(p.ws + WS_Q1) + 128 * hd : COLS + 128 * hd; ldq = d ? 512 : 3584; Kg = COLS + 512 + 512 * d + 128 * hd; ldk = 3584; Vg = COLS + 1536 + 128 * hd + 32 * sl; ldv = 3584; }
    const bf16_t* LO = COLS + OFF_LO;
    const float* LAM = (const float*)(p.ws + WS_LAM);
    bf16_t* HB = (bf16_t*)(p.ws + WS_ACT);
    LAS bf16_t* Qs = (LAS bf16_t*)(lds + E_QS); LAS bf16_t* Ks = (LAS bf16_t*)(lds + E_KS); LAS bf16_t* Vs = (LAS bf16_t*)(lds + E_VS);
    LAS bf16_t* Ps = (LAS bf16_t*)(lds + E_PS); LAS bf16_t* STs = (LAS bf16_t*)(lds + E_ST); LAS float* Fs = (LAS float*)(lds + E_F);
    const unsigned ks_base = (unsigned)(size_t)Ks, vs_base = (unsigned)(size_t)Vs;
    float bi = 0.f, bfv = 0.f;
    if (MODE == 0) { bi = p.in[I_MBI][d * 4 + hd]; bfv = p.in[I_MBF][d * 4 + hd]; }
    __syncthreads();
    for (int e = tid; e < 48 * PQ / 2; e += NT) ((LAS unsigned*)STs)[e] = 0u;
    for (int e = tid; e < 64 * PV / 2; e += NT) ((LAS unsigned*)Vs)[e] = 0u;
    __syncthreads();
    f32x4 Sacc[NDV];
#pragma unroll
    for (int n = 0; n < NDV; ++n) Sacc[n] = (f32x4){0.f, 0.f, 0.f, 0.f};
    u32x4 rq[2], rk[2], rv = (u32x4){0u, 0u, 0u, 0u}; float gi = 0.f, gf = 0.f; f32x4 rlam = (f32x4){1.f, 1.f, 1.f, 1.f};
    const int prow0 = tid >> 4, ppc = tid & 15;
    const int vrow = tid >> 2, vpc = tid & 3;
    GLA_PREFETCH(0);
    for (int ci = 0; ci < 132; ++ci) {
        const int row0 = chunk_row0(d, b, ci);
        unsigned oz = 0u; asm volatile("" : "+v"(oz));
        const unsigned ks_b = ks_base + oz, vs_b = vs_base + oz;
        f32x4 lamv = rlam;
        if (MODE == 0) {
            if (tid < 64) {
                const float li = gi + bi, x = gf + bfv;
                float v = -log1pf(expf(-x));
#pragma unroll
                for (int o = 1; o < 64; o <<= 1) { const float t = __shfl_up(v, o); if (lane >= o) v += t; }
                const int rc = d ? 63 - lane : lane;
                Fs[rc] = expf(v) * 0.08838834764831845f; Fs[64 + rc] = expf(li - v);
                if (lane == 63) Fs[128] = expf(v);
            }
        }
#pragma unroll
        for (int i = 0; i < 2; ++i) { const int row = prow0 + 32 * i; *(LAS u32x4*)(Qs + row * PQ + 8 * ppc) = rq[i]; *(LAS u32x4*)(Ks + row * PQ + 8 * ppc) = rk[i]; }
        if (MODE == 0) __syncthreads();
        if (tid < 256) {
            if (MODE == 0) { const float w = Fs[64 + vrow]; u32x4 o;
#pragma unroll
                for (int e = 0; e < 4; ++e) o[e] = pack2(__uint_as_float(rv[e] << 16) * w, __uint_as_float(rv[e] & 0xffff0000u) * w);
                *(LAS u32x4*)(Vs + vrow * PV + 8 * vpc) = o;
                if (vpc == 0) Vs[vrow * PV + 32] = f2bf(w); }
            else *(LAS u32x4*)(Vs + vrow * PV + 8 * vpc) = rv;
        }
        __syncthreads();
        if (ci + 1 < 132) GLA_PREFETCH(ci + 1);
        if (MODE == 0) { const float l = Fs[128]; lamv = (f32x4){l, l, l, l}; }
        {
            const int tt = wv & 3, sh = wv >> 2;
            f32x4 pacc[2] = {(f32x4){0.f, 0.f, 0.f, 0.f}, (f32x4){0.f, 0.f, 0.f, 0.f}};
#pragma unroll
            for (int kk = 0; kk < 4; ++kk) { const bf16x8 bq = *(const LAS bf16x8*)(Qs + (16 * tt + r) * PQ + 32 * kk + 8 * q);
#pragma unroll
                for (int i = 0; i < 2; ++i) { const bf16x8 a = *(const LAS bf16x8*)(Ks + (16 * (2 * sh + i) + r) * PQ + 32 * kk + 8 * q); pacc[i] = __builtin_amdgcn_mfma_f32_16x16x32_bf16(a, bq, pacc[i], 0, 0, 0); } }
            const int t = 16 * tt + r;
#pragma unroll
            for (int i = 0; i < 2; ++i) { const int s0 = 16 * (2 * sh + i) + 4 * q; float v[4];
#pragma unroll
                for (int j = 0; j < 4; ++j) { const int s = s0 + j; const bool ok = d ? (s >= t) : (s <= t); v[j] = ok ? pacc[i][j] : 0.f; }
                u32x2 w; w.x = pack2(v[0], v[1]); w.y = pack2(v[2], v[3]); *(LAS u32x2*)(Ps + t * PS + s0) = w; }
        }
#pragma unroll
        for (int kk = 0; kk < 2; ++kk) { const bf16x8 a = tr_frag(ks_b, PQ, 32 * kk, 16 * wv, r, q);
#pragma unroll
            for (int n = 0; n < NDV; ++n) { const bf16x8 bv = tr_frag(vs_b, PV, 32 * kk, 16 * n, r, q); Sacc[n] = __builtin_amdgcn_mfma_f32_16x16x32_bf16(a, bv, Sacc[n], 0, 0, 0); } }
        __syncthreads();
        {
            const int tt = wv & 3, nA = wv >> 2;
            f32x4 oacc = (f32x4){0.f, 0.f, 0.f, 0.f}, dacc = (f32x4){0.f, 0.f, 0.f, 0.f};
#pragma unroll
            for (int kk = 0; kk < 2; ++kk) { const bf16x8 bp = *(const LAS bf16x8*)(Ps + (16 * tt + r) * PS + 32 * kk + 8 * q);
                const bf16x8 a = tr_frag(vs_b, PV, 32 * kk, 16 * nA, r, q); oacc = __builtin_amdgcn_mfma_f32_16x16x32_bf16(a, bp, oacc, 0, 0, 0);
                if (MODE == 0) { const bf16x8 a2 = tr_frag(vs_b, PV, 32 * kk, 32, r, q); dacc = __builtin_amdgcn_mfma_f32_16x16x32_bf16(a2, bp, dacc, 0, 0, 0); } }
#pragma unroll
            for (int kk = 0; kk < 4; ++kk) { const bf16x8 bq = *(const LAS bf16x8*)(Qs + (16 * tt + r) * PQ + 32 * kk + 8 * q);
                const bf16x8 a = *(const LAS bf16x8*)(STs + (16 * nA + r) * PQ + 32 * kk + 8 * q); oacc = __builtin_amdgcn_mfma_f32_16x16x32_bf16(a, bq, oacc, 0, 0, 0);
                if (MODE == 0) { const bf16x8 a2 = *(const LAS bf16x8*)(STs + (32 + r) * PQ + 32 * kk + 8 * q); dacc = __builtin_amdgcn_mfma_f32_16x16x32_bf16(a2, bq, dacc, 0, 0, 0); } }
            const int t = 16 * tt + r;
            float o0 = oacc[0], o1 = oacc[1], o2 = oacc[2], o3 = oacc[3];
            if (MODE == 0) { const float rs = Fs[t]; const float den = __shfl(dacc[0], r) * rs; const float inv = rs / fmaxf(fabsf(den), 1.f); o0 *= inv; o1 *= inv; o2 *= inv; o3 *= inv; }
            u32x2 w; w.x = pack2(o0, o1); w.y = pack2(o2, o3);
            *(u32x2*)(HB + ((size_t)d * NALL + row0 + t) * 512 + 128 * hd + 32 * sl + 16 * nA + 4 * q) = w;
        }
        __syncthreads();
#pragma unroll
        for (int n = 0; n < NDV; ++n) { Sacc[n] = Sacc[n] * lamv; u32x2 w; w.x = pack2(Sacc[n][0], Sacc[n][1]); w.y = pack2(Sacc[n][2], Sacc[n][3]); *(LAS u32x2*)(STs + (16 * n + r) * PQ + 16 * wv + 4 * q) = w; }
    }
    __syncthreads();
}

DI void phase_hgrn_prep(const P& p, LAS unsigned char* ldsb) {
    LAS float* tot = (LAS float*)ldsb;
    const int tid = mk_tid(), ch = tid & 127, qt = tid >> 7;
    bf16_t* C1 = (bf16_t*)(p.ws + WS_COLS); bf16_t* Q1 = (bf16_t*)(p.ws + WS_Q1); float* LAM = (float*)(p.ws + WS_LAM);
    for (int vb = blockIdx.x; vb < NRC * 4; vb += gridDim.x) {
        const int rc = vb >> 2, hd = vb & 3, c = 128 * hd + ch; const size_t rbase = (size_t)rc * 64 + 16 * qt;
        const float lb = sigm(p.in[I_HLB][512 + c] - p.in[I_HLB][c]);
        float qv[16], l0[16], l1[16], k0[16], k1[16];
#pragma unroll
        for (int i = 0; i < 16; ++i) { const bf16_t* base = C1 + (rbase + i) * 3584;
            qv[i] = siluf(bf2f(base[c])); const float s0 = sigm(bf2f(base[512 + c])), s1 = sigm(bf2f(base[1024 + c]));
            l0[i] = logf(lb + (1.f - lb) * s0); l1[i] = logf(lb + (1.f - lb) * s1); k0[i] = (1.f - lb) * (1.f - s0); k1[i] = (1.f - lb) * (1.f - s1); }
#pragma unroll
        for (int i = 1; i < 16; ++i) l0[i] += l0[i - 1];
#pragma unroll
        for (int i = 14; i >= 0; --i) l1[i] += l1[i + 1];
        __syncthreads();
        tot[qt * 128 + ch] = l0[15]; tot[512 + qt * 128 + ch] = l1[0];
        __syncthreads();
        float off0 = 0.f, off1 = 0.f, t0 = 0.f, t1 = 0.f;
#pragma unroll
        for (int j = 0; j < 4; ++j) { const float a = tot[j * 128 + ch], bb = tot[512 + j * 128 + ch]; t0 += a; t1 += bb; if (j < qt) off0 += a; if (j > qt) off1 += bb; }
#pragma unroll
        for (int i = 0; i < 16; ++i) { bf16_t* base = C1 + (rbase + i) * 3584; const float c0 = l0[i] + off0, c1 = l1[i] + off1;
            base[c] = f2bf(qv[i] * expf(c0)); base[512 + c] = f2bf(k0[i] * expf(-c0)); base[1024 + c] = f2bf(k1[i] * expf(-c1)); Q1[(rbase + i) * 512 + c] = f2bf(qv[i] * expf(c1)); }
        if (qt == 0) { LAM[((size_t)rc) * 512 + c] = expf(t0); LAM[((size_t)NRC + rc) * 512 + c] = expf(t1); }
    }
    __syncthreads();
}
constexpr int M_XB = 0, M_XCS = M_XB + 67 * 64 * 4, M_XCF = M_XCS + 64 * 72 * 2, M_W = M_XCF + 64 * 64 * 4, M_AU = M_W + 4 * 64 * 72 * 2, M_SEG = M_AU + 4 * 64 * 65 * 4, M_PRM = M_SEG + 4 * 8 * 64 * 4,
              M_CAR = M_PRM + 11 * 64 * 4, M_END = M_CAR + 2 * 64 * 4;
static_assert(M_END <= LDS_BYTES, "lru LDS map");
DI float nexpm1_small(float x) { const float ser = -x * (1.f + x * 0.5f * (1.f + x * (1.f / 3.f) * (1.f + x * 0.25f * (1.f + x * 0.2f)))); return (x > -0.25f) ? ser : 1.f - fexp(x); }
DI int lru_rc_at(int d, int b, int s) { if (s < 4) return 512 + 4 * b + (d ? 3 - s : s); const int lc = s - 4; return 128 * b + (d ? 127 - lc : lc); }
template <int PASS> DI void lru_pass(const P& p, LAS unsigned char* lds, const int lb, const int nlb) {
    const int tid = mk_tid(), lane = tid & 63, wv = __builtin_amdgcn_readfirstlane(tid >> 6), r = lane & 15, q = lane >> 4;
    const int hb = lb & 7;
    const bf16_t* C1 = (const bf16_t*)(p.ws + WS_COLS); bf16_t* Y = (bf16_t*)(p.ws + WS_Z); float* LSUM = (float*)(p.ws + WS_LSUM);
    LAS float* XB = (LAS float*)(lds + M_XB); LAS bf16_t* XCs = (LAS bf16_t*)(lds + M_XCS); LAS float* XCf = (LAS float*)(lds + M_XCF); LAS bf16_t* Wt = (LAS bf16_t*)(lds + M_W);
    LAS float* AU = (LAS float*)(lds + M_AU);
    LAS float* SEG = (LAS float*)(lds + M_SEG);
    LAS float* prm = (LAS float*)(lds + M_PRM);
    LAS float* CAR = (LAS float*)(lds + M_CAR);
    __syncthreads();
    for (int e = tid; e < 4 * 4096; e += NT) { const int g = e >> 12, i = (e >> 6) & 63, j = e & 63, d = g >> 1; const size_t o = ((size_t)(d * 8 + hb) * 64 + i) * 64 + j;
        Wt[(g * 64 + j) * 72 + i] = f2bf((g & 1) ? p.in[I_WI][o] : p.in[I_WA][o]); }
    if (tid < 64) { const int ch = 64 * hb + tid;
        prm[tid] = p.in[I_CONVW][ch]; prm[64 + tid] = p.in[I_CONVW][512 + ch]; prm[128 + tid] = p.in[I_CONVW][1024 + ch]; prm[192 + tid] = p.in[I_CONVW][1536 + ch]; prm[256 + tid] = p.in[I_CONVB][ch];
        prm[320 + tid] = p.in[I_BA][ch]; prm[384 + tid] = p.in[I_BA][512 + ch]; prm[448 + tid] = p.in[I_BI][ch]; prm[512 + tid] = p.in[I_BI][512 + ch];
        prm[576 + tid] = log1pf(expf(-p.in[I_LAM][ch])); prm[640 + tid] = log1pf(expf(-p.in[I_LAM][512 + ch])); }
    const int nrc = (PASS == 1) ? NRC : 512, rstep = nlb >> 3;
    u32x4 px[2];
#define LRU_PREFETCH(rc_) do { const int rc__ = (rc_); const int row0_ = rc__ * 64; const int seg_lo_ = (rc__ >= 512) ? NLAT + ((rc__ - 512) >> 2) * LC : (rc__ >> 7) * L, seg_hi_ = seg_lo_ + ((rc__ >= 512) ? LC : L); \
    _Pragma("unroll") for (int i = 0; i < 2; ++i) { const int e = tid + 512 * i, rr = e >> 3, pc = e & 7, grow = row0_ - 2 + rr; px[i] = (u32x4){0u, 0u, 0u, 0u}; \
        if (e < 67 * 8 && grow >= seg_lo_ && grow < seg_hi_) px[i] = *(const u32x4*)(C1 + (size_t)grow * C1LD + 2560 + 64 * hb + 8 * pc); } } while (0)
    int rc = lb >> 3;
    if (rc < nrc) LRU_PREFETCH(rc);
    for (; rc < nrc; rc += rstep) {
        const int row0 = rc * 64;
        const int sg = tid >> 6, j = lane, ch = 64 * hb + j;
        float cin = 0.f;
        if (PASS == 3 && tid < 128) { const int d = tid >> 6, b = rc >> 7, cl = rc & 127, pos = 4 + (d ? 127 - cl : cl);
            const float* S = LSUM + (size_t)d * NRC * 1024 + 2 * ch;
#pragma unroll 4
            for (int s = 0; s < pos; ++s) { const float* e2 = S + (size_t)lru_rc_at(d, b, s) * 1024; cin = e2[0] * cin + e2[1]; }
        }
        float gbv[8];
        if (PASS == 3) {
#pragma unroll
            for (int k = 0; k < 8; ++k) gbv[k] = bf2f(C1[(size_t)(row0 + 8 * sg + k) * C1LD + 3072 + ch]); }
#pragma unroll
        for (int i = 0; i < 2; ++i) { const int e = tid + 512 * i; if (e < 67 * 8) { const int rr = e >> 3, pc = e & 7; const u32x4 v = px[i];
            f32x4 lo, hi; lo[0] = __uint_as_float(v[0] << 16); lo[1] = __uint_as_float(v[0] & 0xffff0000u); lo[2] = __uint_as_float(v[1] << 16); lo[3] = __uint_as_float(v[1] & 0xffff0000u);
            hi[0] = __uint_as_float(v[2] << 16); hi[1] = __uint_as_float(v[2] & 0xffff0000u); hi[2] = __uint_as_float(v[3] << 16); hi[3] = __uint_as_float(v[3] & 0xffff0000u);
            *(LAS f32x4*)(XB + rr * 64 + 8 * pc) = lo; *(LAS f32x4*)(XB + rr * 64 + 8 * pc + 4) = hi; } }
        if (PASS == 3 && tid < 128) CAR[tid] = cin;
        __syncthreads();
        if (rc + rstep < nrc) LRU_PREFETCH(rc + rstep);
        {
            const int t = tid >> 3, i0 = 8 * (tid & 7); float xc[8];
#pragma unroll
            for (int c = 0; c < 8; ++c) { const int i = i0 + c; xc[c] = prm[256 + i] + prm[i] * XB[t * 64 + i] + prm[64 + i] * XB[(t + 1) * 64 + i] + prm[128 + i] * XB[(t + 2) * 64 + i] + prm[192 + i] * XB[(t + 3) * 64 + i]; XCf[t * 64 + i] = xc[c]; }
            u32x4 w; w.x = pack2(xc[0], xc[1]); w.y = pack2(xc[2], xc[3]); w.z = pack2(xc[4], xc[5]); w.w = pack2(xc[6], xc[7]);
            *(LAS u32x4*)(XCs + t * 72 + i0) = w;
        }
        __syncthreads();
        {
            const int jt = wv & 3, th = wv >> 2, jc = 16 * jt + r;
#pragma unroll
            for (int d = 0; d < 2; ++d) { const float ba = prm[320 + 64 * d + jc], bi = prm[448 + 64 * d + jc], spl = prm[576 + 64 * d + jc];
#pragma unroll
                for (int i2 = 0; i2 < 2; ++i2) { const int tt = 2 * th + i2;
                    f32x4 aa = (f32x4){0.f, 0.f, 0.f, 0.f}, ai = (f32x4){0.f, 0.f, 0.f, 0.f};
#pragma unroll
                    for (int kk = 0; kk < 2; ++kk) { const bf16x8 xf = *(const LAS bf16x8*)(XCs + (16 * tt + r) * 72 + 32 * kk + 8 * q);
                        const bf16x8 wa = *(const LAS bf16x8*)(Wt + ((2 * d) * 64 + 16 * jt + r) * 72 + 32 * kk + 8 * q), wi = *(const LAS bf16x8*)(Wt + ((2 * d + 1) * 64 + 16 * jt + r) * 72 + 32 * kk + 8 * q);
                        aa = __builtin_amdgcn_mfma_f32_16x16x32_bf16(xf, wa, aa, 0, 0, 0); ai = __builtin_amdgcn_mfma_f32_16x16x32_bf16(xf, wi, ai, 0, 0, 0); }
#pragma unroll
                    for (int jj = 0; jj < 4; ++jj) { const int t = 16 * tt + 4 * q + jj;
                        const float rg = fsigm(aa[jj] + ba), ig = fsigm(ai[jj] + bi), la = -8.f * rg * spl;
                        AU[((2 * d) * 64 + t) * 65 + jc] = 1.f - nexpm1_small(la); AU[((2 * d + 1) * 64 + t) * 65 + jc] = sqrtf(nexpm1_small(2.f * la)) * (ig * XCf[t * 64 + jc]); } } }
        }
        __syncthreads();
        const LAS float* A0 = AU + (8 * sg) * 65 + j; const LAS float* U0 = AU + (64 + 8 * sg) * 65 + j; const LAS float* A1 = AU + (128 + 8 * sg) * 65 + j; const LAS float* U1 = AU + (192 + 8 * sg) * 65 + j;
        {
            float p0 = 1.f, h0 = 0.f, p1 = 1.f, h1 = 0.f;
#pragma unroll
            for (int k = 0; k < 8; ++k) { const float a = A0[k * 65]; h0 = a * h0 + U0[k * 65]; p0 *= a; }
#pragma unroll
            for (int k = 7; k >= 0; --k) { const float a = A1[k * 65]; h1 = a * h1 + U1[k * 65]; p1 *= a; }
            SEG[(0 * 8 + sg) * 64 + j] = p0; SEG[(1 * 8 + sg) * 64 + j] = h0; SEG[(2 * 8 + sg) * 64 + j] = p1; SEG[(3 * 8 + sg) * 64 + j] = h1;
        }
        __syncthreads();
        if (PASS == 1) {
            if (tid < 128) { const int d = tid >> 6; float pa = 1.f, hh = 0.f;
#pragma unroll
                for (int s2 = 0; s2 < 8; ++s2) { const int sgi = d ? 7 - s2 : s2; const float ps = SEG[((2 * d) * 8 + sgi) * 64 + j], hs = SEG[((2 * d + 1) * 8 + sgi) * 64 + j]; hh = ps * hh + hs; pa *= ps; }
                float* o = LSUM + ((size_t)d * NRC + rc) * 1024 + 2 * ch; o[0] = pa; o[1] = hh; }
        } else {
            float hf = CAR[j], hbk = CAR[64 + j];
            for (int s2 = 0; s2 < sg; ++s2) hf = SEG[(0 * 8 + s2) * 64 + j] * hf + SEG[(1 * 8 + s2) * 64 + j];
            for (int s2 = 7; s2 > sg; --s2) hbk = SEG[(2 * 8 + s2) * 64 + j] * hbk + SEG[(3 * 8 + s2) * 64 + j];
            float of[8];
#pragma unroll
            for (int k = 0; k < 8; ++k) { hf = A0[k * 65] * hf + U0[k * 65]; of[k] = hf; }
#pragma unroll
            for (int k = 7; k >= 0; --k) { hbk = A1[k * 65] * hbk + U1[k * 65]; of[k] += hbk; }
#pragma unroll
            for (int k = 0; k < 8; ++k) Y[(size_t)nat_row(row0 + 8 * sg + k) * D + 512 + ch] = f2bf(of[k] * fgelu(gbv[k]));
        }
        __syncthreads();
    }
#undef LRU_PREFETCH
}
constexpr int PT = 72, PM = 40;
constexpr int C_PRM = 0, C_GAM = C_PRM + 3072, C_MISC = C_GAM + 1024, C_SBF = C_MISC + 1280, C_TILES = C_SBF + 2 * 64 * PT * 2, C_TH = C_TILES + 5 * 80 * PT * 2, C_MBF = C_TH + 2 * 64 * PT * 2,
              C_SM = C_MBF + 4 * 16 * 20 * 4, C_W1T = C_SM + 4 * 4 * 16 * PM * 2, C_AH = C_W1T + 4 * 64 * PM * 2, C_YV = C_AH + 4 * 16 * PT * 2, C_END = C_YV + 64 * PM * 2;
static_assert(C_END <= LDS_BYTES, "rwkv chunk LDS map");
DI void unpack4(u32x2 v, float* o) { o[0] = __uint_as_float(v.x << 16); o[1] = __uint_as_float(v.x & 0xffff0000u); o[2] = __uint_as_float(v.y << 16); o[3] = __uint_as_float(v.y & 0xffff0000u); }
DI u32x2 pack4(float a, float b, float c, float d) { u32x2 w; w.x = pack2(a, b); w.y = pack2(c, d); return w; }
DI bf16x8 zero_if(bf16x8 v, bool z) { const bf16x8 zz = {0, 0, 0, 0, 0, 0, 0, 0}; return z ? zz : v; }

DI void rwkv_chunk_unit(const P& p, LAS unsigned char* lds, const int vb) {
    const int tid = mk_tid(), lane = tid & 63, wv = __builtin_amdgcn_readfirstlane(tid >> 6), r = lane & 15, q = lane >> 4;
    const int d = vb >> 5, b = (vb >> 3) & 3, h = vb & 7;
    const bf16_t* RW = (const bf16_t*)(p.ws + WS_COLS) + OFF_RW; const bf16_t* LO = (const bf16_t*)(p.ws + WS_COLS) + OFF_LO; bf16_t* Z = (bf16_t*)(p.ws + WS_Z);
    LAS float* prm = (LAS float*)(lds + C_PRM); LAS float* GAM = (LAS float*)(lds + C_GAM); LAS float* SSQ = (LAS float*)(lds + C_MISC); LAS float* BSP = SSQ + 128; LAS float* BS = SSQ + 256;
    LAS bf16_t* Sbf = (LAS bf16_t*)(lds + C_SBF);
    LAS bf16_t* At = (LAS bf16_t*)(lds + C_TILES); LAS bf16_t* Rt = At + 80 * PT; LAS bf16_t* Bt = Rt + 80 * PT; LAS bf16_t* Kt = Bt + 80 * PT; LAS bf16_t* Vt = Kt + 80 * PT;
    LAS bf16_t* TH = (LAS bf16_t*)(lds + C_TH); LAS bf16_t* AD = TH + 64 * PT; LAS float* OUT = (LAS float*)(lds + C_TH);
    LAS float* MBf = (LAS float*)(lds + C_MBF);
    LAS bf16_t* MK = (LAS bf16_t*)(lds + C_SM); LAS bf16_t* NK = MK + 4 * 16 * PM; LAS bf16_t* NB = NK + 4 * 16 * PM; LAS bf16_t* DNV = NB + 4 * 16 * PM;
    LAS bf16_t* W1T = (LAS bf16_t*)(lds + C_W1T); LAS bf16_t* AH = (LAS bf16_t*)(lds + C_AH); LAS bf16_t* YV = (LAS bf16_t*)(lds + C_YV);
    const unsigned at_b = (unsigned)(size_t)At, bt_b = (unsigned)(size_t)Bt, kt_b = (unsigned)(size_t)Kt, vt_b = (unsigned)(size_t)Vt;
    __syncthreads();
    for (int e = tid; e < (C_END - C_SBF) / 4; e += NT) ((LAS unsigned*)(lds + C_SBF))[e] = 0u;
    if (tid < 64) { const int j = tid, c = 64 * h + j; const float* mu = p.in[I_MU] + d * 1664;
        prm[j] = mu[c]; prm[64 + j] = mu[512 + c]; prm[128 + j] = mu[1024 + c]; prm[192 + j] = mu[1536 + j]; prm[256 + j] = mu[1600 + j];
        prm[320 + j] = p.in[I_W0][d * 512 + c]; prm[384 + j] = p.in[I_A0][d * 512 + c]; prm[448 + j] = p.in[I_KK][d * 512 + c]; prm[512 + j] = p.in[I_KA][d * 512 + c];
        prm[576 + j] = p.in[I_RK][(d * 8 + h) * 64 + j]; prm[640 + j] = p.in[I_LNW][d * 512 + c]; prm[704 + j] = p.in[I_LNB][d * 512 + c]; }
    const int m1 = wv & 3, h2 = wv >> 2;
    bf16x8 fw2[2][2], fa2[2][2];
#pragma unroll
    for (int t = 0; t < 2; ++t)
#pragma unroll
        for (int kk = 0; kk < 2; ++kk) { const int c = 64 * h + 16 * (2 * h2 + t) + r;
            const float* w2p = p.in[I_W2L] + (size_t)(d * 64 + 32 * kk + 8 * q) * 512 + c; const float* a2p = p.in[I_A2L] + (size_t)(d * 64 + 32 * kk + 8 * q) * 512 + c;
#pragma unroll
            for (int e = 0; e < 8; ++e) { fw2[t][kk][e] = (short)f2bf(w2p[e * 512]); fa2[t][kk][e] = (short)f2bf(a2p[e * 512]); }
            asm volatile("" ::: "memory"); }
    f32x4 Sacc[2] = {(f32x4){0.f, 0.f, 0.f, 0.f}, (f32x4){0.f, 0.f, 0.f, 0.f}};
    int cur = 0;
    __syncthreads();
    for (int n0 = 0; n0 < LT; n0 += 64) {
        const int u1 = 16 * m1 + r, n1 = n0 + u1; const bool hp = (n1 != 0) && (n1 != LC);
        const size_t row1 = (size_t)step_row(d, b, n1), prow1 = hp ? (size_t)step_row(d, b, n1 - 1) : row1;
        float rs[8], ks[8], vs[8];
#pragma unroll
        for (int t = 0; t < 2; ++t) { const int cb = 32 * h2 + 16 * t + 4 * q;
            float a0[4], a1[4];
#define RW_SHIFT(dst, off, muo) { unpack4(*(const u32x2*)(RW + row1 * 1536 + (off) + 64 * h + cb), a0); if (hp) unpack4(*(const u32x2*)(RW + prow1 * 1536 + (off) + 64 * h + cb), a1); else { a1[0] = a1[1] = a1[2] = a1[3] = 0.f; } \
            const f32x4 mu4 = *(const LAS f32x4*)(prm + (muo) + cb); _Pragma("unroll") for (int jj = 0; jj < 4; ++jj) dst[4 * t + jj] = a0[jj] + mu4[jj] * (a1[jj] - a0[jj]); }
            RW_SHIFT(rs, 0, 0) RW_SHIFT(ks, 512, 64) RW_SHIFT(vs, 1024, 128)
#undef RW_SHIFT
            float th[4], ad[4];
            { unpack4(*(const u32x2*)(LO + row1 * 512 + 64 * d + cb), a0); if (hp) unpack4(*(const u32x2*)(LO + prow1 * 512 + 64 * d + cb), a1); else { a1[0] = a1[1] = a1[2] = a1[3] = 0.f; }
              const f32x4 mu4 = *(const LAS f32x4*)(prm + 192 + cb);
#pragma unroll
              for (int jj = 0; jj < 4; ++jj) th[jj] = ftanh(a0[jj] + mu4[jj] * (a1[jj] - a0[jj])); }
            { unpack4(*(const u32x2*)(LO + row1 * 512 + 128 + 64 * d + cb), a0); if (hp) unpack4(*(const u32x2*)(LO + prow1 * 512 + 128 + 64 * d + cb), a1); else { a1[0] = a1[1] = a1[2] = a1[3] = 0.f; }
              const f32x4 mu4 = *(const LAS f32x4*)(prm + 256 + cb);
#pragma unroll
              for (int jj = 0; jj < 4; ++jj) ad[jj] = a0[jj] + mu4[jj] * (a1[jj] - a0[jj]); }
            *(LAS u32x2*)(TH + u1 * PT + cb) = pack4(th[0], th[1], th[2], th[3]); *(LAS u32x2*)(AD + u1 * PT + cb) = pack4(ad[0], ad[1], ad[2], ad[3]);
            asm volatile("" ::: "memory");
        }
        __syncthreads();
        float elog[8], av[8], kkr[8], km[8]; float ssq = 0.f, bsp = 0.f;
#pragma unroll
        for (int t = 0; t < 2; ++t) { const int cb = 32 * h2 + 16 * t + 4 * q;
            f32x4 xw = (f32x4){0.f, 0.f, 0.f, 0.f}, xa = (f32x4){0.f, 0.f, 0.f, 0.f};
#pragma unroll
            for (int kk = 0; kk < 2; ++kk) { const bf16x8 bt = *(const LAS bf16x8*)(TH + u1 * PT + 32 * kk + 8 * q), ba = *(const LAS bf16x8*)(AD + u1 * PT + 32 * kk + 8 * q);
                xw = __builtin_amdgcn_mfma_f32_16x16x32_bf16(fw2[t][kk], bt, xw, 0, 0, 0); xa = __builtin_amdgcn_mfma_f32_16x16x32_bf16(fa2[t][kk], ba, xa, 0, 0, 0); }
            const f32x4 w04 = *(const LAS f32x4*)(prm + 320 + cb), a04 = *(const LAS f32x4*)(prm + 384 + cb), kk4 = *(const LAS f32x4*)(prm + 448 + cb), ka4 = *(const LAS f32x4*)(prm + 512 + cb), rk4 = *(const LAS f32x4*)(prm + 576 + cb);
#pragma unroll
            for (int jj = 0; jj < 4; ++jj) { const int e = 4 * t + jj;
                elog[e] = 0.6065306597126334f * fsigm(xw[jj] + w04[jj]); av[e] = fsigm(xa[jj] + a04[jj]);
                kkr[e] = ks[e] * kk4[jj]; ssq += kkr[e] * kkr[e]; km[e] = ks[e] * (1.f + (av[e] - 1.f) * ka4[jj]); bsp += rs[e] * km[e] * rk4[jj]; }
            asm volatile("" ::: "memory");
        }
        ssq += __shfl_xor(ssq, 16); ssq += __shfl_xor(ssq, 32); bsp += __shfl_xor(bsp, 16); bsp += __shfl_xor(bsp, 32);
        if (q == 0) { SSQ[h2 * 64 + u1] = ssq; BSP[h2 * 64 + u1] = bsp; }
        __syncthreads();
        {
            const float tot = SSQ[u1] + SSQ[64 + u1]; const float inv = 1.f / fmaxf(sqrtf(tot), 1e-12f);
            if (h2 == 0 && q == 0) BS[u1] = BSP[u1] + BSP[64 + u1];
#pragma unroll
            for (int t = 0; t < 2; ++t) { const int cb = 32 * h2 + 16 * t + 4 * q; float al[4], be[4], ka[4], rh[4];
#pragma unroll
                for (int jj = 0; jj < 4; ++jj) { const int e = 4 * t + jj;
                    float g = -elog[e];
#pragma unroll
                    for (int o = 1; o < 16; o <<= 1) { const float tmp = __shfl_up(g, o, 16); if (r >= o) g += tmp; }
                    const float ep = fexp(g), em = frcp(ep), epp = fexp(g + elog[e]);
                    const float kk = kkr[e] * inv;
                    al[jj] = kk * epp; be[jj] = kk * av[e] * em; ka[jj] = km[e] * em; rh[jj] = rs[e] * ep;
                    if (r == 15) GAM[m1 * 64 + cb + jj] = ep; }
                *(LAS u32x2*)(At + u1 * PT + cb) = pack4(al[0], al[1], al[2], al[3]); *(LAS u32x2*)(Bt + u1 * PT + cb) = pack4(be[0], be[1], be[2], be[3]);
                *(LAS u32x2*)(Kt + u1 * PT + cb) = pack4(ka[0], ka[1], ka[2], ka[3]); *(LAS u32x2*)(Rt + u1 * PT + cb) = pack4(rh[0], rh[1], rh[2], rh[3]);
                *(LAS u32x2*)(Vt + u1 * PT + cb) = pack4(vs[4 * t], vs[4 * t + 1], vs[4 * t + 2], vs[4 * t + 3]);
                asm volatile("" ::: "memory"); }
        }
        __syncthreads();
        {
            const int m = wv >> 1, pp = wv & 1; LAS bf16_t* XB = pp ? Rt : At;
            f32x4 c1 = (f32x4){0.f, 0.f, 0.f, 0.f}, c2 = (f32x4){0.f, 0.f, 0.f, 0.f};
#pragma unroll
            for (int kk = 0; kk < 2; ++kk) { const bf16x8 bx = *(const LAS bf16x8*)(XB + (16 * m + r) * PT + 32 * kk + 8 * q);
                const bf16x8 a1 = *(const LAS bf16x8*)(Bt + (16 * m + r) * PT + 32 * kk + 8 * q), a2 = *(const LAS bf16x8*)(Kt + (16 * m + r) * PT + 32 * kk + 8 * q);
                c1 = __builtin_amdgcn_mfma_f32_16x16x32_bf16(a1, bx, c1, 0, 0, 0); c2 = __builtin_amdgcn_mfma_f32_16x16x32_bf16(a2, bx, c2, 0, 0, 0); }
#pragma unroll
            for (int jj = 0; jj < 4; ++jj) { const int s = 4 * q + jj; const bool ok = pp ? (s <= r) : (s < r); if (!ok) { c1[jj] = 0.f; c2[jj] = 0.f; } }
            if (pp == 0) { *(LAS f32x4*)(MBf + (m * 16 + r) * 20 + 4 * q) = c1; *(LAS u32x2*)(MK + (m * 16 + r) * PM + 4 * q) = pack4(c2[0], c2[1], c2[2], c2[3]); }
            else { *(LAS u32x2*)(NB + (m * 16 + r) * PM + 4 * q) = pack4(c1[0], c1[1], c1[2], c1[3]); *(LAS u32x2*)(NK + (m * 16 + r) * PM + 4 * q) = pack4(c2[0], c2[1], c2[2], c2[3]); }
        }
        __syncthreads();
        if (wv < 4) {
            const int m = wv, c = r; float X[16];
#pragma unroll
            for (int u = 0; u < 16; ++u) { float x = (c == u) ? 1.f : 0.f;
                if (u > 0) { const LAS f32x4* rowp = (const LAS f32x4*)(MBf + (m * 16 + u) * 20);
#pragma unroll
                    for (int s4 = 0; s4 < 4; ++s4) { if (4 * s4 < u) { const f32x4 l = rowp[s4];
#pragma unroll
                        for (int e = 0; e < 4; ++e) if (4 * s4 + e < u) x -= l[e] * X[4 * s4 + e]; } } }
                X[u] = x; }
            if (q == 0) {
#pragma unroll
                for (int u = 0; u < 16; ++u) DNV[(m * 16 + u) * PM + c] = f2bf(X[u]); }
        } else {
            const int m = wv - 4; const bf16x8 a = *(const LAS bf16x8*)(MK + (m * 16 + r) * PM + 8 * q);
#pragma unroll
            for (int it = 0; it < 4; ++it) { const bf16x8 bv = tr_frag(vt_b, PT, 16 * m, 16 * it, r, q);
                const f32x4 acc = __builtin_amdgcn_mfma_f32_16x16x32_bf16(a, bv, (f32x4){0.f, 0.f, 0.f, 0.f}, 0, 0, 0);
                *(LAS u32x2*)(W1T + (m * 64 + 16 * it + r) * PM + 4 * q) = pack4(acc[0], acc[1], acc[2], acc[3]); }
        }
        __syncthreads();
        f32x4 yhat[4] = {(f32x4){0.f, 0.f, 0.f, 0.f}, (f32x4){0.f, 0.f, 0.f, 0.f}, (f32x4){0.f, 0.f, 0.f, 0.f}, (f32x4){0.f, 0.f, 0.f, 0.f}};
        if (wv < 4) {
            const int it = wv;
#pragma unroll
            for (int m = 0; m < 4; ++m) { const bf16x8 a = *(const LAS bf16x8*)(DNV + (m * 16 + r) * PM + 8 * q), bw = *(const LAS bf16x8*)(W1T + (m * 64 + 16 * it + r) * PM + 8 * q);
                yhat[m] = __builtin_amdgcn_mfma_f32_16x16x32_bf16(a, bw, yhat[m], 0, 0, 0); }
        } else {
            const int jt = wv - 4;
#pragma unroll
            for (int m = 0; m < 4; ++m) { const bf16x8 a = tr_frag(at_b, PT, 16 * m, 16 * jt, r, q), bd = *(const LAS bf16x8*)(DNV + (m * 16 + r) * PM + 8 * q);
                const f32x4 acc = __builtin_amdgcn_mfma_f32_16x16x32_bf16(a, bd, (f32x4){0.f, 0.f, 0.f, 0.f}, 0, 0, 0);
                *(LAS u32x2*)(AH + (m * 16 + r) * PT + 16 * jt + 4 * q) = pack4(acc[0], acc[1], acc[2], acc[3]); }
        }
        __syncthreads();
#pragma unroll 1
        for (int m = 0; m < 4; ++m) {
            LAS bf16_t* Sc = Sbf + cur * 64 * PT; LAS bf16_t* Sn = Sbf + (cur ^ 1) * 64 * PT;
            const int it = wv & 3;
            f32x4 oacc = (f32x4){0.f, 0.f, 0.f, 0.f};
            if (wv < 4) {
                f32x4 acc = (m == 0) ? yhat[0] : (m == 1) ? yhat[1] : (m == 2) ? yhat[2] : yhat[3];
#pragma unroll
                for (int kk = 0; kk < 2; ++kk) { const bf16x8 a = *(const LAS bf16x8*)(AH + (m * 16 + r) * PT + 32 * kk + 8 * q), bs = *(const LAS bf16x8*)(Sc + (16 * it + r) * PT + 32 * kk + 8 * q);
                    acc = __builtin_amdgcn_mfma_f32_16x16x32_bf16(a, bs, acc, 0, 0, 0); }
                *(LAS u32x2*)(YV + (16 * it + r) * PM + 4 * q) = pack4(-acc[0], -acc[1], -acc[2], -acc[3]);
            } else {
#pragma unroll
                for (int kk = 0; kk < 2; ++kk) { const bf16x8 a = *(const LAS bf16x8*)(Rt + (16 * m + r) * PT + 32 * kk + 8 * q), bs = *(const LAS bf16x8*)(Sc + (16 * it + r) * PT + 32 * kk + 8 * q);
                    oacc = __builtin_amdgcn_mfma_f32_16x16x32_bf16(a, bs, oacc, 0, 0, 0); }
                const bf16x8 a = *(const LAS bf16x8*)(NK + (m * 16 + r) * PM + 8 * q), bv = tr_frag(vt_b, PT, 16 * m, 16 * it, r, q);
                oacc = __builtin_amdgcn_mfma_f32_16x16x32_bf16(a, bv, oacc, 0, 0, 0);
            }
            __syncthreads();
            {
                const int jh = wv >> 2; const bf16x8 bv = tr_frag(vt_b, PT, 16 * m, 16 * it, r, q), by = *(const LAS bf16x8*)(YV + (16 * it + r) * PM + 8 * q);
#pragma unroll
                for (int x = 0; x < 2; ++x) { const int jt = 2 * jh + x;
                    const bf16x8 a1 = zero_if(tr_frag(kt_b, PT, 16 * m, 16 * jt, r, q), q >= 2), a2 = tr_frag(bt_b, PT, 16 * m, 16 * jt, r, q);
                    Sacc[x] = __builtin_amdgcn_mfma_f32_16x16x32_bf16(a1, bv, Sacc[x], 0, 0, 0); Sacc[x] = __builtin_amdgcn_mfma_f32_16x16x32_bf16(a2, by, Sacc[x], 0, 0, 0);
                    const f32x4 gm = *(const LAS f32x4*)(GAM + m * 64 + 16 * jt + 4 * q); Sacc[x] = Sacc[x] * gm;
                    *(LAS u32x2*)(Sn + (16 * it + r) * PT + 16 * jt + 4 * q) = pack4(Sacc[x][0], Sacc[x][1], Sacc[x][2], Sacc[x][3]); }
                if (wv >= 4) { const bf16x8 a = *(const LAS bf16x8*)(NB + (m * 16 + r) * PM + 8 * q);
                    oacc = __builtin_amdgcn_mfma_f32_16x16x32_bf16(a, by, oacc, 0, 0, 0);
#pragma unroll
                    for (int jj = 0; jj < 4; ++jj) OUT[(16 * m + 4 * q + jj) * 65 + 16 * it + r] = oacc[jj]; }
            }
            __syncthreads();
            cur ^= 1;
        }
#pragma unroll 2
        for (int mm = 0; mm < 8; ++mm) { const int u = wv + 8 * mm; const size_t row = (size_t)step_row(d, b, n0 + u);
            const float o = OUT[u * 65 + lane]; const float mean = wave_sum(o) * (1.f / 64.f); const float dv = o - mean; const float var = wave_sum(dv * dv) * (1.f / 64.f);
            const float z = dv * rsqrtf(var + 64e-5f) * prm[640 + lane] + prm[704 + lane] + BS[u] * bf2f(Vt[u * PT + lane]);
            Z[((size_t)d * NALL + row) * 512 + 64 * h + lane] = f2bf(z); }
        __syncthreads();
    }
}
DI void phase_mlstm_post(const P& p) {
    const int lane = mk_tid() & 63, wv = mk_tid() >> 6;
    const bf16_t* ML = (const bf16_t*)(p.ws + WS_COLS) + OFF_ML; const bf16_t* HB = (const bf16_t*)(p.ws + WS_ACT); bf16_t* Y = (bf16_t*)(p.ws + WS_COLS);
    for (int r = blockIdx.x * 8 + wv; r < NALL; r += gridDim.x * 8)
        post_headnorm_row(HB, (size_t)r, p.in[I_MNG], ML + (size_t)r * 2048 + 1536, 0, Y + (size_t)r * D + 512, lane);
}
DI void phase_hgrn_post(const P& p) {
    const int lane = mk_tid() & 63, wv = mk_tid() >> 6;
    const bf16_t* C1 = (const bf16_t*)(p.ws + WS_COLS); const bf16_t* HB = (const bf16_t*)(p.ws + WS_ACT); bf16_t* Y = (bf16_t*)(p.ws + WS_Z);
    for (int r = blockIdx.x * 8 + wv; r < NLAT; r += gridDim.x * 8)
        post_headnorm_row(HB, (size_t)r, p.in[I_HNG], C1 + (size_t)r * C1LD + 2048, 1, Y + (size_t)nat_row(r) * D, lane);
}

constexpr int N_PHASES = 19;
__global__ void __launch_bounds__(NT, 2) mk_fwd(P p) {
    extern __shared__ __attribute__((aligned(16))) unsigned char lds_raw[];
    LAS unsigned char* lds = (LAS unsigned char*)lds_raw;
    cooperative_groups::grid_group grid = cooperative_groups::this_grid();
    const int lo = p.ph_lo, hi = p.ph_hi;
#define IN(k) (lo <= (k) && (k) < hi)
#define SEAM(k) do { if (IN(k) && IN((k) + 1)) grid.sync(); } while (0)
#ifndef MK_DUP
#define MK_DUP -1
#endif
#define PHASE(k, ...) if (IN(k)) { __VA_ARGS__ if (MK_DUP == (k)) { grid.sync(); __VA_ARGS__ } } SEAM(k);
    unsigned char* ws = p.ws;
    const float* MODV = (const float*)(ws + WS_MODV);
    float* HC = (float*)(ws + WS_HC);
    bf16_t* ACT = (bf16_t*)(ws + WS_ACT); bf16_t* COLS = (bf16_t*)(ws + WS_COLS); bf16_t* Y1 = (bf16_t*)(ws + WS_Z);
    PHASE(0, phase_wprep(p, lds); phase_modv(p, lds);)
    PHASE(1, phase_modnorm(p, 0, 0, p.in[I_X], p.in[I_CTX], NALL, false);)
    PHASE(2, EpiStore3 E{COLS + OFF_RW, 1536, 6, COLS + OFF_LO, 512, 8, COLS + OFF_ML, 2048}; run_gemm(lds, ACT, (const bf16_t*)(ws + WS_W_EVIN), NALL, 4096, 1024, E);)
    PHASE(3, for (int vb = blockIdx.x; vb < 192; vb += gridDim.x) { if (vb < 64) rwkv_chunk_unit(p, lds, vb); else gla_unit<0>(p, lds, vb - 64); })
    if (IN(3) && MK_DUP == 103) { grid.sync(); for (int vb = blockIdx.x; vb < 64; vb += gridDim.x) rwkv_chunk_unit(p, lds, vb); grid.sync(); }
    if (IN(3) && MK_DUP == 203) { grid.sync(); for (int vb = blockIdx.x; vb < 128; vb += gridDim.x) gla_unit<0>(p, lds, vb); grid.sync(); }
    PHASE(4, phase_mlstm_post(p); phase_rwkv_post(p, lds);)
    PHASE(5, EpiResid E{p.in[I_X], p.out, p.in[I_CTX], HC, MODV, 2}; run_gemm(lds, COLS, (const bf16_t*)(ws + WS_W_EVOUT), NALL, 1024, 1024, E);)
    PHASE(6, phase_modnorm(p, 0, 1, p.out, HC, NALL, false);)
    PHASE(7, EpiSwiglu E{COLS}; run_gemm(lds, ACT, (const bf16_t*)(ws + WS_W_UP), NALL, 5632, 1024, E);)
    PHASE(8, EpiResid E{p.out, p.out, HC, HC, MODV, 5}; run_gemm(lds, COLS, (const bf16_t*)(ws + WS_W_DN), NALL, 1024, 2816, E);)
    PHASE(9, phase_modnorm(p, 1, 0, p.out, HC, NALL, true);)
    PHASE(10, EpiStore3 E{COLS, C1LD, 1 << 30, COLS, C1LD, 1 << 30, COLS, C1LD}; run_gemm(lds, ACT, (const bf16_t*)(ws + WS_W_ODIN), NALL, 3584, 1024, E);)
    PHASE(11, phase_hgrn_prep(p, lds); lru_pass<1>(p, lds, (int)blockIdx.x, (int)gridDim.x);)
    PHASE(12, { const int half = (int)gridDim.x >> 1; if ((int)blockIdx.x < half) { for (int u = blockIdx.x; u < 128; u += half) gla_unit<1>(p, lds, u); } else lru_pass<3>(p, lds, (int)blockIdx.x - half, (int)gridDim.x - half); })
    if (IN(12) && MK_DUP == 112) { grid.sync(); lru_pass<3>(p, lds, (int)blockIdx.x, (int)gridDim.x); grid.sync(); }
    if (IN(12) && MK_DUP == 212) { grid.sync(); for (int vb = blockIdx.x; vb < 128; vb += gridDim.x) gla_unit<1>(p, lds, vb); grid.sync(); }
    PHASE(13, phase_hgrn_post(p);)
    PHASE(14, EpiResid E{p.out, p.out, HC, HC, MODV + 5 * 6144, 2}; run_gemm(lds, Y1, (const bf16_t*)(ws + WS_W_ODOUT), NLAT, 1024, 1024, E);)
    PHASE(15, phase_modnorm(p, 1, 1, p.out, HC, NLAT, false);)
    PHASE(16, EpiSwiglu E{COLS}; run_gemm(lds, ACT, (const bf16_t*)(ws + WS_W_UP) + W_UP_STRIDE, NLAT, 5632, 1024, E);)
    PHASE(17, EpiResid E{p.out, p.out, HC, HC, MODV + 5 * 6144, 5}; run_gemm(lds, COLS, (const bf16_t*)(ws + WS_W_DN) + W_DN_STRIDE, NLAT, 1024, 2816, E);)
    PHASE(18, phase_finalnorm(p);)
#undef IN
#undef SEAM
}
}

#ifndef MK_ONE_LAUNCH
#define MK_ONE_LAUNCH 1
#endif
extern "C" void kernel_launch(void* const* d_in, const int* in_sizes, int n_in, void* d_out, int out_size, void* d_ws, size_t ws_size, hipStream_t stream) {
    using namespace mk;
    static int grid = 0;
    if (grid == 0) {
        int dev = 0, cus = 0, per_cu = 0;
        if (n_in != N_IN || ws_size < WS_END) { fprintf(stderr, "kernel_launch: unexpected n_in %d / ws_size %zu\n", n_in, ws_size); grid = -1; return; }
        (void)hipGetDevice(&dev); (void)hipDeviceGetAttribute(&cus, hipDeviceAttributeMultiprocessorCount, dev);
        (void)hipFuncSetAttribute((const void*)mk_fwd, hipFuncAttributeMaxDynamicSharedMemorySize, LDS_BYTES);
        (void)hipOccupancyMaxActiveBlocksPerMultiprocessor(&per_cu, (const void*)mk_fwd, NT, LDS_BYTES);
        if (per_cu < 1) { fprintf(stderr, "kernel_launch: occupancy query says %d blocks per CU\n", per_cu); per_cu = 1; }
        (void)hipGetLastError();
        grid = cus;
    }
    if (grid < 0) return;
    P p{};
    for (int i = 0; i < N_IN; ++i) p.in[i] = (const float*)d_in[i];
    p.out = (float*)d_out; p.ws = (unsigned char*)d_ws;
#if MK_ONE_LAUNCH
    p.ph_lo = 0; p.ph_hi = N_PHASES;
    void* args[] = {&p};
    hipError_t e = hipLaunchCooperativeKernel((const void*)mk_fwd, dim3(grid), dim3(NT), args, LDS_BYTES, stream);
    if (e != hipSuccess) fprintf(stderr, "cooperative launch failed: %s (grid %d)\n", hipGetErrorString(e), grid);
#else
    for (int k = 0; k < N_PHASES; ++k) { p.ph_lo = k; p.ph_hi = k + 1; hipLaunchKernelGGL(mk_fwd, dim3(grid), dim3(NT), LDS_BYTES, stream, p); }
#endif
}
```

```cpp
#include <hip/hip_runtime.h>
#include <hip/hip_cooperative_groups.h>
#include <cstdio>
#include <cstdint>
__device__ __forceinline__ int mk_tid() { int t = threadIdx.x; asm volatile("" : "+v"(t)); return t; }
#define MK_DUP -1
#define MK_RDUP -1
namespace pg8 {
#define PG8_LAS __attribute__((address_space(3)))
typedef unsigned short bf16_t;
typedef short bf16x8 __attribute__((ext_vector_type(8)));
typedef float f32x4 __attribute__((ext_vector_type(4)));
typedef unsigned u32x4 __attribute__((ext_vector_type(4)));
constexpr int BM = 256, BK = 64, HALF = 128, HTB = HALF * BK * 2  , STAGE_BYTES = 8 * HTB, NXCD = 8, WGM = 8;

__host__ __device__ __forceinline__ int lds_byte(int r, int c) { const int st = (r >> 4) * 2 + (c >> 5), rr = r & 15, cc = c & 31, ob = rr * 64 + cc * 2; return st * 1024 + (ob ^ (((ob >> 9) & 1) << 5)); }
__host__ __device__ __forceinline__ void stage_rc(int b, int& R, int& C) { const int st = b / 1024, sb = b % 1024, swz = sb ^ (((sb >> 9) & 1) << 5); R = (st >> 1) * 16 + swz / 64; C = (st & 1) * 32 + (swz % 64) / 2; }
__host__ __device__ __forceinline__ int perm32(int rho) { const int n = rho >> 4, i = rho & 15; return 8 * (i >> 2) + 4 * n + (i & 3); }

struct Unit { int pm, pn; };
struct Gemm { const bf16_t* A; const bf16_t* Bt; int M, N, K; };

struct StaticOrder {
    int nM, nN, nwg, G, c;
    __host__ __device__ void init(int M, int N, int G_, int c_) { nM = M / BM; nN = N / BM; nwg = nM * nN; G = G_; c = c_; }
    __host__ __device__ bool next(int i, Unit& u) const {
        const long L = (long)i * G + c; if (L >= nwg) return false;
        int wgid = (int)L; { const int q = nwg / NXCD, r = nwg % NXCD, xcd = wgid % NXCD, off = wgid / NXCD; wgid = (xcd < r ? xcd * (q + 1) : r * (q + 1) + (xcd - r) * q) + off; }
        const int nig = WGM * nN, gid = wgid / nig, fm = gid * WGM, gsz = (nM - fm) < WGM ? (nM - fm) : WGM;
        u.pm = fm + ((wgid % nig) % gsz); u.pn = (wgid % nig) / gsz; return true;
    }
    __device__ __forceinline__ void a_ready(const Unit&) const {}
    __device__ __forceinline__ void done(const Unit&) const {}
};
__device__ __forceinline__ unsigned cvt_pk_bf16(float lo, float hi) { unsigned r; asm volatile("v_cvt_pk_bf16_f32 %0, %1, %2" : "=v"(r) : "v"(lo), "v"(hi)); return r; }
typedef float f32x2 __attribute__((ext_vector_type(2)));
template <class Epi, class Sched, bool STAMP = false>
__device__ __forceinline__ void gemm_phase(PG8_LAS unsigned char* lds, const Gemm g, const Sched& S, const Epi& E, unsigned long long* stamps) {
    const int tid = mk_tid(), wid = __builtin_amdgcn_readfirstlane(tid >> 6), lane = tid & 63, wr = wid >> 2, wc = wid & 3, fr = lane & 15, fq = lane >> 4;
    const int K = g.K, nt = K / BK;
    int ts_lo = 0, ts_hi = 0, nts = 0; const unsigned long long rt_entry = STAMP ? (unsigned long long)wall_clock64() : 0ull;
#define PG8_STAMP() do { if (STAMP && wid == 0 && nts < 64) { const unsigned long long _c = (unsigned long long)clock64(); \
        ts_lo = (lane == nts) ? (int)(unsigned)_c : ts_lo; ts_hi = (lane == nts) ? (int)(unsigned)(_c >> 32) : ts_hi; ++nts; } } while (0)
    PG8_STAMP();
    unsigned voffA[2], voffB[2];
#pragma unroll
    for (int i = 0; i < 2; ++i) { int R, C; stage_rc(tid * 16 + i * 8192, R, C); const int Rb = Epi::PERM ? ((R & ~31) + perm32(R & 31)) : R;
        voffA[i] = (unsigned)(R * K + C) * 2u; voffB[i] = (unsigned)(Rb * K + C) * 2u; }
    const size_t kstep = (size_t)(BK * 2);
    const size_t hstep = (size_t)HALF * K * 2;
    const size_t tstep = 2 * hstep;
    const unsigned ldsw = (unsigned)wid * 1024u;
    const int aoff = lds_byte(wr * 64 + fr, fq * 8), boff = lds_byte(wc * 32 + fr, fq * 8);
#define PG8_SA(b, h) (((b) * 2 + (h)) * HTB)
#define PG8_SB(b, h) ((4 + (b) * 2 + (h)) * HTB)
#define PG8_STAGE(bufoff, gbase, voff) do { _Pragma("unroll") for (int _i = 0; _i < 2; ++_i) \
        __builtin_amdgcn_global_load_lds((const unsigned*)((const char*)(gbase) + (voff)[_i]), (PG8_LAS unsigned*)(lds + (bufoff) + ldsw + _i * 8192), 16, 0, 0); } while (0)
#define PG8_LDA(dst, b, h) do { _Pragma("unroll") for (int m = 0; m < 4; ++m) _Pragma("unroll") for (int k = 0; k < 2; ++k) dst[m][k] = *(const PG8_LAS bf16x8*)(lds + PG8_SA(b, h) + aoff + m * 2048 + k * 1024); } while (0)
#define PG8_LDB(dst, b, h) do { _Pragma("unroll") for (int n = 0; n < 2; ++n) _Pragma("unroll") for (int k = 0; k < 2; ++k) dst[n][k] = *(const PG8_LAS bf16x8*)(lds + PG8_SB(b, h) + boff + n * 2048 + k * 1024); } while (0)
#define PG8_MMA(ai, bj, At, Bt) do { __builtin_amdgcn_s_setprio(1); _Pragma("unroll") for (int m = 0; m < 4; ++m) _Pragma("unroll") for (int n = 0; n < 2; ++n) _Pragma("unroll") for (int k = 0; k < 2; ++k) \
        acc[ai][bj][m][n] = __builtin_amdgcn_mfma_f32_16x16x32_bf16(Bt[n][k], At[m][k], acc[ai][bj][m][n], 0, 0, 0); __builtin_amdgcn_s_setprio(0); } while (0)
#define PG8_WAIT_V(n) asm volatile("s_waitcnt vmcnt(" #n ")" ::: "memory")
#define PG8_WAIT_L(n) asm volatile("s_waitcnt lgkmcnt(" #n ")" ::: "memory")
#define PG8_BAR __builtin_amdgcn_s_barrier()
#define PG8_SCHED __builtin_amdgcn_sched_barrier(0)
    Unit cur, nxt; int ui = 0;
    if (!S.next(0, cur)) return;
    f32x4 acc[2][2][4][2];
#pragma unroll
    for (int a = 0; a < 2; ++a)
#pragma unroll
        for (int b = 0; b < 2; ++b)
#pragma unroll
            for (int m = 0; m < 4; ++m)
#pragma unroll
                for (int n = 0; n < 2; ++n) acc[a][b][m][n] = (f32x4){0.f, 0.f, 0.f, 0.f};
    bf16x8 At[4][2], B0[2][2], B1[2][2];
    const char* cA = (const char*)g.A + (size_t)cur.pm * tstep; const char* cB = (const char*)g.Bt + (size_t)cur.pn * tstep;
    S.a_ready(cur);
    PG8_STAGE(PG8_SB(0, 0), cB, voffB); PG8_STAGE(PG8_SA(0, 0), cA, voffA); PG8_STAGE(PG8_SB(0, 1), cB + hstep, voffB); PG8_STAGE(PG8_SA(0, 1), cA + hstep, voffA);
    if (wr == 1) PG8_BAR;
    PG8_WAIT_V(4); PG8_BAR;
    PG8_STAGE(PG8_SB(1, 0), cB + kstep, voffB); PG8_STAGE(PG8_SA(1, 0), cA + kstep, voffA); PG8_STAGE(PG8_SB(1, 1), cB + hstep + kstep, voffB);
    PG8_WAIT_V(6); PG8_BAR;
    PG8_STAMP();
    for (;;) {
        const bool has_next = S.next(ui + 1, nxt);
        const char* nA = has_next ? (const char*)g.A + (size_t)nxt.pm * tstep : cA; const char* nB = has_next ? (const char*)g.Bt + (size_t)nxt.pn * tstep : cB;
        for (int t = 0; t < nt; t += 2) {
            const bool last = (t == nt - 2);
            const char* a1 = cA + (size_t)(t + 1) * kstep;
            const char* a2 = last ? nA : cA + (size_t)(t + 2) * kstep; const char* b2 = last ? nB : cB + (size_t)(t + 2) * kstep;
            const char* a3 = a2 + kstep; const char* b3 = b2 + kstep;
            if (last && has_next) S.a_ready(nxt);
            PG8_LDB(B0, 0, 0); PG8_SCHED; PG8_LDA(At, 0, 0); PG8_STAGE(PG8_SA(1, 1), a1 + hstep, voffA);
            PG8_WAIT_L(8); PG8_BAR; PG8_WAIT_L(0); PG8_MMA(0, 0, At, B0); PG8_BAR; PG8_SCHED;
            PG8_LDB(B1, 0, 1); PG8_STAGE(PG8_SB(0, 0), b2, voffB);
            PG8_BAR; PG8_WAIT_L(0); PG8_MMA(0, 1, At, B1); PG8_BAR;
            PG8_LDA(At, 0, 1); PG8_STAGE(PG8_SA(0, 0), a2, voffA);
            PG8_BAR; PG8_WAIT_L(0); PG8_MMA(1, 0, At, B0); PG8_BAR; PG8_SCHED;
            PG8_STAGE(PG8_SB(0, 1), b2 + hstep, voffB);
            PG8_WAIT_V(6); PG8_BAR; PG8_MMA(1, 1, At, B1); PG8_BAR;
            PG8_LDB(B0, 1, 0); PG8_SCHED; PG8_LDA(At, 1, 0); PG8_STAGE(PG8_SA(0, 1), a2 + hstep, voffA);
            PG8_WAIT_L(8); PG8_BAR; PG8_WAIT_L(0); PG8_MMA(0, 0, At, B0); PG8_BAR; PG8_SCHED;
            PG8_LDB(B1, 1, 1); PG8_STAGE(PG8_SB(1, 0), b3, voffB);
            PG8_BAR; PG8_WAIT_L(0); PG8_MMA(0, 1, At, B1); PG8_BAR;
            PG8_LDA(At, 1, 1); PG8_STAGE(PG8_SA(1, 0), a3, voffA);
            PG8_BAR; PG8_WAIT_L(0); PG8_MMA(1, 0, At, B0); PG8_BAR; PG8_SCHED;
            PG8_STAGE(PG8_SB(1, 1), b3 + hstep, voffB);
            PG8_WAIT_V(6); PG8_BAR; PG8_MMA(1, 1, At, B1); PG8_BAR;
        }
        PG8_STAMP();
        if constexpr (!Epi::AFTER_DRAIN) { E(acc, cur, wr, wc, fr, fq); S.done(cur); }
        PG8_STAMP();
        if (!has_next) break;
#pragma unroll
        for (int a = 0; a < 2; ++a)
#pragma unroll
            for (int b = 0; b < 2; ++b)
#pragma unroll
                for (int m = 0; m < 4; ++m)
#pragma unroll
                    for (int n = 0; n < 2; ++n) acc[a][b][m][n] = (f32x4){0.f, 0.f, 0.f, 0.f};
        cur = nxt; cA = nA; cB = nB; ++ui;
    }
    PG8_WAIT_V(0);
    if (wr == 0) PG8_BAR;
    PG8_BAR;
    if constexpr (Epi::AFTER_DRAIN) { E.fused(acc, cur, wr, wc, fr, fq, lds, wid, lane); S.done(cur); }
    PG8_STAMP();
    if (STAMP && wid == 0) { stamps[lane] = lane < nts ? (((unsigned long long)(unsigned)ts_hi << 32) | (unsigned)ts_lo) : 0ull;
        if (lane == 62) stamps[62] = rt_entry; if (lane == 63) stamps[63] = (unsigned long long)wall_clock64(); }
#undef PG8_STAMP
#undef PG8_SA
#undef PG8_SB
#undef PG8_STAGE
#undef PG8_LDA
#undef PG8_LDB
#undef PG8_MMA
#undef PG8_WAIT_V
#undef PG8_WAIT_L
#undef PG8_BAR
#undef PG8_SCHED
}
}

namespace mk {
#define DI __device__ __forceinline__
#define LAS __attribute__((address_space(3)))
typedef unsigned short bf16_t;
typedef float f32x4 __attribute__((ext_vector_type(4)));
typedef unsigned u32x2 __attribute__((ext_vector_type(2)));
typedef unsigned u32x4 __attribute__((ext_vector_type(4)));

constexpr int D = 1024, NB = 4, L = 8192, LC = 256, NLAT = NB * L, NCTX = NB * LC, NALL = NLAT + NCTX, LT = L + LC, DFF = 2816;
constexpr int NT = 512;
constexpr size_t MiB = (size_t)1 << 20;
constexpr size_t WS_CTL = 0, WS_MODV = 1 * MiB, WS_HC = 2 * MiB, WS_W_EVIN = 6 * MiB, WS_W_EVOUT = 14 * MiB, WS_W_ODIN = 16 * MiB, WS_W_ODOUT = 23 * MiB,
                 WS_W_UP = 25 * MiB, WS_W_DN = 47 * MiB, WS_ACT = 58 * MiB, WS_COLS = 124 * MiB, WS_Z = 388 * MiB, WS_Z1 = 454 * MiB, WS_LAM = 486 * MiB, WS_LSUM = 489 * MiB, WS_END = 494 * MiB;
constexpr size_t W_UP_STRIDE = (size_t)5632 * 1024, W_DN_STRIDE = (size_t)1024 * 2816;
constexpr size_t OFF_RW = 0, OFF_LO = (size_t)NALL * 1536, OFF_ML = OFF_LO + (size_t)NALL * 512;
constexpr int LDS_BYTES = 163840;
constexpr int C1LD = 3584;
DI int nat_row(int r) { const int b = r / L, pp = r % L; return b * L + (pp % 128) * 64 + pp / 128; }

enum { I_X = 0, I_C, I_CTX, I_CCTX, I_N1G, I_N2G, I_MODW, I_MODB, I_W1, I_W3, I_W2, I_FING, I_EVIN, I_EVOUT, I_MU, I_W0, I_W2L, I_A0, I_A2L, I_KK, I_KA, I_RK,
       I_LNW, I_LNB, I_G2, I_MBI, I_MBF, I_MNG, I_ODIN, I_ODOUT, I_HLB, I_HNG, I_CONVW, I_CONVB, I_WA, I_BA, I_WI, I_BI, I_LAM, N_IN };

struct P { const float* in[N_IN]; float* out; unsigned char* ws; int ph_lo, ph_hi; };

DI float bf2f(bf16_t v) { return __uint_as_float(((unsigned)v) << 16); }
typedef float f32x2_t __attribute__((ext_vector_type(2)));
typedef __bf16 bf16x2_t __attribute__((ext_vector_type(2)));
DI unsigned pack2(float lo, float hi) { const f32x2_t v = {lo, hi}; return __builtin_bit_cast(unsigned, __builtin_convertvector(v, bf16x2_t)); }
DI bf16_t f2bf(float f) { return (bf16_t)(pack2(f, f) & 0xffffu); }
DI float sigm(float x) { return 1.f / (1.f + expf(-x)); }
DI float siluf(float x) { return x * sigm(x); }
DI float geluf(float x) { return 0.5f * x * (1.f + tanhf(0.7978845608028654f * (x + 0.044715f * x * x * x))); }
DI float fexp(float x) { return __builtin_amdgcn_exp2f(x * 1.4426950408889634f); }
DI float frcp(float x) { return __builtin_amdgcn_rcpf(x); }
DI float fsigm(float x) { return frcp(1.f + fexp(-x)); }
DI float ftanh(float x) { return 1.f - 2.f * frcp(1.f + fexp(2.f * x)); }
DI float fgelu(float x) { return 0.5f * x * (1.f + ftanh(0.7978845608028654f * (x + 0.044715f * x * x * x))); }
template <int CTRL> DI float dppf(float x) { return __int_as_float(__builtin_amdgcn_update_dpp(0, __float_as_int(x), CTRL, 0xF, 0xF, false)); }
DI float sum8(float s) { s += dppf<0xB1>(s); s += dppf<0x4E>(s); s += dppf<0x141>(s); return s; }
DI float scan16(float x) { x += dppf<0x111>(x); x += dppf<0x112>(x); x += dppf<0x114>(x); x += dppf<0x118>(x); return x; }
DI float wave_sum(float v) {
#pragma unroll
    for (int o = 32; o >= 1; o >>= 1) v += __shfl_xor(v, o);
    return v;
}
DI int step_row(int d, int b, int n) {
    if (n < LC) return NLAT + b * LC + (d ? LC - 1 - n : n);
    const int m = n - LC; return b * L + (d ? L - 1 - m : m);
}

DI int matN(int m) { return m == 0 ? 4096 : m == 1 ? 1024 : m == 2 ? 3584 : m == 3 ? 1024 : m < 6 ? 5632 : 1024; }
DI int matK(int m) { return m < 6 ? 1024 : 2816; }
DI int matTile0(int m) { return m == 0 ? 0 : m == 1 ? 1024 : m == 2 ? 1280 : m == 3 ? 2176 : m == 4 ? 2432 : m == 5 ? 3840 : m == 6 ? 5248 : m == 7 ? 5952 : 6656; }
DI size_t matOff(int m) { return m == 0 ? WS_W_EVIN : m == 1 ? WS_W_EVOUT : m == 2 ? WS_W_ODIN : m == 3 ? WS_W_ODOUT : m == 4 ? WS_W_UP : m == 5 ? WS_W_UP + W_UP_STRIDE * 2 : m == 6 ? WS_W_DN : WS_W_DN + W_DN_STRIDE * 2; }
DI const float* matSrc(const P& p, int m, int n, int& ld) {
    if (m == 0) { ld = 3984; int col; if (n < 1920) col = n; else if (n < 1936) col = 3968 + (n - 1920); else if (n < 2048) return nullptr; else col = 1920 + (n - 2048); return p.in[I_EVIN] + col; }
    if (m == 1) { ld = 1024; return p.in[I_EVOUT] + n; }
    if (m == 2) { ld = 3584; return p.in[I_ODIN] + n; }
    if (m == 3) { ld = 1024; return p.in[I_ODOUT] + n; }
    if (m < 6) { ld = 2816; const int l = m - 4, pn = n >> 8, w = n & 255; const size_t lo = (size_t)l * 1024 * 2816; return (w < 128) ? p.in[I_W1] + lo + 128 * pn + w : p.in[I_W3] + lo + 128 * pn + (w - 128); }
    ld = 1024; return p.in[I_W2] + (size_t)(m - 6) * 2816 * 1024 + n;
}
DI void phase_wprep(const P& p, LAS unsigned char* ldsb) {
    LAS float* tile = (LAS float*)ldsb;
    const int tid = mk_tid(), tx = tid & 63, ty = tid >> 6;
    for (int item = blockIdx.x; item < 6656; item += gridDim.x) {
        int m = 0;
#pragma unroll
        for (int q = 1; q < 8; ++q) if (item >= matTile0(q)) m = q;
        const int local = item - matTile0(m), K = matK(m), nK = K >> 6, nb = local / nK, kb = local - nb * nK, n0 = nb * 64, k0 = kb * 64;
        bf16_t* Bt = (bf16_t*)(p.ws + matOff(m));
        int ld; const float* src = matSrc(p, m, n0 + tx, ld);
        __syncthreads();
#pragma unroll
        for (int i = 0; i < 8; ++i) { const int k = k0 + ty + 8 * i; tile[(ty + 8 * i) * 65 + tx] = src ? src[(size_t)k * ld] : 0.f; }
        __syncthreads();
#pragma unroll
        for (int i = 0; i < 8; ++i) { const int nn = ty + 8 * i; Bt[(size_t)(n0 + nn) * K + k0 + tx] = f2bf(tile[tx * 65 + nn]); }
    }
    __syncthreads();
}
DI void phase_modv(const P& p, LAS unsigned char* ldsb) {
    LAS float* sc = (LAS float*)ldsb;
    const int tid = mk_tid();
    float* MODV = (float*)(p.ws + WS_MODV);
    __syncthreads();
    for (int e = tid; e < 5 * 1024; e += NT) { const int s = e >> 10, k = e & 1023; const float v = (s < 4) ? p.in[I_C][s * 1024 + k] : p.in[I_CCTX][k]; sc[e] = siluf(v); }
    __syncthreads();
    for (int vb = blockIdx.x; vb < 24; vb += gridDim.x) {
        const int l = vb / 12, n = (vb % 12) * 512 + tid;
        const float* W = p.in[I_MODW] + (size_t)l * 1024 * 6144 + n;
        float a0 = 0.f, a1 = 0.f, a2 = 0.f, a3 = 0.f, a4 = 0.f;
#pragma unroll 8
        for (int k = 0; k < 1024; ++k) { const float w = W[(size_t)k * 6144]; a0 += sc[k] * w; a1 += sc[1024 + k] * w; a2 += sc[2048 + k] * w; a3 += sc[3072 + k] * w; a4 += sc[4096 + k] * w; }
        const float bb = p.in[I_MODB][l * 6144 + n];
        float* o = MODV + (size_t)l * 5 * 6144 + n;
        o[0] = a0 + bb; o[6144] = a1 + bb; o[2 * 6144] = a2 + bb; o[3 * 6144] = a3 + bb; o[4 * 6144] = a4 + bb;
    }
    __syncthreads();
}

DI void phase_modnorm(const P& p, int layer, int which, const float* hlat, const float* hctx, int nrows, bool permute) {
    const int lane = mk_tid() & 63, wv = mk_tid() >> 6;
    const float* MODV = (const float*)(p.ws + WS_MODV) + (size_t)layer * 5 * 6144;
    const float* g = p.in[which ? I_N2G : I_N1G] + layer * 1024;
    bf16_t* ACT = (bf16_t*)(p.ws + WS_ACT);
    for (int r = blockIdx.x * 8 + wv; r < nrows; r += gridDim.x * 8) {
        const bool isctx = r >= NLAT;
        const float* src = isctx ? hctx + (size_t)(r - NLAT) * D : hlat + (size_t)r * D;
        const int sv = isctx ? 4 : r / L;
        const float* shift = MODV + sv * 6144 + (which ? 3 : 0) * 1024; const float* scale = shift + 1024;
        int dr = r;
        if (permute && !isctx) { const int b = r / L, t = r % L; dr = b * L + (t % 64) * 128 + t / 64; }
        f32x4 v[4]; float ss = 0.f;
#pragma unroll
        for (int j = 0; j < 4; ++j) { v[j] = *(const f32x4*)(src + 4 * lane + 256 * j); ss += v[j].x * v[j].x + v[j].y * v[j].y + v[j].z * v[j].z + v[j].w * v[j].w; }
        const float rinv = rsqrtf(wave_sum(ss) * (1.f / D) + 1e-6f);
#pragma unroll
        for (int j = 0; j < 4; ++j) { const int c = 4 * lane + 256 * j;
            const f32x4 gg = *(const f32x4*)(g + c), sc = *(const f32x4*)(scale + c), sh = *(const f32x4*)(shift + c);
            const float o0 = v[j].x * rinv * gg.x * (1.f + sc.x) + sh.x, o1 = v[j].y * rinv * gg.y * (1.f + sc.y) + sh.y, o2 = v[j].z * rinv * gg.z * (1.f + sc.z) + sh.z, o3 = v[j].w * rinv * gg.w * (1.f + sc.w) + sh.w;
            u32x2 w; w.x = pack2(o0, o1); w.y = pack2(o2, o3);
            *(u32x2*)(ACT + (size_t)dr * D + c) = w; }
    }
}
DI void phase_finalnorm(const P& p) {
    const int lane = mk_tid() & 63, wv = mk_tid() >> 6;
    const float* g = p.in[I_FING];
    for (int r = blockIdx.x * 8 + wv; r < NLAT; r += gridDim.x * 8) {
        float* src = p.out + (size_t)r * D;
        f32x4 v[4]; float ss = 0.f;
#pragma unroll
        for (int j = 0; j < 4; ++j) { v[j] = *(const f32x4*)(src + 4 * lane + 256 * j); ss += v[j].x * v[j].x + v[j].y * v[j].y + v[j].z * v[j].z + v[j].w * v[j].w; }
        const float rinv = rsqrtf(wave_sum(ss) * (1.f / D) + 1e-6f);
#pragma unroll
        for (int j = 0; j < 4; ++j) { const int c = 4 * lane + 256 * j; const f32x4 gg = *(const f32x4*)(g + c);
            f32x4 o; o.x = v[j].x * rinv * gg.x; o.y = v[j].y * rinv * gg.y; o.z = v[j].z * rinv * gg.z; o.w = v[j].w * rinv * gg.w; *(f32x4*)(src + c) = o; }
    }
}

struct EpiStore3 {
    static constexpr bool PERM = false, AFTER_DRAIN = false;
    bf16_t* p0; int ld0; int pn1; bf16_t* p1; int ld1; int pn2; bf16_t* p2; int ld2;
    DI void operator()(const f32x4 (&acc)[2][2][4][2], const pg8::Unit& u, int wr, int wc, int fr, int fq) const {
        bf16_t* base; int ld, ct;
        if (u.pn >= pn2) { base = p2; ld = ld2; ct = u.pn - pn2; } else if (u.pn >= pn1) { base = p1; ld = ld1; ct = u.pn - pn1; } else { base = p0; ld = ld0; ct = u.pn; }
        const int row0 = u.pm * 256 + wr * 64 + fr, col0 = ct * 256 + wc * 32 + 4 * fq;
#pragma unroll
        for (int ai = 0; ai < 2; ++ai)
#pragma unroll
            for (int m = 0; m < 4; ++m) { bf16_t* rowp = base + (size_t)(row0 + ai * 128 + m * 16) * ld + col0;
#pragma unroll
                for (int bj = 0; bj < 2; ++bj)
#pragma unroll
                    for (int n = 0; n < 2; ++n) { const f32x4 v = acc[ai][bj][m][n]; u32x2 w; w.x = pack2(v[0], v[1]); w.y = pack2(v[2], v[3]); *(u32x2*)(rowp + bj * 128 + n * 16) = w; } }
    }
};
struct EpiResid {
    static constexpr bool PERM = false, AFTER_DRAIN = false;
    const float* hin; float* hout; const float* cin; float* cout; const float* modv_l; int gidx;
    DI void operator()(const f32x4 (&acc)[2][2][4][2], const pg8::Unit& u, int wr, int wc, int fr, int fq) const {
        const bool isctx = u.pm >= 128; const int sv = isctx ? 4 : (u.pm >> 5);
        const float* gate = modv_l + sv * 6144 + gidx * 1024;
        const float* bi = isctx ? cin : hin; float* bo = isctx ? cout : hout;
        const int row0 = (isctx ? (u.pm - 128) : u.pm) * 256 + wr * 64 + fr, col0 = u.pn * 256 + wc * 32 + 4 * fq;
        f32x4 gv[2][2];
#pragma unroll
        for (int bj = 0; bj < 2; ++bj)
#pragma unroll
            for (int n = 0; n < 2; ++n) gv[bj][n] = *(const f32x4*)(gate + col0 + bj * 128 + n * 16);
#pragma unroll
        for (int ai = 0; ai < 2; ++ai)
#pragma unroll
            for (int m = 0; m < 4; ++m) { const size_t off = (size_t)(row0 + ai * 128 + m * 16) * D + col0;
#pragma unroll
                for (int bj = 0; bj < 2; ++bj)
#pragma unroll
                    for (int n = 0; n < 2; ++n) { const f32x4 bs = *(const f32x4*)(bi + off + bj * 128 + n * 16); *(f32x4*)(bo + off + bj * 128 + n * 16) = bs + gv[bj][n] * acc[ai][bj][m][n]; } }
    }
};
struct EpiSwiglu {
    static constexpr bool PERM = false, AFTER_DRAIN = false;
    bf16_t* G;
    DI void operator()(const f32x4 (&acc)[2][2][4][2], const pg8::Unit& u, int wr, int wc, int fr, int fq) const {
        const int row0 = u.pm * 256 + wr * 64 + fr, col0 = u.pn * 128 + wc * 32 + 4 * fq;
#pragma unroll
        for (int ai = 0; ai < 2; ++ai)
#pragma unroll
            for (int m = 0; m < 4; ++m) { bf16_t* rowp = G + (size_t)(row0 + ai * 128 + m * 16) * DFF + col0;
#pragma unroll
                for (int n = 0; n < 2; ++n) { const f32x4 a = acc[ai][0][m][n], b = acc[ai][1][m][n];
                    const float g0 = a[0] / (1.f + __expf(-a[0])) * b[0], g1 = a[1] / (1.f + __expf(-a[1])) * b[1], g2 = a[2] / (1.f + __expf(-a[2])) * b[2], g3 = a[3] / (1.f + __expf(-a[3])) * b[3];
                    u32x2 w; w.x = pack2(g0, g1); w.y = pack2(g2, g3); *(u32x2*)(rowp + n * 16) = w; } }
    }
};
template <class Epi> DI void run_gemm(LAS unsigned char* lds, const bf16_t* A, const bf16_t* Bt, int M, int N, int K, const Epi& E) {
    pg8::Gemm g{A, Bt, M, N, K}; pg8::StaticOrder S; S.init(M, N, (int)gridDim.x, (int)blockIdx.x);
    pg8::gemm_phase<Epi, pg8::StaticOrder, false>((PG8_LAS unsigned char*)lds, g, S, E, nullptr);
    __syncthreads();
}

DI void phase_rwkv_scan_unit(const P& p, LAS unsigned char* ldsb, const int vb) {
    LAS float* lds = (LAS float*)ldsb;
    LAS float *w2s = lds, *a2s = lds + 4096, *prm = lds + 8192, *TH = prm + 768, *AD = TH + 2048, *R = AD + 2048, *W = R + 2048, *K = W + 2048, *KK = K + 2048, *BV = KK + 2048,
              *V = BV + 2048, *BS = V + 2048, *OUT = BS + 32;
    const int tid = mk_tid(), lane = tid & 63, wv = tid >> 6;
    const bf16_t* RW = (const bf16_t*)(p.ws + WS_COLS) + OFF_RW; const bf16_t* LO = (const bf16_t*)(p.ws + WS_COLS) + OFF_LO; bf16_t* Z = (bf16_t*)(p.ws + WS_Z);
    const int srow = tid >> 3, sg = tid & 7;
    {
        const int d = vb >> 5, b = (vb >> 3) & 3, h = vb & 7;
        __syncthreads();
        for (int e = tid; e < 4096; e += NT) { const int i = e >> 6, c = e & 63; w2s[e] = p.in[I_W2L][(size_t)(d * 64 + i) * 512 + 64 * h + c]; a2s[e] = p.in[I_A2L][(size_t)(d * 64 + i) * 512 + 64 * h + c]; }
        if (tid < 64) { const int j = tid, c = 64 * h + j; const float* mu = p.in[I_MU] + d * 1664;
            prm[j] = mu[c]; prm[64 + j] = mu[512 + c]; prm[128 + j] = mu[1024 + c]; prm[192 + j] = mu[1536 + j]; prm[256 + j] = mu[1600 + j];
            prm[320 + j] = p.in[I_W0][d * 512 + c]; prm[384 + j] = p.in[I_A0][d * 512 + c]; prm[448 + j] = p.in[I_KK][d * 512 + c]; prm[512 + j] = p.in[I_KA][d * 512 + c];
            prm[576 + j] = p.in[I_RK][(d * 8 + h) * 64 + j]; prm[640 + j] = p.in[I_LNW][d * 512 + c]; prm[704 + j] = p.in[I_LNB][d * 512 + c]; }
        __syncthreads();
        float S0 = 0.f, S1 = 0.f, S2 = 0.f, S3 = 0.f, S4 = 0.f, S5 = 0.f, S6 = 0.f, S7 = 0.f;
        for (int n0 = 0; n0 < LT; n0 += 32) {
            float rs[4], ks[4], vs[4];
#pragma unroll
            for (int m = 0; m < 4; ++m) { const int s = wv + 8 * m, n = n0 + s; const bool hp = (n != 0) && (n != LC);
                const size_t row = (size_t)step_row(d, b, n), prow = hp ? (size_t)step_row(d, b, n - 1) : row; const int c = 64 * h + lane;
                const float r0 = bf2f(RW[row * 1536 + c]), k0 = bf2f(RW[row * 1536 + 512 + c]), v0 = bf2f(RW[row * 1536 + 1024 + c]);
                const float r1 = hp ? bf2f(RW[prow * 1536 + c]) : 0.f, k1 = hp ? bf2f(RW[prow * 1536 + 512 + c]) : 0.f, v1 = hp ? bf2f(RW[prow * 1536 + 1024 + c]) : 0.f;
                rs[m] = r0 + prm[lane] * (r1 - r0); ks[m] = k0 + prm[64 + lane] * (k1 - k0); vs[m] = v0 + prm[128 + lane] * (v1 - v0);
                const float wd0 = bf2f(LO[row * 512 + 64 * d + lane]), wd1 = hp ? bf2f(LO[prow * 512 + 64 * d + lane]) : 0.f;
                const float ad0 = bf2f(LO[row * 512 + 128 + 64 * d + lane]), ad1 = hp ? bf2f(LO[prow * 512 + 128 + 64 * d + lane]) : 0.f;
                TH[s * 64 + lane] = tanhf(wd0 + prm[192 + lane] * (wd1 - wd0)); AD[s * 64 + lane] = ad0 + prm[256 + lane] * (ad1 - ad0); }
            __syncthreads();
#pragma unroll
            for (int m = 0; m < 4; ++m) { const int s = wv + 8 * m;
                float xw = prm[320 + lane], xa = prm[384 + lane];
#pragma unroll 8
                for (int i = 0; i < 64; ++i) { xw += TH[s * 64 + i] * w2s[i * 64 + lane]; xa += AD[s * 64 + i] * a2s[i * 64 + lane]; }
                const float elog = 0.6065306597126334f * sigm(xw), dec = expf(-elog), a = sigm(xa);
                const float kkr = ks[m] * prm[448 + lane]; const float ss = wave_sum(kkr * kkr); const float kkn = kkr / fmaxf(sqrtf(ss), 1e-12f);
                const float km = ks[m] * (1.f + (a - 1.f) * prm[512 + lane]);
                const float bs = wave_sum(rs[m] * km * prm[576 + lane]);
                R[s * 64 + lane] = rs[m]; W[s * 64 + lane] = dec; K[s * 64 + lane] = km; KK[s * 64 + lane] = kkn; BV[s * 64 + lane] = kkn * a; V[s * 64 + lane] = vs[m];
                if (lane == 0) BS[s] = bs; }
            __syncthreads();
            for (int s = 0; s < 32; ++s) {
                const LAS f32x4* pq = (const LAS f32x4*)(KK + s * 64 + 8 * sg); const f32x4 q0 = pq[0], q1 = pq[1];
                const LAS f32x4* pw = (const LAS f32x4*)(W + s * 64 + 8 * sg); const f32x4 w0 = pw[0], w1 = pw[1];
                const LAS f32x4* pb = (const LAS f32x4*)(BV + s * 64 + 8 * sg); const f32x4 b0 = pb[0], b1 = pb[1];
                const LAS f32x4* pk = (const LAS f32x4*)(K + s * 64 + 8 * sg); const f32x4 k0 = pk[0], k1 = pk[1];
                const LAS f32x4* pr = (const LAS f32x4*)(R + s * 64 + 8 * sg); const f32x4 r0 = pr[0], r1 = pr[1];
                const float vi = V[s * 64 + srow];
                float sa = S0 * q0.x + S1 * q0.y + S2 * q0.z + S3 * q0.w + S4 * q1.x + S5 * q1.y + S6 * q1.z + S7 * q1.w;
                sa += __shfl_xor(sa, 1); sa += __shfl_xor(sa, 2); sa += __shfl_xor(sa, 4);
                S0 = S0 * w0.x - sa * b0.x + vi * k0.x; S1 = S1 * w0.y - sa * b0.y + vi * k0.y; S2 = S2 * w0.z - sa * b0.z + vi * k0.z; S3 = S3 * w0.w - sa * b0.w + vi * k0.w;
                S4 = S4 * w1.x - sa * b1.x + vi * k1.x; S5 = S5 * w1.y - sa * b1.y + vi * k1.y; S6 = S6 * w1.z - sa * b1.z + vi * k1.z; S7 = S7 * w1.w - sa * b1.w + vi * k1.w;
                float o = S0 * r0.x + S1 * r0.y + S2 * r0.z + S3 * r0.w + S4 * r1.x + S5 * r1.y + S6 * r1.z + S7 * r1.w;
                o += __shfl_xor(o, 1); o += __shfl_xor(o, 2); o += __shfl_xor(o, 4);
                if (sg == 0) OUT[s * 64 + srow] = o;
            }
            __syncthreads();
#pragma unroll
            for (int m = 0; m < 4; ++m) { const int s = wv + 8 * m, n = n0 + s; const size_t row = (size_t)step_row(d, b, n);
                const float o = OUT[s * 64 + lane]; const float mean = wave_sum(o) * (1.f / 64.f); const float dv = o - mean; const float var = wave_sum(dv * dv) * (1.f / 64.f);
                const float z = dv * rsqrtf(var + 64e-5f) * prm[640 + lane] + prm[704 + lane] + BS[s] * V[s * 64 + lane];
                Z[((size_t)d * NALL + row) * 512 + 64 * h + lane] = f2bf(z); }
        }
    }
    __syncthreads();
}
DI void phase_rwkv_post(const P& p, LAS unsigned char* ldsb) {
    LAS float* sg = (LAS float*)ldsb;
    const int tid = mk_tid();
    const bf16_t* LO = (const bf16_t*)(p.ws + WS_COLS) + OFF_LO; const bf16_t* Z = (const bf16_t*)(p.ws + WS_Z); bf16_t* Y = (bf16_t*)(p.ws + WS_COLS);
    const float* g2 = p.in[I_G2];
    for (int vb = blockIdx.x; vb < NALL / 8; vb += gridDim.x) {
        const size_t row0 = (size_t)vb * 8;
        __syncthreads();
        for (int e = tid; e < 1024; e += NT) { const int q = e >> 7, r = e & 127; sg[e] = sigm(bf2f(LO[(row0 + q) * 512 + 256 + r])); }
        __syncthreads();
        float a0 = 0.f, a1 = 0.f, a2 = 0.f, a3 = 0.f, a4 = 0.f, a5 = 0.f, a6 = 0.f, a7 = 0.f;
#pragma unroll 4
        for (int r = 0; r < 128; ++r) { const float g = g2[r * 512 + tid];
            a0 += sg[r] * g; a1 += sg[128 + r] * g; a2 += sg[256 + r] * g; a3 += sg[384 + r] * g; a4 += sg[512 + r] * g; a5 += sg[640 + r] * g; a6 += sg[768 + r] * g; a7 += sg[896 + r] * g; }
#define MK_RP(q, aq) { const size_t rr = row0 + q; const float z = bf2f(Z[rr * 512 + tid]) + bf2f(Z[((size_t)NALL + rr) * 512 + tid]); Y[rr * D + tid] = f2bf(z * aq); }
        MK_RP(0, a0) MK_RP(1, a1) MK_RP(2, a2) MK_RP(3, a3) MK_RP(4, a4) MK_RP(5, a5) MK_RP(6, a6) MK_RP(7, a7)
#undef MK_RP
    }
    __syncthreads();
}
DI void post_headnorm_row(const bf16_t* HB, size_t row, const float* ng, const bf16_t* gsrc, int gate_kind, bf16_t* ydst, int lane) {
    const int c0 = 8 * lane;
    const u32x4 h0 = *(const u32x4*)(HB + row * 512 + c0), h1 = *(const u32x4*)(HB + ((size_t)NALL + row) * 512 + c0), gg = *(const u32x4*)(gsrc + c0);
    float h[8], g[8];
#pragma unroll
    for (int j = 0; j < 4; ++j) { h[2 * j] = __uint_as_float(h0[j] << 16) + __uint_as_float(h1[j] << 16); h[2 * j + 1] = __uint_as_float(h0[j] & 0xffff0000u) + __uint_as_float(h1[j] & 0xffff0000u);
        g[2 * j] = __uint_as_float(gg[j] << 16); g[2 * j + 1] = __uint_as_float(gg[j] & 0xffff0000u); }
    float ss = 0.f;
#pragma unroll
    for (int j = 0; j < 8; ++j) ss += h[j] * h[j];
    ss += __shfl_xor(ss, 1); ss += __shfl_xor(ss, 2); ss += __shfl_xor(ss, 4); ss += __shfl_xor(ss, 8);
    const float rinv = rsqrtf(ss * (1.f / 128.f) + 1e-6f);
    unsigned o[4];
#pragma unroll
    for (int j = 0; j < 4; ++j) { const float y0 = h[2 * j] * rinv * ng[c0 + 2 * j] * (gate_kind ? siluf(g[2 * j]) : sigm(g[2 * j])), y1 = h[2 * j + 1] * rinv * ng[c0 + 2 * j + 1] * (gate_kind ? siluf(g[2 * j + 1]) : sigm(g[2 * j + 1]));
        o[j] = pack2(y0, y1); }
    u32x4 w; w.x = o[0]; w.y = o[1]; w.z = o[2]; w.w = o[3];
    *(u32x4*)(ydst + c0) = w;
}
typedef short bf16x8 __attribute__((ext_vector_type(8)));
typedef short s16x4 __attribute__((ext_vector_type(4)));
constexpr int PQ = 136, PS = 72, PV = 56;
constexpr int E_QS = 0, E_KS = E_QS + 64 * PQ * 2, E_VS = E_KS + 64 * PQ * 2, E_PS = E_VS + 64 * PV * 2, E_ST = E_PS + 64 * PS * 2, E_F = E_ST + 48 * PQ * 2, E_END = E_F + 1024;
constexpr size_t WS_Q1 = WS_COLS + (size_t)231 * MiB;
constexpr int NRC = NALL / 64;

DI int chunk_row0(int d, int b, int ci) {
    if (ci < 4) { const int cc = d ? 3 - ci : ci; return NLAT + b * LC + 64 * cc; }
    const int lc = ci - 4, cl = d ? 127 - lc : lc; return b * L + 64 * cl;
}
DI bf16x8 tr_frag(unsigned tile_base, int pitch, int k0, int c0, int r, int q) {
    const unsigned a0 = tile_base + (unsigned)(((k0 + 8 * q + (r >> 2)) * pitch + c0 + 4 * (r & 3)) * 2), a1 = a0 + (unsigned)(4 * pitch * 2);
    s16x4 x, y;
    asm volatile("ds_read_b64_tr_b16 %0, %2\n\tds_read_b64_tr_b16 %1, %3\n\ts_waitcnt lgkmcnt(0)" : "=&v"(x), "=&v"(y) : "v"(a0), "v"(a1) : "memory");
    bf16x8 o; o[0] = x[0]; o[1] = x[1]; o[2] = x[2]; o[3] = x[3]; o[4] = y[0]; o[5] = y[1]; o[6] = y[2]; o[7] = y[3];
    return o;
}

#define GLA_PREFETCH(ci_) do { const int row0_ = chunk_row0(d, b, (ci_)); \
    _Pragma("unroll") for (int i = 0; i < 2; ++i) { const size_t row_ = (size_t)(row0_ + prow0 + 32 * i); \
        rq[i] = *(const u32x4*)(Qg + row_ * ldq + 8 * ppc); rk[i] = *(const u32x4*)(Kg + row_ * ldk + 8 * ppc); } \
    if (tid < 256) rv = *(const u32x4*)(Vg + (size_t)(row0_ + vrow) * ldv + 8 * vpc); \
    if (MODE == 0) { if (tid < 64) { const size_t row_ = (size_t)(row0_ + (d ? 63 - lane : lane)); gi = bf2f(LO[row_ * 512 + 384 + 4 * d + hd]); gf = bf2f(LO[row_ * 512 + 392 + 4 * d + hd]); } } \
    else rlam = *(const f32x4*)(LAM + ((size_t)d * NRC + (row0_ >> 6)) * 512 + 128 * hd + 16 * wv + 4 * q); } while (0)

template <int MODE> DI void gla_unit(const P& p, LAS unsigned char* lds, int unit) {
    constexpr int NDV = MODE == 0 ? 3 : 2;
    const int tid = mk_tid(), lane = tid & 63, wv = __builtin_amdgcn_readfirstlane(tid >> 6), r = lane & 15, q = lane >> 4;
    const int d = unit >> 6, b = (unit >> 4) & 3, hd = (unit >> 2) & 3, sl = unit & 3;
    const bf16_t* COLS = (const bf16_t*)(p.ws + WS_COLS);
    const bf16_t *Qg, *Kg, *Vg; int ldq, ldk, ldv;
    if (MODE == 0) { const bf16_t* ML = COLS + OFF_ML; Qg = ML + 128 * hd; Kg = ML + 512 + 128 * hd; Vg = ML + 1024 + 128 * hd + 32 * sl; ldq = ldk = ldv = 2048; }
    else { Qg = d ? (const bf16_t*)(p.ws + WS_Q1) + 128 * hd : COLS + 128 * hd; ldq = d ? 512 : 3584; Kg = COLS + 512 + 512 * d + 128 * hd; ldk = 3584; Vg = COLS + 1536 + 128 * hd + 32 * sl; ldv = 3584; }
    const bf16_t* LO = COLS + OFF_LO;
    const float* LAM = (const float*)(p.ws + WS_LAM);
    bf16_t* HB = (bf16_t*)(p.ws + WS_ACT);
    LAS bf16_t* Qs = (LAS bf16_t*)(lds + E_QS); LAS bf16_t* Ks = (LAS bf16_t*)(lds + E_KS); LAS bf16_t* Vs = (LAS bf16_t*)(lds + E_VS);
    LAS bf16_t* Ps = (LAS bf16_t*)(lds + E_PS); LAS bf16_t* STs = (LAS bf16_t*)(lds + E_ST); LAS float* Fs = (LAS float*)(lds + E_F);
    const unsigned ks_base = (unsigned)(size_t)Ks, vs_base = (unsigned)(size_t)Vs;
    float bi = 0.f, bfv = 0.f;
    if (MODE == 0) { bi = p.in[I_MBI][d * 4 + hd]; bfv = p.in[I_MBF][d * 4 + hd]; }
    __syncthreads();
    for (int e = tid; e < 48 * PQ / 2; e += NT) ((LAS unsigned*)STs)[e] = 0u;
    for (int e = tid; e < 64 * PV / 2; e += NT) ((LAS unsigned*)Vs)[e] = 0u;
    __syncthreads();
    f32x4 Sacc[NDV];
#pragma unroll
    for (int n = 0; n < NDV; ++n) Sacc[n] = (f32x4){0.f, 0.f, 0.f, 0.f};
    u32x4 rq[2], rk[2], rv = (u32x4){0u, 0u, 0u, 0u}; float gi = 0.f, gf = 0.f; f32x4 rlam = (f32x4){1.f, 1.f, 1.f, 1.f};
    const int prow0 = tid >> 4, ppc = tid & 15;
    const int vrow = tid >> 2, vpc = tid & 3;
    GLA_PREFETCH(0);
    for (int ci = 0; ci < 132; ++ci) {
        const int row0 = chunk_row0(d, b, ci);
        unsigned oz = 0u; asm volatile("" : "+v"(oz));
        const unsigned ks_b = ks_base + oz, vs_b = vs_base + oz;
        f32x4 lamv = rlam;
        if (MODE == 0) {
            if (tid < 64) {
                const float li = gi + bi, x = gf + bfv;
                float v = -log1pf(expf(-x));
#pragma unroll
                for (int o = 1; o < 64; o <<= 1) { const float t = __shfl_up(v, o); if (lane >= o) v += t; }
                const int rc = d ? 63 - lane : lane;
                Fs[rc] = expf(v) * 0.08838834764831845f; Fs[64 + rc] = expf(li - v);
                if (lane == 63) Fs[128] = expf(v);
            }
        }
#pragma unroll
        for (int i = 0; i < 2; ++i) { const int row = prow0 + 32 * i; *(LAS u32x4*)(Qs + row * PQ + 8 * ppc) = rq[i]; *(LAS u32x4*)(Ks + row * PQ + 8 * ppc) = rk[i]; }
        if (MODE == 0) __syncthreads();
        if (tid < 256) {
            if (MODE == 0) { const float w = Fs[64 + vrow]; u32x4 o;
#pragma unroll
                for (int e = 0; e < 4; ++e) o[e] = pack2(__uint_as_float(rv[e] << 16) * w, __uint_as_float(rv[e] & 0xffff0000u) * w);
                *(LAS u32x4*)(Vs + vrow * PV + 8 * vpc) = o;
                if (vpc == 0) Vs[vrow * PV + 32] = f2bf(w); }
            else *(LAS u32x4*)(Vs + vrow * PV + 8 * vpc) = rv;
        }
        __syncthreads();
        if (ci + 1 < 132) GLA_PREFETCH(ci + 1);
        if (MODE == 0) { const float l = Fs[128]; lamv = (f32x4){l, l, l, l}; }
        {
            const int tt = wv & 3, sh = wv >> 2;
            f32x4 pacc[2] = {(f32x4){0.f, 0.f, 0.f, 0.f}, (f32x4){0.f, 0.f, 0.f, 0.f}};
#pragma unroll
            for (int kk = 0; kk < 4; ++kk) { const bf16x8 bq = *(const LAS bf16x8*)(Qs + (16 * tt + r) * PQ + 32 * kk + 8 * q);
#pragma unroll
                for (int i = 0; i < 2; ++i) { const bf16x8 a = *(const LAS bf16x8*)(Ks + (16 * (2 * sh + i) + r) * PQ + 32 * kk + 8 * q); pacc[i] = __builtin_amdgcn_mfma_f32_16x16x32_bf16(a, bq, pacc[i], 0, 0, 0); } }
            const int t = 16 * tt + r;
#pragma unroll
            for (int i = 0; i < 2; ++i) { const int s0 = 16 * (2 * sh + i) + 4 * q; float v[4];
#pragma unroll
                for (int j = 0; j < 4; ++j) { const int s = s0 + j; const bool ok = d ? (s >= t) : (s <= t); v[j] = ok ? pacc[i][j] : 0.f; }
                u32x2 w; w.x = pack2(v[0], v[1]); w.y = pack2(v[2], v[3]); *(LAS u32x2*)(Ps + t * PS + s0) = w; }
        }
#pragma unroll
        for (int kk = 0; kk < 2; ++kk) { const bf16x8 a = tr_frag(ks_b, PQ, 32 * kk, 16 * wv, r, q);
#pragma unroll
            for (int n = 0; n < NDV; ++n) { const bf16x8 bv = tr_frag(vs_b, PV, 32 * kk, 16 * n, r, q); Sacc[n] = __builtin_amdgcn_mfma_f32_16x16x32_bf16(a, bv, Sacc[n], 0, 0, 0); } }
        __syncthreads();
        {
            const int tt = wv & 3, nA = wv >> 2;
            f32x4 oacc = (f32x4){0.f, 0.f, 0.f, 0.f}, dacc = (f32x4){0.f, 0.f, 0.f, 0.f};
#pragma unroll
            for (int kk = 0; kk < 2; ++kk) { const bf16x8 bp = *(const LAS bf16x8*)(Ps + (16 * tt + r) * PS + 32 * kk + 8 * q);
                const bf16x8 a = tr_frag(vs_b, PV, 32 * kk, 16 * nA, r, q); oacc = __builtin_amdgcn_mfma_f32_16x16x32_bf16(a, bp, oacc, 0, 0, 0);
                if (MODE == 0) { const bf16x8 a2 = tr_frag(vs_b, PV, 32 * kk, 32, r, q); dacc = __builtin_amdgcn_mfma_f32_16x16x32_bf16(a2, bp, dacc, 0, 0, 0); } }
#pragma unroll
            for (int kk = 0; kk < 4; ++kk) { const bf16x8 bq = *(const LAS bf16x8*)(Qs + (16 * tt + r) * PQ + 32 * kk + 8 * q);
                const bf16x8 a = *(const LAS bf16x8*)(STs + (16 * nA + r) * PQ + 32 * kk + 8 * q); oacc = __builtin_amdgcn_mfma_f32_16x16x32_bf16(a, bq, oacc, 0, 0, 0);
                if (MODE == 0) { const bf16x8 a2 = *(const LAS bf16x8*)(STs + (32 + r) * PQ + 32 * kk + 8 * q); dacc = __builtin_amdgcn_mfma_f32_16x16x32_bf16(a2, bq, dacc, 0, 0, 0); } }
            const int t = 16 * tt + r;
            float o0 = oacc[0], o1 = oacc[1], o2 = oacc[2], o3 = oacc[3];
            if (MODE == 0) { const float rs = Fs[t]; const float den = __shfl(dacc[0], r) * rs; const float inv = rs / fmaxf(fabsf(den), 1.f); o0 *= inv; o1 *= inv; o2 *= inv; o3 *= inv; }
            u32x2 w; w.x = pack2(o0, o1); w.y = pack2(o2, o3);
            *(u32x2*)(HB + ((size_t)d * NALL + row0 + t) * 512 + 128 * hd + 32 * sl + 16 * nA + 4 * q) = w;
        }
        __syncthreads();
#pragma unroll
        for (int n = 0; n < NDV; ++n) { Sacc[n] = Sacc[n] * lamv; u32x2 w; w.x = pack2(Sacc[n][0], Sacc[n][1]); w.y = pack2(Sacc[n][2], Sacc[n][3]); *(LAS u32x2*)(STs + (16 * n + r) * PQ + 16 * wv + 4 * q) = w; }
    }
    __syncthreads();
}

DI void phase_hgrn_prep(const P& p, LAS unsigned char* ldsb) {
    LAS float* tot = (LAS float*)ldsb;
    const int tid = mk_tid(), ch = tid & 127, qt = tid >> 7;
    bf16_t* C1 = (bf16_t*)(p.ws + WS_COLS); bf16_t* Q1 = (bf16_t*)(p.ws + WS_Q1); float* LAM = (float*)(p.ws + WS_LAM);
    for (int vb = blockIdx.x; vb < NRC * 4; vb += gridDim.x) {
        const int rc = vb >> 2, hd = vb & 3, c = 128 * hd + ch; const size_t rbase = (size_t)rc * 64 + 16 * qt;
        const float lb = sigm(p.in[I_HLB][512 + c] - p.in[I_HLB][c]);
        float qv[16], l0[16], l1[16], k0[16], k1[16];
#pragma unroll
        for (int i = 0; i < 16; ++i) { const bf16_t* base = C1 + (rbase + i) * 3584;
            qv[i] = siluf(bf2f(base[c])); const float s0 = sigm(bf2f(base[512 + c])), s1 = sigm(bf2f(base[1024 + c]));
            l0[i] = logf(lb + (1.f - lb) * s0); l1[i] = logf(lb + (1.f - lb) * s1); k0[i] = (1.f - lb) * (1.f - s0); k1[i] = (1.f - lb) * (1.f - s1); }
#pragma unroll
        for (int i = 1; i < 16; ++i) l0[i] += l0[i - 1];
#pragma unroll
        for (int i = 14; i >= 0; --i) l1[i] += l1[i + 1];
        __syncthreads();
        tot[qt * 128 + ch] = l0[15]; tot[512 + qt * 128 + ch] = l1[0];
        __syncthreads();
        float off0 = 0.f, off1 = 0.f, t0 = 0.f, t1 = 0.f;
#pragma unroll
        for (int j = 0; j < 4; ++j) { const float a = tot[j * 128 + ch], bb = tot[512 + j * 128 + ch]; t0 += a; t1 += bb; if (j < qt) off0 += a; if (j > qt) off1 += bb; }
#pragma unroll
        for (int i = 0; i < 16; ++i) { bf16_t* base = C1 + (rbase + i) * 3584; const float c0 = l0[i] + off0, c1 = l1[i] + off1;
            base[c] = f2bf(qv[i] * expf(c0)); base[512 + c] = f2bf(k0[i] * expf(-c0)); base[1024 + c] = f2bf(k1[i] * expf(-c1)); Q1[(rbase + i) * 512 + c] = f2bf(qv[i] * expf(c1)); }
        if (qt == 0) { LAM[((size_t)rc) * 512 + c] = expf(t0); LAM[((size_t)NRC + rc) * 512 + c] = expf(t1); }
    }
    __syncthreads();
}
constexpr int M_XB = 0, M_XCS = M_XB + 67 * 64 * 4, M_XCF = M_XCS + 64 * 72 * 2, M_W = M_XCF + 64 * 64 * 4, M_AU = M_W + 4 * 64 * 72 * 2, M_SEG = M_AU + 4 * 64 * 65 * 4, M_PRM = M_SEG + 4 * 8 * 64 * 4,
              M_CAR = M_PRM + 11 * 64 * 4, M_END = M_CAR + 2 * 64 * 4;
static_assert(M_END <= LDS_BYTES, "lru LDS map");
DI float nexpm1_small(float x) { const float ser = -x * (1.f + x * 0.5f * (1.f + x * (1.f / 3.f) * (1.f + x * 0.25f * (1.f + x * 0.2f)))); return (x > -0.25f) ? ser : 1.f - fexp(x); }
DI int lru_rc_at(int d, int b, int s) { if (s < 4) return 512 + 4 * b + (d ? 3 - s : s); const int lc = s - 4; return 128 * b + (d ? 127 - lc : lc); }
template <int PASS> DI void lru_pass(const P& p, LAS unsigned char* lds, const int lb, const int nlb) {
    const int tid = mk_tid(), lane = tid & 63, wv = __builtin_amdgcn_readfirstlane(tid >> 6), r = lane & 15, q = lane >> 4;
    const int hb = lb & 7;
    const bf16_t* C1 = (const bf16_t*)(p.ws + WS_COLS); bf16_t* Y = (bf16_t*)(p.ws + WS_Z); float* LSUM = (float*)(p.ws + WS_LSUM);
    LAS float* XB = (LAS float*)(lds + M_XB); LAS bf16_t* XCs = (LAS bf16_t*)(lds + M_XCS); LAS float* XCf = (LAS float*)(lds + M_XCF); LAS bf16_t* Wt = (LAS bf16_t*)(lds + M_W);
    LAS float* AU = (LAS float*)(lds + M_AU);
    LAS float* SEG = (LAS float*)(lds + M_SEG);
    LAS float* prm = (LAS float*)(lds + M_PRM);
    LAS float* CAR = (LAS float*)(lds + M_CAR);
    __syncthreads();
    for (int e = tid; e < 4 * 4096; e += NT) { const int g = e >> 12, i = (e >> 6) & 63, j = e & 63, d = g >> 1; const size_t o = ((size_t)(d * 8 + hb) * 64 + i) * 64 + j;
        Wt[(g * 64 + j) * 72 + i] = f2bf((g & 1) ? p.in[I_WI][o] : p.in[I_WA][o]); }
    if (tid < 64) { const int ch = 64 * hb + tid;
        prm[tid] = p.in[I_CONVW][ch]; prm[64 + tid] = p.in[I_CONVW][512 + ch]; prm[128 + tid] = p.in[I_CONVW][1024 + ch]; prm[192 + tid] = p.in[I_CONVW][1536 + ch]; prm[256 + tid] = p.in[I_CONVB][ch];
        prm[320 + tid] = p.in[I_BA][ch]; prm[384 + tid] = p.in[I_BA][512 + ch]; prm[448 + tid] = p.in[I_BI][ch]; prm[512 + tid] = p.in[I_BI][512 + ch];
        prm[576 + tid] = log1pf(expf(-p.in[I_LAM][ch])); prm[640 + tid] = log1pf(expf(-p.in[I_LAM][512 + ch])); }
    const int nrc = (PASS == 1) ? NRC : 512, rstep = nlb >> 3;
    u32x4 px[2];
#define LRU_PREFETCH(rc_) do { const int rc__ = (rc_); const int row0_ = rc__ * 64; const int seg_lo_ = (rc__ >= 512) ? NLAT + ((rc__ - 512) >> 2) * LC : (rc__ >> 7) * L, seg_hi_ = seg_lo_ + ((rc__ >= 512) ? LC : L); \
    _Pragma("unroll") for (int i = 0; i < 2; ++i) { const int e = tid + 512 * i, rr = e >> 3, pc = e & 7, grow = row0_ - 2 + rr; px[i] = (u32x4){0u, 0u, 0u, 0u}; \
        if (e < 67 * 8 && grow >= seg_lo_ && grow < seg_hi_) px[i] = *(const u32x4*)(C1 + (size_t)grow * C1LD + 2560 + 64 * hb + 8 * pc); } } while (0)
    int rc = lb >> 3;
    if (rc < nrc) LRU_PREFETCH(rc);
    for (; rc < nrc; rc += rstep) {
        const int row0 = rc * 64;
        const int sg = tid >> 6, j = lane, ch = 64 * hb + j;
        float cin = 0.f;
        if (PASS == 3 && tid < 128) { const int d = tid >> 6, b = rc >> 7, cl = rc & 127, pos = 4 + (d ? 127 - cl : cl);
            const float* S = LSUM + (size_t)d * NRC * 1024 + 2 * ch;
#pragma unroll 4
            for (int s = 0; s < pos; ++s) { const float* e2 = S + (size_t)lru_rc_at(d, b, s) * 1024; cin = e2[0] * cin + e2[1]; }
        }
        float gbv[8];
        if (PASS == 3) {
#pragma unroll
            for (int k = 0; k < 8; ++k) gbv[k] = bf2f(C1[(size_t)(row0 + 8 * sg + k) * C1LD + 3072 + ch]); }
#pragma unroll
        for (int i = 0; i < 2; ++i) { const int e = tid + 512 * i; if (e < 67 * 8) { const int rr = e >> 3, pc = e & 7; const u32x4 v = px[i];
            f32x4 lo, hi; lo[0] = __uint_as_float(v[0] << 16); lo[1] = __uint_as_float(v[0] & 0xffff0000u); lo[2] = __uint_as_float(v[1] << 16); lo[3] = __uint_as_float(v[1] & 0xffff0000u);
            hi[0] = __uint_as_float(v[2] << 16); hi[1] = __uint_as_float(v[2] & 0xffff0000u); hi[2] = __uint_as_float(v[3] << 16); hi[3] = __uint_as_float(v[3] & 0xffff0000u);
            *(LAS f32x4*)(XB + rr * 64 + 8 * pc) = lo; *(LAS f32x4*)(XB + rr * 64 + 8 * pc + 4) = hi; } }
        if (PASS == 3 && tid < 128) CAR[tid] = cin;
        __syncthreads();
        if (rc + rstep < nrc) LRU_PREFETCH(rc + rstep);
        {
            const int t = tid >> 3, i0 = 8 * (tid & 7); float xc[8];
#pragma unroll
            for (int c = 0; c < 8; ++c) { const int i = i0 + c; xc[c] = prm[256 + i] + prm[i] * XB[t * 64 + i] + prm[64 + i] * XB[(t + 1) * 64 + i] + prm[128 + i] * XB[(t + 2) * 64 + i] + prm[192 + i] * XB[(t + 3) * 64 + i]; XCf[t * 64 + i] = xc[c]; }
            u32x4 w; w.x = pack2(xc[0], xc[1]); w.y = pack2(xc[2], xc[3]); w.z = pack2(xc[4], xc[5]); w.w = pack2(xc[6], xc[7]);
            *(LAS u32x4*)(XCs + t * 72 + i0) = w;
        }
        __syncthreads();
        {
            const int jt = wv & 3, th = wv >> 2, jc = 16 * jt + r;
#pragma unroll
            for (int d = 0; d < 2; ++d) { const float ba = prm[320 + 64 * d + jc], bi = prm[448 + 64 * d + jc], spl = prm[576 + 64 * d + jc];
#pragma unroll
                for (int i2 = 0; i2 < 2; ++i2) { const int tt = 2 * th + i2;
                    f32x4 aa = (f32x4){0.f, 0.f, 0.f, 0.f}, ai = (f32x4){0.f, 0.f, 0.f, 0.f};
#pragma unroll
                    for (int kk = 0; kk < 2; ++kk) { const bf16x8 xf = *(const LAS bf16x8*)(XCs + (16 * tt + r) * 72 + 32 * kk + 8 * q);
                        const bf16x8 wa = *(const LAS bf16x8*)(Wt + ((2 * d) * 64 + 16 * jt + r) * 72 + 32 * kk + 8 * q), wi = *(const LAS bf16x8*)(Wt + ((2 * d + 1) * 64 + 16 * jt + r) * 72 + 32 * kk + 8 * q);
                        aa = __builtin_amdgcn_mfma_f32_16x16x32_bf16(xf, wa, aa, 0, 0, 0); ai = __builtin_amdgcn_mfma_f32_16x16x32_bf16(xf, wi, ai, 0, 0, 0); }
#pragma unroll
                    for (int jj = 0; jj < 4; ++jj) { const int t = 16 * tt + 4 * q + jj;
                        const float rg = fsigm(aa[jj] + ba), ig = fsigm(ai[jj] + bi), la = -8.f * rg * spl;
                        AU[((2 * d) * 64 + t) * 65 + jc] = 1.f - nexpm1_small(la); AU[((2 * d + 1) * 64 + t) * 65 + jc] = sqrtf(nexpm1_small(2.f * la)) * (ig * XCf[t * 64 + jc]); } } }
        }
        __syncthreads();
        const LAS float* A0 = AU + (8 * sg) * 65 + j; const LAS float* U0 = AU + (64 + 8 * sg) * 65 + j; const LAS float* A1 = AU + (128 + 8 * sg) * 65 + j; const LAS float* U1 = AU + (192 + 8 * sg) * 65 + j;
        {
            float p0 = 1.f, h0 = 0.f, p1 = 1.f, h1 = 0.f;
#pragma unroll
            for (int k = 0; k < 8; ++k) { const float a = A0[k * 65]; h0 = a * h0 + U0[k * 65]; p0 *= a; }
#pragma unroll
            for (int k = 7; k >= 0; --k) { const float a = A1[k * 65]; h1 = a * h1 + U1[k * 65]; p1 *= a; }
            SEG[(0 * 8 + sg) * 64 + j] = p0; SEG[(1 * 8 + sg) * 64 + j] = h0; SEG[(2 * 8 + sg) * 64 + j] = p1; SEG[(3 * 8 + sg) * 64 + j] = h1;
        }
        __syncthreads();
        if (PASS == 1) {
            if (tid < 128) { const int d = tid >> 6; float pa = 1.f, hh = 0.f;
#pragma unroll
                for (int s2 = 0; s2 < 8; ++s2) { const int sgi = d ? 7 - s2 : s2; const float ps = SEG[((2 * d) * 8 + sgi) * 64 + j], hs = SEG[((2 * d + 1) * 8 + sgi) * 64 + j]; hh = ps * hh + hs; pa *= ps; }
                float* o = LSUM + ((size_t)d * NRC + rc) * 1024 + 2 * ch; o[0] = pa; o[1] = hh; }
        } else {
            float hf = CAR[j], hbk = CAR[64 + j];
            for (int s2 = 0; s2 < sg; ++s2) hf = SEG[(0 * 8 + s2) * 64 + j] * hf + SEG[(1 * 8 + s2) * 64 + j];
            for (int s2 = 7; s2 > sg; --s2) hbk = SEG[(2 * 8 + s2) * 64 + j] * hbk + SEG[(3 * 8 + s2) * 64 + j];
            float of[8];
#pragma unroll
            for (int k = 0; k < 8; ++k) { hf = A0[k * 65] * hf + U0[k * 65]; of[k] = hf; }
#pragma unroll
            for (int k = 7; k >= 0; --k) { hbk = A1[k * 65] * hbk + U1[k * 65]; of[k] += hbk; }
#pragma unroll
            for (int k = 0; k < 8; ++k) Y[(size_t)nat_row(row0 + 8 * sg + k) * D + 512 + ch] = f2bf(of[k] * fgelu(gbv[k]));
        }
        __syncthreads();
    }
#undef LRU_PREFETCH
}
constexpr int PT = 72, PM = 40;
constexpr int C_PRM = 0, C_GAM = C_PRM + 3072, C_MISC = C_GAM + 1024, C_SBF = C_MISC + 1280, C_TILES = C_SBF + 2 * 64 * PT * 2, C_TH = C_TILES + 5 * 80 * PT * 2, C_MBF = C_TH + 2 * 64 * PT * 2,
              C_SM = C_MBF + 4 * 16 * 20 * 4, C_W1T = C_SM + 4 * 4 * 16 * PM * 2, C_AH = C_W1T + 4 * 64 * PM * 2, C_YV = C_AH + 4 * 16 * PT * 2, C_END = C_YV + 64 * PM * 2;
static_assert(C_END <= LDS_BYTES, "rwkv chunk LDS map");
DI void unpack4(u32x2 v, float* o) { o[0] = __uint_as_float(v.x << 16); o[1] = __uint_as_float(v.x & 0xffff0000u); o[2] = __uint_as_float(v.y << 16); o[3] = __uint_as_float(v.y & 0xffff0000u); }
DI u32x2 pack4(float a, float b, float c, float d) { u32x2 w; w.x = pack2(a, b); w.y = pack2(c, d); return w; }
DI bf16x8 zero_if(bf16x8 v, bool z) { const bf16x8 zz = {0, 0, 0, 0, 0, 0, 0, 0}; return z ? zz : v; }

constexpr int RING_SLOTS = 4, SLOT_U64 = 5632;
constexpr size_t WS_RING = WS_Z1;
DI void wait_ge(unsigned* word, unsigned want) {
    unsigned spins = 0;
    while ((unsigned)__builtin_amdgcn_readfirstlane((int)__hip_atomic_load(word, __ATOMIC_RELAXED, __HIP_MEMORY_SCOPE_AGENT)) < want) { __builtin_amdgcn_s_sleep(2); if (++spins > (1u << 21)) break; }
    __builtin_amdgcn_fence(__ATOMIC_ACQUIRE, "agent");
    asm volatile("s_waitcnt vmcnt(0)" ::: "memory");
}
template <int ROLE> DI void rwkv_chunk_unit(const P& p, LAS unsigned char* lds, const int vb) {
    const int tid = mk_tid(), lane = tid & 63, wv = __builtin_amdgcn_readfirstlane(tid >> 6), r = lane & 15, q = lane >> 4;
    const int d = vb >> 5, b = (vb >> 3) & 3, h = vb & 7;
    const bf16_t* RW = (const bf16_t*)(p.ws + WS_COLS) + OFF_RW; const bf16_t* LO = (const bf16_t*)(p.ws + WS_COLS) + OFF_LO; bf16_t* Z = (bf16_t*)(p.ws + WS_Z);
    unsigned long long* ring = (unsigned long long*)(p.ws + WS_RING) + (size_t)vb * RING_SLOTS * SLOT_U64;
    unsigned* READY = (unsigned*)(p.ws + WS_CTL) + 64 * vb; unsigned* ACK = (unsigned*)(p.ws + WS_CTL) + 64 * (64 + vb);
    LAS float* prm = (LAS float*)(lds + C_PRM); LAS float* GAM = (LAS float*)(lds + C_GAM); LAS float* SSQ = (LAS float*)(lds + C_MISC); LAS float* BSP = SSQ + 128; LAS float* BS = SSQ + 256;
    LAS bf16_t* Sbf = (LAS bf16_t*)(lds + C_SBF);
    LAS bf16_t* At = (LAS bf16_t*)(lds + C_TILES); LAS bf16_t* Rt = At + 80 * PT; LAS bf16_t* Bt = Rt + 80 * PT; LAS bf16_t* Kt = Bt + 80 * PT; LAS bf16_t* Vt = Kt + 80 * PT;
    LAS bf16_t* TH = (LAS bf16_t*)(lds + C_TH); LAS bf16_t* AD = TH + 64 * PT; LAS float* OUT = (LAS float*)(lds + C_TH);
    LAS float* MBf = (LAS float*)(lds + C_MBF);
    LAS bf16_t* MK = (LAS bf16_t*)(lds + C_SM); LAS bf16_t* NK = MK + 4 * 16 * PM; LAS bf16_t* NB = NK + 4 * 16 * PM; LAS bf16_t* DNV = NB + 4 * 16 * PM;
    LAS bf16_t* W1T = (LAS bf16_t*)(lds + C_W1T); LAS bf16_t* AH = (LAS bf16_t*)(lds + C_AH); LAS bf16_t* YV = (LAS bf16_t*)(lds + C_YV);
    const unsigned at_b = (unsigned)(size_t)At, bt_b = (unsigned)(size_t)Bt, kt_b = (unsigned)(size_t)Kt, vt_b = (unsigned)(size_t)Vt;
    __syncthreads();
    for (int e = tid; e < (C_END - C_SBF) / 4; e += NT) ((LAS unsigned*)(lds + C_SBF))[e] = 0u;
    if (tid < 64) { const int j = tid, c = 64 * h + j; const float* mu = p.in[I_MU] + d * 1664;
        prm[j] = mu[c]; prm[64 + j] = mu[512 + c]; prm[128 + j] = mu[1024 + c]; prm[192 + j] = mu[1536 + j]; prm[256 + j] = mu[1600 + j];
        prm[320 + j] = p.in[I_W0][d * 512 + c]; prm[384 + j] = p.in[I_A0][d * 512 + c]; prm[448 + j] = p.in[I_KK][d * 512 + c]; prm[512 + j] = p.in[I_KA][d * 512 + c];
        prm[576 + j] = p.in[I_RK][(d * 8 + h) * 64 + j]; prm[640 + j] = p.in[I_LNW][d * 512 + c]; prm[704 + j] = p.in[I_LNB][d * 512 + c]; }
    const int m1 = wv & 3, h2 = wv >> 2;
    bf16x8 fw2[2][2], fa2[2][2];
#pragma unroll
    for (int t = 0; t < 2; ++t)
#pragma unroll
        for (int kk = 0; kk < 2; ++kk) { const int c = 64 * h + 16 * (2 * h2 + t) + r;
            const float* w2p = p.in[I_W2L] + (size_t)(d * 64 + 32 * kk + 8 * q) * 512 + c; const float* a2p = p.in[I_A2L] + (size_t)(d * 64 + 32 * kk + 8 * q) * 512 + c;
#pragma unroll
            for (int e = 0; e < 8; ++e) { fw2[t][kk][e] = (short)f2bf(w2p[e * 512]); fa2[t][kk][e] = (short)f2bf(a2p[e * 512]); }
            asm volatile("" ::: "memory"); }
    f32x4 Sacc[2] = {(f32x4){0.f, 0.f, 0.f, 0.f}, (f32x4){0.f, 0.f, 0.f, 0.f}};
    int cur = 0;
    u32x2 gc[2][5], gp[2][5];
#define RWKV_LOAD(n0x) do { const int n1_ = (n0x) + 16 * m1 + r; const bool hp_ = (n1_ != 0) && (n1_ != LC); const size_t row_ = (size_t)step_row(d, b, n1_), prow_ = hp_ ? (size_t)step_row(d, b, n1_ - 1) : row_; \
    _Pragma("unroll") for (int t = 0; t < 2; ++t) { const int cb_ = 32 * h2 + 16 * t + 4 * q; \
        gc[t][0] = *(const u32x2*)(RW + row_ * 1536 + 64 * h + cb_); gc[t][1] = *(const u32x2*)(RW + row_ * 1536 + 512 + 64 * h + cb_); gc[t][2] = *(const u32x2*)(RW + row_ * 1536 + 1024 + 64 * h + cb_); \
        gc[t][3] = *(const u32x2*)(LO + row_ * 512 + 64 * d + cb_); gc[t][4] = *(const u32x2*)(LO + row_ * 512 + 128 + 64 * d + cb_); \
        gp[t][0] = *(const u32x2*)(RW + prow_ * 1536 + 64 * h + cb_); gp[t][1] = *(const u32x2*)(RW + prow_ * 1536 + 512 + 64 * h + cb_); gp[t][2] = *(const u32x2*)(RW + prow_ * 1536 + 1024 + 64 * h + cb_); \
        gp[t][3] = *(const u32x2*)(LO + prow_ * 512 + 64 * d + cb_); gp[t][4] = *(const u32x2*)(LO + prow_ * 512 + 128 + 64 * d + cb_); } } while (0)
    if (ROLE != 1) RWKV_LOAD(0);
    __syncthreads();
    for (int n0 = 0; n0 < LT; n0 += 64) {
        if (ROLE != 1) for (int rep0 = 0; rep0 < (MK_RDUP == 0 ? 2 : 1); ++rep0) {
        const int u1 = 16 * m1 + r, n1 = n0 + u1; const bool hp = (n1 != 0) && (n1 != LC);
        float rs[8], ks[8], vs[8];
#pragma unroll
        for (int t = 0; t < 2; ++t) { const int cb = 32 * h2 + 16 * t + 4 * q;
            float a0[4], a1[4];
#define RW_SHIFT(dst, idx, muo) { unpack4(gc[t][idx], a0); if (hp) unpack4(gp[t][idx], a1); else { a1[0] = a1[1] = a1[2] = a1[3] = 0.f; } \
            const f32x4 mu4 = *(const LAS f32x4*)(prm + (muo) + cb); _Pragma("unroll") for (int jj = 0; jj < 4; ++jj) dst[4 * t + jj] = a0[jj] + mu4[jj] * (a1[jj] - a0[jj]); }
            RW_SHIFT(rs, 0, 0) RW_SHIFT(ks, 1, 64) RW_SHIFT(vs, 2, 128)
#undef RW_SHIFT
            float th[4], ad[4];
            { unpack4(gc[t][3], a0); if (hp) unpack4(gp[t][3], a1); else { a1[0] = a1[1] = a1[2] = a1[3] = 0.f; }
              const f32x4 mu4 = *(const LAS f32x4*)(prm + 192 + cb);
#pragma unroll
              for (int jj = 0; jj < 4; ++jj) th[jj] = ftanh(a0[jj] + mu4[jj] * (a1[jj] - a0[jj])); }
            { unpack4(gc[t][4], a0); if (hp) unpack4(gp[t][4], a1); else { a1[0] = a1[1] = a1[2] = a1[3] = 0.f; }
              const f32x4 mu4 = *(const LAS f32x4*)(prm + 256 + cb);
#pragma unroll
              for (int jj = 0; jj < 4; ++jj) ad[jj] = a0[jj] + mu4[jj] * (a1[jj] - a0[jj]); }
            *(LAS u32x2*)(TH + u1 * PT + cb) = pack4(th[0], th[1], th[2], th[3]); *(LAS u32x2*)(AD + u1 * PT + cb) = pack4(ad[0], ad[1], ad[2], ad[3]);
            asm volatile("" ::: "memory");
        }
        __syncthreads();
        float elog[8], av[8], kkr[8], km[8]; float ssq = 0.f, bsp = 0.f;
#pragma unroll
        for (int t = 0; t < 2; ++t) { const int cb = 32 * h2 + 16 * t + 4 * q;
            f32x4 xw = (f32x4){0.f, 0.f, 0.f, 0.f}, xa = (f32x4){0.f, 0.f, 0.f, 0.f};
#pragma unroll
            for (int kk = 0; kk < 2; ++kk) { const bf16x8 bt = *(const LAS bf16x8*)(TH + u1 * PT + 32 * kk + 8 * q), ba = *(const LAS bf16x8*)(AD + u1 * PT + 32 * kk + 8 * q);
                xw = __builtin_amdgcn_mfma_f32_16x16x32_bf16(fw2[t][kk], bt, xw, 0, 0, 0); xa = __builtin_amdgcn_mfma_f32_16x16x32_bf16(fa2[t][kk], ba, xa, 0, 0, 0); }
            const f32x4 w04 = *(const LAS f32x4*)(prm + 320 + cb), a04 = *(const LAS f32x4*)(prm + 384 + cb), kk4 = *(const LAS f32x4*)(prm + 448 + cb), ka4 = *(const LAS f32x4*)(prm + 512 + cb), rk4 = *(const LAS f32x4*)(prm + 576 + cb);
#pragma unroll
            for (int jj = 0; jj < 4; ++jj) { const int e = 4 * t + jj;
                elog[e] = 0.6065306597126334f * fsigm(xw[jj] + w04[jj]); av[e] = fsigm(xa[jj] + a04[jj]);
                kkr[e] = ks[e] * kk4[jj]; ssq += kkr[e] * kkr[e]; km[e] = ks[e] * (1.f + (av[e] - 1.f) * ka4[jj]); bsp += rs[e] * km[e] * rk4[jj]; }
            asm volatile("" ::: "memory");
        }
        ssq += __shfl_xor(ssq, 16); ssq += __shfl_xor(ssq, 32); bsp += __shfl_xor(bsp, 16); bsp += __shfl_xor(bsp, 32);
        if (q == 0) { SSQ[h2 * 64 + u1] = ssq; BSP[h2 * 64 + u1] = bsp; }
        __syncthreads();
        {
            const float tot = SSQ[u1] + SSQ[64 + u1]; const float inv = 1.f / fmaxf(sqrtf(tot), 1e-12f);
            if (h2 == 0 && q == 0) BS[u1] = BSP[u1] + BSP[64 + u1];
#pragma unroll
            for (int t = 0; t < 2; ++t) { const int cb = 32 * h2 + 16 * t + 4 * q; float al[4], be[4], ka[4], rh[4];
#pragma unroll
                for (int jj = 0; jj < 4; ++jj) { const int e = 4 * t + jj;
                    const float g = scan16(-elog[e]);
                    const float ep = fexp(g), em = frcp(ep), epp = fexp(g + elog[e]);
                    const float kk = kkr[e] * inv;
                    al[jj] = kk * epp; be[jj] = kk * av[e] * em; ka[jj] = km[e] * em; rh[jj] = rs[e] * ep;
                    if (r == 15) GAM[m1 * 64 + cb + jj] = ep; }
                *(LAS u32x2*)(At + u1 * PT + cb) = pack4(al[0], al[1], al[2], al[3]); *(LAS u32x2*)(Bt + u1 * PT + cb) = pack4(be[0], be[1], be[2], be[3]);
                *(LAS u32x2*)(Kt + u1 * PT + cb) = pack4(ka[0], ka[1], ka[2], ka[3]); *(LAS u32x2*)(Rt + u1 * PT + cb) = pack4(rh[0], rh[1], rh[2], rh[3]);
                *(LAS u32x2*)(Vt + u1 * PT + cb) = pack4(vs[4 * t], vs[4 * t + 1], vs[4 * t + 2], vs[4 * t + 3]);
                asm volatile("" ::: "memory"); }
        }
        __syncthreads();
        }
        if (ROLE != 1 && n0 + 64 < LT) RWKV_LOAD(n0 + 64);
        if (ROLE == 2) {
            const unsigned g = (unsigned)(n0 >> 6);
            if (g >= RING_SLOTS) { if (wv == 0) wait_ge(ACK, g - RING_SLOTS + 1); __syncthreads(); }
            unsigned long long* slot = ring + (size_t)(g % RING_SLOTS) * SLOT_U64;
            for (int e = tid; e < 5280; e += NT) { unsigned long long v;
                if (e < 5120) v = *(const LAS unsigned long long*)(lds + C_TILES + (e >> 10) * (80 * PT * 2) + ((e >> 4) & 63) * (PT * 2) + (e & 15) * 8);
                else if (e < 5248) v = *(const LAS unsigned long long*)(lds + C_GAM + (e - 5120) * 8);
                else v = *(const LAS unsigned long long*)((LAS unsigned char*)BS + (e - 5248) * 8);
                __hip_atomic_store(slot + e, v, __ATOMIC_RELAXED, __HIP_MEMORY_SCOPE_AGENT); }
            asm volatile("s_waitcnt vmcnt(0)" ::: "memory");
            __syncthreads();
            if (tid == 0) __hip_atomic_store(READY, g + 1u, __ATOMIC_RELAXED, __HIP_MEMORY_SCOPE_AGENT);
            continue;
        }
        if (ROLE == 1) {
            const unsigned g = (unsigned)(n0 >> 6);
            if (wv == 0) wait_ge(READY, g + 1u);
            __syncthreads();
            const unsigned long long* slot = ring + (size_t)(g % RING_SLOTS) * SLOT_U64;
            for (int e = tid; e < 5280; e += NT) { const unsigned long long v = slot[e];
                if (e < 5120) *(LAS unsigned long long*)(lds + C_TILES + (e >> 10) * (80 * PT * 2) + ((e >> 4) & 63) * (PT * 2) + (e & 15) * 8) = v;
                else if (e < 5248) *(LAS unsigned long long*)(lds + C_GAM + (e - 5120) * 8) = v;
                else *(LAS unsigned long long*)((LAS unsigned char*)BS + (e - 5248) * 8) = v; }
            asm volatile("s_waitcnt vmcnt(0)" ::: "memory");
            __syncthreads();
            if (tid == 0) __hip_atomic_store(ACK, g + 1u, __ATOMIC_RELAXED, __HIP_MEMORY_SCOPE_AGENT);
        }
        f32x4 yhat[4];
        for (int rep1 = 0; rep1 < (MK_RDUP == 1 ? 2 : 1); ++rep1) {
        {
            const int m = wv >> 1, pp = wv & 1; LAS bf16_t* XB = pp ? Rt : At;
            f32x4 c1 = (f32x4){0.f, 0.f, 0.f, 0.f}, c2 = (f32x4){0.f, 0.f, 0.f, 0.f};
#pragma unroll
            for (int kk = 0; kk < 2; ++kk) { const bf16x8 bx = *(const LAS bf16x8*)(XB + (16 * m + r) * PT + 32 * kk + 8 * q);
                const bf16x8 a1 = *(const LAS bf16x8*)(Bt + (16 * m + r) * PT + 32 * kk + 8 * q), a2 = *(const LAS bf16x8*)(Kt + (16 * m + r) * PT + 32 * kk + 8 * q);
                c1 = __builtin_amdgcn_mfma_f32_16x16x32_bf16(a1, bx, c1, 0, 0, 0); c2 = __builtin_amdgcn_mfma_f32_16x16x32_bf16(a2, bx, c2, 0, 0, 0); }
#pragma unroll
            for (int jj = 0; jj < 4; ++jj) { const int s = 4 * q + jj; const bool ok = pp ? (s <= r) : (s < r); if (!ok) { c1[jj] = 0.f; c2[jj] = 0.f; } }
            if (pp == 0) { *(LAS f32x4*)(MBf + (m * 16 + r) * 20 + 4 * q) = c1; *(LAS u32x2*)(MK + (m * 16 + r) * PM + 4 * q) = pack4(c2[0], c2[1], c2[2], c2[3]); }
            else { *(LAS u32x2*)(NB + (m * 16 + r) * PM + 4 * q) = pack4(c1[0], c1[1], c1[2], c1[3]); *(LAS u32x2*)(NK + (m * 16 + r) * PM + 4 * q) = pack4(c2[0], c2[1], c2[2], c2[3]); }
        }
        __syncthreads();
        if (wv < 4) {
            const int m = wv, c = r; float X[16];
#pragma unroll
            for (int u = 0; u < 16; ++u) { float x = (c == u) ? 1.f : 0.f;
                if (u > 0) { const LAS f32x4* rowp = (const LAS f32x4*)(MBf + (m * 16 + u) * 20);
#pragma unroll
                    for (int s4 = 0; s4 < 4; ++s4) { if (4 * s4 < u) { const f32x4 l = rowp[s4];
#pragma unroll
                        for (int e = 0; e < 4; ++e) if (4 * s4 + e < u) x -= l[e] * X[4 * s4 + e]; } } }
                X[u] = x; }
            if (q == 0) {
#pragma unroll
                for (int u = 0; u < 16; ++u) DNV[(m * 16 + u) * PM + c] = f2bf(X[u]); }
        } else {
            const int m = wv - 4; const bf16x8 a = *(const LAS bf16x8*)(MK + (m * 16 + r) * PM + 8 * q);
#pragma unroll
            for (int it = 0; it < 4; ++it) { const bf16x8 bv = tr_frag(vt_b, PT, 16 * m, 16 * it, r, q);
                const f32x4 acc = __builtin_amdgcn_mfma_f32_16x16x32_bf16(a, bv, (f32x4){0.f, 0.f, 0.f, 0.f}, 0, 0, 0);
                *(LAS u32x2*)(W1T + (m * 64 + 16 * it + r) * PM + 4 * q) = pack4(acc[0], acc[1], acc[2], acc[3]); }
        }
        __syncthreads();
#pragma unroll
        for (int m = 0; m < 4; ++m) yhat[m] = (f32x4){0.f, 0.f, 0.f, 0.f};
        if (wv < 4) {
            const int it = wv;
#pragma unroll
            for (int m = 0; m < 4; ++m) { const bf16x8 a = *(const LAS bf16x8*)(DNV + (m * 16 + r) * PM + 8 * q), bw = *(const LAS bf16x8*)(W1T + (m * 64 + 16 * it + r) * PM + 8 * q);
                yhat[m] = __builtin_amdgcn_mfma_f32_16x16x32_bf16(a, bw, yhat[m], 0, 0, 0); }
        } else {
            const int jt = wv - 4;
#pragma unroll
            for (int m = 0; m < 4; ++m) { const bf16x8 a = tr_frag(at_b, PT, 16 * m, 16 * jt, r, q), bd = *(const LAS bf16x8*)(DNV + (m * 16 + r) * PM + 8 * q);
                const f32x4 acc = __builtin_amdgcn_mfma_f32_16x16x32_bf16(a, bd, (f32x4){0.f, 0.f, 0.f, 0.f}, 0, 0, 0);
                *(LAS u32x2*)(AH + (m * 16 + r) * PT + 16 * jt + 4 * q) = pack4(acc[0], acc[1], acc[2], acc[3]); }
        }
        __syncthreads();
        }
#pragma unroll 1
        for (int m = 0; m < 4; ++m) {
            LAS bf16_t* Sc = Sbf + cur * 64 * PT; LAS bf16_t* Sn = Sbf + (cur ^ 1) * 64 * PT;
            const int it = wv & 3, jh = wv >> 2;
            f32x4 oacc = (f32x4){0.f, 0.f, 0.f, 0.f};
            const bf16x8 bv = tr_frag(vt_b, PT, 16 * m, 16 * it, r, q);
            const bf16x8 ka0 = zero_if(tr_frag(kt_b, PT, 16 * m, 16 * (2 * jh), r, q), q >= 2), ka1 = zero_if(tr_frag(kt_b, PT, 16 * m, 16 * (2 * jh + 1), r, q), q >= 2);
            const bf16x8 ba0 = tr_frag(bt_b, PT, 16 * m, 16 * (2 * jh), r, q), ba1 = tr_frag(bt_b, PT, 16 * m, 16 * (2 * jh + 1), r, q);
            if (wv < 4) {
                f32x4 acc = (m == 0) ? yhat[0] : (m == 1) ? yhat[1] : (m == 2) ? yhat[2] : yhat[3];
#pragma unroll
                for (int kk = 0; kk < 2; ++kk) { const bf16x8 a = *(const LAS bf16x8*)(AH + (m * 16 + r) * PT + 32 * kk + 8 * q), bs = *(const LAS bf16x8*)(Sc + (16 * it + r) * PT + 32 * kk + 8 * q);
                    acc = __builtin_amdgcn_mfma_f32_16x16x32_bf16(a, bs, acc, 0, 0, 0); }
                *(LAS u32x2*)(YV + (16 * it + r) * PM + 4 * q) = pack4(-acc[0], -acc[1], -acc[2], -acc[3]);
            } else {
#pragma unroll
                for (int kk = 0; kk < 2; ++kk) { const bf16x8 a = *(const LAS bf16x8*)(Rt + (16 * m + r) * PT + 32 * kk + 8 * q), bs = *(const LAS bf16x8*)(Sc + (16 * it + r) * PT + 32 * kk + 8 * q);
                    oacc = __builtin_amdgcn_mfma_f32_16x16x32_bf16(a, bs, oacc, 0, 0, 0); }
                const bf16x8 a = *(const LAS bf16x8*)(NK + (m * 16 + r) * PM + 8 * q);
                oacc = __builtin_amdgcn_mfma_f32_16x16x32_bf16(a, bv, oacc, 0, 0, 0);
            }
            __syncthreads();
            {
                const bf16x8 by = *(const LAS bf16x8*)(YV + (16 * it + r) * PM + 8 * q);
#pragma unroll
                for (int x = 0; x < 2; ++x) { const int jt = 2 * jh + x;
                    const bf16x8 a1 = x ? ka1 : ka0, a2 = x ? ba1 : ba0;
                    Sacc[x] = __builtin_amdgcn_mfma_f32_16x16x32_bf16(a1, bv, Sacc[x], 0, 0, 0); Sacc[x] = __builtin_amdgcn_mfma_f32_16x16x32_bf16(a2, by, Sacc[x], 0, 0, 0);
                    const f32x4 gm = *(const LAS f32x4*)(GAM + m * 64 + 16 * jt + 4 * q); Sacc[x] = Sacc[x] * gm;
                    *(LAS u32x2*)(Sn + (16 * it + r) * PT + 16 * jt + 4 * q) = pack4(Sacc[x][0], Sacc[x][1], Sacc[x][2], Sacc[x][3]); }
                if (wv >= 4) { const bf16x8 a = *(const LAS bf16x8*)(NB + (m * 16 + r) * PM + 8 * q);
                    oacc = __builtin_amdgcn_mfma_f32_16x16x32_bf16(a, by, oacc, 0, 0, 0);
#pragma unroll
                    for (int jj = 0; jj < 4; ++jj) OUT[(16 * m + 4 * q + jj) * 68 + 16 * it + r] = oacc[jj]; }
            }
            __syncthreads();
            cur ^= 1;
        }
        for (int rep6 = 0; rep6 < (MK_RDUP == 6 ? 2 : 1); ++rep6) {
            const int u = tid >> 3, part = tid & 7; const size_t row = (size_t)step_row(d, b, n0 + u);
            const f32x4 o0 = *(const LAS f32x4*)(OUT + u * 68 + 8 * part), o1 = *(const LAS f32x4*)(OUT + u * 68 + 8 * part + 4);
            const float mean = sum8((o0[0] + o0[1]) + (o0[2] + o0[3]) + (o1[0] + o1[1]) + (o1[2] + o1[3])) * (1.f / 64.f);
            const f32x4 d0 = o0 - mean, d1 = o1 - mean;
            const float var = sum8((d0[0] * d0[0] + d0[1] * d0[1]) + (d0[2] * d0[2] + d0[3] * d0[3]) + (d1[0] * d1[0] + d1[1] * d1[1]) + (d1[2] * d1[2] + d1[3] * d1[3])) * (1.f / 64.f);
            const float rstd = rsqrtf(var + 64e-5f), bs = BS[u];
            const f32x4 w0 = *(const LAS f32x4*)(prm + 640 + 8 * part), w1 = *(const LAS f32x4*)(prm + 644 + 8 * part), b0 = *(const LAS f32x4*)(prm + 704 + 8 * part), b1 = *(const LAS f32x4*)(prm + 708 + 8 * part);
            const u32x4 vv = *(const LAS u32x4*)(Vt + u * PT + 8 * part);
            float z[8];
#pragma unroll
            for (int k = 0; k < 4; ++k) { z[k] = d0[k] * rstd * w0[k] + b0[k]; z[4 + k] = d1[k] * rstd * w1[k] + b1[k]; }
#pragma unroll
            for (int k = 0; k < 4; ++k) { z[2 * k] += bs * __uint_as_float(vv[k] << 16); z[2 * k + 1] += bs * __uint_as_float(vv[k] & 0xffff0000u); }
            u32x4 w; w.x = pack2(z[0], z[1]); w.y = pack2(z[2], z[3]); w.z = pack2(z[4], z[5]); w.w = pack2(z[6], z[7]);
            *(u32x4*)(Z + ((size_t)d * NALL + row) * 512 + 64 * h + 8 * part) = w;
        }
        __syncthreads();
    }
}
DI void phase_mlstm_post(const P& p) {
    const int lane = mk_tid() & 63, wv = mk_tid() >> 6;
    const bf16_t* ML = (const bf16_t*)(p.ws + WS_COLS) + OFF_ML; const bf16_t* HB = (const bf16_t*)(p.ws + WS_ACT); bf16_t* Y = (bf16_t*)(p.ws + WS_COLS);
    for (int r = blockIdx.x * 8 + wv; r < NALL; r += gridDim.x * 8)
        post_headnorm_row(HB, (size_t)r, p.in[I_MNG], ML + (size_t)r * 2048 + 1536, 0, Y + (size_t)r * D + 512, lane);
}
DI void phase_hgrn_post(const P& p) {
    const int lane = mk_tid() & 63, wv = mk_tid() >> 6;
    const bf16_t* C1 = (const bf16_t*)(p.ws + WS_COLS); const bf16_t* HB = (const bf16_t*)(p.ws + WS_ACT); bf16_t* Y = (bf16_t*)(p.ws + WS_Z);
    for (int r = blockIdx.x * 8 + wv; r < NLAT; r += gridDim.x * 8)
        post_headnorm_row(HB, (size_t)r, p.in[I_HNG], C1 + (size_t)r * C1LD + 2048, 1, Y + (size_t)nat_row(r) * D, lane);
}

constexpr int N_PHASES = 19;
__global__ void __launch_bounds__(NT, 2) mk_fwd(P p) {
    extern __shared__ __attribute__((aligned(16))) unsigned char lds_raw[];
    LAS unsigned char* lds = (LAS unsigned char*)lds_raw;
    cooperative_groups::grid_group grid = cooperative_groups::this_grid();
    const int lo = p.ph_lo, hi = p.ph_hi;
#define IN(k) (lo <= (k) && (k) < hi)
#define SEAM(k) do { if (IN(k) && IN((k) + 1)) grid.sync(); } while (0)
#ifndef MK_DUP
#define MK_DUP -1
#endif
#define PHASE(k, ...) if (IN(k)) { __VA_ARGS__ if (MK_DUP == (k)) { grid.sync(); __VA_ARGS__ } } SEAM(k);
    unsigned char* ws = p.ws;
    const float* MODV = (const float*)(ws + WS_MODV);
    float* HC = (float*)(ws + WS_HC);
    bf16_t* ACT = (bf16_t*)(ws + WS_ACT); bf16_t* COLS = (bf16_t*)(ws + WS_COLS); bf16_t* Y1 = (bf16_t*)(ws + WS_Z);
    PHASE(0, phase_wprep(p, lds); phase_modv(p, lds);)
    PHASE(1, phase_modnorm(p, 0, 0, p.in[I_X], p.in[I_CTX], NALL, false);)
    PHASE(2, EpiStore3 E{COLS + OFF_RW, 1536, 6, COLS + OFF_LO, 512, 8, COLS + OFF_ML, 2048}; run_gemm(lds, ACT, (const bf16_t*)(ws + WS_W_EVIN), NALL, 4096, 1024, E);)
    PHASE(3, { const int bx = (int)blockIdx.x;
        if (gridDim.x == 256) { if (bx < 64) rwkv_chunk_unit<1>(p, lds, bx); else if (bx < 128) rwkv_chunk_unit<2>(p, lds, bx - 64); else gla_unit<0>(p, lds, bx - 128); }
        else for (int vb = bx; vb < 192; vb += gridDim.x) { if (vb < 64) rwkv_chunk_unit<0>(p, lds, vb); else gla_unit<0>(p, lds, vb - 64); } })
    if (IN(3) && MK_DUP == 103) { grid.sync(); for (int vb = blockIdx.x; vb < 64; vb += gridDim.x) rwkv_chunk_unit<0>(p, lds, vb); grid.sync(); }
    if (IN(3) && MK_DUP == 203) { grid.sync(); for (int vb = blockIdx.x; vb < 128; vb += gridDim.x) gla_unit<0>(p, lds, vb); grid.sync(); }
    PHASE(4, phase_mlstm_post(p); phase_rwkv_post(p, lds);)
    PHASE(5, EpiResid E{p.in[I_X], p.out, p.in[I_CTX], HC, MODV, 2}; run_gemm(lds, COLS, (const bf16_t*)(ws + WS_W_EVOUT), NALL, 1024, 1024, E);)
    PHASE(6, phase_modnorm(p, 0, 1, p.out, HC, NALL, false);)
    PHASE(7, EpiSwiglu E{COLS}; run_gemm(lds, ACT, (const bf16_t*)(ws + WS_W_UP), NALL, 5632, 1024, E);)
    PHASE(8, EpiResid E{p.out, p.out, HC, HC, MODV, 5}; run_gemm(lds, COLS, (const bf16_t*)(ws + WS_W_DN), NALL, 1024, 2816, E);)
    PHASE(9, phase_modnorm(p, 1, 0, p.out, HC, NALL, true);)
    PHASE(10, EpiStore3 E{COLS, C1LD, 1 << 30, COLS, C1LD, 1 << 30, COLS, C1LD}; run_gemm(lds, ACT, (const bf16_t*)(ws + WS_W_ODIN), NALL, 3584, 1024, E);)
    PHASE(11, phase_hgrn_prep(p, lds); lru_pass<1>(p, lds, (int)blockIdx.x, (int)gridDim.x);)
    PHASE(12, { const int half = (int)gridDim.x >> 1; if ((int)blockIdx.x < half) { for (int u = blockIdx.x; u < 128; u += half) gla_unit<1>(p, lds, u); } else lru_pass<3>(p, lds, (int)blockIdx.x - half, (int)gridDim.x - half); })
    if (IN(12) && MK_DUP == 112) { grid.sync(); lru_pass<3>(p, lds, (int)blockIdx.x, (int)gridDim.x); grid.sync(); }
    if (IN(12) && MK_DUP == 212) { grid.sync(); for (int vb = blockIdx.x; vb < 128; vb += gridDim.x) gla_unit<1>(p, lds, vb); grid.sync(); }
    PHASE(13, phase_hgrn_post(p);)
    PHASE(14, EpiResid E{p.out, p.out, HC, HC, MODV + 5 * 6144, 2}; run_gemm(lds, Y1, (const bf16_t*)(ws + WS_W_ODOUT), NLAT, 1024, 1024, E);)
    PHASE(15, phase_modnorm(p, 1, 1, p.out, HC, NLAT, false);)
    PHASE(16, EpiSwiglu E{COLS}; run_gemm(lds, ACT, (const bf16_t*)(ws + WS_W_UP) + W_UP_STRIDE, NLAT, 5632, 1024, E);)
    PHASE(17, EpiResid E{p.out, p.out, HC, HC, MODV + 5 * 6144, 5}; run_gemm(lds, COLS, (const bf16_t*)(ws + WS_W_DN) + W_DN_STRIDE, NLAT, 1024, 2816, E);)
    PHASE(18, phase_finalnorm(p);)
#undef IN
#undef SEAM
}
}

#ifndef MK_ONE_LAUNCH
#define MK_ONE_LAUNCH 1
#endif
extern "C" void kernel_launch(void* const* d_in, const int* in_sizes, int n_in, void* d_out, int out_size, void* d_ws, size_t ws_size, hipStream_t stream) {
    using namespace mk;
    static int grid = 0;
    if (grid == 0) {
        int dev = 0, cus = 0, per_cu = 0;
        if (n_in != N_IN || ws_size < WS_END) { fprintf(stderr, "kernel_launch: unexpected n_in %d / ws_size %zu\n", n_in, ws_size); grid = -1; return; }
        (void)hipGetDevice(&dev); (void)hipDeviceGetAttribute(&cus, hipDeviceAttributeMultiprocessorCount, dev);
        (void)hipFuncSetAttribute((const void*)mk_fwd, hipFuncAttributeMaxDynamicSharedMemorySize, LDS_BYTES);
        (void)hipOccupancyMaxActiveBlocksPerMultiprocessor(&per_cu, (const void*)mk_fwd, NT, LDS_BYTES);
        if (per_cu < 1) { fprintf(stderr, "kernel_launch: occupancy query says %d blocks per CU\n", per_cu); per_cu = 1; }
        (void)hipGetLastError();
        grid = cus;
    }
    if (grid < 0) return;
    if (hipMemsetAsync((char*)d_ws + WS_CTL, 0, 65536, stream) != hipSuccess) { fprintf(stderr, "kernel_launch: memset of the control words failed\n"); return; }
    P p{};
    for (int i = 0; i < N_IN; ++i) p.in[i] = (const float*)d_in[i];
    p.out = (float*)d_out; p.ws = (unsigned char*)d_ws;
#if MK_ONE_LAUNCH
    p.ph_lo = 0; p.ph_hi = N_PHASES;
    void* args[] = {&p};
    hipError_t e = hipLaunchCooperativeKernel((const void*)mk_fwd, dim3(grid), dim3(NT), args, LDS_BYTES, stream);
    if (e != hipSuccess) fprintf(stderr, "cooperative launch failed: %s (grid %d)\n", hipGetErrorString(e), grid);
#else
    for (int k = 0; k < N_PHASES; ++k) { p.ph_lo = k; p.ph_hi = k + 1; hipLaunchKernelGGL(mk_fwd, dim3(grid), dim3(NT), LDS_BYTES, stream, p); }
#endif
}
```

```cpp
#include <hip/hip_runtime.h>
#include <hip/hip_cooperative_groups.h>
#include <cstdio>
#include <cstdint>
__device__ __forceinline__ int mk_tid() { int t = threadIdx.x; asm volatile("" : "+v"(t)); return t; }
#define MK_DUP -1
#define MK_RDUP -1
namespace pg8 {
#define PG8_LAS __attribute__((address_space(3)))
typedef unsigned short bf16_t;
typedef short bf16x8 __attribute__((ext_vector_type(8)));
typedef float f32x4 __attribute__((ext_vector_type(4)));
typedef unsigned u32x4 __attribute__((ext_vector_type(4)));
constexpr int BM = 256, BK = 64, HALF = 128, HTB = HALF * BK * 2  , STAGE_BYTES = 8 * HTB, NXCD = 8, WGM = 8;

__host__ __device__ __forceinline__ int lds_byte(int r, int c) { const int st = (r >> 4) * 2 + (c >> 5), rr = r & 15, cc = c & 31, ob = rr * 64 + cc * 2; return st * 1024 + (ob ^ (((ob >> 9) & 1) << 5)); }
__host__ __device__ __forceinline__ void stage_rc(int b, int& R, int& C) { const int st = b / 1024, sb = b % 1024, swz = sb ^ (((sb >> 9) & 1) << 5); R = (st >> 1) * 16 + swz / 64; C = (st & 1) * 32 + (swz % 64) / 2; }
__host__ __device__ __forceinline__ int perm32(int rho) { const int n = rho >> 4, i = rho & 15; return 8 * (i >> 2) + 4 * n + (i & 3); }

struct Unit { int pm, pn; };
struct Gemm { const bf16_t* A; const bf16_t* Bt; int M, N, K; };

struct StaticOrder {
    int nM, nN, nwg, G, c;
    __host__ __device__ void init(int M, int N, int G_, int c_) { nM = M / BM; nN = N / BM; nwg = nM * nN; G = G_; c = c_; }
    __host__ __device__ bool next(int i, Unit& u) const {
        const long L = (long)i * G + c; if (L >= nwg) return false;
        int wgid = (int)L; { const int q = nwg / NXCD, r = nwg % NXCD, xcd = wgid % NXCD, off = wgid / NXCD; wgid = (xcd < r ? xcd * (q + 1) : r * (q + 1) + (xcd - r) * q) + off; }
        const int nig = WGM * nN, gid = wgid / nig, fm = gid * WGM, gsz = (nM - fm) < WGM ? (nM - fm) : WGM;
        u.pm = fm + ((wgid % nig) % gsz); u.pn = (wgid % nig) / gsz; return true;
    }
    __device__ __forceinline__ void a_ready(const Unit&) const {}
    __device__ __forceinline__ void done(const Unit&) const {}
};
__device__ __forceinline__ unsigned cvt_pk_bf16(float lo, float hi) { unsigned r; asm volatile("v_cvt_pk_bf16_f32 %0, %1, %2" : "=v"(r) : "v"(lo), "v"(hi)); return r; }
typedef float f32x2 __attribute__((ext_vector_type(2)));
template <class Epi, class Sched, bool STAMP = false>
__device__ __forceinline__ void gemm_phase(PG8_LAS unsigned char* lds, const Gemm g, const Sched& S, const Epi& E, unsigned long long* stamps) {
    const int tid = mk_tid(), wid = __builtin_amdgcn_readfirstlane(tid >> 6), lane = tid & 63, wr = wid >> 2, wc = wid & 3, fr = lane & 15, fq = lane >> 4;
    const int K = g.K, nt = K / BK;
    int ts_lo = 0, ts_hi = 0, nts = 0; const unsigned long long rt_entry = STAMP ? (unsigned long long)wall_clock64() : 0ull;
#define PG8_STAMP() do { if (STAMP && wid == 0 && nts < 64) { const unsigned long long _c = (unsigned long long)clock64(); \
        ts_lo = (lane == nts) ? (int)(unsigned)_c : ts_lo; ts_hi = (lane == nts) ? (int)(unsigned)(_c >> 32) : ts_hi; ++nts; } } while (0)
    PG8_STAMP();
    unsigned voffA[2], voffB[2];
#pragma unroll
    for (int i = 0; i < 2; ++i) { int R, C; stage_rc(tid * 16 + i * 8192, R, C); const int Rb = Epi::PERM ? ((R & ~31) + perm32(R & 31)) : R;
        voffA[i] = (unsigned)(R * K + C) * 2u; voffB[i] = (unsigned)(Rb * K + C) * 2u; }
    const size_t kstep = (size_t)(BK * 2);
    const size_t hstep = (size_t)HALF * K * 2;
    const size_t tstep = 2 * hstep;
    const unsigned ldsw = (unsigned)wid * 1024u;
    const int aoff = lds_byte(wr * 64 + fr, fq * 8), boff = lds_byte(wc * 32 + fr, fq * 8);
#define PG8_SA(b, h) (((b) * 2 + (h)) * HTB)
#define PG8_SB(b, h) ((4 + (b) * 2 + (h)) * HTB)
#define PG8_STAGE(bufoff, gbase, voff) do { _Pragma("unroll") for (int _i = 0; _i < 2; ++_i) \
        __builtin_amdgcn_global_load_lds((const unsigned*)((const char*)(gbase) + (voff)[_i]), (PG8_LAS unsigned*)(lds + (bufoff) + ldsw + _i * 8192), 16, 0, 0); } while (0)
#define PG8_LDA(dst, b, h) do { _Pragma("unroll") for (int m = 0; m < 4; ++m) _Pragma("unroll") for (int k = 0; k < 2; ++k) dst[m][k] = *(const PG8_LAS bf16x8*)(lds + PG8_SA(b, h) + aoff + m * 2048 + k * 1024); } while (0)
#define PG8_LDB(dst, b, h) do { _Pragma("unroll") for (int n = 0; n < 2; ++n) _Pragma("unroll") for (int k = 0; k < 2; ++k) dst[n][k] = *(const PG8_LAS bf16x8*)(lds + PG8_SB(b, h) + boff + n * 2048 + k * 1024); } while (0)
#define PG8_MMA(ai, bj, At, Bt) do { __builtin_amdgcn_s_setprio(1); _Pragma("unroll") for (int m = 0; m < 4; ++m) _Pragma("unroll") for (int n = 0; n < 2; ++n) _Pragma("unroll") for (int k = 0; k < 2; ++k) \
        acc[ai][bj][m][n] = __builtin_amdgcn_mfma_f32_16x16x32_bf16(Bt[n][k], At[m][k], acc[ai][bj][m][n], 0, 0, 0); __builtin_amdgcn_s_setprio(0); } while (0)
#define PG8_WAIT_V(n) asm volatile("s_waitcnt vmcnt(" #n ")" ::: "memory")
#define PG8_WAIT_L(n) asm volatile("s_waitcnt lgkmcnt(" #n ")" ::: "memory")
#define PG8_BAR __builtin_amdgcn_s_barrier()
#define PG8_SCHED __builtin_amdgcn_sched_barrier(0)
    Unit cur, nxt; int ui = 0;
    if (!S.next(0, cur)) return;
    f32x4 acc[2][2][4][2];
#pragma unroll
    for (int a = 0; a < 2; ++a)
#pragma unroll
        for (int b = 0; b < 2; ++b)
#pragma unroll
            for (int m = 0; m < 4; ++m)
#pragma unroll
                for (int n = 0; n < 2; ++n) acc[a][b][m][n] = (f32x4){0.f, 0.f, 0.f, 0.f};
    bf16x8 At[4][2], B0[2][2], B1[2][2];
    const char* cA = (const char*)g.A + (size_t)cur.pm * tstep; const char* cB = (const char*)g.Bt + (size_t)cur.pn * tstep;
    S.a_ready(cur);
    PG8_STAGE(PG8_SB(0, 0), cB, voffB); PG8_STAGE(PG8_SA(0, 0), cA, voffA); PG8_STAGE(PG8_SB(0, 1), cB + hstep, voffB); PG8_STAGE(PG8_SA(0, 1), cA + hstep, voffA);
    if (wr == 1) PG8_BAR;
    PG8_WAIT_V(4); PG8_BAR;
    PG8_STAGE(PG8_SB(1, 0), cB + kstep, voffB); PG8_STAGE(PG8_SA(1, 0), cA + kstep, voffA); PG8_STAGE(PG8_SB(1, 1), cB + hstep + kstep, voffB);
    PG8_WAIT_V(6); PG8_BAR;
    PG8_STAMP();
    for (;;) {
        const bool has_next = S.next(ui + 1, nxt);
        const char* nA = has_next ? (const char*)g.A + (size_t)nxt.pm * tstep : cA; const char* nB = has_next ? (const char*)g.Bt + (size_t)nxt.pn * tstep : cB;
        for (int t = 0; t < nt; t += 2) {
            const bool last = (t == nt - 2);
            const char* a1 = cA + (size_t)(t + 1) * kstep;
            const char* a2 = last ? nA : cA + (size_t)(t + 2) * kstep; const char* b2 = last ? nB : cB + (size_t)(t + 2) * kstep;
            const char* a3 = a2 + kstep; const char* b3 = b2 + kstep;
            if (last && has_next) S.a_ready(nxt);
            PG8_LDB(B0, 0, 0); PG8_SCHED; PG8_LDA(At, 0, 0); PG8_STAGE(PG8_SA(1, 1), a1 + hstep, voffA);
            PG8_WAIT_L(8); PG8_BAR; PG8_WAIT_L(0); PG8_MMA(0, 0, At, B0); PG8_BAR; PG8_SCHED;
            PG8_LDB(B1, 0, 1); PG8_STAGE(PG8_SB(0, 0), b2, voffB);
            PG8_BAR; PG8_WAIT_L(0); PG8_MMA(0, 1, At, B1); PG8_BAR;
            PG8_LDA(At, 0, 1); PG8_STAGE(PG8_SA(0, 0), a2, voffA);
            PG8_BAR; PG8_WAIT_L(0); PG8_MMA(1, 0, At, B0); PG8_BAR; PG8_SCHED;
            PG8_STAGE(PG8_SB(0, 1), b2 + hstep, voffB);
            PG8_WAIT_V(6); PG8_BAR; PG8_MMA(1, 1, At, B1); PG8_BAR;
            PG8_LDB(B0, 1, 0); PG8_SCHED; PG8_LDA(At, 1, 0); PG8_STAGE(PG8_SA(0, 1), a2 + hstep, voffA);
            PG8_WAIT_L(8); PG8_BAR; PG8_WAIT_L(0); PG8_MMA(0, 0, At, B0); PG8_BAR; PG8_SCHED;
            PG8_LDB(B1, 1, 1); PG8_STAGE(PG8_SB(1, 0), b3, voffB);
            PG8_BAR; PG8_WAIT_L(0); PG8_MMA(0, 1, At, B1); PG8_BAR;
            PG8_LDA(At, 1, 1); PG8_STAGE(PG8_SA(1, 0), a3, voffA);
            PG8_BAR; PG8_WAIT_L(0); PG8_MMA(1, 0, At, B0); PG8_BAR; PG8_SCHED;
            PG8_STAGE(PG8_SB(1, 1), b3 + hstep, voffB);
            PG8_WAIT_V(6); PG8_BAR; PG8_MMA(1, 1, At, B1); PG8_BAR;
        }
        PG8_STAMP();
        if constexpr (!Epi::AFTER_DRAIN) { E(acc, cur, wr, wc, fr, fq); S.done(cur); }
        PG8_STAMP();
        if (!has_next) break;
#pragma unroll
        for (int a = 0; a < 2; ++a)
#pragma unroll
            for (int b = 0; b < 2; ++b)
#pragma unroll
                for (int m = 0; m < 4; ++m)
#pragma unroll
                    for (int n = 0; n < 2; ++n) acc[a][b][m][n] = (f32x4){0.f, 0.f, 0.f, 0.f};
        cur = nxt; cA = nA; cB = nB; ++ui;
    }
    PG8_WAIT_V(0);
    if (wr == 0) PG8_BAR;
    PG8_BAR;
    if constexpr (Epi::AFTER_DRAIN) { E.fused(acc, cur, wr, wc, fr, fq, lds, wid, lane); S.done(cur); }
    PG8_STAMP();
    if (STAMP && wid == 0) { stamps[lane] = lane < nts ? (((unsigned long long)(unsigned)ts_hi << 32) | (unsigned)ts_lo) : 0ull;
        if (lane == 62) stamps[62] = rt_entry; if (lane == 63) stamps[63] = (unsigned long long)wall_clock64(); }
#undef PG8_STAMP
#undef PG8_SA
#undef PG8_SB
#undef PG8_STAGE
#undef PG8_LDA
#undef PG8_LDB
#undef PG8_MMA
#undef PG8_WAIT_V
#undef PG8_WAIT_L
#undef PG8_BAR
#undef PG8_SCHED
}
}

namespace mk {
#define DI __device__ __forceinline__
#define LAS __attribute__((address_space(3)))
typedef unsigned short bf16_t;
typedef float f32x4 __attribute__((ext_vector_type(4)));
typedef unsigned u32x2 __attribute__((ext_vector_type(2)));
typedef unsigned u32x4 __attribute__((ext_vector_type(4)));

constexpr int D = 1024, NB = 4, L = 8192, LC = 256, NLAT = NB * L, NCTX = NB * LC, NALL = NLAT + NCTX, LT = L + LC, DFF = 2816;
constexpr int NT = 512;
constexpr size_t MiB = (size_t)1 << 20;
constexpr size_t WS_CTL = 0, WS_MODV = 1 * MiB, WS_HC = 2 * MiB, WS_W_EVIN = 6 * MiB, WS_W_EVOUT = 14 * MiB, WS_W_ODIN = 16 * MiB, WS_W_ODOUT = 23 * MiB,
                 WS_W_UP = 25 * MiB, WS_W_DN = 47 * MiB, WS_ACT = 58 * MiB, WS_COLS = 124 * MiB, WS_Z = 388 * MiB, WS_Z1 = 454 * MiB, WS_LAM = 486 * MiB, WS_LSUM = 489 * MiB, WS_LCAR = 494 * MiB, WS_END = 497 * MiB;
constexpr size_t W_UP_STRIDE = (size_t)5632 * 1024, W_DN_STRIDE = (size_t)1024 * 2816;
constexpr size_t OFF_RW = 0, OFF_LO = (size_t)NALL * 1536, OFF_ML = OFF_LO + (size_t)NALL * 512;
constexpr int LDS_BYTES = 163840;
constexpr int C1LD = 3584;
DI int nat_row(int r) { const int b = r / L, pp = r % L; return b * L + (pp % 128) * 64 + pp / 128; }

enum { I_X = 0, I_C, I_CTX, I_CCTX, I_N1G, I_N2G, I_MODW, I_MODB, I_W1, I_W3, I_W2, I_FING, I_EVIN, I_EVOUT, I_MU, I_W0, I_W2L, I_A0, I_A2L, I_KK, I_KA, I_RK,
       I_LNW, I_LNB, I_G2, I_MBI, I_MBF, I_MNG, I_ODIN, I_ODOUT, I_HLB, I_HNG, I_CONVW, I_CONVB, I_WA, I_BA, I_WI, I_BI, I_LAM, N_IN };

struct P { const float* in[N_IN]; float* out; unsigned char* ws; int ph_lo, ph_hi; };

DI float bf2f(bf16_t v) { return __uint_as_float(((unsigned)v) << 16); }
typedef float f32x2_t __attribute__((ext_vector_type(2)));
typedef __bf16 bf16x2_t __attribute__((ext_vector_type(2)));
DI unsigned pack2(float lo, float hi) { const f32x2_t v = {lo, hi}; return __builtin_bit_cast(unsigned, __builtin_convertvector(v, bf16x2_t)); }
DI bf16_t f2bf(float f) { return (bf16_t)(pack2(f, f) & 0xffffu); }
DI float sigm(float x) { return 1.f / (1.f + expf(-x)); }
DI float siluf(float x) { return x * sigm(x); }
DI float geluf(float x) { return 0.5f * x * (1.f + tanhf(0.7978845608028654f * (x + 0.044715f * x * x * x))); }
DI float fexp(float x) { return __builtin_amdgcn_exp2f(x * 1.4426950408889634f); }
DI float frcp(float x) { return __builtin_amdgcn_rcpf(x); }
DI float fsigm(float x) { return frcp(1.f + fexp(-x)); }
DI float ftanh(float x) { return 1.f - 2.f * frcp(1.f + fexp(2.f * x)); }
DI float fgelu(float x) { return 0.5f * x * (1.f + ftanh(0.7978845608028654f * (x + 0.044715f * x * x * x))); }
template <int CTRL> DI float dppf(float x) { return __int_as_float(__builtin_amdgcn_update_dpp(0, __float_as_int(x), CTRL, 0xF, 0xF, false)); }
DI float sum8(float s) { s += dppf<0xB1>(s); s += dppf<0x4E>(s); s += dppf<0x141>(s); return s; }
DI float scan16(float x) { x += dppf<0x111>(x); x += dppf<0x112>(x); x += dppf<0x114>(x); x += dppf<0x118>(x); return x; }
DI float wave_sum(float v) {
#pragma unroll
    for (int o = 32; o >= 1; o >>= 1) v += __shfl_xor(v, o);
    return v;
}
DI int step_row(int d, int b, int n) {
    if (n < LC) return NLAT + b * LC + (d ? LC - 1 - n : n);
    const int m = n - LC; return b * L + (d ? L - 1 - m : m);
}

DI int matN(int m) { return m == 0 ? 4096 : m == 1 ? 1024 : m == 2 ? 3584 : m == 3 ? 1024 : m < 6 ? 5632 : 1024; }
DI int matK(int m) { return m < 6 ? 1024 : 2816; }
DI int matTile0(int m) { return m == 0 ? 0 : m == 1 ? 1024 : m == 2 ? 1280 : m == 3 ? 2176 : m == 4 ? 2432 : m == 5 ? 3840 : m == 6 ? 5248 : m == 7 ? 5952 : 6656; }
DI size_t matOff(int m) { return m == 0 ? WS_W_EVIN : m == 1 ? WS_W_EVOUT : m == 2 ? WS_W_ODIN : m == 3 ? WS_W_ODOUT : m == 4 ? WS_W_UP : m == 5 ? WS_W_UP + W_UP_STRIDE * 2 : m == 6 ? WS_W_DN : WS_W_DN + W_DN_STRIDE * 2; }
DI const float* matSrc(const P& p, int m, int n, int& ld) {
    if (m == 0) { ld = 3984; int col; if (n < 1920) col = n; else if (n < 1936) col = 3968 + (n - 1920); else if (n < 2048) return nullptr; else col = 1920 + (n - 2048); return p.in[I_EVIN] + col; }
    if (m == 1) { ld = 1024; return p.in[I_EVOUT] + n; }
    if (m == 2) { ld = 3584; return p.in[I_ODIN] + n; }
    if (m == 3) { ld = 1024; return p.in[I_ODOUT] + n; }
    if (m < 6) { ld = 2816; const int l = m - 4, pn = n >> 8, w = n & 255; const size_t lo = (size_t)l * 1024 * 2816; return (w < 128) ? p.in[I_W1] + lo + 128 * pn + w : p.in[I_W3] + lo + 128 * pn + (w - 128); }
    ld = 1024; return p.in[I_W2] + (size_t)(m - 6) * 2816 * 1024 + n;
}
DI void phase_wprep(const P& p, LAS unsigned char* ldsb) {
    LAS float* tile = (LAS float*)ldsb;
    const int tid = mk_tid(), tx = tid & 63, ty = tid >> 6;
    for (int item = blockIdx.x; item < 6656; item += gridDim.x) {
        int m = 0;
#pragma unroll
        for (int q = 1; q < 8; ++q) if (item >= matTile0(q)) m = q;
        const int local = item - matTile0(m), K = matK(m), nK = K >> 6, nb = local / nK, kb = local - nb * nK, n0 = nb * 64, k0 = kb * 64;
        bf16_t* Bt = (bf16_t*)(p.ws + matOff(m));
        int ld; const float* src = matSrc(p, m, n0 + tx, ld);
        __syncthreads();
#pragma unroll
        for (int i = 0; i < 8; ++i) { const int k = k0 + ty + 8 * i; tile[(ty + 8 * i) * 65 + tx] = src ? src[(size_t)k * ld] : 0.f; }
        __syncthreads();
#pragma unroll
        for (int i = 0; i < 8; ++i) { const int nn = ty + 8 * i; Bt[(size_t)(n0 + nn) * K + k0 + tx] = f2bf(tile[tx * 65 + nn]); }
    }
    __syncthreads();
}
DI void phase_modv(const P& p, LAS unsigned char* ldsb) {
    LAS float* sc = (LAS float*)ldsb;
    const int tid = mk_tid();
    float* MODV = (float*)(p.ws + WS_MODV);
    __syncthreads();
    for (int e = tid; e < 5 * 1024; e += NT) { const int s = e >> 10, k = e & 1023; const float v = (s < 4) ? p.in[I_C][s * 1024 + k] : p.in[I_CCTX][k]; sc[e] = siluf(v); }
    __syncthreads();
    for (int vb = blockIdx.x; vb < 24; vb += gridDim.x) {
        const int l = vb / 12, n = (vb % 12) * 512 + tid;
        const float* W = p.in[I_MODW] + (size_t)l * 1024 * 6144 + n;
        float a0 = 0.f, a1 = 0.f, a2 = 0.f, a3 = 0.f, a4 = 0.f;
#pragma unroll 8
        for (int k = 0; k < 1024; ++k) { const float w = W[(size_t)k * 6144]; a0 += sc[k] * w; a1 += sc[1024 + k] * w; a2 += sc[2048 + k] * w; a3 += sc[3072 + k] * w; a4 += sc[4096 + k] * w; }
        const float bb = p.in[I_MODB][l * 6144 + n];
        float* o = MODV + (size_t)l * 5 * 6144 + n;
        o[0] = a0 + bb; o[6144] = a1 + bb; o[2 * 6144] = a2 + bb; o[3 * 6144] = a3 + bb; o[4 * 6144] = a4 + bb;
    }
    __syncthreads();
}

DI void phase_modnorm(const P& p, int layer, int which, const float* hlat, const float* hctx, int nrows, bool permute) {
    const int lane = mk_tid() & 63, wv = mk_tid() >> 6;
    const float* MODV = (const float*)(p.ws + WS_MODV) + (size_t)layer * 5 * 6144;
    const float* g = p.in[which ? I_N2G : I_N1G] + layer * 1024;
    bf16_t* ACT = (bf16_t*)(p.ws + WS_ACT);
    for (int r = blockIdx.x * 8 + wv; r < nrows; r += gridDim.x * 8) {
        const bool isctx = r >= NLAT;
        const float* src = isctx ? hctx + (size_t)(r - NLAT) * D : hlat + (size_t)r * D;
        const int sv = isctx ? 4 : r / L;
        const float* shift = MODV + sv * 6144 + (which ? 3 : 0) * 1024; const float* scale = shift + 1024;
        int dr = r;
        if (permute && !isctx) { const int b = r / L, t = r % L; dr = b * L + (t % 64) * 128 + t / 64; }
        f32x4 v[4]; float ss = 0.f;
#pragma unroll
        for (int j = 0; j < 4; ++j) { v[j] = *(const f32x4*)(src + 4 * lane + 256 * j); ss += v[j].x * v[j].x + v[j].y * v[j].y + v[j].z * v[j].z + v[j].w * v[j].w; }
        const float rinv = rsqrtf(wave_sum(ss) * (1.f / D) + 1e-6f);
#pragma unroll
        for (int j = 0; j < 4; ++j) { const int c = 4 * lane + 256 * j;
            const f32x4 gg = *(const f32x4*)(g + c), sc = *(const f32x4*)(scale + c), sh = *(const f32x4*)(shift + c);
            const float o0 = v[j].x * rinv * gg.x * (1.f + sc.x) + sh.x, o1 = v[j].y * rinv * gg.y * (1.f + sc.y) + sh.y, o2 = v[j].z * rinv * gg.z * (1.f + sc.z) + sh.z, o3 = v[j].w * rinv * gg.w * (1.f + sc.w) + sh.w;
            u32x2 w; w.x = pack2(o0, o1); w.y = pack2(o2, o3);
            *(u32x2*)(ACT + (size_t)dr * D + c) = w; }
    }
}
DI void phase_finalnorm(const P& p) {
    const int lane = mk_tid() & 63, wv = mk_tid() >> 6;
    const float* g = p.in[I_FING];
    for (int r = blockIdx.x * 8 + wv; r < NLAT; r += gridDim.x * 8) {
        float* src = p.out + (size_t)r * D;
        f32x4 v[4]; float ss = 0.f;
#pragma unroll
        for (int j = 0; j < 4; ++j) { v[j] = *(const f32x4*)(src + 4 * lane + 256 * j); ss += v[j].x * v[j].x + v[j].y * v[j].y + v[j].z * v[j].z + v[j].w * v[j].w; }
        const float rinv = rsqrtf(wave_sum(ss) * (1.f / D) + 1e-6f);
#pragma unroll
        for (int j = 0; j < 4; ++j) { const int c = 4 * lane + 256 * j; const f32x4 gg = *(const f32x4*)(g + c);
            f32x4 o; o.x = v[j].x * rinv * gg.x; o.y = v[j].y * rinv * gg.y; o.z = v[j].z * rinv * gg.z; o.w = v[j].w * rinv * gg.w; *(f32x4*)(src + c) = o; }
    }
}

struct EpiStore3 {
    static constexpr bool PERM = true, AFTER_DRAIN = false;
    bf16_t* p0; int ld0; int pn1; bf16_t* p1; int ld1; int pn2; bf16_t* p2; int ld2;
    DI void operator()(const f32x4 (&acc)[2][2][4][2], const pg8::Unit& u, int wr, int wc, int fr, int fq) const {
        bf16_t* base; int ld, ct;
        if (u.pn >= pn2) { base = p2; ld = ld2; ct = u.pn - pn2; } else if (u.pn >= pn1) { base = p1; ld = ld1; ct = u.pn - pn1; } else { base = p0; ld = ld0; ct = u.pn; }
        const int row0 = u.pm * 256 + wr * 64 + fr, col0 = ct * 256 + wc * 32 + 8 * fq;
#pragma unroll
        for (int ai = 0; ai < 2; ++ai)
#pragma unroll
            for (int m = 0; m < 4; ++m) { bf16_t* rowp = base + (size_t)(row0 + ai * 128 + m * 16) * ld + col0;
#pragma unroll
                for (int bj = 0; bj < 2; ++bj) { const f32x4 v0 = acc[ai][bj][m][0], v1 = acc[ai][bj][m][1];
                    u32x4 w; w.x = pack2(v0[0], v0[1]); w.y = pack2(v0[2], v0[3]); w.z = pack2(v1[0], v1[1]); w.w = pack2(v1[2], v1[3]); *(u32x4*)(rowp + bj * 128) = w; } }
    }
};
struct EpiResid {
    static constexpr bool PERM = false, AFTER_DRAIN = false;
    const float* hin; float* hout; const float* cin; float* cout; const float* modv_l; int gidx;
    DI void operator()(const f32x4 (&acc)[2][2][4][2], const pg8::Unit& u, int wr, int wc, int fr, int fq) const {
        const bool isctx = u.pm >= 128; const int sv = isctx ? 4 : (u.pm >> 5);
        const float* gate = modv_l + sv * 6144 + gidx * 1024;
        const float* bi = isctx ? cin : hin; float* bo = isctx ? cout : hout;
        const int row0 = (isctx ? (u.pm - 128) : u.pm) * 256 + wr * 64 + fr, col0 = u.pn * 256 + wc * 32 + 4 * fq;
        f32x4 gv[2][2];
#pragma unroll
        for (int bj = 0; bj < 2; ++bj)
#pragma unroll
            for (int n = 0; n < 2; ++n) gv[bj][n] = *(const f32x4*)(gate + col0 + bj * 128 + n * 16);
#pragma unroll
        for (int ai = 0; ai < 2; ++ai)
#pragma unroll
            for (int m = 0; m < 4; ++m) { const size_t off = (size_t)(row0 + ai * 128 + m * 16) * D + col0;
#pragma unroll
                for (int bj = 0; bj < 2; ++bj)
#pragma unroll
                    for (int n = 0; n < 2; ++n) { const f32x4 bs = *(const f32x4*)(bi + off + bj * 128 + n * 16); *(f32x4*)(bo + off + bj * 128 + n * 16) = bs + gv[bj][n] * acc[ai][bj][m][n]; } }
    }
};
struct EpiSwiglu {
    static constexpr bool PERM = true, AFTER_DRAIN = false;
    bf16_t* G;
    DI void operator()(const f32x4 (&acc)[2][2][4][2], const pg8::Unit& u, int wr, int wc, int fr, int fq) const {
        const int row0 = u.pm * 256 + wr * 64 + fr, col0 = u.pn * 128 + wc * 32 + 8 * fq;
#pragma unroll
        for (int ai = 0; ai < 2; ++ai)
#pragma unroll
            for (int m = 0; m < 4; ++m) { bf16_t* rowp = G + (size_t)(row0 + ai * 128 + m * 16) * DFF + col0; float g[8];
#pragma unroll
                for (int n = 0; n < 2; ++n) { const f32x4 a = acc[ai][0][m][n], b = acc[ai][1][m][n];
#pragma unroll
                    for (int j = 0; j < 4; ++j) g[4 * n + j] = a[j] * frcp(1.f + fexp(-a[j])) * b[j]; }
                u32x4 w; w.x = pack2(g[0], g[1]); w.y = pack2(g[2], g[3]); w.z = pack2(g[4], g[5]); w.w = pack2(g[6], g[7]); *(u32x4*)rowp = w; }
    }
};
template <class Epi> DI void run_gemm(LAS unsigned char* lds, const bf16_t* A, const bf16_t* Bt, int M, int N, int K, const Epi& E) {
    pg8::Gemm g{A, Bt, M, N, K}; pg8::StaticOrder S; S.init(M, N, (int)gridDim.x, (int)blockIdx.x);
    pg8::gemm_phase<Epi, pg8::StaticOrder, false>((PG8_LAS unsigned char*)lds, g, S, E, nullptr);
    __syncthreads();
}

DI void phase_rwkv_scan_unit(const P& p, LAS unsigned char* ldsb, const int vb) {
    LAS float* lds = (LAS float*)ldsb;
    LAS float *w2s = lds, *a2s = lds + 4096, *prm = lds + 8192, *TH = prm + 768, *AD = TH + 2048, *R = AD + 2048, *W = R + 2048, *K = W + 2048, *KK = K + 2048, *BV = KK + 2048,
              *V = BV + 2048, *BS = V + 2048, *OUT = BS + 32;
    const int tid = mk_tid(), lane = tid & 63, wv = tid >> 6;
    const bf16_t* RW = (const bf16_t*)(p.ws + WS_COLS) + OFF_RW; const bf16_t* LO = (const bf16_t*)(p.ws + WS_COLS) + OFF_LO; bf16_t* Z = (bf16_t*)(p.ws + WS_Z);
    const int srow = tid >> 3, sg = tid & 7;
    {
        const int d = vb >> 5, b = (vb >> 3) & 3, h = vb & 7;
        __syncthreads();
        for (int e = tid; e < 4096; e += NT) { const int i = e >> 6, c = e & 63; w2s[e] = p.in[I_W2L][(size_t)(d * 64 + i) * 512 + 64 * h + c]; a2s[e] = p.in[I_A2L][(size_t)(d * 64 + i) * 512 + 64 * h + c]; }
        if (tid < 64) { const int j = tid, c = 64 * h + j; const float* mu = p.in[I_MU] + d * 1664;
            prm[j] = mu[c]; prm[64 + j] = mu[512 + c]; prm[128 + j] = mu[1024 + c]; prm[192 + j] = mu[1536 + j]; prm[256 + j] = mu[1600 + j];
            prm[320 + j] = p.in[I_W0][d * 512 + c]; prm[384 + j] = p.in[I_A0][d * 512 + c]; prm[448 + j] = p.in[I_KK][d * 512 + c]; prm[512 + j] = p.in[I_KA][d * 512 + c];
            prm[576 + j] = p.in[I_RK][(d * 8 + h) * 64 + j]; prm[640 + j] = p.in[I_LNW][d * 512 + c]; prm[704 + j] = p.in[I_LNB][d * 512 + c]; }
        __syncthreads();
        float S0 = 0.f, S1 = 0.f, S2 = 0.f, S3 = 0.f, S4 = 0.f, S5 = 0.f, S6 = 0.f, S7 = 0.f;
        for (int n0 = 0; n0 < LT; n0 += 32) {
            float rs[4], ks[4], vs[4];
#pragma unroll
            for (int m = 0; m < 4; ++m) { const int s = wv + 8 * m, n = n0 + s; const bool hp = (n != 0) && (n != LC);
                const size_t row = (size_t)step_row(d, b, n), prow = hp ? (size_t)step_row(d, b, n - 1) : row; const int c = 64 * h + lane;
                const float r0 = bf2f(RW[row * 1536 + c]), k0 = bf2f(RW[row * 1536 + 512 + c]), v0 = bf2f(RW[row * 1536 + 1024 + c]);
                const float r1 = hp ? bf2f(RW[prow * 1536 + c]) : 0.f, k1 = hp ? bf2f(RW[prow * 1536 + 512 + c]) : 0.f, v1 = hp ? bf2f(RW[prow * 1536 + 1024 + c]) : 0.f;
                rs[m] = r0 + prm[lane] * (r1 - r0); ks[m] = k0 + prm[64 + lane] * (k1 - k0); vs[m] = v0 + prm[128 + lane] * (v1 - v0);
                const float wd0 = bf2f(LO[row * 512 + 64 * d + lane]), wd1 = hp ? bf2f(LO[prow * 512 + 64 * d + lane]) : 0.f;
                const float ad0 = bf2f(LO[row * 512 + 128 + 64 * d + lane]), ad1 = hp ? bf2f(LO[prow * 512 + 128 + 64 * d + lane]) : 0.f;
                TH[s * 64 + lane] = tanhf(wd0 + prm[192 + lane] * (wd1 - wd0)); AD[s * 64 + lane] = ad0 + prm[256 + lane] * (ad1 - ad0); }
            __syncthreads();
#pragma unroll
            for (int m = 0; m < 4; ++m) { const int s = wv + 8 * m;
                float xw = prm[320 + lane], xa = prm[384 + lane];
#pragma unroll 8
                for (int i = 0; i < 64; ++i) { xw += TH[s * 64 + i] * w2s[i * 64 + lane]; xa += AD[s * 64 + i] * a2s[i * 64 + lane]; }
                const float elog = 0.6065306597126334f * sigm(xw), dec = expf(-elog), a = sigm(xa);
                const float kkr = ks[m] * prm[448 + lane]; const float ss = wave_sum(kkr * kkr); const float kkn = kkr / fmaxf(sqrtf(ss), 1e-12f);
                const float km = ks[m] * (1.f + (a - 1.f) * prm[512 + lane]);
                const float bs = wave_sum(rs[m] * km * prm[576 + lane]);
                R[s * 64 + lane] = rs[m]; W[s * 64 + lane] = dec; K[s * 64 + lane] = km; KK[s * 64 + lane] = kkn; BV[s * 64 + lane] = kkn * a; V[s * 64 + lane] = vs[m];
                if (lane == 0) BS[s] = bs; }
            __syncthreads();
            for (int s = 0; s < 32; ++s) {
                const LAS f32x4* pq = (const LAS f32x4*)(KK + s * 64 + 8 * sg); const f32x4 q0 = pq[0], q1 = pq[1];
                const LAS f32x4* pw = (const LAS f32x4*)(W + s * 64 + 8 * sg); const f32x4 w0 = pw[0], w1 = pw[1];
                const LAS f32x4* pb = (const LAS f32x4*)(BV + s * 64 + 8 * sg); const f32x4 b0 = pb[0], b1 = pb[1];
                const LAS f32x4* pk = (const LAS f32x4*)(K + s * 64 + 8 * sg); const f32x4 k0 = pk[0], k1 = pk[1];
                const LAS f32x4* pr = (const LAS f32x4*)(R + s * 64 + 8 * sg); const f32x4 r0 = pr[0], r1 = pr[1];
                const float vi = V[s * 64 + srow];
                float sa = S0 * q0.x + S1 * q0.y + S2 * q0.z + S3 * q0.w + S4 * q1.x + S5 * q1.y + S6 * q1.z + S7 * q1.w;
                sa += __shfl_xor(sa, 1); sa += __shfl_xor(sa, 2); sa += __shfl_xor(sa, 4);
                S0 = S0 * w0.x - sa * b0.x + vi * k0.x; S1 = S1 * w0.y - sa * b0.y + vi * k0.y; S2 = S2 * w0.z - sa * b0.z + vi * k0.z; S3 = S3 * w0.w - sa * b0.w + vi * k0.w;
                S4 = S4 * w1.x - sa * b1.x + vi * k1.x; S5 = S5 * w1.y - sa * b1.y + vi * k1.y; S6 = S6 * w1.z - sa * b1.z + vi * k1.z; S7 = S7 * w1.w - sa * b1.w + vi * k1.w;
                float o = S0 * r0.x + S1 * r0.y + S2 * r0.z + S3 * r0.w + S4 * r1.x + S5 * r1.y + S6 * r1.z + S7 * r1.w;
                o += __shfl_xor(o, 1); o += __shfl_xor(o, 2); o += __shfl_xor(o, 4);
                if (sg == 0) OUT[s * 64 + srow] = o;
            }
            __syncthreads();
#pragma unroll
            for (int m = 0; m < 4; ++m) { const int s = wv + 8 * m, n = n0 + s; const size_t row = (size_t)step_row(d, b, n);
                const float o = OUT[s * 64 + lane]; const float mean = wave_sum(o) * (1.f / 64.f); const float dv = o - mean; const float var = wave_sum(dv * dv) * (1.f / 64.f);
                const float z = dv * rsqrtf(var + 64e-5f) * prm[640 + lane] + prm[704 + lane] + BS[s] * V[s * 64 + lane];
                Z[((size_t)d * NALL + row) * 512 + 64 * h + lane] = f2bf(z); }
        }
    }
    __syncthreads();
}
DI void phase_rwkv_post(const P& p, LAS unsigned char* ldsb) {
    LAS float* sg = (LAS float*)ldsb;
    const int tid = mk_tid();
    const bf16_t* LO = (const bf16_t*)(p.ws + WS_COLS) + OFF_LO; const bf16_t* Z = (const bf16_t*)(p.ws + WS_Z); bf16_t* Y = (bf16_t*)(p.ws + WS_COLS);
    const float* g2 = p.in[I_G2];
    for (int vb = blockIdx.x; vb < NALL / 8; vb += gridDim.x) {
        const size_t row0 = (size_t)vb * 8;
        __syncthreads();
        for (int e = tid; e < 1024; e += NT) { const int q = e >> 7, r = e & 127; sg[e] = sigm(bf2f(LO[(row0 + q) * 512 + 256 + r])); }
        __syncthreads();
        float a0 = 0.f, a1 = 0.f, a2 = 0.f, a3 = 0.f, a4 = 0.f, a5 = 0.f, a6 = 0.f, a7 = 0.f;
#pragma unroll 4
        for (int r = 0; r < 128; ++r) { const float g = g2[r * 512 + tid];
            a0 += sg[r] * g; a1 += sg[128 + r] * g; a2 += sg[256 + r] * g; a3 += sg[384 + r] * g; a4 += sg[512 + r] * g; a5 += sg[640 + r] * g; a6 += sg[768 + r] * g; a7 += sg[896 + r] * g; }
#define MK_RP(q, aq) { const size_t rr = row0 + q; const float z = bf2f(Z[rr * 512 + tid]) + bf2f(Z[((size_t)NALL + rr) * 512 + tid]); Y[rr * D + tid] = f2bf(z * aq); }
        MK_RP(0, a0) MK_RP(1, a1) MK_RP(2, a2) MK_RP(3, a3) MK_RP(4, a4) MK_RP(5, a5) MK_RP(6, a6) MK_RP(7, a7)
#undef MK_RP
    }
    __syncthreads();
}
DI void post_headnorm_row(const bf16_t* HB, size_t row, const float* ng, const bf16_t* gsrc, int gate_kind, bf16_t* ydst, int lane) {
    const int c0 = 8 * lane;
    const u32x4 h0 = *(const u32x4*)(HB + row * 512 + c0), h1 = *(const u32x4*)(HB + ((size_t)NALL + row) * 512 + c0), gg = *(const u32x4*)(gsrc + c0);
    float h[8], g[8];
#pragma unroll
    for (int j = 0; j < 4; ++j) { h[2 * j] = __uint_as_float(h0[j] << 16) + __uint_as_float(h1[j] << 16); h[2 * j + 1] = __uint_as_float(h0[j] & 0xffff0000u) + __uint_as_float(h1[j] & 0xffff0000u);
        g[2 * j] = __uint_as_float(gg[j] << 16); g[2 * j + 1] = __uint_as_float(gg[j] & 0xffff0000u); }
    float ss = 0.f;
#pragma unroll
    for (int j = 0; j < 8; ++j) ss += h[j] * h[j];
    ss += __shfl_xor(ss, 1); ss += __shfl_xor(ss, 2); ss += __shfl_xor(ss, 4); ss += __shfl_xor(ss, 8);
    const float rinv = rsqrtf(ss * (1.f / 128.f) + 1e-6f);
    unsigned o[4];
#pragma unroll
    for (int j = 0; j < 4; ++j) { const float y0 = h[2 * j] * rinv * ng[c0 + 2 * j] * (gate_kind ? siluf(g[2 * j]) : sigm(g[2 * j])), y1 = h[2 * j + 1] * rinv * ng[c0 + 2 * j + 1] * (gate_kind ? siluf(g[2 * j + 1]) : sigm(g[2 * j + 1]));
        o[j] = pack2(y0, y1); }
    u32x4 w; w.x = o[0]; w.y = o[1]; w.z = o[2]; w.w = o[3];
    *(u32x4*)(ydst + c0) = w;
}
typedef short bf16x8 __attribute__((ext_vector_type(8)));
typedef short s16x4 __attribute__((ext_vector_type(4)));
constexpr int PQ = 136, PS = 72, PV = 56;
constexpr int E_QS = 0, E_KS = E_QS + 64 * PQ * 2, E_VS = E_KS + 64 * PQ * 2, E_PS = E_VS + 64 * PV * 2, E_ST = E_PS + 64 * PS * 2, E_F = E_ST + 48 * PQ * 2, E_END = E_F + 1024;
constexpr size_t WS_Q1 = WS_COLS + (size_t)231 * MiB;
constexpr int NRC = NALL / 64;

DI int chunk_row0(int d, int b, int ci) {
    if (ci < 4) { const int cc = d ? 3 - ci : ci; return NLAT + b * LC + 64 * cc; }
    const int lc = ci - 4, cl = d ? 127 - lc : lc; return b * L + 64 * cl;
}
DI bf16x8 tr_frag(unsigned tile_base, int pitch, int k0, int c0, int r, int q) {
    const unsigned a0 = tile_base + (unsigned)(((k0 + 8 * q + (r >> 2)) * pitch + c0 + 4 * (r & 3)) * 2), a1 = a0 + (unsigned)(4 * pitch * 2);
    s16x4 x, y;
    asm volatile("ds_read_b64_tr_b16 %0, %2\n\tds_read_b64_tr_b16 %1, %3\n\ts_waitcnt lgkmcnt(0)" : "=&v"(x), "=&v"(y) : "v"(a0), "v"(a1) : "memory");
    bf16x8 o; o[0] = x[0]; o[1] = x[1]; o[2] = x[2]; o[3] = x[3]; o[4] = y[0]; o[5] = y[1]; o[6] = y[2]; o[7] = y[3];
    return o;
}

#define GLA_PREFETCH(ci_) do { const int row0_ = chunk_row0(d, b, (ci_)); \
    _Pragma("unroll") for (int i = 0; i < 2; ++i) { const size_t row_ = (size_t)(row0_ + prow0 + 32 * i); \
        rq[i] = *(const u32x4*)(Qg + row_ * ldq + 8 * ppc); rk[i] = *(const u32x4*)(Kg + row_ * ldk + 8 * ppc); } \
    if (tid < 256) rv = *(const u32x4*)(Vg + (size_t)(row0_ + vrow) * ldv + 8 * vpc); \
    if (MODE == 0) { if (tid < 64) { const size_t row_ = (size_t)(row0_ + (d ? 63 - lane : lane)); gi = bf2f(LO[row_ * 512 + 384 + 4 * d + hd]); gf = bf2f(LO[row_ * 512 + 392 + 4 * d + hd]); } } \
    else rlam = *(const f32x4*)(LAM + ((size_t)d * NRC + (row0_ >> 6)) * 512 + 128 * hd + 16 * wv + 4 * q); } while (0)

template <int MODE> DI void gla_unit(const P& p, LAS unsigned char* lds, int unit) {
    constexpr int NDV = MODE == 0 ? 3 : 2;
    const int tid = mk_tid(), lane = tid & 63, wv = __builtin_amdgcn_readfirstlane(tid >> 6), r = lane & 15, q = lane >> 4;
    const int d = unit >> 6, b = (unit >> 4) & 3, hd = (unit >> 2) & 3, sl = unit & 3;
    const bf16_t* COLS = (const bf16_t*)(p.ws + WS_COLS);
    const bf16_t *Qg, *Kg, *Vg; int ldq, ldk, ldv;
    if (MODE == 0) { const bf16_t* ML = COLS + OFF_ML; Qg = ML + 128 * hd; Kg = ML + 512 + 128 * hd; Vg = ML + 1024 + 128 * hd + 32 * sl; ldq = ldk = ldv = 2048; }
    else { Qg = d ? (const bf16_t*)(p.ws + WS_Q1) + 128 * hd : COLS + 128 * hd; ldq = d ? 512 : 3584; Kg = COLS + 512 + 512 * d + 128 * hd; ldk = 3584; Vg = COLS + 1536 + 128 * hd + 32 * sl; ldv = 3584; }
    const bf16_t* LO = COLS + OFF_LO;
    const float* LAM = (const float*)(p.ws + WS_LAM);
    bf16_t* HB = (bf16_t*)(p.ws + WS_ACT);
    LAS bf16_t* Qs = (LAS bf16_t*)(lds + E_QS); LAS bf16_t* Ks = (LAS bf16_t*)(lds + E_KS); LAS bf16_t* Vs = (LAS bf16_t*)(lds + E_VS);
    LAS bf16_t* Ps = (LAS bf16_t*)(lds + E_PS); LAS bf16_t* STs = (LAS bf16_t*)(lds + E_ST); LAS float* Fs = (LAS float*)(lds + E_F);
    const unsigned ks_base = (unsigned)(size_t)Ks, vs_base = (unsigned)(size_t)Vs;
    float bi = 0.f, bfv = 0.f;
    if (MODE == 0) { bi = p.in[I_MBI][d * 4 + hd]; bfv = p.in[I_MBF][d * 4 + hd]; }
    __syncthreads();
    for (int e = tid; e < 48 * PQ / 2; e += NT) ((LAS unsigned*)STs)[e] = 0u;
    for (int e = tid; e < 64 * PV / 2; e += NT) ((LAS unsigned*)Vs)[e] = 0u;
    __syncthreads();
    f32x4 Sacc[NDV];
#pragma unroll
    for (int n = 0; n < NDV; ++n) Sacc[n] = (f32x4){0.f, 0.f, 0.f, 0.f};
    u32x4 rq[2], rk[2], rv = (u32x4){0u, 0u, 0u, 0u}; float gi = 0.f, gf = 0.f; f32x4 rlam = (f32x4){1.f, 1.f, 1.f, 1.f};
    const int prow0 = tid >> 4, ppc = tid & 15;
    const int vrow = tid >> 2, vpc = tid & 3;
    GLA_PREFETCH(0);
    for (int ci = 0; ci < 132; ++ci) {
        const int row0 = chunk_row0(d, b, ci);
        unsigned oz = 0u; asm volatile("" : "+v"(oz));
        const unsigned ks_b = ks_base + oz, vs_b = vs_base + oz;
        f32x4 lamv = rlam;
        if (MODE == 0) {
            if (tid < 64) {
                const float li = gi + bi, x = gf + bfv;
                float v = -log1pf(expf(-x));
#pragma unroll
                for (int o = 1; o < 64; o <<= 1) { const float t = __shfl_up(v, o); if (lane >= o) v += t; }
                const int rc = d ? 63 - lane : lane;
                Fs[rc] = expf(v) * 0.08838834764831845f; Fs[64 + rc] = expf(li - v);
                if (lane == 63) Fs[128] = expf(v);
            }
        }
#pragma unroll
        for (int i = 0; i < 2; ++i) { const int row = prow0 + 32 * i; *(LAS u32x4*)(Qs + row * PQ + 8 * ppc) = rq[i]; *(LAS u32x4*)(Ks + row * PQ + 8 * ppc) = rk[i]; }
        if (MODE == 0) __syncthreads();
        if (tid < 256) {
            if (MODE == 0) { const float w = Fs[64 + vrow]; u32x4 o;
#pragma unroll
                for (int e = 0; e < 4; ++e) o[e] = pack2(__uint_as_float(rv[e] << 16) * w, __uint_as_float(rv[e] & 0xffff0000u) * w);
                *(LAS u32x4*)(Vs + vrow * PV + 8 * vpc) = o;
                if (vpc == 0) Vs[vrow * PV + 32] = f2bf(w); }
            else *(LAS u32x4*)(Vs + vrow * PV + 8 * vpc) = rv;
        }
        __syncthreads();
        if (ci + 1 < 132) GLA_PREFETCH(ci + 1);
        if (MODE == 0) { const float l = Fs[128]; lamv = (f32x4){l, l, l, l}; }
        {
            const int tt = wv & 3, sh = wv >> 2;
            f32x4 pacc[2] = {(f32x4){0.f, 0.f, 0.f, 0.f}, (f32x4){0.f, 0.f, 0.f, 0.f}};
#pragma unroll
            for (int kk = 0; kk < 4; ++kk) { const bf16x8 bq = *(const LAS bf16x8*)(Qs + (16 * tt + r) * PQ + 32 * kk + 8 * q);
#pragma unroll
                for (int i = 0; i < 2; ++i) { const bf16x8 a = *(const LAS bf16x8*)(Ks + (16 * (2 * sh + i) + r) * PQ + 32 * kk + 8 * q); pacc[i] = __builtin_amdgcn_mfma_f32_16x16x32_bf16(a, bq, pacc[i], 0, 0, 0); } }
            const int t = 16 * tt + r;
#pragma unroll
            for (int i = 0; i < 2; ++i) { const int s0 = 16 * (2 * sh + i) + 4 * q; float v[4];
#pragma unroll
                for (int j = 0; j < 4; ++j) { const int s = s0 + j; const bool ok = d ? (s >= t) : (s <= t); v[j] = ok ? pacc[i][j] : 0.f; }
                u32x2 w; w.x = pack2(v[0], v[1]); w.y = pack2(v[2], v[3]); *(LAS u32x2*)(Ps + t * PS + s0) = w; }
        }
#pragma unroll
        for (int kk = 0; kk < 2; ++kk) { const bf16x8 a = tr_frag(ks_b, PQ, 32 * kk, 16 * wv, r, q);
#pragma unroll
            for (int n = 0; n < NDV; ++n) { const bf16x8 bv = tr_frag(vs_b, PV, 32 * kk, 16 * n, r, q); Sacc[n] = __builtin_amdgcn_mfma_f32_16x16x32_bf16(a, bv, Sacc[n], 0, 0, 0); } }
        __syncthreads();
        {
            const int tt = wv & 3, nA = wv >> 2;
            f32x4 oacc = (f32x4){0.f, 0.f, 0.f, 0.f}, dacc = (f32x4){0.f, 0.f, 0.f, 0.f};
#pragma unroll
            for (int kk = 0; kk < 2; ++kk) { const bf16x8 bp = *(const LAS bf16x8*)(Ps + (16 * tt + r) * PS + 32 * kk + 8 * q);
                const bf16x8 a = tr_frag(vs_b, PV, 32 * kk, 16 * nA, r, q); oacc = __builtin_amdgcn_mfma_f32_16x16x32_bf16(a, bp, oacc, 0, 0, 0);
                if (MODE == 0) { const bf16x8 a2 = tr_frag(vs_b, PV, 32 * kk, 32, r, q); dacc = __builtin_amdgcn_mfma_f32_16x16x32_bf16(a2, bp, dacc, 0, 0, 0); } }
#pragma unroll
            for (int kk = 0; kk < 4; ++kk) { const bf16x8 bq = *(const LAS bf16x8*)(Qs + (16 * tt + r) * PQ + 32 * kk + 8 * q);
                const bf16x8 a = *(const LAS bf16x8*)(STs + (16 * nA + r) * PQ + 32 * kk + 8 * q); oacc = __builtin_amdgcn_mfma_f32_16x16x32_bf16(a, bq, oacc, 0, 0, 0);
                if (MODE == 0) { const bf16x8 a2 = *(const LAS bf16x8*)(STs + (32 + r) * PQ + 32 * kk + 8 * q); dacc = __builtin_amdgcn_mfma_f32_16x16x32_bf16(a2, bq, dacc, 0, 0, 0); } }
            const int t = 16 * tt + r;
            float o0 = oacc[0], o1 = oacc[1], o2 = oacc[2], o3 = oacc[3];
            if (MODE == 0) { const float rs = Fs[t]; const float den = __shfl(dacc[0], r) * rs; const float inv = rs / fmaxf(fabsf(den), 1.f); o0 *= inv; o1 *= inv; o2 *= inv; o3 *= inv; }
            u32x2 w; w.x = pack2(o0, o1); w.y = pack2(o2, o3);
            *(u32x2*)(HB + ((size_t)d * NALL + row0 + t) * 512 + 128 * hd + 32 * sl + 16 * nA + 4 * q) = w;
        }
        __syncthreads();
#pragma unroll
        for (int n = 0; n < NDV; ++n) { Sacc[n] = Sacc[n] * lamv; u32x2 w; w.x = pack2(Sacc[n][0], Sacc[n][1]); w.y = pack2(Sacc[n][2], Sacc[n][3]); *(LAS u32x2*)(STs + (16 * n + r) * PQ + 16 * wv + 4 * q) = w; }
    }
    __syncthreads();
}

DI void phase_hgrn_prep(const P& p, LAS unsigned char* ldsb) {
    LAS float* tot = (LAS float*)ldsb;
    const int tid = mk_tid(), ch = tid & 127, qt = tid >> 7;
    bf16_t* C1 = (bf16_t*)(p.ws + WS_COLS); bf16_t* Q1 = (bf16_t*)(p.ws + WS_Q1); float* LAM = (float*)(p.ws + WS_LAM);
    for (int vb = blockIdx.x; vb < NRC * 4; vb += gridDim.x) {
        const int rc = vb >> 2, hd = vb & 3, c = 128 * hd + ch; const size_t rbase = (size_t)rc * 64 + 16 * qt;
        const float lb = sigm(p.in[I_HLB][512 + c] - p.in[I_HLB][c]);
        float qv[16], l0[16], l1[16], k0[16], k1[16];
#pragma unroll
        for (int i = 0; i < 16; ++i) { const bf16_t* base = C1 + (rbase + i) * 3584;
            qv[i] = siluf(bf2f(base[c])); const float s0 = sigm(bf2f(base[512 + c])), s1 = sigm(bf2f(base[1024 + c]));
            l0[i] = logf(lb + (1.f - lb) * s0); l1[i] = logf(lb + (1.f - lb) * s1); k0[i] = (1.f - lb) * (1.f - s0); k1[i] = (1.f - lb) * (1.f - s1); }
#pragma unroll
        for (int i = 1; i < 16; ++i) l0[i] += l0[i - 1];
#pragma unroll
        for (int i = 14; i >= 0; --i) l1[i] += l1[i + 1];
        __syncthreads();
        tot[qt * 128 + ch] = l0[15]; tot[512 + qt * 128 + ch] = l1[0];
        __syncthreads();
        float off0 = 0.f, off1 = 0.f, t0 = 0.f, t1 = 0.f;
#pragma unroll
        for (int j = 0; j < 4; ++j) { const float a = tot[j * 128 + ch], bb = tot[512 + j * 128 + ch]; t0 += a; t1 += bb; if (j < qt) off0 += a; if (j > qt) off1 += bb; }
#pragma unroll
        for (int i = 0; i < 16; ++i) { bf16_t* base = C1 + (rbase + i) * 3584; const float c0 = l0[i] + off0, c1 = l1[i] + off1;
            base[c] = f2bf(qv[i] * expf(c0)); base[512 + c] = f2bf(k0[i] * expf(-c0)); base[1024 + c] = f2bf(k1[i] * expf(-c1)); Q1[(rbase + i) * 512 + c] = f2bf(qv[i] * expf(c1)); }
        if (qt == 0) { LAM[((size_t)rc) * 512 + c] = expf(t0); LAM[((size_t)NRC + rc) * 512 + c] = expf(t1); }
    }
    __syncthreads();
}
DI float flog(float x) { return __builtin_amdgcn_logf(x) * 0.6931471805599453f; }
DI void phase_hgrn_prep2(const P& p, LAS unsigned char* ldsb) {
    LAS float* tot = (LAS float*)ldsb;
    const int tid = mk_tid(), cp = tid & 63, qt = (tid >> 6) & 3, rs = tid >> 8, c0 = 8 * cp;
    bf16_t* C1 = (bf16_t*)(p.ws + WS_COLS); bf16_t* Q1 = (bf16_t*)(p.ws + WS_Q1); float* LAM = (float*)(p.ws + WS_LAM);
    float lb[8], omlb[8];
#pragma unroll
    for (int k = 0; k < 8; ++k) { lb[k] = fsigm(p.in[I_HLB][512 + c0 + k] - p.in[I_HLB][c0 + k]); omlb[k] = 1.f - lb[k]; }
    for (int vb = blockIdx.x; vb < NRC / 2; vb += gridDim.x) {
        const int rc = 2 * vb + rs; const size_t rbase = (size_t)rc * 64 + 16 * qt;
        float s0[8], s1[8];
#pragma unroll
        for (int k = 0; k < 8; ++k) { s0[k] = 0.f; s1[k] = 0.f; }
#pragma unroll 4
        for (int i = 0; i < 16; ++i) { const bf16_t* base = C1 + (rbase + i) * 3584; const u32x4 f0 = *(const u32x4*)(base + 512 + c0), f1 = *(const u32x4*)(base + 1024 + c0);
#pragma unroll
            for (int k = 0; k < 4; ++k) { s0[2 * k] += flog(lb[2 * k] + omlb[2 * k] * fsigm(__uint_as_float(f0[k] << 16))); s0[2 * k + 1] += flog(lb[2 * k + 1] + omlb[2 * k + 1] * fsigm(__uint_as_float(f0[k] & 0xffff0000u)));
                s1[2 * k] += flog(lb[2 * k] + omlb[2 * k] * fsigm(__uint_as_float(f1[k] << 16))); s1[2 * k + 1] += flog(lb[2 * k + 1] + omlb[2 * k + 1] * fsigm(__uint_as_float(f1[k] & 0xffff0000u))); } }
        __syncthreads();
#pragma unroll
        for (int k = 0; k < 8; k += 4) { *(LAS f32x4*)(tot + ((rs * 2 + 0) * 4 + qt) * 512 + c0 + k) = (f32x4){s0[k], s0[k + 1], s0[k + 2], s0[k + 3]}; *(LAS f32x4*)(tot + ((rs * 2 + 1) * 4 + qt) * 512 + c0 + k) = (f32x4){s1[k], s1[k + 1], s1[k + 2], s1[k + 3]}; }
        __syncthreads();
        float run0[8], run1[8], t0[8], t1[8];
#pragma unroll
        for (int k = 0; k < 8; ++k) { run0[k] = 0.f; run1[k] = 0.f; t0[k] = 0.f; t1[k] = 0.f; }
#pragma unroll
        for (int j = 0; j < 4; ++j)
#pragma unroll
            for (int k = 0; k < 8; ++k) { const float a = tot[((rs * 2 + 0) * 4 + j) * 512 + c0 + k], bb = tot[((rs * 2 + 1) * 4 + j) * 512 + c0 + k]; t0[k] += a; t1[k] += bb; if (j < qt) run0[k] += a; if (j >= qt) run1[k] += bb; }
        if (qt == 0) {
#pragma unroll
            for (int k = 0; k < 8; k += 4) { *(f32x4*)(LAM + (size_t)rc * 512 + c0 + k) = (f32x4){fexp(t0[k]), fexp(t0[k + 1]), fexp(t0[k + 2]), fexp(t0[k + 3])};
                *(f32x4*)(LAM + ((size_t)NRC + rc) * 512 + c0 + k) = (f32x4){fexp(t1[k]), fexp(t1[k + 1]), fexp(t1[k + 2]), fexp(t1[k + 3])}; } }
#pragma unroll 2
        for (int i = 0; i < 16; ++i) { bf16_t* base = C1 + (rbase + i) * 3584; const u32x4 qv = *(const u32x4*)(base + c0), f0 = *(const u32x4*)(base + 512 + c0), f1 = *(const u32x4*)(base + 1024 + c0);
            float oq0[8], ok0[8], ok1[8], oq1[8];
#pragma unroll
            for (int k = 0; k < 8; ++k) { const unsigned wq = qv[k >> 1], w0 = f0[k >> 1], w1 = f1[k >> 1];
                const float qx = (k & 1) ? __uint_as_float(wq & 0xffff0000u) : __uint_as_float(wq << 16), x0 = (k & 1) ? __uint_as_float(w0 & 0xffff0000u) : __uint_as_float(w0 << 16), x1 = (k & 1) ? __uint_as_float(w1 & 0xffff0000u) : __uint_as_float(w1 << 16);
                const float sq = qx * fsigm(qx), sg0 = fsigm(x0), sg1 = fsigm(x1);
                const float l0 = flog(lb[k] + omlb[k] * sg0), l1 = flog(lb[k] + omlb[k] * sg1);
                run0[k] += l0;
                const float cb = run1[k];
                run1[k] -= l1;
                const float e0 = fexp(run0[k]), e1 = fexp(cb);
                oq0[k] = sq * e0; ok0[k] = omlb[k] * (1.f - sg0) * frcp(e0); ok1[k] = omlb[k] * (1.f - sg1) * frcp(e1); oq1[k] = sq * e1; }
            u32x4 w; w.x = pack2(oq0[0], oq0[1]); w.y = pack2(oq0[2], oq0[3]); w.z = pack2(oq0[4], oq0[5]); w.w = pack2(oq0[6], oq0[7]); *(u32x4*)(base + c0) = w;
            w.x = pack2(ok0[0], ok0[1]); w.y = pack2(ok0[2], ok0[3]); w.z = pack2(ok0[4], ok0[5]); w.w = pack2(ok0[6], ok0[7]); *(u32x4*)(base + 512 + c0) = w;
            w.x = pack2(ok1[0], ok1[1]); w.y = pack2(ok1[2], ok1[3]); w.z = pack2(ok1[4], ok1[5]); w.w = pack2(ok1[6], ok1[7]); *(u32x4*)(base + 1024 + c0) = w;
            w.x = pack2(oq1[0], oq1[1]); w.y = pack2(oq1[2], oq1[3]); w.z = pack2(oq1[4], oq1[5]); w.w = pack2(oq1[6], oq1[7]); *(u32x4*)(Q1 + (rbase + i) * 512 + c0) = w; }
    }
    __syncthreads();
}
constexpr int M_XB = 0, M_XCS = M_XB + 67 * 64 * 4, M_XCF = M_XCS + 64 * 72 * 2, M_W = M_XCF + 64 * 64 * 4, M_AU = M_W + 4 * 64 * 72 * 2, M_SEG = M_AU + 4 * 64 * 65 * 4, M_PRM = M_SEG + 4 * 8 * 64 * 4,
              M_CAR = M_PRM + 11 * 64 * 4, M_END = M_CAR + 2 * 64 * 4;
static_assert(M_END <= LDS_BYTES, "lru LDS map");
DI float nexpm1_small(float x) { const float ser = -x * (1.f + x * 0.5f * (1.f + x * (1.f / 3.f) * (1.f + x * 0.25f * (1.f + x * 0.2f)))); return (x > -0.25f) ? ser : 1.f - fexp(x); }
DI int lru_rc_at(int d, int b, int s) { if (s < 4) return 512 + 4 * b + (d ? 3 - s : s); const int lc = s - 4; return 128 * b + (d ? 127 - lc : lc); }
template <int PASS> DI void lru_pass(const P& p, LAS unsigned char* lds, const int lb, const int nlb) {
    const int tid = mk_tid(), lane = tid & 63, wv = __builtin_amdgcn_readfirstlane(tid >> 6), r = lane & 15, q = lane >> 4;
    const int hb = lb & 7;
    const bf16_t* C1 = (const bf16_t*)(p.ws + WS_COLS); bf16_t* Y = (bf16_t*)(p.ws + WS_Z); float* LSUM = (float*)(p.ws + WS_LSUM);
    LAS float* XB = (LAS float*)(lds + M_XB); LAS bf16_t* XCs = (LAS bf16_t*)(lds + M_XCS); LAS float* XCf = (LAS float*)(lds + M_XCF); LAS bf16_t* Wt = (LAS bf16_t*)(lds + M_W);
    LAS float* AU = (LAS float*)(lds + M_AU);
    LAS float* SEG = (LAS float*)(lds + M_SEG);
    LAS float* prm = (LAS float*)(lds + M_PRM);
    LAS float* CAR = (LAS float*)(lds + M_CAR);
    __syncthreads();
    for (int e = tid; e < 4 * 4096; e += NT) { const int g = e >> 12, i = (e >> 6) & 63, j = e & 63, d = g >> 1; const size_t o = ((size_t)(d * 8 + hb) * 64 + i) * 64 + j;
        Wt[(g * 64 + j) * 72 + i] = f2bf((g & 1) ? p.in[I_WI][o] : p.in[I_WA][o]); }
    if (tid < 64) { const int ch = 64 * hb + tid;
        prm[tid] = p.in[I_CONVW][ch]; prm[64 + tid] = p.in[I_CONVW][512 + ch]; prm[128 + tid] = p.in[I_CONVW][1024 + ch]; prm[192 + tid] = p.in[I_CONVW][1536 + ch]; prm[256 + tid] = p.in[I_CONVB][ch];
        prm[320 + tid] = p.in[I_BA][ch]; prm[384 + tid] = p.in[I_BA][512 + ch]; prm[448 + tid] = p.in[I_BI][ch]; prm[512 + tid] = p.in[I_BI][512 + ch];
        prm[576 + tid] = log1pf(expf(-p.in[I_LAM][ch])); prm[640 + tid] = log1pf(expf(-p.in[I_LAM][512 + ch])); }
    const int nrc = (PASS == 1) ? NRC : 512;
    const int cpr = (PASS == 3) ? 512 / (nlb >> 3) : 1, rc_lo = (PASS == 3) ? (lb >> 3) * cpr : (lb >> 3), rstep = (PASS == 3) ? 1 : (nlb >> 3), rc_hi = (PASS == 3) ? rc_lo + cpr : nrc;
    float* LCAR = (float*)(p.ws + WS_LCAR);
    if (PASS == 3 && tid < 128) { const int d = tid >> 6, j = tid & 63, ch = 64 * hb + j, b = rc_lo >> 7, cl0 = rc_lo & 127;
        const int p_lo = d ? 4 + 127 - (cl0 + cpr - 1) : 4 + cl0;
        const float* S = LSUM + (size_t)d * NRC * 1024 + 2 * ch; float hcar = 0.f;
#pragma unroll 8
        for (int s = 0; s < p_lo; ++s) { const float* e2 = S + (size_t)lru_rc_at(d, b, s) * 1024; hcar = e2[0] * hcar + e2[1]; }
        for (int s = p_lo; s < p_lo + cpr; ++s) { const int rcs = lru_rc_at(d, b, s); LCAR[((size_t)d * NRC + rcs) * 512 + ch] = hcar; const float* e2 = S + (size_t)rcs * 1024; hcar = e2[0] * hcar + e2[1]; }
    }
    u32x4 px[2];
#define LRU_PREFETCH(rc_) do { const int rc__ = (rc_); const int row0_ = rc__ * 64; const int seg_lo_ = (rc__ >= 512) ? NLAT + ((rc__ - 512) >> 2) * LC : (rc__ >> 7) * L, seg_hi_ = seg_lo_ + ((rc__ >= 512) ? LC : L); \
    _Pragma("unroll") for (int i = 0; i < 2; ++i) { const int e = tid + 512 * i, rr = e >> 3, pc = e & 7, grow = row0_ - 2 + rr; px[i] = (u32x4){0u, 0u, 0u, 0u}; \
        if (e < 67 * 8 && grow >= seg_lo_ && grow < seg_hi_) px[i] = *(const u32x4*)(C1 + (size_t)grow * C1LD + 2560 + 64 * hb + 8 * pc); } } while (0)
    int rc = rc_lo;
    if (rc < rc_hi) LRU_PREFETCH(rc);
    for (; rc < rc_hi; rc += rstep) {
        const int row0 = rc * 64;
        const int sg = tid >> 6, j = lane, ch = 64 * hb + j;
        float cin = 0.f;
        if (PASS == 3 && tid < 128) cin = LCAR[((size_t)(tid >> 6) * NRC + rc) * 512 + ch];
        float gbv[8];
        if (PASS == 3) {
#pragma unroll
            for (int k = 0; k < 8; ++k) gbv[k] = bf2f(C1[(size_t)(row0 + 8 * sg + k) * C1LD + 3072 + ch]); }
#pragma unroll
        for (int i = 0; i < 2; ++i) { const int e = tid + 512 * i; if (e < 67 * 8) { const int rr = e >> 3, pc = e & 7; const u32x4 v = px[i];
            f32x4 lo, hi; lo[0] = __uint_as_float(v[0] << 16); lo[1] = __uint_as_float(v[0] & 0xffff0000u); lo[2] = __uint_as_float(v[1] << 16); lo[3] = __uint_as_float(v[1] & 0xffff0000u);
            hi[0] = __uint_as_float(v[2] << 16); hi[1] = __uint_as_float(v[2] & 0xffff0000u); hi[2] = __uint_as_float(v[3] << 16); hi[3] = __uint_as_float(v[3] & 0xffff0000u);
            *(LAS f32x4*)(XB + rr * 64 + 8 * pc) = lo; *(LAS f32x4*)(XB + rr * 64 + 8 * pc + 4) = hi; } }
        if (PASS == 3 && tid < 128) CAR[tid] = cin;
        __syncthreads();
        if (rc + rstep < rc_hi) LRU_PREFETCH(rc + rstep);
        {
            const int t = tid >> 3, i0 = 8 * (tid & 7); float xc[8];
#pragma unroll
            for (int c = 0; c < 8; ++c) { const int i = i0 + c; xc[c] = prm[256 + i] + prm[i] * XB[t * 64 + i] + prm[64 + i] * XB[(t + 1) * 64 + i] + prm[128 + i] * XB[(t + 2) * 64 + i] + prm[192 + i] * XB[(t + 3) * 64 + i]; XCf[t * 64 + i] = xc[c]; }
            u32x4 w; w.x = pack2(xc[0], xc[1]); w.y = pack2(xc[2], xc[3]); w.z = pack2(xc[4], xc[5]); w.w = pack2(xc[6], xc[7]);
            *(LAS u32x4*)(XCs + t * 72 + i0) = w;
        }
        __syncthreads();
        {
            const int jt = wv & 3, th = wv >> 2, jc = 16 * jt + r;
#pragma unroll
            for (int d = 0; d < 2; ++d) { const float ba = prm[320 + 64 * d + jc], bi = prm[448 + 64 * d + jc], spl = prm[576 + 64 * d + jc];
#pragma unroll
                for (int i2 = 0; i2 < 2; ++i2) { const int tt = 2 * th + i2;
                    f32x4 aa = (f32x4){0.f, 0.f, 0.f, 0.f}, ai = (f32x4){0.f, 0.f, 0.f, 0.f};
#pragma unroll
                    for (int kk = 0; kk < 2; ++kk) { const bf16x8 xf = *(const LAS bf16x8*)(XCs + (16 * tt + r) * 72 + 32 * kk + 8 * q);
                        const bf16x8 wa = *(const LAS bf16x8*)(Wt + ((2 * d) * 64 + 16 * jt + r) * 72 + 32 * kk + 8 * q), wi = *(const LAS bf16x8*)(Wt + ((2 * d + 1) * 64 + 16 * jt + r) * 72 + 32 * kk + 8 * q);
                        aa = __builtin_amdgcn_mfma_f32_16x16x32_bf16(xf, wa, aa, 0, 0, 0); ai = __builtin_amdgcn_mfma_f32_16x16x32_bf16(xf, wi, ai, 0, 0, 0); }
#pragma unroll
                    for (int jj = 0; jj < 4; ++jj) { const int t = 16 * tt + 4 * q + jj;
                        const float rg = fsigm(aa[jj] + ba), ig = fsigm(ai[jj] + bi), la = -8.f * rg * spl;
                        AU[((2 * d) * 64 + t) * 65 + jc] = 1.f - nexpm1_small(la); AU[((2 * d + 1) * 64 + t) * 65 + jc] = sqrtf(nexpm1_small(2.f * la)) * (ig * XCf[t * 64 + jc]); } } }
        }
        __syncthreads();
        const LAS float* A0 = AU + (8 * sg) * 65 + j; const LAS float* U0 = AU + (64 + 8 * sg) * 65 + j; const LAS float* A1 = AU + (128 + 8 * sg) * 65 + j; const LAS float* U1 = AU + (192 + 8 * sg) * 65 + j;
        {
            float p0 = 1.f, h0 = 0.f, p1 = 1.f, h1 = 0.f;
#pragma unroll
            for (int k = 0; k < 8; ++k) { const float a = A0[k * 65]; h0 = a * h0 + U0[k * 65]; p0 *= a; }
#pragma unroll
            for (int k = 7; k >= 0; --k) { const float a = A1[k * 65]; h1 = a * h1 + U1[k * 65]; p1 *= a; }
            SEG[(0 * 8 + sg) * 64 + j] = p0; SEG[(1 * 8 + sg) * 64 + j] = h0; SEG[(2 * 8 + sg) * 64 + j] = p1; SEG[(3 * 8 + sg) * 64 + j] = h1;
        }
        __syncthreads();
        if (PASS == 1) {
            if (tid < 128) { const int d = tid >> 6; float pa = 1.f, hh = 0.f;
#pragma unroll
                for (int s2 = 0; s2 < 8; ++s2) { const int sgi = d ? 7 - s2 : s2; const float ps = SEG[((2 * d) * 8 + sgi) * 64 + j], hs = SEG[((2 * d + 1) * 8 + sgi) * 64 + j]; hh = ps * hh + hs; pa *= ps; }
                float* o = LSUM + ((size_t)d * NRC + rc) * 1024 + 2 * ch; o[0] = pa; o[1] = hh; }
        } else {
            float hf = CAR[j], hbk = CAR[64 + j];
            for (int s2 = 0; s2 < sg; ++s2) hf = SEG[(0 * 8 + s2) * 64 + j] * hf + SEG[(1 * 8 + s2) * 64 + j];
            for (int s2 = 7; s2 > sg; --s2) hbk = SEG[(2 * 8 + s2) * 64 + j] * hbk + SEG[(3 * 8 + s2) * 64 + j];
            float of[8];
#pragma unroll
            for (int k = 0; k < 8; ++k) { hf = A0[k * 65] * hf + U0[k * 65]; of[k] = hf; }
#pragma unroll
            for (int k = 7; k >= 0; --k) { hbk = A1[k * 65] * hbk + U1[k * 65]; of[k] += hbk; }
#pragma unroll
            for (int k = 0; k < 8; ++k) Y[(size_t)nat_row(row0 + 8 * sg + k) * D + 512 + ch] = f2bf(of[k] * fgelu(gbv[k]));
        }
        __syncthreads();
    }
#undef LRU_PREFETCH
}
constexpr int PT = 72, PM = 40;
constexpr int C_PRM = 0, C_GAM = C_PRM + 3072, C_MISC = C_GAM + 1024, C_SBF = C_MISC + 1280, C_TILES = C_SBF + 2 * 64 * PT * 2, C_TH = C_TILES + 5 * 80 * PT * 2, C_MBF = C_TH + 2 * 64 * PT * 2,
              C_SM = C_MBF + 4 * 16 * 20 * 4, C_W1T = C_SM + 4 * 4 * 16 * PM * 2, C_AH = C_W1T + 4 * 64 * PM * 2, C_YV = C_AH + 4 * 16 * PT * 2, C_END = C_YV + 64 * PM * 2;
static_assert(C_END <= LDS_BYTES, "rwkv chunk LDS map");
DI void unpack4(u32x2 v, float* o) { o[0] = __uint_as_float(v.x << 16); o[1] = __uint_as_float(v.x & 0xffff0000u); o[2] = __uint_as_float(v.y << 16); o[3] = __uint_as_float(v.y & 0xffff0000u); }
DI u32x2 pack4(float a, float b, float c, float d) { u32x2 w; w.x = pack2(a, b); w.y = pack2(c, d); return w; }
DI bf16x8 zero_if(bf16x8 v, bool z) { const bf16x8 zz = {0, 0, 0, 0, 0, 0, 0, 0}; return z ? zz : v; }

constexpr int RING_SLOTS = 4, SLOT_U64 = 5632;
constexpr size_t WS_RING = WS_Z1;
DI void wait_ge(unsigned* word, unsigned want) {
    unsigned spins = 0;
    while ((unsigned)__builtin_amdgcn_readfirstlane((int)__hip_atomic_load(word, __ATOMIC_RELAXED, __HIP_MEMORY_SCOPE_AGENT)) < want) { __builtin_amdgcn_s_sleep(2); if (++spins > (1u << 21)) break; }
    __builtin_amdgcn_fence(__ATOMIC_ACQUIRE, "agent");
    asm volatile("s_waitcnt vmcnt(0)" ::: "memory");
}
template <int ROLE> DI void rwkv_chunk_unit(const P& p, LAS unsigned char* lds, const int vb) {
    const int tid = mk_tid(), lane = tid & 63, wv = __builtin_amdgcn_readfirstlane(tid >> 6), r = lane & 15, q = lane >> 4;
    const int d = vb >> 5, b = (vb >> 3) & 3, h = vb & 7;
    const bf16_t* RW = (const bf16_t*)(p.ws + WS_COLS) + OFF_RW; const bf16_t* LO = (const bf16_t*)(p.ws + WS_COLS) + OFF_LO; bf16_t* Z = (bf16_t*)(p.ws + WS_Z);
    unsigned long long* ring = (unsigned long long*)(p.ws + WS_RING) + (size_t)vb * RING_SLOTS * SLOT_U64;
    unsigned* READY = (unsigned*)(p.ws + WS_CTL) + 64 * vb; unsigned* ACK = (unsigned*)(p.ws + WS_CTL) + 64 * (64 + vb);
    LAS float* prm = (LAS float*)(lds + C_PRM); LAS float* GAM = (LAS float*)(lds + C_GAM); LAS float* SSQ = (LAS float*)(lds + C_MISC); LAS float* BSP = SSQ + 128; LAS float* BS = SSQ + 256;
    LAS bf16_t* Sbf = (LAS bf16_t*)(lds + C_SBF);
    LAS bf16_t* At = (LAS bf16_t*)(lds + C_TILES); LAS bf16_t* Rt = At + 80 * PT; LAS bf16_t* Bt = Rt + 80 * PT; LAS bf16_t* Kt = Bt + 80 * PT; LAS bf16_t* Vt = Kt + 80 * PT;
    LAS bf16_t* TH = (LAS bf16_t*)(lds + C_TH); LAS bf16_t* AD = TH + 64 * PT; LAS float* OUT = (LAS float*)(lds + C_TH);
    LAS float* MBf = (LAS float*)(lds + C_MBF);
    LAS bf16_t* MK = (LAS bf16_t*)(lds + C_SM); LAS bf16_t* NK = MK + 4 * 16 * PM; LAS bf16_t* NB = NK + 4 * 16 * PM; LAS bf16_t* DNV = NB + 4 * 16 * PM;
    LAS bf16_t* W1T = (LAS bf16_t*)(lds + C_W1T); LAS bf16_t* AH = (LAS bf16_t*)(lds + C_AH); LAS bf16_t* YV = (LAS bf16_t*)(lds + C_YV);
    const unsigned at_b = (unsigned)(size_t)At, bt_b = (unsigned)(size_t)Bt, kt_b = (unsigned)(size_t)Kt, vt_b = (unsigned)(size_t)Vt;
    __syncthreads();
    for (int e = tid; e < (C_END - C_SBF) / 4; e += NT) ((LAS unsigned*)(lds + C_SBF))[e] = 0u;
    if (tid < 64) { const int j = tid, c = 64 * h + j; const float* mu = p.in[I_MU] + d * 1664;
        prm[j] = mu[c]; prm[64 + j] = mu[512 + c]; prm[128 + j] = mu[1024 + c]; prm[192 + j] = mu[1536 + j]; prm[256 + j] = mu[1600 + j];
        prm[320 + j] = p.in[I_W0][d * 512 + c]; prm[384 + j] = p.in[I_A0][d * 512 + c]; prm[448 + j] = p.in[I_KK][d * 512 + c]; prm[512 + j] = p.in[I_KA][d * 512 + c];
        prm[576 + j] = p.in[I_RK][(d * 8 + h) * 64 + j]; prm[640 + j] = p.in[I_LNW][d * 512 + c]; prm[704 + j] = p.in[I_LNB][d * 512 + c]; }
    const int m1 = wv & 3, h2 = wv >> 2;
    bf16x8 fw2[2][2], fa2[2][2];
#pragma unroll
    for (int t = 0; t < 2; ++t)
#pragma unroll
        for (int kk = 0; kk < 2; ++kk) { const int c = 64 * h + 16 * (2 * h2 + t) + r;
            const float* w2p = p.in[I_W2L] + (size_t)(d * 64 + 32 * kk + 8 * q) * 512 + c; const float* a2p = p.in[I_A2L] + (size_t)(d * 64 + 32 * kk + 8 * q) * 512 + c;
#pragma unroll
            for (int e = 0; e < 8; ++e) { fw2[t][kk][e] = (short)f2bf(w2p[e * 512]); fa2[t][kk][e] = (short)f2bf(a2p[e * 512]); }
            asm volatile("" ::: "memory"); }
    f32x4 Sacc[2] = {(f32x4){0.f, 0.f, 0.f, 0.f}, (f32x4){0.f, 0.f, 0.f, 0.f}};
    int cur = 0;
    unsigned long long pf[11]; bool pf_ok = false;
    u32x2 gc[2][5], gp[2][5];
#define RWKV_LOAD(n0x) do { const int n1_ = (n0x) + 16 * m1 + r; const bool hp_ = (n1_ != 0) && (n1_ != LC); const size_t row_ = (size_t)step_row(d, b, n1_), prow_ = hp_ ? (size_t)step_row(d, b, n1_ - 1) : row_; \
    _Pragma("unroll") for (int t = 0; t < 2; ++t) { const int cb_ = 32 * h2 + 16 * t + 4 * q; \
        gc[t][0] = *(const u32x2*)(RW + row_ * 1536 + 64 * h + cb_); gc[t][1] = *(const u32x2*)(RW + row_ * 1536 + 512 + 64 * h + cb_); gc[t][2] = *(const u32x2*)(RW + row_ * 1536 + 1024 + 64 * h + cb_); \
        gc[t][3] = *(const u32x2*)(LO + row_ * 512 + 64 * d + cb_); gc[t][4] = *(const u32x2*)(LO + row_ * 512 + 128 + 64 * d + cb_); \
        gp[t][0] = *(const u32x2*)(RW + prow_ * 1536 + 64 * h + cb_); gp[t][1] = *(const u32x2*)(RW + prow_ * 1536 + 512 + 64 * h + cb_); gp[t][2] = *(const u32x2*)(RW + prow_ * 1536 + 1024 + 64 * h + cb_); \
        gp[t][3] = *(const u32x2*)(LO + prow_ * 512 + 64 * d + cb_); gp[t][4] = *(const u32x2*)(LO + prow_ * 512 + 128 + 64 * d + cb_); } } while (0)
    if (ROLE != 1) RWKV_LOAD(0);
    __syncthreads();
    for (int n0 = 0; n0 < LT; n0 += 64) {
        if (ROLE != 1) for (int rep0 = 0; rep0 < (MK_RDUP == 0 ? 2 : 1); ++rep0) {
        const int u1 = 16 * m1 + r, n1 = n0 + u1; const bool hp = (n1 != 0) && (n1 != LC);
        float rs[8], ks[8], vs[8];
#pragma unroll
        for (int t = 0; t < 2; ++t) { const int cb = 32 * h2 + 16 * t + 4 * q;
            float a0[4], a1[4];
#define RW_SHIFT(dst, idx, muo) { unpack4(gc[t][idx], a0); if (hp) unpack4(gp[t][idx], a1); else { a1[0] = a1[1] = a1[2] = a1[3] = 0.f; } \
            const f32x4 mu4 = *(const LAS f32x4*)(prm + (muo) + cb); _Pragma("unroll") for (int jj = 0; jj < 4; ++jj) dst[4 * t + jj] = a0[jj] + mu4[jj] * (a1[jj] - a0[jj]); }
            RW_SHIFT(rs, 0, 0) RW_SHIFT(ks, 1, 64) RW_SHIFT(vs, 2, 128)
#undef RW_SHIFT
            float th[4], ad[4];
            { unpack4(gc[t][3], a0); if (hp) unpack4(gp[t][3], a1); else { a1[0] = a1[1] = a1[2] = a1[3] = 0.f; }
              const f32x4 mu4 = *(const LAS f32x4*)(prm + 192 + cb);
#pragma unroll
              for (int jj = 0; jj < 4; ++jj) th[jj] = ftanh(a0[jj] + mu4[jj] * (a1[jj] - a0[jj])); }
            { unpack4(gc[t][4], a0); if (hp) unpack4(gp[t][4], a1); else { a1[0] = a1[1] = a1[2] = a1[3] = 0.f; }
              const f32x4 mu4 = *(const LAS f32x4*)(prm + 256 + cb);
#pragma unroll
              for (int jj = 0; jj < 4; ++jj) ad[jj] = a0[jj] + mu4[jj] * (a1[jj] - a0[jj]); }
            *(LAS u32x2*)(TH + u1 * PT + cb) = pack4(th[0], th[1], th[2], th[3]); *(LAS u32x2*)(AD + u1 * PT + cb) = pack4(ad[0], ad[1], ad[2], ad[3]);
            asm volatile("" ::: "memory");
        }
        __syncthreads();
        float elog[8], av[8], kkr[8], km[8]; float ssq = 0.f, bsp = 0.f;
#pragma unroll
        for (int t = 0; t < 2; ++t) { const int cb = 32 * h2 + 16 * t + 4 * q;
            f32x4 xw = (f32x4){0.f, 0.f, 0.f, 0.f}, xa = (f32x4){0.f, 0.f, 0.f, 0.f};
#pragma unroll
            for (int kk = 0; kk < 2; ++kk) { const bf16x8 bt = *(const LAS bf16x8*)(TH + u1 * PT + 32 * kk + 8 * q), ba = *(const LAS bf16x8*)(AD + u1 * PT + 32 * kk + 8 * q);
                xw = __builtin_amdgcn_mfma_f32_16x16x32_bf16(fw2[t][kk], bt, xw, 0, 0, 0); xa = __builtin_amdgcn_mfma_f32_16x16x32_bf16(fa2[t][kk], ba, xa, 0, 0, 0); }
            const f32x4 w04 = *(const LAS f32x4*)(prm + 320 + cb), a04 = *(const LAS f32x4*)(prm + 384 + cb), kk4 = *(const LAS f32x4*)(prm + 448 + cb), ka4 = *(const LAS f32x4*)(prm + 512 + cb), rk4 = *(const LAS f32x4*)(prm + 576 + cb);
#pragma unroll
            for (int jj = 0; jj < 4; ++jj) { const int e = 4 * t + jj;
                elog[e] = 0.6065306597126334f * fsigm(xw[jj] + w04[jj]); av[e] = fsigm(xa[jj] + a04[jj]);
                kkr[e] = ks[e] * kk4[jj]; ssq += kkr[e] * kkr[e]; km[e] = ks[e] * (1.f + (av[e] - 1.f) * ka4[jj]); bsp += rs[e] * km[e] * rk4[jj]; }
            asm volatile("" ::: "memory");
        }
        ssq += __shfl_xor(ssq, 16); ssq += __shfl_xor(ssq, 32); bsp += __shfl_xor(bsp, 16); bsp += __shfl_xor(bsp, 32);
        if (q == 0) { SSQ[h2 * 64 + u1] = ssq; BSP[h2 * 64 + u1] = bsp; }
        __syncthreads();
        {
            const float tot = SSQ[u1] + SSQ[64 + u1]; const float inv = 1.f / fmaxf(sqrtf(tot), 1e-12f);
            if (h2 == 0 && q == 0) BS[u1] = BSP[u1] + BSP[64 + u1];
#pragma unroll
            for (int t = 0; t < 2; ++t) { const int cb = 32 * h2 + 16 * t + 4 * q; float al[4], be[4], ka[4], rh[4];
#pragma unroll
                for (int jj = 0; jj < 4; ++jj) { const int e = 4 * t + jj;
                    const float g = scan16(-elog[e]);
                    const float ep = fexp(g), em = frcp(ep), epp = fexp(g + elog[e]);
                    const float kk = kkr[e] * inv;
                    al[jj] = kk * epp; be[jj] = kk * av[e] * em; ka[jj] = km[e] * em; rh[jj] = rs[e] * ep;
                    if (r == 15) GAM[m1 * 64 + cb + jj] = ep; }
                *(LAS u32x2*)(At + u1 * PT + cb) = pack4(al[0], al[1], al[2], al[3]); *(LAS u32x2*)(Bt + u1 * PT + cb) = pack4(be[0], be[1], be[2], be[3]);
                *(LAS u32x2*)(Kt + u1 * PT + cb) = pack4(ka[0], ka[1], ka[2], ka[3]); *(LAS u32x2*)(Rt + u1 * PT + cb) = pack4(rh[0], rh[1], rh[2], rh[3]);
                *(LAS u32x2*)(Vt + u1 * PT + cb) = pack4(vs[4 * t], vs[4 * t + 1], vs[4 * t + 2], vs[4 * t + 3]);
                asm volatile("" ::: "memory"); }
        }
        __syncthreads();
        }
        if (ROLE != 1 && n0 + 64 < LT) RWKV_LOAD(n0 + 64);
        if (ROLE == 2) {
            const unsigned g = (unsigned)(n0 >> 6);
            if (g >= RING_SLOTS) { if (wv == 0) wait_ge(ACK, g - RING_SLOTS + 1); __syncthreads(); }
            unsigned long long* slot = ring + (size_t)(g % RING_SLOTS) * SLOT_U64;
            for (int e = tid; e < 5280; e += NT) { unsigned long long v;
                if (e < 5120) v = *(const LAS unsigned long long*)(lds + C_TILES + (e >> 10) * (80 * PT * 2) + ((e >> 4) & 63) * (PT * 2) + (e & 15) * 8);
                else if (e < 5248) v = *(const LAS unsigned long long*)(lds + C_GAM + (e - 5120) * 8);
                else v = *(const LAS unsigned long long*)((LAS unsigned char*)BS + (e - 5248) * 8);
                __hip_atomic_store(slot + e, v, __ATOMIC_RELAXED, __HIP_MEMORY_SCOPE_AGENT); }
            asm volatile("s_waitcnt vmcnt(0)" ::: "memory");
            __syncthreads();
            if (tid == 0) __hip_atomic_store(READY, g + 1u, __ATOMIC_RELAXED, __HIP_MEMORY_SCOPE_AGENT);
            continue;
        }
        if (ROLE == 1) {
            const unsigned g = (unsigned)(n0 >> 6);
            if (!pf_ok) { if (wv == 0) wait_ge(READY, g + 1u); __syncthreads();
                const unsigned long long* slot = ring + (size_t)(g % RING_SLOTS) * SLOT_U64;
#pragma unroll
                for (int k = 0; k < 11; ++k) { const int e = tid + NT * k; if (e < 5280) pf[k] = slot[e]; } }
#pragma unroll
            for (int k = 0; k < 11; ++k) { const int e = tid + NT * k; if (e < 5280) { const unsigned long long v = pf[k];
                if (e < 5120) *(LAS unsigned long long*)(lds + C_TILES + (e >> 10) * (80 * PT * 2) + ((e >> 4) & 63) * (PT * 2) + (e & 15) * 8) = v;
                else if (e < 5248) *(LAS unsigned long long*)(lds + C_GAM + (e - 5120) * 8) = v;
                else *(LAS unsigned long long*)((LAS unsigned char*)BS + (e - 5248) * 8) = v; } }
            asm volatile("s_waitcnt vmcnt(0)" ::: "memory");
            __syncthreads();
            if (tid == 0) __hip_atomic_store(ACK, g + 1u, __ATOMIC_RELAXED, __HIP_MEMORY_SCOPE_AGENT);
        }
        f32x4 yhat[4];
        for (int rep1 = 0; rep1 < (MK_RDUP == 1 ? 2 : 1); ++rep1) {
        {
            const int m = wv >> 1, pp = wv & 1; LAS bf16_t* XB = pp ? Rt : At;
            f32x4 c1 = (f32x4){0.f, 0.f, 0.f, 0.f}, c2 = (f32x4){0.f, 0.f, 0.f, 0.f};
#pragma unroll
            for (int kk = 0; kk < 2; ++kk) { const bf16x8 bx = *(const LAS bf16x8*)(XB + (16 * m + r) * PT + 32 * kk + 8 * q);
                const bf16x8 a1 = *(const LAS bf16x8*)(Bt + (16 * m + r) * PT + 32 * kk + 8 * q), a2 = *(const LAS bf16x8*)(Kt + (16 * m + r) * PT + 32 * kk + 8 * q);
                c1 = __builtin_amdgcn_mfma_f32_16x16x32_bf16(a1, bx, c1, 0, 0, 0); c2 = __builtin_amdgcn_mfma_f32_16x16x32_bf16(a2, bx, c2, 0, 0, 0); }
#pragma unroll
            for (int jj = 0; jj < 4; ++jj) { const int s = 4 * q + jj; const bool ok = pp ? (s <= r) : (s < r); if (!ok) { c1[jj] = 0.f; c2[jj] = 0.f; } }
            if (pp == 0) { *(LAS f32x4*)(MBf + (m * 16 + r) * 20 + 4 * q) = c1; *(LAS u32x2*)(MK + (m * 16 + r) * PM + 4 * q) = pack4(c2[0], c2[1], c2[2], c2[3]); }
            else { *(LAS u32x2*)(NB + (m * 16 + r) * PM + 4 * q) = pack4(c1[0], c1[1], c1[2], c1[3]); *(LAS u32x2*)(NK + (m * 16 + r) * PM + 4 * q) = pack4(c2[0], c2[1], c2[2], c2[3]); }
        }
        __syncthreads();
        if (wv < 4) {
            const int m = wv, c = r; float X[16];
#pragma unroll
            for (int u = 0; u < 16; ++u) { float x = (c == u) ? 1.f : 0.f;
                if (u > 0) { const LAS f32x4* rowp = (const LAS f32x4*)(MBf + (m * 16 + u) * 20);
#pragma unroll
                    for (int s4 = 0; s4 < 4; ++s4) { if (4 * s4 < u) { const f32x4 l = rowp[s4];
#pragma unroll
                        for (int e = 0; e < 4; ++e) if (4 * s4 + e < u) x -= l[e] * X[4 * s4 + e]; } } }
                X[u] = x; }
            if (q == 0) {
#pragma unroll
                for (int u = 0; u < 16; ++u) DNV[(m * 16 + u) * PM + c] = f2bf(X[u]); }
        } else {
            const int m = wv - 4; const bf16x8 a = *(const LAS bf16x8*)(MK + (m * 16 + r) * PM + 8 * q);
#pragma unroll
            for (int it = 0; it < 4; ++it) { const bf16x8 bv = tr_frag(vt_b, PT, 16 * m, 16 * it, r, q);
                const f32x4 acc = __builtin_amdgcn_mfma_f32_16x16x32_bf16(a, bv, (f32x4){0.f, 0.f, 0.f, 0.f}, 0, 0, 0);
                *(LAS u32x2*)(W1T + (m * 64 + 16 * it + r) * PM + 4 * q) = pack4(acc[0], acc[1], acc[2], acc[3]); }
        }
        __syncthreads();
#pragma unroll
        for (int m = 0; m < 4; ++m) yhat[m] = (f32x4){0.f, 0.f, 0.f, 0.f};
        if (wv < 4) {
            const int it = wv;
#pragma unroll
            for (int m = 0; m < 4; ++m) { const bf16x8 a = *(const LAS bf16x8*)(DNV + (m * 16 + r) * PM + 8 * q), bw = *(const LAS bf16x8*)(W1T + (m * 64 + 16 * it + r) * PM + 8 * q);
                yhat[m] = __builtin_amdgcn_mfma_f32_16x16x32_bf16(a, bw, yhat[m], 0, 0, 0); }
        } else {
            const int jt = wv - 4;
#pragma unroll
            for (int m = 0; m < 4; ++m) { const bf16x8 a = tr_frag(at_b, PT, 16 * m, 16 * jt, r, q), bd = *(const LAS bf16x8*)(DNV + (m * 16 + r) * PM + 8 * q);
                const f32x4 acc = __builtin_amdgcn_mfma_f32_16x16x32_bf16(a, bd, (f32x4){0.f, 0.f, 0.f, 0.f}, 0, 0, 0);
                *(LAS u32x2*)(AH + (m * 16 + r) * PT + 16 * jt + 4 * q) = pack4(acc[0], acc[1], acc[2], acc[3]); }
        }
        __syncthreads();
        }
#pragma unroll 1
        for (int m = 0; m < 4; ++m) {
            LAS bf16_t* Sc = Sbf + cur * 64 * PT; LAS bf16_t* Sn = Sbf + (cur ^ 1) * 64 * PT;
            const int it = wv & 3, jh = wv >> 2;
            f32x4 oacc = (f32x4){0.f, 0.f, 0.f, 0.f};
            const bf16x8 bv = tr_frag(vt_b, PT, 16 * m, 16 * it, r, q);
            const bf16x8 ka0 = zero_if(tr_frag(kt_b, PT, 16 * m, 16 * (2 * jh), r, q), q >= 2), ka1 = zero_if(tr_frag(kt_b, PT, 16 * m, 16 * (2 * jh + 1), r, q), q >= 2);
            const bf16x8 ba0 = tr_frag(bt_b, PT, 16 * m, 16 * (2 * jh), r, q), ba1 = tr_frag(bt_b, PT, 16 * m, 16 * (2 * jh + 1), r, q);
            if (wv < 4) {
                f32x4 acc = (m == 0) ? yhat[0] : (m == 1) ? yhat[1] : (m == 2) ? yhat[2] : yhat[3];
#pragma unroll
                for (int kk = 0; kk < 2; ++kk) { const bf16x8 a = *(const LAS bf16x8*)(AH + (m * 16 + r) * PT + 32 * kk + 8 * q), bs = *(const LAS bf16x8*)(Sc + (16 * it + r) * PT + 32 * kk + 8 * q);
                    acc = __builtin_amdgcn_mfma_f32_16x16x32_bf16(a, bs, acc, 0, 0, 0); }
                *(LAS u32x2*)(YV + (16 * it + r) * PM + 4 * q) = pack4(-acc[0], -acc[1], -acc[2], -acc[3]);
            } else {
#pragma unroll
                for (int kk = 0; kk < 2; ++kk) { const bf16x8 a = *(const LAS bf16x8*)(Rt + (16 * m + r) * PT + 32 * kk + 8 * q), bs = *(const LAS bf16x8*)(Sc + (16 * it + r) * PT + 32 * kk + 8 * q);
                    oacc = __builtin_amdgcn_mfma_f32_16x16x32_bf16(a, bs, oacc, 0, 0, 0); }
                const bf16x8 a = *(const LAS bf16x8*)(NK + (m * 16 + r) * PM + 8 * q);
                oacc = __builtin_amdgcn_mfma_f32_16x16x32_bf16(a, bv, oacc, 0, 0, 0);
            }
            if (ROLE == 1 && m == 0) { if (tid == 0) { const unsigned g1 = (unsigned)(n0 >> 6) + 1u; unsigned ok = 0u;
                    if (g1 < 132u && __hip_atomic_load(READY, __ATOMIC_RELAXED, __HIP_MEMORY_SCOPE_AGENT) >= g1 + 1u) { __builtin_amdgcn_fence(__ATOMIC_ACQUIRE, "agent"); asm volatile("s_waitcnt vmcnt(0)" ::: "memory"); ok = 1u; }
                    ((LAS unsigned*)MBf)[16] = ok; } }
            __syncthreads();
            if (ROLE == 1 && m == 0) { pf_ok = ((LAS unsigned*)MBf)[16] != 0u;
                if (pf_ok) { const unsigned long long* slot = ring + (size_t)(((unsigned)(n0 >> 6) + 1u) % RING_SLOTS) * SLOT_U64;
#pragma unroll
                    for (int k = 0; k < 11; ++k) { const int e = tid + NT * k; if (e < 5280) pf[k] = slot[e]; } } }
            {
                const bf16x8 by = *(const LAS bf16x8*)(YV + (16 * it + r) * PM + 8 * q);
#pragma unroll
                for (int x = 0; x < 2; ++x) { const int jt = 2 * jh + x;
                    const bf16x8 a1 = x ? ka1 : ka0, a2 = x ? ba1 : ba0;
                    Sacc[x] = __builtin_amdgcn_mfma_f32_16x16x32_bf16(a1, bv, Sacc[x], 0, 0, 0); Sacc[x] = __builtin_amdgcn_mfma_f32_16x16x32_bf16(a2, by, Sacc[x], 0, 0, 0);
                    const f32x4 gm = *(const LAS f32x4*)(GAM + m * 64 + 16 * jt + 4 * q); Sacc[x] = Sacc[x] * gm;
                    *(LAS u32x2*)(Sn + (16 * it + r) * PT + 16 * jt + 4 * q) = pack4(Sacc[x][0], Sacc[x][1], Sacc[x][2], Sacc[x][3]); }
                if (wv >= 4) { const bf16x8 a = *(const LAS bf16x8*)(NB + (m * 16 + r) * PM + 8 * q);
                    oacc = __builtin_amdgcn_mfma_f32_16x16x32_bf16(a, by, oacc, 0, 0, 0);
#pragma unroll
                    for (int jj = 0; jj < 4; ++jj) OUT[(16 * m + 4 * q + jj) * 68 + 16 * it + r] = oacc[jj]; }
            }
            __syncthreads();
            cur ^= 1;
        }
        for (int rep6 = 0; rep6 < (MK_RDUP == 6 ? 2 : 1); ++rep6) {
            const int u = tid >> 3, part = tid & 7; const size_t row = (size_t)step_row(d, b, n0 + u);
            const f32x4 o0 = *(const LAS f32x4*)(OUT + u * 68 + 8 * part), o1 = *(const LAS f32x4*)(OUT + u * 68 + 8 * part + 4);
            const float mean = sum8((o0[0] + o0[1]) + (o0[2] + o0[3]) + (o1[0] + o1[1]) + (o1[2] + o1[3])) * (1.f / 64.f);
            const f32x4 d0 = o0 - mean, d1 = o1 - mean;
            const float var = sum8((d0[0] * d0[0] + d0[1] * d0[1]) + (d0[2] * d0[2] + d0[3] * d0[3]) + (d1[0] * d1[0] + d1[1] * d1[1]) + (d1[2] * d1[2] + d1[3] * d1[3])) * (1.f / 64.f);
            const float rstd = rsqrtf(var + 64e-5f), bs = BS[u];
            const f32x4 w0 = *(const LAS f32x4*)(prm + 640 + 8 * part), w1 = *(const LAS f32x4*)(prm + 644 + 8 * part), b0 = *(const LAS f32x4*)(prm + 704 + 8 * part), b1 = *(const LAS f32x4*)(prm + 708 + 8 * part);
            const u32x4 vv = *(const LAS u32x4*)(Vt + u * PT + 8 * part);
            float z[8];
#pragma unroll
            for (int k = 0; k < 4; ++k) { z[k] = d0[k] * rstd * w0[k] + b0[k]; z[4 + k] = d1[k] * rstd * w1[k] + b1[k]; }
#pragma unroll
            for (int k = 0; k < 4; ++k) { z[2 * k] += bs * __uint_as_float(vv[k] << 16); z[2 * k + 1] += bs * __uint_as_float(vv[k] & 0xffff0000u); }
            u32x4 w; w.x = pack2(z[0], z[1]); w.y = pack2(z[2], z[3]); w.z = pack2(z[4], z[5]); w.w = pack2(z[6], z[7]);
            *(u32x4*)(Z + ((size_t)d * NALL + row) * 512 + 64 * h + 8 * part) = w;
        }
        __syncthreads();
    }
}
constexpr int RP_G2 = 0, RP_G2P = 520, RP_SG = RP_G2 + 128 * RP_G2P * 2, RP_END = RP_SG + 64 * PQ * 2;
static_assert(RP_END <= LDS_BYTES, "rwkv post LDS map");
DI void phase_rwkv_post2(const P& p, LAS unsigned char* lds) {
    const int tid = mk_tid(), lane = tid & 63, wv = __builtin_amdgcn_readfirstlane(tid >> 6), r = lane & 15, q = lane >> 4;
    const bf16_t* LO = (const bf16_t*)(p.ws + WS_COLS) + OFF_LO; const bf16_t* Z = (const bf16_t*)(p.ws + WS_Z); bf16_t* Y = (bf16_t*)(p.ws + WS_COLS);
    LAS bf16_t* G2s = (LAS bf16_t*)(lds + RP_G2); LAS bf16_t* SG = (LAS bf16_t*)(lds + RP_SG);
    const unsigned g2_b = (unsigned)(size_t)G2s;
    if ((int)blockIdx.x >= NRC) return;
    __syncthreads();
    for (int e = tid; e < 128 * 128; e += NT) { const int rr = e >> 7, c4 = (e & 127) * 4; const f32x4 v = *(const f32x4*)(p.in[I_G2] + rr * 512 + c4);
        *(LAS u32x2*)(G2s + rr * RP_G2P + c4) = pack4(v[0], v[1], v[2], v[3]); }
    for (int rc = blockIdx.x; rc < NRC; rc += gridDim.x) {
        const size_t row0 = (size_t)rc * 64;
        __syncthreads();
        for (int e = tid; e < 64 * 16; e += NT) { const int t = e >> 4, pc = e & 15; const u32x4 v = *(const u32x4*)(LO + (row0 + t) * 512 + 256 + 8 * pc); u32x4 o;
#pragma unroll
            for (int k = 0; k < 4; ++k) o[k] = pack2(fsigm(__uint_as_float(v[k] << 16)), fsigm(__uint_as_float(v[k] & 0xffff0000u)));
            *(LAS u32x4*)(SG + t * PQ + 8 * pc) = o; }
        __syncthreads();
#pragma unroll 1
        for (int ci = 0; ci < 4; ++ci) { const int ct = 4 * wv + ci;
            f32x4 acc[4] = {(f32x4){0.f, 0.f, 0.f, 0.f}, (f32x4){0.f, 0.f, 0.f, 0.f}, (f32x4){0.f, 0.f, 0.f, 0.f}, (f32x4){0.f, 0.f, 0.f, 0.f}};
#pragma unroll
            for (int kk = 0; kk < 4; ++kk) { const bf16x8 a = tr_frag(g2_b, RP_G2P, 32 * kk, 16 * ct, r, q);
#pragma unroll
                for (int tt = 0; tt < 4; ++tt) { const bf16x8 bs = *(const LAS bf16x8*)(SG + (16 * tt + r) * PQ + 32 * kk + 8 * q); acc[tt] = __builtin_amdgcn_mfma_f32_16x16x32_bf16(a, bs, acc[tt], 0, 0, 0); } }
#pragma unroll
            for (int tt = 0; tt < 4; ++tt) { const size_t row = row0 + 16 * tt + r; const int c = 16 * ct + 4 * q;
                float z0[4], z1[4]; unpack4(*(const u32x2*)(Z + row * 512 + c), z0); unpack4(*(const u32x2*)(Z + ((size_t)NALL + row) * 512 + c), z1);
                *(u32x2*)(Y + row * D + c) = pack4((z0[0] + z1[0]) * acc[tt][0], (z0[1] + z1[1]) * acc[tt][1], (z0[2] + z1[2]) * acc[tt][2], (z0[3] + z1[3]) * acc[tt][3]); }
        }
    }
    __syncthreads();
}
DI void phase_mlstm_post(const P& p) {
    const int lane = mk_tid() & 63, wv = mk_tid() >> 6;
    const bf16_t* ML = (const bf16_t*)(p.ws + WS_COLS) + OFF_ML; const bf16_t* HB = (const bf16_t*)(p.ws + WS_ACT); bf16_t* Y = (bf16_t*)(p.ws + WS_COLS);
    for (int r = blockIdx.x * 8 + wv; r < NALL; r += gridDim.x * 8)
        post_headnorm_row(HB, (size_t)r, p.in[I_MNG], ML + (size_t)r * 2048 + 1536, 0, Y + (size_t)r * D + 512, lane);
}
DI void phase_hgrn_post(const P& p) {
    const int lane = mk_tid() & 63, wv = mk_tid() >> 6;
    const bf16_t* C1 = (const bf16_t*)(p.ws + WS_COLS); const bf16_t* HB = (const bf16_t*)(p.ws + WS_ACT); bf16_t* Y = (bf16_t*)(p.ws + WS_Z);
    for (int r = blockIdx.x * 8 + wv; r < NLAT; r += gridDim.x * 8)
        post_headnorm_row(HB, (size_t)r, p.in[I_HNG], C1 + (size_t)r * C1LD + 2048, 1, Y + (size_t)nat_row(r) * D, lane);
}

constexpr int N_PHASES = 19;
__global__ void __launch_bounds__(NT, 2) mk_fwd(P p) {
    extern __shared__ __attribute__((aligned(16))) unsigned char lds_raw[];
    LAS unsigned char* lds = (LAS unsigned char*)lds_raw;
    cooperative_groups::grid_group grid = cooperative_groups::this_grid();
    const int lo = p.ph_lo, hi = p.ph_hi;
#define IN(k) (lo <= (k) && (k) < hi)
#define SEAM(k) do { if (IN(k) && IN((k) + 1)) grid.sync(); } while (0)
#ifndef MK_DUP
#define MK_DUP -1
#endif
#define PHASE(k, ...) if (IN(k)) { __VA_ARGS__ if (MK_DUP == (k)) { grid.sync(); __VA_ARGS__ } } SEAM(k);
    unsigned char* ws = p.ws;
    const float* MODV = (const float*)(ws + WS_MODV);
    float* HC = (float*)(ws + WS_HC);
    bf16_t* ACT = (bf16_t*)(ws + WS_ACT); bf16_t* COLS = (bf16_t*)(ws + WS_COLS); bf16_t* Y1 = (bf16_t*)(ws + WS_Z);
    PHASE(0, phase_wprep(p, lds); phase_modv(p, lds);)
    PHASE(1, phase_modnorm(p, 0, 0, p.in[I_X], p.in[I_CTX], NALL, false);)
    PHASE(2, EpiStore3 E{COLS + OFF_RW, 1536, 6, COLS + OFF_LO, 512, 8, COLS + OFF_ML, 2048}; run_gemm(lds, ACT, (const bf16_t*)(ws + WS_W_EVIN), NALL, 4096, 1024, E);)
    PHASE(3, { const int bx = (int)blockIdx.x;
        if (gridDim.x == 256) { if (bx < 64) rwkv_chunk_unit<1>(p, lds, bx); else if (bx < 128) rwkv_chunk_unit<2>(p, lds, bx - 64); else gla_unit<0>(p, lds, bx - 128); }
        else for (int vb = bx; vb < 192; vb += gridDim.x) { if (vb < 64) rwkv_chunk_unit<0>(p, lds, vb); else gla_unit<0>(p, lds, vb - 64); } })
    if (IN(3) && MK_DUP == 103) { grid.sync(); for (int vb = blockIdx.x; vb < 64; vb += gridDim.x) rwkv_chunk_unit<0>(p, lds, vb); grid.sync(); }
    if (IN(3) && MK_DUP == 203) { grid.sync(); for (int vb = blockIdx.x; vb < 128; vb += gridDim.x) gla_unit<0>(p, lds, vb); grid.sync(); }
    PHASE(4, phase_mlstm_post(p); phase_rwkv_post2(p, lds);)
    PHASE(5, EpiResid E{p.in[I_X], p.out, p.in[I_CTX], HC, MODV, 2}; run_gemm(lds, COLS, (const bf16_t*)(ws + WS_W_EVOUT), NALL, 1024, 1024, E);)
    PHASE(6, phase_modnorm(p, 0, 1, p.out, HC, NALL, false);)
    PHASE(7, EpiSwiglu E{COLS}; run_gemm(lds, ACT, (const bf16_t*)(ws + WS_W_UP), NALL, 5632, 1024, E);)
    PHASE(8, EpiResid E{p.out, p.out, HC, HC, MODV, 5}; run_gemm(lds, COLS, (const bf16_t*)(ws + WS_W_DN), NALL, 1024, 2816, E);)
    PHASE(9, phase_modnorm(p, 1, 0, p.out, HC, NALL, true);)
    PHASE(10, EpiStore3 E{COLS, C1LD, 1 << 30, COLS, C1LD, 1 << 30, COLS, C1LD}; run_gemm(lds, ACT, (const bf16_t*)(ws + WS_W_ODIN), NALL, 3584, 1024, E);)
    PHASE(11, phase_hgrn_prep2(p, lds); lru_pass<1>(p, lds, (int)blockIdx.x, (int)gridDim.x);)
    PHASE(12, { const int half = (int)gridDim.x >> 1; if ((int)blockIdx.x < half) { for (int u = blockIdx.x; u < 128; u += half) gla_unit<1>(p, lds, u); } else lru_pass<3>(p, lds, (int)blockIdx.x - half, (int)gridDim.x - half); })
    if (IN(12) && MK_DUP == 112) { grid.sync(); lru_pass<3>(p, lds, (int)blockIdx.x, (int)gridDim.x); grid.sync(); }
    if (IN(12) && MK_DUP == 212) { grid.sync(); for (int vb = blockIdx.x; vb < 128; vb += gridDim.x) gla_unit<1>(p, lds, vb); grid.sync(); }
    PHASE(13, phase_hgrn_post(p);)
    PHASE(14, EpiResid E{p.out, p.out, HC, HC, MODV + 5 * 6144, 2}; run_gemm(lds, Y1, (const bf16_t*)(ws + WS_W_ODOUT), NLAT, 1024, 1024, E);)
    PHASE(15, phase_modnorm(p, 1, 1, p.out, HC, NLAT, false);)
    PHASE(16, EpiSwiglu E{COLS}; run_gemm(lds, ACT, (const bf16_t*)(ws + WS_W_UP) + W_UP_STRIDE, NLAT, 5632, 1024, E);)
    PHASE(17, EpiResid E{p.out, p.out, HC, HC, MODV + 5 * 6144, 5}; run_gemm(lds, COLS, (const bf16_t*)(ws + WS_W_DN) + W_DN_STRIDE, NLAT, 1024, 2816, E);)
    PHASE(18, phase_finalnorm(p);)
#undef IN
#undef SEAM
}
}

#ifndef MK_ONE_LAUNCH
#define MK_ONE_LAUNCH 1
#endif
extern "C" void kernel_launch(void* const* d_in, const int* in_sizes, int n_in, void* d_out, int out_size, void* d_ws, size_t ws_size, hipStream_t stream) {
    using namespace mk;
    static int grid = 0;
    if (grid == 0) {
        int dev = 0, cus = 0, per_cu = 0;
        if (n_in != N_IN || ws_size < WS_END) { fprintf(stderr, "kernel_launch: unexpected n_in %d / ws_size %zu\n", n_in, ws_size); grid = -1; return; }
        (void)hipGetDevice(&dev); (void)hipDeviceGetAttribute(&cus, hipDeviceAttributeMultiprocessorCount, dev);
        (void)hipFuncSetAttribute((const void*)mk_fwd, hipFuncAttributeMaxDynamicSharedMemorySize, LDS_BYTES);
        (void)hipOccupancyMaxActiveBlocksPerMultiprocessor(&per_cu, (const void*)mk_fwd, NT, LDS_BYTES);
        if (per_cu < 1) { fprintf(stderr, "kernel_launch: occupancy query says %d blocks per CU\n", per_cu); per_cu = 1; }
        (void)hipGetLastError();
        grid = cus;
    }
    if (grid < 0) return;
    if (hipMemsetAsync((char*)d_ws + WS_CTL, 0, 65536, stream) != hipSuccess) { fprintf(stderr, "kernel_launch: memset of the control words failed\n"); return; }
    P p{};
    for (int i = 0; i < N_IN; ++i) p.in[i] = (const float*)d_in[i];
    p.out = (float*)d_out; p.ws = (unsigned char*)d_ws;
#if MK_ONE_LAUNCH
    p.ph_lo = 0; p.ph_hi = N_PHASES;
    void* args[] = {&p};
    hipError_t e = hipLaunchCooperativeKernel((const void*)mk_fwd, dim3(grid), dim3(NT), args, LDS_BYTES, stream);
    if (e != hipSuccess) fprintf(stderr, "cooperative launch failed: %s (grid %d)\n", hipGetErrorString(e), grid);
#else
    for (int k = 0; k < N_PHASES; ++k) { p.ph_lo = k; p.ph_hi = k + 1; hipLaunchKernelGGL(mk_fwd, dim3(grid), dim3(NT), LDS_BYTES, stream, p); }
#endif
}
```

```cpp
#include <hip/hip_runtime.h>
#include <hip/hip_cooperative_groups.h>
#include <cstdio>
#include <cstdint>
__device__ __forceinline__ int mk_tid() { int t = threadIdx.x; asm volatile("" : "+v"(t)); return t; }
#define MK_DUP -1
#define MK_RDUP -1
namespace pg8 {
#define PG8_LAS __attribute__((address_space(3)))
typedef unsigned short bf16_t;
typedef short bf16x8 __attribute__((ext_vector_type(8)));
typedef float f32x4 __attribute__((ext_vector_type(4)));
typedef unsigned u32x4 __attribute__((ext_vector_type(4)));
constexpr int BM = 256, BK = 64, HALF = 128, HTB = HALF * BK * 2  , STAGE_BYTES = 8 * HTB, NXCD = 8, WGM = 8;

__host__ __device__ __forceinline__ int lds_byte(int r, int c) { const int st = (r >> 4) * 2 + (c >> 5), rr = r & 15, cc = c & 31, ob = rr * 64 + cc * 2; return st * 1024 + (ob ^ (((ob >> 9) & 1) << 5)); }
__host__ __device__ __forceinline__ void stage_rc(int b, int& R, int& C) { const int st = b / 1024, sb = b % 1024, swz = sb ^ (((sb >> 9) & 1) << 5); R = (st >> 1) * 16 + swz / 64; C = (st & 1) * 32 + (swz % 64) / 2; }
__host__ __device__ __forceinline__ int perm32(int rho) { const int n = rho >> 4, i = rho & 15; return 8 * (i >> 2) + 4 * n + (i & 3); }

struct Unit { int pm, pn; };
struct Gemm { const bf16_t* A; const bf16_t* Bt; int M, N, K; };

struct StaticOrder {
    int nM, nN, nwg, G, c;
    __host__ __device__ void init(int M, int N, int G_, int c_) { nM = M / BM; nN = N / BM; nwg = nM * nN; G = G_; c = c_; }
    __host__ __device__ bool next(int i, Unit& u) const {
        const long L = (long)i * G + c; if (L >= nwg) return false;
        int wgid = (int)L; { const int q = nwg / NXCD, r = nwg % NXCD, xcd = wgid % NXCD, off = wgid / NXCD; wgid = (xcd < r ? xcd * (q + 1) : r * (q + 1) + (xcd - r) * q) + off; }
        const int nig = WGM * nN, gid = wgid / nig, fm = gid * WGM, gsz = (nM - fm) < WGM ? (nM - fm) : WGM;
        u.pm = fm + ((wgid % nig) % gsz); u.pn = (wgid % nig) / gsz; return true;
    }
    __device__ __forceinline__ void a_ready(const Unit&) const {}
    __device__ __forceinline__ void done(const Unit&) const {}
};
__device__ __forceinline__ unsigned cvt_pk_bf16(float lo, float hi) { unsigned r; asm volatile("v_cvt_pk_bf16_f32 %0, %1, %2" : "=v"(r) : "v"(lo), "v"(hi)); return r; }
typedef float f32x2 __attribute__((ext_vector_type(2)));
template <class Epi, class Sched, bool STAMP = false>
__device__ __forceinline__ void gemm_phase(PG8_LAS unsigned char* lds, const Gemm g, const Sched& S, const Epi& E, unsigned long long* stamps) {
    const int tid = mk_tid(), wid = __builtin_amdgcn_readfirstlane(tid >> 6), lane = tid & 63, wr = wid >> 2, wc = wid & 3, fr = lane & 15, fq = lane >> 4;
    const int K = g.K, nt = K / BK;
    int ts_lo = 0, ts_hi = 0, nts = 0; const unsigned long long rt_entry = STAMP ? (unsigned long long)wall_clock64() : 0ull;
#define PG8_STAMP() do { if (STAMP && wid == 0 && nts < 64) { const unsigned long long _c = (unsigned long long)clock64(); \
        ts_lo = (lane == nts) ? (int)(unsigned)_c : ts_lo; ts_hi = (lane == nts) ? (int)(unsigned)(_c >> 32) : ts_hi; ++nts; } } while (0)
    PG8_STAMP();
    unsigned voffA[2], voffB[2];
#pragma unroll
    for (int i = 0; i < 2; ++i) { int R, C; stage_rc(tid * 16 + i * 8192, R, C); const int Rb = Epi::PERM ? ((R & ~31) + perm32(R & 31)) : R;
        voffA[i] = (unsigned)(R * K + C) * 2u; voffB[i] = (unsigned)(Rb * K + C) * 2u; }
    const size_t kstep = (size_t)(BK * 2);
    const size_t hstep = (size_t)HALF * K * 2;
    const size_t tstep = 2 * hstep;
    const unsigned ldsw = (unsigned)wid * 1024u;
    const int aoff = lds_byte(wr * 64 + fr, fq * 8), boff = lds_byte(wc * 32 + fr, fq * 8);
#define PG8_SA(b, h) (((b) * 2 + (h)) * HTB)
#define PG8_SB(b, h) ((4 + (b) * 2 + (h)) * HTB)
#define PG8_STAGE(bufoff, gbase, voff) do { _Pragma("unroll") for (int _i = 0; _i < 2; ++_i) \
        __builtin_amdgcn_global_load_lds((const unsigned*)((const char*)(gbase) + (voff)[_i]), (PG8_LAS unsigned*)(lds + (bufoff) + ldsw + _i * 8192), 16, 0, 0); } while (0)
#define PG8_LDA(dst, b, h) do { _Pragma("unroll") for (int m = 0; m < 4; ++m) _Pragma("unroll") for (int k = 0; k < 2; ++k) dst[m][k] = *(const PG8_LAS bf16x8*)(lds + PG8_SA(b, h) + aoff + m * 2048 + k * 1024); } while (0)
#define PG8_LDB(dst, b, h) do { _Pragma("unroll") for (int n = 0; n < 2; ++n) _Pragma("unroll") for (int k = 0; k < 2; ++k) dst[n][k] = *(const PG8_LAS bf16x8*)(lds + PG8_SB(b, h) + boff + n * 2048 + k * 1024); } while (0)
#define PG8_MMA(ai, bj, At, Bt) do { __builtin_amdgcn_s_setprio(1); _Pragma("unroll") for (int m = 0; m < 4; ++m) _Pragma("unroll") for (int n = 0; n < 2; ++n) _Pragma("unroll") for (int k = 0; k < 2; ++k) \
        acc[ai][bj][m][n] = __builtin_amdgcn_mfma_f32_16x16x32_bf16(Bt[n][k], At[m][k], acc[ai][bj][m][n], 0, 0, 0); __builtin_amdgcn_s_setprio(0); } while (0)
#define PG8_WAIT_V(n) asm volatile("s_waitcnt vmcnt(" #n ")" ::: "memory")
#define PG8_WAIT_L(n) asm volatile("s_waitcnt lgkmcnt(" #n ")" ::: "memory")
#define PG8_BAR __builtin_amdgcn_s_barrier()
#define PG8_SCHED __builtin_amdgcn_sched_barrier(0)
    Unit cur, nxt; int ui = 0;
    if (!S.next(0, cur)) return;
    f32x4 acc[2][2][4][2];
#pragma unroll
    for (int a = 0; a < 2; ++a)
#pragma unroll
        for (int b = 0; b < 2; ++b)
#pragma unroll
            for (int m = 0; m < 4; ++m)
#pragma unroll
                for (int n = 0; n < 2; ++n) acc[a][b][m][n] = (f32x4){0.f, 0.f, 0.f, 0.f};
    bf16x8 At[4][2], B0[2][2], B1[2][2];
    const char* cA = (const char*)g.A + (size_t)cur.pm * tstep; const char* cB = (const char*)g.Bt + (size_t)cur.pn * tstep;
    S.a_ready(cur);
    PG8_STAGE(PG8_SB(0, 0), cB, voffB); PG8_STAGE(PG8_SA(0, 0), cA, voffA); PG8_STAGE(PG8_SB(0, 1), cB + hstep, voffB); PG8_STAGE(PG8_SA(0, 1), cA + hstep, voffA);
    if (wr == 1) PG8_BAR;
    PG8_WAIT_V(4); PG8_BAR;
    PG8_STAGE(PG8_SB(1, 0), cB + kstep, voffB); PG8_STAGE(PG8_SA(1, 0), cA + kstep, voffA); PG8_STAGE(PG8_SB(1, 1), cB + hstep + kstep, voffB);
    PG8_WAIT_V(6); PG8_BAR;
    PG8_STAMP();
    for (;;) {
        const bool has_next = S.next(ui + 1, nxt);
        const char* nA = has_next ? (const char*)g.A + (size_t)nxt.pm * tstep : cA; const char* nB = has_next ? (const char*)g.Bt + (size_t)nxt.pn * tstep : cB;
        for (int t = 0; t < nt; t += 2) {
            const bool last = (t == nt - 2);
            const char* a1 = cA + (size_t)(t + 1) * kstep;
            const char* a2 = last ? nA : cA + (size_t)(t + 2) * kstep; const char* b2 = last ? nB : cB + (size_t)(t + 2) * kstep;
            const char* a3 = a2 + kstep; const char* b3 = b2 + kstep;
            if (last && has_next) S.a_ready(nxt);
            PG8_LDB(B0, 0, 0); PG8_SCHED; PG8_LDA(At, 0, 0); PG8_STAGE(PG8_SA(1, 1), a1 + hstep, voffA);
            PG8_WAIT_L(8); PG8_BAR; PG8_WAIT_L(0); PG8_MMA(0, 0, At, B0); PG8_BAR; PG8_SCHED;
            PG8_LDB(B1, 0, 1); PG8_STAGE(PG8_SB(0, 0), b2, voffB);
            PG8_BAR; PG8_WAIT_L(0); PG8_MMA(0, 1, At, B1); PG8_BAR;
            PG8_LDA(At, 0, 1); PG8_STAGE(PG8_SA(0, 0), a2, voffA);
            PG8_BAR; PG8_WAIT_L(0); PG8_MMA(1, 0, At, B0); PG8_BAR; PG8_SCHED;
            PG8_STAGE(PG8_SB(0, 1), b2 + hstep, voffB);
            PG8_WAIT_V(6); PG8_BAR; PG8_MMA(1, 1, At, B1); PG8_BAR;
            PG8_LDB(B0, 1, 0); PG8_SCHED; PG8_LDA(At, 1, 0); PG8_STAGE(PG8_SA(0, 1), a2 + hstep, voffA);
            PG8_WAIT_L(8); PG8_BAR; PG8_WAIT_L(0); PG8_MMA(0, 0, At, B0); PG8_BAR; PG8_SCHED;
            PG8_LDB(B1, 1, 1); PG8_STAGE(PG8_SB(1, 0), b3, voffB);
            PG8_BAR; PG8_WAIT_L(0); PG8_MMA(0, 1, At, B1); PG8_BAR;
            PG8_LDA(At, 1, 1); PG8_STAGE(PG8_SA(1, 0), a3, voffA);
            PG8_BAR; PG8_WAIT_L(0); PG8_MMA(1, 0, At, B0); PG8_BAR; PG8_SCHED;
            PG8_STAGE(PG8_SB(1, 1), b3 + hstep, voffB);
            PG8_WAIT_V(6); PG8_BAR; PG8_MMA(1, 1, At, B1); PG8_BAR;
        }
        PG8_STAMP();
        if constexpr (!Epi::AFTER_DRAIN) { E(acc, cur, wr, wc, fr, fq); S.done(cur); }
        PG8_STAMP();
        if (!has_next) break;
#pragma unroll
        for (int a = 0; a < 2; ++a)
#pragma unroll
            for (int b = 0; b < 2; ++b)
#pragma unroll
                for (int m = 0; m < 4; ++m)
#pragma unroll
                    for (int n = 0; n < 2; ++n) acc[a][b][m][n] = (f32x4){0.f, 0.f, 0.f, 0.f};
        cur = nxt; cA = nA; cB = nB; ++ui;
    }
    PG8_WAIT_V(0);
    if (wr == 0) PG8_BAR;
    PG8_BAR;
    if constexpr (Epi::AFTER_DRAIN) { E.fused(acc, cur, wr, wc, fr, fq, lds, wid, lane); S.done(cur); }
    PG8_STAMP();
    if (STAMP && wid == 0) { stamps[lane] = lane < nts ? (((unsigned long long)(unsigned)ts_hi << 32) | (unsigned)ts_lo) : 0ull;
        if (lane == 62) stamps[62] = rt_entry; if (lane == 63) stamps[63] = (unsigned long long)wall_clock64(); }
#undef PG8_STAMP
#undef PG8_SA
#undef PG8_SB
#undef PG8_STAGE
#undef PG8_LDA
#undef PG8_LDB
#undef PG8_MMA
#undef PG8_WAIT_V
#undef PG8_WAIT_L
#undef PG8_BAR
#undef PG8_SCHED
}
}

namespace mk {
#define DI __device__ __forceinline__
#define LAS __attribute__((address_space(3)))
typedef unsigned short bf16_t;
typedef float f32x4 __attribute__((ext_vector_type(4)));
typedef unsigned u32x2 __attribute__((ext_vector_type(2)));
typedef unsigned u32x4 __attribute__((ext_vector_type(4)));

constexpr int D = 1024, NB = 4, L = 8192, LC = 256, NLAT = NB * L, NCTX = NB * LC, NALL = NLAT + NCTX, LT = L + LC, DFF = 2816;
constexpr int NT = 512;
constexpr size_t MiB = (size_t)1 << 20;
constexpr size_t WS_CTL = 0, WS_MODV = 1 * MiB, WS_HC = 2 * MiB, WS_W_EVIN = 6 * MiB, WS_W_EVOUT = 14 * MiB, WS_W_ODIN = 16 * MiB, WS_W_ODOUT = 23 * MiB,
                 WS_W_UP = 25 * MiB, WS_W_DN = 47 * MiB, WS_ACT = 58 * MiB, WS_COLS = 124 * MiB, WS_Z = 388 * MiB, WS_Z1 = 454 * MiB, WS_LAM = 486 * MiB, WS_LSUM = 489 * MiB, WS_LCAR = 494 * MiB, WS_SSQP = 497 * MiB, WS_GSC = 504 * MiB, WS_END = 505 * MiB;
constexpr size_t SSQP_STRIDE = (size_t)NALL * 16, GSC_STRIDE = 5 * 1024, SHW_OFF = 3 * GSC_STRIDE, SHW_STRIDE = 5 * 5632;
constexpr size_t W_UP_STRIDE = (size_t)5632 * 1024, W_DN_STRIDE = (size_t)1024 * 2816;
constexpr size_t OFF_RW = 0, OFF_LO = (size_t)NALL * 1536, OFF_ML = OFF_LO + (size_t)NALL * 512;
constexpr int LDS_BYTES = 163840;
constexpr int C1LD = 3584;
DI int nat_row(int r) { const int b = r / L, pp = r % L; return b * L + (pp % 128) * 64 + pp / 128; }

enum { I_X = 0, I_C, I_CTX, I_CCTX, I_N1G, I_N2G, I_MODW, I_MODB, I_W1, I_W3, I_W2, I_FING, I_EVIN, I_EVOUT, I_MU, I_W0, I_W2L, I_A0, I_A2L, I_KK, I_KA, I_RK,
       I_LNW, I_LNB, I_G2, I_MBI, I_MBF, I_MNG, I_ODIN, I_ODOUT, I_HLB, I_HNG, I_CONVW, I_CONVB, I_WA, I_BA, I_WI, I_BI, I_LAM, N_IN };

struct P { const float* in[N_IN]; float* out; unsigned char* ws; int ph_lo, ph_hi; };

DI float bf2f(bf16_t v) { return __uint_as_float(((unsigned)v) << 16); }
typedef float f32x2_t __attribute__((ext_vector_type(2)));
typedef __bf16 bf16x2_t __attribute__((ext_vector_type(2)));
DI unsigned pack2(float lo, float hi) { const f32x2_t v = {lo, hi}; return __builtin_bit_cast(unsigned, __builtin_convertvector(v, bf16x2_t)); }
DI bf16_t f2bf(float f) { return (bf16_t)(pack2(f, f) & 0xffffu); }
DI float sigm(float x) { return 1.f / (1.f + expf(-x)); }
DI float siluf(float x) { return x * sigm(x); }
DI float geluf(float x) { return 0.5f * x * (1.f + tanhf(0.7978845608028654f * (x + 0.044715f * x * x * x))); }
DI float fexp(float x) { return __builtin_amdgcn_exp2f(x * 1.4426950408889634f); }
DI float frcp(float x) { return __builtin_amdgcn_rcpf(x); }
DI float fsigm(float x) { return frcp(1.f + fexp(-x)); }
DI float ftanh(float x) { return 1.f - 2.f * frcp(1.f + fexp(2.f * x)); }
DI float fgelu(float x) { return 0.5f * x * (1.f + ftanh(0.7978845608028654f * (x + 0.044715f * x * x * x))); }
template <int CTRL> DI float dppf(float x) { return __int_as_float(__builtin_amdgcn_update_dpp(0, __float_as_int(x), CTRL, 0xF, 0xF, false)); }
DI float sum8(float s) { s += dppf<0xB1>(s); s += dppf<0x4E>(s); s += dppf<0x141>(s); return s; }
DI float scan16(float x) { x += dppf<0x111>(x); x += dppf<0x112>(x); x += dppf<0x114>(x); x += dppf<0x118>(x); return x; }
DI float wave_sum(float v) {
#pragma unroll
    for (int o = 32; o >= 1; o >>= 1) v += __shfl_xor(v, o);
    return v;
}
DI int step_row(int d, int b, int n) {
    if (n < LC) return NLAT + b * LC + (d ? LC - 1 - n : n);
    const int m = n - LC; return b * L + (d ? L - 1 - m : m);
}

DI int matN(int m) { return m == 0 ? 4096 : m == 1 ? 1024 : m == 2 ? 3584 : m == 3 ? 1024 : m < 6 ? 5632 : 1024; }
DI int matK(int m) { return m < 6 ? 1024 : 2816; }
DI int matTile0(int m) { return m == 0 ? 0 : m == 1 ? 1024 : m == 2 ? 1280 : m == 3 ? 2176 : m == 4 ? 2432 : m == 5 ? 3840 : m == 6 ? 5248 : m == 7 ? 5952 : 6656; }
DI size_t matOff(int m) { return m == 0 ? WS_W_EVIN : m == 1 ? WS_W_EVOUT : m == 2 ? WS_W_ODIN : m == 3 ? WS_W_ODOUT : m == 4 ? WS_W_UP : m == 5 ? WS_W_UP + W_UP_STRIDE * 2 : m == 6 ? WS_W_DN : WS_W_DN + W_DN_STRIDE * 2; }
DI const float* matSrc(const P& p, int m, int n, int& ld) {
    if (m == 0) { ld = 3984; int col; if (n < 1920) col = n; else if (n < 1936) col = 3968 + (n - 1920); else if (n < 2048) return nullptr; else col = 1920 + (n - 2048); return p.in[I_EVIN] + col; }
    if (m == 1) { ld = 1024; return p.in[I_EVOUT] + n; }
    if (m == 2) { ld = 3584; return p.in[I_ODIN] + n; }
    if (m == 3) { ld = 1024; return p.in[I_ODOUT] + n; }
    if (m < 6) { ld = 2816; const int l = m - 4, pn = n >> 8, w = n & 255; const size_t lo = (size_t)l * 1024 * 2816; return (w < 128) ? p.in[I_W1] + lo + 128 * pn + w : p.in[I_W3] + lo + 128 * pn + (w - 128); }
    ld = 1024; return p.in[I_W2] + (size_t)(m - 6) * 2816 * 1024 + n;
}
DI void phase_wprep(const P& p, LAS unsigned char* ldsb) {
    LAS float* tile = (LAS float*)ldsb;
    const int tid = mk_tid(), tx = tid & 63, ty = tid >> 6;
    for (int item = blockIdx.x; item < 6656; item += gridDim.x) {
        int m = 0;
#pragma unroll
        for (int q = 1; q < 8; ++q) if (item >= matTile0(q)) m = q;
        const int local = item - matTile0(m), K = matK(m), nK = K >> 6, nb = local / nK, kb = local - nb * nK, n0 = nb * 64, k0 = kb * 64;
        bf16_t* Bt = (bf16_t*)(p.ws + matOff(m));
        int ld; const float* src = matSrc(p, m, n0 + tx, ld);
        __syncthreads();
#pragma unroll
        for (int i = 0; i < 8; ++i) { const int k = k0 + ty + 8 * i; tile[(ty + 8 * i) * 65 + tx] = src ? src[(size_t)k * ld] : 0.f; }
        __syncthreads();
#pragma unroll
        for (int i = 0; i < 8; ++i) { const int nn = ty + 8 * i; Bt[(size_t)(n0 + nn) * K + k0 + tx] = f2bf(tile[tx * 65 + nn]); }
    }
    __syncthreads();
}
DI void phase_modv(const P& p, LAS unsigned char* ldsb) {
    LAS float* sc = (LAS float*)ldsb;
    const int tid = mk_tid();
    float* MODV = (float*)(p.ws + WS_MODV);
    __syncthreads();
    for (int e = tid; e < 5 * 1024; e += NT) { const int s = e >> 10, k = e & 1023; const float v = (s < 4) ? p.in[I_C][s * 1024 + k] : p.in[I_CCTX][k]; sc[e] = siluf(v); }
    __syncthreads();
    for (int vb = blockIdx.x; vb < 24; vb += gridDim.x) {
        const int l = vb / 12, n = (vb % 12) * 512 + tid;
        const float* W = p.in[I_MODW] + (size_t)l * 1024 * 6144 + n;
        float a0 = 0.f, a1 = 0.f, a2 = 0.f, a3 = 0.f, a4 = 0.f;
#pragma unroll 8
        for (int k = 0; k < 1024; ++k) { const float w = W[(size_t)k * 6144]; a0 += sc[k] * w; a1 += sc[1024 + k] * w; a2 += sc[2048 + k] * w; a3 += sc[3072 + k] * w; a4 += sc[4096 + k] * w; }
        const float bb = p.in[I_MODB][l * 6144 + n];
        float* o = MODV + (size_t)l * 5 * 6144 + n;
        o[0] = a0 + bb; o[6144] = a1 + bb; o[2 * 6144] = a2 + bb; o[3 * 6144] = a3 + bb; o[4 * 6144] = a4 + bb;
    }
    __syncthreads();
}

DI void phase_modnorm(const P& p, int layer, int which, const float* hlat, const float* hctx, int nrows, bool permute) {
    const int lane = mk_tid() & 63, wv = mk_tid() >> 6;
    const float* MODV = (const float*)(p.ws + WS_MODV) + (size_t)layer * 5 * 6144;
    const float* g = p.in[which ? I_N2G : I_N1G] + layer * 1024;
    bf16_t* ACT = (bf16_t*)(p.ws + WS_ACT);
    for (int r = blockIdx.x * 8 + wv; r < nrows; r += gridDim.x * 8) {
        const bool isctx = r >= NLAT;
        const float* src = isctx ? hctx + (size_t)(r - NLAT) * D : hlat + (size_t)r * D;
        const int sv = isctx ? 4 : r / L;
        const float* shift = MODV + sv * 6144 + (which ? 3 : 0) * 1024; const float* scale = shift + 1024;
        int dr = r;
        if (permute && !isctx) { const int b = r / L, t = r % L; dr = b * L + (t % 64) * 128 + t / 64; }
        f32x4 v[4]; float ss = 0.f;
#pragma unroll
        for (int j = 0; j < 4; ++j) { v[j] = *(const f32x4*)(src + 4 * lane + 256 * j); ss += v[j].x * v[j].x + v[j].y * v[j].y + v[j].z * v[j].z + v[j].w * v[j].w; }
        const float rinv = rsqrtf(wave_sum(ss) * (1.f / D) + 1e-6f);
#pragma unroll
        for (int j = 0; j < 4; ++j) { const int c = 4 * lane + 256 * j;
            const f32x4 gg = *(const f32x4*)(g + c), sc = *(const f32x4*)(scale + c), sh = *(const f32x4*)(shift + c);
            const float o0 = v[j].x * rinv * gg.x * (1.f + sc.x) + sh.x, o1 = v[j].y * rinv * gg.y * (1.f + sc.y) + sh.y, o2 = v[j].z * rinv * gg.z * (1.f + sc.z) + sh.z, o3 = v[j].w * rinv * gg.w * (1.f + sc.w) + sh.w;
            u32x2 w; w.x = pack2(o0, o1); w.y = pack2(o2, o3);
            *(u32x2*)(ACT + (size_t)dr * D + c) = w; }
    }
}
DI void phase_finalnorm(const P& p) {
    const int lane = mk_tid() & 63, wv = mk_tid() >> 6;
    const float* g = p.in[I_FING];
    for (int r = blockIdx.x * 8 + wv; r < NLAT; r += gridDim.x * 8) {
        float* src = p.out + (size_t)r * D;
        f32x4 v[4]; float ss = 0.f;
#pragma unroll
        for (int j = 0; j < 4; ++j) { v[j] = *(const f32x4*)(src + 4 * lane + 256 * j); ss += v[j].x * v[j].x + v[j].y * v[j].y + v[j].z * v[j].z + v[j].w * v[j].w; }
        const float rinv = rsqrtf(wave_sum(ss) * (1.f / D) + 1e-6f);
#pragma unroll
        for (int j = 0; j < 4; ++j) { const int c = 4 * lane + 256 * j; const f32x4 gg = *(const f32x4*)(g + c);
            f32x4 o; o.x = v[j].x * rinv * gg.x; o.y = v[j].y * rinv * gg.y; o.z = v[j].z * rinv * gg.z; o.w = v[j].w * rinv * gg.w; *(f32x4*)(src + c) = o; }
    }
}

struct EpiStore3 {
    static constexpr bool PERM = true, AFTER_DRAIN = false;
    bf16_t* p0; int ld0; int pn1; bf16_t* p1; int ld1; int pn2; bf16_t* p2; int ld2; int pm0;
    DI void operator()(const f32x4 (&acc)[2][2][4][2], const pg8::Unit& u, int wr, int wc, int fr, int fq) const {
        bf16_t* base; int ld, ct;
        if (u.pn >= pn2) { base = p2; ld = ld2; ct = u.pn - pn2; } else if (u.pn >= pn1) { base = p1; ld = ld1; ct = u.pn - pn1; } else { base = p0; ld = ld0; ct = u.pn; }
        const int row0 = (u.pm + pm0) * 256 + wr * 64 + fr, col0 = ct * 256 + wc * 32 + 8 * fq;
#pragma unroll
        for (int ai = 0; ai < 2; ++ai)
#pragma unroll
            for (int m = 0; m < 4; ++m) { bf16_t* rowp = base + (size_t)(row0 + ai * 128 + m * 16) * ld + col0;
#pragma unroll
                for (int bj = 0; bj < 2; ++bj) { const f32x4 v0 = acc[ai][bj][m][0], v1 = acc[ai][bj][m][1];
                    u32x4 w; w.x = pack2(v0[0], v0[1]); w.y = pack2(v0[2], v0[3]); w.z = pack2(v1[0], v1[1]); w.w = pack2(v1[2], v1[3]); *(u32x4*)(rowp + bj * 128) = w; } }
    }
};
struct EpiResid {
    static constexpr bool PERM = false, AFTER_DRAIN = false;
    const float* hin; float* hout; const float* cin; float* cout; const float* modv_l; int gidx; int pm0;
    DI void operator()(const f32x4 (&acc)[2][2][4][2], const pg8::Unit& u, int wr, int wc, int fr, int fq) const {
        const int pm = u.pm + pm0; const bool isctx = pm >= 128; const int sv = isctx ? 4 : (pm >> 5);
        const float* gate = modv_l + sv * 6144 + gidx * 1024;
        const float* bi = isctx ? cin : hin; float* bo = isctx ? cout : hout;
        const int row0 = (isctx ? (pm - 128) : pm) * 256 + wr * 64 + fr, col0 = u.pn * 256 + wc * 32 + 4 * fq;
        f32x4 gv[2][2];
#pragma unroll
        for (int bj = 0; bj < 2; ++bj)
#pragma unroll
            for (int n = 0; n < 2; ++n) gv[bj][n] = *(const f32x4*)(gate + col0 + bj * 128 + n * 16);
#pragma unroll
        for (int ai = 0; ai < 2; ++ai)
#pragma unroll
            for (int m = 0; m < 4; ++m) { const size_t off = (size_t)(row0 + ai * 128 + m * 16) * D + col0;
#pragma unroll
                for (int bj = 0; bj < 2; ++bj)
#pragma unroll
                    for (int n = 0; n < 2; ++n) { const f32x4 bs = *(const f32x4*)(bi + off + bj * 128 + n * 16); *(f32x4*)(bo + off + bj * 128 + n * 16) = bs + gv[bj][n] * acc[ai][bj][m][n]; } }
    }
};
struct EpiResidN {
    static constexpr bool PERM = false, AFTER_DRAIN = false;
    const float* hin; float* hout; const float* cin; float* cout; const float* modv_l; int gidx;
    bf16_t* act; const float* gsc; float* ssqp; int permute;
    DI void operator()(const f32x4 (&acc)[2][2][4][2], const pg8::Unit& u, int wr, int wc, int fr, int fq) const {
        const bool isctx = u.pm >= 128; const int sv = isctx ? 4 : (u.pm >> 5);
        const float* gate = modv_l + sv * 6144 + gidx * 1024; const float* gs = gsc + sv * 1024;
        const float* bi = isctx ? cin : hin; float* bo = isctx ? cout : hout;
        const int row0 = (isctx ? (u.pm - 128) : u.pm) * 256 + wr * 64 + fr, col0 = u.pn * 256 + wc * 32 + 4 * fq;
        f32x4 gv[2][2], gsv[2][2];
#pragma unroll
        for (int bj = 0; bj < 2; ++bj)
#pragma unroll
            for (int n = 0; n < 2; ++n) { gv[bj][n] = *(const f32x4*)(gate + col0 + bj * 128 + n * 16); gsv[bj][n] = *(const f32x4*)(gs + col0 + bj * 128 + n * 16); }
#pragma unroll
        for (int ai = 0; ai < 2; ++ai)
#pragma unroll
            for (int m = 0; m < 4; ++m) { const int rl = row0 + ai * 128 + m * 16; const size_t off = (size_t)rl * D + col0;
                int arow = u.pm * 256 + wr * 64 + fr + ai * 128 + m * 16;
                if (permute && !isctx) { const int b = arow / L, t = arow % L; arow = b * L + (t % 64) * 128 + t / 64; }
                float ss = 0.f;
#pragma unroll
                for (int bj = 0; bj < 2; ++bj)
#pragma unroll
                    for (int n = 0; n < 2; ++n) { const f32x4 bs = *(const f32x4*)(bi + off + bj * 128 + n * 16); const f32x4 hn = bs + gv[bj][n] * acc[ai][bj][m][n];
                        *(f32x4*)(bo + off + bj * 128 + n * 16) = hn; ss += (hn[0] * hn[0] + hn[1] * hn[1]) + (hn[2] * hn[2] + hn[3] * hn[3]);
                        const f32x4 an = hn * gsv[bj][n]; u32x2 w; w.x = pack2(an[0], an[1]); w.y = pack2(an[2], an[3]); *(u32x2*)(act + (size_t)arow * D + col0 + bj * 128 + n * 16) = w; }
                ss += __shfl_xor(ss, 16); ss += __shfl_xor(ss, 32);
                if (fq == 0) ssqp[(size_t)arow * 16 + u.pn * 4 + wc] = ss; }
    }
};
struct EpiSwiglu {
    static constexpr bool PERM = true, AFTER_DRAIN = false;
    bf16_t* G; int pm0;
    DI void operator()(const f32x4 (&acc)[2][2][4][2], const pg8::Unit& u, int wr, int wc, int fr, int fq) const {
        const int row0 = (u.pm + pm0) * 256 + wr * 64 + fr, col0 = u.pn * 128 + wc * 32 + 8 * fq;
#pragma unroll
        for (int ai = 0; ai < 2; ++ai)
#pragma unroll
            for (int m = 0; m < 4; ++m) { bf16_t* rowp = G + (size_t)(row0 + ai * 128 + m * 16) * DFF + col0; float g[8];
#pragma unroll
                for (int n = 0; n < 2; ++n) { const f32x4 a = acc[ai][0][m][n], b = acc[ai][1][m][n];
#pragma unroll
                    for (int j = 0; j < 4; ++j) g[4 * n + j] = a[j] * frcp(1.f + fexp(-a[j])) * b[j]; }
                u32x4 w; w.x = pack2(g[0], g[1]); w.y = pack2(g[2], g[3]); w.z = pack2(g[4], g[5]); w.w = pack2(g[6], g[7]); *(u32x4*)rowp = w; }
    }
};
template <class Epi> DI void run_gemm(LAS unsigned char* lds, const bf16_t* A, const bf16_t* Bt, int M, int N, int K, const Epi& E) {
    pg8::Gemm g{A, Bt, M, N, K}; pg8::StaticOrder S; S.init(M, N, (int)gridDim.x, (int)blockIdx.x);
    pg8::gemm_phase<Epi, pg8::StaticOrder, false>((PG8_LAS unsigned char*)lds, g, S, E, nullptr);
    __syncthreads();
}


DI void phase_norm_tables(const P& p) {
    const int tid = mk_tid(), lane = tid & 63, wv = tid >> 6;
    const float* MODV = (const float*)(p.ws + WS_MODV); float* GSC = (float*)(p.ws + WS_GSC); float* SHW = GSC + SHW_OFF;
    for (int e = blockIdx.x * NT + tid; e < 3 * 5 * 1024; e += gridDim.x * NT) { const int site = e / 5120, s = (e / 1024) % 5, c = e & 1023;
        const int layer = site ? 1 : 0, scidx = (site == 1) ? 1 : 4; const float g = p.in[(site == 1) ? I_N1G : I_N2G][layer * 1024 + c];
        GSC[e] = g * (1.f + MODV[(size_t)layer * 5 * 6144 + s * 6144 + scidx * 1024 + c]); }
    for (int w = blockIdx.x * 8 + wv; w < 5632 + 3584 + 5632; w += gridDim.x * 8) {
        int site, n; const bf16_t* Bt;
        if (w < 5632) { site = 0; n = w; Bt = (const bf16_t*)(p.ws + WS_W_UP); } else if (w < 5632 + 3584) { site = 1; n = w - 5632; Bt = (const bf16_t*)(p.ws + WS_W_ODIN); } else { site = 2; n = w - 5632 - 3584; Bt = (const bf16_t*)(p.ws + WS_W_UP) + W_UP_STRIDE; }
        const int layer = site ? 1 : 0, shidx = (site == 1) ? 0 : 3;
        const u32x4 w0 = *(const u32x4*)(Bt + (size_t)n * 1024 + 16 * lane), w1 = *(const u32x4*)(Bt + (size_t)n * 1024 + 16 * lane + 8);
        float wf[16];
#pragma unroll
        for (int k = 0; k < 4; ++k) { wf[2 * k] = __uint_as_float(w0[k] << 16); wf[2 * k + 1] = __uint_as_float(w0[k] & 0xffff0000u); wf[8 + 2 * k] = __uint_as_float(w1[k] << 16); wf[8 + 2 * k + 1] = __uint_as_float(w1[k] & 0xffff0000u); }
#pragma unroll
        for (int s = 0; s < 5; ++s) { const float* sh = MODV + (size_t)layer * 5 * 6144 + s * 6144 + shidx * 1024 + 16 * lane; float a = 0.f;
#pragma unroll
            for (int k = 0; k < 16; ++k) a += sh[k] * wf[k];
            a = wave_sum(a);
            if (lane == 0) SHW[(size_t)site * SHW_STRIDE + s * 5632 + n] = a; }
    }
}
DI void phase_rwkv_scan_unit(const P& p, LAS unsigned char* ldsb, const int vb) {
    LAS float* lds = (LAS float*)ldsb;
    LAS float *w2s = lds, *a2s = lds + 4096, *prm = lds + 8192, *TH = prm + 768, *AD = TH + 2048, *R = AD + 2048, *W = R + 2048, *K = W + 2048, *KK = K + 2048, *BV = KK + 2048,
              *V = BV + 2048, *BS = V + 2048, *OUT = BS + 32;
    const int tid = mk_tid(), lane = tid & 63, wv = tid >> 6;
    const bf16_t* RW = (const bf16_t*)(p.ws + WS_COLS) + OFF_RW; const bf16_t* LO = (const bf16_t*)(p.ws + WS_COLS) + OFF_LO; bf16_t* Z = (bf16_t*)(p.ws + WS_Z);
    const int srow = tid >> 3, sg = tid & 7;
    {
        const int d = vb >> 5, b = (vb >> 3) & 3, h = vb & 7;
        __syncthreads();
        for (int e = tid; e < 4096; e += NT) { const int i = e >> 6, c = e & 63; w2s[e] = p.in[I_W2L][(size_t)(d * 64 + i) * 512 + 64 * h + c]; a2s[e] = p.in[I_A2L][(size_t)(d * 64 + i) * 512 + 64 * h + c]; }
        if (tid < 64) { const int j = tid, c = 64 * h + j; const float* mu = p.in[I_MU] + d * 1664;
            prm[j] = mu[c]; prm[64 + j] = mu[512 + c]; prm[128 + j] = mu[1024 + c]; prm[192 + j] = mu[1536 + j]; prm[256 + j] = mu[1600 + j];
            prm[320 + j] = p.in[I_W0][d * 512 + c]; prm[384 + j] = p.in[I_A0][d * 512 + c]; prm[448 + j] = p.in[I_KK][d * 512 + c]; prm[512 + j] = p.in[I_KA][d * 512 + c];
            prm[576 + j] = p.in[I_RK][(d * 8 + h) * 64 + j]; prm[640 + j] = p.in[I_LNW][d * 512 + c]; prm[704 + j] = p.in[I_LNB][d * 512 + c]; }
        __syncthreads();
        float S0 = 0.f, S1 = 0.f, S2 = 0.f, S3 = 0.f, S4 = 0.f, S5 = 0.f, S6 = 0.f, S7 = 0.f;
        for (int n0 = 0; n0 < LT; n0 += 32) {
            float rs[4], ks[4], vs[4];
#pragma unroll
            for (int m = 0; m < 4; ++m) { const int s = wv + 8 * m, n = n0 + s; const bool hp = (n != 0) && (n != LC);
                const size_t row = (size_t)step_row(d, b, n), prow = hp ? (size_t)step_row(d, b, n - 1) : row; const int c = 64 * h + lane;
                const float r0 = bf2f(RW[row * 1536 + c]), k0 = bf2f(RW[row * 1536 + 512 + c]), v0 = bf2f(RW[row * 1536 + 1024 + c]);
                const float r1 = hp ? bf2f(RW[prow * 1536 + c]) : 0.f, k1 = hp ? bf2f(RW[prow * 1536 + 512 + c]) : 0.f, v1 = hp ? bf2f(RW[prow * 1536 + 1024 + c]) : 0.f;
                rs[m] = r0 + prm[lane] * (r1 - r0); ks[m] = k0 + prm[64 + lane] * (k1 - k0); vs[m] = v0 + prm[128 + lane] * (v1 - v0);
                const float wd0 = bf2f(LO[row * 512 + 64 * d + lane]), wd1 = hp ? bf2f(LO[prow * 512 + 64 * d + lane]) : 0.f;
                const float ad0 = bf2f(LO[row * 512 + 128 + 64 * d + lane]), ad1 = hp ? bf2f(LO[prow * 512 + 128 + 64 * d + lane]) : 0.f;
                TH[s * 64 + lane] = tanhf(wd0 + prm[192 + lane] * (wd1 - wd0)); AD[s * 64 + lane] = ad0 + prm[256 + lane] * (ad1 - ad0); }
            __syncthreads();
#pragma unroll
            for (int m = 0; m < 4; ++m) { const int s = wv + 8 * m;
                float xw = prm[320 + lane], xa = prm[384 + lane];
#pragma unroll 8
                for (int i = 0; i < 64; ++i) { xw += TH[s * 64 + i] * w2s[i * 64 + lane]; xa += AD[s * 64 + i] * a2s[i * 64 + lane]; }
                const float elog = 0.6065306597126334f * sigm(xw), dec = expf(-elog), a = sigm(xa);
                const float kkr = ks[m] * prm[448 + lane]; const float ss = wave_sum(kkr * kkr); const float kkn = kkr / fmaxf(sqrtf(ss), 1e-12f);
                const float km = ks[m] * (1.f + (a - 1.f) * prm[512 + lane]);
                const float bs = wave_sum(rs[m] * km * prm[576 + lane]);
                R[s * 64 + lane] = rs[m]; W[s * 64 + lane] = dec; K[s * 64 + lane] = km; KK[s * 64 + lane] = kkn; BV[s * 64 + lane] = kkn * a; V[s * 64 + lane] = vs[m];
                if (lane == 0) BS[s] = bs; }
            __syncthreads();
            for (int s = 0; s < 32; ++s) {
                const LAS f32x4* pq = (const LAS f32x4*)(KK + s * 64 + 8 * sg); const f32x4 q0 = pq[0], q1 = pq[1];
                const LAS f32x4* pw = (const LAS f32x4*)(W + s * 64 + 8 * sg); const f32x4 w0 = pw[0], w1 = pw[1];
                const LAS f32x4* pb = (const LAS f32x4*)(BV + s * 64 + 8 * sg); const f32x4 b0 = pb[0], b1 = pb[1];
                const LAS f32x4* pk = (const LAS f32x4*)(K + s * 64 + 8 * sg); const f32x4 k0 = pk[0], k1 = pk[1];
                const LAS f32x4* pr = (const LAS f32x4*)(R + s * 64 + 8 * sg); const f32x4 r0 = pr[0], r1 = pr[1];
                const float vi = V[s * 64 + srow];
                float sa = S0 * q0.x + S1 * q0.y + S2 * q0.z + S3 * q0.w + S4 * q1.x + S5 * q1.y + S6 * q1.z + S7 * q1.w;
                sa += __shfl_xor(sa, 1); sa += __shfl_xor(sa, 2); sa += __shfl_xor(sa, 4);
                S0 = S0 * w0.x - sa * b0.x + vi * k0.x; S1 = S1 * w0.y - sa * b0.y + vi * k0.y; S2 = S2 * w0.z - sa * b0.z + vi * k0.z; S3 = S3 * w0.w - sa * b0.w + vi * k0.w;
                S4 = S4 * w1.x - sa * b1.x + vi * k1.x; S5 = S5 * w1.y - sa * b1.y + vi * k1.y; S6 = S6 * w1.z - sa * b1.z + vi * k1.z; S7 = S7 * w1.w - sa * b1.w + vi * k1.w;
                float o = S0 * r0.x + S1 * r0.y + S2 * r0.z + S3 * r0.w + S4 * r1.x + S5 * r1.y + S6 * r1.z + S7 * r1.w;
                o += __shfl_xor(o, 1); o += __shfl_xor(o, 2); o += __shfl_xor(o, 4);
                if (sg == 0) OUT[s * 64 + srow] = o;
            }
            __syncthreads();
#pragma unroll
            for (int m = 0; m < 4; ++m) { const int s = wv + 8 * m, n = n0 + s; const size_t row = (size_t)step_row(d, b, n);
                const float o = OUT[s * 64 + lane]; const float mean = wave_sum(o) * (1.f / 64.f); const float dv = o - mean; const float var = wave_sum(dv * dv) * (1.f / 64.f);
                const float z = dv * rsqrtf(var + 64e-5f) * prm[640 + lane] + prm[704 + lane] + BS[s] * V[s * 64 + lane];
                Z[((size_t)d * NALL + row) * 512 + 64 * h + lane] = f2bf(z); }
        }
    }
    __syncthreads();
}
DI void phase_rwkv_post(const P& p, LAS unsigned char* ldsb) {
    LAS float* sg = (LAS float*)ldsb;
    const int tid = mk_tid();
    const bf16_t* LO = (const bf16_t*)(p.ws + WS_COLS) + OFF_LO; const bf16_t* Z = (const bf16_t*)(p.ws + WS_Z); bf16_t* Y = (bf16_t*)(p.ws + WS_COLS);
    const float* g2 = p.in[I_G2];
    for (int vb = blockIdx.x; vb < NALL / 8; vb += gridDim.x) {
        const size_t row0 = (size_t)vb * 8;
        __syncthreads();
        for (int e = tid; e < 1024; e += NT) { const int q = e >> 7, r = e & 127; sg[e] = sigm(bf2f(LO[(row0 + q) * 512 + 256 + r])); }
        __syncthreads();
        float a0 = 0.f, a1 = 0.f, a2 = 0.f, a3 = 0.f, a4 = 0.f, a5 = 0.f, a6 = 0.f, a7 = 0.f;
#pragma unroll 4
        for (int r = 0; r < 128; ++r) { const float g = g2[r * 512 + tid];
            a0 += sg[r] * g; a1 += sg[128 + r] * g; a2 += sg[256 + r] * g; a3 += sg[384 + r] * g; a4 += sg[512 + r] * g; a5 += sg[640 + r] * g; a6 += sg[768 + r] * g; a7 += sg[896 + r] * g; }
#define MK_RP(q, aq) { const size_t rr = row0 + q; const float z = bf2f(Z[rr * 512 + tid]) + bf2f(Z[((size_t)NALL + rr) * 512 + tid]); Y[rr * D + tid] = f2bf(z * aq); }
        MK_RP(0, a0) MK_RP(1, a1) MK_RP(2, a2) MK_RP(3, a3) MK_RP(4, a4) MK_RP(5, a5) MK_RP(6, a6) MK_RP(7, a7)
#undef MK_RP
    }
    __syncthreads();
}
DI void post_headnorm_row(const bf16_t* HB, size_t row, const float* ng, const bf16_t* gsrc, int gate_kind, bf16_t* ydst, int lane) {
    const int c0 = 8 * lane;
    const u32x4 h0 = *(const u32x4*)(HB + row * 512 + c0), h1 = *(const u32x4*)(HB + ((size_t)NALL + row) * 512 + c0), gg = *(const u32x4*)(gsrc + c0);
    float h[8], g[8];
#pragma unroll
    for (int j = 0; j < 4; ++j) { h[2 * j] = __uint_as_float(h0[j] << 16) + __uint_as_float(h1[j] << 16); h[2 * j + 1] = __uint_as_float(h0[j] & 0xffff0000u) + __uint_as_float(h1[j] & 0xffff0000u);
        g[2 * j] = __uint_as_float(gg[j] << 16); g[2 * j + 1] = __uint_as_float(gg[j] & 0xffff0000u); }
    float ss = 0.f;
#pragma unroll
    for (int j = 0; j < 8; ++j) ss += h[j] * h[j];
    ss += __shfl_xor(ss, 1); ss += __shfl_xor(ss, 2); ss += __shfl_xor(ss, 4); ss += __shfl_xor(ss, 8);
    const float rinv = rsqrtf(ss * (1.f / 128.f) + 1e-6f);
    unsigned o[4];
#pragma unroll
    for (int j = 0; j < 4; ++j) { const float y0 = h[2 * j] * rinv * ng[c0 + 2 * j] * (gate_kind ? siluf(g[2 * j]) : sigm(g[2 * j])), y1 = h[2 * j + 1] * rinv * ng[c0 + 2 * j + 1] * (gate_kind ? siluf(g[2 * j + 1]) : sigm(g[2 * j + 1]));
        o[j] = pack2(y0, y1); }
    u32x4 w; w.x = o[0]; w.y = o[1]; w.z = o[2]; w.w = o[3];
    *(u32x4*)(ydst + c0) = w;
}
typedef short bf16x8 __attribute__((ext_vector_type(8)));
typedef short s16x4 __attribute__((ext_vector_type(4)));
constexpr int PQ = 136, PS = 72, PV = 56;
constexpr int E_QS = 0, E_KS = E_QS + 64 * PQ * 2, E_VS = E_KS + 64 * PQ * 2, E_PS = E_VS + 64 * PV * 2, E_ST = E_PS + 64 * PS * 2, E_F = E_ST + 48 * PQ * 2, E_END = E_F + 1024;
constexpr size_t WS_Q1 = WS_COLS + (size_t)231 * MiB;
constexpr int NRC = NALL / 64;

DI int chunk_row0(int d, int b, int ci) {
    if (ci < 4) { const int cc = d ? 3 - ci : ci; return NLAT + b * LC + 64 * cc; }
    const int lc = ci - 4, cl = d ? 127 - lc : lc; return b * L + 64 * cl;
}
DI bf16x8 tr_frag(unsigned tile_base, int pitch, int k0, int c0, int r, int q) {
    const unsigned a0 = tile_base + (unsigned)(((k0 + 8 * q + (r >> 2)) * pitch + c0 + 4 * (r & 3)) * 2), a1 = a0 + (unsigned)(4 * pitch * 2);
    s16x4 x, y;
    asm volatile("ds_read_b64_tr_b16 %0, %2\n\tds_read_b64_tr_b16 %1, %3\n\ts_waitcnt lgkmcnt(0)" : "=&v"(x), "=&v"(y) : "v"(a0), "v"(a1) : "memory");
    bf16x8 o; o[0] = x[0]; o[1] = x[1]; o[2] = x[2]; o[3] = x[3]; o[4] = y[0]; o[5] = y[1]; o[6] = y[2]; o[7] = y[3];
    return o;
}

#define GLA_PREFETCH(ci_) do { const int row0_ = chunk_row0(d, b, (ci_)); \
    _Pragma("unroll") for (int i = 0; i < 2; ++i) { const size_t row_ = (size_t)(row0_ + prow0 + 32 * i); \
        rq[i] = *(const u32x4*)(Qg + row_ * ldq + 8 * ppc); rk[i] = *(const u32x4*)(Kg + row_ * ldk + 8 * ppc); } \
    if (tid < 256) rv = *(const u32x4*)(Vg + (size_t)(row0_ + vrow) * ldv + 8 * vpc); \
    if (MODE == 0) { if (tid < 64) { const size_t row_ = (size_t)(row0_ + (d ? 63 - lane : lane)); gi = bf2f(LO[row_ * 512 + 384 + 4 * d + hd]); gf = bf2f(LO[row_ * 512 + 392 + 4 * d + hd]); } } \
    else rlam = *(const f32x4*)(LAM + ((size_t)d * NRC + (row0_ >> 6)) * 512 + 128 * hd + 16 * wv + 4 * q); } while (0)

template <int MODE> DI void gla_unit(const P& p, LAS unsigned char* lds, int unit) {
    constexpr int NDV = MODE == 0 ? 3 : 2;
    const int tid = mk_tid(), lane = tid & 63, wv = __builtin_amdgcn_readfirstlane(tid >> 6), r = lane & 15, q = lane >> 4;
    const int d = unit >> 6, b = (unit >> 4) & 3, hd = (unit >> 2) & 3, sl = unit & 3;
    const bf16_t* COLS = (const bf16_t*)(p.ws + WS_COLS);
    const bf16_t *Qg, *Kg, *Vg; int ldq, ldk, ldv;
    if (MODE == 0) { const bf16_t* ML = COLS + OFF_ML; Qg = ML + 128 * hd; Kg = ML + 512 + 128 * hd; Vg = ML + 1024 + 128 * hd + 32 * sl; ldq = ldk = ldv = 2048; }
    else { Qg = d ? (const bf16_t*)(p.ws + WS_Q1) + 128 * hd : COLS + 128 * hd; ldq = d ? 512 : 3584; Kg = COLS + 512 + 512 * d + 128 * hd; ldk = 3584; Vg = COLS + 1536 + 128 * hd + 32 * sl; ldv = 3584; }
    const bf16_t* LO = COLS + OFF_LO;
    const float* LAM = (const float*)(p.ws + WS_LAM);
    bf16_t* HB = (bf16_t*)(p.ws + WS_ACT);
    LAS bf16_t* Qs = (LAS bf16_t*)(lds + E_QS); LAS bf16_t* Ks = (LAS bf16_t*)(lds + E_KS); LAS bf16_t* Vs = (LAS bf16_t*)(lds + E_VS);
    LAS bf16_t* Ps = (LAS bf16_t*)(lds + E_PS); LAS bf16_t* STs = (LAS bf16_t*)(lds + E_ST); LAS float* Fs = (LAS float*)(lds + E_F);
    const unsigned ks_base = (unsigned)(size_t)Ks, vs_base = (unsigned)(size_t)Vs;
    float bi = 0.f, bfv = 0.f;
    if (MODE == 0) { bi = p.in[I_MBI][d * 4 + hd]; bfv = p.in[I_MBF][d * 4 + hd]; }
    __syncthreads();
    for (int e = tid; e < 48 * PQ / 2; e += NT) ((LAS unsigned*)STs)[e] = 0u;
    for (int e = tid; e < 64 * PV / 2; e += NT) ((LAS unsigned*)Vs)[e] = 0u;
    __syncthreads();
    f32x4 Sacc[NDV];
#pragma unroll
    for (int n = 0; n < NDV; ++n) Sacc[n] = (f32x4){0.f, 0.f, 0.f, 0.f};
    u32x4 rq[2], rk[2], rv = (u32x4){0u, 0u, 0u, 0u}; float gi = 0.f, gf = 0.f; f32x4 rlam = (f32x4){1.f, 1.f, 1.f, 1.f};
    const int prow0 = tid >> 4, ppc = tid & 15;
    const int vrow = tid >> 2, vpc = tid & 3;
    GLA_PREFETCH(0);
    for (int ci = 0; ci < 132; ++ci) {
        const int row0 = chunk_row0(d, b, ci);
        unsigned oz = 0u; asm volatile("" : "+v"(oz));
        const unsigned ks_b = ks_base + oz, vs_b = vs_base + oz;
        f32x4 lamv = rlam;
        if (MODE == 0) {
            if (tid < 64) {
                const float li = gi + bi, x = gf + bfv;
                float v = -log1pf(expf(-x));
#pragma unroll
                for (int o = 1; o < 64; o <<= 1) { const float t = __shfl_up(v, o); if (lane >= o) v += t; }
                const int rc = d ? 63 - lane : lane;
                Fs[rc] = expf(v) * 0.08838834764831845f; Fs[64 + rc] = expf(li - v);
                if (lane == 63) Fs[128] = expf(v);
            }
        }
#pragma unroll
        for (int i = 0; i < 2; ++i) { const int row = prow0 + 32 * i; *(LAS u32x4*)(Qs + row * PQ + 8 * ppc) = rq[i]; *(LAS u32x4*)(Ks + row * PQ + 8 * ppc) = rk[i]; }
        if (MODE == 0) __syncthreads();
        if (tid < 256) {
            if (MODE == 0) { const float w = Fs[64 + vrow]; u32x4 o;
#pragma unroll
                for (int e = 0; e < 4; ++e) o[e] = pack2(__uint_as_float(rv[e] << 16) * w, __uint_as_float(rv[e] & 0xffff0000u) * w);
                *(LAS u32x4*)(Vs + vrow * PV + 8 * vpc) = o;
                if (vpc == 0) Vs[vrow * PV + 32] = f2bf(w); }
            else *(LAS u32x4*)(Vs + vrow * PV + 8 * vpc) = rv;
        }
        __syncthreads();
        if (ci + 1 < 132) GLA_PREFETCH(ci + 1);
        if (MODE == 0) { const float l = Fs[128]; lamv = (f32x4){l, l, l, l}; }
        {
            const int tt = wv & 3, sh = wv >> 2;
            f32x4 pacc[2] = {(f32x4){0.f, 0.f, 0.f, 0.f}, (f32x4){0.f, 0.f, 0.f, 0.f}};
#pragma unroll
            for (int kk = 0; kk < 4; ++kk) { const bf16x8 bq = *(const LAS bf16x8*)(Qs + (16 * tt + r) * PQ + 32 * kk + 8 * q);
#pragma unroll
                for (int i = 0; i < 2; ++i) { const bf16x8 a = *(const LAS bf16x8*)(Ks + (16 * (2 * sh + i) + r) * PQ + 32 * kk + 8 * q); pacc[i] = __builtin_amdgcn_mfma_f32_16x16x32_bf16(a, bq, pacc[i], 0, 0, 0); } }
            const int t = 16 * tt + r;
#pragma unroll
            for (int i = 0; i < 2; ++i) { const int s0 = 16 * (2 * sh + i) + 4 * q; float v[4];
#pragma unroll
                for (int j = 0; j < 4; ++j) { const int s = s0 + j; const bool ok = d ? (s >= t) : (s <= t); v[j] = ok ? pacc[i][j] : 0.f; }
                u32x2 w; w.x = pack2(v[0], v[1]); w.y = pack2(v[2], v[3]); *(LAS u32x2*)(Ps + t * PS + s0) = w; }
        }
#pragma unroll
        for (int kk = 0; kk < 2; ++kk) { const bf16x8 a = tr_frag(ks_b, PQ, 32 * kk, 16 * wv, r, q);
#pragma unroll
            for (int n = 0; n < NDV; ++n) { const bf16x8 bv = tr_frag(vs_b, PV, 32 * kk, 16 * n, r, q); Sacc[n] = __builtin_amdgcn_mfma_f32_16x16x32_bf16(a, bv, Sacc[n], 0, 0, 0); } }
        __syncthreads();
        {
            const int tt = wv & 3, nA = wv >> 2;
            f32x4 oacc = (f32x4){0.f, 0.f, 0.f, 0.f}, dacc = (f32x4){0.f, 0.f, 0.f, 0.f};
#pragma unroll
            for (int kk = 0; kk < 2; ++kk) { const bf16x8 bp = *(const LAS bf16x8*)(Ps + (16 * tt + r) * PS + 32 * kk + 8 * q);
                const bf16x8 a = tr_frag(vs_b, PV, 32 * kk, 16 * nA, r, q); oacc = __builtin_amdgcn_mfma_f32_16x16x32_bf16(a, bp, oacc, 0, 0, 0);
                if (MODE == 0) { const bf16x8 a2 = tr_frag(vs_b, PV, 32 * kk, 32, r, q); dacc = __builtin_amdgcn_mfma_f32_16x16x32_bf16(a2, bp, dacc, 0, 0, 0); } }
#pragma unroll
            for (int kk = 0; kk < 4; ++kk) { const bf16x8 bq = *(const LAS bf16x8*)(Qs + (16 * tt + r) * PQ + 32 * kk + 8 * q);
                const bf16x8 a = *(const LAS bf16x8*)(STs + (16 * nA + r) * PQ + 32 * kk + 8 * q); oacc = __builtin_amdgcn_mfma_f32_16x16x32_bf16(a, bq, oacc, 0, 0, 0);
                if (MODE == 0) { const bf16x8 a2 = *(const LAS bf16x8*)(STs + (32 + r) * PQ + 32 * kk + 8 * q); dacc = __builtin_amdgcn_mfma_f32_16x16x32_bf16(a2, bq, dacc, 0, 0, 0); } }
            const int t = 16 * tt + r;
            float o0 = oacc[0], o1 = oacc[1], o2 = oacc[2], o3 = oacc[3];
            if (MODE == 0) { const float rs = Fs[t]; const float den = __shfl(dacc[0], r) * rs; const float inv = rs / fmaxf(fabsf(den), 1.f); o0 *= inv; o1 *= inv; o2 *= inv; o3 *= inv; }
            u32x2 w; w.x = pack2(o0, o1); w.y = pack2(o2, o3);
            *(u32x2*)(HB + ((size_t)d * NALL + row0 + t) * 512 + 128 * hd + 32 * sl + 16 * nA + 4 * q) = w;
        }
        __syncthreads();
#pragma unroll
        for (int n = 0; n < NDV; ++n) { Sacc[n] = Sacc[n] * lamv; u32x2 w; w.x = pack2(Sacc[n][0], Sacc[n][1]); w.y = pack2(Sacc[n][2], Sacc[n][3]); *(LAS u32x2*)(STs + (16 * n + r) * PQ + 16 * wv + 4 * q) = w; }
    }
    __syncthreads();
}

DI void phase_hgrn_prep(const P& p, LAS unsigned char* ldsb) {
    LAS float* tot = (LAS float*)ldsb;
    const int tid = mk_tid(), ch = tid & 127, qt = tid >> 7;
    bf16_t* C1 = (bf16_t*)(p.ws + WS_COLS); bf16_t* Q1 = (bf16_t*)(p.ws + WS_Q1); float* LAM = (float*)(p.ws + WS_LAM);
    for (int vb = blockIdx.x; vb < NRC * 4; vb += gridDim.x) {
        const int rc = vb >> 2, hd = vb & 3, c = 128 * hd + ch; const size_t rbase = (size_t)rc * 64 + 16 * qt;
        const float lb = sigm(p.in[I_HLB][512 + c] - p.in[I_HLB][c]);
        float qv[16], l0[16], l1[16], k0[16], k1[16];
#pragma unroll
        for (int i = 0; i < 16; ++i) { const bf16_t* base = C1 + (rbase + i) * 3584;
            qv[i] = siluf(bf2f(base[c])); const float s0 = sigm(bf2f(base[512 + c])), s1 = sigm(bf2f(base[1024 + c]));
            l0[i] = logf(lb + (1.f - lb) * s0); l1[i] = logf(lb + (1.f - lb) * s1); k0[i] = (1.f - lb) * (1.f - s0); k1[i] = (1.f - lb) * (1.f - s1); }
#pragma unroll
        for (int i = 1; i < 16; ++i) l0[i] += l0[i - 1];
#pragma unroll
        for (int i = 14; i >= 0; --i) l1[i] += l1[i + 1];
        __syncthreads();
        tot[qt * 128 + ch] = l0[15]; tot[512 + qt * 128 + ch] = l1[0];
        __syncthreads();
        float off0 = 0.f, off1 = 0.f, t0 = 0.f, t1 = 0.f;
#pragma unroll
        for (int j = 0; j < 4; ++j) { const float a = tot[j * 128 + ch], bb = tot[512 + j * 128 + ch]; t0 += a; t1 += bb; if (j < qt) off0 += a; if (j > qt) off1 += bb; }
#pragma unroll
        for (int i = 0; i < 16; ++i) { bf16_t* base = C1 + (rbase + i) * 3584; const float c0 = l0[i] + off0, c1 = l1[i] + off1;
            base[c] = f2bf(qv[i] * expf(c0)); base[512 + c] = f2bf(k0[i] * expf(-c0)); base[1024 + c] = f2bf(k1[i] * expf(-c1)); Q1[(rbase + i) * 512 + c] = f2bf(qv[i] * expf(c1)); }
        if (qt == 0) { LAM[((size_t)rc) * 512 + c] = expf(t0); LAM[((size_t)NRC + rc) * 512 + c] = expf(t1); }
    }
    __syncthreads();
}
DI float flog(float x) { return __builtin_amdgcn_logf(x) * 0.6931471805599453f; }
DI void phase_hgrn_prep2(const P& p, LAS unsigned char* ldsb) {
    LAS float* tot = (LAS float*)ldsb;
    const int tid = mk_tid(), cp = tid & 63, qt = (tid >> 6) & 3, rs = tid >> 8, c0 = 8 * cp;
    bf16_t* C1 = (bf16_t*)(p.ws + WS_COLS); bf16_t* Q1 = (bf16_t*)(p.ws + WS_Q1); float* LAM = (float*)(p.ws + WS_LAM);
    float lb[8], omlb[8];
#pragma unroll
    for (int k = 0; k < 8; ++k) { lb[k] = fsigm(p.in[I_HLB][512 + c0 + k] - p.in[I_HLB][c0 + k]); omlb[k] = 1.f - lb[k]; }
    for (int vb = blockIdx.x; vb < NRC / 2; vb += gridDim.x) {
        const int rc = 2 * vb + rs; const size_t rbase = (size_t)rc * 64 + 16 * qt;
        float s0[8], s1[8];
#pragma unroll
        for (int k = 0; k < 8; ++k) { s0[k] = 0.f; s1[k] = 0.f; }
#pragma unroll 4
        for (int i = 0; i < 16; ++i) { const bf16_t* base = C1 + (rbase + i) * 3584; const u32x4 f0 = *(const u32x4*)(base + 512 + c0), f1 = *(const u32x4*)(base + 1024 + c0);
#pragma unroll
            for (int k = 0; k < 4; ++k) { s0[2 * k] += flog(lb[2 * k] + omlb[2 * k] * fsigm(__uint_as_float(f0[k] << 16))); s0[2 * k + 1] += flog(lb[2 * k + 1] + omlb[2 * k + 1] * fsigm(__uint_as_float(f0[k] & 0xffff0000u)));
                s1[2 * k] += flog(lb[2 * k] + omlb[2 * k] * fsigm(__uint_as_float(f1[k] << 16))); s1[2 * k + 1] += flog(lb[2 * k + 1] + omlb[2 * k + 1] * fsigm(__uint_as_float(f1[k] & 0xffff0000u))); } }
        __syncthreads();
#pragma unroll
        for (int k = 0; k < 8; k += 4) { *(LAS f32x4*)(tot + ((rs * 2 + 0) * 4 + qt) * 512 + c0 + k) = (f32x4){s0[k], s0[k + 1], s0[k + 2], s0[k + 3]}; *(LAS f32x4*)(tot + ((rs * 2 + 1) * 4 + qt) * 512 + c0 + k) = (f32x4){s1[k], s1[k + 1], s1[k + 2], s1[k + 3]}; }
        __syncthreads();
        float run0[8], run1[8], t0[8], t1[8];
#pragma unroll
        for (int k = 0; k < 8; ++k) { run0[k] = 0.f; run1[k] = 0.f; t0[k] = 0.f; t1[k] = 0.f; }
#pragma unroll
        for (int j = 0; j < 4; ++j)
#pragma unroll
            for (int k = 0; k < 8; ++k) { const float a = tot[((rs * 2 + 0) * 4 + j) * 512 + c0 + k], bb = tot[((rs * 2 + 1) * 4 + j) * 512 + c0 + k]; t0[k] += a; t1[k] += bb; if (j < qt) run0[k] += a; if (j >= qt) run1[k] += bb; }
        if (qt == 0) {
#pragma unroll
            for (int k = 0; k < 8; k += 4) { *(f32x4*)(LAM + (size_t)rc * 512 + c0 + k) = (f32x4){fexp(t0[k]), fexp(t0[k + 1]), fexp(t0[k + 2]), fexp(t0[k + 3])};
                *(f32x4*)(LAM + ((size_t)NRC + rc) * 512 + c0 + k) = (f32x4){fexp(t1[k]), fexp(t1[k + 1]), fexp(t1[k + 2]), fexp(t1[k + 3])}; } }
#pragma unroll 2
        for (int i = 0; i < 16; ++i) { bf16_t* base = C1 + (rbase + i) * 3584; const u32x4 qv = *(const u32x4*)(base + c0), f0 = *(const u32x4*)(base + 512 + c0), f1 = *(const u32x4*)(base + 1024 + c0);
            float oq0[8], ok0[8], ok1[8], oq1[8];
#pragma unroll
            for (int k = 0; k < 8; ++k) { const unsigned wq = qv[k >> 1], w0 = f0[k >> 1], w1 = f1[k >> 1];
                const float qx = (k & 1) ? __uint_as_float(wq & 0xffff0000u) : __uint_as_float(wq << 16), x0 = (k & 1) ? __uint_as_float(w0 & 0xffff0000u) : __uint_as_float(w0 << 16), x1 = (k & 1) ? __uint_as_float(w1 & 0xffff0000u) : __uint_as_float(w1 << 16);
                const float sq = qx * fsigm(qx), sg0 = fsigm(x0), sg1 = fsigm(x1);
                const float l0 = flog(lb[k] + omlb[k] * sg0), l1 = flog(lb[k] + omlb[k] * sg1);
                run0[k] += l0;
                const float cb = run1[k];
                run1[k] -= l1;
                const float e0 = fexp(run0[k]), e1 = fexp(cb);
                oq0[k] = sq * e0; ok0[k] = omlb[k] * (1.f - sg0) * frcp(e0); ok1[k] = omlb[k] * (1.f - sg1) * frcp(e1); oq1[k] = sq * e1; }
            u32x4 w; w.x = pack2(oq0[0], oq0[1]); w.y = pack2(oq0[2], oq0[3]); w.z = pack2(oq0[4], oq0[5]); w.w = pack2(oq0[6], oq0[7]); *(u32x4*)(base + c0) = w;
            w.x = pack2(ok0[0], ok0[1]); w.y = pack2(ok0[2], ok0[3]); w.z = pack2(ok0[4], ok0[5]); w.w = pack2(ok0[6], ok0[7]); *(u32x4*)(base + 512 + c0) = w;
            w.x = pack2(ok1[0], ok1[1]); w.y = pack2(ok1[2], ok1[3]); w.z = pack2(ok1[4], ok1[5]); w.w = pack2(ok1[6], ok1[7]); *(u32x4*)(base + 1024 + c0) = w;
            w.x = pack2(oq1[0], oq1[1]); w.y = pack2(oq1[2], oq1[3]); w.z = pack2(oq1[4], oq1[5]); w.w = pack2(oq1[6], oq1[7]); *(u32x4*)(Q1 + (rbase + i) * 512 + c0) = w; }
    }
    __syncthreads();
}
constexpr int M_XB = 0, M_XCS = M_XB + 67 * 64 * 4, M_XCF = M_XCS + 64 * 72 * 2, M_W = M_XCF + 64 * 64 * 4, M_AU = M_W + 4 * 64 * 72 * 2, M_SEG = M_AU + 4 * 64 * 65 * 4, M_PRM = M_SEG + 4 * 8 * 64 * 4,
              M_CAR = M_PRM + 11 * 64 * 4, M_END = M_CAR + 2 * 64 * 4;
static_assert(M_END <= LDS_BYTES, "lru LDS map");
DI float nexpm1_small(float x) { const float ser = -x * (1.f + x * 0.5f * (1.f + x * (1.f / 3.f) * (1.f + x * 0.25f * (1.f + x * 0.2f)))); return (x > -0.25f) ? ser : 1.f - fexp(x); }
DI int lru_rc_at(int d, int b, int s) { if (s < 4) return 512 + 4 * b + (d ? 3 - s : s); const int lc = s - 4; return 128 * b + (d ? 127 - lc : lc); }
template <int PASS> DI void lru_pass(const P& p, LAS unsigned char* lds, const int lb, const int nlb) {
    const int tid = mk_tid(), lane = tid & 63, wv = __builtin_amdgcn_readfirstlane(tid >> 6), r = lane & 15, q = lane >> 4;
    const int hb = lb & 7;
    const bf16_t* C1 = (const bf16_t*)(p.ws + WS_COLS); bf16_t* Y = (bf16_t*)(p.ws + WS_Z); float* LSUM = (float*)(p.ws + WS_LSUM);
    LAS float* XB = (LAS float*)(lds + M_XB); LAS bf16_t* XCs = (LAS bf16_t*)(lds + M_XCS); LAS float* XCf = (LAS float*)(lds + M_XCF); LAS bf16_t* Wt = (LAS bf16_t*)(lds + M_W);
    LAS float* AU = (LAS float*)(lds + M_AU);
    LAS float* SEG = (LAS float*)(lds + M_SEG);
    LAS float* prm = (LAS float*)(lds + M_PRM);
    LAS float* CAR = (LAS float*)(lds + M_CAR);
    __syncthreads();
    for (int e = tid; e < 4 * 4096; e += NT) { const int g = e >> 12, i = (e >> 6) & 63, j = e & 63, d = g >> 1; const size_t o = ((size_t)(d * 8 + hb) * 64 + i) * 64 + j;
        Wt[(g * 64 + j) * 72 + i] = f2bf((g & 1) ? p.in[I_WI][o] : p.in[I_WA][o]); }
    if (tid < 64) { const int ch = 64 * hb + tid;
        prm[tid] = p.in[I_CONVW][ch]; prm[64 + tid] = p.in[I_CONVW][512 + ch]; prm[128 + tid] = p.in[I_CONVW][1024 + ch]; prm[192 + tid] = p.in[I_CONVW][1536 + ch]; prm[256 + tid] = p.in[I_CONVB][ch];
        prm[320 + tid] = p.in[I_BA][ch]; prm[384 + tid] = p.in[I_BA][512 + ch]; prm[448 + tid] = p.in[I_BI][ch]; prm[512 + tid] = p.in[I_BI][512 + ch];
        prm[576 + tid] = log1pf(expf(-p.in[I_LAM][ch])); prm[640 + tid] = log1pf(expf(-p.in[I_LAM][512 + ch])); }
    const int nrc = (PASS == 1) ? NRC : 512;
    const int cpr = (PASS == 3) ? 512 / (nlb >> 3) : 1, rc_lo = (PASS == 3) ? (lb >> 3) * cpr : (lb >> 3), rstep = (PASS == 3) ? 1 : (nlb >> 3), rc_hi = (PASS == 3) ? rc_lo + cpr : nrc;
    float* LCAR = (float*)(p.ws + WS_LCAR);
    if (PASS == 3 && tid < 128) { const int d = tid >> 6, j = tid & 63, ch = 64 * hb + j, b = rc_lo >> 7, cl0 = rc_lo & 127;
        const int p_lo = d ? 4 + 127 - (cl0 + cpr - 1) : 4 + cl0;
        const float* S = LSUM + (size_t)d * NRC * 1024 + 2 * ch; float hcar = 0.f;
#pragma unroll 8
        for (int s = 0; s < p_lo; ++s) { const float* e2 = S + (size_t)lru_rc_at(d, b, s) * 1024; hcar = e2[0] * hcar + e2[1]; }
        for (int s = p_lo; s < p_lo + cpr; ++s) { const int rcs = lru_rc_at(d, b, s); LCAR[((size_t)d * NRC + rcs) * 512 + ch] = hcar; const float* e2 = S + (size_t)rcs * 1024; hcar = e2[0] * hcar + e2[1]; }
    }
    u32x4 px[2];
#define LRU_PREFETCH(rc_) do { const int rc__ = (rc_); const int row0_ = rc__ * 64; const int seg_lo_ = (rc__ >= 512) ? NLAT + ((rc__ - 512) >> 2) * LC : (rc__ >> 7) * L, seg_hi_ = seg_lo_ + ((rc__ >= 512) ? LC : L); \
    _Pragma("unroll") for (int i = 0; i < 2; ++i) { const int e = tid + 512 * i, rr = e >> 3, pc = e & 7, grow = row0_ - 2 + rr; px[i] = (u32x4){0u, 0u, 0u, 0u}; \
        if (e < 67 * 8 && grow >= seg_lo_ && grow < seg_hi_) px[i] = *(const u32x4*)(C1 + (size_t)grow * C1LD + 2560 + 64 * hb + 8 * pc); } } while (0)
    int rc = rc_lo;
    if (rc < rc_hi) LRU_PREFETCH(rc);
    for (; rc < rc_hi; rc += rstep) {
        const int row0 = rc * 64;
        const int sg = tid >> 6, j = lane, ch = 64 * hb + j;
        float cin = 0.f;
        if (PASS == 3 && tid < 128) cin = LCAR[((size_t)(tid >> 6) * NRC + rc) * 512 + ch];
        float gbv[8];
        if (PASS == 3) {
#pragma unroll
            for (int k = 0; k < 8; ++k) gbv[k] = bf2f(C1[(size_t)(row0 + 8 * sg + k) * C1LD + 3072 + ch]); }
#pragma unroll
        for (int i = 0; i < 2; ++i) { const int e = tid + 512 * i; if (e < 67 * 8) { const int rr = e >> 3, pc = e & 7; const u32x4 v = px[i];
            f32x4 lo, hi; lo[0] = __uint_as_float(v[0] << 16); lo[1] = __uint_as_float(v[0] & 0xffff0000u); lo[2] = __uint_as_float(v[1] << 16); lo[3] = __uint_as_float(v[1] & 0xffff0000u);
            hi[0] = __uint_as_float(v[2] << 16); hi[1] = __uint_as_float(v[2] & 0xffff0000u); hi[2] = __uint_as_float(v[3] << 16); hi[3] = __uint_as_float(v[3] & 0xffff0000u);
            *(LAS f32x4*)(XB + rr * 64 + 8 * pc) = lo; *(LAS f32x4*)(XB + rr * 64 + 8 * pc + 4) = hi; } }
        if (PASS == 3 && tid < 128) CAR[tid] = cin;
        __syncthreads();
        if (rc + rstep < rc_hi) LRU_PREFETCH(rc + rstep);
        {
            const int t = tid >> 3, i0 = 8 * (tid & 7); float xc[8];
#pragma unroll
            for (int c = 0; c < 8; ++c) { const int i = i0 + c; xc[c] = prm[256 + i] + prm[i] * XB[t * 64 + i] + prm[64 + i] * XB[(t + 1) * 64 + i] + prm[128 + i] * XB[(t + 2) * 64 + i] + prm[192 + i] * XB[(t + 3) * 64 + i]; XCf[t * 64 + i] = xc[c]; }
            u32x4 w; w.x = pack2(xc[0], xc[1]); w.y = pack2(xc[2], xc[3]); w.z = pack2(xc[4], xc[5]); w.w = pack2(xc[6], xc[7]);
            *(LAS u32x4*)(XCs + t * 72 + i0) = w;
        }
        __syncthreads();
        {
            const int jt = wv & 3, th = wv >> 2, jc = 16 * jt + r;
#pragma unroll
            for (int d = 0; d < 2; ++d) { const float ba = prm[320 + 64 * d + jc], bi = prm[448 + 64 * d + jc], spl = prm[576 + 64 * d + jc];
#pragma unroll
                for (int i2 = 0; i2 < 2; ++i2) { const int tt = 2 * th + i2;
                    f32x4 aa = (f32x4){0.f, 0.f, 0.f, 0.f}, ai = (f32x4){0.f, 0.f, 0.f, 0.f};
#pragma unroll
                    for (int kk = 0; kk < 2; ++kk) { const bf16x8 xf = *(const LAS bf16x8*)(XCs + (16 * tt + r) * 72 + 32 * kk + 8 * q);
                        const bf16x8 wa = *(const LAS bf16x8*)(Wt + ((2 * d) * 64 + 16 * jt + r) * 72 + 32 * kk + 8 * q), wi = *(const LAS bf16x8*)(Wt + ((2 * d + 1) * 64 + 16 * jt + r) * 72 + 32 * kk + 8 * q);
                        aa = __builtin_amdgcn_mfma_f32_16x16x32_bf16(xf, wa, aa, 0, 0, 0); ai = __builtin_amdgcn_mfma_f32_16x16x32_bf16(xf, wi, ai, 0, 0, 0); }
#pragma unroll
                    for (int jj = 0; jj < 4; ++jj) { const int t = 16 * tt + 4 * q + jj;
                        const float rg = fsigm(aa[jj] + ba), ig = fsigm(ai[jj] + bi), la = -8.f * rg * spl;
                        AU[((2 * d) * 64 + t) * 65 + jc] = 1.f - nexpm1_small(la); AU[((2 * d + 1) * 64 + t) * 65 + jc] = sqrtf(nexpm1_small(2.f * la)) * (ig * XCf[t * 64 + jc]); } } }
        }
        __syncthreads();
        const LAS float* A0 = AU + (8 * sg) * 65 + j; const LAS float* U0 = AU + (64 + 8 * sg) * 65 + j; const LAS float* A1 = AU + (128 + 8 * sg) * 65 + j; const LAS float* U1 = AU + (192 + 8 * sg) * 65 + j;
        {
            float p0 = 1.f, h0 = 0.f, p1 = 1.f, h1 = 0.f;
#pragma unroll
            for (int k = 0; k < 8; ++k) { const float a = A0[k * 65]; h0 = a * h0 + U0[k * 65]; p0 *= a; }
#pragma unroll
            for (int k = 7; k >= 0; --k) { const float a = A1[k * 65]; h1 = a * h1 + U1[k * 65]; p1 *= a; }
            SEG[(0 * 8 + sg) * 64 + j] = p0; SEG[(1 * 8 + sg) * 64 + j] = h0; SEG[(2 * 8 + sg) * 64 + j] = p1; SEG[(3 * 8 + sg) * 64 + j] = h1;
        }
        __syncthreads();
        if (PASS == 1) {
            if (tid < 128) { const int d = tid >> 6; float pa = 1.f, hh = 0.f;
#pragma unroll
                for (int s2 = 0; s2 < 8; ++s2) { const int sgi = d ? 7 - s2 : s2; const float ps = SEG[((2 * d) * 8 + sgi) * 64 + j], hs = SEG[((2 * d + 1) * 8 + sgi) * 64 + j]; hh = ps * hh + hs; pa *= ps; }
                float* o = LSUM + ((size_t)d * NRC + rc) * 1024 + 2 * ch; o[0] = pa; o[1] = hh; }
        } else {
            float hf = CAR[j], hbk = CAR[64 + j];
            for (int s2 = 0; s2 < sg; ++s2) hf = SEG[(0 * 8 + s2) * 64 + j] * hf + SEG[(1 * 8 + s2) * 64 + j];
            for (int s2 = 7; s2 > sg; --s2) hbk = SEG[(2 * 8 + s2) * 64 + j] * hbk + SEG[(3 * 8 + s2) * 64 + j];
            float of[8];
#pragma unroll
            for (int k = 0; k < 8; ++k) { hf = A0[k * 65] * hf + U0[k * 65]; of[k] = hf; }
#pragma unroll
            for (int k = 7; k >= 0; --k) { hbk = A1[k * 65] * hbk + U1[k * 65]; of[k] += hbk; }
#pragma unroll
            for (int k = 0; k < 8; ++k) Y[(size_t)nat_row(row0 + 8 * sg + k) * D + 512 + ch] = f2bf(of[k] * fgelu(gbv[k]));
        }
        __syncthreads();
    }
#undef LRU_PREFETCH
}
constexpr int PT = 72, PM = 40;
constexpr int C_PRM = 0, C_GAM = C_PRM + 3072, C_MISC = C_GAM + 1024, C_SBF = C_MISC + 1280, C_TILES = C_SBF + 2 * 64 * PT * 2, C_TH = C_TILES + 5 * 80 * PT * 2, C_MBF = C_TH + 2 * 64 * PT * 2,
              C_SM = C_MBF + 4 * 16 * 20 * 4, C_W1T = C_SM + 4 * 4 * 16 * PM * 2, C_AH = C_W1T + 4 * 64 * PM * 2, C_YV = C_AH + 4 * 16 * PT * 2, C_END = C_YV + 64 * PM * 2;
static_assert(C_END <= LDS_BYTES, "rwkv chunk LDS map");
DI void unpack4(u32x2 v, float* o) { o[0] = __uint_as_float(v.x << 16); o[1] = __uint_as_float(v.x & 0xffff0000u); o[2] = __uint_as_float(v.y << 16); o[3] = __uint_as_float(v.y & 0xffff0000u); }
DI u32x2 pack4(float a, float b, float c, float d) { u32x2 w; w.x = pack2(a, b); w.y = pack2(c, d); return w; }
DI bf16x8 zero_if(bf16x8 v, bool z) { const bf16x8 zz = {0, 0, 0, 0, 0, 0, 0, 0}; return z ? zz : v; }

constexpr int RING_SLOTS = 4, SLOT_U64 = 5632;
constexpr size_t WS_RING = WS_Z1;
DI void wait_ge(unsigned* word, unsigned want) {
    unsigned spins = 0;
    while ((unsigned)__builtin_amdgcn_readfirstlane((int)__hip_atomic_load(word, __ATOMIC_RELAXED, __HIP_MEMORY_SCOPE_AGENT)) < want) { __builtin_amdgcn_s_sleep(2); if (++spins > (1u << 21)) break; }
    __builtin_amdgcn_fence(__ATOMIC_ACQUIRE, "agent");
    asm volatile("s_waitcnt vmcnt(0)" ::: "memory");
}
template <int ROLE> DI void rwkv_chunk_unit(const P& p, LAS unsigned char* lds, const int vb) {
    const int tid = mk_tid(), lane = tid & 63, wv = __builtin_amdgcn_readfirstlane(tid >> 6), r = lane & 15, q = lane >> 4;
    const int d = vb >> 5, b = (vb >> 3) & 3, h = vb & 7;
    const bf16_t* RW = (const bf16_t*)(p.ws + WS_COLS) + OFF_RW; const bf16_t* LO = (const bf16_t*)(p.ws + WS_COLS) + OFF_LO; bf16_t* Z = (bf16_t*)(p.ws + WS_Z);
    unsigned long long* ring = (unsigned long long*)(p.ws + WS_RING) + (size_t)vb * RING_SLOTS * SLOT_U64;
    unsigned* READY = (unsigned*)(p.ws + WS_CTL) + 64 * vb; unsigned* ACK = (unsigned*)(p.ws + WS_CTL) + 64 * (64 + vb);
    LAS float* prm = (LAS float*)(lds + C_PRM); LAS float* GAM = (LAS float*)(lds + C_GAM); LAS float* SSQ = (LAS float*)(lds + C_MISC); LAS float* BSP = SSQ + 128; LAS float* BS = SSQ + 256;
    LAS bf16_t* Sbf = (LAS bf16_t*)(lds + C_SBF);
    LAS bf16_t* At = (LAS bf16_t*)(lds + C_TILES); LAS bf16_t* Rt = At + 80 * PT; LAS bf16_t* Bt = Rt + 80 * PT; LAS bf16_t* Kt = Bt + 80 * PT; LAS bf16_t* Vt = Kt + 80 * PT;
    LAS bf16_t* TH = (LAS bf16_t*)(lds + C_TH); LAS bf16_t* AD = TH + 64 * PT; LAS float* OUT = (LAS float*)(lds + C_TH);
    LAS float* MBf = (LAS float*)(lds + C_MBF);
    LAS bf16_t* MK = (LAS bf16_t*)(lds + C_SM); LAS bf16_t* NK = MK + 4 * 16 * PM; LAS bf16_t* NB = NK + 4 * 16 * PM; LAS bf16_t* DNV = NB + 4 * 16 * PM;
    LAS bf16_t* W1T = (LAS bf16_t*)(lds + C_W1T); LAS bf16_t* AH = (LAS bf16_t*)(lds + C_AH); LAS bf16_t* YV = (LAS bf16_t*)(lds + C_YV);
    const unsigned at_b = (unsigned)(size_t)At, bt_b = (unsigned)(size_t)Bt, kt_b = (unsigned)(size_t)Kt, vt_b = (unsigned)(size_t)Vt;
    __syncthreads();
    for (int e = tid; e < (C_END - C_SBF) / 4; e += NT) ((LAS unsigned*)(lds + C_SBF))[e] = 0u;
    if (tid < 64) { const int j = tid, c = 64 * h + j; const float* mu = p.in[I_MU] + d * 1664;
        prm[j] = mu[c]; prm[64 + j] = mu[512 + c]; prm[128 + j] = mu[1024 + c]; prm[192 + j] = mu[1536 + j]; prm[256 + j] = mu[1600 + j];
        prm[320 + j] = p.in[I_W0][d * 512 + c]; prm[384 + j] = p.in[I_A0][d * 512 + c]; prm[448 + j] = p.in[I_KK][d * 512 + c]; prm[512 + j] = p.in[I_KA][d * 512 + c];
        prm[576 + j] = p.in[I_RK][(d * 8 + h) * 64 + j]; prm[640 + j] = p.in[I_LNW][d * 512 + c]; prm[704 + j] = p.in[I_LNB][d * 512 + c]; }
    const int m1 = wv & 3, h2 = wv >> 2, cb8 = 32 * h2 + 8 * q;
    bf16x8 fw2[2][2], fa2[2][2];
    if (ROLE != 1) {
#pragma unroll
    for (int t = 0; t < 2; ++t)
#pragma unroll
        for (int kk = 0; kk < 2; ++kk) { const int c = 64 * h + 32 * h2 + 8 * (r >> 2) + 4 * t + (r & 3);
            const float* w2p = p.in[I_W2L] + (size_t)(d * 64 + 32 * kk + 8 * q) * 512 + c; const float* a2p = p.in[I_A2L] + (size_t)(d * 64 + 32 * kk + 8 * q) * 512 + c;
#pragma unroll
            for (int e = 0; e < 8; ++e) { fw2[t][kk][e] = (short)f2bf(w2p[e * 512]); fa2[t][kk][e] = (short)f2bf(a2p[e * 512]); }
            asm volatile("" ::: "memory"); }
    }
    f32x4 Sacc[2] = {(f32x4){0.f, 0.f, 0.f, 0.f}, (f32x4){0.f, 0.f, 0.f, 0.f}};
    int cur = 0;
    unsigned ack_seen = 0u;
    unsigned long long pf[11]; bool pf_ok = false;
    u32x4 gc[5], gp[5];
#define RWKV_LOAD(n0x) do { const int n1_ = (n0x) + 16 * m1 + r; const bool hp_ = (n1_ != 0) && (n1_ != LC); const unsigned row_ = (unsigned)step_row(d, b, n1_), prow_ = hp_ ? (unsigned)step_row(d, b, n1_ - 1) : row_; \
    const unsigned rwc_ = row_ * 1536u + 64u * h + cb8, rwp_ = prow_ * 1536u + 64u * h + cb8, loc_ = row_ * 512u + 64u * d + cb8, lop_ = prow_ * 512u + 64u * d + cb8; \
    gc[0] = *(const u32x4*)(RW + rwc_); gc[1] = *(const u32x4*)(RW + rwc_ + 512u); gc[2] = *(const u32x4*)(RW + rwc_ + 1024u); gc[3] = *(const u32x4*)(LO + loc_); gc[4] = *(const u32x4*)(LO + loc_ + 128u); \
    gp[0] = *(const u32x4*)(RW + rwp_); gp[1] = *(const u32x4*)(RW + rwp_ + 512u); gp[2] = *(const u32x4*)(RW + rwp_ + 1024u); gp[3] = *(const u32x4*)(LO + lop_); gp[4] = *(const u32x4*)(LO + lop_ + 128u); } while (0)
    if (ROLE != 1) RWKV_LOAD(0);
    __syncthreads();
    for (int n0 = 0; n0 < LT; n0 += 64) {
        if (ROLE != 1) for (int rep0 = 0; rep0 < (MK_RDUP == 0 ? 2 : 1); ++rep0) {
        const int u1 = 16 * m1 + r, n1 = n0 + u1; const bool hp = (n1 != 0) && (n1 != LC);
        float rs[8], ks[8], vs[8];
        {
            float a0[8], a1[8], th[8], ad[8];
#define UNPACK8(v, o) { _Pragma("unroll") for (int k_ = 0; k_ < 4; ++k_) { o[2 * k_] = __uint_as_float(v[k_] << 16); o[2 * k_ + 1] = __uint_as_float(v[k_] & 0xffff0000u); } }
#define RW_SHIFT(dst, idx, muo) { const u32x4 pz = hp ? gp[idx] : (u32x4){0u, 0u, 0u, 0u}; UNPACK8(gc[idx], a0) UNPACK8(pz, a1) \
            const f32x4 mu0 = *(const LAS f32x4*)(prm + (muo) + cb8), mu1 = *(const LAS f32x4*)(prm + (muo) + cb8 + 4); \
            _Pragma("unroll") for (int e = 0; e < 4; ++e) { dst[e] = a0[e] + mu0[e] * (a1[e] - a0[e]); dst[4 + e] = a0[4 + e] + mu1[e] * (a1[4 + e] - a0[4 + e]); } }
            RW_SHIFT(rs, 0, 0) RW_SHIFT(ks, 1, 64) RW_SHIFT(vs, 2, 128) RW_SHIFT(th, 3, 192) RW_SHIFT(ad, 4, 256)
#undef RW_SHIFT
#pragma unroll
            for (int e = 0; e < 8; ++e) th[e] = ftanh(th[e]);
            u32x4 w; w.x = pack2(th[0], th[1]); w.y = pack2(th[2], th[3]); w.z = pack2(th[4], th[5]); w.w = pack2(th[6], th[7]); *(LAS u32x4*)(TH + u1 * PT + cb8) = w;
            w.x = pack2(ad[0], ad[1]); w.y = pack2(ad[2], ad[3]); w.z = pack2(ad[4], ad[5]); w.w = pack2(ad[6], ad[7]); *(LAS u32x4*)(AD + u1 * PT + cb8) = w;
            asm volatile("" ::: "memory");
        }
        __syncthreads();
        float elog[8], av[8], kkr[8], km[8]; float ssq = 0.f, bsp = 0.f;
#pragma unroll
        for (int t = 0; t < 2; ++t) {
            f32x4 xw = (f32x4){0.f, 0.f, 0.f, 0.f}, xa = (f32x4){0.f, 0.f, 0.f, 0.f};
#pragma unroll
            for (int kk = 0; kk < 2; ++kk) { const bf16x8 bt = *(const LAS bf16x8*)(TH + u1 * PT + 32 * kk + 8 * q), ba = *(const LAS bf16x8*)(AD + u1 * PT + 32 * kk + 8 * q);
                xw = __builtin_amdgcn_mfma_f32_16x16x32_bf16(fw2[t][kk], bt, xw, 0, 0, 0); xa = __builtin_amdgcn_mfma_f32_16x16x32_bf16(fa2[t][kk], ba, xa, 0, 0, 0); }
            const int cb = cb8 + 4 * t;
            const f32x4 w04 = *(const LAS f32x4*)(prm + 320 + cb), a04 = *(const LAS f32x4*)(prm + 384 + cb), kk4 = *(const LAS f32x4*)(prm + 448 + cb), ka4 = *(const LAS f32x4*)(prm + 512 + cb), rk4 = *(const LAS f32x4*)(prm + 576 + cb);
#pragma unroll
            for (int jj = 0; jj < 4; ++jj) { const int e = 4 * t + jj;
                elog[e] = 0.6065306597126334f * fsigm(xw[jj] + w04[jj]); av[e] = fsigm(xa[jj] + a04[jj]);
                kkr[e] = ks[e] * kk4[jj]; ssq += kkr[e] * kkr[e]; km[e] = ks[e] * (1.f + (av[e] - 1.f) * ka4[jj]); bsp += rs[e] * km[e] * rk4[jj]; }
            asm volatile("" ::: "memory");
        }
        ssq += __shfl_xor(ssq, 16); ssq += __shfl_xor(ssq, 32); bsp += __shfl_xor(bsp, 16); bsp += __shfl_xor(bsp, 32);
        if (q == 0) { SSQ[h2 * 64 + u1] = ssq; BSP[h2 * 64 + u1] = bsp; }
        __syncthreads();
        {
            const float tot = SSQ[u1] + SSQ[64 + u1]; const float inv = 1.f / fmaxf(sqrtf(tot), 1e-12f);
            if (h2 == 0 && q == 0) BS[u1] = BSP[u1] + BSP[64 + u1];
            float al[8], be[8], ka[8], rh[8];
#pragma unroll
            for (int e = 0; e < 8; ++e) {
                const float g = scan16(-elog[e]);
                const float ep = fexp(g), em = frcp(ep), epp = fexp(g + elog[e]);
                const float kk = kkr[e] * inv;
                al[e] = kk * epp; be[e] = kk * av[e] * em; ka[e] = km[e] * em; rh[e] = rs[e] * ep;
                if (r == 15) GAM[m1 * 64 + cb8 + e] = ep; }
            u32x4 w;
#define ST8(T, v) w.x = pack2(v[0], v[1]); w.y = pack2(v[2], v[3]); w.z = pack2(v[4], v[5]); w.w = pack2(v[6], v[7]); *(LAS u32x4*)(T + u1 * PT + cb8) = w;
            ST8(At, al) ST8(Bt, be) ST8(Kt, ka) ST8(Rt, rh) ST8(Vt, vs)
#undef ST8
        }
        __syncthreads();
        }
        if (ROLE == 0 && n0 + 64 < LT) RWKV_LOAD(n0 + 64);
        if (ROLE == 2) {
            const unsigned g = (unsigned)(n0 >> 6);
            if (g > 0u) { asm volatile("s_waitcnt vmcnt(0)" ::: "memory"); __syncthreads(); if (tid == 0) __hip_atomic_store(READY, g, __ATOMIC_RELAXED, __HIP_MEMORY_SCOPE_AGENT); }
            if (n0 + 64 < LT) RWKV_LOAD(n0 + 64);
            if (g >= RING_SLOTS && ack_seen < g - RING_SLOTS + 1) {
                if (tid == 0) { wait_ge(ACK, g - RING_SLOTS + 1); ((LAS unsigned*)MBf)[17] = __hip_atomic_load(ACK, __ATOMIC_RELAXED, __HIP_MEMORY_SCOPE_AGENT); }
                __syncthreads(); ack_seen = ((LAS unsigned*)MBf)[17]; }
            unsigned long long* slot = ring + (size_t)(g % RING_SLOTS) * SLOT_U64;
            for (int e = tid; e < 5280; e += NT) { unsigned long long v;
                if (e < 5120) v = *(const LAS unsigned long long*)(lds + C_TILES + (e >> 10) * (80 * PT * 2) + ((e >> 4) & 63) * (PT * 2) + (e & 15) * 8);
                else if (e < 5248) v = *(const LAS unsigned long long*)(lds + C_GAM + (e - 5120) * 8);
                else v = *(const LAS unsigned long long*)((LAS unsigned char*)BS + (e - 5248) * 8);
                __hip_atomic_store(slot + e, v, __ATOMIC_RELAXED, __HIP_MEMORY_SCOPE_AGENT); }
            if (g == 131u) { asm volatile("s_waitcnt vmcnt(0)" ::: "memory"); __syncthreads(); if (tid == 0) __hip_atomic_store(READY, g + 1u, __ATOMIC_RELAXED, __HIP_MEMORY_SCOPE_AGENT); }
            continue;
        }
        if (ROLE == 1) {
            const unsigned g = (unsigned)(n0 >> 6);
            if (!pf_ok) { if (wv == 0) wait_ge(READY, g + 1u); __syncthreads();
                const unsigned long long* slot = ring + (size_t)(g % RING_SLOTS) * SLOT_U64;
#pragma unroll
                for (int k = 0; k < 11; ++k) { const int e = tid + NT * k; if (e < 5280) pf[k] = slot[e]; } }
#pragma unroll
            for (int k = 0; k < 11; ++k) { const int e = tid + NT * k; if (e < 5280) { const unsigned long long v = pf[k];
                if (e < 5120) *(LAS unsigned long long*)(lds + C_TILES + (e >> 10) * (80 * PT * 2) + ((e >> 4) & 63) * (PT * 2) + (e & 15) * 8) = v;
                else if (e < 5248) *(LAS unsigned long long*)(lds + C_GAM + (e - 5120) * 8) = v;
                else *(LAS unsigned long long*)((LAS unsigned char*)BS + (e - 5248) * 8) = v; } }
            asm volatile("s_waitcnt vmcnt(0)" ::: "memory");
            __syncthreads();
            if (tid == 0) __hip_atomic_store(ACK, g + 1u, __ATOMIC_RELAXED, __HIP_MEMORY_SCOPE_AGENT);
        }
        f32x4 yhat[4];
        for (int rep1 = 0; rep1 < (MK_RDUP == 1 ? 2 : 1); ++rep1) {
        {
            const int m = wv >> 1, pp = wv & 1; LAS bf16_t* XB = pp ? Rt : At;
            f32x4 c1 = (f32x4){0.f, 0.f, 0.f, 0.f}, c2 = (f32x4){0.f, 0.f, 0.f, 0.f};
#pragma unroll
            for (int kk = 0; kk < 2; ++kk) { const bf16x8 bx = *(const LAS bf16x8*)(XB + (16 * m + r) * PT + 32 * kk + 8 * q);
                const bf16x8 a1 = *(const LAS bf16x8*)(Bt + (16 * m + r) * PT + 32 * kk + 8 * q), a2 = *(const LAS bf16x8*)(Kt + (16 * m + r) * PT + 32 * kk + 8 * q);
                c1 = __builtin_amdgcn_mfma_f32_16x16x32_bf16(a1, bx, c1, 0, 0, 0); c2 = __builtin_amdgcn_mfma_f32_16x16x32_bf16(a2, bx, c2, 0, 0, 0); }
#pragma unroll
            for (int jj = 0; jj < 4; ++jj) { const int s = 4 * q + jj; const bool ok = pp ? (s <= r) : (s < r); if (!ok) { c1[jj] = 0.f; c2[jj] = 0.f; } }
            if (pp == 0) { *(LAS f32x4*)(MBf + (m * 16 + r) * 20 + 4 * q) = c1; *(LAS u32x2*)(MK + (m * 16 + r) * PM + 4 * q) = pack4(c2[0], c2[1], c2[2], c2[3]); }
            else { *(LAS u32x2*)(NB + (m * 16 + r) * PM + 4 * q) = pack4(c1[0], c1[1], c1[2], c1[3]); *(LAS u32x2*)(NK + (m * 16 + r) * PM + 4 * q) = pack4(c2[0], c2[1], c2[2], c2[3]); }
        }
        __syncthreads();
        if (wv < 4) {
            const int m = wv, c = r; float X[16];
#pragma unroll
            for (int u = 0; u < 16; ++u) { float x = (c == u) ? 1.f : 0.f;
                if (u > 0) { const LAS f32x4* rowp = (const LAS f32x4*)(MBf + (m * 16 + u) * 20);
#pragma unroll
                    for (int s4 = 0; s4 < 4; ++s4) { if (4 * s4 < u) { const f32x4 l = rowp[s4];
#pragma unroll
                        for (int e = 0; e < 4; ++e) if (4 * s4 + e < u) x -= l[e] * X[4 * s4 + e]; } } }
                X[u] = x; }
            if (q == 0) {
#pragma unroll
                for (int u = 0; u < 16; ++u) DNV[(m * 16 + u) * PM + c] = f2bf(X[u]); }
        } else {
            const int m = wv - 4; const bf16x8 a = *(const LAS bf16x8*)(MK + (m * 16 + r) * PM + 8 * q);
#pragma unroll
            for (int it = 0; it < 4; ++it) { const bf16x8 bv = tr_frag(vt_b, PT, 16 * m, 16 * it, r, q);
                const f32x4 acc = __builtin_amdgcn_mfma_f32_16x16x32_bf16(a, bv, (f32x4){0.f, 0.f, 0.f, 0.f}, 0, 0, 0);
                *(LAS u32x2*)(W1T + (m * 64 + 16 * it + r) * PM + 4 * q) = pack4(acc[0], acc[1], acc[2], acc[3]); }
        }
        __syncthreads();
#pragma unroll
        for (int m = 0; m < 4; ++m) yhat[m] = (f32x4){0.f, 0.f, 0.f, 0.f};
        if (wv < 4) {
            const int it = wv;
#pragma unroll
            for (int m = 0; m < 4; ++m) { const bf16x8 a = *(const LAS bf16x8*)(DNV + (m * 16 + r) * PM + 8 * q), bw = *(const LAS bf16x8*)(W1T + (m * 64 + 16 * it + r) * PM + 8 * q);
                yhat[m] = __builtin_amdgcn_mfma_f32_16x16x32_bf16(a, bw, yhat[m], 0, 0, 0); }
        } else {
            const int jt = wv - 4;
#pragma unroll
            for (int m = 0; m < 4; ++m) { const bf16x8 a = tr_frag(at_b, PT, 16 * m, 16 * jt, r, q), bd = *(const LAS bf16x8*)(DNV + (m * 16 + r) * PM + 8 * q);
                const f32x4 acc = __builtin_amdgcn_mfma_f32_16x16x32_bf16(a, bd, (f32x4){0.f, 0.f, 0.f, 0.f}, 0, 0, 0);
                *(LAS u32x2*)(AH + (m * 16 + r) * PT + 16 * jt + 4 * q) = pack4(acc[0], acc[1], acc[2], acc[3]); }
        }
        __syncthreads();
        }
#pragma unroll 1
        for (int m = 0; m < 4; ++m) {
            LAS bf16_t* Sc = Sbf + cur * 64 * PT; LAS bf16_t* Sn = Sbf + (cur ^ 1) * 64 * PT;
            const int it = wv & 3, jh = wv >> 2;
            f32x4 oacc = (f32x4){0.f, 0.f, 0.f, 0.f};
            const bf16x8 bv = tr_frag(vt_b, PT, 16 * m, 16 * it, r, q);
            const bf16x8 ka0 = zero_if(tr_frag(kt_b, PT, 16 * m, 16 * (2 * jh), r, q), q >= 2), ka1 = zero_if(tr_frag(kt_b, PT, 16 * m, 16 * (2 * jh + 1), r, q), q >= 2);
            const bf16x8 ba0 = tr_frag(bt_b, PT, 16 * m, 16 * (2 * jh), r, q), ba1 = tr_frag(bt_b, PT, 16 * m, 16 * (2 * jh + 1), r, q);
            if (wv < 4) {
                f32x4 acc = (m == 0) ? yhat[0] : (m == 1) ? yhat[1] : (m == 2) ? yhat[2] : yhat[3];
#pragma unroll
                for (int kk = 0; kk < 2; ++kk) { const bf16x8 a = *(const LAS bf16x8*)(AH + (m * 16 + r) * PT + 32 * kk + 8 * q), bs = *(const LAS bf16x8*)(Sc + (16 * it + r) * PT + 32 * kk + 8 * q);
                    acc = __builtin_amdgcn_mfma_f32_16x16x32_bf16(a, bs, acc, 0, 0, 0); }
                *(LAS u32x2*)(YV + (16 * it + r) * PM + 4 * q) = pack4(-acc[0], -acc[1], -acc[2], -acc[3]);
            } else {
#pragma unroll
                for (int kk = 0; kk < 2; ++kk) { const bf16x8 a = *(const LAS bf16x8*)(Rt + (16 * m + r) * PT + 32 * kk + 8 * q), bs = *(const LAS bf16x8*)(Sc + (16 * it + r) * PT + 32 * kk + 8 * q);
                    oacc = __builtin_amdgcn_mfma_f32_16x16x32_bf16(a, bs, oacc, 0, 0, 0); }
                const bf16x8 a = *(const LAS bf16x8*)(NK + (m * 16 + r) * PM + 8 * q);
                oacc = __builtin_amdgcn_mfma_f32_16x16x32_bf16(a, bv, oacc, 0, 0, 0);
            }
            if (ROLE == 1 && m == 0) { if (tid == 0) { const unsigned g1 = (unsigned)(n0 >> 6) + 1u; unsigned ok = 0u;
                    if (g1 < 132u && __hip_atomic_load(READY, __ATOMIC_RELAXED, __HIP_MEMORY_SCOPE_AGENT) >= g1 + 1u) { __builtin_amdgcn_fence(__ATOMIC_ACQUIRE, "agent"); asm volatile("s_waitcnt vmcnt(0)" ::: "memory"); ok = 1u; }
                    ((LAS unsigned*)MBf)[16] = ok; } }
            __syncthreads();
            if (ROLE == 1 && m == 0) { pf_ok = ((LAS unsigned*)MBf)[16] != 0u;
                if (pf_ok) { const unsigned long long* slot = ring + (size_t)(((unsigned)(n0 >> 6) + 1u) % RING_SLOTS) * SLOT_U64;
#pragma unroll
                    for (int k = 0; k < 11; ++k) { const int e = tid + NT * k; if (e < 5280) pf[k] = slot[e]; } } }
            {
                const bf16x8 by = *(const LAS bf16x8*)(YV + (16 * it + r) * PM + 8 * q);
#pragma unroll
                for (int x = 0; x < 2; ++x) { const int jt = 2 * jh + x;
                    const bf16x8 a1 = x ? ka1 : ka0, a2 = x ? ba1 : ba0;
                    Sacc[x] = __builtin_amdgcn_mfma_f32_16x16x32_bf16(a1, bv, Sacc[x], 0, 0, 0); Sacc[x] = __builtin_amdgcn_mfma_f32_16x16x32_bf16(a2, by, Sacc[x], 0, 0, 0);
                    const f32x4 gm = *(const LAS f32x4*)(GAM + m * 64 + 16 * jt + 4 * q); Sacc[x] = Sacc[x] * gm;
                    *(LAS u32x2*)(Sn + (16 * it + r) * PT + 16 * jt + 4 * q) = pack4(Sacc[x][0], Sacc[x][1], Sacc[x][2], Sacc[x][3]); }
                if (wv >= 4) { const bf16x8 a = *(const LAS bf16x8*)(NB + (m * 16 + r) * PM + 8 * q);
                    oacc = __builtin_amdgcn_mfma_f32_16x16x32_bf16(a, by, oacc, 0, 0, 0);
#pragma unroll
                    for (int jj = 0; jj < 4; ++jj) OUT[(16 * m + 4 * q + jj) * 68 + 16 * it + r] = oacc[jj]; }
            }
            __syncthreads();
            cur ^= 1;
        }
        for (int rep6 = 0; rep6 < (MK_RDUP == 6 ? 2 : 1); ++rep6) {
            const int u = tid >> 3, part = tid & 7; const size_t row = (size_t)step_row(d, b, n0 + u);
            const f32x4 o0 = *(const LAS f32x4*)(OUT + u * 68 + 8 * part), o1 = *(const LAS f32x4*)(OUT + u * 68 + 8 * part + 4);
            const float mean = sum8((o0[0] + o0[1]) + (o0[2] + o0[3]) + (o1[0] + o1[1]) + (o1[2] + o1[3])) * (1.f / 64.f);
            const f32x4 d0 = o0 - mean, d1 = o1 - mean;
            const float var = sum8((d0[0] * d0[0] + d0[1] * d0[1]) + (d0[2] * d0[2] + d0[3] * d0[3]) + (d1[0] * d1[0] + d1[1] * d1[1]) + (d1[2] * d1[2] + d1[3] * d1[3])) * (1.f / 64.f);
            const float rstd = rsqrtf(var + 64e-5f), bs = BS[u];
            const f32x4 w0 = *(const LAS f32x4*)(prm + 640 + 8 * part), w1 = *(const LAS f32x4*)(prm + 644 + 8 * part), b0 = *(const LAS f32x4*)(prm + 704 + 8 * part), b1 = *(const LAS f32x4*)(prm + 708 + 8 * part);
            const u32x4 vv = *(const LAS u32x4*)(Vt + u * PT + 8 * part);
            float z[8];
#pragma unroll
            for (int k = 0; k < 4; ++k) { z[k] = d0[k] * rstd * w0[k] + b0[k]; z[4 + k] = d1[k] * rstd * w1[k] + b1[k]; }
#pragma unroll
            for (int k = 0; k < 4; ++k) { z[2 * k] += bs * __uint_as_float(vv[k] << 16); z[2 * k + 1] += bs * __uint_as_float(vv[k] & 0xffff0000u); }
            u32x4 w; w.x = pack2(z[0], z[1]); w.y = pack2(z[2], z[3]); w.z = pack2(z[4], z[5]); w.w = pack2(z[6], z[7]);
            *(u32x4*)(Z + ((size_t)d * NALL + row) * 512 + 64 * h + 8 * part) = w;
        }
        __syncthreads();
    }
}
constexpr int RP_G2 = 0, RP_G2P = 520, RP_SG = RP_G2 + 128 * RP_G2P * 2, RP_END = RP_SG + 64 * PQ * 2;
static_assert(RP_END <= LDS_BYTES, "rwkv post LDS map");
DI void phase_rwkv_post2(const P& p, LAS unsigned char* lds) {
    const int tid = mk_tid(), lane = tid & 63, wv = __builtin_amdgcn_readfirstlane(tid >> 6), r = lane & 15, q = lane >> 4;
    const bf16_t* LO = (const bf16_t*)(p.ws + WS_COLS) + OFF_LO; const bf16_t* Z = (const bf16_t*)(p.ws + WS_Z); bf16_t* Y = (bf16_t*)(p.ws + WS_COLS);
    LAS bf16_t* G2s = (LAS bf16_t*)(lds + RP_G2); LAS bf16_t* SG = (LAS bf16_t*)(lds + RP_SG);
    const unsigned g2_b = (unsigned)(size_t)G2s;
    if ((int)blockIdx.x >= NRC) return;
    __syncthreads();
    for (int e = tid; e < 128 * 128; e += NT) { const int rr = e >> 7, c4 = (e & 127) * 4; const f32x4 v = *(const f32x4*)(p.in[I_G2] + rr * 512 + c4);
        *(LAS u32x2*)(G2s + rr * RP_G2P + c4) = pack4(v[0], v[1], v[2], v[3]); }
    for (int rc = blockIdx.x; rc < NRC; rc += gridDim.x) {
        const size_t row0 = (size_t)rc * 64;
        __syncthreads();
        for (int e = tid; e < 64 * 16; e += NT) { const int t = e >> 4, pc = e & 15; const u32x4 v = *(const u32x4*)(LO + (row0 + t) * 512 + 256 + 8 * pc); u32x4 o;
#pragma unroll
            for (int k = 0; k < 4; ++k) o[k] = pack2(fsigm(__uint_as_float(v[k] << 16)), fsigm(__uint_as_float(v[k] & 0xffff0000u)));
            *(LAS u32x4*)(SG + t * PQ + 8 * pc) = o; }
        __syncthreads();
#pragma unroll 1
        for (int ci = 0; ci < 4; ++ci) { const int ct = 4 * wv + ci;
            f32x4 acc[4] = {(f32x4){0.f, 0.f, 0.f, 0.f}, (f32x4){0.f, 0.f, 0.f, 0.f}, (f32x4){0.f, 0.f, 0.f, 0.f}, (f32x4){0.f, 0.f, 0.f, 0.f}};
#pragma unroll
            for (int kk = 0; kk < 4; ++kk) { const bf16x8 a = tr_frag(g2_b, RP_G2P, 32 * kk, 16 * ct, r, q);
#pragma unroll
                for (int tt = 0; tt < 4; ++tt) { const bf16x8 bs = *(const LAS bf16x8*)(SG + (16 * tt + r) * PQ + 32 * kk + 8 * q); acc[tt] = __builtin_amdgcn_mfma_f32_16x16x32_bf16(a, bs, acc[tt], 0, 0, 0); } }
#pragma unroll
            for (int tt = 0; tt < 4; ++tt) { const size_t row = row0 + 16 * tt + r; const int c = 16 * ct + 4 * q;
                float z0[4], z1[4]; unpack4(*(const u32x2*)(Z + row * 512 + c), z0); unpack4(*(const u32x2*)(Z + ((size_t)NALL + row) * 512 + c), z1);
                *(u32x2*)(Y + row * D + c) = pack4((z0[0] + z1[0]) * acc[tt][0], (z0[1] + z1[1]) * acc[tt][1], (z0[2] + z1[2]) * acc[tt][2], (z0[3] + z1[3]) * acc[tt][3]); }
        }
    }
    __syncthreads();
}
DI void phase_mlstm_post(const P& p) {
    const int lane = mk_tid() & 63, wv = mk_tid() >> 6;
    const bf16_t* ML = (const bf16_t*)(p.ws + WS_COLS) + OFF_ML; const bf16_t* HB = (const bf16_t*)(p.ws + WS_ACT); bf16_t* Y = (bf16_t*)(p.ws + WS_COLS);
    for (int r = blockIdx.x * 8 + wv; r < NALL; r += gridDim.x * 8)
        post_headnorm_row(HB, (size_t)r, p.in[I_MNG], ML + (size_t)r * 2048 + 1536, 0, Y + (size_t)r * D + 512, lane);
}
DI void phase_hgrn_post(const P& p) {
    const int lane = mk_tid() & 63, wv = mk_tid() >> 6;
    const bf16_t* C1 = (const bf16_t*)(p.ws + WS_COLS); const bf16_t* HB = (const bf16_t*)(p.ws + WS_ACT); bf16_t* Y = (bf16_t*)(p.ws + WS_Z);
    for (int r = blockIdx.x * 8 + wv; r < NLAT; r += gridDim.x * 8)
        post_headnorm_row(HB, (size_t)r, p.in[I_HNG], C1 + (size_t)r * C1LD + 2048, 1, Y + (size_t)nat_row(r) * D, lane);
}

constexpr int N_PHASES = 19;
__global__ void __launch_bounds__(NT, 2) mk_fwd(P p) {
    extern __shared__ __attribute__((aligned(16))) unsigned char lds_raw[];
    LAS unsigned char* lds = (LAS unsigned char*)lds_raw;
    cooperative_groups::grid_group grid = cooperative_groups::this_grid();
    const int lo = p.ph_lo, hi = p.ph_hi;
#define IN(k) (lo <= (k) && (k) < hi)
#define SEAM(k) do { if (IN(k) && IN((k) + 1)) grid.sync(); } while (0)
#ifndef MK_DUP
#define MK_DUP -1
#endif
#define PHASE(k, ...) if (IN(k)) { __VA_ARGS__ if (MK_DUP == (k)) { grid.sync(); __VA_ARGS__ } } SEAM(k);
    unsigned char* ws = p.ws;
    const float* MODV = (const float*)(ws + WS_MODV);
    float* HC = (float*)(ws + WS_HC);
    float* SSQP = (float*)(ws + WS_SSQP); const float* GSC = (const float*)(ws + WS_GSC); const float* SHW = GSC + SHW_OFF;
    bf16_t* ACT = (bf16_t*)(ws + WS_ACT); bf16_t* COLS = (bf16_t*)(ws + WS_COLS); bf16_t* Y1 = (bf16_t*)(ws + WS_Z);
    PHASE(0, phase_wprep(p, lds); phase_modv(p, lds);)
    PHASE(1, phase_modnorm(p, 0, 0, p.in[I_X], p.in[I_CTX], NALL, false);)
    PHASE(2, { EpiStore3 E{COLS + OFF_RW, 1536, 6, COLS + OFF_LO, 512, 8, COLS + OFF_ML, 2048, 0}; run_gemm(lds, ACT, (const bf16_t*)(ws + WS_W_EVIN), NLAT, 4096, 1024, E); E.pm0 = 128; run_gemm(lds, ACT + (size_t)NLAT * 1024, (const bf16_t*)(ws + WS_W_EVIN), NCTX, 4096, 1024, E); })
    PHASE(3, { const int bx = (int)blockIdx.x;
        if (gridDim.x == 256) { if (bx < 64) rwkv_chunk_unit<1>(p, lds, bx); else if (bx < 128) rwkv_chunk_unit<2>(p, lds, bx - 64); else gla_unit<0>(p, lds, bx - 128); }
        else for (int vb = bx; vb < 192; vb += gridDim.x) { if (vb < 64) rwkv_chunk_unit<0>(p, lds, vb); else gla_unit<0>(p, lds, vb - 64); } })
    if (IN(3) && MK_DUP == 303) { grid.sync(); if (blockIdx.x < 64) rwkv_chunk_unit<1>(p, lds, blockIdx.x); grid.sync(); }
    if (IN(3) && MK_DUP == 403) { grid.sync(); if (blockIdx.x >= 64 && blockIdx.x < 128) rwkv_chunk_unit<2>(p, lds, blockIdx.x - 64); grid.sync(); }
    if (IN(3) && MK_DUP == 103) { grid.sync(); for (int vb = blockIdx.x; vb < 64; vb += gridDim.x) rwkv_chunk_unit<0>(p, lds, vb); grid.sync(); }
    if (IN(3) && MK_DUP == 203) { grid.sync(); for (int vb = blockIdx.x; vb < 128; vb += gridDim.x) gla_unit<0>(p, lds, vb); grid.sync(); }
    PHASE(4, phase_mlstm_post(p); phase_rwkv_post2(p, lds);)
    PHASE(5, { EpiResid E{p.in[I_X], p.out, p.in[I_CTX], HC, MODV, 2, 0}; run_gemm(lds, COLS, (const bf16_t*)(ws + WS_W_EVOUT), NLAT, 1024, 1024, E); E.pm0 = 128; run_gemm(lds, COLS + (size_t)NLAT * 1024, (const bf16_t*)(ws + WS_W_EVOUT), NCTX, 1024, 1024, E); })
    PHASE(6, phase_modnorm(p, 0, 1, p.out, HC, NALL, false);)
    PHASE(7, { EpiSwiglu E{COLS, 0}; run_gemm(lds, ACT, (const bf16_t*)(ws + WS_W_UP), NLAT, 5632, 1024, E); E.pm0 = 128; run_gemm(lds, ACT + (size_t)NLAT * 1024, (const bf16_t*)(ws + WS_W_UP), NCTX, 5632, 1024, E); })
    PHASE(8, { EpiResid E{p.out, p.out, HC, HC, MODV, 5, 0}; run_gemm(lds, COLS, (const bf16_t*)(ws + WS_W_DN), NLAT, 1024, 2816, E); E.pm0 = 128; run_gemm(lds, COLS + (size_t)NLAT * 2816, (const bf16_t*)(ws + WS_W_DN), NCTX, 1024, 2816, E); })
    PHASE(9, phase_modnorm(p, 1, 0, p.out, HC, NALL, true);)
    PHASE(10, { EpiStore3 E{COLS, C1LD, 1 << 30, COLS, C1LD, 1 << 30, COLS, C1LD, 0}; run_gemm(lds, ACT, (const bf16_t*)(ws + WS_W_ODIN), NLAT, 3584, 1024, E); E.pm0 = 128; run_gemm(lds, ACT + (size_t)NLAT * 1024, (const bf16_t*)(ws + WS_W_ODIN), NCTX, 3584, 1024, E); })
    PHASE(11, phase_hgrn_prep2(p, lds); lru_pass<1>(p, lds, (int)blockIdx.x, (int)gridDim.x);)
    PHASE(12, { const int half = (int)gridDim.x >> 1; if ((int)blockIdx.x < half) { for (int u = blockIdx.x; u < 128; u += half) gla_unit<1>(p, lds, u); } else lru_pass<3>(p, lds, (int)blockIdx.x - half, (int)gridDim.x - half); })
    if (IN(12) && MK_DUP == 112) { grid.sync(); lru_pass<3>(p, lds, (int)blockIdx.x, (int)gridDim.x); grid.sync(); }
    if (IN(12) && MK_DUP == 212) { grid.sync(); for (int vb = blockIdx.x; vb < 128; vb += gridDim.x) gla_unit<1>(p, lds, vb); grid.sync(); }
    PHASE(13, phase_hgrn_post(p);)
    PHASE(14, EpiResid E{p.out, p.out, HC, HC, MODV + 5 * 6144, 2, 0}; run_gemm(lds, Y1, (const bf16_t*)(ws + WS_W_ODOUT), NLAT, 1024, 1024, E);)
    PHASE(15, phase_modnorm(p, 1, 1, p.out, HC, NLAT, false);)
    PHASE(16, EpiSwiglu E{COLS, 0}; run_gemm(lds, ACT, (const bf16_t*)(ws + WS_W_UP) + W_UP_STRIDE, NLAT, 5632, 1024, E);)
    PHASE(17, EpiResid E{p.out, p.out, HC, HC, MODV + 5 * 6144, 5, 0}; run_gemm(lds, COLS, (const bf16_t*)(ws + WS_W_DN) + W_DN_STRIDE, NLAT, 1024, 2816, E);)
    PHASE(18, phase_finalnorm(p);)
#undef IN
#undef SEAM
}
}

#ifndef MK_ONE_LAUNCH
#define MK_ONE_LAUNCH 1
#endif
extern "C" void kernel_launch(void* const* d_in, const int* in_sizes, int n_in, void* d_out, int out_size, void* d_ws, size_t ws_size, hipStream_t stream) {
    using namespace mk;
    static int grid = 0;
    if (grid == 0) {
        int dev = 0, cus = 0, per_cu = 0;
        if (n_in != N_IN || ws_size < WS_END) { fprintf(stderr, "kernel_launch: unexpected n_in %d / ws_size %zu\n", n_in, ws_size); grid = -1; return; }
        (void)hipGetDevice(&dev); (void)hipDeviceGetAttribute(&cus, hipDeviceAttributeMultiprocessorCount, dev);
        (void)hipFuncSetAttribute((const void*)mk_fwd, hipFuncAttributeMaxDynamicSharedMemorySize, LDS_BYTES);
        (void)hipOccupancyMaxActiveBlocksPerMultiprocessor(&per_cu, (const void*)mk_fwd, NT, LDS_BYTES);
        if (per_cu < 1) { fprintf(stderr, "kernel_launch: occupancy query says %d blocks per CU\n", per_cu); per_cu = 1; }
        (void)hipGetLastError();
        grid = cus;
    }
    if (grid < 0) return;
    if (hipMemsetAsync((char*)d_ws + WS_CTL, 0, 65536, stream) != hipSuccess) { fprintf(stderr, "kernel_launch: memset of the control words failed\n"); return; }
    P p{};
    for (int i = 0; i < N_IN; ++i) p.in[i] = (const float*)d_in[i];
    p.out = (float*)d_out; p.ws = (unsigned char*)d_ws;
#if MK_ONE_LAUNCH
    p.ph_lo = 0; p.ph_hi = N_PHASES;
    void* args[] = {&p};
    hipError_t e = hipLaunchCooperativeKernel((const void*)mk_fwd, dim3(grid), dim3(NT), args, LDS_BYTES, stream);
    if (e != hipSuccess) fprintf(stderr, "cooperative launch failed: %s (grid %d)\n", hipGetErrorString(e), grid);
#else
    for (int k = 0; k < N_PHASES; ++k) { p.ph_lo = k; p.ph_hi = k + 1; hipLaunchKernelGGL(mk_fwd, dim3(grid), dim3(NT), LDS_BYTES, stream, p); }
#endif
}
```

```cpp
#include <hip/hip_runtime.h>
#include <hip/hip_cooperative_groups.h>
#include <cstdio>
#include <cstdint>
__device__ __forceinline__ int mk_tid() { int t = threadIdx.x; asm volatile("" : "+v"(t)); return t; }
#define MK_DUP -1
#define MK_RDUP -1
namespace pg8 {
#define PG8_LAS __attribute__((address_space(3)))
typedef unsigned short bf16_t;
typedef short bf16x8 __attribute__((ext_vector_type(8)));
typedef float f32x4 __attribute__((ext_vector_type(4)));
typedef unsigned u32x4 __attribute__((ext_vector_type(4)));
constexpr int BM = 256, BK = 64, HALF = 128, HTB = HALF * BK * 2  , STAGE_BYTES = 8 * HTB, NXCD = 8, WGM = 8;

__host__ __device__ __forceinline__ int lds_byte(int r, int c) { const int st = (r >> 4) * 2 + (c >> 5), rr = r & 15, cc = c & 31, ob = rr * 64 + cc * 2; return st * 1024 + (ob ^ (((ob >> 9) & 1) << 5)); }
__host__ __device__ __forceinline__ void stage_rc(int b, int& R, int& C) { const int st = b / 1024, sb = b % 1024, swz = sb ^ (((sb >> 9) & 1) << 5); R = (st >> 1) * 16 + swz / 64; C = (st & 1) * 32 + (swz % 64) / 2; }
__host__ __device__ __forceinline__ int perm32(int rho) { const int n = rho >> 4, i = rho & 15; return 8 * (i >> 2) + 4 * n + (i & 3); }

struct Unit { int pm, pn; };
struct Gemm { const bf16_t* A; const bf16_t* Bt; int M, N, K; };

struct StaticOrder {
    int nM, nN, nwg, G, c;
    __host__ __device__ void init(int M, int N, int G_, int c_) { nM = M / BM; nN = N / BM; nwg = nM * nN; G = G_; c = c_; }
    __host__ __device__ bool next(int i, Unit& u) const {
        const long L = (long)i * G + c; if (L >= nwg) return false;
        int wgid = (int)L; { const int q = nwg / NXCD, r = nwg % NXCD, xcd = wgid % NXCD, off = wgid / NXCD; wgid = (xcd < r ? xcd * (q + 1) : r * (q + 1) + (xcd - r) * q) + off; }
        const int nig = WGM * nN, gid = wgid / nig, fm = gid * WGM, gsz = (nM - fm) < WGM ? (nM - fm) : WGM;
        u.pm = fm + ((wgid % nig) % gsz); u.pn = (wgid % nig) / gsz; return true;
    }
    __device__ __forceinline__ void a_ready(const Unit&) const {}
    __device__ __forceinline__ void done(const Unit&) const {}
};
__device__ __forceinline__ unsigned cvt_pk_bf16(float lo, float hi) { unsigned r; asm volatile("v_cvt_pk_bf16_f32 %0, %1, %2" : "=v"(r) : "v"(lo), "v"(hi)); return r; }
typedef float f32x2 __attribute__((ext_vector_type(2)));
template <class Epi, class Sched, bool STAMP = false>
__device__ __forceinline__ void gemm_phase(PG8_LAS unsigned char* lds, const Gemm g, const Sched& S, const Epi& E, unsigned long long* stamps) {
    const int tid = mk_tid(), wid = __builtin_amdgcn_readfirstlane(tid >> 6), lane = tid & 63, wr = wid >> 2, wc = wid & 3, fr = lane & 15, fq = lane >> 4;
    const int K = g.K, nt = K / BK;
    int ts_lo = 0, ts_hi = 0, nts = 0; const unsigned long long rt_entry = STAMP ? (unsigned long long)wall_clock64() : 0ull;
#define PG8_STAMP() do { if (STAMP && wid == 0 && nts < 64) { const unsigned long long _c = (unsigned long long)clock64(); \
        ts_lo = (lane == nts) ? (int)(unsigned)_c : ts_lo; ts_hi = (lane == nts) ? (int)(unsigned)(_c >> 32) : ts_hi; ++nts; } } while (0)
    PG8_STAMP();
    unsigned voffA[2], voffB[2];
#pragma unroll
    for (int i = 0; i < 2; ++i) { int R, C; stage_rc(tid * 16 + i * 8192, R, C); const int Rb = Epi::PERM ? ((R & ~31) + perm32(R & 31)) : R;
        voffA[i] = (unsigned)(R * K + C) * 2u; voffB[i] = (unsigned)(Rb * K + C) * 2u; }
    const size_t kstep = (size_t)(BK * 2);
    const size_t hstep = (size_t)HALF * K * 2;
    const size_t tstep = 2 * hstep;
    const unsigned ldsw = (unsigned)wid * 1024u;
    const int aoff = lds_byte(wr * 64 + fr, fq * 8), boff = lds_byte(wc * 32 + fr, fq * 8);
#define PG8_SA(b, h) (((b) * 2 + (h)) * HTB)
#define PG8_SB(b, h) ((4 + (b) * 2 + (h)) * HTB)
#define PG8_STAGE(bufoff, gbase, voff) do { _Pragma("unroll") for (int _i = 0; _i < 2; ++_i) \
        __builtin_amdgcn_global_load_lds((const unsigned*)((const char*)(gbase) + (voff)[_i]), (PG8_LAS unsigned*)(lds + (bufoff) + ldsw + _i * 8192), 16, 0, 0); } while (0)
#define PG8_LDA(dst, b, h) do { _Pragma("unroll") for (int m = 0; m < 4; ++m) _Pragma("unroll") for (int k = 0; k < 2; ++k) dst[m][k] = *(const PG8_LAS bf16x8*)(lds + PG8_SA(b, h) + aoff + m * 2048 + k * 1024); } while (0)
#define PG8_LDB(dst, b, h) do { _Pragma("unroll") for (int n = 0; n < 2; ++n) _Pragma("unroll") for (int k = 0; k < 2; ++k) dst[n][k] = *(const PG8_LAS bf16x8*)(lds + PG8_SB(b, h) + boff + n * 2048 + k * 1024); } while (0)
#define PG8_MMA(ai, bj, At, Bt) do { __builtin_amdgcn_s_setprio(1); _Pragma("unroll") for (int m = 0; m < 4; ++m) _Pragma("unroll") for (int n = 0; n < 2; ++n) _Pragma("unroll") for (int k = 0; k < 2; ++k) \
        acc[ai][bj][m][n] = __builtin_amdgcn_mfma_f32_16x16x32_bf16(Bt[n][k], At[m][k], acc[ai][bj][m][n], 0, 0, 0); __builtin_amdgcn_s_setprio(0); } while (0)
#define PG8_WAIT_V(n) asm volatile("s_waitcnt vmcnt(" #n ")" ::: "memory")
#define PG8_WAIT_L(n) asm volatile("s_waitcnt lgkmcnt(" #n ")" ::: "memory")
#define PG8_BAR __builtin_amdgcn_s_barrier()
#define PG8_SCHED __builtin_amdgcn_sched_barrier(0)
    Unit cur, nxt; int ui = 0;
    if (!S.next(0, cur)) return;
    f32x4 acc[2][2][4][2];
#pragma unroll
    for (int a = 0; a < 2; ++a)
#pragma unroll
        for (int b = 0; b < 2; ++b)
#pragma unroll
            for (int m = 0; m < 4; ++m)
#pragma unroll
                for (int n = 0; n < 2; ++n) acc[a][b][m][n] = (f32x4){0.f, 0.f, 0.f, 0.f};
    bf16x8 At[4][2], B0[2][2], B1[2][2];
    const char* cA = (const char*)g.A + (size_t)cur.pm * tstep; const char* cB = (const char*)g.Bt + (size_t)cur.pn * tstep;
    S.a_ready(cur);
    PG8_STAGE(PG8_SB(0, 0), cB, voffB); PG8_STAGE(PG8_SA(0, 0), cA, voffA); PG8_STAGE(PG8_SB(0, 1), cB + hstep, voffB); PG8_STAGE(PG8_SA(0, 1), cA + hstep, voffA);
    if (wr == 1) PG8_BAR;
    PG8_WAIT_V(4); PG8_BAR;
    PG8_STAGE(PG8_SB(1, 0), cB + kstep, voffB); PG8_STAGE(PG8_SA(1, 0), cA + kstep, voffA); PG8_STAGE(PG8_SB(1, 1), cB + hstep + kstep, voffB);
    PG8_WAIT_V(6); PG8_BAR;
    PG8_STAMP();
    for (;;) {
        const bool has_next = S.next(ui + 1, nxt);
        const char* nA = has_next ? (const char*)g.A + (size_t)nxt.pm * tstep : cA; const char* nB = has_next ? (const char*)g.Bt + (size_t)nxt.pn * tstep : cB;
        for (int t = 0; t < nt; t += 2) {
            const bool last = (t == nt - 2);
            const char* a1 = cA + (size_t)(t + 1) * kstep;
            const char* a2 = last ? nA : cA + (size_t)(t + 2) * kstep; const char* b2 = last ? nB : cB + (size_t)(t + 2) * kstep;
            const char* a3 = a2 + kstep; const char* b3 = b2 + kstep;
            if (last && has_next) S.a_ready(nxt);
            PG8_LDB(B0, 0, 0); PG8_SCHED; PG8_LDA(At, 0, 0); PG8_STAGE(PG8_SA(1, 1), a1 + hstep, voffA);
            PG8_WAIT_L(8); PG8_BAR; PG8_WAIT_L(0); PG8_MMA(0, 0, At, B0); PG8_BAR; PG8_SCHED;
            PG8_LDB(B1, 0, 1); PG8_STAGE(PG8_SB(0, 0), b2, voffB);
            PG8_BAR; PG8_WAIT_L(0); PG8_MMA(0, 1, At, B1); PG8_BAR;
            PG8_LDA(At, 0, 1); PG8_STAGE(PG8_SA(0, 0), a2, voffA);
            PG8_BAR; PG8_WAIT_L(0); PG8_MMA(1, 0, At, B0); PG8_BAR; PG8_SCHED;
            PG8_STAGE(PG8_SB(0, 1), b2 + hstep, voffB);
            PG8_WAIT_V(6); PG8_BAR; PG8_MMA(1, 1, At, B1); PG8_BAR;
            PG8_LDB(B0, 1, 0); PG8_SCHED; PG8_LDA(At, 1, 0); PG8_STAGE(PG8_SA(0, 1), a2 + hstep, voffA);
            PG8_WAIT_L(8); PG8_BAR; PG8_WAIT_L(0); PG8_MMA(0, 0, At, B0); PG8_BAR; PG8_SCHED;
            PG8_LDB(B1, 1, 1); PG8_STAGE(PG8_SB(1, 0), b3, voffB);
            PG8_BAR; PG8_WAIT_L(0); PG8_MMA(0, 1, At, B1); PG8_BAR;
            PG8_LDA(At, 1, 1); PG8_STAGE(PG8_SA(1, 0), a3, voffA);
            PG8_BAR; PG8_WAIT_L(0); PG8_MMA(1, 0, At, B0); PG8_BAR; PG8_SCHED;
            PG8_STAGE(PG8_SB(1, 1), b3 + hstep, voffB);
            PG8_WAIT_V(6); PG8_BAR; PG8_MMA(1, 1, At, B1); PG8_BAR;
        }
        PG8_STAMP();
        if constexpr (!Epi::AFTER_DRAIN) { E(acc, cur, wr, wc, fr, fq); S.done(cur); }
        PG8_STAMP();
        if (!has_next) break;
#pragma unroll
        for (int a = 0; a < 2; ++a)
#pragma unroll
            for (int b = 0; b < 2; ++b)
#pragma unroll
                for (int m = 0; m < 4; ++m)
#pragma unroll
                    for (int n = 0; n < 2; ++n) acc[a][b][m][n] = (f32x4){0.f, 0.f, 0.f, 0.f};
        cur = nxt; cA = nA; cB = nB; ++ui;
    }
    PG8_WAIT_V(0);
    if (wr == 0) PG8_BAR;
    PG8_BAR;
    if constexpr (Epi::AFTER_DRAIN) { E.fused(acc, cur, wr, wc, fr, fq, lds, wid, lane); S.done(cur); }
    PG8_STAMP();
    if (STAMP && wid == 0) { stamps[lane] = lane < nts ? (((unsigned long long)(unsigned)ts_hi << 32) | (unsigned)ts_lo) : 0ull;
        if (lane == 62) stamps[62] = rt_entry; if (lane == 63) stamps[63] = (unsigned long long)wall_clock64(); }
#undef PG8_STAMP
#undef PG8_SA
#undef PG8_SB
#undef PG8_STAGE
#undef PG8_LDA
#undef PG8_LDB
#undef PG8_MMA
#undef PG8_WAIT_V
#undef PG8_WAIT_L
#undef PG8_BAR
#undef PG8_SCHED
}
}

namespace mk {
#define DI __device__ __forceinline__
#define LAS __attribute__((address_space(3)))
typedef unsigned short bf16_t;
typedef float f32x4 __attribute__((ext_vector_type(4)));
typedef unsigned u32x2 __attribute__((ext_vector_type(2)));
typedef unsigned u32x4 __attribute__((ext_vector_type(4)));

constexpr int D = 1024, NB = 4, L = 8192, LC = 256, NLAT = NB * L, NCTX = NB * LC, NALL = NLAT + NCTX, LT = L + LC, DFF = 2816;
constexpr int NT = 512;
constexpr size_t MiB = (size_t)1 << 20;
constexpr size_t WS_CTL = 0, WS_MODV = 1 * MiB, WS_HC = 2 * MiB, WS_W_EVIN = 6 * MiB, WS_W_EVOUT = 14 * MiB, WS_W_ODIN = 16 * MiB, WS_W_ODOUT = 23 * MiB,
                 WS_W_UP = 25 * MiB, WS_W_DN = 47 * MiB, WS_ACT = 58 * MiB, WS_COLS = 124 * MiB, WS_Z = 388 * MiB, WS_Z1 = 454 * MiB, WS_LAM = 486 * MiB, WS_LSUM = 489 * MiB, WS_LCAR = 494 * MiB, WS_SSQP = 497 * MiB, WS_GSC = 504 * MiB, WS_END = 505 * MiB;
constexpr size_t SSQP_STRIDE = (size_t)NALL * 16, GSC_STRIDE = 5 * 1024, SHW_OFF = 3 * GSC_STRIDE, SHW_STRIDE = 5 * 5632;
constexpr size_t W_UP_STRIDE = (size_t)5632 * 1024, W_DN_STRIDE = (size_t)1024 * 2816;
constexpr size_t OFF_RW = 0, OFF_LO = (size_t)NALL * 1536, OFF_ML = OFF_LO + (size_t)NALL * 512;
constexpr int LDS_BYTES = 163840;
constexpr int C1LD = 3584;
DI int nat_row(int r) { const int b = r / L, pp = r % L; return b * L + (pp % 128) * 64 + pp / 128; }

enum { I_X = 0, I_C, I_CTX, I_CCTX, I_N1G, I_N2G, I_MODW, I_MODB, I_W1, I_W3, I_W2, I_FING, I_EVIN, I_EVOUT, I_MU, I_W0, I_W2L, I_A0, I_A2L, I_KK, I_KA, I_RK,
       I_LNW, I_LNB, I_G2, I_MBI, I_MBF, I_MNG, I_ODIN, I_ODOUT, I_HLB, I_HNG, I_CONVW, I_CONVB, I_WA, I_BA, I_WI, I_BI, I_LAM, N_IN };

struct P { const float* in[N_IN]; float* out; unsigned char* ws; int ph_lo, ph_hi; };

DI float bf2f(bf16_t v) { return __uint_as_float(((unsigned)v) << 16); }
typedef float f32x2_t __attribute__((ext_vector_type(2)));
typedef __bf16 bf16x2_t __attribute__((ext_vector_type(2)));
DI unsigned pack2(float lo, float hi) { const f32x2_t v = {lo, hi}; return __builtin_bit_cast(unsigned, __builtin_convertvector(v, bf16x2_t)); }
DI bf16_t f2bf(float f) { return (bf16_t)(pack2(f, f) & 0xffffu); }
DI float sigm(float x) { return 1.f / (1.f + expf(-x)); }
DI float siluf(float x) { return x * sigm(x); }
DI float geluf(float x) { return 0.5f * x * (1.f + tanhf(0.7978845608028654f * (x + 0.044715f * x * x * x))); }
DI float fexp(float x) { return __builtin_amdgcn_exp2f(x * 1.4426950408889634f); }
DI float frcp(float x) { return __builtin_amdgcn_rcpf(x); }
DI float fsigm(float x) { return frcp(1.f + fexp(-x)); }
DI float ftanh(float x) { return 1.f - 2.f * frcp(1.f + fexp(2.f * x)); }
DI float fgelu(float x) { return 0.5f * x * (1.f + ftanh(0.7978845608028654f * (x + 0.044715f * x * x * x))); }
template <int CTRL> DI float dppf(float x) { return __int_as_float(__builtin_amdgcn_update_dpp(0, __float_as_int(x), CTRL, 0xF, 0xF, false)); }
DI float sum8(float s) { s += dppf<0xB1>(s); s += dppf<0x4E>(s); s += dppf<0x141>(s); return s; }
DI float scan16(float x) { x += dppf<0x111>(x); x += dppf<0x112>(x); x += dppf<0x114>(x); x += dppf<0x118>(x); return x; }
DI float wave_sum(float v) { v += dppf<0xB1>(v); v += dppf<0x4E>(v); v += dppf<0x141>(v); v += dppf<0x140>(v); v += __shfl_xor(v, 16); v += __shfl_xor(v, 32); return v; }
DI int step_row(int d, int b, int n) {
    if (n < LC) return NLAT + b * LC + (d ? LC - 1 - n : n);
    const int m = n - LC; return b * L + (d ? L - 1 - m : m);
}

DI int matN(int m) { return m == 0 ? 4096 : m == 1 ? 1024 : m == 2 ? 3584 : m == 3 ? 1024 : m < 6 ? 5632 : 1024; }
DI int matK(int m) { return m < 6 ? 1024 : 2816; }
DI int matTile0(int m) { return m == 0 ? 0 : m == 1 ? 1024 : m == 2 ? 1280 : m == 3 ? 2176 : m == 4 ? 2432 : m == 5 ? 3840 : m == 6 ? 5248 : m == 7 ? 5952 : 6656; }
DI size_t matOff(int m) { return m == 0 ? WS_W_EVIN : m == 1 ? WS_W_EVOUT : m == 2 ? WS_W_ODIN : m == 3 ? WS_W_ODOUT : m == 4 ? WS_W_UP : m == 5 ? WS_W_UP + W_UP_STRIDE * 2 : m == 6 ? WS_W_DN : WS_W_DN + W_DN_STRIDE * 2; }
DI const float* matSrc(const P& p, int m, int n, int& ld) {
    if (m == 0) { ld = 3984; int col; if (n < 1920) col = n; else if (n < 1936) col = 3968 + (n - 1920); else if (n < 2048) return nullptr; else col = 1920 + (n - 2048); return p.in[I_EVIN] + col; }
    if (m == 1) { ld = 1024; return p.in[I_EVOUT] + n; }
    if (m == 2) { ld = 3584; return p.in[I_ODIN] + n; }
    if (m == 3) { ld = 1024; return p.in[I_ODOUT] + n; }
    if (m < 6) { ld = 2816; const int l = m - 4, pn = n >> 8, w = n & 255; const size_t lo = (size_t)l * 1024 * 2816; return (w < 128) ? p.in[I_W1] + lo + 128 * pn + w : p.in[I_W3] + lo + 128 * pn + (w - 128); }
    ld = 1024; return p.in[I_W2] + (size_t)(m - 6) * 2816 * 1024 + n;
}
DI void phase_wprep(const P& p, LAS unsigned char* ldsb) {
    LAS float* tile = (LAS float*)ldsb;
    const int tid = mk_tid(), tx = tid & 63, ty = tid >> 6;
    for (int item = blockIdx.x; item < 6656; item += gridDim.x) {
        int m = 0;
#pragma unroll
        for (int q = 1; q < 8; ++q) if (item >= matTile0(q)) m = q;
        const int local = item - matTile0(m), K = matK(m), nK = K >> 6, nb = local / nK, kb = local - nb * nK, n0 = nb * 64, k0 = kb * 64;
        bf16_t* Bt = (bf16_t*)(p.ws + matOff(m));
        int ld; const float* src = matSrc(p, m, n0 + tx, ld);
        __syncthreads();
#pragma unroll
        for (int i = 0; i < 8; ++i) { const int k = k0 + ty + 8 * i; tile[(ty + 8 * i) * 65 + tx] = src ? src[(size_t)k * ld] : 0.f; }
        __syncthreads();
#pragma unroll
        for (int i = 0; i < 8; ++i) { const int nn = ty + 8 * i; Bt[(size_t)(n0 + nn) * K + k0 + tx] = f2bf(tile[tx * 65 + nn]); }
    }
    __syncthreads();
}
DI void phase_modv(const P& p, LAS unsigned char* ldsb) {
    LAS float* sc = (LAS float*)ldsb;
    const int tid = mk_tid();
    float* MODV = (float*)(p.ws + WS_MODV);
    __syncthreads();
    for (int e = tid; e < 5 * 1024; e += NT) { const int s = e >> 10, k = e & 1023; const float v = (s < 4) ? p.in[I_C][s * 1024 + k] : p.in[I_CCTX][k]; sc[e] = siluf(v); }
    __syncthreads();
    for (int vb = blockIdx.x; vb < 24; vb += gridDim.x) {
        const int l = vb / 12, n = (vb % 12) * 512 + tid;
        const float* W = p.in[I_MODW] + (size_t)l * 1024 * 6144 + n;
        float a0 = 0.f, a1 = 0.f, a2 = 0.f, a3 = 0.f, a4 = 0.f;
#pragma unroll 8
        for (int k = 0; k < 1024; ++k) { const float w = W[(size_t)k * 6144]; a0 += sc[k] * w; a1 += sc[1024 + k] * w; a2 += sc[2048 + k] * w; a3 += sc[3072 + k] * w; a4 += sc[4096 + k] * w; }
        const float bb = p.in[I_MODB][l * 6144 + n];
        float* o = MODV + (size_t)l * 5 * 6144 + n;
        o[0] = a0 + bb; o[6144] = a1 + bb; o[2 * 6144] = a2 + bb; o[3 * 6144] = a3 + bb; o[4 * 6144] = a4 + bb;
    }
    __syncthreads();
}

DI void phase_modnorm(const P& p, int layer, int which, const float* hlat, const float* hctx, int nrows, bool permute) {
    const int lane = mk_tid() & 63, wv = mk_tid() >> 6;
    const float* MODV = (const float*)(p.ws + WS_MODV) + (size_t)layer * 5 * 6144;
    const float* g = p.in[which ? I_N2G : I_N1G] + layer * 1024;
    bf16_t* ACT = (bf16_t*)(p.ws + WS_ACT);
    f32x4 gs[4], sh[4]; int sv_have = -1;
    const int rstep = gridDim.x * 8; int r = blockIdx.x * 8 + wv;
    f32x4 v[4], vn[4];
#define MN_SRC(rr) (((rr) >= NLAT) ? hctx + (size_t)((rr) - NLAT) * D : hlat + (size_t)(rr) * D)
    if (r < nrows) { const float* src = MN_SRC(r);
#pragma unroll
        for (int j = 0; j < 4; ++j) v[j] = *(const f32x4*)(src + 4 * lane + 256 * j); }
    for (; r < nrows; r += rstep) {
        const bool isctx = r >= NLAT; const int sv = isctx ? 4 : r / L;
        if (r + rstep < nrows) { const float* src = MN_SRC(r + rstep);
#pragma unroll
            for (int j = 0; j < 4; ++j) vn[j] = *(const f32x4*)(src + 4 * lane + 256 * j); }
        if (sv != sv_have) { sv_have = sv; const float* shift = MODV + sv * 6144 + (which ? 3 : 0) * 1024; const float* scale = shift + 1024;
#pragma unroll
            for (int j = 0; j < 4; ++j) { const int c = 4 * lane + 256 * j; const f32x4 gg = *(const f32x4*)(g + c), sc = *(const f32x4*)(scale + c); gs[j] = gg * (sc + 1.f); sh[j] = *(const f32x4*)(shift + c); } }
        int dr = r;
        if (permute && !isctx) { const int b = r / L, t = r % L; dr = b * L + (t % 64) * 128 + t / 64; }
        float ss = 0.f;
#pragma unroll
        for (int j = 0; j < 4; ++j) ss += (v[j].x * v[j].x + v[j].y * v[j].y) + (v[j].z * v[j].z + v[j].w * v[j].w);
        const float rinv = rsqrtf(wave_sum(ss) * (1.f / D) + 1e-6f);
#pragma unroll
        for (int j = 0; j < 4; ++j) { const int c = 4 * lane + 256 * j; const f32x4 o = v[j] * rinv * gs[j] + sh[j];
            u32x2 w; w.x = pack2(o[0], o[1]); w.y = pack2(o[2], o[3]);
            *(u32x2*)(ACT + (size_t)dr * D + c) = w; v[j] = vn[j]; }
    }
#undef MN_SRC
}
DI void phase_finalnorm(const P& p) {
    const int lane = mk_tid() & 63, wv = mk_tid() >> 6;
    const float* g = p.in[I_FING];
    f32x4 gg[4];
#pragma unroll
    for (int j = 0; j < 4; ++j) gg[j] = *(const f32x4*)(g + 4 * lane + 256 * j);
    const int rstep = gridDim.x * 8; int r = blockIdx.x * 8 + wv;
    f32x4 v[4], vn[4];
    if (r < NLAT) {
#pragma unroll
        for (int j = 0; j < 4; ++j) v[j] = *(const f32x4*)(p.out + (size_t)r * D + 4 * lane + 256 * j); }
    for (; r < NLAT; r += rstep) {
        if (r + rstep < NLAT) {
#pragma unroll
            for (int j = 0; j < 4; ++j) vn[j] = *(const f32x4*)(p.out + (size_t)(r + rstep) * D + 4 * lane + 256 * j); }
        float ss = 0.f;
#pragma unroll
        for (int j = 0; j < 4; ++j) ss += (v[j].x * v[j].x + v[j].y * v[j].y) + (v[j].z * v[j].z + v[j].w * v[j].w);
        const float rinv = rsqrtf(wave_sum(ss) * (1.f / D) + 1e-6f);
#pragma unroll
        for (int j = 0; j < 4; ++j) { *(f32x4*)(p.out + (size_t)r * D + 4 * lane + 256 * j) = v[j] * rinv * gg[j]; v[j] = vn[j]; }
    }
}

struct EpiStore3 {
    static constexpr bool PERM = true, AFTER_DRAIN = false;
    bf16_t* p0; int ld0; int pn1; bf16_t* p1; int ld1; int pn2; bf16_t* p2; int ld2; int pm0;
    DI void operator()(const f32x4 (&acc)[2][2][4][2], const pg8::Unit& u, int wr, int wc, int fr, int fq) const {
        bf16_t* base; int ld, ct;
        if (u.pn >= pn2) { base = p2; ld = ld2; ct = u.pn - pn2; } else if (u.pn >= pn1) { base = p1; ld = ld1; ct = u.pn - pn1; } else { base = p0; ld = ld0; ct = u.pn; }
        const int row0 = (u.pm + pm0) * 256 + wr * 64 + fr, col0 = ct * 256 + wc * 32 + 8 * fq;
#pragma unroll
        for (int ai = 0; ai < 2; ++ai)
#pragma unroll
            for (int m = 0; m < 4; ++m) { bf16_t* rowp = base + (size_t)(row0 + ai * 128 + m * 16) * ld + col0;
#pragma unroll
                for (int bj = 0; bj < 2; ++bj) { const f32x4 v0 = acc[ai][bj][m][0], v1 = acc[ai][bj][m][1];
                    u32x4 w; w.x = pack2(v0[0], v0[1]); w.y = pack2(v0[2], v0[3]); w.z = pack2(v1[0], v1[1]); w.w = pack2(v1[2], v1[3]); *(u32x4*)(rowp + bj * 128) = w; } }
    }
};
struct EpiResid {
    static constexpr bool PERM = false, AFTER_DRAIN = false;
    const float* hin; float* hout; const float* cin; float* cout; const float* modv_l; int gidx; int pm0;
    DI void operator()(const f32x4 (&acc)[2][2][4][2], const pg8::Unit& u, int wr, int wc, int fr, int fq) const {
        const int pm = u.pm + pm0; const bool isctx = pm >= 128; const int sv = isctx ? 4 : (pm >> 5);
        const float* gate = modv_l + sv * 6144 + gidx * 1024;
        const float* bi = isctx ? cin : hin; float* bo = isctx ? cout : hout;
        const int row0 = (isctx ? (pm - 128) : pm) * 256 + wr * 64 + fr, col0 = u.pn * 256 + wc * 32 + 4 * fq;
        f32x4 gv[2][2];
#pragma unroll
        for (int bj = 0; bj < 2; ++bj)
#pragma unroll
            for (int n = 0; n < 2; ++n) gv[bj][n] = *(const f32x4*)(gate + col0 + bj * 128 + n * 16);
#pragma unroll
        for (int ai = 0; ai < 2; ++ai)
#pragma unroll
            for (int m = 0; m < 4; ++m) { const size_t off = (size_t)(row0 + ai * 128 + m * 16) * D + col0;
#pragma unroll
                for (int bj = 0; bj < 2; ++bj)
#pragma unroll
                    for (int n = 0; n < 2; ++n) { const f32x4 bs = *(const f32x4*)(bi + off + bj * 128 + n * 16); *(f32x4*)(bo + off + bj * 128 + n * 16) = bs + gv[bj][n] * acc[ai][bj][m][n]; } }
    }
};
struct EpiResidN {
    static constexpr bool PERM = false, AFTER_DRAIN = false;
    const float* hin; float* hout; const float* cin; float* cout; const float* modv_l; int gidx;
    bf16_t* act; const float* gsc; float* ssqp; int permute;
    DI void operator()(const f32x4 (&acc)[2][2][4][2], const pg8::Unit& u, int wr, int wc, int fr, int fq) const {
        const bool isctx = u.pm >= 128; const int sv = isctx ? 4 : (u.pm >> 5);
        const float* gate = modv_l + sv * 6144 + gidx * 1024; const float* gs = gsc + sv * 1024;
        const float* bi = isctx ? cin : hin; float* bo = isctx ? cout : hout;
        const int row0 = (isctx ? (u.pm - 128) : u.pm) * 256 + wr * 64 + fr, col0 = u.pn * 256 + wc * 32 + 4 * fq;
        f32x4 gv[2][2], gsv[2][2];
#pragma unroll
        for (int bj = 0; bj < 2; ++bj)
#pragma unroll
            for (int n = 0; n < 2; ++n) { gv[bj][n] = *(const f32x4*)(gate + col0 + bj * 128 + n * 16); gsv[bj][n] = *(const f32x4*)(gs + col0 + bj * 128 + n * 16); }
#pragma unroll
        for (int ai = 0; ai < 2; ++ai)
#pragma unroll
            for (int m = 0; m < 4; ++m) { const int rl = row0 + ai * 128 + m * 16; const size_t off = (size_t)rl * D + col0;
                int arow = u.pm * 256 + wr * 64 + fr + ai * 128 + m * 16;
                if (permute && !isctx) { const int b = arow / L, t = arow % L; arow = b * L + (t % 64) * 128 + t / 64; }
                float ss = 0.f;
#pragma unroll
                for (int bj = 0; bj < 2; ++bj)
#pragma unroll
                    for (int n = 0; n < 2; ++n) { const f32x4 bs = *(const f32x4*)(bi + off + bj * 128 + n * 16); const f32x4 hn = bs + gv[bj][n] * acc[ai][bj][m][n];
                        *(f32x4*)(bo + off + bj * 128 + n * 16) = hn; ss += (hn[0] * hn[0] + hn[1] * hn[1]) + (hn[2] * hn[2] + hn[3] * hn[3]);
                        const f32x4 an = hn * gsv[bj][n]; u32x2 w; w.x = pack2(an[0], an[1]); w.y = pack2(an[2], an[3]); *(u32x2*)(act + (size_t)arow * D + col0 + bj * 128 + n * 16) = w; }
                ss += __shfl_xor(ss, 16); ss += __shfl_xor(ss, 32);
                if (fq == 0) ssqp[(size_t)arow * 16 + u.pn * 4 + wc] = ss; }
    }
};
struct EpiSwiglu {
    static constexpr bool PERM = true, AFTER_DRAIN = false;
    bf16_t* G; int pm0;
    DI void operator()(const f32x4 (&acc)[2][2][4][2], const pg8::Unit& u, int wr, int wc, int fr, int fq) const {
        const int row0 = (u.pm + pm0) * 256 + wr * 64 + fr, col0 = u.pn * 128 + wc * 32 + 8 * fq;
#pragma unroll
        for (int ai = 0; ai < 2; ++ai)
#pragma unroll
            for (int m = 0; m < 4; ++m) { bf16_t* rowp = G + (size_t)(row0 + ai * 128 + m * 16) * DFF + col0; float g[8];
#pragma unroll
                for (int n = 0; n < 2; ++n) { const f32x4 a = acc[ai][0][m][n], b = acc[ai][1][m][n];
#pragma unroll
                    for (int j = 0; j < 4; ++j) g[4 * n + j] = a[j] * frcp(1.f + fexp(-a[j])) * b[j]; }
                u32x4 w; w.x = pack2(g[0], g[1]); w.y = pack2(g[2], g[3]); w.z = pack2(g[4], g[5]); w.w = pack2(g[6], g[7]); *(u32x4*)rowp = w; }
    }
};
template <class Epi> DI void run_gemm(LAS unsigned char* lds, const bf16_t* A, const bf16_t* Bt, int M, int N, int K, const Epi& E) {
    pg8::Gemm g{A, Bt, M, N, K}; pg8::StaticOrder S; S.init(M, N, (int)gridDim.x, (int)blockIdx.x);
    pg8::gemm_phase<Epi, pg8::StaticOrder, false>((PG8_LAS unsigned char*)lds, g, S, E, nullptr);
    __syncthreads();
}


DI void phase_norm_tables(const P& p) {
    const int tid = mk_tid(), lane = tid & 63, wv = tid >> 6;
    const float* MODV = (const float*)(p.ws + WS_MODV); float* GSC = (float*)(p.ws + WS_GSC); float* SHW = GSC + SHW_OFF;
    for (int e = blockIdx.x * NT + tid; e < 3 * 5 * 1024; e += gridDim.x * NT) { const int site = e / 5120, s = (e / 1024) % 5, c = e & 1023;
        const int layer = site ? 1 : 0, scidx = (site == 1) ? 1 : 4; const float g = p.in[(site == 1) ? I_N1G : I_N2G][layer * 1024 + c];
        GSC[e] = g * (1.f + MODV[(size_t)layer * 5 * 6144 + s * 6144 + scidx * 1024 + c]); }
    for (int w = blockIdx.x * 8 + wv; w < 5632 + 3584 + 5632; w += gridDim.x * 8) {
        int site, n; const bf16_t* Bt;
        if (w < 5632) { site = 0; n = w; Bt = (const bf16_t*)(p.ws + WS_W_UP); } else if (w < 5632 + 3584) { site = 1; n = w - 5632; Bt = (const bf16_t*)(p.ws + WS_W_ODIN); } else { site = 2; n = w - 5632 - 3584; Bt = (const bf16_t*)(p.ws + WS_W_UP) + W_UP_STRIDE; }
        const int layer = site ? 1 : 0, shidx = (site == 1) ? 0 : 3;
        const u32x4 w0 = *(const u32x4*)(Bt + (size_t)n * 1024 + 16 * lane), w1 = *(const u32x4*)(Bt + (size_t)n * 1024 + 16 * lane + 8);
        float wf[16];
#pragma unroll
        for (int k = 0; k < 4; ++k) { wf[2 * k] = __uint_as_float(w0[k] << 16); wf[2 * k + 1] = __uint_as_float(w0[k] & 0xffff0000u); wf[8 + 2 * k] = __uint_as_float(w1[k] << 16); wf[8 + 2 * k + 1] = __uint_as_float(w1[k] & 0xffff0000u); }
#pragma unroll
        for (int s = 0; s < 5; ++s) { const float* sh = MODV + (size_t)layer * 5 * 6144 + s * 6144 + shidx * 1024 + 16 * lane; float a = 0.f;
#pragma unroll
            for (int k = 0; k < 16; ++k) a += sh[k] * wf[k];
            a = wave_sum(a);
            if (lane == 0) SHW[(size_t)site * SHW_STRIDE + s * 5632 + n] = a; }
    }
}
DI void phase_rwkv_scan_unit(const P& p, LAS unsigned char* ldsb, const int vb) {
    LAS float* lds = (LAS float*)ldsb;
    LAS float *w2s = lds, *a2s = lds + 4096, *prm = lds + 8192, *TH = prm + 768, *AD = TH + 2048, *R = AD + 2048, *W = R + 2048, *K = W + 2048, *KK = K + 2048, *BV = KK + 2048,
              *V = BV + 2048, *BS = V + 2048, *OUT = BS + 32;
    const int tid = mk_tid(), lane = tid & 63, wv = tid >> 6;
    const bf16_t* RW = (const bf16_t*)(p.ws + WS_COLS) + OFF_RW; const bf16_t* LO = (const bf16_t*)(p.ws + WS_COLS) + OFF_LO; bf16_t* Z = (bf16_t*)(p.ws + WS_Z);
    const int srow = tid >> 3, sg = tid & 7;
    {
        const int d = vb >> 5, b = (vb >> 3) & 3, h = vb & 7;
        __syncthreads();
        for (int e = tid; e < 4096; e += NT) { const int i = e >> 6, c = e & 63; w2s[e] = p.in[I_W2L][(size_t)(d * 64 + i) * 512 + 64 * h + c]; a2s[e] = p.in[I_A2L][(size_t)(d * 64 + i) * 512 + 64 * h + c]; }
        if (tid < 64) { const int j = tid, c = 64 * h + j; const float* mu = p.in[I_MU] + d * 1664;
            prm[j] = mu[c]; prm[64 + j] = mu[512 + c]; prm[128 + j] = mu[1024 + c]; prm[192 + j] = mu[1536 + j]; prm[256 + j] = mu[1600 + j];
            prm[320 + j] = p.in[I_W0][d * 512 + c]; prm[384 + j] = p.in[I_A0][d * 512 + c]; prm[448 + j] = p.in[I_KK][d * 512 + c]; prm[512 + j] = p.in[I_KA][d * 512 + c];
            prm[576 + j] = p.in[I_RK][(d * 8 + h) * 64 + j]; prm[640 + j] = p.in[I_LNW][d * 512 + c]; prm[704 + j] = p.in[I_LNB][d * 512 + c]; }
        __syncthreads();
        float S0 = 0.f, S1 = 0.f, S2 = 0.f, S3 = 0.f, S4 = 0.f, S5 = 0.f, S6 = 0.f, S7 = 0.f;
        for (int n0 = 0; n0 < LT; n0 += 32) {
            float rs[4], ks[4], vs[4];
#pragma unroll
            for (int m = 0; m < 4; ++m) { const int s = wv + 8 * m, n = n0 + s; const bool hp = (n != 0) && (n != LC);
                const size_t row = (size_t)step_row(d, b, n), prow = hp ? (size_t)step_row(d, b, n - 1) : row; const int c = 64 * h + lane;
                const float r0 = bf2f(RW[row * 1536 + c]), k0 = bf2f(RW[row * 1536 + 512 + c]), v0 = bf2f(RW[row * 1536 + 1024 + c]);
                const float r1 = hp ? bf2f(RW[prow * 1536 + c]) : 0.f, k1 = hp ? bf2f(RW[prow * 1536 + 512 + c]) : 0.f, v1 = hp ? bf2f(RW[prow * 1536 + 1024 + c]) : 0.f;
                rs[m] = r0 + prm[lane] * (r1 - r0); ks[m] = k0 + prm[64 + lane] * (k1 - k0); vs[m] = v0 + prm[128 + lane] * (v1 - v0);
                const float wd0 = bf2f(LO[row * 512 + 64 * d + lane]), wd1 = hp ? bf2f(LO[prow * 512 + 64 * d + lane]) : 0.f;
                const float ad0 = bf2f(LO[row * 512 + 128 + 64 * d + lane]), ad1 = hp ? bf2f(LO[prow * 512 + 128 + 64 * d + lane]) : 0.f;
                TH[s * 64 + lane] = tanhf(wd0 + prm[192 + lane] * (wd1 - wd0)); AD[s * 64 + lane] = ad0 + prm[256 + lane] * (ad1 - ad0); }
            __syncthreads();
#pragma unroll
            for (int m = 0; m < 4; ++m) { const int s = wv + 8 * m;
                float xw = prm[320 + lane], xa = prm[384 + lane];
#pragma unroll 8
                for (int i = 0; i < 64; ++i) { xw += TH[s * 64 + i] * w2s[i * 64 + lane]; xa += AD[s * 64 + i] * a2s[i * 64 + lane]; }
                const float elog = 0.6065306597126334f * sigm(xw), dec = expf(-elog), a = sigm(xa);
                const float kkr = ks[m] * prm[448 + lane]; const float ss = wave_sum(kkr * kkr); const float kkn = kkr / fmaxf(sqrtf(ss), 1e-12f);
                const float km = ks[m] * (1.f + (a - 1.f) * prm[512 + lane]);
                const float bs = wave_sum(rs[m] * km * prm[576 + lane]);
                R[s * 64 + lane] = rs[m]; W[s * 64 + lane] = dec; K[s * 64 + lane] = km; KK[s * 64 + lane] = kkn; BV[s * 64 + lane] = kkn * a; V[s * 64 + lane] = vs[m];
                if (lane == 0) BS[s] = bs; }
            __syncthreads();
            for (int s = 0; s < 32; ++s) {
                const LAS f32x4* pq = (const LAS f32x4*)(KK + s * 64 + 8 * sg); const f32x4 q0 = pq[0], q1 = pq[1];
                const LAS f32x4* pw = (const LAS f32x4*)(W + s * 64 + 8 * sg); const f32x4 w0 = pw[0], w1 = pw[1];
                const LAS f32x4* pb = (const LAS f32x4*)(BV + s * 64 + 8 * sg); const f32x4 b0 = pb[0], b1 = pb[1];
                const LAS f32x4* pk = (const LAS f32x4*)(K + s * 64 + 8 * sg); const f32x4 k0 = pk[0], k1 = pk[1];
                const LAS f32x4* pr = (const LAS f32x4*)(R + s * 64 + 8 * sg); const f32x4 r0 = pr[0], r1 = pr[1];
                const float vi = V[s * 64 + srow];
                float sa = S0 * q0.x + S1 * q0.y + S2 * q0.z + S3 * q0.w + S4 * q1.x + S5 * q1.y + S6 * q1.z + S7 * q1.w;
                sa += __shfl_xor(sa, 1); sa += __shfl_xor(sa, 2); sa += __shfl_xor(sa, 4);
                S0 = S0 * w0.x - sa * b0.x + vi * k0.x; S1 = S1 * w0.y - sa * b0.y + vi * k0.y; S2 = S2 * w0.z - sa * b0.z + vi * k0.z; S3 = S3 * w0.w - sa * b0.w + vi * k0.w;
                S4 = S4 * w1.x - sa * b1.x + vi * k1.x; S5 = S5 * w1.y - sa * b1.y + vi * k1.y; S6 = S6 * w1.z - sa * b1.z + vi * k1.z; S7 = S7 * w1.w - sa * b1.w + vi * k1.w;
                float o = S0 * r0.x + S1 * r0.y + S2 * r0.z + S3 * r0.w + S4 * r1.x + S5 * r1.y + S6 * r1.z + S7 * r1.w;
                o += __shfl_xor(o, 1); o += __shfl_xor(o, 2); o += __shfl_xor(o, 4);
                if (sg == 0) OUT[s * 64 + srow] = o;
            }
            __syncthreads();
#pragma unroll
            for (int m = 0; m < 4; ++m) { const int s = wv + 8 * m, n = n0 + s; const size_t row = (size_t)step_row(d, b, n);
                const float o = OUT[s * 64 + lane]; const float mean = wave_sum(o) * (1.f / 64.f); const float dv = o - mean; const float var = wave_sum(dv * dv) * (1.f / 64.f);
                const float z = dv * rsqrtf(var + 64e-5f) * prm[640 + lane] + prm[704 + lane] + BS[s] * V[s * 64 + lane];
                Z[((size_t)d * NALL + row) * 512 + 64 * h + lane] = f2bf(z); }
        }
    }
    __syncthreads();
}
DI void phase_rwkv_post(const P& p, LAS unsigned char* ldsb) {
    LAS float* sg = (LAS float*)ldsb;
    const int tid = mk_tid();
    const bf16_t* LO = (const bf16_t*)(p.ws + WS_COLS) + OFF_LO; const bf16_t* Z = (const bf16_t*)(p.ws + WS_Z); bf16_t* Y = (bf16_t*)(p.ws + WS_COLS);
    const float* g2 = p.in[I_G2];
    for (int vb = blockIdx.x; vb < NALL / 8; vb += gridDim.x) {
        const size_t row0 = (size_t)vb * 8;
        __syncthreads();
        for (int e = tid; e < 1024; e += NT) { const int q = e >> 7, r = e & 127; sg[e] = sigm(bf2f(LO[(row0 + q) * 512 + 256 + r])); }
        __syncthreads();
        float a0 = 0.f, a1 = 0.f, a2 = 0.f, a3 = 0.f, a4 = 0.f, a5 = 0.f, a6 = 0.f, a7 = 0.f;
#pragma unroll 4
        for (int r = 0; r < 128; ++r) { const float g = g2[r * 512 + tid];
            a0 += sg[r] * g; a1 += sg[128 + r] * g; a2 += sg[256 + r] * g; a3 += sg[384 + r] * g; a4 += sg[512 + r] * g; a5 += sg[640 + r] * g; a6 += sg[768 + r] * g; a7 += sg[896 + r] * g; }
#define MK_RP(q, aq) { const size_t rr = row0 + q; const float z = bf2f(Z[rr * 512 + tid]) + bf2f(Z[((size_t)NALL + rr) * 512 + tid]); Y[rr * D + tid] = f2bf(z * aq); }
        MK_RP(0, a0) MK_RP(1, a1) MK_RP(2, a2) MK_RP(3, a3) MK_RP(4, a4) MK_RP(5, a5) MK_RP(6, a6) MK_RP(7, a7)
#undef MK_RP
    }
    __syncthreads();
}
DI void post_headnorm_row(const bf16_t* HB, size_t row, const float* ng, const bf16_t* gsrc, int gate_kind, bf16_t* ydst, int lane) {
    const int c0 = 8 * lane;
    const u32x4 h0 = *(const u32x4*)(HB + row * 512 + c0), h1 = *(const u32x4*)(HB + ((size_t)NALL + row) * 512 + c0), gg = *(const u32x4*)(gsrc + c0);
    float h[8], g[8];
#pragma unroll
    for (int j = 0; j < 4; ++j) { h[2 * j] = __uint_as_float(h0[j] << 16) + __uint_as_float(h1[j] << 16); h[2 * j + 1] = __uint_as_float(h0[j] & 0xffff0000u) + __uint_as_float(h1[j] & 0xffff0000u);
        g[2 * j] = __uint_as_float(gg[j] << 16); g[2 * j + 1] = __uint_as_float(gg[j] & 0xffff0000u); }
    float ss = 0.f;
#pragma unroll
    for (int j = 0; j < 8; ++j) ss += h[j] * h[j];
    ss += __shfl_xor(ss, 1); ss += __shfl_xor(ss, 2); ss += __shfl_xor(ss, 4); ss += __shfl_xor(ss, 8);
    const float rinv = rsqrtf(ss * (1.f / 128.f) + 1e-6f);
    unsigned o[4];
#pragma unroll
    for (int j = 0; j < 4; ++j) { const float y0 = h[2 * j] * rinv * ng[c0 + 2 * j] * (gate_kind ? siluf(g[2 * j]) : sigm(g[2 * j])), y1 = h[2 * j + 1] * rinv * ng[c0 + 2 * j + 1] * (gate_kind ? siluf(g[2 * j + 1]) : sigm(g[2 * j + 1]));
        o[j] = pack2(y0, y1); }
    u32x4 w; w.x = o[0]; w.y = o[1]; w.z = o[2]; w.w = o[3];
    *(u32x4*)(ydst + c0) = w;
}
typedef short bf16x8 __attribute__((ext_vector_type(8)));
typedef short s16x4 __attribute__((ext_vector_type(4)));
constexpr int PQ = 136, PS = 72, PV = 56;
constexpr int E_QS = 0, E_KS = E_QS + 64 * PQ * 2, E_VS = E_KS + 64 * PQ * 2, E_PS = E_VS + 64 * PV * 2, E_ST = E_PS + 64 * PS * 2, E_F = E_ST + 48 * PQ * 2, E_END = E_F + 1024;
constexpr size_t WS_Q1 = WS_COLS + (size_t)231 * MiB;
constexpr int NRC = NALL / 64;

DI int chunk_row0(int d, int b, int ci) {
    if (ci < 4) { const int cc = d ? 3 - ci : ci; return NLAT + b * LC + 64 * cc; }
    const int lc = ci - 4, cl = d ? 127 - lc : lc; return b * L + 64 * cl;
}
DI bf16x8 tr_frag(unsigned tile_base, int pitch, int k0, int c0, int r, int q) {
    const unsigned a0 = tile_base + (unsigned)(((k0 + 8 * q + (r >> 2)) * pitch + c0 + 4 * (r & 3)) * 2), a1 = a0 + (unsigned)(4 * pitch * 2);
    s16x4 x, y;
    asm volatile("ds_read_b64_tr_b16 %0, %2\n\tds_read_b64_tr_b16 %1, %3\n\ts_waitcnt lgkmcnt(0)" : "=&v"(x), "=&v"(y) : "v"(a0), "v"(a1) : "memory");
    bf16x8 o; o[0] = x[0]; o[1] = x[1]; o[2] = x[2]; o[3] = x[3]; o[4] = y[0]; o[5] = y[1]; o[6] = y[2]; o[7] = y[3];
    return o;
}

#define GLA_PREFETCH(ci_) do { const int row0_ = chunk_row0(d, b, (ci_)); \
    _Pragma("unroll") for (int i = 0; i < 2; ++i) { const size_t row_ = (size_t)(row0_ + prow0 + 32 * i); \
        rq[i] = *(const u32x4*)(Qg + row_ * ldq + 8 * ppc); rk[i] = *(const u32x4*)(Kg + row_ * ldk + 8 * ppc); } \
    if (tid < 256) rv = *(const u32x4*)(Vg + (size_t)(row0_ + vrow) * ldv + 8 * vpc); \
    if (MODE == 0) { if (tid < 64) { const size_t row_ = (size_t)(row0_ + (d ? 63 - lane : lane)); gi = bf2f(LO[row_ * 512 + 384 + 4 * d + hd]); gf = bf2f(LO[row_ * 512 + 392 + 4 * d + hd]); } } \
    else rlam = *(const f32x4*)(LAM + ((size_t)d * NRC + (row0_ >> 6)) * 512 + 128 * hd + 16 * wv + 4 * q); } while (0)

template <int MODE> DI void gla_unit(const P& p, LAS unsigned char* lds, int unit) {
    constexpr int NDV = MODE == 0 ? 3 : 2;
    const int tid = mk_tid(), lane = tid & 63, wv = __builtin_amdgcn_readfirstlane(tid >> 6), r = lane & 15, q = lane >> 4;
    const int d = unit >> 6, b = (unit >> 4) & 3, hd = (unit >> 2) & 3, sl = unit & 3;
    const bf16_t* COLS = (const bf16_t*)(p.ws + WS_COLS);
    const bf16_t *Qg, *Kg, *Vg; int ldq, ldk, ldv;
    if (MODE == 0) { const bf16_t* ML = COLS + OFF_ML; Qg = ML + 128 * hd; Kg = ML + 512 + 128 * hd; Vg = ML + 1024 + 128 * hd + 32 * sl; ldq = ldk = ldv = 2048; }
    else { Qg = d ? (const bf16_t*)(p.ws + WS_Q1) + 128 * hd : COLS + 128 * hd; ldq = d ? 512 : 3584; Kg = COLS + 512 + 512 * d + 128 * hd; ldk = 3584; Vg = COLS + 1536 + 128 * hd + 32 * sl; ldv = 3584; }
    const bf16_t* LO = COLS + OFF_LO;
    const float* LAM = (const float*)(p.ws + WS_LAM);
    bf16_t* HB = (bf16_t*)(p.ws + WS_ACT);
    LAS bf16_t* Qs = (LAS bf16_t*)(lds + E_QS); LAS bf16_t* Ks = (LAS bf16_t*)(lds + E_KS); LAS bf16_t* Vs = (LAS bf16_t*)(lds + E_VS);
    LAS bf16_t* Ps = (LAS bf16_t*)(lds + E_PS); LAS bf16_t* STs = (LAS bf16_t*)(lds + E_ST); LAS float* Fs = (LAS float*)(lds + E_F);
    const unsigned ks_base = (unsigned)(size_t)Ks, vs_base = (unsigned)(size_t)Vs;
    float bi = 0.f, bfv = 0.f;
    if (MODE == 0) { bi = p.in[I_MBI][d * 4 + hd]; bfv = p.in[I_MBF][d * 4 + hd]; }
    __syncthreads();
    for (int e = tid; e < 48 * PQ / 2; e += NT) ((LAS unsigned*)STs)[e] = 0u;
    for (int e = tid; e < 64 * PV / 2; e += NT) ((LAS unsigned*)Vs)[e] = 0u;
    __syncthreads();
    f32x4 Sacc[NDV];
#pragma unroll
    for (int n = 0; n < NDV; ++n) Sacc[n] = (f32x4){0.f, 0.f, 0.f, 0.f};
    u32x4 rq[2], rk[2], rv = (u32x4){0u, 0u, 0u, 0u}; float gi = 0.f, gf = 0.f; f32x4 rlam = (f32x4){1.f, 1.f, 1.f, 1.f};
    const int prow0 = tid >> 4, ppc = tid & 15;
    const int vrow = tid >> 2, vpc = tid & 3;
    GLA_PREFETCH(0);
    for (int ci = 0; ci < 132; ++ci) {
        const int row0 = chunk_row0(d, b, ci);
        unsigned oz = 0u; asm volatile("" : "+v"(oz));
        const unsigned ks_b = ks_base + oz, vs_b = vs_base + oz;
        f32x4 lamv = rlam;
        if (MODE == 0) {
            if (tid < 64) {
                const float li = gi + bi, x = gf + bfv;
                float v = -log1pf(expf(-x));
#pragma unroll
                for (int o = 1; o < 64; o <<= 1) { const float t = __shfl_up(v, o); if (lane >= o) v += t; }
                const int rc = d ? 63 - lane : lane;
                Fs[rc] = expf(v) * 0.08838834764831845f; Fs[64 + rc] = expf(li - v);
                if (lane == 63) Fs[128] = expf(v);
            }
        }
#pragma unroll
        for (int i = 0; i < 2; ++i) { const int row = prow0 + 32 * i; *(LAS u32x4*)(Qs + row * PQ + 8 * ppc) = rq[i]; *(LAS u32x4*)(Ks + row * PQ + 8 * ppc) = rk[i]; }
        if (MODE == 0) __syncthreads();
        if (tid < 256) {
            if (MODE == 0) { const float w = Fs[64 + vrow]; u32x4 o;
#pragma unroll
                for (int e = 0; e < 4; ++e) o[e] = pack2(__uint_as_float(rv[e] << 16) * w, __uint_as_float(rv[e] & 0xffff0000u) * w);
                *(LAS u32x4*)(Vs + vrow * PV + 8 * vpc) = o;
                if (vpc == 0) Vs[vrow * PV + 32] = f2bf(w); }
            else *(LAS u32x4*)(Vs + vrow * PV + 8 * vpc) = rv;
        }
        __syncthreads();
        if (ci + 1 < 132) GLA_PREFETCH(ci + 1);
        if (MODE == 0) { const float l = Fs[128]; lamv = (f32x4){l, l, l, l}; }
        {
            const int tt = wv & 3, sh = wv >> 2;
            f32x4 pacc[2] = {(f32x4){0.f, 0.f, 0.f, 0.f}, (f32x4){0.f, 0.f, 0.f, 0.f}};
#pragma unroll
            for (int kk = 0; kk < 4; ++kk) { const bf16x8 bq = *(const LAS bf16x8*)(Qs + (16 * tt + r) * PQ + 32 * kk + 8 * q);
#pragma unroll
                for (int i = 0; i < 2; ++i) { const bf16x8 a = *(const LAS bf16x8*)(Ks + (16 * (2 * sh + i) + r) * PQ + 32 * kk + 8 * q); pacc[i] = __builtin_amdgcn_mfma_f32_16x16x32_bf16(a, bq, pacc[i], 0, 0, 0); } }
            const int t = 16 * tt + r;
#pragma unroll
            for (int i = 0; i < 2; ++i) { const int s0 = 16 * (2 * sh + i) + 4 * q; float v[4];
#pragma unroll
                for (int j = 0; j < 4; ++j) { const int s = s0 + j; const bool ok = d ? (s >= t) : (s <= t); v[j] = ok ? pacc[i][j] : 0.f; }
                u32x2 w; w.x = pack2(v[0], v[1]); w.y = pack2(v[2], v[3]); *(LAS u32x2*)(Ps + t * PS + s0) = w; }
        }
#pragma unroll
        for (int kk = 0; kk < 2; ++kk) { const bf16x8 a = tr_frag(ks_b, PQ, 32 * kk, 16 * wv, r, q);
#pragma unroll
            for (int n = 0; n < NDV; ++n) { const bf16x8 bv = tr_frag(vs_b, PV, 32 * kk, 16 * n, r, q); Sacc[n] = __builtin_amdgcn_mfma_f32_16x16x32_bf16(a, bv, Sacc[n], 0, 0, 0); } }
        __syncthreads();
        {
            const int tt = wv & 3, nA = wv >> 2;
            f32x4 oacc = (f32x4){0.f, 0.f, 0.f, 0.f}, dacc = (f32x4){0.f, 0.f, 0.f, 0.f};
#pragma unroll
            for (int kk = 0; kk < 2; ++kk) { const bf16x8 bp = *(const LAS bf16x8*)(Ps + (16 * tt + r) * PS + 32 * kk + 8 * q);
                const bf16x8 a = tr_frag(vs_b, PV, 32 * kk, 16 * nA, r, q); oacc = __builtin_amdgcn_mfma_f32_16x16x32_bf16(a, bp, oacc, 0, 0, 0);
                if (MODE == 0) { const bf16x8 a2 = tr_frag(vs_b, PV, 32 * kk, 32, r, q); dacc = __builtin_amdgcn_mfma_f32_16x16x32_bf16(a2, bp, dacc, 0, 0, 0); } }
#pragma unroll
            for (int kk = 0; kk < 4; ++kk) { const bf16x8 bq = *(const LAS bf16x8*)(Qs + (16 * tt + r) * PQ + 32 * kk + 8 * q);
                const bf16x8 a = *(const LAS bf16x8*)(STs + (16 * nA + r) * PQ + 32 * kk + 8 * q); oacc = __builtin_amdgcn_mfma_f32_16x16x32_bf16(a, bq, oacc, 0, 0, 0);
                if (MODE == 0) { const bf16x8 a2 = *(const LAS bf16x8*)(STs + (32 + r) * PQ + 32 * kk + 8 * q); dacc = __builtin_amdgcn_mfma_f32_16x16x32_bf16(a2, bq, dacc, 0, 0, 0); } }
            const int t = 16 * tt + r;
            float o0 = oacc[0], o1 = oacc[1], o2 = oacc[2], o3 = oacc[3];
            if (MODE == 0) { const float rs = Fs[t]; const float den = __shfl(dacc[0], r) * rs; const float inv = rs / fmaxf(fabsf(den), 1.f); o0 *= inv; o1 *= inv; o2 *= inv; o3 *= inv; }
            u32x2 w; w.x = pack2(o0, o1); w.y = pack2(o2, o3);
            *(u32x2*)(HB + ((size_t)d * NALL + row0 + t) * 512 + 128 * hd + 32 * sl + 16 * nA + 4 * q) = w;
        }
        __syncthreads();
#pragma unroll
        for (int n = 0; n < NDV; ++n) { Sacc[n] = Sacc[n] * lamv; u32x2 w; w.x = pack2(Sacc[n][0], Sacc[n][1]); w.y = pack2(Sacc[n][2], Sacc[n][3]); *(LAS u32x2*)(STs + (16 * n + r) * PQ + 16 * wv + 4 * q) = w; }
    }
    __syncthreads();
}

DI void phase_hgrn_prep(const P& p, LAS unsigned char* ldsb) {
    LAS float* tot = (LAS float*)ldsb;
    const int tid = mk_tid(), ch = tid & 127, qt = tid >> 7;
    bf16_t* C1 = (bf16_t*)(p.ws + WS_COLS); bf16_t* Q1 = (bf16_t*)(p.ws + WS_Q1); float* LAM = (float*)(p.ws + WS_LAM);
    for (int vb = blockIdx.x; vb < NRC * 4; vb += gridDim.x) {
        const int rc = vb >> 2, hd = vb & 3, c = 128 * hd + ch; const size_t rbase = (size_t)rc * 64 + 16 * qt;
        const float lb = sigm(p.in[I_HLB][512 + c] - p.in[I_HLB][c]);
        float qv[16], l0[16], l1[16], k0[16], k1[16];
#pragma unroll
        for (int i = 0; i < 16; ++i) { const bf16_t* base = C1 + (rbase + i) * 3584;
            qv[i] = siluf(bf2f(base[c])); const float s0 = sigm(bf2f(base[512 + c])), s1 = sigm(bf2f(base[1024 + c]));
            l0[i] = logf(lb + (1.f - lb) * s0); l1[i] = logf(lb + (1.f - lb) * s1); k0[i] = (1.f - lb) * (1.f - s0); k1[i] = (1.f - lb) * (1.f - s1); }
#pragma unroll
        for (int i = 1; i < 16; ++i) l0[i] += l0[i - 1];
#pragma unroll
        for (int i = 14; i >= 0; --i) l1[i] += l1[i + 1];
        __syncthreads();
        tot[qt * 128 + ch] = l0[15]; tot[512 + qt * 128 + ch] = l1[0];
        __syncthreads();
        float off0 = 0.f, off1 = 0.f, t0 = 0.f, t1 = 0.f;
#pragma unroll
        for (int j = 0; j < 4; ++j) { const float a = tot[j * 128 + ch], bb = tot[512 + j * 128 + ch]; t0 += a; t1 += bb; if (j < qt) off0 += a; if (j > qt) off1 += bb; }
#pragma unroll
        for (int i = 0; i < 16; ++i) { bf16_t* base = C1 + (rbase + i) * 3584; const float c0 = l0[i] + off0, c1 = l1[i] + off1;
            base[c] = f2bf(qv[i] * expf(c0)); base[512 + c] = f2bf(k0[i] * expf(-c0)); base[1024 + c] = f2bf(k1[i] * expf(-c1)); Q1[(rbase + i) * 512 + c] = f2bf(qv[i] * expf(c1)); }
        if (qt == 0) { LAM[((size_t)rc) * 512 + c] = expf(t0); LAM[((size_t)NRC + rc) * 512 + c] = expf(t1); }
    }
    __syncthreads();
}
DI float flog(float x) { return __builtin_amdgcn_logf(x) * 0.6931471805599453f; }
DI void phase_hgrn_prep2(const P& p, LAS unsigned char* ldsb) {
    LAS float* tot = (LAS float*)ldsb;
    const int tid = mk_tid(), cp = tid & 63, qt = (tid >> 6) & 3, rs = tid >> 8, c0 = 8 * cp;
    bf16_t* C1 = (bf16_t*)(p.ws + WS_COLS); bf16_t* Q1 = (bf16_t*)(p.ws + WS_Q1); float* LAM = (float*)(p.ws + WS_LAM);
    float lb[8], omlb[8];
#pragma unroll
    for (int k = 0; k < 8; ++k) { lb[k] = fsigm(p.in[I_HLB][512 + c0 + k] - p.in[I_HLB][c0 + k]); omlb[k] = 1.f - lb[k]; }
    for (int vb = blockIdx.x; vb < NRC / 2; vb += gridDim.x) {
        const int rc = 2 * vb + rs; const size_t rbase = (size_t)rc * 64 + 16 * qt;
        float s0[8], s1[8];
#pragma unroll
        for (int k = 0; k < 8; ++k) { s0[k] = 0.f; s1[k] = 0.f; }
#pragma unroll 4
        for (int i = 0; i < 16; ++i) { const bf16_t* base = C1 + (rbase + i) * 3584; const u32x4 f0 = *(const u32x4*)(base + 512 + c0), f1 = *(const u32x4*)(base + 1024 + c0);
#pragma unroll
            for (int k = 0; k < 4; ++k) { s0[2 * k] += flog(lb[2 * k] + omlb[2 * k] * fsigm(__uint_as_float(f0[k] << 16))); s0[2 * k + 1] += flog(lb[2 * k + 1] + omlb[2 * k + 1] * fsigm(__uint_as_float(f0[k] & 0xffff0000u)));
                s1[2 * k] += flog(lb[2 * k] + omlb[2 * k] * fsigm(__uint_as_float(f1[k] << 16))); s1[2 * k + 1] += flog(lb[2 * k + 1] + omlb[2 * k + 1] * fsigm(__uint_as_float(f1[k] & 0xffff0000u))); } }
        __syncthreads();
#pragma unroll
        for (int k = 0; k < 8; k += 4) { *(LAS f32x4*)(tot + ((rs * 2 + 0) * 4 + qt) * 512 + c0 + k) = (f32x4){s0[k], s0[k + 1], s0[k + 2], s0[k + 3]}; *(LAS f32x4*)(tot + ((rs * 2 + 1) * 4 + qt) * 512 + c0 + k) = (f32x4){s1[k], s1[k + 1], s1[k + 2], s1[k + 3]}; }
        __syncthreads();
        float run0[8], run1[8], t0[8], t1[8];
#pragma unroll
        for (int k = 0; k < 8; ++k) { run0[k] = 0.f; run1[k] = 0.f; t0[k] = 0.f; t1[k] = 0.f; }
#pragma unroll
        for (int j = 0; j < 4; ++j)
#pragma unroll
            for (int k = 0; k < 8; ++k) { const float a = tot[((rs * 2 + 0) * 4 + j) * 512 + c0 + k], bb = tot[((rs * 2 + 1) * 4 + j) * 512 + c0 + k]; t0[k] += a; t1[k] += bb; if (j < qt) run0[k] += a; if (j >= qt) run1[k] += bb; }
        if (qt == 0) {
#pragma unroll
            for (int k = 0; k < 8; k += 4) { *(f32x4*)(LAM + (size_t)rc * 512 + c0 + k) = (f32x4){fexp(t0[k]), fexp(t0[k + 1]), fexp(t0[k + 2]), fexp(t0[k + 3])};
                *(f32x4*)(LAM + ((size_t)NRC + rc) * 512 + c0 + k) = (f32x4){fexp(t1[k]), fexp(t1[k + 1]), fexp(t1[k + 2]), fexp(t1[k + 3])}; } }
#pragma unroll 2
        for (int i = 0; i < 16; ++i) { bf16_t* base = C1 + (rbase + i) * 3584; const u32x4 qv = *(const u32x4*)(base + c0), f0 = *(const u32x4*)(base + 512 + c0), f1 = *(const u32x4*)(base + 1024 + c0);
            float oq0[8], ok0[8], ok1[8], oq1[8];
#pragma unroll
            for (int k = 0; k < 8; ++k) { const unsigned wq = qv[k >> 1], w0 = f0[k >> 1], w1 = f1[k >> 1];
                const float qx = (k & 1) ? __uint_as_float(wq & 0xffff0000u) : __uint_as_float(wq << 16), x0 = (k & 1) ? __uint_as_float(w0 & 0xffff0000u) : __uint_as_float(w0 << 16), x1 = (k & 1) ? __uint_as_float(w1 & 0xffff0000u) : __uint_as_float(w1 << 16);
                const float sq = qx * fsigm(qx), sg0 = fsigm(x0), sg1 = fsigm(x1);
                const float l0 = flog(lb[k] + omlb[k] * sg0), l1 = flog(lb[k] + omlb[k] * sg1);
                run0[k] += l0;
                const float cb = run1[k];
                run1[k] -= l1;
                const float e0 = fexp(run0[k]), e1 = fexp(cb);
                oq0[k] = sq * e0; ok0[k] = omlb[k] * (1.f - sg0) * frcp(e0); ok1[k] = omlb[k] * (1.f - sg1) * frcp(e1); oq1[k] = sq * e1; }
            u32x4 w; w.x = pack2(oq0[0], oq0[1]); w.y = pack2(oq0[2], oq0[3]); w.z = pack2(oq0[4], oq0[5]); w.w = pack2(oq0[6], oq0[7]); *(u32x4*)(base + c0) = w;
            w.x = pack2(ok0[0], ok0[1]); w.y = pack2(ok0[2], ok0[3]); w.z = pack2(ok0[4], ok0[5]); w.w = pack2(ok0[6], ok0[7]); *(u32x4*)(base + 512 + c0) = w;
            w.x = pack2(ok1[0], ok1[1]); w.y = pack2(ok1[2], ok1[3]); w.z = pack2(ok1[4], ok1[5]); w.w = pack2(ok1[6], ok1[7]); *(u32x4*)(base + 1024 + c0) = w;
            w.x = pack2(oq1[0], oq1[1]); w.y = pack2(oq1[2], oq1[3]); w.z = pack2(oq1[4], oq1[5]); w.w = pack2(oq1[6], oq1[7]); *(u32x4*)(Q1 + (rbase + i) * 512 + c0) = w; }
    }
    __syncthreads();
}
constexpr int M_XB = 0, M_XCS = M_XB + 67 * 64 * 4, M_XCF = M_XCS + 64 * 72 * 2, M_W = M_XCF + 64 * 64 * 4, M_AU = M_W + 4 * 64 * 72 * 2, M_SEG = M_AU + 4 * 64 * 65 * 4, M_PRM = M_SEG + 4 * 8 * 64 * 4,
              M_CAR = M_PRM + 11 * 64 * 4, M_END = M_CAR + 2 * 64 * 4;
static_assert(M_END <= LDS_BYTES, "lru LDS map");
DI float nexpm1_small(float x) { const float ser = -x * (1.f + x * 0.5f * (1.f + x * (1.f / 3.f) * (1.f + x * 0.25f * (1.f + x * 0.2f)))); return (x > -0.25f) ? ser : 1.f - fexp(x); }
DI int lru_rc_at(int d, int b, int s) { if (s < 4) return 512 + 4 * b + (d ? 3 - s : s); const int lc = s - 4; return 128 * b + (d ? 127 - lc : lc); }
template <int PASS> DI void lru_pass(const P& p, LAS unsigned char* lds, const int lb, const int nlb) {
    const int tid = mk_tid(), lane = tid & 63, wv = __builtin_amdgcn_readfirstlane(tid >> 6), r = lane & 15, q = lane >> 4;
    const int hb = lb & 7;
    const bf16_t* C1 = (const bf16_t*)(p.ws + WS_COLS); bf16_t* Y = (bf16_t*)(p.ws + WS_Z); float* LSUM = (float*)(p.ws + WS_LSUM);
    LAS float* XB = (LAS float*)(lds + M_XB); LAS bf16_t* XCs = (LAS bf16_t*)(lds + M_XCS); LAS float* XCf = (LAS float*)(lds + M_XCF); LAS bf16_t* Wt = (LAS bf16_t*)(lds + M_W);
    LAS float* AU = (LAS float*)(lds + M_AU);
    LAS float* SEG = (LAS float*)(lds + M_SEG);
    LAS float* prm = (LAS float*)(lds + M_PRM);
    LAS float* CAR = (LAS float*)(lds + M_CAR);
    __syncthreads();
    for (int e = tid; e < 4 * 4096; e += NT) { const int g = e >> 12, i = (e >> 6) & 63, j = e & 63, d = g >> 1; const size_t o = ((size_t)(d * 8 + hb) * 64 + i) * 64 + j;
        Wt[(g * 64 + j) * 72 + i] = f2bf((g & 1) ? p.in[I_WI][o] : p.in[I_WA][o]); }
    if (tid < 64) { const int ch = 64 * hb + tid;
        prm[tid] = p.in[I_CONVW][ch]; prm[64 + tid] = p.in[I_CONVW][512 + ch]; prm[128 + tid] = p.in[I_CONVW][1024 + ch]; prm[192 + tid] = p.in[I_CONVW][1536 + ch]; prm[256 + tid] = p.in[I_CONVB][ch];
        prm[320 + tid] = p.in[I_BA][ch]; prm[384 + tid] = p.in[I_BA][512 + ch]; prm[448 + tid] = p.in[I_BI][ch]; prm[512 + tid] = p.in[I_BI][512 + ch];
        prm[576 + tid] = log1pf(expf(-p.in[I_LAM][ch])); prm[640 + tid] = log1pf(expf(-p.in[I_LAM][512 + ch])); }
    const int nrc = (PASS == 1) ? NRC : 512;
    const int cpr = (PASS == 3) ? 512 / (nlb >> 3) : 1, rc_lo = (PASS == 3) ? (lb >> 3) * cpr : (lb >> 3), rstep = (PASS == 3) ? 1 : (nlb >> 3), rc_hi = (PASS == 3) ? rc_lo + cpr : nrc;
    float* LCAR = (float*)(p.ws + WS_LCAR);
    if (PASS == 3 && tid < 128) { const int d = tid >> 6, j = tid & 63, ch = 64 * hb + j, b = rc_lo >> 7, cl0 = rc_lo & 127;
        const int p_lo = d ? 4 + 127 - (cl0 + cpr - 1) : 4 + cl0;
        const float* S = LSUM + (size_t)d * NRC * 1024 + 2 * ch; float hcar = 0.f;
#pragma unroll 8
        for (int s = 0; s < p_lo; ++s) { const float* e2 = S + (size_t)lru_rc_at(d, b, s) * 1024; hcar = e2[0] * hcar + e2[1]; }
        for (int s = p_lo; s < p_lo + cpr; ++s) { const int rcs = lru_rc_at(d, b, s); LCAR[((size_t)d * NRC + rcs) * 512 + ch] = hcar; const float* e2 = S + (size_t)rcs * 1024; hcar = e2[0] * hcar + e2[1]; }
    }
    u32x4 px[2];
#define LRU_PREFETCH(rc_) do { const int rc__ = (rc_); const int row0_ = rc__ * 64; const int seg_lo_ = (rc__ >= 512) ? NLAT + ((rc__ - 512) >> 2) * LC : (rc__ >> 7) * L, seg_hi_ = seg_lo_ + ((rc__ >= 512) ? LC : L); \
    _Pragma("unroll") for (int i = 0; i < 2; ++i) { const int e = tid + 512 * i, rr = e >> 3, pc = e & 7, grow = row0_ - 2 + rr; px[i] = (u32x4){0u, 0u, 0u, 0u}; \
        if (e < 67 * 8 && grow >= seg_lo_ && grow < seg_hi_) px[i] = *(const u32x4*)(C1 + (size_t)grow * C1LD + 2560 + 64 * hb + 8 * pc); } } while (0)
    int rc = rc_lo;
    if (rc < rc_hi) LRU_PREFETCH(rc);
    for (; rc < rc_hi; rc += rstep) {
        const int row0 = rc * 64;
        const int sg = tid >> 6, j = lane, ch = 64 * hb + j;
        float cin = 0.f;
        if (PASS == 3 && tid < 128) cin = LCAR[((size_t)(tid >> 6) * NRC + rc) * 512 + ch];
        float gbv[8];
        if (PASS == 3) {
#pragma unroll
            for (int k = 0; k < 8; ++k) gbv[k] = bf2f(C1[(size_t)(row0 + 8 * sg + k) * C1LD + 3072 + ch]); }
#pragma unroll
        for (int i = 0; i < 2; ++i) { const int e = tid + 512 * i; if (e < 67 * 8) { const int rr = e >> 3, pc = e & 7; const u32x4 v = px[i];
            f32x4 lo, hi; lo[0] = __uint_as_float(v[0] << 16); lo[1] = __uint_as_float(v[0] & 0xffff0000u); lo[2] = __uint_as_float(v[1] << 16); lo[3] = __uint_as_float(v[1] & 0xffff0000u);
            hi[0] = __uint_as_float(v[2] << 16); hi[1] = __uint_as_float(v[2] & 0xffff0000u); hi[2] = __uint_as_float(v[3] << 16); hi[3] = __uint_as_float(v[3] & 0xffff0000u);
            *(LAS f32x4*)(XB + rr * 64 + 8 * pc) = lo; *(LAS f32x4*)(XB + rr * 64 + 8 * pc + 4) = hi; } }
        if (PASS == 3 && tid < 128) CAR[tid] = cin;
        __syncthreads();
        if (rc + rstep < rc_hi) LRU_PREFETCH(rc + rstep);
        {
            const int t = tid >> 3, i0 = 8 * (tid & 7); float xc[8];
#pragma unroll
            for (int c = 0; c < 8; ++c) { const int i = i0 + c; xc[c] = prm[256 + i] + prm[i] * XB[t * 64 + i] + prm[64 + i] * XB[(t + 1) * 64 + i] + prm[128 + i] * XB[(t + 2) * 64 + i] + prm[192 + i] * XB[(t + 3) * 64 + i]; XCf[t * 64 + i] = xc[c]; }
            u32x4 w; w.x = pack2(xc[0], xc[1]); w.y = pack2(xc[2], xc[3]); w.z = pack2(xc[4], xc[5]); w.w = pack2(xc[6], xc[7]);
            *(LAS u32x4*)(XCs + t * 72 + i0) = w;
        }
        __syncthreads();
        {
            const int jt = wv & 3, th = wv >> 2, jc = 16 * jt + r;
#pragma unroll
            for (int d = 0; d < 2; ++d) { const float ba = prm[320 + 64 * d + jc], bi = prm[448 + 64 * d + jc], spl = prm[576 + 64 * d + jc];
#pragma unroll
                for (int i2 = 0; i2 < 2; ++i2) { const int tt = 2 * th + i2;
                    f32x4 aa = (f32x4){0.f, 0.f, 0.f, 0.f}, ai = (f32x4){0.f, 0.f, 0.f, 0.f};
#pragma unroll
                    for (int kk = 0; kk < 2; ++kk) { const bf16x8 xf = *(const LAS bf16x8*)(XCs + (16 * tt + r) * 72 + 32 * kk + 8 * q);
                        const bf16x8 wa = *(const LAS bf16x8*)(Wt + ((2 * d) * 64 + 16 * jt + r) * 72 + 32 * kk + 8 * q), wi = *(const LAS bf16x8*)(Wt + ((2 * d + 1) * 64 + 16 * jt + r) * 72 + 32 * kk + 8 * q);
                        aa = __builtin_amdgcn_mfma_f32_16x16x32_bf16(xf, wa, aa, 0, 0, 0); ai = __builtin_amdgcn_mfma_f32_16x16x32_bf16(xf, wi, ai, 0, 0, 0); }
#pragma unroll
                    for (int jj = 0; jj < 4; ++jj) { const int t = 16 * tt + 4 * q + jj;
                        const float rg = fsigm(aa[jj] + ba), ig = fsigm(ai[jj] + bi), la = -8.f * rg * spl;
                        AU[((2 * d) * 64 + t) * 65 + jc] = 1.f - nexpm1_small(la); AU[((2 * d + 1) * 64 + t) * 65 + jc] = sqrtf(nexpm1_small(2.f * la)) * (ig * XCf[t * 64 + jc]); } } }
        }
        __syncthreads();
        const LAS float* A0 = AU + (8 * sg) * 65 + j; const LAS float* U0 = AU + (64 + 8 * sg) * 65 + j; const LAS float* A1 = AU + (128 + 8 * sg) * 65 + j; const LAS float* U1 = AU + (192 + 8 * sg) * 65 + j;
        {
            float p0 = 1.f, h0 = 0.f, p1 = 1.f, h1 = 0.f;
#pragma unroll
            for (int k = 0; k < 8; ++k) { const float a = A0[k * 65]; h0 = a * h0 + U0[k * 65]; p0 *= a; }
#pragma unroll
            for (int k = 7; k >= 0; --k) { const float a = A1[k * 65]; h1 = a * h1 + U1[k * 65]; p1 *= a; }
            SEG[(0 * 8 + sg) * 64 + j] = p0; SEG[(1 * 8 + sg) * 64 + j] = h0; SEG[(2 * 8 + sg) * 64 + j] = p1; SEG[(3 * 8 + sg) * 64 + j] = h1;
        }
        __syncthreads();
        if (PASS == 1) {
            if (tid < 128) { const int d = tid >> 6; float pa = 1.f, hh = 0.f;
#pragma unroll
                for (int s2 = 0; s2 < 8; ++s2) { const int sgi = d ? 7 - s2 : s2; const float ps = SEG[((2 * d) * 8 + sgi) * 64 + j], hs = SEG[((2 * d + 1) * 8 + sgi) * 64 + j]; hh = ps * hh + hs; pa *= ps; }
                float* o = LSUM + ((size_t)d * NRC + rc) * 1024 + 2 * ch; o[0] = pa; o[1] = hh; }
        } else {
            float hf = CAR[j], hbk = CAR[64 + j];
            for (int s2 = 0; s2 < sg; ++s2) hf = SEG[(0 * 8 + s2) * 64 + j] * hf + SEG[(1 * 8 + s2) * 64 + j];
            for (int s2 = 7; s2 > sg; --s2) hbk = SEG[(2 * 8 + s2) * 64 + j] * hbk + SEG[(3 * 8 + s2) * 64 + j];
            float of[8];
#pragma unroll
            for (int k = 0; k < 8; ++k) { hf = A0[k * 65] * hf + U0[k * 65]; of[k] = hf; }
#pragma unroll
            for (int k = 7; k >= 0; --k) { hbk = A1[k * 65] * hbk + U1[k * 65]; of[k] += hbk; }
#pragma unroll
            for (int k = 0; k < 8; ++k) Y[(size_t)nat_row(row0 + 8 * sg + k) * D + 512 + ch] = f2bf(of[k] * fgelu(gbv[k]));
        }
        __syncthreads();
    }
#undef LRU_PREFETCH
}
constexpr int PT = 72, PM = 40;
constexpr int C_PRM = 0, C_GAM = C_PRM + 3072, C_MISC = C_GAM + 1024, C_SBF = C_MISC + 1280, C_TILES = C_SBF + 2 * 64 * PT * 2, C_TH = C_TILES + 5 * 80 * PT * 2, C_MBF = C_TH + 2 * 64 * PT * 2,
              C_SM = C_MBF + 4 * 16 * 20 * 4, C_W1T = C_SM + 4 * 4 * 16 * PM * 2, C_AH = C_W1T + 4 * 64 * PM * 2, C_YV = C_AH + 4 * 16 * PT * 2, C_END = C_YV + 64 * PM * 2;
static_assert(C_END <= LDS_BYTES, "rwkv chunk LDS map");
DI void unpack4(u32x2 v, float* o) { o[0] = __uint_as_float(v.x << 16); o[1] = __uint_as_float(v.x & 0xffff0000u); o[2] = __uint_as_float(v.y << 16); o[3] = __uint_as_float(v.y & 0xffff0000u); }
DI u32x2 pack4(float a, float b, float c, float d) { u32x2 w; w.x = pack2(a, b); w.y = pack2(c, d); return w; }
DI bf16x8 zero_if(bf16x8 v, bool z) { const bf16x8 zz = {0, 0, 0, 0, 0, 0, 0, 0}; return z ? zz : v; }

constexpr int RING_SLOTS = 4, SLOT_U64 = 5632;
constexpr size_t WS_RING = WS_Z1;
DI void wait_ge(unsigned* word, unsigned want) {
    unsigned spins = 0;
    while ((unsigned)__builtin_amdgcn_readfirstlane((int)__hip_atomic_load(word, __ATOMIC_RELAXED, __HIP_MEMORY_SCOPE_AGENT)) < want) { __builtin_amdgcn_s_sleep(2); if (++spins > (1u << 21)) break; }
    __builtin_amdgcn_fence(__ATOMIC_ACQUIRE, "agent");
    asm volatile("s_waitcnt vmcnt(0)" ::: "memory");
}
template <int ROLE> DI void rwkv_chunk_unit(const P& p, LAS unsigned char* lds, const int vb) {
    const int tid = mk_tid(), lane = tid & 63, wv = __builtin_amdgcn_readfirstlane(tid >> 6), r = lane & 15, q = lane >> 4;
    const int d = vb >> 5, b = (vb >> 3) & 3, h = vb & 7;
    const bf16_t* RW = (const bf16_t*)(p.ws + WS_COLS) + OFF_RW; const bf16_t* LO = (const bf16_t*)(p.ws + WS_COLS) + OFF_LO; bf16_t* Z = (bf16_t*)(p.ws + WS_Z);
    unsigned long long* ring = (unsigned long long*)(p.ws + WS_RING) + (size_t)vb * RING_SLOTS * SLOT_U64;
    unsigned* READY = (unsigned*)(p.ws + WS_CTL) + 64 * vb; unsigned* ACK = (unsigned*)(p.ws + WS_CTL) + 64 * (64 + vb);
    LAS float* prm = (LAS float*)(lds + C_PRM); LAS float* GAM = (LAS float*)(lds + C_GAM); LAS float* SSQ = (LAS float*)(lds + C_MISC); LAS float* BSP = SSQ + 128; LAS float* BS = SSQ + 256;
    LAS bf16_t* Sbf = (LAS bf16_t*)(lds + C_SBF);
    LAS bf16_t* At = (LAS bf16_t*)(lds + C_TILES); LAS bf16_t* Rt = At + 80 * PT; LAS bf16_t* Bt = Rt + 80 * PT; LAS bf16_t* Kt = Bt + 80 * PT; LAS bf16_t* Vt = Kt + 80 * PT;
    LAS bf16_t* TH = (LAS bf16_t*)(lds + C_TH); LAS bf16_t* AD = TH + 64 * PT; LAS float* OUT = (LAS float*)(lds + C_TH);
    LAS float* MBf = (LAS float*)(lds + C_MBF);
    LAS bf16_t* MK = (LAS bf16_t*)(lds + C_SM); LAS bf16_t* NK = MK + 4 * 16 * PM; LAS bf16_t* NB = NK + 4 * 16 * PM; LAS bf16_t* DNV = NB + 4 * 16 * PM;
    LAS bf16_t* W1T = (LAS bf16_t*)(lds + C_W1T); LAS bf16_t* AH = (LAS bf16_t*)(lds + C_AH); LAS bf16_t* YV = (LAS bf16_t*)(lds + C_YV);
    const unsigned at_b = (unsigned)(size_t)At, bt_b = (unsigned)(size_t)Bt, kt_b = (unsigned)(size_t)Kt, vt_b = (unsigned)(size_t)Vt;
    __syncthreads();
    for (int e = tid; e < (C_END - C_SBF) / 4; e += NT) ((LAS unsigned*)(lds + C_SBF))[e] = 0u;
    if (tid < 64) { const int j = tid, c = 64 * h + j; const float* mu = p.in[I_MU] + d * 1664;
        prm[j] = mu[c]; prm[64 + j] = mu[512 + c]; prm[128 + j] = mu[1024 + c]; prm[192 + j] = mu[1536 + j]; prm[256 + j] = mu[1600 + j];
        prm[320 + j] = p.in[I_W0][d * 512 + c]; prm[384 + j] = p.in[I_A0][d * 512 + c]; prm[448 + j] = p.in[I_KK][d * 512 + c]; prm[512 + j] = p.in[I_KA][d * 512 + c];
        prm[576 + j] = p.in[I_RK][(d * 8 + h) * 64 + j]; prm[640 + j] = p.in[I_LNW][d * 512 + c]; prm[704 + j] = p.in[I_LNB][d * 512 + c]; }
    const int m1 = wv & 3, h2 = wv >> 2, cb8 = 32 * h2 + 8 * q;
    bf16x8 fw2[2][2], fa2[2][2];
    if (ROLE != 1) {
#pragma unroll
    for (int t = 0; t < 2; ++t)
#pragma unroll
        for (int kk = 0; kk < 2; ++kk) { const int c = 64 * h + 32 * h2 + 8 * (r >> 2) + 4 * t + (r & 3);
            const float* w2p = p.in[I_W2L] + (size_t)(d * 64 + 32 * kk + 8 * q) * 512 + c; const float* a2p = p.in[I_A2L] + (size_t)(d * 64 + 32 * kk + 8 * q) * 512 + c;
#pragma unroll
            for (int e = 0; e < 8; ++e) { fw2[t][kk][e] = (short)f2bf(w2p[e * 512]); fa2[t][kk][e] = (short)f2bf(a2p[e * 512]); }
            asm volatile("" ::: "memory"); }
    }
    f32x4 Sacc[2] = {(f32x4){0.f, 0.f, 0.f, 0.f}, (f32x4){0.f, 0.f, 0.f, 0.f}};
    int cur = 0;
    unsigned ack_seen = 0u;
    unsigned long long pf[11]; bool pf_ok = false;
    u32x4 gc[5], gp[5];
#define RWKV_LOAD(n0x) do { const int n1_ = (n0x) + 16 * m1 + r; const bool hp_ = (n1_ != 0) && (n1_ != LC); const unsigned row_ = (unsigned)step_row(d, b, n1_), prow_ = hp_ ? (unsigned)step_row(d, b, n1_ - 1) : row_; \
    const unsigned rwc_ = row_ * 1536u + 64u * h + cb8, rwp_ = prow_ * 1536u + 64u * h + cb8, loc_ = row_ * 512u + 64u * d + cb8, lop_ = prow_ * 512u + 64u * d + cb8; \
    gc[0] = *(const u32x4*)(RW + rwc_); gc[1] = *(const u32x4*)(RW + rwc_ + 512u); gc[2] = *(const u32x4*)(RW + rwc_ + 1024u); gc[3] = *(const u32x4*)(LO + loc_); gc[4] = *(const u32x4*)(LO + loc_ + 128u); \
    gp[0] = *(const u32x4*)(RW + rwp_); gp[1] = *(const u32x4*)(RW + rwp_ + 512u); gp[2] = *(const u32x4*)(RW + rwp_ + 1024u); gp[3] = *(const u32x4*)(LO + lop_); gp[4] = *(const u32x4*)(LO + lop_ + 128u); } while (0)
    if (ROLE != 1) RWKV_LOAD(0);
    __syncthreads();
    for (int n0 = 0; n0 < LT; n0 += 64) {
        if (ROLE != 1) for (int rep0 = 0; rep0 < (MK_RDUP == 0 ? 2 : 1); ++rep0) {
        const int u1 = 16 * m1 + r, n1 = n0 + u1; const bool hp = (n1 != 0) && (n1 != LC);
        float rs[8], ks[8], vs[8];
        {
            float a0[8], a1[8], th[8], ad[8];
#define UNPACK8(v, o) { _Pragma("unroll") for (int k_ = 0; k_ < 4; ++k_) { o[2 * k_] = __uint_as_float(v[k_] << 16); o[2 * k_ + 1] = __uint_as_float(v[k_] & 0xffff0000u); } }
#define RW_SHIFT(dst, idx, muo) { const u32x4 pz = hp ? gp[idx] : (u32x4){0u, 0u, 0u, 0u}; UNPACK8(gc[idx], a0) UNPACK8(pz, a1) \
            const f32x4 mu0 = *(const LAS f32x4*)(prm + (muo) + cb8), mu1 = *(const LAS f32x4*)(prm + (muo) + cb8 + 4); \
            _Pragma("unroll") for (int e = 0; e < 4; ++e) { dst[e] = a0[e] + mu0[e] * (a1[e] - a0[e]); dst[4 + e] = a0[4 + e] + mu1[e] * (a1[4 + e] - a0[4 + e]); } }
            RW_SHIFT(rs, 0, 0) RW_SHIFT(ks, 1, 64) RW_SHIFT(vs, 2, 128) RW_SHIFT(th, 3, 192) RW_SHIFT(ad, 4, 256)
#undef RW_SHIFT
#pragma unroll
            for (int e = 0; e < 8; ++e) th[e] = ftanh(th[e]);
            u32x4 w; w.x = pack2(th[0], th[1]); w.y = pack2(th[2], th[3]); w.z = pack2(th[4], th[5]); w.w = pack2(th[6], th[7]); *(LAS u32x4*)(TH + u1 * PT + cb8) = w;
            w.x = pack2(ad[0], ad[1]); w.y = pack2(ad[2], ad[3]); w.z = pack2(ad[4], ad[5]); w.w = pack2(ad[6], ad[7]); *(LAS u32x4*)(AD + u1 * PT + cb8) = w;
            asm volatile("" ::: "memory");
        }
        __syncthreads();
        float elog[8], av[8], kkr[8], km[8]; float ssq = 0.f, bsp = 0.f;
#pragma unroll
        for (int t = 0; t < 2; ++t) {
            f32x4 xw = (f32x4){0.f, 0.f, 0.f, 0.f}, xa = (f32x4){0.f, 0.f, 0.f, 0.f};
#pragma unroll
            for (int kk = 0; kk < 2; ++kk) { const bf16x8 bt = *(const LAS bf16x8*)(TH + u1 * PT + 32 * kk + 8 * q), ba = *(const LAS bf16x8*)(AD + u1 * PT + 32 * kk + 8 * q);
                xw = __builtin_amdgcn_mfma_f32_16x16x32_bf16(fw2[t][kk], bt, xw, 0, 0, 0); xa = __builtin_amdgcn_mfma_f32_16x16x32_bf16(fa2[t][kk], ba, xa, 0, 0, 0); }
            const int cb = cb8 + 4 * t;
            const f32x4 w04 = *(const LAS f32x4*)(prm + 320 + cb), a04 = *(const LAS f32x4*)(prm + 384 + cb), kk4 = *(const LAS f32x4*)(prm + 448 + cb), ka4 = *(const LAS f32x4*)(prm + 512 + cb), rk4 = *(const LAS f32x4*)(prm + 576 + cb);
#pragma unroll
            for (int jj = 0; jj < 4; ++jj) { const int e = 4 * t + jj;
                elog[e] = 0.6065306597126334f * fsigm(xw[jj] + w04[jj]); av[e] = fsigm(xa[jj] + a04[jj]);
                kkr[e] = ks[e] * kk4[jj]; ssq += kkr[e] * kkr[e]; km[e] = ks[e] * (1.f + (av[e] - 1.f) * ka4[jj]); bsp += rs[e] * km[e] * rk4[jj]; }
            asm volatile("" ::: "memory");
        }
        ssq += __shfl_xor(ssq, 16); ssq += __shfl_xor(ssq, 32); bsp += __shfl_xor(bsp, 16); bsp += __shfl_xor(bsp, 32);
        if (q == 0) { SSQ[h2 * 64 + u1] = ssq; BSP[h2 * 64 + u1] = bsp; }
        __syncthreads();
        {
            const float tot = SSQ[u1] + SSQ[64 + u1]; const float inv = 1.f / fmaxf(sqrtf(tot), 1e-12f);
            if (h2 == 0 && q == 0) BS[u1] = BSP[u1] + BSP[64 + u1];
            float al[8], be[8], ka[8], rh[8];
#pragma unroll
            for (int e = 0; e < 8; ++e) {
                const float g = scan16(-elog[e]);
                const float ep = fexp(g), em = frcp(ep), epp = fexp(g + elog[e]);
                const float kk = kkr[e] * inv;
                al[e] = kk * epp; be[e] = kk * av[e] * em; ka[e] = km[e] * em; rh[e] = rs[e] * ep;
                if (r == 15) GAM[m1 * 64 + cb8 + e] = ep; }
            u32x4 w;
#define ST8(T, v) w.x = pack2(v[0], v[1]); w.y = pack2(v[2], v[3]); w.z = pack2(v[4], v[5]); w.w = pack2(v[6], v[7]); *(LAS u32x4*)(T + u1 * PT + cb8) = w;
            ST8(At, al) ST8(Bt, be) ST8(Kt, ka) ST8(Rt, rh) ST8(Vt, vs)
#undef ST8
        }
        __syncthreads();
        }
        if (ROLE == 0 && n0 + 64 < LT) RWKV_LOAD(n0 + 64);
        if (ROLE == 2) {
            const unsigned g = (unsigned)(n0 >> 6);
            if (g > 0u) { asm volatile("s_waitcnt vmcnt(0)" ::: "memory"); __syncthreads(); if (tid == 0) __hip_atomic_store(READY, g, __ATOMIC_RELAXED, __HIP_MEMORY_SCOPE_AGENT); }
            if (n0 + 64 < LT) RWKV_LOAD(n0 + 64);
            if (g >= RING_SLOTS && ack_seen < g - RING_SLOTS + 1) {
                if (tid == 0) { wait_ge(ACK, g - RING_SLOTS + 1); ((LAS unsigned*)MBf)[17] = __hip_atomic_load(ACK, __ATOMIC_RELAXED, __HIP_MEMORY_SCOPE_AGENT); }
                __syncthreads(); ack_seen = ((LAS unsigned*)MBf)[17]; }
            unsigned long long* slot = ring + (size_t)(g % RING_SLOTS) * SLOT_U64;
            for (int e = tid; e < 5280; e += NT) { unsigned long long v;
                if (e < 5120) v = *(const LAS unsigned long long*)(lds + C_TILES + (e >> 10) * (80 * PT * 2) + ((e >> 4) & 63) * (PT * 2) + (e & 15) * 8);
                else if (e < 5248) v = *(const LAS unsigned long long*)(lds + C_GAM + (e - 5120) * 8);
                else v = *(const LAS unsigned long long*)((LAS unsigned char*)BS + (e - 5248) * 8);
                __hip_atomic_store(slot + e, v, __ATOMIC_RELAXED, __HIP_MEMORY_SCOPE_AGENT); }
            if (g == 131u) { asm volatile("s_waitcnt vmcnt(0)" ::: "memory"); __syncthreads(); if (tid == 0) __hip_atomic_store(READY, g + 1u, __ATOMIC_RELAXED, __HIP_MEMORY_SCOPE_AGENT); }
            continue;
        }
        if (ROLE == 1) {
            const unsigned g = (unsigned)(n0 >> 6);
            if (!pf_ok) { if (wv == 0) wait_ge(READY, g + 1u); __syncthreads();
                const unsigned long long* slot = ring + (size_t)(g % RING_SLOTS) * SLOT_U64;
#pragma unroll
                for (int k = 0; k < 11; ++k) { const int e = tid + NT * k; if (e < 5280) pf[k] = slot[e]; } }
#pragma unroll
            for (int k = 0; k < 11; ++k) { const int e = tid + NT * k; if (e < 5280) { const unsigned long long v = pf[k];
                if (e < 5120) *(LAS unsigned long long*)(lds + C_TILES + (e >> 10) * (80 * PT * 2) + ((e >> 4) & 63) * (PT * 2) + (e & 15) * 8) = v;
                else if (e < 5248) *(LAS unsigned long long*)(lds + C_GAM + (e - 5120) * 8) = v;
                else *(LAS unsigned long long*)((LAS unsigned char*)BS + (e - 5248) * 8) = v; } }
            asm volatile("s_waitcnt vmcnt(0)" ::: "memory");
            __syncthreads();
            if (tid == 0) __hip_atomic_store(ACK, g + 1u, __ATOMIC_RELAXED, __HIP_MEMORY_SCOPE_AGENT);
        }
        f32x4 yhat[4];
        for (int rep1 = 0; rep1 < (MK_RDUP == 1 ? 2 : 1); ++rep1) {
        {
            const int m = wv >> 1, pp = wv & 1; LAS bf16_t* XB = pp ? Rt : At;
            f32x4 c1 = (f32x4){0.f, 0.f, 0.f, 0.f}, c2 = (f32x4){0.f, 0.f, 0.f, 0.f};
#pragma unroll
            for (int kk = 0; kk < 2; ++kk) { const bf16x8 bx = *(const LAS bf16x8*)(XB + (16 * m + r) * PT + 32 * kk + 8 * q);
                const bf16x8 a1 = *(const LAS bf16x8*)(Bt + (16 * m + r) * PT + 32 * kk + 8 * q), a2 = *(const LAS bf16x8*)(Kt + (16 * m + r) * PT + 32 * kk + 8 * q);
                c1 = __builtin_amdgcn_mfma_f32_16x16x32_bf16(a1, bx, c1, 0, 0, 0); c2 = __builtin_amdgcn_mfma_f32_16x16x32_bf16(a2, bx, c2, 0, 0, 0); }
#pragma unroll
            for (int jj = 0; jj < 4; ++jj) { const int s = 4 * q + jj; const bool ok = pp ? (s <= r) : (s < r); if (!ok) { c1[jj] = 0.f; c2[jj] = 0.f; } }
            if (pp == 0) { *(LAS f32x4*)(MBf + (m * 16 + r) * 20 + 4 * q) = c1; *(LAS u32x2*)(MK + (m * 16 + r) * PM + 4 * q) = pack4(c2[0], c2[1], c2[2], c2[3]); }
            else { *(LAS u32x2*)(NB + (m * 16 + r) * PM + 4 * q) = pack4(c1[0], c1[1], c1[2], c1[3]); *(LAS u32x2*)(NK + (m * 16 + r) * PM + 4 * q) = pack4(c2[0], c2[1], c2[2], c2[3]); }
        }
        __syncthreads();
        if (wv < 4) {
            const int m = wv, c = r; float X[16];
#pragma unroll
            for (int u = 0; u < 16; ++u) { float x = (c == u) ? 1.f : 0.f;
                if (u > 0) { const LAS f32x4* rowp = (const LAS f32x4*)(MBf + (m * 16 + u) * 20);
#pragma unroll
                    for (int s4 = 0; s4 < 4; ++s4) { if (4 * s4 < u) { const f32x4 l = rowp[s4];
#pragma unroll
                        for (int e = 0; e < 4; ++e) if (4 * s4 + e < u) x -= l[e] * X[4 * s4 + e]; } } }
                X[u] = x; }
            if (q == 0) {
#pragma unroll
                for (int u = 0; u < 16; ++u) DNV[(m * 16 + u) * PM + c] = f2bf(X[u]); }
        } else {
            const int m = wv - 4; const bf16x8 a = *(const LAS bf16x8*)(MK + (m * 16 + r) * PM + 8 * q);
#pragma unroll
            for (int it = 0; it < 4; ++it) { const bf16x8 bv = tr_frag(vt_b, PT, 16 * m, 16 * it, r, q);
                const f32x4 acc = __builtin_amdgcn_mfma_f32_16x16x32_bf16(a, bv, (f32x4){0.f, 0.f, 0.f, 0.f}, 0, 0, 0);
                *(LAS u32x2*)(W1T + (m * 64 + 16 * it + r) * PM + 4 * q) = pack4(acc[0], acc[1], acc[2], acc[3]); }
        }
        __syncthreads();
#pragma unroll
        for (int m = 0; m < 4; ++m) yhat[m] = (f32x4){0.f, 0.f, 0.f, 0.f};
        if (wv < 4) {
            const int it = wv;
#pragma unroll
            for (int m = 0; m < 4; ++m) { const bf16x8 a = *(const LAS bf16x8*)(DNV + (m * 16 + r) * PM + 8 * q), bw = *(const LAS bf16x8*)(W1T + (m * 64 + 16 * it + r) * PM + 8 * q);
                yhat[m] = __builtin_amdgcn_mfma_f32_16x16x32_bf16(a, bw, yhat[m], 0, 0, 0); }
        } else {
            const int jt = wv - 4;
#pragma unroll
            for (int m = 0; m < 4; ++m) { const bf16x8 a = tr_frag(at_b, PT, 16 * m, 16 * jt, r, q), bd = *(const LAS bf16x8*)(DNV + (m * 16 + r) * PM + 8 * q);
                const f32x4 acc = __builtin_amdgcn_mfma_f32_16x16x32_bf16(a, bd, (f32x4){0.f, 0.f, 0.f, 0.f}, 0, 0, 0);
                *(LAS u32x2*)(AH + (m * 16 + r) * PT + 16 * jt + 4 * q) = pack4(acc[0], acc[1], acc[2], acc[3]); }
        }
        __syncthreads();
        }
#pragma unroll 1
        for (int m = 0; m < 4; ++m) {
            LAS bf16_t* Sc = Sbf + cur * 64 * PT; LAS bf16_t* Sn = Sbf + (cur ^ 1) * 64 * PT;
            const int it = wv & 3, jh = wv >> 2;
            f32x4 oacc = (f32x4){0.f, 0.f, 0.f, 0.f};
            const bf16x8 bv = tr_frag(vt_b, PT, 16 * m, 16 * it, r, q);
            const bf16x8 ka0 = zero_if(tr_frag(kt_b, PT, 16 * m, 16 * (2 * jh), r, q), q >= 2), ka1 = zero_if(tr_frag(kt_b, PT, 16 * m, 16 * (2 * jh + 1), r, q), q >= 2);
            const bf16x8 ba0 = tr_frag(bt_b, PT, 16 * m, 16 * (2 * jh), r, q), ba1 = tr_frag(bt_b, PT, 16 * m, 16 * (2 * jh + 1), r, q);
            if (wv < 4) {
                f32x4 acc = (m == 0) ? yhat[0] : (m == 1) ? yhat[1] : (m == 2) ? yhat[2] : yhat[3];
#pragma unroll
                for (int kk = 0; kk < 2; ++kk) { const bf16x8 a = *(const LAS bf16x8*)(AH + (m * 16 + r) * PT + 32 * kk + 8 * q), bs = *(const LAS bf16x8*)(Sc + (16 * it + r) * PT + 32 * kk + 8 * q);
                    acc = __builtin_amdgcn_mfma_f32_16x16x32_bf16(a, bs, acc, 0, 0, 0); }
                *(LAS u32x2*)(YV + (16 * it + r) * PM + 4 * q) = pack4(-acc[0], -acc[1], -acc[2], -acc[3]);
            } else {
#pragma unroll
                for (int kk = 0; kk < 2; ++kk) { const bf16x8 a = *(const LAS bf16x8*)(Rt + (16 * m + r) * PT + 32 * kk + 8 * q), bs = *(const LAS bf16x8*)(Sc + (16 * it + r) * PT + 32 * kk + 8 * q);
                    oacc = __builtin_amdgcn_mfma_f32_16x16x32_bf16(a, bs, oacc, 0, 0, 0); }
                const bf16x8 a = *(const LAS bf16x8*)(NK + (m * 16 + r) * PM + 8 * q);
                oacc = __builtin_amdgcn_mfma_f32_16x16x32_bf16(a, bv, oacc, 0, 0, 0);
            }
            if (ROLE == 1 && m == 0) { if (tid == 0) { const unsigned g1 = (unsigned)(n0 >> 6) + 1u; unsigned ok = 0u;
                    if (g1 < 132u && __hip_atomic_load(READY, __ATOMIC_RELAXED, __HIP_MEMORY_SCOPE_AGENT) >= g1 + 1u) { __builtin_amdgcn_fence(__ATOMIC_ACQUIRE, "agent"); asm volatile("s_waitcnt vmcnt(0)" ::: "memory"); ok = 1u; }
                    ((LAS unsigned*)MBf)[16] = ok; } }
            __syncthreads();
            if (ROLE == 1 && m == 0) { pf_ok = ((LAS unsigned*)MBf)[16] != 0u;
                if (pf_ok) { const unsigned long long* slot = ring + (size_t)(((unsigned)(n0 >> 6) + 1u) % RING_SLOTS) * SLOT_U64;
#pragma unroll
                    for (int k = 0; k < 11; ++k) { const int e = tid + NT * k; if (e < 5280) pf[k] = slot[e]; } } }
            {
                const bf16x8 by = *(const LAS bf16x8*)(YV + (16 * it + r) * PM + 8 * q);
#pragma unroll
                for (int x = 0; x < 2; ++x) { const int jt = 2 * jh + x;
                    const bf16x8 a1 = x ? ka1 : ka0, a2 = x ? ba1 : ba0;
                    Sacc[x] = __builtin_amdgcn_mfma_f32_16x16x32_bf16(a1, bv, Sacc[x], 0, 0, 0); Sacc[x] = __builtin_amdgcn_mfma_f32_16x16x32_bf16(a2, by, Sacc[x], 0, 0, 0);
                    const f32x4 gm = *(const LAS f32x4*)(GAM + m * 64 + 16 * jt + 4 * q); Sacc[x] = Sacc[x] * gm;
                    *(LAS u32x2*)(Sn + (16 * it + r) * PT + 16 * jt + 4 * q) = pack4(Sacc[x][0], Sacc[x][1], Sacc[x][2], Sacc[x][3]); }
                if (wv >= 4) { const bf16x8 a = *(const LAS bf16x8*)(NB + (m * 16 + r) * PM + 8 * q);
                    oacc = __builtin_amdgcn_mfma_f32_16x16x32_bf16(a, by, oacc, 0, 0, 0);
#pragma unroll
                    for (int jj = 0; jj < 4; ++jj) OUT[(16 * m + 4 * q + jj) * 68 + 16 * it + r] = oacc[jj]; }
            }
            __syncthreads();
            cur ^= 1;
        }
        for (int rep6 = 0; rep6 < (MK_RDUP == 6 ? 2 : 1); ++rep6) {
            const int u = tid >> 3, part = tid & 7; const size_t row = (size_t)step_row(d, b, n0 + u);
            const f32x4 o0 = *(const LAS f32x4*)(OUT + u * 68 + 8 * part), o1 = *(const LAS f32x4*)(OUT + u * 68 + 8 * part + 4);
            const float mean = sum8((o0[0] + o0[1]) + (o0[2] + o0[3]) + (o1[0] + o1[1]) + (o1[2] + o1[3])) * (1.f / 64.f);
            const f32x4 d0 = o0 - mean, d1 = o1 - mean;
            const float var = sum8((d0[0] * d0[0] + d0[1] * d0[1]) + (d0[2] * d0[2] + d0[3] * d0[3]) + (d1[0] * d1[0] + d1[1] * d1[1]) + (d1[2] * d1[2] + d1[3] * d1[3])) * (1.f / 64.f);
            const float rstd = rsqrtf(var + 64e-5f), bs = BS[u];
            const f32x4 w0 = *(const LAS f32x4*)(prm + 640 + 8 * part), w1 = *(const LAS f32x4*)(prm + 644 + 8 * part), b0 = *(const LAS f32x4*)(prm + 704 + 8 * part), b1 = *(const LAS f32x4*)(prm + 708 + 8 * part);
            const u32x4 vv = *(const LAS u32x4*)(Vt + u * PT + 8 * part);
            float z[8];
#pragma unroll
            for (int k = 0; k < 4; ++k) { z[k] = d0[k] * rstd * w0[k] + b0[k]; z[4 + k] = d1[k] * rstd * w1[k] + b1[k]; }
#pragma unroll
            for (int k = 0; k < 4; ++k) { z[2 * k] += bs * __uint_as_float(vv[k] << 16); z[2 * k + 1] += bs * __uint_as_float(vv[k] & 0xffff0000u); }
            u32x4 w; w.x = pack2(z[0], z[1]); w.y = pack2(z[2], z[3]); w.z = pack2(z[4], z[5]); w.w = pack2(z[6], z[7]);
            *(u32x4*)(Z + ((size_t)d * NALL + row) * 512 + 64 * h + 8 * part) = w;
        }
        __syncthreads();
    }
}
constexpr int RP_G2 = 0, RP_G2P = 520, RP_SG = RP_G2 + 128 * RP_G2P * 2, RP_END = RP_SG + 64 * PQ * 2;
static_assert(RP_END <= LDS_BYTES, "rwkv post LDS map");
DI void phase_rwkv_post2(const P& p, LAS unsigned char* lds) {
    const int tid = mk_tid(), lane = tid & 63, wv = __builtin_amdgcn_readfirstlane(tid >> 6), r = lane & 15, q = lane >> 4;
    const bf16_t* LO = (const bf16_t*)(p.ws + WS_COLS) + OFF_LO; const bf16_t* Z = (const bf16_t*)(p.ws + WS_Z); bf16_t* Y = (bf16_t*)(p.ws + WS_COLS);
    LAS bf16_t* G2s = (LAS bf16_t*)(lds + RP_G2); LAS bf16_t* SG = (LAS bf16_t*)(lds + RP_SG);
    const unsigned g2_b = (unsigned)(size_t)G2s;
    if ((int)blockIdx.x >= NRC) return;
    __syncthreads();
    for (int e = tid; e < 128 * 128; e += NT) { const int rr = e >> 7, c4 = (e & 127) * 4; const f32x4 v = *(const f32x4*)(p.in[I_G2] + rr * 512 + c4);
        *(LAS u32x2*)(G2s + rr * RP_G2P + c4) = pack4(v[0], v[1], v[2], v[3]); }
    for (int rc = blockIdx.x; rc < NRC; rc += gridDim.x) {
        const size_t row0 = (size_t)rc * 64;
        __syncthreads();
        for (int e = tid; e < 64 * 16; e += NT) { const int t = e >> 4, pc = e & 15; const u32x4 v = *(const u32x4*)(LO + (row0 + t) * 512 + 256 + 8 * pc); u32x4 o;
#pragma unroll
            for (int k = 0; k < 4; ++k) o[k] = pack2(fsigm(__uint_as_float(v[k] << 16)), fsigm(__uint_as_float(v[k] & 0xffff0000u)));
            *(LAS u32x4*)(SG + t * PQ + 8 * pc) = o; }
        __syncthreads();
#pragma unroll 1
        for (int ci = 0; ci < 4; ++ci) { const int ct = 4 * wv + ci;
            f32x4 acc[4] = {(f32x4){0.f, 0.f, 0.f, 0.f}, (f32x4){0.f, 0.f, 0.f, 0.f}, (f32x4){0.f, 0.f, 0.f, 0.f}, (f32x4){0.f, 0.f, 0.f, 0.f}};
#pragma unroll
            for (int kk = 0; kk < 4; ++kk) { const bf16x8 a = tr_frag(g2_b, RP_G2P, 32 * kk, 16 * ct, r, q);
#pragma unroll
                for (int tt = 0; tt < 4; ++tt) { const bf16x8 bs = *(const LAS bf16x8*)(SG + (16 * tt + r) * PQ + 32 * kk + 8 * q); acc[tt] = __builtin_amdgcn_mfma_f32_16x16x32_bf16(a, bs, acc[tt], 0, 0, 0); } }
#pragma unroll
            for (int tt = 0; tt < 4; ++tt) { const size_t row = row0 + 16 * tt + r; const int c = 16 * ct + 4 * q;
                float z0[4], z1[4]; unpack4(*(const u32x2*)(Z + row * 512 + c), z0); unpack4(*(const u32x2*)(Z + ((size_t)NALL + row) * 512 + c), z1);
                *(u32x2*)(Y + row * D + c) = pack4((z0[0] + z1[0]) * acc[tt][0], (z0[1] + z1[1]) * acc[tt][1], (z0[2] + z1[2]) * acc[tt][2], (z0[3] + z1[3]) * acc[tt][3]); }
        }
    }
    __syncthreads();
}
#define XB_TMO      128
#define XB_XCNT(j)  (256  + 64 * (j))
#define XB_XSUB(j)  (1280 + 64 * (j))
#define XB_XGEN(j)  (2304 + 64 * (j))
#define XB_TOP      3328
#define XB_TOPGEN   3392
#define XCD_BAR_WORDS 3456
#define XB_SPIN_CAP (1u << 18)

__device__ __forceinline__ unsigned xb_ld(unsigned* p)              { return __hip_atomic_load(p, __ATOMIC_RELAXED, __HIP_MEMORY_SCOPE_AGENT); }
__device__ __forceinline__ unsigned xb_add(unsigned* p, unsigned v) { return __hip_atomic_fetch_add(p, v, __ATOMIC_RELAXED, __HIP_MEMORY_SCOPE_AGENT); }
__device__ __forceinline__ unsigned xb_xcc_id() { return (unsigned)__builtin_amdgcn_s_getreg((3 << 11) | 20) & 0xFu; }
#define XB_SPIN(cond, bar) do { unsigned _sp = 0; while (cond) { __builtin_amdgcn_s_sleep(1); \
    if ((++_sp & 255u) == 0u) { if (xb_ld(&(bar)[XB_TMO])) break; if (_sp > XB_SPIN_CAP) { atomicAdd(&(bar)[XB_TMO], 1u); break; } } } } while (0)

struct XcdBarrier {
    unsigned* bar; unsigned x;
    volatile LAS unsigned* st;
};

__device__ __forceinline__ XcdBarrier xcd_barrier_post(unsigned* bar, volatile LAS unsigned* st) {
    XcdBarrier b; b.bar = bar; b.x = xb_xcc_id(); b.st = st;
    if (threadIdx.x == 0) (void)xb_add(&bar[XB_XCNT(b.x)], 1u);
    return b;
}
__device__ __forceinline__ void xcd_barrier_complete(unsigned* bar, unsigned x, unsigned& nloc, unsigned& nx) {
    const unsigned G = gridDim.x * gridDim.y * gridDim.z;
    unsigned sum, cnt, mine, sp = 0u;
    for (;;) {
        sum = 0u; cnt = 0u; mine = 0u;
#pragma unroll
        for (unsigned j = 0; j < 16; ++j) { const unsigned c = xb_ld(&bar[XB_XCNT(j)]); sum += c; cnt += (c > 0u) ? 1u : 0u; mine = (j == x) ? c : mine; }
        if (sum == G) break;
        __builtin_amdgcn_s_sleep(1);
        if ((++sp & 255u) == 0u) { if (xb_ld(&bar[XB_TMO])) break; if (sp > XB_SPIN_CAP) { atomicAdd(&bar[XB_TMO], 1u); break; } }
    }
    nloc = mine > 0u ? mine : 1u; nx = cnt > 0u ? cnt : 1u;
}

__device__ __forceinline__ void xcd_barrier(const XcdBarrier& b) {
    asm volatile("s_waitcnt vmcnt(0)" ::: "memory");
    __syncthreads();
    if (threadIdx.x == 0) {
        unsigned* bar = b.bar;
        __builtin_amdgcn_s_waitcnt(0);
        unsigned nloc = b.st[0], nx = b.st[1];
        if (nloc == 0u) { xcd_barrier_complete(bar, b.x, nloc, nx); b.st[0] = nloc; b.st[1] = nx; }
        const unsigned old = xb_add(&bar[XB_XSUB(b.x)], 1u);
        const unsigned gen = old / nloc;
        if (old + 1u == (gen + 1u) * nloc) {
            __builtin_amdgcn_fence(__ATOMIC_RELEASE, "agent");
            asm volatile("s_waitcnt vmcnt(0)" ::: "memory");
            const unsigned og = xb_add(&bar[XB_TOP], 1u);
            const unsigned tg = og / nx;
            if (og + 1u == (tg + 1u) * nx) xb_add(&bar[XB_TOPGEN], 1u);
            else XB_SPIN(xb_ld(&bar[XB_TOPGEN]) == tg, bar);
            __builtin_amdgcn_fence(__ATOMIC_ACQUIRE, "agent");
            xb_add(&bar[XB_XGEN(b.x)], 1u);
            asm volatile("s_waitcnt vmcnt(0)" ::: "memory");
        } else {
            XB_SPIN(xb_ld(&bar[XB_XGEN(b.x)]) == gen, bar);
            __builtin_amdgcn_fence(__ATOMIC_ACQUIRE, "agent");
            asm volatile("s_waitcnt vmcnt(0)" ::: "memory");
        }
    }
    __syncthreads();
}
DI void phase_mlstm_post(const P& p) {
    const int lane = mk_tid() & 63, wv = mk_tid() >> 6;
    const bf16_t* ML = (const bf16_t*)(p.ws + WS_COLS) + OFF_ML; const bf16_t* HB = (const bf16_t*)(p.ws + WS_ACT); bf16_t* Y = (bf16_t*)(p.ws + WS_COLS);
    for (int r = blockIdx.x * 8 + wv; r < NALL; r += gridDim.x * 8)
        post_headnorm_row(HB, (size_t)r, p.in[I_MNG], ML + (size_t)r * 2048 + 1536, 0, Y + (size_t)r * D + 512, lane);
}
DI void phase_hgrn_post(const P& p) {
    const int lane = mk_tid() & 63, wv = mk_tid() >> 6;
    const bf16_t* C1 = (const bf16_t*)(p.ws + WS_COLS); const bf16_t* HB = (const bf16_t*)(p.ws + WS_ACT); bf16_t* Y = (bf16_t*)(p.ws + WS_Z);
    for (int r = blockIdx.x * 8 + wv; r < NLAT; r += gridDim.x * 8)
        post_headnorm_row(HB, (size_t)r, p.in[I_HNG], C1 + (size_t)r * C1LD + 2048, 1, Y + (size_t)nat_row(r) * D, lane);
}

constexpr int N_PHASES = 19;
__global__ void __launch_bounds__(NT, 2) mk_fwd(P p) {
    extern __shared__ __attribute__((aligned(16))) unsigned char lds_raw[];
    LAS unsigned char* lds = (LAS unsigned char*)lds_raw;
    cooperative_groups::grid_group grid = cooperative_groups::this_grid();
    const int lo = p.ph_lo, hi = p.ph_hi;
    volatile LAS unsigned* xst = (volatile LAS unsigned*)(lds + LDS_BYTES - 16);
    if (threadIdx.x < 4) xst[threadIdx.x] = 0u;
    __syncthreads();
    const XcdBarrier xbar = xcd_barrier_post((unsigned*)(p.ws + WS_CTL) + 8192, xst);
#define IN(k) (lo <= (k) && (k) < hi)
#define SEAM(k) do { if (IN(k) && IN((k) + 1)) xcd_barrier(xbar); } while (0)
#ifndef MK_DUP
#define MK_DUP -1
#endif
#define PHASE(k, ...) if (IN(k)) { __VA_ARGS__ if (MK_DUP == (k)) { grid.sync(); __VA_ARGS__ } } SEAM(k);
    unsigned char* ws = p.ws;
    const float* MODV = (const float*)(ws + WS_MODV);
    float* HC = (float*)(ws + WS_HC);
    float* SSQP = (float*)(ws + WS_SSQP); const float* GSC = (const float*)(ws + WS_GSC); const float* SHW = GSC + SHW_OFF;
    bf16_t* ACT = (bf16_t*)(ws + WS_ACT); bf16_t* COLS = (bf16_t*)(ws + WS_COLS); bf16_t* Y1 = (bf16_t*)(ws + WS_Z);
    PHASE(0, phase_wprep(p, lds); phase_modv(p, lds);)
    PHASE(1, phase_modnorm(p, 0, 0, p.in[I_X], p.in[I_CTX], NALL, false);)
    PHASE(2, { EpiStore3 E{COLS + OFF_RW, 1536, 6, COLS + OFF_LO, 512, 8, COLS + OFF_ML, 2048, 0}; run_gemm(lds, ACT, (const bf16_t*)(ws + WS_W_EVIN), NLAT, 4096, 1024, E); E.pm0 = 128; run_gemm(lds, ACT + (size_t)NLAT * 1024, (const bf16_t*)(ws + WS_W_EVIN), NCTX, 4096, 1024, E); })
    PHASE(3, { const int bx = (int)blockIdx.x;
        if (gridDim.x == 256) { if (bx < 64) rwkv_chunk_unit<1>(p, lds, bx); else if (bx < 128) rwkv_chunk_unit<2>(p, lds, bx - 64); else gla_unit<0>(p, lds, bx - 128); }
        else for (int vb = bx; vb < 192; vb += gridDim.x) { if (vb < 64) rwkv_chunk_unit<0>(p, lds, vb); else gla_unit<0>(p, lds, vb - 64); } })
    if (IN(3) && MK_DUP == 303) { grid.sync(); if (blockIdx.x < 64) rwkv_chunk_unit<1>(p, lds, blockIdx.x); grid.sync(); }
    if (IN(3) && MK_DUP == 403) { grid.sync(); if (blockIdx.x >= 64 && blockIdx.x < 128) rwkv_chunk_unit<2>(p, lds, blockIdx.x - 64); grid.sync(); }
    if (IN(3) && MK_DUP == 103) { grid.sync(); for (int vb = blockIdx.x; vb < 64; vb += gridDim.x) rwkv_chunk_unit<0>(p, lds, vb); grid.sync(); }
    if (IN(3) && MK_DUP == 203) { grid.sync(); for (int vb = blockIdx.x; vb < 128; vb += gridDim.x) gla_unit<0>(p, lds, vb); grid.sync(); }
    PHASE(4, phase_mlstm_post(p); phase_rwkv_post2(p, lds);)
    PHASE(5, { EpiResid E{p.in[I_X], p.out, p.in[I_CTX], HC, MODV, 2, 0}; run_gemm(lds, COLS, (const bf16_t*)(ws + WS_W_EVOUT), NLAT, 1024, 1024, E); E.pm0 = 128; run_gemm(lds, COLS + (size_t)NLAT * 1024, (const bf16_t*)(ws + WS_W_EVOUT), NCTX, 1024, 1024, E); })
    PHASE(6, phase_modnorm(p, 0, 1, p.out, HC, NALL, false);)
    PHASE(7, { EpiSwiglu E{COLS, 0}; run_gemm(lds, ACT, (const bf16_t*)(ws + WS_W_UP), NLAT, 5632, 1024, E); E.pm0 = 128; run_gemm(lds, ACT + (size_t)NLAT * 1024, (const bf16_t*)(ws + WS_W_UP), NCTX, 5632, 1024, E); })
    PHASE(8, { EpiResid E{p.out, p.out, HC, HC, MODV, 5, 0}; run_gemm(lds, COLS, (const bf16_t*)(ws + WS_W_DN), NLAT, 1024, 2816, E); E.pm0 = 128; run_gemm(lds, COLS + (size_t)NLAT * 2816, (const bf16_t*)(ws + WS_W_DN), NCTX, 1024, 2816, E); })
    PHASE(9, phase_modnorm(p, 1, 0, p.out, HC, NALL, true);)
    PHASE(10, { EpiStore3 E{COLS, C1LD, 1 << 30, COLS, C1LD, 1 << 30, COLS, C1LD, 0}; run_gemm(lds, ACT, (const bf16_t*)(ws + WS_W_ODIN), NLAT, 3584, 1024, E); E.pm0 = 128; run_gemm(lds, ACT + (size_t)NLAT * 1024, (const bf16_t*)(ws + WS_W_ODIN), NCTX, 3584, 1024, E); })
    PHASE(11, phase_hgrn_prep2(p, lds); lru_pass<1>(p, lds, (int)blockIdx.x, (int)gridDim.x);)
    PHASE(12, { const int half = (int)gridDim.x >> 1; if ((int)blockIdx.x < half) { for (int u = blockIdx.x; u < 128; u += half) gla_unit<1>(p, lds, u); } else lru_pass<3>(p, lds, (int)blockIdx.x - half, (int)gridDim.x - half); })
    if (IN(12) && MK_DUP == 112) { grid.sync(); lru_pass<3>(p, lds, (int)blockIdx.x, (int)gridDim.x); grid.sync(); }
    if (IN(12) && MK_DUP == 212) { grid.sync(); for (int vb = blockIdx.x; vb < 128; vb += gridDim.x) gla_unit<1>(p, lds, vb); grid.sync(); }
    PHASE(13, phase_hgrn_post(p);)
    PHASE(14, EpiResid E{p.out, p.out, HC, HC, MODV + 5 * 6144, 2, 0}; run_gemm(lds, Y1, (const bf16_t*)(ws + WS_W_ODOUT), NLAT, 1024, 1024, E);)
    PHASE(15, phase_modnorm(p, 1, 1, p.out, HC, NLAT, false);)
    PHASE(16, EpiSwiglu E{COLS, 0}; run_gemm(lds, ACT, (const bf16_t*)(ws + WS_W_UP) + W_UP_STRIDE, NLAT, 5632, 1024, E);)
    PHASE(17, EpiResid E{p.out, p.out, HC, HC, MODV + 5 * 6144, 5, 0}; run_gemm(lds, COLS, (const bf16_t*)(ws + WS_W_DN) + W_DN_STRIDE, NLAT, 1024, 2816, E);)
    PHASE(18, phase_finalnorm(p);)
    if (hi > 4096) grid.sync();
#undef IN
#undef SEAM
}
}

#ifndef MK_ONE_LAUNCH
#define MK_ONE_LAUNCH 1
#endif
extern "C" void kernel_launch(void* const* d_in, const int* in_sizes, int n_in, void* d_out, int out_size, void* d_ws, size_t ws_size, hipStream_t stream) {
    using namespace mk;
    static int grid = 0;
    if (grid == 0) {
        int dev = 0, cus = 0, per_cu = 0;
        if (n_in != N_IN || ws_size < WS_END) { fprintf(stderr, "kernel_launch: unexpected n_in %d / ws_size %zu\n", n_in, ws_size); grid = -1; return; }
        (void)hipGetDevice(&dev); (void)hipDeviceGetAttribute(&cus, hipDeviceAttributeMultiprocessorCount, dev);
        (void)hipFuncSetAttribute((const void*)mk_fwd, hipFuncAttributeMaxDynamicSharedMemorySize, LDS_BYTES);
        (void)hipOccupancyMaxActiveBlocksPerMultiprocessor(&per_cu, (const void*)mk_fwd, NT, LDS_BYTES);
        if (per_cu < 1) { fprintf(stderr, "kernel_launch: occupancy query says %d blocks per CU\n", per_cu); per_cu = 1; }
        (void)hipGetLastError();
        grid = cus;
    }
    if (grid < 0) return;
    if (hipMemsetAsync((char*)d_ws + WS_CTL, 0, 65536, stream) != hipSuccess) { fprintf(stderr, "kernel_launch: memset of the control words failed\n"); return; }
    P p{};
    for (int i = 0; i < N_IN; ++i) p.in[i] = (const float*)d_in[i];
    p.out = (float*)d_out; p.ws = (unsigned char*)d_ws;
#if MK_ONE_LAUNCH
    p.ph_lo = 0; p.ph_hi = N_PHASES;
    void* args[] = {&p};
    hipError_t e = hipLaunchCooperativeKernel((const void*)mk_fwd, dim3(grid), dim3(NT), args, LDS_BYTES, stream);
    if (e != hipSuccess) fprintf(stderr, "cooperative launch failed: %s (grid %d)\n", hipGetErrorString(e), grid);
#else
    for (int k = 0; k < N_PHASES; ++k) { p.ph_lo = k; p.ph_hi = k + 1; hipLaunchKernelGGL(mk_fwd, dim3(grid), dim3(NT), LDS_BYTES, stream, p); }
#endif
}
```

```cpp
#include <hip/hip_runtime.h>
#include <hip/hip_cooperative_groups.h>
#include <cstdio>
#include <cstdint>
__device__ __forceinline__ int mk_tid() { int t = threadIdx.x; asm volatile("" : "+v"(t)); return t; }
#define MK_DUP -1
#define MK_RDUP -1
namespace pg8 {
#define PG8_LAS __attribute__((address_space(3)))
typedef unsigned short bf16_t;
typedef short bf16x8 __attribute__((ext_vector_type(8)));
typedef float f32x4 __attribute__((ext_vector_type(4)));
typedef unsigned u32x4 __attribute__((ext_vector_type(4)));
constexpr int BM = 256, BK = 64, HALF = 128, HTB = HALF * BK * 2  , STAGE_BYTES = 8 * HTB, NXCD = 8, WGM = 8;

__host__ __device__ __forceinline__ int lds_byte(int r, int c) { const int st = (r >> 4) * 2 + (c >> 5), rr = r & 15, cc = c & 31, ob = rr * 64 + cc * 2; return st * 1024 + (ob ^ (((ob >> 9) & 1) << 5)); }
__host__ __device__ __forceinline__ void stage_rc(int b, int& R, int& C) { const int st = b / 1024, sb = b % 1024, swz = sb ^ (((sb >> 9) & 1) << 5); R = (st >> 1) * 16 + swz / 64; C = (st & 1) * 32 + (swz % 64) / 2; }
__host__ __device__ __forceinline__ int perm32(int rho) { const int n = rho >> 4, i = rho & 15; return 8 * (i >> 2) + 4 * n + (i & 3); }

struct Unit { int pm, pn; };
struct Gemm { const bf16_t* A; const bf16_t* Bt; int M, N, K; };

struct StaticOrder {
    int nM, nN, nwg, G, c;
    __host__ __device__ void init(int M, int N, int G_, int c_) { nM = M / BM; nN = N / BM; nwg = nM * nN; G = G_; c = c_; }
    __host__ __device__ bool next(int i, Unit& u) const {
        const long L = (long)i * G + c; if (L >= nwg) return false;
        int wgid = (int)L; { const int q = nwg / NXCD, r = nwg % NXCD, xcd = wgid % NXCD, off = wgid / NXCD; wgid = (xcd < r ? xcd * (q + 1) : r * (q + 1) + (xcd - r) * q) + off; }
        const int nig = WGM * nN, gid = wgid / nig, fm = gid * WGM, gsz = (nM - fm) < WGM ? (nM - fm) : WGM;
        u.pm = fm + ((wgid % nig) % gsz); u.pn = (wgid % nig) / gsz; return true;
    }
    __device__ __forceinline__ void a_ready(const Unit&) const {}
    __device__ __forceinline__ void done(const Unit&) const {}
};
__device__ __forceinline__ unsigned cvt_pk_bf16(float lo, float hi) { unsigned r; asm volatile("v_cvt_pk_bf16_f32 %0, %1, %2" : "=v"(r) : "v"(lo), "v"(hi)); return r; }
typedef float f32x2 __attribute__((ext_vector_type(2)));
template <class Epi, class Sched, bool STAMP = false>
__device__ __forceinline__ void gemm_phase(PG8_LAS unsigned char* lds, const Gemm g, const Sched& S, const Epi& E, unsigned long long* stamps) {
    const int tid = mk_tid(), wid = __builtin_amdgcn_readfirstlane(tid >> 6), lane = tid & 63, wr = wid >> 2, wc = wid & 3, fr = lane & 15, fq = lane >> 4;
    const int K = g.K, nt = K / BK;
    int ts_lo = 0, ts_hi = 0, nts = 0; const unsigned long long rt_entry = STAMP ? (unsigned long long)wall_clock64() : 0ull;
#define PG8_STAMP() do { if (STAMP && wid == 0 && nts < 64) { const unsigned long long _c = (unsigned long long)clock64(); \
        ts_lo = (lane == nts) ? (int)(unsigned)_c : ts_lo; ts_hi = (lane == nts) ? (int)(unsigned)(_c >> 32) : ts_hi; ++nts; } } while (0)
    PG8_STAMP();
    unsigned voffA[2], voffB[2];
#pragma unroll
    for (int i = 0; i < 2; ++i) { int R, C; stage_rc(tid * 16 + i * 8192, R, C); const int Rb = Epi::PERM ? ((R & ~31) + perm32(R & 31)) : R;
        voffA[i] = (unsigned)(R * K + C) * 2u; voffB[i] = (unsigned)(Rb * K + C) * 2u; }
    const size_t kstep = (size_t)(BK * 2);
    const size_t hstep = (size_t)HALF * K * 2;
    const size_t tstep = 2 * hstep;
    const unsigned ldsw = (unsigned)wid * 1024u;
    const int aoff = lds_byte(wr * 64 + fr, fq * 8), boff = lds_byte(wc * 32 + fr, fq * 8);
#define PG8_SA(b, h) (((b) * 2 + (h)) * HTB)
#define PG8_SB(b, h) ((4 + (b) * 2 + (h)) * HTB)
#define PG8_STAGE(bufoff, gbase, voff) do { _Pragma("unroll") for (int _i = 0; _i < 2; ++_i) \
        __builtin_amdgcn_global_load_lds((const unsigned*)((const char*)(gbase) + (voff)[_i]), (PG8_LAS unsigned*)(lds + (bufoff) + ldsw + _i * 8192), 16, 0, 0); } while (0)
#define PG8_LDA(dst, b, h) do { _Pragma("unroll") for (int m = 0; m < 4; ++m) _Pragma("unroll") for (int k = 0; k < 2; ++k) dst[m][k] = *(const PG8_LAS bf16x8*)(lds + PG8_SA(b, h) + aoff + m * 2048 + k * 1024); } while (0)
#define PG8_LDB(dst, b, h) do { _Pragma("unroll") for (int n = 0; n < 2; ++n) _Pragma("unroll") for (int k = 0; k < 2; ++k) dst[n][k] = *(const PG8_LAS bf16x8*)(lds + PG8_SB(b, h) + boff + n * 2048 + k * 1024); } while (0)
#define PG8_MMA(ai, bj, At, Bt) do { __builtin_amdgcn_s_setprio(1); _Pragma("unroll") for (int m = 0; m < 4; ++m) _Pragma("unroll") for (int n = 0; n < 2; ++n) _Pragma("unroll") for (int k = 0; k < 2; ++k) \
        acc[ai][bj][m][n] = __builtin_amdgcn_mfma_f32_16x16x32_bf16(Bt[n][k], At[m][k], acc[ai][bj][m][n], 0, 0, 0); __builtin_amdgcn_s_setprio(0); } while (0)
#define PG8_WAIT_V(n) asm volatile("s_waitcnt vmcnt(" #n ")" ::: "memory")
#define PG8_WAIT_L(n) asm volatile("s_waitcnt lgkmcnt(" #n ")" ::: "memory")
#define PG8_BAR __builtin_amdgcn_s_barrier()
#define PG8_SCHED __builtin_amdgcn_sched_barrier(0)
    Unit cur, nxt; int ui = 0;
    if (!S.next(0, cur)) return;
    f32x4 acc[2][2][4][2];
#pragma unroll
    for (int a = 0; a < 2; ++a)
#pragma unroll
        for (int b = 0; b < 2; ++b)
#pragma unroll
            for (int m = 0; m < 4; ++m)
#pragma unroll
                for (int n = 0; n < 2; ++n) acc[a][b][m][n] = (f32x4){0.f, 0.f, 0.f, 0.f};
    bf16x8 At[4][2], B0[2][2], B1[2][2];
    const char* cA = (const char*)g.A + (size_t)cur.pm * tstep; const char* cB = (const char*)g.Bt + (size_t)cur.pn * tstep;
    S.a_ready(cur);
    PG8_STAGE(PG8_SB(0, 0), cB, voffB); PG8_STAGE(PG8_SA(0, 0), cA, voffA); PG8_STAGE(PG8_SB(0, 1), cB + hstep, voffB); PG8_STAGE(PG8_SA(0, 1), cA + hstep, voffA);
    if (wr == 1) PG8_BAR;
    PG8_WAIT_V(4); PG8_BAR;
    PG8_STAGE(PG8_SB(1, 0), cB + kstep, voffB); PG8_STAGE(PG8_SA(1, 0), cA + kstep, voffA); PG8_STAGE(PG8_SB(1, 1), cB + hstep + kstep, voffB);
    PG8_WAIT_V(6); PG8_BAR;
    PG8_STAMP();
    for (;;) {
        const bool has_next = S.next(ui + 1, nxt);
        const char* nA = has_next ? (const char*)g.A + (size_t)nxt.pm * tstep : cA; const char* nB = has_next ? (const char*)g.Bt + (size_t)nxt.pn * tstep : cB;
        for (int t = 0; t < nt; t += 2) {
            const bool last = (t == nt - 2);
            const char* a1 = cA + (size_t)(t + 1) * kstep;
            const char* a2 = last ? nA : cA + (size_t)(t + 2) * kstep; const char* b2 = last ? nB : cB + (size_t)(t + 2) * kstep;
            const char* a3 = a2 + kstep; const char* b3 = b2 + kstep;
            if (last && has_next) S.a_ready(nxt);
            PG8_LDB(B0, 0, 0); PG8_SCHED; PG8_LDA(At, 0, 0); PG8_STAGE(PG8_SA(1, 1), a1 + hstep, voffA);
            PG8_WAIT_L(8); PG8_BAR; PG8_WAIT_L(0); PG8_MMA(0, 0, At, B0); PG8_BAR; PG8_SCHED;
            PG8_LDB(B1, 0, 1); PG8_STAGE(PG8_SB(0, 0), b2, voffB);
            PG8_BAR; PG8_WAIT_L(0); PG8_MMA(0, 1, At, B1); PG8_BAR;
            PG8_LDA(At, 0, 1); PG8_STAGE(PG8_SA(0, 0), a2, voffA);
            PG8_BAR; PG8_WAIT_L(0); PG8_MMA(1, 0, At, B0); PG8_BAR; PG8_SCHED;
            PG8_STAGE(PG8_SB(0, 1), b2 + hstep, voffB);
            PG8_WAIT_V(6); PG8_BAR; PG8_MMA(1, 1, At, B1); PG8_BAR;
            PG8_LDB(B0, 1, 0); PG8_SCHED; PG8_LDA(At, 1, 0); PG8_STAGE(PG8_SA(0, 1), a2 + hstep, voffA);
            PG8_WAIT_L(8); PG8_BAR; PG8_WAIT_L(0); PG8_MMA(0, 0, At, B0); PG8_BAR; PG8_SCHED;
            PG8_LDB(B1, 1, 1); PG8_STAGE(PG8_SB(1, 0), b3, voffB);
            PG8_BAR; PG8_WAIT_L(0); PG8_MMA(0, 1, At, B1); PG8_BAR;
            PG8_LDA(At, 1, 1); PG8_STAGE(PG8_SA(1, 0), a3, voffA);
            PG8_BAR; PG8_WAIT_L(0); PG8_MMA(1, 0, At, B0); PG8_BAR; PG8_SCHED;
            PG8_STAGE(PG8_SB(1, 1), b3 + hstep, voffB);
            PG8_WAIT_V(6); PG8_BAR; PG8_MMA(1, 1, At, B1); PG8_BAR;
        }
        PG8_STAMP();
        if constexpr (!Epi::AFTER_DRAIN) { E(acc, cur, wr, wc, fr, fq); S.done(cur); }
        PG8_STAMP();
        if (!has_next) break;
#pragma unroll
        for (int a = 0; a < 2; ++a)
#pragma unroll
            for (int b = 0; b < 2; ++b)
#pragma unroll
                for (int m = 0; m < 4; ++m)
#pragma unroll
                    for (int n = 0; n < 2; ++n) acc[a][b][m][n] = (f32x4){0.f, 0.f, 0.f, 0.f};
        cur = nxt; cA = nA; cB = nB; ++ui;
    }
    PG8_WAIT_V(0);
    if (wr == 0) PG8_BAR;
    PG8_BAR;
    if constexpr (Epi::AFTER_DRAIN) { E.fused(acc, cur, wr, wc, fr, fq, lds, wid, lane); S.done(cur); }
    PG8_STAMP();
    if (STAMP && wid == 0) { stamps[lane] = lane < nts ? (((unsigned long long)(unsigned)ts_hi << 32) | (unsigned)ts_lo) : 0ull;
        if (lane == 62) stamps[62] = rt_entry; if (lane == 63) stamps[63] = (unsigned long long)wall_clock64(); }
#undef PG8_STAMP
#undef PG8_SA
#undef PG8_SB
#undef PG8_STAGE
#undef PG8_LDA
#undef PG8_LDB
#undef PG8_MMA
#undef PG8_WAIT_V
#undef PG8_WAIT_L
#undef PG8_BAR
#undef PG8_SCHED
}
}

namespace mk {
#define DI __device__ __forceinline__
#define LAS __attribute__((address_space(3)))
typedef unsigned short bf16_t;
typedef float f32x4 __attribute__((ext_vector_type(4)));
typedef unsigned u32x2 __attribute__((ext_vector_type(2)));
typedef unsigned u32x4 __attribute__((ext_vector_type(4)));

constexpr int D = 1024, NB = 4, L = 8192, LC = 256, NLAT = NB * L, NCTX = NB * LC, NALL = NLAT + NCTX, LT = L + LC, DFF = 2816;
constexpr int NT = 512;
constexpr size_t MiB = (size_t)1 << 20;
constexpr size_t WS_CTL = 0, WS_MODV = 1 * MiB, WS_HC = 2 * MiB, WS_W_EVIN = 6 * MiB, WS_W_EVOUT = 14 * MiB, WS_W_ODIN = 16 * MiB, WS_W_ODOUT = 23 * MiB,
                 WS_W_UP = 25 * MiB, WS_W_DN = 47 * MiB, WS_ACT = 58 * MiB, WS_COLS = 124 * MiB, WS_Z = 388 * MiB, WS_Z1 = 454 * MiB, WS_LAM = 486 * MiB, WS_LSUM = 489 * MiB, WS_LCAR = 494 * MiB, WS_SSQP = 497 * MiB, WS_GSC = 504 * MiB, WS_END = 505 * MiB;
constexpr size_t SSQP_STRIDE = (size_t)NALL * 16, GSC_STRIDE = 5 * 1024, SHW_OFF = 3 * GSC_STRIDE, SHW_STRIDE = 5 * 5632;
constexpr size_t W_UP_STRIDE = (size_t)5632 * 1024, W_DN_STRIDE = (size_t)1024 * 2816;
constexpr size_t OFF_RW = 0, OFF_LO = (size_t)NALL * 1536, OFF_ML = OFF_LO + (size_t)NALL * 512;
constexpr int LDS_BYTES = 163840;
constexpr int C1LD = 3584;
DI int nat_row(int r) { const int b = r / L, pp = r % L; return b * L + (pp % 128) * 64 + pp / 128; }

enum { I_X = 0, I_C, I_CTX, I_CCTX, I_N1G, I_N2G, I_MODW, I_MODB, I_W1, I_W3, I_W2, I_FING, I_EVIN, I_EVOUT, I_MU, I_W0, I_W2L, I_A0, I_A2L, I_KK, I_KA, I_RK,
       I_LNW, I_LNB, I_G2, I_MBI, I_MBF, I_MNG, I_ODIN, I_ODOUT, I_HLB, I_HNG, I_CONVW, I_CONVB, I_WA, I_BA, I_WI, I_BI, I_LAM, N_IN };

struct P { const float* in[N_IN]; float* out; unsigned char* ws; int ph_lo, ph_hi; };

DI float bf2f(bf16_t v) { return __uint_as_float(((unsigned)v) << 16); }
typedef float f32x2_t __attribute__((ext_vector_type(2)));
typedef __bf16 bf16x2_t __attribute__((ext_vector_type(2)));
DI unsigned pack2(float lo, float hi) { const f32x2_t v = {lo, hi}; return __builtin_bit_cast(unsigned, __builtin_convertvector(v, bf16x2_t)); }
DI bf16_t f2bf(float f) { return (bf16_t)(pack2(f, f) & 0xffffu); }
DI float sigm(float x) { return 1.f / (1.f + expf(-x)); }
DI float siluf(float x) { return x * sigm(x); }
DI float geluf(float x) { return 0.5f * x * (1.f + tanhf(0.7978845608028654f * (x + 0.044715f * x * x * x))); }
DI float fexp(float x) { return __builtin_amdgcn_exp2f(x * 1.4426950408889634f); }
DI float frcp(float x) { return __builtin_amdgcn_rcpf(x); }
DI float fsigm(float x) { return frcp(1.f + fexp(-x)); }
DI float ftanh(float x) { return 1.f - 2.f * frcp(1.f + fexp(2.f * x)); }
DI float fgelu(float x) { return 0.5f * x * (1.f + ftanh(0.7978845608028654f * (x + 0.044715f * x * x * x))); }
template <int CTRL> DI float dppf(float x) { return __int_as_float(__builtin_amdgcn_update_dpp(0, __float_as_int(x), CTRL, 0xF, 0xF, false)); }
DI float sum8(float s) { s += dppf<0xB1>(s); s += dppf<0x4E>(s); s += dppf<0x141>(s); return s; }
DI float scan16(float x) { x += dppf<0x111>(x); x += dppf<0x112>(x); x += dppf<0x114>(x); x += dppf<0x118>(x); return x; }
DI float wave_sum(float v) { v += dppf<0xB1>(v); v += dppf<0x4E>(v); v += dppf<0x141>(v); v += dppf<0x140>(v); v += __shfl_xor(v, 16); v += __shfl_xor(v, 32); return v; }
DI int step_row(int d, int b, int n) {
    if (n < LC) return NLAT + b * LC + (d ? LC - 1 - n : n);
    const int m = n - LC; return b * L + (d ? L - 1 - m : m);
}

DI int matN(int m) { return m == 0 ? 4096 : m == 1 ? 1024 : m == 2 ? 3584 : m == 3 ? 1024 : m < 6 ? 5632 : 1024; }
DI int matK(int m) { return m < 6 ? 1024 : 2816; }
DI int matTile0(int m) { return m == 0 ? 0 : m == 1 ? 1024 : m == 2 ? 1280 : m == 3 ? 2176 : m == 4 ? 2432 : m == 5 ? 3840 : m == 6 ? 5248 : m == 7 ? 5952 : 6656; }
DI size_t matOff(int m) { return m == 0 ? WS_W_EVIN : m == 1 ? WS_W_EVOUT : m == 2 ? WS_W_ODIN : m == 3 ? WS_W_ODOUT : m == 4 ? WS_W_UP : m == 5 ? WS_W_UP + W_UP_STRIDE * 2 : m == 6 ? WS_W_DN : WS_W_DN + W_DN_STRIDE * 2; }
DI const float* matSrc(const P& p, int m, int n, int& ld) {
    if (m == 0) { ld = 3984; int col; if (n < 1920) col = n; else if (n < 1936) col = 3968 + (n - 1920); else if (n < 2048) return nullptr; else col = 1920 + (n - 2048); return p.in[I_EVIN] + col; }
    if (m == 1) { ld = 1024; return p.in[I_EVOUT] + n; }
    if (m == 2) { ld = 3584; return p.in[I_ODIN] + n; }
    if (m == 3) { ld = 1024; return p.in[I_ODOUT] + n; }
    if (m < 6) { ld = 2816; const int l = m - 4, pn = n >> 8, w = n & 255; const size_t lo = (size_t)l * 1024 * 2816; return (w < 128) ? p.in[I_W1] + lo + 128 * pn + w : p.in[I_W3] + lo + 128 * pn + (w - 128); }
    ld = 1024; return p.in[I_W2] + (size_t)(m - 6) * 2816 * 1024 + n;
}
DI void phase_wprep(const P& p, LAS unsigned char* ldsb) {
    LAS float* tile = (LAS float*)ldsb;
    const int tid = mk_tid(), tx = tid & 63, ty = tid >> 6;
    for (int item = blockIdx.x; item < 6656; item += gridDim.x) {
        int m = 0;
#pragma unroll
        for (int q = 1; q < 8; ++q) if (item >= matTile0(q)) m = q;
        const int local = item - matTile0(m), K = matK(m), nK = K >> 6, nb = local / nK, kb = local - nb * nK, n0 = nb * 64, k0 = kb * 64;
        bf16_t* Bt = (bf16_t*)(p.ws + matOff(m));
        int ld; const float* src = matSrc(p, m, n0 + tx, ld);
        __syncthreads();
#pragma unroll
        for (int i = 0; i < 8; ++i) { const int k = k0 + ty + 8 * i; tile[(ty + 8 * i) * 65 + tx] = src ? src[(size_t)k * ld] : 0.f; }
        __syncthreads();
#pragma unroll
        for (int i = 0; i < 8; ++i) { const int nn = ty + 8 * i; Bt[(size_t)(n0 + nn) * K + k0 + tx] = f2bf(tile[tx * 65 + nn]); }
    }
    __syncthreads();
}
DI void phase_modv(const P& p, LAS unsigned char* ldsb) {
    LAS float* sc = (LAS float*)ldsb;
    const int tid = mk_tid();
    float* MODV = (float*)(p.ws + WS_MODV);
    __syncthreads();
    for (int e = tid; e < 5 * 1024; e += NT) { const int s = e >> 10, k = e & 1023; const float v = (s < 4) ? p.in[I_C][s * 1024 + k] : p.in[I_CCTX][k]; sc[e] = siluf(v); }
    __syncthreads();
    for (int vb = blockIdx.x; vb < 24; vb += gridDim.x) {
        const int l = vb / 12, n = (vb % 12) * 512 + tid;
        const float* W = p.in[I_MODW] + (size_t)l * 1024 * 6144 + n;
        float a0 = 0.f, a1 = 0.f, a2 = 0.f, a3 = 0.f, a4 = 0.f;
#pragma unroll 8
        for (int k = 0; k < 1024; ++k) { const float w = W[(size_t)k * 6144]; a0 += sc[k] * w; a1 += sc[1024 + k] * w; a2 += sc[2048 + k] * w; a3 += sc[3072 + k] * w; a4 += sc[4096 + k] * w; }
        const float bb = p.in[I_MODB][l * 6144 + n];
        float* o = MODV + (size_t)l * 5 * 6144 + n;
        o[0] = a0 + bb; o[6144] = a1 + bb; o[2 * 6144] = a2 + bb; o[3 * 6144] = a3 + bb; o[4 * 6144] = a4 + bb;
    }
    __syncthreads();
}

DI void phase_modnorm(const P& p, int layer, int which, const float* hlat, const float* hctx, int nrows, bool permute) {
    const int lane = mk_tid() & 63, wv = mk_tid() >> 6;
    const float* MODV = (const float*)(p.ws + WS_MODV) + (size_t)layer * 5 * 6144;
    const float* g = p.in[which ? I_N2G : I_N1G] + layer * 1024;
    bf16_t* ACT = (bf16_t*)(p.ws + WS_ACT);
    f32x4 gs[4], sh[4]; int sv_have = -1;
    const int rstep = gridDim.x * 8; int r = blockIdx.x * 8 + wv;
    f32x4 v[4], vn[4];
#define MN_SRC(rr) (((rr) >= NLAT) ? hctx + (size_t)((rr) - NLAT) * D : hlat + (size_t)(rr) * D)
    if (r < nrows) { const float* src = MN_SRC(r);
#pragma unroll
        for (int j = 0; j < 4; ++j) v[j] = *(const f32x4*)(src + 4 * lane + 256 * j); }
    for (; r < nrows; r += rstep) {
        const bool isctx = r >= NLAT; const int sv = isctx ? 4 : r / L;
        if (r + rstep < nrows) { const float* src = MN_SRC(r + rstep);
#pragma unroll
            for (int j = 0; j < 4; ++j) vn[j] = *(const f32x4*)(src + 4 * lane + 256 * j); }
        if (sv != sv_have) { sv_have = sv; const float* shift = MODV + sv * 6144 + (which ? 3 : 0) * 1024; const float* scale = shift + 1024;
#pragma unroll
            for (int j = 0; j < 4; ++j) { const int c = 4 * lane + 256 * j; const f32x4 gg = *(const f32x4*)(g + c), sc = *(const f32x4*)(scale + c); gs[j] = gg * (sc + 1.f); sh[j] = *(const f32x4*)(shift + c); } }
        int dr = r;
        if (permute && !isctx) { const int b = r / L, t = r % L; dr = b * L + (t % 64) * 128 + t / 64; }
        float ss = 0.f;
#pragma unroll
        for (int j = 0; j < 4; ++j) ss += (v[j].x * v[j].x + v[j].y * v[j].y) + (v[j].z * v[j].z + v[j].w * v[j].w);
        const float rinv = rsqrtf(wave_sum(ss) * (1.f / D) + 1e-6f);
#pragma unroll
        for (int j = 0; j < 4; ++j) { const int c = 4 * lane + 256 * j; const f32x4 o = v[j] * rinv * gs[j] + sh[j];
            u32x2 w; w.x = pack2(o[0], o[1]); w.y = pack2(o[2], o[3]);
            *(u32x2*)(ACT + (size_t)dr * D + c) = w; v[j] = vn[j]; }
    }
#undef MN_SRC
}
DI void phase_finalnorm(const P& p) {
    const int lane = mk_tid() & 63, wv = mk_tid() >> 6;
    const float* g = p.in[I_FING];
    f32x4 gg[4];
#pragma unroll
    for (int j = 0; j < 4; ++j) gg[j] = *(const f32x4*)(g + 4 * lane + 256 * j);
    const int rstep = gridDim.x * 8; int r = blockIdx.x * 8 + wv;
    f32x4 v[4], vn[4];
    if (r < NLAT) {
#pragma unroll
        for (int j = 0; j < 4; ++j) v[j] = *(const f32x4*)(p.out + (size_t)r * D + 4 * lane + 256 * j); }
    for (; r < NLAT; r += rstep) {
        if (r + rstep < NLAT) {
#pragma unroll
            for (int j = 0; j < 4; ++j) vn[j] = *(const f32x4*)(p.out + (size_t)(r + rstep) * D + 4 * lane + 256 * j); }
        float ss = 0.f;
#pragma unroll
        for (int j = 0; j < 4; ++j) ss += (v[j].x * v[j].x + v[j].y * v[j].y) + (v[j].z * v[j].z + v[j].w * v[j].w);
        const float rinv = rsqrtf(wave_sum(ss) * (1.f / D) + 1e-6f);
#pragma unroll
        for (int j = 0; j < 4; ++j) { *(f32x4*)(p.out + (size_t)r * D + 4 * lane + 256 * j) = v[j] * rinv * gg[j]; v[j] = vn[j]; }
    }
}

struct EpiStore3 {
    static constexpr bool PERM = true, AFTER_DRAIN = false;
    bf16_t* p0; int ld0; int pn1; bf16_t* p1; int ld1; int pn2; bf16_t* p2; int ld2; int pm0;
    DI void operator()(const f32x4 (&acc)[2][2][4][2], const pg8::Unit& u, int wr, int wc, int fr, int fq) const {
        bf16_t* base; int ld, ct;
        if (u.pn >= pn2) { base = p2; ld = ld2; ct = u.pn - pn2; } else if (u.pn >= pn1) { base = p1; ld = ld1; ct = u.pn - pn1; } else { base = p0; ld = ld0; ct = u.pn; }
        const int row0 = (u.pm + pm0) * 256 + wr * 64 + fr, col0 = ct * 256 + wc * 32 + 8 * fq;
#pragma unroll
        for (int ai = 0; ai < 2; ++ai)
#pragma unroll
            for (int m = 0; m < 4; ++m) { bf16_t* rowp = base + (size_t)(row0 + ai * 128 + m * 16) * ld + col0;
#pragma unroll
                for (int bj = 0; bj < 2; ++bj) { const f32x4 v0 = acc[ai][bj][m][0], v1 = acc[ai][bj][m][1];
                    u32x4 w; w.x = pack2(v0[0], v0[1]); w.y = pack2(v0[2], v0[3]); w.z = pack2(v1[0], v1[1]); w.w = pack2(v1[2], v1[3]); *(u32x4*)(rowp + bj * 128) = w; } }
    }
};
struct EpiResid {
    static constexpr bool PERM = false, AFTER_DRAIN = false;
    const float* hin; float* hout; const float* cin; float* cout; const float* modv_l; int gidx; int pm0;
    DI void operator()(const f32x4 (&acc)[2][2][4][2], const pg8::Unit& u, int wr, int wc, int fr, int fq) const {
        const int pm = u.pm + pm0; const bool isctx = pm >= 128; const int sv = isctx ? 4 : (pm >> 5);
        const float* gate = modv_l + sv * 6144 + gidx * 1024;
        const float* bi = isctx ? cin : hin; float* bo = isctx ? cout : hout;
        const int row0 = (isctx ? (pm - 128) : pm) * 256 + wr * 64 + fr, col0 = u.pn * 256 + wc * 32 + 4 * fq;
        f32x4 gv[2][2];
#pragma unroll
        for (int bj = 0; bj < 2; ++bj)
#pragma unroll
            for (int n = 0; n < 2; ++n) gv[bj][n] = *(const f32x4*)(gate + col0 + bj * 128 + n * 16);
#pragma unroll
        for (int ai = 0; ai < 2; ++ai)
#pragma unroll
            for (int m = 0; m < 4; ++m) { const size_t off = (size_t)(row0 + ai * 128 + m * 16) * D + col0;
#pragma unroll
                for (int bj = 0; bj < 2; ++bj)
#pragma unroll
                    for (int n = 0; n < 2; ++n) { const f32x4 bs = *(const f32x4*)(bi + off + bj * 128 + n * 16); *(f32x4*)(bo + off + bj * 128 + n * 16) = bs + gv[bj][n] * acc[ai][bj][m][n]; } }
    }
};
struct EpiResidN {
    static constexpr bool PERM = false, AFTER_DRAIN = false;
    const float* hin; float* hout; const float* cin; float* cout; const float* modv_l; int gidx;
    bf16_t* act; const float* gsc; float* ssqp; int permute;
    DI void operator()(const f32x4 (&acc)[2][2][4][2], const pg8::Unit& u, int wr, int wc, int fr, int fq) const {
        const bool isctx = u.pm >= 128; const int sv = isctx ? 4 : (u.pm >> 5);
        const float* gate = modv_l + sv * 6144 + gidx * 1024; const float* gs = gsc + sv * 1024;
        const float* bi = isctx ? cin : hin; float* bo = isctx ? cout : hout;
        const int row0 = (isctx ? (u.pm - 128) : u.pm) * 256 + wr * 64 + fr, col0 = u.pn * 256 + wc * 32 + 4 * fq;
        f32x4 gv[2][2], gsv[2][2];
#pragma unroll
        for (int bj = 0; bj < 2; ++bj)
#pragma unroll
            for (int n = 0; n < 2; ++n) { gv[bj][n] = *(const f32x4*)(gate + col0 + bj * 128 + n * 16); gsv[bj][n] = *(const f32x4*)(gs + col0 + bj * 128 + n * 16); }
#pragma unroll
        for (int ai = 0; ai < 2; ++ai)
#pragma unroll
            for (int m = 0; m < 4; ++m) { const int rl = row0 + ai * 128 + m * 16; const size_t off = (size_t)rl * D + col0;
                int arow = u.pm * 256 + wr * 64 + fr + ai * 128 + m * 16;
                if (permute && !isctx) { const int b = arow / L, t = arow % L; arow = b * L + (t % 64) * 128 + t / 64; }
                float ss = 0.f;
#pragma unroll
                for (int bj = 0; bj < 2; ++bj)
#pragma unroll
                    for (int n = 0; n < 2; ++n) { const f32x4 bs = *(const f32x4*)(bi + off + bj * 128 + n * 16); const f32x4 hn = bs + gv[bj][n] * acc[ai][bj][m][n];
                        *(f32x4*)(bo + off + bj * 128 + n * 16) = hn; ss += (hn[0] * hn[0] + hn[1] * hn[1]) + (hn[2] * hn[2] + hn[3] * hn[3]);
                        const f32x4 an = hn * gsv[bj][n]; u32x2 w; w.x = pack2(an[0], an[1]); w.y = pack2(an[2], an[3]); *(u32x2*)(act + (size_t)arow * D + col0 + bj * 128 + n * 16) = w; }
                ss += __shfl_xor(ss, 16); ss += __shfl_xor(ss, 32);
                if (fq == 0) ssqp[(size_t)arow * 16 + u.pn * 4 + wc] = ss; }
    }
};
struct EpiSwiglu {
    static constexpr bool PERM = true, AFTER_DRAIN = false;
    bf16_t* G; int pm0;
    DI void operator()(const f32x4 (&acc)[2][2][4][2], const pg8::Unit& u, int wr, int wc, int fr, int fq) const {
        const int row0 = (u.pm + pm0) * 256 + wr * 64 + fr, col0 = u.pn * 128 + wc * 32 + 8 * fq;
#pragma unroll
        for (int ai = 0; ai < 2; ++ai)
#pragma unroll
            for (int m = 0; m < 4; ++m) { bf16_t* rowp = G + (size_t)(row0 + ai * 128 + m * 16) * DFF + col0; float g[8];
#pragma unroll
                for (int n = 0; n < 2; ++n) { const f32x4 a = acc[ai][0][m][n], b = acc[ai][1][m][n];
#pragma unroll
                    for (int j = 0; j < 4; ++j) g[4 * n + j] = a[j] * frcp(1.f + fexp(-a[j])) * b[j]; }
                u32x4 w; w.x = pack2(g[0], g[1]); w.y = pack2(g[2], g[3]); w.z = pack2(g[4], g[5]); w.w = pack2(g[6], g[7]); *(u32x4*)rowp = w; }
    }
};
template <class Epi> DI void run_gemm(LAS unsigned char* lds, const bf16_t* A, const bf16_t* Bt, int M, int N, int K, const Epi& E) {
    pg8::Gemm g{A, Bt, M, N, K}; pg8::StaticOrder S; S.init(M, N, (int)gridDim.x, (int)blockIdx.x);
    pg8::gemm_phase<Epi, pg8::StaticOrder, false>((PG8_LAS unsigned char*)lds, g, S, E, nullptr);
    __syncthreads();
}


DI void phase_norm_tables(const P& p) {
    const int tid = mk_tid(), lane = tid & 63, wv = tid >> 6;
    const float* MODV = (const float*)(p.ws + WS_MODV); float* GSC = (float*)(p.ws + WS_GSC); float* SHW = GSC + SHW_OFF;
    for (int e = blockIdx.x * NT + tid; e < 3 * 5 * 1024; e += gridDim.x * NT) { const int site = e / 5120, s = (e / 1024) % 5, c = e & 1023;
        const int layer = site ? 1 : 0, scidx = (site == 1) ? 1 : 4; const float g = p.in[(site == 1) ? I_N1G : I_N2G][layer * 1024 + c];
        GSC[e] = g * (1.f + MODV[(size_t)layer * 5 * 6144 + s * 6144 + scidx * 1024 + c]); }
    for (int w = blockIdx.x * 8 + wv; w < 5632 + 3584 + 5632; w += gridDim.x * 8) {
        int site, n; const bf16_t* Bt;
        if (w < 5632) { site = 0; n = w; Bt = (const bf16_t*)(p.ws + WS_W_UP); } else if (w < 5632 + 3584) { site = 1; n = w - 5632; Bt = (const bf16_t*)(p.ws + WS_W_ODIN); } else { site = 2; n = w - 5632 - 3584; Bt = (const bf16_t*)(p.ws + WS_W_UP) + W_UP_STRIDE; }
        const int layer = site ? 1 : 0, shidx = (site == 1) ? 0 : 3;
        const u32x4 w0 = *(const u32x4*)(Bt + (size_t)n * 1024 + 16 * lane), w1 = *(const u32x4*)(Bt + (size_t)n * 1024 + 16 * lane + 8);
        float wf[16];
#pragma unroll
        for (int k = 0; k < 4; ++k) { wf[2 * k] = __uint_as_float(w0[k] << 16); wf[2 * k + 1] = __uint_as_float(w0[k] & 0xffff0000u); wf[8 + 2 * k] = __uint_as_float(w1[k] << 16); wf[8 + 2 * k + 1] = __uint_as_float(w1[k] & 0xffff0000u); }
#pragma unroll
        for (int s = 0; s < 5; ++s) { const float* sh = MODV + (size_t)layer * 5 * 6144 + s * 6144 + shidx * 1024 + 16 * lane; float a = 0.f;
#pragma unroll
            for (int k = 0; k < 16; ++k) a += sh[k] * wf[k];
            a = wave_sum(a);
            if (lane == 0) SHW[(size_t)site * SHW_STRIDE + s * 5632 + n] = a; }
    }
}
DI void phase_rwkv_scan_unit(const P& p, LAS unsigned char* ldsb, const int vb) {
    LAS float* lds = (LAS float*)ldsb;
    LAS float *w2s = lds, *a2s = lds + 4096, *prm = lds + 8192, *TH = prm + 768, *AD = TH + 2048, *R = AD + 2048, *W = R + 2048, *K = W + 2048, *KK = K + 2048, *BV = KK + 2048,
              *V = BV + 2048, *BS = V + 2048, *OUT = BS + 32;
    const int tid = mk_tid(), lane = tid & 63, wv = tid >> 6;
    const bf16_t* RW = (const bf16_t*)(p.ws + WS_COLS) + OFF_RW; const bf16_t* LO = (const bf16_t*)(p.ws + WS_COLS) + OFF_LO; bf16_t* Z = (bf16_t*)(p.ws + WS_Z);
    const int srow = tid >> 3, sg = tid & 7;
    {
        const int d = vb >> 5, b = (vb >> 3) & 3, h = vb & 7;
        __syncthreads();
        for (int e = tid; e < 4096; e += NT) { const int i = e >> 6, c = e & 63; w2s[e] = p.in[I_W2L][(size_t)(d * 64 + i) * 512 + 64 * h + c]; a2s[e] = p.in[I_A2L][(size_t)(d * 64 + i) * 512 + 64 * h + c]; }
        if (tid < 64) { const int j = tid, c = 64 * h + j; const float* mu = p.in[I_MU] + d * 1664;
            prm[j] = mu[c]; prm[64 + j] = mu[512 + c]; prm[128 + j] = mu[1024 + c]; prm[192 + j] = mu[1536 + j]; prm[256 + j] = mu[1600 + j];
            prm[320 + j] = p.in[I_W0][d * 512 + c]; prm[384 + j] = p.in[I_A0][d * 512 + c]; prm[448 + j] = p.in[I_KK][d * 512 + c]; prm[512 + j] = p.in[I_KA][d * 512 + c];
            prm[576 + j] = p.in[I_RK][(d * 8 + h) * 64 + j]; prm[640 + j] = p.in[I_LNW][d * 512 + c]; prm[704 + j] = p.in[I_LNB][d * 512 + c]; }
        __syncthreads();
        float S0 = 0.f, S1 = 0.f, S2 = 0.f, S3 = 0.f, S4 = 0.f, S5 = 0.f, S6 = 0.f, S7 = 0.f;
        for (int n0 = 0; n0 < LT; n0 += 32) {
            float rs[4], ks[4], vs[4];
#pragma unroll
            for (int m = 0; m < 4; ++m) { const int s = wv + 8 * m, n = n0 + s; const bool hp = (n != 0) && (n != LC);
                const size_t row = (size_t)step_row(d, b, n), prow = hp ? (size_t)step_row(d, b, n - 1) : row; const int c = 64 * h + lane;
                const float r0 = bf2f(RW[row * 1536 + c]), k0 = bf2f(RW[row * 1536 + 512 + c]), v0 = bf2f(RW[row * 1536 + 1024 + c]);
                const float r1 = hp ? bf2f(RW[prow * 1536 + c]) : 0.f, k1 = hp ? bf2f(RW[prow * 1536 + 512 + c]) : 0.f, v1 = hp ? bf2f(RW[prow * 1536 + 1024 + c]) : 0.f;
                rs[m] = r0 + prm[lane] * (r1 - r0); ks[m] = k0 + prm[64 + lane] * (k1 - k0); vs[m] = v0 + prm[128 + lane] * (v1 - v0);
                const float wd0 = bf2f(LO[row * 512 + 64 * d + lane]), wd1 = hp ? bf2f(LO[prow * 512 + 64 * d + lane]) : 0.f;
                const float ad0 = bf2f(LO[row * 512 + 128 + 64 * d + lane]), ad1 = hp ? bf2f(LO[prow * 512 + 128 + 64 * d + lane]) : 0.f;
                TH[s * 64 + lane] = tanhf(wd0 + prm[192 + lane] * (wd1 - wd0)); AD[s * 64 + lane] = ad0 + prm[256 + lane] * (ad1 - ad0); }
            __syncthreads();
#pragma unroll
            for (int m = 0; m < 4; ++m) { const int s = wv + 8 * m;
                float xw = prm[320 + lane], xa = prm[384 + lane];
#pragma unroll 8
                for (int i = 0; i < 64; ++i) { xw += TH[s * 64 + i] * w2s[i * 64 + lane]; xa += AD[s * 64 + i] * a2s[i * 64 + lane]; }
                const float elog = 0.6065306597126334f * sigm(xw), dec = expf(-elog), a = sigm(xa);
                const float kkr = ks[m] * prm[448 + lane]; const float ss = wave_sum(kkr * kkr); const float kkn = kkr / fmaxf(sqrtf(ss), 1e-12f);
                const float km = ks[m] * (1.f + (a - 1.f) * prm[512 + lane]);
                const float bs = wave_sum(rs[m] * km * prm[576 + lane]);
                R[s * 64 + lane] = rs[m]; W[s * 64 + lane] = dec; K[s * 64 + lane] = km; KK[s * 64 + lane] = kkn; BV[s * 64 + lane] = kkn * a; V[s * 64 + lane] = vs[m];
                if (lane == 0) BS[s] = bs; }
            __syncthreads();
            for (int s = 0; s < 32; ++s) {
                const LAS f32x4* pq = (const LAS f32x4*)(KK + s * 64 + 8 * sg); const f32x4 q0 = pq[0], q1 = pq[1];
                const LAS f32x4* pw = (const LAS f32x4*)(W + s * 64 + 8 * sg); const f32x4 w0 = pw[0], w1 = pw[1];
                const LAS f32x4* pb = (const LAS f32x4*)(BV + s * 64 + 8 * sg); const f32x4 b0 = pb[0], b1 = pb[1];
                const LAS f32x4* pk = (const LAS f32x4*)(K + s * 64 + 8 * sg); const f32x4 k0 = pk[0], k1 = pk[1];
                const LAS f32x4* pr = (const LAS f32x4*)(R + s * 64 + 8 * sg); const f32x4 r0 = pr[0], r1 = pr[1];
                const float vi = V[s * 64 + srow];
                float sa = S0 * q0.x + S1 * q0.y + S2 * q0.z + S3 * q0.w + S4 * q1.x + S5 * q1.y + S6 * q1.z + S7 * q1.w;
                sa += __shfl_xor(sa, 1); sa += __shfl_xor(sa, 2); sa += __shfl_xor(sa, 4);
                S0 = S0 * w0.x - sa * b0.x + vi * k0.x; S1 = S1 * w0.y - sa * b0.y + vi * k0.y; S2 = S2 * w0.z - sa * b0.z + vi * k0.z; S3 = S3 * w0.w - sa * b0.w + vi * k0.w;
                S4 = S4 * w1.x - sa * b1.x + vi * k1.x; S5 = S5 * w1.y - sa * b1.y + vi * k1.y; S6 = S6 * w1.z - sa * b1.z + vi * k1.z; S7 = S7 * w1.w - sa * b1.w + vi * k1.w;
                float o = S0 * r0.x + S1 * r0.y + S2 * r0.z + S3 * r0.w + S4 * r1.x + S5 * r1.y + S6 * r1.z + S7 * r1.w;
                o += __shfl_xor(o, 1); o += __shfl_xor(o, 2); o += __shfl_xor(o, 4);
                if (sg == 0) OUT[s * 64 + srow] = o;
            }
            __syncthreads();
#pragma unroll
            for (int m = 0; m < 4; ++m) { const int s = wv + 8 * m, n = n0 + s; const size_t row = (size_t)step_row(d, b, n);
                const float o = OUT[s * 64 + lane]; const float mean = wave_sum(o) * (1.f / 64.f); const float dv = o - mean; const float var = wave_sum(dv * dv) * (1.f / 64.f);
                const float z = dv * rsqrtf(var + 64e-5f) * prm[640 + lane] + prm[704 + lane] + BS[s] * V[s * 64 + lane];
                Z[((size_t)d * NALL + row) * 512 + 64 * h + lane] = f2bf(z); }
        }
    }
    __syncthreads();
}
DI void phase_rwkv_post(const P& p, LAS unsigned char* ldsb) {
    LAS float* sg = (LAS float*)ldsb;
    const int tid = mk_tid();
    const bf16_t* LO = (const bf16_t*)(p.ws + WS_COLS) + OFF_LO; const bf16_t* Z = (const bf16_t*)(p.ws + WS_Z); bf16_t* Y = (bf16_t*)(p.ws + WS_COLS);
    const float* g2 = p.in[I_G2];
    for (int vb = blockIdx.x; vb < NALL / 8; vb += gridDim.x) {
        const size_t row0 = (size_t)vb * 8;
        __syncthreads();
        for (int e = tid; e < 1024; e += NT) { const int q = e >> 7, r = e & 127; sg[e] = sigm(bf2f(LO[(row0 + q) * 512 + 256 + r])); }
        __syncthreads();
        float a0 = 0.f, a1 = 0.f, a2 = 0.f, a3 = 0.f, a4 = 0.f, a5 = 0.f, a6 = 0.f, a7 = 0.f;
#pragma unroll 4
        for (int r = 0; r < 128; ++r) { const float g = g2[r * 512 + tid];
            a0 += sg[r] * g; a1 += sg[128 + r] * g; a2 += sg[256 + r] * g; a3 += sg[384 + r] * g; a4 += sg[512 + r] * g; a5 += sg[640 + r] * g; a6 += sg[768 + r] * g; a7 += sg[896 + r] * g; }
#define MK_RP(q, aq) { const size_t rr = row0 + q; const float z = bf2f(Z[rr * 512 + tid]) + bf2f(Z[((size_t)NALL + rr) * 512 + tid]); Y[rr * D + tid] = f2bf(z * aq); }
        MK_RP(0, a0) MK_RP(1, a1) MK_RP(2, a2) MK_RP(3, a3) MK_RP(4, a4) MK_RP(5, a5) MK_RP(6, a6) MK_RP(7, a7)
#undef MK_RP
    }
    __syncthreads();
}
DI void post_headnorm_row(const bf16_t* HB, size_t row, const float* ng, const bf16_t* gsrc, int gate_kind, bf16_t* ydst, int lane) {
    const int c0 = 8 * lane;
    const u32x4 h0 = *(const u32x4*)(HB + row * 512 + c0), h1 = *(const u32x4*)(HB + ((size_t)NALL + row) * 512 + c0), gg = *(const u32x4*)(gsrc + c0);
    float h[8], g[8];
#pragma unroll
    for (int j = 0; j < 4; ++j) { h[2 * j] = __uint_as_float(h0[j] << 16) + __uint_as_float(h1[j] << 16); h[2 * j + 1] = __uint_as_float(h0[j] & 0xffff0000u) + __uint_as_float(h1[j] & 0xffff0000u);
        g[2 * j] = __uint_as_float(gg[j] << 16); g[2 * j + 1] = __uint_as_float(gg[j] & 0xffff0000u); }
    float ss = 0.f;
#pragma unroll
    for (int j = 0; j < 8; ++j) ss += h[j] * h[j];
    ss += __shfl_xor(ss, 1); ss += __shfl_xor(ss, 2); ss += __shfl_xor(ss, 4); ss += __shfl_xor(ss, 8);
    const float rinv = rsqrtf(ss * (1.f / 128.f) + 1e-6f);
    unsigned o[4];
#pragma unroll
    for (int j = 0; j < 4; ++j) { const float y0 = h[2 * j] * rinv * ng[c0 + 2 * j] * (gate_kind ? siluf(g[2 * j]) : sigm(g[2 * j])), y1 = h[2 * j + 1] * rinv * ng[c0 + 2 * j + 1] * (gate_kind ? siluf(g[2 * j + 1]) : sigm(g[2 * j + 1]));
        o[j] = pack2(y0, y1); }
    u32x4 w; w.x = o[0]; w.y = o[1]; w.z = o[2]; w.w = o[3];
    *(u32x4*)(ydst + c0) = w;
}
typedef short bf16x8 __attribute__((ext_vector_type(8)));
typedef short s16x4 __attribute__((ext_vector_type(4)));
constexpr int PQ = 136, PS = 72, PV = 56;
constexpr int E_QS = 0, E_KS = E_QS + 64 * PQ * 2, E_VS = E_KS + 64 * PQ * 2, E_PS = E_VS + 64 * PV * 2, E_ST = E_PS + 64 * PS * 2, E_F = E_ST + 48 * PQ * 2, E_END = E_F + 1024;
constexpr size_t WS_Q1 = WS_COLS + (size_t)231 * MiB;
constexpr int NRC = NALL / 64;

DI int chunk_row0(int d, int b, int ci) {
    if (ci < 4) { const int cc = d ? 3 - ci : ci; return NLAT + b * LC + 64 * cc; }
    const int lc = ci - 4, cl = d ? 127 - lc : lc; return b * L + 64 * cl;
}
DI bf16x8 tr_frag(unsigned tile_base, int pitch, int k0, int c0, int r, int q) {
    const unsigned a0 = tile_base + (unsigned)(((k0 + 8 * q + (r >> 2)) * pitch + c0 + 4 * (r & 3)) * 2), a1 = a0 + (unsigned)(4 * pitch * 2);
    s16x4 x, y;
    asm volatile("ds_read_b64_tr_b16 %0, %2\n\tds_read_b64_tr_b16 %1, %3\n\ts_waitcnt lgkmcnt(0)" : "=&v"(x), "=&v"(y) : "v"(a0), "v"(a1) : "memory");
    bf16x8 o; o[0] = x[0]; o[1] = x[1]; o[2] = x[2]; o[3] = x[3]; o[4] = y[0]; o[5] = y[1]; o[6] = y[2]; o[7] = y[3];
    return o;
}

#define GLA_PREFETCH(ci_) do { const int row0_ = chunk_row0(d, b, (ci_)); \
    _Pragma("unroll") for (int i = 0; i < 2; ++i) { const size_t row_ = (size_t)(row0_ + prow0 + 32 * i); \
        rq[i] = *(const u32x4*)(Qg + row_ * ldq + 8 * ppc); rk[i] = *(const u32x4*)(Kg + row_ * ldk + 8 * ppc); } \
    if (tid < 256) rv = *(const u32x4*)(Vg + (size_t)(row0_ + vrow) * ldv + 8 * vpc); \
    if (MODE == 0) { if (tid < 64) { const size_t row_ = (size_t)(row0_ + (d ? 63 - lane : lane)); gi = bf2f(LO[row_ * 512 + 384 + 4 * d + hd]); gf = bf2f(LO[row_ * 512 + 392 + 4 * d + hd]); } } \
    else rlam = *(const f32x4*)(LAM + ((size_t)d * NRC + (row0_ >> 6)) * 512 + 128 * hd + 16 * wv + 4 * q); } while (0)

template <int MODE> DI void gla_unit(const P& p, LAS unsigned char* lds, int unit) {
    constexpr int NDV = MODE == 0 ? 3 : 2;
    const int tid = mk_tid(), lane = tid & 63, wv = __builtin_amdgcn_readfirstlane(tid >> 6), r = lane & 15, q = lane >> 4;
    const int d = unit >> 6, b = (unit >> 4) & 3, hd = (unit >> 2) & 3, sl = unit & 3;
    const bf16_t* COLS = (const bf16_t*)(p.ws + WS_COLS);
    const bf16_t *Qg, *Kg, *Vg; int ldq, ldk, ldv;
    if (MODE == 0) { const bf16_t* ML = COLS + OFF_ML; Qg = ML + 128 * hd; Kg = ML + 512 + 128 * hd; Vg = ML + 1024 + 128 * hd + 32 * sl; ldq = ldk = ldv = 2048; }
    else { Qg = d ? (const bf16_t*)(p.ws + WS_Q1) + 128 * hd : COLS + 128 * hd; ldq = d ? 512 : 3584; Kg = COLS + 512 + 512 * d + 128 * hd; ldk = 3584; Vg = COLS + 1536 + 128 * hd + 32 * sl; ldv = 3584; }
    const bf16_t* LO = COLS + OFF_LO;
    const float* LAM = (const float*)(p.ws + WS_LAM);
    bf16_t* HB = (bf16_t*)(p.ws + WS_ACT);
    LAS bf16_t* Qs = (LAS bf16_t*)(lds + E_QS); LAS bf16_t* Ks = (LAS bf16_t*)(lds + E_KS); LAS bf16_t* Vs = (LAS bf16_t*)(lds + E_VS);
    LAS bf16_t* Ps = (LAS bf16_t*)(lds + E_PS); LAS bf16_t* STs = (LAS bf16_t*)(lds + E_ST); LAS float* Fs = (LAS float*)(lds + E_F);
    const unsigned ks_base = (unsigned)(size_t)Ks, vs_base = (unsigned)(size_t)Vs;
    float bi = 0.f, bfv = 0.f;
    if (MODE == 0) { bi = p.in[I_MBI][d * 4 + hd]; bfv = p.in[I_MBF][d * 4 + hd]; }
    __syncthreads();
    for (int e = tid; e < 48 * PQ / 2; e += NT) ((LAS unsigned*)STs)[e] = 0u;
    for (int e = tid; e < 64 * PV / 2; e += NT) ((LAS unsigned*)Vs)[e] = 0u;
    __syncthreads();
    f32x4 Sacc[NDV];
#pragma unroll
    for (int n = 0; n < NDV; ++n) Sacc[n] = (f32x4){0.f, 0.f, 0.f, 0.f};
    u32x4 rq[2], rk[2], rv = (u32x4){0u, 0u, 0u, 0u}; float gi = 0.f, gf = 0.f; f32x4 rlam = (f32x4){1.f, 1.f, 1.f, 1.f};
    const int prow0 = tid >> 4, ppc = tid & 15;
    const int vrow = tid >> 2, vpc = tid & 3;
    GLA_PREFETCH(0);
    for (int ci = 0; ci < 132; ++ci) {
        const int row0 = chunk_row0(d, b, ci);
        unsigned oz = 0u; asm volatile("" : "+v"(oz));
        const unsigned ks_b = ks_base + oz, vs_b = vs_base + oz;
        f32x4 lamv = rlam;
        if (MODE == 0) {
            if (tid < 64) {
                const float li = gi + bi, x = gf + bfv;
                float v = -log1pf(expf(-x));
#pragma unroll
                for (int o = 1; o < 64; o <<= 1) { const float t = __shfl_up(v, o); if (lane >= o) v += t; }
                const int rc = d ? 63 - lane : lane;
                Fs[rc] = expf(v) * 0.08838834764831845f; Fs[64 + rc] = expf(li - v);
                if (lane == 63) Fs[128] = expf(v);
            }
        }
#pragma unroll
        for (int i = 0; i < 2; ++i) { const int row = prow0 + 32 * i; *(LAS u32x4*)(Qs + row * PQ + 8 * ppc) = rq[i]; *(LAS u32x4*)(Ks + row * PQ + 8 * ppc) = rk[i]; }
        if (MODE == 0) __syncthreads();
        if (tid < 256) {
            if (MODE == 0) { const float w = Fs[64 + vrow]; u32x4 o;
#pragma unroll
                for (int e = 0; e < 4; ++e) o[e] = pack2(__uint_as_float(rv[e] << 16) * w, __uint_as_float(rv[e] & 0xffff0000u) * w);
                *(LAS u32x4*)(Vs + vrow * PV + 8 * vpc) = o;
                if (vpc == 0) Vs[vrow * PV + 32] = f2bf(w); }
            else *(LAS u32x4*)(Vs + vrow * PV + 8 * vpc) = rv;
        }
        __syncthreads();
        if (ci + 1 < 132) GLA_PREFETCH(ci + 1);
        if (MODE == 0) { const float l = Fs[128]; lamv = (f32x4){l, l, l, l}; }
        {
            const int tt = wv & 3, sh = wv >> 2;
            f32x4 pacc[2] = {(f32x4){0.f, 0.f, 0.f, 0.f}, (f32x4){0.f, 0.f, 0.f, 0.f}};
#pragma unroll
            for (int kk = 0; kk < 4; ++kk) { const bf16x8 bq = *(const LAS bf16x8*)(Qs + (16 * tt + r) * PQ + 32 * kk + 8 * q);
#pragma unroll
                for (int i = 0; i < 2; ++i) { const bf16x8 a = *(const LAS bf16x8*)(Ks + (16 * (2 * sh + i) + r) * PQ + 32 * kk + 8 * q); pacc[i] = __builtin_amdgcn_mfma_f32_16x16x32_bf16(a, bq, pacc[i], 0, 0, 0); } }
            const int t = 16 * tt + r;
#pragma unroll
            for (int i = 0; i < 2; ++i) { const int s0 = 16 * (2 * sh + i) + 4 * q; float v[4];
#pragma unroll
                for (int j = 0; j < 4; ++j) { const int s = s0 + j; const bool ok = d ? (s >= t) : (s <= t); v[j] = ok ? pacc[i][j] : 0.f; }
                u32x2 w; w.x = pack2(v[0], v[1]); w.y = pack2(v[2], v[3]); *(LAS u32x2*)(Ps + t * PS + s0) = w; }
        }
#pragma unroll
        for (int kk = 0; kk < 2; ++kk) { const bf16x8 a = tr_frag(ks_b, PQ, 32 * kk, 16 * wv, r, q);
#pragma unroll
            for (int n = 0; n < NDV; ++n) { const bf16x8 bv = tr_frag(vs_b, PV, 32 * kk, 16 * n, r, q); Sacc[n] = __builtin_amdgcn_mfma_f32_16x16x32_bf16(a, bv, Sacc[n], 0, 0, 0); } }
        __syncthreads();
        {
            const int tt = wv & 3, nA = wv >> 2;
            f32x4 oacc = (f32x4){0.f, 0.f, 0.f, 0.f}, dacc = (f32x4){0.f, 0.f, 0.f, 0.f};
#pragma unroll
            for (int kk = 0; kk < 2; ++kk) { const bf16x8 bp = *(const LAS bf16x8*)(Ps + (16 * tt + r) * PS + 32 * kk + 8 * q);
                const bf16x8 a = tr_frag(vs_b, PV, 32 * kk, 16 * nA, r, q); oacc = __builtin_amdgcn_mfma_f32_16x16x32_bf16(a, bp, oacc, 0, 0, 0);
                if (MODE == 0) { const bf16x8 a2 = tr_frag(vs_b, PV, 32 * kk, 32, r, q); dacc = __builtin_amdgcn_mfma_f32_16x16x32_bf16(a2, bp, dacc, 0, 0, 0); } }
#pragma unroll
            for (int kk = 0; kk < 4; ++kk) { const bf16x8 bq = *(const LAS bf16x8*)(Qs + (16 * tt + r) * PQ + 32 * kk + 8 * q);
                const bf16x8 a = *(const LAS bf16x8*)(STs + (16 * nA + r) * PQ + 32 * kk + 8 * q); oacc = __builtin_amdgcn_mfma_f32_16x16x32_bf16(a, bq, oacc, 0, 0, 0);
                if (MODE == 0) { const bf16x8 a2 = *(const LAS bf16x8*)(STs + (32 + r) * PQ + 32 * kk + 8 * q); dacc = __builtin_amdgcn_mfma_f32_16x16x32_bf16(a2, bq, dacc, 0, 0, 0); } }
            const int t = 16 * tt + r;
            float o0 = oacc[0], o1 = oacc[1], o2 = oacc[2], o3 = oacc[3];
            if (MODE == 0) { const float rs = Fs[t]; const float den = __shfl(dacc[0], r) * rs; const float inv = rs / fmaxf(fabsf(den), 1.f); o0 *= inv; o1 *= inv; o2 *= inv; o3 *= inv; }
            u32x2 w; w.x = pack2(o0, o1); w.y = pack2(o2, o3);
            *(u32x2*)(HB + ((size_t)d * NALL + row0 + t) * 512 + 128 * hd + 32 * sl + 16 * nA + 4 * q) = w;
        }
        __syncthreads();
#pragma unroll
        for (int n = 0; n < NDV; ++n) { Sacc[n] = Sacc[n] * lamv; u32x2 w; w.x = pack2(Sacc[n][0], Sacc[n][1]); w.y = pack2(Sacc[n][2], Sacc[n][3]); *(LAS u32x2*)(STs + (16 * n + r) * PQ + 16 * wv + 4 * q) = w; }
    }
    __syncthreads();
}

DI void phase_hgrn_prep(const P& p, LAS unsigned char* ldsb) {
    LAS float* tot = (LAS float*)ldsb;
    const int tid = mk_tid(), ch = tid & 127, qt = tid >> 7;
    bf16_t* C1 = (bf16_t*)(p.ws + WS_COLS); bf16_t* Q1 = (bf16_t*)(p.ws + WS_Q1); float* LAM = (float*)(p.ws + WS_LAM);
    for (int vb = blockIdx.x; vb < NRC * 4; vb += gridDim.x) {
        const int rc = vb >> 2, hd = vb & 3, c = 128 * hd + ch; const size_t rbase = (size_t)rc * 64 + 16 * qt;
        const float lb = sigm(p.in[I_HLB][512 + c] - p.in[I_HLB][c]);
        float qv[16], l0[16], l1[16], k0[16], k1[16];
#pragma unroll
        for (int i = 0; i < 16; ++i) { const bf16_t* base = C1 + (rbase + i) * 3584;
            qv[i] = siluf(bf2f(base[c])); const float s0 = sigm(bf2f(base[512 + c])), s1 = sigm(bf2f(base[1024 + c]));
            l0[i] = logf(lb + (1.f - lb) * s0); l1[i] = logf(lb + (1.f - lb) * s1); k0[i] = (1.f - lb) * (1.f - s0); k1[i] = (1.f - lb) * (1.f - s1); }
#pragma unroll
        for (int i = 1; i < 16; ++i) l0[i] += l0[i - 1];
#pragma unroll
        for (int i = 14; i >= 0; --i) l1[i] += l1[i + 1];
        __syncthreads();
        tot[qt * 128 + ch] = l0[15]; tot[512 + qt * 128 + ch] = l1[0];
        __syncthreads();
        float off0 = 0.f, off1 = 0.f, t0 = 0.f, t1 = 0.f;
#pragma unroll
        for (int j = 0; j < 4; ++j) { const float a = tot[j * 128 + ch], bb = tot[512 + j * 128 + ch]; t0 += a; t1 += bb; if (j < qt) off0 += a; if (j > qt) off1 += bb; }
#pragma unroll
        for (int i = 0; i < 16; ++i) { bf16_t* base = C1 + (rbase + i) * 3584; const float c0 = l0[i] + off0, c1 = l1[i] + off1;
            base[c] = f2bf(qv[i] * expf(c0)); base[512 + c] = f2bf(k0[i] * expf(-c0)); base[1024 + c] = f2bf(k1[i] * expf(-c1)); Q1[(rbase + i) * 512 + c] = f2bf(qv[i] * expf(c1)); }
        if (qt == 0) { LAM[((size_t)rc) * 512 + c] = expf(t0); LAM[((size_t)NRC + rc) * 512 + c] = expf(t1); }
    }
    __syncthreads();
}
DI float flog(float x) { return __builtin_amdgcn_logf(x) * 0.6931471805599453f; }
DI void phase_hgrn_prep2(const P& p, LAS unsigned char* ldsb) {
    LAS float* tot = (LAS float*)ldsb;
    const int tid = mk_tid(), cp = tid & 63, qt = (tid >> 6) & 3, rs = tid >> 8, c0 = 8 * cp;
    bf16_t* C1 = (bf16_t*)(p.ws + WS_COLS); bf16_t* Q1 = (bf16_t*)(p.ws + WS_Q1); float* LAM = (float*)(p.ws + WS_LAM);
    float lb[8], omlb[8];
#pragma unroll
    for (int k = 0; k < 8; ++k) { lb[k] = fsigm(p.in[I_HLB][512 + c0 + k] - p.in[I_HLB][c0 + k]); omlb[k] = 1.f - lb[k]; }
    for (int vb = blockIdx.x; vb < NRC / 2; vb += gridDim.x) {
        const int rc = 2 * vb + rs; const size_t rbase = (size_t)rc * 64 + 16 * qt;
        float s0[8], s1[8];
#pragma unroll
        for (int k = 0; k < 8; ++k) { s0[k] = 0.f; s1[k] = 0.f; }
#pragma unroll 4
        for (int i = 0; i < 16; ++i) { const bf16_t* base = C1 + (rbase + i) * 3584; const u32x4 f0 = *(const u32x4*)(base + 512 + c0), f1 = *(const u32x4*)(base + 1024 + c0);
#pragma unroll
            for (int k = 0; k < 4; ++k) { s0[2 * k] += flog(lb[2 * k] + omlb[2 * k] * fsigm(__uint_as_float(f0[k] << 16))); s0[2 * k + 1] += flog(lb[2 * k + 1] + omlb[2 * k + 1] * fsigm(__uint_as_float(f0[k] & 0xffff0000u)));
                s1[2 * k] += flog(lb[2 * k] + omlb[2 * k] * fsigm(__uint_as_float(f1[k] << 16))); s1[2 * k + 1] += flog(lb[2 * k + 1] + omlb[2 * k + 1] * fsigm(__uint_as_float(f1[k] & 0xffff0000u))); } }
        __syncthreads();
#pragma unroll
        for (int k = 0; k < 8; k += 4) { *(LAS f32x4*)(tot + ((rs * 2 + 0) * 4 + qt) * 512 + c0 + k) = (f32x4){s0[k], s0[k + 1], s0[k + 2], s0[k + 3]}; *(LAS f32x4*)(tot + ((rs * 2 + 1) * 4 + qt) * 512 + c0 + k) = (f32x4){s1[k], s1[k + 1], s1[k + 2], s1[k + 3]}; }
        __syncthreads();
        float run0[8], run1[8], t0[8], t1[8];
#pragma unroll
        for (int k = 0; k < 8; ++k) { run0[k] = 0.f; run1[k] = 0.f; t0[k] = 0.f; t1[k] = 0.f; }
#pragma unroll
        for (int j = 0; j < 4; ++j)
#pragma unroll
            for (int k = 0; k < 8; ++k) { const float a = tot[((rs * 2 + 0) * 4 + j) * 512 + c0 + k], bb = tot[((rs * 2 + 1) * 4 + j) * 512 + c0 + k]; t0[k] += a; t1[k] += bb; if (j < qt) run0[k] += a; if (j >= qt) run1[k] += bb; }
        if (qt == 0) {
#pragma unroll
            for (int k = 0; k < 8; k += 4) { *(f32x4*)(LAM + (size_t)rc * 512 + c0 + k) = (f32x4){fexp(t0[k]), fexp(t0[k + 1]), fexp(t0[k + 2]), fexp(t0[k + 3])};
                *(f32x4*)(LAM + ((size_t)NRC + rc) * 512 + c0 + k) = (f32x4){fexp(t1[k]), fexp(t1[k + 1]), fexp(t1[k + 2]), fexp(t1[k + 3])}; } }
#pragma unroll 2
        for (int i = 0; i < 16; ++i) { bf16_t* base = C1 + (rbase + i) * 3584; const u32x4 qv = *(const u32x4*)(base + c0), f0 = *(const u32x4*)(base + 512 + c0), f1 = *(const u32x4*)(base + 1024 + c0);
            float oq0[8], ok0[8], ok1[8], oq1[8];
#pragma unroll
            for (int k = 0; k < 8; ++k) { const unsigned wq = qv[k >> 1], w0 = f0[k >> 1], w1 = f1[k >> 1];
                const float qx = (k & 1) ? __uint_as_float(wq & 0xffff0000u) : __uint_as_float(wq << 16), x0 = (k & 1) ? __uint_as_float(w0 & 0xffff0000u) : __uint_as_float(w0 << 16), x1 = (k & 1) ? __uint_as_float(w1 & 0xffff0000u) : __uint_as_float(w1 << 16);
                const float sq = qx * fsigm(qx), sg0 = fsigm(x0), sg1 = fsigm(x1);
                const float l0 = flog(lb[k] + omlb[k] * sg0), l1 = flog(lb[k] + omlb[k] * sg1);
                run0[k] += l0;
                const float cb = run1[k];
                run1[k] -= l1;
                const float e0 = fexp(run0[k]), e1 = fexp(cb);
                oq0[k] = sq * e0; ok0[k] = omlb[k] * (1.f - sg0) * frcp(e0); ok1[k] = omlb[k] * (1.f - sg1) * frcp(e1); oq1[k] = sq * e1; }
            u32x4 w; w.x = pack2(oq0[0], oq0[1]); w.y = pack2(oq0[2], oq0[3]); w.z = pack2(oq0[4], oq0[5]); w.w = pack2(oq0[6], oq0[7]); *(u32x4*)(base + c0) = w;
            w.x = pack2(ok0[0], ok0[1]); w.y = pack2(ok0[2], ok0[3]); w.z = pack2(ok0[4], ok0[5]); w.w = pack2(ok0[6], ok0[7]); *(u32x4*)(base + 512 + c0) = w;
            w.x = pack2(ok1[0], ok1[1]); w.y = pack2(ok1[2], ok1[3]); w.z = pack2(ok1[4], ok1[5]); w.w = pack2(ok1[6], ok1[7]); *(u32x4*)(base + 1024 + c0) = w;
            w.x = pack2(oq1[0], oq1[1]); w.y = pack2(oq1[2], oq1[3]); w.z = pack2(oq1[4], oq1[5]); w.w = pack2(oq1[6], oq1[7]); *(u32x4*)(Q1 + (rbase + i) * 512 + c0) = w; }
    }
    __syncthreads();
}
constexpr int XBP = 68, M_XB = 0, M_XCS = M_XB + 67 * XBP * 4, M_XCF = M_XCS + 64 * 72 * 2, M_W = M_XCF + 64 * 64 * 4, M_AU = M_W + 4 * 64 * 72 * 2, M_SEG = M_AU + 4 * 64 * 65 * 4, M_PRM = M_SEG + 4 * 8 * 64 * 4,
              M_CAR = M_PRM + 11 * 64 * 4, M_END = M_CAR + 2 * 64 * 4;
static_assert(M_END <= LDS_BYTES, "lru LDS map");
DI float nexpm1_small(float x) { const float ser = -x * (1.f + x * 0.5f * (1.f + x * (1.f / 3.f) * (1.f + x * 0.25f * (1.f + x * 0.2f)))); return (x > -0.25f) ? ser : 1.f - fexp(x); }
DI int lru_rc_at(int d, int b, int s) { if (s < 4) return 512 + 4 * b + (d ? 3 - s : s); const int lc = s - 4; return 128 * b + (d ? 127 - lc : lc); }
template <int PASS> DI void lru_pass(const P& p, LAS unsigned char* lds, const int lb, const int nlb) {
    const int tid = mk_tid(), lane = tid & 63, wv = __builtin_amdgcn_readfirstlane(tid >> 6), r = lane & 15, q = lane >> 4;
    const int hb = lb & 7;
    const bf16_t* C1 = (const bf16_t*)(p.ws + WS_COLS); bf16_t* Y = (bf16_t*)(p.ws + WS_Z); float* LSUM = (float*)(p.ws + WS_LSUM);
    LAS float* XB = (LAS float*)(lds + M_XB); LAS bf16_t* XCs = (LAS bf16_t*)(lds + M_XCS); LAS float* XCf = (LAS float*)(lds + M_XCF); LAS bf16_t* Wt = (LAS bf16_t*)(lds + M_W);
    LAS float* AU = (LAS float*)(lds + M_AU);
    LAS float* SEG = (LAS float*)(lds + M_SEG);
    LAS float* prm = (LAS float*)(lds + M_PRM);
    LAS float* CAR = (LAS float*)(lds + M_CAR);
    __syncthreads();
    for (int e = tid; e < 4 * 4096; e += NT) { const int g = e >> 12, i = (e >> 6) & 63, j = e & 63, d = g >> 1; const size_t o = ((size_t)(d * 8 + hb) * 64 + i) * 64 + j;
        Wt[(g * 64 + j) * 72 + i] = f2bf((g & 1) ? p.in[I_WI][o] : p.in[I_WA][o]); }
    if (tid < 64) { const int ch = 64 * hb + tid;
        prm[tid] = p.in[I_CONVW][ch]; prm[64 + tid] = p.in[I_CONVW][512 + ch]; prm[128 + tid] = p.in[I_CONVW][1024 + ch]; prm[192 + tid] = p.in[I_CONVW][1536 + ch]; prm[256 + tid] = p.in[I_CONVB][ch];
        prm[320 + tid] = p.in[I_BA][ch]; prm[384 + tid] = p.in[I_BA][512 + ch]; prm[448 + tid] = p.in[I_BI][ch]; prm[512 + tid] = p.in[I_BI][512 + ch];
        prm[576 + tid] = log1pf(expf(-p.in[I_LAM][ch])); prm[640 + tid] = log1pf(expf(-p.in[I_LAM][512 + ch])); }
    const int nrc = (PASS == 1) ? NRC : 512;
    const int cpr = (PASS == 3) ? 512 / (nlb >> 3) : 1, rc_lo = (PASS == 3) ? (lb >> 3) * cpr : (lb >> 3), rstep = (PASS == 3) ? 1 : (nlb >> 3), rc_hi = (PASS == 3) ? rc_lo + cpr : nrc;
    float* LCAR = (float*)(p.ws + WS_LCAR);
    if (PASS == 3 && tid < 128) { const int d = tid >> 6, j = tid & 63, ch = 64 * hb + j, b = rc_lo >> 7, cl0 = rc_lo & 127;
        const int p_lo = d ? 4 + 127 - (cl0 + cpr - 1) : 4 + cl0;
        const float* S = LSUM + (size_t)d * NRC * 1024 + 2 * ch; float hcar = 0.f;
#pragma unroll 8
        for (int s = 0; s < p_lo; ++s) { const float* e2 = S + (size_t)lru_rc_at(d, b, s) * 1024; hcar = e2[0] * hcar + e2[1]; }
        for (int s = p_lo; s < p_lo + cpr; ++s) { const int rcs = lru_rc_at(d, b, s); LCAR[((size_t)d * NRC + rcs) * 512 + ch] = hcar; const float* e2 = S + (size_t)rcs * 1024; hcar = e2[0] * hcar + e2[1]; }
    }
    u32x4 px[2];
#define LRU_PREFETCH(rc_) do { const int rc__ = (rc_); const int row0_ = rc__ * 64; const int seg_lo_ = (rc__ >= 512) ? NLAT + ((rc__ - 512) >> 2) * LC : (rc__ >> 7) * L, seg_hi_ = seg_lo_ + ((rc__ >= 512) ? LC : L); \
    _Pragma("unroll") for (int i = 0; i < 2; ++i) { const int e = tid + 512 * i, rr = e >> 3, pc = e & 7, grow = row0_ - 2 + rr; px[i] = (u32x4){0u, 0u, 0u, 0u}; \
        if (e < 67 * 8 && grow >= seg_lo_ && grow < seg_hi_) px[i] = *(const u32x4*)(C1 + (size_t)grow * C1LD + 2560 + 64 * hb + 8 * pc); } } while (0)
    int rc = rc_lo;
    if (rc < rc_hi) LRU_PREFETCH(rc);
    for (; rc < rc_hi; rc += rstep) {
        const int row0 = rc * 64;
        const int sg = tid >> 6, j = lane, ch = 64 * hb + j;
        float cin = 0.f;
        if (PASS == 3 && tid < 128) cin = LCAR[((size_t)(tid >> 6) * NRC + rc) * 512 + ch];
        float gbv[8];
        if (PASS == 3) {
#pragma unroll
            for (int k = 0; k < 8; ++k) gbv[k] = bf2f(C1[(size_t)(row0 + 8 * sg + k) * C1LD + 3072 + ch]); }
#pragma unroll
        for (int i = 0; i < 2; ++i) { const int e = tid + 512 * i; if (e < 67 * 8) { const int rr = e >> 3, pc = e & 7; const u32x4 v = px[i];
            f32x4 lo, hi; lo[0] = __uint_as_float(v[0] << 16); lo[1] = __uint_as_float(v[0] & 0xffff0000u); lo[2] = __uint_as_float(v[1] << 16); lo[3] = __uint_as_float(v[1] & 0xffff0000u);
            hi[0] = __uint_as_float(v[2] << 16); hi[1] = __uint_as_float(v[2] & 0xffff0000u); hi[2] = __uint_as_float(v[3] << 16); hi[3] = __uint_as_float(v[3] & 0xffff0000u);
            *(LAS f32x4*)(XB + rr * XBP + 8 * pc) = lo; *(LAS f32x4*)(XB + rr * XBP + 8 * pc + 4) = hi; } }
        if (PASS == 3 && tid < 128) CAR[tid] = cin;
        __syncthreads();
        if (rc + rstep < rc_hi) LRU_PREFETCH(rc + rstep);
        {
            const int t = tid >> 3, i0 = 8 * (tid & 7); float xc[8];
#pragma unroll
            for (int c = 0; c < 8; ++c) { const int i = i0 + c; xc[c] = prm[256 + i] + prm[i] * XB[t * XBP + i] + prm[64 + i] * XB[(t + 1) * XBP + i] + prm[128 + i] * XB[(t + 2) * XBP + i] + prm[192 + i] * XB[(t + 3) * XBP + i]; XCf[t * 64 + i] = xc[c]; }
            u32x4 w; w.x = pack2(xc[0], xc[1]); w.y = pack2(xc[2], xc[3]); w.z = pack2(xc[4], xc[5]); w.w = pack2(xc[6], xc[7]);
            *(LAS u32x4*)(XCs + t * 72 + i0) = w;
        }
        __syncthreads();
        {
            const int jt = wv & 3, th = wv >> 2, jc = 16 * jt + r;
#pragma unroll
            for (int d = 0; d < 2; ++d) { const float ba = prm[320 + 64 * d + jc], bi = prm[448 + 64 * d + jc], spl = prm[576 + 64 * d + jc];
#pragma unroll
                for (int i2 = 0; i2 < 2; ++i2) { const int tt = 2 * th + i2;
                    f32x4 aa = (f32x4){0.f, 0.f, 0.f, 0.f}, ai = (f32x4){0.f, 0.f, 0.f, 0.f};
#pragma unroll
                    for (int kk = 0; kk < 2; ++kk) { const bf16x8 xf = *(const LAS bf16x8*)(XCs + (16 * tt + r) * 72 + 32 * kk + 8 * q);
                        const bf16x8 wa = *(const LAS bf16x8*)(Wt + ((2 * d) * 64 + 16 * jt + r) * 72 + 32 * kk + 8 * q), wi = *(const LAS bf16x8*)(Wt + ((2 * d + 1) * 64 + 16 * jt + r) * 72 + 32 * kk + 8 * q);
                        aa = __builtin_amdgcn_mfma_f32_16x16x32_bf16(xf, wa, aa, 0, 0, 0); ai = __builtin_amdgcn_mfma_f32_16x16x32_bf16(xf, wi, ai, 0, 0, 0); }
#pragma unroll
                    for (int jj = 0; jj < 4; ++jj) { const int t = 16 * tt + 4 * q + jj;
                        const float rg = fsigm(aa[jj] + ba), ig = fsigm(ai[jj] + bi), la = -8.f * rg * spl;
                        const float a = fexp(la);
                        AU[((2 * d) * 64 + t) * 65 + jc] = a; AU[((2 * d + 1) * 64 + t) * 65 + jc] = __builtin_amdgcn_sqrtf(fmaxf(fmaf(-a, a, 1.f), 0.f)) * (ig * XCf[t * 64 + jc]); } } }
        }
        __syncthreads();
        const LAS float* A0 = AU + (8 * sg) * 65 + j; const LAS float* U0 = AU + (64 + 8 * sg) * 65 + j; const LAS float* A1 = AU + (128 + 8 * sg) * 65 + j; const LAS float* U1 = AU + (192 + 8 * sg) * 65 + j;
        {
            float p0 = 1.f, h0 = 0.f, p1 = 1.f, h1 = 0.f;
#pragma unroll
            for (int k = 0; k < 8; ++k) { const float a = A0[k * 65]; h0 = a * h0 + U0[k * 65]; p0 *= a; }
#pragma unroll
            for (int k = 7; k >= 0; --k) { const float a = A1[k * 65]; h1 = a * h1 + U1[k * 65]; p1 *= a; }
            SEG[(0 * 8 + sg) * 64 + j] = p0; SEG[(1 * 8 + sg) * 64 + j] = h0; SEG[(2 * 8 + sg) * 64 + j] = p1; SEG[(3 * 8 + sg) * 64 + j] = h1;
        }
        __syncthreads();
        if (PASS == 1) {
            if (tid < 128) { const int d = tid >> 6; float pa = 1.f, hh = 0.f;
#pragma unroll
                for (int s2 = 0; s2 < 8; ++s2) { const int sgi = d ? 7 - s2 : s2; const float ps = SEG[((2 * d) * 8 + sgi) * 64 + j], hs = SEG[((2 * d + 1) * 8 + sgi) * 64 + j]; hh = ps * hh + hs; pa *= ps; }
                float* o = LSUM + ((size_t)d * NRC + rc) * 1024 + 2 * ch; o[0] = pa; o[1] = hh; }
        } else {
            float hf = CAR[j], hbk = CAR[64 + j];
            for (int s2 = 0; s2 < sg; ++s2) hf = SEG[(0 * 8 + s2) * 64 + j] * hf + SEG[(1 * 8 + s2) * 64 + j];
            for (int s2 = 7; s2 > sg; --s2) hbk = SEG[(2 * 8 + s2) * 64 + j] * hbk + SEG[(3 * 8 + s2) * 64 + j];
            float of[8];
#pragma unroll
            for (int k = 0; k < 8; ++k) { hf = A0[k * 65] * hf + U0[k * 65]; of[k] = hf; }
#pragma unroll
            for (int k = 7; k >= 0; --k) { hbk = A1[k * 65] * hbk + U1[k * 65]; of[k] += hbk; }
#pragma unroll
            for (int k = 0; k < 8; ++k) Y[(size_t)nat_row(row0 + 8 * sg + k) * D + 512 + ch] = f2bf(of[k] * fgelu(gbv[k]));
        }
        __syncthreads();
    }
#undef LRU_PREFETCH
}
constexpr int PT = 72, PM = 40;
constexpr int C_PRM = 0, C_GAM = C_PRM + 3072, C_MISC = C_GAM + 1024, C_SBF = C_MISC + 1280, C_TILES = C_SBF + 2 * 64 * PT * 2, C_TH = C_TILES + 5 * 80 * PT * 2, C_MBF = C_TH + 2 * 64 * PT * 2,
              C_SM = C_MBF + 4 * 16 * 20 * 4, C_W1T = C_SM + 4 * 4 * 16 * PM * 2, C_AH = C_W1T + 4 * 64 * PM * 2, C_YV = C_AH + 4 * 16 * PT * 2, C_END = C_YV + 64 * PM * 2;
static_assert(C_END <= LDS_BYTES, "rwkv chunk LDS map");
DI void unpack4(u32x2 v, float* o) { o[0] = __uint_as_float(v.x << 16); o[1] = __uint_as_float(v.x & 0xffff0000u); o[2] = __uint_as_float(v.y << 16); o[3] = __uint_as_float(v.y & 0xffff0000u); }
DI u32x2 pack4(float a, float b, float c, float d) { u32x2 w; w.x = pack2(a, b); w.y = pack2(c, d); return w; }
DI bf16x8 zero_if(bf16x8 v, bool z) { const bf16x8 zz = {0, 0, 0, 0, 0, 0, 0, 0}; return z ? zz : v; }

constexpr int RING_SLOTS = 4, SLOT_U64 = 5632;
constexpr size_t WS_RING = WS_Z1;
DI void wait_ge(unsigned* word, unsigned want) {
    unsigned spins = 0;
    while ((unsigned)__builtin_amdgcn_readfirstlane((int)__hip_atomic_load(word, __ATOMIC_RELAXED, __HIP_MEMORY_SCOPE_AGENT)) < want) { __builtin_amdgcn_s_sleep(2); if (++spins > (1u << 21)) break; }
    __builtin_amdgcn_fence(__ATOMIC_ACQUIRE, "agent");
    asm volatile("s_waitcnt vmcnt(0)" ::: "memory");
}
template <int ROLE> DI void rwkv_chunk_unit(const P& p, LAS unsigned char* lds, const int vb) {
    const int tid = mk_tid(), lane = tid & 63, wv = __builtin_amdgcn_readfirstlane(tid >> 6), r = lane & 15, q = lane >> 4;
    const int d = vb >> 5, b = (vb >> 3) & 3, h = vb & 7;
    const bf16_t* RW = (const bf16_t*)(p.ws + WS_COLS) + OFF_RW; const bf16_t* LO = (const bf16_t*)(p.ws + WS_COLS) + OFF_LO; bf16_t* Z = (bf16_t*)(p.ws + WS_Z);
    unsigned long long* ring = (unsigned long long*)(p.ws + WS_RING) + (size_t)vb * RING_SLOTS * SLOT_U64;
    unsigned* READY = (unsigned*)(p.ws + WS_CTL) + 64 * vb; unsigned* ACK = (unsigned*)(p.ws + WS_CTL) + 64 * (64 + vb);
    LAS float* prm = (LAS float*)(lds + C_PRM); LAS float* GAM = (LAS float*)(lds + C_GAM); LAS float* SSQ = (LAS float*)(lds + C_MISC); LAS float* BSP = SSQ + 128; LAS float* BS = SSQ + 256;
    LAS bf16_t* Sbf = (LAS bf16_t*)(lds + C_SBF);
    LAS bf16_t* At = (LAS bf16_t*)(lds + C_TILES); LAS bf16_t* Rt = At + 80 * PT; LAS bf16_t* Bt = Rt + 80 * PT; LAS bf16_t* Kt = Bt + 80 * PT; LAS bf16_t* Vt = Kt + 80 * PT;
    LAS bf16_t* TH = (LAS bf16_t*)(lds + C_TH); LAS bf16_t* AD = TH + 64 * PT; LAS float* OUT = (LAS float*)(lds + C_TH);
    LAS float* MBf = (LAS float*)(lds + C_MBF);
    LAS bf16_t* MK = (LAS bf16_t*)(lds + C_SM); LAS bf16_t* NK = MK + 4 * 16 * PM; LAS bf16_t* NB = NK + 4 * 16 * PM; LAS bf16_t* DNV = NB + 4 * 16 * PM;
    LAS bf16_t* W1T = (LAS bf16_t*)(lds + C_W1T); LAS bf16_t* AH = (LAS bf16_t*)(lds + C_AH); LAS bf16_t* YV = (LAS bf16_t*)(lds + C_YV);
    const unsigned at_b = (unsigned)(size_t)At, bt_b = (unsigned)(size_t)Bt, kt_b = (unsigned)(size_t)Kt, vt_b = (unsigned)(size_t)Vt;
    __syncthreads();
    for (int e = tid; e < (C_END - C_SBF) / 4; e += NT) ((LAS unsigned*)(lds + C_SBF))[e] = 0u;
    if (tid < 64) { const int j = tid, c = 64 * h + j; const float* mu = p.in[I_MU] + d * 1664;
        prm[j] = mu[c]; prm[64 + j] = mu[512 + c]; prm[128 + j] = mu[1024 + c]; prm[192 + j] = mu[1536 + j]; prm[256 + j] = mu[1600 + j];
        prm[320 + j] = p.in[I_W0][d * 512 + c]; prm[384 + j] = p.in[I_A0][d * 512 + c]; prm[448 + j] = p.in[I_KK][d * 512 + c]; prm[512 + j] = p.in[I_KA][d * 512 + c];
        prm[576 + j] = p.in[I_RK][(d * 8 + h) * 64 + j]; prm[640 + j] = p.in[I_LNW][d * 512 + c]; prm[704 + j] = p.in[I_LNB][d * 512 + c]; }
    const int m1 = wv & 3, h2 = wv >> 2, cb8 = 32 * h2 + 8 * q;
    bf16x8 fw2[2][2], fa2[2][2];
    if (ROLE != 1) {
#pragma unroll
    for (int t = 0; t < 2; ++t)
#pragma unroll
        for (int kk = 0; kk < 2; ++kk) { const int c = 64 * h + 32 * h2 + 8 * (r >> 2) + 4 * t + (r & 3);
            const float* w2p = p.in[I_W2L] + (size_t)(d * 64 + 32 * kk + 8 * q) * 512 + c; const float* a2p = p.in[I_A2L] + (size_t)(d * 64 + 32 * kk + 8 * q) * 512 + c;
#pragma unroll
            for (int e = 0; e < 8; ++e) { fw2[t][kk][e] = (short)f2bf(w2p[e * 512]); fa2[t][kk][e] = (short)f2bf(a2p[e * 512]); }
            asm volatile("" ::: "memory"); }
    }
    f32x4 Sacc[2] = {(f32x4){0.f, 0.f, 0.f, 0.f}, (f32x4){0.f, 0.f, 0.f, 0.f}};
    int cur = 0;
    unsigned ack_seen = 0u;
    unsigned long long pf[11]; bool pf_ok = false;
    u32x4 gc[5], gp[5];
#define RWKV_LOAD(n0x) do { const int n1_ = (n0x) + 16 * m1 + r; const bool hp_ = (n1_ != 0) && (n1_ != LC); const unsigned row_ = (unsigned)step_row(d, b, n1_), prow_ = hp_ ? (unsigned)step_row(d, b, n1_ - 1) : row_; \
    const unsigned rwc_ = row_ * 1536u + 64u * h + cb8, rwp_ = prow_ * 1536u + 64u * h + cb8, loc_ = row_ * 512u + 64u * d + cb8, lop_ = prow_ * 512u + 64u * d + cb8; \
    gc[0] = *(const u32x4*)(RW + rwc_); gc[1] = *(const u32x4*)(RW + rwc_ + 512u); gc[2] = *(const u32x4*)(RW + rwc_ + 1024u); gc[3] = *(const u32x4*)(LO + loc_); gc[4] = *(const u32x4*)(LO + loc_ + 128u); \
    gp[0] = *(const u32x4*)(RW + rwp_); gp[1] = *(const u32x4*)(RW + rwp_ + 512u); gp[2] = *(const u32x4*)(RW + rwp_ + 1024u); gp[3] = *(const u32x4*)(LO + lop_); gp[4] = *(const u32x4*)(LO + lop_ + 128u); } while (0)
    if (ROLE != 1) RWKV_LOAD(0);
    __syncthreads();
    for (int n0 = 0; n0 < LT; n0 += 64) {
        if (ROLE != 1) for (int rep0 = 0; rep0 < (MK_RDUP == 0 ? 2 : 1); ++rep0) {
        const int u1 = 16 * m1 + r, n1 = n0 + u1; const bool hp = (n1 != 0) && (n1 != LC);
        float rs[8], ks[8], vs[8];
        {
            float a0[8], a1[8], th[8], ad[8];
#define UNPACK8(v, o) { _Pragma("unroll") for (int k_ = 0; k_ < 4; ++k_) { o[2 * k_] = __uint_as_float(v[k_] << 16); o[2 * k_ + 1] = __uint_as_float(v[k_] & 0xffff0000u); } }
#define RW_SHIFT(dst, idx, muo) { const u32x4 pz = hp ? gp[idx] : (u32x4){0u, 0u, 0u, 0u}; UNPACK8(gc[idx], a0) UNPACK8(pz, a1) \
            const f32x4 mu0 = *(const LAS f32x4*)(prm + (muo) + cb8), mu1 = *(const LAS f32x4*)(prm + (muo) + cb8 + 4); \
            _Pragma("unroll") for (int e = 0; e < 4; ++e) { dst[e] = a0[e] + mu0[e] * (a1[e] - a0[e]); dst[4 + e] = a0[4 + e] + mu1[e] * (a1[4 + e] - a0[4 + e]); } }
            RW_SHIFT(rs, 0, 0) RW_SHIFT(ks, 1, 64) RW_SHIFT(vs, 2, 128) RW_SHIFT(th, 3, 192) RW_SHIFT(ad, 4, 256)
#undef RW_SHIFT
#pragma unroll
            for (int e = 0; e < 8; ++e) th[e] = ftanh(th[e]);
            u32x4 w; w.x = pack2(th[0], th[1]); w.y = pack2(th[2], th[3]); w.z = pack2(th[4], th[5]); w.w = pack2(th[6], th[7]); *(LAS u32x4*)(TH + u1 * PT + cb8) = w;
            w.x = pack2(ad[0], ad[1]); w.y = pack2(ad[2], ad[3]); w.z = pack2(ad[4], ad[5]); w.w = pack2(ad[6], ad[7]); *(LAS u32x4*)(AD + u1 * PT + cb8) = w;
            asm volatile("" ::: "memory");
        }
        __syncthreads();
        float elog[8], av[8], kkr[8], km[8]; float ssq = 0.f, bsp = 0.f;
#pragma unroll
        for (int t = 0; t < 2; ++t) {
            f32x4 xw = (f32x4){0.f, 0.f, 0.f, 0.f}, xa = (f32x4){0.f, 0.f, 0.f, 0.f};
#pragma unroll
            for (int kk = 0; kk < 2; ++kk) { const bf16x8 bt = *(const LAS bf16x8*)(TH + u1 * PT + 32 * kk + 8 * q), ba = *(const LAS bf16x8*)(AD + u1 * PT + 32 * kk + 8 * q);
                xw = __builtin_amdgcn_mfma_f32_16x16x32_bf16(fw2[t][kk], bt, xw, 0, 0, 0); xa = __builtin_amdgcn_mfma_f32_16x16x32_bf16(fa2[t][kk], ba, xa, 0, 0, 0); }
            const int cb = cb8 + 4 * t;
            const f32x4 w04 = *(const LAS f32x4*)(prm + 320 + cb), a04 = *(const LAS f32x4*)(prm + 384 + cb), kk4 = *(const LAS f32x4*)(prm + 448 + cb), ka4 = *(const LAS f32x4*)(prm + 512 + cb), rk4 = *(const LAS f32x4*)(prm + 576 + cb);
#pragma unroll
            for (int jj = 0; jj < 4; ++jj) { const int e = 4 * t + jj;
                elog[e] = 0.6065306597126334f * fsigm(xw[jj] + w04[jj]); av[e] = fsigm(xa[jj] + a04[jj]);
                kkr[e] = ks[e] * kk4[jj]; ssq += kkr[e] * kkr[e]; km[e] = ks[e] * (1.f + (av[e] - 1.f) * ka4[jj]); bsp += rs[e] * km[e] * rk4[jj]; }
            asm volatile("" ::: "memory");
        }
        ssq += __shfl_xor(ssq, 16); ssq += __shfl_xor(ssq, 32); bsp += __shfl_xor(bsp, 16); bsp += __shfl_xor(bsp, 32);
        if (q == 0) { SSQ[h2 * 64 + u1] = ssq; BSP[h2 * 64 + u1] = bsp; }
        __syncthreads();
        {
            const float tot = SSQ[u1] + SSQ[64 + u1]; const float inv = 1.f / fmaxf(sqrtf(tot), 1e-12f);
            if (h2 == 0 && q == 0) BS[u1] = BSP[u1] + BSP[64 + u1];
            float al[8], be[8], ka[8], rh[8];
#pragma unroll
            for (int e = 0; e < 8; ++e) {
                const float g = scan16(-elog[e]);
                const float ep = fexp(g), em = frcp(ep), epp = fexp(g + elog[e]);
                const float kk = kkr[e] * inv;
                al[e] = kk * epp; be[e] = kk * av[e] * em; ka[e] = km[e] * em; rh[e] = rs[e] * ep;
                if (r == 15) GAM[m1 * 64 + cb8 + e] = ep; }
            u32x4 w;
#define ST8(T, v) w.x = pack2(v[0], v[1]); w.y = pack2(v[2], v[3]); w.z = pack2(v[4], v[5]); w.w = pack2(v[6], v[7]); *(LAS u32x4*)(T + u1 * PT + cb8) = w;
            ST8(At, al) ST8(Bt, be) ST8(Kt, ka) ST8(Rt, rh) ST8(Vt, vs)
#undef ST8
        }
        __syncthreads();
        }
        if (ROLE == 0 && n0 + 64 < LT) RWKV_LOAD(n0 + 64);
        if (ROLE == 2) {
            const unsigned g = (unsigned)(n0 >> 6);
            if (g > 0u) { asm volatile("s_waitcnt vmcnt(0)" ::: "memory"); __syncthreads(); if (tid == 0) __hip_atomic_store(READY, g, __ATOMIC_RELAXED, __HIP_MEMORY_SCOPE_AGENT); }
            if (n0 + 64 < LT) RWKV_LOAD(n0 + 64);
            if (g >= RING_SLOTS && ack_seen < g - RING_SLOTS + 1) {
                if (tid == 0) { wait_ge(ACK, g - RING_SLOTS + 1); ((LAS unsigned*)MBf)[17] = __hip_atomic_load(ACK, __ATOMIC_RELAXED, __HIP_MEMORY_SCOPE_AGENT); }
                __syncthreads(); ack_seen = ((LAS unsigned*)MBf)[17]; }
            unsigned long long* slot = ring + (size_t)(g % RING_SLOTS) * SLOT_U64;
            for (int e = tid; e < 5280; e += NT) { unsigned long long v;
                if (e < 5120) v = *(const LAS unsigned long long*)(lds + C_TILES + (e >> 10) * (80 * PT * 2) + ((e >> 4) & 63) * (PT * 2) + (e & 15) * 8);
                else if (e < 5248) v = *(const LAS unsigned long long*)(lds + C_GAM + (e - 5120) * 8);
                else v = *(const LAS unsigned long long*)((LAS unsigned char*)BS + (e - 5248) * 8);
                __hip_atomic_store(slot + e, v, __ATOMIC_RELAXED, __HIP_MEMORY_SCOPE_AGENT); }
            if (g == 131u) { asm volatile("s_waitcnt vmcnt(0)" ::: "memory"); __syncthreads(); if (tid == 0) __hip_atomic_store(READY, g + 1u, __ATOMIC_RELAXED, __HIP_MEMORY_SCOPE_AGENT); }
            continue;
        }
        if (ROLE == 1) {
            const unsigned g = (unsigned)(n0 >> 6);
            if (!pf_ok) { if (wv == 0) wait_ge(READY, g + 1u); __syncthreads();
                const unsigned long long* slot = ring + (size_t)(g % RING_SLOTS) * SLOT_U64;
#pragma unroll
                for (int k = 0; k < 11; ++k) { const int e = tid + NT * k; if (e < 5280) pf[k] = slot[e]; } }
#pragma unroll
            for (int k = 0; k < 11; ++k) { const int e = tid + NT * k; if (e < 5280) { const unsigned long long v = pf[k];
                if (e < 5120) *(LAS unsigned long long*)(lds + C_TILES + (e >> 10) * (80 * PT * 2) + ((e >> 4) & 63) * (PT * 2) + (e & 15) * 8) = v;
                else if (e < 5248) *(LAS unsigned long long*)(lds + C_GAM + (e - 5120) * 8) = v;
                else *(LAS unsigned long long*)((LAS unsigned char*)BS + (e - 5248) * 8) = v; } }
            asm volatile("s_waitcnt vmcnt(0)" ::: "memory");
            __syncthreads();
            if (tid == 0) __hip_atomic_store(ACK, g + 1u, __ATOMIC_RELAXED, __HIP_MEMORY_SCOPE_AGENT);
        }
        f32x4 yhat[4];
        for (int rep1 = 0; rep1 < (MK_RDUP == 1 ? 2 : 1); ++rep1) {
        {
            const int m = wv >> 1, pp = wv & 1; LAS bf16_t* XB = pp ? Rt : At;
            f32x4 c1 = (f32x4){0.f, 0.f, 0.f, 0.f}, c2 = (f32x4){0.f, 0.f, 0.f, 0.f};
#pragma unroll
            for (int kk = 0; kk < 2; ++kk) { const bf16x8 bx = *(const LAS bf16x8*)(XB + (16 * m + r) * PT + 32 * kk + 8 * q);
                const bf16x8 a1 = *(const LAS bf16x8*)(Bt + (16 * m + r) * PT + 32 * kk + 8 * q), a2 = *(const LAS bf16x8*)(Kt + (16 * m + r) * PT + 32 * kk + 8 * q);
                c1 = __builtin_amdgcn_mfma_f32_16x16x32_bf16(a1, bx, c1, 0, 0, 0); c2 = __builtin_amdgcn_mfma_f32_16x16x32_bf16(a2, bx, c2, 0, 0, 0); }
#pragma unroll
            for (int jj = 0; jj < 4; ++jj) { const int s = 4 * q + jj; const bool ok = pp ? (s <= r) : (s < r); if (!ok) { c1[jj] = 0.f; c2[jj] = 0.f; } }
            if (pp == 0) { *(LAS f32x4*)(MBf + (m * 16 + r) * 20 + 4 * q) = c1; *(LAS u32x2*)(MK + (m * 16 + r) * PM + 4 * q) = pack4(c2[0], c2[1], c2[2], c2[3]); }
            else { *(LAS u32x2*)(NB + (m * 16 + r) * PM + 4 * q) = pack4(c1[0], c1[1], c1[2], c1[3]); *(LAS u32x2*)(NK + (m * 16 + r) * PM + 4 * q) = pack4(c2[0], c2[1], c2[2], c2[3]); }
        }
        __syncthreads();
        if (wv < 4) {
            const int m = wv, c = r; float X[16];
#pragma unroll
            for (int u = 0; u < 16; ++u) { float x = (c == u) ? 1.f : 0.f;
                if (u > 0) { const LAS f32x4* rowp = (const LAS f32x4*)(MBf + (m * 16 + u) * 20);
#pragma unroll
                    for (int s4 = 0; s4 < 4; ++s4) { if (4 * s4 < u) { const f32x4 l = rowp[s4];
#pragma unroll
                        for (int e = 0; e < 4; ++e) if (4 * s4 + e < u) x -= l[e] * X[4 * s4 + e]; } } }
                X[u] = x; }
            if (q == 0) {
#pragma unroll
                for (int u = 0; u < 16; ++u) DNV[(m * 16 + u) * PM + c] = f2bf(X[u]); }
        } else {
            const int m = wv - 4; const bf16x8 a = *(const LAS bf16x8*)(MK + (m * 16 + r) * PM + 8 * q);
#pragma unroll
            for (int it = 0; it < 4; ++it) { const bf16x8 bv = tr_frag(vt_b, PT, 16 * m, 16 * it, r, q);
                const f32x4 acc = __builtin_amdgcn_mfma_f32_16x16x32_bf16(a, bv, (f32x4){0.f, 0.f, 0.f, 0.f}, 0, 0, 0);
                *(LAS u32x2*)(W1T + (m * 64 + 16 * it + r) * PM + 4 * q) = pack4(acc[0], acc[1], acc[2], acc[3]); }
        }
        __syncthreads();
#pragma unroll
        for (int m = 0; m < 4; ++m) yhat[m] = (f32x4){0.f, 0.f, 0.f, 0.f};
        if (wv < 4) {
            const int it = wv;
#pragma unroll
            for (int m = 0; m < 4; ++m) { const bf16x8 a = *(const LAS bf16x8*)(DNV + (m * 16 + r) * PM + 8 * q), bw = *(const LAS bf16x8*)(W1T + (m * 64 + 16 * it + r) * PM + 8 * q);
                yhat[m] = __builtin_amdgcn_mfma_f32_16x16x32_bf16(a, bw, yhat[m], 0, 0, 0); }
        } else {
            const int jt = wv - 4;
#pragma unroll
            for (int m = 0; m < 4; ++m) { const bf16x8 a = tr_frag(at_b, PT, 16 * m, 16 * jt, r, q), bd = *(const LAS bf16x8*)(DNV + (m * 16 + r) * PM + 8 * q);
                const f32x4 acc = __builtin_amdgcn_mfma_f32_16x16x32_bf16(a, bd, (f32x4){0.f, 0.f, 0.f, 0.f}, 0, 0, 0);
                *(LAS u32x2*)(AH + (m * 16 + r) * PT + 16 * jt + 4 * q) = pack4(acc[0], acc[1], acc[2], acc[3]); }
        }
        __syncthreads();
        }
#pragma unroll 1
        for (int m = 0; m < 4; ++m) {
            LAS bf16_t* Sc = Sbf + cur * 64 * PT; LAS bf16_t* Sn = Sbf + (cur ^ 1) * 64 * PT;
            const int it = wv & 3, jh = wv >> 2;
            f32x4 oacc = (f32x4){0.f, 0.f, 0.f, 0.f};
            const bf16x8 bv = tr_frag(vt_b, PT, 16 * m, 16 * it, r, q);
            const bf16x8 ka0 = zero_if(tr_frag(kt_b, PT, 16 * m, 16 * (2 * jh), r, q), q >= 2), ka1 = zero_if(tr_frag(kt_b, PT, 16 * m, 16 * (2 * jh + 1), r, q), q >= 2);
            const bf16x8 ba0 = tr_frag(bt_b, PT, 16 * m, 16 * (2 * jh), r, q), ba1 = tr_frag(bt_b, PT, 16 * m, 16 * (2 * jh + 1), r, q);
            if (wv < 4) {
                f32x4 acc = (m == 0) ? yhat[0] : (m == 1) ? yhat[1] : (m == 2) ? yhat[2] : yhat[3];
#pragma unroll
                for (int kk = 0; kk < 2; ++kk) { const bf16x8 a = *(const LAS bf16x8*)(AH + (m * 16 + r) * PT + 32 * kk + 8 * q), bs = *(const LAS bf16x8*)(Sc + (16 * it + r) * PT + 32 * kk + 8 * q);
                    acc = __builtin_amdgcn_mfma_f32_16x16x32_bf16(a, bs, acc, 0, 0, 0); }
                *(LAS u32x2*)(YV + (16 * it + r) * PM + 4 * q) = pack4(-acc[0], -acc[1], -acc[2], -acc[3]);
            } else {
#pragma unroll
                for (int kk = 0; kk < 2; ++kk) { const bf16x8 a = *(const LAS bf16x8*)(Rt + (16 * m + r) * PT + 32 * kk + 8 * q), bs = *(const LAS bf16x8*)(Sc + (16 * it + r) * PT + 32 * kk + 8 * q);
                    oacc = __builtin_amdgcn_mfma_f32_16x16x32_bf16(a, bs, oacc, 0, 0, 0); }
                const bf16x8 a = *(const LAS bf16x8*)(NK + (m * 16 + r) * PM + 8 * q);
                oacc = __builtin_amdgcn_mfma_f32_16x16x32_bf16(a, bv, oacc, 0, 0, 0);
            }
            if (ROLE == 1 && m == 0) { if (tid == 0) { const unsigned g1 = (unsigned)(n0 >> 6) + 1u; unsigned ok = 0u;
                    if (g1 < 132u && __hip_atomic_load(READY, __ATOMIC_RELAXED, __HIP_MEMORY_SCOPE_AGENT) >= g1 + 1u) { __builtin_amdgcn_fence(__ATOMIC_ACQUIRE, "agent"); asm volatile("s_waitcnt vmcnt(0)" ::: "memory"); ok = 1u; }
                    ((LAS unsigned*)MBf)[16] = ok; } }
            __syncthreads();
            if (ROLE == 1 && m == 0) { pf_ok = ((LAS unsigned*)MBf)[16] != 0u;
                if (pf_ok) { const unsigned long long* slot = ring + (size_t)(((unsigned)(n0 >> 6) + 1u) % RING_SLOTS) * SLOT_U64;
#pragma unroll
                    for (int k = 0; k < 11; ++k) { const int e = tid + NT * k; if (e < 5280) pf[k] = slot[e]; } } }
            {
                const bf16x8 by = *(const LAS bf16x8*)(YV + (16 * it + r) * PM + 8 * q);
#pragma unroll
                for (int x = 0; x < 2; ++x) { const int jt = 2 * jh + x;
                    const bf16x8 a1 = x ? ka1 : ka0, a2 = x ? ba1 : ba0;
                    Sacc[x] = __builtin_amdgcn_mfma_f32_16x16x32_bf16(a1, bv, Sacc[x], 0, 0, 0); Sacc[x] = __builtin_amdgcn_mfma_f32_16x16x32_bf16(a2, by, Sacc[x], 0, 0, 0);
                    const f32x4 gm = *(const LAS f32x4*)(GAM + m * 64 + 16 * jt + 4 * q); Sacc[x] = Sacc[x] * gm;
                    *(LAS u32x2*)(Sn + (16 * it + r) * PT + 16 * jt + 4 * q) = pack4(Sacc[x][0], Sacc[x][1], Sacc[x][2], Sacc[x][3]); }
                if (wv >= 4) { const bf16x8 a = *(const LAS bf16x8*)(NB + (m * 16 + r) * PM + 8 * q);
                    oacc = __builtin_amdgcn_mfma_f32_16x16x32_bf16(a, by, oacc, 0, 0, 0);
#pragma unroll
                    for (int jj = 0; jj < 4; ++jj) OUT[(16 * m + 4 * q + jj) * 68 + 16 * it + r] = oacc[jj]; }
            }
            __syncthreads();
            cur ^= 1;
        }
        for (int rep6 = 0; rep6 < (MK_RDUP == 6 ? 2 : 1); ++rep6) {
            const int u = tid >> 3, part = tid & 7; const size_t row = (size_t)step_row(d, b, n0 + u);
            const f32x4 o0 = *(const LAS f32x4*)(OUT + u * 68 + 8 * part), o1 = *(const LAS f32x4*)(OUT + u * 68 + 8 * part + 4);
            const float mean = sum8((o0[0] + o0[1]) + (o0[2] + o0[3]) + (o1[0] + o1[1]) + (o1[2] + o1[3])) * (1.f / 64.f);
            const f32x4 d0 = o0 - mean, d1 = o1 - mean;
            const float var = sum8((d0[0] * d0[0] + d0[1] * d0[1]) + (d0[2] * d0[2] + d0[3] * d0[3]) + (d1[0] * d1[0] + d1[1] * d1[1]) + (d1[2] * d1[2] + d1[3] * d1[3])) * (1.f / 64.f);
            const float rstd = rsqrtf(var + 64e-5f), bs = BS[u];
            const f32x4 w0 = *(const LAS f32x4*)(prm + 640 + 8 * part), w1 = *(const LAS f32x4*)(prm + 644 + 8 * part), b0 = *(const LAS f32x4*)(prm + 704 + 8 * part), b1 = *(const LAS f32x4*)(prm + 708 + 8 * part);
            const u32x4 vv = *(const LAS u32x4*)(Vt + u * PT + 8 * part);
            float z[8];
#pragma unroll
            for (int k = 0; k < 4; ++k) { z[k] = d0[k] * rstd * w0[k] + b0[k]; z[4 + k] = d1[k] * rstd * w1[k] + b1[k]; }
#pragma unroll
            for (int k = 0; k < 4; ++k) { z[2 * k] += bs * __uint_as_float(vv[k] << 16); z[2 * k + 1] += bs * __uint_as_float(vv[k] & 0xffff0000u); }
            u32x4 w; w.x = pack2(z[0], z[1]); w.y = pack2(z[2], z[3]); w.z = pack2(z[4], z[5]); w.w = pack2(z[6], z[7]);
            *(u32x4*)(Z + ((size_t)d * NALL + row) * 512 + 64 * h + 8 * part) = w;
        }
        __syncthreads();
    }
}
constexpr int RP_G2 = 0, RP_G2P = 520, RP_SG = RP_G2 + 128 * RP_G2P * 2, RP_END = RP_SG + 64 * PQ * 2;
static_assert(RP_END <= LDS_BYTES, "rwkv post LDS map");
DI void phase_rwkv_post2(const P& p, LAS unsigned char* lds) {
    const int tid = mk_tid(), lane = tid & 63, wv = __builtin_amdgcn_readfirstlane(tid >> 6), r = lane & 15, q = lane >> 4;
    const bf16_t* LO = (const bf16_t*)(p.ws + WS_COLS) + OFF_LO; const bf16_t* Z = (const bf16_t*)(p.ws + WS_Z); bf16_t* Y = (bf16_t*)(p.ws + WS_COLS);
    LAS bf16_t* G2s = (LAS bf16_t*)(lds + RP_G2); LAS bf16_t* SG = (LAS bf16_t*)(lds + RP_SG);
    const unsigned g2_b = (unsigned)(size_t)G2s;
    if ((int)blockIdx.x >= NRC) return;
    __syncthreads();
    for (int e = tid; e < 128 * 128; e += NT) { const int rr = e >> 7, c4 = (e & 127) * 4; const f32x4 v = *(const f32x4*)(p.in[I_G2] + rr * 512 + c4);
        *(LAS u32x2*)(G2s + rr * RP_G2P + c4) = pack4(v[0], v[1], v[2], v[3]); }
    for (int rc = blockIdx.x; rc < NRC; rc += gridDim.x) {
        const size_t row0 = (size_t)rc * 64;
        __syncthreads();
        for (int e = tid; e < 64 * 16; e += NT) { const int t = e >> 4, pc = e & 15; const u32x4 v = *(const u32x4*)(LO + (row0 + t) * 512 + 256 + 8 * pc); u32x4 o;
#pragma unroll
            for (int k = 0; k < 4; ++k) o[k] = pack2(fsigm(__uint_as_float(v[k] << 16)), fsigm(__uint_as_float(v[k] & 0xffff0000u)));
            *(LAS u32x4*)(SG + t * PQ + 8 * pc) = o; }
        __syncthreads();
#pragma unroll 1
        for (int ci = 0; ci < 4; ++ci) { const int ct = 4 * wv + ci;
            f32x4 acc[4] = {(f32x4){0.f, 0.f, 0.f, 0.f}, (f32x4){0.f, 0.f, 0.f, 0.f}, (f32x4){0.f, 0.f, 0.f, 0.f}, (f32x4){0.f, 0.f, 0.f, 0.f}};
#pragma unroll
            for (int kk = 0; kk < 4; ++kk) { const bf16x8 a = tr_frag(g2_b, RP_G2P, 32 * kk, 16 * ct, r, q);
#pragma unroll
                for (int tt = 0; tt < 4; ++tt) { const bf16x8 bs = *(const LAS bf16x8*)(SG + (16 * tt + r) * PQ + 32 * kk + 8 * q); acc[tt] = __builtin_amdgcn_mfma_f32_16x16x32_bf16(a, bs, acc[tt], 0, 0, 0); } }
#pragma unroll
            for (int tt = 0; tt < 4; ++tt) { const size_t row = row0 + 16 * tt + r; const int c = 16 * ct + 4 * q;
                float z0[4], z1[4]; unpack4(*(const u32x2*)(Z + row * 512 + c), z0); unpack4(*(const u32x2*)(Z + ((size_t)NALL + row) * 512 + c), z1);
                *(u32x2*)(Y + row * D + c) = pack4((z0[0] + z1[0]) * acc[tt][0], (z0[1] + z1[1]) * acc[tt][1], (z0[2] + z1[2]) * acc[tt][2], (z0[3] + z1[3]) * acc[tt][3]); }
        }
    }
    __syncthreads();
}
#define XB_TMO      128
#define XB_XCNT(j)  (256  + 64 * (j))
#define XB_XSUB(j)  (1280 + 64 * (j))
#define XB_XGEN(j)  (2304 + 64 * (j))
#define XB_TOP      3328
#define XB_TOPGEN   3392
#define XCD_BAR_WORDS 3456
#define XB_SPIN_CAP (1u << 18)

__device__ __forceinline__ unsigned xb_ld(unsigned* p)              { return __hip_atomic_load(p, __ATOMIC_RELAXED, __HIP_MEMORY_SCOPE_AGENT); }
__device__ __forceinline__ unsigned xb_add(unsigned* p, unsigned v) { return __hip_atomic_fetch_add(p, v, __ATOMIC_RELAXED, __HIP_MEMORY_SCOPE_AGENT); }
__device__ __forceinline__ unsigned xb_xcc_id() { return (unsigned)__builtin_amdgcn_s_getreg((3 << 11) | 20) & 0xFu; }
#define XB_SPIN(cond, bar) do { unsigned _sp = 0; while (cond) { __builtin_amdgcn_s_sleep(1); \
    if ((++_sp & 255u) == 0u) { if (xb_ld(&(bar)[XB_TMO])) break; if (_sp > XB_SPIN_CAP) { atomicAdd(&(bar)[XB_TMO], 1u); break; } } } } while (0)

struct XcdBarrier {
    unsigned* bar; unsigned x;
    volatile LAS unsigned* st;
};

__device__ __forceinline__ XcdBarrier xcd_barrier_post(unsigned* bar, volatile LAS unsigned* st) {
    XcdBarrier b; b.bar = bar; b.x = xb_xcc_id(); b.st = st;
    if (threadIdx.x == 0) (void)xb_add(&bar[XB_XCNT(b.x)], 1u);
    return b;
}
__device__ __forceinline__ void xcd_barrier_complete(unsigned* bar, unsigned x, unsigned& nloc, unsigned& nx) {
    const unsigned G = gridDim.x * gridDim.y * gridDim.z;
    unsigned sum, cnt, mine, sp = 0u;
    for (;;) {
        sum = 0u; cnt = 0u; mine = 0u;
#pragma unroll
        for (unsigned j = 0; j < 16; ++j) { const unsigned c = xb_ld(&bar[XB_XCNT(j)]); sum += c; cnt += (c > 0u) ? 1u : 0u; mine = (j == x) ? c : mine; }
        if (sum == G) break;
        __builtin_amdgcn_s_sleep(1);
        if ((++sp & 255u) == 0u) { if (xb_ld(&bar[XB_TMO])) break; if (sp > XB_SPIN_CAP) { atomicAdd(&bar[XB_TMO], 1u); break; } }
    }
    nloc = mine > 0u ? mine : 1u; nx = cnt > 0u ? cnt : 1u;
}

__device__ __forceinline__ void xcd_barrier(const XcdBarrier& b) {
    asm volatile("s_waitcnt vmcnt(0)" ::: "memory");
    __syncthreads();
    if (threadIdx.x == 0) {
        unsigned* bar = b.bar;
        __builtin_amdgcn_s_waitcnt(0);
        unsigned nloc = b.st[0], nx = b.st[1];
        if (nloc == 0u) { xcd_barrier_complete(bar, b.x, nloc, nx); b.st[0] = nloc; b.st[1] = nx; }
        const unsigned old = xb_add(&bar[XB_XSUB(b.x)], 1u);
        const unsigned gen = old / nloc;
        if (old + 1u == (gen + 1u) * nloc) {
            __builtin_amdgcn_fence(__ATOMIC_RELEASE, "agent");
            asm volatile("s_waitcnt vmcnt(0)" ::: "memory");
            const unsigned og = xb_add(&bar[XB_TOP], 1u);
            const unsigned tg = og / nx;
            if (og + 1u == (tg + 1u) * nx) xb_add(&bar[XB_TOPGEN], 1u);
            else XB_SPIN(xb_ld(&bar[XB_TOPGEN]) == tg, bar);
            __builtin_amdgcn_fence(__ATOMIC_ACQUIRE, "agent");
            xb_add(&bar[XB_XGEN(b.x)], 1u);
            asm volatile("s_waitcnt vmcnt(0)" ::: "memory");
        } else {
            XB_SPIN(xb_ld(&bar[XB_XGEN(b.x)]) == gen, bar);
            __builtin_amdgcn_fence(__ATOMIC_ACQUIRE, "agent");
            asm volatile("s_waitcnt vmcnt(0)" ::: "memory");
        }
    }
    __syncthreads();
}
DI void phase_mlstm_post(const P& p) {
    const int lane = mk_tid() & 63, wv = mk_tid() >> 6;
    const bf16_t* ML = (const bf16_t*)(p.ws + WS_COLS) + OFF_ML; const bf16_t* HB = (const bf16_t*)(p.ws + WS_ACT); bf16_t* Y = (bf16_t*)(p.ws + WS_COLS);
    for (int r = blockIdx.x * 8 + wv; r < NALL; r += gridDim.x * 8)
        post_headnorm_row(HB, (size_t)r, p.in[I_MNG], ML + (size_t)r * 2048 + 1536, 0, Y + (size_t)r * D + 512, lane);
}
DI void phase_hgrn_post(const P& p) {
    const int lane = mk_tid() & 63, wv = mk_tid() >> 6;
    const bf16_t* C1 = (const bf16_t*)(p.ws + WS_COLS); const bf16_t* HB = (const bf16_t*)(p.ws + WS_ACT); bf16_t* Y = (bf16_t*)(p.ws + WS_Z);
    for (int r = blockIdx.x * 8 + wv; r < NLAT; r += gridDim.x * 8)
        post_headnorm_row(HB, (size_t)r, p.in[I_HNG], C1 + (size_t)r * C1LD + 2048, 1, Y + (size_t)nat_row(r) * D, lane);
}

constexpr int N_PHASES = 19;
__global__ void __launch_bounds__(NT, 2) mk_fwd(P p) {
    extern __shared__ __attribute__((aligned(16))) unsigned char lds_raw[];
    LAS unsigned char* lds = (LAS unsigned char*)lds_raw;
    cooperative_groups::grid_group grid = cooperative_groups::this_grid();
    const int lo = p.ph_lo, hi = p.ph_hi;
    volatile LAS unsigned* xst = (volatile LAS unsigned*)(lds + LDS_BYTES - 16);
    if (threadIdx.x < 4) xst[threadIdx.x] = 0u;
    __syncthreads();
    const XcdBarrier xbar = xcd_barrier_post((unsigned*)(p.ws + WS_CTL) + 8192, xst);
#define IN(k) (lo <= (k) && (k) < hi)
#define SEAM(k) do { if (IN(k) && IN((k) + 1)) xcd_barrier(xbar); } while (0)
#ifndef MK_DUP
#define MK_DUP -1
#endif
#define PHASE(k, ...) if (IN(k)) { __VA_ARGS__ if (MK_DUP == (k)) { grid.sync(); __VA_ARGS__ } } SEAM(k);
    unsigned char* ws = p.ws;
    const float* MODV = (const float*)(ws + WS_MODV);
    float* HC = (float*)(ws + WS_HC);
    float* SSQP = (float*)(ws + WS_SSQP); const float* GSC = (const float*)(ws + WS_GSC); const float* SHW = GSC + SHW_OFF;
    bf16_t* ACT = (bf16_t*)(ws + WS_ACT); bf16_t* COLS = (bf16_t*)(ws + WS_COLS); bf16_t* Y1 = (bf16_t*)(ws + WS_Z);
    PHASE(0, phase_wprep(p, lds); phase_modv(p, lds);)
    PHASE(1, phase_modnorm(p, 0, 0, p.in[I_X], p.in[I_CTX], NALL, false);)
    PHASE(2, { EpiStore3 E{COLS + OFF_RW, 1536, 6, COLS + OFF_LO, 512, 8, COLS + OFF_ML, 2048, 0}; run_gemm(lds, ACT, (const bf16_t*)(ws + WS_W_EVIN), NLAT, 4096, 1024, E); E.pm0 = 128; run_gemm(lds, ACT + (size_t)NLAT * 1024, (const bf16_t*)(ws + WS_W_EVIN), NCTX, 4096, 1024, E); })
    PHASE(3, { const int bx = (int)blockIdx.x;
        if (gridDim.x == 256) { if (bx < 64) rwkv_chunk_unit<1>(p, lds, bx); else if (bx < 128) rwkv_chunk_unit<2>(p, lds, bx - 64); else gla_unit<0>(p, lds, bx - 128); }
        else for (int vb = bx; vb < 192; vb += gridDim.x) { if (vb < 64) rwkv_chunk_unit<0>(p, lds, vb); else gla_unit<0>(p, lds, vb - 64); } })
    if (IN(3) && MK_DUP == 303) { grid.sync(); if (blockIdx.x < 64) rwkv_chunk_unit<1>(p, lds, blockIdx.x); grid.sync(); }
    if (IN(3) && MK_DUP == 403) { grid.sync(); if (blockIdx.x >= 64 && blockIdx.x < 128) rwkv_chunk_unit<2>(p, lds, blockIdx.x - 64); grid.sync(); }
    if (IN(3) && MK_DUP == 103) { grid.sync(); for (int vb = blockIdx.x; vb < 64; vb += gridDim.x) rwkv_chunk_unit<0>(p, lds, vb); grid.sync(); }
    if (IN(3) && MK_DUP == 203) { grid.sync(); for (int vb = blockIdx.x; vb < 128; vb += gridDim.x) gla_unit<0>(p, lds, vb); grid.sync(); }
    PHASE(4, phase_mlstm_post(p); phase_rwkv_post2(p, lds);)
    PHASE(5, { EpiResid E{p.in[I_X], p.out, p.in[I_CTX], HC, MODV, 2, 0}; run_gemm(lds, COLS, (const bf16_t*)(ws + WS_W_EVOUT), NLAT, 1024, 1024, E); E.pm0 = 128; run_gemm(lds, COLS + (size_t)NLAT * 1024, (const bf16_t*)(ws + WS_W_EVOUT), NCTX, 1024, 1024, E); })
    PHASE(6, phase_modnorm(p, 0, 1, p.out, HC, NALL, false);)
    PHASE(7, { EpiSwiglu E{COLS, 0}; run_gemm(lds, ACT, (const bf16_t*)(ws + WS_W_UP), NLAT, 5632, 1024, E); E.pm0 = 128; run_gemm(lds, ACT + (size_t)NLAT * 1024, (const bf16_t*)(ws + WS_W_UP), NCTX, 5632, 1024, E); })
    PHASE(8, { EpiResid E{p.out, p.out, HC, HC, MODV, 5, 0}; run_gemm(lds, COLS, (const bf16_t*)(ws + WS_W_DN), NLAT, 1024, 2816, E); E.pm0 = 128; run_gemm(lds, COLS + (size_t)NLAT * 2816, (const bf16_t*)(ws + WS_W_DN), NCTX, 1024, 2816, E); })
    PHASE(9, phase_modnorm(p, 1, 0, p.out, HC, NALL, true);)
    PHASE(10, { EpiStore3 E{COLS, C1LD, 1 << 30, COLS, C1LD, 1 << 30, COLS, C1LD, 0}; run_gemm(lds, ACT, (const bf16_t*)(ws + WS_W_ODIN), NLAT, 3584, 1024, E); E.pm0 = 128; run_gemm(lds, ACT + (size_t)NLAT * 1024, (const bf16_t*)(ws + WS_W_ODIN), NCTX, 3584, 1024, E); })
    PHASE(11, phase_hgrn_prep2(p, lds); lru_pass<1>(p, lds, (int)blockIdx.x, (int)gridDim.x);)
    PHASE(12, { const int half = (int)gridDim.x >> 1; if ((int)blockIdx.x < half) { for (int u = blockIdx.x; u < 128; u += half) gla_unit<1>(p, lds, u); } else lru_pass<3>(p, lds, (int)blockIdx.x - half, (int)gridDim.x - half); })
    if (IN(12) && MK_DUP == 112) { grid.sync(); lru_pass<3>(p, lds, (int)blockIdx.x, (int)gridDim.x); grid.sync(); }
    if (IN(12) && MK_DUP == 212) { grid.sync(); for (int vb = blockIdx.x; vb < 128; vb += gridDim.x) gla_unit<1>(p, lds, vb); grid.sync(); }
    PHASE(13, phase_hgrn_post(p);)
    PHASE(14, EpiResid E{p.out, p.out, HC, HC, MODV + 5 * 6144, 2, 0}; run_gemm(lds, Y1, (const bf16_t*)(ws + WS_W_ODOUT), NLAT, 1024, 1024, E);)
    PHASE(15, phase_modnorm(p, 1, 1, p.out, HC, NLAT, false);)
    PHASE(16, EpiSwiglu E{COLS, 0}; run_gemm(lds, ACT, (const bf16_t*)(ws + WS_W_UP) + W_UP_STRIDE, NLAT, 5632, 1024, E);)
    PHASE(17, EpiResid E{p.out, p.out, HC, HC, MODV + 5 * 6144, 5, 0}; run_gemm(lds, COLS, (const bf16_t*)(ws + WS_W_DN) + W_DN_STRIDE, NLAT, 1024, 2816, E);)
    PHASE(18, phase_finalnorm(p);)
    if (hi > 4096) grid.sync();
#undef IN
#undef SEAM
}
}

#ifndef MK_ONE_LAUNCH
#define MK_ONE_LAUNCH 1
#endif
extern "C" void kernel_launch(void* const* d_in, const int* in_sizes, int n_in, void* d_out, int out_size, void* d_ws, size_t ws_size, hipStream_t stream) {
    using namespace mk;
    static int grid = 0;
    if (grid == 0) {
        int dev = 0, cus = 0, per_cu = 0;
        if (n_in != N_IN || ws_size < WS_END) { fprintf(stderr, "kernel_launch: unexpected n_in %d / ws_size %zu\n", n_in, ws_size); grid = -1; return; }
        (void)hipGetDevice(&dev); (void)hipDeviceGetAttribute(&cus, hipDeviceAttributeMultiprocessorCount, dev);
        (void)hipFuncSetAttribute((const void*)mk_fwd, hipFuncAttributeMaxDynamicSharedMemorySize, LDS_BYTES);
        (void)hipOccupancyMaxActiveBlocksPerMultiprocessor(&per_cu, (const void*)mk_fwd, NT, LDS_BYTES);
        if (per_cu < 1) { fprintf(stderr, "kernel_launch: occupancy query says %d blocks per CU\n", per_cu); per_cu = 1; }
        (void)hipGetLastError();
        grid = cus;
    }
    if (grid < 0) return;
    if (hipMemsetAsync((char*)d_ws + WS_CTL, 0, 65536, stream) != hipSuccess) { fprintf(stderr, "kernel_launch: memset of the control words failed\n"); return; }
    P p{};
    for (int i = 0; i < N_IN; ++i) p.in[i] = (const float*)d_in[i];
    p.out = (float*)d_out; p.ws = (unsigned char*)d_ws;
#if MK_ONE_LAUNCH
    p.ph_lo = 0; p.ph_hi = N_PHASES;
    void* args[] = {&p};
    hipError_t e = hipLaunchCooperativeKernel((const void*)mk_fwd, dim3(grid), dim3(NT), args, LDS_BYTES, stream);
    if (e != hipSuccess) fprintf(stderr, "cooperative launch failed: %s (grid %d)\n", hipGetErrorString(e), grid);
#else
    for (int k = 0; k < N_PHASES; ++k) { p.ph_lo = k; p.ph_hi = k + 1; hipLaunchKernelGGL(mk_fwd, dim3(grid), dim3(NT), LDS_BYTES, stream, p); }
#endif
}
```

```cpp
#include <hip/hip_runtime.h>
#include <hip/hip_cooperative_groups.h>
#include <cstdio>
#include <cstdint>
__device__ __forceinline__ int mk_tid() { int t = threadIdx.x; asm volatile("" : "+v"(t)); return t; }
#define MK_DUP -1
#define MK_RDUP -1
namespace pg8 {
#define PG8_LAS __attribute__((address_space(3)))
typedef unsigned short bf16_t;
typedef short bf16x8 __attribute__((ext_vector_type(8)));
typedef float f32x4 __attribute__((ext_vector_type(4)));
typedef unsigned u32x4 __attribute__((ext_vector_type(4)));
constexpr int BM = 256, BK = 64, HALF = 128, HTB = HALF * BK * 2  , STAGE_BYTES = 8 * HTB, NXCD = 8, WGM = 8;

__host__ __device__ __forceinline__ int lds_byte(int r, int c) { const int st = (r >> 4) * 2 + (c >> 5), rr = r & 15, cc = c & 31, ob = rr * 64 + cc * 2; return st * 1024 + (ob ^ (((ob >> 9) & 1) << 5)); }
__host__ __device__ __forceinline__ void stage_rc(int b, int& R, int& C) { const int st = b / 1024, sb = b % 1024, swz = sb ^ (((sb >> 9) & 1) << 5); R = (st >> 1) * 16 + swz / 64; C = (st & 1) * 32 + (swz % 64) / 2; }
__host__ __device__ __forceinline__ int perm32(int rho) { const int n = rho >> 4, i = rho & 15; return 8 * (i >> 2) + 4 * n + (i & 3); }

struct Unit { int pm, pn; };
struct Gemm { const bf16_t* A; const bf16_t* Bt; int M, N, K; };

struct StaticOrder {
    int nM, nN, nwg, G, c;
    __host__ __device__ void init(int M, int N, int G_, int c_) { nM = M / BM; nN = N / BM; nwg = nM * nN; G = G_; c = c_; }
    __host__ __device__ bool next(int i, Unit& u) const {
        const long L = (long)i * G + c; if (L >= nwg) return false;
        int wgid = (int)L; { const int q = nwg / NXCD, r = nwg % NXCD, xcd = wgid % NXCD, off = wgid / NXCD; wgid = (xcd < r ? xcd * (q + 1) : r * (q + 1) + (xcd - r) * q) + off; }
        const int nig = WGM * nN, gid = wgid / nig, fm = gid * WGM, gsz = (nM - fm) < WGM ? (nM - fm) : WGM;
        u.pm = fm + ((wgid % nig) % gsz); u.pn = (wgid % nig) / gsz; return true;
    }
    __device__ __forceinline__ void a_ready(const Unit&) const {}
    __device__ __forceinline__ void done(const Unit&) const {}
};
__device__ __forceinline__ unsigned cvt_pk_bf16(float lo, float hi) { unsigned r; asm volatile("v_cvt_pk_bf16_f32 %0, %1, %2" : "=v"(r) : "v"(lo), "v"(hi)); return r; }
typedef float f32x2 __attribute__((ext_vector_type(2)));
template <class Epi, class Sched, bool STAMP = false>
__device__ __forceinline__ void gemm_phase(PG8_LAS unsigned char* lds, const Gemm g, const Sched& S, const Epi& E, unsigned long long* stamps) {
    const int tid = mk_tid(), wid = __builtin_amdgcn_readfirstlane(tid >> 6), lane = tid & 63, wr = wid >> 2, wc = wid & 3, fr = lane & 15, fq = lane >> 4;
    const int K = g.K, nt = K / BK;
    int ts_lo = 0, ts_hi = 0, nts = 0; const unsigned long long rt_entry = STAMP ? (unsigned long long)wall_clock64() : 0ull;
#define PG8_STAMP() do { if (STAMP && wid == 0 && nts < 64) { const unsigned long long _c = (unsigned long long)clock64(); \
        ts_lo = (lane == nts) ? (int)(unsigned)_c : ts_lo; ts_hi = (lane == nts) ? (int)(unsigned)(_c >> 32) : ts_hi; ++nts; } } while (0)
    PG8_STAMP();
    unsigned voffA[2], voffB[2];
#pragma unroll
    for (int i = 0; i < 2; ++i) { int R, C; stage_rc(tid * 16 + i * 8192, R, C); const int Rb = Epi::PERM ? ((R & ~31) + perm32(R & 31)) : R;
        voffA[i] = (unsigned)(R * K + C) * 2u; voffB[i] = (unsigned)(Rb * K + C) * 2u; }
    const size_t kstep = (size_t)(BK * 2);
    const size_t hstep = (size_t)HALF * K * 2;
    const size_t tstep = 2 * hstep;
    const unsigned ldsw = (unsigned)wid * 1024u;
    const int aoff = lds_byte(wr * 64 + fr, fq * 8), boff = lds_byte(wc * 32 + fr, fq * 8);
#define PG8_SA(b, h) (((b) * 2 + (h)) * HTB)
#define PG8_SB(b, h) ((4 + (b) * 2 + (h)) * HTB)
#define PG8_STAGE(bufoff, gbase, voff) do { _Pragma("unroll") for (int _i = 0; _i < 2; ++_i) \
        __builtin_amdgcn_global_load_lds((const unsigned*)((const char*)(gbase) + (voff)[_i]), (PG8_LAS unsigned*)(lds + (bufoff) + ldsw + _i * 8192), 16, 0, 0); } while (0)
#define PG8_LDA(dst, b, h) do { _Pragma("unroll") for (int m = 0; m < 4; ++m) _Pragma("unroll") for (int k = 0; k < 2; ++k) dst[m][k] = *(const PG8_LAS bf16x8*)(lds + PG8_SA(b, h) + aoff + m * 2048 + k * 1024); } while (0)
#define PG8_LDB(dst, b, h) do { _Pragma("unroll") for (int n = 0; n < 2; ++n) _Pragma("unroll") for (int k = 0; k < 2; ++k) dst[n][k] = *(const PG8_LAS bf16x8*)(lds + PG8_SB(b, h) + boff + n * 2048 + k * 1024); } while (0)
#define PG8_MMA(ai, bj, At, Bt) do { __builtin_amdgcn_s_setprio(1); _Pragma("unroll") for (int m = 0; m < 4; ++m) _Pragma("unroll") for (int n = 0; n < 2; ++n) _Pragma("unroll") for (int k = 0; k < 2; ++k) \
        acc[ai][bj][m][n] = __builtin_amdgcn_mfma_f32_16x16x32_bf16(Bt[n][k], At[m][k], acc[ai][bj][m][n], 0, 0, 0); __builtin_amdgcn_s_setprio(0); } while (0)
#define PG8_WAIT_V(n) asm volatile("s_waitcnt vmcnt(" #n ")" ::: "memory")
#define PG8_WAIT_L(n) asm volatile("s_waitcnt lgkmcnt(" #n ")" ::: "memory")
#define PG8_BAR __builtin_amdgcn_s_barrier()
#define PG8_SCHED __builtin_amdgcn_sched_barrier(0)
    Unit cur, nxt; int ui = 0;
    if (!S.next(0, cur)) return;
    f32x4 acc[2][2][4][2];
#pragma unroll
    for (int a = 0; a < 2; ++a)
#pragma unroll
        for (int b = 0; b < 2; ++b)
#pragma unroll
            for (int m = 0; m < 4; ++m)
#pragma unroll
                for (int n = 0; n < 2; ++n) acc[a][b][m][n] = (f32x4){0.f, 0.f, 0.f, 0.f};
    bf16x8 At[4][2], B0[2][2], B1[2][2];
    const char* cA = (const char*)g.A + (size_t)cur.pm * tstep; const char* cB = (const char*)g.Bt + (size_t)cur.pn * tstep;
    S.a_ready(cur);
    PG8_STAGE(PG8_SB(0, 0), cB, voffB); PG8_STAGE(PG8_SA(0, 0), cA, voffA); PG8_STAGE(PG8_SB(0, 1), cB + hstep, voffB); PG8_STAGE(PG8_SA(0, 1), cA + hstep, voffA);
    if (wr == 1) PG8_BAR;
    PG8_WAIT_V(4); PG8_BAR;
    PG8_STAGE(PG8_SB(1, 0), cB + kstep, voffB); PG8_STAGE(PG8_SA(1, 0), cA + kstep, voffA); PG8_STAGE(PG8_SB(1, 1), cB + hstep + kstep, voffB);
    PG8_WAIT_V(6); PG8_BAR;
    PG8_STAMP();
    for (;;) {
        const bool has_next = S.next(ui + 1, nxt);
        const char* nA = has_next ? (const char*)g.A + (size_t)nxt.pm * tstep : cA; const char* nB = has_next ? (const char*)g.Bt + (size_t)nxt.pn * tstep : cB;
        for (int t = 0; t < nt; t += 2) {
            const bool last = (t == nt - 2);
            const char* a1 = cA + (size_t)(t + 1) * kstep;
            const char* a2 = last ? nA : cA + (size_t)(t + 2) * kstep; const char* b2 = last ? nB : cB + (size_t)(t + 2) * kstep;
            const char* a3 = a2 + kstep; const char* b3 = b2 + kstep;
            if (last && has_next) S.a_ready(nxt);
            PG8_LDB(B0, 0, 0); PG8_SCHED; PG8_LDA(At, 0, 0); PG8_STAGE(PG8_SA(1, 1), a1 + hstep, voffA);
            PG8_WAIT_L(8); PG8_BAR; PG8_WAIT_L(0); PG8_MMA(0, 0, At, B0); PG8_BAR; PG8_SCHED;
            PG8_LDB(B1, 0, 1); PG8_STAGE(PG8_SB(0, 0), b2, voffB);
            PG8_BAR; PG8_WAIT_L(0); PG8_MMA(0, 1, At, B1); PG8_BAR;
            PG8_LDA(At, 0, 1); PG8_STAGE(PG8_SA(0, 0), a2, voffA);
            PG8_BAR; PG8_WAIT_L(0); PG8_MMA(1, 0, At, B0); PG8_BAR; PG8_SCHED;
            PG8_STAGE(PG8_SB(0, 1), b2 + hstep, voffB);
            PG8_WAIT_V(6); PG8_BAR; PG8_MMA(1, 1, At, B1); PG8_BAR;
            PG8_LDB(B0, 1, 0); PG8_SCHED; PG8_LDA(At, 1, 0); PG8_STAGE(PG8_SA(0, 1), a2 + hstep, voffA);
            PG8_WAIT_L(8); PG8_BAR; PG8_WAIT_L(0); PG8_MMA(0, 0, At, B0); PG8_BAR; PG8_SCHED;
            PG8_LDB(B1, 1, 1); PG8_STAGE(PG8_SB(1, 0), b3, voffB);
            PG8_BAR; PG8_WAIT_L(0); PG8_MMA(0, 1, At, B1); PG8_BAR;
            PG8_LDA(At, 1, 1); PG8_STAGE(PG8_SA(1, 0), a3, voffA);
            PG8_BAR; PG8_WAIT_L(0); PG8_MMA(1, 0, At, B0); PG8_BAR; PG8_SCHED;
            PG8_STAGE(PG8_SB(1, 1), b3 + hstep, voffB);
            PG8_WAIT_V(6); PG8_BAR; PG8_MMA(1, 1, At, B1); PG8_BAR;
        }
        PG8_STAMP();
        if constexpr (!Epi::AFTER_DRAIN) { E(acc, cur, wr, wc, fr, fq); S.done(cur); }
        PG8_STAMP();
        if (!has_next) break;
#pragma unroll
        for (int a = 0; a < 2; ++a)
#pragma unroll
            for (int b = 0; b < 2; ++b)
#pragma unroll
                for (int m = 0; m < 4; ++m)
#pragma unroll
                    for (int n = 0; n < 2; ++n) acc[a][b][m][n] = (f32x4){0.f, 0.f, 0.f, 0.f};
        cur = nxt; cA = nA; cB = nB; ++ui;
    }
    PG8_WAIT_V(0);
    if (wr == 0) PG8_BAR;
    PG8_BAR;
    if constexpr (Epi::AFTER_DRAIN) { E.fused(acc, cur, wr, wc, fr, fq, lds, wid, lane); S.done(cur); }
    PG8_STAMP();
    if (STAMP && wid == 0) { stamps[lane] = lane < nts ? (((unsigned long long)(unsigned)ts_hi << 32) | (unsigned)ts_lo) : 0ull;
        if (lane == 62) stamps[62] = rt_entry; if (lane == 63) stamps[63] = (unsigned long long)wall_clock64(); }
#undef PG8_STAMP
#undef PG8_SA
#undef PG8_SB
#undef PG8_STAGE
#undef PG8_LDA
#undef PG8_LDB
#undef PG8_MMA
#undef PG8_WAIT_V
#undef PG8_WAIT_L
#undef PG8_BAR
#undef PG8_SCHED
}
}

namespace mk {
#define DI __device__ __forceinline__
#define LAS __attribute__((address_space(3)))
typedef unsigned short bf16_t;
typedef float f32x4 __attribute__((ext_vector_type(4)));
typedef unsigned u32x2 __attribute__((ext_vector_type(2)));
typedef unsigned u32x4 __attribute__((ext_vector_type(4)));

constexpr int D = 1024, NB = 4, L = 8192, LC = 256, NLAT = NB * L, NCTX = NB * LC, NALL = NLAT + NCTX, LT = L + LC, DFF = 2816;
constexpr int NT = 512;
constexpr size_t MiB = (size_t)1 << 20;
constexpr size_t WS_CTL = 0, WS_MODV = 1 * MiB, WS_HC = 2 * MiB, WS_W_EVIN = 6 * MiB, WS_W_EVOUT = 14 * MiB, WS_W_ODIN = 16 * MiB, WS_W_ODOUT = 23 * MiB,
                 WS_W_UP = 25 * MiB, WS_W_DN = 47 * MiB, WS_ACT = 58 * MiB, WS_COLS = 124 * MiB, WS_Z = 388 * MiB, WS_Z1 = 454 * MiB, WS_LAM = 486 * MiB, WS_LSUM = 489 * MiB, WS_LCAR = 494 * MiB, WS_SSQP = 497 * MiB, WS_GSC = 504 * MiB, WS_END = 505 * MiB;
constexpr size_t SSQP_STRIDE = (size_t)NALL * 16, GSC_STRIDE = 5 * 1024, SHW_OFF = 3 * GSC_STRIDE, SHW_STRIDE = 5 * 5632;
constexpr size_t W_UP_STRIDE = (size_t)5632 * 1024, W_DN_STRIDE = (size_t)1024 * 2816;
constexpr size_t OFF_RW = 0, OFF_LO = (size_t)NALL * 1536, OFF_ML = OFF_LO + (size_t)NALL * 512;
constexpr int LDS_BYTES = 163840;
constexpr int C1LD = 3584;
DI int nat_row(int r) { const int b = r / L, pp = r % L; return b * L + (pp % 128) * 64 + pp / 128; }

enum { I_X = 0, I_C, I_CTX, I_CCTX, I_N1G, I_N2G, I_MODW, I_MODB, I_W1, I_W3, I_W2, I_FING, I_EVIN, I_EVOUT, I_MU, I_W0, I_W2L, I_A0, I_A2L, I_KK, I_KA, I_RK,
       I_LNW, I_LNB, I_G2, I_MBI, I_MBF, I_MNG, I_ODIN, I_ODOUT, I_HLB, I_HNG, I_CONVW, I_CONVB, I_WA, I_BA, I_WI, I_BI, I_LAM, N_IN };

struct P { const float* in[N_IN]; float* out; unsigned char* ws; int ph_lo, ph_hi; };

DI float bf2f(bf16_t v) { return __uint_as_float(((unsigned)v) << 16); }
typedef float f32x2_t __attribute__((ext_vector_type(2)));
typedef __bf16 bf16x2_t __attribute__((ext_vector_type(2)));
DI unsigned pack2(float lo, float hi) { const f32x2_t v = {lo, hi}; return __builtin_bit_cast(unsigned, __builtin_convertvector(v, bf16x2_t)); }
DI bf16_t f2bf(float f) { return (bf16_t)(pack2(f, f) & 0xffffu); }
DI float sigm(float x) { return 1.f / (1.f + expf(-x)); }
DI float siluf(float x) { return x * sigm(x); }
DI float geluf(float x) { return 0.5f * x * (1.f + tanhf(0.7978845608028654f * (x + 0.044715f * x * x * x))); }
DI float fexp(float x) { return __builtin_amdgcn_exp2f(x * 1.4426950408889634f); }
DI float frcp(float x) { return __builtin_amdgcn_rcpf(x); }
DI float fsigm(float x) { return frcp(1.f + fexp(-x)); }
DI float ftanh(float x) { return 1.f - 2.f * frcp(1.f + fexp(2.f * x)); }
DI float fgelu(float x) { return 0.5f * x * (1.f + ftanh(0.7978845608028654f * (x + 0.044715f * x * x * x))); }
template <int CTRL> DI float dppf(float x) { return __int_as_float(__builtin_amdgcn_update_dpp(0, __float_as_int(x), CTRL, 0xF, 0xF, false)); }
DI float sum8(float s) { s += dppf<0xB1>(s); s += dppf<0x4E>(s); s += dppf<0x141>(s); return s; }
DI float scan16(float x) { x += dppf<0x111>(x); x += dppf<0x112>(x); x += dppf<0x114>(x); x += dppf<0x118>(x); return x; }
DI float wave_sum(float v) { v += dppf<0xB1>(v); v += dppf<0x4E>(v); v += dppf<0x141>(v); v += dppf<0x140>(v); v += __shfl_xor(v, 16); v += __shfl_xor(v, 32); return v; }
DI int step_row(int d, int b, int n) {
    if (n < LC) return NLAT + b * LC + (d ? LC - 1 - n : n);
    const int m = n - LC; return b * L + (d ? L - 1 - m : m);
}

DI int matN(int m) { return m == 0 ? 4096 : m == 1 ? 1024 : m == 2 ? 3584 : m == 3 ? 1024 : m < 6 ? 5632 : 1024; }
DI int matK(int m) { return m < 6 ? 1024 : 2816; }
DI int matTile0(int m) { return m == 0 ? 0 : m == 1 ? 1024 : m == 2 ? 1280 : m == 3 ? 2176 : m == 4 ? 2432 : m == 5 ? 3840 : m == 6 ? 5248 : m == 7 ? 5952 : 6656; }
DI size_t matOff(int m) { return m == 0 ? WS_W_EVIN : m == 1 ? WS_W_EVOUT : m == 2 ? WS_W_ODIN : m == 3 ? WS_W_ODOUT : m == 4 ? WS_W_UP : m == 5 ? WS_W_UP + W_UP_STRIDE * 2 : m == 6 ? WS_W_DN : WS_W_DN + W_DN_STRIDE * 2; }
DI const float* matSrc(const P& p, int m, int n, int& ld) {
    if (m == 0) { ld = 3984; int col; if (n < 1920) col = n; else if (n < 1936) col = 3968 + (n - 1920); else if (n < 2048) return nullptr; else col = 1920 + (n - 2048); return p.in[I_EVIN] + col; }
    if (m == 1) { ld = 1024; return p.in[I_EVOUT] + n; }
    if (m == 2) { ld = 3584; return p.in[I_ODIN] + n; }
    if (m == 3) { ld = 1024; return p.in[I_ODOUT] + n; }
    if (m < 6) { ld = 2816; const int l = m - 4, pn = n >> 8, w = n & 255; const size_t lo = (size_t)l * 1024 * 2816; return (w < 128) ? p.in[I_W1] + lo + 128 * pn + w : p.in[I_W3] + lo + 128 * pn + (w - 128); }
    ld = 1024; return p.in[I_W2] + (size_t)(m - 6) * 2816 * 1024 + n;
}
DI void phase_wprep(const P& p, LAS unsigned char* ldsb) {
    LAS float* tile = (LAS float*)ldsb;
    const int tid = mk_tid(), tx = tid & 63, ty = tid >> 6;
    for (int item = blockIdx.x; item < 6656; item += gridDim.x) {
        int m = 0;
#pragma unroll
        for (int q = 1; q < 8; ++q) if (item >= matTile0(q)) m = q;
        const int local = item - matTile0(m), K = matK(m), nK = K >> 6, nb = local / nK, kb = local - nb * nK, n0 = nb * 64, k0 = kb * 64;
        bf16_t* Bt = (bf16_t*)(p.ws + matOff(m));
        int ld; const float* src = matSrc(p, m, n0 + tx, ld);
        __syncthreads();
#pragma unroll
        for (int i = 0; i < 8; ++i) { const int k = k0 + ty + 8 * i; tile[(ty + 8 * i) * 65 + tx] = src ? src[(size_t)k * ld] : 0.f; }
        __syncthreads();
#pragma unroll
        for (int i = 0; i < 8; ++i) { const int nn = ty + 8 * i; Bt[(size_t)(n0 + nn) * K + k0 + tx] = f2bf(tile[tx * 65 + nn]); }
    }
    __syncthreads();
}
DI void phase_modv(const P& p, LAS unsigned char* ldsb) {
    LAS float* sc = (LAS float*)ldsb;
    const int tid = mk_tid();
    float* MODV = (float*)(p.ws + WS_MODV);
    __syncthreads();
    for (int e = tid; e < 5 * 1024; e += NT) { const int s = e >> 10, k = e & 1023; const float v = (s < 4) ? p.in[I_C][s * 1024 + k] : p.in[I_CCTX][k]; sc[e] = siluf(v); }
    __syncthreads();
    for (int vb = blockIdx.x; vb < 24; vb += gridDim.x) {
        const int l = vb / 12, n = (vb % 12) * 512 + tid;
        const float* W = p.in[I_MODW] + (size_t)l * 1024 * 6144 + n;
        float a0 = 0.f, a1 = 0.f, a2 = 0.f, a3 = 0.f, a4 = 0.f;
#pragma unroll 8
        for (int k = 0; k < 1024; ++k) { const float w = W[(size_t)k * 6144]; a0 += sc[k] * w; a1 += sc[1024 + k] * w; a2 += sc[2048 + k] * w; a3 += sc[3072 + k] * w; a4 += sc[4096 + k] * w; }
        const float bb = p.in[I_MODB][l * 6144 + n];
        float* o = MODV + (size_t)l * 5 * 6144 + n;
        o[0] = a0 + bb; o[6144] = a1 + bb; o[2 * 6144] = a2 + bb; o[3 * 6144] = a3 + bb; o[4 * 6144] = a4 + bb;
    }
    __syncthreads();
}

DI void phase_modnorm(const P& p, int layer, int which, const float* hlat, const float* hctx, int nrows, bool permute) {
    const int lane = mk_tid() & 63, wv = mk_tid() >> 6;
    const float* MODV = (const float*)(p.ws + WS_MODV) + (size_t)layer * 5 * 6144;
    const float* g = p.in[which ? I_N2G : I_N1G] + layer * 1024;
    bf16_t* ACT = (bf16_t*)(p.ws + WS_ACT);
    f32x4 gs[4], sh[4]; int sv_have = -1;
    const int rstep = gridDim.x * 8; int r = blockIdx.x * 8 + wv;
    f32x4 v[4], vn[4];
#define MN_SRC(rr) (((rr) >= NLAT) ? hctx + (size_t)((rr) - NLAT) * D : hlat + (size_t)(rr) * D)
    if (r < nrows) { const float* src = MN_SRC(r);
#pragma unroll
        for (int j = 0; j < 4; ++j) v[j] = *(const f32x4*)(src + 4 * lane + 256 * j); }
    for (; r < nrows; r += rstep) {
        const bool isctx = r >= NLAT; const int sv = isctx ? 4 : r / L;
        if (r + rstep < nrows) { const float* src = MN_SRC(r + rstep);
#pragma unroll
            for (int j = 0; j < 4; ++j) vn[j] = *(const f32x4*)(src + 4 * lane + 256 * j); }
        if (sv != sv_have) { sv_have = sv; const float* shift = MODV + sv * 6144 + (which ? 3 : 0) * 1024; const float* scale = shift + 1024;
#pragma unroll
            for (int j = 0; j < 4; ++j) { const int c = 4 * lane + 256 * j; const f32x4 gg = *(const f32x4*)(g + c), sc = *(const f32x4*)(scale + c); gs[j] = gg * (sc + 1.f); sh[j] = *(const f32x4*)(shift + c); } }
        int dr = r;
        if (permute && !isctx) { const int b = r / L, t = r % L; dr = b * L + (t % 64) * 128 + t / 64; }
        float ss = 0.f;
#pragma unroll
        for (int j = 0; j < 4; ++j) ss += (v[j].x * v[j].x + v[j].y * v[j].y) + (v[j].z * v[j].z + v[j].w * v[j].w);
        const float rinv = rsqrtf(wave_sum(ss) * (1.f / D) + 1e-6f);
#pragma unroll
        for (int j = 0; j < 4; ++j) { const int c = 4 * lane + 256 * j; const f32x4 o = v[j] * rinv * gs[j] + sh[j];
            u32x2 w; w.x = pack2(o[0], o[1]); w.y = pack2(o[2], o[3]);
            *(u32x2*)(ACT + (size_t)dr * D + c) = w; v[j] = vn[j]; }
    }
#undef MN_SRC
}
DI void phase_finalnorm(const P& p) {
    const int lane = mk_tid() & 63, wv = mk_tid() >> 6;
    const float* g = p.in[I_FING];
    f32x4 gg[4];
#pragma unroll
    for (int j = 0; j < 4; ++j) gg[j] = *(const f32x4*)(g + 4 * lane + 256 * j);
    const int rstep = gridDim.x * 8; int r = blockIdx.x * 8 + wv;
    f32x4 v[4], vn[4];
    if (r < NLAT) {
#pragma unroll
        for (int j = 0; j < 4; ++j) v[j] = *(const f32x4*)(p.out + (size_t)r * D + 4 * lane + 256 * j); }
    for (; r < NLAT; r += rstep) {
        if (r + rstep < NLAT) {
#pragma unroll
            for (int j = 0; j < 4; ++j) vn[j] = *(const f32x4*)(p.out + (size_t)(r + rstep) * D + 4 * lane + 256 * j); }
        float ss = 0.f;
#pragma unroll
        for (int j = 0; j < 4; ++j) ss += (v[j].x * v[j].x + v[j].y * v[j].y) + (v[j].z * v[j].z + v[j].w * v[j].w);
        const float rinv = rsqrtf(wave_sum(ss) * (1.f / D) + 1e-6f);
#pragma unroll
        for (int j = 0; j < 4; ++j) { *(f32x4*)(p.out + (size_t)r * D + 4 * lane + 256 * j) = v[j] * rinv * gg[j]; v[j] = vn[j]; }
    }
}

struct EpiStore3 {
    static constexpr bool PERM = true, AFTER_DRAIN = false;
    bf16_t* p0; int ld0; int pn1; bf16_t* p1; int ld1; int pn2; bf16_t* p2; int ld2; int pm0;
    DI void operator()(const f32x4 (&acc)[2][2][4][2], const pg8::Unit& u, int wr, int wc, int fr, int fq) const {
        bf16_t* base; int ld, ct;
        if (u.pn >= pn2) { base = p2; ld = ld2; ct = u.pn - pn2; } else if (u.pn >= pn1) { base = p1; ld = ld1; ct = u.pn - pn1; } else { base = p0; ld = ld0; ct = u.pn; }
        const int row0 = (u.pm + pm0) * 256 + wr * 64 + fr, col0 = ct * 256 + wc * 32 + 8 * fq;
#pragma unroll
        for (int ai = 0; ai < 2; ++ai)
#pragma unroll
            for (int m = 0; m < 4; ++m) { bf16_t* rowp = base + (size_t)(row0 + ai * 128 + m * 16) * ld + col0;
#pragma unroll
                for (int bj = 0; bj < 2; ++bj) { const f32x4 v0 = acc[ai][bj][m][0], v1 = acc[ai][bj][m][1];
                    u32x4 w; w.x = pack2(v0[0], v0[1]); w.y = pack2(v0[2], v0[3]); w.z = pack2(v1[0], v1[1]); w.w = pack2(v1[2], v1[3]); *(u32x4*)(rowp + bj * 128) = w; } }
    }
};
struct EpiResid {
    static constexpr bool PERM = false, AFTER_DRAIN = false;
    const float* hin; float* hout; const float* cin; float* cout; const float* modv_l; int gidx; int pm0;
    DI void operator()(const f32x4 (&acc)[2][2][4][2], const pg8::Unit& u, int wr, int wc, int fr, int fq) const {
        const int pm = u.pm + pm0; const bool isctx = pm >= 128; const int sv = isctx ? 4 : (pm >> 5);
        const float* gate = modv_l + sv * 6144 + gidx * 1024;
        const float* bi = isctx ? cin : hin; float* bo = isctx ? cout : hout;
        const int row0 = (isctx ? (pm - 128) : pm) * 256 + wr * 64 + fr, col0 = u.pn * 256 + wc * 32 + 4 * fq;
        f32x4 gv[2][2];
#pragma unroll
        for (int bj = 0; bj < 2; ++bj)
#pragma unroll
            for (int n = 0; n < 2; ++n) gv[bj][n] = *(const f32x4*)(gate + col0 + bj * 128 + n * 16);
#pragma unroll
        for (int ai = 0; ai < 2; ++ai)
#pragma unroll
            for (int m = 0; m < 4; ++m) { const size_t off = (size_t)(row0 + ai * 128 + m * 16) * D + col0;
#pragma unroll
                for (int bj = 0; bj < 2; ++bj)
#pragma unroll
                    for (int n = 0; n < 2; ++n) { const f32x4 bs = *(const f32x4*)(bi + off + bj * 128 + n * 16); *(f32x4*)(bo + off + bj * 128 + n * 16) = bs + gv[bj][n] * acc[ai][bj][m][n]; } }
    }
};
struct EpiResidN {
    static constexpr bool PERM = false, AFTER_DRAIN = false;
    const float* hin; float* hout; const float* cin; float* cout; const float* modv_l; int gidx;
    bf16_t* act; const float* gsc; float* ssqp; int permute;
    DI void operator()(const f32x4 (&acc)[2][2][4][2], const pg8::Unit& u, int wr, int wc, int fr, int fq) const {
        const bool isctx = u.pm >= 128; const int sv = isctx ? 4 : (u.pm >> 5);
        const float* gate = modv_l + sv * 6144 + gidx * 1024; const float* gs = gsc + sv * 1024;
        const float* bi = isctx ? cin : hin; float* bo = isctx ? cout : hout;
        const int row0 = (isctx ? (u.pm - 128) : u.pm) * 256 + wr * 64 + fr, col0 = u.pn * 256 + wc * 32 + 4 * fq;
        f32x4 gv[2][2], gsv[2][2];
#pragma unroll
        for (int bj = 0; bj < 2; ++bj)
#pragma unroll
            for (int n = 0; n < 2; ++n) { gv[bj][n] = *(const f32x4*)(gate + col0 + bj * 128 + n * 16); gsv[bj][n] = *(const f32x4*)(gs + col0 + bj * 128 + n * 16); }
#pragma unroll
        for (int ai = 0; ai < 2; ++ai)
#pragma unroll
            for (int m = 0; m < 4; ++m) { const int rl = row0 + ai * 128 + m * 16; const size_t off = (size_t)rl * D + col0;
                int arow = u.pm * 256 + wr * 64 + fr + ai * 128 + m * 16;
                if (permute && !isctx) { const int b = arow / L, t = arow % L; arow = b * L + (t % 64) * 128 + t / 64; }
                float ss = 0.f;
#pragma unroll
                for (int bj = 0; bj < 2; ++bj)
#pragma unroll
                    for (int n = 0; n < 2; ++n) { const f32x4 bs = *(const f32x4*)(bi + off + bj * 128 + n * 16); const f32x4 hn = bs + gv[bj][n] * acc[ai][bj][m][n];
                        *(f32x4*)(bo + off + bj * 128 + n * 16) = hn; ss += (hn[0] * hn[0] + hn[1] * hn[1]) + (hn[2] * hn[2] + hn[3] * hn[3]);
                        const f32x4 an = hn * gsv[bj][n]; u32x2 w; w.x = pack2(an[0], an[1]); w.y = pack2(an[2], an[3]); *(u32x2*)(act + (size_t)arow * D + col0 + bj * 128 + n * 16) = w; }
                ss += __shfl_xor(ss, 16); ss += __shfl_xor(ss, 32);
                if (fq == 0) ssqp[(size_t)arow * 16 + u.pn * 4 + wc] = ss; }
    }
};
struct EpiSwiglu {
    static constexpr bool PERM = true, AFTER_DRAIN = false;
    bf16_t* G; int pm0;
    DI void operator()(const f32x4 (&acc)[2][2][4][2], const pg8::Unit& u, int wr, int wc, int fr, int fq) const {
        const int row0 = (u.pm + pm0) * 256 + wr * 64 + fr, col0 = u.pn * 128 + wc * 32 + 8 * fq;
#pragma unroll
        for (int ai = 0; ai < 2; ++ai)
#pragma unroll
            for (int m = 0; m < 4; ++m) { bf16_t* rowp = G + (size_t)(row0 + ai * 128 + m * 16) * DFF + col0; float g[8];
#pragma unroll
                for (int n = 0; n < 2; ++n) { const f32x4 a = acc[ai][0][m][n], b = acc[ai][1][m][n];
#pragma unroll
                    for (int j = 0; j < 4; ++j) g[4 * n + j] = a[j] * frcp(1.f + fexp(-a[j])) * b[j]; }
                u32x4 w; w.x = pack2(g[0], g[1]); w.y = pack2(g[2], g[3]); w.z = pack2(g[4], g[5]); w.w = pack2(g[6], g[7]); *(u32x4*)rowp = w; }
    }
};
template <class Epi> DI void run_gemm(LAS unsigned char* lds, const bf16_t* A, const bf16_t* Bt, int M, int N, int K, const Epi& E) {
    pg8::Gemm g{A, Bt, M, N, K}; pg8::StaticOrder S; S.init(M, N, (int)gridDim.x, (int)blockIdx.x);
    pg8::gemm_phase<Epi, pg8::StaticOrder, false>((PG8_LAS unsigned char*)lds, g, S, E, nullptr);
    __syncthreads();
}


DI void phase_norm_tables(const P& p) {
    const int tid = mk_tid(), lane = tid & 63, wv = tid >> 6;
    const float* MODV = (const float*)(p.ws + WS_MODV); float* GSC = (float*)(p.ws + WS_GSC); float* SHW = GSC + SHW_OFF;
    for (int e = blockIdx.x * NT + tid; e < 3 * 5 * 1024; e += gridDim.x * NT) { const int site = e / 5120, s = (e / 1024) % 5, c = e & 1023;
        const int layer = site ? 1 : 0, scidx = (site == 1) ? 1 : 4; const float g = p.in[(site == 1) ? I_N1G : I_N2G][layer * 1024 + c];
        GSC[e] = g * (1.f + MODV[(size_t)layer * 5 * 6144 + s * 6144 + scidx * 1024 + c]); }
    for (int w = blockIdx.x * 8 + wv; w < 5632 + 3584 + 5632; w += gridDim.x * 8) {
        int site, n; const bf16_t* Bt;
        if (w < 5632) { site = 0; n = w; Bt = (const bf16_t*)(p.ws + WS_W_UP); } else if (w < 5632 + 3584) { site = 1; n = w - 5632; Bt = (const bf16_t*)(p.ws + WS_W_ODIN); } else { site = 2; n = w - 5632 - 3584; Bt = (const bf16_t*)(p.ws + WS_W_UP) + W_UP_STRIDE; }
        const int layer = site ? 1 : 0, shidx = (site == 1) ? 0 : 3;
        const u32x4 w0 = *(const u32x4*)(Bt + (size_t)n * 1024 + 16 * lane), w1 = *(const u32x4*)(Bt + (size_t)n * 1024 + 16 * lane + 8);
        float wf[16];
#pragma unroll
        for (int k = 0; k < 4; ++k) { wf[2 * k] = __uint_as_float(w0[k] << 16); wf[2 * k + 1] = __uint_as_float(w0[k] & 0xffff0000u); wf[8 + 2 * k] = __uint_as_float(w1[k] << 16); wf[8 + 2 * k + 1] = __uint_as_float(w1[k] & 0xffff0000u); }
#pragma unroll
        for (int s = 0; s < 5; ++s) { const float* sh = MODV + (size_t)layer * 5 * 6144 + s * 6144 + shidx * 1024 + 16 * lane; float a = 0.f;
#pragma unroll
            for (int k = 0; k < 16; ++k) a += sh[k] * wf[k];
            a = wave_sum(a);
            if (lane == 0) SHW[(size_t)site * SHW_STRIDE + s * 5632 + n] = a; }
    }
}
DI void phase_rwkv_scan_unit(const P& p, LAS unsigned char* ldsb, const int vb) {
    LAS float* lds = (LAS float*)ldsb;
    LAS float *w2s = lds, *a2s = lds + 4096, *prm = lds + 8192, *TH = prm + 768, *AD = TH + 2048, *R = AD + 2048, *W = R + 2048, *K = W + 2048, *KK = K + 2048, *BV = KK + 2048,
              *V = BV + 2048, *BS = V + 2048, *OUT = BS + 32;
    const int tid = mk_tid(), lane = tid & 63, wv = tid >> 6;
    const bf16_t* RW = (const bf16_t*)(p.ws + WS_COLS) + OFF_RW; const bf16_t* LO = (const bf16_t*)(p.ws + WS_COLS) + OFF_LO; bf16_t* Z = (bf16_t*)(p.ws + WS_Z);
    const int srow = tid >> 3, sg = tid & 7;
    {
        const int d = vb >> 5, b = (vb >> 3) & 3, h = vb & 7;
        __syncthreads();
        for (int e = tid; e < 4096; e += NT) { const int i = e >> 6, c = e & 63; w2s[e] = p.in[I_W2L][(size_t)(d * 64 + i) * 512 + 64 * h + c]; a2s[e] = p.in[I_A2L][(size_t)(d * 64 + i) * 512 + 64 * h + c]; }
        if (tid < 64) { const int j = tid, c = 64 * h + j; const float* mu = p.in[I_MU] + d * 1664;
            prm[j] = mu[c]; prm[64 + j] = mu[512 + c]; prm[128 + j] = mu[1024 + c]; prm[192 + j] = mu[1536 + j]; prm[256 + j] = mu[1600 + j];
            prm[320 + j] = p.in[I_W0][d * 512 + c]; prm[384 + j] = p.in[I_A0][d * 512 + c]; prm[448 + j] = p.in[I_KK][d * 512 + c]; prm[512 + j] = p.in[I_KA][d * 512 + c];
            prm[576 + j] = p.in[I_RK][(d * 8 + h) * 64 + j]; prm[640 + j] = p.in[I_LNW][d * 512 + c]; prm[704 + j] = p.in[I_LNB][d * 512 + c]; }
        __syncthreads();
        float S0 = 0.f, S1 = 0.f, S2 = 0.f, S3 = 0.f, S4 = 0.f, S5 = 0.f, S6 = 0.f, S7 = 0.f;
        for (int n0 = 0; n0 < LT; n0 += 32) {
            float rs[4], ks[4], vs[4];
#pragma unroll
            for (int m = 0; m < 4; ++m) { const int s = wv + 8 * m, n = n0 + s; const bool hp = (n != 0) && (n != LC);
                const size_t row = (size_t)step_row(d, b, n), prow = hp ? (size_t)step_row(d, b, n - 1) : row; const int c = 64 * h + lane;
                const float r0 = bf2f(RW[row * 1536 + c]), k0 = bf2f(RW[row * 1536 + 512 + c]), v0 = bf2f(RW[row * 1536 + 1024 + c]);
                const float r1 = hp ? bf2f(RW[prow * 1536 + c]) : 0.f, k1 = hp ? bf2f(RW[prow * 1536 + 512 + c]) : 0.f, v1 = hp ? bf2f(RW[prow * 1536 + 1024 + c]) : 0.f;
                rs[m] = r0 + prm[lane] * (r1 - r0); ks[m] = k0 + prm[64 + lane] * (k1 - k0); vs[m] = v0 + prm[128 + lane] * (v1 - v0);
                const float wd0 = bf2f(LO[row * 512 + 64 * d + lane]), wd1 = hp ? bf2f(LO[prow * 512 + 64 * d + lane]) : 0.f;
                const float ad0 = bf2f(LO[row * 512 + 128 + 64 * d + lane]), ad1 = hp ? bf2f(LO[prow * 512 + 128 + 64 * d + lane]) : 0.f;
                TH[s * 64 + lane] = tanhf(wd0 + prm[192 + lane] * (wd1 - wd0)); AD[s * 64 + lane] = ad0 + prm[256 + lane] * (ad1 - ad0); }
            __syncthreads();
#pragma unroll
            for (int m = 0; m < 4; ++m) { const int s = wv + 8 * m;
                float xw = prm[320 + lane], xa = prm[384 + lane];
#pragma unroll 8
                for (int i = 0; i < 64; ++i) { xw += TH[s * 64 + i] * w2s[i * 64 + lane]; xa += AD[s * 64 + i] * a2s[i * 64 + lane]; }
                const float elog = 0.6065306597126334f * sigm(xw), dec = expf(-elog), a = sigm(xa);
                const float kkr = ks[m] * prm[448 + lane]; const float ss = wave_sum(kkr * kkr); const float kkn = kkr / fmaxf(sqrtf(ss), 1e-12f);
                const float km = ks[m] * (1.f + (a - 1.f) * prm[512 + lane]);
                const float bs = wave_sum(rs[m] * km * prm[576 + lane]);
                R[s * 64 + lane] = rs[m]; W[s * 64 + lane] = dec; K[s * 64 + lane] = km; KK[s * 64 + lane] = kkn; BV[s * 64 + lane] = kkn * a; V[s * 64 + lane] = vs[m];
                if (lane == 0) BS[s] = bs; }
            __syncthreads();
            for (int s = 0; s < 32; ++s) {
                const LAS f32x4* pq = (const LAS f32x4*)(KK + s * 64 + 8 * sg); const f32x4 q0 = pq[0], q1 = pq[1];
                const LAS f32x4* pw = (const LAS f32x4*)(W + s * 64 + 8 * sg); const f32x4 w0 = pw[0], w1 = pw[1];
                const LAS f32x4* pb = (const LAS f32x4*)(BV + s * 64 + 8 * sg); const f32x4 b0 = pb[0], b1 = pb[1];
                const LAS f32x4* pk = (const LAS f32x4*)(K + s * 64 + 8 * sg); const f32x4 k0 = pk[0], k1 = pk[1];
                const LAS f32x4* pr = (const LAS f32x4*)(R + s * 64 + 8 * sg); const f32x4 r0 = pr[0], r1 = pr[1];
                const float vi = V[s * 64 + srow];
                float sa = S0 * q0.x + S1 * q0.y + S2 * q0.z + S3 * q0.w + S4 * q1.x + S5 * q1.y + S6 * q1.z + S7 * q1.w;
                sa += __shfl_xor(sa, 1); sa += __shfl_xor(sa, 2); sa += __shfl_xor(sa, 4);
                S0 = S0 * w0.x - sa * b0.x + vi * k0.x; S1 = S1 * w0.y - sa * b0.y + vi * k0.y; S2 = S2 * w0.z - sa * b0.z + vi * k0.z; S3 = S3 * w0.w - sa * b0.w + vi * k0.w;
                S4 = S4 * w1.x - sa * b1.x + vi * k1.x; S5 = S5 * w1.y - sa * b1.y + vi * k1.y; S6 = S6 * w1.z - sa * b1.z + vi * k1.z; S7 = S7 * w1.w - sa * b1.w + vi * k1.w;
                float o = S0 * r0.x + S1 * r0.y + S2 * r0.z + S3 * r0.w + S4 * r1.x + S5 * r1.y + S6 * r1.z + S7 * r1.w;
                o += __shfl_xor(o, 1); o += __shfl_xor(o, 2); o += __shfl_xor(o, 4);
                if (sg == 0) OUT[s * 64 + srow] = o;
            }
            __syncthreads();
#pragma unroll
            for (int m = 0; m < 4; ++m) { const int s = wv + 8 * m, n = n0 + s; const size_t row = (size_t)step_row(d, b, n);
                const float o = OUT[s * 64 + lane]; const float mean = wave_sum(o) * (1.f / 64.f); const float dv = o - mean; const float var = wave_sum(dv * dv) * (1.f / 64.f);
                const float z = dv * rsqrtf(var + 64e-5f) * prm[640 + lane] + prm[704 + lane] + BS[s] * V[s * 64 + lane];
                Z[((size_t)d * NALL + row) * 512 + 64 * h + lane] = f2bf(z); }
        }
    }
    __syncthreads();
}
DI void phase_rwkv_post(const P& p, LAS unsigned char* ldsb) {
    LAS float* sg = (LAS float*)ldsb;
    const int tid = mk_tid();
    const bf16_t* LO = (const bf16_t*)(p.ws + WS_COLS) + OFF_LO; const bf16_t* Z = (const bf16_t*)(p.ws + WS_Z); bf16_t* Y = (bf16_t*)(p.ws + WS_COLS);
    const float* g2 = p.in[I_G2];
    for (int vb = blockIdx.x; vb < NALL / 8; vb += gridDim.x) {
        const size_t row0 = (size_t)vb * 8;
        __syncthreads();
        for (int e = tid; e < 1024; e += NT) { const int q = e >> 7, r = e & 127; sg[e] = sigm(bf2f(LO[(row0 + q) * 512 + 256 + r])); }
        __syncthreads();
        float a0 = 0.f, a1 = 0.f, a2 = 0.f, a3 = 0.f, a4 = 0.f, a5 = 0.f, a6 = 0.f, a7 = 0.f;
#pragma unroll 4
        for (int r = 0; r < 128; ++r) { const float g = g2[r * 512 + tid];
            a0 += sg[r] * g; a1 += sg[128 + r] * g; a2 += sg[256 + r] * g; a3 += sg[384 + r] * g; a4 += sg[512 + r] * g; a5 += sg[640 + r] * g; a6 += sg[768 + r] * g; a7 += sg[896 + r] * g; }
#define MK_RP(q, aq) { const size_t rr = row0 + q; const float z = bf2f(Z[rr * 512 + tid]) + bf2f(Z[((size_t)NALL + rr) * 512 + tid]); Y[rr * D + tid] = f2bf(z * aq); }
        MK_RP(0, a0) MK_RP(1, a1) MK_RP(2, a2) MK_RP(3, a3) MK_RP(4, a4) MK_RP(5, a5) MK_RP(6, a6) MK_RP(7, a7)
#undef MK_RP
    }
    __syncthreads();
}
DI void post_headnorm_row(const bf16_t* HB, size_t row, const float* ng, const bf16_t* gsrc, int gate_kind, bf16_t* ydst, int lane) {
    const int c0 = 8 * lane;
    const u32x4 h0 = *(const u32x4*)(HB + row * 512 + c0), h1 = *(const u32x4*)(HB + ((size_t)NALL + row) * 512 + c0), gg = *(const u32x4*)(gsrc + c0);
    float h[8], g[8];
#pragma unroll
    for (int j = 0; j < 4; ++j) { h[2 * j] = __uint_as_float(h0[j] << 16) + __uint_as_float(h1[j] << 16); h[2 * j + 1] = __uint_as_float(h0[j] & 0xffff0000u) + __uint_as_float(h1[j] & 0xffff0000u);
        g[2 * j] = __uint_as_float(gg[j] << 16); g[2 * j + 1] = __uint_as_float(gg[j] & 0xffff0000u); }
    float ss = 0.f;
#pragma unroll
    for (int j = 0; j < 8; ++j) ss += h[j] * h[j];
    ss += __shfl_xor(ss, 1); ss += __shfl_xor(ss, 2); ss += __shfl_xor(ss, 4); ss += __shfl_xor(ss, 8);
    const float rinv = rsqrtf(ss * (1.f / 128.f) + 1e-6f);
    unsigned o[4];
#pragma unroll
    for (int j = 0; j < 4; ++j) { const float y0 = h[2 * j] * rinv * ng[c0 + 2 * j] * (gate_kind ? siluf(g[2 * j]) : sigm(g[2 * j])), y1 = h[2 * j + 1] * rinv * ng[c0 + 2 * j + 1] * (gate_kind ? siluf(g[2 * j + 1]) : sigm(g[2 * j + 1]));
        o[j] = pack2(y0, y1); }
    u32x4 w; w.x = o[0]; w.y = o[1]; w.z = o[2]; w.w = o[3];
    *(u32x4*)(ydst + c0) = w;
}
typedef short bf16x8 __attribute__((ext_vector_type(8)));
typedef short s16x4 __attribute__((ext_vector_type(4)));
constexpr int PQ = 136, PS = 72, PV = 56;
constexpr int E_QS = 0, E_KS = E_QS + 64 * PQ * 2, E_VS = E_KS + 64 * PQ * 2, E_PS = E_VS + 64 * PV * 2, E_ST = E_PS + 64 * PS * 2, E_F = E_ST + 48 * PQ * 2, E_END = E_F + 2048;
constexpr size_t WS_Q1 = WS_COLS + (size_t)231 * MiB;
constexpr int NRC = NALL / 64;

DI int chunk_row0(int d, int b, int ci) {
    if (ci < 4) { const int cc = d ? 3 - ci : ci; return NLAT + b * LC + 64 * cc; }
    const int lc = ci - 4, cl = d ? 127 - lc : lc; return b * L + 64 * cl;
}
DI bf16x8 tr_frag(unsigned tile_base, int pitch, int k0, int c0, int r, int q) {
    const unsigned a0 = tile_base + (unsigned)(((k0 + 8 * q + (r >> 2)) * pitch + c0 + 4 * (r & 3)) * 2), a1 = a0 + (unsigned)(4 * pitch * 2);
    s16x4 x, y;
    asm volatile("ds_read_b64_tr_b16 %0, %2\n\tds_read_b64_tr_b16 %1, %3\n\ts_waitcnt lgkmcnt(0)" : "=&v"(x), "=&v"(y) : "v"(a0), "v"(a1) : "memory");
    bf16x8 o; o[0] = x[0]; o[1] = x[1]; o[2] = x[2]; o[3] = x[3]; o[4] = y[0]; o[5] = y[1]; o[6] = y[2]; o[7] = y[3];
    return o;
}

DI unsigned tr_addr(unsigned tile_base, int pitch, int k0, int c0, int r, int q) { return tile_base + (unsigned)(((k0 + 8 * q + (r >> 2)) * pitch + c0 + 4 * (r & 3)) * 2); }
DI bf16x8 tr_join(s16x4 x, s16x4 y) { bf16x8 o; o[0] = x[0]; o[1] = x[1]; o[2] = x[2]; o[3] = x[3]; o[4] = y[0]; o[5] = y[1]; o[6] = y[2]; o[7] = y[3]; return o; }
DI void tr_frag2(bf16x8& f0, bf16x8& f1, unsigned a0, unsigned h0, unsigned a1, unsigned h1) {
    s16x4 x0, y0, x1, y1; const unsigned b0 = a0 + h0, b1 = a1 + h1;
    asm volatile("ds_read_b64_tr_b16 %0, %4\n\tds_read_b64_tr_b16 %1, %5\n\tds_read_b64_tr_b16 %2, %6\n\tds_read_b64_tr_b16 %3, %7\n\ts_waitcnt lgkmcnt(0)"
                 : "=&v"(x0), "=&v"(y0), "=&v"(x1), "=&v"(y1) : "v"(a0), "v"(b0), "v"(a1), "v"(b1) : "memory");
    f0 = tr_join(x0, y0); f1 = tr_join(x1, y1);
}
DI void tr_frag3(bf16x8& f0, bf16x8& f1, bf16x8& f2, unsigned a0, unsigned h0, unsigned a1, unsigned h1, unsigned a2, unsigned h2) {
    s16x4 x0, y0, x1, y1, x2, y2; const unsigned b0 = a0 + h0, b1 = a1 + h1, b2 = a2 + h2;
    asm volatile("ds_read_b64_tr_b16 %0, %6\n\tds_read_b64_tr_b16 %1, %7\n\tds_read_b64_tr_b16 %2, %8\n\tds_read_b64_tr_b16 %3, %9\n\tds_read_b64_tr_b16 %4, %10\n\tds_read_b64_tr_b16 %5, %11\n\ts_waitcnt lgkmcnt(0)"
                 : "=&v"(x0), "=&v"(y0), "=&v"(x1), "=&v"(y1), "=&v"(x2), "=&v"(y2) : "v"(a0), "v"(b0), "v"(a1), "v"(b1), "v"(a2), "v"(b2) : "memory");
    f0 = tr_join(x0, y0); f1 = tr_join(x1, y1); f2 = tr_join(x2, y2);
}
DI void tr_frag4(bf16x8& f0, bf16x8& f1, bf16x8& f2, bf16x8& f3, unsigned a0, unsigned h0, unsigned a1, unsigned h1, unsigned a2, unsigned h2, unsigned a3, unsigned h3) {
    s16x4 x0, y0, x1, y1, x2, y2, x3, y3; const unsigned b0 = a0 + h0, b1 = a1 + h1, b2 = a2 + h2, b3 = a3 + h3;
    asm volatile("ds_read_b64_tr_b16 %0, %8\n\tds_read_b64_tr_b16 %1, %9\n\tds_read_b64_tr_b16 %2, %10\n\tds_read_b64_tr_b16 %3, %11\n\tds_read_b64_tr_b16 %4, %12\n\tds_read_b64_tr_b16 %5, %13\n\tds_read_b64_tr_b16 %6, %14\n\tds_read_b64_tr_b16 %7, %15\n\ts_waitcnt lgkmcnt(0)"
                 : "=&v"(x0), "=&v"(y0), "=&v"(x1), "=&v"(y1), "=&v"(x2), "=&v"(y2), "=&v"(x3), "=&v"(y3) : "v"(a0), "v"(b0), "v"(a1), "v"(b1), "v"(a2), "v"(b2), "v"(a3), "v"(b3) : "memory");
    f0 = tr_join(x0, y0); f1 = tr_join(x1, y1); f2 = tr_join(x2, y2); f3 = tr_join(x3, y3);
}
DI void tr_frag5(bf16x8& f0, bf16x8& f1, bf16x8& f2, bf16x8& f3, bf16x8& f4, unsigned a0, unsigned h0, unsigned a1, unsigned h1, unsigned a2, unsigned h2, unsigned a3, unsigned h3, unsigned a4, unsigned h4) {
    s16x4 x0, y0, x1, y1, x2, y2, x3, y3, x4, y4; const unsigned b0 = a0 + h0, b1 = a1 + h1, b2 = a2 + h2, b3 = a3 + h3, b4 = a4 + h4;
    asm volatile("ds_read_b64_tr_b16 %0, %10\n\tds_read_b64_tr_b16 %1, %11\n\tds_read_b64_tr_b16 %2, %12\n\tds_read_b64_tr_b16 %3, %13\n\tds_read_b64_tr_b16 %4, %14\n\tds_read_b64_tr_b16 %5, %15\n\tds_read_b64_tr_b16 %6, %16\n\tds_read_b64_tr_b16 %7, %17\n\tds_read_b64_tr_b16 %8, %18\n\tds_read_b64_tr_b16 %9, %19\n\ts_waitcnt lgkmcnt(0)"
                 : "=&v"(x0), "=&v"(y0), "=&v"(x1), "=&v"(y1), "=&v"(x2), "=&v"(y2), "=&v"(x3), "=&v"(y3), "=&v"(x4), "=&v"(y4) : "v"(a0), "v"(b0), "v"(a1), "v"(b1), "v"(a2), "v"(b2), "v"(a3), "v"(b3), "v"(a4), "v"(b4) : "memory");
    f0 = tr_join(x0, y0); f1 = tr_join(x1, y1); f2 = tr_join(x2, y2); f3 = tr_join(x3, y3); f4 = tr_join(x4, y4);
}

#define GLA_PREFETCH(ci_) do { const int row0_ = chunk_row0(d, b, (ci_)); \
    _Pragma("unroll") for (int i = 0; i < 2; ++i) { const size_t row_ = (size_t)(row0_ + prow0 + 32 * i); \
        rq[i] = *(const u32x4*)(Qg + row_ * ldq + 8 * ppc); rk[i] = *(const u32x4*)(Kg + row_ * ldk + 8 * ppc); } \
    if (tid < 256) rv = *(const u32x4*)(Vg + (size_t)(row0_ + vrow) * ldv + 8 * vpc); \
    if (MODE != 0) rlam = *(const f32x4*)(LAM + ((size_t)d * NRC + (row0_ >> 6)) * 512 + 128 * hd + 16 * wv + 4 * q); } while (0)

DI float flog(float x) { return __builtin_amdgcn_logf(x) * 0.6931471805599453f; }
#define GLA_GATE_LOAD(ci_) do { const size_t row_ = (size_t)(chunk_row0(d, b, (ci_)) + (d ? 63 - lane : lane)); gi = bf2f(LO[row_ * 512 + 384 + 4 * d + hd]); gf = bf2f(LO[row_ * 512 + 392 + 4 * d + hd]); } while (0)
#define GLA_GATE_COMPUTE(buf_) do { const float li_ = gi + bi, x_ = gf + bfv; float v_ = scan16(-flog(1.f + fexp(-x_))); \
    const float t0_ = __int_as_float(__builtin_amdgcn_readlane(__float_as_int(v_), 15)), t1_ = __int_as_float(__builtin_amdgcn_readlane(__float_as_int(v_), 31)), t2_ = __int_as_float(__builtin_amdgcn_readlane(__float_as_int(v_), 47)); \
    v_ += (q >= 1 ? t0_ : 0.f) + (q >= 2 ? t1_ : 0.f) + (q >= 3 ? t2_ : 0.f); const int rc_ = d ? 63 - lane : lane; LAS float* F_ = Fs + (buf_) * 132; \
    F_[rc_] = fexp(v_) * 0.08838834764831845f; F_[64 + rc_] = fexp(li_ - v_); if (lane == 63) F_[128] = fexp(v_); } while (0)
template <int MODE> DI void gla_unit(const P& p, LAS unsigned char* lds, int unit) {
    constexpr int NDV = MODE == 0 ? 3 : 2;
    const int tid = mk_tid(), lane = tid & 63, wv = __builtin_amdgcn_readfirstlane(tid >> 6), r = lane & 15, q = lane >> 4;
    const int d = unit >> 6, b = (unit >> 4) & 3, hd = (unit >> 2) & 3, sl = unit & 3;
    const bf16_t* COLS = (const bf16_t*)(p.ws + WS_COLS);
    const bf16_t *Qg, *Kg, *Vg; int ldq, ldk, ldv;
    if (MODE == 0) { const bf16_t* ML = COLS + OFF_ML; Qg = ML + 128 * hd; Kg = ML + 512 + 128 * hd; Vg = ML + 1024 + 128 * hd + 32 * sl; ldq = ldk = ldv = 2048; }
    else { Qg = d ? (const bf16_t*)(p.ws + WS_Q1) + 128 * hd : COLS + 128 * hd; ldq = d ? 512 : 3584; Kg = COLS + 512 + 512 * d + 128 * hd; ldk = 3584; Vg = COLS + 1536 + 128 * hd + 32 * sl; ldv = 3584; }
    const bf16_t* LO = COLS + OFF_LO;
    const float* LAM = (const float*)(p.ws + WS_LAM);
    bf16_t* HB = (bf16_t*)(p.ws + WS_ACT);
    LAS bf16_t* Qs = (LAS bf16_t*)(lds + E_QS); LAS bf16_t* Ks = (LAS bf16_t*)(lds + E_KS); LAS bf16_t* Vs = (LAS bf16_t*)(lds + E_VS);
    LAS bf16_t* Ps = (LAS bf16_t*)(lds + E_PS); LAS bf16_t* STs = (LAS bf16_t*)(lds + E_ST); LAS float* Fs = (LAS float*)(lds + E_F);
    const unsigned ks_base = (unsigned)(size_t)Ks, vs_base = (unsigned)(size_t)Vs;
    float bi = 0.f, bfv = 0.f;
    if (MODE == 0) { bi = p.in[I_MBI][d * 4 + hd]; bfv = p.in[I_MBF][d * 4 + hd]; }
    __syncthreads();
    for (int e = tid; e < 48 * PQ / 2; e += NT) ((LAS unsigned*)STs)[e] = 0u;
    for (int e = tid; e < 64 * PV / 2; e += NT) ((LAS unsigned*)Vs)[e] = 0u;
    __syncthreads();
    f32x4 Sacc[NDV];
#pragma unroll
    for (int n = 0; n < NDV; ++n) Sacc[n] = (f32x4){0.f, 0.f, 0.f, 0.f};
    u32x4 rq[2], rk[2], rv = (u32x4){0u, 0u, 0u, 0u}; float gi = 0.f, gf = 0.f; f32x4 rlam = (f32x4){1.f, 1.f, 1.f, 1.f};
    const int prow0 = tid >> 4, ppc = tid & 15;
    const int vrow = tid >> 2, vpc = tid & 3;
    GLA_PREFETCH(0);
    if (MODE == 0) { if (tid < 64) { GLA_GATE_LOAD(0); GLA_GATE_COMPUTE(0); GLA_GATE_LOAD(1); } __syncthreads(); }
    for (int ci = 0; ci < 132; ++ci) {
        const int row0 = chunk_row0(d, b, ci);
        unsigned oz = 0u; asm volatile("" : "+v"(oz));
        const unsigned ks_b = ks_base + oz, vs_b = vs_base + oz;
        f32x4 lamv = rlam;
        const LAS float* Fc = Fs + (ci & 1) * 132;
#pragma unroll
        for (int i = 0; i < 2; ++i) { const int row = prow0 + 32 * i; *(LAS u32x4*)(Qs + row * PQ + 8 * ppc) = rq[i]; *(LAS u32x4*)(Ks + row * PQ + 8 * ppc) = rk[i]; }
        if (tid < 256) {
            if (MODE == 0) { const float w = Fc[64 + vrow]; u32x4 o;
#pragma unroll
                for (int e = 0; e < 4; ++e) o[e] = pack2(__uint_as_float(rv[e] << 16) * w, __uint_as_float(rv[e] & 0xffff0000u) * w);
                *(LAS u32x4*)(Vs + vrow * PV + 8 * vpc) = o;
                if (vpc == 0) Vs[vrow * PV + 32] = f2bf(w); }
            else *(LAS u32x4*)(Vs + vrow * PV + 8 * vpc) = rv;
        }
        __syncthreads();
        if (ci + 1 < 132) GLA_PREFETCH(ci + 1);
        if (MODE == 0) { const float l = Fc[128]; lamv = (f32x4){l, l, l, l};
            if (tid < 64 && ci + 1 < 132) { GLA_GATE_COMPUTE((ci + 1) & 1); if (ci + 2 < 132) GLA_GATE_LOAD(ci + 2); } }
        {
            const int tt = wv & 3, sh = wv >> 2;
            f32x4 pacc[2] = {(f32x4){0.f, 0.f, 0.f, 0.f}, (f32x4){0.f, 0.f, 0.f, 0.f}};
#pragma unroll
            for (int kk = 0; kk < 4; ++kk) { const bf16x8 bq = *(const LAS bf16x8*)(Qs + (16 * tt + r) * PQ + 32 * kk + 8 * q);
#pragma unroll
                for (int i = 0; i < 2; ++i) { const bf16x8 a = *(const LAS bf16x8*)(Ks + (16 * (2 * sh + i) + r) * PQ + 32 * kk + 8 * q); pacc[i] = __builtin_amdgcn_mfma_f32_16x16x32_bf16(a, bq, pacc[i], 0, 0, 0); } }
            const int t = 16 * tt + r;
#pragma unroll
            for (int i = 0; i < 2; ++i) { const int s0 = 16 * (2 * sh + i) + 4 * q; float v[4];
#pragma unroll
                for (int j = 0; j < 4; ++j) { const int s = s0 + j; const bool ok = d ? (s >= t) : (s <= t); v[j] = ok ? pacc[i][j] : 0.f; }
                u32x2 w; w.x = pack2(v[0], v[1]); w.y = pack2(v[2], v[3]); *(LAS u32x2*)(Ps + t * PS + s0) = w; }
        }
        bf16x8 vfr[2][3];
#pragma unroll
        for (int kk = 0; kk < 2; ++kk) { bf16x8 a;
            if (NDV == 3) tr_frag4(a, vfr[kk][0], vfr[kk][1], vfr[kk][2], tr_addr(ks_b, PQ, 32 * kk, 16 * wv, r, q), 8u * PQ, tr_addr(vs_b, PV, 32 * kk, 0, r, q), 8u * PV, tr_addr(vs_b, PV, 32 * kk, 16, r, q), 8u * PV, tr_addr(vs_b, PV, 32 * kk, 32, r, q), 8u * PV);
            else { tr_frag3(a, vfr[kk][0], vfr[kk][1], tr_addr(ks_b, PQ, 32 * kk, 16 * wv, r, q), 8u * PQ, tr_addr(vs_b, PV, 32 * kk, 0, r, q), 8u * PV, tr_addr(vs_b, PV, 32 * kk, 16, r, q), 8u * PV); vfr[kk][2] = vfr[kk][1]; }
#pragma unroll
            for (int n = 0; n < NDV; ++n) Sacc[n] = __builtin_amdgcn_mfma_f32_16x16x32_bf16(a, vfr[kk][n], Sacc[n], 0, 0, 0); }
        __syncthreads();
        {
            const int tt = wv & 3, nA = wv >> 2;
            f32x4 oacc = (f32x4){0.f, 0.f, 0.f, 0.f}, dacc = (f32x4){0.f, 0.f, 0.f, 0.f};
#pragma unroll
            for (int kk = 0; kk < 2; ++kk) { const bf16x8 bp = *(const LAS bf16x8*)(Ps + (16 * tt + r) * PS + 32 * kk + 8 * q);
                const bf16x8 a = nA ? vfr[kk][1] : vfr[kk][0]; oacc = __builtin_amdgcn_mfma_f32_16x16x32_bf16(a, bp, oacc, 0, 0, 0);
                if (MODE == 0) dacc = __builtin_amdgcn_mfma_f32_16x16x32_bf16(vfr[kk][2], bp, dacc, 0, 0, 0); }
#pragma unroll
            for (int kk = 0; kk < 4; ++kk) { const bf16x8 bq = *(const LAS bf16x8*)(Qs + (16 * tt + r) * PQ + 32 * kk + 8 * q);
                const bf16x8 a = *(const LAS bf16x8*)(STs + (16 * nA + r) * PQ + 32 * kk + 8 * q); oacc = __builtin_amdgcn_mfma_f32_16x16x32_bf16(a, bq, oacc, 0, 0, 0);
                if (MODE == 0) { const bf16x8 a2 = *(const LAS bf16x8*)(STs + (32 + r) * PQ + 32 * kk + 8 * q); dacc = __builtin_amdgcn_mfma_f32_16x16x32_bf16(a2, bq, dacc, 0, 0, 0); } }
            const int t = 16 * tt + r;
            float o0 = oacc[0], o1 = oacc[1], o2 = oacc[2], o3 = oacc[3];
            if (MODE == 0) { const float rs = Fc[t]; const float den = __shfl(dacc[0], r) * rs; const float inv = rs / fmaxf(fabsf(den), 1.f); o0 *= inv; o1 *= inv; o2 *= inv; o3 *= inv; }
            u32x2 w; w.x = pack2(o0, o1); w.y = pack2(o2, o3);
            *(u32x2*)(HB + ((size_t)d * NALL + row0 + t) * 512 + 128 * hd + 32 * sl + 16 * nA + 4 * q) = w;
        }
        __syncthreads();
#pragma unroll
        for (int n = 0; n < NDV; ++n) { Sacc[n] = Sacc[n] * lamv; u32x2 w; w.x = pack2(Sacc[n][0], Sacc[n][1]); w.y = pack2(Sacc[n][2], Sacc[n][3]); *(LAS u32x2*)(STs + (16 * n + r) * PQ + 16 * wv + 4 * q) = w; }
    }
    __syncthreads();
}

DI void phase_hgrn_prep(const P& p, LAS unsigned char* ldsb) {
    LAS float* tot = (LAS float*)ldsb;
    const int tid = mk_tid(), ch = tid & 127, qt = tid >> 7;
    bf16_t* C1 = (bf16_t*)(p.ws + WS_COLS); bf16_t* Q1 = (bf16_t*)(p.ws + WS_Q1); float* LAM = (float*)(p.ws + WS_LAM);
    for (int vb = blockIdx.x; vb < NRC * 4; vb += gridDim.x) {
        const int rc = vb >> 2, hd = vb & 3, c = 128 * hd + ch; const size_t rbase = (size_t)rc * 64 + 16 * qt;
        const float lb = sigm(p.in[I_HLB][512 + c] - p.in[I_HLB][c]);
        float qv[16], l0[16], l1[16], k0[16], k1[16];
#pragma unroll
        for (int i = 0; i < 16; ++i) { const bf16_t* base = C1 + (rbase + i) * 3584;
            qv[i] = siluf(bf2f(base[c])); const float s0 = sigm(bf2f(base[512 + c])), s1 = sigm(bf2f(base[1024 + c]));
            l0[i] = logf(lb + (1.f - lb) * s0); l1[i] = logf(lb + (1.f - lb) * s1); k0[i] = (1.f - lb) * (1.f - s0); k1[i] = (1.f - lb) * (1.f - s1); }
#pragma unroll
        for (int i = 1; i < 16; ++i) l0[i] += l0[i - 1];
#pragma unroll
        for (int i = 14; i >= 0; --i) l1[i] += l1[i + 1];
        __syncthreads();
        tot[qt * 128 + ch] = l0[15]; tot[512 + qt * 128 + ch] = l1[0];
        __syncthreads();
        float off0 = 0.f, off1 = 0.f, t0 = 0.f, t1 = 0.f;
#pragma unroll
        for (int j = 0; j < 4; ++j) { const float a = tot[j * 128 + ch], bb = tot[512 + j * 128 + ch]; t0 += a; t1 += bb; if (j < qt) off0 += a; if (j > qt) off1 += bb; }
#pragma unroll
        for (int i = 0; i < 16; ++i) { bf16_t* base = C1 + (rbase + i) * 3584; const float c0 = l0[i] + off0, c1 = l1[i] + off1;
            base[c] = f2bf(qv[i] * expf(c0)); base[512 + c] = f2bf(k0[i] * expf(-c0)); base[1024 + c] = f2bf(k1[i] * expf(-c1)); Q1[(rbase + i) * 512 + c] = f2bf(qv[i] * expf(c1)); }
        if (qt == 0) { LAM[((size_t)rc) * 512 + c] = expf(t0); LAM[((size_t)NRC + rc) * 512 + c] = expf(t1); }
    }
    __syncthreads();
}
DI void phase_hgrn_prep2(const P& p, LAS unsigned char* ldsb) {
    LAS float* tot = (LAS float*)ldsb;
    const int tid = mk_tid(), cp = tid & 63, qt = (tid >> 6) & 3, rs = tid >> 8, c0 = 8 * cp;
    bf16_t* C1 = (bf16_t*)(p.ws + WS_COLS); bf16_t* Q1 = (bf16_t*)(p.ws + WS_Q1); float* LAM = (float*)(p.ws + WS_LAM);
    float lb[8], omlb[8];
#pragma unroll
    for (int k = 0; k < 8; ++k) { lb[k] = fsigm(p.in[I_HLB][512 + c0 + k] - p.in[I_HLB][c0 + k]); omlb[k] = 1.f - lb[k]; }
    for (int vb = blockIdx.x; vb < NRC / 2; vb += gridDim.x) {
        const int rc = 2 * vb + rs; const size_t rbase = (size_t)rc * 64 + 16 * qt;
        float s0[8], s1[8];
#pragma unroll
        for (int k = 0; k < 8; ++k) { s0[k] = 0.f; s1[k] = 0.f; }
#pragma unroll 4
        for (int i = 0; i < 16; ++i) { const bf16_t* base = C1 + (rbase + i) * 3584; const u32x4 f0 = *(const u32x4*)(base + 512 + c0), f1 = *(const u32x4*)(base + 1024 + c0);
#pragma unroll
            for (int k = 0; k < 4; ++k) { s0[2 * k] += flog(lb[2 * k] + omlb[2 * k] * fsigm(__uint_as_float(f0[k] << 16))); s0[2 * k + 1] += flog(lb[2 * k + 1] + omlb[2 * k + 1] * fsigm(__uint_as_float(f0[k] & 0xffff0000u)));
                s1[2 * k] += flog(lb[2 * k] + omlb[2 * k] * fsigm(__uint_as_float(f1[k] << 16))); s1[2 * k + 1] += flog(lb[2 * k + 1] + omlb[2 * k + 1] * fsigm(__uint_as_float(f1[k] & 0xffff0000u))); } }
        __syncthreads();
#pragma unroll
        for (int k = 0; k < 8; k += 4) { *(LAS f32x4*)(tot + ((rs * 2 + 0) * 4 + qt) * 512 + c0 + k) = (f32x4){s0[k], s0[k + 1], s0[k + 2], s0[k + 3]}; *(LAS f32x4*)(tot + ((rs * 2 + 1) * 4 + qt) * 512 + c0 + k) = (f32x4){s1[k], s1[k + 1], s1[k + 2], s1[k + 3]}; }
        __syncthreads();
        float run0[8], run1[8], t0[8], t1[8];
#pragma unroll
        for (int k = 0; k < 8; ++k) { run0[k] = 0.f; run1[k] = 0.f; t0[k] = 0.f; t1[k] = 0.f; }
#pragma unroll
        for (int j = 0; j < 4; ++j)
#pragma unroll
            for (int k = 0; k < 8; ++k) { const float a = tot[((rs * 2 + 0) * 4 + j) * 512 + c0 + k], bb = tot[((rs * 2 + 1) * 4 + j) * 512 + c0 + k]; t0[k] += a; t1[k] += bb; if (j < qt) run0[k] += a; if (j >= qt) run1[k] += bb; }
        if (qt == 0) {
#pragma unroll
            for (int k = 0; k < 8; k += 4) { *(f32x4*)(LAM + (size_t)rc * 512 + c0 + k) = (f32x4){fexp(t0[k]), fexp(t0[k + 1]), fexp(t0[k + 2]), fexp(t0[k + 3])};
                *(f32x4*)(LAM + ((size_t)NRC + rc) * 512 + c0 + k) = (f32x4){fexp(t1[k]), fexp(t1[k + 1]), fexp(t1[k + 2]), fexp(t1[k + 3])}; } }
#pragma unroll 2
        for (int i = 0; i < 16; ++i) { bf16_t* base = C1 + (rbase + i) * 3584; const u32x4 qv = *(const u32x4*)(base + c0), f0 = *(const u32x4*)(base + 512 + c0), f1 = *(const u32x4*)(base + 1024 + c0);
            float oq0[8], ok0[8], ok1[8], oq1[8];
#pragma unroll
            for (int k = 0; k < 8; ++k) { const unsigned wq = qv[k >> 1], w0 = f0[k >> 1], w1 = f1[k >> 1];
                const float qx = (k & 1) ? __uint_as_float(wq & 0xffff0000u) : __uint_as_float(wq << 16), x0 = (k & 1) ? __uint_as_float(w0 & 0xffff0000u) : __uint_as_float(w0 << 16), x1 = (k & 1) ? __uint_as_float(w1 & 0xffff0000u) : __uint_as_float(w1 << 16);
                const float sq = qx * fsigm(qx), sg0 = fsigm(x0), sg1 = fsigm(x1);
                const float l0 = flog(lb[k] + omlb[k] * sg0), l1 = flog(lb[k] + omlb[k] * sg1);
                run0[k] += l0;
                const float cb = run1[k];
                run1[k] -= l1;
                const float e0 = fexp(run0[k]), e1 = fexp(cb);
                oq0[k] = sq * e0; ok0[k] = omlb[k] * (1.f - sg0) * frcp(e0); ok1[k] = omlb[k] * (1.f - sg1) * frcp(e1); oq1[k] = sq * e1; }
            u32x4 w; w.x = pack2(oq0[0], oq0[1]); w.y = pack2(oq0[2], oq0[3]); w.z = pack2(oq0[4], oq0[5]); w.w = pack2(oq0[6], oq0[7]); *(u32x4*)(base + c0) = w;
            w.x = pack2(ok0[0], ok0[1]); w.y = pack2(ok0[2], ok0[3]); w.z = pack2(ok0[4], ok0[5]); w.w = pack2(ok0[6], ok0[7]); *(u32x4*)(base + 512 + c0) = w;
            w.x = pack2(ok1[0], ok1[1]); w.y = pack2(ok1[2], ok1[3]); w.z = pack2(ok1[4], ok1[5]); w.w = pack2(ok1[6], ok1[7]); *(u32x4*)(base + 1024 + c0) = w;
            w.x = pack2(oq1[0], oq1[1]); w.y = pack2(oq1[2], oq1[3]); w.z = pack2(oq1[4], oq1[5]); w.w = pack2(oq1[6], oq1[7]); *(u32x4*)(Q1 + (rbase + i) * 512 + c0) = w; }
    }
    __syncthreads();
}
constexpr int XBP = 68, M_XB = 0, M_XCS = M_XB + 67 * XBP * 4, M_XCF = M_XCS + 64 * 72 * 2, M_W = M_XCF + 64 * 64 * 4, M_AU = M_W + 4 * 64 * 72 * 2, M_SEG = M_AU + 4 * 64 * 65 * 4, M_PRM = M_SEG + 4 * 8 * 64 * 4,
              M_CAR = M_PRM + 11 * 64 * 4, M_END = M_CAR + 2 * 64 * 4;
static_assert(M_END <= LDS_BYTES, "lru LDS map");
DI float nexpm1_small(float x) { const float ser = -x * (1.f + x * 0.5f * (1.f + x * (1.f / 3.f) * (1.f + x * 0.25f * (1.f + x * 0.2f)))); return (x > -0.25f) ? ser : 1.f - fexp(x); }
DI int lru_rc_at(int d, int b, int s) { if (s < 4) return 512 + 4 * b + (d ? 3 - s : s); const int lc = s - 4; return 128 * b + (d ? 127 - lc : lc); }
template <int PASS> DI void lru_pass(const P& p, LAS unsigned char* lds, const int lb, const int nlb) {
    const int tid = mk_tid(), lane = tid & 63, wv = __builtin_amdgcn_readfirstlane(tid >> 6), r = lane & 15, q = lane >> 4;
    const int hb = lb & 7;
    const bf16_t* C1 = (const bf16_t*)(p.ws + WS_COLS); bf16_t* Y = (bf16_t*)(p.ws + WS_Z); float* LSUM = (float*)(p.ws + WS_LSUM);
    LAS float* XB = (LAS float*)(lds + M_XB); LAS bf16_t* XCs = (LAS bf16_t*)(lds + M_XCS); LAS float* XCf = (LAS float*)(lds + M_XCF); LAS bf16_t* Wt = (LAS bf16_t*)(lds + M_W);
    LAS float* AU = (LAS float*)(lds + M_AU);
    LAS float* SEG = (LAS float*)(lds + M_SEG);
    LAS float* prm = (LAS float*)(lds + M_PRM);
    LAS float* CAR = (LAS float*)(lds + M_CAR);
    __syncthreads();
    for (int e = tid; e < 4 * 4096; e += NT) { const int g = e >> 12, i = (e >> 6) & 63, j = e & 63, d = g >> 1; const size_t o = ((size_t)(d * 8 + hb) * 64 + i) * 64 + j;
        Wt[(g * 64 + j) * 72 + i] = f2bf((g & 1) ? p.in[I_WI][o] : p.in[I_WA][o]); }
    if (tid < 64) { const int ch = 64 * hb + tid;
        prm[tid] = p.in[I_CONVW][ch]; prm[64 + tid] = p.in[I_CONVW][512 + ch]; prm[128 + tid] = p.in[I_CONVW][1024 + ch]; prm[192 + tid] = p.in[I_CONVW][1536 + ch]; prm[256 + tid] = p.in[I_CONVB][ch];
        prm[320 + tid] = p.in[I_BA][ch]; prm[384 + tid] = p.in[I_BA][512 + ch]; prm[448 + tid] = p.in[I_BI][ch]; prm[512 + tid] = p.in[I_BI][512 + ch];
        prm[576 + tid] = log1pf(expf(-p.in[I_LAM][ch])); prm[640 + tid] = log1pf(expf(-p.in[I_LAM][512 + ch])); }
    const int nrc = (PASS == 1) ? NRC : 512;
    const int cpr = (PASS == 3) ? 512 / (nlb >> 3) : 1, rc_lo = (PASS == 3) ? (lb >> 3) * cpr : (lb >> 3), rstep = (PASS == 3) ? 1 : (nlb >> 3), rc_hi = (PASS == 3) ? rc_lo + cpr : nrc;
    float* LCAR = (float*)(p.ws + WS_LCAR);
    if (PASS == 3 && tid < 128) { const int d = tid >> 6, j = tid & 63, ch = 64 * hb + j, b = rc_lo >> 7, cl0 = rc_lo & 127;
        const int p_lo = d ? 4 + 127 - (cl0 + cpr - 1) : 4 + cl0;
        const float* S = LSUM + (size_t)d * NRC * 1024 + 2 * ch; float hcar = 0.f;
#pragma unroll 8
        for (int s = 0; s < p_lo; ++s) { const float* e2 = S + (size_t)lru_rc_at(d, b, s) * 1024; hcar = e2[0] * hcar + e2[1]; }
        for (int s = p_lo; s < p_lo + cpr; ++s) { const int rcs = lru_rc_at(d, b, s); LCAR[((size_t)d * NRC + rcs) * 512 + ch] = hcar; const float* e2 = S + (size_t)rcs * 1024; hcar = e2[0] * hcar + e2[1]; }
    }
    u32x4 px[2];
#define LRU_PREFETCH(rc_) do { const int rc__ = (rc_); const int row0_ = rc__ * 64; const int seg_lo_ = (rc__ >= 512) ? NLAT + ((rc__ - 512) >> 2) * LC : (rc__ >> 7) * L, seg_hi_ = seg_lo_ + ((rc__ >= 512) ? LC : L); \
    _Pragma("unroll") for (int i = 0; i < 2; ++i) { const int e = tid + 512 * i, rr = e >> 3, pc = e & 7, grow = row0_ - 2 + rr; px[i] = (u32x4){0u, 0u, 0u, 0u}; \
        if (e < 67 * 8 && grow >= seg_lo_ && grow < seg_hi_) px[i] = *(const u32x4*)(C1 + (size_t)grow * C1LD + 2560 + 64 * hb + 8 * pc); } } while (0)
    int rc = rc_lo;
    if (rc < rc_hi) LRU_PREFETCH(rc);
    for (; rc < rc_hi; rc += rstep) {
        const int row0 = rc * 64;
        const int sg = tid >> 6, j = lane, ch = 64 * hb + j;
        float cin = 0.f;
        if (PASS == 3 && tid < 128) cin = LCAR[((size_t)(tid >> 6) * NRC + rc) * 512 + ch];
        float gbv[8];
        if (PASS == 3) {
#pragma unroll
            for (int k = 0; k < 8; ++k) gbv[k] = bf2f(C1[(size_t)(row0 + 8 * sg + k) * C1LD + 3072 + ch]); }
#pragma unroll
        for (int i = 0; i < 2; ++i) { const int e = tid + 512 * i; if (e < 67 * 8) { const int rr = e >> 3, pc = e & 7; const u32x4 v = px[i];
            f32x4 lo, hi; lo[0] = __uint_as_float(v[0] << 16); lo[1] = __uint_as_float(v[0] & 0xffff0000u); lo[2] = __uint_as_float(v[1] << 16); lo[3] = __uint_as_float(v[1] & 0xffff0000u);
            hi[0] = __uint_as_float(v[2] << 16); hi[1] = __uint_as_float(v[2] & 0xffff0000u); hi[2] = __uint_as_float(v[3] << 16); hi[3] = __uint_as_float(v[3] & 0xffff0000u);
            *(LAS f32x4*)(XB + rr * XBP + 8 * pc) = lo; *(LAS f32x4*)(XB + rr * XBP + 8 * pc + 4) = hi; } }
        if (PASS == 3 && tid < 128) CAR[tid] = cin;
        __syncthreads();
        if (rc + rstep < rc_hi) LRU_PREFETCH(rc + rstep);
        {
            const int t = tid >> 3, i0 = 8 * (tid & 7); float xc[8];
#pragma unroll
            for (int c = 0; c < 8; ++c) { const int i = i0 + c; xc[c] = prm[256 + i] + prm[i] * XB[t * XBP + i] + prm[64 + i] * XB[(t + 1) * XBP + i] + prm[128 + i] * XB[(t + 2) * XBP + i] + prm[192 + i] * XB[(t + 3) * XBP + i]; XCf[t * 64 + i] = xc[c]; }
            u32x4 w; w.x = pack2(xc[0], xc[1]); w.y = pack2(xc[2], xc[3]); w.z = pack2(xc[4], xc[5]); w.w = pack2(xc[6], xc[7]);
            *(LAS u32x4*)(XCs + t * 72 + i0) = w;
        }
        __syncthreads();
        {
            const int jt = wv & 3, th = wv >> 2, jc = 16 * jt + r;
#pragma unroll
            for (int d = 0; d < 2; ++d) { const float ba = prm[320 + 64 * d + jc], bi = prm[448 + 64 * d + jc], spl = prm[576 + 64 * d + jc];
#pragma unroll
                for (int i2 = 0; i2 < 2; ++i2) { const int tt = 2 * th + i2;
                    f32x4 aa = (f32x4){0.f, 0.f, 0.f, 0.f}, ai = (f32x4){0.f, 0.f, 0.f, 0.f};
#pragma unroll
                    for (int kk = 0; kk < 2; ++kk) { const bf16x8 xf = *(const LAS bf16x8*)(XCs + (16 * tt + r) * 72 + 32 * kk + 8 * q);
                        const bf16x8 wa = *(const LAS bf16x8*)(Wt + ((2 * d) * 64 + 16 * jt + r) * 72 + 32 * kk + 8 * q), wi = *(const LAS bf16x8*)(Wt + ((2 * d + 1) * 64 + 16 * jt + r) * 72 + 32 * kk + 8 * q);
                        aa = __builtin_amdgcn_mfma_f32_16x16x32_bf16(xf, wa, aa, 0, 0, 0); ai = __builtin_amdgcn_mfma_f32_16x16x32_bf16(xf, wi, ai, 0, 0, 0); }
#pragma unroll
                    for (int jj = 0; jj < 4; ++jj) { const int t = 16 * tt + 4 * q + jj;
                        const float rg = fsigm(aa[jj] + ba), ig = fsigm(ai[jj] + bi), la = -8.f * rg * spl;
                        const float a = fexp(la);
                        AU[((2 * d) * 64 + t) * 65 + jc] = a; AU[((2 * d + 1) * 64 + t) * 65 + jc] = __builtin_amdgcn_sqrtf(fmaxf(fmaf(-a, a, 1.f), 0.f)) * (ig * XCf[t * 64 + jc]); } } }
        }
        __syncthreads();
        const LAS float* A0 = AU + (8 * sg) * 65 + j; const LAS float* U0 = AU + (64 + 8 * sg) * 65 + j; const LAS float* A1 = AU + (128 + 8 * sg) * 65 + j; const LAS float* U1 = AU + (192 + 8 * sg) * 65 + j;
        {
            float p0 = 1.f, h0 = 0.f, p1 = 1.f, h1 = 0.f;
#pragma unroll
            for (int k = 0; k < 8; ++k) { const float a = A0[k * 65]; h0 = a * h0 + U0[k * 65]; p0 *= a; }
#pragma unroll
            for (int k = 7; k >= 0; --k) { const float a = A1[k * 65]; h1 = a * h1 + U1[k * 65]; p1 *= a; }
            SEG[(0 * 8 + sg) * 64 + j] = p0; SEG[(1 * 8 + sg) * 64 + j] = h0; SEG[(2 * 8 + sg) * 64 + j] = p1; SEG[(3 * 8 + sg) * 64 + j] = h1;
        }
        __syncthreads();
        if (PASS == 1) {
            if (tid < 128) { const int d = tid >> 6; float pa = 1.f, hh = 0.f;
#pragma unroll
                for (int s2 = 0; s2 < 8; ++s2) { const int sgi = d ? 7 - s2 : s2; const float ps = SEG[((2 * d) * 8 + sgi) * 64 + j], hs = SEG[((2 * d + 1) * 8 + sgi) * 64 + j]; hh = ps * hh + hs; pa *= ps; }
                float* o = LSUM + ((size_t)d * NRC + rc) * 1024 + 2 * ch; o[0] = pa; o[1] = hh; }
        } else {
            float hf = CAR[j], hbk = CAR[64 + j];
            for (int s2 = 0; s2 < sg; ++s2) hf = SEG[(0 * 8 + s2) * 64 + j] * hf + SEG[(1 * 8 + s2) * 64 + j];
            for (int s2 = 7; s2 > sg; --s2) hbk = SEG[(2 * 8 + s2) * 64 + j] * hbk + SEG[(3 * 8 + s2) * 64 + j];
            float of[8];
#pragma unroll
            for (int k = 0; k < 8; ++k) { hf = A0[k * 65] * hf + U0[k * 65]; of[k] = hf; }
#pragma unroll
            for (int k = 7; k >= 0; --k) { hbk = A1[k * 65] * hbk + U1[k * 65]; of[k] += hbk; }
#pragma unroll
            for (int k = 0; k < 8; ++k) Y[(size_t)nat_row(row0 + 8 * sg + k) * D + 512 + ch] = f2bf(of[k] * fgelu(gbv[k]));
        }
        __syncthreads();
    }
#undef LRU_PREFETCH
}
constexpr int PT = 72, PM = 40;
constexpr int C_PRM = 0, C_GAM = C_PRM + 3072, C_MISC = C_GAM + 1024, C_SBF = C_MISC + 1280, C_TILES = C_SBF + 2 * 64 * PT * 2, C_TH = C_TILES + 5 * 80 * PT * 2, C_MBF = C_TH + 2 * 64 * PT * 2,
              C_SM = C_MBF + 4 * 16 * 20 * 4, C_W1T = C_SM + 4 * 4 * 16 * PM * 2, C_AH = C_W1T + 4 * 64 * PM * 2, C_YV = C_AH + 4 * 16 * PT * 2, C_END = C_YV + 64 * PM * 2;
static_assert(C_END <= LDS_BYTES, "rwkv chunk LDS map");
DI void unpack4(u32x2 v, float* o) { o[0] = __uint_as_float(v.x << 16); o[1] = __uint_as_float(v.x & 0xffff0000u); o[2] = __uint_as_float(v.y << 16); o[3] = __uint_as_float(v.y & 0xffff0000u); }
DI u32x2 pack4(float a, float b, float c, float d) { u32x2 w; w.x = pack2(a, b); w.y = pack2(c, d); return w; }
DI bf16x8 zero_if(bf16x8 v, bool z) { const bf16x8 zz = {0, 0, 0, 0, 0, 0, 0, 0}; return z ? zz : v; }

constexpr int RING_SLOTS = 4, SLOT_U64 = 7936;
constexpr int S_GAM = 4096, S_BS = 4224, S_AH = 4256, S_NK = 5280, S_NB = 5536, S_YH = 5792, S_END = 7840;
DI int slot_lds(int e) {
    if (e < S_GAM) return C_TILES + ((e >> 10) + 1) * (80 * PT * 2) + ((e >> 4) & 63) * (PT * 2) + (e & 15) * 8;
    if (e < S_BS) return C_GAM + (e - S_GAM) * 8;
    if (e < S_AH) return C_MISC + 1024 + (e - S_BS) * 8;
    if (e < S_NK) { const int x = e - S_AH; return C_AH + (x >> 4) * (PT * 2) + (x & 15) * 8; }
    if (e < S_NB) { const int x = e - S_NK; return C_SM + 4 * 16 * PM * 2 + (x >> 2) * (PM * 2) + (x & 3) * 8; }
    const int x = e - S_NB; return C_SM + 2 * 4 * 16 * PM * 2 + (x >> 2) * (PM * 2) + (x & 3) * 8;
}
constexpr size_t WS_RING = WS_Z1;
DI void wait_ge(unsigned* word, unsigned want) {
    unsigned spins = 0;
    while ((unsigned)__builtin_amdgcn_readfirstlane((int)__hip_atomic_load(word, __ATOMIC_RELAXED, __HIP_MEMORY_SCOPE_AGENT)) < want) { __builtin_amdgcn_s_sleep(2); if (++spins > (1u << 21)) break; }
    __builtin_amdgcn_fence(__ATOMIC_ACQUIRE, "agent");
    asm volatile("s_waitcnt vmcnt(0)" ::: "memory");
}
template <int ROLE> DI void rwkv_chunk_unit(const P& p, LAS unsigned char* lds, const int vb, const int hs = 0) {
    const int tid = mk_tid(), lane = tid & 63, wv = __builtin_amdgcn_readfirstlane(tid >> 6), r = lane & 15, q = lane >> 4;
    const int d = vb >> 5, b = (vb >> 3) & 3, h = vb & 7;
    const bf16_t* RW = (const bf16_t*)(p.ws + WS_COLS) + OFF_RW; const bf16_t* LO = (const bf16_t*)(p.ws + WS_COLS) + OFF_LO; bf16_t* Z = (bf16_t*)(p.ws + WS_Z);
    unsigned long long* ring = (unsigned long long*)(p.ws + WS_RING) + (size_t)vb * RING_SLOTS * SLOT_U64;
    unsigned* READY0 = (unsigned*)(p.ws + WS_CTL) + 64 * vb; unsigned* READY1 = (unsigned*)(p.ws + WS_CTL) + 64 * (192 + vb); unsigned* ACK = (unsigned*)(p.ws + WS_CTL) + 64 * (64 + vb);
    unsigned* READYH = hs ? READY1 : READY0;
    LAS float* prm = (LAS float*)(lds + C_PRM); LAS float* GAM = (LAS float*)(lds + C_GAM); LAS float* SSQ = (LAS float*)(lds + C_MISC); LAS float* BSP = SSQ + 128; LAS float* BS = SSQ + 256;
    LAS bf16_t* Sbf = (LAS bf16_t*)(lds + C_SBF);
    LAS bf16_t* At = (LAS bf16_t*)(lds + C_TILES); LAS bf16_t* Rt = At + 80 * PT; LAS bf16_t* Bt = Rt + 80 * PT; LAS bf16_t* Kt = Bt + 80 * PT; LAS bf16_t* Vt = Kt + 80 * PT;
    LAS bf16_t* TH = (LAS bf16_t*)(lds + C_TH); LAS bf16_t* AD = TH + 64 * PT; LAS float* OUT = (LAS float*)(lds + C_TH);
    LAS float* MBf = (LAS float*)(lds + C_MBF);
    LAS bf16_t* MK = (LAS bf16_t*)(lds + C_SM); LAS bf16_t* NK = MK + 4 * 16 * PM; LAS bf16_t* NB = NK + 4 * 16 * PM; LAS bf16_t* DNV = NB + 4 * 16 * PM;
    LAS bf16_t* W1T = (LAS bf16_t*)(lds + C_W1T); LAS bf16_t* AH = (LAS bf16_t*)(lds + C_AH); LAS bf16_t* YV = (LAS bf16_t*)(lds + C_YV);
    const unsigned at_b = (unsigned)(size_t)At, bt_b = (unsigned)(size_t)Bt, kt_b = (unsigned)(size_t)Kt, vt_b = (unsigned)(size_t)Vt;
    __syncthreads();
    for (int e = tid; e < (C_END - C_SBF) / 4; e += NT) ((LAS unsigned*)(lds + C_SBF))[e] = 0u;
    if (tid < 64) { const int j = tid, c = 64 * h + j; const float* mu = p.in[I_MU] + d * 1664;
        prm[j] = mu[c]; prm[64 + j] = mu[512 + c]; prm[128 + j] = mu[1024 + c]; prm[192 + j] = mu[1536 + j]; prm[256 + j] = mu[1600 + j];
        prm[320 + j] = p.in[I_W0][d * 512 + c]; prm[384 + j] = p.in[I_A0][d * 512 + c]; prm[448 + j] = p.in[I_KK][d * 512 + c]; prm[512 + j] = p.in[I_KA][d * 512 + c];
        prm[576 + j] = p.in[I_RK][(d * 8 + h) * 64 + j]; prm[640 + j] = p.in[I_LNW][d * 512 + c]; prm[704 + j] = p.in[I_LNB][d * 512 + c]; }
    const int m1 = wv & 3, h2 = wv >> 2, cb8 = 32 * h2 + 8 * q;
    bf16x8 fw2[2][2], fa2[2][2];
    if (ROLE != 1) {
#pragma unroll
    for (int t = 0; t < 2; ++t)
#pragma unroll
        for (int kk = 0; kk < 2; ++kk) { const int c = 64 * h + 32 * h2 + 8 * (r >> 2) + 4 * t + (r & 3);
            const float* w2p = p.in[I_W2L] + (size_t)(d * 64 + 32 * kk + 8 * q) * 512 + c; const float* a2p = p.in[I_A2L] + (size_t)(d * 64 + 32 * kk + 8 * q) * 512 + c;
#pragma unroll
            for (int e = 0; e < 8; ++e) { fw2[t][kk][e] = (short)f2bf(w2p[e * 512]); fa2[t][kk][e] = (short)f2bf(a2p[e * 512]); }
            asm volatile("" ::: "memory"); }
    }
    f32x4 Sacc[2] = {(f32x4){0.f, 0.f, 0.f, 0.f}, (f32x4){0.f, 0.f, 0.f, 0.f}};
    int cur = 0;
    unsigned ack_seen = 0u;
    unsigned long long pf[12]; f32x4 yh[4]; bool pf_ok = false;
    u32x4 gc[5], gp[5];
#define RWKV_LOAD(n0x) do { const int n1_ = (n0x) + 16 * m1 + r; const bool hp_ = (n1_ != 0) && (n1_ != LC); const unsigned row_ = (unsigned)step_row(d, b, n1_), prow_ = hp_ ? (unsigned)step_row(d, b, n1_ - 1) : row_; \
    const unsigned rwc_ = row_ * 1536u + 64u * h + cb8, rwp_ = prow_ * 1536u + 64u * h + cb8, loc_ = row_ * 512u + 64u * d + cb8, lop_ = prow_ * 512u + 64u * d + cb8; \
    gc[0] = *(const u32x4*)(RW + rwc_); gc[1] = *(const u32x4*)(RW + rwc_ + 512u); gc[2] = *(const u32x4*)(RW + rwc_ + 1024u); gc[3] = *(const u32x4*)(LO + loc_); gc[4] = *(const u32x4*)(LO + loc_ + 128u); \
    gp[0] = *(const u32x4*)(RW + rwp_); gp[1] = *(const u32x4*)(RW + rwp_ + 512u); gp[2] = *(const u32x4*)(RW + rwp_ + 1024u); gp[3] = *(const u32x4*)(LO + lop_); gp[4] = *(const u32x4*)(LO + lop_ + 128u); } while (0)
    const int n0_start = (ROLE == 2) ? 64 * hs : 0, n0_step = (ROLE == 2) ? 128 : 64;
    if (ROLE != 1) RWKV_LOAD(n0_start);
    __syncthreads();
    for (int n0 = n0_start; n0 < LT; n0 += n0_step) {
        if (ROLE != 1) for (int rep0 = 0; rep0 < (MK_RDUP == 0 ? 2 : 1); ++rep0) {
        const int u1 = 16 * m1 + r, n1 = n0 + u1; const bool hp = (n1 != 0) && (n1 != LC);
        float rs[8], ks[8], vs[8];
        {
            float a0[8], a1[8], th[8], ad[8];
#define UNPACK8(v, o) { _Pragma("unroll") for (int k_ = 0; k_ < 4; ++k_) { o[2 * k_] = __uint_as_float(v[k_] << 16); o[2 * k_ + 1] = __uint_as_float(v[k_] & 0xffff0000u); } }
#define RW_SHIFT(dst, idx, muo) { const u32x4 pz = hp ? gp[idx] : (u32x4){0u, 0u, 0u, 0u}; UNPACK8(gc[idx], a0) UNPACK8(pz, a1) \
            const f32x4 mu0 = *(const LAS f32x4*)(prm + (muo) + cb8), mu1 = *(const LAS f32x4*)(prm + (muo) + cb8 + 4); \
            _Pragma("unroll") for (int e = 0; e < 4; ++e) { dst[e] = a0[e] + mu0[e] * (a1[e] - a0[e]); dst[4 + e] = a0[4 + e] + mu1[e] * (a1[4 + e] - a0[4 + e]); } }
            RW_SHIFT(th, 3, 192) asm volatile("" ::: "memory"); RW_SHIFT(ad, 4, 256) asm volatile("" ::: "memory"); RW_SHIFT(rs, 0, 0) asm volatile("" ::: "memory"); RW_SHIFT(ks, 1, 64) asm volatile("" ::: "memory"); RW_SHIFT(vs, 2, 128)
#undef RW_SHIFT
#pragma unroll
            for (int e = 0; e < 8; ++e) th[e] = ftanh(th[e]);
            u32x4 w; w.x = pack2(th[0], th[1]); w.y = pack2(th[2], th[3]); w.z = pack2(th[4], th[5]); w.w = pack2(th[6], th[7]); *(LAS u32x4*)(TH + u1 * PT + cb8) = w;
            w.x = pack2(ad[0], ad[1]); w.y = pack2(ad[2], ad[3]); w.z = pack2(ad[4], ad[5]); w.w = pack2(ad[6], ad[7]); *(LAS u32x4*)(AD + u1 * PT + cb8) = w;
            asm volatile("" ::: "memory");
        }
        __syncthreads();
        float elog[8], av[8], kkr[8], km[8]; float ssq = 0.f, bsp = 0.f;
#pragma unroll
        for (int t = 0; t < 2; ++t) {
            f32x4 xw = (f32x4){0.f, 0.f, 0.f, 0.f}, xa = (f32x4){0.f, 0.f, 0.f, 0.f};
#pragma unroll
            for (int kk = 0; kk < 2; ++kk) { const bf16x8 bt = *(const LAS bf16x8*)(TH + u1 * PT + 32 * kk + 8 * q), ba = *(const LAS bf16x8*)(AD + u1 * PT + 32 * kk + 8 * q);
                xw = __builtin_amdgcn_mfma_f32_16x16x32_bf16(fw2[t][kk], bt, xw, 0, 0, 0); xa = __builtin_amdgcn_mfma_f32_16x16x32_bf16(fa2[t][kk], ba, xa, 0, 0, 0); }
            const int cb = cb8 + 4 * t;
            const f32x4 w04 = *(const LAS f32x4*)(prm + 320 + cb), a04 = *(const LAS f32x4*)(prm + 384 + cb), kk4 = *(const LAS f32x4*)(prm + 448 + cb), ka4 = *(const LAS f32x4*)(prm + 512 + cb), rk4 = *(const LAS f32x4*)(prm + 576 + cb);
#pragma unroll
            for (int jj = 0; jj < 4; ++jj) { const int e = 4 * t + jj;
                elog[e] = 0.6065306597126334f * fsigm(xw[jj] + w04[jj]); av[e] = fsigm(xa[jj] + a04[jj]);
                kkr[e] = ks[e] * kk4[jj]; ssq += kkr[e] * kkr[e]; km[e] = ks[e] * (1.f + (av[e] - 1.f) * ka4[jj]); bsp += rs[e] * km[e] * rk4[jj]; }
            asm volatile("" ::: "memory");
        }
        ssq += __shfl_xor(ssq, 16); ssq += __shfl_xor(ssq, 32); bsp += __shfl_xor(bsp, 16); bsp += __shfl_xor(bsp, 32);
        if (q == 0) { SSQ[h2 * 64 + u1] = ssq; BSP[h2 * 64 + u1] = bsp; }
        __syncthreads();
        {
            const float tot = SSQ[u1] + SSQ[64 + u1]; const float inv = 1.f / fmaxf(sqrtf(tot), 1e-12f);
            if (h2 == 0 && q == 0) BS[u1] = BSP[u1] + BSP[64 + u1];
            float al[8], be[8], ka[8], rh[8];
#pragma unroll
            for (int e = 0; e < 8; ++e) {
                const float g = scan16(-elog[e]);
                const float ep = fexp(g), em = frcp(ep), epp = fexp(g + elog[e]);
                const float kk = kkr[e] * inv;
                al[e] = kk * epp; be[e] = kk * av[e] * em; ka[e] = km[e] * em; rh[e] = rs[e] * ep;
                if (r == 15) GAM[m1 * 64 + cb8 + e] = ep; }
            u32x4 w;
#define ST8(T, v) w.x = pack2(v[0], v[1]); w.y = pack2(v[2], v[3]); w.z = pack2(v[4], v[5]); w.w = pack2(v[6], v[7]); *(LAS u32x4*)(T + u1 * PT + cb8) = w;
            ST8(At, al) ST8(Bt, be) ST8(Kt, ka) ST8(Rt, rh) ST8(Vt, vs)
#undef ST8
        }
        __syncthreads();
        }
        if (ROLE == 0 && n0 + 64 < LT) RWKV_LOAD(n0 + 64);
        f32x4 yhat[4];
        if (ROLE == 1) {
            const unsigned g = (unsigned)(n0 >> 6);
            if (!pf_ok) { if (wv == 0) wait_ge((g & 1u) ? READY1 : READY0, (g >> 1) + 1u); __syncthreads();
                const unsigned long long* slot = ring + (size_t)(g % RING_SLOTS) * SLOT_U64;
#pragma unroll
                for (int k = 0; k < 12; ++k) { const int e = tid + NT * k; if (e < S_YH) pf[k] = slot[e]; }
#pragma unroll
                for (int m = 0; m < 4; ++m) yh[m] = *(const f32x4*)(slot + S_YH + ((m * 4 + (wv & 3)) * 64 + lane) * 2); }
            for (int rep7 = 0; rep7 < (MK_RDUP == 7 ? 2 : 1); ++rep7) { if (rep7) __syncthreads();
#pragma unroll
            for (int k = 0; k < 12; ++k) { const int e = tid + NT * k; if (e < S_YH) *(LAS unsigned long long*)(lds + slot_lds(e)) = pf[k]; }
            asm volatile("s_waitcnt vmcnt(0)" ::: "memory");
            __syncthreads(); }
            if (tid == 0) __hip_atomic_store(ACK, g + 1u, __ATOMIC_RELAXED, __HIP_MEMORY_SCOPE_AGENT);
#pragma unroll
            for (int m = 0; m < 4; ++m) yhat[m] = yh[m];
        }
        if (ROLE != 1) for (int rep1 = 0; rep1 < (MK_RDUP == 1 ? 2 : 1); ++rep1) {
        {
            const int m = wv >> 1, pp = wv & 1; LAS bf16_t* XB = pp ? Rt : At;
            f32x4 c1 = (f32x4){0.f, 0.f, 0.f, 0.f}, c2 = (f32x4){0.f, 0.f, 0.f, 0.f};
#pragma unroll
            for (int kk = 0; kk < 2; ++kk) { const bf16x8 bx = *(const LAS bf16x8*)(XB + (16 * m + r) * PT + 32 * kk + 8 * q);
                const bf16x8 a1 = *(const LAS bf16x8*)(Bt + (16 * m + r) * PT + 32 * kk + 8 * q), a2 = *(const LAS bf16x8*)(Kt + (16 * m + r) * PT + 32 * kk + 8 * q);
                c1 = __builtin_amdgcn_mfma_f32_16x16x32_bf16(a1, bx, c1, 0, 0, 0); c2 = __builtin_amdgcn_mfma_f32_16x16x32_bf16(a2, bx, c2, 0, 0, 0); }
#pragma unroll
            for (int jj = 0; jj < 4; ++jj) { const int s = 4 * q + jj; const bool ok = pp ? (s <= r) : (s < r); if (!ok) { c1[jj] = 0.f; c2[jj] = 0.f; } }
            if (pp == 0) { *(LAS f32x4*)(MBf + (m * 16 + r) * 20 + 4 * q) = c1; *(LAS u32x2*)(MK + (m * 16 + r) * PM + 4 * q) = pack4(c2[0], c2[1], c2[2], c2[3]); }
            else { *(LAS u32x2*)(NB + (m * 16 + r) * PM + 4 * q) = pack4(c1[0], c1[1], c1[2], c1[3]); *(LAS u32x2*)(NK + (m * 16 + r) * PM + 4 * q) = pack4(c2[0], c2[1], c2[2], c2[3]); }
        }
        __syncthreads();
        if (wv < 4) {
            const int m = wv, c = r; float X[16];
#pragma unroll
            for (int u = 0; u < 16; ++u) { float x = (c == u) ? 1.f : 0.f;
                if (u > 0) { const LAS f32x4* rowp = (const LAS f32x4*)(MBf + (m * 16 + u) * 20);
#pragma unroll
                    for (int s4 = 0; s4 < 4; ++s4) { if (4 * s4 < u) { const f32x4 l = rowp[s4];
#pragma unroll
                        for (int e = 0; e < 4; ++e) if (4 * s4 + e < u) x -= l[e] * X[4 * s4 + e]; } } }
                X[u] = x; }
            if (q == 0) {
#pragma unroll
                for (int u = 0; u < 16; ++u) DNV[(m * 16 + u) * PM + c] = f2bf(X[u]); }
        } else {
            const int m = wv - 4; const bf16x8 a = *(const LAS bf16x8*)(MK + (m * 16 + r) * PM + 8 * q);
            bf16x8 bvs[4]; tr_frag4(bvs[0], bvs[1], bvs[2], bvs[3], tr_addr(vt_b, PT, 16 * m, 0, r, q), 8u * PT, tr_addr(vt_b, PT, 16 * m, 16, r, q), 8u * PT, tr_addr(vt_b, PT, 16 * m, 32, r, q), 8u * PT, tr_addr(vt_b, PT, 16 * m, 48, r, q), 8u * PT);
#pragma unroll
            for (int it = 0; it < 4; ++it) { const bf16x8 bv = bvs[it];
                const f32x4 acc = __builtin_amdgcn_mfma_f32_16x16x32_bf16(a, bv, (f32x4){0.f, 0.f, 0.f, 0.f}, 0, 0, 0);
                *(LAS u32x2*)(W1T + (m * 64 + 16 * it + r) * PM + 4 * q) = pack4(acc[0], acc[1], acc[2], acc[3]); }
        }
        __syncthreads();
#pragma unroll
        for (int m = 0; m < 4; ++m) yhat[m] = (f32x4){0.f, 0.f, 0.f, 0.f};
        {
            const int it = wv & 3;
#pragma unroll
            for (int m = 0; m < 4; ++m) { const bf16x8 a = *(const LAS bf16x8*)(DNV + (m * 16 + r) * PM + 8 * q), bw = *(const LAS bf16x8*)(W1T + (m * 64 + 16 * it + r) * PM + 8 * q);
                yhat[m] = __builtin_amdgcn_mfma_f32_16x16x32_bf16(a, bw, yhat[m], 0, 0, 0); }
        }
        if (wv >= 4) {
            const int jt = wv - 4;
            bf16x8 afs[4]; tr_frag4(afs[0], afs[1], afs[2], afs[3], tr_addr(at_b, PT, 0, 16 * jt, r, q), 8u * PT, tr_addr(at_b, PT, 16, 16 * jt, r, q), 8u * PT, tr_addr(at_b, PT, 32, 16 * jt, r, q), 8u * PT, tr_addr(at_b, PT, 48, 16 * jt, r, q), 8u * PT);
#pragma unroll
            for (int m = 0; m < 4; ++m) { const bf16x8 a = afs[m], bd = *(const LAS bf16x8*)(DNV + (m * 16 + r) * PM + 8 * q);
                const f32x4 acc = __builtin_amdgcn_mfma_f32_16x16x32_bf16(a, bd, (f32x4){0.f, 0.f, 0.f, 0.f}, 0, 0, 0);
                *(LAS u32x2*)(AH + (m * 16 + r) * PT + 16 * jt + 4 * q) = pack4(acc[0], acc[1], acc[2], acc[3]); }
        }
        __syncthreads();
        }
        if (ROLE == 2) {
            const unsigned g = (unsigned)(n0 >> 6);
            if (g >= 2u) { asm volatile("s_waitcnt vmcnt(0)" ::: "memory"); __syncthreads(); if (tid == 0) __hip_atomic_store(READYH, (g >> 1), __ATOMIC_RELAXED, __HIP_MEMORY_SCOPE_AGENT); }
            if (n0 + 128 < LT) RWKV_LOAD(n0 + 128);
            if (g >= RING_SLOTS && ack_seen < g - RING_SLOTS + 1) {
                if (tid == 0) { wait_ge(ACK, g - RING_SLOTS + 1); ((LAS unsigned*)MBf)[17] = __hip_atomic_load(ACK, __ATOMIC_RELAXED, __HIP_MEMORY_SCOPE_AGENT); }
                __syncthreads(); ack_seen = ((LAS unsigned*)MBf)[17]; }
            unsigned long long* slot = ring + (size_t)(g % RING_SLOTS) * SLOT_U64;
#pragma unroll 2
            for (int k = 0; k < 12; ++k) { const int e = tid + NT * k; if (e < S_YH) __hip_atomic_store(slot + e, *(const LAS unsigned long long*)(lds + slot_lds(e)), __ATOMIC_RELAXED, __HIP_MEMORY_SCOPE_AGENT); }
            if (wv < 4) {
#pragma unroll
                for (int m = 0; m < 4; ++m) { unsigned long long* yp = slot + S_YH + ((m * 4 + wv) * 64 + lane) * 2;
                    __hip_atomic_store(yp, ((unsigned long long)__float_as_uint(yhat[m][1]) << 32) | __float_as_uint(yhat[m][0]), __ATOMIC_RELAXED, __HIP_MEMORY_SCOPE_AGENT);
                    __hip_atomic_store(yp + 1, ((unsigned long long)__float_as_uint(yhat[m][3]) << 32) | __float_as_uint(yhat[m][2]), __ATOMIC_RELAXED, __HIP_MEMORY_SCOPE_AGENT); } }
            if (g + 2u >= 132u) { asm volatile("s_waitcnt vmcnt(0)" ::: "memory"); __syncthreads(); if (tid == 0) __hip_atomic_store(READYH, (g >> 1) + 1u, __ATOMIC_RELAXED, __HIP_MEMORY_SCOPE_AGENT); }
            continue;
        }
#pragma unroll 1
        for (int m = 0; m < 4; ++m) {
            LAS bf16_t* Sc = Sbf + cur * 64 * PT; LAS bf16_t* Sn = Sbf + (cur ^ 1) * 64 * PT;
            const int it = wv & 3, jh = wv >> 2;
            bf16x8 bv, ka0, ka1;
            tr_frag3(bv, ka0, ka1, tr_addr(vt_b, PT, 16 * m, 16 * it, r, q), 8u * PT, tr_addr(kt_b, PT, 16 * m, 16 * (2 * jh), r, q), 8u * PT, tr_addr(kt_b, PT, 16 * m, 16 * (2 * jh + 1), r, q), 8u * PT);
            ka0 = zero_if(ka0, q >= 2); ka1 = zero_if(ka1, q >= 2);
            s16x4 hb0, hb1;
            { const unsigned a0 = bt_b + (unsigned)(((16 * m + 4 * q + (r >> 2)) * PT + 16 * (2 * jh) + 4 * (r & 3)) * 2), a1 = a0 + 32u;
              asm volatile("ds_read_b64_tr_b16 %0, %2\n\tds_read_b64_tr_b16 %1, %3\n\ts_waitcnt lgkmcnt(0)" : "=&v"(hb0), "=&v"(hb1) : "v"(a0), "v"(a1) : "memory"); }
            const bf16x8 ba0 = {hb0[0], hb0[1], hb0[2], hb0[3], 0, 0, 0, 0}, ba1 = {hb1[0], hb1[1], hb1[2], hb1[3], 0, 0, 0, 0};
            const bf16x8 s0 = *(const LAS bf16x8*)(Sc + (16 * it + r) * PT + 8 * q), s1 = *(const LAS bf16x8*)(Sc + (16 * it + r) * PT + 32 + 8 * q);
            f32x4 acc = (m == 0) ? yhat[0] : (m == 1) ? yhat[1] : (m == 2) ? yhat[2] : yhat[3];
            acc = __builtin_amdgcn_mfma_f32_16x16x32_bf16(*(const LAS bf16x8*)(AH + (m * 16 + r) * PT + 8 * q), s0, acc, 0, 0, 0);
            acc = __builtin_amdgcn_mfma_f32_16x16x32_bf16(*(const LAS bf16x8*)(AH + (m * 16 + r) * PT + 32 + 8 * q), s1, acc, 0, 0, 0);
            const u32x2 ny = pack4(-acc[0], -acc[1], -acc[2], -acc[3]);
            bf16x8 nyv = {0, 0, 0, 0, 0, 0, 0, 0}; { const s16x4 t4 = __builtin_bit_cast(s16x4, ny); nyv[0] = t4[0]; nyv[1] = t4[1]; nyv[2] = t4[2]; nyv[3] = t4[3]; }
#pragma unroll
            for (int x = 0; x < 2; ++x) { const int jt = 2 * jh + x;
                Sacc[x] = __builtin_amdgcn_mfma_f32_16x16x32_bf16(x ? ka1 : ka0, bv, Sacc[x], 0, 0, 0); Sacc[x] = __builtin_amdgcn_mfma_f32_16x16x32_bf16(x ? ba1 : ba0, nyv, Sacc[x], 0, 0, 0);
                const f32x4 gm = *(const LAS f32x4*)(GAM + m * 64 + 16 * jt + 4 * q); Sacc[x] = Sacc[x] * gm;
                *(LAS u32x2*)(Sn + (16 * it + r) * PT + 16 * jt + 4 * q) = pack4(Sacc[x][0], Sacc[x][1], Sacc[x][2], Sacc[x][3]); }
            if (wv >= 4) {
                f32x4 oacc = (f32x4){0.f, 0.f, 0.f, 0.f};
                oacc = __builtin_amdgcn_mfma_f32_16x16x32_bf16(*(const LAS bf16x8*)(Rt + (16 * m + r) * PT + 8 * q), s0, oacc, 0, 0, 0);
                oacc = __builtin_amdgcn_mfma_f32_16x16x32_bf16(*(const LAS bf16x8*)(Rt + (16 * m + r) * PT + 32 + 8 * q), s1, oacc, 0, 0, 0);
                oacc = __builtin_amdgcn_mfma_f32_16x16x32_bf16(*(const LAS bf16x8*)(NK + (m * 16 + r) * PM + 8 * q), bv, oacc, 0, 0, 0);
                const s16x4 nb4 = *(const LAS s16x4*)(NB + (m * 16 + r) * PM + 4 * q); const bf16x8 nbp = {nb4[0], nb4[1], nb4[2], nb4[3], 0, 0, 0, 0};
                oacc = __builtin_amdgcn_mfma_f32_16x16x32_bf16(nbp, nyv, oacc, 0, 0, 0);
#pragma unroll
                for (int jj = 0; jj < 4; ++jj) OUT[(16 * m + 4 * q + jj) * 68 + 16 * it + r] = oacc[jj]; }
            if (ROLE == 1 && m == 0) { if (tid == 0) { const unsigned g1 = (unsigned)(n0 >> 6) + 1u; unsigned ok = 0u;
                    if (g1 < 132u && __hip_atomic_load((g1 & 1u) ? READY1 : READY0, __ATOMIC_RELAXED, __HIP_MEMORY_SCOPE_AGENT) >= (g1 >> 1) + 1u) { __builtin_amdgcn_fence(__ATOMIC_ACQUIRE, "agent"); asm volatile("s_waitcnt vmcnt(0)" ::: "memory"); ok = 1u; }
                    ((LAS unsigned*)MBf)[16] = ok; } }
            __syncthreads();
            if (ROLE == 1 && m == 0) { pf_ok = ((LAS unsigned*)MBf)[16] != 0u;
                if (pf_ok) { const unsigned long long* slot = ring + (size_t)(((unsigned)(n0 >> 6) + 1u) % RING_SLOTS) * SLOT_U64;
#pragma unroll
                    for (int k = 0; k < 12; ++k) { const int e = tid + NT * k; if (e < S_YH) pf[k] = slot[e]; }
#pragma unroll
                    for (int mm = 0; mm < 4; ++mm) yh[mm] = *(const f32x4*)(slot + S_YH + ((mm * 4 + (wv & 3)) * 64 + lane) * 2); } }
            cur ^= 1;
        }
        for (int rep6 = 0; rep6 < (MK_RDUP == 6 ? 2 : 1); ++rep6) {
            const int u = tid >> 3, part = tid & 7; const size_t row = (size_t)step_row(d, b, n0 + u);
            const f32x4 o0 = *(const LAS f32x4*)(OUT + u * 68 + 8 * part), o1 = *(const LAS f32x4*)(OUT + u * 68 + 8 * part + 4);
            const float mean = sum8((o0[0] + o0[1]) + (o0[2] + o0[3]) + (o1[0] + o1[1]) + (o1[2] + o1[3])) * (1.f / 64.f);
            const f32x4 d0 = o0 - mean, d1 = o1 - mean;
            const float var = sum8((d0[0] * d0[0] + d0[1] * d0[1]) + (d0[2] * d0[2] + d0[3] * d0[3]) + (d1[0] * d1[0] + d1[1] * d1[1]) + (d1[2] * d1[2] + d1[3] * d1[3])) * (1.f / 64.f);
            const float rstd = rsqrtf(var + 64e-5f), bs = BS[u];
            const f32x4 w0 = *(const LAS f32x4*)(prm + 640 + 8 * part), w1 = *(const LAS f32x4*)(prm + 644 + 8 * part), b0 = *(const LAS f32x4*)(prm + 704 + 8 * part), b1 = *(const LAS f32x4*)(prm + 708 + 8 * part);
            const u32x4 vv = *(const LAS u32x4*)(Vt + u * PT + 8 * part);
            float z[8];
#pragma unroll
            for (int k = 0; k < 4; ++k) { z[k] = d0[k] * rstd * w0[k] + b0[k]; z[4 + k] = d1[k] * rstd * w1[k] + b1[k]; }
#pragma unroll
            for (int k = 0; k < 4; ++k) { z[2 * k] += bs * __uint_as_float(vv[k] << 16); z[2 * k + 1] += bs * __uint_as_float(vv[k] & 0xffff0000u); }
            u32x4 w; w.x = pack2(z[0], z[1]); w.y = pack2(z[2], z[3]); w.z = pack2(z[4], z[5]); w.w = pack2(z[6], z[7]);
            *(u32x4*)(Z + ((size_t)d * NALL + row) * 512 + 64 * h + 8 * part) = w;
        }
        __syncthreads();
    }
}
constexpr int RP_G2 = 0, RP_G2P = 520, RP_SG = RP_G2 + 128 * RP_G2P * 2, RP_END = RP_SG + 64 * PQ * 2;
static_assert(RP_END <= LDS_BYTES, "rwkv post LDS map");
DI void phase_rwkv_post2(const P& p, LAS unsigned char* lds) {
    const int tid = mk_tid(), lane = tid & 63, wv = __builtin_amdgcn_readfirstlane(tid >> 6), r = lane & 15, q = lane >> 4;
    const bf16_t* LO = (const bf16_t*)(p.ws + WS_COLS) + OFF_LO; const bf16_t* Z = (const bf16_t*)(p.ws + WS_Z); bf16_t* Y = (bf16_t*)(p.ws + WS_COLS);
    LAS bf16_t* G2s = (LAS bf16_t*)(lds + RP_G2); LAS bf16_t* SG = (LAS bf16_t*)(lds + RP_SG);
    const unsigned g2_b = (unsigned)(size_t)G2s;
    if ((int)blockIdx.x >= NRC) return;
    __syncthreads();
    for (int e = tid; e < 128 * 128; e += NT) { const int rr = e >> 7, c4 = (e & 127) * 4; const f32x4 v = *(const f32x4*)(p.in[I_G2] + rr * 512 + c4);
        *(LAS u32x2*)(G2s + rr * RP_G2P + c4) = pack4(v[0], v[1], v[2], v[3]); }
    for (int rc = blockIdx.x; rc < NRC; rc += gridDim.x) {
        const size_t row0 = (size_t)rc * 64;
        __syncthreads();
        for (int e = tid; e < 64 * 16; e += NT) { const int t = e >> 4, pc = e & 15; const u32x4 v = *(const u32x4*)(LO + (row0 + t) * 512 + 256 + 8 * pc); u32x4 o;
#pragma unroll
            for (int k = 0; k < 4; ++k) o[k] = pack2(fsigm(__uint_as_float(v[k] << 16)), fsigm(__uint_as_float(v[k] & 0xffff0000u)));
            *(LAS u32x4*)(SG + t * PQ + 8 * pc) = o; }
        __syncthreads();
#pragma unroll 1
        for (int ci = 0; ci < 4; ++ci) { const int ct = 4 * wv + ci;
            f32x4 acc[4] = {(f32x4){0.f, 0.f, 0.f, 0.f}, (f32x4){0.f, 0.f, 0.f, 0.f}, (f32x4){0.f, 0.f, 0.f, 0.f}, (f32x4){0.f, 0.f, 0.f, 0.f}};
#pragma unroll
            for (int kk = 0; kk < 4; ++kk) { const bf16x8 a = tr_frag(g2_b, RP_G2P, 32 * kk, 16 * ct, r, q);
#pragma unroll
                for (int tt = 0; tt < 4; ++tt) { const bf16x8 bs = *(const LAS bf16x8*)(SG + (16 * tt + r) * PQ + 32 * kk + 8 * q); acc[tt] = __builtin_amdgcn_mfma_f32_16x16x32_bf16(a, bs, acc[tt], 0, 0, 0); } }
#pragma unroll
            for (int tt = 0; tt < 4; ++tt) { const size_t row = row0 + 16 * tt + r; const int c = 16 * ct + 4 * q;
                float z0[4], z1[4]; unpack4(*(const u32x2*)(Z + row * 512 + c), z0); unpack4(*(const u32x2*)(Z + ((size_t)NALL + row) * 512 + c), z1);
                *(u32x2*)(Y + row * D + c) = pack4((z0[0] + z1[0]) * acc[tt][0], (z0[1] + z1[1]) * acc[tt][1], (z0[2] + z1[2]) * acc[tt][2], (z0[3] + z1[3]) * acc[tt][3]); }
        }
    }
    __syncthreads();
}
#define XB_TMO      128
#define XB_XCNT(j)  (256  + 64 * (j))
#define XB_XSUB(j)  (1280 + 64 * (j))
#define XB_XGEN(j)  (2304 + 64 * (j))
#define XB_TOP      3328
#define XB_TOPGEN   3392
#define XCD_BAR_WORDS 3456
#define XB_SPIN_CAP (1u << 18)

__device__ __forceinline__ unsigned xb_ld(unsigned* p)              { return __hip_atomic_load(p, __ATOMIC_RELAXED, __HIP_MEMORY_SCOPE_AGENT); }
__device__ __forceinline__ unsigned xb_add(unsigned* p, unsigned v) { return __hip_atomic_fetch_add(p, v, __ATOMIC_RELAXED, __HIP_MEMORY_SCOPE_AGENT); }
__device__ __forceinline__ unsigned xb_xcc_id() { return (unsigned)__builtin_amdgcn_s_getreg((3 << 11) | 20) & 0xFu; }
#define XB_SPIN(cond, bar) do { unsigned _sp = 0; while (cond) { __builtin_amdgcn_s_sleep(1); \
    if ((++_sp & 255u) == 0u) { if (xb_ld(&(bar)[XB_TMO])) break; if (_sp > XB_SPIN_CAP) { atomicAdd(&(bar)[XB_TMO], 1u); break; } } } } while (0)

struct XcdBarrier {
    unsigned* bar; unsigned x;
    volatile LAS unsigned* st;
};

__device__ __forceinline__ XcdBarrier xcd_barrier_post(unsigned* bar, volatile LAS unsigned* st) {
    XcdBarrier b; b.bar = bar; b.x = xb_xcc_id(); b.st = st;
    if (threadIdx.x == 0) (void)xb_add(&bar[XB_XCNT(b.x)], 1u);
    return b;
}
__device__ __forceinline__ void xcd_barrier_complete(unsigned* bar, unsigned x, unsigned& nloc, unsigned& nx) {
    const unsigned G = gridDim.x * gridDim.y * gridDim.z;
    unsigned sum, cnt, mine, sp = 0u;
    for (;;) {
        sum = 0u; cnt = 0u; mine = 0u;
#pragma unroll
        for (unsigned j = 0; j < 16; ++j) { const unsigned c = xb_ld(&bar[XB_XCNT(j)]); sum += c; cnt += (c > 0u) ? 1u : 0u; mine = (j == x) ? c : mine; }
        if (sum == G) break;
        __builtin_amdgcn_s_sleep(1);
        if ((++sp & 255u) == 0u) { if (xb_ld(&bar[XB_TMO])) break; if (sp > XB_SPIN_CAP) { atomicAdd(&bar[XB_TMO], 1u); break; } }
    }
    nloc = mine > 0u ? mine : 1u; nx = cnt > 0u ? cnt : 1u;
}

__device__ __forceinline__ void xcd_barrier(const XcdBarrier& b) {
    asm volatile("s_waitcnt vmcnt(0)" ::: "memory");
    __syncthreads();
    if (threadIdx.x == 0) {
        unsigned* bar = b.bar;
        __builtin_amdgcn_s_waitcnt(0);
        unsigned nloc = b.st[0], nx = b.st[1];
        if (nloc == 0u) { xcd_barrier_complete(bar, b.x, nloc, nx); b.st[0] = nloc; b.st[1] = nx; }
        const unsigned old = xb_add(&bar[XB_XSUB(b.x)], 1u);
        const unsigned gen = old / nloc;
        if (old + 1u == (gen + 1u) * nloc) {
            __builtin_amdgcn_fence(__ATOMIC_RELEASE, "agent");
            asm volatile("s_waitcnt vmcnt(0)" ::: "memory");
            const unsigned og = xb_add(&bar[XB_TOP], 1u);
            const unsigned tg = og / nx;
            if (og + 1u == (tg + 1u) * nx) xb_add(&bar[XB_TOPGEN], 1u);
            else XB_SPIN(xb_ld(&bar[XB_TOPGEN]) == tg, bar);
            __builtin_amdgcn_fence(__ATOMIC_ACQUIRE, "agent");
            xb_add(&bar[XB_XGEN(b.x)], 1u);
            asm volatile("s_waitcnt vmcnt(0)" ::: "memory");
        } else {
            XB_SPIN(xb_ld(&bar[XB_XGEN(b.x)]) == gen, bar);
            __builtin_amdgcn_fence(__ATOMIC_ACQUIRE, "agent");
            asm volatile("s_waitcnt vmcnt(0)" ::: "memory");
        }
    }
    __syncthreads();
}
DI void phase_mlstm_post(const P& p) {
    const int lane = mk_tid() & 63, wv = mk_tid() >> 6;
    const bf16_t* ML = (const bf16_t*)(p.ws + WS_COLS) + OFF_ML; const bf16_t* HB = (const bf16_t*)(p.ws + WS_ACT); bf16_t* Y = (bf16_t*)(p.ws + WS_COLS);
    for (int r = blockIdx.x * 8 + wv; r < NALL; r += gridDim.x * 8)
        post_headnorm_row(HB, (size_t)r, p.in[I_MNG], ML + (size_t)r * 2048 + 1536, 0, Y + (size_t)r * D + 512, lane);
}
DI void phase_hgrn_post(const P& p) {
    const int lane = mk_tid() & 63, wv = mk_tid() >> 6;
    const bf16_t* C1 = (const bf16_t*)(p.ws + WS_COLS); const bf16_t* HB = (const bf16_t*)(p.ws + WS_ACT); bf16_t* Y = (bf16_t*)(p.ws + WS_Z);
    for (int r = blockIdx.x * 8 + wv; r < NLAT; r += gridDim.x * 8)
        post_headnorm_row(HB, (size_t)r, p.in[I_HNG], C1 + (size_t)r * C1LD + 2048, 1, Y + (size_t)nat_row(r) * D, lane);
}

constexpr int N_PHASES = 19;
__global__ void __launch_bounds__(NT, 2) mk_fwd(P p) {
    extern __shared__ __attribute__((aligned(16))) unsigned char lds_raw[];
    LAS unsigned char* lds = (LAS unsigned char*)lds_raw;
    cooperative_groups::grid_group grid = cooperative_groups::this_grid();
    const int lo = p.ph_lo, hi = p.ph_hi;
    volatile LAS unsigned* xst = (volatile LAS unsigned*)(lds + LDS_BYTES - 16);
    if (threadIdx.x < 4) xst[threadIdx.x] = 0u;
    __syncthreads();
    const XcdBarrier xbar = xcd_barrier_post((unsigned*)(p.ws + WS_CTL) + 8192, xst);
#define IN(k) (lo <= (k) && (k) < hi)
#define SEAM(k) do { if (IN(k) && IN((k) + 1)) xcd_barrier(xbar); } while (0)
#ifndef MK_DUP
#define MK_DUP -1
#endif
#define PHASE(k, ...) if (IN(k)) { __VA_ARGS__ if (MK_DUP == (k)) { grid.sync(); __VA_ARGS__ } } SEAM(k);
    unsigned char* ws = p.ws;
    const float* MODV = (const float*)(ws + WS_MODV);
    float* HC = (float*)(ws + WS_HC);
    float* SSQP = (float*)(ws + WS_SSQP); const float* GSC = (const float*)(ws + WS_GSC); const float* SHW = GSC + SHW_OFF;
    bf16_t* ACT = (bf16_t*)(ws + WS_ACT); bf16_t* COLS = (bf16_t*)(ws + WS_COLS); bf16_t* Y1 = (bf16_t*)(ws + WS_Z);
    PHASE(0, phase_wprep(p, lds); phase_modv(p, lds);)
    PHASE(1, phase_modnorm(p, 0, 0, p.in[I_X], p.in[I_CTX], NALL, false);)
    PHASE(2, { EpiStore3 E{COLS + OFF_RW, 1536, 6, COLS + OFF_LO, 512, 8, COLS + OFF_ML, 2048, 0}; run_gemm(lds, ACT, (const bf16_t*)(ws + WS_W_EVIN), NLAT, 4096, 1024, E); E.pm0 = 128; run_gemm(lds, ACT + (size_t)NLAT * 1024, (const bf16_t*)(ws + WS_W_EVIN), NCTX, 4096, 1024, E); })
    PHASE(3, { const int bx = (int)blockIdx.x;
        if (gridDim.x == 256) { if (bx < 64) rwkv_chunk_unit<1>(p, lds, bx); else if (bx < 192) rwkv_chunk_unit<2>(p, lds, (bx - 64) & 63, (bx - 64) >> 6); else { gla_unit<0>(p, lds, 2 * (bx - 192)); gla_unit<0>(p, lds, 2 * (bx - 192) + 1); } }
        else for (int vb = bx; vb < 192; vb += gridDim.x) { if (vb < 64) rwkv_chunk_unit<0>(p, lds, vb); else gla_unit<0>(p, lds, vb - 64); } })
    if (IN(3) && MK_DUP == 303) { grid.sync(); if (blockIdx.x < 64) rwkv_chunk_unit<1>(p, lds, blockIdx.x); grid.sync(); }
    if (IN(3) && MK_DUP == 403) { grid.sync(); if (blockIdx.x >= 64 && blockIdx.x < 128) rwkv_chunk_unit<2>(p, lds, blockIdx.x - 64, 0); grid.sync(); }
    if (IN(3) && MK_DUP == 103) { grid.sync(); for (int vb = blockIdx.x; vb < 64; vb += gridDim.x) rwkv_chunk_unit<0>(p, lds, vb); grid.sync(); }
    if (IN(3) && MK_DUP == 203) { grid.sync(); for (int vb = blockIdx.x; vb < 128; vb += gridDim.x) gla_unit<0>(p, lds, vb); grid.sync(); }
    PHASE(4, phase_mlstm_post(p); phase_rwkv_post2(p, lds);)
    PHASE(5, { EpiResid E{p.in[I_X], p.out, p.in[I_CTX], HC, MODV, 2, 0}; run_gemm(lds, COLS, (const bf16_t*)(ws + WS_W_EVOUT), NLAT, 1024, 1024, E); E.pm0 = 128; run_gemm(lds, COLS + (size_t)NLAT * 1024, (const bf16_t*)(ws + WS_W_EVOUT), NCTX, 1024, 1024, E); })
    PHASE(6, phase_modnorm(p, 0, 1, p.out, HC, NALL, false);)
    PHASE(7, { EpiSwiglu E{COLS, 0}; run_gemm(lds, ACT, (const bf16_t*)(ws + WS_W_UP), NLAT, 5632, 1024, E); E.pm0 = 128; run_gemm(lds, ACT + (size_t)NLAT * 1024, (const bf16_t*)(ws + WS_W_UP), NCTX, 5632, 1024, E); })
    PHASE(8, { EpiResid E{p.out, p.out, HC, HC, MODV, 5, 0}; run_gemm(lds, COLS, (const bf16_t*)(ws + WS_W_DN), NLAT, 1024, 2816, E); E.pm0 = 128; run_gemm(lds, COLS + (size_t)NLAT * 2816, (const bf16_t*)(ws + WS_W_DN), NCTX, 1024, 2816, E); })
    PHASE(9, phase_modnorm(p, 1, 0, p.out, HC, NALL, true);)
    PHASE(10, { EpiStore3 E{COLS, C1LD, 1 << 30, COLS, C1LD, 1 << 30, COLS, C1LD, 0}; run_gemm(lds, ACT, (const bf16_t*)(ws + WS_W_ODIN), NLAT, 3584, 1024, E); E.pm0 = 128; run_gemm(lds, ACT + (size_t)NLAT * 1024, (const bf16_t*)(ws + WS_W_ODIN), NCTX, 3584, 1024, E); })
    PHASE(11, phase_hgrn_prep2(p, lds); lru_pass<1>(p, lds, (int)blockIdx.x, (int)gridDim.x);)
    PHASE(12, { const int half = (int)gridDim.x >> 1; if ((int)blockIdx.x < half) { for (int u = blockIdx.x; u < 128; u += half) gla_unit<1>(p, lds, u); } else lru_pass<3>(p, lds, (int)blockIdx.x - half, (int)gridDim.x - half); })
    if (IN(12) && MK_DUP == 112) { grid.sync(); lru_pass<3>(p, lds, (int)blockIdx.x, (int)gridDim.x); grid.sync(); }
    if (IN(12) && MK_DUP == 212) { grid.sync(); for (int vb = blockIdx.x; vb < 128; vb += gridDim.x) gla_unit<1>(p, lds, vb); grid.sync(); }
    PHASE(13, phase_hgrn_post(p);)
    PHASE(14, EpiResid E{p.out, p.out, HC, HC, MODV + 5 * 6144, 2, 0}; run_gemm(lds, Y1, (const bf16_t*)(ws + WS_W_ODOUT), NLAT, 1024, 1024, E);)
    PHASE(15, phase_modnorm(p, 1, 1, p.out, HC, NLAT, false);)
    PHASE(16, EpiSwiglu E{COLS, 0}; run_gemm(lds, ACT, (const bf16_t*)(ws + WS_W_UP) + W_UP_STRIDE, NLAT, 5632, 1024, E);)
    PHASE(17, EpiResid E{p.out, p.out, HC, HC, MODV + 5 * 6144, 5, 0}; run_gemm(lds, COLS, (const bf16_t*)(ws + WS_W_DN) + W_DN_STRIDE, NLAT, 1024, 2816, E);)
    PHASE(18, phase_finalnorm(p);)
    if (hi > 4096) grid.sync();
#undef IN
#undef SEAM
}
}

#ifndef MK_ONE_LAUNCH
#define MK_ONE_LAUNCH 1
#endif
extern "C" void kernel_launch(void* const* d_in, const int* in_sizes, int n_in, void* d_out, int out_size, void* d_ws, size_t ws_size, hipStream_t stream) {
    using namespace mk;
    static int grid = 0;
    if (grid == 0) {
        int dev = 0, cus = 0, per_cu = 0;
        if (n_in != N_IN || ws_size < WS_END) { fprintf(stderr, "kernel_launch: unexpected n_in %d / ws_size %zu\n", n_in, ws_size); grid = -1; return; }
        (void)hipGetDevice(&dev); (void)hipDeviceGetAttribute(&cus, hipDeviceAttributeMultiprocessorCount, dev);
        (void)hipFuncSetAttribute((const void*)mk_fwd, hipFuncAttributeMaxDynamicSharedMemorySize, LDS_BYTES);
        (void)hipOccupancyMaxActiveBlocksPerMultiprocessor(&per_cu, (const void*)mk_fwd, NT, LDS_BYTES);
        if (per_cu < 1) { fprintf(stderr, "kernel_launch: occupancy query says %d blocks per CU\n", per_cu); per_cu = 1; }
        (void)hipGetLastError();
        grid = cus;
    }
    if (grid < 0) return;
    if (hipMemsetAsync((char*)d_ws + WS_CTL, 0, 65536, stream) != hipSuccess) { fprintf(stderr, "kernel_launch: memset of the control words failed\n"); return; }
    P p{};
    for (int i = 0; i < N_IN; ++i) p.in[i] = (const float*)d_in[i];
    p.out = (float*)d_out; p.ws = (unsigned char*)d_ws;
#if MK_ONE_LAUNCH
    p.ph_lo = 0; p.ph_hi = N_PHASES;
    void* args[] = {&p};
    hipError_t e = hipLaunchCooperativeKernel((const void*)mk_fwd, dim3(grid), dim3(NT), args, LDS_BYTES, stream);
    if (e != hipSuccess) fprintf(stderr, "cooperative launch failed: %s (grid %d)\n", hipGetErrorString(e), grid);
#else
    for (int k = 0; k < N_PHASES; ++k) { p.ph_lo = k; p.ph_hi = k + 1; hipLaunchKernelGGL(mk_fwd, dim3(grid), dim3(NT), LDS_BYTES, stream, p); }
#endif
}
```

```cpp
#include <hip/hip_runtime.h>
#include <hip/hip_cooperative_groups.h>
#include <cstdio>
#include <cstdint>
__device__ __forceinline__ int mk_tid() { int t = threadIdx.x; asm volatile("" : "+v"(t)); return t; }
#define MK_DUP -1
#define MK_RDUP -1
namespace pg8 {
#define PG8_LAS __attribute__((address_space(3)))
typedef unsigned short bf16_t;
typedef short bf16x8 __attribute__((ext_vector_type(8)));
typedef float f32x4 __attribute__((ext_vector_type(4)));
typedef unsigned u32x4 __attribute__((ext_vector_type(4)));
constexpr int BM = 256, BK = 64, HALF = 128, HTB = HALF * BK * 2  , STAGE_BYTES = 8 * HTB, NXCD = 8, WGM = 8;

__host__ __device__ __forceinline__ int lds_byte(int r, int c) { const int st = (r >> 4) * 2 + (c >> 5), rr = r & 15, cc = c & 31, ob = rr * 64 + cc * 2; return st * 1024 + (ob ^ (((ob >> 9) & 1) << 5)); }
__host__ __device__ __forceinline__ void stage_rc(int b, int& R, int& C) { const int st = b / 1024, sb = b % 1024, swz = sb ^ (((sb >> 9) & 1) << 5); R = (st >> 1) * 16 + swz / 64; C = (st & 1) * 32 + (swz % 64) / 2; }
__host__ __device__ __forceinline__ int perm32(int rho) { const int n = rho >> 4, i = rho & 15; return 8 * (i >> 2) + 4 * n + (i & 3); }

struct Unit { int pm, pn; };
struct Gemm { const bf16_t* A; const bf16_t* Bt; int M, N, K; };

struct StaticOrder {
    int nM, nN, nwg, G, c;
    __host__ __device__ void init(int M, int N, int G_, int c_) { nM = M / BM; nN = N / BM; nwg = nM * nN; G = G_; c = c_; }
    __host__ __device__ bool next(int i, Unit& u) const {
        const long L = (long)i * G + c; if (L >= nwg) return false;
        int wgid = (int)L; { const int q = nwg / NXCD, r = nwg % NXCD, xcd = wgid % NXCD, off = wgid / NXCD; wgid = (xcd < r ? xcd * (q + 1) : r * (q + 1) + (xcd - r) * q) + off; }
        const int nig = WGM * nN, gid = wgid / nig, fm = gid * WGM, gsz = (nM - fm) < WGM ? (nM - fm) : WGM;
        u.pm = fm + ((wgid % nig) % gsz); u.pn = (wgid % nig) / gsz; return true;
    }
    __device__ __forceinline__ void a_ready(const Unit&) const {}
    __device__ __forceinline__ void done(const Unit&) const {}
};
__device__ __forceinline__ unsigned cvt_pk_bf16(float lo, float hi) { unsigned r; asm volatile("v_cvt_pk_bf16_f32 %0, %1, %2" : "=v"(r) : "v"(lo), "v"(hi)); return r; }
typedef float f32x2 __attribute__((ext_vector_type(2)));
template <class Epi, class Sched, bool STAMP = false>
__device__ __forceinline__ void gemm_phase(PG8_LAS unsigned char* lds, const Gemm g, const Sched& S, const Epi& E, unsigned long long* stamps) {
    const int tid = mk_tid(), wid = __builtin_amdgcn_readfirstlane(tid >> 6), lane = tid & 63, wr = wid >> 2, wc = wid & 3, fr = lane & 15, fq = lane >> 4;
    const int K = g.K, nt = K / BK;
    int ts_lo = 0, ts_hi = 0, nts = 0; const unsigned long long rt_entry = STAMP ? (unsigned long long)wall_clock64() : 0ull;
#define PG8_STAMP() do { if (STAMP && wid == 0 && nts < 64) { const unsigned long long _c = (unsigned long long)clock64(); \
        ts_lo = (lane == nts) ? (int)(unsigned)_c : ts_lo; ts_hi = (lane == nts) ? (int)(unsigned)(_c >> 32) : ts_hi; ++nts; } } while (0)
    PG8_STAMP();
    unsigned voffA[2], voffB[2];
#pragma unroll
    for (int i = 0; i < 2; ++i) { int R, C; stage_rc(tid * 16 + i * 8192, R, C); const int Rb = Epi::PERM ? ((R & ~31) + perm32(R & 31)) : R;
        voffA[i] = (unsigned)(R * K + C) * 2u; voffB[i] = (unsigned)(Rb * K + C) * 2u; }
    const size_t kstep = (size_t)(BK * 2);
    const size_t hstep = (size_t)HALF * K * 2;
    const size_t tstep = 2 * hstep;
    const unsigned ldsw = (unsigned)wid * 1024u;
    const int aoff = lds_byte(wr * 64 + fr, fq * 8), boff = lds_byte(wc * 32 + fr, fq * 8);
#define PG8_SA(b, h) (((b) * 2 + (h)) * HTB)
#define PG8_SB(b, h) ((4 + (b) * 2 + (h)) * HTB)
#define PG8_STAGE(bufoff, gbase, voff) do { _Pragma("unroll") for (int _i = 0; _i < 2; ++_i) \
        __builtin_amdgcn_global_load_lds((const unsigned*)((const char*)(gbase) + (voff)[_i]), (PG8_LAS unsigned*)(lds + (bufoff) + ldsw + _i * 8192), 16, 0, 0); } while (0)
#define PG8_LDA(dst, b, h) do { _Pragma("unroll") for (int m = 0; m < 4; ++m) _Pragma("unroll") for (int k = 0; k < 2; ++k) dst[m][k] = *(const PG8_LAS bf16x8*)(lds + PG8_SA(b, h) + aoff + m * 2048 + k * 1024); } while (0)
#define PG8_LDB(dst, b, h) do { _Pragma("unroll") for (int n = 0; n < 2; ++n) _Pragma("unroll") for (int k = 0; k < 2; ++k) dst[n][k] = *(const PG8_LAS bf16x8*)(lds + PG8_SB(b, h) + boff + n * 2048 + k * 1024); } while (0)
#define PG8_MMA(ai, bj, At, Bt) do { __builtin_amdgcn_s_setprio(1); _Pragma("unroll") for (int m = 0; m < 4; ++m) _Pragma("unroll") for (int n = 0; n < 2; ++n) _Pragma("unroll") for (int k = 0; k < 2; ++k) \
        acc[ai][bj][m][n] = __builtin_amdgcn_mfma_f32_16x16x32_bf16(Bt[n][k], At[m][k], acc[ai][bj][m][n], 0, 0, 0); __builtin_amdgcn_s_setprio(0); } while (0)
#define PG8_WAIT_V(n) asm volatile("s_waitcnt vmcnt(" #n ")" ::: "memory")
#define PG8_WAIT_L(n) asm volatile("s_waitcnt lgkmcnt(" #n ")" ::: "memory")
#define PG8_BAR __builtin_amdgcn_s_barrier()
#define PG8_SCHED __builtin_amdgcn_sched_barrier(0)
    Unit cur, nxt; int ui = 0;
    if (!S.next(0, cur)) return;
    f32x4 acc[2][2][4][2];
#pragma unroll
    for (int a = 0; a < 2; ++a)
#pragma unroll
        for (int b = 0; b < 2; ++b)
#pragma unroll
            for (int m = 0; m < 4; ++m)
#pragma unroll
                for (int n = 0; n < 2; ++n) acc[a][b][m][n] = (f32x4){0.f, 0.f, 0.f, 0.f};
    bf16x8 At[4][2], B0[2][2], B1[2][2];
    const char* cA = (const char*)g.A + (size_t)cur.pm * tstep; const char* cB = (const char*)g.Bt + (size_t)cur.pn * tstep;
    S.a_ready(cur);
    PG8_STAGE(PG8_SB(0, 0), cB, voffB); PG8_STAGE(PG8_SA(0, 0), cA, voffA); PG8_STAGE(PG8_SB(0, 1), cB + hstep, voffB); PG8_STAGE(PG8_SA(0, 1), cA + hstep, voffA);
    if (wr == 1) PG8_BAR;
    PG8_WAIT_V(4); PG8_BAR;
    PG8_STAGE(PG8_SB(1, 0), cB + kstep, voffB); PG8_STAGE(PG8_SA(1, 0), cA + kstep, voffA); PG8_STAGE(PG8_SB(1, 1), cB + hstep + kstep, voffB);
    PG8_WAIT_V(6); PG8_BAR;
    PG8_STAMP();
    for (;;) {
        const bool has_next = S.next(ui + 1, nxt);
        const char* nA = has_next ? (const char*)g.A + (size_t)nxt.pm * tstep : cA; const char* nB = has_next ? (const char*)g.Bt + (size_t)nxt.pn * tstep : cB;
        for (int t = 0; t < nt; t += 2) {
            const bool last = (t == nt - 2);
            const char* a1 = cA + (size_t)(t + 1) * kstep;
            const char* a2 = last ? nA : cA + (size_t)(t + 2) * kstep; const char* b2 = last ? nB : cB + (size_t)(t + 2) * kstep;
            const char* a3 = a2 + kstep; const char* b3 = b2 + kstep;
            if (last && has_next) S.a_ready(nxt);
            PG8_LDB(B0, 0, 0); PG8_SCHED; PG8_LDA(At, 0, 0); PG8_STAGE(PG8_SA(1, 1), a1 + hstep, voffA);
            PG8_WAIT_L(8); PG8_BAR; PG8_WAIT_L(0); PG8_MMA(0, 0, At, B0); PG8_BAR; PG8_SCHED;
            PG8_LDB(B1, 0, 1); PG8_STAGE(PG8_SB(0, 0), b2, voffB);
            PG8_BAR; PG8_WAIT_L(0); PG8_MMA(0, 1, At, B1); PG8_BAR;
            PG8_LDA(At, 0, 1); PG8_STAGE(PG8_SA(0, 0), a2, voffA);
            PG8_BAR; PG8_WAIT_L(0); PG8_MMA(1, 0, At, B0); PG8_BAR; PG8_SCHED;
            PG8_STAGE(PG8_SB(0, 1), b2 + hstep, voffB);
            PG8_WAIT_V(6); PG8_BAR; PG8_MMA(1, 1, At, B1); PG8_BAR;
            PG8_LDB(B0, 1, 0); PG8_SCHED; PG8_LDA(At, 1, 0); PG8_STAGE(PG8_SA(0, 1), a2 + hstep, voffA);
            PG8_WAIT_L(8); PG8_BAR; PG8_WAIT_L(0); PG8_MMA(0, 0, At, B0); PG8_BAR; PG8_SCHED;
            PG8_LDB(B1, 1, 1); PG8_STAGE(PG8_SB(1, 0), b3, voffB);
            PG8_BAR; PG8_WAIT_L(0); PG8_MMA(0, 1, At, B1); PG8_BAR;
            PG8_LDA(At, 1, 1); PG8_STAGE(PG8_SA(1, 0), a3, voffA);
            PG8_BAR; PG8_WAIT_L(0); PG8_MMA(1, 0, At, B0); PG8_BAR; PG8_SCHED;
            PG8_STAGE(PG8_SB(1, 1), b3 + hstep, voffB);
            PG8_WAIT_V(6); PG8_BAR; PG8_MMA(1, 1, At, B1); PG8_BAR;
        }
        PG8_STAMP();
        if constexpr (!Epi::AFTER_DRAIN) { E(acc, cur, wr, wc, fr, fq); S.done(cur); }
        PG8_STAMP();
        if (!has_next) break;
#pragma unroll
        for (int a = 0; a < 2; ++a)
#pragma unroll
            for (int b = 0; b < 2; ++b)
#pragma unroll
                for (int m = 0; m < 4; ++m)
#pragma unroll
                    for (int n = 0; n < 2; ++n) acc[a][b][m][n] = (f32x4){0.f, 0.f, 0.f, 0.f};
        cur = nxt; cA = nA; cB = nB; ++ui;
    }
    PG8_WAIT_V(0);
    if (wr == 0) PG8_BAR;
    PG8_BAR;
    if constexpr (Epi::AFTER_DRAIN) { E.fused(acc, cur, wr, wc, fr, fq, lds, wid, lane); S.done(cur); }
    PG8_STAMP();
    if (STAMP && wid == 0) { stamps[lane] = lane < nts ? (((unsigned long long)(unsigned)ts_hi << 32) | (unsigned)ts_lo) : 0ull;
        if (lane == 62) stamps[62] = rt_entry; if (lane == 63) stamps[63] = (unsigned long long)wall_clock64(); }
#undef PG8_STAMP
#undef PG8_SA
#undef PG8_SB
#undef PG8_STAGE
#undef PG8_LDA
#undef PG8_LDB
#undef PG8_MMA
#undef PG8_WAIT_V
#undef PG8_WAIT_L
#undef PG8_BAR
#undef PG8_SCHED
}
}

namespace mk {
#define DI __device__ __forceinline__
#define LAS __attribute__((address_space(3)))
typedef unsigned short bf16_t;
typedef float f32x4 __attribute__((ext_vector_type(4)));
typedef unsigned u32x2 __attribute__((ext_vector_type(2)));
typedef unsigned u32x4 __attribute__((ext_vector_type(4)));

constexpr int D = 1024, NB = 4, L = 8192, LC = 256, NLAT = NB * L, NCTX = NB * LC, NALL = NLAT + NCTX, LT = L + LC, DFF = 2816;
constexpr int NT = 512;
constexpr size_t MiB = (size_t)1 << 20;
constexpr size_t WS_CTL = 0, WS_MODV = 1 * MiB, WS_HC = 2 * MiB, WS_W_EVIN = 6 * MiB, WS_W_EVOUT = 14 * MiB, WS_W_ODIN = 16 * MiB, WS_W_ODOUT = 23 * MiB,
                 WS_W_UP = 25 * MiB, WS_W_DN = 47 * MiB, WS_ACT = 58 * MiB, WS_COLS = 124 * MiB, WS_Z = 388 * MiB, WS_Z1 = 454 * MiB, WS_LAM = 486 * MiB, WS_LSUM = 489 * MiB, WS_LCAR = 494 * MiB, WS_SSQP = 497 * MiB, WS_GSC = 504 * MiB, WS_END = 505 * MiB;
constexpr size_t SSQP_STRIDE = (size_t)NALL * 16, GSC_STRIDE = 5 * 1024, SHW_OFF = 3 * GSC_STRIDE, SHW_STRIDE = 5 * 5632;
constexpr size_t W_UP_STRIDE = (size_t)5632 * 1024, W_DN_STRIDE = (size_t)1024 * 2816;
constexpr size_t OFF_RW = 0, OFF_LO = (size_t)NALL * 1536, OFF_ML = OFF_LO + (size_t)NALL * 512;
constexpr int LDS_BYTES = 163840;
constexpr int C1LD = 3584;
DI int nat_row(int r) { const int b = r / L, pp = r % L; return b * L + (pp % 128) * 64 + pp / 128; }

enum { I_X = 0, I_C, I_CTX, I_CCTX, I_N1G, I_N2G, I_MODW, I_MODB, I_W1, I_W3, I_W2, I_FING, I_EVIN, I_EVOUT, I_MU, I_W0, I_W2L, I_A0, I_A2L, I_KK, I_KA, I_RK,
       I_LNW, I_LNB, I_G2, I_MBI, I_MBF, I_MNG, I_ODIN, I_ODOUT, I_HLB, I_HNG, I_CONVW, I_CONVB, I_WA, I_BA, I_WI, I_BI, I_LAM, N_IN };

struct P { const float* in[N_IN]; float* out; unsigned char* ws; int ph_lo, ph_hi; };

DI float bf2f(bf16_t v) { return __uint_as_float(((unsigned)v) << 16); }
typedef float f32x2_t __attribute__((ext_vector_type(2)));
typedef __bf16 bf16x2_t __attribute__((ext_vector_type(2)));
DI unsigned pack2(float lo, float hi) { const f32x2_t v = {lo, hi}; return __builtin_bit_cast(unsigned, __builtin_convertvector(v, bf16x2_t)); }
DI bf16_t f2bf(float f) { return (bf16_t)(pack2(f, f) & 0xffffu); }
DI float sigm(float x) { return 1.f / (1.f + expf(-x)); }
DI float siluf(float x) { return x * sigm(x); }
DI float geluf(float x) { return 0.5f * x * (1.f + tanhf(0.7978845608028654f * (x + 0.044715f * x * x * x))); }
DI float fexp(float x) { return __builtin_amdgcn_exp2f(x * 1.4426950408889634f); }
DI float frcp(float x) { return __builtin_amdgcn_rcpf(x); }
DI float fsigm(float x) { return frcp(1.f + fexp(-x)); }
DI float ftanh(float x) { return 1.f - 2.f * frcp(1.f + fexp(2.f * x)); }
DI float fgelu(float x) { return 0.5f * x * (1.f + ftanh(0.7978845608028654f * (x + 0.044715f * x * x * x))); }
template <int CTRL> DI float dppf(float x) { return __int_as_float(__builtin_amdgcn_update_dpp(0, __float_as_int(x), CTRL, 0xF, 0xF, false)); }
DI float sum8(float s) { s += dppf<0xB1>(s); s += dppf<0x4E>(s); s += dppf<0x141>(s); return s; }
DI float scan16(float x) { x += dppf<0x111>(x); x += dppf<0x112>(x); x += dppf<0x114>(x); x += dppf<0x118>(x); return x; }
DI float wave_sum(float v) { v += dppf<0xB1>(v); v += dppf<0x4E>(v); v += dppf<0x141>(v); v += dppf<0x140>(v); v += __shfl_xor(v, 16); v += __shfl_xor(v, 32); return v; }
DI int step_row(int d, int b, int n) {
    if (n < LC) return NLAT + b * LC + (d ? LC - 1 - n : n);
    const int m = n - LC; return b * L + (d ? L - 1 - m : m);
}

DI int matN(int m) { return m == 0 ? 4096 : m == 1 ? 1024 : m == 2 ? 3584 : m == 3 ? 1024 : m < 6 ? 5632 : 1024; }
DI int matK(int m) { return m < 6 ? 1024 : 2816; }
DI int matTile0(int m) { return m == 0 ? 0 : m == 1 ? 1024 : m == 2 ? 1280 : m == 3 ? 2176 : m == 4 ? 2432 : m == 5 ? 3840 : m == 6 ? 5248 : m == 7 ? 5952 : 6656; }
DI size_t matOff(int m) { return m == 0 ? WS_W_EVIN : m == 1 ? WS_W_EVOUT : m == 2 ? WS_W_ODIN : m == 3 ? WS_W_ODOUT : m == 4 ? WS_W_UP : m == 5 ? WS_W_UP + W_UP_STRIDE * 2 : m == 6 ? WS_W_DN : WS_W_DN + W_DN_STRIDE * 2; }
DI const float* matSrc(const P& p, int m, int n, int& ld) {
    if (m == 0) { ld = 3984; int col; if (n < 1920) col = n; else if (n < 1936) col = 3968 + (n - 1920); else if (n < 2048) return nullptr; else col = 1920 + (n - 2048); return p.in[I_EVIN] + col; }
    if (m == 1) { ld = 1024; return p.in[I_EVOUT] + n; }
    if (m == 2) { ld = 3584; return p.in[I_ODIN] + n; }
    if (m == 3) { ld = 1024; return p.in[I_ODOUT] + n; }
    if (m < 6) { ld = 2816; const int l = m - 4, pn = n >> 8, w = n & 255; const size_t lo = (size_t)l * 1024 * 2816; return (w < 128) ? p.in[I_W1] + lo + 128 * pn + w : p.in[I_W3] + lo + 128 * pn + (w - 128); }
    ld = 1024; return p.in[I_W2] + (size_t)(m - 6) * 2816 * 1024 + n;
}
DI void phase_wprep(const P& p, LAS unsigned char* ldsb) {
    LAS float* tile = (LAS float*)ldsb;
    const int tid = mk_tid(), tx = tid & 63, ty = tid >> 6;
    for (int item = blockIdx.x; item < 6656; item += gridDim.x) {
        int m = 0;
#pragma unroll
        for (int q = 1; q < 8; ++q) if (item >= matTile0(q)) m = q;
        const int local = item - matTile0(m), K = matK(m), nK = K >> 6, nb = local / nK, kb = local - nb * nK, n0 = nb * 64, k0 = kb * 64;
        bf16_t* Bt = (bf16_t*)(p.ws + matOff(m));
        int ld; const float* src = matSrc(p, m, n0 + tx, ld);
        __syncthreads();
#pragma unroll
        for (int i = 0; i < 8; ++i) { const int k = k0 + ty + 8 * i; tile[(ty + 8 * i) * 65 + tx] = src ? src[(size_t)k * ld] : 0.f; }
        __syncthreads();
#pragma unroll
        for (int i = 0; i < 8; ++i) { const int nn = ty + 8 * i; Bt[(size_t)(n0 + nn) * K + k0 + tx] = f2bf(tile[tx * 65 + nn]); }
    }
    __syncthreads();
}
DI void phase_modv(const P& p, LAS unsigned char* ldsb) {
    LAS float* sc = (LAS float*)ldsb;
    LAS float* part = sc + 5 * 1024;
    const int tid = mk_tid(), lane = tid & 63, wv = tid >> 6;
    float* MODV = (float*)(p.ws + WS_MODV);
    if ((int)blockIdx.x >= 192) return;
    __syncthreads();
    for (int e = tid; e < 5 * 1024; e += NT) { const int s = e >> 10, k = e & 1023; const float v = (s < 4) ? p.in[I_C][s * 1024 + k] : p.in[I_CCTX][k]; sc[e] = siluf(v); }
    __syncthreads();
    for (int vb = blockIdx.x; vb < 192; vb += gridDim.x) {
        const int l = vb / 96, n = (vb % 96) * 64 + lane;
        const float* W = p.in[I_MODW] + (size_t)l * 1024 * 6144 + (size_t)(128 * wv) * 6144 + n;
        float a0 = 0.f, a1 = 0.f, a2 = 0.f, a3 = 0.f, a4 = 0.f;
#pragma unroll 16
        for (int k = 0; k < 128; ++k) { const float w = W[(size_t)k * 6144]; const int kk = 128 * wv + k; a0 += sc[kk] * w; a1 += sc[1024 + kk] * w; a2 += sc[2048 + kk] * w; a3 += sc[3072 + kk] * w; a4 += sc[4096 + kk] * w; }
        __syncthreads();
        part[(wv * 5 + 0) * 64 + lane] = a0; part[(wv * 5 + 1) * 64 + lane] = a1; part[(wv * 5 + 2) * 64 + lane] = a2; part[(wv * 5 + 3) * 64 + lane] = a3; part[(wv * 5 + 4) * 64 + lane] = a4;
        __syncthreads();
        if (tid < 320) { const int s = tid >> 6; float t = p.in[I_MODB][l * 6144 + (vb % 96) * 64 + lane];
#pragma unroll
            for (int w8 = 0; w8 < 8; ++w8) t += part[(w8 * 5 + s) * 64 + lane];
            MODV[(size_t)l * 5 * 6144 + s * 6144 + (vb % 96) * 64 + lane] = t; }
    }
    __syncthreads();
}

DI void phase_modnorm(const P& p, int layer, int which, const float* hlat, const float* hctx, int nrows, bool permute) {
    const int lane = mk_tid() & 63, wv = mk_tid() >> 6;
    const float* MODV = (const float*)(p.ws + WS_MODV) + (size_t)layer * 5 * 6144;
    const float* g = p.in[which ? I_N2G : I_N1G] + layer * 1024;
    bf16_t* ACT = (bf16_t*)(p.ws + WS_ACT);
    f32x4 gs[4], sh[4]; int sv_have = -1;
    const int rstep = gridDim.x * 8; int r = blockIdx.x * 8 + wv;
    f32x4 v[4], vn[4];
#define MN_SRC(rr) (((rr) >= NLAT) ? hctx + (size_t)((rr) - NLAT) * D : hlat + (size_t)(rr) * D)
    if (r < nrows) { const float* src = MN_SRC(r);
#pragma unroll
        for (int j = 0; j < 4; ++j) v[j] = *(const f32x4*)(src + 4 * lane + 256 * j); }
    for (; r < nrows; r += rstep) {
        const bool isctx = r >= NLAT; const int sv = isctx ? 4 : r / L;
        if (r + rstep < nrows) { const float* src = MN_SRC(r + rstep);
#pragma unroll
            for (int j = 0; j < 4; ++j) vn[j] = *(const f32x4*)(src + 4 * lane + 256 * j); }
        if (sv != sv_have) { sv_have = sv; const float* shift = MODV + sv * 6144 + (which ? 3 : 0) * 1024; const float* scale = shift + 1024;
#pragma unroll
            for (int j = 0; j < 4; ++j) { const int c = 4 * lane + 256 * j; const f32x4 gg = *(const f32x4*)(g + c), sc = *(const f32x4*)(scale + c); gs[j] = gg * (sc + 1.f); sh[j] = *(const f32x4*)(shift + c); } }
        int dr = r;
        if (permute && !isctx) { const int b = r / L, t = r % L; dr = b * L + (t % 64) * 128 + t / 64; }
        float ss = 0.f;
#pragma unroll
        for (int j = 0; j < 4; ++j) ss += (v[j].x * v[j].x + v[j].y * v[j].y) + (v[j].z * v[j].z + v[j].w * v[j].w);
        const float rinv = rsqrtf(wave_sum(ss) * (1.f / D) + 1e-6f);
#pragma unroll
        for (int j = 0; j < 4; ++j) { const int c = 4 * lane + 256 * j; const f32x4 o = v[j] * rinv * gs[j] + sh[j];
            u32x2 w; w.x = pack2(o[0], o[1]); w.y = pack2(o[2], o[3]);
            *(u32x2*)(ACT + (size_t)dr * D + c) = w; v[j] = vn[j]; }
    }
#undef MN_SRC
}
DI void phase_finalnorm(const P& p) {
    const int lane = mk_tid() & 63, wv = mk_tid() >> 6;
    const float* g = p.in[I_FING];
    f32x4 gg[4];
#pragma unroll
    for (int j = 0; j < 4; ++j) gg[j] = *(const f32x4*)(g + 4 * lane + 256 * j);
    const int rstep = gridDim.x * 8; int r = blockIdx.x * 8 + wv;
    f32x4 v[4], vn[4];
    if (r < NLAT) {
#pragma unroll
        for (int j = 0; j < 4; ++j) v[j] = *(const f32x4*)(p.out + (size_t)r * D + 4 * lane + 256 * j); }
    for (; r < NLAT; r += rstep) {
        if (r + rstep < NLAT) {
#pragma unroll
            for (int j = 0; j < 4; ++j) vn[j] = *(const f32x4*)(p.out + (size_t)(r + rstep) * D + 4 * lane + 256 * j); }
        float ss = 0.f;
#pragma unroll
        for (int j = 0; j < 4; ++j) ss += (v[j].x * v[j].x + v[j].y * v[j].y) + (v[j].z * v[j].z + v[j].w * v[j].w);
        const float rinv = rsqrtf(wave_sum(ss) * (1.f / D) + 1e-6f);
#pragma unroll
        for (int j = 0; j < 4; ++j) { *(f32x4*)(p.out + (size_t)r * D + 4 * lane + 256 * j) = v[j] * rinv * gg[j]; v[j] = vn[j]; }
    }
}

struct EpiStore3 {
    static constexpr bool PERM = true, AFTER_DRAIN = false;
    bf16_t* p0; int ld0; int pn1; bf16_t* p1; int ld1; int pn2; bf16_t* p2; int ld2; int pm0;
    DI void operator()(const f32x4 (&acc)[2][2][4][2], const pg8::Unit& u, int wr, int wc, int fr, int fq) const {
        bf16_t* base; int ld, ct;
        if (u.pn >= pn2) { base = p2; ld = ld2; ct = u.pn - pn2; } else if (u.pn >= pn1) { base = p1; ld = ld1; ct = u.pn - pn1; } else { base = p0; ld = ld0; ct = u.pn; }
        const int row0 = (u.pm + pm0) * 256 + wr * 64 + fr, col0 = ct * 256 + wc * 32 + 8 * fq;
#pragma unroll
        for (int ai = 0; ai < 2; ++ai)
#pragma unroll
            for (int m = 0; m < 4; ++m) { bf16_t* rowp = base + (size_t)(row0 + ai * 128 + m * 16) * ld + col0;
#pragma unroll
                for (int bj = 0; bj < 2; ++bj) { const f32x4 v0 = acc[ai][bj][m][0], v1 = acc[ai][bj][m][1];
                    u32x4 w; w.x = pack2(v0[0], v0[1]); w.y = pack2(v0[2], v0[3]); w.z = pack2(v1[0], v1[1]); w.w = pack2(v1[2], v1[3]); *(u32x4*)(rowp + bj * 128) = w; } }
    }
};
struct EpiResid {
    static constexpr bool PERM = false, AFTER_DRAIN = false;
    const float* hin; float* hout; const float* cin; float* cout; const float* modv_l; int gidx; int pm0;
    DI void operator()(const f32x4 (&acc)[2][2][4][2], const pg8::Unit& u, int wr, int wc, int fr, int fq) const {
        const int pm = u.pm + pm0; const bool isctx = pm >= 128; const int sv = isctx ? 4 : (pm >> 5);
        const float* gate = modv_l + sv * 6144 + gidx * 1024;
        const float* bi = isctx ? cin : hin; float* bo = isctx ? cout : hout;
        const int row0 = (isctx ? (pm - 128) : pm) * 256 + wr * 64 + fr, col0 = u.pn * 256 + wc * 32 + 4 * fq;
        f32x4 gv[2][2];
#pragma unroll
        for (int bj = 0; bj < 2; ++bj)
#pragma unroll
            for (int n = 0; n < 2; ++n) gv[bj][n] = *(const f32x4*)(gate + col0 + bj * 128 + n * 16);
#pragma unroll
        for (int ai = 0; ai < 2; ++ai)
#pragma unroll
            for (int m = 0; m < 4; ++m) { const size_t off = (size_t)(row0 + ai * 128 + m * 16) * D + col0;
#pragma unroll
                for (int bj = 0; bj < 2; ++bj)
#pragma unroll
                    for (int n = 0; n < 2; ++n) { const f32x4 bs = *(const f32x4*)(bi + off + bj * 128 + n * 16); *(f32x4*)(bo + off + bj * 128 + n * 16) = bs + gv[bj][n] * acc[ai][bj][m][n]; } }
    }
};
struct EpiResidN {
    static constexpr bool PERM = false, AFTER_DRAIN = false;
    const float* hin; float* hout; const float* cin; float* cout; const float* modv_l; int gidx;
    bf16_t* act; const float* gsc; float* ssqp; int permute;
    DI void operator()(const f32x4 (&acc)[2][2][4][2], const pg8::Unit& u, int wr, int wc, int fr, int fq) const {
        const bool isctx = u.pm >= 128; const int sv = isctx ? 4 : (u.pm >> 5);
        const float* gate = modv_l + sv * 6144 + gidx * 1024; const float* gs = gsc + sv * 1024;
        const float* bi = isctx ? cin : hin; float* bo = isctx ? cout : hout;
        const int row0 = (isctx ? (u.pm - 128) : u.pm) * 256 + wr * 64 + fr, col0 = u.pn * 256 + wc * 32 + 4 * fq;
        f32x4 gv[2][2], gsv[2][2];
#pragma unroll
        for (int bj = 0; bj < 2; ++bj)
#pragma unroll
            for (int n = 0; n < 2; ++n) { gv[bj][n] = *(const f32x4*)(gate + col0 + bj * 128 + n * 16); gsv[bj][n] = *(const f32x4*)(gs + col0 + bj * 128 + n * 16); }
#pragma unroll
        for (int ai = 0; ai < 2; ++ai)
#pragma unroll
            for (int m = 0; m < 4; ++m) { const int rl = row0 + ai * 128 + m * 16; const size_t off = (size_t)rl * D + col0;
                int arow = u.pm * 256 + wr * 64 + fr + ai * 128 + m * 16;
                if (permute && !isctx) { const int b = arow / L, t = arow % L; arow = b * L + (t % 64) * 128 + t / 64; }
                float ss = 0.f;
#pragma unroll
                for (int bj = 0; bj < 2; ++bj)
#pragma unroll
                    for (int n = 0; n < 2; ++n) { const f32x4 bs = *(const f32x4*)(bi + off + bj * 128 + n * 16); const f32x4 hn = bs + gv[bj][n] * acc[ai][bj][m][n];
                        *(f32x4*)(bo + off + bj * 128 + n * 16) = hn; ss += (hn[0] * hn[0] + hn[1] * hn[1]) + (hn[2] * hn[2] + hn[3] * hn[3]);
                        const f32x4 an = hn * gsv[bj][n]; u32x2 w; w.x = pack2(an[0], an[1]); w.y = pack2(an[2], an[3]); *(u32x2*)(act + (size_t)arow * D + col0 + bj * 128 + n * 16) = w; }
                ss += __shfl_xor(ss, 16); ss += __shfl_xor(ss, 32);
                if (fq == 0) ssqp[(size_t)arow * 16 + u.pn * 4 + wc] = ss; }
    }
};
struct EpiSwiglu {
    static constexpr bool PERM = true, AFTER_DRAIN = false;
    bf16_t* G; int pm0;
    DI void operator()(const f32x4 (&acc)[2][2][4][2], const pg8::Unit& u, int wr, int wc, int fr, int fq) const {
        const int row0 = (u.pm + pm0) * 256 + wr * 64 + fr, col0 = u.pn * 128 + wc * 32 + 8 * fq;
#pragma unroll
        for (int ai = 0; ai < 2; ++ai)
#pragma unroll
            for (int m = 0; m < 4; ++m) { bf16_t* rowp = G + (size_t)(row0 + ai * 128 + m * 16) * DFF + col0; float g[8];
#pragma unroll
                for (int n = 0; n < 2; ++n) { const f32x4 a = acc[ai][0][m][n], b = acc[ai][1][m][n];
#pragma unroll
                    for (int j = 0; j < 4; ++j) g[4 * n + j] = a[j] * frcp(1.f + fexp(-a[j])) * b[j]; }
                u32x4 w; w.x = pack2(g[0], g[1]); w.y = pack2(g[2], g[3]); w.z = pack2(g[4], g[5]); w.w = pack2(g[6], g[7]); *(u32x4*)rowp = w; }
    }
};
template <class Epi> DI void run_gemm(LAS unsigned char* lds, const bf16_t* A, const bf16_t* Bt, int M, int N, int K, const Epi& E) {
    pg8::Gemm g{A, Bt, M, N, K}; pg8::StaticOrder S; S.init(M, N, (int)gridDim.x, (int)blockIdx.x);
    pg8::gemm_phase<Epi, pg8::StaticOrder, false>((PG8_LAS unsigned char*)lds, g, S, E, nullptr);
    __syncthreads();
}


DI void phase_norm_tables(const P& p) {
    const int tid = mk_tid(), lane = tid & 63, wv = tid >> 6;
    const float* MODV = (const float*)(p.ws + WS_MODV); float* GSC = (float*)(p.ws + WS_GSC); float* SHW = GSC + SHW_OFF;
    for (int e = blockIdx.x * NT + tid; e < 3 * 5 * 1024; e += gridDim.x * NT) { const int site = e / 5120, s = (e / 1024) % 5, c = e & 1023;
        const int layer = site ? 1 : 0, scidx = (site == 1) ? 1 : 4; const float g = p.in[(site == 1) ? I_N1G : I_N2G][layer * 1024 + c];
        GSC[e] = g * (1.f + MODV[(size_t)layer * 5 * 6144 + s * 6144 + scidx * 1024 + c]); }
    for (int w = blockIdx.x * 8 + wv; w < 5632 + 3584 + 5632; w += gridDim.x * 8) {
        int site, n; const bf16_t* Bt;
        if (w < 5632) { site = 0; n = w; Bt = (const bf16_t*)(p.ws + WS_W_UP); } else if (w < 5632 + 3584) { site = 1; n = w - 5632; Bt = (const bf16_t*)(p.ws + WS_W_ODIN); } else { site = 2; n = w - 5632 - 3584; Bt = (const bf16_t*)(p.ws + WS_W_UP) + W_UP_STRIDE; }
        const int layer = site ? 1 : 0, shidx = (site == 1) ? 0 : 3;
        const u32x4 w0 = *(const u32x4*)(Bt + (size_t)n * 1024 + 16 * lane), w1 = *(const u32x4*)(Bt + (size_t)n * 1024 + 16 * lane + 8);
        float wf[16];
#pragma unroll
        for (int k = 0; k < 4; ++k) { wf[2 * k] = __uint_as_float(w0[k] << 16); wf[2 * k + 1] = __uint_as_float(w0[k] & 0xffff0000u); wf[8 + 2 * k] = __uint_as_float(w1[k] << 16); wf[8 + 2 * k + 1] = __uint_as_float(w1[k] & 0xffff0000u); }
#pragma unroll
        for (int s = 0; s < 5; ++s) { const float* sh = MODV + (size_t)layer * 5 * 6144 + s * 6144 + shidx * 1024 + 16 * lane; float a = 0.f;
#pragma unroll
            for (int k = 0; k < 16; ++k) a += sh[k] * wf[k];
            a = wave_sum(a);
            if (lane == 0) SHW[(size_t)site * SHW_STRIDE + s * 5632 + n] = a; }
    }
}
DI void phase_rwkv_scan_unit(const P& p, LAS unsigned char* ldsb, const int vb) {
    LAS float* lds = (LAS float*)ldsb;
    LAS float *w2s = lds, *a2s = lds + 4096, *prm = lds + 8192, *TH = prm + 768, *AD = TH + 2048, *R = AD + 2048, *W = R + 2048, *K = W + 2048, *KK = K + 2048, *BV = KK + 2048,
              *V = BV + 2048, *BS = V + 2048, *OUT = BS + 32;
    const int tid = mk_tid(), lane = tid & 63, wv = tid >> 6;
    const bf16_t* RW = (const bf16_t*)(p.ws + WS_COLS) + OFF_RW; const bf16_t* LO = (const bf16_t*)(p.ws + WS_COLS) + OFF_LO; bf16_t* Z = (bf16_t*)(p.ws + WS_Z);
    const int srow = tid >> 3, sg = tid & 7;
    {
        const int d = vb >> 5, b = (vb >> 3) & 3, h = vb & 7;
        __syncthreads();
        for (int e = tid; e < 4096; e += NT) { const int i = e >> 6, c = e & 63; w2s[e] = p.in[I_W2L][(size_t)(d * 64 + i) * 512 + 64 * h + c]; a2s[e] = p.in[I_A2L][(size_t)(d * 64 + i) * 512 + 64 * h + c]; }
        if (tid < 64) { const int j = tid, c = 64 * h + j; const float* mu = p.in[I_MU] + d * 1664;
            prm[j] = mu[c]; prm[64 + j] = mu[512 + c]; prm[128 + j] = mu[1024 + c]; prm[192 + j] = mu[1536 + j]; prm[256 + j] = mu[1600 + j];
            prm[320 + j] = p.in[I_W0][d * 512 + c]; prm[384 + j] = p.in[I_A0][d * 512 + c]; prm[448 + j] = p.in[I_KK][d * 512 + c]; prm[512 + j] = p.in[I_KA][d * 512 + c];
            prm[576 + j] = p.in[I_RK][(d * 8 + h) * 64 + j]; prm[640 + j] = p.in[I_LNW][d * 512 + c]; prm[704 + j] = p.in[I_LNB][d * 512 + c]; }
        __syncthreads();
        float S0 = 0.f, S1 = 0.f, S2 = 0.f, S3 = 0.f, S4 = 0.f, S5 = 0.f, S6 = 0.f, S7 = 0.f;
        for (int n0 = 0; n0 < LT; n0 += 32) {
            float rs[4], ks[4], vs[4];
#pragma unroll
            for (int m = 0; m < 4; ++m) { const int s = wv + 8 * m, n = n0 + s; const bool hp = (n != 0) && (n != LC);
                const size_t row = (size_t)step_row(d, b, n), prow = hp ? (size_t)step_row(d, b, n - 1) : row; const int c = 64 * h + lane;
                const float r0 = bf2f(RW[row * 1536 + c]), k0 = bf2f(RW[row * 1536 + 512 + c]), v0 = bf2f(RW[row * 1536 + 1024 + c]);
                const float r1 = hp ? bf2f(RW[prow * 1536 + c]) : 0.f, k1 = hp ? bf2f(RW[prow * 1536 + 512 + c]) : 0.f, v1 = hp ? bf2f(RW[prow * 1536 + 1024 + c]) : 0.f;
                rs[m] = r0 + prm[lane] * (r1 - r0); ks[m] = k0 + prm[64 + lane] * (k1 - k0); vs[m] = v0 + prm[128 + lane] * (v1 - v0);
                const float wd0 = bf2f(LO[row * 512 + 64 * d + lane]), wd1 = hp ? bf2f(LO[prow * 512 + 64 * d + lane]) : 0.f;
                const float ad0 = bf2f(LO[row * 512 + 128 + 64 * d + lane]), ad1 = hp ? bf2f(LO[prow * 512 + 128 + 64 * d + lane]) : 0.f;
                TH[s * 64 + lane] = tanhf(wd0 + prm[192 + lane] * (wd1 - wd0)); AD[s * 64 + lane] = ad0 + prm[256 + lane] * (ad1 - ad0); }
            __syncthreads();
#pragma unroll
            for (int m = 0; m < 4; ++m) { const int s = wv + 8 * m;
                float xw = prm[320 + lane], xa = prm[384 + lane];
#pragma unroll 8
                for (int i = 0; i < 64; ++i) { xw += TH[s * 64 + i] * w2s[i * 64 + lane]; xa += AD[s * 64 + i] * a2s[i * 64 + lane]; }
                const float elog = 0.6065306597126334f * sigm(xw), dec = expf(-elog), a = sigm(xa);
                const float kkr = ks[m] * prm[448 + lane]; const float ss = wave_sum(kkr * kkr); const float kkn = kkr / fmaxf(sqrtf(ss), 1e-12f);
                const float km = ks[m] * (1.f + (a - 1.f) * prm[512 + lane]);
                const float bs = wave_sum(rs[m] * km * prm[576 + lane]);
                R[s * 64 + lane] = rs[m]; W[s * 64 + lane] = dec; K[s * 64 + lane] = km; KK[s * 64 + lane] = kkn; BV[s * 64 + lane] = kkn * a; V[s * 64 + lane] = vs[m];
                if (lane == 0) BS[s] = bs; }
            __syncthreads();
            for (int s = 0; s < 32; ++s) {
                const LAS f32x4* pq = (const LAS f32x4*)(KK + s * 64 + 8 * sg); const f32x4 q0 = pq[0], q1 = pq[1];
                const LAS f32x4* pw = (const LAS f32x4*)(W + s * 64 + 8 * sg); const f32x4 w0 = pw[0], w1 = pw[1];
                const LAS f32x4* pb = (const LAS f32x4*)(BV + s * 64 + 8 * sg); const f32x4 b0 = pb[0], b1 = pb[1];
                const LAS f32x4* pk = (const LAS f32x4*)(K + s * 64 + 8 * sg); const f32x4 k0 = pk[0], k1 = pk[1];
                const LAS f32x4* pr = (const LAS f32x4*)(R + s * 64 + 8 * sg); const f32x4 r0 = pr[0], r1 = pr[1];
                const float vi = V[s * 64 + srow];
                float sa = S0 * q0.x + S1 * q0.y + S2 * q0.z + S3 * q0.w + S4 * q1.x + S5 * q1.y + S6 * q1.z + S7 * q1.w;
                sa += __shfl_xor(sa, 1); sa += __shfl_xor(sa, 2); sa += __shfl_xor(sa, 4);
                S0 = S0 * w0.x - sa * b0.x + vi * k0.x; S1 = S1 * w0.y - sa * b0.y + vi * k0.y; S2 = S2 * w0.z - sa * b0.z + vi * k0.z; S3 = S3 * w0.w - sa * b0.w + vi * k0.w;
                S4 = S4 * w1.x - sa * b1.x + vi * k1.x; S5 = S5 * w1.y - sa * b1.y + vi * k1.y; S6 = S6 * w1.z - sa * b1.z + vi * k1.z; S7 = S7 * w1.w - sa * b1.w + vi * k1.w;
                float o = S0 * r0.x + S1 * r0.y + S2 * r0.z + S3 * r0.w + S4 * r1.x + S5 * r1.y + S6 * r1.z + S7 * r1.w;
                o += __shfl_xor(o, 1); o += __shfl_xor(o, 2); o += __shfl_xor(o, 4);
                if (sg == 0) OUT[s * 64 + srow] = o;
            }
            __syncthreads();
#pragma unroll
            for (int m = 0; m < 4; ++m) { const int s = wv + 8 * m, n = n0 + s; const size_t row = (size_t)step_row(d, b, n);
                const float o = OUT[s * 64 + lane]; const float mean = wave_sum(o) * (1.f / 64.f); const float dv = o - mean; const float var = wave_sum(dv * dv) * (1.f / 64.f);
                const float z = dv * rsqrtf(var + 64e-5f) * prm[640 + lane] + prm[704 + lane] + BS[s] * V[s * 64 + lane];
                Z[((size_t)d * NALL + row) * 512 + 64 * h + lane] = f2bf(z); }
        }
    }
    __syncthreads();
}
DI void phase_rwkv_post(const P& p, LAS unsigned char* ldsb) {
    LAS float* sg = (LAS float*)ldsb;
    const int tid = mk_tid();
    const bf16_t* LO = (const bf16_t*)(p.ws + WS_COLS) + OFF_LO; const bf16_t* Z = (const bf16_t*)(p.ws + WS_Z); bf16_t* Y = (bf16_t*)(p.ws + WS_COLS);
    const float* g2 = p.in[I_G2];
    for (int vb = blockIdx.x; vb < NALL / 8; vb += gridDim.x) {
        const size_t row0 = (size_t)vb * 8;
        __syncthreads();
        for (int e = tid; e < 1024; e += NT) { const int q = e >> 7, r = e & 127; sg[e] = sigm(bf2f(LO[(row0 + q) * 512 + 256 + r])); }
        __syncthreads();
        float a0 = 0.f, a1 = 0.f, a2 = 0.f, a3 = 0.f, a4 = 0.f, a5 = 0.f, a6 = 0.f, a7 = 0.f;
#pragma unroll 4
        for (int r = 0; r < 128; ++r) { const float g = g2[r * 512 + tid];
            a0 += sg[r] * g; a1 += sg[128 + r] * g; a2 += sg[256 + r] * g; a3 += sg[384 + r] * g; a4 += sg[512 + r] * g; a5 += sg[640 + r] * g; a6 += sg[768 + r] * g; a7 += sg[896 + r] * g; }
#define MK_RP(q, aq) { const size_t rr = row0 + q; const float z = bf2f(Z[rr * 512 + tid]) + bf2f(Z[((size_t)NALL + rr) * 512 + tid]); Y[rr * D + tid] = f2bf(z * aq); }
        MK_RP(0, a0) MK_RP(1, a1) MK_RP(2, a2) MK_RP(3, a3) MK_RP(4, a4) MK_RP(5, a5) MK_RP(6, a6) MK_RP(7, a7)
#undef MK_RP
    }
    __syncthreads();
}
DI void post_headnorm_row(const bf16_t* HB, size_t row, const float* ng, const bf16_t* gsrc, int gate_kind, bf16_t* ydst, int lane) {
    const int c0 = 8 * lane;
    const u32x4 h0 = *(const u32x4*)(HB + row * 512 + c0), h1 = *(const u32x4*)(HB + ((size_t)NALL + row) * 512 + c0), gg = *(const u32x4*)(gsrc + c0);
    float h[8], g[8];
#pragma unroll
    for (int j = 0; j < 4; ++j) { h[2 * j] = __uint_as_float(h0[j] << 16) + __uint_as_float(h1[j] << 16); h[2 * j + 1] = __uint_as_float(h0[j] & 0xffff0000u) + __uint_as_float(h1[j] & 0xffff0000u);
        g[2 * j] = __uint_as_float(gg[j] << 16); g[2 * j + 1] = __uint_as_float(gg[j] & 0xffff0000u); }
    float ss = 0.f;
#pragma unroll
    for (int j = 0; j < 8; ++j) ss += h[j] * h[j];
    ss += __shfl_xor(ss, 1); ss += __shfl_xor(ss, 2); ss += __shfl_xor(ss, 4); ss += __shfl_xor(ss, 8);
    const float rinv = rsqrtf(ss * (1.f / 128.f) + 1e-6f);
    unsigned o[4];
#pragma unroll
    for (int j = 0; j < 4; ++j) { const float y0 = h[2 * j] * rinv * ng[c0 + 2 * j] * (gate_kind ? siluf(g[2 * j]) : sigm(g[2 * j])), y1 = h[2 * j + 1] * rinv * ng[c0 + 2 * j + 1] * (gate_kind ? siluf(g[2 * j + 1]) : sigm(g[2 * j + 1]));
        o[j] = pack2(y0, y1); }
    u32x4 w; w.x = o[0]; w.y = o[1]; w.z = o[2]; w.w = o[3];
    *(u32x4*)(ydst + c0) = w;
}
typedef short bf16x8 __attribute__((ext_vector_type(8)));
typedef short s16x4 __attribute__((ext_vector_type(4)));
constexpr int PQ = 136, PS = 72, PV = 56;
constexpr int E_QS = 0, E_KS = E_QS + 64 * PQ * 2, E_VS = E_KS + 64 * PQ * 2, E_PS = E_VS + 64 * PV * 2, E_ST = E_PS + 64 * PS * 2, E_F = E_ST + 48 * PQ * 2, E_END = E_F + 2048;
constexpr size_t WS_Q1 = WS_COLS + (size_t)231 * MiB;
constexpr int NRC = NALL / 64;

DI int chunk_row0(int d, int b, int ci) {
    if (ci < 4) { const int cc = d ? 3 - ci : ci; return NLAT + b * LC + 64 * cc; }
    const int lc = ci - 4, cl = d ? 127 - lc : lc; return b * L + 64 * cl;
}
DI bf16x8 tr_frag(unsigned tile_base, int pitch, int k0, int c0, int r, int q) {
    const unsigned a0 = tile_base + (unsigned)(((k0 + 8 * q + (r >> 2)) * pitch + c0 + 4 * (r & 3)) * 2), a1 = a0 + (unsigned)(4 * pitch * 2);
    s16x4 x, y;
    asm volatile("ds_read_b64_tr_b16 %0, %2\n\tds_read_b64_tr_b16 %1, %3\n\ts_waitcnt lgkmcnt(0)" : "=&v"(x), "=&v"(y) : "v"(a0), "v"(a1) : "memory");
    bf16x8 o; o[0] = x[0]; o[1] = x[1]; o[2] = x[2]; o[3] = x[3]; o[4] = y[0]; o[5] = y[1]; o[6] = y[2]; o[7] = y[3];
    return o;
}

DI unsigned tr_addr(unsigned tile_base, int pitch, int k0, int c0, int r, int q) { return tile_base + (unsigned)(((k0 + 8 * q + (r >> 2)) * pitch + c0 + 4 * (r & 3)) * 2); }
DI bf16x8 tr_join(s16x4 x, s16x4 y) { bf16x8 o; o[0] = x[0]; o[1] = x[1]; o[2] = x[2]; o[3] = x[3]; o[4] = y[0]; o[5] = y[1]; o[6] = y[2]; o[7] = y[3]; return o; }
DI void tr_frag2(bf16x8& f0, bf16x8& f1, unsigned a0, unsigned h0, unsigned a1, unsigned h1) {
    s16x4 x0, y0, x1, y1; const unsigned b0 = a0 + h0, b1 = a1 + h1;
    asm volatile("ds_read_b64_tr_b16 %0, %4\n\tds_read_b64_tr_b16 %1, %5\n\tds_read_b64_tr_b16 %2, %6\n\tds_read_b64_tr_b16 %3, %7\n\ts_waitcnt lgkmcnt(0)"
                 : "=&v"(x0), "=&v"(y0), "=&v"(x1), "=&v"(y1) : "v"(a0), "v"(b0), "v"(a1), "v"(b1) : "memory");
    f0 = tr_join(x0, y0); f1 = tr_join(x1, y1);
}
DI void tr_frag3(bf16x8& f0, bf16x8& f1, bf16x8& f2, unsigned a0, unsigned h0, unsigned a1, unsigned h1, unsigned a2, unsigned h2) {
    s16x4 x0, y0, x1, y1, x2, y2; const unsigned b0 = a0 + h0, b1 = a1 + h1, b2 = a2 + h2;
    asm volatile("ds_read_b64_tr_b16 %0, %6\n\tds_read_b64_tr_b16 %1, %7\n\tds_read_b64_tr_b16 %2, %8\n\tds_read_b64_tr_b16 %3, %9\n\tds_read_b64_tr_b16 %4, %10\n\tds_read_b64_tr_b16 %5, %11\n\ts_waitcnt lgkmcnt(0)"
                 : "=&v"(x0), "=&v"(y0), "=&v"(x1), "=&v"(y1), "=&v"(x2), "=&v"(y2) : "v"(a0), "v"(b0), "v"(a1), "v"(b1), "v"(a2), "v"(b2) : "memory");
    f0 = tr_join(x0, y0); f1 = tr_join(x1, y1); f2 = tr_join(x2, y2);
}
DI void tr_frag4(bf16x8& f0, bf16x8& f1, bf16x8& f2, bf16x8& f3, unsigned a0, unsigned h0, unsigned a1, unsigned h1, unsigned a2, unsigned h2, unsigned a3, unsigned h3) {
    s16x4 x0, y0, x1, y1, x2, y2, x3, y3; const unsigned b0 = a0 + h0, b1 = a1 + h1, b2 = a2 + h2, b3 = a3 + h3;
    asm volatile("ds_read_b64_tr_b16 %0, %8\n\tds_read_b64_tr_b16 %1, %9\n\tds_read_b64_tr_b16 %2, %10\n\tds_read_b64_tr_b16 %3, %11\n\tds_read_b64_tr_b16 %4, %12\n\tds_read_b64_tr_b16 %5, %13\n\tds_read_b64_tr_b16 %6, %14\n\tds_read_b64_tr_b16 %7, %15\n\ts_waitcnt lgkmcnt(0)"
                 : "=&v"(x0), "=&v"(y0), "=&v"(x1), "=&v"(y1), "=&v"(x2), "=&v"(y2), "=&v"(x3), "=&v"(y3) : "v"(a0), "v"(b0), "v"(a1), "v"(b1), "v"(a2), "v"(b2), "v"(a3), "v"(b3) : "memory");
    f0 = tr_join(x0, y0); f1 = tr_join(x1, y1); f2 = tr_join(x2, y2); f3 = tr_join(x3, y3);
}
DI void tr_frag5(bf16x8& f0, bf16x8& f1, bf16x8& f2, bf16x8& f3, bf16x8& f4, unsigned a0, unsigned h0, unsigned a1, unsigned h1, unsigned a2, unsigned h2, unsigned a3, unsigned h3, unsigned a4, unsigned h4) {
    s16x4 x0, y0, x1, y1, x2, y2, x3, y3, x4, y4; const unsigned b0 = a0 + h0, b1 = a1 + h1, b2 = a2 + h2, b3 = a3 + h3, b4 = a4 + h4;
    asm volatile("ds_read_b64_tr_b16 %0, %10\n\tds_read_b64_tr_b16 %1, %11\n\tds_read_b64_tr_b16 %2, %12\n\tds_read_b64_tr_b16 %3, %13\n\tds_read_b64_tr_b16 %4, %14\n\tds_read_b64_tr_b16 %5, %15\n\tds_read_b64_tr_b16 %6, %16\n\tds_read_b64_tr_b16 %7, %17\n\tds_read_b64_tr_b16 %8, %18\n\tds_read_b64_tr_b16 %9, %19\n\ts_waitcnt lgkmcnt(0)"
                 : "=&v"(x0), "=&v"(y0), "=&v"(x1), "=&v"(y1), "=&v"(x2), "=&v"(y2), "=&v"(x3), "=&v"(y3), "=&v"(x4), "=&v"(y4) : "v"(a0), "v"(b0), "v"(a1), "v"(b1), "v"(a2), "v"(b2), "v"(a3), "v"(b3), "v"(a4), "v"(b4) : "memory");
    f0 = tr_join(x0, y0); f1 = tr_join(x1, y1); f2 = tr_join(x2, y2); f3 = tr_join(x3, y3); f4 = tr_join(x4, y4);
}

#define GLA_PREFETCH(ci_) do { const int row0_ = chunk_row0(d, b, (ci_)); \
    _Pragma("unroll") for (int i = 0; i < 2; ++i) { const size_t row_ = (size_t)(row0_ + prow0 + 32 * i); \
        rq[i] = *(const u32x4*)(Qg + row_ * ldq + 8 * ppc); rk[i] = *(const u32x4*)(Kg + row_ * ldk + 8 * ppc); } \
    if (tid < 256) rv = *(const u32x4*)(Vg + (size_t)(row0_ + vrow) * ldv + 8 * vpc); \
    if (MODE != 0) rlam = *(const f32x4*)(LAM + ((size_t)d * NRC + (row0_ >> 6)) * 512 + 128 * hd + 16 * wv + 4 * q); } while (0)

DI float flog(float x) { return __builtin_amdgcn_logf(x) * 0.6931471805599453f; }
#define GLA_GATE_LOAD(ci_) do { const size_t row_ = (size_t)(chunk_row0(d, b, (ci_)) + (d ? 63 - lane : lane)); gi = bf2f(LO[row_ * 512 + 384 + 4 * d + hd]); gf = bf2f(LO[row_ * 512 + 392 + 4 * d + hd]); } while (0)
#define GLA_GATE_COMPUTE(buf_) do { const float li_ = gi + bi, x_ = gf + bfv; float v_ = scan16(-flog(1.f + fexp(-x_))); \
    const float t0_ = __int_as_float(__builtin_amdgcn_readlane(__float_as_int(v_), 15)), t1_ = __int_as_float(__builtin_amdgcn_readlane(__float_as_int(v_), 31)), t2_ = __int_as_float(__builtin_amdgcn_readlane(__float_as_int(v_), 47)); \
    v_ += (q >= 1 ? t0_ : 0.f) + (q >= 2 ? t1_ : 0.f) + (q >= 3 ? t2_ : 0.f); const int rc_ = d ? 63 - lane : lane; LAS float* F_ = Fs + (buf_) * 132; \
    F_[rc_] = fexp(v_) * 0.08838834764831845f; F_[64 + rc_] = fexp(li_ - v_); if (lane == 63) F_[128] = fexp(v_); } while (0)
template <int MODE> DI void gla_unit(const P& p, LAS unsigned char* lds, int unit) {
    constexpr int NDV = MODE == 0 ? 3 : 2;
    const int tid = mk_tid(), lane = tid & 63, wv = __builtin_amdgcn_readfirstlane(tid >> 6), r = lane & 15, q = lane >> 4;
    const int d = unit >> 6, b = (unit >> 4) & 3, hd = (unit >> 2) & 3, sl = unit & 3;
    const bf16_t* COLS = (const bf16_t*)(p.ws + WS_COLS);
    const bf16_t *Qg, *Kg, *Vg; int ldq, ldk, ldv;
    if (MODE == 0) { const bf16_t* ML = COLS + OFF_ML; Qg = ML + 128 * hd; Kg = ML + 512 + 128 * hd; Vg = ML + 1024 + 128 * hd + 32 * sl; ldq = ldk = ldv = 2048; }
    else { Qg = d ? (const bf16_t*)(p.ws + WS_Q1) + 128 * hd : COLS + 128 * hd; ldq = d ? 512 : 3584; Kg = COLS + 512 + 512 * d + 128 * hd; ldk = 3584; Vg = COLS + 1536 + 128 * hd + 32 * sl; ldv = 3584; }
    const bf16_t* LO = COLS + OFF_LO;
    const float* LAM = (const float*)(p.ws + WS_LAM);
    bf16_t* HB = (bf16_t*)(p.ws + WS_ACT);
    LAS bf16_t* Qs = (LAS bf16_t*)(lds + E_QS); LAS bf16_t* Ks = (LAS bf16_t*)(lds + E_KS); LAS bf16_t* Vs = (LAS bf16_t*)(lds + E_VS);
    LAS bf16_t* Ps = (LAS bf16_t*)(lds + E_PS); LAS bf16_t* STs = (LAS bf16_t*)(lds + E_ST); LAS float* Fs = (LAS float*)(lds + E_F);
    const unsigned ks_base = (unsigned)(size_t)Ks, vs_base = (unsigned)(size_t)Vs;
    float bi = 0.f, bfv = 0.f;
    if (MODE == 0) { bi = p.in[I_MBI][d * 4 + hd]; bfv = p.in[I_MBF][d * 4 + hd]; }
    __syncthreads();
    for (int e = tid; e < 48 * PQ / 2; e += NT) ((LAS unsigned*)STs)[e] = 0u;
    for (int e = tid; e < 64 * PV / 2; e += NT) ((LAS unsigned*)Vs)[e] = 0u;
    __syncthreads();
    f32x4 Sacc[NDV];
#pragma unroll
    for (int n = 0; n < NDV; ++n) Sacc[n] = (f32x4){0.f, 0.f, 0.f, 0.f};
    u32x4 rq[2], rk[2], rv = (u32x4){0u, 0u, 0u, 0u}; float gi = 0.f, gf = 0.f; f32x4 rlam = (f32x4){1.f, 1.f, 1.f, 1.f};
    const int prow0 = tid >> 4, ppc = tid & 15;
    const int vrow = tid >> 2, vpc = tid & 3;
    GLA_PREFETCH(0);
    if (MODE == 0) { if (tid < 64) { GLA_GATE_LOAD(0); GLA_GATE_COMPUTE(0); GLA_GATE_LOAD(1); } __syncthreads(); }
    for (int ci = 0; ci < 132; ++ci) {
        const int row0 = chunk_row0(d, b, ci);
        unsigned oz = 0u; asm volatile("" : "+v"(oz));
        const unsigned ks_b = ks_base + oz, vs_b = vs_base + oz;
        f32x4 lamv = rlam;
        const LAS float* Fc = Fs + (ci & 1) * 132;
#pragma unroll
        for (int i = 0; i < 2; ++i) { const int row = prow0 + 32 * i; *(LAS u32x4*)(Qs + row * PQ + 8 * ppc) = rq[i]; *(LAS u32x4*)(Ks + row * PQ + 8 * ppc) = rk[i]; }
        if (tid < 256) {
            if (MODE == 0) { const float w = Fc[64 + vrow]; u32x4 o;
#pragma unroll
                for (int e = 0; e < 4; ++e) o[e] = pack2(__uint_as_float(rv[e] << 16) * w, __uint_as_float(rv[e] & 0xffff0000u) * w);
                *(LAS u32x4*)(Vs + vrow * PV + 8 * vpc) = o;
                if (vpc == 0) Vs[vrow * PV + 32] = f2bf(w); }
            else *(LAS u32x4*)(Vs + vrow * PV + 8 * vpc) = rv;
        }
        __syncthreads();
        if (ci + 1 < 132) GLA_PREFETCH(ci + 1);
        if (MODE == 0) { const float l = Fc[128]; lamv = (f32x4){l, l, l, l};
            if (tid < 64 && ci + 1 < 132) { GLA_GATE_COMPUTE((ci + 1) & 1); if (ci + 2 < 132) GLA_GATE_LOAD(ci + 2); } }
        {
            const int tt = wv & 3, sh = wv >> 2;
            f32x4 pacc[2] = {(f32x4){0.f, 0.f, 0.f, 0.f}, (f32x4){0.f, 0.f, 0.f, 0.f}};
#pragma unroll
            for (int kk = 0; kk < 4; ++kk) { const bf16x8 bq = *(const LAS bf16x8*)(Qs + (16 * tt + r) * PQ + 32 * kk + 8 * q);
#pragma unroll
                for (int i = 0; i < 2; ++i) { const bf16x8 a = *(const LAS bf16x8*)(Ks + (16 * (2 * sh + i) + r) * PQ + 32 * kk + 8 * q); pacc[i] = __builtin_amdgcn_mfma_f32_16x16x32_bf16(a, bq, pacc[i], 0, 0, 0); } }
            const int t = 16 * tt + r;
#pragma unroll
            for (int i = 0; i < 2; ++i) { const int s0 = 16 * (2 * sh + i) + 4 * q; float v[4];
#pragma unroll
                for (int j = 0; j < 4; ++j) { const int s = s0 + j; const bool ok = d ? (s >= t) : (s <= t); v[j] = ok ? pacc[i][j] : 0.f; }
                u32x2 w; w.x = pack2(v[0], v[1]); w.y = pack2(v[2], v[3]); *(LAS u32x2*)(Ps + t * PS + s0) = w; }
        }
        bf16x8 vfr[2][3];
#pragma unroll
        for (int kk = 0; kk < 2; ++kk) { bf16x8 a;
            if (NDV == 3) tr_frag4(a, vfr[kk][0], vfr[kk][1], vfr[kk][2], tr_addr(ks_b, PQ, 32 * kk, 16 * wv, r, q), 8u * PQ, tr_addr(vs_b, PV, 32 * kk, 0, r, q), 8u * PV, tr_addr(vs_b, PV, 32 * kk, 16, r, q), 8u * PV, tr_addr(vs_b, PV, 32 * kk, 32, r, q), 8u * PV);
            else { tr_frag3(a, vfr[kk][0], vfr[kk][1], tr_addr(ks_b, PQ, 32 * kk, 16 * wv, r, q), 8u * PQ, tr_addr(vs_b, PV, 32 * kk, 0, r, q), 8u * PV, tr_addr(vs_b, PV, 32 * kk, 16, r, q), 8u * PV); vfr[kk][2] = vfr[kk][1]; }
#pragma unroll
            for (int n = 0; n < NDV; ++n) Sacc[n] = __builtin_amdgcn_mfma_f32_16x16x32_bf16(a, vfr[kk][n], Sacc[n], 0, 0, 0); }
        __syncthreads();
        {
            const int tt = wv & 3, nA = wv >> 2;
            f32x4 oacc = (f32x4){0.f, 0.f, 0.f, 0.f}, dacc = (f32x4){0.f, 0.f, 0.f, 0.f};
#pragma unroll
            for (int kk = 0; kk < 2; ++kk) { const bf16x8 bp = *(const LAS bf16x8*)(Ps + (16 * tt + r) * PS + 32 * kk + 8 * q);
                const bf16x8 a = nA ? vfr[kk][1] : vfr[kk][0]; oacc = __builtin_amdgcn_mfma_f32_16x16x32_bf16(a, bp, oacc, 0, 0, 0);
                if (MODE == 0) dacc = __builtin_amdgcn_mfma_f32_16x16x32_bf16(vfr[kk][2], bp, dacc, 0, 0, 0); }
#pragma unroll
            for (int kk = 0; kk < 4; ++kk) { const bf16x8 bq = *(const LAS bf16x8*)(Qs + (16 * tt + r) * PQ + 32 * kk + 8 * q);
                const bf16x8 a = *(const LAS bf16x8*)(STs + (16 * nA + r) * PQ + 32 * kk + 8 * q); oacc = __builtin_amdgcn_mfma_f32_16x16x32_bf16(a, bq, oacc, 0, 0, 0);
                if (MODE == 0) { const bf16x8 a2 = *(const LAS bf16x8*)(STs + (32 + r) * PQ + 32 * kk + 8 * q); dacc = __builtin_amdgcn_mfma_f32_16x16x32_bf16(a2, bq, dacc, 0, 0, 0); } }
            const int t = 16 * tt + r;
            float o0 = oacc[0], o1 = oacc[1], o2 = oacc[2], o3 = oacc[3];
            if (MODE == 0) { const float rs = Fc[t]; const float den = __shfl(dacc[0], r) * rs; const float inv = rs / fmaxf(fabsf(den), 1.f); o0 *= inv; o1 *= inv; o2 *= inv; o3 *= inv; }
            u32x2 w; w.x = pack2(o0, o1); w.y = pack2(o2, o3);
            *(u32x2*)(HB + ((size_t)d * NALL + row0 + t) * 512 + 128 * hd + 32 * sl + 16 * nA + 4 * q) = w;
        }
        __syncthreads();
#pragma unroll
        for (int n = 0; n < NDV; ++n) { Sacc[n] = Sacc[n] * lamv; u32x2 w; w.x = pack2(Sacc[n][0], Sacc[n][1]); w.y = pack2(Sacc[n][2], Sacc[n][3]); *(LAS u32x2*)(STs + (16 * n + r) * PQ + 16 * wv + 4 * q) = w; }
    }
    __syncthreads();
}

DI void phase_hgrn_prep(const P& p, LAS unsigned char* ldsb) {
    LAS float* tot = (LAS float*)ldsb;
    const int tid = mk_tid(), ch = tid & 127, qt = tid >> 7;
    bf16_t* C1 = (bf16_t*)(p.ws + WS_COLS); bf16_t* Q1 = (bf16_t*)(p.ws + WS_Q1); float* LAM = (float*)(p.ws + WS_LAM);
    for (int vb = blockIdx.x; vb < NRC * 4; vb += gridDim.x) {
        const int rc = vb >> 2, hd = vb & 3, c = 128 * hd + ch; const size_t rbase = (size_t)rc * 64 + 16 * qt;
        const float lb = sigm(p.in[I_HLB][512 + c] - p.in[I_HLB][c]);
        float qv[16], l0[16], l1[16], k0[16], k1[16];
#pragma unroll
        for (int i = 0; i < 16; ++i) { const bf16_t* base = C1 + (rbase + i) * 3584;
            qv[i] = siluf(bf2f(base[c])); const float s0 = sigm(bf2f(base[512 + c])), s1 = sigm(bf2f(base[1024 + c]));
            l0[i] = logf(lb + (1.f - lb) * s0); l1[i] = logf(lb + (1.f - lb) * s1); k0[i] = (1.f - lb) * (1.f - s0); k1[i] = (1.f - lb) * (1.f - s1); }
#pragma unroll
        for (int i = 1; i < 16; ++i) l0[i] += l0[i - 1];
#pragma unroll
        for (int i = 14; i >= 0; --i) l1[i] += l1[i + 1];
        __syncthreads();
        tot[qt * 128 + ch] = l0[15]; tot[512 + qt * 128 + ch] = l1[0];
        __syncthreads();
        float off0 = 0.f, off1 = 0.f, t0 = 0.f, t1 = 0.f;
#pragma unroll
        for (int j = 0; j < 4; ++j) { const float a = tot[j * 128 + ch], bb = tot[512 + j * 128 + ch]; t0 += a; t1 += bb; if (j < qt) off0 += a; if (j > qt) off1 += bb; }
#pragma unroll
        for (int i = 0; i < 16; ++i) { bf16_t* base = C1 + (rbase + i) * 3584; const float c0 = l0[i] + off0, c1 = l1[i] + off1;
            base[c] = f2bf(qv[i] * expf(c0)); base[512 + c] = f2bf(k0[i] * expf(-c0)); base[1024 + c] = f2bf(k1[i] * expf(-c1)); Q1[(rbase + i) * 512 + c] = f2bf(qv[i] * expf(c1)); }
        if (qt == 0) { LAM[((size_t)rc) * 512 + c] = expf(t0); LAM[((size_t)NRC + rc) * 512 + c] = expf(t1); }
    }
    __syncthreads();
}
DI void phase_hgrn_prep2(const P& p, LAS unsigned char* ldsb) {
    LAS float* tot = (LAS float*)ldsb;
    const int tid = mk_tid(), cp = tid & 63, qt = (tid >> 6) & 3, rs = tid >> 8, c0 = 8 * cp;
    bf16_t* C1 = (bf16_t*)(p.ws + WS_COLS); bf16_t* Q1 = (bf16_t*)(p.ws + WS_Q1); float* LAM = (float*)(p.ws + WS_LAM);
    float lb[8], omlb[8];
#pragma unroll
    for (int k = 0; k < 8; ++k) { lb[k] = fsigm(p.in[I_HLB][512 + c0 + k] - p.in[I_HLB][c0 + k]); omlb[k] = 1.f - lb[k]; }
    for (int vb = blockIdx.x; vb < NRC / 2; vb += gridDim.x) {
        const int rc = 2 * vb + rs; const size_t rbase = (size_t)rc * 64 + 16 * qt;
        float s0[8], s1[8];
#pragma unroll
        for (int k = 0; k < 8; ++k) { s0[k] = 0.f; s1[k] = 0.f; }
#pragma unroll 4
        for (int i = 0; i < 16; ++i) { const bf16_t* base = C1 + (rbase + i) * 3584; const u32x4 f0 = *(const u32x4*)(base + 512 + c0), f1 = *(const u32x4*)(base + 1024 + c0);
#pragma unroll
            for (int k = 0; k < 4; ++k) { s0[2 * k] += flog(lb[2 * k] + omlb[2 * k] * fsigm(__uint_as_float(f0[k] << 16))); s0[2 * k + 1] += flog(lb[2 * k + 1] + omlb[2 * k + 1] * fsigm(__uint_as_float(f0[k] & 0xffff0000u)));
                s1[2 * k] += flog(lb[2 * k] + omlb[2 * k] * fsigm(__uint_as_float(f1[k] << 16))); s1[2 * k + 1] += flog(lb[2 * k + 1] + omlb[2 * k + 1] * fsigm(__uint_as_float(f1[k] & 0xffff0000u))); } }
        __syncthreads();
#pragma unroll
        for (int k = 0; k < 8; k += 4) { *(LAS f32x4*)(tot + ((rs * 2 + 0) * 4 + qt) * 512 + c0 + k) = (f32x4){s0[k], s0[k + 1], s0[k + 2], s0[k + 3]}; *(LAS f32x4*)(tot + ((rs * 2 + 1) * 4 + qt) * 512 + c0 + k) = (f32x4){s1[k], s1[k + 1], s1[k + 2], s1[k + 3]}; }
        __syncthreads();
        float run0[8], run1[8], t0[8], t1[8];
#pragma unroll
        for (int k = 0; k < 8; ++k) { run0[k] = 0.f; run1[k] = 0.f; t0[k] = 0.f; t1[k] = 0.f; }
#pragma unroll
        for (int j = 0; j < 4; ++j)
#pragma unroll
            for (int k = 0; k < 8; ++k) { const float a = tot[((rs * 2 + 0) * 4 + j) * 512 + c0 + k], bb = tot[((rs * 2 + 1) * 4 + j) * 512 + c0 + k]; t0[k] += a; t1[k] += bb; if (j < qt) run0[k] += a; if (j >= qt) run1[k] += bb; }
        if (qt == 0) {
#pragma unroll
            for (int k = 0; k < 8; k += 4) { *(f32x4*)(LAM + (size_t)rc * 512 + c0 + k) = (f32x4){fexp(t0[k]), fexp(t0[k + 1]), fexp(t0[k + 2]), fexp(t0[k + 3])};
                *(f32x4*)(LAM + ((size_t)NRC + rc) * 512 + c0 + k) = (f32x4){fexp(t1[k]), fexp(t1[k + 1]), fexp(t1[k + 2]), fexp(t1[k + 3])}; } }
#pragma unroll 2
        for (int i = 0; i < 16; ++i) { bf16_t* base = C1 + (rbase + i) * 3584; const u32x4 qv = *(const u32x4*)(base + c0), f0 = *(const u32x4*)(base + 512 + c0), f1 = *(const u32x4*)(base + 1024 + c0);
            float oq0[8], ok0[8], ok1[8], oq1[8];
#pragma unroll
            for (int k = 0; k < 8; ++k) { const unsigned wq = qv[k >> 1], w0 = f0[k >> 1], w1 = f1[k >> 1];
                const float qx = (k & 1) ? __uint_as_float(wq & 0xffff0000u) : __uint_as_float(wq << 16), x0 = (k & 1) ? __uint_as_float(w0 & 0xffff0000u) : __uint_as_float(w0 << 16), x1 = (k & 1) ? __uint_as_float(w1 & 0xffff0000u) : __uint_as_float(w1 << 16);
                const float sq = qx * fsigm(qx), sg0 = fsigm(x0), sg1 = fsigm(x1);
                const float l0 = flog(lb[k] + omlb[k] * sg0), l1 = flog(lb[k] + omlb[k] * sg1);
                run0[k] += l0;
                const float cb = run1[k];
                run1[k] -= l1;
                const float e0 = fexp(run0[k]), e1 = fexp(cb);
                oq0[k] = sq * e0; ok0[k] = omlb[k] * (1.f - sg0) * frcp(e0); ok1[k] = omlb[k] * (1.f - sg1) * frcp(e1); oq1[k] = sq * e1; }
            u32x4 w; w.x = pack2(oq0[0], oq0[1]); w.y = pack2(oq0[2], oq0[3]); w.z = pack2(oq0[4], oq0[5]); w.w = pack2(oq0[6], oq0[7]); *(u32x4*)(base + c0) = w;
            w.x = pack2(ok0[0], ok0[1]); w.y = pack2(ok0[2], ok0[3]); w.z = pack2(ok0[4], ok0[5]); w.w = pack2(ok0[6], ok0[7]); *(u32x4*)(base + 512 + c0) = w;
            w.x = pack2(ok1[0], ok1[1]); w.y = pack2(ok1[2], ok1[3]); w.z = pack2(ok1[4], ok1[5]); w.w = pack2(ok1[6], ok1[7]); *(u32x4*)(base + 1024 + c0) = w;
            w.x = pack2(oq1[0], oq1[1]); w.y = pack2(oq1[2], oq1[3]); w.z = pack2(oq1[4], oq1[5]); w.w = pack2(oq1[6], oq1[7]); *(u32x4*)(Q1 + (rbase + i) * 512 + c0) = w; }
    }
    __syncthreads();
}
constexpr int XBP = 68, M_XB = 0, M_XCS = M_XB + 67 * XBP * 4, M_XCF = M_XCS + 64 * 72 * 2, M_W = M_XCF + 64 * 64 * 4, M_AU = M_W + 4 * 64 * 72 * 2, M_SEG = M_AU + 4 * 64 * 65 * 4, M_PRM = M_SEG + 4 * 8 * 64 * 4,
              M_CAR = M_PRM + 11 * 64 * 4, M_END = M_CAR + 2 * 64 * 4;
static_assert(M_END <= LDS_BYTES, "lru LDS map");
DI float nexpm1_small(float x) { const float ser = -x * (1.f + x * 0.5f * (1.f + x * (1.f / 3.f) * (1.f + x * 0.25f * (1.f + x * 0.2f)))); return (x > -0.25f) ? ser : 1.f - fexp(x); }
DI int lru_rc_at(int d, int b, int s) { if (s < 4) return 512 + 4 * b + (d ? 3 - s : s); const int lc = s - 4; return 128 * b + (d ? 127 - lc : lc); }
template <int PASS> DI void lru_pass(const P& p, LAS unsigned char* lds, const int lb, const int nlb) {
    const int tid = mk_tid(), lane = tid & 63, wv = __builtin_amdgcn_readfirstlane(tid >> 6), r = lane & 15, q = lane >> 4;
    const int hb = lb & 7;
    const bf16_t* C1 = (const bf16_t*)(p.ws + WS_COLS); bf16_t* Y = (bf16_t*)(p.ws + WS_Z); float* LSUM = (float*)(p.ws + WS_LSUM);
    LAS float* XB = (LAS float*)(lds + M_XB); LAS bf16_t* XCs = (LAS bf16_t*)(lds + M_XCS); LAS float* XCf = (LAS float*)(lds + M_XCF); LAS bf16_t* Wt = (LAS bf16_t*)(lds + M_W);
    LAS float* AU = (LAS float*)(lds + M_AU);
    LAS float* SEG = (LAS float*)(lds + M_SEG);
    LAS float* prm = (LAS float*)(lds + M_PRM);
    LAS float* CAR = (LAS float*)(lds + M_CAR);
    __syncthreads();
    for (int e = tid; e < 4 * 4096; e += NT) { const int g = e >> 12, i = (e >> 6) & 63, j = e & 63, d = g >> 1; const size_t o = ((size_t)(d * 8 + hb) * 64 + i) * 64 + j;
        Wt[(g * 64 + j) * 72 + i] = f2bf((g & 1) ? p.in[I_WI][o] : p.in[I_WA][o]); }
    if (tid < 64) { const int ch = 64 * hb + tid;
        prm[tid] = p.in[I_CONVW][ch]; prm[64 + tid] = p.in[I_CONVW][512 + ch]; prm[128 + tid] = p.in[I_CONVW][1024 + ch]; prm[192 + tid] = p.in[I_CONVW][1536 + ch]; prm[256 + tid] = p.in[I_CONVB][ch];
        prm[320 + tid] = p.in[I_BA][ch]; prm[384 + tid] = p.in[I_BA][512 + ch]; prm[448 + tid] = p.in[I_BI][ch]; prm[512 + tid] = p.in[I_BI][512 + ch];
        prm[576 + tid] = log1pf(expf(-p.in[I_LAM][ch])); prm[640 + tid] = log1pf(expf(-p.in[I_LAM][512 + ch])); }
    const int nrc = (PASS == 1) ? NRC : 512;
    const int cpr = (PASS == 3) ? 512 / (nlb >> 3) : 1, rc_lo = (PASS == 3) ? (lb >> 3) * cpr : (lb >> 3), rstep = (PASS == 3) ? 1 : (nlb >> 3), rc_hi = (PASS == 3) ? rc_lo + cpr : nrc;
    float* LCAR = (float*)(p.ws + WS_LCAR);
    if (PASS == 3 && tid < 128) { const int d = tid >> 6, j = tid & 63, ch = 64 * hb + j, b = rc_lo >> 7, cl0 = rc_lo & 127;
        const int p_lo = d ? 4 + 127 - (cl0 + cpr - 1) : 4 + cl0;
        const float* S = LSUM + (size_t)d * NRC * 1024 + 2 * ch; float hcar = 0.f;
#pragma unroll 8
        for (int s = 0; s < p_lo; ++s) { const float* e2 = S + (size_t)lru_rc_at(d, b, s) * 1024; hcar = e2[0] * hcar + e2[1]; }
        for (int s = p_lo; s < p_lo + cpr; ++s) { const int rcs = lru_rc_at(d, b, s); LCAR[((size_t)d * NRC + rcs) * 512 + ch] = hcar; const float* e2 = S + (size_t)rcs * 1024; hcar = e2[0] * hcar + e2[1]; }
    }
    u32x4 px[2];
#define LRU_PREFETCH(rc_) do { const int rc__ = (rc_); const int row0_ = rc__ * 64; const int seg_lo_ = (rc__ >= 512) ? NLAT + ((rc__ - 512) >> 2) * LC : (rc__ >> 7) * L, seg_hi_ = seg_lo_ + ((rc__ >= 512) ? LC : L); \
    _Pragma("unroll") for (int i = 0; i < 2; ++i) { const int e = tid + 512 * i, rr = e >> 3, pc = e & 7, grow = row0_ - 2 + rr; px[i] = (u32x4){0u, 0u, 0u, 0u}; \
        if (e < 67 * 8 && grow >= seg_lo_ && grow < seg_hi_) px[i] = *(const u32x4*)(C1 + (size_t)grow * C1LD + 2560 + 64 * hb + 8 * pc); } } while (0)
    int rc = rc_lo;
    if (rc < rc_hi) LRU_PREFETCH(rc);
    for (; rc < rc_hi; rc += rstep) {
        const int row0 = rc * 64;
        const int sg = tid >> 6, j = lane, ch = 64 * hb + j;
        float cin = 0.f;
        if (PASS == 3 && tid < 128) cin = LCAR[((size_t)(tid >> 6) * NRC + rc) * 512 + ch];
        float gbv[8];
        if (PASS == 3) {
#pragma unroll
            for (int k = 0; k < 8; ++k) gbv[k] = bf2f(C1[(size_t)(row0 + 8 * sg + k) * C1LD + 3072 + ch]); }
#pragma unroll
        for (int i = 0; i < 2; ++i) { const int e = tid + 512 * i; if (e < 67 * 8) { const int rr = e >> 3, pc = e & 7; const u32x4 v = px[i];
            f32x4 lo, hi; lo[0] = __uint_as_float(v[0] << 16); lo[1] = __uint_as_float(v[0] & 0xffff0000u); lo[2] = __uint_as_float(v[1] << 16); lo[3] = __uint_as_float(v[1] & 0xffff0000u);
            hi[0] = __uint_as_float(v[2] << 16); hi[1] = __uint_as_float(v[2] & 0xffff0000u); hi[2] = __uint_as_float(v[3] << 16); hi[3] = __uint_as_float(v[3] & 0xffff0000u);
            *(LAS f32x4*)(XB + rr * XBP + 8 * pc) = lo; *(LAS f32x4*)(XB + rr * XBP + 8 * pc + 4) = hi; } }
        if (PASS == 3 && tid < 128) CAR[tid] = cin;
        __syncthreads();
        if (rc + rstep < rc_hi) LRU_PREFETCH(rc + rstep);
        {
            const int t = tid >> 3, i0 = 8 * (tid & 7); float xc[8];
#pragma unroll
            for (int c = 0; c < 8; ++c) { const int i = i0 + c; xc[c] = prm[256 + i] + prm[i] * XB[t * XBP + i] + prm[64 + i] * XB[(t + 1) * XBP + i] + prm[128 + i] * XB[(t + 2) * XBP + i] + prm[192 + i] * XB[(t + 3) * XBP + i]; XCf[t * 64 + i] = xc[c]; }
            u32x4 w; w.x = pack2(xc[0], xc[1]); w.y = pack2(xc[2], xc[3]); w.z = pack2(xc[4], xc[5]); w.w = pack2(xc[6], xc[7]);
            *(LAS u32x4*)(XCs + t * 72 + i0) = w;
        }
        __syncthreads();
        {
            const int jt = wv & 3, th = wv >> 2, jc = 16 * jt + r;
#pragma unroll
            for (int d = 0; d < 2; ++d) { const float ba = prm[320 + 64 * d + jc], bi = prm[448 + 64 * d + jc], spl = prm[576 + 64 * d + jc];
#pragma unroll
                for (int i2 = 0; i2 < 2; ++i2) { const int tt = 2 * th + i2;
                    f32x4 aa = (f32x4){0.f, 0.f, 0.f, 0.f}, ai = (f32x4){0.f, 0.f, 0.f, 0.f};
#pragma unroll
                    for (int kk = 0; kk < 2; ++kk) { const bf16x8 xf = *(const LAS bf16x8*)(XCs + (16 * tt + r) * 72 + 32 * kk + 8 * q);
                        const bf16x8 wa = *(const LAS bf16x8*)(Wt + ((2 * d) * 64 + 16 * jt + r) * 72 + 32 * kk + 8 * q), wi = *(const LAS bf16x8*)(Wt + ((2 * d + 1) * 64 + 16 * jt + r) * 72 + 32 * kk + 8 * q);
                        aa = __builtin_amdgcn_mfma_f32_16x16x32_bf16(xf, wa, aa, 0, 0, 0); ai = __builtin_amdgcn_mfma_f32_16x16x32_bf16(xf, wi, ai, 0, 0, 0); }
#pragma unroll
                    for (int jj = 0; jj < 4; ++jj) { const int t = 16 * tt + 4 * q + jj;
                        const float rg = fsigm(aa[jj] + ba), ig = fsigm(ai[jj] + bi), la = -8.f * rg * spl;
                        const float a = fexp(la);
                        AU[((2 * d) * 64 + t) * 65 + jc] = a; AU[((2 * d + 1) * 64 + t) * 65 + jc] = __builtin_amdgcn_sqrtf(fmaxf(fmaf(-a, a, 1.f), 0.f)) * (ig * XCf[t * 64 + jc]); } } }
        }
        __syncthreads();
        const LAS float* A0 = AU + (8 * sg) * 65 + j; const LAS float* U0 = AU + (64 + 8 * sg) * 65 + j; const LAS float* A1 = AU + (128 + 8 * sg) * 65 + j; const LAS float* U1 = AU + (192 + 8 * sg) * 65 + j;
        {
            float p0 = 1.f, h0 = 0.f, p1 = 1.f, h1 = 0.f;
#pragma unroll
            for (int k = 0; k < 8; ++k) { const float a = A0[k * 65]; h0 = a * h0 + U0[k * 65]; p0 *= a; }
#pragma unroll
            for (int k = 7; k >= 0; --k) { const float a = A1[k * 65]; h1 = a * h1 + U1[k * 65]; p1 *= a; }
            SEG[(0 * 8 + sg) * 64 + j] = p0; SEG[(1 * 8 + sg) * 64 + j] = h0; SEG[(2 * 8 + sg) * 64 + j] = p1; SEG[(3 * 8 + sg) * 64 + j] = h1;
        }
        __syncthreads();
        if (PASS == 1) {
            if (tid < 128) { const int d = tid >> 6; float pa = 1.f, hh = 0.f;
#pragma unroll
                for (int s2 = 0; s2 < 8; ++s2) { const int sgi = d ? 7 - s2 : s2; const float ps = SEG[((2 * d) * 8 + sgi) * 64 + j], hs = SEG[((2 * d + 1) * 8 + sgi) * 64 + j]; hh = ps * hh + hs; pa *= ps; }
                float* o = LSUM + ((size_t)d * NRC + rc) * 1024 + 2 * ch; o[0] = pa; o[1] = hh; }
        } else {
            float hf = CAR[j], hbk = CAR[64 + j];
            for (int s2 = 0; s2 < sg; ++s2) hf = SEG[(0 * 8 + s2) * 64 + j] * hf + SEG[(1 * 8 + s2) * 64 + j];
            for (int s2 = 7; s2 > sg; --s2) hbk = SEG[(2 * 8 + s2) * 64 + j] * hbk + SEG[(3 * 8 + s2) * 64 + j];
            float of[8];
#pragma unroll
            for (int k = 0; k < 8; ++k) { hf = A0[k * 65] * hf + U0[k * 65]; of[k] = hf; }
#pragma unroll
            for (int k = 7; k >= 0; --k) { hbk = A1[k * 65] * hbk + U1[k * 65]; of[k] += hbk; }
#pragma unroll
            for (int k = 0; k < 8; ++k) Y[(size_t)nat_row(row0 + 8 * sg + k) * D + 512 + ch] = f2bf(of[k] * fgelu(gbv[k]));
        }
        __syncthreads();
    }
#undef LRU_PREFETCH
}
constexpr int PT = 72, PM = 40;
constexpr int C_PRM = 0, C_GAM = C_PRM + 3072, C_MISC = C_GAM + 1024, C_SBF = C_MISC + 1280, C_TILES = C_SBF + 2 * 64 * PT * 2, C_TH = C_TILES + 5 * 80 * PT * 2, C_MBF = C_TH + 2 * 64 * PT * 2,
              C_SM = C_MBF + 4 * 16 * 20 * 4, C_W1T = C_SM + 4 * 4 * 16 * PM * 2, C_AH = C_W1T + 4 * 64 * PM * 2, C_YV = C_AH + 4 * 16 * PT * 2, C_END = C_YV + 64 * PM * 2;
static_assert(C_END <= LDS_BYTES, "rwkv chunk LDS map");
DI void unpack4(u32x2 v, float* o) { o[0] = __uint_as_float(v.x << 16); o[1] = __uint_as_float(v.x & 0xffff0000u); o[2] = __uint_as_float(v.y << 16); o[3] = __uint_as_float(v.y & 0xffff0000u); }
DI u32x2 pack4(float a, float b, float c, float d) { u32x2 w; w.x = pack2(a, b); w.y = pack2(c, d); return w; }
DI bf16x8 zero_if(bf16x8 v, bool z) { const bf16x8 zz = {0, 0, 0, 0, 0, 0, 0, 0}; return z ? zz : v; }

constexpr int RING_SLOTS = 4, SLOT_U64 = 7936;
constexpr int S_GAM = 4096, S_BS = 4224, S_AH = 4256, S_NK = 5280, S_NB = 5536, S_YH = 5792, S_END = 7840;
DI int slot_lds(int e) {
    if (e < S_GAM) return C_TILES + ((e >> 10) + 1) * (80 * PT * 2) + ((e >> 4) & 63) * (PT * 2) + (e & 15) * 8;
    if (e < S_BS) return C_GAM + (e - S_GAM) * 8;
    if (e < S_AH) return C_MISC + 1024 + (e - S_BS) * 8;
    if (e < S_NK) { const int x = e - S_AH; return C_AH + (x >> 4) * (PT * 2) + (x & 15) * 8; }
    if (e < S_NB) { const int x = e - S_NK; return C_SM + 4 * 16 * PM * 2 + (x >> 2) * (PM * 2) + (x & 3) * 8; }
    const int x = e - S_NB; return C_SM + 2 * 4 * 16 * PM * 2 + (x >> 2) * (PM * 2) + (x & 3) * 8;
}
constexpr size_t WS_RING = WS_Z1;
DI void wait_ge(unsigned* word, unsigned want) {
    unsigned spins = 0;
    while ((unsigned)__builtin_amdgcn_readfirstlane((int)__hip_atomic_load(word, __ATOMIC_RELAXED, __HIP_MEMORY_SCOPE_AGENT)) < want) { __builtin_amdgcn_s_sleep(2); if (++spins > (1u << 21)) break; }
    __builtin_amdgcn_fence(__ATOMIC_ACQUIRE, "agent");
    asm volatile("s_waitcnt vmcnt(0)" ::: "memory");
}
template <int ROLE> DI void rwkv_chunk_unit(const P& p, LAS unsigned char* lds, const int vb, const int hs = 0) {
    const int tid = mk_tid(), lane = tid & 63, wv = __builtin_amdgcn_readfirstlane(tid >> 6), r = lane & 15, q = lane >> 4;
    const int d = vb >> 5, b = (vb >> 3) & 3, h = vb & 7;
    const bf16_t* RW = (const bf16_t*)(p.ws + WS_COLS) + OFF_RW; const bf16_t* LO = (const bf16_t*)(p.ws + WS_COLS) + OFF_LO; bf16_t* Z = (bf16_t*)(p.ws + WS_Z);
    unsigned long long* ring = (unsigned long long*)(p.ws + WS_RING) + (size_t)vb * RING_SLOTS * SLOT_U64;
    unsigned* READY0 = (unsigned*)(p.ws + WS_CTL) + 64 * vb; unsigned* READY1 = (unsigned*)(p.ws + WS_CTL) + 64 * (192 + vb); unsigned* ACK = (unsigned*)(p.ws + WS_CTL) + 64 * (64 + vb);
    unsigned* READYH = hs ? READY1 : READY0;
    LAS float* prm = (LAS float*)(lds + C_PRM); LAS float* GAM = (LAS float*)(lds + C_GAM); LAS float* SSQ = (LAS float*)(lds + C_MISC); LAS float* BSP = SSQ + 128; LAS float* BS = SSQ + 256;
    LAS bf16_t* Sbf = (LAS bf16_t*)(lds + C_SBF);
    LAS bf16_t* At = (LAS bf16_t*)(lds + C_TILES); LAS bf16_t* Rt = At + 80 * PT; LAS bf16_t* Bt = Rt + 80 * PT; LAS bf16_t* Kt = Bt + 80 * PT; LAS bf16_t* Vt = Kt + 80 * PT;
    LAS bf16_t* TH = (LAS bf16_t*)(lds + C_TH); LAS bf16_t* AD = TH + 64 * PT; LAS float* OUT = (LAS float*)(lds + C_TH);
    LAS float* MBf = (LAS float*)(lds + C_MBF);
    LAS bf16_t* MK = (LAS bf16_t*)(lds + C_SM); LAS bf16_t* NK = MK + 4 * 16 * PM; LAS bf16_t* NB = NK + 4 * 16 * PM; LAS bf16_t* DNV = NB + 4 * 16 * PM;
    LAS bf16_t* W1T = (LAS bf16_t*)(lds + C_W1T); LAS bf16_t* AH = (LAS bf16_t*)(lds + C_AH); LAS bf16_t* YV = (LAS bf16_t*)(lds + C_YV);
    const unsigned at_b = (unsigned)(size_t)At, bt_b = (unsigned)(size_t)Bt, kt_b = (unsigned)(size_t)Kt, vt_b = (unsigned)(size_t)Vt;
    __syncthreads();
    for (int e = tid; e < (C_END - C_SBF) / 4; e += NT) ((LAS unsigned*)(lds + C_SBF))[e] = 0u;
    if (tid < 64) { const int j = tid, c = 64 * h + j; const float* mu = p.in[I_MU] + d * 1664;
        prm[j] = mu[c]; prm[64 + j] = mu[512 + c]; prm[128 + j] = mu[1024 + c]; prm[192 + j] = mu[1536 + j]; prm[256 + j] = mu[1600 + j];
        prm[320 + j] = p.in[I_W0][d * 512 + c]; prm[384 + j] = p.in[I_A0][d * 512 + c]; prm[448 + j] = p.in[I_KK][d * 512 + c]; prm[512 + j] = p.in[I_KA][d * 512 + c];
        prm[576 + j] = p.in[I_RK][(d * 8 + h) * 64 + j]; prm[640 + j] = p.in[I_LNW][d * 512 + c]; prm[704 + j] = p.in[I_LNB][d * 512 + c]; }
    const int m1 = wv & 3, h2 = wv >> 2, cb8 = 32 * h2 + 8 * q;
    bf16x8 fw2[2][2], fa2[2][2];
    if (ROLE != 1) {
#pragma unroll
    for (int t = 0; t < 2; ++t)
#pragma unroll
        for (int kk = 0; kk < 2; ++kk) { const int c = 64 * h + 32 * h2 + 8 * (r >> 2) + 4 * t + (r & 3);
            const float* w2p = p.in[I_W2L] + (size_t)(d * 64 + 32 * kk + 8 * q) * 512 + c; const float* a2p = p.in[I_A2L] + (size_t)(d * 64 + 32 * kk + 8 * q) * 512 + c;
#pragma unroll
            for (int e = 0; e < 8; ++e) { fw2[t][kk][e] = (short)f2bf(w2p[e * 512]); fa2[t][kk][e] = (short)f2bf(a2p[e * 512]); }
            asm volatile("" ::: "memory"); }
    }
    f32x4 Sacc[2] = {(f32x4){0.f, 0.f, 0.f, 0.f}, (f32x4){0.f, 0.f, 0.f, 0.f}};
    int cur = 0;
    unsigned ack_seen = 0u;
    unsigned long long pf[12]; f32x4 yh[4]; bool pf_ok = false;
    u32x4 gc[5], gp[5];
#define RWKV_LOAD(n0x) do { const int n1_ = (n0x) + 16 * m1 + r; const bool hp_ = (n1_ != 0) && (n1_ != LC); const unsigned row_ = (unsigned)step_row(d, b, n1_), prow_ = hp_ ? (unsigned)step_row(d, b, n1_ - 1) : row_; \
    const unsigned rwc_ = row_ * 1536u + 64u * h + cb8, rwp_ = prow_ * 1536u + 64u * h + cb8, loc_ = row_ * 512u + 64u * d + cb8, lop_ = prow_ * 512u + 64u * d + cb8; \
    gc[0] = *(const u32x4*)(RW + rwc_); gc[1] = *(const u32x4*)(RW + rwc_ + 512u); gc[2] = *(const u32x4*)(RW + rwc_ + 1024u); gc[3] = *(const u32x4*)(LO + loc_); gc[4] = *(const u32x4*)(LO + loc_ + 128u); \
    gp[0] = *(const u32x4*)(RW + rwp_); gp[1] = *(const u32x4*)(RW + rwp_ + 512u); gp[2] = *(const u32x4*)(RW + rwp_ + 1024u); gp[3] = *(const u32x4*)(LO + lop_); gp[4] = *(const u32x4*)(LO + lop_ + 128u); } while (0)
    const int n0_start = (ROLE == 2) ? 64 * hs : 0, n0_step = (ROLE == 2) ? 128 : 64;
    if (ROLE != 1) RWKV_LOAD(n0_start);
    __syncthreads();
    for (int n0 = n0_start; n0 < LT; n0 += n0_step) {
        if (ROLE != 1) for (int rep0 = 0; rep0 < (MK_RDUP == 0 ? 2 : 1); ++rep0) {
        const int u1 = 16 * m1 + r, n1 = n0 + u1; const bool hp = (n1 != 0) && (n1 != LC);
        float rs[8], ks[8], vs[8];
        {
            float a0[8], a1[8], th[8], ad[8];
#define UNPACK8(v, o) { _Pragma("unroll") for (int k_ = 0; k_ < 4; ++k_) { o[2 * k_] = __uint_as_float(v[k_] << 16); o[2 * k_ + 1] = __uint_as_float(v[k_] & 0xffff0000u); } }
#define RW_SHIFT(dst, idx, muo) { const u32x4 pz = hp ? gp[idx] : (u32x4){0u, 0u, 0u, 0u}; UNPACK8(gc[idx], a0) UNPACK8(pz, a1) \
            const f32x4 mu0 = *(const LAS f32x4*)(prm + (muo) + cb8), mu1 = *(const LAS f32x4*)(prm + (muo) + cb8 + 4); \
            _Pragma("unroll") for (int e = 0; e < 4; ++e) { dst[e] = a0[e] + mu0[e] * (a1[e] - a0[e]); dst[4 + e] = a0[4 + e] + mu1[e] * (a1[4 + e] - a0[4 + e]); } }
            RW_SHIFT(th, 3, 192) asm volatile("" ::: "memory"); RW_SHIFT(ad, 4, 256) asm volatile("" ::: "memory"); RW_SHIFT(rs, 0, 0) asm volatile("" ::: "memory"); RW_SHIFT(ks, 1, 64) asm volatile("" ::: "memory"); RW_SHIFT(vs, 2, 128)
#undef RW_SHIFT
#pragma unroll
            for (int e = 0; e < 8; ++e) th[e] = ftanh(th[e]);
            u32x4 w; w.x = pack2(th[0], th[1]); w.y = pack2(th[2], th[3]); w.z = pack2(th[4], th[5]); w.w = pack2(th[6], th[7]); *(LAS u32x4*)(TH + u1 * PT + cb8) = w;
            w.x = pack2(ad[0], ad[1]); w.y = pack2(ad[2], ad[3]); w.z = pack2(ad[4], ad[5]); w.w = pack2(ad[6], ad[7]); *(LAS u32x4*)(AD + u1 * PT + cb8) = w;
            asm volatile("" ::: "memory");
        }
        __syncthreads();
        float elog[8], av[8], kkr[8], km[8]; float ssq = 0.f, bsp = 0.f;
#pragma unroll
        for (int t = 0; t < 2; ++t) {
            f32x4 xw = (f32x4){0.f, 0.f, 0.f, 0.f}, xa = (f32x4){0.f, 0.f, 0.f, 0.f};
#pragma unroll
            for (int kk = 0; kk < 2; ++kk) { const bf16x8 bt = *(const LAS bf16x8*)(TH + u1 * PT + 32 * kk + 8 * q), ba = *(const LAS bf16x8*)(AD + u1 * PT + 32 * kk + 8 * q);
                xw = __builtin_amdgcn_mfma_f32_16x16x32_bf16(fw2[t][kk], bt, xw, 0, 0, 0); xa = __builtin_amdgcn_mfma_f32_16x16x32_bf16(fa2[t][kk], ba, xa, 0, 0, 0); }
            const int cb = cb8 + 4 * t;
            const f32x4 w04 = *(const LAS f32x4*)(prm + 320 + cb), a04 = *(const LAS f32x4*)(prm + 384 + cb), kk4 = *(const LAS f32x4*)(prm + 448 + cb), ka4 = *(const LAS f32x4*)(prm + 512 + cb), rk4 = *(const LAS f32x4*)(prm + 576 + cb);
#pragma unroll
            for (int jj = 0; jj < 4; ++jj) { const int e = 4 * t + jj;
                elog[e] = 0.6065306597126334f * fsigm(xw[jj] + w04[jj]); av[e] = fsigm(xa[jj] + a04[jj]);
                kkr[e] = ks[e] * kk4[jj]; ssq += kkr[e] * kkr[e]; km[e] = ks[e] * (1.f + (av[e] - 1.f) * ka4[jj]); bsp += rs[e] * km[e] * rk4[jj]; }
            asm volatile("" ::: "memory");
        }
        ssq += __shfl_xor(ssq, 16); ssq += __shfl_xor(ssq, 32); bsp += __shfl_xor(bsp, 16); bsp += __shfl_xor(bsp, 32);
        if (q == 0) { SSQ[h2 * 64 + u1] = ssq; BSP[h2 * 64 + u1] = bsp; }
        __syncthreads();
        {
            const float tot = SSQ[u1] + SSQ[64 + u1]; const float inv = 1.f / fmaxf(sqrtf(tot), 1e-12f);
            if (h2 == 0 && q == 0) BS[u1] = BSP[u1] + BSP[64 + u1];
            float al[8], be[8], ka[8], rh[8];
#pragma unroll
            for (int e = 0; e < 8; ++e) {
                const float g = scan16(-elog[e]);
                const float ep = fexp(g), em = frcp(ep), epp = fexp(g + elog[e]);
                const float kk = kkr[e] * inv;
                al[e] = kk * epp; be[e] = kk * av[e] * em; ka[e] = km[e] * em; rh[e] = rs[e] * ep;
                if (r == 15) GAM[m1 * 64 + cb8 + e] = ep; }
            u32x4 w;
#define ST8(T, v) w.x = pack2(v[0], v[1]); w.y = pack2(v[2], v[3]); w.z = pack2(v[4], v[5]); w.w = pack2(v[6], v[7]); *(LAS u32x4*)(T + u1 * PT + cb8) = w;
            ST8(At, al) ST8(Bt, be) ST8(Kt, ka) ST8(Rt, rh) ST8(Vt, vs)
#undef ST8
        }
        __syncthreads();
        }
        if (ROLE == 0 && n0 + 64 < LT) RWKV_LOAD(n0 + 64);
        f32x4 yhat[4];
        if (ROLE == 1) {
            const unsigned g = (unsigned)(n0 >> 6);
            if (!pf_ok) { if (wv == 0) wait_ge((g & 1u) ? READY1 : READY0, (g >> 1) + 1u); __syncthreads();
                const unsigned long long* slot = ring + (size_t)(g % RING_SLOTS) * SLOT_U64;
#pragma unroll
                for (int k = 0; k < 12; ++k) { const int e = tid + NT * k; if (e < S_YH) pf[k] = slot[e]; }
#pragma unroll
                for (int m = 0; m < 4; ++m) yh[m] = *(const f32x4*)(slot + S_YH + ((m * 4 + (wv & 3)) * 64 + lane) * 2); }
            for (int rep7 = 0; rep7 < (MK_RDUP == 7 ? 2 : 1); ++rep7) { if (rep7) __syncthreads();
#pragma unroll
            for (int k = 0; k < 12; ++k) { const int e = tid + NT * k; if (e < S_YH) *(LAS unsigned long long*)(lds + slot_lds(e)) = pf[k]; }
            asm volatile("s_waitcnt vmcnt(0)" ::: "memory");
            __syncthreads(); }
            if (tid == 0) __hip_atomic_store(ACK, g + 1u, __ATOMIC_RELAXED, __HIP_MEMORY_SCOPE_AGENT);
#pragma unroll
            for (int m = 0; m < 4; ++m) yhat[m] = yh[m];
        }
        if (ROLE != 1) for (int rep1 = 0; rep1 < (MK_RDUP == 1 ? 2 : 1); ++rep1) {
        {
            const int m = wv >> 1, pp = wv & 1; LAS bf16_t* XB = pp ? Rt : At;
            f32x4 c1 = (f32x4){0.f, 0.f, 0.f, 0.f}, c2 = (f32x4){0.f, 0.f, 0.f, 0.f};
#pragma unroll
            for (int kk = 0; kk < 2; ++kk) { const bf16x8 bx = *(const LAS bf16x8*)(XB + (16 * m + r) * PT + 32 * kk + 8 * q);
                const bf16x8 a1 = *(const LAS bf16x8*)(Bt + (16 * m + r) * PT + 32 * kk + 8 * q), a2 = *(const LAS bf16x8*)(Kt + (16 * m + r) * PT + 32 * kk + 8 * q);
                c1 = __builtin_amdgcn_mfma_f32_16x16x32_bf16(a1, bx, c1, 0, 0, 0); c2 = __builtin_amdgcn_mfma_f32_16x16x32_bf16(a2, bx, c2, 0, 0, 0); }
#pragma unroll
            for (int jj = 0; jj < 4; ++jj) { const int s = 4 * q + jj; const bool ok = pp ? (s <= r) : (s < r); if (!ok) { c1[jj] = 0.f; c2[jj] = 0.f; } }
            if (pp == 0) { *(LAS f32x4*)(MBf + (m * 16 + r) * 20 + 4 * q) = c1; *(LAS u32x2*)(MK + (m * 16 + r) * PM + 4 * q) = pack4(c2[0], c2[1], c2[2], c2[3]); }
            else { *(LAS u32x2*)(NB + (m * 16 + r) * PM + 4 * q) = pack4(c1[0], c1[1], c1[2], c1[3]); *(LAS u32x2*)(NK + (m * 16 + r) * PM + 4 * q) = pack4(c2[0], c2[1], c2[2], c2[3]); }
        }
        __syncthreads();
        if (wv < 4) {
            const int m = wv, c = r; float X[16];
#pragma unroll
            for (int u = 0; u < 16; ++u) { float x = (c == u) ? 1.f : 0.f;
                if (u > 0) { const LAS f32x4* rowp = (const LAS f32x4*)(MBf + (m * 16 + u) * 20);
#pragma unroll
                    for (int s4 = 0; s4 < 4; ++s4) { if (4 * s4 < u) { const f32x4 l = rowp[s4];
#pragma unroll
                        for (int e = 0; e < 4; ++e) if (4 * s4 + e < u) x -= l[e] * X[4 * s4 + e]; } } }
                X[u] = x; }
            if (q == 0) {
#pragma unroll
                for (int u = 0; u < 16; ++u) DNV[(m * 16 + u) * PM + c] = f2bf(X[u]); }
        } else {
            const int m = wv - 4; const bf16x8 a = *(const LAS bf16x8*)(MK + (m * 16 + r) * PM + 8 * q);
            bf16x8 bvs[4]; tr_frag4(bvs[0], bvs[1], bvs[2], bvs[3], tr_addr(vt_b, PT, 16 * m, 0, r, q), 8u * PT, tr_addr(vt_b, PT, 16 * m, 16, r, q), 8u * PT, tr_addr(vt_b, PT, 16 * m, 32, r, q), 8u * PT, tr_addr(vt_b, PT, 16 * m, 48, r, q), 8u * PT);
#pragma unroll
            for (int it = 0; it < 4; ++it) { const bf16x8 bv = bvs[it];
                const f32x4 acc = __builtin_amdgcn_mfma_f32_16x16x32_bf16(a, bv, (f32x4){0.f, 0.f, 0.f, 0.f}, 0, 0, 0);
                *(LAS u32x2*)(W1T + (m * 64 + 16 * it + r) * PM + 4 * q) = pack4(acc[0], acc[1], acc[2], acc[3]); }
        }
        __syncthreads();
#pragma unroll
        for (int m = 0; m < 4; ++m) yhat[m] = (f32x4){0.f, 0.f, 0.f, 0.f};
        {
            const int it = wv & 3;
#pragma unroll
            for (int m = 0; m < 4; ++m) { const bf16x8 a = *(const LAS bf16x8*)(DNV + (m * 16 + r) * PM + 8 * q), bw = *(const LAS bf16x8*)(W1T + (m * 64 + 16 * it + r) * PM + 8 * q);
                yhat[m] = __builtin_amdgcn_mfma_f32_16x16x32_bf16(a, bw, yhat[m], 0, 0, 0); }
        }
        if (wv >= 4) {
            const int jt = wv - 4;
            bf16x8 afs[4]; tr_frag4(afs[0], afs[1], afs[2], afs[3], tr_addr(at_b, PT, 0, 16 * jt, r, q), 8u * PT, tr_addr(at_b, PT, 16, 16 * jt, r, q), 8u * PT, tr_addr(at_b, PT, 32, 16 * jt, r, q), 8u * PT, tr_addr(at_b, PT, 48, 16 * jt, r, q), 8u * PT);
#pragma unroll
            for (int m = 0; m < 4; ++m) { const bf16x8 a = afs[m], bd = *(const LAS bf16x8*)(DNV + (m * 16 + r) * PM + 8 * q);
                const f32x4 acc = __builtin_amdgcn_mfma_f32_16x16x32_bf16(a, bd, (f32x4){0.f, 0.f, 0.f, 0.f}, 0, 0, 0);
                *(LAS u32x2*)(AH + (m * 16 + r) * PT + 16 * jt + 4 * q) = pack4(acc[0], acc[1], acc[2], acc[3]); }
        }
        __syncthreads();
        }
        if (ROLE == 2) {
            const unsigned g = (unsigned)(n0 >> 6);
            if (g >= 2u) { asm volatile("s_waitcnt vmcnt(0)" ::: "memory"); __syncthreads(); if (tid == 0) __hip_atomic_store(READYH, (g >> 1), __ATOMIC_RELAXED, __HIP_MEMORY_SCOPE_AGENT); }
            if (n0 + 128 < LT) RWKV_LOAD(n0 + 128);
            if (g >= RING_SLOTS && ack_seen < g - RING_SLOTS + 1) {
                if (tid == 0) { wait_ge(ACK, g - RING_SLOTS + 1); ((LAS unsigned*)MBf)[17] = __hip_atomic_load(ACK, __ATOMIC_RELAXED, __HIP_MEMORY_SCOPE_AGENT); }
                __syncthreads(); ack_seen = ((LAS unsigned*)MBf)[17]; }
            unsigned long long* slot = ring + (size_t)(g % RING_SLOTS) * SLOT_U64;
#pragma unroll 2
            for (int k = 0; k < 12; ++k) { const int e = tid + NT * k; if (e < S_YH) __hip_atomic_store(slot + e, *(const LAS unsigned long long*)(lds + slot_lds(e)), __ATOMIC_RELAXED, __HIP_MEMORY_SCOPE_AGENT); }
            if (wv < 4) {
#pragma unroll
                for (int m = 0; m < 4; ++m) { unsigned long long* yp = slot + S_YH + ((m * 4 + wv) * 64 + lane) * 2;
                    __hip_atomic_store(yp, ((unsigned long long)__float_as_uint(yhat[m][1]) << 32) | __float_as_uint(yhat[m][0]), __ATOMIC_RELAXED, __HIP_MEMORY_SCOPE_AGENT);
                    __hip_atomic_store(yp + 1, ((unsigned long long)__float_as_uint(yhat[m][3]) << 32) | __float_as_uint(yhat[m][2]), __ATOMIC_RELAXED, __HIP_MEMORY_SCOPE_AGENT); } }
            if (g + 2u >= 132u) { asm volatile("s_waitcnt vmcnt(0)" ::: "memory"); __syncthreads(); if (tid == 0) __hip_atomic_store(READYH, (g >> 1) + 1u, __ATOMIC_RELAXED, __HIP_MEMORY_SCOPE_AGENT); }
            continue;
        }
#pragma unroll 1
        for (int m = 0; m < 4; ++m) {
            LAS bf16_t* Sc = Sbf + cur * 64 * PT; LAS bf16_t* Sn = Sbf + (cur ^ 1) * 64 * PT;
            const int it = wv & 3, jh = wv >> 2;
            bf16x8 bv, ka0, ka1;
            tr_frag3(bv, ka0, ka1, tr_addr(vt_b, PT, 16 * m, 16 * it, r, q), 8u * PT, tr_addr(kt_b, PT, 16 * m, 16 * (2 * jh), r, q), 8u * PT, tr_addr(kt_b, PT, 16 * m, 16 * (2 * jh + 1), r, q), 8u * PT);
            ka0 = zero_if(ka0, q >= 2); ka1 = zero_if(ka1, q >= 2);
            s16x4 hb0, hb1;
            { const unsigned a0 = bt_b + (unsigned)(((16 * m + 4 * q + (r >> 2)) * PT + 16 * (2 * jh) + 4 * (r & 3)) * 2), a1 = a0 + 32u;
              asm volatile("ds_read_b64_tr_b16 %0, %2\n\tds_read_b64_tr_b16 %1, %3\n\ts_waitcnt lgkmcnt(0)" : "=&v"(hb0), "=&v"(hb1) : "v"(a0), "v"(a1) : "memory"); }
            const bf16x8 ba0 = {hb0[0], hb0[1], hb0[2], hb0[3], 0, 0, 0, 0}, ba1 = {hb1[0], hb1[1], hb1[2], hb1[3], 0, 0, 0, 0};
            const bf16x8 s0 = *(const LAS bf16x8*)(Sc + (16 * it + r) * PT + 8 * q), s1 = *(const LAS bf16x8*)(Sc + (16 * it + r) * PT + 32 + 8 * q);
            f32x4 acc = (m == 0) ? yhat[0] : (m == 1) ? yhat[1] : (m == 2) ? yhat[2] : yhat[3];
            acc = __builtin_amdgcn_mfma_f32_16x16x32_bf16(*(const LAS bf16x8*)(AH + (m * 16 + r) * PT + 8 * q), s0, acc, 0, 0, 0);
            acc = __builtin_amdgcn_mfma_f32_16x16x32_bf16(*(const LAS bf16x8*)(AH + (m * 16 + r) * PT + 32 + 8 * q), s1, acc, 0, 0, 0);
            const u32x2 ny = pack4(-acc[0], -acc[1], -acc[2], -acc[3]);
            bf16x8 nyv = {0, 0, 0, 0, 0, 0, 0, 0}; { const s16x4 t4 = __builtin_bit_cast(s16x4, ny); nyv[0] = t4[0]; nyv[1] = t4[1]; nyv[2] = t4[2]; nyv[3] = t4[3]; }
#pragma unroll
            for (int x = 0; x < 2; ++x) { const int jt = 2 * jh + x;
                Sacc[x] = __builtin_amdgcn_mfma_f32_16x16x32_bf16(x ? ka1 : ka0, bv, Sacc[x], 0, 0, 0); Sacc[x] = __builtin_amdgcn_mfma_f32_16x16x32_bf16(x ? ba1 : ba0, nyv, Sacc[x], 0, 0, 0);
                const f32x4 gm = *(const LAS f32x4*)(GAM + m * 64 + 16 * jt + 4 * q); Sacc[x] = Sacc[x] * gm;
                *(LAS u32x2*)(Sn + (16 * it + r) * PT + 16 * jt + 4 * q) = pack4(Sacc[x][0], Sacc[x][1], Sacc[x][2], Sacc[x][3]); }
            if (wv >= 4) {
                f32x4 oacc = (f32x4){0.f, 0.f, 0.f, 0.f};
                oacc = __builtin_amdgcn_mfma_f32_16x16x32_bf16(*(const LAS bf16x8*)(Rt + (16 * m + r) * PT + 8 * q), s0, oacc, 0, 0, 0);
                oacc = __builtin_amdgcn_mfma_f32_16x16x32_bf16(*(const LAS bf16x8*)(Rt + (16 * m + r) * PT + 32 + 8 * q), s1, oacc, 0, 0, 0);
                oacc = __builtin_amdgcn_mfma_f32_16x16x32_bf16(*(const LAS bf16x8*)(NK + (m * 16 + r) * PM + 8 * q), bv, oacc, 0, 0, 0);
                const s16x4 nb4 = *(const LAS s16x4*)(NB + (m * 16 + r) * PM + 4 * q); const bf16x8 nbp = {nb4[0], nb4[1], nb4[2], nb4[3], 0, 0, 0, 0};
                oacc = __builtin_amdgcn_mfma_f32_16x16x32_bf16(nbp, nyv, oacc, 0, 0, 0);
#pragma unroll
                for (int jj = 0; jj < 4; ++jj) OUT[(16 * m + 4 * q + jj) * 68 + 16 * it + r] = oacc[jj]; }
            if (ROLE == 1 && m == 0) { if (tid == 0) { const unsigned g1 = (unsigned)(n0 >> 6) + 1u; unsigned ok = 0u;
                    if (g1 < 132u && __hip_atomic_load((g1 & 1u) ? READY1 : READY0, __ATOMIC_RELAXED, __HIP_MEMORY_SCOPE_AGENT) >= (g1 >> 1) + 1u) { __builtin_amdgcn_fence(__ATOMIC_ACQUIRE, "agent"); asm volatile("s_waitcnt vmcnt(0)" ::: "memory"); ok = 1u; }
                    ((LAS unsigned*)MBf)[16] = ok; } }
            __syncthreads();
            if (ROLE == 1 && m == 0) { pf_ok = ((LAS unsigned*)MBf)[16] != 0u;
                if (pf_ok) { const unsigned long long* slot = ring + (size_t)(((unsigned)(n0 >> 6) + 1u) % RING_SLOTS) * SLOT_U64;
#pragma unroll
                    for (int k = 0; k < 12; ++k) { const int e = tid + NT * k; if (e < S_YH) pf[k] = slot[e]; }
#pragma unroll
                    for (int mm = 0; mm < 4; ++mm) yh[mm] = *(const f32x4*)(slot + S_YH + ((mm * 4 + (wv & 3)) * 64 + lane) * 2); } }
            cur ^= 1;
        }
        for (int rep6 = 0; rep6 < (MK_RDUP == 6 ? 2 : 1); ++rep6) {
            const int u = tid >> 3, part = tid & 7; const size_t row = (size_t)step_row(d, b, n0 + u);
            const f32x4 o0 = *(const LAS f32x4*)(OUT + u * 68 + 8 * part), o1 = *(const LAS f32x4*)(OUT + u * 68 + 8 * part + 4);
            const float mean = sum8((o0[0] + o0[1]) + (o0[2] + o0[3]) + (o1[0] + o1[1]) + (o1[2] + o1[3])) * (1.f / 64.f);
            const f32x4 d0 = o0 - mean, d1 = o1 - mean;
            const float var = sum8((d0[0] * d0[0] + d0[1] * d0[1]) + (d0[2] * d0[2] + d0[3] * d0[3]) + (d1[0] * d1[0] + d1[1] * d1[1]) + (d1[2] * d1[2] + d1[3] * d1[3])) * (1.f / 64.f);
            const float rstd = rsqrtf(var + 64e-5f), bs = BS[u];
            const f32x4 w0 = *(const LAS f32x4*)(prm + 640 + 8 * part), w1 = *(const LAS f32x4*)(prm + 644 + 8 * part), b0 = *(const LAS f32x4*)(prm + 704 + 8 * part), b1 = *(const LAS f32x4*)(prm + 708 + 8 * part);
            const u32x4 vv = *(const LAS u32x4*)(Vt + u * PT + 8 * part);
            float z[8];
#pragma unroll
            for (int k = 0; k < 4; ++k) { z[k] = d0[k] * rstd * w0[k] + b0[k]; z[4 + k] = d1[k] * rstd * w1[k] + b1[k]; }
#pragma unroll
            for (int k = 0; k < 4; ++k) { z[2 * k] += bs * __uint_as_float(vv[k] << 16); z[2 * k + 1] += bs * __uint_as_float(vv[k] & 0xffff0000u); }
            u32x4 w; w.x = pack2(z[0], z[1]); w.y = pack2(z[2], z[3]); w.z = pack2(z[4], z[5]); w.w = pack2(z[6], z[7]);
            *(u32x4*)(Z + ((size_t)d * NALL + row) * 512 + 64 * h + 8 * part) = w;
        }
        __syncthreads();
    }
}
constexpr int RP_G2 = 0, RP_G2P = 520, RP_SG = RP_G2 + 128 * RP_G2P * 2, RP_END = RP_SG + 64 * PQ * 2;
static_assert(RP_END <= LDS_BYTES, "rwkv post LDS map");
DI void phase_rwkv_post2(const P& p, LAS unsigned char* lds) {
    const int tid = mk_tid(), lane = tid & 63, wv = __builtin_amdgcn_readfirstlane(tid >> 6), r = lane & 15, q = lane >> 4;
    const bf16_t* LO = (const bf16_t*)(p.ws + WS_COLS) + OFF_LO; const bf16_t* Z = (const bf16_t*)(p.ws + WS_Z); bf16_t* Y = (bf16_t*)(p.ws + WS_COLS);
    LAS bf16_t* G2s = (LAS bf16_t*)(lds + RP_G2); LAS bf16_t* SG = (LAS bf16_t*)(lds + RP_SG);
    const unsigned g2_b = (unsigned)(size_t)G2s;
    if ((int)blockIdx.x >= NRC) return;
    __syncthreads();
    for (int e = tid; e < 128 * 128; e += NT) { const int rr = e >> 7, c4 = (e & 127) * 4; const f32x4 v = *(const f32x4*)(p.in[I_G2] + rr * 512 + c4);
        *(LAS u32x2*)(G2s + rr * RP_G2P + c4) = pack4(v[0], v[1], v[2], v[3]); }
    for (int rc = blockIdx.x; rc < NRC; rc += gridDim.x) {
        const size_t row0 = (size_t)rc * 64;
        __syncthreads();
        for (int e = tid; e < 64 * 16; e += NT) { const int t = e >> 4, pc = e & 15; const u32x4 v = *(const u32x4*)(LO + (row0 + t) * 512 + 256 + 8 * pc); u32x4 o;
#pragma unroll
            for (int k = 0; k < 4; ++k) o[k] = pack2(fsigm(__uint_as_float(v[k] << 16)), fsigm(__uint_as_float(v[k] & 0xffff0000u)));
            *(LAS u32x4*)(SG + t * PQ + 8 * pc) = o; }
        __syncthreads();
#pragma unroll 1
        for (int ci = 0; ci < 4; ++ci) { const int ct = 4 * wv + ci;
            f32x4 acc[4] = {(f32x4){0.f, 0.f, 0.f, 0.f}, (f32x4){0.f, 0.f, 0.f, 0.f}, (f32x4){0.f, 0.f, 0.f, 0.f}, (f32x4){0.f, 0.f, 0.f, 0.f}};
#pragma unroll
            for (int kk = 0; kk < 4; ++kk) { const bf16x8 a = tr_frag(g2_b, RP_G2P, 32 * kk, 16 * ct, r, q);
#pragma unroll
                for (int tt = 0; tt < 4; ++tt) { const bf16x8 bs = *(const LAS bf16x8*)(SG + (16 * tt + r) * PQ + 32 * kk + 8 * q); acc[tt] = __builtin_amdgcn_mfma_f32_16x16x32_bf16(a, bs, acc[tt], 0, 0, 0); } }
#pragma unroll
            for (int tt = 0; tt < 4; ++tt) { const size_t row = row0 + 16 * tt + r; const int c = 16 * ct + 4 * q;
                float z0[4], z1[4]; unpack4(*(const u32x2*)(Z + row * 512 + c), z0); unpack4(*(const u32x2*)(Z + ((size_t)NALL + row) * 512 + c), z1);
                *(u32x2*)(Y + row * D + c) = pack4((z0[0] + z1[0]) * acc[tt][0], (z0[1] + z1[1]) * acc[tt][1], (z0[2] + z1[2]) * acc[tt][2], (z0[3] + z1[3]) * acc[tt][3]); }
        }
    }
    __syncthreads();
}
#define XB_TMO      128
#define XB_XCNT(j)  (256  + 64 * (j))
#define XB_XSUB(j)  (1280 + 64 * (j))
#define XB_XGEN(j)  (2304 + 64 * (j))
#define XB_TOP      3328
#define XB_TOPGEN   3392
#define XCD_BAR_WORDS 3456
#define XB_SPIN_CAP (1u << 18)

__device__ __forceinline__ unsigned xb_ld(unsigned* p)              { return __hip_atomic_load(p, __ATOMIC_RELAXED, __HIP_MEMORY_SCOPE_AGENT); }
__device__ __forceinline__ unsigned xb_add(unsigned* p, unsigned v) { return __hip_atomic_fetch_add(p, v, __ATOMIC_RELAXED, __HIP_MEMORY_SCOPE_AGENT); }
__device__ __forceinline__ unsigned xb_xcc_id() { return (unsigned)__builtin_amdgcn_s_getreg((3 << 11) | 20) & 0xFu; }
#define XB_SPIN(cond, bar) do { unsigned _sp = 0; while (cond) { __builtin_amdgcn_s_sleep(1); \
    if ((++_sp & 255u) == 0u) { if (xb_ld(&(bar)[XB_TMO])) break; if (_sp > XB_SPIN_CAP) { atomicAdd(&(bar)[XB_TMO], 1u); break; } } } } while (0)

struct XcdBarrier {
    unsigned* bar; unsigned x;
    volatile LAS unsigned* st;
};

__device__ __forceinline__ XcdBarrier xcd_barrier_post(unsigned* bar, volatile LAS unsigned* st) {
    XcdBarrier b; b.bar = bar; b.x = xb_xcc_id(); b.st = st;
    if (threadIdx.x == 0) (void)xb_add(&bar[XB_XCNT(b.x)], 1u);
    return b;
}
__device__ __forceinline__ void xcd_barrier_complete(unsigned* bar, unsigned x, unsigned& nloc, unsigned& nx) {
    const unsigned G = gridDim.x * gridDim.y * gridDim.z;
    unsigned sum, cnt, mine, sp = 0u;
    for (;;) {
        sum = 0u; cnt = 0u; mine = 0u;
#pragma unroll
        for (unsigned j = 0; j < 16; ++j) { const unsigned c = xb_ld(&bar[XB_XCNT(j)]); sum += c; cnt += (c > 0u) ? 1u : 0u; mine = (j == x) ? c : mine; }
        if (sum == G) break;
        __builtin_amdgcn_s_sleep(1);
        if ((++sp & 255u) == 0u) { if (xb_ld(&bar[XB_TMO])) break; if (sp > XB_SPIN_CAP) { atomicAdd(&bar[XB_TMO], 1u); break; } }
    }
    nloc = mine > 0u ? mine : 1u; nx = cnt > 0u ? cnt : 1u;
}

__device__ __forceinline__ void xcd_barrier(const XcdBarrier& b) {
    asm volatile("s_waitcnt vmcnt(0)" ::: "memory");
    __syncthreads();
    if (threadIdx.x == 0) {
        unsigned* bar = b.bar;
        __builtin_amdgcn_s_waitcnt(0);
        unsigned nloc = b.st[0], nx = b.st[1];
        if (nloc == 0u) { xcd_barrier_complete(bar, b.x, nloc, nx); b.st[0] = nloc; b.st[1] = nx; }
        const unsigned old = xb_add(&bar[XB_XSUB(b.x)], 1u);
        const unsigned gen = old / nloc;
        if (old + 1u == (gen + 1u) * nloc) {
            __builtin_amdgcn_fence(__ATOMIC_RELEASE, "agent");
            asm volatile("s_waitcnt vmcnt(0)" ::: "memory");
            const unsigned og = xb_add(&bar[XB_TOP], 1u);
            const unsigned tg = og / nx;
            if (og + 1u == (tg + 1u) * nx) xb_add(&bar[XB_TOPGEN], 1u);
            else XB_SPIN(xb_ld(&bar[XB_TOPGEN]) == tg, bar);
            __builtin_amdgcn_fence(__ATOMIC_ACQUIRE, "agent");
            xb_add(&bar[XB_XGEN(b.x)], 1u);
            asm volatile("s_waitcnt vmcnt(0)" ::: "memory");
        } else {
            XB_SPIN(xb_ld(&bar[XB_XGEN(b.x)]) == gen, bar);
            __builtin_amdgcn_fence(__ATOMIC_ACQUIRE, "agent");
            asm volatile("s_waitcnt vmcnt(0)" ::: "memory");
        }
    }
    __syncthreads();
}
constexpr int SG_P = 72;
template <bool DUAL, class Epi> DI void small_gemm(LAS unsigned char* lds, const bf16_t* A, const bf16_t* Bt, int M, int N, int K, const Epi& E) {
    const int tid = mk_tid(), lane = tid & 63, wv = __builtin_amdgcn_readfirstlane(tid >> 6), r = lane & 15, q = lane >> 4, mt = wv & 3, nh = wv >> 2;
    constexpr int BUF = 3 * 64 * SG_P;
    LAS bf16_t* base = (LAS bf16_t*)lds;
    const int ntn = N / 64, ntiles = (M / 64) * ntn, nkc = K / 64, prow = tid >> 3, ppc = tid & 7;
    for (int tile = blockIdx.x; tile < ntiles; tile += gridDim.x) {
        const int tm = tile / ntn, tn = tile - tm * ntn;
        const int c0 = 64 * tn; const int brow0 = DUAL ? 256 * (c0 >> 7) + (c0 & 127) : c0;
        const bf16_t* ag = A + (size_t)(64 * tm + prow) * K + 8 * ppc; const bf16_t* bg = Bt + (size_t)(brow0 + prow) * K + 8 * ppc;
        f32x4 acc[2] = {(f32x4){0.f, 0.f, 0.f, 0.f}, (f32x4){0.f, 0.f, 0.f, 0.f}}, acc3[2] = {(f32x4){0.f, 0.f, 0.f, 0.f}, (f32x4){0.f, 0.f, 0.f, 0.f}};
        u32x4 ra = *(const u32x4*)ag, rb = *(const u32x4*)bg, rb3 = (u32x4){0u, 0u, 0u, 0u};
        if (DUAL) rb3 = *(const u32x4*)(bg + (size_t)128 * K);
        __syncthreads();
        { LAS bf16_t* S0 = base; *(LAS u32x4*)(S0 + prow * SG_P + 8 * ppc) = ra; *(LAS u32x4*)(S0 + 64 * SG_P + prow * SG_P + 8 * ppc) = rb; if (DUAL) *(LAS u32x4*)(S0 + 128 * SG_P + prow * SG_P + 8 * ppc) = rb3; }
        if (nkc > 1) { ra = *(const u32x4*)(ag + 64); rb = *(const u32x4*)(bg + 64); if (DUAL) rb3 = *(const u32x4*)(bg + (size_t)128 * K + 64); }
        __syncthreads();
        for (int kc = 0; kc < nkc; ++kc) {
            LAS bf16_t* As = base + (kc & 1) * BUF; LAS bf16_t* Bs = As + 64 * SG_P; LAS bf16_t* B3 = Bs + 64 * SG_P;
            if (kc + 1 < nkc) { LAS bf16_t* Sn = base + ((kc + 1) & 1) * BUF; *(LAS u32x4*)(Sn + prow * SG_P + 8 * ppc) = ra; *(LAS u32x4*)(Sn + 64 * SG_P + prow * SG_P + 8 * ppc) = rb; if (DUAL) *(LAS u32x4*)(Sn + 128 * SG_P + prow * SG_P + 8 * ppc) = rb3; }
            if (kc + 2 < nkc) { ra = *(const u32x4*)(ag + 64 * (kc + 2)); rb = *(const u32x4*)(bg + 64 * (kc + 2)); if (DUAL) rb3 = *(const u32x4*)(bg + (size_t)128 * K + 64 * (kc + 2)); }
#pragma unroll
            for (int kk = 0; kk < 2; ++kk) { const bf16x8 a = *(const LAS bf16x8*)(As + (16 * mt + r) * SG_P + 32 * kk + 8 * q);
#pragma unroll
                for (int x = 0; x < 2; ++x) { const bf16x8 bb = *(const LAS bf16x8*)(Bs + (16 * (2 * nh + x) + r) * SG_P + 32 * kk + 8 * q); acc[x] = __builtin_amdgcn_mfma_f32_16x16x32_bf16(bb, a, acc[x], 0, 0, 0);
                    if (DUAL) { const bf16x8 b3 = *(const LAS bf16x8*)(B3 + (16 * (2 * nh + x) + r) * SG_P + 32 * kk + 8 * q); acc3[x] = __builtin_amdgcn_mfma_f32_16x16x32_bf16(b3, a, acc3[x], 0, 0, 0); } } }
            __syncthreads();
        }
#pragma unroll
        for (int x = 0; x < 2; ++x) E(64 * tm + 16 * mt + r, c0 + 16 * (2 * nh + x) + 4 * q, acc[x], acc3[x]);
    }
    __syncthreads();
}
struct SEpiStore3 { bf16_t* p0; int ld0; int c1; bf16_t* p1; int ld1; int c2; bf16_t* p2; int ld2;
    DI void operator()(int m, int c, const f32x4& v, const f32x4&) const { bf16_t* base; int ld, cc;
        if (c >= c2) { base = p2; ld = ld2; cc = c - c2; } else if (c >= c1) { base = p1; ld = ld1; cc = c - c1; } else { base = p0; ld = ld0; cc = c; }
        *(u32x2*)(base + (size_t)(NLAT + m) * ld + cc) = pack4(v[0], v[1], v[2], v[3]); } };
struct SEpiResid { const float* cin; float* cout; const float* gate;
    DI void operator()(int m, int c, const f32x4& v, const f32x4&) const { const f32x4 g = *(const f32x4*)(gate + c), bs = *(const f32x4*)(cin + (size_t)m * D + c); *(f32x4*)(cout + (size_t)m * D + c) = bs + g * v; } };
struct SEpiSwiglu { bf16_t* G;
    DI void operator()(int m, int c, const f32x4& a, const f32x4& b) const { float g[4];
#pragma unroll
        for (int j = 0; j < 4; ++j) g[j] = a[j] * frcp(1.f + fexp(-a[j])) * b[j];
        *(u32x2*)(G + (size_t)(NLAT + m) * DFF + c) = pack4(g[0], g[1], g[2], g[3]); } };
DI void phase_mlstm_post(const P& p) {
    const int lane = mk_tid() & 63, wv = mk_tid() >> 6;
    const bf16_t* ML = (const bf16_t*)(p.ws + WS_COLS) + OFF_ML; const bf16_t* HB = (const bf16_t*)(p.ws + WS_ACT); bf16_t* Y = (bf16_t*)(p.ws + WS_COLS);
    for (int r = blockIdx.x * 8 + wv; r < NALL; r += gridDim.x * 8)
        post_headnorm_row(HB, (size_t)r, p.in[I_MNG], ML + (size_t)r * 2048 + 1536, 0, Y + (size_t)r * D + 512, lane);
}
DI void phase_hgrn_post(const P& p) {
    const int lane = mk_tid() & 63, wv = mk_tid() >> 6;
    const bf16_t* C1 = (const bf16_t*)(p.ws + WS_COLS); const bf16_t* HB = (const bf16_t*)(p.ws + WS_ACT); bf16_t* Y = (bf16_t*)(p.ws + WS_Z);
    for (int r = blockIdx.x * 8 + wv; r < NLAT; r += gridDim.x * 8)
        post_headnorm_row(HB, (size_t)r, p.in[I_HNG], C1 + (size_t)r * C1LD + 2048, 1, Y + (size_t)nat_row(r) * D, lane);
}

constexpr int N_PHASES = 19;
__global__ void __launch_bounds__(NT, 2) mk_fwd(P p) {
    extern __shared__ __attribute__((aligned(16))) unsigned char lds_raw[];
    LAS unsigned char* lds = (LAS unsigned char*)lds_raw;
    cooperative_groups::grid_group grid = cooperative_groups::this_grid();
    const int lo = p.ph_lo, hi = p.ph_hi;
    volatile LAS unsigned* xst = (volatile LAS unsigned*)(lds + LDS_BYTES - 16);
    if (threadIdx.x < 4) xst[threadIdx.x] = 0u;
    __syncthreads();
    const XcdBarrier xbar = xcd_barrier_post((unsigned*)(p.ws + WS_CTL) + 8192, xst);
#define IN(k) (lo <= (k) && (k) < hi)
#define SEAM(k) do { if (IN(k) && IN((k) + 1)) xcd_barrier(xbar); } while (0)
#ifndef MK_DUP
#define MK_DUP -1
#endif
#define PHASE(k, ...) if (IN(k)) { __VA_ARGS__ if (MK_DUP == (k)) { grid.sync(); __VA_ARGS__ } } SEAM(k);
    unsigned char* ws = p.ws;
    const float* MODV = (const float*)(ws + WS_MODV);
    float* HC = (float*)(ws + WS_HC);
    float* SSQP = (float*)(ws + WS_SSQP); const float* GSC = (const float*)(ws + WS_GSC); const float* SHW = GSC + SHW_OFF;
    bf16_t* ACT = (bf16_t*)(ws + WS_ACT); bf16_t* COLS = (bf16_t*)(ws + WS_COLS); bf16_t* Y1 = (bf16_t*)(ws + WS_Z);
    PHASE(0, phase_modv(p, lds);)
    PHASE(1, phase_modnorm(p, 0, 0, p.in[I_X], p.in[I_CTX], NALL, false); phase_wprep(p, lds);)
    PHASE(2, { EpiStore3 E{COLS + OFF_RW, 1536, 6, COLS + OFF_LO, 512, 8, COLS + OFF_ML, 2048, 0}; run_gemm(lds, ACT, (const bf16_t*)(ws + WS_W_EVIN), NLAT, 4096, 1024, E); SEpiStore3 S{COLS + OFF_RW, 1536, 1536, COLS + OFF_LO, 512, 2048, COLS + OFF_ML, 2048}; small_gemm<false>(lds, ACT + (size_t)NLAT * 1024, (const bf16_t*)(ws + WS_W_EVIN), NCTX, 4096, 1024, S); })
    PHASE(3, { const int bx = (int)blockIdx.x;
        if (gridDim.x == 256) { if (bx < 64) rwkv_chunk_unit<1>(p, lds, bx); else if (bx < 192) rwkv_chunk_unit<2>(p, lds, (bx - 64) & 63, (bx - 64) >> 6); else { gla_unit<0>(p, lds, 2 * (bx - 192)); gla_unit<0>(p, lds, 2 * (bx - 192) + 1); } }
        else for (int vb = bx; vb < 192; vb += gridDim.x) { if (vb < 64) rwkv_chunk_unit<0>(p, lds, vb); else gla_unit<0>(p, lds, vb - 64); } })
    if (IN(3) && MK_DUP == 303) { grid.sync(); if (blockIdx.x < 64) rwkv_chunk_unit<1>(p, lds, blockIdx.x); grid.sync(); }
    if (IN(3) && MK_DUP == 403) { grid.sync(); if (blockIdx.x >= 64 && blockIdx.x < 128) rwkv_chunk_unit<2>(p, lds, blockIdx.x - 64, 0); grid.sync(); }
    if (IN(3) && MK_DUP == 103) { grid.sync(); for (int vb = blockIdx.x; vb < 64; vb += gridDim.x) rwkv_chunk_unit<0>(p, lds, vb); grid.sync(); }
    if (IN(3) && MK_DUP == 203) { grid.sync(); for (int vb = blockIdx.x; vb < 128; vb += gridDim.x) gla_unit<0>(p, lds, vb); grid.sync(); }
    PHASE(4, phase_mlstm_post(p); phase_rwkv_post2(p, lds);)
    PHASE(5, { EpiResid E{p.in[I_X], p.out, p.in[I_CTX], HC, MODV, 2, 0}; run_gemm(lds, COLS, (const bf16_t*)(ws + WS_W_EVOUT), NLAT, 1024, 1024, E); SEpiResid S{p.in[I_CTX], HC, MODV + 4 * 6144 + 2 * 1024}; small_gemm<false>(lds, COLS + (size_t)NLAT * 1024, (const bf16_t*)(ws + WS_W_EVOUT), NCTX, 1024, 1024, S); })
    PHASE(6, phase_modnorm(p, 0, 1, p.out, HC, NALL, false);)
    PHASE(7, { EpiSwiglu E{COLS, 0}; run_gemm(lds, ACT, (const bf16_t*)(ws + WS_W_UP), NLAT, 5632, 1024, E); SEpiSwiglu S{COLS}; small_gemm<true>(lds, ACT + (size_t)NLAT * 1024, (const bf16_t*)(ws + WS_W_UP), NCTX, 2816, 1024, S); })
    PHASE(8, { EpiResid E{p.out, p.out, HC, HC, MODV, 5, 0}; run_gemm(lds, COLS, (const bf16_t*)(ws + WS_W_DN), NLAT, 1024, 2816, E); SEpiResid S{HC, HC, MODV + 4 * 6144 + 5 * 1024}; small_gemm<false>(lds, COLS + (size_t)NLAT * 2816, (const bf16_t*)(ws + WS_W_DN), NCTX, 1024, 2816, S); })
    PHASE(9, phase_modnorm(p, 1, 0, p.out, HC, NALL, true);)
    PHASE(10, { EpiStore3 E{COLS, C1LD, 1 << 30, COLS, C1LD, 1 << 30, COLS, C1LD, 0}; run_gemm(lds, ACT, (const bf16_t*)(ws + WS_W_ODIN), NLAT, 3584, 1024, E); SEpiStore3 S{COLS, C1LD, 1 << 30, COLS, C1LD, 1 << 30, COLS, C1LD}; small_gemm<false>(lds, ACT + (size_t)NLAT * 1024, (const bf16_t*)(ws + WS_W_ODIN), NCTX, 3584, 1024, S); })
    PHASE(11, phase_hgrn_prep2(p, lds); lru_pass<1>(p, lds, (int)blockIdx.x, (int)gridDim.x);)
    PHASE(12, { const int half = (int)gridDim.x >> 1; if ((int)blockIdx.x < half) { for (int u = blockIdx.x; u < 128; u += half) gla_unit<1>(p, lds, u); } else lru_pass<3>(p, lds, (int)blockIdx.x - half, (int)gridDim.x - half); })
    if (IN(12) && MK_DUP == 112) { grid.sync(); lru_pass<3>(p, lds, (int)blockIdx.x, (int)gridDim.x); grid.sync(); }
    if (IN(12) && MK_DUP == 212) { grid.sync(); for (int vb = blockIdx.x; vb < 128; vb += gridDim.x) gla_unit<1>(p, lds, vb); grid.sync(); }
    PHASE(13, phase_hgrn_post(p);)
    PHASE(14, EpiResid E{p.out, p.out, HC, HC, MODV + 5 * 6144, 2, 0}; run_gemm(lds, Y1, (const bf16_t*)(ws + WS_W_ODOUT), NLAT, 1024, 1024, E);)
    PHASE(15, phase_modnorm(p, 1, 1, p.out, HC, NLAT, false);)
    PHASE(16, EpiSwiglu E{COLS, 0}; run_gemm(lds, ACT, (const bf16_t*)(ws + WS_W_UP) + W_UP_STRIDE, NLAT, 5632, 1024, E);)
    PHASE(17, EpiResid E{p.out, p.out, HC, HC, MODV + 5 * 6144, 5, 0}; run_gemm(lds, COLS, (const bf16_t*)(ws + WS_W_DN) + W_DN_STRIDE, NLAT, 1024, 2816, E);)
    PHASE(18, phase_finalnorm(p);)
    if (hi > 4096) grid.sync();
#undef IN
#undef SEAM
}
}

#ifndef MK_ONE_LAUNCH
#define MK_ONE_LAUNCH 1
#endif
extern "C" void kernel_launch(void* const* d_in, const int* in_sizes, int n_in, void* d_out, int out_size, void* d_ws, size_t ws_size, hipStream_t stream) {
    using namespace mk;
    static int grid = 0;
    if (grid == 0) {
        int dev = 0, cus = 0, per_cu = 0;
        if (n_in != N_IN || ws_size < WS_END) { fprintf(stderr, "kernel_launch: unexpected n_in %d / ws_size %zu\n", n_in, ws_size); grid = -1; return; }
        (void)hipGetDevice(&dev); (void)hipDeviceGetAttribute(&cus, hipDeviceAttributeMultiprocessorCount, dev);
        (void)hipFuncSetAttribute((const void*)mk_fwd, hipFuncAttributeMaxDynamicSharedMemorySize, LDS_BYTES);
        (void)hipOccupancyMaxActiveBlocksPerMultiprocessor(&per_cu, (const void*)mk_fwd, NT, LDS_BYTES);
        if (per_cu < 1) { fprintf(stderr, "kernel_launch: occupancy query says %d blocks per CU\n", per_cu); per_cu = 1; }
        (void)hipGetLastError();
        grid = cus;
    }
    if (grid < 0) return;
    if (hipMemsetAsync((char*)d_ws + WS_CTL, 0, 65536, stream) != hipSuccess) { fprintf(stderr, "kernel_launch: memset of the control words failed\n"); return; }
    P p{};
    for (int i = 0; i < N_IN; ++i) p.in[i] = (const float*)d_in[i];
    p.out = (float*)d_out; p.ws = (unsigned char*)d_ws;
#if MK_ONE_LAUNCH
    p.ph_lo = 0; p.ph_hi = N_PHASES;
    void* args[] = {&p};
    hipError_t e = hipLaunchCooperativeKernel((const void*)mk_fwd, dim3(grid), dim3(NT), args, LDS_BYTES, stream);
    if (e != hipSuccess) fprintf(stderr, "cooperative launch failed: %s (grid %d)\n", hipGetErrorString(e), grid);
#else
    for (int k = 0; k < N_PHASES; ++k) { p.ph_lo = k; p.ph_hi = k + 1; hipLaunchKernelGGL(mk_fwd, dim3(grid), dim3(NT), LDS_BYTES, stream, p); }
#endif
}
```

```cpp
#include <hip/hip_runtime.h>
#include <hip/hip_cooperative_groups.h>
#include <cstdio>
#include <cstdint>
__device__ __forceinline__ int mk_tid() { int t = threadIdx.x; asm volatile("" : "+v"(t)); return t; }
#define MK_DUP -1
#define MK_RDUP -1
namespace pg8 {
#define PG8_LAS __attribute__((address_space(3)))
typedef unsigned short bf16_t;
typedef short bf16x8 __attribute__((ext_vector_type(8)));
typedef float f32x4 __attribute__((ext_vector_type(4)));
typedef unsigned u32x4 __attribute__((ext_vector_type(4)));
constexpr int BM = 256, BK = 64, HALF = 128, HTB = HALF * BK * 2  , STAGE_BYTES = 8 * HTB, NXCD = 8, WGM = 8;

__host__ __device__ __forceinline__ int lds_byte(int r, int c) { const int st = (r >> 4) * 2 + (c >> 5), rr = r & 15, cc = c & 31, ob = rr * 64 + cc * 2; return st * 1024 + (ob ^ (((ob >> 9) & 1) << 5)); }
__host__ __device__ __forceinline__ void stage_rc(int b, int& R, int& C) { const int st = b / 1024, sb = b % 1024, swz = sb ^ (((sb >> 9) & 1) << 5); R = (st >> 1) * 16 + swz / 64; C = (st & 1) * 32 + (swz % 64) / 2; }
__host__ __device__ __forceinline__ int perm32(int rho) { const int n = rho >> 4, i = rho & 15; return 8 * (i >> 2) + 4 * n + (i & 3); }

struct Unit { int pm, pn; };
struct Gemm { const bf16_t* A; const bf16_t* Bt; int M, N, K; };

struct StaticOrder {
    int nM, nN, nwg, G, c;
    __host__ __device__ void init(int M, int N, int G_, int c_) { nM = M / BM; nN = N / BM; nwg = nM * nN; G = G_; c = c_; }
    __host__ __device__ bool next(int i, Unit& u) const {
        const long L = (long)i * G + c; if (L >= nwg) return false;
        int wgid = (int)L; { const int q = nwg / NXCD, r = nwg % NXCD, xcd = wgid % NXCD, off = wgid / NXCD; wgid = (xcd < r ? xcd * (q + 1) : r * (q + 1) + (xcd - r) * q) + off; }
        const int nig = WGM * nN, gid = wgid / nig, fm = gid * WGM, gsz = (nM - fm) < WGM ? (nM - fm) : WGM;
        u.pm = fm + ((wgid % nig) % gsz); u.pn = (wgid % nig) / gsz; return true;
    }
    __device__ __forceinline__ void a_ready(const Unit&) const {}
    __device__ __forceinline__ void done(const Unit&) const {}
};
__device__ __forceinline__ unsigned cvt_pk_bf16(float lo, float hi) { unsigned r; asm volatile("v_cvt_pk_bf16_f32 %0, %1, %2" : "=v"(r) : "v"(lo), "v"(hi)); return r; }
typedef float f32x2 __attribute__((ext_vector_type(2)));
template <class Epi, class Sched, bool STAMP = false>
__device__ __forceinline__ void gemm_phase(PG8_LAS unsigned char* lds, const Gemm g, const Sched& S, const Epi& E, unsigned long long* stamps) {
    const int tid = mk_tid(), wid = __builtin_amdgcn_readfirstlane(tid >> 6), lane = tid & 63, wr = wid >> 2, wc = wid & 3, fr = lane & 15, fq = lane >> 4;
    const int K = g.K, nt = K / BK;
    int ts_lo = 0, ts_hi = 0, nts = 0; const unsigned long long rt_entry = STAMP ? (unsigned long long)wall_clock64() : 0ull;
#define PG8_STAMP() do { if (STAMP && wid == 0 && nts < 64) { const unsigned long long _c = (unsigned long long)clock64(); \
        ts_lo = (lane == nts) ? (int)(unsigned)_c : ts_lo; ts_hi = (lane == nts) ? (int)(unsigned)(_c >> 32) : ts_hi; ++nts; } } while (0)
    PG8_STAMP();
    unsigned voffA[2], voffB[2];
#pragma unroll
    for (int i = 0; i < 2; ++i) { int R, C; stage_rc(tid * 16 + i * 8192, R, C); const int Rb = Epi::PERM ? ((R & ~31) + perm32(R & 31)) : R;
        voffA[i] = (unsigned)(R * K + C) * 2u; voffB[i] = (unsigned)(Rb * K + C) * 2u; }
    const size_t kstep = (size_t)(BK * 2);
    const size_t hstep = (size_t)HALF * K * 2;
    const size_t tstep = 2 * hstep;
    const unsigned ldsw = (unsigned)wid * 1024u;
    const int aoff = lds_byte(wr * 64 + fr, fq * 8), boff = lds_byte(wc * 32 + fr, fq * 8);
#define PG8_SA(b, h) (((b) * 2 + (h)) * HTB)
#define PG8_SB(b, h) ((4 + (b) * 2 + (h)) * HTB)
#define PG8_STAGE(bufoff, gbase, voff) do { _Pragma("unroll") for (int _i = 0; _i < 2; ++_i) \
        __builtin_amdgcn_global_load_lds((const unsigned*)((const char*)(gbase) + (voff)[_i]), (PG8_LAS unsigned*)(lds + (bufoff) + ldsw + _i * 8192), 16, 0, 0); } while (0)
#define PG8_LDA(dst, b, h) do { _Pragma("unroll") for (int m = 0; m < 4; ++m) _Pragma("unroll") for (int k = 0; k < 2; ++k) dst[m][k] = *(const PG8_LAS bf16x8*)(lds + PG8_SA(b, h) + aoff + m * 2048 + k * 1024); } while (0)
#define PG8_LDB(dst, b, h) do { _Pragma("unroll") for (int n = 0; n < 2; ++n) _Pragma("unroll") for (int k = 0; k < 2; ++k) dst[n][k] = *(const PG8_LAS bf16x8*)(lds + PG8_SB(b, h) + boff + n * 2048 + k * 1024); } while (0)
#define PG8_MMA(ai, bj, At, Bt) do { __builtin_amdgcn_s_setprio(1); _Pragma("unroll") for (int m = 0; m < 4; ++m) _Pragma("unroll") for (int n = 0; n < 2; ++n) _Pragma("unroll") for (int k = 0; k < 2; ++k) \
        acc[ai][bj][m][n] = __builtin_amdgcn_mfma_f32_16x16x32_bf16(Bt[n][k], At[m][k], acc[ai][bj][m][n], 0, 0, 0); __builtin_amdgcn_s_setprio(0); } while (0)
#define PG8_WAIT_V(n) asm volatile("s_waitcnt vmcnt(" #n ")" ::: "memory")
#define PG8_WAIT_L(n) asm volatile("s_waitcnt lgkmcnt(" #n ")" ::: "memory")
#define PG8_BAR __builtin_amdgcn_s_barrier()
#define PG8_SCHED __builtin_amdgcn_sched_barrier(0)
    Unit cur, nxt; int ui = 0;
    if (!S.next(0, cur)) return;
    f32x4 acc[2][2][4][2];
#pragma unroll
    for (int a = 0; a < 2; ++a)
#pragma unroll
        for (int b = 0; b < 2; ++b)
#pragma unroll
            for (int m = 0; m < 4; ++m)
#pragma unroll
                for (int n = 0; n < 2; ++n) acc[a][b][m][n] = (f32x4){0.f, 0.f, 0.f, 0.f};
    bf16x8 At[4][2], B0[2][2], B1[2][2];
    const char* cA = (const char*)g.A + (size_t)cur.pm * tstep; const char* cB = (const char*)g.Bt + (size_t)cur.pn * tstep;
    S.a_ready(cur);
    PG8_STAGE(PG8_SB(0, 0), cB, voffB); PG8_STAGE(PG8_SA(0, 0), cA, voffA); PG8_STAGE(PG8_SB(0, 1), cB + hstep, voffB); PG8_STAGE(PG8_SA(0, 1), cA + hstep, voffA);
    if (wr == 1) PG8_BAR;
    PG8_WAIT_V(4); PG8_BAR;
    PG8_STAGE(PG8_SB(1, 0), cB + kstep, voffB); PG8_STAGE(PG8_SA(1, 0), cA + kstep, voffA); PG8_STAGE(PG8_SB(1, 1), cB + hstep + kstep, voffB);
    PG8_WAIT_V(6); PG8_BAR;
    PG8_STAMP();
    for (;;) {
        const bool has_next = S.next(ui + 1, nxt);
        const char* nA = has_next ? (const char*)g.A + (size_t)nxt.pm * tstep : cA; const char* nB = has_next ? (const char*)g.Bt + (size_t)nxt.pn * tstep : cB;
        for (int t = 0; t < nt; t += 2) {
            const bool last = (t == nt - 2);
            const char* a1 = cA + (size_t)(t + 1) * kstep;
            const char* a2 = last ? nA : cA + (size_t)(t + 2) * kstep; const char* b2 = last ? nB : cB + (size_t)(t + 2) * kstep;
            const char* a3 = a2 + kstep; const char* b3 = b2 + kstep;
            if (last && has_next) S.a_ready(nxt);
            PG8_LDB(B0, 0, 0); PG8_SCHED; PG8_LDA(At, 0, 0); PG8_STAGE(PG8_SA(1, 1), a1 + hstep, voffA);
            PG8_WAIT_L(8); PG8_BAR; PG8_WAIT_L(0); PG8_MMA(0, 0, At, B0); PG8_BAR; PG8_SCHED;
            PG8_LDB(B1, 0, 1); PG8_STAGE(PG8_SB(0, 0), b2, voffB);
            PG8_BAR; PG8_WAIT_L(0); PG8_MMA(0, 1, At, B1); PG8_BAR;
            PG8_LDA(At, 0, 1); PG8_STAGE(PG8_SA(0, 0), a2, voffA);
            PG8_BAR; PG8_WAIT_L(0); PG8_MMA(1, 0, At, B0); PG8_BAR; PG8_SCHED;
            PG8_STAGE(PG8_SB(0, 1), b2 + hstep, voffB);
            PG8_WAIT_V(6); PG8_BAR; PG8_MMA(1, 1, At, B1); PG8_BAR;
            PG8_LDB(B0, 1, 0); PG8_SCHED; PG8_LDA(At, 1, 0); PG8_STAGE(PG8_SA(0, 1), a2 + hstep, voffA);
            PG8_WAIT_L(8); PG8_BAR; PG8_WAIT_L(0); PG8_MMA(0, 0, At, B0); PG8_BAR; PG8_SCHED;
            PG8_LDB(B1, 1, 1); PG8_STAGE(PG8_SB(1, 0), b3, voffB);
            PG8_BAR; PG8_WAIT_L(0); PG8_MMA(0, 1, At, B1); PG8_BAR;
            PG8_LDA(At, 1, 1); PG8_STAGE(PG8_SA(1, 0), a3, voffA);
            PG8_BAR; PG8_WAIT_L(0); PG8_MMA(1, 0, At, B0); PG8_BAR; PG8_SCHED;
            PG8_STAGE(PG8_SB(1, 1), b3 + hstep, voffB);
            PG8_WAIT_V(6); PG8_BAR; PG8_MMA(1, 1, At, B1); PG8_BAR;
        }
        PG8_STAMP();
        if constexpr (!Epi::AFTER_DRAIN) { E(acc, cur, wr, wc, fr, fq); S.done(cur); }
        PG8_STAMP();
        if (!has_next) break;
#pragma unroll
        for (int a = 0; a < 2; ++a)
#pragma unroll
            for (int b = 0; b < 2; ++b)
#pragma unroll
                for (int m = 0; m < 4; ++m)
#pragma unroll
                    for (int n = 0; n < 2; ++n) acc[a][b][m][n] = (f32x4){0.f, 0.f, 0.f, 0.f};
        cur = nxt; cA = nA; cB = nB; ++ui;
    }
    PG8_WAIT_V(0);
    if (wr == 0) PG8_BAR;
    PG8_BAR;
    if constexpr (Epi::AFTER_DRAIN) { E.fused(acc, cur, wr, wc, fr, fq, lds, wid, lane); S.done(cur); }
    PG8_STAMP();
    if (STAMP && wid == 0) { stamps[lane] = lane < nts ? (((unsigned long long)(unsigned)ts_hi << 32) | (unsigned)ts_lo) : 0ull;
        if (lane == 62) stamps[62] = rt_entry; if (lane == 63) stamps[63] = (unsigned long long)wall_clock64(); }
#undef PG8_STAMP
#undef PG8_SA
#undef PG8_SB
#undef PG8_STAGE
#undef PG8_LDA
#undef PG8_LDB
#undef PG8_MMA
#undef PG8_WAIT_V
#undef PG8_WAIT_L
#undef PG8_BAR
#undef PG8_SCHED
}
}

namespace mk {
#define DI __device__ __forceinline__
#define LAS __attribute__((address_space(3)))
typedef unsigned short bf16_t;
typedef float f32x4 __attribute__((ext_vector_type(4)));
typedef unsigned u32x2 __attribute__((ext_vector_type(2)));
typedef unsigned u32x4 __attribute__((ext_vector_type(4)));

constexpr int D = 1024, NB = 4, L = 8192, LC = 256, NLAT = NB * L, NCTX = NB * LC, NALL = NLAT + NCTX, LT = L + LC, DFF = 2816;
constexpr int NT = 512;
constexpr size_t MiB = (size_t)1 << 20;
constexpr size_t WS_CTL = 0, WS_MODV = 1 * MiB, WS_HC = 2 * MiB, WS_W_EVIN = 6 * MiB, WS_W_EVOUT = 14 * MiB, WS_W_ODIN = 16 * MiB, WS_W_ODOUT = 23 * MiB,
                 WS_W_UP = 25 * MiB, WS_W_DN = 47 * MiB, WS_ACT = 58 * MiB, WS_COLS = 124 * MiB, WS_Z = 388 * MiB, WS_Z1 = 454 * MiB, WS_LAM = 486 * MiB, WS_LSUM = 489 * MiB, WS_LCAR = 494 * MiB, WS_SSQP = 497 * MiB, WS_GSC = 504 * MiB, WS_END = 505 * MiB;
constexpr size_t SSQP_STRIDE = (size_t)NALL * 16, GSC_STRIDE = 5 * 1024, SHW_OFF = 3 * GSC_STRIDE, SHW_STRIDE = 5 * 5632;
constexpr size_t W_UP_STRIDE = (size_t)5632 * 1024, W_DN_STRIDE = (size_t)1024 * 2816;
constexpr size_t OFF_RW = 0, OFF_LO = (size_t)NALL * 1536, OFF_ML = OFF_LO + (size_t)NALL * 512;
constexpr int LDS_BYTES = 163840;
constexpr int C1LD = 3584;
DI int nat_row(int r) { const int b = r / L, pp = r % L; return b * L + (pp % 128) * 64 + pp / 128; }

enum { I_X = 0, I_C, I_CTX, I_CCTX, I_N1G, I_N2G, I_MODW, I_MODB, I_W1, I_W3, I_W2, I_FING, I_EVIN, I_EVOUT, I_MU, I_W0, I_W2L, I_A0, I_A2L, I_KK, I_KA, I_RK,
       I_LNW, I_LNB, I_G2, I_MBI, I_MBF, I_MNG, I_ODIN, I_ODOUT, I_HLB, I_HNG, I_CONVW, I_CONVB, I_WA, I_BA, I_WI, I_BI, I_LAM, N_IN };

struct P { const float* in[N_IN]; float* out; unsigned char* ws; int ph_lo, ph_hi; };

DI float bf2f(bf16_t v) { return __uint_as_float(((unsigned)v) << 16); }
typedef float f32x2_t __attribute__((ext_vector_type(2)));
typedef __bf16 bf16x2_t __attribute__((ext_vector_type(2)));
DI unsigned pack2(float lo, float hi) { const f32x2_t v = {lo, hi}; return __builtin_bit_cast(unsigned, __builtin_convertvector(v, bf16x2_t)); }
DI bf16_t f2bf(float f) { return (bf16_t)(pack2(f, f) & 0xffffu); }
DI float sigm(float x) { return 1.f / (1.f + expf(-x)); }
DI float siluf(float x) { return x * sigm(x); }
DI float geluf(float x) { return 0.5f * x * (1.f + tanhf(0.7978845608028654f * (x + 0.044715f * x * x * x))); }
DI float fexp(float x) { return __builtin_amdgcn_exp2f(x * 1.4426950408889634f); }
DI float frcp(float x) { return __builtin_amdgcn_rcpf(x); }
DI float fsigm(float x) { return frcp(1.f + fexp(-x)); }
DI float ftanh(float x) { return 1.f - 2.f * frcp(1.f + fexp(2.f * x)); }
DI float fgelu(float x) { return 0.5f * x * (1.f + ftanh(0.7978845608028654f * (x + 0.044715f * x * x * x))); }
template <int CTRL> DI float dppf(float x) { return __int_as_float(__builtin_amdgcn_update_dpp(0, __float_as_int(x), CTRL, 0xF, 0xF, false)); }
DI float sum8(float s) { s += dppf<0xB1>(s); s += dppf<0x4E>(s); s += dppf<0x141>(s); return s; }
DI float scan16(float x) { x += dppf<0x111>(x); x += dppf<0x112>(x); x += dppf<0x114>(x); x += dppf<0x118>(x); return x; }
DI float wave_sum(float v) { v += dppf<0xB1>(v); v += dppf<0x4E>(v); v += dppf<0x141>(v); v += dppf<0x140>(v); v += __shfl_xor(v, 16); v += __shfl_xor(v, 32); return v; }
DI int step_row(int d, int b, int n) {
    if (n < LC) return NLAT + b * LC + (d ? LC - 1 - n : n);
    const int m = n - LC; return b * L + (d ? L - 1 - m : m);
}

DI int matN(int m) { return m == 0 ? 4096 : m == 1 ? 1024 : m == 2 ? 3584 : m == 3 ? 1024 : m < 6 ? 5632 : 1024; }
DI int matK(int m) { return m < 6 ? 1024 : 2816; }
DI int matTile0(int m) { return m == 0 ? 0 : m == 1 ? 1024 : m == 2 ? 1280 : m == 3 ? 2176 : m == 4 ? 2432 : m == 5 ? 3840 : m == 6 ? 5248 : m == 7 ? 5952 : 6656; }
DI size_t matOff(int m) { return m == 0 ? WS_W_EVIN : m == 1 ? WS_W_EVOUT : m == 2 ? WS_W_ODIN : m == 3 ? WS_W_ODOUT : m == 4 ? WS_W_UP : m == 5 ? WS_W_UP + W_UP_STRIDE * 2 : m == 6 ? WS_W_DN : WS_W_DN + W_DN_STRIDE * 2; }
DI const float* matSrc(const P& p, int m, int n, int& ld) {
    if (m == 0) { ld = 3984; int col; if (n < 1920) col = n; else if (n < 1936) col = 3968 + (n - 1920); else if (n < 2048) return nullptr; else col = 1920 + (n - 2048); return p.in[I_EVIN] + col; }
    if (m == 1) { ld = 1024; return p.in[I_EVOUT] + n; }
    if (m == 2) { ld = 3584; return p.in[I_ODIN] + n; }
    if (m == 3) { ld = 1024; return p.in[I_ODOUT] + n; }
    if (m < 6) { ld = 2816; const int l = m - 4, pn = n >> 8, w = n & 255; const size_t lo = (size_t)l * 1024 * 2816; return (w < 128) ? p.in[I_W1] + lo + 128 * pn + w : p.in[I_W3] + lo + 128 * pn + (w - 128); }
    ld = 1024; return p.in[I_W2] + (size_t)(m - 6) * 2816 * 1024 + n;
}
DI void phase_wprep(const P& p, LAS unsigned char* ldsb) {
    LAS float* tile = (LAS float*)ldsb;
    const int tid = mk_tid(), tx = tid & 63, ty = tid >> 6;
    for (int item = blockIdx.x; item < 6656; item += gridDim.x) {
        int m = 0;
#pragma unroll
        for (int q = 1; q < 8; ++q) if (item >= matTile0(q)) m = q;
        const int local = item - matTile0(m), K = matK(m), nK = K >> 6, nb = local / nK, kb = local - nb * nK, n0 = nb * 64, k0 = kb * 64;
        bf16_t* Bt = (bf16_t*)(p.ws + matOff(m));
        int ld; const float* src = matSrc(p, m, n0 + tx, ld);
        __syncthreads();
#pragma unroll
        for (int i = 0; i < 8; ++i) { const int k = k0 + ty + 8 * i; tile[(ty + 8 * i) * 65 + tx] = src ? src[(size_t)k * ld] : 0.f; }
        __syncthreads();
#pragma unroll
        for (int i = 0; i < 8; ++i) { const int nn = ty + 8 * i; Bt[(size_t)(n0 + nn) * K + k0 + tx] = f2bf(tile[tx * 65 + nn]); }
    }
    __syncthreads();
}
DI void phase_modv(const P& p, LAS unsigned char* ldsb) {
    LAS float* sc = (LAS float*)ldsb;
    LAS float* part = sc + 5 * 1024;
    const int tid = mk_tid(), lane = tid & 63, wv = tid >> 6;
    float* MODV = (float*)(p.ws + WS_MODV);
    if ((int)blockIdx.x >= 192) return;
    __syncthreads();
    for (int e = tid; e < 5 * 1024; e += NT) { const int s = e >> 10, k = e & 1023; const float v = (s < 4) ? p.in[I_C][s * 1024 + k] : p.in[I_CCTX][k]; sc[e] = siluf(v); }
    __syncthreads();
    for (int vb = blockIdx.x; vb < 192; vb += gridDim.x) {
        const int l = vb / 96, n = (vb % 96) * 64 + lane;
        const float* W = p.in[I_MODW] + (size_t)l * 1024 * 6144 + (size_t)(128 * wv) * 6144 + n;
        float a0 = 0.f, a1 = 0.f, a2 = 0.f, a3 = 0.f, a4 = 0.f;
#pragma unroll 16
        for (int k = 0; k < 128; ++k) { const float w = W[(size_t)k * 6144]; const int kk = 128 * wv + k; a0 += sc[kk] * w; a1 += sc[1024 + kk] * w; a2 += sc[2048 + kk] * w; a3 += sc[3072 + kk] * w; a4 += sc[4096 + kk] * w; }
        __syncthreads();
        part[(wv * 5 + 0) * 64 + lane] = a0; part[(wv * 5 + 1) * 64 + lane] = a1; part[(wv * 5 + 2) * 64 + lane] = a2; part[(wv * 5 + 3) * 64 + lane] = a3; part[(wv * 5 + 4) * 64 + lane] = a4;
        __syncthreads();
        if (tid < 320) { const int s = tid >> 6; float t = p.in[I_MODB][l * 6144 + (vb % 96) * 64 + lane];
#pragma unroll
            for (int w8 = 0; w8 < 8; ++w8) t += part[(w8 * 5 + s) * 64 + lane];
            MODV[(size_t)l * 5 * 6144 + s * 6144 + (vb % 96) * 64 + lane] = t; }
    }
    __syncthreads();
}

DI void phase_modnorm(const P& p, int layer, int which, const float* hlat, const float* hctx, int nrows, bool permute) {
    const int lane = mk_tid() & 63, wv = mk_tid() >> 6;
    const float* MODV = (const float*)(p.ws + WS_MODV) + (size_t)layer * 5 * 6144;
    const float* g = p.in[which ? I_N2G : I_N1G] + layer * 1024;
    bf16_t* ACT = (bf16_t*)(p.ws + WS_ACT);
    f32x4 gs[4], sh[4]; int sv_have = -1;
    const int rstep = gridDim.x * 8; int r = blockIdx.x * 8 + wv;
    f32x4 v[4], vn[4];
#define MN_SRC(rr) (((rr) >= NLAT) ? hctx + (size_t)((rr) - NLAT) * D : hlat + (size_t)(rr) * D)
    if (r < nrows) { const float* src = MN_SRC(r);
#pragma unroll
        for (int j = 0; j < 4; ++j) v[j] = *(const f32x4*)(src + 4 * lane + 256 * j); }
    for (; r < nrows; r += rstep) {
        const bool isctx = r >= NLAT; const int sv = isctx ? 4 : r / L;
        if (r + rstep < nrows) { const float* src = MN_SRC(r + rstep);
#pragma unroll
            for (int j = 0; j < 4; ++j) vn[j] = *(const f32x4*)(src + 4 * lane + 256 * j); }
        if (sv != sv_have) { sv_have = sv; const float* shift = MODV + sv * 6144 + (which ? 3 : 0) * 1024; const float* scale = shift + 1024;
#pragma unroll
            for (int j = 0; j < 4; ++j) { const int c = 4 * lane + 256 * j; const f32x4 gg = *(const f32x4*)(g + c), sc = *(const f32x4*)(scale + c); gs[j] = gg * (sc + 1.f); sh[j] = *(const f32x4*)(shift + c); } }
        int dr = r;
        if (permute && !isctx) { const int b = r / L, t = r % L; dr = b * L + (t % 64) * 128 + t / 64; }
        float ss = 0.f;
#pragma unroll
        for (int j = 0; j < 4; ++j) ss += (v[j].x * v[j].x + v[j].y * v[j].y) + (v[j].z * v[j].z + v[j].w * v[j].w);
        const float rinv = rsqrtf(wave_sum(ss) * (1.f / D) + 1e-6f);
#pragma unroll
        for (int j = 0; j < 4; ++j) { const int c = 4 * lane + 256 * j; const f32x4 o = v[j] * rinv * gs[j] + sh[j];
            u32x2 w; w.x = pack2(o[0], o[1]); w.y = pack2(o[2], o[3]);
            *(u32x2*)(ACT + (size_t)dr * D + c) = w; v[j] = vn[j]; }
    }
#undef MN_SRC
}
DI void phase_finalnorm(const P& p) {
    const int lane = mk_tid() & 63, wv = mk_tid() >> 6;
    const float* g = p.in[I_FING];
    f32x4 gg[4];
#pragma unroll
    for (int j = 0; j < 4; ++j) gg[j] = *(const f32x4*)(g + 4 * lane + 256 * j);
    const int rstep = gridDim.x * 8; int r = blockIdx.x * 8 + wv;
    f32x4 v[4], vn[4];
    if (r < NLAT) {
#pragma unroll
        for (int j = 0; j < 4; ++j) v[j] = *(const f32x4*)(p.out + (size_t)r * D + 4 * lane + 256 * j); }
    for (; r < NLAT; r += rstep) {
        if (r + rstep < NLAT) {
#pragma unroll
            for (int j = 0; j < 4; ++j) vn[j] = *(const f32x4*)(p.out + (size_t)(r + rstep) * D + 4 * lane + 256 * j); }
        float ss = 0.f;
#pragma unroll
        for (int j = 0; j < 4; ++j) ss += (v[j].x * v[j].x + v[j].y * v[j].y) + (v[j].z * v[j].z + v[j].w * v[j].w);
        const float rinv = rsqrtf(wave_sum(ss) * (1.f / D) + 1e-6f);
#pragma unroll
        for (int j = 0; j < 4; ++j) { *(f32x4*)(p.out + (size_t)r * D + 4 * lane + 256 * j) = v[j] * rinv * gg[j]; v[j] = vn[j]; }
    }
}

struct EpiStore3 {
    static constexpr bool PERM = true, AFTER_DRAIN = false;
    bf16_t* p0; int ld0; int pn1; bf16_t* p1; int ld1; int pn2; bf16_t* p2; int ld2; int pm0;
    DI void operator()(const f32x4 (&acc)[2][2][4][2], const pg8::Unit& u, int wr, int wc, int fr, int fq) const {
        bf16_t* base; int ld, ct;
        if (u.pn >= pn2) { base = p2; ld = ld2; ct = u.pn - pn2; } else if (u.pn >= pn1) { base = p1; ld = ld1; ct = u.pn - pn1; } else { base = p0; ld = ld0; ct = u.pn; }
        const int row0 = (u.pm + pm0) * 256 + wr * 64 + fr, col0 = ct * 256 + wc * 32 + 8 * fq;
#pragma unroll
        for (int ai = 0; ai < 2; ++ai)
#pragma unroll
            for (int m = 0; m < 4; ++m) { bf16_t* rowp = base + (size_t)(row0 + ai * 128 + m * 16) * ld + col0;
#pragma unroll
                for (int bj = 0; bj < 2; ++bj) { const f32x4 v0 = acc[ai][bj][m][0], v1 = acc[ai][bj][m][1];
                    u32x4 w; w.x = pack2(v0[0], v0[1]); w.y = pack2(v0[2], v0[3]); w.z = pack2(v1[0], v1[1]); w.w = pack2(v1[2], v1[3]); *(u32x4*)(rowp + bj * 128) = w; if (MK_RDUP == 20) { asm volatile("" ::: "memory"); *(u32x4*)(rowp + bj * 128) = w; asm volatile("" ::: "memory"); } } }
    }
};
struct EpiResid {
    static constexpr bool PERM = false, AFTER_DRAIN = false;
    const float* hin; float* hout; const float* cin; float* cout; const float* modv_l; int gidx; int pm0;
    DI void operator()(const f32x4 (&acc)[2][2][4][2], const pg8::Unit& u, int wr, int wc, int fr, int fq) const {
        const int pm = u.pm + pm0; const bool isctx = pm >= 128; const int sv = isctx ? 4 : (pm >> 5);
        const float* gate = modv_l + sv * 6144 + gidx * 1024;
        const float* bi = isctx ? cin : hin; float* bo = isctx ? cout : hout;
        const int row0 = (isctx ? (pm - 128) : pm) * 256 + wr * 64 + fr, col0 = u.pn * 256 + wc * 32 + 4 * fq;
        f32x4 gv[2][2];
#pragma unroll
        for (int bj = 0; bj < 2; ++bj)
#pragma unroll
            for (int n = 0; n < 2; ++n) gv[bj][n] = *(const f32x4*)(gate + col0 + bj * 128 + n * 16);
#pragma unroll
        for (int ai = 0; ai < 2; ++ai)
#pragma unroll
            for (int m = 0; m < 4; ++m) { const size_t off = (size_t)(row0 + ai * 128 + m * 16) * D + col0;
#pragma unroll
                for (int bj = 0; bj < 2; ++bj)
#pragma unroll
                    for (int n = 0; n < 2; ++n) { const f32x4 bs = *(const f32x4*)(bi + off + bj * 128 + n * 16); *(f32x4*)(bo + off + bj * 128 + n * 16) = bs + gv[bj][n] * acc[ai][bj][m][n]; } }
    }
};
struct EpiResidN {
    static constexpr bool PERM = false, AFTER_DRAIN = false;
    const float* hin; float* hout; const float* cin; float* cout; const float* modv_l; int gidx;
    bf16_t* act; const float* gsc; float* ssqp; int permute;
    DI void operator()(const f32x4 (&acc)[2][2][4][2], const pg8::Unit& u, int wr, int wc, int fr, int fq) const {
        const bool isctx = u.pm >= 128; const int sv = isctx ? 4 : (u.pm >> 5);
        const float* gate = modv_l + sv * 6144 + gidx * 1024; const float* gs = gsc + sv * 1024;
        const float* bi = isctx ? cin : hin; float* bo = isctx ? cout : hout;
        const int row0 = (isctx ? (u.pm - 128) : u.pm) * 256 + wr * 64 + fr, col0 = u.pn * 256 + wc * 32 + 4 * fq;
        f32x4 gv[2][2], gsv[2][2];
#pragma unroll
        for (int bj = 0; bj < 2; ++bj)
#pragma unroll
            for (int n = 0; n < 2; ++n) { gv[bj][n] = *(const f32x4*)(gate + col0 + bj * 128 + n * 16); gsv[bj][n] = *(const f32x4*)(gs + col0 + bj * 128 + n * 16); }
#pragma unroll
        for (int ai = 0; ai < 2; ++ai)
#pragma unroll
            for (int m = 0; m < 4; ++m) { const int rl = row0 + ai * 128 + m * 16; const size_t off = (size_t)rl * D + col0;
                int arow = u.pm * 256 + wr * 64 + fr + ai * 128 + m * 16;
                if (permute && !isctx) { const int b = arow / L, t = arow % L; arow = b * L + (t % 64) * 128 + t / 64; }
                float ss = 0.f;
#pragma unroll
                for (int bj = 0; bj < 2; ++bj)
#pragma unroll
                    for (int n = 0; n < 2; ++n) { const f32x4 bs = *(const f32x4*)(bi + off + bj * 128 + n * 16); const f32x4 hn = bs + gv[bj][n] * acc[ai][bj][m][n];
                        *(f32x4*)(bo + off + bj * 128 + n * 16) = hn; ss += (hn[0] * hn[0] + hn[1] * hn[1]) + (hn[2] * hn[2] + hn[3] * hn[3]);
                        const f32x4 an = hn * gsv[bj][n]; u32x2 w; w.x = pack2(an[0], an[1]); w.y = pack2(an[2], an[3]); *(u32x2*)(act + (size_t)arow * D + col0 + bj * 128 + n * 16) = w; }
                ss += __shfl_xor(ss, 16); ss += __shfl_xor(ss, 32);
                if (fq == 0) ssqp[(size_t)arow * 16 + u.pn * 4 + wc] = ss; }
    }
};
struct EpiSwiglu {
    static constexpr bool PERM = true, AFTER_DRAIN = false;
    bf16_t* G; int pm0;
    DI void operator()(const f32x4 (&acc)[2][2][4][2], const pg8::Unit& u, int wr, int wc, int fr, int fq) const {
        const int row0 = (u.pm + pm0) * 256 + wr * 64 + fr, col0 = u.pn * 128 + wc * 32 + 8 * fq;
#pragma unroll
        for (int ai = 0; ai < 2; ++ai)
#pragma unroll
            for (int m = 0; m < 4; ++m) { bf16_t* rowp = G + (size_t)(row0 + ai * 128 + m * 16) * DFF + col0; float g[8];
#pragma unroll
                for (int n = 0; n < 2; ++n) { const f32x4 a = acc[ai][0][m][n], b = acc[ai][1][m][n];
#pragma unroll
                    for (int j = 0; j < 4; ++j) g[4 * n + j] = a[j] * frcp(1.f + fexp(-a[j])) * b[j]; }
                u32x4 w; w.x = pack2(g[0], g[1]); w.y = pack2(g[2], g[3]); w.z = pack2(g[4], g[5]); w.w = pack2(g[6], g[7]); *(u32x4*)rowp = w; }
    }
};
template <class Epi> DI void run_gemm(LAS unsigned char* lds, const bf16_t* A, const bf16_t* Bt, int M, int N, int K, const Epi& E) {
    pg8::Gemm g{A, Bt, M, N, K}; pg8::StaticOrder S; S.init(M, N, (int)gridDim.x, (int)blockIdx.x);
    pg8::gemm_phase<Epi, pg8::StaticOrder, false>((PG8_LAS unsigned char*)lds, g, S, E, nullptr);
    __syncthreads();
}


DI void phase_norm_tables(const P& p) {
    const int tid = mk_tid(), lane = tid & 63, wv = tid >> 6;
    const float* MODV = (const float*)(p.ws + WS_MODV); float* GSC = (float*)(p.ws + WS_GSC); float* SHW = GSC + SHW_OFF;
    for (int e = blockIdx.x * NT + tid; e < 3 * 5 * 1024; e += gridDim.x * NT) { const int site = e / 5120, s = (e / 1024) % 5, c = e & 1023;
        const int layer = site ? 1 : 0, scidx = (site == 1) ? 1 : 4; const float g = p.in[(site == 1) ? I_N1G : I_N2G][layer * 1024 + c];
        GSC[e] = g * (1.f + MODV[(size_t)layer * 5 * 6144 + s * 6144 + scidx * 1024 + c]); }
    for (int w = blockIdx.x * 8 + wv; w < 5632 + 3584 + 5632; w += gridDim.x * 8) {
        int site, n; const bf16_t* Bt;
        if (w < 5632) { site = 0; n = w; Bt = (const bf16_t*)(p.ws + WS_W_UP); } else if (w < 5632 + 3584) { site = 1; n = w - 5632; Bt = (const bf16_t*)(p.ws + WS_W_ODIN); } else { site = 2; n = w - 5632 - 3584; Bt = (const bf16_t*)(p.ws + WS_W_UP) + W_UP_STRIDE; }
        const int layer = site ? 1 : 0, shidx = (site == 1) ? 0 : 3;
        const u32x4 w0 = *(const u32x4*)(Bt + (size_t)n * 1024 + 16 * lane), w1 = *(const u32x4*)(Bt + (size_t)n * 1024 + 16 * lane + 8);
        float wf[16];
#pragma unroll
        for (int k = 0; k < 4; ++k) { wf[2 * k] = __uint_as_float(w0[k] << 16); wf[2 * k + 1] = __uint_as_float(w0[k] & 0xffff0000u); wf[8 + 2 * k] = __uint_as_float(w1[k] << 16); wf[8 + 2 * k + 1] = __uint_as_float(w1[k] & 0xffff0000u); }
#pragma unroll
        for (int s = 0; s < 5; ++s) { const float* sh = MODV + (size_t)layer * 5 * 6144 + s * 6144 + shidx * 1024 + 16 * lane; float a = 0.f;
#pragma unroll
            for (int k = 0; k < 16; ++k) a += sh[k] * wf[k];
            a = wave_sum(a);
            if (lane == 0) SHW[(size_t)site * SHW_STRIDE + s * 5632 + n] = a; }
    }
}
DI void phase_rwkv_scan_unit(const P& p, LAS unsigned char* ldsb, const int vb) {
    LAS float* lds = (LAS float*)ldsb;
    LAS float *w2s = lds, *a2s = lds + 4096, *prm = lds + 8192, *TH = prm + 768, *AD = TH + 2048, *R = AD + 2048, *W = R + 2048, *K = W + 2048, *KK = K + 2048, *BV = KK + 2048,
              *V = BV + 2048, *BS = V + 2048, *OUT = BS + 32;
    const int tid = mk_tid(), lane = tid & 63, wv = tid >> 6;
    const bf16_t* RW = (const bf16_t*)(p.ws + WS_COLS) + OFF_RW; const bf16_t* LO = (const bf16_t*)(p.ws + WS_COLS) + OFF_LO; bf16_t* Z = (bf16_t*)(p.ws + WS_Z);
    const int srow = tid >> 3, sg = tid & 7;
    {
        const int d = vb >> 5, b = (vb >> 3) & 3, h = vb & 7;
        __syncthreads();
        for (int e = tid; e < 4096; e += NT) { const int i = e >> 6, c = e & 63; w2s[e] = p.in[I_W2L][(size_t)(d * 64 + i) * 512 + 64 * h + c]; a2s[e] = p.in[I_A2L][(size_t)(d * 64 + i) * 512 + 64 * h + c]; }
        if (tid < 64) { const int j = tid, c = 64 * h + j; const float* mu = p.in[I_MU] + d * 1664;
            prm[j] = mu[c]; prm[64 + j] = mu[512 + c]; prm[128 + j] = mu[1024 + c]; prm[192 + j] = mu[1536 + j]; prm[256 + j] = mu[1600 + j];
            prm[320 + j] = p.in[I_W0][d * 512 + c]; prm[384 + j] = p.in[I_A0][d * 512 + c]; prm[448 + j] = p.in[I_KK][d * 512 + c]; prm[512 + j] = p.in[I_KA][d * 512 + c];
            prm[576 + j] = p.in[I_RK][(d * 8 + h) * 64 + j]; prm[640 + j] = p.in[I_LNW][d * 512 + c]; prm[704 + j] = p.in[I_LNB][d * 512 + c]; }
        __syncthreads();
        float S0 = 0.f, S1 = 0.f, S2 = 0.f, S3 = 0.f, S4 = 0.f, S5 = 0.f, S6 = 0.f, S7 = 0.f;
        for (int n0 = 0; n0 < LT; n0 += 32) {
            float rs[4], ks[4], vs[4];
#pragma unroll
            for (int m = 0; m < 4; ++m) { const int s = wv + 8 * m, n = n0 + s; const bool hp = (n != 0) && (n != LC);
                const size_t row = (size_t)step_row(d, b, n), prow = hp ? (size_t)step_row(d, b, n - 1) : row; const int c = 64 * h + lane;
                const float r0 = bf2f(RW[row * 1536 + c]), k0 = bf2f(RW[row * 1536 + 512 + c]), v0 = bf2f(RW[row * 1536 + 1024 + c]);
                const float r1 = hp ? bf2f(RW[prow * 1536 + c]) : 0.f, k1 = hp ? bf2f(RW[prow * 1536 + 512 + c]) : 0.f, v1 = hp ? bf2f(RW[prow * 1536 + 1024 + c]) : 0.f;
                rs[m] = r0 + prm[lane] * (r1 - r0); ks[m] = k0 + prm[64 + lane] * (k1 - k0); vs[m] = v0 + prm[128 + lane] * (v1 - v0);
                const float wd0 = bf2f(LO[row * 512 + 64 * d + lane]), wd1 = hp ? bf2f(LO[prow * 512 + 64 * d + lane]) : 0.f;
                const float ad0 = bf2f(LO[row * 512 + 128 + 64 * d + lane]), ad1 = hp ? bf2f(LO[prow * 512 + 128 + 64 * d + lane]) : 0.f;
                TH[s * 64 + lane] = tanhf(wd0 + prm[192 + lane] * (wd1 - wd0)); AD[s * 64 + lane] = ad0 + prm[256 + lane] * (ad1 - ad0); }
            __syncthreads();
#pragma unroll
            for (int m = 0; m < 4; ++m) { const int s = wv + 8 * m;
                float xw = prm[320 + lane], xa = prm[384 + lane];
#pragma unroll 8
                for (int i = 0; i < 64; ++i) { xw += TH[s * 64 + i] * w2s[i * 64 + lane]; xa += AD[s * 64 + i] * a2s[i * 64 + lane]; }
                const float elog = 0.6065306597126334f * sigm(xw), dec = expf(-elog), a = sigm(xa);
                const float kkr = ks[m] * prm[448 + lane]; const float ss = wave_sum(kkr * kkr); const float kkn = kkr / fmaxf(sqrtf(ss), 1e-12f);
                const float km = ks[m] * (1.f + (a - 1.f) * prm[512 + lane]);
                const float bs = wave_sum(rs[m] * km * prm[576 + lane]);
                R[s * 64 + lane] = rs[m]; W[s * 64 + lane] = dec; K[s * 64 + lane] = km; KK[s * 64 + lane] = kkn; BV[s * 64 + lane] = kkn * a; V[s * 64 + lane] = vs[m];
                if (lane == 0) BS[s] = bs; }
            __syncthreads();
            for (int s = 0; s < 32; ++s) {
                const LAS f32x4* pq = (const LAS f32x4*)(KK + s * 64 + 8 * sg); const f32x4 q0 = pq[0], q1 = pq[1];
                const LAS f32x4* pw = (const LAS f32x4*)(W + s * 64 + 8 * sg); const f32x4 w0 = pw[0], w1 = pw[1];
                const LAS f32x4* pb = (const LAS f32x4*)(BV + s * 64 + 8 * sg); const f32x4 b0 = pb[0], b1 = pb[1];
                const LAS f32x4* pk = (const LAS f32x4*)(K + s * 64 + 8 * sg); const f32x4 k0 = pk[0], k1 = pk[1];
                const LAS f32x4* pr = (const LAS f32x4*)(R + s * 64 + 8 * sg); const f32x4 r0 = pr[0], r1 = pr[1];
                const float vi = V[s * 64 + srow];
                float sa = S0 * q0.x + S1 * q0.y + S2 * q0.z + S3 * q0.w + S4 * q1.x + S5 * q1.y + S6 * q1.z + S7 * q1.w;
                sa += __shfl_xor(sa, 1); sa += __shfl_xor(sa, 2); sa += __shfl_xor(sa, 4);
                S0 = S0 * w0.x - sa * b0.x + vi * k0.x; S1 = S1 * w0.y - sa * b0.y + vi * k0.y; S2 = S2 * w0.z - sa * b0.z + vi * k0.z; S3 = S3 * w0.w - sa * b0.w + vi * k0.w;
                S4 = S4 * w1.x - sa * b1.x + vi * k1.x; S5 = S5 * w1.y - sa * b1.y + vi * k1.y; S6 = S6 * w1.z - sa * b1.z + vi * k1.z; S7 = S7 * w1.w - sa * b1.w + vi * k1.w;
                float o = S0 * r0.x + S1 * r0.y + S2 * r0.z + S3 * r0.w + S4 * r1.x + S5 * r1.y + S6 * r1.z + S7 * r1.w;
                o += __shfl_xor(o, 1); o += __shfl_xor(o, 2); o += __shfl_xor(o, 4);
                if (sg == 0) OUT[s * 64 + srow] = o;
            }
            __syncthreads();
#pragma unroll
            for (int m = 0; m < 4; ++m) { const int s = wv + 8 * m, n = n0 + s; const size_t row = (size_t)step_row(d, b, n);
                const float o = OUT[s * 64 + lane]; const float mean = wave_sum(o) * (1.f / 64.f); const float dv = o - mean; const float var = wave_sum(dv * dv) * (1.f / 64.f);
                const float z = dv * rsqrtf(var + 64e-5f) * prm[640 + lane] + prm[704 + lane] + BS[s] * V[s * 64 + lane];
                Z[((size_t)d * NALL + row) * 512 + 64 * h + lane] = f2bf(z); }
        }
    }
    __syncthreads();
}
DI void phase_rwkv_post(const P& p, LAS unsigned char* ldsb) {
    LAS float* sg = (LAS float*)ldsb;
    const int tid = mk_tid();
    const bf16_t* LO = (const bf16_t*)(p.ws + WS_COLS) + OFF_LO; const bf16_t* Z = (const bf16_t*)(p.ws + WS_Z); bf16_t* Y = (bf16_t*)(p.ws + WS_COLS);
    const float* g2 = p.in[I_G2];
    for (int vb = blockIdx.x; vb < NALL / 8; vb += gridDim.x) {
        const size_t row0 = (size_t)vb * 8;
        __syncthreads();
        for (int e = tid; e < 1024; e += NT) { const int q = e >> 7, r = e & 127; sg[e] = sigm(bf2f(LO[(row0 + q) * 512 + 256 + r])); }
        __syncthreads();
        float a0 = 0.f, a1 = 0.f, a2 = 0.f, a3 = 0.f, a4 = 0.f, a5 = 0.f, a6 = 0.f, a7 = 0.f;
#pragma unroll 4
        for (int r = 0; r < 128; ++r) { const float g = g2[r * 512 + tid];
            a0 += sg[r] * g; a1 += sg[128 + r] * g; a2 += sg[256 + r] * g; a3 += sg[384 + r] * g; a4 += sg[512 + r] * g; a5 += sg[640 + r] * g; a6 += sg[768 + r] * g; a7 += sg[896 + r] * g; }
#define MK_RP(q, aq) { const size_t rr = row0 + q; const float z = bf2f(Z[rr * 512 + tid]) + bf2f(Z[((size_t)NALL + rr) * 512 + tid]); Y[rr * D + tid] = f2bf(z * aq); }
        MK_RP(0, a0) MK_RP(1, a1) MK_RP(2, a2) MK_RP(3, a3) MK_RP(4, a4) MK_RP(5, a5) MK_RP(6, a6) MK_RP(7, a7)
#undef MK_RP
    }
    __syncthreads();
}
DI void post_headnorm_row(const bf16_t* HB, size_t row, const float* ng, const bf16_t* gsrc, int gate_kind, bf16_t* ydst, int lane) {
    const int c0 = 8 * lane;
    const u32x4 h0 = *(const u32x4*)(HB + row * 512 + c0), h1 = *(const u32x4*)(HB + ((size_t)NALL + row) * 512 + c0), gg = *(const u32x4*)(gsrc + c0);
    float h[8], g[8];
#pragma unroll
    for (int j = 0; j < 4; ++j) { h[2 * j] = __uint_as_float(h0[j] << 16) + __uint_as_float(h1[j] << 16); h[2 * j + 1] = __uint_as_float(h0[j] & 0xffff0000u) + __uint_as_float(h1[j] & 0xffff0000u);
        g[2 * j] = __uint_as_float(gg[j] << 16); g[2 * j + 1] = __uint_as_float(gg[j] & 0xffff0000u); }
    float ss = 0.f;
#pragma unroll
    for (int j = 0; j < 8; ++j) ss += h[j] * h[j];
    ss += __shfl_xor(ss, 1); ss += __shfl_xor(ss, 2); ss += __shfl_xor(ss, 4); ss += __shfl_xor(ss, 8);
    const float rinv = rsqrtf(ss * (1.f / 128.f) + 1e-6f);
    unsigned o[4];
#pragma unroll
    for (int j = 0; j < 4; ++j) { const float y0 = h[2 * j] * rinv * ng[c0 + 2 * j] * (gate_kind ? siluf(g[2 * j]) : sigm(g[2 * j])), y1 = h[2 * j + 1] * rinv * ng[c0 + 2 * j + 1] * (gate_kind ? siluf(g[2 * j + 1]) : sigm(g[2 * j + 1]));
        o[j] = pack2(y0, y1); }
    u32x4 w; w.x = o[0]; w.y = o[1]; w.z = o[2]; w.w = o[3];
    *(u32x4*)(ydst + c0) = w;
}
typedef short bf16x8 __attribute__((ext_vector_type(8)));
typedef short s16x4 __attribute__((ext_vector_type(4)));
constexpr int PQ = 136, PS = 72, PV = 56;
constexpr int E_QS = 0, E_KS = E_QS + 64 * PQ * 2, E_VS = E_KS + 64 * PQ * 2, E_PS = E_VS + 64 * PV * 2, E_ST = E_PS + 64 * PS * 2, E_F = E_ST + 48 * PQ * 2, E_END = E_F + 2048;
constexpr size_t WS_Q1 = WS_COLS + (size_t)231 * MiB;
constexpr int NRC = NALL / 64;

DI int chunk_row0(int d, int b, int ci) {
    if (ci < 4) { const int cc = d ? 3 - ci : ci; return NLAT + b * LC + 64 * cc; }
    const int lc = ci - 4, cl = d ? 127 - lc : lc; return b * L + 64 * cl;
}
DI bf16x8 tr_frag(unsigned tile_base, int pitch, int k0, int c0, int r, int q) {
    const unsigned a0 = tile_base + (unsigned)(((k0 + 8 * q + (r >> 2)) * pitch + c0 + 4 * (r & 3)) * 2), a1 = a0 + (unsigned)(4 * pitch * 2);
    s16x4 x, y;
    asm volatile("ds_read_b64_tr_b16 %0, %2\n\tds_read_b64_tr_b16 %1, %3\n\ts_waitcnt lgkmcnt(0)" : "=&v"(x), "=&v"(y) : "v"(a0), "v"(a1) : "memory");
    bf16x8 o; o[0] = x[0]; o[1] = x[1]; o[2] = x[2]; o[3] = x[3]; o[4] = y[0]; o[5] = y[1]; o[6] = y[2]; o[7] = y[3];
    return o;
}

DI unsigned tr_addr(unsigned tile_base, int pitch, int k0, int c0, int r, int q) { return tile_base + (unsigned)(((k0 + 8 * q + (r >> 2)) * pitch + c0 + 4 * (r & 3)) * 2); }
DI bf16x8 tr_join(s16x4 x, s16x4 y) { bf16x8 o; o[0] = x[0]; o[1] = x[1]; o[2] = x[2]; o[3] = x[3]; o[4] = y[0]; o[5] = y[1]; o[6] = y[2]; o[7] = y[3]; return o; }
DI void tr_frag2(bf16x8& f0, bf16x8& f1, unsigned a0, unsigned h0, unsigned a1, unsigned h1) {
    s16x4 x0, y0, x1, y1; const unsigned b0 = a0 + h0, b1 = a1 + h1;
    asm volatile("ds_read_b64_tr_b16 %0, %4\n\tds_read_b64_tr_b16 %1, %5\n\tds_read_b64_tr_b16 %2, %6\n\tds_read_b64_tr_b16 %3, %7\n\ts_waitcnt lgkmcnt(0)"
                 : "=&v"(x0), "=&v"(y0), "=&v"(x1), "=&v"(y1) : "v"(a0), "v"(b0), "v"(a1), "v"(b1) : "memory");
    f0 = tr_join(x0, y0); f1 = tr_join(x1, y1);
}
DI void tr_frag3(bf16x8& f0, bf16x8& f1, bf16x8& f2, unsigned a0, unsigned h0, unsigned a1, unsigned h1, unsigned a2, unsigned h2) {
    s16x4 x0, y0, x1, y1, x2, y2; const unsigned b0 = a0 + h0, b1 = a1 + h1, b2 = a2 + h2;
    asm volatile("ds_read_b64_tr_b16 %0, %6\n\tds_read_b64_tr_b16 %1, %7\n\tds_read_b64_tr_b16 %2, %8\n\tds_read_b64_tr_b16 %3, %9\n\tds_read_b64_tr_b16 %4, %10\n\tds_read_b64_tr_b16 %5, %11\n\ts_waitcnt lgkmcnt(0)"
                 : "=&v"(x0), "=&v"(y0), "=&v"(x1), "=&v"(y1), "=&v"(x2), "=&v"(y2) : "v"(a0), "v"(b0), "v"(a1), "v"(b1), "v"(a2), "v"(b2) : "memory");
    f0 = tr_join(x0, y0); f1 = tr_join(x1, y1); f2 = tr_join(x2, y2);
}
DI void tr_frag4(bf16x8& f0, bf16x8& f1, bf16x8& f2, bf16x8& f3, unsigned a0, unsigned h0, unsigned a1, unsigned h1, unsigned a2, unsigned h2, unsigned a3, unsigned h3) {
    s16x4 x0, y0, x1, y1, x2, y2, x3, y3; const unsigned b0 = a0 + h0, b1 = a1 + h1, b2 = a2 + h2, b3 = a3 + h3;
    asm volatile("ds_read_b64_tr_b16 %0, %8\n\tds_read_b64_tr_b16 %1, %9\n\tds_read_b64_tr_b16 %2, %10\n\tds_read_b64_tr_b16 %3, %11\n\tds_read_b64_tr_b16 %4, %12\n\tds_read_b64_tr_b16 %5, %13\n\tds_read_b64_tr_b16 %6, %14\n\tds_read_b64_tr_b16 %7, %15\n\ts_waitcnt lgkmcnt(0)"
                 : "=&v"(x0), "=&v"(y0), "=&v"(x1), "=&v"(y1), "=&v"(x2), "=&v"(y2), "=&v"(x3), "=&v"(y3) : "v"(a0), "v"(b0), "v"(a1), "v"(b1), "v"(a2), "v"(b2), "v"(a3), "v"(b3) : "memory");
    f0 = tr_join(x0, y0); f1 = tr_join(x1, y1); f2 = tr_join(x2, y2); f3 = tr_join(x3, y3);
}
DI void tr_frag5(bf16x8& f0, bf16x8& f1, bf16x8& f2, bf16x8& f3, bf16x8& f4, unsigned a0, unsigned h0, unsigned a1, unsigned h1, unsigned a2, unsigned h2, unsigned a3, unsigned h3, unsigned a4, unsigned h4) {
    s16x4 x0, y0, x1, y1, x2, y2, x3, y3, x4, y4; const unsigned b0 = a0 + h0, b1 = a1 + h1, b2 = a2 + h2, b3 = a3 + h3, b4 = a4 + h4;
    asm volatile("ds_read_b64_tr_b16 %0, %10\n\tds_read_b64_tr_b16 %1, %11\n\tds_read_b64_tr_b16 %2, %12\n\tds_read_b64_tr_b16 %3, %13\n\tds_read_b64_tr_b16 %4, %14\n\tds_read_b64_tr_b16 %5, %15\n\tds_read_b64_tr_b16 %6, %16\n\tds_read_b64_tr_b16 %7, %17\n\tds_read_b64_tr_b16 %8, %18\n\tds_read_b64_tr_b16 %9, %19\n\ts_waitcnt lgkmcnt(0)"
                 : "=&v"(x0), "=&v"(y0), "=&v"(x1), "=&v"(y1), "=&v"(x2), "=&v"(y2), "=&v"(x3), "=&v"(y3), "=&v"(x4), "=&v"(y4) : "v"(a0), "v"(b0), "v"(a1), "v"(b1), "v"(a2), "v"(b2), "v"(a3), "v"(b3), "v"(a4), "v"(b4) : "memory");
    f0 = tr_join(x0, y0); f1 = tr_join(x1, y1); f2 = tr_join(x2, y2); f3 = tr_join(x3, y3); f4 = tr_join(x4, y4);
}

#define GLA_PREFETCH(ci_) do { const int row0_ = chunk_row0(d, b, (ci_)); \
    _Pragma("unroll") for (int i = 0; i < 2; ++i) { const size_t row_ = (size_t)(row0_ + prow0 + 32 * i); \
        rq[i] = *(const u32x4*)(Qg + row_ * ldq + 8 * ppc); rk[i] = *(const u32x4*)(Kg + row_ * ldk + 8 * ppc); } \
    if (tid < 256) rv = *(const u32x4*)(Vg + (size_t)(row0_ + vrow) * ldv + 8 * vpc); \
    if (MODE != 0) rlam = *(const f32x4*)(LAM + ((size_t)d * NRC + (row0_ >> 6)) * 512 + 128 * hd + 16 * wv + 4 * q); } while (0)

DI float flog(float x) { return __builtin_amdgcn_logf(x) * 0.6931471805599453f; }
#define GLA_GATE_LOAD(ci_) do { const size_t row_ = (size_t)(chunk_row0(d, b, (ci_)) + (d ? 63 - lane : lane)); gi = bf2f(LO[row_ * 512 + 384 + 4 * d + hd]); gf = bf2f(LO[row_ * 512 + 392 + 4 * d + hd]); } while (0)
#define GLA_GATE_COMPUTE(buf_) do { const float li_ = gi + bi, x_ = gf + bfv; float v_ = scan16(-flog(1.f + fexp(-x_))); \
    const float t0_ = __int_as_float(__builtin_amdgcn_readlane(__float_as_int(v_), 15)), t1_ = __int_as_float(__builtin_amdgcn_readlane(__float_as_int(v_), 31)), t2_ = __int_as_float(__builtin_amdgcn_readlane(__float_as_int(v_), 47)); \
    v_ += (q >= 1 ? t0_ : 0.f) + (q >= 2 ? t1_ : 0.f) + (q >= 3 ? t2_ : 0.f); const int rc_ = d ? 63 - lane : lane; LAS float* F_ = Fs + (buf_) * 132; \
    F_[rc_] = fexp(v_) * 0.08838834764831845f; F_[64 + rc_] = fexp(li_ - v_); if (lane == 63) F_[128] = fexp(v_); } while (0)
template <int MODE> DI void gla_unit(const P& p, LAS unsigned char* lds, int unit) {
    constexpr int NDV = MODE == 0 ? 3 : 2;
    const int tid = mk_tid(), lane = tid & 63, wv = __builtin_amdgcn_readfirstlane(tid >> 6), r = lane & 15, q = lane >> 4;
    const int d = unit >> 6, b = (unit >> 4) & 3, hd = (unit >> 2) & 3, sl = unit & 3;
    const bf16_t* COLS = (const bf16_t*)(p.ws + WS_COLS);
    const bf16_t *Qg, *Kg, *Vg; int ldq, ldk, ldv;
    if (MODE == 0) { const bf16_t* ML = COLS + OFF_ML; Qg = ML + 128 * hd; Kg = ML + 512 + 128 * hd; Vg = ML + 1024 + 128 * hd + 32 * sl; ldq = ldk = ldv = 2048; }
    else { Qg = d ? (const bf16_t*)(p.ws + WS_Q1) + 128 * hd : COLS + 128 * hd; ldq = d ? 512 : 3584; Kg = COLS + 512 + 512 * d + 128 * hd; ldk = 3584; Vg = COLS + 1536 + 128 * hd + 32 * sl; ldv = 3584; }
    const bf16_t* LO = COLS + OFF_LO;
    const float* LAM = (const float*)(p.ws + WS_LAM);
    bf16_t* HB = (bf16_t*)(p.ws + WS_ACT);
    LAS bf16_t* Qs = (LAS bf16_t*)(lds + E_QS); LAS bf16_t* Ks = (LAS bf16_t*)(lds + E_KS); LAS bf16_t* Vs = (LAS bf16_t*)(lds + E_VS);
    LAS bf16_t* Ps = (LAS bf16_t*)(lds + E_PS); LAS bf16_t* STs = (LAS bf16_t*)(lds + E_ST); LAS float* Fs = (LAS float*)(lds + E_F);
    const unsigned ks_base = (unsigned)(size_t)Ks, vs_base = (unsigned)(size_t)Vs;
    float bi = 0.f, bfv = 0.f;
    if (MODE == 0) { bi = p.in[I_MBI][d * 4 + hd]; bfv = p.in[I_MBF][d * 4 + hd]; }
    __syncthreads();
    for (int e = tid; e < 48 * PQ / 2; e += NT) ((LAS unsigned*)STs)[e] = 0u;
    for (int e = tid; e < 64 * PV / 2; e += NT) ((LAS unsigned*)Vs)[e] = 0u;
    __syncthreads();
    f32x4 Sacc[NDV];
#pragma unroll
    for (int n = 0; n < NDV; ++n) Sacc[n] = (f32x4){0.f, 0.f, 0.f, 0.f};
    u32x4 rq[2], rk[2], rv = (u32x4){0u, 0u, 0u, 0u}; float gi = 0.f, gf = 0.f; f32x4 rlam = (f32x4){1.f, 1.f, 1.f, 1.f};
    const int prow0 = tid >> 4, ppc = tid & 15;
    const int vrow = tid >> 2, vpc = tid & 3;
    GLA_PREFETCH(0);
    if (MODE == 0) { if (tid < 64) { GLA_GATE_LOAD(0); GLA_GATE_COMPUTE(0); GLA_GATE_LOAD(1); } __syncthreads(); }
    for (int ci = 0; ci < 132; ++ci) {
        const int row0 = chunk_row0(d, b, ci);
        unsigned oz = 0u; asm volatile("" : "+v"(oz));
        const unsigned ks_b = ks_base + oz, vs_b = vs_base + oz;
        f32x4 lamv = rlam;
        const LAS float* Fc = Fs + (ci & 1) * 132;
#pragma unroll
        for (int i = 0; i < 2; ++i) { const int row = prow0 + 32 * i; *(LAS u32x4*)(Qs + row * PQ + 8 * ppc) = rq[i]; *(LAS u32x4*)(Ks + row * PQ + 8 * ppc) = rk[i]; }
        if (tid < 256) {
            if (MODE == 0) { const float w = Fc[64 + vrow]; u32x4 o;
#pragma unroll
                for (int e = 0; e < 4; ++e) o[e] = pack2(__uint_as_float(rv[e] << 16) * w, __uint_as_float(rv[e] & 0xffff0000u) * w);
                *(LAS u32x4*)(Vs + vrow * PV + 8 * vpc) = o;
                if (vpc == 0) Vs[vrow * PV + 32] = f2bf(w); }
            else *(LAS u32x4*)(Vs + vrow * PV + 8 * vpc) = rv;
        }
        __syncthreads();
        if (ci + 1 < 132) GLA_PREFETCH(ci + 1);
        if (MODE == 0) { const float l = Fc[128]; lamv = (f32x4){l, l, l, l};
            if (tid < 64 && ci + 1 < 132) { GLA_GATE_COMPUTE((ci + 1) & 1); if (ci + 2 < 132) GLA_GATE_LOAD(ci + 2); } }
        {
            const int tt = wv & 3, sh = wv >> 2;
            f32x4 pacc[2] = {(f32x4){0.f, 0.f, 0.f, 0.f}, (f32x4){0.f, 0.f, 0.f, 0.f}};
#pragma unroll
            for (int kk = 0; kk < 4; ++kk) { const bf16x8 bq = *(const LAS bf16x8*)(Qs + (16 * tt + r) * PQ + 32 * kk + 8 * q);
#pragma unroll
                for (int i = 0; i < 2; ++i) { const bf16x8 a = *(const LAS bf16x8*)(Ks + (16 * (2 * sh + i) + r) * PQ + 32 * kk + 8 * q); pacc[i] = __builtin_amdgcn_mfma_f32_16x16x32_bf16(a, bq, pacc[i], 0, 0, 0); } }
            const int t = 16 * tt + r;
#pragma unroll
            for (int i = 0; i < 2; ++i) { const int s0 = 16 * (2 * sh + i) + 4 * q; float v[4];
#pragma unroll
                for (int j = 0; j < 4; ++j) { const int s = s0 + j; const bool ok = d ? (s >= t) : (s <= t); v[j] = ok ? pacc[i][j] : 0.f; }
                u32x2 w; w.x = pack2(v[0], v[1]); w.y = pack2(v[2], v[3]); *(LAS u32x2*)(Ps + t * PS + s0) = w; }
        }
        bf16x8 vfr[2][3];
#pragma unroll
        for (int kk = 0; kk < 2; ++kk) { bf16x8 a;
            if (NDV == 3) tr_frag4(a, vfr[kk][0], vfr[kk][1], vfr[kk][2], tr_addr(ks_b, PQ, 32 * kk, 16 * wv, r, q), 8u * PQ, tr_addr(vs_b, PV, 32 * kk, 0, r, q), 8u * PV, tr_addr(vs_b, PV, 32 * kk, 16, r, q), 8u * PV, tr_addr(vs_b, PV, 32 * kk, 32, r, q), 8u * PV);
            else { tr_frag3(a, vfr[kk][0], vfr[kk][1], tr_addr(ks_b, PQ, 32 * kk, 16 * wv, r, q), 8u * PQ, tr_addr(vs_b, PV, 32 * kk, 0, r, q), 8u * PV, tr_addr(vs_b, PV, 32 * kk, 16, r, q), 8u * PV); vfr[kk][2] = vfr[kk][1]; }
#pragma unroll
            for (int n = 0; n < NDV; ++n) Sacc[n] = __builtin_amdgcn_mfma_f32_16x16x32_bf16(a, vfr[kk][n], Sacc[n], 0, 0, 0); }
        __syncthreads();
        {
            const int tt = wv & 3, nA = wv >> 2;
            f32x4 oacc = (f32x4){0.f, 0.f, 0.f, 0.f}, dacc = (f32x4){0.f, 0.f, 0.f, 0.f};
#pragma unroll
            for (int kk = 0; kk < 2; ++kk) { const bf16x8 bp = *(const LAS bf16x8*)(Ps + (16 * tt + r) * PS + 32 * kk + 8 * q);
                const bf16x8 a = nA ? vfr[kk][1] : vfr[kk][0]; oacc = __builtin_amdgcn_mfma_f32_16x16x32_bf16(a, bp, oacc, 0, 0, 0);
                if (MODE == 0) dacc = __builtin_amdgcn_mfma_f32_16x16x32_bf16(vfr[kk][2], bp, dacc, 0, 0, 0); }
#pragma unroll
            for (int kk = 0; kk < 4; ++kk) { const bf16x8 bq = *(const LAS bf16x8*)(Qs + (16 * tt + r) * PQ + 32 * kk + 8 * q);
                const bf16x8 a = *(const LAS bf16x8*)(STs + (16 * nA + r) * PQ + 32 * kk + 8 * q); oacc = __builtin_amdgcn_mfma_f32_16x16x32_bf16(a, bq, oacc, 0, 0, 0);
                if (MODE == 0) { const bf16x8 a2 = *(const LAS bf16x8*)(STs + (32 + r) * PQ + 32 * kk + 8 * q); dacc = __builtin_amdgcn_mfma_f32_16x16x32_bf16(a2, bq, dacc, 0, 0, 0); } }
            const int t = 16 * tt + r;
            float o0 = oacc[0], o1 = oacc[1], o2 = oacc[2], o3 = oacc[3];
            if (MODE == 0) { const float rs = Fc[t]; const float den = __shfl(dacc[0], r) * rs; const float inv = rs / fmaxf(fabsf(den), 1.f); o0 *= inv; o1 *= inv; o2 *= inv; o3 *= inv; }
            u32x2 w; w.x = pack2(o0, o1); w.y = pack2(o2, o3);
            *(u32x2*)(HB + ((size_t)d * NALL + row0 + t) * 512 + 128 * hd + 32 * sl + 16 * nA + 4 * q) = w;
        }
        __syncthreads();
#pragma unroll
        for (int n = 0; n < NDV; ++n) { Sacc[n] = Sacc[n] * lamv; u32x2 w; w.x = pack2(Sacc[n][0], Sacc[n][1]); w.y = pack2(Sacc[n][2], Sacc[n][3]); *(LAS u32x2*)(STs + (16 * n + r) * PQ + 16 * wv + 4 * q) = w; }
    }
    __syncthreads();
}

DI void phase_hgrn_prep(const P& p, LAS unsigned char* ldsb) {
    LAS float* tot = (LAS float*)ldsb;
    const int tid = mk_tid(), ch = tid & 127, qt = tid >> 7;
    bf16_t* C1 = (bf16_t*)(p.ws + WS_COLS); bf16_t* Q1 = (bf16_t*)(p.ws + WS_Q1); float* LAM = (float*)(p.ws + WS_LAM);
    for (int vb = blockIdx.x; vb < NRC * 4; vb += gridDim.x) {
        const int rc = vb >> 2, hd = vb & 3, c = 128 * hd + ch; const size_t rbase = (size_t)rc * 64 + 16 * qt;
        const float lb = sigm(p.in[I_HLB][512 + c] - p.in[I_HLB][c]);
        float qv[16], l0[16], l1[16], k0[16], k1[16];
#pragma unroll
        for (int i = 0; i < 16; ++i) { const bf16_t* base = C1 + (rbase + i) * 3584;
            qv[i] = siluf(bf2f(base[c])); const float s0 = sigm(bf2f(base[512 + c])), s1 = sigm(bf2f(base[1024 + c]));
            l0[i] = logf(lb + (1.f - lb) * s0); l1[i] = logf(lb + (1.f - lb) * s1); k0[i] = (1.f - lb) * (1.f - s0); k1[i] = (1.f - lb) * (1.f - s1); }
#pragma unroll
        for (int i = 1; i < 16; ++i) l0[i] += l0[i - 1];
#pragma unroll
        for (int i = 14; i >= 0; --i) l1[i] += l1[i + 1];
        __syncthreads();
        tot[qt * 128 + ch] = l0[15]; tot[512 + qt * 128 + ch] = l1[0];
        __syncthreads();
        float off0 = 0.f, off1 = 0.f, t0 = 0.f, t1 = 0.f;
#pragma unroll
        for (int j = 0; j < 4; ++j) { const float a = tot[j * 128 + ch], bb = tot[512 + j * 128 + ch]; t0 += a; t1 += bb; if (j < qt) off0 += a; if (j > qt) off1 += bb; }
#pragma unroll
        for (int i = 0; i < 16; ++i) { bf16_t* base = C1 + (rbase + i) * 3584; const float c0 = l0[i] + off0, c1 = l1[i] + off1;
            base[c] = f2bf(qv[i] * expf(c0)); base[512 + c] = f2bf(k0[i] * expf(-c0)); base[1024 + c] = f2bf(k1[i] * expf(-c1)); Q1[(rbase + i) * 512 + c] = f2bf(qv[i] * expf(c1)); }
        if (qt == 0) { LAM[((size_t)rc) * 512 + c] = expf(t0); LAM[((size_t)NRC + rc) * 512 + c] = expf(t1); }
    }
    __syncthreads();
}
DI void phase_hgrn_prep2(const P& p, LAS unsigned char* ldsb) {
    LAS float* tot = (LAS float*)ldsb;
    const int tid = mk_tid(), cp = tid & 63, qt = (tid >> 6) & 3, rs = tid >> 8, c0 = 8 * cp;
    bf16_t* C1 = (bf16_t*)(p.ws + WS_COLS); bf16_t* Q1 = (bf16_t*)(p.ws + WS_Q1); float* LAM = (float*)(p.ws + WS_LAM);
    float lb[8], omlb[8];
#pragma unroll
    for (int k = 0; k < 8; ++k) { lb[k] = fsigm(p.in[I_HLB][512 + c0 + k] - p.in[I_HLB][c0 + k]); omlb[k] = 1.f - lb[k]; }
    for (int vb = blockIdx.x; vb < NRC / 2; vb += gridDim.x) {
        const int rc = 2 * vb + rs; const size_t rbase = (size_t)rc * 64 + 16 * qt;
        float s0[8], s1[8];
#pragma unroll
        for (int k = 0; k < 8; ++k) { s0[k] = 0.f; s1[k] = 0.f; }
#pragma unroll 4
        for (int i = 0; i < 16; ++i) { const bf16_t* base = C1 + (rbase + i) * 3584; const u32x4 f0 = *(const u32x4*)(base + 512 + c0), f1 = *(const u32x4*)(base + 1024 + c0);
#pragma unroll
            for (int k = 0; k < 4; ++k) { s0[2 * k] += flog(lb[2 * k] + omlb[2 * k] * fsigm(__uint_as_float(f0[k] << 16))); s0[2 * k + 1] += flog(lb[2 * k + 1] + omlb[2 * k + 1] * fsigm(__uint_as_float(f0[k] & 0xffff0000u)));
                s1[2 * k] += flog(lb[2 * k] + omlb[2 * k] * fsigm(__uint_as_float(f1[k] << 16))); s1[2 * k + 1] += flog(lb[2 * k + 1] + omlb[2 * k + 1] * fsigm(__uint_as_float(f1[k] & 0xffff0000u))); } }
        __syncthreads();
#pragma unroll
        for (int k = 0; k < 8; k += 4) { *(LAS f32x4*)(tot + ((rs * 2 + 0) * 4 + qt) * 512 + c0 + k) = (f32x4){s0[k], s0[k + 1], s0[k + 2], s0[k + 3]}; *(LAS f32x4*)(tot + ((rs * 2 + 1) * 4 + qt) * 512 + c0 + k) = (f32x4){s1[k], s1[k + 1], s1[k + 2], s1[k + 3]}; }
        __syncthreads();
        float run0[8], run1[8], t0[8], t1[8];
#pragma unroll
        for (int k = 0; k < 8; ++k) { run0[k] = 0.f; run1[k] = 0.f; t0[k] = 0.f; t1[k] = 0.f; }
#pragma unroll
        for (int j = 0; j < 4; ++j)
#pragma unroll
            for (int k = 0; k < 8; ++k) { const float a = tot[((rs * 2 + 0) * 4 + j) * 512 + c0 + k], bb = tot[((rs * 2 + 1) * 4 + j) * 512 + c0 + k]; t0[k] += a; t1[k] += bb; if (j < qt) run0[k] += a; if (j >= qt) run1[k] += bb; }
        if (qt == 0) {
#pragma unroll
            for (int k = 0; k < 8; k += 4) { *(f32x4*)(LAM + (size_t)rc * 512 + c0 + k) = (f32x4){fexp(t0[k]), fexp(t0[k + 1]), fexp(t0[k + 2]), fexp(t0[k + 3])};
                *(f32x4*)(LAM + ((size_t)NRC + rc) * 512 + c0 + k) = (f32x4){fexp(t1[k]), fexp(t1[k + 1]), fexp(t1[k + 2]), fexp(t1[k + 3])}; } }
#pragma unroll 2
        for (int i = 0; i < 16; ++i) { bf16_t* base = C1 + (rbase + i) * 3584; const u32x4 qv = *(const u32x4*)(base + c0), f0 = *(const u32x4*)(base + 512 + c0), f1 = *(const u32x4*)(base + 1024 + c0);
            float oq0[8], ok0[8], ok1[8], oq1[8];
#pragma unroll
            for (int k = 0; k < 8; ++k) { const unsigned wq = qv[k >> 1], w0 = f0[k >> 1], w1 = f1[k >> 1];
                const float qx = (k & 1) ? __uint_as_float(wq & 0xffff0000u) : __uint_as_float(wq << 16), x0 = (k & 1) ? __uint_as_float(w0 & 0xffff0000u) : __uint_as_float(w0 << 16), x1 = (k & 1) ? __uint_as_float(w1 & 0xffff0000u) : __uint_as_float(w1 << 16);
                const float sq = qx * fsigm(qx), sg0 = fsigm(x0), sg1 = fsigm(x1);
                const float l0 = flog(lb[k] + omlb[k] * sg0), l1 = flog(lb[k] + omlb[k] * sg1);
                run0[k] += l0;
                const float cb = run1[k];
                run1[k] -= l1;
                const float e0 = fexp(run0[k]), e1 = fexp(cb);
                oq0[k] = sq * e0; ok0[k] = omlb[k] * (1.f - sg0) * frcp(e0); ok1[k] = omlb[k] * (1.f - sg1) * frcp(e1); oq1[k] = sq * e1; }
            u32x4 w; w.x = pack2(oq0[0], oq0[1]); w.y = pack2(oq0[2], oq0[3]); w.z = pack2(oq0[4], oq0[5]); w.w = pack2(oq0[6], oq0[7]); *(u32x4*)(base + c0) = w;
            w.x = pack2(ok0[0], ok0[1]); w.y = pack2(ok0[2], ok0[3]); w.z = pack2(ok0[4], ok0[5]); w.w = pack2(ok0[6], ok0[7]); *(u32x4*)(base + 512 + c0) = w;
            w.x = pack2(ok1[0], ok1[1]); w.y = pack2(ok1[2], ok1[3]); w.z = pack2(ok1[4], ok1[5]); w.w = pack2(ok1[6], ok1[7]); *(u32x4*)(base + 1024 + c0) = w;
            w.x = pack2(oq1[0], oq1[1]); w.y = pack2(oq1[2], oq1[3]); w.z = pack2(oq1[4], oq1[5]); w.w = pack2(oq1[6], oq1[7]); *(u32x4*)(Q1 + (rbase + i) * 512 + c0) = w; }
    }
    __syncthreads();
}
constexpr int XBP = 68, M_XB = 0, M_XCS = M_XB + 67 * XBP * 4, M_XCF = M_XCS + 64 * 72 * 2, M_W = M_XCF + 64 * 64 * 4, M_AU = M_W + 4 * 64 * 72 * 2, M_SEG = M_AU + 4 * 64 * 65 * 4, M_PRM = M_SEG + 4 * 8 * 64 * 4,
              M_CAR = M_PRM + 11 * 64 * 4, M_END = M_CAR + 2 * 64 * 4;
static_assert(M_END <= LDS_BYTES, "lru LDS map");
DI float nexpm1_small(float x) { const float ser = -x * (1.f + x * 0.5f * (1.f + x * (1.f / 3.f) * (1.f + x * 0.25f * (1.f + x * 0.2f)))); return (x > -0.25f) ? ser : 1.f - fexp(x); }
DI int lru_rc_at(int d, int b, int s) { if (s < 4) return 512 + 4 * b + (d ? 3 - s : s); const int lc = s - 4; return 128 * b + (d ? 127 - lc : lc); }
template <int PASS> DI void lru_pass(const P& p, LAS unsigned char* lds, const int lb, const int nlb) {
    const int tid = mk_tid(), lane = tid & 63, wv = __builtin_amdgcn_readfirstlane(tid >> 6), r = lane & 15, q = lane >> 4;
    const int hb = lb & 7;
    const bf16_t* C1 = (const bf16_t*)(p.ws + WS_COLS); bf16_t* Y = (bf16_t*)(p.ws + WS_Z); float* LSUM = (float*)(p.ws + WS_LSUM);
    LAS float* XB = (LAS float*)(lds + M_XB); LAS bf16_t* XCs = (LAS bf16_t*)(lds + M_XCS); LAS float* XCf = (LAS float*)(lds + M_XCF); LAS bf16_t* Wt = (LAS bf16_t*)(lds + M_W);
    LAS float* AU = (LAS float*)(lds + M_AU);
    LAS float* SEG = (LAS float*)(lds + M_SEG);
    LAS float* prm = (LAS float*)(lds + M_PRM);
    LAS float* CAR = (LAS float*)(lds + M_CAR);
    __syncthreads();
    for (int e = tid; e < 4 * 4096; e += NT) { const int g = e >> 12, i = (e >> 6) & 63, j = e & 63, d = g >> 1; const size_t o = ((size_t)(d * 8 + hb) * 64 + i) * 64 + j;
        Wt[(g * 64 + j) * 72 + i] = f2bf((g & 1) ? p.in[I_WI][o] : p.in[I_WA][o]); }
    if (tid < 64) { const int ch = 64 * hb + tid;
        prm[tid] = p.in[I_CONVW][ch]; prm[64 + tid] = p.in[I_CONVW][512 + ch]; prm[128 + tid] = p.in[I_CONVW][1024 + ch]; prm[192 + tid] = p.in[I_CONVW][1536 + ch]; prm[256 + tid] = p.in[I_CONVB][ch];
        prm[320 + tid] = p.in[I_BA][ch]; prm[384 + tid] = p.in[I_BA][512 + ch]; prm[448 + tid] = p.in[I_BI][ch]; prm[512 + tid] = p.in[I_BI][512 + ch];
        prm[576 + tid] = log1pf(expf(-p.in[I_LAM][ch])); prm[640 + tid] = log1pf(expf(-p.in[I_LAM][512 + ch])); }
    const int nrc = (PASS == 1) ? NRC : 512;
    const int cpr = (PASS == 3) ? 512 / (nlb >> 3) : 1, rc_lo = (PASS == 3) ? (lb >> 3) * cpr : (lb >> 3), rstep = (PASS == 3) ? 1 : (nlb >> 3), rc_hi = (PASS == 3) ? rc_lo + cpr : nrc;
    float* LCAR = (float*)(p.ws + WS_LCAR);
    if (PASS == 3 && tid < 128) { const int d = tid >> 6, j = tid & 63, ch = 64 * hb + j, b = rc_lo >> 7, cl0 = rc_lo & 127;
        const int p_lo = d ? 4 + 127 - (cl0 + cpr - 1) : 4 + cl0;
        const float* S = LSUM + (size_t)d * NRC * 1024 + 2 * ch; float hcar = 0.f;
#pragma unroll 8
        for (int s = 0; s < p_lo; ++s) { const float* e2 = S + (size_t)lru_rc_at(d, b, s) * 1024; hcar = e2[0] * hcar + e2[1]; }
        for (int s = p_lo; s < p_lo + cpr; ++s) { const int rcs = lru_rc_at(d, b, s); LCAR[((size_t)d * NRC + rcs) * 512 + ch] = hcar; const float* e2 = S + (size_t)rcs * 1024; hcar = e2[0] * hcar + e2[1]; }
    }
    u32x4 px[2];
#define LRU_PREFETCH(rc_) do { const int rc__ = (rc_); const int row0_ = rc__ * 64; const int seg_lo_ = (rc__ >= 512) ? NLAT + ((rc__ - 512) >> 2) * LC : (rc__ >> 7) * L, seg_hi_ = seg_lo_ + ((rc__ >= 512) ? LC : L); \
    _Pragma("unroll") for (int i = 0; i < 2; ++i) { const int e = tid + 512 * i, rr = e >> 3, pc = e & 7, grow = row0_ - 2 + rr; px[i] = (u32x4){0u, 0u, 0u, 0u}; \
        if (e < 67 * 8 && grow >= seg_lo_ && grow < seg_hi_) px[i] = *(const u32x4*)(C1 + (size_t)grow * C1LD + 2560 + 64 * hb + 8 * pc); } } while (0)
    int rc = rc_lo;
    if (rc < rc_hi) LRU_PREFETCH(rc);
    for (; rc < rc_hi; rc += rstep) {
        const int row0 = rc * 64;
        const int sg = tid >> 6, j = lane, ch = 64 * hb + j;
        float cin = 0.f;
        if (PASS == 3 && tid < 128) cin = LCAR[((size_t)(tid >> 6) * NRC + rc) * 512 + ch];
        float gbv[8];
        if (PASS == 3) {
#pragma unroll
            for (int k = 0; k < 8; ++k) gbv[k] = bf2f(C1[(size_t)(row0 + 8 * sg + k) * C1LD + 3072 + ch]); }
#pragma unroll
        for (int i = 0; i < 2; ++i) { const int e = tid + 512 * i; if (e < 67 * 8) { const int rr = e >> 3, pc = e & 7; const u32x4 v = px[i];
            f32x4 lo, hi; lo[0] = __uint_as_float(v[0] << 16); lo[1] = __uint_as_float(v[0] & 0xffff0000u); lo[2] = __uint_as_float(v[1] << 16); lo[3] = __uint_as_float(v[1] & 0xffff0000u);
            hi[0] = __uint_as_float(v[2] << 16); hi[1] = __uint_as_float(v[2] & 0xffff0000u); hi[2] = __uint_as_float(v[3] << 16); hi[3] = __uint_as_float(v[3] & 0xffff0000u);
            *(LAS f32x4*)(XB + rr * XBP + 8 * pc) = lo; *(LAS f32x4*)(XB + rr * XBP + 8 * pc + 4) = hi; } }
        if (PASS == 3 && tid < 128) CAR[tid] = cin;
        __syncthreads();
        if (rc + rstep < rc_hi) LRU_PREFETCH(rc + rstep);
        {
            const int t = tid >> 3, i0 = 8 * (tid & 7); float xc[8];
#pragma unroll
            for (int c = 0; c < 8; ++c) { const int i = i0 + c; xc[c] = prm[256 + i] + prm[i] * XB[t * XBP + i] + prm[64 + i] * XB[(t + 1) * XBP + i] + prm[128 + i] * XB[(t + 2) * XBP + i] + prm[192 + i] * XB[(t + 3) * XBP + i]; XCf[t * 64 + i] = xc[c]; }
            u32x4 w; w.x = pack2(xc[0], xc[1]); w.y = pack2(xc[2], xc[3]); w.z = pack2(xc[4], xc[5]); w.w = pack2(xc[6], xc[7]);
            *(LAS u32x4*)(XCs + t * 72 + i0) = w;
        }
        __syncthreads();
        {
            const int jt = wv & 3, th = wv >> 2, jc = 16 * jt + r;
#pragma unroll
            for (int d = 0; d < 2; ++d) { const float ba = prm[320 + 64 * d + jc], bi = prm[448 + 64 * d + jc], spl = prm[576 + 64 * d + jc];
#pragma unroll
                for (int i2 = 0; i2 < 2; ++i2) { const int tt = 2 * th + i2;
                    f32x4 aa = (f32x4){0.f, 0.f, 0.f, 0.f}, ai = (f32x4){0.f, 0.f, 0.f, 0.f};
#pragma unroll
                    for (int kk = 0; kk < 2; ++kk) { const bf16x8 xf = *(const LAS bf16x8*)(XCs + (16 * tt + r) * 72 + 32 * kk + 8 * q);
                        const bf16x8 wa = *(const LAS bf16x8*)(Wt + ((2 * d) * 64 + 16 * jt + r) * 72 + 32 * kk + 8 * q), wi = *(const LAS bf16x8*)(Wt + ((2 * d + 1) * 64 + 16 * jt + r) * 72 + 32 * kk + 8 * q);
                        aa = __builtin_amdgcn_mfma_f32_16x16x32_bf16(xf, wa, aa, 0, 0, 0); ai = __builtin_amdgcn_mfma_f32_16x16x32_bf16(xf, wi, ai, 0, 0, 0); }
#pragma unroll
                    for (int jj = 0; jj < 4; ++jj) { const int t = 16 * tt + 4 * q + jj;
                        const float rg = fsigm(aa[jj] + ba), ig = fsigm(ai[jj] + bi), la = -8.f * rg * spl;
                        const float a = fexp(la);
                        AU[((2 * d) * 64 + t) * 65 + jc] = a; AU[((2 * d + 1) * 64 + t) * 65 + jc] = __builtin_amdgcn_sqrtf(fmaxf(fmaf(-a, a, 1.f), 0.f)) * (ig * XCf[t * 64 + jc]); } } }
        }
        __syncthreads();
        const LAS float* A0 = AU + (8 * sg) * 65 + j; const LAS float* U0 = AU + (64 + 8 * sg) * 65 + j; const LAS float* A1 = AU + (128 + 8 * sg) * 65 + j; const LAS float* U1 = AU + (192 + 8 * sg) * 65 + j;
        {
            float p0 = 1.f, h0 = 0.f, p1 = 1.f, h1 = 0.f;
#pragma unroll
            for (int k = 0; k < 8; ++k) { const float a = A0[k * 65]; h0 = a * h0 + U0[k * 65]; p0 *= a; }
#pragma unroll
            for (int k = 7; k >= 0; --k) { const float a = A1[k * 65]; h1 = a * h1 + U1[k * 65]; p1 *= a; }
            SEG[(0 * 8 + sg) * 64 + j] = p0; SEG[(1 * 8 + sg) * 64 + j] = h0; SEG[(2 * 8 + sg) * 64 + j] = p1; SEG[(3 * 8 + sg) * 64 + j] = h1;
        }
        __syncthreads();
        if (PASS == 1) {
            if (tid < 128) { const int d = tid >> 6; float pa = 1.f, hh = 0.f;
#pragma unroll
                for (int s2 = 0; s2 < 8; ++s2) { const int sgi = d ? 7 - s2 : s2; const float ps = SEG[((2 * d) * 8 + sgi) * 64 + j], hs = SEG[((2 * d + 1) * 8 + sgi) * 64 + j]; hh = ps * hh + hs; pa *= ps; }
                float* o = LSUM + ((size_t)d * NRC + rc) * 1024 + 2 * ch; o[0] = pa; o[1] = hh; }
        } else {
            float hf = CAR[j], hbk = CAR[64 + j];
            for (int s2 = 0; s2 < sg; ++s2) hf = SEG[(0 * 8 + s2) * 64 + j] * hf + SEG[(1 * 8 + s2) * 64 + j];
            for (int s2 = 7; s2 > sg; --s2) hbk = SEG[(2 * 8 + s2) * 64 + j] * hbk + SEG[(3 * 8 + s2) * 64 + j];
            float of[8];
#pragma unroll
            for (int k = 0; k < 8; ++k) { hf = A0[k * 65] * hf + U0[k * 65]; of[k] = hf; }
#pragma unroll
            for (int k = 7; k >= 0; --k) { hbk = A1[k * 65] * hbk + U1[k * 65]; of[k] += hbk; }
#pragma unroll
            for (int k = 0; k < 8; ++k) Y[(size_t)nat_row(row0 + 8 * sg + k) * D + 512 + ch] = f2bf(of[k] * fgelu(gbv[k]));
        }
        __syncthreads();
    }
#undef LRU_PREFETCH
}
constexpr int PT = 72, PM = 40;
constexpr int C_PRM = 0, C_GAM = C_PRM + 3072, C_MISC = C_GAM + 1024, C_SBF = C_MISC + 1280, C_TILES = C_SBF + 2 * 64 * PT * 2, C_TH = C_TILES + 5 * 80 * PT * 2, C_MBF = C_TH + 2 * 64 * PT * 2,
              C_SM = C_MBF + 4 * 16 * 20 * 4, C_W1T = C_SM + 4 * 4 * 16 * PM * 2, C_AH = C_W1T + 4 * 64 * PM * 2, C_YV = C_AH + 4 * 16 * PT * 2, C_END = C_YV + 64 * PM * 2;
static_assert(C_END <= LDS_BYTES, "rwkv chunk LDS map");
DI void unpack4(u32x2 v, float* o) { o[0] = __uint_as_float(v.x << 16); o[1] = __uint_as_float(v.x & 0xffff0000u); o[2] = __uint_as_float(v.y << 16); o[3] = __uint_as_float(v.y & 0xffff0000u); }
DI u32x2 pack4(float a, float b, float c, float d) { u32x2 w; w.x = pack2(a, b); w.y = pack2(c, d); return w; }
DI bf16x8 zero_if(bf16x8 v, bool z) { const bf16x8 zz = {0, 0, 0, 0, 0, 0, 0, 0}; return z ? zz : v; }

constexpr int RING_SLOTS = 4, SLOT_U64 = 7936;
constexpr int S_GAM = 4096, S_BS = 4224, S_AH = 4256, S_NK = 5280, S_NB = 5536, S_YH = 5792, S_END = 7840;
DI int slot_lds(int e) {
    if (e < S_GAM) return C_TILES + ((e >> 10) + 1) * (80 * PT * 2) + ((e >> 4) & 63) * (PT * 2) + (e & 15) * 8;
    if (e < S_BS) return C_GAM + (e - S_GAM) * 8;
    if (e < S_AH) return C_MISC + 1024 + (e - S_BS) * 8;
    if (e < S_NK) { const int x = e - S_AH; return C_AH + (x >> 4) * (PT * 2) + (x & 15) * 8; }
    if (e < S_NB) { const int x = e - S_NK; return C_SM + 4 * 16 * PM * 2 + (x >> 2) * (PM * 2) + (x & 3) * 8; }
    const int x = e - S_NB; return C_SM + 2 * 4 * 16 * PM * 2 + (x >> 2) * (PM * 2) + (x & 3) * 8;
}
constexpr size_t WS_RING = WS_Z1;
DI void wait_ge(unsigned* word, unsigned want) {
    unsigned spins = 0;
    while ((unsigned)__builtin_amdgcn_readfirstlane((int)__hip_atomic_load(word, __ATOMIC_RELAXED, __HIP_MEMORY_SCOPE_AGENT)) < want) { __builtin_amdgcn_s_sleep(2); if (++spins > (1u << 21)) break; }
    __builtin_amdgcn_fence(__ATOMIC_ACQUIRE, "agent");
    asm volatile("s_waitcnt vmcnt(0)" ::: "memory");
}
template <int ROLE> DI void rwkv_chunk_unit(const P& p, LAS unsigned char* lds, const int vb, const int hs = 0) {
    const int tid = mk_tid(), lane = tid & 63, wv = __builtin_amdgcn_readfirstlane(tid >> 6), r = lane & 15, q = lane >> 4;
    const int d = vb >> 5, b = (vb >> 3) & 3, h = vb & 7;
    const bf16_t* RW = (const bf16_t*)(p.ws + WS_COLS) + OFF_RW; const bf16_t* LO = (const bf16_t*)(p.ws + WS_COLS) + OFF_LO; bf16_t* Z = (bf16_t*)(p.ws + WS_Z);
    unsigned long long* ring = (unsigned long long*)(p.ws + WS_RING) + (size_t)vb * RING_SLOTS * SLOT_U64;
    unsigned* READY0 = (unsigned*)(p.ws + WS_CTL) + 64 * vb; unsigned* READY1 = (unsigned*)(p.ws + WS_CTL) + 64 * (192 + vb); unsigned* ACK = (unsigned*)(p.ws + WS_CTL) + 64 * (64 + vb);
    unsigned* READYH = hs ? READY1 : READY0;
    LAS float* prm = (LAS float*)(lds + C_PRM); LAS float* GAM = (LAS float*)(lds + C_GAM); LAS float* SSQ = (LAS float*)(lds + C_MISC); LAS float* BSP = SSQ + 128; LAS float* BS = SSQ + 256;
    LAS bf16_t* Sbf = (LAS bf16_t*)(lds + C_SBF);
    LAS bf16_t* At = (LAS bf16_t*)(lds + C_TILES); LAS bf16_t* Rt = At + 80 * PT; LAS bf16_t* Bt = Rt + 80 * PT; LAS bf16_t* Kt = Bt + 80 * PT; LAS bf16_t* Vt = Kt + 80 * PT;
    LAS bf16_t* TH = (LAS bf16_t*)(lds + C_TH); LAS bf16_t* AD = TH + 64 * PT; LAS float* OUT = (LAS float*)(lds + C_TH);
    LAS float* MBf = (LAS float*)(lds + C_MBF);
    LAS bf16_t* MK = (LAS bf16_t*)(lds + C_SM); LAS bf16_t* NK = MK + 4 * 16 * PM; LAS bf16_t* NB = NK + 4 * 16 * PM; LAS bf16_t* DNV = NB + 4 * 16 * PM;
    LAS bf16_t* W1T = (LAS bf16_t*)(lds + C_W1T); LAS bf16_t* AH = (LAS bf16_t*)(lds + C_AH); LAS bf16_t* YV = (LAS bf16_t*)(lds + C_YV);
    const unsigned at_b = (unsigned)(size_t)At, bt_b = (unsigned)(size_t)Bt, kt_b = (unsigned)(size_t)Kt, vt_b = (unsigned)(size_t)Vt;
    __syncthreads();
    for (int e = tid; e < (C_END - C_SBF) / 4; e += NT) ((LAS unsigned*)(lds + C_SBF))[e] = 0u;
    if (tid < 64) { const int j = tid, c = 64 * h + j; const float* mu = p.in[I_MU] + d * 1664;
        prm[j] = mu[c]; prm[64 + j] = mu[512 + c]; prm[128 + j] = mu[1024 + c]; prm[192 + j] = mu[1536 + j]; prm[256 + j] = mu[1600 + j];
        prm[320 + j] = p.in[I_W0][d * 512 + c]; prm[384 + j] = p.in[I_A0][d * 512 + c]; prm[448 + j] = p.in[I_KK][d * 512 + c]; prm[512 + j] = p.in[I_KA][d * 512 + c];
        prm[576 + j] = p.in[I_RK][(d * 8 + h) * 64 + j]; prm[640 + j] = p.in[I_LNW][d * 512 + c]; prm[704 + j] = p.in[I_LNB][d * 512 + c]; }
    const int m1 = wv & 3, h2 = wv >> 2, cb8 = 32 * h2 + 8 * q;
    bf16x8 fw2[2][2], fa2[2][2];
    if (ROLE != 1) {
#pragma unroll
    for (int t = 0; t < 2; ++t)
#pragma unroll
        for (int kk = 0; kk < 2; ++kk) { const int c = 64 * h + 32 * h2 + 8 * (r >> 2) + 4 * t + (r & 3);
            const float* w2p = p.in[I_W2L] + (size_t)(d * 64 + 32 * kk + 8 * q) * 512 + c; const float* a2p = p.in[I_A2L] + (size_t)(d * 64 + 32 * kk + 8 * q) * 512 + c;
#pragma unroll
            for (int e = 0; e < 8; ++e) { fw2[t][kk][e] = (short)f2bf(w2p[e * 512]); fa2[t][kk][e] = (short)f2bf(a2p[e * 512]); }
            asm volatile("" ::: "memory"); }
    }
    f32x4 Sacc[2] = {(f32x4){0.f, 0.f, 0.f, 0.f}, (f32x4){0.f, 0.f, 0.f, 0.f}};
    int cur = 0;
    unsigned ack_seen = 0u;
    unsigned long long pf[12]; f32x4 yh[4]; bool pf_ok = false;
    u32x4 gc[5], gp[5];
#define RWKV_LOAD(n0x) do { const int n1_ = (n0x) + 16 * m1 + r; const bool hp_ = (n1_ != 0) && (n1_ != LC); const unsigned row_ = (unsigned)step_row(d, b, n1_), prow_ = hp_ ? (unsigned)step_row(d, b, n1_ - 1) : row_; \
    const unsigned rwc_ = row_ * 1536u + 64u * h + cb8, rwp_ = prow_ * 1536u + 64u * h + cb8, loc_ = row_ * 512u + 64u * d + cb8, lop_ = prow_ * 512u + 64u * d + cb8; \
    gc[0] = *(const u32x4*)(RW + rwc_); gc[1] = *(const u32x4*)(RW + rwc_ + 512u); gc[2] = *(const u32x4*)(RW + rwc_ + 1024u); gc[3] = *(const u32x4*)(LO + loc_); gc[4] = *(const u32x4*)(LO + loc_ + 128u); \
    gp[0] = *(const u32x4*)(RW + rwp_); gp[1] = *(const u32x4*)(RW + rwp_ + 512u); gp[2] = *(const u32x4*)(RW + rwp_ + 1024u); gp[3] = *(const u32x4*)(LO + lop_); gp[4] = *(const u32x4*)(LO + lop_ + 128u); } while (0)
    const int n0_start = (ROLE == 2) ? 64 * hs : 0, n0_step = (ROLE == 2) ? 128 : 64;
    if (ROLE != 1) RWKV_LOAD(n0_start);
    __syncthreads();
    for (int n0 = n0_start; n0 < LT; n0 += n0_step) {
        if (ROLE != 1) for (int rep0 = 0; rep0 < (MK_RDUP == 0 ? 2 : 1); ++rep0) {
        const int u1 = 16 * m1 + r, n1 = n0 + u1; const bool hp = (n1 != 0) && (n1 != LC);
        float rs[8], ks[8], vs[8];
        {
            float a0[8], a1[8], th[8], ad[8];
#define UNPACK8(v, o) { _Pragma("unroll") for (int k_ = 0; k_ < 4; ++k_) { o[2 * k_] = __uint_as_float(v[k_] << 16); o[2 * k_ + 1] = __uint_as_float(v[k_] & 0xffff0000u); } }
#define RW_SHIFT(dst, idx, muo) { const u32x4 pz = hp ? gp[idx] : (u32x4){0u, 0u, 0u, 0u}; UNPACK8(gc[idx], a0) UNPACK8(pz, a1) \
            const f32x4 mu0 = *(const LAS f32x4*)(prm + (muo) + cb8), mu1 = *(const LAS f32x4*)(prm + (muo) + cb8 + 4); \
            _Pragma("unroll") for (int e = 0; e < 4; ++e) { dst[e] = a0[e] + mu0[e] * (a1[e] - a0[e]); dst[4 + e] = a0[4 + e] + mu1[e] * (a1[4 + e] - a0[4 + e]); } }
            RW_SHIFT(th, 3, 192) asm volatile("" ::: "memory"); RW_SHIFT(ad, 4, 256) asm volatile("" ::: "memory"); RW_SHIFT(rs, 0, 0) asm volatile("" ::: "memory"); RW_SHIFT(ks, 1, 64) asm volatile("" ::: "memory"); RW_SHIFT(vs, 2, 128)
#undef RW_SHIFT
#pragma unroll
            for (int e = 0; e < 8; ++e) th[e] = ftanh(th[e]);
            u32x4 w; w.x = pack2(th[0], th[1]); w.y = pack2(th[2], th[3]); w.z = pack2(th[4], th[5]); w.w = pack2(th[6], th[7]); *(LAS u32x4*)(TH + u1 * PT + cb8) = w;
            w.x = pack2(ad[0], ad[1]); w.y = pack2(ad[2], ad[3]); w.z = pack2(ad[4], ad[5]); w.w = pack2(ad[6], ad[7]); *(LAS u32x4*)(AD + u1 * PT + cb8) = w;
            asm volatile("" ::: "memory");
        }
        __syncthreads();
        float elog[8], av[8], kkr[8], km[8]; float ssq = 0.f, bsp = 0.f;
#pragma unroll
        for (int t = 0; t < 2; ++t) {
            f32x4 xw = (f32x4){0.f, 0.f, 0.f, 0.f}, xa = (f32x4){0.f, 0.f, 0.f, 0.f};
#pragma unroll
            for (int kk = 0; kk < 2; ++kk) { const bf16x8 bt = *(const LAS bf16x8*)(TH + u1 * PT + 32 * kk + 8 * q), ba = *(const LAS bf16x8*)(AD + u1 * PT + 32 * kk + 8 * q);
                xw = __builtin_amdgcn_mfma_f32_16x16x32_bf16(fw2[t][kk], bt, xw, 0, 0, 0); xa = __builtin_amdgcn_mfma_f32_16x16x32_bf16(fa2[t][kk], ba, xa, 0, 0, 0); }
            const int cb = cb8 + 4 * t;
            const f32x4 w04 = *(const LAS f32x4*)(prm + 320 + cb), a04 = *(const LAS f32x4*)(prm + 384 + cb), kk4 = *(const LAS f32x4*)(prm + 448 + cb), ka4 = *(const LAS f32x4*)(prm + 512 + cb), rk4 = *(const LAS f32x4*)(prm + 576 + cb);
#pragma unroll
            for (int jj = 0; jj < 4; ++jj) { const int e = 4 * t + jj;
                elog[e] = 0.6065306597126334f * fsigm(xw[jj] + w04[jj]); av[e] = fsigm(xa[jj] + a04[jj]);
                kkr[e] = ks[e] * kk4[jj]; ssq += kkr[e] * kkr[e]; km[e] = ks[e] * (1.f + (av[e] - 1.f) * ka4[jj]); bsp += rs[e] * km[e] * rk4[jj]; }
            asm volatile("" ::: "memory");
        }
        ssq += __shfl_xor(ssq, 16); ssq += __shfl_xor(ssq, 32); bsp += __shfl_xor(bsp, 16); bsp += __shfl_xor(bsp, 32);
        if (q == 0) { SSQ[h2 * 64 + u1] = ssq; BSP[h2 * 64 + u1] = bsp; }
        __syncthreads();
        {
            const float tot = SSQ[u1] + SSQ[64 + u1]; const float inv = 1.f / fmaxf(sqrtf(tot), 1e-12f);
            if (h2 == 0 && q == 0) BS[u1] = BSP[u1] + BSP[64 + u1];
            float al[8], be[8], ka[8], rh[8];
#pragma unroll
            for (int e = 0; e < 8; ++e) {
                const float g = scan16(-elog[e]);
                const float ep = fexp(g), em = frcp(ep), epp = fexp(g + elog[e]);
                const float kk = kkr[e] * inv;
                al[e] = kk * epp; be[e] = kk * av[e] * em; ka[e] = km[e] * em; rh[e] = rs[e] * ep;
                if (r == 15) GAM[m1 * 64 + cb8 + e] = ep; }
            u32x4 w;
#define ST8(T, v) w.x = pack2(v[0], v[1]); w.y = pack2(v[2], v[3]); w.z = pack2(v[4], v[5]); w.w = pack2(v[6], v[7]); *(LAS u32x4*)(T + u1 * PT + cb8) = w;
            ST8(At, al) ST8(Bt, be) ST8(Kt, ka) ST8(Rt, rh) ST8(Vt, vs)
#undef ST8
        }
        __syncthreads();
        }
        if (ROLE == 0 && n0 + 64 < LT) RWKV_LOAD(n0 + 64);
        f32x4 yhat[4];
        if (ROLE == 1) {
            const unsigned g = (unsigned)(n0 >> 6);
            if (!pf_ok) { if (wv == 0) wait_ge((g & 1u) ? READY1 : READY0, (g >> 1) + 1u); __syncthreads();
                const unsigned long long* slot = ring + (size_t)(g % RING_SLOTS) * SLOT_U64;
#pragma unroll
                for (int k = 0; k < 12; ++k) { const int e = tid + NT * k; if (e < S_YH) pf[k] = slot[e]; }
#pragma unroll
                for (int m = 0; m < 4; ++m) yh[m] = *(const f32x4*)(slot + S_YH + ((m * 4 + (wv & 3)) * 64 + lane) * 2); }
            for (int rep7 = 0; rep7 < (MK_RDUP == 7 ? 2 : 1); ++rep7) { if (rep7) __syncthreads();
#pragma unroll
            for (int k = 0; k < 12; ++k) { const int e = tid + NT * k; if (e < S_YH) *(LAS unsigned long long*)(lds + slot_lds(e)) = pf[k]; }
            asm volatile("s_waitcnt vmcnt(0)" ::: "memory");
            __syncthreads(); }
            if (tid == 0) __hip_atomic_store(ACK, g + 1u, __ATOMIC_RELAXED, __HIP_MEMORY_SCOPE_AGENT);
#pragma unroll
            for (int m = 0; m < 4; ++m) yhat[m] = yh[m];
        }
        if (ROLE != 1) for (int rep1 = 0; rep1 < (MK_RDUP == 1 ? 2 : 1); ++rep1) {
        {
            const int m = wv >> 1, pp = wv & 1; LAS bf16_t* XB = pp ? Rt : At;
            f32x4 c1 = (f32x4){0.f, 0.f, 0.f, 0.f}, c2 = (f32x4){0.f, 0.f, 0.f, 0.f};
#pragma unroll
            for (int kk = 0; kk < 2; ++kk) { const bf16x8 bx = *(const LAS bf16x8*)(XB + (16 * m + r) * PT + 32 * kk + 8 * q);
                const bf16x8 a1 = *(const LAS bf16x8*)(Bt + (16 * m + r) * PT + 32 * kk + 8 * q), a2 = *(const LAS bf16x8*)(Kt + (16 * m + r) * PT + 32 * kk + 8 * q);
                c1 = __builtin_amdgcn_mfma_f32_16x16x32_bf16(a1, bx, c1, 0, 0, 0); c2 = __builtin_amdgcn_mfma_f32_16x16x32_bf16(a2, bx, c2, 0, 0, 0); }
#pragma unroll
            for (int jj = 0; jj < 4; ++jj) { const int s = 4 * q + jj; const bool ok = pp ? (s <= r) : (s < r); if (!ok) { c1[jj] = 0.f; c2[jj] = 0.f; } }
            if (pp == 0) { *(LAS f32x4*)(MBf + (m * 16 + r) * 20 + 4 * q) = c1; *(LAS u32x2*)(MK + (m * 16 + r) * PM + 4 * q) = pack4(c2[0], c2[1], c2[2], c2[3]); }
            else { *(LAS u32x2*)(NB + (m * 16 + r) * PM + 4 * q) = pack4(c1[0], c1[1], c1[2], c1[3]); *(LAS u32x2*)(NK + (m * 16 + r) * PM + 4 * q) = pack4(c2[0], c2[1], c2[2], c2[3]); }
        }
        __syncthreads();
        if (wv < 4) {
            const int m = wv, c = r; float X[16];
#pragma unroll
            for (int u = 0; u < 16; ++u) { float x = (c == u) ? 1.f : 0.f;
                if (u > 0) { const LAS f32x4* rowp = (const LAS f32x4*)(MBf + (m * 16 + u) * 20);
#pragma unroll
                    for (int s4 = 0; s4 < 4; ++s4) { if (4 * s4 < u) { const f32x4 l = rowp[s4];
#pragma unroll
                        for (int e = 0; e < 4; ++e) if (4 * s4 + e < u) x -= l[e] * X[4 * s4 + e]; } } }
                X[u] = x; }
            if (q == 0) {
#pragma unroll
                for (int u = 0; u < 16; ++u) DNV[(m * 16 + u) * PM + c] = f2bf(X[u]); }
        } else {
            const int m = wv - 4; const bf16x8 a = *(const LAS bf16x8*)(MK + (m * 16 + r) * PM + 8 * q);
            bf16x8 bvs[4]; tr_frag4(bvs[0], bvs[1], bvs[2], bvs[3], tr_addr(vt_b, PT, 16 * m, 0, r, q), 8u * PT, tr_addr(vt_b, PT, 16 * m, 16, r, q), 8u * PT, tr_addr(vt_b, PT, 16 * m, 32, r, q), 8u * PT, tr_addr(vt_b, PT, 16 * m, 48, r, q), 8u * PT);
#pragma unroll
            for (int it = 0; it < 4; ++it) { const bf16x8 bv = bvs[it];
                const f32x4 acc = __builtin_amdgcn_mfma_f32_16x16x32_bf16(a, bv, (f32x4){0.f, 0.f, 0.f, 0.f}, 0, 0, 0);
                *(LAS u32x2*)(W1T + (m * 64 + 16 * it + r) * PM + 4 * q) = pack4(acc[0], acc[1], acc[2], acc[3]); }
        }
        __syncthreads();
#pragma unroll
        for (int m = 0; m < 4; ++m) yhat[m] = (f32x4){0.f, 0.f, 0.f, 0.f};
        {
            const int it = wv & 3;
#pragma unroll
            for (int m = 0; m < 4; ++m) { const bf16x8 a = *(const LAS bf16x8*)(DNV + (m * 16 + r) * PM + 8 * q), bw = *(const LAS bf16x8*)(W1T + (m * 64 + 16 * it + r) * PM + 8 * q);
                yhat[m] = __builtin_amdgcn_mfma_f32_16x16x32_bf16(a, bw, yhat[m], 0, 0, 0); }
        }
        if (wv >= 4) {
            const int jt = wv - 4;
            bf16x8 afs[4]; tr_frag4(afs[0], afs[1], afs[2], afs[3], tr_addr(at_b, PT, 0, 16 * jt, r, q), 8u * PT, tr_addr(at_b, PT, 16, 16 * jt, r, q), 8u * PT, tr_addr(at_b, PT, 32, 16 * jt, r, q), 8u * PT, tr_addr(at_b, PT, 48, 16 * jt, r, q), 8u * PT);
#pragma unroll
            for (int m = 0; m < 4; ++m) { const bf16x8 a = afs[m], bd = *(const LAS bf16x8*)(DNV + (m * 16 + r) * PM + 8 * q);
                const f32x4 acc = __builtin_amdgcn_mfma_f32_16x16x32_bf16(a, bd, (f32x4){0.f, 0.f, 0.f, 0.f}, 0, 0, 0);
                *(LAS u32x2*)(AH + (m * 16 + r) * PT + 16 * jt + 4 * q) = pack4(acc[0], acc[1], acc[2], acc[3]); }
        }
        __syncthreads();
        }
        if (ROLE == 2) {
            const unsigned g = (unsigned)(n0 >> 6);
            if (g >= 2u) { asm volatile("s_waitcnt vmcnt(0)" ::: "memory"); __syncthreads(); if (tid == 0) __hip_atomic_store(READYH, (g >> 1), __ATOMIC_RELAXED, __HIP_MEMORY_SCOPE_AGENT); }
            if (n0 + 128 < LT) RWKV_LOAD(n0 + 128);
            if (g >= RING_SLOTS && ack_seen < g - RING_SLOTS + 1) {
                if (tid == 0) { wait_ge(ACK, g - RING_SLOTS + 1); ((LAS unsigned*)MBf)[17] = __hip_atomic_load(ACK, __ATOMIC_RELAXED, __HIP_MEMORY_SCOPE_AGENT); }
                __syncthreads(); ack_seen = ((LAS unsigned*)MBf)[17]; }
            unsigned long long* slot = ring + (size_t)(g % RING_SLOTS) * SLOT_U64;
#pragma unroll 2
            for (int k = 0; k < 12; ++k) { const int e = tid + NT * k; if (e < S_YH) __hip_atomic_store(slot + e, *(const LAS unsigned long long*)(lds + slot_lds(e)), __ATOMIC_RELAXED, __HIP_MEMORY_SCOPE_AGENT); }
            if (wv < 4) {
#pragma unroll
                for (int m = 0; m < 4; ++m) { unsigned long long* yp = slot + S_YH + ((m * 4 + wv) * 64 + lane) * 2;
                    __hip_atomic_store(yp, ((unsigned long long)__float_as_uint(yhat[m][1]) << 32) | __float_as_uint(yhat[m][0]), __ATOMIC_RELAXED, __HIP_MEMORY_SCOPE_AGENT);
                    __hip_atomic_store(yp + 1, ((unsigned long long)__float_as_uint(yhat[m][3]) << 32) | __float_as_uint(yhat[m][2]), __ATOMIC_RELAXED, __HIP_MEMORY_SCOPE_AGENT); } }
            if (g + 2u >= 132u) { asm volatile("s_waitcnt vmcnt(0)" ::: "memory"); __syncthreads(); if (tid == 0) __hip_atomic_store(READYH, (g >> 1) + 1u, __ATOMIC_RELAXED, __HIP_MEMORY_SCOPE_AGENT); }
            continue;
        }
#pragma unroll 1
        for (int m = 0; m < 4; ++m) {
            LAS bf16_t* Sc = Sbf + cur * 64 * PT; LAS bf16_t* Sn = Sbf + (cur ^ 1) * 64 * PT;
            const int it = wv & 3, jh = wv >> 2;
            bf16x8 bv, ka0, ka1;
            tr_frag3(bv, ka0, ka1, tr_addr(vt_b, PT, 16 * m, 16 * it, r, q), 8u * PT, tr_addr(kt_b, PT, 16 * m, 16 * (2 * jh), r, q), 8u * PT, tr_addr(kt_b, PT, 16 * m, 16 * (2 * jh + 1), r, q), 8u * PT);
            ka0 = zero_if(ka0, q >= 2); ka1 = zero_if(ka1, q >= 2);
            s16x4 hb0, hb1;
            { const unsigned a0 = bt_b + (unsigned)(((16 * m + 4 * q + (r >> 2)) * PT + 16 * (2 * jh) + 4 * (r & 3)) * 2), a1 = a0 + 32u;
              asm volatile("ds_read_b64_tr_b16 %0, %2\n\tds_read_b64_tr_b16 %1, %3\n\ts_waitcnt lgkmcnt(0)" : "=&v"(hb0), "=&v"(hb1) : "v"(a0), "v"(a1) : "memory"); }
            const bf16x8 ba0 = {hb0[0], hb0[1], hb0[2], hb0[3], 0, 0, 0, 0}, ba1 = {hb1[0], hb1[1], hb1[2], hb1[3], 0, 0, 0, 0};
            const bf16x8 s0 = *(const LAS bf16x8*)(Sc + (16 * it + r) * PT + 8 * q), s1 = *(const LAS bf16x8*)(Sc + (16 * it + r) * PT + 32 + 8 * q);
            f32x4 acc = (m == 0) ? yhat[0] : (m == 1) ? yhat[1] : (m == 2) ? yhat[2] : yhat[3];
            acc = __builtin_amdgcn_mfma_f32_16x16x32_bf16(*(const LAS bf16x8*)(AH + (m * 16 + r) * PT + 8 * q), s0, acc, 0, 0, 0);
            acc = __builtin_amdgcn_mfma_f32_16x16x32_bf16(*(const LAS bf16x8*)(AH + (m * 16 + r) * PT + 32 + 8 * q), s1, acc, 0, 0, 0);
            const u32x2 ny = pack4(-acc[0], -acc[1], -acc[2], -acc[3]);
            bf16x8 nyv = {0, 0, 0, 0, 0, 0, 0, 0}; { const s16x4 t4 = __builtin_bit_cast(s16x4, ny); nyv[0] = t4[0]; nyv[1] = t4[1]; nyv[2] = t4[2]; nyv[3] = t4[3]; }
#pragma unroll
            for (int x = 0; x < 2; ++x) { const int jt = 2 * jh + x;
                Sacc[x] = __builtin_amdgcn_mfma_f32_16x16x32_bf16(x ? ka1 : ka0, bv, Sacc[x], 0, 0, 0); Sacc[x] = __builtin_amdgcn_mfma_f32_16x16x32_bf16(x ? ba1 : ba0, nyv, Sacc[x], 0, 0, 0);
                const f32x4 gm = *(const LAS f32x4*)(GAM + m * 64 + 16 * jt + 4 * q); Sacc[x] = Sacc[x] * gm;
                *(LAS u32x2*)(Sn + (16 * it + r) * PT + 16 * jt + 4 * q) = pack4(Sacc[x][0], Sacc[x][1], Sacc[x][2], Sacc[x][3]); }
            if (wv >= 4) {
                f32x4 oacc = (f32x4){0.f, 0.f, 0.f, 0.f};
                oacc = __builtin_amdgcn_mfma_f32_16x16x32_bf16(*(const LAS bf16x8*)(Rt + (16 * m + r) * PT + 8 * q), s0, oacc, 0, 0, 0);
                oacc = __builtin_amdgcn_mfma_f32_16x16x32_bf16(*(const LAS bf16x8*)(Rt + (16 * m + r) * PT + 32 + 8 * q), s1, oacc, 0, 0, 0);
                oacc = __builtin_amdgcn_mfma_f32_16x16x32_bf16(*(const LAS bf16x8*)(NK + (m * 16 + r) * PM + 8 * q), bv, oacc, 0, 0, 0);
                const s16x4 nb4 = *(const LAS s16x4*)(NB + (m * 16 + r) * PM + 4 * q); const bf16x8 nbp = {nb4[0], nb4[1], nb4[2], nb4[3], 0, 0, 0, 0};
                oacc = __builtin_amdgcn_mfma_f32_16x16x32_bf16(nbp, nyv, oacc, 0, 0, 0);
#pragma unroll
                for (int jj = 0; jj < 4; ++jj) OUT[(16 * m + 4 * q + jj) * 68 + 16 * it + r] = oacc[jj]; }
            if (ROLE == 1 && m == 0) { if (tid == 0) { const unsigned g1 = (unsigned)(n0 >> 6) + 1u; unsigned ok = 0u;
                    if (g1 < 132u && __hip_atomic_load((g1 & 1u) ? READY1 : READY0, __ATOMIC_RELAXED, __HIP_MEMORY_SCOPE_AGENT) >= (g1 >> 1) + 1u) { __builtin_amdgcn_fence(__ATOMIC_ACQUIRE, "agent"); asm volatile("s_waitcnt vmcnt(0)" ::: "memory"); ok = 1u; }
                    ((LAS unsigned*)MBf)[16] = ok; } }
            __syncthreads();
            if (ROLE == 1 && m == 0) { pf_ok = ((LAS unsigned*)MBf)[16] != 0u;
                if (pf_ok) { const unsigned long long* slot = ring + (size_t)(((unsigned)(n0 >> 6) + 1u) % RING_SLOTS) * SLOT_U64;
#pragma unroll
                    for (int k = 0; k < 12; ++k) { const int e = tid + NT * k; if (e < S_YH) pf[k] = slot[e]; }
#pragma unroll
                    for (int mm = 0; mm < 4; ++mm) yh[mm] = *(const f32x4*)(slot + S_YH + ((mm * 4 + (wv & 3)) * 64 + lane) * 2); } }
            cur ^= 1;
        }
        for (int rep6 = 0; rep6 < (MK_RDUP == 6 ? 2 : 1); ++rep6) {
            const int u = tid >> 3, part = tid & 7; const size_t row = (size_t)step_row(d, b, n0 + u);
            const f32x4 o0 = *(const LAS f32x4*)(OUT + u * 68 + 8 * part), o1 = *(const LAS f32x4*)(OUT + u * 68 + 8 * part + 4);
            const float mean = sum8((o0[0] + o0[1]) + (o0[2] + o0[3]) + (o1[0] + o1[1]) + (o1[2] + o1[3])) * (1.f / 64.f);
            const f32x4 d0 = o0 - mean, d1 = o1 - mean;
            const float var = sum8((d0[0] * d0[0] + d0[1] * d0[1]) + (d0[2] * d0[2] + d0[3] * d0[3]) + (d1[0] * d1[0] + d1[1] * d1[1]) + (d1[2] * d1[2] + d1[3] * d1[3])) * (1.f / 64.f);
            const float rstd = rsqrtf(var + 64e-5f), bs = BS[u];
            const f32x4 w0 = *(const LAS f32x4*)(prm + 640 + 8 * part), w1 = *(const LAS f32x4*)(prm + 644 + 8 * part), b0 = *(const LAS f32x4*)(prm + 704 + 8 * part), b1 = *(const LAS f32x4*)(prm + 708 + 8 * part);
            const u32x4 vv = *(const LAS u32x4*)(Vt + u * PT + 8 * part);
            float z[8];
#pragma unroll
            for (int k = 0; k < 4; ++k) { z[k] = d0[k] * rstd * w0[k] + b0[k]; z[4 + k] = d1[k] * rstd * w1[k] + b1[k]; }
#pragma unroll
            for (int k = 0; k < 4; ++k) { z[2 * k] += bs * __uint_as_float(vv[k] << 16); z[2 * k + 1] += bs * __uint_as_float(vv[k] & 0xffff0000u); }
            u32x4 w; w.x = pack2(z[0], z[1]); w.y = pack2(z[2], z[3]); w.z = pack2(z[4], z[5]); w.w = pack2(z[6], z[7]);
            *(u32x4*)(Z + ((size_t)d * NALL + row) * 512 + 64 * h + 8 * part) = w;
        }
        __syncthreads();
    }
}
constexpr int RP_G2 = 0, RP_G2P = 520, RP_SG = RP_G2 + 128 * RP_G2P * 2, RP_END = RP_SG + 64 * PQ * 2;
static_assert(RP_END <= LDS_BYTES, "rwkv post LDS map");
DI void phase_rwkv_post2(const P& p, LAS unsigned char* lds) {
    const int tid = mk_tid(), lane = tid & 63, wv = __builtin_amdgcn_readfirstlane(tid >> 6), r = lane & 15, q = lane >> 4;
    const bf16_t* LO = (const bf16_t*)(p.ws + WS_COLS) + OFF_LO; const bf16_t* Z = (const bf16_t*)(p.ws + WS_Z); bf16_t* Y = (bf16_t*)(p.ws + WS_COLS);
    LAS bf16_t* G2s = (LAS bf16_t*)(lds + RP_G2); LAS bf16_t* SG = (LAS bf16_t*)(lds + RP_SG);
    const unsigned g2_b = (unsigned)(size_t)G2s;
    if ((int)blockIdx.x >= NRC) return;
    __syncthreads();
    for (int e = tid; e < 128 * 128; e += NT) { const int rr = e >> 7, c4 = (e & 127) * 4; const f32x4 v = *(const f32x4*)(p.in[I_G2] + rr * 512 + c4);
        *(LAS u32x2*)(G2s + rr * RP_G2P + c4) = pack4(v[0], v[1], v[2], v[3]); }
    for (int rc = blockIdx.x; rc < NRC; rc += gridDim.x) {
        const size_t row0 = (size_t)rc * 64;
        __syncthreads();
        for (int e = tid; e < 64 * 16; e += NT) { const int t = e >> 4, pc = e & 15; const u32x4 v = *(const u32x4*)(LO + (row0 + t) * 512 + 256 + 8 * pc); u32x4 o;
#pragma unroll
            for (int k = 0; k < 4; ++k) o[k] = pack2(fsigm(__uint_as_float(v[k] << 16)), fsigm(__uint_as_float(v[k] & 0xffff0000u)));
            *(LAS u32x4*)(SG + t * PQ + 8 * pc) = o; }
        __syncthreads();
#pragma unroll 1
        for (int ci = 0; ci < 4; ++ci) { const int ct = 4 * wv + ci;
            f32x4 acc[4] = {(f32x4){0.f, 0.f, 0.f, 0.f}, (f32x4){0.f, 0.f, 0.f, 0.f}, (f32x4){0.f, 0.f, 0.f, 0.f}, (f32x4){0.f, 0.f, 0.f, 0.f}};
#pragma unroll
            for (int kk = 0; kk < 4; ++kk) { const bf16x8 a = tr_frag(g2_b, RP_G2P, 32 * kk, 16 * ct, r, q);
#pragma unroll
                for (int tt = 0; tt < 4; ++tt) { const bf16x8 bs = *(const LAS bf16x8*)(SG + (16 * tt + r) * PQ + 32 * kk + 8 * q); acc[tt] = __builtin_amdgcn_mfma_f32_16x16x32_bf16(a, bs, acc[tt], 0, 0, 0); } }
#pragma unroll
            for (int tt = 0; tt < 4; ++tt) { const size_t row = row0 + 16 * tt + r; const int c = 16 * ct + 4 * q;
                float z0[4], z1[4]; unpack4(*(const u32x2*)(Z + row * 512 + c), z0); unpack4(*(const u32x2*)(Z + ((size_t)NALL + row) * 512 + c), z1);
                *(u32x2*)(Y + row * D + c) = pack4((z0[0] + z1[0]) * acc[tt][0], (z0[1] + z1[1]) * acc[tt][1], (z0[2] + z1[2]) * acc[tt][2], (z0[3] + z1[3]) * acc[tt][3]); }
        }
    }
    __syncthreads();
}
#define XB_TMO      128
#define XB_XCNT(j)  (256  + 64 * (j))
#define XB_XSUB(j)  (1280 + 64 * (j))
#define XB_XGEN(j)  (2304 + 64 * (j))
#define XB_TOP      3328
#define XB_TOPGEN   3392
#define XCD_BAR_WORDS 3456
#define XB_SPIN_CAP (1u << 18)

__device__ __forceinline__ unsigned xb_ld(unsigned* p)              { return __hip_atomic_load(p, __ATOMIC_RELAXED, __HIP_MEMORY_SCOPE_AGENT); }
__device__ __forceinline__ unsigned xb_add(unsigned* p, unsigned v) { return __hip_atomic_fetch_add(p, v, __ATOMIC_RELAXED, __HIP_MEMORY_SCOPE_AGENT); }
__device__ __forceinline__ unsigned xb_xcc_id() { return (unsigned)__builtin_amdgcn_s_getreg((3 << 11) | 20) & 0xFu; }
#define XB_SPIN(cond, bar) do { unsigned _sp = 0; while (cond) { __builtin_amdgcn_s_sleep(1); \
    if ((++_sp & 255u) == 0u) { if (xb_ld(&(bar)[XB_TMO])) break; if (_sp > XB_SPIN_CAP) { atomicAdd(&(bar)[XB_TMO], 1u); break; } } } } while (0)

struct XcdBarrier {
    unsigned* bar; unsigned x;
    volatile LAS unsigned* st;
};

__device__ __forceinline__ XcdBarrier xcd_barrier_post(unsigned* bar, volatile LAS unsigned* st) {
    XcdBarrier b; b.bar = bar; b.x = xb_xcc_id(); b.st = st;
    if (threadIdx.x == 0) (void)xb_add(&bar[XB_XCNT(b.x)], 1u);
    return b;
}
__device__ __forceinline__ void xcd_barrier_complete(unsigned* bar, unsigned x, unsigned& nloc, unsigned& nx) {
    const unsigned G = gridDim.x * gridDim.y * gridDim.z;
    unsigned sum, cnt, mine, sp = 0u;
    for (;;) {
        sum = 0u; cnt = 0u; mine = 0u;
#pragma unroll
        for (unsigned j = 0; j < 16; ++j) { const unsigned c = xb_ld(&bar[XB_XCNT(j)]); sum += c; cnt += (c > 0u) ? 1u : 0u; mine = (j == x) ? c : mine; }
        if (sum == G) break;
        __builtin_amdgcn_s_sleep(1);
        if ((++sp & 255u) == 0u) { if (xb_ld(&bar[XB_TMO])) break; if (sp > XB_SPIN_CAP) { atomicAdd(&bar[XB_TMO], 1u); break; } }
    }
    nloc = mine > 0u ? mine : 1u; nx = cnt > 0u ? cnt : 1u;
}

__device__ __forceinline__ void xcd_barrier(const XcdBarrier& b) {
    asm volatile("s_waitcnt vmcnt(0)" ::: "memory");
    __syncthreads();
    if (threadIdx.x == 0) {
        unsigned* bar = b.bar;
        __builtin_amdgcn_s_waitcnt(0);
        unsigned nloc = b.st[0], nx = b.st[1];
        if (nloc == 0u) { xcd_barrier_complete(bar, b.x, nloc, nx); b.st[0] = nloc; b.st[1] = nx; }
        const unsigned old = xb_add(&bar[XB_XSUB(b.x)], 1u);
        const unsigned gen = old / nloc;
        if (old + 1u == (gen + 1u) * nloc) {
            __builtin_amdgcn_fence(__ATOMIC_RELEASE, "agent");
            asm volatile("s_waitcnt vmcnt(0)" ::: "memory");
            const unsigned og = xb_add(&bar[XB_TOP], 1u);
            const unsigned tg = og / nx;
            if (og + 1u == (tg + 1u) * nx) xb_add(&bar[XB_TOPGEN], 1u);
            else XB_SPIN(xb_ld(&bar[XB_TOPGEN]) == tg, bar);
            __builtin_amdgcn_fence(__ATOMIC_ACQUIRE, "agent");
            xb_add(&bar[XB_XGEN(b.x)], 1u);
            asm volatile("s_waitcnt vmcnt(0)" ::: "memory");
        } else {
            XB_SPIN(xb_ld(&bar[XB_XGEN(b.x)]) == gen, bar);
            __builtin_amdgcn_fence(__ATOMIC_ACQUIRE, "agent");
            asm volatile("s_waitcnt vmcnt(0)" ::: "memory");
        }
    }
    __syncthreads();
}
constexpr int SG_P = 72;
template <bool DUAL, class Epi> DI void small_gemm(LAS unsigned char* lds, const bf16_t* A, const bf16_t* Bt, int M, int N, int K, const Epi& E) {
    const int tid = mk_tid(), lane = tid & 63, wv = __builtin_amdgcn_readfirstlane(tid >> 6), r = lane & 15, q = lane >> 4, mt = wv & 3, nh = wv >> 2;
    constexpr int BUF = 3 * 64 * SG_P;
    LAS bf16_t* base = (LAS bf16_t*)lds;
    const int ntn = N / 64, ntiles = (M / 64) * ntn, nkc = K / 64, prow = tid >> 3, ppc = tid & 7;
    for (int tile = blockIdx.x; tile < ntiles; tile += gridDim.x) {
        const int tm = tile / ntn, tn = tile - tm * ntn;
        const int c0 = 64 * tn; const int brow0 = DUAL ? 256 * (c0 >> 7) + (c0 & 127) : c0;
        const bf16_t* ag = A + (size_t)(64 * tm + prow) * K + 8 * ppc; const bf16_t* bg = Bt + (size_t)(brow0 + prow) * K + 8 * ppc;
        f32x4 acc[2] = {(f32x4){0.f, 0.f, 0.f, 0.f}, (f32x4){0.f, 0.f, 0.f, 0.f}}, acc3[2] = {(f32x4){0.f, 0.f, 0.f, 0.f}, (f32x4){0.f, 0.f, 0.f, 0.f}};
        u32x4 ra = *(const u32x4*)ag, rb = *(const u32x4*)bg, rb3 = (u32x4){0u, 0u, 0u, 0u};
        if (DUAL) rb3 = *(const u32x4*)(bg + (size_t)128 * K);
        __syncthreads();
        { LAS bf16_t* S0 = base; *(LAS u32x4*)(S0 + prow * SG_P + 8 * ppc) = ra; *(LAS u32x4*)(S0 + 64 * SG_P + prow * SG_P + 8 * ppc) = rb; if (DUAL) *(LAS u32x4*)(S0 + 128 * SG_P + prow * SG_P + 8 * ppc) = rb3; }
        if (nkc > 1) { ra = *(const u32x4*)(ag + 64); rb = *(const u32x4*)(bg + 64); if (DUAL) rb3 = *(const u32x4*)(bg + (size_t)128 * K + 64); }
        __syncthreads();
        for (int kc = 0; kc < nkc; ++kc) {
            LAS bf16_t* As = base + (kc & 1) * BUF; LAS bf16_t* Bs = As + 64 * SG_P; LAS bf16_t* B3 = Bs + 64 * SG_P;
            if (kc + 1 < nkc) { LAS bf16_t* Sn = base + ((kc + 1) & 1) * BUF; *(LAS u32x4*)(Sn + prow * SG_P + 8 * ppc) = ra; *(LAS u32x4*)(Sn + 64 * SG_P + prow * SG_P + 8 * ppc) = rb; if (DUAL) *(LAS u32x4*)(Sn + 128 * SG_P + prow * SG_P + 8 * ppc) = rb3; }
            if (kc + 2 < nkc) { ra = *(const u32x4*)(ag + 64 * (kc + 2)); rb = *(const u32x4*)(bg + 64 * (kc + 2)); if (DUAL) rb3 = *(const u32x4*)(bg + (size_t)128 * K + 64 * (kc + 2)); }
#pragma unroll
            for (int kk = 0; kk < 2; ++kk) { const bf16x8 a = *(const LAS bf16x8*)(As + (16 * mt + r) * SG_P + 32 * kk + 8 * q);
#pragma unroll
                for (int x = 0; x < 2; ++x) { const bf16x8 bb = *(const LAS bf16x8*)(Bs + (16 * (2 * nh + x) + r) * SG_P + 32 * kk + 8 * q); acc[x] = __builtin_amdgcn_mfma_f32_16x16x32_bf16(bb, a, acc[x], 0, 0, 0);
                    if (DUAL) { const bf16x8 b3 = *(const LAS bf16x8*)(B3 + (16 * (2 * nh + x) + r) * SG_P + 32 * kk + 8 * q); acc3[x] = __builtin_amdgcn_mfma_f32_16x16x32_bf16(b3, a, acc3[x], 0, 0, 0); } } }
            __syncthreads();
        }
#pragma unroll
        for (int x = 0; x < 2; ++x) E(64 * tm + 16 * mt + r, c0 + 16 * (2 * nh + x) + 4 * q, acc[x], acc3[x]);
    }
    __syncthreads();
}
struct SEpiStore3 { bf16_t* p0; int ld0; int c1; bf16_t* p1; int ld1; int c2; bf16_t* p2; int ld2;
    DI void operator()(int m, int c, const f32x4& v, const f32x4&) const { bf16_t* base; int ld, cc;
        if (c >= c2) { base = p2; ld = ld2; cc = c - c2; } else if (c >= c1) { base = p1; ld = ld1; cc = c - c1; } else { base = p0; ld = ld0; cc = c; }
        *(u32x2*)(base + (size_t)(NLAT + m) * ld + cc) = pack4(v[0], v[1], v[2], v[3]); } };
struct SEpiResid { const float* cin; float* cout; const float* gate;
    DI void operator()(int m, int c, const f32x4& v, const f32x4&) const { const f32x4 g = *(const f32x4*)(gate + c), bs = *(const f32x4*)(cin + (size_t)m * D + c); *(f32x4*)(cout + (size_t)m * D + c) = bs + g * v; } };
struct SEpiSwiglu { bf16_t* G;
    DI void operator()(int m, int c, const f32x4& a, const f32x4& b) const { float g[4];
#pragma unroll
        for (int j = 0; j < 4; ++j) g[j] = a[j] * frcp(1.f + fexp(-a[j])) * b[j];
        *(u32x2*)(G + (size_t)(NLAT + m) * DFF + c) = pack4(g[0], g[1], g[2], g[3]); } };
DI void phase_mlstm_post(const P& p) {
    const int lane = mk_tid() & 63, wv = mk_tid() >> 6;
    const bf16_t* ML = (const bf16_t*)(p.ws + WS_COLS) + OFF_ML; const bf16_t* HB = (const bf16_t*)(p.ws + WS_ACT); bf16_t* Y = (bf16_t*)(p.ws + WS_COLS);
    for (int r = blockIdx.x * 8 + wv; r < NALL; r += gridDim.x * 8)
        post_headnorm_row(HB, (size_t)r, p.in[I_MNG], ML + (size_t)r * 2048 + 1536, 0, Y + (size_t)r * D + 512, lane);
}
DI void phase_hgrn_post(const P& p) {
    const int lane = mk_tid() & 63, wv = mk_tid() >> 6;
    const bf16_t* C1 = (const bf16_t*)(p.ws + WS_COLS); const bf16_t* HB = (const bf16_t*)(p.ws + WS_ACT); bf16_t* Y = (bf16_t*)(p.ws + WS_Z);
    for (int r = blockIdx.x * 8 + wv; r < NLAT; r += gridDim.x * 8)
        post_headnorm_row(HB, (size_t)r, p.in[I_HNG], C1 + (size_t)r * C1LD + 2048, 1, Y + (size_t)nat_row(r) * D, lane);
}

constexpr int N_PHASES = 19;
__global__ void __launch_bounds__(NT, 2) mk_fwd(P p) {
    extern __shared__ __attribute__((aligned(16))) unsigned char lds_raw[];
    LAS unsigned char* lds = (LAS unsigned char*)lds_raw;
    cooperative_groups::grid_group grid = cooperative_groups::this_grid();
    const int lo = p.ph_lo, hi = p.ph_hi;
    volatile LAS unsigned* xst = (volatile LAS unsigned*)(lds + LDS_BYTES - 16);
    if (threadIdx.x < 4) xst[threadIdx.x] = 0u;
    __syncthreads();
    const XcdBarrier xbar = xcd_barrier_post((unsigned*)(p.ws + WS_CTL) + 8192, xst);
#define IN(k) (lo <= (k) && (k) < hi)
#define SEAM(k) do { if (IN(k) && IN((k) + 1)) xcd_barrier(xbar); } while (0)
#ifndef MK_DUP
#define MK_DUP -1
#endif
#define PHASE(k, ...) if (IN(k)) { __VA_ARGS__ if (MK_DUP == (k)) { grid.sync(); __VA_ARGS__ } } SEAM(k);
    unsigned char* ws = p.ws;
    const float* MODV = (const float*)(ws + WS_MODV);
    float* HC = (float*)(ws + WS_HC);
    float* SSQP = (float*)(ws + WS_SSQP); const float* GSC = (const float*)(ws + WS_GSC); const float* SHW = GSC + SHW_OFF;
    bf16_t* ACT = (bf16_t*)(ws + WS_ACT); bf16_t* COLS = (bf16_t*)(ws + WS_COLS); bf16_t* Y1 = (bf16_t*)(ws + WS_Z);
    PHASE(0, phase_modv(p, lds);)
    PHASE(1, phase_modnorm(p, 0, 0, p.in[I_X], p.in[I_CTX], NALL, false); phase_wprep(p, lds);)
    PHASE(2, { EpiStore3 E{COLS + OFF_RW, 1536, 6, COLS + OFF_LO, 512, 8, COLS + OFF_ML, 2048, 0}; run_gemm(lds, ACT, (const bf16_t*)(ws + WS_W_EVIN), NLAT, 4096, 1024, E); SEpiStore3 S{COLS + OFF_RW, 1536, 1536, COLS + OFF_LO, 512, 2048, COLS + OFF_ML, 2048}; small_gemm<false>(lds, ACT + (size_t)NLAT * 1024, (const bf16_t*)(ws + WS_W_EVIN), NCTX, 4096, 1024, S); })
    PHASE(3, { const int bx = (int)blockIdx.x;
        if (gridDim.x == 256) { if (bx < 64) rwkv_chunk_unit<1>(p, lds, bx); else if (bx < 192) rwkv_chunk_unit<2>(p, lds, (bx - 64) & 63, (bx - 64) >> 6); else { gla_unit<0>(p, lds, 2 * (bx - 192)); gla_unit<0>(p, lds, 2 * (bx - 192) + 1); } }
        else for (int vb = bx; vb < 192; vb += gridDim.x) { if (vb < 64) rwkv_chunk_unit<0>(p, lds, vb); else gla_unit<0>(p, lds, vb - 64); } })
    if (IN(3) && MK_DUP == 303) { grid.sync(); if (blockIdx.x < 64) rwkv_chunk_unit<1>(p, lds, blockIdx.x); grid.sync(); }
    if (IN(3) && MK_DUP == 403) { grid.sync(); if (blockIdx.x >= 64 && blockIdx.x < 128) rwkv_chunk_unit<2>(p, lds, blockIdx.x - 64, 0); grid.sync(); }
    if (IN(3) && MK_DUP == 103) { grid.sync(); for (int vb = blockIdx.x; vb < 64; vb += gridDim.x) rwkv_chunk_unit<0>(p, lds, vb); grid.sync(); }
    if (IN(3) && MK_DUP == 203) { grid.sync(); for (int vb = blockIdx.x; vb < 128; vb += gridDim.x) gla_unit<0>(p, lds, vb); grid.sync(); }
    PHASE(4, phase_mlstm_post(p); phase_rwkv_post2(p, lds);)
    PHASE(5, { EpiResid E{p.in[I_X], p.out, p.in[I_CTX], HC, MODV, 2, 0}; run_gemm(lds, COLS, (const bf16_t*)(ws + WS_W_EVOUT), NLAT, 1024, 1024, E); SEpiResid S{p.in[I_CTX], HC, MODV + 4 * 6144 + 2 * 1024}; small_gemm<false>(lds, COLS + (size_t)NLAT * 1024, (const bf16_t*)(ws + WS_W_EVOUT), NCTX, 1024, 1024, S); })
    PHASE(6, phase_modnorm(p, 0, 1, p.out, HC, NALL, false);)
    PHASE(7, { EpiSwiglu E{COLS, 0}; run_gemm(lds, ACT, (const bf16_t*)(ws + WS_W_UP), NLAT, 5632, 1024, E); SEpiSwiglu S{COLS}; small_gemm<true>(lds, ACT + (size_t)NLAT * 1024, (const bf16_t*)(ws + WS_W_UP), NCTX, 2816, 1024, S); })
    PHASE(8, { EpiResid E{p.out, p.out, HC, HC, MODV, 5, 0}; run_gemm(lds, COLS, (const bf16_t*)(ws + WS_W_DN), NLAT, 1024, 2816, E); SEpiResid S{HC, HC, MODV + 4 * 6144 + 5 * 1024}; small_gemm<false>(lds, COLS + (size_t)NLAT * 2816, (const bf16_t*)(ws + WS_W_DN), NCTX, 1024, 2816, S); })
    PHASE(9, phase_modnorm(p, 1, 0, p.out, HC, NALL, true);)
    PHASE(10, { EpiStore3 E{COLS, C1LD, 1 << 30, COLS, C1LD, 1 << 30, COLS, C1LD, 0}; run_gemm(lds, ACT, (const bf16_t*)(ws + WS_W_ODIN), NLAT, 3584, 1024, E); SEpiStore3 S{COLS, C1LD, 1 << 30, COLS, C1LD, 1 << 30, COLS, C1LD}; small_gemm<false>(lds, ACT + (size_t)NLAT * 1024, (const bf16_t*)(ws + WS_W_ODIN), NCTX, 3584, 1024, S); })
    PHASE(11, phase_hgrn_prep2(p, lds); lru_pass<1>(p, lds, (int)blockIdx.x, (int)gridDim.x);)
    PHASE(12, { const int half = (int)gridDim.x >> 1; if ((int)blockIdx.x < half) { for (int u = blockIdx.x; u < 128; u += half) gla_unit<1>(p, lds, u); } else lru_pass<3>(p, lds, (int)blockIdx.x - half, (int)gridDim.x - half); })
    if (IN(12) && MK_DUP == 112) { grid.sync(); lru_pass<3>(p, lds, (int)blockIdx.x, (int)gridDim.x); grid.sync(); }
    if (IN(12) && MK_DUP == 212) { grid.sync(); for (int vb = blockIdx.x; vb < 128; vb += gridDim.x) gla_unit<1>(p, lds, vb); grid.sync(); }
    PHASE(13, phase_hgrn_post(p);)
    PHASE(14, EpiResid E{p.out, p.out, HC, HC, MODV + 5 * 6144, 2, 0}; run_gemm(lds, Y1, (const bf16_t*)(ws + WS_W_ODOUT), NLAT, 1024, 1024, E);)
    PHASE(15, phase_modnorm(p, 1, 1, p.out, HC, NLAT, false);)
    PHASE(16, EpiSwiglu E{COLS, 0}; run_gemm(lds, ACT, (const bf16_t*)(ws + WS_W_UP) + W_UP_STRIDE, NLAT, 5632, 1024, E);)
    PHASE(17, EpiResid E{p.out, p.out, HC, HC, MODV + 5 * 6144, 5, 0}; run_gemm(lds, COLS, (const bf16_t*)(ws + WS_W_DN) + W_DN_STRIDE, NLAT, 1024, 2816, E);)
    PHASE(18, phase_finalnorm(p);)
    if (hi > 4096) grid.sync();
#undef IN
#undef SEAM
}
}

#ifndef MK_ONE_LAUNCH
#define MK_ONE_LAUNCH 1
#endif
extern "C" void kernel_launch(void* const* d_in, const int* in_sizes, int n_in, void* d_out, int out_size, void* d_ws, size_t ws_size, hipStream_t stream) {
    using namespace mk;
    static int grid = 0;
    if (grid == 0) {
        int dev = 0, cus = 0, per_cu = 0;
        if (n_in != N_IN || ws_size < WS_END) { fprintf(stderr, "kernel_launch: unexpected n_in %d / ws_size %zu\n", n_in, ws_size); grid = -1; return; }
        (void)hipGetDevice(&dev); (void)hipDeviceGetAttribute(&cus, hipDeviceAttributeMultiprocessorCount, dev);
        (void)hipFuncSetAttribute((const void*)mk_fwd, hipFuncAttributeMaxDynamicSharedMemorySize, LDS_BYTES);
        (void)hipOccupancyMaxActiveBlocksPerMultiprocessor(&per_cu, (const void*)mk_fwd, NT, LDS_BYTES);
        if (per_cu < 1) { fprintf(stderr, "kernel_launch: occupancy query says %d blocks per CU\n", per_cu); per_cu = 1; }
        (void)hipGetLastError();
        grid = cus;
    }
    if (grid < 0) return;
    if (hipMemsetAsync((char*)d_ws + WS_CTL, 0, 65536, stream) != hipSuccess) { fprintf(stderr, "kernel_launch: memset of the control words failed\n"); return; }
    P p{};
    for (int i = 0; i < N_IN; ++i) p.in[i] = (const float*)d_in[i];
    p.out = (float*)d_out; p.ws = (unsigned char*)d_ws;
#if MK_ONE_LAUNCH
    p.ph_lo = 0; p.ph_hi = N_PHASES;
    void* args[] = {&p};
    hipError_t e = hipLaunchCooperativeKernel((const void*)mk_fwd, dim3(grid), dim3(NT), args, LDS_BYTES, stream);
    if (e != hipSuccess) fprintf(stderr, "cooperative launch failed: %s (grid %d)\n", hipGetErrorString(e), grid);
#else
    for (int k = 0; k < N_PHASES; ++k) { p.ph_lo = k; p.ph_hi = k + 1; hipLaunchKernelGGL(mk_fwd, dim3(grid), dim3(NT), LDS_BYTES, stream, p); }
#endif
}
```

```cpp
#include <hip/hip_runtime.h>
#include <hip/hip_cooperative_groups.h>
#include <cstdio>
#include <cstdint>
__device__ __forceinline__ int mk_tid() { int t = threadIdx.x; asm volatile("" : "+v"(t)); return t; }
#define MK_DUP -1
#define MK_RDUP -1
namespace pg8 {
#define PG8_LAS __attribute__((address_space(3)))
typedef unsigned short bf16_t;
typedef short bf16x8 __attribute__((ext_vector_type(8)));
typedef float f32x4 __attribute__((ext_vector_type(4)));
typedef unsigned u32x4 __attribute__((ext_vector_type(4)));
constexpr int BM = 256, BK = 64, HALF = 128, HTB = HALF * BK * 2  , STAGE_BYTES = 8 * HTB, NXCD = 8, WGM = 8;

__host__ __device__ __forceinline__ int lds_byte(int r, int c) { const int st = (r >> 4) * 2 + (c >> 5), rr = r & 15, cc = c & 31, ob = rr * 64 + cc * 2; return st * 1024 + (ob ^ (((ob >> 9) & 1) << 5)); }
__host__ __device__ __forceinline__ void stage_rc(int b, int& R, int& C) { const int st = b / 1024, sb = b % 1024, swz = sb ^ (((sb >> 9) & 1) << 5); R = (st >> 1) * 16 + swz / 64; C = (st & 1) * 32 + (swz % 64) / 2; }
__host__ __device__ __forceinline__ int perm32(int rho) { const int n = rho >> 4, i = rho & 15; return 8 * (i >> 2) + 4 * n + (i & 3); }

struct Unit { int pm, pn; };
struct Gemm { const bf16_t* A; const bf16_t* Bt; int M, N, K; };

struct StaticOrder {
    int nM, nN, nwg, G, c;
    __host__ __device__ void init(int M, int N, int G_, int c_) { nM = M / BM; nN = N / BM; nwg = nM * nN; G = G_; c = c_; }
    __host__ __device__ bool next(int i, Unit& u) const {
        const long L = (long)i * G + c; if (L >= nwg) return false;
        int wgid = (int)L; { const int q = nwg / NXCD, r = nwg % NXCD, xcd = wgid % NXCD, off = wgid / NXCD; wgid = (xcd < r ? xcd * (q + 1) : r * (q + 1) + (xcd - r) * q) + off; }
        const int nig = WGM * nN, gid = wgid / nig, fm = gid * WGM, gsz = (nM - fm) < WGM ? (nM - fm) : WGM;
        u.pm = fm + ((wgid % nig) % gsz); u.pn = (wgid % nig) / gsz; return true;
    }
    __device__ __forceinline__ void a_ready(const Unit&) const {}
    __device__ __forceinline__ void done(const Unit&) const {}
};
__device__ __forceinline__ unsigned cvt_pk_bf16(float lo, float hi) { unsigned r; asm volatile("v_cvt_pk_bf16_f32 %0, %1, %2" : "=v"(r) : "v"(lo), "v"(hi)); return r; }
typedef float f32x2 __attribute__((ext_vector_type(2)));
template <class Epi, class Sched, bool STAMP = false>
__device__ __forceinline__ void gemm_phase(PG8_LAS unsigned char* lds, const Gemm g, const Sched& S, const Epi& E, unsigned long long* stamps) {
    const int tid = mk_tid(), wid = __builtin_amdgcn_readfirstlane(tid >> 6), lane = tid & 63, wr = wid >> 2, wc = wid & 3, fr = lane & 15, fq = lane >> 4;
    const int K = g.K, nt = K / BK;
    int ts_lo = 0, ts_hi = 0, nts = 0; const unsigned long long rt_entry = STAMP ? (unsigned long long)wall_clock64() : 0ull;
#define PG8_STAMP() do { if (STAMP && wid == 0 && nts < 64) { const unsigned long long _c = (unsigned long long)clock64(); \
        ts_lo = (lane == nts) ? (int)(unsigned)_c : ts_lo; ts_hi = (lane == nts) ? (int)(unsigned)(_c >> 32) : ts_hi; ++nts; } } while (0)
    PG8_STAMP();
    unsigned voffA[2], voffB[2];
#pragma unroll
    for (int i = 0; i < 2; ++i) { int R, C; stage_rc(tid * 16 + i * 8192, R, C); const int Rb = Epi::PERM ? ((R & ~31) + perm32(R & 31)) : R;
        voffA[i] = (unsigned)(R * K + C) * 2u; voffB[i] = (unsigned)(Rb * K + C) * 2u; }
    const size_t kstep = (size_t)(BK * 2);
    const size_t hstep = (size_t)HALF * K * 2;
    const size_t tstep = 2 * hstep;
    const unsigned ldsw = (unsigned)wid * 1024u;
    const int aoff = lds_byte(wr * 64 + fr, fq * 8), boff = lds_byte(wc * 32 + fr, fq * 8);
#define PG8_SA(b, h) (((b) * 2 + (h)) * HTB)
#define PG8_SB(b, h) ((4 + (b) * 2 + (h)) * HTB)
#define PG8_STAGE(bufoff, gbase, voff) do { _Pragma("unroll") for (int _i = 0; _i < 2; ++_i) \
        __builtin_amdgcn_global_load_lds((const unsigned*)((const char*)(gbase) + (voff)[_i]), (PG8_LAS unsigned*)(lds + (bufoff) + ldsw + _i * 8192), 16, 0, 0); } while (0)
#define PG8_LDA(dst, b, h) do { _Pragma("unroll") for (int m = 0; m < 4; ++m) _Pragma("unroll") for (int k = 0; k < 2; ++k) dst[m][k] = *(const PG8_LAS bf16x8*)(lds + PG8_SA(b, h) + aoff + m * 2048 + k * 1024); } while (0)
#define PG8_LDB(dst, b, h) do { _Pragma("unroll") for (int n = 0; n < 2; ++n) _Pragma("unroll") for (int k = 0; k < 2; ++k) dst[n][k] = *(const PG8_LAS bf16x8*)(lds + PG8_SB(b, h) + boff + n * 2048 + k * 1024); } while (0)
#define PG8_MMA(ai, bj, At, Bt) do { __builtin_amdgcn_s_setprio(1); _Pragma("unroll") for (int m = 0; m < 4; ++m) _Pragma("unroll") for (int n = 0; n < 2; ++n) _Pragma("unroll") for (int k = 0; k < 2; ++k) \
        acc[ai][bj][m][n] = __builtin_amdgcn_mfma_f32_16x16x32_bf16(Bt[n][k], At[m][k], acc[ai][bj][m][n], 0, 0, 0); __builtin_amdgcn_s_setprio(0); } while (0)
#define PG8_WAIT_V(n) asm volatile("s_waitcnt vmcnt(" #n ")" ::: "memory")
#define PG8_WAIT_L(n) asm volatile("s_waitcnt lgkmcnt(" #n ")" ::: "memory")
#define PG8_BAR __builtin_amdgcn_s_barrier()
#define PG8_SCHED __builtin_amdgcn_sched_barrier(0)
    Unit cur, nxt; int ui = 0;
    if (!S.next(0, cur)) return;
    f32x4 acc[2][2][4][2];
#pragma unroll
    for (int a = 0; a < 2; ++a)
#pragma unroll
        for (int b = 0; b < 2; ++b)
#pragma unroll
            for (int m = 0; m < 4; ++m)
#pragma unroll
                for (int n = 0; n < 2; ++n) acc[a][b][m][n] = (f32x4){0.f, 0.f, 0.f, 0.f};
    bf16x8 At[4][2], B0[2][2], B1[2][2];
    const char* cA = (const char*)g.A + (size_t)cur.pm * tstep; const char* cB = (const char*)g.Bt + (size_t)cur.pn * tstep;
    S.a_ready(cur);
    PG8_STAGE(PG8_SB(0, 0), cB, voffB); PG8_STAGE(PG8_SA(0, 0), cA, voffA); PG8_STAGE(PG8_SB(0, 1), cB + hstep, voffB); PG8_STAGE(PG8_SA(0, 1), cA + hstep, voffA);
    if (wr == 1) PG8_BAR;
    PG8_WAIT_V(4); PG8_BAR;
    PG8_STAGE(PG8_SB(1, 0), cB + kstep, voffB); PG8_STAGE(PG8_SA(1, 0), cA + kstep, voffA); PG8_STAGE(PG8_SB(1, 1), cB + hstep + kstep, voffB);
    PG8_WAIT_V(6); PG8_BAR;
    PG8_STAMP();
    for (;;) {
        const bool has_next = S.next(ui + 1, nxt);
        const char* nA = has_next ? (const char*)g.A + (size_t)nxt.pm * tstep : cA; const char* nB = has_next ? (const char*)g.Bt + (size_t)nxt.pn * tstep : cB;
        for (int t = 0; t < nt; t += 2) {
            const bool last = (t == nt - 2);
            const char* a1 = cA + (size_t)(t + 1) * kstep;
            const char* a2 = last ? nA : cA + (size_t)(t + 2) * kstep; const char* b2 = last ? nB : cB + (size_t)(t + 2) * kstep;
            const char* a3 = a2 + kstep; const char* b3 = b2 + kstep;
            if (last && has_next) S.a_ready(nxt);
            PG8_LDB(B0, 0, 0); PG8_SCHED; PG8_LDA(At, 0, 0); PG8_STAGE(PG8_SA(1, 1), a1 + hstep, voffA);
            PG8_WAIT_L(8); PG8_BAR; PG8_WAIT_L(0); PG8_MMA(0, 0, At, B0); PG8_BAR; PG8_SCHED;
            PG8_LDB(B1, 0, 1); PG8_STAGE(PG8_SB(0, 0), b2, voffB);
            PG8_BAR; PG8_WAIT_L(0); PG8_MMA(0, 1, At, B1); PG8_BAR;
            PG8_LDA(At, 0, 1); PG8_STAGE(PG8_SA(0, 0), a2, voffA);
            PG8_BAR; PG8_WAIT_L(0); PG8_MMA(1, 0, At, B0); PG8_BAR; PG8_SCHED;
            PG8_STAGE(PG8_SB(0, 1), b2 + hstep, voffB);
            PG8_WAIT_V(6); PG8_BAR; PG8_MMA(1, 1, At, B1); PG8_BAR;
            PG8_LDB(B0, 1, 0); PG8_SCHED; PG8_LDA(At, 1, 0); PG8_STAGE(PG8_SA(0, 1), a2 + hstep, voffA);
            PG8_WAIT_L(8); PG8_BAR; PG8_WAIT_L(0); PG8_MMA(0, 0, At, B0); PG8_BAR; PG8_SCHED;
            PG8_LDB(B1, 1, 1); PG8_STAGE(PG8_SB(1, 0), b3, voffB);
            PG8_BAR; PG8_WAIT_L(0); PG8_MMA(0, 1, At, B1); PG8_BAR;
            PG8_LDA(At, 1, 1); PG8_STAGE(PG8_SA(1, 0), a3, voffA);
            PG8_BAR; PG8_WAIT_L(0); PG8_MMA(1, 0, At, B0); PG8_BAR; PG8_SCHED;
            PG8_STAGE(PG8_SB(1, 1), b3 + hstep, voffB);
            PG8_WAIT_V(6); PG8_BAR; PG8_MMA(1, 1, At, B1); PG8_BAR;
        }
        PG8_STAMP();
        if constexpr (!Epi::AFTER_DRAIN) { E(acc, cur, wr, wc, fr, fq); S.done(cur); }
        PG8_STAMP();
        if (!has_next) break;
#pragma unroll
        for (int a = 0; a < 2; ++a)
#pragma unroll
            for (int b = 0; b < 2; ++b)
#pragma unroll
                for (int m = 0; m < 4; ++m)
#pragma unroll
                    for (int n = 0; n < 2; ++n) acc[a][b][m][n] = (f32x4){0.f, 0.f, 0.f, 0.f};
        cur = nxt; cA = nA; cB = nB; ++ui;
    }
    PG8_WAIT_V(0);
    if (wr == 0) PG8_BAR;
    PG8_BAR;
    if constexpr (Epi::AFTER_DRAIN) { E.fused(acc, cur, wr, wc, fr, fq, lds, wid, lane); S.done(cur); }
    PG8_STAMP();
    if (STAMP && wid == 0) { stamps[lane] = lane < nts ? (((unsigned long long)(unsigned)ts_hi << 32) | (unsigned)ts_lo) : 0ull;
        if (lane == 62) stamps[62] = rt_entry; if (lane == 63) stamps[63] = (unsigned long long)wall_clock64(); }
#undef PG8_STAMP
#undef PG8_SA
#undef PG8_SB
#undef PG8_STAGE
#undef PG8_LDA
#undef PG8_LDB
#undef PG8_MMA
#undef PG8_WAIT_V
#undef PG8_WAIT_L
#undef PG8_BAR
#undef PG8_SCHED
}
}

namespace mk {
#define DI __device__ __forceinline__
#define LAS __attribute__((address_space(3)))
typedef unsigned short bf16_t;
typedef float f32x4 __attribute__((ext_vector_type(4)));
typedef unsigned u32x2 __attribute__((ext_vector_type(2)));
typedef unsigned u32x4 __attribute__((ext_vector_type(4)));

constexpr int D = 1024, NB = 4, L = 8192, LC = 256, NLAT = NB * L, NCTX = NB * LC, NALL = NLAT + NCTX, LT = L + LC, DFF = 2816;
constexpr int NT = 512;
constexpr size_t MiB = (size_t)1 << 20;
constexpr size_t WS_CTL = 0, WS_MODV = 1 * MiB, WS_HC = 2 * MiB, WS_W_EVIN = 6 * MiB, WS_W_EVOUT = 14 * MiB, WS_W_ODIN = 16 * MiB, WS_W_ODOUT = 23 * MiB,
                 WS_W_UP = 25 * MiB, WS_W_DN = 47 * MiB, WS_ACT = 58 * MiB, WS_COLS = 124 * MiB, WS_Z = 388 * MiB, WS_Z1 = 454 * MiB, WS_LAM = 486 * MiB, WS_LSUM = 489 * MiB, WS_LCAR = 494 * MiB, WS_SSQP = 497 * MiB, WS_GSC = 504 * MiB, WS_END = 505 * MiB;
constexpr size_t SSQP_STRIDE = (size_t)NALL * 16, GSC_STRIDE = 5 * 1024, SHW_OFF = 3 * GSC_STRIDE, SHW_STRIDE = 5 * 5632;
constexpr size_t W_UP_STRIDE = (size_t)5632 * 1024, W_DN_STRIDE = (size_t)1024 * 2816;
constexpr size_t OFF_RW = 0, OFF_LO = (size_t)NALL * 1536, OFF_ML = OFF_LO + (size_t)NALL * 512;
constexpr int LDS_BYTES = 163840;
constexpr int C1LD = 3584;
DI int nat_row(int r) { const int b = r / L, pp = r % L; return b * L + (pp % 128) * 64 + pp / 128; }

enum { I_X = 0, I_C, I_CTX, I_CCTX, I_N1G, I_N2G, I_MODW, I_MODB, I_W1, I_W3, I_W2, I_FING, I_EVIN, I_EVOUT, I_MU, I_W0, I_W2L, I_A0, I_A2L, I_KK, I_KA, I_RK,
       I_LNW, I_LNB, I_G2, I_MBI, I_MBF, I_MNG, I_ODIN, I_ODOUT, I_HLB, I_HNG, I_CONVW, I_CONVB, I_WA, I_BA, I_WI, I_BI, I_LAM, N_IN };

struct P { const float* in[N_IN]; float* out; unsigned char* ws; int ph_lo, ph_hi; };

DI float bf2f(bf16_t v) { return __uint_as_float(((unsigned)v) << 16); }
typedef float f32x2_t __attribute__((ext_vector_type(2)));
typedef __bf16 bf16x2_t __attribute__((ext_vector_type(2)));
DI unsigned pack2(float lo, float hi) { const f32x2_t v = {lo, hi}; return __builtin_bit_cast(unsigned, __builtin_convertvector(v, bf16x2_t)); }
DI bf16_t f2bf(float f) { return (bf16_t)(pack2(f, f) & 0xffffu); }
DI float sigm(float x) { return 1.f / (1.f + expf(-x)); }
DI float siluf(float x) { return x * sigm(x); }
DI float geluf(float x) { return 0.5f * x * (1.f + tanhf(0.7978845608028654f * (x + 0.044715f * x * x * x))); }
DI float fexp(float x) { return __builtin_amdgcn_exp2f(x * 1.4426950408889634f); }
DI float frcp(float x) { return __builtin_amdgcn_rcpf(x); }
DI float fsigm(float x) { return frcp(1.f + fexp(-x)); }
DI float ftanh(float x) { return 1.f - 2.f * frcp(1.f + fexp(2.f * x)); }
DI float fgelu(float x) { return 0.5f * x * (1.f + ftanh(0.7978845608028654f * (x + 0.044715f * x * x * x))); }
template <int CTRL> DI float dppf(float x) { return __int_as_float(__builtin_amdgcn_update_dpp(0, __float_as_int(x), CTRL, 0xF, 0xF, false)); }
DI float sum8(float s) { s += dppf<0xB1>(s); s += dppf<0x4E>(s); s += dppf<0x141>(s); return s; }
DI float scan16(float x) { x += dppf<0x111>(x); x += dppf<0x112>(x); x += dppf<0x114>(x); x += dppf<0x118>(x); return x; }
DI float wave_sum(float v) { v += dppf<0xB1>(v); v += dppf<0x4E>(v); v += dppf<0x141>(v); v += dppf<0x140>(v); v += __shfl_xor(v, 16); v += __shfl_xor(v, 32); return v; }
DI int step_row(int d, int b, int n) {
    if (n < LC) return NLAT + b * LC + (d ? LC - 1 - n : n);
    const int m = n - LC; return b * L + (d ? L - 1 - m : m);
}

DI int matN(int m) { return m == 0 ? 4096 : m == 1 ? 1024 : m == 2 ? 3584 : m == 3 ? 1024 : m < 6 ? 5632 : 1024; }
DI int matK(int m) { return m < 6 ? 1024 : 2816; }
DI int matTile0(int m) { return m == 0 ? 0 : m == 1 ? 1024 : m == 2 ? 1280 : m == 3 ? 2176 : m == 4 ? 2432 : m == 5 ? 3840 : m == 6 ? 5248 : m == 7 ? 5952 : 6656; }
DI size_t matOff(int m) { return m == 0 ? WS_W_EVIN : m == 1 ? WS_W_EVOUT : m == 2 ? WS_W_ODIN : m == 3 ? WS_W_ODOUT : m == 4 ? WS_W_UP : m == 5 ? WS_W_UP + W_UP_STRIDE * 2 : m == 6 ? WS_W_DN : WS_W_DN + W_DN_STRIDE * 2; }
DI const float* matSrc(const P& p, int m, int n, int& ld) {
    if (m == 0) { ld = 3984; int col; if (n < 1920) col = n; else if (n < 1936) col = 3968 + (n - 1920); else if (n < 2048) return nullptr; else col = 1920 + (n - 2048); return p.in[I_EVIN] + col; }
    if (m == 1) { ld = 1024; return p.in[I_EVOUT] + n; }
    if (m == 2) { ld = 3584; return p.in[I_ODIN] + n; }
    if (m == 3) { ld = 1024; return p.in[I_ODOUT] + n; }
    if (m < 6) { ld = 2816; const int l = m - 4, pn = n >> 8, w = n & 255; const size_t lo = (size_t)l * 1024 * 2816; return (w < 128) ? p.in[I_W1] + lo + 128 * pn + w : p.in[I_W3] + lo + 128 * pn + (w - 128); }
    ld = 1024; return p.in[I_W2] + (size_t)(m - 6) * 2816 * 1024 + n;
}
DI void phase_wprep(const P& p, LAS unsigned char* ldsb) {
    LAS float* tile = (LAS float*)ldsb;
    const int tid = mk_tid(), tx = tid & 63, ty = tid >> 6;
    for (int item = blockIdx.x; item < 6656; item += gridDim.x) {
        int m = 0;
#pragma unroll
        for (int q = 1; q < 8; ++q) if (item >= matTile0(q)) m = q;
        const int local = item - matTile0(m), K = matK(m), nK = K >> 6, nb = local / nK, kb = local - nb * nK, n0 = nb * 64, k0 = kb * 64;
        bf16_t* Bt = (bf16_t*)(p.ws + matOff(m));
        int ld; const float* src = matSrc(p, m, n0 + tx, ld);
        __syncthreads();
#pragma unroll
        for (int i = 0; i < 8; ++i) { const int k = k0 + ty + 8 * i; tile[(ty + 8 * i) * 65 + tx] = src ? src[(size_t)k * ld] : 0.f; }
        __syncthreads();
#pragma unroll
        for (int i = 0; i < 8; ++i) { const int nn = ty + 8 * i; Bt[(size_t)(n0 + nn) * K + k0 + tx] = f2bf(tile[tx * 65 + nn]); }
    }
    __syncthreads();
}
DI void phase_modv(const P& p, LAS unsigned char* ldsb) {
    LAS float* sc = (LAS float*)ldsb;
    LAS float* part = sc + 5 * 1024;
    const int tid = mk_tid(), lane = tid & 63, wv = tid >> 6;
    float* MODV = (float*)(p.ws + WS_MODV);
    if ((int)blockIdx.x >= 192) return;
    __syncthreads();
    for (int e = tid; e < 5 * 1024; e += NT) { const int s = e >> 10, k = e & 1023; const float v = (s < 4) ? p.in[I_C][s * 1024 + k] : p.in[I_CCTX][k]; sc[e] = siluf(v); }
    __syncthreads();
    for (int vb = blockIdx.x; vb < 192; vb += gridDim.x) {
        const int l = vb / 96, n = (vb % 96) * 64 + lane;
        const float* W = p.in[I_MODW] + (size_t)l * 1024 * 6144 + (size_t)(128 * wv) * 6144 + n;
        float a0 = 0.f, a1 = 0.f, a2 = 0.f, a3 = 0.f, a4 = 0.f;
#pragma unroll 16
        for (int k = 0; k < 128; ++k) { const float w = W[(size_t)k * 6144]; const int kk = 128 * wv + k; a0 += sc[kk] * w; a1 += sc[1024 + kk] * w; a2 += sc[2048 + kk] * w; a3 += sc[3072 + kk] * w; a4 += sc[4096 + kk] * w; }
        __syncthreads();
        part[(wv * 5 + 0) * 64 + lane] = a0; part[(wv * 5 + 1) * 64 + lane] = a1; part[(wv * 5 + 2) * 64 + lane] = a2; part[(wv * 5 + 3) * 64 + lane] = a3; part[(wv * 5 + 4) * 64 + lane] = a4;
        __syncthreads();
        if (tid < 320) { const int s = tid >> 6; float t = p.in[I_MODB][l * 6144 + (vb % 96) * 64 + lane];
#pragma unroll
            for (int w8 = 0; w8 < 8; ++w8) t += part[(w8 * 5 + s) * 64 + lane];
            MODV[(size_t)l * 5 * 6144 + s * 6144 + (vb % 96) * 64 + lane] = t; }
    }
    __syncthreads();
}

DI void phase_modnorm(const P& p, int layer, int which, const float* hlat, const float* hctx, int nrows, bool permute) {
    const int lane = mk_tid() & 63, wv = mk_tid() >> 6;
    const float* MODV = (const float*)(p.ws + WS_MODV) + (size_t)layer * 5 * 6144;
    const float* g = p.in[which ? I_N2G : I_N1G] + layer * 1024;
    bf16_t* ACT = (bf16_t*)(p.ws + WS_ACT);
    f32x4 gs[4], sh[4]; int sv_have = -1;
    const int rstep = gridDim.x * 8; int r = blockIdx.x * 8 + wv;
    f32x4 v[4], vn[4];
#define MN_SRC(rr) (((rr) >= NLAT) ? hctx + (size_t)((rr) - NLAT) * D : hlat + (size_t)(rr) * D)
    if (r < nrows) { const float* src = MN_SRC(r);
#pragma unroll
        for (int j = 0; j < 4; ++j) v[j] = *(const f32x4*)(src + 4 * lane + 256 * j); }
    for (; r < nrows; r += rstep) {
        const bool isctx = r >= NLAT; const int sv = isctx ? 4 : r / L;
        if (r + rstep < nrows) { const float* src = MN_SRC(r + rstep);
#pragma unroll
            for (int j = 0; j < 4; ++j) vn[j] = *(const f32x4*)(src + 4 * lane + 256 * j); }
        if (sv != sv_have) { sv_have = sv; const float* shift = MODV + sv * 6144 + (which ? 3 : 0) * 1024; const float* scale = shift + 1024;
#pragma unroll
            for (int j = 0; j < 4; ++j) { const int c = 4 * lane + 256 * j; const f32x4 gg = *(const f32x4*)(g + c), sc = *(const f32x4*)(scale + c); gs[j] = gg * (sc + 1.f); sh[j] = *(const f32x4*)(shift + c); } }
        int dr = r;
        if (permute && !isctx) { const int b = r / L, t = r % L; dr = b * L + (t % 64) * 128 + t / 64; }
        float ss = 0.f;
#pragma unroll
        for (int j = 0; j < 4; ++j) ss += (v[j].x * v[j].x + v[j].y * v[j].y) + (v[j].z * v[j].z + v[j].w * v[j].w);
        const float rinv = rsqrtf(wave_sum(ss) * (1.f / D) + 1e-6f);
#pragma unroll
        for (int j = 0; j < 4; ++j) { const int c = 4 * lane + 256 * j; const f32x4 o = v[j] * rinv * gs[j] + sh[j];
            u32x2 w; w.x = pack2(o[0], o[1]); w.y = pack2(o[2], o[3]);
            *(u32x2*)(ACT + (size_t)dr * D + c) = w; v[j] = vn[j]; }
    }
#undef MN_SRC
}
DI void phase_finalnorm(const P& p) {
    const int lane = mk_tid() & 63, wv = mk_tid() >> 6;
    const float* g = p.in[I_FING];
    f32x4 gg[4];
#pragma unroll
    for (int j = 0; j < 4; ++j) gg[j] = *(const f32x4*)(g + 4 * lane + 256 * j);
    const int rstep = gridDim.x * 8; int r = blockIdx.x * 8 + wv;
    f32x4 v[4], vn[4];
    if (r < NLAT) {
#pragma unroll
        for (int j = 0; j < 4; ++j) v[j] = *(const f32x4*)(p.out + (size_t)r * D + 4 * lane + 256 * j); }
    for (; r < NLAT; r += rstep) {
        if (r + rstep < NLAT) {
#pragma unroll
            for (int j = 0; j < 4; ++j) vn[j] = *(const f32x4*)(p.out + (size_t)(r + rstep) * D + 4 * lane + 256 * j); }
        float ss = 0.f;
#pragma unroll
        for (int j = 0; j < 4; ++j) ss += (v[j].x * v[j].x + v[j].y * v[j].y) + (v[j].z * v[j].z + v[j].w * v[j].w);
        const float rinv = rsqrtf(wave_sum(ss) * (1.f / D) + 1e-6f);
#pragma unroll
        for (int j = 0; j < 4; ++j) { *(f32x4*)(p.out + (size_t)r * D + 4 * lane + 256 * j) = v[j] * rinv * gg[j]; v[j] = vn[j]; }
    }
}

struct EpiStore3 {
    static constexpr bool PERM = true, AFTER_DRAIN = false;
    bf16_t* p0; int ld0; int pn1; bf16_t* p1; int ld1; int pn2; bf16_t* p2; int ld2; int pm0;
    DI void operator()(const f32x4 (&acc)[2][2][4][2], const pg8::Unit& u, int wr, int wc, int fr, int fq) const {
        bf16_t* base; int ld, ct;
        if (u.pn >= pn2) { base = p2; ld = ld2; ct = u.pn - pn2; } else if (u.pn >= pn1) { base = p1; ld = ld1; ct = u.pn - pn1; } else { base = p0; ld = ld0; ct = u.pn; }
        const int row0 = (u.pm + pm0) * 256 + wr * 64 + fr, col0 = ct * 256 + wc * 32 + 8 * fq;
#pragma unroll
        for (int ai = 0; ai < 2; ++ai)
#pragma unroll
            for (int m = 0; m < 4; ++m) { bf16_t* rowp = base + (size_t)(row0 + ai * 128 + m * 16) * ld + col0;
#pragma unroll
                for (int bj = 0; bj < 2; ++bj) { const f32x4 v0 = acc[ai][bj][m][0], v1 = acc[ai][bj][m][1];
                    u32x4 w; w.x = pack2(v0[0], v0[1]); w.y = pack2(v0[2], v0[3]); w.z = pack2(v1[0], v1[1]); w.w = pack2(v1[2], v1[3]); *(u32x4*)(rowp + bj * 128) = w; if (MK_RDUP == 20) { asm volatile("" ::: "memory"); *(u32x4*)(rowp + bj * 128) = w; asm volatile("" ::: "memory"); } } }
    }
};
struct EpiResid {
    static constexpr bool PERM = false, AFTER_DRAIN = false;
    const float* hin; float* hout; const float* cin; float* cout; const float* modv_l; int gidx; int pm0;
    DI void operator()(const f32x4 (&acc)[2][2][4][2], const pg8::Unit& u, int wr, int wc, int fr, int fq) const {
        const int pm = u.pm + pm0; const bool isctx = pm >= 128; const int sv = isctx ? 4 : (pm >> 5);
        const float* gate = modv_l + sv * 6144 + gidx * 1024;
        const float* bi = isctx ? cin : hin; float* bo = isctx ? cout : hout;
        const int row0 = (isctx ? (pm - 128) : pm) * 256 + wr * 64 + fr, col0 = u.pn * 256 + wc * 32 + 4 * fq;
        f32x4 gv[2][2];
#pragma unroll
        for (int bj = 0; bj < 2; ++bj)
#pragma unroll
            for (int n = 0; n < 2; ++n) gv[bj][n] = *(const f32x4*)(gate + col0 + bj * 128 + n * 16);
#pragma unroll
        for (int ai = 0; ai < 2; ++ai)
#pragma unroll
            for (int m = 0; m < 4; ++m) { const size_t off = (size_t)(row0 + ai * 128 + m * 16) * D + col0;
#pragma unroll
                for (int bj = 0; bj < 2; ++bj)
#pragma unroll
                    for (int n = 0; n < 2; ++n) { const f32x4 bs = *(const f32x4*)(bi + off + bj * 128 + n * 16); *(f32x4*)(bo + off + bj * 128 + n * 16) = bs + gv[bj][n] * acc[ai][bj][m][n]; } }
    }
};
struct EpiResidN {
    static constexpr bool PERM = false, AFTER_DRAIN = false;
    const float* hin; float* hout; const float* cin; float* cout; const float* modv_l; int gidx;
    bf16_t* act; const float* gsc; float* ssqp; int permute;
    DI void operator()(const f32x4 (&acc)[2][2][4][2], const pg8::Unit& u, int wr, int wc, int fr, int fq) const {
        const bool isctx = u.pm >= 128; const int sv = isctx ? 4 : (u.pm >> 5);
        const float* gate = modv_l + sv * 6144 + gidx * 1024; const float* gs = gsc + sv * 1024;
        const float* bi = isctx ? cin : hin; float* bo = isctx ? cout : hout;
        const int row0 = (isctx ? (u.pm - 128) : u.pm) * 256 + wr * 64 + fr, col0 = u.pn * 256 + wc * 32 + 4 * fq;
        f32x4 gv[2][2], gsv[2][2];
#pragma unroll
        for (int bj = 0; bj < 2; ++bj)
#pragma unroll
            for (int n = 0; n < 2; ++n) { gv[bj][n] = *(const f32x4*)(gate + col0 + bj * 128 + n * 16); gsv[bj][n] = *(const f32x4*)(gs + col0 + bj * 128 + n * 16); }
#pragma unroll
        for (int ai = 0; ai < 2; ++ai)
#pragma unroll
            for (int m = 0; m < 4; ++m) { const int rl = row0 + ai * 128 + m * 16; const size_t off = (size_t)rl * D + col0;
                int arow = u.pm * 256 + wr * 64 + fr + ai * 128 + m * 16;
                if (permute && !isctx) { const int b = arow / L, t = arow % L; arow = b * L + (t % 64) * 128 + t / 64; }
                float ss = 0.f;
#pragma unroll
                for (int bj = 0; bj < 2; ++bj)
#pragma unroll
                    for (int n = 0; n < 2; ++n) { const f32x4 bs = *(const f32x4*)(bi + off + bj * 128 + n * 16); const f32x4 hn = bs + gv[bj][n] * acc[ai][bj][m][n];
                        *(f32x4*)(bo + off + bj * 128 + n * 16) = hn; ss += (hn[0] * hn[0] + hn[1] * hn[1]) + (hn[2] * hn[2] + hn[3] * hn[3]);
                        const f32x4 an = hn * gsv[bj][n]; u32x2 w; w.x = pack2(an[0], an[1]); w.y = pack2(an[2], an[3]); *(u32x2*)(act + (size_t)arow * D + col0 + bj * 128 + n * 16) = w; }
                ss += __shfl_xor(ss, 16); ss += __shfl_xor(ss, 32);
                if (fq == 0) ssqp[(size_t)arow * 16 + u.pn * 4 + wc] = ss; }
    }
};
struct EpiSwiglu {
    static constexpr bool PERM = true, AFTER_DRAIN = false;
    bf16_t* G; int pm0;
    DI void operator()(const f32x4 (&acc)[2][2][4][2], const pg8::Unit& u, int wr, int wc, int fr, int fq) const {
        const int row0 = (u.pm + pm0) * 256 + wr * 64 + fr, col0 = u.pn * 128 + wc * 32 + 8 * fq;
#pragma unroll
        for (int ai = 0; ai < 2; ++ai)
#pragma unroll
            for (int m = 0; m < 4; ++m) { bf16_t* rowp = G + (size_t)(row0 + ai * 128 + m * 16) * DFF + col0; float g[8];
#pragma unroll
                for (int n = 0; n < 2; ++n) { const f32x4 a = acc[ai][0][m][n], b = acc[ai][1][m][n];
#pragma unroll
                    for (int j = 0; j < 4; ++j) g[4 * n + j] = a[j] * frcp(1.f + fexp(-a[j])) * b[j]; }
                u32x4 w; w.x = pack2(g[0], g[1]); w.y = pack2(g[2], g[3]); w.z = pack2(g[4], g[5]); w.w = pack2(g[6], g[7]); *(u32x4*)rowp = w; }
    }
};
template <class Epi> DI void run_gemm(LAS unsigned char* lds, const bf16_t* A, const bf16_t* Bt, int M, int N, int K, const Epi& E) {
    pg8::Gemm g{A, Bt, M, N, K}; pg8::StaticOrder S; S.init(M, N, (int)gridDim.x, (int)blockIdx.x);
    pg8::gemm_phase<Epi, pg8::StaticOrder, false>((PG8_LAS unsigned char*)lds, g, S, E, nullptr);
    __syncthreads();
}


DI void phase_norm_tables(const P& p) {
    const int tid = mk_tid(), lane = tid & 63, wv = tid >> 6;
    const float* MODV = (const float*)(p.ws + WS_MODV); float* GSC = (float*)(p.ws + WS_GSC); float* SHW = GSC + SHW_OFF;
    for (int e = blockIdx.x * NT + tid; e < 3 * 5 * 1024; e += gridDim.x * NT) { const int site = e / 5120, s = (e / 1024) % 5, c = e & 1023;
        const int layer = site ? 1 : 0, scidx = (site == 1) ? 1 : 4; const float g = p.in[(site == 1) ? I_N1G : I_N2G][layer * 1024 + c];
        GSC[e] = g * (1.f + MODV[(size_t)layer * 5 * 6144 + s * 6144 + scidx * 1024 + c]); }
    for (int w = blockIdx.x * 8 + wv; w < 5632 + 3584 + 5632; w += gridDim.x * 8) {
        int site, n; const bf16_t* Bt;
        if (w < 5632) { site = 0; n = w; Bt = (const bf16_t*)(p.ws + WS_W_UP); } else if (w < 5632 + 3584) { site = 1; n = w - 5632; Bt = (const bf16_t*)(p.ws + WS_W_ODIN); } else { site = 2; n = w - 5632 - 3584; Bt = (const bf16_t*)(p.ws + WS_W_UP) + W_UP_STRIDE; }
        const int layer = site ? 1 : 0, shidx = (site == 1) ? 0 : 3;
        const u32x4 w0 = *(const u32x4*)(Bt + (size_t)n * 1024 + 16 * lane), w1 = *(const u32x4*)(Bt + (size_t)n * 1024 + 16 * lane + 8);
        float wf[16];
#pragma unroll
        for (int k = 0; k < 4; ++k) { wf[2 * k] = __uint_as_float(w0[k] << 16); wf[2 * k + 1] = __uint_as_float(w0[k] & 0xffff0000u); wf[8 + 2 * k] = __uint_as_float(w1[k] << 16); wf[8 + 2 * k + 1] = __uint_as_float(w1[k] & 0xffff0000u); }
#pragma unroll
        for (int s = 0; s < 5; ++s) { const float* sh = MODV + (size_t)layer * 5 * 6144 + s * 6144 + shidx * 1024 + 16 * lane; float a = 0.f;
#pragma unroll
            for (int k = 0; k < 16; ++k) a += sh[k] * wf[k];
            a = wave_sum(a);
            if (lane == 0) SHW[(size_t)site * SHW_STRIDE + s * 5632 + n] = a; }
    }
}
DI void phase_rwkv_scan_unit(const P& p, LAS unsigned char* ldsb, const int vb) {
    LAS float* lds = (LAS float*)ldsb;
    LAS float *w2s = lds, *a2s = lds + 4096, *prm = lds + 8192, *TH = prm + 768, *AD = TH + 2048, *R = AD + 2048, *W = R + 2048, *K = W + 2048, *KK = K + 2048, *BV = KK + 2048,
              *V = BV + 2048, *BS = V + 2048, *OUT = BS + 32;
    const int tid = mk_tid(), lane = tid & 63, wv = tid >> 6;
    const bf16_t* RW = (const bf16_t*)(p.ws + WS_COLS) + OFF_RW; const bf16_t* LO = (const bf16_t*)(p.ws + WS_COLS) + OFF_LO; bf16_t* Z = (bf16_t*)(p.ws + WS_Z);
    const int srow = tid >> 3, sg = tid & 7;
    {
        const int d = vb >> 5, b = (vb >> 3) & 3, h = vb & 7;
        __syncthreads();
        for (int e = tid; e < 4096; e += NT) { const int i = e >> 6, c = e & 63; w2s[e] = p.in[I_W2L][(size_t)(d * 64 + i) * 512 + 64 * h + c]; a2s[e] = p.in[I_A2L][(size_t)(d * 64 + i) * 512 + 64 * h + c]; }
        if (tid < 64) { const int j = tid, c = 64 * h + j; const float* mu = p.in[I_MU] + d * 1664;
            prm[j] = mu[c]; prm[64 + j] = mu[512 + c]; prm[128 + j] = mu[1024 + c]; prm[192 + j] = mu[1536 + j]; prm[256 + j] = mu[1600 + j];
            prm[320 + j] = p.in[I_W0][d * 512 + c]; prm[384 + j] = p.in[I_A0][d * 512 + c]; prm[448 + j] = p.in[I_KK][d * 512 + c]; prm[512 + j] = p.in[I_KA][d * 512 + c];
            prm[576 + j] = p.in[I_RK][(d * 8 + h) * 64 + j]; prm[640 + j] = p.in[I_LNW][d * 512 + c]; prm[704 + j] = p.in[I_LNB][d * 512 + c]; }
        __syncthreads();
        float S0 = 0.f, S1 = 0.f, S2 = 0.f, S3 = 0.f, S4 = 0.f, S5 = 0.f, S6 = 0.f, S7 = 0.f;
        for (int n0 = 0; n0 < LT; n0 += 32) {
            float rs[4], ks[4], vs[4];
#pragma unroll
            for (int m = 0; m < 4; ++m) { const int s = wv + 8 * m, n = n0 + s; const bool hp = (n != 0) && (n != LC);
                const size_t row = (size_t)step_row(d, b, n), prow = hp ? (size_t)step_row(d, b, n - 1) : row; const int c = 64 * h + lane;
                const float r0 = bf2f(RW[row * 1536 + c]), k0 = bf2f(RW[row * 1536 + 512 + c]), v0 = bf2f(RW[row * 1536 + 1024 + c]);
                const float r1 = hp ? bf2f(RW[prow * 1536 + c]) : 0.f, k1 = hp ? bf2f(RW[prow * 1536 + 512 + c]) : 0.f, v1 = hp ? bf2f(RW[prow * 1536 + 1024 + c]) : 0.f;
                rs[m] = r0 + prm[lane] * (r1 - r0); ks[m] = k0 + prm[64 + lane] * (k1 - k0); vs[m] = v0 + prm[128 + lane] * (v1 - v0);
                const float wd0 = bf2f(LO[row * 512 + 64 * d + lane]), wd1 = hp ? bf2f(LO[prow * 512 + 64 * d + lane]) : 0.f;
                const float ad0 = bf2f(LO[row * 512 + 128 + 64 * d + lane]), ad1 = hp ? bf2f(LO[prow * 512 + 128 + 64 * d + lane]) : 0.f;
                TH[s * 64 + lane] = tanhf(wd0 + prm[192 + lane] * (wd1 - wd0)); AD[s * 64 + lane] = ad0 + prm[256 + lane] * (ad1 - ad0); }
            __syncthreads();
#pragma unroll
            for (int m = 0; m < 4; ++m) { const int s = wv + 8 * m;
                float xw = prm[320 + lane], xa = prm[384 + lane];
#pragma unroll 8
                for (int i = 0; i < 64; ++i) { xw += TH[s * 64 + i] * w2s[i * 64 + lane]; xa += AD[s * 64 + i] * a2s[i * 64 + lane]; }
                const float elog = 0.6065306597126334f * sigm(xw), dec = expf(-elog), a = sigm(xa);
                const float kkr = ks[m] * prm[448 + lane]; const float ss = wave_sum(kkr * kkr); const float kkn = kkr / fmaxf(sqrtf(ss), 1e-12f);
                const float km = ks[m] * (1.f + (a - 1.f) * prm[512 + lane]);
                const float bs = wave_sum(rs[m] * km * prm[576 + lane]);
                R[s * 64 + lane] = rs[m]; W[s * 64 + lane] = dec; K[s * 64 + lane] = km; KK[s * 64 + lane] = kkn; BV[s * 64 + lane] = kkn * a; V[s * 64 + lane] = vs[m];
                if (lane == 0) BS[s] = bs; }
            __syncthreads();
            for (int s = 0; s < 32; ++s) {
                const LAS f32x4* pq = (const LAS f32x4*)(KK + s * 64 + 8 * sg); const f32x4 q0 = pq[0], q1 = pq[1];
                const LAS f32x4* pw = (const LAS f32x4*)(W + s * 64 + 8 * sg); const f32x4 w0 = pw[0], w1 = pw[1];
                const LAS f32x4* pb = (const LAS f32x4*)(BV + s * 64 + 8 * sg); const f32x4 b0 = pb[0], b1 = pb[1];
                const LAS f32x4* pk = (const LAS f32x4*)(K + s * 64 + 8 * sg); const f32x4 k0 = pk[0], k1 = pk[1];
                const LAS f32x4* pr = (const LAS f32x4*)(R + s * 64 + 8 * sg); const f32x4 r0 = pr[0], r1 = pr[1];
                const float vi = V[s * 64 + srow];
                float sa = S0 * q0.x + S1 * q0.y + S2 * q0.z + S3 * q0.w + S4 * q1.x + S5 * q1.y + S6 * q1.z + S7 * q1.w;
                sa += __shfl_xor(sa, 1); sa += __shfl_xor(sa, 2); sa += __shfl_xor(sa, 4);
                S0 = S0 * w0.x - sa * b0.x + vi * k0.x; S1 = S1 * w0.y - sa * b0.y + vi * k0.y; S2 = S2 * w0.z - sa * b0.z + vi * k0.z; S3 = S3 * w0.w - sa * b0.w + vi * k0.w;
                S4 = S4 * w1.x - sa * b1.x + vi * k1.x; S5 = S5 * w1.y - sa * b1.y + vi * k1.y; S6 = S6 * w1.z - sa * b1.z + vi * k1.z; S7 = S7 * w1.w - sa * b1.w + vi * k1.w;
                float o = S0 * r0.x + S1 * r0.y + S2 * r0.z + S3 * r0.w + S4 * r1.x + S5 * r1.y + S6 * r1.z + S7 * r1.w;
                o += __shfl_xor(o, 1); o += __shfl_xor(o, 2); o += __shfl_xor(o, 4);
                if (sg == 0) OUT[s * 64 + srow] = o;
            }
            __syncthreads();
#pragma unroll
            for (int m = 0; m < 4; ++m) { const int s = wv + 8 * m, n = n0 + s; const size_t row = (size_t)step_row(d, b, n);
                const float o = OUT[s * 64 + lane]; const float mean = wave_sum(o) * (1.f / 64.f); const float dv = o - mean; const float var = wave_sum(dv * dv) * (1.f / 64.f);
                const float z = dv * rsqrtf(var + 64e-5f) * prm[640 + lane] + prm[704 + lane] + BS[s] * V[s * 64 + lane];
                Z[((size_t)d * NALL + row) * 512 + 64 * h + lane] = f2bf(z); }
        }
    }
    __syncthreads();
}
DI void phase_rwkv_post(const P& p, LAS unsigned char* ldsb) {
    LAS float* sg = (LAS float*)ldsb;
    const int tid = mk_tid();
    const bf16_t* LO = (const bf16_t*)(p.ws + WS_COLS) + OFF_LO; const bf16_t* Z = (const bf16_t*)(p.ws + WS_Z); bf16_t* Y = (bf16_t*)(p.ws + WS_COLS);
    const float* g2 = p.in[I_G2];
    for (int vb = blockIdx.x; vb < NALL / 8; vb += gridDim.x) {
        const size_t row0 = (size_t)vb * 8;
        __syncthreads();
        for (int e = tid; e < 1024; e += NT) { const int q = e >> 7, r = e & 127; sg[e] = sigm(bf2f(LO[(row0 + q) * 512 + 256 + r])); }
        __syncthreads();
        float a0 = 0.f, a1 = 0.f, a2 = 0.f, a3 = 0.f, a4 = 0.f, a5 = 0.f, a6 = 0.f, a7 = 0.f;
#pragma unroll 4
        for (int r = 0; r < 128; ++r) { const float g = g2[r * 512 + tid];
            a0 += sg[r] * g; a1 += sg[128 + r] * g; a2 += sg[256 + r] * g; a3 += sg[384 + r] * g; a4 += sg[512 + r] * g; a5 += sg[640 + r] * g; a6 += sg[768 + r] * g; a7 += sg[896 + r] * g; }
#define MK_RP(q, aq) { const size_t rr = row0 + q; const float z = bf2f(Z[rr * 512 + tid]) + bf2f(Z[((size_t)NALL + rr) * 512 + tid]); Y[rr * D + tid] = f2bf(z * aq); }
        MK_RP(0, a0) MK_RP(1, a1) MK_RP(2, a2) MK_RP(3, a3) MK_RP(4, a4) MK_RP(5, a5) MK_RP(6, a6) MK_RP(7, a7)
#undef MK_RP
    }
    __syncthreads();
}
DI void post_headnorm_row(const bf16_t* HB, size_t row, const float* ng, const bf16_t* gsrc, int gate_kind, bf16_t* ydst, int lane) {
    const int c0 = 8 * lane;
    const u32x4 h0 = *(const u32x4*)(HB + row * 512 + c0), h1 = *(const u32x4*)(HB + ((size_t)NALL + row) * 512 + c0), gg = *(const u32x4*)(gsrc + c0);
    float h[8], g[8];
#pragma unroll
    for (int j = 0; j < 4; ++j) { h[2 * j] = __uint_as_float(h0[j] << 16) + __uint_as_float(h1[j] << 16); h[2 * j + 1] = __uint_as_float(h0[j] & 0xffff0000u) + __uint_as_float(h1[j] & 0xffff0000u);
        g[2 * j] = __uint_as_float(gg[j] << 16); g[2 * j + 1] = __uint_as_float(gg[j] & 0xffff0000u); }
    float ss = 0.f;
#pragma unroll
    for (int j = 0; j < 8; ++j) ss += h[j] * h[j];
    ss += __shfl_xor(ss, 1); ss += __shfl_xor(ss, 2); ss += __shfl_xor(ss, 4); ss += __shfl_xor(ss, 8);
    const float rinv = rsqrtf(ss * (1.f / 128.f) + 1e-6f);
    unsigned o[4];
#pragma unroll
    for (int j = 0; j < 4; ++j) { const float y0 = h[2 * j] * rinv * ng[c0 + 2 * j] * (gate_kind ? siluf(g[2 * j]) : sigm(g[2 * j])), y1 = h[2 * j + 1] * rinv * ng[c0 + 2 * j + 1] * (gate_kind ? siluf(g[2 * j + 1]) : sigm(g[2 * j + 1]));
        o[j] = pack2(y0, y1); }
    u32x4 w; w.x = o[0]; w.y = o[1]; w.z = o[2]; w.w = o[3];
    *(u32x4*)(ydst + c0) = w;
}

DI void phase_headnorm_post(const bf16_t* HB, const float* ng, const bf16_t* gbase, int gld, int gate_kind, bf16_t* Y, int ycol0, int nrows, bool permute) {
    const int lane = mk_tid() & 63, wv = mk_tid() >> 6, c0 = 8 * lane;
    float ngv[8];
#pragma unroll
    for (int j = 0; j < 8; ++j) ngv[j] = ng[c0 + j];
    const int rstep = gridDim.x * 8; int r = blockIdx.x * 8 + wv;
    u32x4 h0, h1, gg, n0, n1, ng2;
    if (r < nrows) { h0 = *(const u32x4*)(HB + (size_t)r * 512 + c0); h1 = *(const u32x4*)(HB + ((size_t)NALL + r) * 512 + c0); gg = *(const u32x4*)(gbase + (size_t)r * gld + c0); }
    for (; r < nrows; r += rstep) {
        const int rn = r + rstep;
        if (rn < nrows) { n0 = *(const u32x4*)(HB + (size_t)rn * 512 + c0); n1 = *(const u32x4*)(HB + ((size_t)NALL + rn) * 512 + c0); ng2 = *(const u32x4*)(gbase + (size_t)rn * gld + c0); }
        float h[8], g[8];
#pragma unroll
        for (int j = 0; j < 4; ++j) { h[2 * j] = __uint_as_float(h0[j] << 16) + __uint_as_float(h1[j] << 16); h[2 * j + 1] = __uint_as_float(h0[j] & 0xffff0000u) + __uint_as_float(h1[j] & 0xffff0000u);
            g[2 * j] = __uint_as_float(gg[j] << 16); g[2 * j + 1] = __uint_as_float(gg[j] & 0xffff0000u); }
        float ss = 0.f;
#pragma unroll
        for (int j = 0; j < 8; ++j) ss += h[j] * h[j];
        ss = sum8(ss); ss += dppf<0x140>(ss);
        const float rinv = rsqrtf(ss * (1.f / 128.f) + 1e-6f);
        unsigned o[4];
#pragma unroll
        for (int j = 0; j < 4; ++j) { const float s0 = fsigm(g[2 * j]), s1 = fsigm(g[2 * j + 1]);
            const float y0 = h[2 * j] * rinv * ngv[2 * j] * (gate_kind ? g[2 * j] * s0 : s0), y1 = h[2 * j + 1] * rinv * ngv[2 * j + 1] * (gate_kind ? g[2 * j + 1] * s1 : s1);
            o[j] = pack2(y0, y1); }
        u32x4 w; w.x = o[0]; w.y = o[1]; w.z = o[2]; w.w = o[3];
        const size_t dr = permute ? (size_t)nat_row(r) : (size_t)r;
        *(u32x4*)(Y + dr * D + ycol0 + c0) = w;
        h0 = n0; h1 = n1; gg = ng2;
    }
}
typedef short bf16x8 __attribute__((ext_vector_type(8)));
typedef short s16x4 __attribute__((ext_vector_type(4)));
constexpr int PQ = 136, PS = 72, PV = 56;
constexpr int E_QS = 0, E_KS = E_QS + 64 * PQ * 2, E_VS = E_KS + 64 * PQ * 2, E_PS = E_VS + 64 * PV * 2, E_ST = E_PS + 64 * PS * 2, E_F = E_ST + 48 * PQ * 2, E_END = E_F + 2048;
constexpr size_t WS_Q1 = WS_COLS + (size_t)231 * MiB;
constexpr int NRC = NALL / 64;

DI int chunk_row0(int d, int b, int ci) {
    if (ci < 4) { const int cc = d ? 3 - ci : ci; return NLAT + b * LC + 64 * cc; }
    const int lc = ci - 4, cl = d ? 127 - lc : lc; return b * L + 64 * cl;
}
DI bf16x8 tr_frag(unsigned tile_base, int pitch, int k0, int c0, int r, int q) {
    const unsigned a0 = tile_base + (unsigned)(((k0 + 8 * q + (r >> 2)) * pitch + c0 + 4 * (r & 3)) * 2), a1 = a0 + (unsigned)(4 * pitch * 2);
    s16x4 x, y;
    asm volatile("ds_read_b64_tr_b16 %0, %2\n\tds_read_b64_tr_b16 %1, %3\n\ts_waitcnt lgkmcnt(0)" : "=&v"(x), "=&v"(y) : "v"(a0), "v"(a1) : "memory");
    bf16x8 o; o[0] = x[0]; o[1] = x[1]; o[2] = x[2]; o[3] = x[3]; o[4] = y[0]; o[5] = y[1]; o[6] = y[2]; o[7] = y[3];
    return o;
}

DI unsigned tr_addr(unsigned tile_base, int pitch, int k0, int c0, int r, int q) { return tile_base + (unsigned)(((k0 + 8 * q + (r >> 2)) * pitch + c0 + 4 * (r & 3)) * 2); }
DI bf16x8 tr_join(s16x4 x, s16x4 y) { bf16x8 o; o[0] = x[0]; o[1] = x[1]; o[2] = x[2]; o[3] = x[3]; o[4] = y[0]; o[5] = y[1]; o[6] = y[2]; o[7] = y[3]; return o; }
DI void tr_frag2(bf16x8& f0, bf16x8& f1, unsigned a0, unsigned h0, unsigned a1, unsigned h1) {
    s16x4 x0, y0, x1, y1; const unsigned b0 = a0 + h0, b1 = a1 + h1;
    asm volatile("ds_read_b64_tr_b16 %0, %4\n\tds_read_b64_tr_b16 %1, %5\n\tds_read_b64_tr_b16 %2, %6\n\tds_read_b64_tr_b16 %3, %7\n\ts_waitcnt lgkmcnt(0)"
                 : "=&v"(x0), "=&v"(y0), "=&v"(x1), "=&v"(y1) : "v"(a0), "v"(b0), "v"(a1), "v"(b1) : "memory");
    f0 = tr_join(x0, y0); f1 = tr_join(x1, y1);
}
DI void tr_frag3(bf16x8& f0, bf16x8& f1, bf16x8& f2, unsigned a0, unsigned h0, unsigned a1, unsigned h1, unsigned a2, unsigned h2) {
    s16x4 x0, y0, x1, y1, x2, y2; const unsigned b0 = a0 + h0, b1 = a1 + h1, b2 = a2 + h2;
    asm volatile("ds_read_b64_tr_b16 %0, %6\n\tds_read_b64_tr_b16 %1, %7\n\tds_read_b64_tr_b16 %2, %8\n\tds_read_b64_tr_b16 %3, %9\n\tds_read_b64_tr_b16 %4, %10\n\tds_read_b64_tr_b16 %5, %11\n\ts_waitcnt lgkmcnt(0)"
                 : "=&v"(x0), "=&v"(y0), "=&v"(x1), "=&v"(y1), "=&v"(x2), "=&v"(y2) : "v"(a0), "v"(b0), "v"(a1), "v"(b1), "v"(a2), "v"(b2) : "memory");
    f0 = tr_join(x0, y0); f1 = tr_join(x1, y1); f2 = tr_join(x2, y2);
}
DI void tr_frag4(bf16x8& f0, bf16x8& f1, bf16x8& f2, bf16x8& f3, unsigned a0, unsigned h0, unsigned a1, unsigned h1, unsigned a2, unsigned h2, unsigned a3, unsigned h3) {
    s16x4 x0, y0, x1, y1, x2, y2, x3, y3; const unsigned b0 = a0 + h0, b1 = a1 + h1, b2 = a2 + h2, b3 = a3 + h3;
    asm volatile("ds_read_b64_tr_b16 %0, %8\n\tds_read_b64_tr_b16 %1, %9\n\tds_read_b64_tr_b16 %2, %10\n\tds_read_b64_tr_b16 %3, %11\n\tds_read_b64_tr_b16 %4, %12\n\tds_read_b64_tr_b16 %5, %13\n\tds_read_b64_tr_b16 %6, %14\n\tds_read_b64_tr_b16 %7, %15\n\ts_waitcnt lgkmcnt(0)"
                 : "=&v"(x0), "=&v"(y0), "=&v"(x1), "=&v"(y1), "=&v"(x2), "=&v"(y2), "=&v"(x3), "=&v"(y3) : "v"(a0), "v"(b0), "v"(a1), "v"(b1), "v"(a2), "v"(b2), "v"(a3), "v"(b3) : "memory");
    f0 = tr_join(x0, y0); f1 = tr_join(x1, y1); f2 = tr_join(x2, y2); f3 = tr_join(x3, y3);
}
DI void tr_frag5(bf16x8& f0, bf16x8& f1, bf16x8& f2, bf16x8& f3, bf16x8& f4, unsigned a0, unsigned h0, unsigned a1, unsigned h1, unsigned a2, unsigned h2, unsigned a3, unsigned h3, unsigned a4, unsigned h4) {
    s16x4 x0, y0, x1, y1, x2, y2, x3, y3, x4, y4; const unsigned b0 = a0 + h0, b1 = a1 + h1, b2 = a2 + h2, b3 = a3 + h3, b4 = a4 + h4;
    asm volatile("ds_read_b64_tr_b16 %0, %10\n\tds_read_b64_tr_b16 %1, %11\n\tds_read_b64_tr_b16 %2, %12\n\tds_read_b64_tr_b16 %3, %13\n\tds_read_b64_tr_b16 %4, %14\n\tds_read_b64_tr_b16 %5, %15\n\tds_read_b64_tr_b16 %6, %16\n\tds_read_b64_tr_b16 %7, %17\n\tds_read_b64_tr_b16 %8, %18\n\tds_read_b64_tr_b16 %9, %19\n\ts_waitcnt lgkmcnt(0)"
                 : "=&v"(x0), "=&v"(y0), "=&v"(x1), "=&v"(y1), "=&v"(x2), "=&v"(y2), "=&v"(x3), "=&v"(y3), "=&v"(x4), "=&v"(y4) : "v"(a0), "v"(b0), "v"(a1), "v"(b1), "v"(a2), "v"(b2), "v"(a3), "v"(b3), "v"(a4), "v"(b4) : "memory");
    f0 = tr_join(x0, y0); f1 = tr_join(x1, y1); f2 = tr_join(x2, y2); f3 = tr_join(x3, y3); f4 = tr_join(x4, y4);
}

#define GLA_PREFETCH(ci_) do { const int row0_ = chunk_row0(d, b, (ci_)); \
    _Pragma("unroll") for (int i = 0; i < 2; ++i) { const size_t row_ = (size_t)(row0_ + prow0 + 32 * i); \
        rq[i] = *(const u32x4*)(Qg + row_ * ldq + 8 * ppc); rk[i] = *(const u32x4*)(Kg + row_ * ldk + 8 * ppc); } \
    if (tid < 256) rv = *(const u32x4*)(Vg + (size_t)(row0_ + vrow) * ldv + 8 * vpc); \
    if (MODE != 0) rlam = *(const f32x4*)(LAM + ((size_t)d * NRC + (row0_ >> 6)) * 512 + 128 * hd + 16 * wv + 4 * q); } while (0)

DI float flog(float x) { return __builtin_amdgcn_logf(x) * 0.6931471805599453f; }
#define GLA_GATE_LOAD(ci_) do { const size_t row_ = (size_t)(chunk_row0(d, b, (ci_)) + (d ? 63 - lane : lane)); gi = bf2f(LO[row_ * 512 + 384 + 4 * d + hd]); gf = bf2f(LO[row_ * 512 + 392 + 4 * d + hd]); } while (0)
#define GLA_GATE_COMPUTE(buf_) do { const float li_ = gi + bi, x_ = gf + bfv; float v_ = scan16(-flog(1.f + fexp(-x_))); \
    const float t0_ = __int_as_float(__builtin_amdgcn_readlane(__float_as_int(v_), 15)), t1_ = __int_as_float(__builtin_amdgcn_readlane(__float_as_int(v_), 31)), t2_ = __int_as_float(__builtin_amdgcn_readlane(__float_as_int(v_), 47)); \
    v_ += (q >= 1 ? t0_ : 0.f) + (q >= 2 ? t1_ : 0.f) + (q >= 3 ? t2_ : 0.f); const int rc_ = d ? 63 - lane : lane; LAS float* F_ = Fs + (buf_) * 132; \
    F_[rc_] = fexp(v_) * 0.08838834764831845f; F_[64 + rc_] = fexp(li_ - v_); if (lane == 63) F_[128] = fexp(v_); } while (0)
template <int MODE> DI void gla_unit(const P& p, LAS unsigned char* lds, int unit) {
    constexpr int NDV = MODE == 0 ? 3 : 2;
    const int tid = mk_tid(), lane = tid & 63, wv = __builtin_amdgcn_readfirstlane(tid >> 6), r = lane & 15, q = lane >> 4;
    const int d = unit >> 6, b = (unit >> 4) & 3, hd = (unit >> 2) & 3, sl = unit & 3;
    const bf16_t* COLS = (const bf16_t*)(p.ws + WS_COLS);
    const bf16_t *Qg, *Kg, *Vg; int ldq, ldk, ldv;
    if (MODE == 0) { const bf16_t* ML = COLS + OFF_ML; Qg = ML + 128 * hd; Kg = ML + 512 + 128 * hd; Vg = ML + 1024 + 128 * hd + 32 * sl; ldq = ldk = ldv = 2048; }
    else { Qg = d ? (const bf16_t*)(p.ws + WS_Q1) + 128 * hd : COLS + 128 * hd; ldq = d ? 512 : 3584; Kg = COLS + 512 + 512 * d + 128 * hd; ldk = 3584; Vg = COLS + 1536 + 128 * hd + 32 * sl; ldv = 3584; }
    const bf16_t* LO = COLS + OFF_LO;
    const float* LAM = (const float*)(p.ws + WS_LAM);
    bf16_t* HB = (bf16_t*)(p.ws + WS_ACT);
    LAS bf16_t* Qs = (LAS bf16_t*)(lds + E_QS); LAS bf16_t* Ks = (LAS bf16_t*)(lds + E_KS); LAS bf16_t* Vs = (LAS bf16_t*)(lds + E_VS);
    LAS bf16_t* Ps = (LAS bf16_t*)(lds + E_PS); LAS bf16_t* STs = (LAS bf16_t*)(lds + E_ST); LAS float* Fs = (LAS float*)(lds + E_F);
    const unsigned ks_base = (unsigned)(size_t)Ks, vs_base = (unsigned)(size_t)Vs;
    float bi = 0.f, bfv = 0.f;
    if (MODE == 0) { bi = p.in[I_MBI][d * 4 + hd]; bfv = p.in[I_MBF][d * 4 + hd]; }
    __syncthreads();
    for (int e = tid; e < 48 * PQ / 2; e += NT) ((LAS unsigned*)STs)[e] = 0u;
    for (int e = tid; e < 64 * PV / 2; e += NT) ((LAS unsigned*)Vs)[e] = 0u;
    __syncthreads();
    f32x4 Sacc[NDV];
#pragma unroll
    for (int n = 0; n < NDV; ++n) Sacc[n] = (f32x4){0.f, 0.f, 0.f, 0.f};
    u32x4 rq[2], rk[2], rv = (u32x4){0u, 0u, 0u, 0u}; float gi = 0.f, gf = 0.f; f32x4 rlam = (f32x4){1.f, 1.f, 1.f, 1.f};
    const int prow0 = tid >> 4, ppc = tid & 15;
    const int vrow = tid >> 2, vpc = tid & 3;
    GLA_PREFETCH(0);
    if (MODE == 0) { if (tid < 64) { GLA_GATE_LOAD(0); GLA_GATE_COMPUTE(0); GLA_GATE_LOAD(1); } __syncthreads(); }
    for (int ci = 0; ci < 132; ++ci) {
        const int row0 = chunk_row0(d, b, ci);
        unsigned oz = 0u; asm volatile("" : "+v"(oz));
        const unsigned ks_b = ks_base + oz, vs_b = vs_base + oz;
        f32x4 lamv = rlam;
        const LAS float* Fc = Fs + (ci & 1) * 132;
#pragma unroll
        for (int i = 0; i < 2; ++i) { const int row = prow0 + 32 * i; *(LAS u32x4*)(Qs + row * PQ + 8 * ppc) = rq[i]; *(LAS u32x4*)(Ks + row * PQ + 8 * ppc) = rk[i]; }
        if (tid < 256) {
            if (MODE == 0) { const float w = Fc[64 + vrow]; u32x4 o;
#pragma unroll
                for (int e = 0; e < 4; ++e) o[e] = pack2(__uint_as_float(rv[e] << 16) * w, __uint_as_float(rv[e] & 0xffff0000u) * w);
                *(LAS u32x4*)(Vs + vrow * PV + 8 * vpc) = o;
                if (vpc == 0) Vs[vrow * PV + 32] = f2bf(w); }
            else *(LAS u32x4*)(Vs + vrow * PV + 8 * vpc) = rv;
        }
        __syncthreads();
        if (ci + 1 < 132) GLA_PREFETCH(ci + 1);
        if (MODE == 0) { const float l = Fc[128]; lamv = (f32x4){l, l, l, l};
            if (tid < 64 && ci + 1 < 132) { GLA_GATE_COMPUTE((ci + 1) & 1); if (ci + 2 < 132) GLA_GATE_LOAD(ci + 2); } }
        {
            const int tt = wv & 3, sh = wv >> 2;
            f32x4 pacc[2] = {(f32x4){0.f, 0.f, 0.f, 0.f}, (f32x4){0.f, 0.f, 0.f, 0.f}};
#pragma unroll
            for (int kk = 0; kk < 4; ++kk) { const bf16x8 bq = *(const LAS bf16x8*)(Qs + (16 * tt + r) * PQ + 32 * kk + 8 * q);
#pragma unroll
                for (int i = 0; i < 2; ++i) { const bf16x8 a = *(const LAS bf16x8*)(Ks + (16 * (2 * sh + i) + r) * PQ + 32 * kk + 8 * q); pacc[i] = __builtin_amdgcn_mfma_f32_16x16x32_bf16(a, bq, pacc[i], 0, 0, 0); } }
            const int t = 16 * tt + r;
#pragma unroll
            for (int i = 0; i < 2; ++i) { const int s0 = 16 * (2 * sh + i) + 4 * q; float v[4];
#pragma unroll
                for (int j = 0; j < 4; ++j) { const int s = s0 + j; const bool ok = d ? (s >= t) : (s <= t); v[j] = ok ? pacc[i][j] : 0.f; }
                u32x2 w; w.x = pack2(v[0], v[1]); w.y = pack2(v[2], v[3]); *(LAS u32x2*)(Ps + t * PS + s0) = w; }
        }
        bf16x8 vfr[2][3];
#pragma unroll
        for (int kk = 0; kk < 2; ++kk) { bf16x8 a;
            if (NDV == 3) tr_frag4(a, vfr[kk][0], vfr[kk][1], vfr[kk][2], tr_addr(ks_b, PQ, 32 * kk, 16 * wv, r, q), 8u * PQ, tr_addr(vs_b, PV, 32 * kk, 0, r, q), 8u * PV, tr_addr(vs_b, PV, 32 * kk, 16, r, q), 8u * PV, tr_addr(vs_b, PV, 32 * kk, 32, r, q), 8u * PV);
            else { tr_frag3(a, vfr[kk][0], vfr[kk][1], tr_addr(ks_b, PQ, 32 * kk, 16 * wv, r, q), 8u * PQ, tr_addr(vs_b, PV, 32 * kk, 0, r, q), 8u * PV, tr_addr(vs_b, PV, 32 * kk, 16, r, q), 8u * PV); vfr[kk][2] = vfr[kk][1]; }
#pragma unroll
            for (int n = 0; n < NDV; ++n) Sacc[n] = __builtin_amdgcn_mfma_f32_16x16x32_bf16(a, vfr[kk][n], Sacc[n], 0, 0, 0); }
        __syncthreads();
        {
            const int tt = wv & 3, nA = wv >> 2;
            f32x4 oacc = (f32x4){0.f, 0.f, 0.f, 0.f}, dacc = (f32x4){0.f, 0.f, 0.f, 0.f};
#pragma unroll
            for (int kk = 0; kk < 2; ++kk) { const bf16x8 bp = *(const LAS bf16x8*)(Ps + (16 * tt + r) * PS + 32 * kk + 8 * q);
                const bf16x8 a = nA ? vfr[kk][1] : vfr[kk][0]; oacc = __builtin_amdgcn_mfma_f32_16x16x32_bf16(a, bp, oacc, 0, 0, 0);
                if (MODE == 0) dacc = __builtin_amdgcn_mfma_f32_16x16x32_bf16(vfr[kk][2], bp, dacc, 0, 0, 0); }
#pragma unroll
            for (int kk = 0; kk < 4; ++kk) { const bf16x8 bq = *(const LAS bf16x8*)(Qs + (16 * tt + r) * PQ + 32 * kk + 8 * q);
                const bf16x8 a = *(const LAS bf16x8*)(STs + (16 * nA + r) * PQ + 32 * kk + 8 * q); oacc = __builtin_amdgcn_mfma_f32_16x16x32_bf16(a, bq, oacc, 0, 0, 0);
                if (MODE == 0) { const bf16x8 a2 = *(const LAS bf16x8*)(STs + (32 + r) * PQ + 32 * kk + 8 * q); dacc = __builtin_amdgcn_mfma_f32_16x16x32_bf16(a2, bq, dacc, 0, 0, 0); } }
            const int t = 16 * tt + r;
            float o0 = oacc[0], o1 = oacc[1], o2 = oacc[2], o3 = oacc[3];
            if (MODE == 0) { const float rs = Fc[t]; const float den = __shfl(dacc[0], r) * rs; const float inv = rs / fmaxf(fabsf(den), 1.f); o0 *= inv; o1 *= inv; o2 *= inv; o3 *= inv; }
            u32x2 w; w.x = pack2(o0, o1); w.y = pack2(o2, o3);
            *(u32x2*)(HB + ((size_t)d * NALL + row0 + t) * 512 + 128 * hd + 32 * sl + 16 * nA + 4 * q) = w;
        }
        __syncthreads();
#pragma unroll
        for (int n = 0; n < NDV; ++n) { Sacc[n] = Sacc[n] * lamv; u32x2 w; w.x = pack2(Sacc[n][0], Sacc[n][1]); w.y = pack2(Sacc[n][2], Sacc[n][3]); *(LAS u32x2*)(STs + (16 * n + r) * PQ + 16 * wv + 4 * q) = w; }
    }
    __syncthreads();
}

DI void phase_hgrn_prep(const P& p, LAS unsigned char* ldsb) {
    LAS float* tot = (LAS float*)ldsb;
    const int tid = mk_tid(), ch = tid & 127, qt = tid >> 7;
    bf16_t* C1 = (bf16_t*)(p.ws + WS_COLS); bf16_t* Q1 = (bf16_t*)(p.ws + WS_Q1); float* LAM = (float*)(p.ws + WS_LAM);
    for (int vb = blockIdx.x; vb < NRC * 4; vb += gridDim.x) {
        const int rc = vb >> 2, hd = vb & 3, c = 128 * hd + ch; const size_t rbase = (size_t)rc * 64 + 16 * qt;
        const float lb = sigm(p.in[I_HLB][512 + c] - p.in[I_HLB][c]);
        float qv[16], l0[16], l1[16], k0[16], k1[16];
#pragma unroll
        for (int i = 0; i < 16; ++i) { const bf16_t* base = C1 + (rbase + i) * 3584;
            qv[i] = siluf(bf2f(base[c])); const float s0 = sigm(bf2f(base[512 + c])), s1 = sigm(bf2f(base[1024 + c]));
            l0[i] = logf(lb + (1.f - lb) * s0); l1[i] = logf(lb + (1.f - lb) * s1); k0[i] = (1.f - lb) * (1.f - s0); k1[i] = (1.f - lb) * (1.f - s1); }
#pragma unroll
        for (int i = 1; i < 16; ++i) l0[i] += l0[i - 1];
#pragma unroll
        for (int i = 14; i >= 0; --i) l1[i] += l1[i + 1];
        __syncthreads();
        tot[qt * 128 + ch] = l0[15]; tot[512 + qt * 128 + ch] = l1[0];
        __syncthreads();
        float off0 = 0.f, off1 = 0.f, t0 = 0.f, t1 = 0.f;
#pragma unroll
        for (int j = 0; j < 4; ++j) { const float a = tot[j * 128 + ch], bb = tot[512 + j * 128 + ch]; t0 += a; t1 += bb; if (j < qt) off0 += a; if (j > qt) off1 += bb; }
#pragma unroll
        for (int i = 0; i < 16; ++i) { bf16_t* base = C1 + (rbase + i) * 3584; const float c0 = l0[i] + off0, c1 = l1[i] + off1;
            base[c] = f2bf(qv[i] * expf(c0)); base[512 + c] = f2bf(k0[i] * expf(-c0)); base[1024 + c] = f2bf(k1[i] * expf(-c1)); Q1[(rbase + i) * 512 + c] = f2bf(qv[i] * expf(c1)); }
        if (qt == 0) { LAM[((size_t)rc) * 512 + c] = expf(t0); LAM[((size_t)NRC + rc) * 512 + c] = expf(t1); }
    }
    __syncthreads();
}
DI void phase_hgrn_prep2(const P& p, LAS unsigned char* ldsb) {
    LAS float* tot = (LAS float*)ldsb;
    const int tid = mk_tid(), cp = tid & 63, qt = (tid >> 6) & 3, rs = tid >> 8, c0 = 8 * cp;
    bf16_t* C1 = (bf16_t*)(p.ws + WS_COLS); bf16_t* Q1 = (bf16_t*)(p.ws + WS_Q1); float* LAM = (float*)(p.ws + WS_LAM);
    float lb[8], omlb[8];
#pragma unroll
    for (int k = 0; k < 8; ++k) { lb[k] = fsigm(p.in[I_HLB][512 + c0 + k] - p.in[I_HLB][c0 + k]); omlb[k] = 1.f - lb[k]; }
    for (int vb = blockIdx.x; vb < NRC / 2; vb += gridDim.x) {
        const int rc = 2 * vb + rs; const size_t rbase = (size_t)rc * 64 + 16 * qt;
        float s0[8], s1[8];
#pragma unroll
        for (int k = 0; k < 8; ++k) { s0[k] = 0.f; s1[k] = 0.f; }
#pragma unroll 4
        for (int i = 0; i < 16; ++i) { const bf16_t* base = C1 + (rbase + i) * 3584; const u32x4 f0 = *(const u32x4*)(base + 512 + c0), f1 = *(const u32x4*)(base + 1024 + c0);
#pragma unroll
            for (int k = 0; k < 4; ++k) { s0[2 * k] += flog(lb[2 * k] + omlb[2 * k] * fsigm(__uint_as_float(f0[k] << 16))); s0[2 * k + 1] += flog(lb[2 * k + 1] + omlb[2 * k + 1] * fsigm(__uint_as_float(f0[k] & 0xffff0000u)));
                s1[2 * k] += flog(lb[2 * k] + omlb[2 * k] * fsigm(__uint_as_float(f1[k] << 16))); s1[2 * k + 1] += flog(lb[2 * k + 1] + omlb[2 * k + 1] * fsigm(__uint_as_float(f1[k] & 0xffff0000u))); } }
        __syncthreads();
#pragma unroll
        for (int k = 0; k < 8; k += 4) { *(LAS f32x4*)(tot + ((rs * 2 + 0) * 4 + qt) * 512 + c0 + k) = (f32x4){s0[k], s0[k + 1], s0[k + 2], s0[k + 3]}; *(LAS f32x4*)(tot + ((rs * 2 + 1) * 4 + qt) * 512 + c0 + k) = (f32x4){s1[k], s1[k + 1], s1[k + 2], s1[k + 3]}; }
        __syncthreads();
        float run0[8], run1[8], t0[8], t1[8];
#pragma unroll
        for (int k = 0; k < 8; ++k) { run0[k] = 0.f; run1[k] = 0.f; t0[k] = 0.f; t1[k] = 0.f; }
#pragma unroll
        for (int j = 0; j < 4; ++j)
#pragma unroll
            for (int k = 0; k < 8; ++k) { const float a = tot[((rs * 2 + 0) * 4 + j) * 512 + c0 + k], bb = tot[((rs * 2 + 1) * 4 + j) * 512 + c0 + k]; t0[k] += a; t1[k] += bb; if (j < qt) run0[k] += a; if (j >= qt) run1[k] += bb; }
        if (qt == 0) {
#pragma unroll
            for (int k = 0; k < 8; k += 4) { *(f32x4*)(LAM + (size_t)rc * 512 + c0 + k) = (f32x4){fexp(t0[k]), fexp(t0[k + 1]), fexp(t0[k + 2]), fexp(t0[k + 3])};
                *(f32x4*)(LAM + ((size_t)NRC + rc) * 512 + c0 + k) = (f32x4){fexp(t1[k]), fexp(t1[k + 1]), fexp(t1[k + 2]), fexp(t1[k + 3])}; } }
#pragma unroll 2
        for (int i = 0; i < 16; ++i) { bf16_t* base = C1 + (rbase + i) * 3584; const u32x4 qv = *(const u32x4*)(base + c0), f0 = *(const u32x4*)(base + 512 + c0), f1 = *(const u32x4*)(base + 1024 + c0);
            float oq0[8], ok0[8], ok1[8], oq1[8];
#pragma unroll
            for (int k = 0; k < 8; ++k) { const unsigned wq = qv[k >> 1], w0 = f0[k >> 1], w1 = f1[k >> 1];
                const float qx = (k & 1) ? __uint_as_float(wq & 0xffff0000u) : __uint_as_float(wq << 16), x0 = (k & 1) ? __uint_as_float(w0 & 0xffff0000u) : __uint_as_float(w0 << 16), x1 = (k & 1) ? __uint_as_float(w1 & 0xffff0000u) : __uint_as_float(w1 << 16);
                const float sq = qx * fsigm(qx), sg0 = fsigm(x0), sg1 = fsigm(x1);
                const float l0 = flog(lb[k] + omlb[k] * sg0), l1 = flog(lb[k] + omlb[k] * sg1);
                run0[k] += l0;
                const float cb = run1[k];
                run1[k] -= l1;
                const float e0 = fexp(run0[k]), e1 = fexp(cb);
                oq0[k] = sq * e0; ok0[k] = omlb[k] * (1.f - sg0) * frcp(e0); ok1[k] = omlb[k] * (1.f - sg1) * frcp(e1); oq1[k] = sq * e1; }
            u32x4 w; w.x = pack2(oq0[0], oq0[1]); w.y = pack2(oq0[2], oq0[3]); w.z = pack2(oq0[4], oq0[5]); w.w = pack2(oq0[6], oq0[7]); *(u32x4*)(base + c0) = w;
            w.x = pack2(ok0[0], ok0[1]); w.y = pack2(ok0[2], ok0[3]); w.z = pack2(ok0[4], ok0[5]); w.w = pack2(ok0[6], ok0[7]); *(u32x4*)(base + 512 + c0) = w;
            w.x = pack2(ok1[0], ok1[1]); w.y = pack2(ok1[2], ok1[3]); w.z = pack2(ok1[4], ok1[5]); w.w = pack2(ok1[6], ok1[7]); *(u32x4*)(base + 1024 + c0) = w;
            w.x = pack2(oq1[0], oq1[1]); w.y = pack2(oq1[2], oq1[3]); w.z = pack2(oq1[4], oq1[5]); w.w = pack2(oq1[6], oq1[7]); *(u32x4*)(Q1 + (rbase + i) * 512 + c0) = w; }
    }
    __syncthreads();
}
constexpr int XBP = 68, M_XB = 0, M_XCS = M_XB + 67 * XBP * 4, M_XCF = M_XCS + 64 * 72 * 2, M_W = M_XCF + 64 * 64 * 4, M_AU = M_W + 4 * 64 * 72 * 2, M_SEG = M_AU + 4 * 64 * 65 * 4, M_PRM = M_SEG + 4 * 8 * 64 * 4,
              M_CAR = M_PRM + 11 * 64 * 4, M_END = M_CAR + 2 * 64 * 4;
static_assert(M_END <= LDS_BYTES - 16, "lru LDS map");
DI float nexpm1_small(float x) { const float ser = -x * (1.f + x * 0.5f * (1.f + x * (1.f / 3.f) * (1.f + x * 0.25f * (1.f + x * 0.2f)))); return (x > -0.25f) ? ser : 1.f - fexp(x); }
DI int lru_rc_at(int d, int b, int s) { if (s < 4) return 512 + 4 * b + (d ? 3 - s : s); const int lc = s - 4; return 128 * b + (d ? 127 - lc : lc); }
template <int PASS> DI void lru_pass(const P& p, LAS unsigned char* lds, const int lb, const int nlb) {
    const int tid = mk_tid(), lane = tid & 63, wv = __builtin_amdgcn_readfirstlane(tid >> 6), r = lane & 15, q = lane >> 4;
    const int hb = lb & 7;
    const bf16_t* C1 = (const bf16_t*)(p.ws + WS_COLS); bf16_t* Y = (bf16_t*)(p.ws + WS_Z); float* LSUM = (float*)(p.ws + WS_LSUM);
    LAS float* XB = (LAS float*)(lds + M_XB); LAS bf16_t* XCs = (LAS bf16_t*)(lds + M_XCS); LAS float* XCf = (LAS float*)(lds + M_XCF); LAS bf16_t* Wt = (LAS bf16_t*)(lds + M_W);
    LAS float* AU = (LAS float*)(lds + M_AU);
    LAS float* SEG = (LAS float*)(lds + M_SEG);
    LAS float* prm = (LAS float*)(lds + M_PRM);
    LAS float* CAR = (LAS float*)(lds + M_CAR);
    __syncthreads();
    for (int e = tid; e < 4 * 4096; e += NT) { const int g = e >> 12, i = (e >> 6) & 63, j = e & 63, d = g >> 1; const size_t o = ((size_t)(d * 8 + hb) * 64 + i) * 64 + j;
        Wt[(g * 64 + j) * 72 + i] = f2bf((g & 1) ? p.in[I_WI][o] : p.in[I_WA][o]); }
    if (tid < 64) { const int ch = 64 * hb + tid;
        prm[tid] = p.in[I_CONVW][ch]; prm[64 + tid] = p.in[I_CONVW][512 + ch]; prm[128 + tid] = p.in[I_CONVW][1024 + ch]; prm[192 + tid] = p.in[I_CONVW][1536 + ch]; prm[256 + tid] = p.in[I_CONVB][ch];
        prm[320 + tid] = p.in[I_BA][ch]; prm[384 + tid] = p.in[I_BA][512 + ch]; prm[448 + tid] = p.in[I_BI][ch]; prm[512 + tid] = p.in[I_BI][512 + ch];
        prm[576 + tid] = log1pf(expf(-p.in[I_LAM][ch])); prm[640 + tid] = log1pf(expf(-p.in[I_LAM][512 + ch])); }
    const int nrc = (PASS == 1) ? NRC : 512;
    const int cpr = (PASS == 3) ? 512 / (nlb >> 3) : 1, rc_lo = (PASS == 3) ? (lb >> 3) * cpr : (lb >> 3), rstep = (PASS == 3) ? 1 : (nlb >> 3), rc_hi = (PASS == 3) ? rc_lo + cpr : nrc;
    float* LCAR = (float*)(p.ws + WS_LCAR);
    if (PASS == 3 && tid < 128) { const int d = tid >> 6, j = tid & 63, ch = 64 * hb + j, b = rc_lo >> 7, cl0 = rc_lo & 127;
        const int p_lo = d ? 4 + 127 - (cl0 + cpr - 1) : 4 + cl0;
        const float* S = LSUM + (size_t)d * NRC * 1024 + 2 * ch; float hcar = 0.f;
#pragma unroll 8
        for (int s = 0; s < p_lo; ++s) { const float* e2 = S + (size_t)lru_rc_at(d, b, s) * 1024; hcar = e2[0] * hcar + e2[1]; }
        for (int s = p_lo; s < p_lo + cpr; ++s) { const int rcs = lru_rc_at(d, b, s); LCAR[((size_t)d * NRC + rcs) * 512 + ch] = hcar; const float* e2 = S + (size_t)rcs * 1024; hcar = e2[0] * hcar + e2[1]; }
    }
    u32x4 px[2];
#define LRU_PREFETCH(rc_) do { const int rc__ = (rc_); const int row0_ = rc__ * 64; const int seg_lo_ = (rc__ >= 512) ? NLAT + ((rc__ - 512) >> 2) * LC : (rc__ >> 7) * L, seg_hi_ = seg_lo_ + ((rc__ >= 512) ? LC : L); \
    _Pragma("unroll") for (int i = 0; i < 2; ++i) { const int e = tid + 512 * i, rr = e >> 3, pc = e & 7, grow = row0_ - 2 + rr; px[i] = (u32x4){0u, 0u, 0u, 0u}; \
        if (e < 67 * 8 && grow >= seg_lo_ && grow < seg_hi_) px[i] = *(const u32x4*)(C1 + (size_t)grow * C1LD + 2560 + 64 * hb + 8 * pc); } } while (0)
    int rc = rc_lo;
    if (rc < rc_hi) LRU_PREFETCH(rc);
    for (; rc < rc_hi; rc += rstep) {
        const int row0 = rc * 64;
        const int sg = tid >> 6, j = lane, ch = 64 * hb + j;
        float cin = 0.f;
        if (PASS == 3 && tid < 128) cin = LCAR[((size_t)(tid >> 6) * NRC + rc) * 512 + ch];
        float gbv[8];
        if (PASS == 3) {
#pragma unroll
            for (int k = 0; k < 8; ++k) gbv[k] = bf2f(C1[(size_t)(row0 + 8 * sg + k) * C1LD + 3072 + ch]); }
#pragma unroll
        for (int i = 0; i < 2; ++i) { const int e = tid + 512 * i; if (e < 67 * 8) { const int rr = e >> 3, pc = e & 7; const u32x4 v = px[i];
            f32x4 lo, hi; lo[0] = __uint_as_float(v[0] << 16); lo[1] = __uint_as_float(v[0] & 0xffff0000u); lo[2] = __uint_as_float(v[1] << 16); lo[3] = __uint_as_float(v[1] & 0xffff0000u);
            hi[0] = __uint_as_float(v[2] << 16); hi[1] = __uint_as_float(v[2] & 0xffff0000u); hi[2] = __uint_as_float(v[3] << 16); hi[3] = __uint_as_float(v[3] & 0xffff0000u);
            *(LAS f32x4*)(XB + rr * XBP + 8 * pc) = lo; *(LAS f32x4*)(XB + rr * XBP + 8 * pc + 4) = hi; } }
        if (PASS == 3 && tid < 128) CAR[tid] = cin;
        __syncthreads();
        if (rc + rstep < rc_hi) LRU_PREFETCH(rc + rstep);
        {
            const int t = tid >> 3, i0 = 8 * (tid & 7); float xc[8];
#pragma unroll
            for (int c = 0; c < 8; ++c) { const int i = i0 + c; xc[c] = prm[256 + i] + prm[i] * XB[t * XBP + i] + prm[64 + i] * XB[(t + 1) * XBP + i] + prm[128 + i] * XB[(t + 2) * XBP + i] + prm[192 + i] * XB[(t + 3) * XBP + i]; XCf[t * 64 + i] = xc[c]; }
            u32x4 w; w.x = pack2(xc[0], xc[1]); w.y = pack2(xc[2], xc[3]); w.z = pack2(xc[4], xc[5]); w.w = pack2(xc[6], xc[7]);
            *(LAS u32x4*)(XCs + t * 72 + i0) = w;
        }
        __syncthreads();
        {
            const int jt = wv & 3, th = wv >> 2, jc = 16 * jt + r;
#pragma unroll
            for (int d = 0; d < 2; ++d) { const float ba = prm[320 + 64 * d + jc], bi = prm[448 + 64 * d + jc], spl = prm[576 + 64 * d + jc];
#pragma unroll
                for (int i2 = 0; i2 < 2; ++i2) { const int tt = 2 * th + i2;
                    f32x4 aa = (f32x4){0.f, 0.f, 0.f, 0.f}, ai = (f32x4){0.f, 0.f, 0.f, 0.f};
#pragma unroll
                    for (int kk = 0; kk < 2; ++kk) { const bf16x8 xf = *(const LAS bf16x8*)(XCs + (16 * tt + r) * 72 + 32 * kk + 8 * q);
                        const bf16x8 wa = *(const LAS bf16x8*)(Wt + ((2 * d) * 64 + 16 * jt + r) * 72 + 32 * kk + 8 * q), wi = *(const LAS bf16x8*)(Wt + ((2 * d + 1) * 64 + 16 * jt + r) * 72 + 32 * kk + 8 * q);
                        aa = __builtin_amdgcn_mfma_f32_16x16x32_bf16(xf, wa, aa, 0, 0, 0); ai = __builtin_amdgcn_mfma_f32_16x16x32_bf16(xf, wi, ai, 0, 0, 0); }
#pragma unroll
                    for (int jj = 0; jj < 4; ++jj) { const int t = 16 * tt + 4 * q + jj;
                        const float rg = fsigm(aa[jj] + ba), ig = fsigm(ai[jj] + bi), la = -8.f * rg * spl;
                        const float a = fexp(la);
                        AU[((2 * d) * 64 + t) * 65 + jc] = a; AU[((2 * d + 1) * 64 + t) * 65 + jc] = __builtin_amdgcn_sqrtf(fmaxf(fmaf(-a, a, 1.f), 0.f)) * (ig * XCf[t * 64 + jc]); } } }
        }
        __syncthreads();
        const LAS float* A0 = AU + (8 * sg) * 65 + j; const LAS float* U0 = AU + (64 + 8 * sg) * 65 + j; const LAS float* A1 = AU + (128 + 8 * sg) * 65 + j; const LAS float* U1 = AU + (192 + 8 * sg) * 65 + j;
        {
            float p0 = 1.f, h0 = 0.f, p1 = 1.f, h1 = 0.f;
#pragma unroll
            for (int k = 0; k < 8; ++k) { const float a = A0[k * 65]; h0 = a * h0 + U0[k * 65]; p0 *= a; }
#pragma unroll
            for (int k = 7; k >= 0; --k) { const float a = A1[k * 65]; h1 = a * h1 + U1[k * 65]; p1 *= a; }
            SEG[(0 * 8 + sg) * 64 + j] = p0; SEG[(1 * 8 + sg) * 64 + j] = h0; SEG[(2 * 8 + sg) * 64 + j] = p1; SEG[(3 * 8 + sg) * 64 + j] = h1;
        }
        __syncthreads();
        if (PASS == 1) {
            if (tid < 128) { const int d = tid >> 6; float pa = 1.f, hh = 0.f;
#pragma unroll
                for (int s2 = 0; s2 < 8; ++s2) { const int sgi = d ? 7 - s2 : s2; const float ps = SEG[((2 * d) * 8 + sgi) * 64 + j], hs = SEG[((2 * d + 1) * 8 + sgi) * 64 + j]; hh = ps * hh + hs; pa *= ps; }
                float* o = LSUM + ((size_t)d * NRC + rc) * 1024 + 2 * ch; o[0] = pa; o[1] = hh; }
        } else {
            float hf = CAR[j], hbk = CAR[64 + j];
            for (int s2 = 0; s2 < sg; ++s2) hf = SEG[(0 * 8 + s2) * 64 + j] * hf + SEG[(1 * 8 + s2) * 64 + j];
            for (int s2 = 7; s2 > sg; --s2) hbk = SEG[(2 * 8 + s2) * 64 + j] * hbk + SEG[(3 * 8 + s2) * 64 + j];
            float of[8];
#pragma unroll
            for (int k = 0; k < 8; ++k) { hf = A0[k * 65] * hf + U0[k * 65]; of[k] = hf; }
#pragma unroll
            for (int k = 7; k >= 0; --k) { hbk = A1[k * 65] * hbk + U1[k * 65]; of[k] += hbk; }
#pragma unroll
            for (int k = 0; k < 8; ++k) Y[(size_t)nat_row(row0 + 8 * sg + k) * D + 512 + ch] = f2bf(of[k] * fgelu(gbv[k]));
        }
        __syncthreads();
    }
#undef LRU_PREFETCH
}
constexpr int PT = 72, PM = 40;
constexpr int C_PRM = 0, C_GAM = C_PRM + 3072, C_MISC = C_GAM + 1024, C_SBF = C_MISC + 1280, C_TILES = C_SBF + 2 * 64 * PT * 2, C_TH = C_TILES + 5 * 80 * PT * 2, C_MBF = C_TH + 2 * 64 * PT * 2,
              C_SM = C_MBF + 4 * 16 * 20 * 4, C_W1T = C_SM + 4 * 4 * 16 * PM * 2, C_AH = C_W1T + 4 * 64 * PM * 2, C_YV = C_AH + 4 * 16 * PT * 2, C_END = C_YV + 64 * PM * 2;
static_assert(C_END <= LDS_BYTES - 16, "rwkv chunk LDS map");
DI void unpack4(u32x2 v, float* o) { o[0] = __uint_as_float(v.x << 16); o[1] = __uint_as_float(v.x & 0xffff0000u); o[2] = __uint_as_float(v.y << 16); o[3] = __uint_as_float(v.y & 0xffff0000u); }
DI u32x2 pack4(float a, float b, float c, float d) { u32x2 w; w.x = pack2(a, b); w.y = pack2(c, d); return w; }
DI bf16x8 zero_if(bf16x8 v, bool z) { const bf16x8 zz = {0, 0, 0, 0, 0, 0, 0, 0}; return z ? zz : v; }

constexpr int RING_SLOTS = 4, SLOT_U64 = 7936;
constexpr int S_GAM = 4096, S_BS = 4224, S_AH = 4256, S_NK = 5280, S_NB = 5536, S_YH = 5792, S_END = 7840;
DI int slot_lds(int e) {
    if (e < S_GAM) return C_TILES + ((e >> 10) + 1) * (80 * PT * 2) + ((e >> 4) & 63) * (PT * 2) + (e & 15) * 8;
    if (e < S_BS) return C_GAM + (e - S_GAM) * 8;
    if (e < S_AH) return C_MISC + 1024 + (e - S_BS) * 8;
    if (e < S_NK) { const int x = e - S_AH; return C_AH + (x >> 4) * (PT * 2) + (x & 15) * 8; }
    if (e < S_NB) { const int x = e - S_NK; return C_SM + 4 * 16 * PM * 2 + (x >> 2) * (PM * 2) + (x & 3) * 8; }
    const int x = e - S_NB; return C_SM + 2 * 4 * 16 * PM * 2 + (x >> 2) * (PM * 2) + (x & 3) * 8;
}
constexpr size_t WS_RING = WS_Z1;
DI void wait_ge(unsigned* word, unsigned want) {
    unsigned spins = 0;
    while ((unsigned)__builtin_amdgcn_readfirstlane((int)__hip_atomic_load(word, __ATOMIC_RELAXED, __HIP_MEMORY_SCOPE_AGENT)) < want) { __builtin_amdgcn_s_sleep(2); if (++spins > (1u << 21)) break; }
    __builtin_amdgcn_fence(__ATOMIC_ACQUIRE, "agent");
    asm volatile("s_waitcnt vmcnt(0)" ::: "memory");
}
template <int ROLE> DI void rwkv_chunk_unit(const P& p, LAS unsigned char* lds, const int vb, const int hs = 0) {
    const int tid = mk_tid(), lane = tid & 63, wv = __builtin_amdgcn_readfirstlane(tid >> 6), r = lane & 15, q = lane >> 4;
    const int d = vb >> 5, b = (vb >> 3) & 3, h = vb & 7;
    const bf16_t* RW = (const bf16_t*)(p.ws + WS_COLS) + OFF_RW; const bf16_t* LO = (const bf16_t*)(p.ws + WS_COLS) + OFF_LO; bf16_t* Z = (bf16_t*)(p.ws + WS_Z);
    unsigned long long* ring = (unsigned long long*)(p.ws + WS_RING) + (size_t)vb * RING_SLOTS * SLOT_U64;
    unsigned* READY0 = (unsigned*)(p.ws + WS_CTL) + 64 * vb; unsigned* READY1 = (unsigned*)(p.ws + WS_CTL) + 64 * (192 + vb); unsigned* ACK = (unsigned*)(p.ws + WS_CTL) + 64 * (64 + vb);
    unsigned* READYH = hs ? READY1 : READY0;
    LAS float* prm = (LAS float*)(lds + C_PRM); LAS float* GAM = (LAS float*)(lds + C_GAM); LAS float* SSQ = (LAS float*)(lds + C_MISC); LAS float* BSP = SSQ + 128; LAS float* BS = SSQ + 256;
    LAS bf16_t* Sbf = (LAS bf16_t*)(lds + C_SBF);
    LAS bf16_t* At = (LAS bf16_t*)(lds + C_TILES); LAS bf16_t* Rt = At + 80 * PT; LAS bf16_t* Bt = Rt + 80 * PT; LAS bf16_t* Kt = Bt + 80 * PT; LAS bf16_t* Vt = Kt + 80 * PT;
    LAS bf16_t* TH = (LAS bf16_t*)(lds + C_TH); LAS bf16_t* AD = TH + 64 * PT; LAS float* OUT = (LAS float*)(lds + C_TH);
    LAS float* MBf = (LAS float*)(lds + C_MBF);
    LAS bf16_t* MK = (LAS bf16_t*)(lds + C_SM); LAS bf16_t* NK = MK + 4 * 16 * PM; LAS bf16_t* NB = NK + 4 * 16 * PM; LAS bf16_t* DNV = NB + 4 * 16 * PM;
    LAS bf16_t* W1T = (LAS bf16_t*)(lds + C_W1T); LAS bf16_t* AH = (LAS bf16_t*)(lds + C_AH); LAS bf16_t* YV = (LAS bf16_t*)(lds + C_YV);
    const unsigned at_b = (unsigned)(size_t)At, bt_b = (unsigned)(size_t)Bt, kt_b = (unsigned)(size_t)Kt, vt_b = (unsigned)(size_t)Vt;
    __syncthreads();
    for (int e = tid; e < (C_END - C_SBF) / 4; e += NT) ((LAS unsigned*)(lds + C_SBF))[e] = 0u;
    if (tid < 64) { const int j = tid, c = 64 * h + j; const float* mu = p.in[I_MU] + d * 1664;
        prm[j] = mu[c]; prm[64 + j] = mu[512 + c]; prm[128 + j] = mu[1024 + c]; prm[192 + j] = mu[1536 + j]; prm[256 + j] = mu[1600 + j];
        prm[320 + j] = p.in[I_W0][d * 512 + c]; prm[384 + j] = p.in[I_A0][d * 512 + c]; prm[448 + j] = p.in[I_KK][d * 512 + c]; prm[512 + j] = p.in[I_KA][d * 512 + c];
        prm[576 + j] = p.in[I_RK][(d * 8 + h) * 64 + j]; prm[640 + j] = p.in[I_LNW][d * 512 + c]; prm[704 + j] = p.in[I_LNB][d * 512 + c]; }
    const int m1 = wv & 3, h2 = wv >> 2, cb8 = 32 * h2 + 8 * q;
    bf16x8 fw2[2][2], fa2[2][2];
    if (ROLE != 1) {
#pragma unroll
    for (int t = 0; t < 2; ++t)
#pragma unroll
        for (int kk = 0; kk < 2; ++kk) { const int c = 64 * h + 32 * h2 + 8 * (r >> 2) + 4 * t + (r & 3);
            const float* w2p = p.in[I_W2L] + (size_t)(d * 64 + 32 * kk + 8 * q) * 512 + c; const float* a2p = p.in[I_A2L] + (size_t)(d * 64 + 32 * kk + 8 * q) * 512 + c;
#pragma unroll
            for (int e = 0; e < 8; ++e) { fw2[t][kk][e] = (short)f2bf(w2p[e * 512]); fa2[t][kk][e] = (short)f2bf(a2p[e * 512]); }
            asm volatile("" ::: "memory"); }
    }
    f32x4 Sacc[2] = {(f32x4){0.f, 0.f, 0.f, 0.f}, (f32x4){0.f, 0.f, 0.f, 0.f}};
    int cur = 0;
    unsigned ack_seen = 0u;
    unsigned long long pf[12]; f32x4 yh[4]; bool pf_ok = false;
    u32x4 gc[5], gp[5];
#define RWKV_LOAD(n0x) do { const int n1_ = (n0x) + 16 * m1 + r; const bool hp_ = (n1_ != 0) && (n1_ != LC); const unsigned row_ = (unsigned)step_row(d, b, n1_), prow_ = hp_ ? (unsigned)step_row(d, b, n1_ - 1) : row_; \
    const unsigned rwc_ = row_ * 1536u + 64u * h + cb8, rwp_ = prow_ * 1536u + 64u * h + cb8, loc_ = row_ * 512u + 64u * d + cb8, lop_ = prow_ * 512u + 64u * d + cb8; \
    gc[0] = *(const u32x4*)(RW + rwc_); gc[1] = *(const u32x4*)(RW + rwc_ + 512u); gc[2] = *(const u32x4*)(RW + rwc_ + 1024u); gc[3] = *(const u32x4*)(LO + loc_); gc[4] = *(const u32x4*)(LO + loc_ + 128u); \
    gp[0] = *(const u32x4*)(RW + rwp_); gp[1] = *(const u32x4*)(RW + rwp_ + 512u); gp[2] = *(const u32x4*)(RW + rwp_ + 1024u); gp[3] = *(const u32x4*)(LO + lop_); gp[4] = *(const u32x4*)(LO + lop_ + 128u); } while (0)
    const int n0_start = (ROLE == 2) ? 64 * hs : 0, n0_step = (ROLE == 2) ? 128 : 64;
    if (ROLE != 1) RWKV_LOAD(n0_start);
    __syncthreads();
    for (int n0 = n0_start; n0 < LT; n0 += n0_step) {
        if (ROLE != 1) for (int rep0 = 0; rep0 < (MK_RDUP == 0 ? 2 : 1); ++rep0) {
        const int u1 = 16 * m1 + r, n1 = n0 + u1; const bool hp = (n1 != 0) && (n1 != LC);
        float rs[8], ks[8], vs[8];
        {
            float a0[8], a1[8], th[8], ad[8];
#define UNPACK8(v, o) { _Pragma("unroll") for (int k_ = 0; k_ < 4; ++k_) { o[2 * k_] = __uint_as_float(v[k_] << 16); o[2 * k_ + 1] = __uint_as_float(v[k_] & 0xffff0000u); } }
#define RW_SHIFT(dst, idx, muo) { const u32x4 pz = hp ? gp[idx] : (u32x4){0u, 0u, 0u, 0u}; UNPACK8(gc[idx], a0) UNPACK8(pz, a1) \
            const f32x4 mu0 = *(const LAS f32x4*)(prm + (muo) + cb8), mu1 = *(const LAS f32x4*)(prm + (muo) + cb8 + 4); \
            _Pragma("unroll") for (int e = 0; e < 4; ++e) { dst[e] = a0[e] + mu0[e] * (a1[e] - a0[e]); dst[4 + e] = a0[4 + e] + mu1[e] * (a1[4 + e] - a0[4 + e]); } }
            RW_SHIFT(th, 3, 192) asm volatile("" ::: "memory"); RW_SHIFT(ad, 4, 256) asm volatile("" ::: "memory"); RW_SHIFT(rs, 0, 0) asm volatile("" ::: "memory"); RW_SHIFT(ks, 1, 64) asm volatile("" ::: "memory"); RW_SHIFT(vs, 2, 128)
#undef RW_SHIFT
#pragma unroll
            for (int e = 0; e < 8; ++e) th[e] = ftanh(th[e]);
            u32x4 w; w.x = pack2(th[0], th[1]); w.y = pack2(th[2], th[3]); w.z = pack2(th[4], th[5]); w.w = pack2(th[6], th[7]); *(LAS u32x4*)(TH + u1 * PT + cb8) = w;
            w.x = pack2(ad[0], ad[1]); w.y = pack2(ad[2], ad[3]); w.z = pack2(ad[4], ad[5]); w.w = pack2(ad[6], ad[7]); *(LAS u32x4*)(AD + u1 * PT + cb8) = w;
            asm volatile("" ::: "memory");
        }
        __syncthreads();
        float elog[8], av[8], kkr[8], km[8]; float ssq = 0.f, bsp = 0.f;
#pragma unroll
        for (int t = 0; t < 2; ++t) {
            f32x4 xw = (f32x4){0.f, 0.f, 0.f, 0.f}, xa = (f32x4){0.f, 0.f, 0.f, 0.f};
#pragma unroll
            for (int kk = 0; kk < 2; ++kk) { const bf16x8 bt = *(const LAS bf16x8*)(TH + u1 * PT + 32 * kk + 8 * q), ba = *(const LAS bf16x8*)(AD + u1 * PT + 32 * kk + 8 * q);
                xw = __builtin_amdgcn_mfma_f32_16x16x32_bf16(fw2[t][kk], bt, xw, 0, 0, 0); xa = __builtin_amdgcn_mfma_f32_16x16x32_bf16(fa2[t][kk], ba, xa, 0, 0, 0); }
            const int cb = cb8 + 4 * t;
            const f32x4 w04 = *(const LAS f32x4*)(prm + 320 + cb), a04 = *(const LAS f32x4*)(prm + 384 + cb), kk4 = *(const LAS f32x4*)(prm + 448 + cb), ka4 = *(const LAS f32x4*)(prm + 512 + cb), rk4 = *(const LAS f32x4*)(prm + 576 + cb);
#pragma unroll
            for (int jj = 0; jj < 4; ++jj) { const int e = 4 * t + jj;
                elog[e] = 0.6065306597126334f * fsigm(xw[jj] + w04[jj]); av[e] = fsigm(xa[jj] + a04[jj]);
                kkr[e] = ks[e] * kk4[jj]; ssq += kkr[e] * kkr[e]; km[e] = ks[e] * (1.f + (av[e] - 1.f) * ka4[jj]); bsp += rs[e] * km[e] * rk4[jj]; }
            asm volatile("" ::: "memory");
        }
        ssq += __shfl_xor(ssq, 16); ssq += __shfl_xor(ssq, 32); bsp += __shfl_xor(bsp, 16); bsp += __shfl_xor(bsp, 32);
        if (q == 0) { SSQ[h2 * 64 + u1] = ssq; BSP[h2 * 64 + u1] = bsp; }
        __syncthreads();
        {
            const float tot = SSQ[u1] + SSQ[64 + u1]; const float inv = 1.f / fmaxf(sqrtf(tot), 1e-12f);
            if (h2 == 0 && q == 0) BS[u1] = BSP[u1] + BSP[64 + u1];
            float al[8], be[8], ka[8], rh[8];
#pragma unroll
            for (int e = 0; e < 8; ++e) {
                const float g = scan16(-elog[e]);
                const float ep = fexp(g), em = frcp(ep), epp = fexp(g + elog[e]);
                const float kk = kkr[e] * inv;
                al[e] = kk * epp; be[e] = kk * av[e] * em; ka[e] = km[e] * em; rh[e] = rs[e] * ep;
                if (r == 15) GAM[m1 * 64 + cb8 + e] = ep; }
            u32x4 w;
#define ST8(T, v) w.x = pack2(v[0], v[1]); w.y = pack2(v[2], v[3]); w.z = pack2(v[4], v[5]); w.w = pack2(v[6], v[7]); *(LAS u32x4*)(T + u1 * PT + cb8) = w;
            ST8(At, al) ST8(Bt, be) ST8(Kt, ka) ST8(Rt, rh) ST8(Vt, vs)
#undef ST8
        }
        __syncthreads();
        }
        if (ROLE == 0 && n0 + 64 < LT) RWKV_LOAD(n0 + 64);
        f32x4 yhat[4];
        if (ROLE == 1) {
            const unsigned g = (unsigned)(n0 >> 6);
            if (!pf_ok) { if (wv == 0) wait_ge((g & 1u) ? READY1 : READY0, (g >> 1) + 1u); __syncthreads();
                const unsigned long long* slot = ring + (size_t)(g % RING_SLOTS) * SLOT_U64;
#pragma unroll
                for (int k = 0; k < 12; ++k) { const int e = tid + NT * k; if (e < S_YH) pf[k] = slot[e]; }
#pragma unroll
                for (int m = 0; m < 4; ++m) yh[m] = *(const f32x4*)(slot + S_YH + ((m * 4 + (wv & 3)) * 64 + lane) * 2); }
            for (int rep7 = 0; rep7 < (MK_RDUP == 7 ? 2 : 1); ++rep7) { if (rep7) __syncthreads();
#pragma unroll
            for (int k = 0; k < 12; ++k) { const int e = tid + NT * k; if (e < S_YH) *(LAS unsigned long long*)(lds + slot_lds(e)) = pf[k]; }
            asm volatile("s_waitcnt vmcnt(0)" ::: "memory");
            __syncthreads(); }
            if (tid == 0) __hip_atomic_store(ACK, g + 1u, __ATOMIC_RELAXED, __HIP_MEMORY_SCOPE_AGENT);
#pragma unroll
            for (int m = 0; m < 4; ++m) yhat[m] = yh[m];
        }
        if (ROLE != 1) for (int rep1 = 0; rep1 < (MK_RDUP == 1 ? 2 : 1); ++rep1) {
        {
            const int m = wv >> 1, pp = wv & 1; LAS bf16_t* XB = pp ? Rt : At;
            f32x4 c1 = (f32x4){0.f, 0.f, 0.f, 0.f}, c2 = (f32x4){0.f, 0.f, 0.f, 0.f};
#pragma unroll
            for (int kk = 0; kk < 2; ++kk) { const bf16x8 bx = *(const LAS bf16x8*)(XB + (16 * m + r) * PT + 32 * kk + 8 * q);
                const bf16x8 a1 = *(const LAS bf16x8*)(Bt + (16 * m + r) * PT + 32 * kk + 8 * q), a2 = *(const LAS bf16x8*)(Kt + (16 * m + r) * PT + 32 * kk + 8 * q);
                c1 = __builtin_amdgcn_mfma_f32_16x16x32_bf16(a1, bx, c1, 0, 0, 0); c2 = __builtin_amdgcn_mfma_f32_16x16x32_bf16(a2, bx, c2, 0, 0, 0); }
#pragma unroll
            for (int jj = 0; jj < 4; ++jj) { const int s = 4 * q + jj; const bool ok = pp ? (s <= r) : (s < r); if (!ok) { c1[jj] = 0.f; c2[jj] = 0.f; } }
            if (pp == 0) { *(LAS f32x4*)(MBf + (m * 16 + r) * 20 + 4 * q) = c1; *(LAS u32x2*)(MK + (m * 16 + r) * PM + 4 * q) = pack4(c2[0], c2[1], c2[2], c2[3]); }
            else { *(LAS u32x2*)(NB + (m * 16 + r) * PM + 4 * q) = pack4(c1[0], c1[1], c1[2], c1[3]); *(LAS u32x2*)(NK + (m * 16 + r) * PM + 4 * q) = pack4(c2[0], c2[1], c2[2], c2[3]); }
        }
        __syncthreads();
        if (wv < 4) {
            const int m = wv, c = r; float X[16];
#pragma unroll
            for (int u = 0; u < 16; ++u) { float x = (c == u) ? 1.f : 0.f;
                if (u > 0) { const LAS f32x4* rowp = (const LAS f32x4*)(MBf + (m * 16 + u) * 20);
#pragma unroll
                    for (int s4 = 0; s4 < 4; ++s4) { if (4 * s4 < u) { const f32x4 l = rowp[s4];
#pragma unroll
                        for (int e = 0; e < 4; ++e) if (4 * s4 + e < u) x -= l[e] * X[4 * s4 + e]; } } }
                X[u] = x; }
            if (q == 0) {
#pragma unroll
                for (int u = 0; u < 16; ++u) DNV[(m * 16 + u) * PM + c] = f2bf(X[u]); }
        } else {
            const int m = wv - 4; const bf16x8 a = *(const LAS bf16x8*)(MK + (m * 16 + r) * PM + 8 * q);
            bf16x8 bvs[4]; tr_frag4(bvs[0], bvs[1], bvs[2], bvs[3], tr_addr(vt_b, PT, 16 * m, 0, r, q), 8u * PT, tr_addr(vt_b, PT, 16 * m, 16, r, q), 8u * PT, tr_addr(vt_b, PT, 16 * m, 32, r, q), 8u * PT, tr_addr(vt_b, PT, 16 * m, 48, r, q), 8u * PT);
#pragma unroll
            for (int it = 0; it < 4; ++it) { const bf16x8 bv = bvs[it];
                const f32x4 acc = __builtin_amdgcn_mfma_f32_16x16x32_bf16(a, bv, (f32x4){0.f, 0.f, 0.f, 0.f}, 0, 0, 0);
                *(LAS u32x2*)(W1T + (m * 64 + 16 * it + r) * PM + 4 * q) = pack4(acc[0], acc[1], acc[2], acc[3]); }
        }
        __syncthreads();
#pragma unroll
        for (int m = 0; m < 4; ++m) yhat[m] = (f32x4){0.f, 0.f, 0.f, 0.f};
        {
            const int it = wv & 3;
#pragma unroll
            for (int m = 0; m < 4; ++m) { const bf16x8 a = *(const LAS bf16x8*)(DNV + (m * 16 + r) * PM + 8 * q), bw = *(const LAS bf16x8*)(W1T + (m * 64 + 16 * it + r) * PM + 8 * q);
                yhat[m] = __builtin_amdgcn_mfma_f32_16x16x32_bf16(a, bw, yhat[m], 0, 0, 0); }
        }
        if (wv >= 4) {
            const int jt = wv - 4;
            bf16x8 afs[4]; tr_frag4(afs[0], afs[1], afs[2], afs[3], tr_addr(at_b, PT, 0, 16 * jt, r, q), 8u * PT, tr_addr(at_b, PT, 16, 16 * jt, r, q), 8u * PT, tr_addr(at_b, PT, 32, 16 * jt, r, q), 8u * PT, tr_addr(at_b, PT, 48, 16 * jt, r, q), 8u * PT);
#pragma unroll
            for (int m = 0; m < 4; ++m) { const bf16x8 a = afs[m], bd = *(const LAS bf16x8*)(DNV + (m * 16 + r) * PM + 8 * q);
                const f32x4 acc = __builtin_amdgcn_mfma_f32_16x16x32_bf16(a, bd, (f32x4){0.f, 0.f, 0.f, 0.f}, 0, 0, 0);
                *(LAS u32x2*)(AH + (m * 16 + r) * PT + 16 * jt + 4 * q) = pack4(acc[0], acc[1], acc[2], acc[3]); }
        }
        __syncthreads();
        }
        if (ROLE == 2) {
            const unsigned g = (unsigned)(n0 >> 6);
            if (g >= 2u) { asm volatile("s_waitcnt vmcnt(0)" ::: "memory"); __syncthreads(); if (tid == 0) __hip_atomic_store(READYH, (g >> 1), __ATOMIC_RELAXED, __HIP_MEMORY_SCOPE_AGENT); }
            if (n0 + 128 < LT) RWKV_LOAD(n0 + 128);
            if (g >= RING_SLOTS && ack_seen < g - RING_SLOTS + 1) {
                if (tid == 0) { wait_ge(ACK, g - RING_SLOTS + 1); ((LAS unsigned*)MBf)[17] = __hip_atomic_load(ACK, __ATOMIC_RELAXED, __HIP_MEMORY_SCOPE_AGENT); }
                __syncthreads(); ack_seen = ((LAS unsigned*)MBf)[17]; }
            unsigned long long* slot = ring + (size_t)(g % RING_SLOTS) * SLOT_U64;
#pragma unroll 2
            for (int k = 0; k < 12; ++k) { const int e = tid + NT * k; if (e < S_YH) __hip_atomic_store(slot + e, *(const LAS unsigned long long*)(lds + slot_lds(e)), __ATOMIC_RELAXED, __HIP_MEMORY_SCOPE_AGENT); }
            if (wv < 4) {
#pragma unroll
                for (int m = 0; m < 4; ++m) { unsigned long long* yp = slot + S_YH + ((m * 4 + wv) * 64 + lane) * 2;
                    __hip_atomic_store(yp, ((unsigned long long)__float_as_uint(yhat[m][1]) << 32) | __float_as_uint(yhat[m][0]), __ATOMIC_RELAXED, __HIP_MEMORY_SCOPE_AGENT);
                    __hip_atomic_store(yp + 1, ((unsigned long long)__float_as_uint(yhat[m][3]) << 32) | __float_as_uint(yhat[m][2]), __ATOMIC_RELAXED, __HIP_MEMORY_SCOPE_AGENT); } }
            if (g + 2u >= 132u) { asm volatile("s_waitcnt vmcnt(0)" ::: "memory"); __syncthreads(); if (tid == 0) __hip_atomic_store(READYH, (g >> 1) + 1u, __ATOMIC_RELAXED, __HIP_MEMORY_SCOPE_AGENT); }
            continue;
        }
#pragma unroll 1
        for (int m = 0; m < 4; ++m) {
            LAS bf16_t* Sc = Sbf + cur * 64 * PT; LAS bf16_t* Sn = Sbf + (cur ^ 1) * 64 * PT;
            const int it = wv & 3, jh = wv >> 2;
            bf16x8 bv, ka0, ka1;
            tr_frag3(bv, ka0, ka1, tr_addr(vt_b, PT, 16 * m, 16 * it, r, q), 8u * PT, tr_addr(kt_b, PT, 16 * m, 16 * (2 * jh), r, q), 8u * PT, tr_addr(kt_b, PT, 16 * m, 16 * (2 * jh + 1), r, q), 8u * PT);
            ka0 = zero_if(ka0, q >= 2); ka1 = zero_if(ka1, q >= 2);
            s16x4 hb0, hb1;
            { const unsigned a0 = bt_b + (unsigned)(((16 * m + 4 * q + (r >> 2)) * PT + 16 * (2 * jh) + 4 * (r & 3)) * 2), a1 = a0 + 32u;
              asm volatile("ds_read_b64_tr_b16 %0, %2\n\tds_read_b64_tr_b16 %1, %3\n\ts_waitcnt lgkmcnt(0)" : "=&v"(hb0), "=&v"(hb1) : "v"(a0), "v"(a1) : "memory"); }
            const bf16x8 ba0 = {hb0[0], hb0[1], hb0[2], hb0[3], 0, 0, 0, 0}, ba1 = {hb1[0], hb1[1], hb1[2], hb1[3], 0, 0, 0, 0};
            const bf16x8 s0 = *(const LAS bf16x8*)(Sc + (16 * it + r) * PT + 8 * q), s1 = *(const LAS bf16x8*)(Sc + (16 * it + r) * PT + 32 + 8 * q);
            f32x4 acc = (m == 0) ? yhat[0] : (m == 1) ? yhat[1] : (m == 2) ? yhat[2] : yhat[3];
            acc = __builtin_amdgcn_mfma_f32_16x16x32_bf16(*(const LAS bf16x8*)(AH + (m * 16 + r) * PT + 8 * q), s0, acc, 0, 0, 0);
            acc = __builtin_amdgcn_mfma_f32_16x16x32_bf16(*(const LAS bf16x8*)(AH + (m * 16 + r) * PT + 32 + 8 * q), s1, acc, 0, 0, 0);
            const u32x2 ny = pack4(-acc[0], -acc[1], -acc[2], -acc[3]);
            bf16x8 nyv = {0, 0, 0, 0, 0, 0, 0, 0}; { const s16x4 t4 = __builtin_bit_cast(s16x4, ny); nyv[0] = t4[0]; nyv[1] = t4[1]; nyv[2] = t4[2]; nyv[3] = t4[3]; }
#pragma unroll
            for (int x = 0; x < 2; ++x) { const int jt = 2 * jh + x;
                Sacc[x] = __builtin_amdgcn_mfma_f32_16x16x32_bf16(x ? ka1 : ka0, bv, Sacc[x], 0, 0, 0); Sacc[x] = __builtin_amdgcn_mfma_f32_16x16x32_bf16(x ? ba1 : ba0, nyv, Sacc[x], 0, 0, 0);
                const f32x4 gm = *(const LAS f32x4*)(GAM + m * 64 + 16 * jt + 4 * q); Sacc[x] = Sacc[x] * gm;
                *(LAS u32x2*)(Sn + (16 * it + r) * PT + 16 * jt + 4 * q) = pack4(Sacc[x][0], Sacc[x][1], Sacc[x][2], Sacc[x][3]); }
            if (wv >= 4) {
                f32x4 oacc = (f32x4){0.f, 0.f, 0.f, 0.f};
                oacc = __builtin_amdgcn_mfma_f32_16x16x32_bf16(*(const LAS bf16x8*)(Rt + (16 * m + r) * PT + 8 * q), s0, oacc, 0, 0, 0);
                oacc = __builtin_amdgcn_mfma_f32_16x16x32_bf16(*(const LAS bf16x8*)(Rt + (16 * m + r) * PT + 32 + 8 * q), s1, oacc, 0, 0, 0);
                oacc = __builtin_amdgcn_mfma_f32_16x16x32_bf16(*(const LAS bf16x8*)(NK + (m * 16 + r) * PM + 8 * q), bv, oacc, 0, 0, 0);
                const s16x4 nb4 = *(const LAS s16x4*)(NB + (m * 16 + r) * PM + 4 * q); const bf16x8 nbp = {nb4[0], nb4[1], nb4[2], nb4[3], 0, 0, 0, 0};
                oacc = __builtin_amdgcn_mfma_f32_16x16x32_bf16(nbp, nyv, oacc, 0, 0, 0);
#pragma unroll
                for (int jj = 0; jj < 4; ++jj) OUT[(16 * m + 4 * q + jj) * 68 + 16 * it + r] = oacc[jj]; }
            if (ROLE == 1 && m == 0) { if (tid == 0) { const unsigned g1 = (unsigned)(n0 >> 6) + 1u; unsigned ok = 0u;
                    if (g1 < 132u && __hip_atomic_load((g1 & 1u) ? READY1 : READY0, __ATOMIC_RELAXED, __HIP_MEMORY_SCOPE_AGENT) >= (g1 >> 1) + 1u) { __builtin_amdgcn_fence(__ATOMIC_ACQUIRE, "agent"); asm volatile("s_waitcnt vmcnt(0)" ::: "memory"); ok = 1u; }
                    ((LAS unsigned*)MBf)[16] = ok; } }
            __syncthreads();
            if (ROLE == 1 && m == 0) { pf_ok = ((LAS unsigned*)MBf)[16] != 0u;
                if (pf_ok) { const unsigned long long* slot = ring + (size_t)(((unsigned)(n0 >> 6) + 1u) % RING_SLOTS) * SLOT_U64;
#pragma unroll
                    for (int k = 0; k < 12; ++k) { const int e = tid + NT * k; if (e < S_YH) pf[k] = slot[e]; }
#pragma unroll
                    for (int mm = 0; mm < 4; ++mm) yh[mm] = *(const f32x4*)(slot + S_YH + ((mm * 4 + (wv & 3)) * 64 + lane) * 2); } }
            cur ^= 1;
        }
        for (int rep6 = 0; rep6 < (MK_RDUP == 6 ? 2 : 1); ++rep6) {
            const int u = tid >> 3, part = tid & 7; const size_t row = (size_t)step_row(d, b, n0 + u);
            const f32x4 o0 = *(const LAS f32x4*)(OUT + u * 68 + 8 * part), o1 = *(const LAS f32x4*)(OUT + u * 68 + 8 * part + 4);
            const float mean = sum8((o0[0] + o0[1]) + (o0[2] + o0[3]) + (o1[0] + o1[1]) + (o1[2] + o1[3])) * (1.f / 64.f);
            const f32x4 d0 = o0 - mean, d1 = o1 - mean;
            const float var = sum8((d0[0] * d0[0] + d0[1] * d0[1]) + (d0[2] * d0[2] + d0[3] * d0[3]) + (d1[0] * d1[0] + d1[1] * d1[1]) + (d1[2] * d1[2] + d1[3] * d1[3])) * (1.f / 64.f);
            const float rstd = rsqrtf(var + 64e-5f), bs = BS[u];
            const f32x4 w0 = *(const LAS f32x4*)(prm + 640 + 8 * part), w1 = *(const LAS f32x4*)(prm + 644 + 8 * part), b0 = *(const LAS f32x4*)(prm + 704 + 8 * part), b1 = *(const LAS f32x4*)(prm + 708 + 8 * part);
            const u32x4 vv = *(const LAS u32x4*)(Vt + u * PT + 8 * part);
            float z[8];
#pragma unroll
            for (int k = 0; k < 4; ++k) { z[k] = d0[k] * rstd * w0[k] + b0[k]; z[4 + k] = d1[k] * rstd * w1[k] + b1[k]; }
#pragma unroll
            for (int k = 0; k < 4; ++k) { z[2 * k] += bs * __uint_as_float(vv[k] << 16); z[2 * k + 1] += bs * __uint_as_float(vv[k] & 0xffff0000u); }
            u32x4 w; w.x = pack2(z[0], z[1]); w.y = pack2(z[2], z[3]); w.z = pack2(z[4], z[5]); w.w = pack2(z[6], z[7]);
            *(u32x4*)(Z + ((size_t)d * NALL + row) * 512 + 64 * h + 8 * part) = w;
        }
        __syncthreads();
    }
}
constexpr int RP_G2 = 0, RP_G2P = 520, RP_SG = RP_G2 + 128 * RP_G2P * 2, RP_END = RP_SG + 64 * PQ * 2;
static_assert(RP_END <= LDS_BYTES - 16, "rwkv post LDS map");
DI void phase_rwkv_post2(const P& p, LAS unsigned char* lds) {
    const int tid = mk_tid(), lane = tid & 63, wv = __builtin_amdgcn_readfirstlane(tid >> 6), r = lane & 15, q = lane >> 4;
    const bf16_t* LO = (const bf16_t*)(p.ws + WS_COLS) + OFF_LO; const bf16_t* Z = (const bf16_t*)(p.ws + WS_Z); bf16_t* Y = (bf16_t*)(p.ws + WS_COLS);
    LAS bf16_t* G2s = (LAS bf16_t*)(lds + RP_G2); LAS bf16_t* SG = (LAS bf16_t*)(lds + RP_SG);
    const unsigned g2_b = (unsigned)(size_t)G2s;
    if ((int)blockIdx.x >= NRC) return;
    __syncthreads();
    for (int e = tid; e < 128 * 128; e += NT) { const int rr = e >> 7, c4 = (e & 127) * 4; const f32x4 v = *(const f32x4*)(p.in[I_G2] + rr * 512 + c4);
        *(LAS u32x2*)(G2s + rr * RP_G2P + c4) = pack4(v[0], v[1], v[2], v[3]); }
    for (int rc = blockIdx.x; rc < NRC; rc += gridDim.x) {
        const size_t row0 = (size_t)rc * 64;
        __syncthreads();
        for (int e = tid; e < 64 * 16; e += NT) { const int t = e >> 4, pc = e & 15; const u32x4 v = *(const u32x4*)(LO + (row0 + t) * 512 + 256 + 8 * pc); u32x4 o;
#pragma unroll
            for (int k = 0; k < 4; ++k) o[k] = pack2(fsigm(__uint_as_float(v[k] << 16)), fsigm(__uint_as_float(v[k] & 0xffff0000u)));
            *(LAS u32x4*)(SG + t * PQ + 8 * pc) = o; }
        __syncthreads();
#pragma unroll 1
        for (int ci = 0; ci < 4; ++ci) { const int ct = 4 * wv + ci;
            f32x4 acc[4] = {(f32x4){0.f, 0.f, 0.f, 0.f}, (f32x4){0.f, 0.f, 0.f, 0.f}, (f32x4){0.f, 0.f, 0.f, 0.f}, (f32x4){0.f, 0.f, 0.f, 0.f}};
#pragma unroll
            for (int kk = 0; kk < 4; ++kk) { const bf16x8 a = tr_frag(g2_b, RP_G2P, 32 * kk, 16 * ct, r, q);
#pragma unroll
                for (int tt = 0; tt < 4; ++tt) { const bf16x8 bs = *(const LAS bf16x8*)(SG + (16 * tt + r) * PQ + 32 * kk + 8 * q); acc[tt] = __builtin_amdgcn_mfma_f32_16x16x32_bf16(a, bs, acc[tt], 0, 0, 0); } }
#pragma unroll
            for (int tt = 0; tt < 4; ++tt) { const size_t row = row0 + 16 * tt + r; const int c = 16 * ct + 4 * q;
                float z0[4], z1[4]; unpack4(*(const u32x2*)(Z + row * 512 + c), z0); unpack4(*(const u32x2*)(Z + ((size_t)NALL + row) * 512 + c), z1);
                *(u32x2*)(Y + row * D + c) = pack4((z0[0] + z1[0]) * acc[tt][0], (z0[1] + z1[1]) * acc[tt][1], (z0[2] + z1[2]) * acc[tt][2], (z0[3] + z1[3]) * acc[tt][3]); }
        }
    }
    __syncthreads();
}
#define XB_TMO      128
#define XB_XCNT(j)  (256  + 64 * (j))
#define XB_XSUB(j)  (1280 + 64 * (j))
#define XB_XGEN(j)  (2304 + 64 * (j))
#define XB_TOP      3328
#define XB_TOPGEN   3392
#define XCD_BAR_WORDS 3456
#define XB_SPIN_CAP (1u << 18)

__device__ __forceinline__ unsigned xb_ld(unsigned* p)              { return __hip_atomic_load(p, __ATOMIC_RELAXED, __HIP_MEMORY_SCOPE_AGENT); }
__device__ __forceinline__ unsigned xb_add(unsigned* p, unsigned v) { return __hip_atomic_fetch_add(p, v, __ATOMIC_RELAXED, __HIP_MEMORY_SCOPE_AGENT); }
__device__ __forceinline__ unsigned xb_xcc_id() { return (unsigned)__builtin_amdgcn_s_getreg((3 << 11) | 20) & 0xFu; }
#define XB_SPIN(cond, bar) do { unsigned _sp = 0; while (cond) { __builtin_amdgcn_s_sleep(1); \
    if ((++_sp & 255u) == 0u) { if (xb_ld(&(bar)[XB_TMO])) break; if (_sp > XB_SPIN_CAP) { atomicAdd(&(bar)[XB_TMO], 1u); break; } } } } while (0)

struct XcdBarrier {
    unsigned* bar; unsigned x;
    volatile LAS unsigned* st;
};

__device__ __forceinline__ XcdBarrier xcd_barrier_post(unsigned* bar, volatile LAS unsigned* st) {
    XcdBarrier b; b.bar = bar; b.x = xb_xcc_id(); b.st = st;
    if (threadIdx.x == 0) (void)xb_add(&bar[XB_XCNT(b.x)], 1u);
    return b;
}
__device__ __forceinline__ void xcd_barrier_complete(unsigned* bar, unsigned x, unsigned& nloc, unsigned& nx) {
    const unsigned G = gridDim.x * gridDim.y * gridDim.z;
    unsigned sum, cnt, mine, sp = 0u;
    for (;;) {
        sum = 0u; cnt = 0u; mine = 0u;
#pragma unroll
        for (unsigned j = 0; j < 16; ++j) { const unsigned c = xb_ld(&bar[XB_XCNT(j)]); sum += c; cnt += (c > 0u) ? 1u : 0u; mine = (j == x) ? c : mine; }
        if (sum == G) break;
        __builtin_amdgcn_s_sleep(1);
        if ((++sp & 255u) == 0u) { if (xb_ld(&bar[XB_TMO])) break; if (sp > XB_SPIN_CAP) { atomicAdd(&bar[XB_TMO], 1u); break; } }
    }
    nloc = mine > 0u ? mine : 1u; nx = cnt > 0u ? cnt : 1u;
}

__device__ __forceinline__ void xcd_barrier(const XcdBarrier& b) {
    asm volatile("s_waitcnt vmcnt(0)" ::: "memory");
    __syncthreads();
    if (threadIdx.x == 0) {
        unsigned* bar = b.bar;
        __builtin_amdgcn_s_waitcnt(0);
        unsigned nloc = b.st[0], nx = b.st[1];
        if (nloc == 0u) { xcd_barrier_complete(bar, b.x, nloc, nx); b.st[0] = nloc; b.st[1] = nx; }
        const unsigned old = xb_add(&bar[XB_XSUB(b.x)], 1u);
        const unsigned gen = old / nloc;
        if (old + 1u == (gen + 1u) * nloc) {
            __builtin_amdgcn_fence(__ATOMIC_RELEASE, "agent");
            asm volatile("s_waitcnt vmcnt(0)" ::: "memory");
            const unsigned og = xb_add(&bar[XB_TOP], 1u);
            const unsigned tg = og / nx;
            if (og + 1u == (tg + 1u) * nx) xb_add(&bar[XB_TOPGEN], 1u);
            else XB_SPIN(xb_ld(&bar[XB_TOPGEN]) == tg, bar);
            __builtin_amdgcn_fence(__ATOMIC_ACQUIRE, "agent");
            xb_add(&bar[XB_XGEN(b.x)], 1u);
            asm volatile("s_waitcnt vmcnt(0)" ::: "memory");
        } else {
            XB_SPIN(xb_ld(&bar[XB_XGEN(b.x)]) == gen, bar);
            __builtin_amdgcn_fence(__ATOMIC_ACQUIRE, "agent");
            asm volatile("s_waitcnt vmcnt(0)" ::: "memory");
        }
    }
    __syncthreads();
}
constexpr int SG_P = 72;
template <bool DUAL, class Epi> DI void small_gemm(LAS unsigned char* lds, const bf16_t* A, const bf16_t* Bt, int M, int N, int K, const Epi& E) {
    const int tid = mk_tid(), lane = tid & 63, wv = __builtin_amdgcn_readfirstlane(tid >> 6), r = lane & 15, q = lane >> 4, mt = wv & 3, nh = wv >> 2;
    constexpr int BUF = 3 * 64 * SG_P;
    LAS bf16_t* base = (LAS bf16_t*)lds;
    const int ntn = N / 64, ntiles = (M / 64) * ntn, nkc = K / 64, prow = tid >> 3, ppc = tid & 7;
    for (int tile = blockIdx.x; tile < ntiles; tile += gridDim.x) {
        const int tm = tile / ntn, tn = tile - tm * ntn;
        const int c0 = 64 * tn; const int brow0 = DUAL ? 256 * (c0 >> 7) + (c0 & 127) : c0;
        const bf16_t* ag = A + (size_t)(64 * tm + prow) * K + 8 * ppc; const bf16_t* bg = Bt + (size_t)(brow0 + prow) * K + 8 * ppc;
        f32x4 acc[2] = {(f32x4){0.f, 0.f, 0.f, 0.f}, (f32x4){0.f, 0.f, 0.f, 0.f}}, acc3[2] = {(f32x4){0.f, 0.f, 0.f, 0.f}, (f32x4){0.f, 0.f, 0.f, 0.f}};
        u32x4 ra = *(const u32x4*)ag, rb = *(const u32x4*)bg, rb3 = (u32x4){0u, 0u, 0u, 0u};
        if (DUAL) rb3 = *(const u32x4*)(bg + (size_t)128 * K);
        __syncthreads();
        { LAS bf16_t* S0 = base; *(LAS u32x4*)(S0 + prow * SG_P + 8 * ppc) = ra; *(LAS u32x4*)(S0 + 64 * SG_P + prow * SG_P + 8 * ppc) = rb; if (DUAL) *(LAS u32x4*)(S0 + 128 * SG_P + prow * SG_P + 8 * ppc) = rb3; }
        if (nkc > 1) { ra = *(const u32x4*)(ag + 64); rb = *(const u32x4*)(bg + 64); if (DUAL) rb3 = *(const u32x4*)(bg + (size_t)128 * K + 64); }
        __syncthreads();
        for (int kc = 0; kc < nkc; ++kc) {
            LAS bf16_t* As = base + (kc & 1) * BUF; LAS bf16_t* Bs = As + 64 * SG_P; LAS bf16_t* B3 = Bs + 64 * SG_P;
            if (kc + 1 < nkc) { LAS bf16_t* Sn = base + ((kc + 1) & 1) * BUF; *(LAS u32x4*)(Sn + prow * SG_P + 8 * ppc) = ra; *(LAS u32x4*)(Sn + 64 * SG_P + prow * SG_P + 8 * ppc) = rb; if (DUAL) *(LAS u32x4*)(Sn + 128 * SG_P + prow * SG_P + 8 * ppc) = rb3; }
            if (kc + 2 < nkc) { ra = *(const u32x4*)(ag + 64 * (kc + 2)); rb = *(const u32x4*)(bg + 64 * (kc + 2)); if (DUAL) rb3 = *(const u32x4*)(bg + (size_t)128 * K + 64 * (kc + 2)); }
#pragma unroll
            for (int kk = 0; kk < 2; ++kk) { const bf16x8 a = *(const LAS bf16x8*)(As + (16 * mt + r) * SG_P + 32 * kk + 8 * q);
#pragma unroll
                for (int x = 0; x < 2; ++x) { const bf16x8 bb = *(const LAS bf16x8*)(Bs + (16 * (2 * nh + x) + r) * SG_P + 32 * kk + 8 * q); acc[x] = __builtin_amdgcn_mfma_f32_16x16x32_bf16(bb, a, acc[x], 0, 0, 0);
                    if (DUAL) { const bf16x8 b3 = *(const LAS bf16x8*)(B3 + (16 * (2 * nh + x) + r) * SG_P + 32 * kk + 8 * q); acc3[x] = __builtin_amdgcn_mfma_f32_16x16x32_bf16(b3, a, acc3[x], 0, 0, 0); } } }
            __syncthreads();
        }
#pragma unroll
        for (int x = 0; x < 2; ++x) E(64 * tm + 16 * mt + r, c0 + 16 * (2 * nh + x) + 4 * q, acc[x], acc3[x]);
    }
    __syncthreads();
}
struct SEpiStore3 { bf16_t* p0; int ld0; int c1; bf16_t* p1; int ld1; int c2; bf16_t* p2; int ld2;
    DI void operator()(int m, int c, const f32x4& v, const f32x4&) const { bf16_t* base; int ld, cc;
        if (c >= c2) { base = p2; ld = ld2; cc = c - c2; } else if (c >= c1) { base = p1; ld = ld1; cc = c - c1; } else { base = p0; ld = ld0; cc = c; }
        *(u32x2*)(base + (size_t)(NLAT + m) * ld + cc) = pack4(v[0], v[1], v[2], v[3]); } };
struct SEpiResid { const float* cin; float* cout; const float* gate;
    DI void operator()(int m, int c, const f32x4& v, const f32x4&) const { const f32x4 g = *(const f32x4*)(gate + c), bs = *(const f32x4*)(cin + (size_t)m * D + c); *(f32x4*)(cout + (size_t)m * D + c) = bs + g * v; } };
struct SEpiSwiglu { bf16_t* G;
    DI void operator()(int m, int c, const f32x4& a, const f32x4& b) const { float g[4];
#pragma unroll
        for (int j = 0; j < 4; ++j) g[j] = a[j] * frcp(1.f + fexp(-a[j])) * b[j];
        *(u32x2*)(G + (size_t)(NLAT + m) * DFF + c) = pack4(g[0], g[1], g[2], g[3]); } };
DI void phase_mlstm_post(const P& p) {
    const bf16_t* ML = (const bf16_t*)(p.ws + WS_COLS) + OFF_ML;
    phase_headnorm_post((const bf16_t*)(p.ws + WS_ACT), p.in[I_MNG], ML + 1536, 2048, 0, (bf16_t*)(p.ws + WS_COLS), 512, NALL, false);
}
DI void phase_hgrn_post(const P& p) {
    const bf16_t* C1 = (const bf16_t*)(p.ws + WS_COLS);
    phase_headnorm_post((const bf16_t*)(p.ws + WS_ACT), p.in[I_HNG], C1 + 2048, C1LD, 1, (bf16_t*)(p.ws + WS_Z), 0, NLAT, true);
}

constexpr int N_PHASES = 19;
__global__ void __launch_bounds__(NT, 2) mk_fwd(P p) {
    extern __shared__ __attribute__((aligned(16))) unsigned char lds_raw[];
    LAS unsigned char* lds = (LAS unsigned char*)lds_raw;
    cooperative_groups::grid_group grid = cooperative_groups::this_grid();
    const int lo = p.ph_lo, hi = p.ph_hi;
    volatile LAS unsigned* xst = (volatile LAS unsigned*)(lds + LDS_BYTES - 16);
    if (threadIdx.x < 4) xst[threadIdx.x] = 0u;
    __syncthreads();
    const XcdBarrier xbar = xcd_barrier_post((unsigned*)(p.ws + WS_CTL) + 8192, xst);
#define IN(k) (lo <= (k) && (k) < hi)
#define SEAM(k) do { if (IN(k) && IN((k) + 1)) xcd_barrier(xbar); } while (0)
#ifndef MK_DUP
#define MK_DUP -1
#endif
#define PHASE(k, ...) if (IN(k)) { __VA_ARGS__ if (MK_DUP == (k)) { grid.sync(); __VA_ARGS__ } } SEAM(k);
    unsigned char* ws = p.ws;
    const float* MODV = (const float*)(ws + WS_MODV);
    float* HC = (float*)(ws + WS_HC);
    float* SSQP = (float*)(ws + WS_SSQP); const float* GSC = (const float*)(ws + WS_GSC); const float* SHW = GSC + SHW_OFF;
    bf16_t* ACT = (bf16_t*)(ws + WS_ACT); bf16_t* COLS = (bf16_t*)(ws + WS_COLS); bf16_t* Y1 = (bf16_t*)(ws + WS_Z);
    PHASE(0, phase_modv(p, lds);)
    PHASE(1, phase_modnorm(p, 0, 0, p.in[I_X], p.in[I_CTX], NALL, false); phase_wprep(p, lds);)
    PHASE(2, { EpiStore3 E{COLS + OFF_RW, 1536, 6, COLS + OFF_LO, 512, 8, COLS + OFF_ML, 2048, 0}; run_gemm(lds, ACT, (const bf16_t*)(ws + WS_W_EVIN), NLAT, 4096, 1024, E); SEpiStore3 S{COLS + OFF_RW, 1536, 1536, COLS + OFF_LO, 512, 2048, COLS + OFF_ML, 2048}; small_gemm<false>(lds, ACT + (size_t)NLAT * 1024, (const bf16_t*)(ws + WS_W_EVIN), NCTX, 4096, 1024, S); })
    PHASE(3, { const int bx = (int)blockIdx.x;
        if (gridDim.x == 256) { if (bx < 64) rwkv_chunk_unit<1>(p, lds, bx); else if (bx < 192) rwkv_chunk_unit<2>(p, lds, (bx - 64) & 63, (bx - 64) >> 6); else { gla_unit<0>(p, lds, 2 * (bx - 192)); gla_unit<0>(p, lds, 2 * (bx - 192) + 1); } }
        else for (int vb = bx; vb < 192; vb += gridDim.x) { if (vb < 64) rwkv_chunk_unit<0>(p, lds, vb); else gla_unit<0>(p, lds, vb - 64); } })
    if (IN(3) && MK_DUP == 303) { grid.sync(); if (blockIdx.x < 64) rwkv_chunk_unit<1>(p, lds, blockIdx.x); grid.sync(); }
    if (IN(3) && MK_DUP == 403) { grid.sync(); if (blockIdx.x >= 64 && blockIdx.x < 128) rwkv_chunk_unit<2>(p, lds, blockIdx.x - 64, 0); grid.sync(); }
    if (IN(3) && MK_DUP == 103) { grid.sync(); for (int vb = blockIdx.x; vb < 64; vb += gridDim.x) rwkv_chunk_unit<0>(p, lds, vb); grid.sync(); }
    if (IN(3) && MK_DUP == 203) { grid.sync(); for (int vb = blockIdx.x; vb < 128; vb += gridDim.x) gla_unit<0>(p, lds, vb); grid.sync(); }
    PHASE(4, phase_mlstm_post(p); phase_rwkv_post2(p, lds);)
    PHASE(5, { EpiResid E{p.in[I_X], p.out, p.in[I_CTX], HC, MODV, 2, 0}; run_gemm(lds, COLS, (const bf16_t*)(ws + WS_W_EVOUT), NLAT, 1024, 1024, E); SEpiResid S{p.in[I_CTX], HC, MODV + 4 * 6144 + 2 * 1024}; small_gemm<false>(lds, COLS + (size_t)NLAT * 1024, (const bf16_t*)(ws + WS_W_EVOUT), NCTX, 1024, 1024, S); })
    PHASE(6, phase_modnorm(p, 0, 1, p.out, HC, NALL, false);)
    PHASE(7, { EpiSwiglu E{COLS, 0}; run_gemm(lds, ACT, (const bf16_t*)(ws + WS_W_UP), NLAT, 5632, 1024, E); SEpiSwiglu S{COLS}; small_gemm<true>(lds, ACT + (size_t)NLAT * 1024, (const bf16_t*)(ws + WS_W_UP), NCTX, 2816, 1024, S); })
    PHASE(8, { EpiResid E{p.out, p.out, HC, HC, MODV, 5, 0}; run_gemm(lds, COLS, (const bf16_t*)(ws + WS_W_DN), NLAT, 1024, 2816, E); SEpiResid S{HC, HC, MODV + 4 * 6144 + 5 * 1024}; small_gemm<false>(lds, COLS + (size_t)NLAT * 2816, (const bf16_t*)(ws + WS_W_DN), NCTX, 1024, 2816, S); })
    PHASE(9, phase_modnorm(p, 1, 0, p.out, HC, NALL, true);)
    PHASE(10, { EpiStore3 E{COLS, C1LD, 1 << 30, COLS, C1LD, 1 << 30, COLS, C1LD, 0}; run_gemm(lds, ACT, (const bf16_t*)(ws + WS_W_ODIN), NLAT, 3584, 1024, E); SEpiStore3 S{COLS, C1LD, 1 << 30, COLS, C1LD, 1 << 30, COLS, C1LD}; small_gemm<false>(lds, ACT + (size_t)NLAT * 1024, (const bf16_t*)(ws + WS_W_ODIN), NCTX, 3584, 1024, S); })
    PHASE(11, phase_hgrn_prep2(p, lds); lru_pass<1>(p, lds, (int)blockIdx.x, (int)gridDim.x);)
    PHASE(12, { const int half = (int)gridDim.x >> 1; if ((int)blockIdx.x < half) { for (int u = blockIdx.x; u < 128; u += half) gla_unit<1>(p, lds, u); } else lru_pass<3>(p, lds, (int)blockIdx.x - half, (int)gridDim.x - half); })
    if (IN(12) && MK_DUP == 112) { grid.sync(); lru_pass<3>(p, lds, (int)blockIdx.x, (int)gridDim.x); grid.sync(); }
    if (IN(12) && MK_DUP == 212) { grid.sync(); for (int vb = blockIdx.x; vb < 128; vb += gridDim.x) gla_unit<1>(p, lds, vb); grid.sync(); }
    PHASE(13, phase_hgrn_post(p);)
    PHASE(14, EpiResid E{p.out, p.out, HC, HC, MODV + 5 * 6144, 2, 0}; run_gemm(lds, Y1, (const bf16_t*)(ws + WS_W_ODOUT), NLAT, 1024, 1024, E);)
    PHASE(15, phase_modnorm(p, 1, 1, p.out, HC, NLAT, false);)
    PHASE(16, EpiSwiglu E{COLS, 0}; run_gemm(lds, ACT, (const bf16_t*)(ws + WS_W_UP) + W_UP_STRIDE, NLAT, 5632, 1024, E);)
    PHASE(17, EpiResid E{p.out, p.out, HC, HC, MODV + 5 * 6144, 5, 0}; run_gemm(lds, COLS, (const bf16_t*)(ws + WS_W_DN) + W_DN_STRIDE, NLAT, 1024, 2816, E);)
    PHASE(18, phase_finalnorm(p);)
    if (hi > 4096) grid.sync();
#undef IN
#undef SEAM
}
}

#ifndef MK_ONE_LAUNCH
#define MK_ONE_LAUNCH 1
#endif
extern "C" void kernel_launch(void* const* d_in, const int* in_sizes, int n_in, void* d_out, int out_size, void* d_ws, size_t ws_size, hipStream_t stream) {
    using namespace mk;
    static int grid = 0;
    if (grid == 0) {
        int dev = 0, cus = 0, per_cu = 0;
        if (n_in != N_IN || ws_size < WS_END) { fprintf(stderr, "kernel_launch: unexpected n_in %d / ws_size %zu\n", n_in, ws_size); grid = -1; return; }
        (void)hipGetDevice(&dev); (void)hipDeviceGetAttribute(&cus, hipDeviceAttributeMultiprocessorCount, dev);
        (void)hipFuncSetAttribute((const void*)mk_fwd, hipFuncAttributeMaxDynamicSharedMemorySize, LDS_BYTES);
        (void)hipOccupancyMaxActiveBlocksPerMultiprocessor(&per_cu, (const void*)mk_fwd, NT, LDS_BYTES);
        if (per_cu < 1) { fprintf(stderr, "kernel_launch: occupancy query says %d blocks per CU\n", per_cu); per_cu = 1; }
        (void)hipGetLastError();
        grid = cus;
    }
    if (grid < 0) return;
    if (hipMemsetAsync((char*)d_ws + WS_CTL, 0, 65536, stream) != hipSuccess) { fprintf(stderr, "kernel_launch: memset of the control words failed\n"); return; }
    P p{};
    for (int i = 0; i < N_IN; ++i) p.in[i] = (const float*)d_in[i];
    p.out = (float*)d_out; p.ws = (unsigned char*)d_ws;
#if MK_ONE_LAUNCH
    p.ph_lo = 0; p.ph_hi = N_PHASES;
    void* args[] = {&p};
    hipError_t e = hipLaunchCooperativeKernel((const void*)mk_fwd, dim3(grid), dim3(NT), args, LDS_BYTES, stream);
    if (e != hipSuccess) fprintf(stderr, "cooperative launch failed: %s (grid %d)\n", hipGetErrorString(e), grid);
#else
    for (int k = 0; k < N_PHASES; ++k) { p.ph_lo = k; p.ph_hi = k + 1; hipLaunchKernelGGL(mk_fwd, dim3(grid), dim3(NT), LDS_BYTES, stream, p); }
#endif
}
```

```cpp
#include <hip/hip_runtime.h>
#include <hip/hip_cooperative_groups.h>
#include <cstdio>
#include <cstdint>
__device__ __forceinline__ int mk_tid() { int t = threadIdx.x; asm volatile("" : "+v"(t)); return t; }
#define MK_DUP -1
#define MK_RDUP -1
#define MK_STAG 0
#define MK_TPROBE 0
#define MK_PTIME -1
namespace pg8 {
#define PG8_LAS __attribute__((address_space(3)))
typedef unsigned short bf16_t;
typedef short bf16x8 __attribute__((ext_vector_type(8)));
typedef float f32x4 __attribute__((ext_vector_type(4)));
typedef unsigned u32x4 __attribute__((ext_vector_type(4)));
constexpr int BM = 256, BK = 64, HALF = 128, HTB = HALF * BK * 2  , STAGE_BYTES = 8 * HTB, NXCD = 8, WGM = 8;

__host__ __device__ __forceinline__ int lds_byte(int r, int c) { const int st = (r >> 4) * 2 + (c >> 5), rr = r & 15, cc = c & 31, ob = rr * 64 + cc * 2; return st * 1024 + (ob ^ (((ob >> 9) & 1) << 5)); }
__host__ __device__ __forceinline__ void stage_rc(int b, int& R, int& C) { const int st = b / 1024, sb = b % 1024, swz = sb ^ (((sb >> 9) & 1) << 5); R = (st >> 1) * 16 + swz / 64; C = (st & 1) * 32 + (swz % 64) / 2; }
__host__ __device__ __forceinline__ int perm32(int rho) { const int n = rho >> 4, i = rho & 15; return 8 * (i >> 2) + 4 * n + (i & 3); }

struct Unit { int pm, pn; };
struct Gemm { const bf16_t* A; const bf16_t* Bt; int M, N, K; };

struct StaticOrder {
    int nM, nN, nwg, G, c;
    __host__ __device__ void init(int M, int N, int G_, int c_) { nM = M / BM; nN = N / BM; nwg = nM * nN; G = G_; c = c_; }
    __host__ __device__ bool next(int i, Unit& u) const {
        const long L = (long)i * G + c; if (L >= nwg) return false;
        int wgid = (int)L; { const int q = nwg / NXCD, r = nwg % NXCD, xcd = wgid % NXCD, off = wgid / NXCD; wgid = (xcd < r ? xcd * (q + 1) : r * (q + 1) + (xcd - r) * q) + off; }
        const int nig = WGM * nN, gid = wgid / nig, fm = gid * WGM, gsz = (nM - fm) < WGM ? (nM - fm) : WGM;
        u.pm = fm + ((wgid % nig) % gsz); u.pn = (wgid % nig) / gsz; return true;
    }
    __device__ __forceinline__ void a_ready(const Unit&) const {}
    __device__ __forceinline__ void done(const Unit&) const {}
};
__device__ __forceinline__ unsigned cvt_pk_bf16(float lo, float hi) { unsigned r; asm volatile("v_cvt_pk_bf16_f32 %0, %1, %2" : "=v"(r) : "v"(lo), "v"(hi)); return r; }
typedef float f32x2 __attribute__((ext_vector_type(2)));
template <class Epi, class Sched, bool STAMP = false>
__device__ __forceinline__ void gemm_phase(PG8_LAS unsigned char* lds, const Gemm g, const Sched& S, const Epi& E, unsigned long long* stamps) {
    const int tid = mk_tid(), wid = __builtin_amdgcn_readfirstlane(tid >> 6), lane = tid & 63, wr = wid >> 2, wc = wid & 3, fr = lane & 15, fq = lane >> 4;
    const int K = g.K, nt = K / BK;
    int ts_lo = 0, ts_hi = 0, nts = 0; const unsigned long long rt_entry = STAMP ? (unsigned long long)wall_clock64() : 0ull;
#define PG8_STAMP() do { if (STAMP && wid == 0 && nts < 64) { const unsigned long long _c = (unsigned long long)clock64(); \
        ts_lo = (lane == nts) ? (int)(unsigned)_c : ts_lo; ts_hi = (lane == nts) ? (int)(unsigned)(_c >> 32) : ts_hi; ++nts; } } while (0)
    PG8_STAMP();
    unsigned voffA[2], voffB[2];
#pragma unroll
    for (int i = 0; i < 2; ++i) { int R, C; stage_rc(tid * 16 + i * 8192, R, C); const int Rb = Epi::PERM ? ((R & ~31) + perm32(R & 31)) : R;
        voffA[i] = (unsigned)(R * K + C) * 2u; voffB[i] = (unsigned)(Rb * K + C) * 2u; }
    const size_t kstep = (size_t)(BK * 2);
    const size_t hstep = (size_t)HALF * K * 2;
    const size_t tstep = 2 * hstep;
    const unsigned ldsw = (unsigned)wid * 1024u;
    const int aoff = lds_byte(wr * 64 + fr, fq * 8), boff = lds_byte(wc * 32 + fr, fq * 8);
#define PG8_SA(b, h) (((b) * 2 + (h)) * HTB)
#define PG8_SB(b, h) ((4 + (b) * 2 + (h)) * HTB)
#define PG8_STAGE(bufoff, gbase, voff) do { _Pragma("unroll") for (int _i = 0; _i < 2; ++_i) \
        __builtin_amdgcn_global_load_lds((const unsigned*)((const char*)(gbase) + (voff)[_i]), (PG8_LAS unsigned*)(lds + (bufoff) + ldsw + _i * 8192), 16, 0, 0); } while (0)
#define PG8_LDA(dst, b, h) do { _Pragma("unroll") for (int m = 0; m < 4; ++m) _Pragma("unroll") for (int k = 0; k < 2; ++k) dst[m][k] = *(const PG8_LAS bf16x8*)(lds + PG8_SA(b, h) + aoff + m * 2048 + k * 1024); } while (0)
#define PG8_LDB(dst, b, h) do { _Pragma("unroll") for (int n = 0; n < 2; ++n) _Pragma("unroll") for (int k = 0; k < 2; ++k) dst[n][k] = *(const PG8_LAS bf16x8*)(lds + PG8_SB(b, h) + boff + n * 2048 + k * 1024); } while (0)
#define PG8_MMA(ai, bj, At, Bt) do { __builtin_amdgcn_s_setprio(1); _Pragma("unroll") for (int m = 0; m < 4; ++m) _Pragma("unroll") for (int n = 0; n < 2; ++n) _Pragma("unroll") for (int k = 0; k < 2; ++k) \
        acc[ai][bj][m][n] = __builtin_amdgcn_mfma_f32_16x16x32_bf16(Bt[n][k], At[m][k], acc[ai][bj][m][n], 0, 0, 0); __builtin_amdgcn_s_setprio(0); } while (0)
#define PG8_WAIT_V(n) asm volatile("s_waitcnt vmcnt(" #n ")" ::: "memory")
#define PG8_WAIT_L(n) asm volatile("s_waitcnt lgkmcnt(" #n ")" ::: "memory")
#define PG8_BAR __builtin_amdgcn_s_barrier()
#define PG8_SCHED __builtin_amdgcn_sched_barrier(0)
    Unit cur, nxt; int ui = 0;
    if (!S.next(0, cur)) return;
    f32x4 acc[2][2][4][2];
#pragma unroll
    for (int a = 0; a < 2; ++a)
#pragma unroll
        for (int b = 0; b < 2; ++b)
#pragma unroll
            for (int m = 0; m < 4; ++m)
#pragma unroll
                for (int n = 0; n < 2; ++n) acc[a][b][m][n] = (f32x4){0.f, 0.f, 0.f, 0.f};
    bf16x8 At[4][2], B0[2][2], B1[2][2];
    const char* cA = (const char*)g.A + (size_t)cur.pm * tstep; const char* cB = (const char*)g.Bt + (size_t)cur.pn * tstep;
    S.a_ready(cur);
    PG8_STAGE(PG8_SB(0, 0), cB, voffB); PG8_STAGE(PG8_SA(0, 0), cA, voffA); PG8_STAGE(PG8_SB(0, 1), cB + hstep, voffB); PG8_STAGE(PG8_SA(0, 1), cA + hstep, voffA);
    if (wr == 1) PG8_BAR;
    PG8_WAIT_V(4); PG8_BAR;
    PG8_STAGE(PG8_SB(1, 0), cB + kstep, voffB); PG8_STAGE(PG8_SA(1, 0), cA + kstep, voffA); PG8_STAGE(PG8_SB(1, 1), cB + hstep + kstep, voffB);
    PG8_WAIT_V(6); PG8_BAR;
    PG8_STAMP();
    for (;;) {
        const bool has_next = S.next(ui + 1, nxt);
        const char* nA = has_next ? (const char*)g.A + (size_t)nxt.pm * tstep : cA; const char* nB = has_next ? (const char*)g.Bt + (size_t)nxt.pn * tstep : cB;
        for (int t = 0; t < nt; t += 2) {
            const bool last = (t == nt - 2);
            const char* a1 = cA + (size_t)(t + 1) * kstep;
            const char* a2 = last ? nA : cA + (size_t)(t + 2) * kstep; const char* b2 = last ? nB : cB + (size_t)(t + 2) * kstep;
            const char* a3 = a2 + kstep; const char* b3 = b2 + kstep;
            if (last && has_next) S.a_ready(nxt);
            PG8_LDB(B0, 0, 0); PG8_SCHED; PG8_LDA(At, 0, 0); PG8_STAGE(PG8_SA(1, 1), a1 + hstep, voffA);
            PG8_WAIT_L(8); PG8_BAR; PG8_WAIT_L(0); PG8_MMA(0, 0, At, B0); PG8_BAR; PG8_SCHED;
            PG8_LDB(B1, 0, 1); PG8_STAGE(PG8_SB(0, 0), b2, voffB);
            PG8_BAR; PG8_WAIT_L(0); PG8_MMA(0, 1, At, B1); PG8_BAR;
            PG8_LDA(At, 0, 1); PG8_STAGE(PG8_SA(0, 0), a2, voffA);
            PG8_BAR; PG8_WAIT_L(0); PG8_MMA(1, 0, At, B0); PG8_BAR; PG8_SCHED;
            PG8_STAGE(PG8_SB(0, 1), b2 + hstep, voffB);
            PG8_WAIT_V(6); PG8_BAR; PG8_MMA(1, 1, At, B1); PG8_BAR;
            PG8_LDB(B0, 1, 0); PG8_SCHED; PG8_LDA(At, 1, 0); PG8_STAGE(PG8_SA(0, 1), a2 + hstep, voffA);
            PG8_WAIT_L(8); PG8_BAR; PG8_WAIT_L(0); PG8_MMA(0, 0, At, B0); PG8_BAR; PG8_SCHED;
            PG8_LDB(B1, 1, 1); PG8_STAGE(PG8_SB(1, 0), b3, voffB);
            PG8_BAR; PG8_WAIT_L(0); PG8_MMA(0, 1, At, B1); PG8_BAR;
            PG8_LDA(At, 1, 1); PG8_STAGE(PG8_SA(1, 0), a3, voffA);
            PG8_BAR; PG8_WAIT_L(0); PG8_MMA(1, 0, At, B0); PG8_BAR; PG8_SCHED;
            PG8_STAGE(PG8_SB(1, 1), b3 + hstep, voffB);
            PG8_WAIT_V(6); PG8_BAR; PG8_MMA(1, 1, At, B1); PG8_BAR;
        }
        PG8_STAMP();
        if constexpr (!Epi::AFTER_DRAIN) { E(acc, cur, wr, wc, fr, fq); S.done(cur); }
        PG8_STAMP();
        if (!has_next) break;
#pragma unroll
        for (int a = 0; a < 2; ++a)
#pragma unroll
            for (int b = 0; b < 2; ++b)
#pragma unroll
                for (int m = 0; m < 4; ++m)
#pragma unroll
                    for (int n = 0; n < 2; ++n) acc[a][b][m][n] = (f32x4){0.f, 0.f, 0.f, 0.f};
        cur = nxt; cA = nA; cB = nB; ++ui;
    }
    PG8_WAIT_V(0);
    if (wr == 0) PG8_BAR;
    PG8_BAR;
    if constexpr (Epi::AFTER_DRAIN) { E.fused(acc, cur, wr, wc, fr, fq, lds, wid, lane); S.done(cur); }
    PG8_STAMP();
    if (STAMP && wid == 0) { stamps[lane] = lane < nts ? (((unsigned long long)(unsigned)ts_hi << 32) | (unsigned)ts_lo) : 0ull;
        if (lane == 62) stamps[62] = rt_entry; if (lane == 63) stamps[63] = (unsigned long long)wall_clock64(); }
#undef PG8_STAMP
#undef PG8_SA
#undef PG8_SB
#undef PG8_STAGE
#undef PG8_LDA
#undef PG8_LDB
#undef PG8_MMA
#undef PG8_WAIT_V
#undef PG8_WAIT_L
#undef PG8_BAR
#undef PG8_SCHED
}
}

namespace mk {
#define DI __device__ __forceinline__
#define LAS __attribute__((address_space(3)))
typedef unsigned short bf16_t;
typedef float f32x4 __attribute__((ext_vector_type(4)));
typedef unsigned u32x2 __attribute__((ext_vector_type(2)));
typedef unsigned u32x4 __attribute__((ext_vector_type(4)));

constexpr int D = 1024, NB = 4, L = 8192, LC = 256, NLAT = NB * L, NCTX = NB * LC, NALL = NLAT + NCTX, LT = L + LC, DFF = 2816;
constexpr int NT = 512;
constexpr size_t MiB = (size_t)1 << 20;
constexpr size_t WS_CTL = 0, WS_MODV = 1 * MiB, WS_HC = 2 * MiB, WS_W_EVIN = 6 * MiB, WS_W_EVOUT = 14 * MiB, WS_W_ODIN = 16 * MiB, WS_W_ODOUT = 23 * MiB,
                 WS_W_UP = 25 * MiB, WS_W_DN = 47 * MiB, WS_ACT = 58 * MiB, WS_COLS = 124 * MiB, WS_Z = 388 * MiB, WS_Z1 = 454 * MiB, WS_LAM = 486 * MiB, WS_LSUM = 489 * MiB, WS_LCAR = 494 * MiB, WS_SSQP = 497 * MiB, WS_GSC = 504 * MiB, WS_END = 505 * MiB;
constexpr size_t SSQP_STRIDE = (size_t)NALL * 16, GSC_STRIDE = 5 * 1024, SHW_OFF = 3 * GSC_STRIDE, SHW_STRIDE = 5 * 5632;
constexpr size_t W_UP_STRIDE = (size_t)5632 * 1024, W_DN_STRIDE = (size_t)1024 * 2816;
constexpr size_t OFF_RW = 0, OFF_LO = (size_t)NALL * 1536, OFF_ML = OFF_LO + (size_t)NALL * 512;
constexpr int LDS_BYTES = 163840;
constexpr int C1LD = 3584;
DI int nat_row(int r) { const int b = r / L, pp = r % L; return b * L + (pp % 128) * 64 + pp / 128; }

enum { I_X = 0, I_C, I_CTX, I_CCTX, I_N1G, I_N2G, I_MODW, I_MODB, I_W1, I_W3, I_W2, I_FING, I_EVIN, I_EVOUT, I_MU, I_W0, I_W2L, I_A0, I_A2L, I_KK, I_KA, I_RK,
       I_LNW, I_LNB, I_G2, I_MBI, I_MBF, I_MNG, I_ODIN, I_ODOUT, I_HLB, I_HNG, I_CONVW, I_CONVB, I_WA, I_BA, I_WI, I_BI, I_LAM, N_IN };

struct P { const float* in[N_IN]; float* out; unsigned char* ws; int ph_lo, ph_hi; };

DI float bf2f(bf16_t v) { return __uint_as_float(((unsigned)v) << 16); }
typedef float f32x2_t __attribute__((ext_vector_type(2)));
typedef __bf16 bf16x2_t __attribute__((ext_vector_type(2)));
DI unsigned pack2(float lo, float hi) { const f32x2_t v = {lo, hi}; return __builtin_bit_cast(unsigned, __builtin_convertvector(v, bf16x2_t)); }
DI bf16_t f2bf(float f) { return (bf16_t)(pack2(f, f) & 0xffffu); }
DI float sigm(float x) { return 1.f / (1.f + expf(-x)); }
DI float siluf(float x) { return x * sigm(x); }
DI float geluf(float x) { return 0.5f * x * (1.f + tanhf(0.7978845608028654f * (x + 0.044715f * x * x * x))); }
DI float fexp(float x) { return __builtin_amdgcn_exp2f(x * 1.4426950408889634f); }
DI float frcp(float x) { return __builtin_amdgcn_rcpf(x); }
DI float fsigm(float x) { return frcp(1.f + fexp(-x)); }
DI float ftanh(float x) { return 1.f - 2.f * frcp(1.f + fexp(2.f * x)); }
DI float fgelu(float x) { return 0.5f * x * (1.f + ftanh(0.7978845608028654f * (x + 0.044715f * x * x * x))); }
template <int CTRL> DI float dppf(float x) { return __int_as_float(__builtin_amdgcn_update_dpp(0, __float_as_int(x), CTRL, 0xF, 0xF, false)); }
DI float sum8(float s) { s += dppf<0xB1>(s); s += dppf<0x4E>(s); s += dppf<0x141>(s); return s; }
DI float scan16(float x) { x += dppf<0x111>(x); x += dppf<0x112>(x); x += dppf<0x114>(x); x += dppf<0x118>(x); return x; }
DI float wave_sum(float v) { v += dppf<0xB1>(v); v += dppf<0x4E>(v); v += dppf<0x141>(v); v += dppf<0x140>(v); v += __shfl_xor(v, 16); v += __shfl_xor(v, 32); return v; }
DI int step_row(int d, int b, int n) {
    if (n < LC) return NLAT + b * LC + (d ? LC - 1 - n : n);
    const int m = n - LC; return b * L + (d ? L - 1 - m : m);
}
DI void sub_signal(unsigned* cnt) { asm volatile("s_waitcnt vmcnt(0)" ::: "memory"); __syncthreads();
    if (threadIdx.x == 0) { __builtin_amdgcn_fence(__ATOMIC_RELEASE, "agent"); asm volatile("s_waitcnt vmcnt(0)" ::: "memory"); (void)__hip_atomic_fetch_add(cnt, 1u, __ATOMIC_RELAXED, __HIP_MEMORY_SCOPE_AGENT); } }
DI void sub_wait(unsigned* cnt, unsigned want) {
    if (threadIdx.x == 0) { unsigned spins = 0u; while (__hip_atomic_load(cnt, __ATOMIC_RELAXED, __HIP_MEMORY_SCOPE_AGENT) < want) { __builtin_amdgcn_s_sleep(2); if (++spins > (1u << 22)) break; }
        __builtin_amdgcn_fence(__ATOMIC_ACQUIRE, "agent"); asm volatile("s_waitcnt vmcnt(0)" ::: "memory"); }
    __syncthreads(); }
DI int matN(int m) { return m == 0 ? 4096 : m == 1 ? 1024 : m == 2 ? 3584 : m == 3 ? 1024 : m < 6 ? 5632 : 1024; }
DI int matK(int m) { return m < 6 ? 1024 : 2816; }
DI int matTile0(int m) { return m == 0 ? 0 : m == 1 ? 1024 : m == 2 ? 1280 : m == 3 ? 2176 : m == 4 ? 2432 : m == 5 ? 3840 : m == 6 ? 5248 : m == 7 ? 5952 : 6656; }
DI size_t matOff(int m) { return m == 0 ? WS_W_EVIN : m == 1 ? WS_W_EVOUT : m == 2 ? WS_W_ODIN : m == 3 ? WS_W_ODOUT : m == 4 ? WS_W_UP : m == 5 ? WS_W_UP + W_UP_STRIDE * 2 : m == 6 ? WS_W_DN : WS_W_DN + W_DN_STRIDE * 2; }
DI const float* matSrc(const P& p, int m, int n, int& ld) {
    if (m == 0) { ld = 3984; int col; if (n < 1920) col = n; else if (n < 1936) col = 3968 + (n - 1920); else if (n < 2048) return nullptr; else col = 1920 + (n - 2048); return p.in[I_EVIN] + col; }
    if (m == 1) { ld = 1024; return p.in[I_EVOUT] + n; }
    if (m == 2) { ld = 3584; return p.in[I_ODIN] + n; }
    if (m == 3) { ld = 1024; return p.in[I_ODOUT] + n; }
    if (m < 6) { ld = 2816; const int l = m - 4, pn = n >> 8, w = n & 255; const size_t lo = (size_t)l * 1024 * 2816; return (w < 128) ? p.in[I_W1] + lo + 128 * pn + w : p.in[I_W3] + lo + 128 * pn + (w - 128); }
    ld = 1024; return p.in[I_W2] + (size_t)(m - 6) * 2816 * 1024 + n;
}
DI void phase_wprep(const P& p, LAS unsigned char* ldsb) {
    LAS float* tile = (LAS float*)ldsb;
    const int tid = mk_tid(), tx = tid & 63, ty = tid >> 6;
    float v[8]; bf16_t* Bt = nullptr; int K = 0, n0 = 0, k0 = 0;
#define WP_LOAD(item_) do { const int it_ = (item_); int m = 0; \
        _Pragma("unroll") for (int q = 1; q < 8; ++q) if (it_ >= matTile0(q)) m = q; \
        const int local = it_ - matTile0(m), K_ = matK(m), nK = K_ >> 6, nb = local / nK, kb = local - nb * nK; \
        nBt = (bf16_t*)(p.ws + matOff(m)); nK_ = K_; nn0 = nb * 64; nk0 = kb * 64; \
        int ld; const float* src = matSrc(p, m, nn0 + tx, ld); \
        _Pragma("unroll") for (int i = 0; i < 8; ++i) { const int k = nk0 + ty + 8 * i; v[i] = src ? src[(size_t)k * ld] : 0.f; } } while (0)
    bf16_t* nBt = nullptr; int nK_ = 0, nn0 = 0, nk0 = 0;
    int item = blockIdx.x;
    if (item < 6656) WP_LOAD(item);
    for (; item < 6656; item += gridDim.x) {
        Bt = nBt; K = nK_; n0 = nn0; k0 = nk0;
        __syncthreads();
#pragma unroll
        for (int i = 0; i < 8; ++i) tile[(ty + 8 * i) * 65 + tx] = v[i];
        if (item + (int)gridDim.x < 6656) WP_LOAD(item + (int)gridDim.x);
        __syncthreads();
        const int kp = 2 * (tid & 31), nr = tid >> 5;
#pragma unroll
        for (int i = 0; i < 4; ++i) { const int nn = nr + 16 * i; *(unsigned*)(Bt + (size_t)(n0 + nn) * K + k0 + kp) = pack2(tile[kp * 65 + nn], tile[(kp + 1) * 65 + nn]); }
    }
#undef WP_LOAD
    __syncthreads();
}
DI void phase_modv(const P& p, LAS unsigned char* ldsb) {
    LAS float* sc = (LAS float*)ldsb;
    LAS float* part = sc + 5 * 1024;
    const int tid = mk_tid(), lane = tid & 63, wv = tid >> 6;
    float* MODV = (float*)(p.ws + WS_MODV);
    if ((int)blockIdx.x >= 192) return;
    __syncthreads();
    for (int e = tid; e < 5 * 1024; e += NT) { const int s = e >> 10, k = e & 1023; const float v = (s < 4) ? p.in[I_C][s * 1024 + k] : p.in[I_CCTX][k]; sc[e] = siluf(v); }
    __syncthreads();
    for (int vb = blockIdx.x; vb < 192; vb += gridDim.x) {
        const int l = vb / 96, n = (vb % 96) * 64 + lane;
        const float* W = p.in[I_MODW] + (size_t)l * 1024 * 6144 + (size_t)(128 * wv) * 6144 + n;
        float a0 = 0.f, a1 = 0.f, a2 = 0.f, a3 = 0.f, a4 = 0.f;
#pragma unroll 16
        for (int k = 0; k < 128; ++k) { const float w = W[(size_t)k * 6144]; const int kk = 128 * wv + k; a0 += sc[kk] * w; a1 += sc[1024 + kk] * w; a2 += sc[2048 + kk] * w; a3 += sc[3072 + kk] * w; a4 += sc[4096 + kk] * w; }
        __syncthreads();
        part[(wv * 5 + 0) * 64 + lane] = a0; part[(wv * 5 + 1) * 64 + lane] = a1; part[(wv * 5 + 2) * 64 + lane] = a2; part[(wv * 5 + 3) * 64 + lane] = a3; part[(wv * 5 + 4) * 64 + lane] = a4;
        __syncthreads();
        if (tid < 320) { const int s = tid >> 6; float t = p.in[I_MODB][l * 6144 + (vb % 96) * 64 + lane];
#pragma unroll
            for (int w8 = 0; w8 < 8; ++w8) t += part[(w8 * 5 + s) * 64 + lane];
            MODV[(size_t)l * 5 * 6144 + s * 6144 + (vb % 96) * 64 + lane] = t; }
    }
    __syncthreads();
}

DI void mn_unpack(const u32x4 w, f32x4& a, f32x4& b) {
    a[0] = __uint_as_float(w.x << 16); a[1] = __uint_as_float(w.x & 0xffff0000u); a[2] = __uint_as_float(w.y << 16); a[3] = __uint_as_float(w.y & 0xffff0000u);
    b[0] = __uint_as_float(w.z << 16); b[1] = __uint_as_float(w.z & 0xffff0000u); b[2] = __uint_as_float(w.w << 16); b[3] = __uint_as_float(w.w & 0xffff0000u);
}
template <bool SB> DI void phase_modnorm(const P& p, int layer, int which, const void* hlat, const float* hctx, int nrows, bool permute) {
    const int lane = mk_tid() & 63, wv = mk_tid() >> 6;
    const float* MODV = (const float*)(p.ws + WS_MODV) + (size_t)layer * 5 * 6144;
    const float* g = p.in[which ? I_N2G : I_N1G] + layer * 1024;
    bf16_t* ACT = (bf16_t*)(p.ws + WS_ACT);
    f32x4 gs[4], sh[4]; int sv_have = -1;
    const int rstep = gridDim.x * 8; int r = blockIdx.x * 8 + wv;
    f32x4 v[4], vf[4]; u32x4 vb[2];
#define MN_LOADF(dst, src) { _Pragma("unroll") for (int jj = 0; jj < 4; ++jj) dst[jj] = *(const f32x4*)((src) + 8 * lane + 512 * (jj >> 1) + 4 * (jj & 1)); }
#define MN_LOADB(dst, src) { dst[0] = *(const u32x4*)((src) + 8 * lane); dst[1] = *(const u32x4*)((src) + 8 * lane + 512); }
#define MN_ROW(rr, dr, sv) { \
        if ((sv) != sv_have) { sv_have = (sv); const float* shift = MODV + (sv) * 6144 + (which ? 3 : 0) * 1024; const float* scale = shift + 1024; \
            _Pragma("unroll") for (int jj = 0; jj < 4; ++jj) { const int c = 8 * lane + 512 * (jj >> 1) + 4 * (jj & 1); const f32x4 gg = *(const f32x4*)(g + c), sc = *(const f32x4*)(scale + c); gs[jj] = gg * (sc + 1.f); sh[jj] = *(const f32x4*)(shift + c); } } \
        float ss = 0.f; \
        _Pragma("unroll") for (int jj = 0; jj < 4; ++jj) ss += (v[jj].x * v[jj].x + v[jj].y * v[jj].y) + (v[jj].z * v[jj].z + v[jj].w * v[jj].w); \
        const float rinv = rsqrtf(wave_sum(ss) * (1.f / D) + 1e-6f); \
        _Pragma("unroll") for (int j = 0; j < 2; ++j) { const f32x4 o0 = v[2 * j] * rinv * gs[2 * j] + sh[2 * j], o1 = v[2 * j + 1] * rinv * gs[2 * j + 1] + sh[2 * j + 1]; \
            u32x4 w; w.x = pack2(o0[0], o0[1]); w.y = pack2(o0[2], o0[3]); w.z = pack2(o1[0], o1[1]); w.w = pack2(o1[2], o1[3]); \
            *(u32x4*)(ACT + (size_t)(dr) * D + 8 * lane + 512 * j) = w; } }
    if (r < NLAT) { if (SB) MN_LOADB(vb, (const bf16_t*)hlat + (size_t)r * D) else MN_LOADF(vf, (const float*)hlat + (size_t)r * D) }
    for (; r < NLAT; r += rstep) {
        if (SB) { mn_unpack(vb[0], v[0], v[1]); mn_unpack(vb[1], v[2], v[3]); } else {
#pragma unroll
            for (int jj = 0; jj < 4; ++jj) v[jj] = vf[jj]; }
        if (r + rstep < NLAT) { if (SB) MN_LOADB(vb, (const bf16_t*)hlat + (size_t)(r + rstep) * D) else MN_LOADF(vf, (const float*)hlat + (size_t)(r + rstep) * D) }
        int dr = r;
        if (permute) { const int b = r / L, t = r % L; dr = b * L + (t % 64) * 128 + t / 64; }
        MN_ROW(r, dr, r / L)
    }
    for (r = NLAT + blockIdx.x * 8 + wv; r < nrows; r += rstep) {
        MN_LOADF(v, hctx + (size_t)(r - NLAT) * D)
        MN_ROW(r, r, 4)
    }
#undef MN_ROW
}
DI void phase_finalnorm(const P& p) {
    const int lane = mk_tid() & 63, wv = mk_tid() >> 6;
    const float* g = p.in[I_FING]; const bf16_t* RES = (const bf16_t*)(p.ws + WS_Z);
    f32x4 gg[4];
#pragma unroll
    for (int jj = 0; jj < 4; ++jj) gg[jj] = *(const f32x4*)(g + 8 * lane + 512 * (jj >> 1) + 4 * (jj & 1));
    const int rstep = gridDim.x * 8; int r = blockIdx.x * 8 + wv;
    f32x4 v[4]; u32x4 vb[2];
    if (r < NLAT) MN_LOADB(vb, RES + (size_t)r * D)
    for (; r < NLAT; r += rstep) {
        mn_unpack(vb[0], v[0], v[1]); mn_unpack(vb[1], v[2], v[3]);
        if (r + rstep < NLAT) MN_LOADB(vb, RES + (size_t)(r + rstep) * D)
        float ss = 0.f;
#pragma unroll
        for (int jj = 0; jj < 4; ++jj) ss += (v[jj].x * v[jj].x + v[jj].y * v[jj].y) + (v[jj].z * v[jj].z + v[jj].w * v[jj].w);
        const float rinv = rsqrtf(wave_sum(ss) * (1.f / D) + 1e-6f);
#pragma unroll
        for (int jj = 0; jj < 4; ++jj) *(f32x4*)(p.out + (size_t)r * D + 8 * lane + 512 * (jj >> 1) + 4 * (jj & 1)) = v[jj] * rinv * gg[jj];
    }
}
#undef MN_LOADF
#undef MN_LOADB

struct EpiStore3 {
    static constexpr bool PERM = true, AFTER_DRAIN = false;
    bf16_t* p0; int ld0; int pn1; bf16_t* p1; int ld1; int pn2; bf16_t* p2; int ld2; int pm0;
    DI void operator()(const f32x4 (&acc)[2][2][4][2], const pg8::Unit& u, int wr, int wc, int fr, int fq) const {
        bf16_t* base; int ld, ct;
        if (u.pn >= pn2) { base = p2; ld = ld2; ct = u.pn - pn2; } else if (u.pn >= pn1) { base = p1; ld = ld1; ct = u.pn - pn1; } else { base = p0; ld = ld0; ct = u.pn; }
        const int row0 = (u.pm + pm0) * 256 + wr * 64 + fr, col0 = ct * 256 + wc * 32 + 8 * fq;
#pragma unroll
        for (int ai = 0; ai < 2; ++ai)
#pragma unroll
            for (int m = 0; m < 4; ++m) { bf16_t* rowp = base + (size_t)(row0 + ai * 128 + m * 16) * ld + col0;
#pragma unroll
                for (int bj = 0; bj < 2; ++bj) { const f32x4 v0 = acc[ai][bj][m][0], v1 = acc[ai][bj][m][1];
                    u32x4 w; w.x = pack2(v0[0], v0[1]); w.y = pack2(v0[2], v0[3]); w.z = pack2(v1[0], v1[1]); w.w = pack2(v1[2], v1[3]); *(u32x4*)(rowp + bj * 128) = w; if (MK_RDUP == 20) { asm volatile("" ::: "memory"); *(u32x4*)(rowp + bj * 128) = w; asm volatile("" ::: "memory"); } } }
    }
};
struct EpiResid {
    static constexpr bool PERM = false, AFTER_DRAIN = false;
    const float* hin; float* hout; const float* cin; float* cout; const float* modv_l; int gidx; int pm0;
    DI void operator()(const f32x4 (&acc)[2][2][4][2], const pg8::Unit& u, int wr, int wc, int fr, int fq) const {
        const int pm = u.pm + pm0; const bool isctx = pm >= 128; const int sv = isctx ? 4 : (pm >> 5);
        const float* gate = modv_l + sv * 6144 + gidx * 1024;
        const float* bi = isctx ? cin : hin; float* bo = isctx ? cout : hout;
        const int row0 = (isctx ? (pm - 128) : pm) * 256 + wr * 64 + fr, col0 = u.pn * 256 + wc * 32 + 4 * fq;
        f32x4 gv[2][2];
#pragma unroll
        for (int bj = 0; bj < 2; ++bj)
#pragma unroll
            for (int n = 0; n < 2; ++n) gv[bj][n] = *(const f32x4*)(gate + col0 + bj * 128 + n * 16);
#pragma unroll
        for (int ai = 0; ai < 2; ++ai)
#pragma unroll
            for (int m = 0; m < 4; ++m) { const size_t off = (size_t)(row0 + ai * 128 + m * 16) * D + col0;
#pragma unroll
                for (int bj = 0; bj < 2; ++bj)
#pragma unroll
                    for (int n = 0; n < 2; ++n) { const f32x4 bs = *(const f32x4*)(bi + off + bj * 128 + n * 16); *(f32x4*)(bo + off + bj * 128 + n * 16) = bs + gv[bj][n] * acc[ai][bj][m][n]; } }
    }
};
template <bool SB> struct EpiResidB {
    static constexpr bool PERM = true, AFTER_DRAIN = false;
    const void* hin; bf16_t* hout; const float* modv_l; int gidx;
    DI void operator()(const f32x4 (&acc)[2][2][4][2], const pg8::Unit& u, int wr, int wc, int fr, int fq) const {
        const float* gate = modv_l + (u.pm >> 5) * 6144 + gidx * 1024;
        const int row0 = u.pm * 256 + wr * 64 + fr, col0 = u.pn * 256 + wc * 32 + 8 * fq;
        f32x4 gv[2][2];
#pragma unroll
        for (int bj = 0; bj < 2; ++bj)
#pragma unroll
            for (int n = 0; n < 2; ++n) gv[bj][n] = *(const f32x4*)(gate + col0 + bj * 128 + 4 * n);
#pragma unroll
        for (int ai = 0; ai < 2; ++ai)
#pragma unroll
            for (int m = 0; m < 4; ++m) { const size_t off = (size_t)(row0 + ai * 128 + m * 16) * D + col0;
#pragma unroll
                for (int bj = 0; bj < 2; ++bj) { f32x4 b0, b1;
                    if (SB) mn_unpack(*(const u32x4*)((const bf16_t*)hin + off + bj * 128), b0, b1);
                    else { b0 = *(const f32x4*)((const float*)hin + off + bj * 128); b1 = *(const f32x4*)((const float*)hin + off + bj * 128 + 4); }
                    const f32x4 h0 = b0 + gv[bj][0] * acc[ai][bj][m][0], h1 = b1 + gv[bj][1] * acc[ai][bj][m][1];
                    u32x4 w; w.x = pack2(h0[0], h0[1]); w.y = pack2(h0[2], h0[3]); w.z = pack2(h1[0], h1[1]); w.w = pack2(h1[2], h1[3]);
                    *(u32x4*)(hout + off + bj * 128) = w; } }
    }
};
struct EpiResidN {
    static constexpr bool PERM = false, AFTER_DRAIN = false;
    const float* hin; float* hout; const float* cin; float* cout; const float* modv_l; int gidx;
    bf16_t* act; const float* gsc; float* ssqp; int permute;
    DI void operator()(const f32x4 (&acc)[2][2][4][2], const pg8::Unit& u, int wr, int wc, int fr, int fq) const {
        const bool isctx = u.pm >= 128; const int sv = isctx ? 4 : (u.pm >> 5);
        const float* gate = modv_l + sv * 6144 + gidx * 1024; const float* gs = gsc + sv * 1024;
        const float* bi = isctx ? cin : hin; float* bo = isctx ? cout : hout;
        const int row0 = (isctx ? (u.pm - 128) : u.pm) * 256 + wr * 64 + fr, col0 = u.pn * 256 + wc * 32 + 4 * fq;
        f32x4 gv[2][2], gsv[2][2];
#pragma unroll
        for (int bj = 0; bj < 2; ++bj)
#pragma unroll
            for (int n = 0; n < 2; ++n) { gv[bj][n] = *(const f32x4*)(gate + col0 + bj * 128 + n * 16); gsv[bj][n] = *(const f32x4*)(gs + col0 + bj * 128 + n * 16); }
#pragma unroll
        for (int ai = 0; ai < 2; ++ai)
#pragma unroll
            for (int m = 0; m < 4; ++m) { const int rl = row0 + ai * 128 + m * 16; const size_t off = (size_t)rl * D + col0;
                int arow = u.pm * 256 + wr * 64 + fr + ai * 128 + m * 16;
                if (permute && !isctx) { const int b = arow / L, t = arow % L; arow = b * L + (t % 64) * 128 + t / 64; }
                float ss = 0.f;
#pragma unroll
                for (int bj = 0; bj < 2; ++bj)
#pragma unroll
                    for (int n = 0; n < 2; ++n) { const f32x4 bs = *(const f32x4*)(bi + off + bj * 128 + n * 16); const f32x4 hn = bs + gv[bj][n] * acc[ai][bj][m][n];
                        *(f32x4*)(bo + off + bj * 128 + n * 16) = hn; ss += (hn[0] * hn[0] + hn[1] * hn[1]) + (hn[2] * hn[2] + hn[3] * hn[3]);
                        const f32x4 an = hn * gsv[bj][n]; u32x2 w; w.x = pack2(an[0], an[1]); w.y = pack2(an[2], an[3]); *(u32x2*)(act + (size_t)arow * D + col0 + bj * 128 + n * 16) = w; }
                ss += __shfl_xor(ss, 16); ss += __shfl_xor(ss, 32);
                if (fq == 0) ssqp[(size_t)arow * 16 + u.pn * 4 + wc] = ss; }
    }
};
struct EpiSwiglu {
    static constexpr bool PERM = true, AFTER_DRAIN = false;
    bf16_t* G; int pm0;
    DI void operator()(const f32x4 (&acc)[2][2][4][2], const pg8::Unit& u, int wr, int wc, int fr, int fq) const {
        const int row0 = (u.pm + pm0) * 256 + wr * 64 + fr, col0 = u.pn * 128 + wc * 32 + 8 * fq;
#pragma unroll
        for (int ai = 0; ai < 2; ++ai)
#pragma unroll
            for (int m = 0; m < 4; ++m) { bf16_t* rowp = G + (size_t)(row0 + ai * 128 + m * 16) * DFF + col0; float g[8];
#pragma unroll
                for (int n = 0; n < 2; ++n) { const f32x4 a = acc[ai][0][m][n], b = acc[ai][1][m][n];
#pragma unroll
                    for (int j = 0; j < 4; ++j) g[4 * n + j] = a[j] * frcp(1.f + fexp(-a[j])) * b[j]; }
                u32x4 w; w.x = pack2(g[0], g[1]); w.y = pack2(g[2], g[3]); w.z = pack2(g[4], g[5]); w.w = pack2(g[6], g[7]); *(u32x4*)rowp = w; }
    }
};
template <class Epi> DI void run_gemm(LAS unsigned char* lds, const bf16_t* A, const bf16_t* Bt, int M, int N, int K, const Epi& E, int stagger = 0) {
    for (int i = 0; i < stagger * (int)((blockIdx.x >> 3) & 7); ++i) __builtin_amdgcn_s_sleep(127);
    pg8::Gemm g{A, Bt, M, N, K}; pg8::StaticOrder S; S.init(M, N, (int)gridDim.x, (int)blockIdx.x);
    pg8::gemm_phase<Epi, pg8::StaticOrder, false>((PG8_LAS unsigned char*)lds, g, S, E, nullptr);
    __syncthreads();
}


DI void phase_norm_tables(const P& p) {
    const int tid = mk_tid(), lane = tid & 63, wv = tid >> 6;
    const float* MODV = (const float*)(p.ws + WS_MODV); float* GSC = (float*)(p.ws + WS_GSC); float* SHW = GSC + SHW_OFF;
    for (int e = blockIdx.x * NT + tid; e < 3 * 5 * 1024; e += gridDim.x * NT) { const int site = e / 5120, s = (e / 1024) % 5, c = e & 1023;
        const int layer = site ? 1 : 0, scidx = (site == 1) ? 1 : 4; const float g = p.in[(site == 1) ? I_N1G : I_N2G][layer * 1024 + c];
        GSC[e] = g * (1.f + MODV[(size_t)layer * 5 * 6144 + s * 6144 + scidx * 1024 + c]); }
    for (int w = blockIdx.x * 8 + wv; w < 5632 + 3584 + 5632; w += gridDim.x * 8) {
        int site, n; const bf16_t* Bt;
        if (w < 5632) { site = 0; n = w; Bt = (const bf16_t*)(p.ws + WS_W_UP); } else if (w < 5632 + 3584) { site = 1; n = w - 5632; Bt = (const bf16_t*)(p.ws + WS_W_ODIN); } else { site = 2; n = w - 5632 - 3584; Bt = (const bf16_t*)(p.ws + WS_W_UP) + W_UP_STRIDE; }
        const int layer = site ? 1 : 0, shidx = (site == 1) ? 0 : 3;
        const u32x4 w0 = *(const u32x4*)(Bt + (size_t)n * 1024 + 16 * lane), w1 = *(const u32x4*)(Bt + (size_t)n * 1024 + 16 * lane + 8);
        float wf[16];
#pragma unroll
        for (int k = 0; k < 4; ++k) { wf[2 * k] = __uint_as_float(w0[k] << 16); wf[2 * k + 1] = __uint_as_float(w0[k] & 0xffff0000u); wf[8 + 2 * k] = __uint_as_float(w1[k] << 16); wf[8 + 2 * k + 1] = __uint_as_float(w1[k] & 0xffff0000u); }
#pragma unroll
        for (int s = 0; s < 5; ++s) { const float* sh = MODV + (size_t)layer * 5 * 6144 + s * 6144 + shidx * 1024 + 16 * lane; float a = 0.f;
#pragma unroll
            for (int k = 0; k < 16; ++k) a += sh[k] * wf[k];
            a = wave_sum(a);
            if (lane == 0) SHW[(size_t)site * SHW_STRIDE + s * 5632 + n] = a; }
    }
}
DI void phase_rwkv_scan_unit(const P& p, LAS unsigned char* ldsb, const int vb) {
    LAS float* lds = (LAS float*)ldsb;
    LAS float *w2s = lds, *a2s = lds + 4096, *prm = lds + 8192, *TH = prm + 768, *AD = TH + 2048, *R = AD + 2048, *W = R + 2048, *K = W + 2048, *KK = K + 2048, *BV = KK + 2048,
              *V = BV + 2048, *BS = V + 2048, *OUT = BS + 32;
    const int tid = mk_tid(), lane = tid & 63, wv = tid >> 6;
    const bf16_t* RW = (const bf16_t*)(p.ws + WS_COLS) + OFF_RW; const bf16_t* LO = (const bf16_t*)(p.ws + WS_COLS) + OFF_LO; bf16_t* Z = (bf16_t*)((unsigned char*)p.out);
    const int srow = tid >> 3, sg = tid & 7;
    {
        const int d = vb >> 5, b = (vb >> 3) & 3, h = vb & 7;
        __syncthreads();
        for (int e = tid; e < 4096; e += NT) { const int i = e >> 6, c = e & 63; w2s[e] = p.in[I_W2L][(size_t)(d * 64 + i) * 512 + 64 * h + c]; a2s[e] = p.in[I_A2L][(size_t)(d * 64 + i) * 512 + 64 * h + c]; }
        if (tid < 64) { const int j = tid, c = 64 * h + j; const float* mu = p.in[I_MU] + d * 1664;
            prm[j] = mu[c]; prm[64 + j] = mu[512 + c]; prm[128 + j] = mu[1024 + c]; prm[192 + j] = mu[1536 + j]; prm[256 + j] = mu[1600 + j];
            prm[320 + j] = p.in[I_W0][d * 512 + c]; prm[384 + j] = p.in[I_A0][d * 512 + c]; prm[448 + j] = p.in[I_KK][d * 512 + c]; prm[512 + j] = p.in[I_KA][d * 512 + c];
            prm[576 + j] = p.in[I_RK][(d * 8 + h) * 64 + j]; prm[640 + j] = p.in[I_LNW][d * 512 + c]; prm[704 + j] = p.in[I_LNB][d * 512 + c]; }
        __syncthreads();
        float S0 = 0.f, S1 = 0.f, S2 = 0.f, S3 = 0.f, S4 = 0.f, S5 = 0.f, S6 = 0.f, S7 = 0.f;
        for (int n0 = 0; n0 < LT; n0 += 32) {
            float rs[4], ks[4], vs[4];
#pragma unroll
            for (int m = 0; m < 4; ++m) { const int s = wv + 8 * m, n = n0 + s; const bool hp = (n != 0) && (n != LC);
                const size_t row = (size_t)step_row(d, b, n), prow = hp ? (size_t)step_row(d, b, n - 1) : row; const int c = 64 * h + lane;
                const float r0 = bf2f(RW[row * 1536 + c]), k0 = bf2f(RW[row * 1536 + 512 + c]), v0 = bf2f(RW[row * 1536 + 1024 + c]);
                const float r1 = hp ? bf2f(RW[prow * 1536 + c]) : 0.f, k1 = hp ? bf2f(RW[prow * 1536 + 512 + c]) : 0.f, v1 = hp ? bf2f(RW[prow * 1536 + 1024 + c]) : 0.f;
                rs[m] = r0 + prm[lane] * (r1 - r0); ks[m] = k0 + prm[64 + lane] * (k1 - k0); vs[m] = v0 + prm[128 + lane] * (v1 - v0);
                const float wd0 = bf2f(LO[row * 512 + 64 * d + lane]), wd1 = hp ? bf2f(LO[prow * 512 + 64 * d + lane]) : 0.f;
                const float ad0 = bf2f(LO[row * 512 + 128 + 64 * d + lane]), ad1 = hp ? bf2f(LO[prow * 512 + 128 + 64 * d + lane]) : 0.f;
                TH[s * 64 + lane] = tanhf(wd0 + prm[192 + lane] * (wd1 - wd0)); AD[s * 64 + lane] = ad0 + prm[256 + lane] * (ad1 - ad0); }
            __syncthreads();
#pragma unroll
            for (int m = 0; m < 4; ++m) { const int s = wv + 8 * m;
                float xw = prm[320 + lane], xa = prm[384 + lane];
#pragma unroll 8
                for (int i = 0; i < 64; ++i) { xw += TH[s * 64 + i] * w2s[i * 64 + lane]; xa += AD[s * 64 + i] * a2s[i * 64 + lane]; }
                const float elog = 0.6065306597126334f * sigm(xw), dec = expf(-elog), a = sigm(xa);
                const float kkr = ks[m] * prm[448 + lane]; const float ss = wave_sum(kkr * kkr); const float kkn = kkr / fmaxf(sqrtf(ss), 1e-12f);
                const float km = ks[m] * (1.f + (a - 1.f) * prm[512 + lane]);
                const float bs = wave_sum(rs[m] * km * prm[576 + lane]);
                R[s * 64 + lane] = rs[m]; W[s * 64 + lane] = dec; K[s * 64 + lane] = km; KK[s * 64 + lane] = kkn; BV[s * 64 + lane] = kkn * a; V[s * 64 + lane] = vs[m];
                if (lane == 0) BS[s] = bs; }
            __syncthreads();
            for (int s = 0; s < 32; ++s) {
                const LAS f32x4* pq = (const LAS f32x4*)(KK + s * 64 + 8 * sg); const f32x4 q0 = pq[0], q1 = pq[1];
                const LAS f32x4* pw = (const LAS f32x4*)(W + s * 64 + 8 * sg); const f32x4 w0 = pw[0], w1 = pw[1];
                const LAS f32x4* pb = (const LAS f32x4*)(BV + s * 64 + 8 * sg); const f32x4 b0 = pb[0], b1 = pb[1];
                const LAS f32x4* pk = (const LAS f32x4*)(K + s * 64 + 8 * sg); const f32x4 k0 = pk[0], k1 = pk[1];
                const LAS f32x4* pr = (const LAS f32x4*)(R + s * 64 + 8 * sg); const f32x4 r0 = pr[0], r1 = pr[1];
                const float vi = V[s * 64 + srow];
                float sa = S0 * q0.x + S1 * q0.y + S2 * q0.z + S3 * q0.w + S4 * q1.x + S5 * q1.y + S6 * q1.z + S7 * q1.w;
                sa += __shfl_xor(sa, 1); sa += __shfl_xor(sa, 2); sa += __shfl_xor(sa, 4);
                S0 = S0 * w0.x - sa * b0.x + vi * k0.x; S1 = S1 * w0.y - sa * b0.y + vi * k0.y; S2 = S2 * w0.z - sa * b0.z + vi * k0.z; S3 = S3 * w0.w - sa * b0.w + vi * k0.w;
                S4 = S4 * w1.x - sa * b1.x + vi * k1.x; S5 = S5 * w1.y - sa * b1.y + vi * k1.y; S6 = S6 * w1.z - sa * b1.z + vi * k1.z; S7 = S7 * w1.w - sa * b1.w + vi * k1.w;
                float o = S0 * r0.x + S1 * r0.y + S2 * r0.z + S3 * r0.w + S4 * r1.x + S5 * r1.y + S6 * r1.z + S7 * r1.w;
                o += __shfl_xor(o, 1); o += __shfl_xor(o, 2); o += __shfl_xor(o, 4);
                if (sg == 0) OUT[s * 64 + srow] = o;
            }
            __syncthreads();
#pragma unroll
            for (int m = 0; m < 4; ++m) { const int s = wv + 8 * m, n = n0 + s; const size_t row = (size_t)step_row(d, b, n);
                const float o = OUT[s * 64 + lane]; const float mean = wave_sum(o) * (1.f / 64.f); const float dv = o - mean; const float var = wave_sum(dv * dv) * (1.f / 64.f);
                const float z = dv * rsqrtf(var + 64e-5f) * prm[640 + lane] + prm[704 + lane] + BS[s] * V[s * 64 + lane];
                Z[((size_t)d * NALL + row) * 512 + 64 * h + lane] = f2bf(z); }
        }
    }
    __syncthreads();
}
DI void phase_rwkv_post(const P& p, LAS unsigned char* ldsb) {
    LAS float* sg = (LAS float*)ldsb;
    const int tid = mk_tid();
    const bf16_t* LO = (const bf16_t*)(p.ws + WS_COLS) + OFF_LO; const bf16_t* Z = (const bf16_t*)((unsigned char*)p.out); bf16_t* Y = (bf16_t*)(p.ws + WS_COLS);
    const float* g2 = p.in[I_G2];
    for (int vb = blockIdx.x; vb < NALL / 8; vb += gridDim.x) {
        const size_t row0 = (size_t)vb * 8;
        __syncthreads();
        for (int e = tid; e < 1024; e += NT) { const int q = e >> 7, r = e & 127; sg[e] = sigm(bf2f(LO[(row0 + q) * 512 + 256 + r])); }
        __syncthreads();
        float a0 = 0.f, a1 = 0.f, a2 = 0.f, a3 = 0.f, a4 = 0.f, a5 = 0.f, a6 = 0.f, a7 = 0.f;
#pragma unroll 4
        for (int r = 0; r < 128; ++r) { const float g = g2[r * 512 + tid];
            a0 += sg[r] * g; a1 += sg[128 + r] * g; a2 += sg[256 + r] * g; a3 += sg[384 + r] * g; a4 += sg[512 + r] * g; a5 += sg[640 + r] * g; a6 += sg[768 + r] * g; a7 += sg[896 + r] * g; }
#define MK_RP(q, aq) { const size_t rr = row0 + q; const float z = bf2f(Z[rr * 512 + tid]) + bf2f(Z[((size_t)NALL + rr) * 512 + tid]); Y[rr * D + tid] = f2bf(z * aq); }
        MK_RP(0, a0) MK_RP(1, a1) MK_RP(2, a2) MK_RP(3, a3) MK_RP(4, a4) MK_RP(5, a5) MK_RP(6, a6) MK_RP(7, a7)
#undef MK_RP
    }
    __syncthreads();
}
DI void post_headnorm_row(const bf16_t* HB, size_t row, const float* ng, const bf16_t* gsrc, int gate_kind, bf16_t* ydst, int lane) {
    const int c0 = 8 * lane;
    const u32x4 h0 = *(const u32x4*)(HB + row * 512 + c0), h1 = *(const u32x4*)(HB + ((size_t)NALL + row) * 512 + c0), gg = *(const u32x4*)(gsrc + c0);
    float h[8], g[8];
#pragma unroll
    for (int j = 0; j < 4; ++j) { h[2 * j] = __uint_as_float(h0[j] << 16) + __uint_as_float(h1[j] << 16); h[2 * j + 1] = __uint_as_float(h0[j] & 0xffff0000u) + __uint_as_float(h1[j] & 0xffff0000u);
        g[2 * j] = __uint_as_float(gg[j] << 16); g[2 * j + 1] = __uint_as_float(gg[j] & 0xffff0000u); }
    float ss = 0.f;
#pragma unroll
    for (int j = 0; j < 8; ++j) ss += h[j] * h[j];
    ss += __shfl_xor(ss, 1); ss += __shfl_xor(ss, 2); ss += __shfl_xor(ss, 4); ss += __shfl_xor(ss, 8);
    const float rinv = rsqrtf(ss * (1.f / 128.f) + 1e-6f);
    unsigned o[4];
#pragma unroll
    for (int j = 0; j < 4; ++j) { const float y0 = h[2 * j] * rinv * ng[c0 + 2 * j] * (gate_kind ? siluf(g[2 * j]) : sigm(g[2 * j])), y1 = h[2 * j + 1] * rinv * ng[c0 + 2 * j + 1] * (gate_kind ? siluf(g[2 * j + 1]) : sigm(g[2 * j + 1]));
        o[j] = pack2(y0, y1); }
    u32x4 w; w.x = o[0]; w.y = o[1]; w.z = o[2]; w.w = o[3];
    *(u32x4*)(ydst + c0) = w;
}

DI void phase_headnorm_post(const bf16_t* HB, const float* ng, const bf16_t* gbase, int gld, int gate_kind, bf16_t* Y, int ycol0, int nrows, bool permute) {
    const int lane = mk_tid() & 63, wv = mk_tid() >> 6, c0 = 8 * lane;
    float ngv[8];
#pragma unroll
    for (int j = 0; j < 8; ++j) ngv[j] = ng[c0 + j];
    const int rstep = gridDim.x * 8; int r = blockIdx.x * 8 + wv;
    u32x4 h0, h1, gg, n0, n1, ng2;
    if (r < nrows) { h0 = *(const u32x4*)(HB + (size_t)r * 512 + c0); h1 = *(const u32x4*)(HB + ((size_t)NALL + r) * 512 + c0); gg = *(const u32x4*)(gbase + (size_t)r * gld + c0); }
    for (; r < nrows; r += rstep) {
        const int rn = r + rstep;
        if (rn < nrows) { n0 = *(const u32x4*)(HB + (size_t)rn * 512 + c0); n1 = *(const u32x4*)(HB + ((size_t)NALL + rn) * 512 + c0); ng2 = *(const u32x4*)(gbase + (size_t)rn * gld + c0); }
        float h[8], g[8];
#pragma unroll
        for (int j = 0; j < 4; ++j) { h[2 * j] = __uint_as_float(h0[j] << 16) + __uint_as_float(h1[j] << 16); h[2 * j + 1] = __uint_as_float(h0[j] & 0xffff0000u) + __uint_as_float(h1[j] & 0xffff0000u);
            g[2 * j] = __uint_as_float(gg[j] << 16); g[2 * j + 1] = __uint_as_float(gg[j] & 0xffff0000u); }
        float ss = 0.f;
#pragma unroll
        for (int j = 0; j < 8; ++j) ss += h[j] * h[j];
        ss = sum8(ss); ss += dppf<0x140>(ss);
        const float rinv = rsqrtf(ss * (1.f / 128.f) + 1e-6f);
        unsigned o[4];
#pragma unroll
        for (int j = 0; j < 4; ++j) { const float s0 = fsigm(g[2 * j]), s1 = fsigm(g[2 * j + 1]);
            const float y0 = h[2 * j] * rinv * ngv[2 * j] * (gate_kind ? g[2 * j] * s0 : s0), y1 = h[2 * j + 1] * rinv * ngv[2 * j + 1] * (gate_kind ? g[2 * j + 1] * s1 : s1);
            o[j] = pack2(y0, y1); }
        u32x4 w; w.x = o[0]; w.y = o[1]; w.z = o[2]; w.w = o[3];
        const size_t dr = permute ? (size_t)nat_row(r) : (size_t)r;
        *(u32x4*)(Y + dr * D + ycol0 + c0) = w;
        h0 = n0; h1 = n1; gg = ng2;
    }
}
typedef short bf16x8 __attribute__((ext_vector_type(8)));
typedef short s16x4 __attribute__((ext_vector_type(4)));
constexpr int PQ = 136, PS = 72, PV0 = 88, PV1 = 56;
constexpr int E_BUF = 64 * PQ * 2 * 2 + 64 * PV0 * 2 + 80 * PQ * 2;
constexpr int E_QS = 0, E_KS = E_QS + 64 * PQ * 2, E_VS = E_KS + 64 * PQ * 2, E_ST = E_VS + 64 * PV0 * 2, E_PS = 2 * E_BUF, E_F = E_PS + 64 * PS * 2, E_END = E_F + 2048;
constexpr size_t WS_Q1 = WS_COLS + (size_t)231 * MiB;
constexpr int NRC = NALL / 64;

DI int chunk_row0(int d, int b, int ci) {
    if (ci < 4) { const int cc = d ? 3 - ci : ci; return NLAT + b * LC + 64 * cc; }
    const int lc = ci - 4, cl = d ? 127 - lc : lc; return b * L + 64 * cl;
}
DI bf16x8 tr_frag(unsigned tile_base, int pitch, int k0, int c0, int r, int q) {
    const unsigned a0 = tile_base + (unsigned)(((k0 + 8 * q + (r >> 2)) * pitch + c0 + 4 * (r & 3)) * 2), a1 = a0 + (unsigned)(4 * pitch * 2);
    s16x4 x, y;
    asm volatile("ds_read_b64_tr_b16 %0, %2\n\tds_read_b64_tr_b16 %1, %3\n\ts_waitcnt lgkmcnt(0)" : "=&v"(x), "=&v"(y) : "v"(a0), "v"(a1) : "memory");
    bf16x8 o; o[0] = x[0]; o[1] = x[1]; o[2] = x[2]; o[3] = x[3]; o[4] = y[0]; o[5] = y[1]; o[6] = y[2]; o[7] = y[3];
    return o;
}

DI unsigned tr_addr(unsigned tile_base, int pitch, int k0, int c0, int r, int q) { return tile_base + (unsigned)(((k0 + 8 * q + (r >> 2)) * pitch + c0 + 4 * (r & 3)) * 2); }
DI bf16x8 tr_join(s16x4 x, s16x4 y) { bf16x8 o; o[0] = x[0]; o[1] = x[1]; o[2] = x[2]; o[3] = x[3]; o[4] = y[0]; o[5] = y[1]; o[6] = y[2]; o[7] = y[3]; return o; }
DI void tr_frag2(bf16x8& f0, bf16x8& f1, unsigned a0, unsigned h0, unsigned a1, unsigned h1) {
    s16x4 x0, y0, x1, y1; const unsigned b0 = a0 + h0, b1 = a1 + h1;
    asm volatile("ds_read_b64_tr_b16 %0, %4\n\tds_read_b64_tr_b16 %1, %5\n\tds_read_b64_tr_b16 %2, %6\n\tds_read_b64_tr_b16 %3, %7\n\ts_waitcnt lgkmcnt(0)"
                 : "=&v"(x0), "=&v"(y0), "=&v"(x1), "=&v"(y1) : "v"(a0), "v"(b0), "v"(a1), "v"(b1) : "memory");
    f0 = tr_join(x0, y0); f1 = tr_join(x1, y1);
}
DI void tr_frag3(bf16x8& f0, bf16x8& f1, bf16x8& f2, unsigned a0, unsigned h0, unsigned a1, unsigned h1, unsigned a2, unsigned h2) {
    s16x4 x0, y0, x1, y1, x2, y2; const unsigned b0 = a0 + h0, b1 = a1 + h1, b2 = a2 + h2;
    asm volatile("ds_read_b64_tr_b16 %0, %6\n\tds_read_b64_tr_b16 %1, %7\n\tds_read_b64_tr_b16 %2, %8\n\tds_read_b64_tr_b16 %3, %9\n\tds_read_b64_tr_b16 %4, %10\n\tds_read_b64_tr_b16 %5, %11\n\ts_waitcnt lgkmcnt(0)"
                 : "=&v"(x0), "=&v"(y0), "=&v"(x1), "=&v"(y1), "=&v"(x2), "=&v"(y2) : "v"(a0), "v"(b0), "v"(a1), "v"(b1), "v"(a2), "v"(b2) : "memory");
    f0 = tr_join(x0, y0); f1 = tr_join(x1, y1); f2 = tr_join(x2, y2);
}
DI void tr_frag4(bf16x8& f0, bf16x8& f1, bf16x8& f2, bf16x8& f3, unsigned a0, unsigned h0, unsigned a1, unsigned h1, unsigned a2, unsigned h2, unsigned a3, unsigned h3) {
    s16x4 x0, y0, x1, y1, x2, y2, x3, y3; const unsigned b0 = a0 + h0, b1 = a1 + h1, b2 = a2 + h2, b3 = a3 + h3;
    asm volatile("ds_read_b64_tr_b16 %0, %8\n\tds_read_b64_tr_b16 %1, %9\n\tds_read_b64_tr_b16 %2, %10\n\tds_read_b64_tr_b16 %3, %11\n\tds_read_b64_tr_b16 %4, %12\n\tds_read_b64_tr_b16 %5, %13\n\tds_read_b64_tr_b16 %6, %14\n\tds_read_b64_tr_b16 %7, %15\n\ts_waitcnt lgkmcnt(0)"
                 : "=&v"(x0), "=&v"(y0), "=&v"(x1), "=&v"(y1), "=&v"(x2), "=&v"(y2), "=&v"(x3), "=&v"(y3) : "v"(a0), "v"(b0), "v"(a1), "v"(b1), "v"(a2), "v"(b2), "v"(a3), "v"(b3) : "memory");
    f0 = tr_join(x0, y0); f1 = tr_join(x1, y1); f2 = tr_join(x2, y2); f3 = tr_join(x3, y3);
}
DI void tr_frag5(bf16x8& f0, bf16x8& f1, bf16x8& f2, bf16x8& f3, bf16x8& f4, unsigned a0, unsigned h0, unsigned a1, unsigned h1, unsigned a2, unsigned h2, unsigned a3, unsigned h3, unsigned a4, unsigned h4) {
    s16x4 x0, y0, x1, y1, x2, y2, x3, y3, x4, y4; const unsigned b0 = a0 + h0, b1 = a1 + h1, b2 = a2 + h2, b3 = a3 + h3, b4 = a4 + h4;
    asm volatile("ds_read_b64_tr_b16 %0, %10\n\tds_read_b64_tr_b16 %1, %11\n\tds_read_b64_tr_b16 %2, %12\n\tds_read_b64_tr_b16 %3, %13\n\tds_read_b64_tr_b16 %4, %14\n\tds_read_b64_tr_b16 %5, %15\n\tds_read_b64_tr_b16 %6, %16\n\tds_read_b64_tr_b16 %7, %17\n\tds_read_b64_tr_b16 %8, %18\n\tds_read_b64_tr_b16 %9, %19\n\ts_waitcnt lgkmcnt(0)"
                 : "=&v"(x0), "=&v"(y0), "=&v"(x1), "=&v"(y1), "=&v"(x2), "=&v"(y2), "=&v"(x3), "=&v"(y3), "=&v"(x4), "=&v"(y4) : "v"(a0), "v"(b0), "v"(a1), "v"(b1), "v"(a2), "v"(b2), "v"(a3), "v"(b3), "v"(a4), "v"(b4) : "memory");
    f0 = tr_join(x0, y0); f1 = tr_join(x1, y1); f2 = tr_join(x2, y2); f3 = tr_join(x3, y3); f4 = tr_join(x4, y4);
}

DI void tr_frag6(bf16x8& f0, bf16x8& f1, bf16x8& f2, bf16x8& f3, bf16x8& f4, bf16x8& f5, unsigned a0, unsigned h0, unsigned a1, unsigned h1, unsigned a2, unsigned h2, unsigned a3, unsigned h3, unsigned a4, unsigned h4, unsigned a5, unsigned h5) {
    s16x4 x0, y0, x1, y1, x2, y2, x3, y3, x4, y4, x5, y5; const unsigned b0 = a0 + h0, b1 = a1 + h1, b2 = a2 + h2, b3 = a3 + h3, b4 = a4 + h4, b5 = a5 + h5;
    asm volatile("ds_read_b64_tr_b16 %0, %12\n\tds_read_b64_tr_b16 %1, %13\n\tds_read_b64_tr_b16 %2, %14\n\tds_read_b64_tr_b16 %3, %15\n\tds_read_b64_tr_b16 %4, %16\n\tds_read_b64_tr_b16 %5, %17\n\tds_read_b64_tr_b16 %6, %18\n\tds_read_b64_tr_b16 %7, %19\n\tds_read_b64_tr_b16 %8, %20\n\tds_read_b64_tr_b16 %9, %21\n\tds_read_b64_tr_b16 %10, %22\n\tds_read_b64_tr_b16 %11, %23\n\ts_waitcnt lgkmcnt(0)"
                 : "=&v"(x0), "=&v"(y0), "=&v"(x1), "=&v"(y1), "=&v"(x2), "=&v"(y2), "=&v"(x3), "=&v"(y3), "=&v"(x4), "=&v"(y4), "=&v"(x5), "=&v"(y5)
                 : "v"(a0), "v"(b0), "v"(a1), "v"(b1), "v"(a2), "v"(b2), "v"(a3), "v"(b3), "v"(a4), "v"(b4), "v"(a5), "v"(b5) : "memory");
    f0 = tr_join(x0, y0); f1 = tr_join(x1, y1); f2 = tr_join(x2, y2); f3 = tr_join(x3, y3); f4 = tr_join(x4, y4); f5 = tr_join(x5, y5);
}

#define GLA_PREFETCH(ci_) do { const int row0_ = chunk_row0(d, b, (ci_)); \
    _Pragma("unroll") for (int i = 0; i < 2; ++i) { const size_t row_ = (size_t)(row0_ + prow0 + 32 * i); \
        rq[i] = *(const u32x4*)(Qg + row_ * ldq + 8 * ppc); rk[i] = *(const u32x4*)(Kg + row_ * ldk + 8 * ppc); } \
    if (vact) rv = *(const u32x4*)(Vg + (size_t)(row0_ + vrow) * ldv + 8 * vpc); \
    if (MODE != 0) rlam = *(const f32x4*)(LAM + ((size_t)d * NRC + (row0_ >> 6)) * 512 + 128 * hd + 16 * wv + 4 * q); } while (0)

DI float flog(float x) { return __builtin_amdgcn_logf(x) * 0.6931471805599453f; }
#define GLA_GATE_LOAD(ci_) do { const size_t row_ = (size_t)(chunk_row0(d, b, (ci_)) + (d ? 63 - lane : lane)); gi = bf2f(LO[row_ * 512 + 384 + 4 * d + hd]); gf = bf2f(LO[row_ * 512 + 392 + 4 * d + hd]); } while (0)
#define GLA_GATE_COMPUTE(buf_) do { const float li_ = gi + bi, x_ = gf + bfv; float v_ = scan16(-flog(1.f + fexp(-x_))); \
    const float t0_ = __int_as_float(__builtin_amdgcn_readlane(__float_as_int(v_), 15)), t1_ = __int_as_float(__builtin_amdgcn_readlane(__float_as_int(v_), 31)), t2_ = __int_as_float(__builtin_amdgcn_readlane(__float_as_int(v_), 47)); \
    v_ += (q >= 1 ? t0_ : 0.f) + (q >= 2 ? t1_ : 0.f) + (q >= 3 ? t2_ : 0.f); const int rc_ = d ? 63 - lane : lane; LAS float* F_ = Fs + (buf_) * 132; \
    F_[rc_] = fexp(v_) * 0.08838834764831845f; F_[64 + rc_] = fexp(li_ - v_); if (lane == 63) F_[128] = fexp(v_); } while (0)
#define GLA_STAGE(ci_) do { LAS unsigned char* sb_ = lds + ((ci_) & 1) * E_BUF; LAS bf16_t* Qw_ = (LAS bf16_t*)(sb_ + E_QS); LAS bf16_t* Kw_ = (LAS bf16_t*)(sb_ + E_KS); LAS bf16_t* Vw_ = (LAS bf16_t*)(sb_ + E_VS); \
    _Pragma("unroll") for (int i = 0; i < 2; ++i) { const int row_ = prow0 + 32 * i; *(LAS u32x4*)(Qw_ + row_ * PQ + 8 * ppc) = rq[i]; *(LAS u32x4*)(Kw_ + row_ * PQ + 8 * ppc) = rk[i]; } \
    if (vact) { if (MODE == 0) { const float w_ = Fs[((ci_) & 1) * 132 + 64 + vrow]; u32x4 o_; \
            _Pragma("unroll") for (int e = 0; e < 4; ++e) o_[e] = pack2(__uint_as_float(rv[e] << 16) * w_, __uint_as_float(rv[e] & 0xffff0000u) * w_); \
            *(LAS u32x4*)(Vw_ + vrow * PV + 8 * vpc) = o_; if (vpc == 0) Vw_[vrow * PV + 64] = f2bf(w_); } \
        else *(LAS u32x4*)(Vw_ + vrow * PV + 8 * vpc) = rv; } lam_st = rlam; } while (0)
template <int MODE> DI void gla_unit(const P& p, LAS unsigned char* lds, int unit, unsigned* waitcnt = nullptr) {
    constexpr int NDV = MODE == 0 ? 5 : 2, PV = MODE == 0 ? PV0 : PV1;
    const int tid = mk_tid(), lane = tid & 63, wv = __builtin_amdgcn_readfirstlane(tid >> 6), r = lane & 15, q = lane >> 4;
    const int d = MODE == 0 ? unit >> 5 : unit >> 6, b = MODE == 0 ? (unit >> 3) & 3 : (unit >> 4) & 3, hd = MODE == 0 ? (unit >> 1) & 3 : (unit >> 2) & 3, sl = MODE == 0 ? 2 * (unit & 1) : unit & 3;
    const bf16_t* COLS = (const bf16_t*)(p.ws + WS_COLS);
    const bf16_t *Qg, *Kg, *Vg; int ldq, ldk, ldv;
    if (MODE == 0) { const bf16_t* ML = COLS + OFF_ML; Qg = ML + 128 * hd; Kg = ML + 512 + 128 * hd; Vg = ML + 1024 + 128 * hd + 32 * sl; ldq = ldk = ldv = 2048; }
    else { Qg = d ? (const bf16_t*)(p.ws + WS_Q1) + 128 * hd : COLS + 128 * hd; ldq = d ? 512 : 3584; Kg = COLS + 512 + 512 * d + 128 * hd; ldk = 3584; Vg = COLS + 1536 + 128 * hd + 32 * sl; ldv = 3584; }
    const bf16_t* LO = COLS + OFF_LO;
    const float* LAM = (const float*)(p.ws + WS_LAM);
    bf16_t* HB = (bf16_t*)(p.ws + WS_ACT);
    LAS bf16_t* Ps = (LAS bf16_t*)(lds + E_PS); LAS float* Fs = (LAS float*)(lds + E_F);
    float bi = 0.f, bfv = 0.f;
    if (MODE == 0) { bi = p.in[I_MBI][d * 4 + hd]; bfv = p.in[I_MBF][d * 4 + hd]; }
    __syncthreads();
    for (int e = tid; e < 2 * E_BUF / 4; e += NT) ((LAS unsigned*)lds)[e] = 0u;
    __syncthreads();
    f32x4 Sacc[NDV];
#pragma unroll
    for (int n = 0; n < NDV; ++n) Sacc[n] = (f32x4){0.f, 0.f, 0.f, 0.f};
    u32x4 rq[2], rk[2], rv = (u32x4){0u, 0u, 0u, 0u}; float gi = 0.f, gf = 0.f; f32x4 rlam = (f32x4){1.f, 1.f, 1.f, 1.f}, lam_st = (f32x4){1.f, 1.f, 1.f, 1.f};
    const int prow0 = tid >> 4, ppc = tid & 15;
    const int vrow = MODE == 0 ? tid >> 3 : tid >> 2, vpc = MODE == 0 ? tid & 7 : tid & 3; const bool vact = MODE == 0 || tid < 256;
    if (waitcnt) sub_wait(waitcnt, (unsigned)gridDim.x);
    GLA_PREFETCH(0);
    if (MODE == 0) { if (tid < 64) { GLA_GATE_LOAD(0); GLA_GATE_COMPUTE(0); GLA_GATE_LOAD(1); } __syncthreads(); }
    GLA_STAGE(0);
    GLA_PREFETCH(1);
    __syncthreads();
    for (int ci = 0; ci < 132; ++ci) {
        const int row0 = chunk_row0(d, b, ci);
        unsigned oz = 0u; asm volatile("" : "+v"(oz));
        LAS unsigned char* sb = lds + (ci & 1) * E_BUF + oz; LAS bf16_t* Qs = (LAS bf16_t*)(sb + E_QS); LAS bf16_t* Ks = (LAS bf16_t*)(sb + E_KS); LAS bf16_t* STs = (LAS bf16_t*)(sb + E_ST);
        LAS bf16_t* STn = (LAS bf16_t*)(lds + ((ci + 1) & 1) * E_BUF + E_ST);
        const unsigned ks_b = (unsigned)(size_t)Ks, vs_b = (unsigned)(size_t)(sb + E_VS);
        f32x4 lamv = lam_st;
        const LAS float* Fc = Fs + (ci & 1) * 132;
        if (MODE == 0) { const float l = Fc[128]; lamv = (f32x4){l, l, l, l};
            if (tid < 64 && ci + 1 < 132) { GLA_GATE_COMPUTE((ci + 1) & 1); if (ci + 2 < 132) GLA_GATE_LOAD(ci + 2); } }
        const bool outs = (MODE == 0) || ci >= 4;
        if (outs) {
            const int tt = wv & 3, sh = wv >> 2;
            f32x4 pacc[2] = {(f32x4){0.f, 0.f, 0.f, 0.f}, (f32x4){0.f, 0.f, 0.f, 0.f}};
#pragma unroll
            for (int kk = 0; kk < 4; ++kk) { const bf16x8 bq = *(const LAS bf16x8*)(Qs + (16 * tt + r) * PQ + 32 * kk + 8 * q);
#pragma unroll
                for (int i = 0; i < 2; ++i) { const bf16x8 a = *(const LAS bf16x8*)(Ks + (16 * (2 * sh + i) + r) * PQ + 32 * kk + 8 * q); pacc[i] = __builtin_amdgcn_mfma_f32_16x16x32_bf16(a, bq, pacc[i], 0, 0, 0); } }
            const int t = 16 * tt + r;
#pragma unroll
            for (int i = 0; i < 2; ++i) { const int s0 = 16 * (2 * sh + i) + 4 * q; float v[4];
#pragma unroll
                for (int j = 0; j < 4; ++j) { const int s = s0 + j; const bool ok = d ? (s >= t) : (s <= t); v[j] = ok ? pacc[i][j] : 0.f; }
                u32x2 w; w.x = pack2(v[0], v[1]); w.y = pack2(v[2], v[3]); *(LAS u32x2*)(Ps + t * PS + s0) = w; }
        }
        bf16x8 vfr[2][NDV];
        if (NDV == 2) {
            bf16x8 a0, a1;
            tr_frag6(a0, vfr[0][0], vfr[0][1], a1, vfr[1][0], vfr[1][1], tr_addr(ks_b, PQ, 0, 16 * wv, r, q), 8u * PQ, tr_addr(vs_b, PV, 0, 0, r, q), 8u * PV, tr_addr(vs_b, PV, 0, 16, r, q), 8u * PV,
                     tr_addr(ks_b, PQ, 32, 16 * wv, r, q), 8u * PQ, tr_addr(vs_b, PV, 32, 0, r, q), 8u * PV, tr_addr(vs_b, PV, 32, 16, r, q), 8u * PV);
#pragma unroll
            for (int n = 0; n < NDV; ++n) { Sacc[n] = __builtin_amdgcn_mfma_f32_16x16x32_bf16(a0, vfr[0][n], Sacc[n], 0, 0, 0); Sacc[n] = __builtin_amdgcn_mfma_f32_16x16x32_bf16(a1, vfr[1][n], Sacc[n], 0, 0, 0); }
        } else {
#pragma unroll
        for (int kk = 0; kk < 2; ++kk) { bf16x8 a;
            tr_frag3(a, vfr[kk][0], vfr[kk][1], tr_addr(ks_b, PQ, 32 * kk, 16 * wv, r, q), 8u * PQ, tr_addr(vs_b, PV, 32 * kk, 0, r, q), 8u * PV, tr_addr(vs_b, PV, 32 * kk, 16, r, q), 8u * PV);
            if (NDV == 5) tr_frag3(vfr[kk][NDV - 3], vfr[kk][NDV - 2], vfr[kk][NDV - 1], tr_addr(vs_b, PV, 32 * kk, 32, r, q), 8u * PV, tr_addr(vs_b, PV, 32 * kk, 48, r, q), 8u * PV, tr_addr(vs_b, PV, 32 * kk, 64, r, q), 8u * PV);
#pragma unroll
            for (int n = 0; n < NDV; ++n) Sacc[n] = __builtin_amdgcn_mfma_f32_16x16x32_bf16(a, vfr[kk][n], Sacc[n], 0, 0, 0); } }
        if (outs) __syncthreads();
        if (outs) {
            constexpr int NO = MODE == 0 ? 2 : 1;
            const int tt = wv & 3, nh = wv >> 2;
            f32x4 oacc[NO], dacc = (f32x4){0.f, 0.f, 0.f, 0.f};
#pragma unroll
            for (int i = 0; i < NO; ++i) oacc[i] = (f32x4){0.f, 0.f, 0.f, 0.f};
#pragma unroll
            for (int kk = 0; kk < 2; ++kk) { const bf16x8 bp = *(const LAS bf16x8*)(Ps + (16 * tt + r) * PS + 32 * kk + 8 * q);
#pragma unroll
                for (int i = 0; i < NO; ++i) { const bf16x8 a = nh ? vfr[kk][NO + i] : vfr[kk][i]; oacc[i] = __builtin_amdgcn_mfma_f32_16x16x32_bf16(a, bp, oacc[i], 0, 0, 0); }
                if (MODE == 0) dacc = __builtin_amdgcn_mfma_f32_16x16x32_bf16(vfr[kk][NDV - 1], bp, dacc, 0, 0, 0); }
#pragma unroll
            for (int kk = 0; kk < 4; ++kk) { const bf16x8 bq = *(const LAS bf16x8*)(Qs + (16 * tt + r) * PQ + 32 * kk + 8 * q);
#pragma unroll
                for (int i = 0; i < NO; ++i) { const bf16x8 a = *(const LAS bf16x8*)(STs + (16 * (NO * nh + i) + r) * PQ + 32 * kk + 8 * q); oacc[i] = __builtin_amdgcn_mfma_f32_16x16x32_bf16(a, bq, oacc[i], 0, 0, 0); }
                if (MODE == 0) { const bf16x8 a2 = *(const LAS bf16x8*)(STs + (16 * (NDV - 1) + r) * PQ + 32 * kk + 8 * q); dacc = __builtin_amdgcn_mfma_f32_16x16x32_bf16(a2, bq, dacc, 0, 0, 0); } }
            const int t = 16 * tt + r;
            float inv = 1.f;
            if (MODE == 0) { const float rs = Fc[t]; const float den = __shfl(dacc[0], r) * rs; inv = rs / fmaxf(fabsf(den), 1.f); }
#pragma unroll
            for (int i = 0; i < NO; ++i) { float o0 = oacc[i][0], o1 = oacc[i][1], o2 = oacc[i][2], o3 = oacc[i][3];
                if (MODE == 0) { o0 *= inv; o1 *= inv; o2 *= inv; o3 *= inv; }
                u32x2 w; w.x = pack2(o0, o1); w.y = pack2(o2, o3);
                *(u32x2*)(HB + ((size_t)d * NALL + row0 + t) * 512 + 128 * hd + 32 * sl + 16 * (NO * nh + i) + 4 * q) = w; }
        }
#pragma unroll
        for (int n = 0; n < NDV; ++n) { Sacc[n] = Sacc[n] * lamv; u32x2 w; w.x = pack2(Sacc[n][0], Sacc[n][1]); w.y = pack2(Sacc[n][2], Sacc[n][3]); *(LAS u32x2*)(STn + (16 * n + r) * PQ + 16 * wv + 4 * q) = w; }
        if (ci + 1 < 132) { GLA_STAGE(ci + 1); if (ci + 2 < 132) GLA_PREFETCH(ci + 2); }
        __syncthreads();
    }
    __syncthreads();
}

DI void phase_hgrn_prep(const P& p, LAS unsigned char* ldsb) {
    LAS float* tot = (LAS float*)ldsb;
    const int tid = mk_tid(), ch = tid & 127, qt = tid >> 7;
    bf16_t* C1 = (bf16_t*)(p.ws + WS_COLS); bf16_t* Q1 = (bf16_t*)(p.ws + WS_Q1); float* LAM = (float*)(p.ws + WS_LAM);
    for (int vb = blockIdx.x; vb < NRC * 4; vb += gridDim.x) {
        const int rc = vb >> 2, hd = vb & 3, c = 128 * hd + ch; const size_t rbase = (size_t)rc * 64 + 16 * qt;
        const float lb = sigm(p.in[I_HLB][512 + c] - p.in[I_HLB][c]);
        float qv[16], l0[16], l1[16], k0[16], k1[16];
#pragma unroll
        for (int i = 0; i < 16; ++i) { const bf16_t* base = C1 + (rbase + i) * 3584;
            qv[i] = siluf(bf2f(base[c])); const float s0 = sigm(bf2f(base[512 + c])), s1 = sigm(bf2f(base[1024 + c]));
            l0[i] = logf(lb + (1.f - lb) * s0); l1[i] = logf(lb + (1.f - lb) * s1); k0[i] = (1.f - lb) * (1.f - s0); k1[i] = (1.f - lb) * (1.f - s1); }
#pragma unroll
        for (int i = 1; i < 16; ++i) l0[i] += l0[i - 1];
#pragma unroll
        for (int i = 14; i >= 0; --i) l1[i] += l1[i + 1];
        __syncthreads();
        tot[qt * 128 + ch] = l0[15]; tot[512 + qt * 128 + ch] = l1[0];
        __syncthreads();
        float off0 = 0.f, off1 = 0.f, t0 = 0.f, t1 = 0.f;
#pragma unroll
        for (int j = 0; j < 4; ++j) { const float a = tot[j * 128 + ch], bb = tot[512 + j * 128 + ch]; t0 += a; t1 += bb; if (j < qt) off0 += a; if (j > qt) off1 += bb; }
#pragma unroll
        for (int i = 0; i < 16; ++i) { bf16_t* base = C1 + (rbase + i) * 3584; const float c0 = l0[i] + off0, c1 = l1[i] + off1;
            base[c] = f2bf(qv[i] * expf(c0)); base[512 + c] = f2bf(k0[i] * expf(-c0)); base[1024 + c] = f2bf(k1[i] * expf(-c1)); Q1[(rbase + i) * 512 + c] = f2bf(qv[i] * expf(c1)); }
        if (qt == 0) { LAM[((size_t)rc) * 512 + c] = expf(t0); LAM[((size_t)NRC + rc) * 512 + c] = expf(t1); }
    }
    __syncthreads();
}
DI void phase_hgrn_prep2(const P& p, LAS unsigned char* ldsb) {
    LAS float* tot = (LAS float*)ldsb;
    const int tid = mk_tid(), cp = tid & 63, qt = tid >> 6;
    bf16_t* C1 = (bf16_t*)(p.ws + WS_COLS); bf16_t* Q1 = (bf16_t*)(p.ws + WS_Q1); float* LAM = (float*)(p.ws + WS_LAM);
    for (int vb = (int)((blockIdx.x + (gridDim.x >> 1)) % gridDim.x); vb < NRC * 2; vb += gridDim.x) {
        const int rc = vb >> 1, c0 = 256 * (vb & 1) + 4 * cp; const size_t rbase = (size_t)rc * 64 + 8 * qt;
        float lb[4], omlb[4];
#pragma unroll
        for (int k = 0; k < 4; ++k) { lb[k] = fsigm(p.in[I_HLB][512 + c0 + k] - p.in[I_HLB][c0 + k]); omlb[k] = 1.f - lb[k]; }
        float s0[4], s1[4];
#pragma unroll
        for (int k = 0; k < 4; ++k) { s0[k] = 0.f; s1[k] = 0.f; }
#pragma unroll
        for (int i = 0; i < 8; ++i) { const bf16_t* base = C1 + (rbase + i) * 3584; const u32x2 f0 = *(const u32x2*)(base + 512 + c0), f1 = *(const u32x2*)(base + 1024 + c0);
#pragma unroll
            for (int k = 0; k < 2; ++k) { s0[2 * k] += flog(lb[2 * k] + omlb[2 * k] * fsigm(__uint_as_float(f0[k] << 16))); s0[2 * k + 1] += flog(lb[2 * k + 1] + omlb[2 * k + 1] * fsigm(__uint_as_float(f0[k] & 0xffff0000u)));
                s1[2 * k] += flog(lb[2 * k] + omlb[2 * k] * fsigm(__uint_as_float(f1[k] << 16))); s1[2 * k + 1] += flog(lb[2 * k + 1] + omlb[2 * k + 1] * fsigm(__uint_as_float(f1[k] & 0xffff0000u))); } }
        __syncthreads();
        *(LAS f32x4*)(tot + (0 * 8 + qt) * 256 + 4 * cp) = (f32x4){s0[0], s0[1], s0[2], s0[3]}; *(LAS f32x4*)(tot + (1 * 8 + qt) * 256 + 4 * cp) = (f32x4){s1[0], s1[1], s1[2], s1[3]};
        __syncthreads();
        f32x4 r0 = (f32x4){0.f, 0.f, 0.f, 0.f}, r1 = r0, t0 = r0, t1 = r0;
#pragma unroll
        for (int j = 0; j < 8; ++j) { const f32x4 a = *(const LAS f32x4*)(tot + (0 * 8 + j) * 256 + 4 * cp), bb = *(const LAS f32x4*)(tot + (1 * 8 + j) * 256 + 4 * cp); t0 += a; t1 += bb; if (j < qt) r0 += a; if (j >= qt) r1 += bb; }
        if (qt == 0) { *(f32x4*)(LAM + (size_t)rc * 512 + c0) = (f32x4){fexp(t0[0]), fexp(t0[1]), fexp(t0[2]), fexp(t0[3])}; *(f32x4*)(LAM + ((size_t)NRC + rc) * 512 + c0) = (f32x4){fexp(t1[0]), fexp(t1[1]), fexp(t1[2]), fexp(t1[3])}; }
        float run0[4], run1[4];
#pragma unroll
        for (int k = 0; k < 4; ++k) { run0[k] = r0[k]; run1[k] = r1[k]; }
#pragma unroll 4
        for (int i = 0; i < 8; ++i) { bf16_t* base = C1 + (rbase + i) * 3584; const u32x2 qv = *(const u32x2*)(base + c0), f0 = *(const u32x2*)(base + 512 + c0), f1 = *(const u32x2*)(base + 1024 + c0);
            float oq0[4], ok0[4], ok1[4], oq1[4];
#pragma unroll
            for (int k = 0; k < 4; ++k) { const unsigned wq = qv[k >> 1], w0 = f0[k >> 1], w1 = f1[k >> 1];
                const float qx = (k & 1) ? __uint_as_float(wq & 0xffff0000u) : __uint_as_float(wq << 16), x0 = (k & 1) ? __uint_as_float(w0 & 0xffff0000u) : __uint_as_float(w0 << 16), x1 = (k & 1) ? __uint_as_float(w1 & 0xffff0000u) : __uint_as_float(w1 << 16);
                const float sq = qx * fsigm(qx), sg0 = fsigm(x0), sg1 = fsigm(x1);
                const float l0 = flog(lb[k] + omlb[k] * sg0), l1 = flog(lb[k] + omlb[k] * sg1);
                run0[k] += l0;
                const float cb = run1[k];
                run1[k] -= l1;
                const float e0 = fexp(run0[k]), e1 = fexp(cb);
                oq0[k] = sq * e0; ok0[k] = omlb[k] * (1.f - sg0) * frcp(e0); ok1[k] = omlb[k] * (1.f - sg1) * frcp(e1); oq1[k] = sq * e1; }
            u32x2 w; w.x = pack2(oq0[0], oq0[1]); w.y = pack2(oq0[2], oq0[3]); *(u32x2*)(base + c0) = w;
            w.x = pack2(ok0[0], ok0[1]); w.y = pack2(ok0[2], ok0[3]); *(u32x2*)(base + 512 + c0) = w;
            w.x = pack2(ok1[0], ok1[1]); w.y = pack2(ok1[2], ok1[3]); *(u32x2*)(base + 1024 + c0) = w;
            w.x = pack2(oq1[0], oq1[1]); w.y = pack2(oq1[2], oq1[3]); *(u32x2*)(Q1 + (rbase + i) * 512 + c0) = w; }
    }
    __syncthreads();
}
constexpr int XBP = 68, AUP = 68, XFP = 68, M_XB = 0, M_XCS = M_XB + 67 * XBP * 4, M_XCF = M_XCS + 64 * 72 * 2, M_W = M_XCF + 64 * XFP * 4, M_AU = M_W + 4 * 64 * 72 * 2, M_SEG = M_AU + 4 * 64 * AUP * 4, M_PRM = M_SEG + 4 * 8 * 64 * 4,
              M_CAR = M_PRM + 11 * 64 * 4, M_END = M_CAR + 2 * 64 * 4;
static_assert(M_END <= LDS_BYTES - 16, "lru LDS map");
DI float nexpm1_small(float x) { const float ser = -x * (1.f + x * 0.5f * (1.f + x * (1.f / 3.f) * (1.f + x * 0.25f * (1.f + x * 0.2f)))); return (x > -0.25f) ? ser : 1.f - fexp(x); }
DI int lru_rc_at(int d, int b, int s) { if (s < 4) return 512 + 4 * b + (d ? 3 - s : s); const int lc = s - 4; return 128 * b + (d ? 127 - lc : lc); }
template <int PASS> DI void lru_pass(const P& p, LAS unsigned char* lds, const int lb, const int nlb, const int roff = 0, const int rcnt = -1) {
    const int tid = mk_tid(), lane = tid & 63, wv = __builtin_amdgcn_readfirstlane(tid >> 6), r = lane & 15, q = lane >> 4;
    const int hb = lb & 7;
    const bf16_t* C1 = (const bf16_t*)(p.ws + WS_COLS); bf16_t* Y = (bf16_t*)((unsigned char*)p.out); float* LSUM = (float*)(p.ws + WS_LSUM);
    LAS float* XB = (LAS float*)(lds + M_XB); LAS bf16_t* XCs = (LAS bf16_t*)(lds + M_XCS); LAS float* XCf = (LAS float*)(lds + M_XCF); LAS bf16_t* Wt = (LAS bf16_t*)(lds + M_W);
    LAS float* AU = (LAS float*)(lds + M_AU);
    LAS float* SEG = (LAS float*)(lds + M_SEG);
    LAS float* prm = (LAS float*)(lds + M_PRM);
    LAS float* CAR = (LAS float*)(lds + M_CAR);
    __syncthreads();
    for (int e = tid; e < 4 * 4096; e += NT) { const int g = e >> 12, i = (e >> 6) & 63, j = e & 63, d = g >> 1; const size_t o = ((size_t)(d * 8 + hb) * 64 + i) * 64 + j;
        Wt[(g * 64 + j) * 72 + i] = f2bf((g & 1) ? p.in[I_WI][o] : p.in[I_WA][o]); }
    if (tid < 64) { const int ch = 64 * hb + tid;
        prm[tid] = p.in[I_CONVW][ch]; prm[64 + tid] = p.in[I_CONVW][512 + ch]; prm[128 + tid] = p.in[I_CONVW][1024 + ch]; prm[192 + tid] = p.in[I_CONVW][1536 + ch]; prm[256 + tid] = p.in[I_CONVB][ch];
        prm[320 + tid] = p.in[I_BA][ch]; prm[384 + tid] = p.in[I_BA][512 + ch]; prm[448 + tid] = p.in[I_BI][ch]; prm[512 + tid] = p.in[I_BI][512 + ch];
        prm[576 + tid] = log1pf(expf(-p.in[I_LAM][ch])); prm[640 + tid] = log1pf(expf(-p.in[I_LAM][512 + ch])); }
    const int nrc = (PASS == 1) ? NRC : 512;
    const int span = (PASS == 3) ? 512 / (nlb >> 3) : 1, cpr = (PASS == 3) ? (rcnt < 0 ? span : rcnt) : 1, rc_lo = (PASS == 3) ? (lb >> 3) * span + roff : (lb >> 3), rstep = (PASS == 3) ? 1 : (nlb >> 3), rc_hi = (PASS == 3) ? rc_lo + cpr : nrc;
    float* LCAR = (float*)(p.ws + WS_LCAR);
    if (PASS == 3) { const int d = (tid >> 6) & 1, j = tid & 63, sg4 = tid >> 7, ch = 64 * hb + j, b = rc_lo >> 7, cl0 = rc_lo & 127;
        const int p_lo = d ? 4 + 127 - (cl0 + cpr - 1) : 4 + cl0, q4 = (p_lo + 3) >> 2, s_lo = sg4 * q4, s_hi = (s_lo + q4 < p_lo) ? s_lo + q4 : p_lo;
        const float* S = LSUM + (size_t)d * NRC * 1024 + 2 * ch; float fa = 1.f, fh = 0.f;
#pragma unroll 8
        for (int s = s_lo; s < s_hi; ++s) { const float* e2 = S + (size_t)lru_rc_at(d, b, s) * 1024; const float a = e2[0]; fh = a * fh + e2[1]; fa *= a; }
        SEG[(sg4 * 128 + (tid & 127)) * 2] = fa; SEG[(sg4 * 128 + (tid & 127)) * 2 + 1] = fh;
        __syncthreads();
        if (tid < 128) { float hcar = 0.f;
#pragma unroll
            for (int k = 0; k < 4; ++k) hcar = SEG[(k * 128 + tid) * 2] * hcar + SEG[(k * 128 + tid) * 2 + 1];
            for (int s = p_lo; s < p_lo + cpr; ++s) { const int rcs = lru_rc_at(d, b, s); LCAR[((size_t)d * NRC + rcs) * 512 + ch] = hcar; const float* e2 = S + (size_t)rcs * 1024; hcar = e2[0] * hcar + e2[1]; } }
    }
    u32x4 px[2];
#define LRU_PREFETCH(rc_) do { const int rc__ = (rc_); const int row0_ = rc__ * 64; const int seg_lo_ = (rc__ >= 512) ? NLAT + ((rc__ - 512) >> 2) * LC : (rc__ >> 7) * L, seg_hi_ = seg_lo_ + ((rc__ >= 512) ? LC : L); \
    _Pragma("unroll") for (int i = 0; i < 2; ++i) { const int e = tid + 512 * i, rr = e >> 3, pc = e & 7, grow = row0_ - 2 + rr; px[i] = (u32x4){0u, 0u, 0u, 0u}; \
        if (e < 67 * 8 && grow >= seg_lo_ && grow < seg_hi_) px[i] = *(const u32x4*)(C1 + (size_t)grow * C1LD + 2560 + 64 * hb + 8 * pc); } } while (0)
    int rc = rc_lo;
    if (rc < rc_hi) LRU_PREFETCH(rc);
    for (; rc < rc_hi; rc += rstep) {
        const int row0 = rc * 64;
        const int sg = tid >> 6, j = lane, ch = 64 * hb + j;
        float cin = 0.f;
        if (PASS == 3 && tid < 128) cin = LCAR[((size_t)(tid >> 6) * NRC + rc) * 512 + ch];
        float gbv[8];
        if (PASS == 3) {
#pragma unroll
            for (int k = 0; k < 8; ++k) gbv[k] = bf2f(C1[(size_t)(row0 + 8 * sg + k) * C1LD + 3072 + ch]); }
#pragma unroll
        for (int i = 0; i < 2; ++i) { const int e = tid + 512 * i; if (e < 67 * 8) { const int rr = e >> 3, pc = e & 7; const u32x4 v = px[i];
            f32x4 lo, hi; lo[0] = __uint_as_float(v[0] << 16); lo[1] = __uint_as_float(v[0] & 0xffff0000u); lo[2] = __uint_as_float(v[1] << 16); lo[3] = __uint_as_float(v[1] & 0xffff0000u);
            hi[0] = __uint_as_float(v[2] << 16); hi[1] = __uint_as_float(v[2] & 0xffff0000u); hi[2] = __uint_as_float(v[3] << 16); hi[3] = __uint_as_float(v[3] & 0xffff0000u);
            *(LAS f32x4*)(XB + rr * XBP + 8 * pc) = lo; *(LAS f32x4*)(XB + rr * XBP + 8 * pc + 4) = hi; } }
        if (PASS == 3 && tid < 128) CAR[tid] = cin;
        __syncthreads();
        if (rc + rstep < rc_hi) LRU_PREFETCH(rc + rstep);
        {
            const int t = tid >> 3, i0 = 8 * (tid & 7); float xc[8];
#pragma unroll
            for (int hh = 0; hh < 2; ++hh) { const int i = i0 + 4 * hh;
                f32x4 acc4 = *(const LAS f32x4*)(prm + 256 + i);
#pragma unroll
                for (int k = 0; k < 4; ++k) acc4 += *(const LAS f32x4*)(prm + 64 * k + i) * *(const LAS f32x4*)(XB + (t + k) * XBP + i);
                *(LAS f32x4*)(XCf + t * XFP + i) = acc4; xc[4 * hh] = acc4[0]; xc[4 * hh + 1] = acc4[1]; xc[4 * hh + 2] = acc4[2]; xc[4 * hh + 3] = acc4[3]; }
            u32x4 w; w.x = pack2(xc[0], xc[1]); w.y = pack2(xc[2], xc[3]); w.z = pack2(xc[4], xc[5]); w.w = pack2(xc[6], xc[7]);
            *(LAS u32x4*)(XCs + t * 72 + i0) = w;
        }
        __syncthreads();
        {
            const int jt = wv & 3, th = wv >> 2, jc = 16 * jt + r;
#pragma unroll
            for (int d = 0; d < 2; ++d) { const float ba = prm[320 + 64 * d + jc], bi = prm[448 + 64 * d + jc], spl = prm[576 + 64 * d + jc];
#pragma unroll
                for (int i2 = 0; i2 < 2; ++i2) { const int tt = 2 * th + i2;
                    f32x4 aa = (f32x4){0.f, 0.f, 0.f, 0.f}, ai = (f32x4){0.f, 0.f, 0.f, 0.f};
#pragma unroll
                    for (int kk = 0; kk < 2; ++kk) { const bf16x8 xf = *(const LAS bf16x8*)(XCs + (16 * tt + r) * 72 + 32 * kk + 8 * q);
                        const bf16x8 wa = *(const LAS bf16x8*)(Wt + ((2 * d) * 64 + 16 * jt + r) * 72 + 32 * kk + 8 * q), wi = *(const LAS bf16x8*)(Wt + ((2 * d + 1) * 64 + 16 * jt + r) * 72 + 32 * kk + 8 * q);
                        aa = __builtin_amdgcn_mfma_f32_16x16x32_bf16(xf, wa, aa, 0, 0, 0); ai = __builtin_amdgcn_mfma_f32_16x16x32_bf16(xf, wi, ai, 0, 0, 0); }
#pragma unroll
                    for (int jj = 0; jj < 4; ++jj) { const int t = 16 * tt + 4 * q + jj;
                        const float rg = fsigm(aa[jj] + ba), ig = fsigm(ai[jj] + bi), la = -8.f * rg * spl;
                        const float a = fexp(la);
                        AU[((2 * d) * 64 + t) * AUP + jc] = a; AU[((2 * d + 1) * 64 + t) * AUP + jc] = __builtin_amdgcn_sqrtf(fmaxf(fmaf(-a, a, 1.f), 0.f)) * (ig * XCf[t * XFP + jc]); } } }
        }
        __syncthreads();
        const LAS float* A0 = AU + (8 * sg) * AUP + j; const LAS float* U0 = AU + (64 + 8 * sg) * AUP + j; const LAS float* A1 = AU + (128 + 8 * sg) * AUP + j; const LAS float* U1 = AU + (192 + 8 * sg) * AUP + j;
        {
            float p0 = 1.f, h0 = 0.f, p1 = 1.f, h1 = 0.f;
#pragma unroll
            for (int k = 0; k < 8; ++k) { const float a = A0[k * AUP]; h0 = a * h0 + U0[k * AUP]; p0 *= a; }
#pragma unroll
            for (int k = 7; k >= 0; --k) { const float a = A1[k * AUP]; h1 = a * h1 + U1[k * AUP]; p1 *= a; }
            SEG[(0 * 8 + sg) * 64 + j] = p0; SEG[(1 * 8 + sg) * 64 + j] = h0; SEG[(2 * 8 + sg) * 64 + j] = p1; SEG[(3 * 8 + sg) * 64 + j] = h1;
        }
        __syncthreads();
        if (PASS == 1) {
            if (tid < 128) { const int d = tid >> 6; float pa = 1.f, hh = 0.f;
#pragma unroll
                for (int s2 = 0; s2 < 8; ++s2) { const int sgi = d ? 7 - s2 : s2; const float ps = SEG[((2 * d) * 8 + sgi) * 64 + j], hs = SEG[((2 * d + 1) * 8 + sgi) * 64 + j]; hh = ps * hh + hs; pa *= ps; }
                float* o = LSUM + ((size_t)d * NRC + rc) * 1024 + 2 * ch; o[0] = pa; o[1] = hh; }
        } else {
            float hf = CAR[j], hbk = CAR[64 + j];
            for (int s2 = 0; s2 < sg; ++s2) hf = SEG[(0 * 8 + s2) * 64 + j] * hf + SEG[(1 * 8 + s2) * 64 + j];
            for (int s2 = 7; s2 > sg; --s2) hbk = SEG[(2 * 8 + s2) * 64 + j] * hbk + SEG[(3 * 8 + s2) * 64 + j];
            float of[8];
#pragma unroll
            for (int k = 0; k < 8; ++k) { hf = A0[k * AUP] * hf + U0[k * AUP]; of[k] = hf; }
#pragma unroll
            for (int k = 7; k >= 0; --k) { hbk = A1[k * AUP] * hbk + U1[k * AUP]; of[k] += hbk; }
#pragma unroll
            for (int k = 0; k < 8; ++k) Y[(size_t)nat_row(row0 + 8 * sg + k) * D + 512 + ch] = f2bf(of[k] * fgelu(gbv[k]));
        }
        __syncthreads();
    }
#undef LRU_PREFETCH
}
constexpr int PT = 72, PM = 40;
constexpr int C_PRM = 0, C_GAM = C_PRM + 3072, C_MISC = C_GAM + 1024, C_SBF = C_MISC + 1280, C_TILES = C_SBF + 2 * 64 * PT * 2, C_TH = C_TILES + 5 * 80 * PT * 2, C_MBF = C_TH + 2 * 64 * PT * 2,
              C_SM = C_MBF + 4 * 16 * 20 * 4, C_W1T = C_SM + 4 * 4 * 16 * PM * 2, C_AH = C_W1T + 4 * 64 * PM * 2, C_YV = C_AH + 4 * 16 * PT * 2, C_END = C_YV + 64 * PM * 2;
static_assert(C_END <= LDS_BYTES - 16, "rwkv chunk LDS map");
DI void unpack4(u32x2 v, float* o) { o[0] = __uint_as_float(v.x << 16); o[1] = __uint_as_float(v.x & 0xffff0000u); o[2] = __uint_as_float(v.y << 16); o[3] = __uint_as_float(v.y & 0xffff0000u); }
DI u32x2 pack4(float a, float b, float c, float d) { u32x2 w; w.x = pack2(a, b); w.y = pack2(c, d); return w; }
DI bf16x8 zero_if(bf16x8 v, bool z) { const bf16x8 zz = {0, 0, 0, 0, 0, 0, 0, 0}; return z ? zz : v; }

constexpr int RING_SLOTS = 8, SLOT_U64 = 7936;
#ifndef RW_G0
#define RW_G0 88
#endif
static_assert(RW_G0 % 2 == 0 && RW_G0 <= 132, "RW_G0");
DI int rw_next_group(int g, int hs) { if (g >= RW_G0) return g + 3; const int gn = g + 2; return gn < RW_G0 ? gn : RW_G0 + hs; }
DI int rw_first_group(int hs) { return hs < 2 ? hs : RW_G0 + 2; }
DI void rw_ready_of(unsigned g, unsigned& helper, unsigned& count) { if (g < (unsigned)RW_G0) { helper = g & 1u; count = (g >> 1) + 1u; } else { const unsigned j = g - (unsigned)RW_G0; helper = j % 3u; count = (helper < 2u ? (unsigned)RW_G0 / 2u : 0u) + j / 3u + 1u; } }
constexpr int S_GAM = 4096, S_BS = 4224, S_AH = 4256, S_NK = 5280, S_NB = 5536, S_YH = 5792, S_END = 7840;
DI int slot_lds(int e) {
    if (e < S_GAM) return C_TILES + ((e >> 10) + 1) * (80 * PT * 2) + ((e >> 4) & 63) * (PT * 2) + (e & 15) * 8;
    if (e < S_BS) return C_GAM + (e - S_GAM) * 8;
    if (e < S_AH) return C_MISC + 1024 + (e - S_BS) * 8;
    if (e < S_NK) { const int x = e - S_AH; return C_AH + (x >> 4) * (PT * 2) + (x & 15) * 8; }
    if (e < S_NB) { const int x = e - S_NK; return C_SM + 4 * 16 * PM * 2 + (x >> 2) * (PM * 2) + (x & 3) * 8; }
    const int x = e - S_NB; return C_SM + 2 * 4 * 16 * PM * 2 + (x >> 2) * (PM * 2) + (x & 3) * 8;
}
constexpr size_t WS_RING = WS_Z1;
DI void wait_ge(unsigned* word, unsigned want) {
    unsigned spins = 0;
    while ((unsigned)__builtin_amdgcn_readfirstlane((int)__hip_atomic_load(word, __ATOMIC_RELAXED, __HIP_MEMORY_SCOPE_AGENT)) < want) { __builtin_amdgcn_s_sleep(2); if (++spins > (1u << 21)) break; }
    __builtin_amdgcn_fence(__ATOMIC_ACQUIRE, "agent");
    asm volatile("s_waitcnt vmcnt(0)" ::: "memory");
}
template <int ROLE> DI void rwkv_chunk_unit(const P& p, LAS unsigned char* lds, const int vb, const int hs = 0, unsigned* waitcnt = nullptr) {
    const int tid = mk_tid(), lane = tid & 63, wv = __builtin_amdgcn_readfirstlane(tid >> 6), r = lane & 15, q = lane >> 4;
    const int d = vb >> 5, b = (vb >> 3) & 3, h = vb & 7;
    const bf16_t* RW = (const bf16_t*)(p.ws + WS_COLS) + OFF_RW; const bf16_t* LO = (const bf16_t*)(p.ws + WS_COLS) + OFF_LO; bf16_t* Z = (bf16_t*)((unsigned char*)p.out);
    unsigned long long* ring = (unsigned long long*)(p.ws + WS_RING) + (size_t)vb * RING_SLOTS * SLOT_U64;
    unsigned* READY0 = (unsigned*)(p.ws + WS_CTL) + 64 * vb; unsigned* READY1 = (unsigned*)(p.ws + WS_CTL) + 64 * (192 + vb); unsigned* ACK = (unsigned*)(p.ws + WS_CTL) + 64 * (64 + vb);
    unsigned* READY2 = READY0 + 32; unsigned* READYH = hs == 0 ? READY0 : hs == 1 ? READY1 : READY2; unsigned own = 0u;
    LAS float* prm = (LAS float*)(lds + C_PRM); LAS float* GAM = (LAS float*)(lds + C_GAM); LAS float* SSQ = (LAS float*)(lds + C_MISC); LAS float* BSP = SSQ + 128; LAS float* BS = SSQ + 256;
    LAS bf16_t* Sbf = (LAS bf16_t*)(lds + C_SBF);
    LAS bf16_t* At = (LAS bf16_t*)(lds + C_TILES); LAS bf16_t* Rt = At + 80 * PT; LAS bf16_t* Bt = Rt + 80 * PT; LAS bf16_t* Kt = Bt + 80 * PT; LAS bf16_t* Vt = Kt + 80 * PT;
    LAS bf16_t* TH = (LAS bf16_t*)(lds + C_TH); LAS bf16_t* AD = TH + 64 * PT; LAS float* OUT = (LAS float*)(lds + C_TH);
    LAS float* MBf = (LAS float*)(lds + C_MBF);
    LAS bf16_t* MK = (LAS bf16_t*)(lds + C_SM); LAS bf16_t* NK = MK + 4 * 16 * PM; LAS bf16_t* NB = NK + 4 * 16 * PM; LAS bf16_t* DNV = NB + 4 * 16 * PM;
    LAS bf16_t* W1T = (LAS bf16_t*)(lds + C_W1T); LAS bf16_t* AH = (LAS bf16_t*)(lds + C_AH); LAS bf16_t* YV = (LAS bf16_t*)(lds + C_YV);
    const unsigned at_b = (unsigned)(size_t)At, bt_b = (unsigned)(size_t)Bt, kt_b = (unsigned)(size_t)Kt, vt_b = (unsigned)(size_t)Vt;
    __syncthreads();
    for (int e = tid; e < (C_END - C_SBF) / 4; e += NT) ((LAS unsigned*)(lds + C_SBF))[e] = 0u;
    if (tid < 64) { const int j = tid, c = 64 * h + j; const float* mu = p.in[I_MU] + d * 1664;
        prm[j] = mu[c]; prm[64 + j] = mu[512 + c]; prm[128 + j] = mu[1024 + c]; prm[192 + j] = mu[1536 + j]; prm[256 + j] = mu[1600 + j];
        prm[320 + j] = p.in[I_W0][d * 512 + c]; prm[384 + j] = p.in[I_A0][d * 512 + c]; prm[448 + j] = p.in[I_KK][d * 512 + c]; prm[512 + j] = p.in[I_KA][d * 512 + c];
        prm[576 + j] = p.in[I_RK][(d * 8 + h) * 64 + j]; prm[640 + j] = p.in[I_LNW][d * 512 + c]; prm[704 + j] = p.in[I_LNB][d * 512 + c]; }
    const int m1 = wv & 3, h2 = wv >> 2, cb8 = 32 * h2 + 8 * q;
    bf16x8 fw2[2][2], fa2[2][2];
    if (ROLE != 1) {
#pragma unroll
    for (int t = 0; t < 2; ++t)
#pragma unroll
        for (int kk = 0; kk < 2; ++kk) { const int c = 64 * h + 32 * h2 + 8 * (r >> 2) + 4 * t + (r & 3);
            const float* w2p = p.in[I_W2L] + (size_t)(d * 64 + 32 * kk + 8 * q) * 512 + c; const float* a2p = p.in[I_A2L] + (size_t)(d * 64 + 32 * kk + 8 * q) * 512 + c;
#pragma unroll
            for (int e = 0; e < 8; ++e) { fw2[t][kk][e] = (short)f2bf(w2p[e * 512]); fa2[t][kk][e] = (short)f2bf(a2p[e * 512]); }
            asm volatile("" ::: "memory"); }
    }
    f32x4 Sacc[2] = {(f32x4){0.f, 0.f, 0.f, 0.f}, (f32x4){0.f, 0.f, 0.f, 0.f}};
    int cur = 0;
    unsigned long long tacc = 0ull, tmark = 0ull;
#define TP_BEGIN(code) do { if (MK_TPROBE == (code)) tmark = __builtin_amdgcn_s_memrealtime(); } while (0)
#define TP_END(code) do { if (MK_TPROBE == (code)) tacc += __builtin_amdgcn_s_memrealtime() - tmark; } while (0)
    unsigned ack_seen = 0u;
    unsigned long long pf[12]; f32x4 yh[4]; bool pf_ok = false;
    u32x4 gc[5], gp[5];
#define RWKV_LOAD(n0x) do { const int n1_ = (n0x) + 16 * m1 + r; const bool hp_ = (n1_ != 0) && (n1_ != LC); const unsigned row_ = (unsigned)step_row(d, b, n1_), prow_ = hp_ ? (unsigned)step_row(d, b, n1_ - 1) : row_; \
    const unsigned rwc_ = row_ * 1536u + 64u * h + cb8, rwp_ = prow_ * 1536u + 64u * h + cb8, loc_ = row_ * 512u + 64u * d + cb8, lop_ = prow_ * 512u + 64u * d + cb8; \
    gc[0] = *(const u32x4*)(RW + rwc_); gc[1] = *(const u32x4*)(RW + rwc_ + 512u); gc[2] = *(const u32x4*)(RW + rwc_ + 1024u); gc[3] = *(const u32x4*)(LO + loc_); gc[4] = *(const u32x4*)(LO + loc_ + 128u); \
    gp[0] = *(const u32x4*)(RW + rwp_); gp[1] = *(const u32x4*)(RW + rwp_ + 512u); gp[2] = *(const u32x4*)(RW + rwp_ + 1024u); gp[3] = *(const u32x4*)(LO + lop_); gp[4] = *(const u32x4*)(LO + lop_ + 128u); } while (0)
    const int n0_start = (ROLE == 2) ? 64 * rw_first_group(hs) : 0;
    if (waitcnt) sub_wait(waitcnt, (unsigned)gridDim.x);
    if (ROLE != 1 && n0_start < LT) RWKV_LOAD(n0_start);
    __syncthreads();
    for (int n0 = n0_start; n0 < LT; n0 = (ROLE == 2) ? 64 * rw_next_group(n0 >> 6, hs) : n0 + 64) {
        if (ROLE == 2) { TP_BEGIN(5); TP_BEGIN(15); }
        if (ROLE != 1) for (int rep0 = 0; rep0 < (MK_RDUP == 0 ? 2 : 1); ++rep0) {
        const int u1 = 16 * m1 + r, n1 = n0 + u1; const bool hp = (n1 != 0) && (n1 != LC);
        float rs[8], ks[8], vs[8];
        for (int rA1 = 0; rA1 < (MK_RDUP == 10 ? 2 : 1); ++rA1) {
            float a0[8], a1[8], th[8], ad[8];
#define UNPACK8(v, o) { _Pragma("unroll") for (int k_ = 0; k_ < 4; ++k_) { o[2 * k_] = __uint_as_float(v[k_] << 16); o[2 * k_ + 1] = __uint_as_float(v[k_] & 0xffff0000u); } }
#define RW_SHIFT(dst, idx, muo) { const u32x4 pz = hp ? gp[idx] : (u32x4){0u, 0u, 0u, 0u}; UNPACK8(gc[idx], a0) UNPACK8(pz, a1) \
            const f32x4 mu0 = *(const LAS f32x4*)(prm + (muo) + cb8), mu1 = *(const LAS f32x4*)(prm + (muo) + cb8 + 4); \
            _Pragma("unroll") for (int e = 0; e < 4; ++e) { dst[e] = a0[e] + mu0[e] * (a1[e] - a0[e]); dst[4 + e] = a0[4 + e] + mu1[e] * (a1[4 + e] - a0[4 + e]); } }
            RW_SHIFT(th, 3, 192) asm volatile("" ::: "memory"); RW_SHIFT(ad, 4, 256) asm volatile("" ::: "memory"); RW_SHIFT(rs, 0, 0) asm volatile("" ::: "memory"); RW_SHIFT(ks, 1, 64) asm volatile("" ::: "memory"); RW_SHIFT(vs, 2, 128)
#undef RW_SHIFT
#pragma unroll
            for (int e = 0; e < 8; ++e) th[e] = ftanh(th[e]);
            u32x4 w; w.x = pack2(th[0], th[1]); w.y = pack2(th[2], th[3]); w.z = pack2(th[4], th[5]); w.w = pack2(th[6], th[7]); *(LAS u32x4*)(TH + u1 * PT + cb8) = w;
            w.x = pack2(ad[0], ad[1]); w.y = pack2(ad[2], ad[3]); w.z = pack2(ad[4], ad[5]); w.w = pack2(ad[6], ad[7]); *(LAS u32x4*)(AD + u1 * PT + cb8) = w;
            asm volatile("" ::: "memory");
        }
        __syncthreads();
        float elog[8], av[8], kkr[8], km[8]; float ssq = 0.f, bsp = 0.f;
        for (int rA3 = 0; rA3 < (MK_RDUP == 11 ? 2 : 1); ++rA3) { ssq = 0.f; bsp = 0.f;
#pragma unroll
        for (int t = 0; t < 2; ++t) {
            f32x4 xw = (f32x4){0.f, 0.f, 0.f, 0.f}, xa = (f32x4){0.f, 0.f, 0.f, 0.f};
#pragma unroll
            for (int kk = 0; kk < 2; ++kk) { const bf16x8 bt = *(const LAS bf16x8*)(TH + u1 * PT + 32 * kk + 8 * q), ba = *(const LAS bf16x8*)(AD + u1 * PT + 32 * kk + 8 * q);
                xw = __builtin_amdgcn_mfma_f32_16x16x32_bf16(fw2[t][kk], bt, xw, 0, 0, 0); xa = __builtin_amdgcn_mfma_f32_16x16x32_bf16(fa2[t][kk], ba, xa, 0, 0, 0); }
            const int cb = cb8 + 4 * t;
            const f32x4 w04 = *(const LAS f32x4*)(prm + 320 + cb), a04 = *(const LAS f32x4*)(prm + 384 + cb), kk4 = *(const LAS f32x4*)(prm + 448 + cb), ka4 = *(const LAS f32x4*)(prm + 512 + cb), rk4 = *(const LAS f32x4*)(prm + 576 + cb);
#pragma unroll
            for (int jj = 0; jj < 4; ++jj) { const int e = 4 * t + jj;
                elog[e] = 0.6065306597126334f * fsigm(xw[jj] + w04[jj]); av[e] = fsigm(xa[jj] + a04[jj]);
                kkr[e] = ks[e] * kk4[jj]; ssq += kkr[e] * kkr[e]; km[e] = ks[e] * (1.f + (av[e] - 1.f) * ka4[jj]); bsp += rs[e] * km[e] * rk4[jj]; }
            asm volatile("" ::: "memory");
        }
        ssq += __shfl_xor(ssq, 16); ssq += __shfl_xor(ssq, 32); bsp += __shfl_xor(bsp, 16); bsp += __shfl_xor(bsp, 32);
        if (q == 0) { SSQ[h2 * 64 + u1] = ssq; BSP[h2 * 64 + u1] = bsp; } }
        __syncthreads();
        for (int rA4 = 0; rA4 < (MK_RDUP == 12 ? 2 : 1); ++rA4) {
            const float tot = SSQ[u1] + SSQ[64 + u1]; const float inv = 1.f / fmaxf(sqrtf(tot), 1e-12f);
            if (h2 == 0 && q == 0) BS[u1] = BSP[u1] + BSP[64 + u1];
            float al[8], be[8], ka[8], rh[8];
#pragma unroll
            for (int e = 0; e < 8; ++e) {
                const float g = scan16(-elog[e]);
                const float ep = fexp(g), em = frcp(ep), eps = dppf<0x111>(ep), epp = (r == 0) ? 1.f : eps;
                const float kk = kkr[e] * inv;
                al[e] = kk * epp; be[e] = kk * av[e] * em; ka[e] = km[e] * em; rh[e] = rs[e] * ep;
                if (r == 15) GAM[m1 * 64 + cb8 + e] = ep; }
            u32x4 w;
#define ST8(T, v) w.x = pack2(v[0], v[1]); w.y = pack2(v[2], v[3]); w.z = pack2(v[4], v[5]); w.w = pack2(v[6], v[7]); *(LAS u32x4*)(T + u1 * PT + cb8) = w;
            ST8(At, al) ST8(Bt, be) ST8(Kt, ka) ST8(Rt, rh) ST8(Vt, vs)
#undef ST8
        }
        if (ROLE == 2 && own > 0u) asm volatile("s_waitcnt vmcnt(0)" ::: "memory");
        __syncthreads();
        if (ROLE == 2 && own > 0u && tid == 0) __hip_atomic_store(READYH, own, __ATOMIC_RELAXED, __HIP_MEMORY_SCOPE_AGENT);
        }
        if (ROLE == 0 && n0 + 64 < LT) RWKV_LOAD(n0 + 64);
        f32x4 yhat[4];
        if (ROLE == 1) {
            const unsigned g = (unsigned)(n0 >> 6);
            TP_BEGIN(2); TP_BEGIN(1);
            if (!pf_ok) { if (wv == 0) wait_ge((g & 1u) ? READY1 : READY0, (g >> 1) + 1u); __syncthreads(); TP_END(1);
                const unsigned long long* slot = ring + (size_t)(g % RING_SLOTS) * SLOT_U64;
#pragma unroll
                for (int k = 0; k < 12; ++k) { const int e = tid + NT * k; if (e < S_YH) pf[k] = slot[e]; }
#pragma unroll
                for (int m = 0; m < 4; ++m) yh[m] = *(const f32x4*)(slot + S_YH + ((m * 4 + (wv & 3)) * 64 + lane) * 2); }
            for (int rep7 = 0; rep7 < (MK_RDUP == 7 ? 2 : 1); ++rep7) { if (rep7) __syncthreads();
#pragma unroll
            for (int k = 0; k < 12; ++k) { const int e = tid + NT * k; if (e < S_YH) *(LAS unsigned long long*)(lds + slot_lds(e)) = pf[k]; }
            asm volatile("s_waitcnt vmcnt(0)" ::: "memory");
            __syncthreads(); }
            if (tid == 0) __hip_atomic_store(ACK, g + 1u, __ATOMIC_RELAXED, __HIP_MEMORY_SCOPE_AGENT);
            TP_END(2);
#pragma unroll
            for (int m = 0; m < 4; ++m) yhat[m] = yh[m];
        }
        if (ROLE == 2) { TP_END(5); TP_BEGIN(6); }
        if (ROLE != 1) for (int rep1 = 0; rep1 < (MK_RDUP == 1 ? 2 : 1); ++rep1) {
        {
            const int m = wv >> 1, pp = wv & 1; LAS bf16_t* XB = pp ? Rt : At;
            f32x4 c1 = (f32x4){0.f, 0.f, 0.f, 0.f}, c2 = (f32x4){0.f, 0.f, 0.f, 0.f};
#pragma unroll
            for (int kk = 0; kk < 2; ++kk) { const bf16x8 bx = *(const LAS bf16x8*)(XB + (16 * m + r) * PT + 32 * kk + 8 * q);
                const bf16x8 a1 = *(const LAS bf16x8*)(Bt + (16 * m + r) * PT + 32 * kk + 8 * q), a2 = *(const LAS bf16x8*)(Kt + (16 * m + r) * PT + 32 * kk + 8 * q);
                c1 = __builtin_amdgcn_mfma_f32_16x16x32_bf16(a1, bx, c1, 0, 0, 0); c2 = __builtin_amdgcn_mfma_f32_16x16x32_bf16(a2, bx, c2, 0, 0, 0); }
#pragma unroll
            for (int jj = 0; jj < 4; ++jj) { const int s = 4 * q + jj; const bool ok = pp ? (s <= r) : (s < r); if (!ok) { c1[jj] = 0.f; c2[jj] = 0.f; } }
            if (pp == 0) { *(LAS f32x4*)(MBf + (m * 16 + r) * 20 + 4 * q) = c1; *(LAS u32x2*)(MK + (m * 16 + r) * PM + 4 * q) = pack4(c2[0], c2[1], c2[2], c2[3]); }
            else { *(LAS u32x2*)(NB + (m * 16 + r) * PM + 4 * q) = pack4(c1[0], c1[1], c1[2], c1[3]); *(LAS u32x2*)(NK + (m * 16 + r) * PM + 4 * q) = pack4(c2[0], c2[1], c2[2], c2[3]); }
        }
        __syncthreads();
        if (wv < 4) {
            const int m = wv, c = r; float X[16];
#pragma unroll
            for (int u = 0; u < 16; ++u) { float x = (c == u) ? 1.f : 0.f;
                if (u > 0) { const LAS f32x4* rowp = (const LAS f32x4*)(MBf + (m * 16 + u) * 20);
#pragma unroll
                    for (int s4 = 0; s4 < 4; ++s4) { if (4 * s4 < u) { const f32x4 l = rowp[s4];
#pragma unroll
                        for (int e = 0; e < 4; ++e) if (4 * s4 + e < u) x -= l[e] * X[4 * s4 + e]; } } }
                X[u] = x; }
            if (q == 0) {
#pragma unroll
                for (int u = 0; u < 16; ++u) DNV[(m * 16 + u) * PM + c] = f2bf(X[u]); }
        } else {
            const int m = wv - 4; const bf16x8 a = *(const LAS bf16x8*)(MK + (m * 16 + r) * PM + 8 * q);
            bf16x8 bvs[4]; tr_frag4(bvs[0], bvs[1], bvs[2], bvs[3], tr_addr(vt_b, PT, 16 * m, 0, r, q), 8u * PT, tr_addr(vt_b, PT, 16 * m, 16, r, q), 8u * PT, tr_addr(vt_b, PT, 16 * m, 32, r, q), 8u * PT, tr_addr(vt_b, PT, 16 * m, 48, r, q), 8u * PT);
#pragma unroll
            for (int it = 0; it < 4; ++it) { const bf16x8 bv = bvs[it];
                const f32x4 acc = __builtin_amdgcn_mfma_f32_16x16x32_bf16(a, bv, (f32x4){0.f, 0.f, 0.f, 0.f}, 0, 0, 0);
                *(LAS u32x2*)(W1T + (m * 64 + 16 * it + r) * PM + 4 * q) = pack4(acc[0], acc[1], acc[2], acc[3]); }
        }
        __syncthreads();
#pragma unroll
        for (int m = 0; m < 4; ++m) yhat[m] = (f32x4){0.f, 0.f, 0.f, 0.f};
        {
            const int it = wv & 3;
#pragma unroll
            for (int m = 0; m < 4; ++m) { const bf16x8 a = *(const LAS bf16x8*)(DNV + (m * 16 + r) * PM + 8 * q), bw = *(const LAS bf16x8*)(W1T + (m * 64 + 16 * it + r) * PM + 8 * q);
                yhat[m] = __builtin_amdgcn_mfma_f32_16x16x32_bf16(a, bw, yhat[m], 0, 0, 0); }
        }
        if (wv >= 4) {
            const int jt = wv - 4;
            bf16x8 afs[4]; tr_frag4(afs[0], afs[1], afs[2], afs[3], tr_addr(at_b, PT, 0, 16 * jt, r, q), 8u * PT, tr_addr(at_b, PT, 16, 16 * jt, r, q), 8u * PT, tr_addr(at_b, PT, 32, 16 * jt, r, q), 8u * PT, tr_addr(at_b, PT, 48, 16 * jt, r, q), 8u * PT);
#pragma unroll
            for (int m = 0; m < 4; ++m) { const bf16x8 a = afs[m], bd = *(const LAS bf16x8*)(DNV + (m * 16 + r) * PM + 8 * q);
                const f32x4 acc = __builtin_amdgcn_mfma_f32_16x16x32_bf16(a, bd, (f32x4){0.f, 0.f, 0.f, 0.f}, 0, 0, 0);
                *(LAS u32x2*)(AH + (m * 16 + r) * PT + 16 * jt + 4 * q) = pack4(acc[0], acc[1], acc[2], acc[3]); }
        }
        __syncthreads();
        }
        if (ROLE == 2) { TP_END(6); TP_BEGIN(7); }
        if (ROLE == 2) {
            const unsigned g = (unsigned)(n0 >> 6);
            TP_BEGIN(16);
            TP_END(16);
            const int nn0 = 64 * rw_next_group((int)g, hs);
            if (nn0 < LT) RWKV_LOAD(nn0);
            TP_BEGIN(4);
            if (g >= RING_SLOTS && ack_seen < g - RING_SLOTS + 1) {
                if (tid == 0) { wait_ge(ACK, g - RING_SLOTS + 1); ((LAS unsigned*)MBf)[17] = __hip_atomic_load(ACK, __ATOMIC_RELAXED, __HIP_MEMORY_SCOPE_AGENT); }
                __syncthreads(); ack_seen = ((LAS unsigned*)MBf)[17]; }
            TP_END(4);
            unsigned long long* slot = ring + (size_t)(g % RING_SLOTS) * SLOT_U64;
#pragma unroll
            for (int k = 0; k < 6; ++k) { const int x = tid + NT * k; if (x < S_YH / 2) { const u32x4 v = *(const LAS u32x4*)(lds + slot_lds(2 * x)); const u32x4* dst = (const u32x4*)slot + x;
                asm volatile("global_store_dwordx4 %0, %1, off sc1" :: "v"(dst), "v"(v) : "memory"); } }
            if (wv < 4) {
#pragma unroll
                for (int m = 0; m < 4; ++m) { const u32x4 v = __builtin_bit_cast(u32x4, yhat[m]); const u32x4* dst = (const u32x4*)(slot + S_YH) + ((m * 4 + wv) * 64 + lane);
                    asm volatile("global_store_dwordx4 %0, %1, off sc1" :: "v"(dst), "v"(v) : "memory"); } }
            ++own;
            if (nn0 >= LT) { asm volatile("s_waitcnt vmcnt(0)" ::: "memory"); __syncthreads(); if (tid == 0) __hip_atomic_store(READYH, own, __ATOMIC_RELAXED, __HIP_MEMORY_SCOPE_AGENT); }
            TP_END(7); TP_END(15);
            continue;
        }
        const int it = wv & 3, jh = wv >> 2;
        bf16x8 nbv, nka0, nka1, nba0, nba1;
#define ST5_FETCH(mm) do { tr_frag3(nbv, nka0, nka1, tr_addr(vt_b, PT, 16 * (mm), 16 * it, r, q), 8u * PT, tr_addr(kt_b, PT, 16 * (mm), 16 * (2 * jh), r, q), 8u * PT, tr_addr(kt_b, PT, 16 * (mm), 16 * (2 * jh + 1), r, q), 8u * PT); \
            nka0 = zero_if(nka0, q >= 2); nka1 = zero_if(nka1, q >= 2); \
            { s16x4 hb0_, hb1_; const unsigned a0_ = bt_b + (unsigned)(((16 * (mm) + 4 * q + (r >> 2)) * PT + 16 * (2 * jh) + 4 * (r & 3)) * 2), a1_ = a0_ + 32u; \
              asm volatile("ds_read_b64_tr_b16 %0, %2\n\tds_read_b64_tr_b16 %1, %3\n\ts_waitcnt lgkmcnt(0)" : "=&v"(hb0_), "=&v"(hb1_) : "v"(a0_), "v"(a1_) : "memory"); \
              nba0 = (bf16x8){hb0_[0], hb0_[1], hb0_[2], hb0_[3], 0, 0, 0, 0}; nba1 = (bf16x8){hb1_[0], hb1_[1], hb1_[2], hb1_[3], 0, 0, 0, 0}; } } while (0)
        TP_BEGIN(3);
        if (ROLE == 1) ST5_FETCH(0);
#pragma unroll 1
        for (int m = 0; m < 4; ++m) {
            LAS bf16_t* Sc = Sbf + cur * 64 * PT; LAS bf16_t* Sn = Sbf + (cur ^ 1) * 64 * PT;
            if (ROLE != 1) ST5_FETCH(m);
            const bf16x8 bv = nbv, ka0 = nka0, ka1 = nka1, ba0 = nba0, ba1 = nba1;
            const bf16x8 ah0 = *(const LAS bf16x8*)(AH + (m * 16 + r) * PT + 8 * q), ah1 = *(const LAS bf16x8*)(AH + (m * 16 + r) * PT + 32 + 8 * q);
            const bf16x8 s0 = *(const LAS bf16x8*)(Sc + (16 * it + r) * PT + 8 * q), s1 = *(const LAS bf16x8*)(Sc + (16 * it + r) * PT + 32 + 8 * q);
            f32x4 acc = (m == 0) ? yhat[0] : (m == 1) ? yhat[1] : (m == 2) ? yhat[2] : yhat[3];
            acc = __builtin_amdgcn_mfma_f32_16x16x32_bf16(ah0, s0, acc, 0, 0, 0);
            acc = __builtin_amdgcn_mfma_f32_16x16x32_bf16(ah1, s1, acc, 0, 0, 0);
            const u32x2 ny = pack4(-acc[0], -acc[1], -acc[2], -acc[3]);
            bf16x8 nyv = {0, 0, 0, 0, 0, 0, 0, 0}; { const s16x4 t4 = __builtin_bit_cast(s16x4, ny); nyv[0] = t4[0]; nyv[1] = t4[1]; nyv[2] = t4[2]; nyv[3] = t4[3]; }
#pragma unroll
            for (int x = 0; x < 2; ++x) { const int jt = 2 * jh + x;
                Sacc[x] = __builtin_amdgcn_mfma_f32_16x16x32_bf16(x ? ka1 : ka0, bv, Sacc[x], 0, 0, 0); Sacc[x] = __builtin_amdgcn_mfma_f32_16x16x32_bf16(x ? ba1 : ba0, nyv, Sacc[x], 0, 0, 0);
                const f32x4 gm = *(const LAS f32x4*)(GAM + m * 64 + 16 * jt + 4 * q); Sacc[x] = Sacc[x] * gm;
                *(LAS u32x2*)(Sn + (16 * it + r) * PT + 16 * jt + 4 * q) = pack4(Sacc[x][0], Sacc[x][1], Sacc[x][2], Sacc[x][3]); }
            if (wv >= 4) {
                f32x4 oacc = (f32x4){0.f, 0.f, 0.f, 0.f};
                oacc = __builtin_amdgcn_mfma_f32_16x16x32_bf16(*(const LAS bf16x8*)(Rt + (16 * m + r) * PT + 8 * q), s0, oacc, 0, 0, 0);
                oacc = __builtin_amdgcn_mfma_f32_16x16x32_bf16(*(const LAS bf16x8*)(Rt + (16 * m + r) * PT + 32 + 8 * q), s1, oacc, 0, 0, 0);
                oacc = __builtin_amdgcn_mfma_f32_16x16x32_bf16(*(const LAS bf16x8*)(NK + (m * 16 + r) * PM + 8 * q), bv, oacc, 0, 0, 0);
                const s16x4 nb4 = *(const LAS s16x4*)(NB + (m * 16 + r) * PM + 4 * q); const bf16x8 nbp = {nb4[0], nb4[1], nb4[2], nb4[3], 0, 0, 0, 0};
                oacc = __builtin_amdgcn_mfma_f32_16x16x32_bf16(nbp, nyv, oacc, 0, 0, 0);
#pragma unroll
                for (int jj = 0; jj < 4; ++jj) OUT[(16 * m + 4 * q + jj) * 68 + 16 * it + r] = oacc[jj]; }
            if (ROLE == 1 && m < 3) ST5_FETCH(m + 1);
            if (ROLE == 1 && m == 0) { if (tid == 0) { const unsigned g1 = (unsigned)(n0 >> 6) + 1u; unsigned ok = 0u;
                    if (g1 < 132u && __hip_atomic_load((g1 & 1u) ? READY1 : READY0, __ATOMIC_RELAXED, __HIP_MEMORY_SCOPE_AGENT) >= (g1 >> 1) + 1u) { __builtin_amdgcn_fence(__ATOMIC_ACQUIRE, "agent"); asm volatile("s_waitcnt vmcnt(0)" ::: "memory"); ok = 1u; }
                    ((LAS unsigned*)MBf)[16] = ok; } }
            __syncthreads();
            if (ROLE == 1 && m == 0) { pf_ok = ((LAS unsigned*)MBf)[16] != 0u;
                if (pf_ok) { const unsigned long long* slot = ring + (size_t)(((unsigned)(n0 >> 6) + 1u) % RING_SLOTS) * SLOT_U64;
#pragma unroll
                    for (int k = 0; k < 12; ++k) { const int e = tid + NT * k; if (e < S_YH) pf[k] = slot[e]; }
#pragma unroll
                    for (int mm = 0; mm < 4; ++mm) yh[mm] = *(const f32x4*)(slot + S_YH + ((mm * 4 + (wv & 3)) * 64 + lane) * 2); } }
            cur ^= 1;
        }
#undef ST5_FETCH
        if (ROLE == 1) TP_END(3);
        for (int rep6 = 0; rep6 < (MK_RDUP == 6 ? 2 : 1); ++rep6) {
            const int u = tid >> 3, part = tid & 7; const size_t row = (size_t)step_row(d, b, n0 + u);
            const f32x4 o0 = *(const LAS f32x4*)(OUT + u * 68 + 8 * part), o1 = *(const LAS f32x4*)(OUT + u * 68 + 8 * part + 4);
            const float mean = sum8((o0[0] + o0[1]) + (o0[2] + o0[3]) + (o1[0] + o1[1]) + (o1[2] + o1[3])) * (1.f / 64.f);
            const f32x4 d0 = o0 - mean, d1 = o1 - mean;
            const float var = sum8((d0[0] * d0[0] + d0[1] * d0[1]) + (d0[2] * d0[2] + d0[3] * d0[3]) + (d1[0] * d1[0] + d1[1] * d1[1]) + (d1[2] * d1[2] + d1[3] * d1[3])) * (1.f / 64.f);
            const float rstd = rsqrtf(var + 64e-5f), bs = BS[u];
            const f32x4 w0 = *(const LAS f32x4*)(prm + 640 + 8 * part), w1 = *(const LAS f32x4*)(prm + 644 + 8 * part), b0 = *(const LAS f32x4*)(prm + 704 + 8 * part), b1 = *(const LAS f32x4*)(prm + 708 + 8 * part);
            const u32x4 vv = *(const LAS u32x4*)(Vt + u * PT + 8 * part);
            float z[8];
#pragma unroll
            for (int k = 0; k < 4; ++k) { z[k] = d0[k] * rstd * w0[k] + b0[k]; z[4 + k] = d1[k] * rstd * w1[k] + b1[k]; }
#pragma unroll
            for (int k = 0; k < 4; ++k) { z[2 * k] += bs * __uint_as_float(vv[k] << 16); z[2 * k + 1] += bs * __uint_as_float(vv[k] & 0xffff0000u); }
            u32x4 w; w.x = pack2(z[0], z[1]); w.y = pack2(z[2], z[3]); w.z = pack2(z[4], z[5]); w.w = pack2(z[6], z[7]);
            *(u32x4*)(Z + ((size_t)d * NALL + row) * 512 + 64 * h + 8 * part) = w;
        }
        __syncthreads();
    }
    if (MK_TPROBE > 0 && tid == 0 && (int)blockIdx.x == (ROLE == 1 ? 0 : 64)) { const unsigned long long t0 = __builtin_amdgcn_s_memrealtime(); while (__builtin_amdgcn_s_memrealtime() - t0 < tacc) __builtin_amdgcn_s_sleep(8); }
    __syncthreads();
}
constexpr int MB_RT = 0, MB_BT = 9216, MB_KT = 18432, MB_VT = 27648, MB_PAD = 36864, MB_GAM = 39168, MB_BS = 40192, MB_AH = 40448, MB_NK = 49664, MB_NB = 54784, MB_YH = 59904, MB_SIZE = 68096;
constexpr int MO_OUT = 2 * MB_SIZE, MO_PRM = MO_OUT + 2 * 64 * 72 * 2, MO_CNT = MO_PRM + 2 * 64 * 4, MO_END = MO_CNT + 16;
static_assert(MO_END <= LDS_BYTES - 16, "rwkv main LDS map");
DI int slot_lds2(int e) {
    if (e < S_GAM) return (e >> 10) * 9216 + ((e >> 4) & 63) * (PT * 2) + (e & 15) * 8;
    if (e < S_BS) return MB_GAM + (e - S_GAM) * 8;
    if (e < S_AH) return MB_BS + (e - S_BS) * 8;
    if (e < S_NK) { const int x = e - S_AH; return MB_AH + (x >> 4) * (PT * 2) + (x & 15) * 8; }
    if (e < S_NB) { const int x = e - S_NK; return MB_NK + (x >> 2) * (PM * 2) + (x & 3) * 8; }
    const int x = e - S_NB; return MB_NB + (x >> 2) * (PM * 2) + (x & 3) * 8;
}
DI bf16x8 join44(s16x4 lo, s16x4 hi) { bf16x8 o; o[0] = lo[0]; o[1] = lo[1]; o[2] = lo[2]; o[3] = lo[3]; o[4] = hi[0]; o[5] = hi[1]; o[6] = hi[2]; o[7] = hi[3]; return o; }
DI void rwkv_main2_unit(const P& p, LAS unsigned char* lds, const int vb) {
    const int tid = mk_tid(), lane = tid & 63, wv = __builtin_amdgcn_readfirstlane(tid >> 6), r = lane & 15, q = lane >> 4;
    const int d = vb >> 5, b = (vb >> 3) & 3, h = vb & 7;
    bf16_t* Z = (bf16_t*)((unsigned char*)p.out);
    const unsigned long long* ring = (const unsigned long long*)(p.ws + WS_RING) + (size_t)vb * RING_SLOTS * SLOT_U64;
    unsigned* READY0 = (unsigned*)(p.ws + WS_CTL) + 64 * vb; unsigned* READY1 = (unsigned*)(p.ws + WS_CTL) + 64 * (192 + vb); unsigned* ACK = (unsigned*)(p.ws + WS_CTL) + 64 * (64 + vb);
    LAS float* prm = (LAS float*)(lds + MO_PRM);
    __syncthreads();
    for (int e = tid; e < MO_END / 4; e += NT) ((LAS unsigned*)lds)[e] = 0u;
    __syncthreads();
    if (tid < 64) { const int c = 64 * h + tid; prm[tid] = p.in[I_LNW][d * 512 + c]; prm[64 + tid] = p.in[I_LNB][d * 512 + c]; }
    const int it = wv & 3;
    unsigned long long tacc = 0ull, tmark = 0ull;
#define TP2_BEGIN(code) do { if (MK_TPROBE == (code)) tmark = __builtin_amdgcn_s_memrealtime(); } while (0)
#define TP2_END(code) do { if (MK_TPROBE == (code)) tacc += __builtin_amdgcn_s_memrealtime() - tmark; } while (0)
    f32x4 Sacc[4];
#pragma unroll
    for (int jt = 0; jt < 4; ++jt) Sacc[jt] = (f32x4){0.f, 0.f, 0.f, 0.f};
#define M2_COPYIN(g_, dowait_) do { const unsigned g__ = (g_); TP2_BEGIN(9); if (dowait_) { unsigned hl_, cn_; rw_ready_of(g__, hl_, cn_); wait_ge(hl_ == 0u ? READY0 : hl_ == 1u ? READY1 : READY0 + 32, cn_); } TP2_END(9); TP2_BEGIN(13); \
        const unsigned long long* slot_ = ring + (size_t)(g__ % RING_SLOTS) * SLOT_U64; LAS unsigned char* buf_ = lds + (g__ & 1u) * MB_SIZE; const int lt_ = tid - 256; \
        u32x4 v_[12]; f32x4 y_[4]; \
        _Pragma("unroll") for (int k_ = 0; k_ < 12; ++k_) { const int x_ = lt_ + 256 * k_; v_[k_] = (x_ < S_YH / 2) ? *((const u32x4*)slot_ + x_) : (u32x4){0u, 0u, 0u, 0u}; } \
        _Pragma("unroll") for (int k_ = 0; k_ < 4; ++k_) y_[k_] = *(const f32x4*)(slot_ + S_YH + 2 * (lt_ + 256 * k_)); \
        _Pragma("unroll") for (int k_ = 0; k_ < 12; ++k_) { const int x_ = lt_ + 256 * k_; if (x_ < S_YH / 2) *(LAS u32x4*)(buf_ + slot_lds2(2 * x_)) = v_[k_]; } \
        _Pragma("unroll") for (int k_ = 0; k_ < 4; ++k_) { const int x_ = lt_ + 256 * k_; *(LAS u32x2*)(buf_ + MB_YH + 8 * x_) = pack4(y_[k_][0], y_[k_][1], y_[k_][2], y_[k_][3]); } \
        asm volatile("s_waitcnt vmcnt(0)" ::: "memory"); TP2_END(13); } while (0)
#define M2_POST(g_) do { const unsigned g__ = (g_); LAS unsigned char* buf_ = lds + (g__ & 1u) * MB_SIZE; const LAS bf16_t* OUTb_ = (const LAS bf16_t*)(lds + MO_OUT + (g__ & 1u) * (64 * 72 * 2)); const int lt_ = tid - 256, part_ = lt_ & 7; \
        _Pragma("unroll") for (int k_ = 0; k_ < 2; ++k_) { const int u_ = (lt_ >> 3) + 32 * k_; const size_t row_ = (size_t)step_row(d, b, (int)g__ * 64 + u_); \
            const u32x4 ov_ = *(const LAS u32x4*)(OUTb_ + u_ * 72 + 8 * part_); float o_[8]; \
            _Pragma("unroll") for (int j_ = 0; j_ < 4; ++j_) { o_[2 * j_] = __uint_as_float(ov_[j_] << 16); o_[2 * j_ + 1] = __uint_as_float(ov_[j_] & 0xffff0000u); } \
            const float mean_ = sum8(((o_[0] + o_[1]) + (o_[2] + o_[3])) + ((o_[4] + o_[5]) + (o_[6] + o_[7]))) * (1.f / 64.f); float var_ = 0.f; \
            _Pragma("unroll") for (int j_ = 0; j_ < 8; ++j_) { o_[j_] -= mean_; var_ += o_[j_] * o_[j_]; } \
            var_ = sum8(var_) * (1.f / 64.f); const float rstd_ = rsqrtf(var_ + 64e-5f), bs_ = ((const LAS float*)(buf_ + MB_BS))[u_]; \
            const u32x4 vv_ = *(const LAS u32x4*)(buf_ + MB_VT + (u_ * PT + 8 * part_) * 2); float z_[8]; \
            _Pragma("unroll") for (int j_ = 0; j_ < 8; ++j_) z_[j_] = o_[j_] * rstd_ * prm[8 * part_ + j_] + prm[64 + 8 * part_ + j_]; \
            _Pragma("unroll") for (int j_ = 0; j_ < 4; ++j_) { z_[2 * j_] += bs_ * __uint_as_float(vv_[j_] << 16); z_[2 * j_ + 1] += bs_ * __uint_as_float(vv_[j_] & 0xffff0000u); } \
            u32x4 w_; w_.x = pack2(z_[0], z_[1]); w_.y = pack2(z_[2], z_[3]); w_.z = pack2(z_[4], z_[5]); w_.w = pack2(z_[6], z_[7]); \
            *(u32x4*)(Z + ((size_t)d * NALL + row_) * 512 + 64 * h + 8 * part_) = w_; } } while (0)
    if (wv >= 4) { M2_COPYIN(0u, true); }
    __syncthreads();
    for (unsigned g = 0; g < 132u; ++g) {
        if (wv < 4) {
            TP2_BEGIN(8);
            LAS unsigned char* buf = lds + (g & 1u) * MB_SIZE;
            const unsigned kt_b = (unsigned)(size_t)(buf + MB_KT), bt_b = (unsigned)(size_t)(buf + MB_BT), vt_b = (unsigned)(size_t)(buf + MB_VT);
            LAS bf16_t* OUTb = (LAS bf16_t*)(lds + MO_OUT + (g & 1u) * (64 * 72 * 2));
#pragma unroll 1
            for (int m = 0; m < 4; ++m) {
                bf16x8 bv, ka0, ka1, ka2, ka3;
                tr_frag5(bv, ka0, ka1, ka2, ka3, tr_addr(vt_b, PT, 16 * m, 16 * it, r, q), 8u * PT, tr_addr(kt_b, PT, 16 * m, 0, r, q), 8u * PT, tr_addr(kt_b, PT, 16 * m, 16, r, q), 8u * PT,
                         tr_addr(kt_b, PT, 16 * m, 32, r, q), 8u * PT, tr_addr(kt_b, PT, 16 * m, 48, r, q), 8u * PT);
                s16x4 hb0, hb1, hb2, hb3;
                { const unsigned a0 = bt_b + (unsigned)(((16 * m + 4 * q + (r >> 2)) * PT + 4 * (r & 3)) * 2);
                  asm volatile("ds_read_b64_tr_b16 %0, %4\n\tds_read_b64_tr_b16 %1, %4 offset:32\n\tds_read_b64_tr_b16 %2, %4 offset:64\n\tds_read_b64_tr_b16 %3, %4 offset:96\n\ts_waitcnt lgkmcnt(0)"
                               : "=&v"(hb0), "=&v"(hb1), "=&v"(hb2), "=&v"(hb3) : "v"(a0) : "memory"); }
                const bool up = q >= 2; const s16x4 z4 = {0, 0, 0, 0};
                const LAS bf16_t* AHm = (const LAS bf16_t*)(buf + MB_AH) + (m * 16 + r) * PT + 4 * q; const LAS bf16_t* RTm = (const LAS bf16_t*)(buf + MB_RT) + (16 * m + r) * PT + 4 * q;
                const bf16x8 ah0 = join44(*(const LAS s16x4*)(AHm), *(const LAS s16x4*)(AHm + 16)), ah1 = join44(*(const LAS s16x4*)(AHm + 32), *(const LAS s16x4*)(AHm + 48));
                const bf16x8 rt0 = join44(*(const LAS s16x4*)(RTm), *(const LAS s16x4*)(RTm + 16)), rt1 = join44(*(const LAS s16x4*)(RTm + 32), *(const LAS s16x4*)(RTm + 48));
                const bf16x8 nks = *(const LAS bf16x8*)(buf + MB_NK + ((m * 16 + r) * PM + 8 * q) * 2);
                const bf16x8 nbp = join44(*(const LAS s16x4*)(buf + MB_NB + ((m * 16 + r) * PM + 4 * q) * 2), z4);
                float yh4[4]; unpack4(*(const LAS u32x2*)(buf + MB_YH + ((m * 4 + it) * 64 + lane) * 8), yh4);
                const bf16x8 sf0 = join44(__builtin_bit_cast(s16x4, pack4(Sacc[0][0], Sacc[0][1], Sacc[0][2], Sacc[0][3])), __builtin_bit_cast(s16x4, pack4(Sacc[1][0], Sacc[1][1], Sacc[1][2], Sacc[1][3])));
                const bf16x8 sf1 = join44(__builtin_bit_cast(s16x4, pack4(Sacc[2][0], Sacc[2][1], Sacc[2][2], Sacc[2][3])), __builtin_bit_cast(s16x4, pack4(Sacc[3][0], Sacc[3][1], Sacc[3][2], Sacc[3][3])));
                f32x4 yv = (f32x4){yh4[0], yh4[1], yh4[2], yh4[3]};
                yv = __builtin_amdgcn_mfma_f32_16x16x32_bf16(ah0, sf0, yv, 0, 0, 0); yv = __builtin_amdgcn_mfma_f32_16x16x32_bf16(ah1, sf1, yv, 0, 0, 0);
                f32x4 oa = (f32x4){0.f, 0.f, 0.f, 0.f};
                oa = __builtin_amdgcn_mfma_f32_16x16x32_bf16(rt0, sf0, oa, 0, 0, 0); oa = __builtin_amdgcn_mfma_f32_16x16x32_bf16(rt1, sf1, oa, 0, 0, 0);
                oa = __builtin_amdgcn_mfma_f32_16x16x32_bf16(nks, bv, oa, 0, 0, 0);
                const bf16x8 nyv = join44(__builtin_bit_cast(s16x4, pack4(-yv[0], -yv[1], -yv[2], -yv[3])), z4);
                oa = __builtin_amdgcn_mfma_f32_16x16x32_bf16(nbp, nyv, oa, 0, 0, 0);
#pragma unroll
                for (int jj = 0; jj < 4; ++jj) OUTb[(16 * m + 4 * q + jj) * 72 + 16 * it + r] = f2bf(oa[jj]);
                const LAS float* gm = (const LAS float*)(buf + MB_GAM) + m * 64 + 4 * q;
                Sacc[0] = __builtin_amdgcn_mfma_f32_16x16x32_bf16(zero_if(ka0, up), bv, Sacc[0], 0, 0, 0); Sacc[0] = __builtin_amdgcn_mfma_f32_16x16x32_bf16(join44(hb0, z4), nyv, Sacc[0], 0, 0, 0); Sacc[0] = Sacc[0] * *(const LAS f32x4*)(gm);
                Sacc[1] = __builtin_amdgcn_mfma_f32_16x16x32_bf16(zero_if(ka1, up), bv, Sacc[1], 0, 0, 0); Sacc[1] = __builtin_amdgcn_mfma_f32_16x16x32_bf16(join44(hb1, z4), nyv, Sacc[1], 0, 0, 0); Sacc[1] = Sacc[1] * *(const LAS f32x4*)(gm + 16);
                Sacc[2] = __builtin_amdgcn_mfma_f32_16x16x32_bf16(zero_if(ka2, up), bv, Sacc[2], 0, 0, 0); Sacc[2] = __builtin_amdgcn_mfma_f32_16x16x32_bf16(join44(hb2, z4), nyv, Sacc[2], 0, 0, 0); Sacc[2] = Sacc[2] * *(const LAS f32x4*)(gm + 32);
                Sacc[3] = __builtin_amdgcn_mfma_f32_16x16x32_bf16(zero_if(ka3, up), bv, Sacc[3], 0, 0, 0); Sacc[3] = __builtin_amdgcn_mfma_f32_16x16x32_bf16(join44(hb3, z4), nyv, Sacc[3], 0, 0, 0); Sacc[3] = Sacc[3] * *(const LAS f32x4*)(gm + 48);
            }
            TP2_END(8);
        } else {
            TP2_BEGIN(10);
            if (tid == 256) __hip_atomic_store(ACK, g + 1u, __ATOMIC_RELAXED, __HIP_MEMORY_SCOPE_AGENT);
            TP2_BEGIN(12);
            if (g >= 1u) M2_POST(g - 1u);
            TP2_END(12);
            if (wv == 4 && g + 1u < 132u) { unsigned hl, cn; rw_ready_of(g + 1u, hl, cn); wait_ge(hl == 0u ? READY0 : hl == 1u ? READY1 : READY0 + 32, cn); }
            {
                LAS unsigned* cnt = (LAS unsigned*)(lds + MO_CNT);
                asm volatile("s_waitcnt lgkmcnt(0)" ::: "memory");
                if (lane == 0) __hip_atomic_fetch_add(cnt, 1u, __ATOMIC_RELAXED, __HIP_MEMORY_SCOPE_WORKGROUP);
                while ((unsigned)__builtin_amdgcn_readfirstlane((int)__hip_atomic_load(cnt, __ATOMIC_RELAXED, __HIP_MEMORY_SCOPE_WORKGROUP)) < 4u * (g + 1u)) __builtin_amdgcn_s_sleep(1);
                asm volatile("" ::: "memory");
            }
            if (g + 1u < 132u) { M2_COPYIN(g + 1u, false); }
            TP2_END(10);
        }
        TP2_BEGIN(11);
        __syncthreads();
        TP2_END(11);
    }
    if (wv >= 4) M2_POST(131u);
    __syncthreads();
    if (MK_TPROBE >= 8 && blockIdx.x == 0 && (tid == 0 || tid == 256)) { if ((MK_TPROBE == 10 || MK_TPROBE == 9 || MK_TPROBE == 12 || MK_TPROBE == 13) == (tid == 256)) { const unsigned long long t0 = __builtin_amdgcn_s_memrealtime(); while (__builtin_amdgcn_s_memrealtime() - t0 < tacc) __builtin_amdgcn_s_sleep(8); } }
    __syncthreads();
#undef M2_COPYIN
#undef M2_POST
}
constexpr int RP_G2 = 0, RP_G2P = 520, RP_SG = RP_G2 + 128 * RP_G2P * 2, RP_END = RP_SG + 32 * PQ * 2;
static_assert(RP_END <= LDS_BYTES - 16, "rwkv post LDS map");
DI void phase_rwkv_post2(const P& p, LAS unsigned char* lds) {
    const int tid = mk_tid(), lane = tid & 63, wv = __builtin_amdgcn_readfirstlane(tid >> 6), r = lane & 15, q = lane >> 4;
    const bf16_t* LO = (const bf16_t*)(p.ws + WS_COLS) + OFF_LO; const bf16_t* Z = (const bf16_t*)((unsigned char*)p.out); bf16_t* Y = (bf16_t*)(p.ws + WS_COLS);
    LAS bf16_t* G2s = (LAS bf16_t*)(lds + RP_G2); LAS bf16_t* SG = (LAS bf16_t*)(lds + RP_SG);
    const unsigned g2_b = (unsigned)(size_t)G2s;
    __syncthreads();
    for (int e = tid; e < 128 * 128; e += NT) { const int rr = e >> 7, c4 = (e & 127) * 4; const f32x4 v = *(const f32x4*)(p.in[I_G2] + rr * 512 + c4);
        const int pos = (c4 & ~63) + 16 * ((c4 >> 2) & 3) + 4 * ((c4 >> 4) & 3);
        *(LAS u32x2*)(G2s + rr * RP_G2P + pos) = pack4(v[0], v[1], v[2], v[3]); }
    for (int unit = blockIdx.x; unit < NRC * 2; unit += gridDim.x) {
        const size_t row0 = (size_t)unit * 32;
        __syncthreads();
        { const int t = tid >> 4, pc = tid & 15; const u32x4 v = *(const u32x4*)(LO + (row0 + t) * 512 + 256 + 8 * pc); u32x4 o;
#pragma unroll
            for (int k = 0; k < 4; ++k) o[k] = pack2(fsigm(__uint_as_float(v[k] << 16)), fsigm(__uint_as_float(v[k] & 0xffff0000u)));
            *(LAS u32x4*)(SG + t * PQ + 8 * pc) = o; }
        u32x4 zf[2][2][2];
#pragma unroll
        for (int tt = 0; tt < 2; ++tt) { const size_t row = row0 + 16 * tt + r; const int c = 64 * wv + 16 * q;
#pragma unroll
            for (int dd = 0; dd < 2; ++dd) { zf[tt][dd][0] = *(const u32x4*)(Z + ((size_t)dd * NALL + row) * 512 + c); zf[tt][dd][1] = *(const u32x4*)(Z + ((size_t)dd * NALL + row) * 512 + c + 8); } }
        __syncthreads();
        f32x4 acc[4][2];
#pragma unroll
        for (int ci = 0; ci < 4; ++ci) { acc[ci][0] = (f32x4){0.f, 0.f, 0.f, 0.f}; acc[ci][1] = (f32x4){0.f, 0.f, 0.f, 0.f}; }
#pragma unroll
        for (int kk = 0; kk < 4; ++kk) { bf16x8 a[4];
            tr_frag4(a[0], a[1], a[2], a[3], tr_addr(g2_b, RP_G2P, 32 * kk, 64 * wv, r, q), 8u * RP_G2P, tr_addr(g2_b, RP_G2P, 32 * kk, 64 * wv + 16, r, q), 8u * RP_G2P,
                     tr_addr(g2_b, RP_G2P, 32 * kk, 64 * wv + 32, r, q), 8u * RP_G2P, tr_addr(g2_b, RP_G2P, 32 * kk, 64 * wv + 48, r, q), 8u * RP_G2P);
#pragma unroll
            for (int tt = 0; tt < 2; ++tt) { const bf16x8 bs = *(const LAS bf16x8*)(SG + (16 * tt + r) * PQ + 32 * kk + 8 * q);
#pragma unroll
                for (int ci = 0; ci < 4; ++ci) acc[ci][tt] = __builtin_amdgcn_mfma_f32_16x16x32_bf16(a[ci], bs, acc[ci][tt], 0, 0, 0); } }
#pragma unroll
        for (int tt = 0; tt < 2; ++tt) { const size_t row = row0 + 16 * tt + r; const int c = 64 * wv + 16 * q;
#pragma unroll
            for (int hh = 0; hh < 2; ++hh) { const u32x4 z0 = zf[tt][0][hh], z1 = zf[tt][1][hh]; u32x4 o;
#pragma unroll
                for (int k = 0; k < 4; ++k) { const f32x4 g = acc[2 * hh + (k >> 1)][tt]; const int jj = 2 * (k & 1);
                    o[k] = pack2((__uint_as_float(z0[k] << 16) + __uint_as_float(z1[k] << 16)) * g[jj], (__uint_as_float(z0[k] & 0xffff0000u) + __uint_as_float(z1[k] & 0xffff0000u)) * g[jj + 1]); }
                *(u32x4*)(Y + row * D + c + 8 * hh) = o; } }
    }
    __syncthreads();
}
#define XB_TMO      128
#define XB_XCNT(j)  (256  + 64 * (j))
#define XB_XSUB(j)  (1280 + 64 * (j))
#define XB_XGEN(j)  (2304 + 64 * (j))
#define XB_TOP      3328
#define XB_TOPGEN   3392
#define XCD_BAR_WORDS 3456
#define XB_SPIN_CAP (1u << 18)

__device__ __forceinline__ unsigned xb_ld(unsigned* p)              { return __hip_atomic_load(p, __ATOMIC_RELAXED, __HIP_MEMORY_SCOPE_AGENT); }
__device__ __forceinline__ unsigned xb_add(unsigned* p, unsigned v) { return __hip_atomic_fetch_add(p, v, __ATOMIC_RELAXED, __HIP_MEMORY_SCOPE_AGENT); }
__device__ __forceinline__ unsigned xb_xcc_id() { return (unsigned)__builtin_amdgcn_s_getreg((3 << 11) | 20) & 0xFu; }
#define XB_SPIN(cond, bar) do { unsigned _sp = 0; while (cond) { __builtin_amdgcn_s_sleep(1); \
    if ((++_sp & 255u) == 0u) { if (xb_ld(&(bar)[XB_TMO])) break; if (_sp > XB_SPIN_CAP) { atomicAdd(&(bar)[XB_TMO], 1u); break; } } } } while (0)

struct XcdBarrier {
    unsigned* bar; unsigned x;
    volatile LAS unsigned* st;
};

__device__ __forceinline__ XcdBarrier xcd_barrier_post(unsigned* bar, volatile LAS unsigned* st) {
    XcdBarrier b; b.bar = bar; b.x = xb_xcc_id(); b.st = st;
    if (threadIdx.x == 0) (void)xb_add(&bar[XB_XCNT(b.x)], 1u);
    return b;
}
__device__ __forceinline__ void xcd_barrier_complete(unsigned* bar, unsigned x, unsigned& nloc, unsigned& nx) {
    const unsigned G = gridDim.x * gridDim.y * gridDim.z;
    unsigned sum, cnt, mine, sp = 0u;
    for (;;) {
        sum = 0u; cnt = 0u; mine = 0u;
#pragma unroll
        for (unsigned j = 0; j < 16; ++j) { const unsigned c = xb_ld(&bar[XB_XCNT(j)]); sum += c; cnt += (c > 0u) ? 1u : 0u; mine = (j == x) ? c : mine; }
        if (sum == G) break;
        __builtin_amdgcn_s_sleep(1);
        if ((++sp & 255u) == 0u) { if (xb_ld(&bar[XB_TMO])) break; if (sp > XB_SPIN_CAP) { atomicAdd(&bar[XB_TMO], 1u); break; } }
    }
    nloc = mine > 0u ? mine : 1u; nx = cnt > 0u ? cnt : 1u;
}

__device__ __forceinline__ void xcd_barrier(const XcdBarrier& b) {
    asm volatile("s_waitcnt vmcnt(0)" ::: "memory");
    __syncthreads();
    if (threadIdx.x == 0) {
        unsigned* bar = b.bar;
        __builtin_amdgcn_s_waitcnt(0);
        unsigned nloc = b.st[0], nx = b.st[1];
        if (nloc == 0u) { xcd_barrier_complete(bar, b.x, nloc, nx); b.st[0] = nloc; b.st[1] = nx; }
        const unsigned old = xb_add(&bar[XB_XSUB(b.x)], 1u);
        const unsigned gen = old / nloc;
        if (old + 1u == (gen + 1u) * nloc) {
            __builtin_amdgcn_fence(__ATOMIC_RELEASE, "agent");
            asm volatile("s_waitcnt vmcnt(0)" ::: "memory");
            const unsigned og = xb_add(&bar[XB_TOP], 1u);
            const unsigned tg = og / nx;
            if (og + 1u == (tg + 1u) * nx) xb_add(&bar[XB_TOPGEN], 1u);
            else XB_SPIN(xb_ld(&bar[XB_TOPGEN]) == tg, bar);
            __builtin_amdgcn_fence(__ATOMIC_ACQUIRE, "agent");
            xb_add(&bar[XB_XGEN(b.x)], 1u);
            asm volatile("s_waitcnt vmcnt(0)" ::: "memory");
        } else {
            XB_SPIN(xb_ld(&bar[XB_XGEN(b.x)]) == gen, bar);
            __builtin_amdgcn_fence(__ATOMIC_ACQUIRE, "agent");
            asm volatile("s_waitcnt vmcnt(0)" ::: "memory");
        }
    }
    __syncthreads();
}
constexpr int SG_P = 72;
template <bool DUAL, class Epi> DI void small_gemm(LAS unsigned char* lds, const bf16_t* A, const bf16_t* Bt, int M, int N, int K, const Epi& E) {
    const int tid = mk_tid(), lane = tid & 63, wv = __builtin_amdgcn_readfirstlane(tid >> 6), r = lane & 15, q = lane >> 4, mt = wv & 3, nh = wv >> 2;
    constexpr int BUF = 3 * 64 * SG_P;
    LAS bf16_t* base = (LAS bf16_t*)lds;
    const int ntn = N / 64, ntiles = (M / 64) * ntn, nkc = K / 64, prow = tid >> 3, ppc = tid & 7;
    for (int tile = blockIdx.x; tile < ntiles; tile += gridDim.x) {
        const int tm = tile / ntn, tn = tile - tm * ntn;
        const int c0 = 64 * tn; const int brow0 = DUAL ? 256 * (c0 >> 7) + (c0 & 127) : c0;
        const bf16_t* ag = A + (size_t)(64 * tm + prow) * K + 8 * ppc; const bf16_t* bg = Bt + (size_t)(brow0 + prow) * K + 8 * ppc;
        f32x4 acc[2] = {(f32x4){0.f, 0.f, 0.f, 0.f}, (f32x4){0.f, 0.f, 0.f, 0.f}}, acc3[2] = {(f32x4){0.f, 0.f, 0.f, 0.f}, (f32x4){0.f, 0.f, 0.f, 0.f}};
        u32x4 ra = *(const u32x4*)ag, rb = *(const u32x4*)bg, rb3 = (u32x4){0u, 0u, 0u, 0u};
        if (DUAL) rb3 = *(const u32x4*)(bg + (size_t)128 * K);
        __syncthreads();
        { LAS bf16_t* S0 = base; *(LAS u32x4*)(S0 + prow * SG_P + 8 * ppc) = ra; *(LAS u32x4*)(S0 + 64 * SG_P + prow * SG_P + 8 * ppc) = rb; if (DUAL) *(LAS u32x4*)(S0 + 128 * SG_P + prow * SG_P + 8 * ppc) = rb3; }
        if (nkc > 1) { ra = *(const u32x4*)(ag + 64); rb = *(const u32x4*)(bg + 64); if (DUAL) rb3 = *(const u32x4*)(bg + (size_t)128 * K + 64); }
        __syncthreads();
        for (int kc = 0; kc < nkc; ++kc) {
            LAS bf16_t* As = base + (kc & 1) * BUF; LAS bf16_t* Bs = As + 64 * SG_P; LAS bf16_t* B3 = Bs + 64 * SG_P;
            if (kc + 1 < nkc) { LAS bf16_t* Sn = base + ((kc + 1) & 1) * BUF; *(LAS u32x4*)(Sn + prow * SG_P + 8 * ppc) = ra; *(LAS u32x4*)(Sn + 64 * SG_P + prow * SG_P + 8 * ppc) = rb; if (DUAL) *(LAS u32x4*)(Sn + 128 * SG_P + prow * SG_P + 8 * ppc) = rb3; }
            if (kc + 2 < nkc) { ra = *(const u32x4*)(ag + 64 * (kc + 2)); rb = *(const u32x4*)(bg + 64 * (kc + 2)); if (DUAL) rb3 = *(const u32x4*)(bg + (size_t)128 * K + 64 * (kc + 2)); }
#pragma unroll
            for (int kk = 0; kk < 2; ++kk) { const bf16x8 a = *(const LAS bf16x8*)(As + (16 * mt + r) * SG_P + 32 * kk + 8 * q);
#pragma unroll
                for (int x = 0; x < 2; ++x) { const bf16x8 bb = *(const LAS bf16x8*)(Bs + (16 * (2 * nh + x) + r) * SG_P + 32 * kk + 8 * q); acc[x] = __builtin_amdgcn_mfma_f32_16x16x32_bf16(bb, a, acc[x], 0, 0, 0);
                    if (DUAL) { const bf16x8 b3 = *(const LAS bf16x8*)(B3 + (16 * (2 * nh + x) + r) * SG_P + 32 * kk + 8 * q); acc3[x] = __builtin_amdgcn_mfma_f32_16x16x32_bf16(b3, a, acc3[x], 0, 0, 0); } } }
            __syncthreads();
        }
#pragma unroll
        for (int x = 0; x < 2; ++x) E(64 * tm + 16 * mt + r, c0 + 16 * (2 * nh + x) + 4 * q, acc[x], acc3[x]);
    }
    __syncthreads();
}
template <bool DUAL, class Epi> DI void small_gemm128(LAS unsigned char* lds, const bf16_t* A, const bf16_t* Bt, int M, int N, int K, const Epi& E) {
    const int tid = mk_tid(), lane = tid & 63, wv = __builtin_amdgcn_readfirstlane(tid >> 6), r = lane & 15, q = lane >> 4, wm = wv & 3, wn = wv >> 2;
    constexpr int NB = DUAL ? 4 : 2, BUF = (128 + 64 * NB) * SG_P;
    LAS bf16_t* base = (LAS bf16_t*)lds;
    const int ntn = N / 128, ntiles = (M / 128) * ntn, nkc = K / 64, prow = tid >> 3, ppc = tid & 7;
    const f32x4 z4 = (f32x4){0.f, 0.f, 0.f, 0.f};
    for (int tile = blockIdx.x; tile < ntiles; tile += gridDim.x) {
        const int tm = tile / ntn, tn = tile - tm * ntn;
        const bf16_t* ag = A + (size_t)(128 * tm + prow) * K + 8 * ppc; const bf16_t* bg = Bt + (size_t)((DUAL ? 256 : 128) * tn + prow) * K + 8 * ppc;
        f32x4 acc[2][4], acc3[2][4];
#pragma unroll
        for (int i = 0; i < 2; ++i)
#pragma unroll
            for (int x = 0; x < 4; ++x) { acc[i][x] = z4; acc3[i][x] = z4; }
        u32x4 ra[2], rb[NB];
#define SG_LOAD(kc_) { _Pragma("unroll") for (int i = 0; i < 2; ++i) ra[i] = *(const u32x4*)(ag + (size_t)64 * i * K + 64 * (kc_)); _Pragma("unroll") for (int i = 0; i < NB; ++i) rb[i] = *(const u32x4*)(bg + (size_t)64 * i * K + 64 * (kc_)); }
#define SG_STORE(S_) { _Pragma("unroll") for (int i = 0; i < 2; ++i) *(LAS u32x4*)((S_) + (prow + 64 * i) * SG_P + 8 * ppc) = ra[i]; _Pragma("unroll") for (int i = 0; i < NB; ++i) *(LAS u32x4*)((S_) + (128 + prow + 64 * i) * SG_P + 8 * ppc) = rb[i]; }
        SG_LOAD(0)
        __syncthreads();
        SG_STORE(base)
        if (nkc > 1) SG_LOAD(1)
        __syncthreads();
        for (int kc = 0; kc < nkc; ++kc) {
            LAS bf16_t* As = base + (kc & 1) * BUF; LAS bf16_t* Bs = As + 128 * SG_P;
            if (kc + 1 < nkc) { LAS bf16_t* Sn = base + ((kc + 1) & 1) * BUF; SG_STORE(Sn) }
            if (kc + 2 < nkc) SG_LOAD(kc + 2)
#pragma unroll
            for (int kk = 0; kk < 2; ++kk) { const bf16x8 a0 = *(const LAS bf16x8*)(As + (32 * wm + r) * SG_P + 32 * kk + 8 * q), a1 = *(const LAS bf16x8*)(As + (32 * wm + 16 + r) * SG_P + 32 * kk + 8 * q);
#pragma unroll
                for (int x = 0; x < 4; ++x) { const bf16x8 bb = *(const LAS bf16x8*)(Bs + (64 * wn + 16 * x + r) * SG_P + 32 * kk + 8 * q);
                    acc[0][x] = __builtin_amdgcn_mfma_f32_16x16x32_bf16(bb, a0, acc[0][x], 0, 0, 0); acc[1][x] = __builtin_amdgcn_mfma_f32_16x16x32_bf16(bb, a1, acc[1][x], 0, 0, 0);
                    if (DUAL) { const bf16x8 b3 = *(const LAS bf16x8*)(Bs + (128 + 64 * wn + 16 * x + r) * SG_P + 32 * kk + 8 * q);
                        acc3[0][x] = __builtin_amdgcn_mfma_f32_16x16x32_bf16(b3, a0, acc3[0][x], 0, 0, 0); acc3[1][x] = __builtin_amdgcn_mfma_f32_16x16x32_bf16(b3, a1, acc3[1][x], 0, 0, 0); } } }
            __syncthreads();
        }
#undef SG_LOAD
#undef SG_STORE
#pragma unroll
        for (int i = 0; i < 2; ++i)
#pragma unroll
            for (int x = 0; x < 4; ++x) E(128 * tm + 32 * wm + 16 * i + r, 128 * tn + 64 * wn + 16 * x + 4 * q, acc[i][x], acc3[i][x]);
    }
    __syncthreads();
}
template <class Epi> DI void small_gemm64k(LAS unsigned char* lds, const bf16_t* A, const bf16_t* Bt, int M, int N, int K, const Epi& E) {
    const int tid = mk_tid(), lane = tid & 63, wv = __builtin_amdgcn_readfirstlane(tid >> 6), r = lane & 15, q = lane >> 4, mt = wv & 3, nh = wv >> 2;
    constexpr int PK = 136, BUF = 2 * 64 * PK;
    LAS bf16_t* base = (LAS bf16_t*)lds;
    const int ntn = N / 64, ntiles = (M / 64) * ntn, nkc = K / 128, prow = tid >> 4, ppc = tid & 15;
    const f32x4 z4 = (f32x4){0.f, 0.f, 0.f, 0.f};
    for (int tile = blockIdx.x; tile < ntiles; tile += gridDim.x) {
        const int tm = tile / ntn, tn = tile - tm * ntn;
        const bf16_t* ag = A + (size_t)(64 * tm + prow) * K + 8 * ppc; const bf16_t* bg = Bt + (size_t)(64 * tn + prow) * K + 8 * ppc;
        f32x4 acc[2] = {z4, z4};
        u32x4 ra[2], rb[2];
#define SK_LOAD(kc_) { _Pragma("unroll") for (int i = 0; i < 2; ++i) { ra[i] = *(const u32x4*)(ag + (size_t)32 * i * K + 128 * (kc_)); rb[i] = *(const u32x4*)(bg + (size_t)32 * i * K + 128 * (kc_)); } }
#define SK_STORE(S_) { _Pragma("unroll") for (int i = 0; i < 2; ++i) { *(LAS u32x4*)((S_) + (prow + 32 * i) * PK + 8 * ppc) = ra[i]; *(LAS u32x4*)((S_) + (64 + prow + 32 * i) * PK + 8 * ppc) = rb[i]; } }
        SK_LOAD(0)
        __syncthreads();
        SK_STORE(base)
        if (nkc > 1) SK_LOAD(1)
        __syncthreads();
        for (int kc = 0; kc < nkc; ++kc) {
            LAS bf16_t* As = base + (kc & 1) * BUF; LAS bf16_t* Bs = As + 64 * PK;
            if (kc + 1 < nkc) { LAS bf16_t* Sn = base + ((kc + 1) & 1) * BUF; SK_STORE(Sn) }
            if (kc + 2 < nkc) SK_LOAD(kc + 2)
#pragma unroll
            for (int kk = 0; kk < 4; ++kk) { const bf16x8 a = *(const LAS bf16x8*)(As + (16 * mt + r) * PK + 32 * kk + 8 * q);
#pragma unroll
                for (int x = 0; x < 2; ++x) { const bf16x8 bb = *(const LAS bf16x8*)(Bs + (16 * (2 * nh + x) + r) * PK + 32 * kk + 8 * q); acc[x] = __builtin_amdgcn_mfma_f32_16x16x32_bf16(bb, a, acc[x], 0, 0, 0); } }
            __syncthreads();
        }
#undef SK_LOAD
#undef SK_STORE
#pragma unroll
        for (int x = 0; x < 2; ++x) E(64 * tm + 16 * mt + r, 64 * tn + 16 * (2 * nh + x) + 4 * q, acc[x], z4);
    }
    __syncthreads();
}
struct SEpiStore3 { bf16_t* p0; int ld0; int c1; bf16_t* p1; int ld1; int c2; bf16_t* p2; int ld2;
    DI void operator()(int m, int c, const f32x4& v, const f32x4&) const { bf16_t* base; int ld, cc;
        if (c >= c2) { base = p2; ld = ld2; cc = c - c2; } else if (c >= c1) { base = p1; ld = ld1; cc = c - c1; } else { base = p0; ld = ld0; cc = c; }
        *(u32x2*)(base + (size_t)(NLAT + m) * ld + cc) = pack4(v[0], v[1], v[2], v[3]); } };
struct SEpiResid { const float* cin; float* cout; const float* gate;
    DI void operator()(int m, int c, const f32x4& v, const f32x4&) const { const f32x4 g = *(const f32x4*)(gate + c), bs = *(const f32x4*)(cin + (size_t)m * D + c); *(f32x4*)(cout + (size_t)m * D + c) = bs + g * v; } };
struct SEpiSwiglu { bf16_t* G;
    DI void operator()(int m, int c, const f32x4& a, const f32x4& b) const { float g[4];
#pragma unroll
        for (int j = 0; j < 4; ++j) g[j] = a[j] * frcp(1.f + fexp(-a[j])) * b[j];
        *(u32x2*)(G + (size_t)(NLAT + m) * DFF + c) = pack4(g[0], g[1], g[2], g[3]); } };
DI void phase_mlstm_post(const P& p) {
    const bf16_t* ML = (const bf16_t*)(p.ws + WS_COLS) + OFF_ML;
    phase_headnorm_post((const bf16_t*)(p.ws + WS_ACT), p.in[I_MNG], ML + 1536, 2048, 0, (bf16_t*)(p.ws + WS_COLS), 512, NALL, false);
}
DI void phase_hgrn_post(const P& p) {
    const bf16_t* C1 = (const bf16_t*)(p.ws + WS_COLS);
    phase_headnorm_post((const bf16_t*)(p.ws + WS_ACT), p.in[I_HNG], C1 + 2048, C1LD, 1, (bf16_t*)((unsigned char*)p.out), 0, NLAT, true);
}

constexpr int N_PHASES = 19;
__global__ void __launch_bounds__(NT, 2) mk_fwd(P p) {
    extern __shared__ __attribute__((aligned(16))) unsigned char lds_raw[];
    LAS unsigned char* lds = (LAS unsigned char*)lds_raw;
    cooperative_groups::grid_group grid = cooperative_groups::this_grid();
    const int lo = p.ph_lo, hi = p.ph_hi;
    unsigned long long pt0 = 0ull, ptacc = 0ull;
    if (MK_PTIME == 99 || MK_PTIME == 98) pt0 = __builtin_amdgcn_s_memrealtime();
    volatile LAS unsigned* xst = (volatile LAS unsigned*)(lds + LDS_BYTES - 16);
    if (threadIdx.x < 4) xst[threadIdx.x] = 0u;
    __syncthreads();
    const XcdBarrier xbar = xcd_barrier_post((unsigned*)(p.ws + WS_CTL) + 8192, xst);
#define IN(k) (lo <= (k) && (k) < hi)
#define SEAM(k) do { if (IN(k) && IN((k) + 1)) xcd_barrier(xbar); } while (0)
#ifndef MK_STAG
#define MK_STAG 0
#endif
#ifndef MK_DUP
#define MK_DUP -1
#endif
#ifndef MK_PTIME
#define MK_PTIME -1
#endif
#define PHASE(k, ...) if (IN(k)) { if (MK_PTIME == (k)) pt0 = __builtin_amdgcn_s_memrealtime(); __VA_ARGS__ if (MK_DUP == (k)) { grid.sync(); __VA_ARGS__ } } SEAM(k); if (MK_PTIME == (k)) ptacc = __builtin_amdgcn_s_memrealtime() - pt0;
#define PHASE_NS(k, ...) if (IN(k)) { __VA_ARGS__ } if (IN(k) && IN((k) + 1)) sub_signal(cnt23);
    unsigned char* ws = p.ws;
    const float* MODV = (const float*)(ws + WS_MODV);
    float* HC = (float*)(ws + WS_HC);
    float* SSQP = (float*)(ws + WS_SSQP); const float* GSC = (const float*)(ws + WS_GSC); const float* SHW = GSC + SHW_OFF;
    bf16_t* ACT = (bf16_t*)(ws + WS_ACT); bf16_t* COLS = (bf16_t*)(ws + WS_COLS); bf16_t* Y1 = (bf16_t*)p.out; bf16_t* RES = (bf16_t*)(ws + WS_Z);
    if (MK_PTIME == 98) ptacc = __builtin_amdgcn_s_memrealtime() - pt0;
    PHASE(1, { unsigned* mcnt = (unsigned*)(p.ws + WS_CTL) + 12000; phase_modv(p, lds); sub_signal(mcnt); phase_wprep(p, lds); sub_wait(mcnt, (unsigned)gridDim.x); phase_modnorm<false>(p, 0, 0, p.in[I_X], p.in[I_CTX], NALL, false); })
    unsigned* cnt23 = (unsigned*)(p.ws + WS_CTL) + 12064;
    PHASE(2, { EpiStore3 E{COLS + OFF_RW, 1536, 6, COLS + OFF_LO, 512, 8, COLS + OFF_ML, 2048, 0}; run_gemm(lds, ACT, (const bf16_t*)(ws + WS_W_EVIN), NLAT, 4096, 1024, E, MK_STAG); SEpiStore3 S{COLS + OFF_RW, 1536, 1536, COLS + OFF_LO, 512, 2048, COLS + OFF_ML, 2048}; small_gemm128<false>(lds, ACT + (size_t)NLAT * 1024, (const bf16_t*)(ws + WS_W_EVIN), NCTX, 4096, 1024, S); })
    PHASE(3, { const int bx = (int)blockIdx.x;
        if (gridDim.x == 256) { if (bx < 64) { unsigned long long q0 = 0ull; if (MK_PTIME == 304) q0 = __builtin_amdgcn_s_memrealtime(); rwkv_main2_unit(p, lds, bx); if (MK_PTIME == 304 && bx == 0 && threadIdx.x == 0) { const unsigned long long dt = __builtin_amdgcn_s_memrealtime() - q0, t0 = __builtin_amdgcn_s_memrealtime(); while (__builtin_amdgcn_s_memrealtime() - t0 < dt) __builtin_amdgcn_s_sleep(8); } __syncthreads(); }
            else if (bx < 192) { unsigned long long q0 = 0ull; if (MK_PTIME == 305) q0 = __builtin_amdgcn_s_memrealtime(); rwkv_chunk_unit<2>(p, lds, (bx - 64) & 63, (bx - 64) >> 6); if (MK_PTIME == 305 && bx == 64 && threadIdx.x == 0) { const unsigned long long dt = __builtin_amdgcn_s_memrealtime() - q0, t0 = __builtin_amdgcn_s_memrealtime(); while (__builtin_amdgcn_s_memrealtime() - t0 < dt) __builtin_amdgcn_s_sleep(8); } __syncthreads(); } else { unsigned long long q0 = 0ull; if (MK_PTIME == 303) q0 = __builtin_amdgcn_s_memrealtime(); gla_unit<0>(p, lds, bx - 192); if (MK_DUP == 503) gla_unit<0>(p, lds, bx - 192);
            unsigned long long dt303 = 0ull; if (MK_PTIME == 303) dt303 = __builtin_amdgcn_s_memrealtime() - q0;
            rwkv_chunk_unit<2>(p, lds, bx - 192, 2);
            if (MK_PTIME == 303 && threadIdx.x == 0) { const unsigned long long t0 = __builtin_amdgcn_s_memrealtime(); while (__builtin_amdgcn_s_memrealtime() - t0 < dt303) __builtin_amdgcn_s_sleep(8); } __syncthreads(); } }
        else { for (int vb = bx; vb < 128; vb += gridDim.x) { if (vb < 64) rwkv_chunk_unit<0>(p, lds, vb); else gla_unit<0>(p, lds, vb - 64); } } })
    if (IN(3) && MK_DUP == 303) { grid.sync(); if (blockIdx.x < 64) rwkv_chunk_unit<1>(p, lds, blockIdx.x); grid.sync(); }
    if (IN(3) && MK_DUP == 403) { grid.sync(); if (blockIdx.x >= 64 && blockIdx.x < 128) rwkv_chunk_unit<2>(p, lds, blockIdx.x - 64, 0); grid.sync(); }
    if (IN(3) && MK_DUP == 103) { grid.sync(); for (int vb = blockIdx.x; vb < 64; vb += gridDim.x) rwkv_chunk_unit<0>(p, lds, vb); grid.sync(); }
    if (IN(3) && MK_DUP == 203) { grid.sync(); for (int vb = blockIdx.x; vb < 64; vb += gridDim.x) gla_unit<0>(p, lds, vb); grid.sync(); }
    PHASE(4, phase_mlstm_post(p); phase_rwkv_post2(p, lds);)
    PHASE(5, { EpiResidB<false> E{p.in[I_X], RES, MODV, 2}; run_gemm(lds, COLS, (const bf16_t*)(ws + WS_W_EVOUT), NLAT, 1024, 1024, E); SEpiResid S{p.in[I_CTX], HC, MODV + 4 * 6144 + 2 * 1024}; small_gemm64k(lds, COLS + (size_t)NLAT * 1024, (const bf16_t*)(ws + WS_W_EVOUT), NCTX, 1024, 1024, S); })
    PHASE(6, phase_modnorm<true>(p, 0, 1, RES, HC, NALL, false);)
    PHASE(7, { EpiSwiglu E{COLS, 0}; run_gemm(lds, ACT, (const bf16_t*)(ws + WS_W_UP), NLAT, 5632, 1024, E, MK_STAG); SEpiSwiglu S{COLS}; small_gemm128<true>(lds, ACT + (size_t)NLAT * 1024, (const bf16_t*)(ws + WS_W_UP), NCTX, 2816, 1024, S); })
    PHASE(8, { EpiResidB<true> E{RES, RES, MODV, 5}; run_gemm(lds, COLS, (const bf16_t*)(ws + WS_W_DN), NLAT, 1024, 2816, E); SEpiResid S{HC, HC, MODV + 4 * 6144 + 5 * 1024}; small_gemm64k(lds, COLS + (size_t)NLAT * 2816, (const bf16_t*)(ws + WS_W_DN), NCTX, 1024, 2816, S); })
    PHASE(9, phase_modnorm<true>(p, 1, 0, RES, HC, NALL, true);)
    PHASE(10, { EpiStore3 E{COLS, C1LD, 1 << 30, COLS, C1LD, 1 << 30, COLS, C1LD, 0}; run_gemm(lds, ACT, (const bf16_t*)(ws + WS_W_ODIN), NLAT, 3584, 1024, E, MK_STAG); SEpiStore3 S{COLS, C1LD, 1 << 30, COLS, C1LD, 1 << 30, COLS, C1LD}; small_gemm128<false>(lds, ACT + (size_t)NLAT * 1024, (const bf16_t*)(ws + WS_W_ODIN), NCTX, 3584, 1024, S); })
    PHASE(11, if (MK_PTIME == 111) pt0 = __builtin_amdgcn_s_memrealtime(); phase_hgrn_prep2(p, lds); if (MK_PTIME == 111) ptacc = __builtin_amdgcn_s_memrealtime() - pt0; lru_pass<1>(p, lds, (int)blockIdx.x, (int)gridDim.x);)
    PHASE(12, { const int half = (int)gridDim.x >> 1; if ((int)blockIdx.x < half) { unsigned long long q0 = 0ull; if (MK_PTIME == 312) q0 = __builtin_amdgcn_s_memrealtime(); for (int u = blockIdx.x; u < 128; u += half) gla_unit<1>(p, lds, u); if (MK_PTIME == 312 && blockIdx.x == 0 && threadIdx.x == 0) { const unsigned long long dt = __builtin_amdgcn_s_memrealtime() - q0, t0 = __builtin_amdgcn_s_memrealtime(); while (__builtin_amdgcn_s_memrealtime() - t0 < dt) __builtin_amdgcn_s_sleep(8); } __syncthreads(); } else lru_pass<3>(p, lds, (int)blockIdx.x - half, (int)gridDim.x - half); })
    if (IN(12) && MK_DUP == 112) { grid.sync(); lru_pass<3>(p, lds, (int)blockIdx.x, (int)gridDim.x); grid.sync(); }
    if (IN(12) && MK_DUP == 212) { grid.sync(); for (int vb = blockIdx.x; vb < 128; vb += gridDim.x) gla_unit<1>(p, lds, vb); grid.sync(); }
    PHASE(13, phase_hgrn_post(p);)
    PHASE(14, EpiResidB<true> E{RES, RES, MODV + 5 * 6144, 2}; run_gemm(lds, Y1, (const bf16_t*)(ws + WS_W_ODOUT), NLAT, 1024, 1024, E);)
    PHASE(15, phase_modnorm<true>(p, 1, 1, RES, HC, NLAT, false);)
    PHASE(16, EpiSwiglu E{COLS, 0}; run_gemm(lds, ACT, (const bf16_t*)(ws + WS_W_UP) + W_UP_STRIDE, NLAT, 5632, 1024, E, MK_STAG);)
    PHASE(17, EpiResidB<true> E{RES, RES, MODV + 5 * 6144, 5}; run_gemm(lds, COLS, (const bf16_t*)(ws + WS_W_DN) + W_DN_STRIDE, NLAT, 1024, 2816, E);)
    PHASE(18, phase_finalnorm(p);)
    if (MK_PTIME == 99) ptacc = __builtin_amdgcn_s_memrealtime() - pt0;
    if (MK_PTIME >= 0 && blockIdx.x == 0 && threadIdx.x == 0) { const unsigned long long t0 = __builtin_amdgcn_s_memrealtime(); while (__builtin_amdgcn_s_memrealtime() - t0 < 4ull * ptacc) __builtin_amdgcn_s_sleep(8); }
    if (hi > 4096) grid.sync();
#undef IN
#undef SEAM
}
}

#ifndef MK_ONE_LAUNCH
#define MK_ONE_LAUNCH 1
#endif
extern "C" void kernel_launch(void* const* d_in, const int* in_sizes, int n_in, void* d_out, int out_size, void* d_ws, size_t ws_size, hipStream_t stream) {
    using namespace mk;
    static int grid = 0;
    if (grid == 0) {
        int dev = 0, cus = 0, per_cu = 0;
        if (n_in != N_IN || ws_size < WS_END) { fprintf(stderr, "kernel_launch: unexpected n_in %d / ws_size %zu\n", n_in, ws_size); grid = -1; return; }
        (void)hipGetDevice(&dev); (void)hipDeviceGetAttribute(&cus, hipDeviceAttributeMultiprocessorCount, dev);
        (void)hipFuncSetAttribute((const void*)mk_fwd, hipFuncAttributeMaxDynamicSharedMemorySize, LDS_BYTES);
        (void)hipOccupancyMaxActiveBlocksPerMultiprocessor(&per_cu, (const void*)mk_fwd, NT, LDS_BYTES);
        if (per_cu < 1) { fprintf(stderr, "kernel_launch: occupancy query says %d blocks per CU\n", per_cu); per_cu = 1; }
        (void)hipGetLastError();
        grid = cus;
    }
    if (grid < 0) return;
    if (hipMemsetAsync((char*)d_ws + WS_CTL, 0, 65536, stream) != hipSuccess) { fprintf(stderr, "kernel_launch: memset of the control words failed\n"); return; }
    P p{};
    for (int i = 0; i < N_IN; ++i) p.in[i] = (const float*)d_in[i];
    p.out = (float*)d_out; p.ws = (unsigned char*)d_ws;
#if MK_ONE_LAUNCH
    p.ph_lo = 0; p.ph_hi = N_PHASES;
    void* args[] = {&p};
    hipError_t e = hipLaunchCooperativeKernel((const void*)mk_fwd, dim3(grid), dim3(NT), args, LDS_BYTES, stream);
    if (e != hipSuccess) fprintf(stderr, "cooperative launch failed: %s (grid %d)\n", hipGetErrorString(e), grid);
#else
    for (int k = 0; k < N_PHASES; ++k) { p.ph_lo = k; p.ph_hi = k + 1; hipLaunchKernelGGL(mk_fwd, dim3(grid), dim3(NT), LDS_BYTES, stream, p); }
#endif
}
```
